# Optimizing an MI355X kernel written in HIP

```python
import jax, jax.numpy as jnp
from jax import lax
import numpy as np

D_MODEL = 1024
BATCH = 8
SEQ = 2048
DEPTH = 2

GRID_W = 64
CTX_LEN = 256

A_HEADS = 8
A_KV_HEADS = 2
A_HEAD_DIM = 64
A_WINDOW = 128
A_BLOCK = 128
ROPE_BASE = 10000.0
B_HEADS = 4
B_DK = 128
B_DV = 128
C_HEADS = 4
C_DK = 96
C_DV = 192
C_GATE_RANK = 16
C_GATE_TAU = 16.0
D_GROUPS = 4
D_GROUP_DIM = 64
CHUNK = 64
N_EXPERTS = 16
N_GROUPS = 4
E_PER_GROUP = N_EXPERTS // N_GROUPS
TOP_K = 2
D_FF = 512

N_EVEN = (DEPTH + 1) // 2
N_ODD = DEPTH // 2
A_Q = A_HEADS * A_HEAD_DIM
A_KV = A_KV_HEADS * A_HEAD_DIM
B_KW = B_HEADS * B_DK
B_VW = B_HEADS * B_DV
C_KW = C_HEADS * C_DK
C_VW = C_HEADS * C_DV
D_W = D_GROUPS * D_GROUP_DIM
IN_EVEN = A_Q + 2 * A_KV + 3 * B_KW + 2 * B_VW
MIX_EVEN = A_Q + B_VW
IN_ODD = 2 * C_KW + 2 * C_VW + 2 * C_GATE_RANK + D_W
MIX_ODD = C_VW + D_W
DEEPNORM_ALPHA = (2 * DEPTH) ** 0.25
DEEPNORM_BETA = (8 * DEPTH) ** -0.25
LN_EPS = 1e-5
NEG = -1e30

kernel_name = "hybrid_dit_swa_hgrn2_gla_fnet_moe"


def layer_norm(x):
    xf = x.astype(jnp.float32)
    mu = jnp.mean(xf, -1, keepdims=True)
    var = jnp.mean(jnp.square(xf - mu), -1, keepdims=True)
    return ((xf - mu) * lax.rsqrt(var + LN_EPS)).astype(x.dtype)


def layer_norm_affine(x, g, b):
    xf = x.astype(jnp.float32)
    mu = jnp.mean(xf, -1, keepdims=True)
    var = jnp.mean(jnp.square(xf - mu), -1, keepdims=True)
    return ((xf - mu) * lax.rsqrt(var + LN_EPS) * g + b).astype(x.dtype)


def head_rms_norm(z, g, n_heads):
    B, T, W = z.shape
    zf = z.astype(jnp.float32).reshape(B, T, n_heads, W // n_heads)
    zf = zf * lax.rsqrt(jnp.mean(jnp.square(zf), -1, keepdims=True) + LN_EPS)
    return (zf.reshape(B, T, W) * g).astype(z.dtype)


def split_cols(p, sizes):
    offs = np.cumsum(sizes)[:-1]
    return jnp.split(p, [int(o) for o in offs], axis=-1)


def to_heads(z, n_heads):
    B, T, _ = z.shape
    return z.reshape(B, T, n_heads, -1).transpose(0, 2, 1, 3)


def from_heads(z):
    B, H, T, d = z.shape
    return z.transpose(0, 2, 1, 3).reshape(B, T, H * d)


def rope_half(x, pos):
    half = x.shape[-1] // 2
    inv = ROPE_BASE ** (-jnp.arange(half, dtype=jnp.float32) / half)
    ang = pos.astype(jnp.float32)[:, None] * inv[None, :]
    cos, sin = jnp.cos(ang), jnp.sin(ang)
    x1 = x[..., :half].astype(jnp.float32)
    x2 = x[..., half:].astype(jnp.float32)
    return jnp.concatenate([x1 * cos - x2 * sin, x1 * sin + x2 * cos], -1)


def axial_rope(x, rows, cols):
    r = x.shape[-1] // 2
    return jnp.concatenate([rope_half(x[..., :r], rows), rope_half(x[..., r:], cols)], -1).astype(x.dtype)


def window_attention(q, k, v, kc, vc, sink):
    B, Hkv, G, T, hd = q.shape
    nb = T // A_BLOCK
    scale = hd ** -0.5
    qb = q.reshape(B, Hkv, G, nb, A_BLOCK, hd)
    pad = ((0, 0), (0, 0), (A_BLOCK, A_BLOCK), (0, 0))
    kp = jnp.pad(k, pad).reshape(B, Hkv, nb + 2, A_BLOCK, hd)
    vp = jnp.pad(v, pad).reshape(B, Hkv, nb + 2, A_BLOCK, hd)
    kband = jnp.concatenate([kp[:, :, 0:nb], kp[:, :, 1:nb + 1], kp[:, :, 2:nb + 2]], axis=3)
    vband = jnp.concatenate([vp[:, :, 0:nb], vp[:, :, 1:nb + 1], vp[:, :, 2:nb + 2]], axis=3)
    qpos = jnp.arange(T).reshape(nb, A_BLOCK)
    kpos = jnp.arange(nb)[:, None] * A_BLOCK - A_BLOCK + jnp.arange(3 * A_BLOCK)[None, :]
    valid = ((kpos[:, None, :] >= 0) & (kpos[:, None, :] < T)
             & (jnp.abs(qpos[:, :, None] - kpos[:, None, :]) <= A_WINDOW))
    s_band = jnp.einsum('bhgnqd,bhnkd->bhgnqk', qb, kband).astype(jnp.float32) * scale
    s_band = jnp.where(valid, s_band, NEG)
    s_ctx = jnp.einsum('bhgnqd,bhcd->bhgnqc', qb, kc).astype(jnp.float32) * scale
    s_sink = jnp.broadcast_to(sink.astype(jnp.float32)[None, :, :, None, None, None], (B, Hkv, G, nb, A_BLOCK, 1))
    p = jax.nn.softmax(jnp.concatenate([s_sink, s_ctx, s_band], -1), -1)
    C = kc.shape[2]
    p_ctx = p[..., 1:1 + C].astype(v.dtype)
    p_band = p[..., 1 + C:].astype(v.dtype)
    o = (jnp.einsum('bhgnqc,bhcd->bhgnqd', p_ctx, vc)
         + jnp.einsum('bhgnqk,bhnkd->bhgnqd', p_band, vband))
    return o.reshape(B, Hkv, G, T, hd)


def context_attention(qc, kc, vc, sink):
    B, Hkv, G, C, hd = qc.shape
    s = jnp.einsum('bhgqd,bhkd->bhgqk', qc, kc).astype(jnp.float32) * hd ** -0.5
    s0 = jnp.broadcast_to(sink.astype(jnp.float32)[None, :, :, None, None], (B, Hkv, G, C, 1))
    p = jax.nn.softmax(jnp.concatenate([s0, s], -1), -1)[..., 1:]
    return jnp.einsum('bhgqk,bhkd->bhgqd', p.astype(vc.dtype), vc)


def chunk_gated_scan(q, k, v, log_f, s0):
    B, H, T, dk = q.shape
    dv = v.shape[-1]
    L = CHUNK
    N = T // L
    f32 = jnp.float32
    qf = q.astype(f32).reshape(B, H, N, L, dk)
    kf = k.astype(f32).reshape(B, H, N, L, dk)
    vf = v.astype(f32).reshape(B, H, N, L, dv)
    b = jnp.cumsum(log_f.astype(f32).reshape(B, H, N, L, dk), axis=3)
    g = b[:, :, :, L - 1:L, :]
    ref = b[:, :, :, L // 2:L // 2 + 1, :]
    att = jnp.einsum('bhnld,bhnmd->bhnlm', qf * jnp.exp(b - ref), kf * jnp.exp(ref - b))
    att = jnp.where(jnp.tril(jnp.ones((L, L), dtype=bool)), att, 0.0)
    o = jnp.einsum('bhnlm,bhnme->bhnle', att, vf)
    ds = jnp.einsum('bhnld,bhnle->nbhde', kf * jnp.exp(g - b), vf)
    decay = jnp.exp(g[:, :, :, 0, :]).transpose(2, 0, 1, 3)

    def step(s, inp):
        d, dsn = inp
        return s * d[..., None] + dsn, s

    s_last, s_start = lax.scan(step, s0, (decay, ds))
    o = o + jnp.einsum('bhnld,nbhde->bhnle', qf * jnp.exp(b), s_start)
    return o.reshape(B, H, T, dv).astype(v.dtype), s_last


def bidir_scan(q_c, v_c, kc_dirs, q_l, v_l, kl_dirs):
    B, H, _, dk = q_c.shape
    dv = v_c.shape[-1]
    s0 = jnp.zeros((B, H, dk, dv), jnp.float32)
    (kcf, lcf), (kcb, lcb) = kc_dirs
    (klf, llf), (klb, llb) = kl_dirs
    fl = lambda a: jnp.flip(a, axis=2)
    oc_f, sc_f = chunk_gated_scan(q_c, kcf, v_c, lcf, s0)
    oc_b, sc_b = chunk_gated_scan(fl(q_c), fl(kcb), fl(v_c), fl(lcb), s0)
    ol_f, _ = chunk_gated_scan(q_l, klf, v_l, llf, sc_f)
    ol_b, _ = chunk_gated_scan(fl(q_l), fl(klb), fl(v_l), fl(llb), sc_b)
    return oc_f + fl(oc_b), ol_f + fl(ol_b)


def fourier_mix(z):
    B, T, W = z.shape
    zf = z.astype(jnp.float32).reshape(B, T, D_GROUPS, D_GROUP_DIM)
    y = jnp.fft.fft2(zf, axes=(1, 3), norm='ortho').real
    return y.reshape(B, T, W).astype(z.dtype)


def mixer_even(u, uc, w_in, sink, lb_logits, idx, g_norm, w_out, rows, cols, need_ctx):
    sizes = (A_Q, A_KV, A_KV, B_KW, B_KW, B_KW, B_VW, B_VW)
    aq, ak, av, ff, fb, hq, hi, hg = split_cols(u @ w_in, sizes)
    caq, cak, cav, cff, cfb, chq, chi, chg = split_cols(uc @ w_in, sizes)
    G = A_HEADS // A_KV_HEADS
    sink = sink.reshape(A_KV_HEADS, G)
    q = axial_rope(to_heads(aq, A_HEADS), rows, cols)
    B, _, T, hd = q.shape
    q = q.reshape(B, A_KV_HEADS, G, T, hd)
    k = axial_rope(to_heads(ak, A_KV_HEADS), rows, cols)
    v = to_heads(av, A_KV_HEADS)
    kc = to_heads(cak, A_KV_HEADS)
    vc = to_heads(cav, A_KV_HEADS)
    o_att = from_heads(window_attention(q, k, v, kc, vc, sink).reshape(B, A_HEADS, T, hd))
    lb = jnp.cumsum(jax.nn.softmax(lb_logits.astype(jnp.float32), axis=1), axis=1)[:, idx]

    def gates(z, lb_d):
        f = lb_d + (1.0 - lb_d) * jax.nn.sigmoid(z.astype(jnp.float32))
        return to_heads((1.0 - f).astype(z.dtype), B_HEADS), to_heads(jnp.log(f), B_HEADS)

    o_c, o_l = bidir_scan(to_heads(chq, B_HEADS), to_heads(chi, B_HEADS), (gates(cff, lb[0]), gates(cfb, lb[1])),
                          to_heads(hq, B_HEADS), to_heads(hi, B_HEADS), (gates(ff, lb[0]), gates(fb, lb[1])))
    o_rec = head_rms_norm(from_heads(o_l), g_norm, B_HEADS) * jax.nn.silu(hg)
    y = jnp.concatenate([o_att, o_rec], -1) @ w_out
    if not need_ctx:
        return y, None
    qc = to_heads(caq, A_HEADS)
    C = qc.shape[2]
    qc = qc.reshape(B, A_KV_HEADS, G, C, hd)
    o_att_c = from_heads(context_attention(qc, kc, vc, sink).reshape(B, A_HEADS, C, hd))
    o_rec_c = head_rms_norm(from_heads(o_c), g_norm, B_HEADS) * jax.nn.silu(chg)
    yc = jnp.concatenate([o_att_c, o_rec_c], -1) @ w_out
    return y, yc


def mixer_odd(u, uc, w_in, gate_w, gate_b, g_norm, w_out, need_ctx):
    sizes = (C_KW, C_KW, C_VW, C_GATE_RANK, C_GATE_RANK, C_VW, D_W)

    def gla_inputs(p):
        q, k, v, rf, rb, g, z = split_cols(p, sizes)

        def decay(r, d):
            zz = (r @ gate_w[d] + gate_b[d]).astype(jnp.float32)
            return to_heads(jax.nn.log_sigmoid(zz) / C_GATE_TAU, C_HEADS)

        kh = to_heads(k, C_HEADS)
        return (to_heads(q * (C_DK ** -0.5), C_HEADS), to_heads(v, C_HEADS),
                ((kh, decay(rf, 0)), (kh, decay(rb, 1))), g, z)

    q, v, kd, g, z = gla_inputs(u @ w_in)
    qc, vc, kdc, gc, zc = gla_inputs(uc @ w_in)
    o_c, o_l = bidir_scan(qc, vc, kdc, q, v, kd)
    o_gla = head_rms_norm(from_heads(o_l), g_norm, C_HEADS) * jax.nn.silu(g)
    y = jnp.concatenate([o_gla, fourier_mix(z)], -1) @ w_out
    if not need_ctx:
        return y, None
    o_gla_c = head_rms_norm(from_heads(o_c), g_norm, C_HEADS) * jax.nn.silu(gc)
    yc = jnp.concatenate([o_gla_c, fourier_mix(zc)], -1) @ w_out
    return y, yc


def moe(t, w_router, b_router, w1, w3, w2):
    N = t.shape[0]
    probs = jax.nn.softmax((t @ w_router).astype(jnp.float32), -1)
    sel = probs + b_router.astype(jnp.float32)
    grp_score = jnp.sum(lax.top_k(sel.reshape(N, N_GROUPS, E_PER_GROUP), TOP_K)[0], -1)
    best = jnp.argmax(grp_score, -1)
    in_grp = (jnp.arange(N_EXPERTS) // E_PER_GROUP)[None, :] == best[:, None]
    _, idx = lax.top_k(jnp.where(in_grp, sel, NEG), TOP_K)
    w = jnp.take_along_axis(probs, idx, -1)
    w = w / jnp.sum(w, -1, keepdims=True)
    gates = jnp.sum(jax.nn.one_hot(idx, N_EXPERTS, dtype=jnp.float32) * w[..., None], axis=1)
    y = jnp.zeros(t.shape, jnp.float32)
    for e in range(N_EXPERTS):
        h = jax.nn.silu(t @ w1[e]) * (t @ w3[e])
        y = y + gates[:, e:e + 1] * (h @ w2[e])
    return y.astype(t.dtype)


def modulate(x, shift, scale):
    return x * (1.0 + scale) + shift


def setup_inputs(seed: int = 0) -> dict:
    key = jax.random.key(seed)
    ks = jax.random.split(key, 24)
    f32 = jnp.float32
    D = D_MODEL

    def nrm(k, shape, scale):
        return jax.random.normal(k, shape, f32) * scale

    return {
        'x': nrm(ks[0], (BATCH, SEQ, D), 1.0),
        'c': nrm(ks[1], (BATCH, D), 1.0),
        'ctx': nrm(ks[2], (BATCH, CTX_LEN, D), 1.0),
        'c_ctx': nrm(ks[3], (D,), 1.0),
        'w_ada': nrm(ks[4], (DEPTH, D, 6 * D), 0.5 * D ** -0.5),
        'b_ada': nrm(ks[5], (DEPTH, 6 * D), 0.02),
        'ln_g': 1.0 + nrm(ks[6], (DEPTH, 2, D), 0.02),
        'ln_b': nrm(ks[7], (DEPTH, 2, D), 0.02),
        'w_in_even': nrm(ks[8], (N_EVEN, D, IN_EVEN), D ** -0.5),
        'attn_sink': nrm(ks[9], (N_EVEN, A_HEADS), 0.5),
        'hgrn_lb_logits': nrm(ks[10], (2, N_EVEN + 1, B_KW), 0.5),
        'hgrn_norm': 1.0 + nrm(ks[11], (N_EVEN, B_VW), 0.02),
        'w_out_even': nrm(ks[12], (N_EVEN, MIX_EVEN, D), DEEPNORM_BETA * MIX_EVEN ** -0.5),
        'w_in_odd': nrm(ks[13], (N_ODD, D, IN_ODD), D ** -0.5),
        'gla_gate_w': nrm(ks[14], (N_ODD, 2, C_GATE_RANK, C_KW), C_GATE_RANK ** -0.5),
        'gla_gate_b': nrm(ks[15], (N_ODD, 2, C_KW), 0.5),
        'gla_norm': 1.0 + nrm(ks[16], (N_ODD, C_VW), 0.02),
        'w_out_odd': nrm(ks[17], (N_ODD, MIX_ODD, D), DEEPNORM_BETA * MIX_ODD ** -0.5),
        'w_router': nrm(ks[18], (D, N_EXPERTS), D ** -0.5),
        'b_router': nrm(ks[19], (N_EXPERTS,), 0.01),
        'w_expert_gate': nrm(ks[20], (DEPTH, N_EXPERTS, D, D_FF), D ** -0.5),
        'w_expert_up': nrm(ks[21], (DEPTH, N_EXPERTS, D, D_FF), D ** -0.5),
        'w_expert_down': nrm(ks[22], (DEPTH, N_EXPERTS, D_FF, D), DEEPNORM_BETA * D_FF ** -0.5),
    }


def reference(x, c, ctx, c_ctx, w_ada, b_ada, ln_g, ln_b, w_in_even, attn_sink, hgrn_lb_logits, hgrn_norm,
              w_out_even, w_in_odd, gla_gate_w, gla_gate_b, gla_norm, w_out_odd, w_router, b_router,
              w_expert_gate, w_expert_up, w_expert_down):
    B, T, D = x.shape
    C = ctx.shape[1]
    ROWS = T // GRID_W
    rows = jnp.repeat(jnp.arange(ROWS), GRID_W)
    cols = jnp.tile(jnp.arange(GRID_W), ROWS)
    h = x
    hc = ctx
    for l in range(DEPTH):
        need_ctx = l < DEPTH - 1
        mod = (jax.nn.silu(c) @ w_ada[l] + b_ada[l])[:, None, :]
        mod_c = (jax.nn.silu(c_ctx) @ w_ada[l] + b_ada[l])[None, None, :]
        sh1, sc1, g1, sh2, sc2, g2 = jnp.split(mod, 6, axis=-1)
        csh1, csc1, cg1, csh2, csc2, cg2 = jnp.split(mod_c, 6, axis=-1)
        u = modulate(layer_norm(h), sh1, sc1)
        uc = modulate(layer_norm(hc), csh1, csc1)
        if l % 2 == 0:
            i = l // 2
            m, mc = mixer_even(u, uc, w_in_even[i], attn_sink[i], hgrn_lb_logits, i, hgrn_norm[i],
                               w_out_even[i], rows, cols, need_ctx)
        else:
            i = l // 2
            m, mc = mixer_odd(u, uc, w_in_odd[i], gla_gate_w[i], gla_gate_b[i], gla_norm[i], w_out_odd[i], need_ctx)
        h = layer_norm_affine(DEEPNORM_ALPHA * h + g1 * m, ln_g[l, 0], ln_b[l, 0])
        u = modulate(layer_norm(h), sh2, sc2)
        if need_ctx:
            hc = layer_norm_affine(DEEPNORM_ALPHA * hc + cg1 * mc, ln_g[l, 0], ln_b[l, 0])
            uc = modulate(layer_norm(hc), csh2, csc2)
            tok = jnp.concatenate([uc, u], axis=1).reshape(-1, D)
            y = moe(tok, w_router, b_router, w_expert_gate[l], w_expert_up[l], w_expert_down[l]).reshape(B, C + T, D)
            yc = y[:, :C]
            y = y[:, C:]
            hc = layer_norm_affine(DEEPNORM_ALPHA * hc + cg2 * yc, ln_g[l, 1], ln_b[l, 1])
        else:
            y = moe(u.reshape(-1, D), w_router, b_router, w_expert_gate[l], w_expert_up[l],
                    w_expert_down[l]).reshape(B, T, D)
        h = layer_norm_affine(DEEPNORM_ALPHA * h + g2 * y, ln_g[l, 1], ln_b[l, 1])
    return h
```

```cpp
#ifndef HOST_TEST
#include <hip/hip_runtime.h>
#include <hip/hip_cooperative_groups.h>
#include <cstdio>
namespace cg = cooperative_groups;
#define DEV __device__ __forceinline__
#else
#include <cmath>
#include <cstdio>
#include <cstdlib>
#include <cstring>
#define DEV static inline
#endif

#ifndef T_BATCH
#define T_BATCH 8
#endif
#ifndef T_SEQ
#define T_SEQ 2048
#endif
#ifndef T_CTX
#define T_CTX 256
#endif

constexpr int D = 1024, NB = T_BATCH, T = T_SEQ, C = T_CTX;
constexpr int NC = NB * C, NT = NB * T, NR = NC + NT;
constexpr int GRID_W = 64;
constexpr int IN_EVEN = 3328, IN_ODD = 2592, PW = 3328;
constexpr int NEXP = 16, DFF = 512;
constexpr float ALPHA = 1.4142135623730951f;
constexpr float LN_EPS = 1e-5f;
constexpr int E_AQ = 0, E_AK = 512, E_AV = 640, E_FF = 768, E_HQ = 1792, E_HI = 2304, E_HG = 2816;
constexpr int O_Q = 0, O_K = 384, O_V = 768, O_RF = 1536, O_G = 1568, O_Z = 2336;

#ifdef HOST_TEST
typedef float act_t;
DEV float ldA(const act_t* p) { return *p; }
DEV void stA(act_t* p, float v) { *p = v; }
#else
typedef unsigned short act_t;
DEV float ldA(const act_t* p) { return __uint_as_float(((unsigned)*p) << 16); }
DEV void stA(act_t* p, float v) {
  unsigned u = __float_as_uint(v);
  u += 0x7fffu + ((u >> 16) & 1u);
  *p = (unsigned short)(u >> 16);
}
#endif

struct Params {
  const float *x, *c, *ctx, *c_ctx, *w_ada, *b_ada, *ln_g, *ln_b, *w_in_even, *attn_sink, *lb_logits, *hgrn_norm,
      *w_out_even, *w_in_odd, *gla_gate_w, *gla_gate_b, *gla_norm, *w_out_odd, *w_router, *b_router, *w_eg, *w_eu,
      *w_ed;
  float* out;
  float *mod, *hc, *costab, *sintab, *lbt, *FA, *FB, *ew;
  int* eidx;
  act_t *u, *P, *OF, *OB, *M, *LF;
};

DEV float sigmoidf_(float v) { return 1.0f / (1.0f + expf(-v)); }
DEV float siluf_(float v) { return v / (1.0f + expf(-v)); }

DEV const float* hrow_in(const Params& p, long row) {
  return row < NC ? p.ctx + row * D : p.x + (row - NC) * D;
}
DEV float* hrow(const Params& p, long row) { return row < NC ? p.hc + row * D : p.out + (row - NC) * D; }
DEV const float* modrow(const Params& p, int l, long row) {
  int bb = row < NC ? NB : (int)((row - NC) / T);
  return p.mod + ((long)l * (NB + 1) + bb) * 6 * D;
}

DEV void ph_mod(const Params& p, long i) {
  int j = (int)(i % (6 * D));
  int bb = (int)((i / (6 * D)) % (NB + 1));
  int l = (int)(i / ((long)6 * D * (NB + 1)));
  const float* cv = bb < NB ? p.c + (long)bb * D : p.c_ctx;
  const float* w = p.w_ada + (long)l * D * 6 * D + j;
  float s = p.b_ada[l * 6 * D + j];
  for (int k = 0; k < D; ++k) s += siluf_(cv[k]) * w[(long)k * 6 * D];
  p.mod[i] = s;
}

DEV void ph_tables(const Params& p, long i) {
  if (i < T) {
    double a = 6.283185307179586476925 * (double)i / (double)T;
    p.costab[i] = (float)cos(a);
    p.sintab[i] = (float)sin(a);
  }
  if (i < 1024) {
    int dir = (int)(i / 512), col = (int)(i % 512);
    float l0 = p.lb_logits[(dir * 2 + 0) * 512 + col], l1 = p.lb_logits[(dir * 2 + 1) * 512 + col];
    p.lbt[i] = 1.0f / (1.0f + expf(l1 - l0));
  }
}

DEV void ln_mod_row(const float* h, const float* shift, const float* scale, act_t* u) {
  float mu = 0.f;
  for (int k = 0; k < D; ++k) mu += h[k];
  mu *= (1.0f / D);
  float var = 0.f;
  for (int k = 0; k < D; ++k) { float d = h[k] - mu; var += d * d; }
  var *= (1.0f / D);
  float rs = 1.0f / sqrtf(var + LN_EPS);
  for (int k = 0; k < D; ++k) stA(u + k, (h[k] - mu) * rs * (1.0f + scale[k]) + shift[k]);
}

DEV void ph_lnmod_first(const Params& p, long row) {
  const float* m = modrow(p, 0, row);
  ln_mod_row(hrow_in(p, row), m, m + D, p.u + row * D);
}

DEV void gemm_item_act(const act_t* A, const float* W, act_t* Cout, int K, int N, int ldc, long i) {
  int n4 = (int)(i % (N / 4));
  long row = i / (N / 4);
  const act_t* a = A + row * K;
  const float* w = W + n4 * 4;
  float s0 = 0, s1 = 0, s2 = 0, s3 = 0;
  for (int k = 0; k < K; ++k) {
    float av = ldA(a + k);
    const float* wr = w + (long)k * N;
    s0 += av * wr[0]; s1 += av * wr[1]; s2 += av * wr[2]; s3 += av * wr[3];
  }
  act_t* o = Cout + row * ldc + n4 * 4;
  stA(o, s0); stA(o + 1, s1); stA(o + 2, s2); stA(o + 3, s3);
}

DEV void ph_rope(const Params& p, long i) {
  int pr = (int)(i % 32);
  int hh = (int)((i / 32) % 10);
  long lr = i / 320;
  int t = (int)(lr % T);
  int col = hh < 8 ? E_AQ + hh * 64 : E_AK + (hh - 8) * 64;
  int idx = pr & 15;
  int pos = pr < 16 ? t / GRID_W : t % GRID_W;
  int d0 = pr < 16 ? idx : 32 + idx;
  float inv = powf(10000.0f, -(float)idx / 16.0f);
  float ang = (float)pos * inv;
  float cs = cosf(ang), sn = sinf(ang);
  act_t* base = p.P + (NC + lr) * PW + col;
  float x1 = ldA(base + d0), x2 = ldA(base + d0 + 16);
  stA(base + d0, x1 * cs - x2 * sn);
  stA(base + d0 + 16, x1 * sn + x2 * cs);
}

DEV void ph_attn(const Params& p, long i) {
  int h = (int)(i % 8);
  long row = i / 8;
  int kv = h / 4;
  bool lat = row >= NC;
  int b = lat ? (int)((row - NC) / T) : (int)(row / C);
  int t = lat ? (int)((row - NC) % T) : 0;
  float q[64], acc[64];
  const act_t* qp = p.P + row * PW + E_AQ + h * 64;
#pragma unroll
  for (int d = 0; d < 64; ++d) { q[d] = ldA(qp + d) * 0.125f; acc[d] = 0.f; }
  float m = p.attn_sink[h], l = 1.0f;
  int nkeys = C + (lat ? 257 : 0);
  for (int j = 0; j < nkeys; ++j) {
    long krow;
    if (j < C) krow = (long)b * C + j;
    else {
      int kp = t - 128 + (j - C);
      if (kp < 0 || kp >= T) continue;
      krow = NC + (long)b * T + kp;
    }
    const act_t* kptr = p.P + krow * PW + E_AK + kv * 64;
    const act_t* vptr = p.P + krow * PW + E_AV + kv * 64;
    float s = 0.f;
#pragma unroll
    for (int d = 0; d < 64; ++d) s += q[d] * ldA(kptr + d);
    float mn = fmaxf(m, s);
    float sc = expf(m - mn), pj = expf(s - mn);
    l = l * sc + pj;
#pragma unroll
    for (int d = 0; d < 64; ++d) acc[d] = acc[d] * sc + pj * ldA(vptr + d);
    m = mn;
  }
  float il = 1.0f / l;
  act_t* o = p.u + row * D + h * 64;
#pragma unroll
  for (int d = 0; d < 64; ++d) stA(o + d, acc[d] * il);
}

template <int MODE>
DEV void ph_scan(const Params& p, long i) {
  constexpr int DK = MODE == 0 ? 128 : 96;
  constexpr int DV = MODE == 0 ? 128 : 192;
  int e = (int)(i % DV);
  int dir = (int)((i / DV) % 2);
  int h = (int)((i / (2 * DV)) % 4);
  int b = (int)(i / (8 * DV));
  float S[DK];
#pragma unroll
  for (int d = 0; d < DK; ++d) S[d] = 0.f;
  act_t* OD = dir == 0 ? p.OF : p.OB;
  for (int step = 0; step < C + T; ++step) {
    long row;
    if (step < C) row = (long)b * C + (dir == 0 ? step : C - 1 - step);
    else { int tt = step - C; row = NC + (long)b * T + (dir == 0 ? tt : T - 1 - tt); }
    const act_t* pr = p.P + row * PW;
    float o = 0.f;
    if (MODE == 0) {
      float v = ldA(pr + E_HI + h * 128 + e);
      const act_t* zp = pr + E_FF + dir * 512 + h * 128;
      const act_t* qp = pr + E_HQ + h * 128;
      const float* lb = p.lbt + dir * 512 + h * 128;
#pragma unroll
      for (int d = 0; d < DK; ++d) {
        float f = lb[d] + (1.0f - lb[d]) * sigmoidf_(ldA(zp + d));
        S[d] = f * S[d] + (1.0f - f) * v;
        o += ldA(qp + d) * S[d];
      }
      stA(OD + row * 768 + h * 128 + e, o);
    } else {
      float v = ldA(pr + O_V + h * 192 + e);
      const act_t* kp = pr + O_K + h * 96;
      const act_t* qp = pr + O_Q + h * 96;
      const act_t* lf = p.LF + ((long)dir * NR + row) * 384 + h * 96;
#pragma unroll
      for (int d = 0; d < DK; ++d) {
        float f = expf(ldA(lf + d));
        S[d] = f * S[d] + ldA(kp + d) * v;
        o += ldA(qp + d) * S[d];
      }
      stA(OD + row * 768 + h * 192 + e, o * 0.10206207261596575f);
    }
  }
}

template <int MODE>
DEV void ph_combine(const Params& p, long i) {
  constexpr int DV = MODE == 0 ? 128 : 192;
  int h = (int)(i % 4);
  long row = (MODE == 0) ? i / 4 : NC + i / 4;
  const act_t* f = p.OF + row * 768 + h * DV;
  const act_t* bk = p.OB + row * 768 + h * DV;
  float ss = 0.f;
  for (int e = 0; e < DV; ++e) { float o = ldA(f + e) + ldA(bk + e); ss += o * o; }
  float r = 1.0f / sqrtf(ss / DV + LN_EPS);
  const float* gn = (MODE == 0 ? p.hgrn_norm : p.gla_norm) + h * DV;
  const act_t* g = p.P + row * PW + (MODE == 0 ? E_HG : O_G) + h * DV;
  act_t* o = p.u + row * D + (MODE == 0 ? 512 : 0) + h * DV;
  for (int e = 0; e < DV; ++e) stA(o + e, (ldA(f + e) + ldA(bk + e)) * r * gn[e] * siluf_(ldA(g + e)));
}

DEV void ph_gla_decay(const Params& p, long i) {
  int col = (int)(i % 384);
  long row = (i / 384) % NR;
  int dir = (int)(i / ((long)384 * NR));
  const act_t* r = p.P + row * PW + O_RF + dir * 16;
  const float* gw = p.gla_gate_w + (long)dir * 16 * 384 + col;
  float z = p.gla_gate_b[dir * 384 + col];
  for (int k = 0; k < 16; ++k) z += ldA(r + k) * gw[k * 384];
  float ls = fminf(z, 0.f) - log1pf(expf(-fabsf(z)));
  stA(p.LF + ((long)dir * NR + row) * 384 + col, ls * (1.0f / 16.0f));
}

DEV void ph_f1(const Params& p, long i) {
  int col = (int)(i % 256);
  long lr = i / 256;
  int g = col / 64, cp = col % 64;
  const act_t* z = p.P + (NC + lr) * PW + O_Z + g * 64;
  float a = 0.f, bq = 0.f;
  for (int c = 0; c < 64; ++c) {
    int k = (c * cp * (T / 64)) % T;
    float zv = ldA(z + c);
    a += zv * p.costab[k];
    bq += zv * p.sintab[k];
  }
  p.FA[i] = a;
  p.FB[i] = bq;
}

DEV void ph_f2(const Params& p, long i) {
  int col = (int)(i % 256);
  int tp = (int)((i / 256) % T);
  int b = (int)(i / ((long)256 * T));
  const float* fa = p.FA + (long)b * T * 256 + col;
  const float* fb = p.FB + (long)b * T * 256 + col;
  float y = 0.f;
  for (int t = 0; t < T; ++t) {
    int k = (int)(((long)t * tp) % T);
    y += fa[(long)t * 256] * p.costab[k] - fb[(long)t * 256] * p.sintab[k];
  }
  stA(p.u + (NC + (long)b * T + tp) * D + 768 + col, y * (1.0f / sqrtf((float)T * 64.0f)));
}

DEV void ph_resid_ln(const Params& p, long row, int l, int sub) {
  const float* hin = (l == 0 && sub == 0) ? hrow_in(p, row) : hrow(p, row);
  float* hout = hrow(p, row);
  const float* md = modrow(p, l, row);
  const float* g = md + (sub == 0 ? 2 : 5) * D;
  const act_t* m = p.M + row * D;
  const float* lg = p.ln_g + (l * 2 + sub) * D;
  const float* lb = p.ln_b + (l * 2 + sub) * D;
  float mu = 0.f;
  for (int k = 0; k < D; ++k) mu += ALPHA * hin[k] + g[k] * ldA(m + k);
  mu *= (1.0f / D);
  float var = 0.f;
  for (int k = 0; k < D; ++k) { float d = ALPHA * hin[k] + g[k] * ldA(m + k) - mu; var += d * d; }
  var *= (1.0f / D);
  float rs = 1.0f / sqrtf(var + LN_EPS);
  for (int k = 0; k < D; ++k) hout[k] = (ALPHA * hin[k] + g[k] * ldA(m + k) - mu) * rs * lg[k] + lb[k];
  if (sub == 1 && l == 1) return;
  const float* md2 = (sub == 0) ? md + 3 * D : modrow(p, 1, row);
  float mu2 = 0.f;
  for (int k = 0; k < D; ++k) mu2 += hout[k];
  mu2 *= (1.0f / D);
  float var2 = 0.f;
  for (int k = 0; k < D; ++k) { float d = hout[k] - mu2; var2 += d * d; }
  var2 *= (1.0f / D);
  float rs2 = 1.0f / sqrtf(var2 + LN_EPS);
  float lo[NEXP];
#pragma unroll
  for (int e = 0; e < NEXP; ++e) lo[e] = 0.f;
  for (int k = 0; k < D; ++k) {
    float uv = (hout[k] - mu2) * rs2 * (1.0f + md2[D + k]) + md2[k];
    stA(p.u + row * D + k, uv);
    if (sub == 0) {
      const float* wr = p.w_router + k * NEXP;
#pragma unroll
      for (int e = 0; e < NEXP; ++e) lo[e] += uv * wr[e];
    }
  }
  if (sub != 0) return;
  float mx = lo[0];
#pragma unroll
  for (int e = 1; e < NEXP; ++e) mx = fmaxf(mx, lo[e]);
  float sum = 0.f;
#pragma unroll
  for (int e = 0; e < NEXP; ++e) { lo[e] = expf(lo[e] - mx); sum += lo[e]; }
  float inv = 1.0f / sum;
  float bestg = -1e30f; int bg = 0;
  float gi1 = 0, gi2 = 0; int ge1 = 0, ge2 = 0;
  float gp1 = 0, gp2 = 0;
#pragma unroll
  for (int gq = 0; gq < 4; ++gq) {
    float s1 = -1e30f, s2 = -1e30f, p1 = 0, p2 = 0; int e1 = 0, e2 = 0;
#pragma unroll
    for (int j = 0; j < 4; ++j) {
      int e = gq * 4 + j;
      float pe = lo[e] * inv;
      float se = pe + p.b_router[e];
      if (se > s1) { s2 = s1; p2 = p1; e2 = e1; s1 = se; p1 = pe; e1 = e; }
      else if (se > s2) { s2 = se; p2 = pe; e2 = e; }
    }
    float gs = s1 + s2;
    if (gs > bestg) { bestg = gs; bg = gq; gi1 = s1; gi2 = s2; ge1 = e1; ge2 = e2; gp1 = p1; gp2 = p2; }
  }
  (void)bg; (void)gi1; (void)gi2;
  float wsum = gp1 + gp2;
  p.eidx[row * 2 + 0] = ge1; p.eidx[row * 2 + 1] = ge2;
  p.ew[row * 2 + 0] = gp1 / wsum; p.ew[row * 2 + 1] = gp2 / wsum;
}

DEV void ph_moe_up(const Params& p, long i, int l, long row0) {
  int f4 = (int)(i % (DFF / 4));
  int slot = (int)((i / (DFF / 4)) % 2);
  long row = row0 + i / (DFF / 2);
  int e = p.eidx[row * 2 + slot];
  const float* w1 = p.w_eg + ((long)(l * NEXP + e) * D) * DFF + f4 * 4;
  const float* w3 = p.w_eu + ((long)(l * NEXP + e) * D) * DFF + f4 * 4;
  const act_t* a = p.u + row * D;
  float g0 = 0, g1 = 0, g2 = 0, g3 = 0, u0 = 0, u1 = 0, u2 = 0, u3 = 0;
  for (int k = 0; k < D; ++k) {
    float av = ldA(a + k);
    const float* r1 = w1 + (long)k * DFF;
    const float* r3 = w3 + (long)k * DFF;
    g0 += av * r1[0]; g1 += av * r1[1]; g2 += av * r1[2]; g3 += av * r1[3];
    u0 += av * r3[0]; u1 += av * r3[1]; u2 += av * r3[2]; u3 += av * r3[3];
  }
  act_t* hb = p.P + (row * 2 + slot) * DFF + f4 * 4;
  stA(hb, siluf_(g0) * u0); stA(hb + 1, siluf_(g1) * u1); stA(hb + 2, siluf_(g2) * u2); stA(hb + 3, siluf_(g3) * u3);
}

DEV void ph_moe_down(const Params& p, long i, int l, long row0) {
  int j4 = (int)(i % (D / 4));
  long row = row0 + i / (D / 4);
  float y0 = 0, y1 = 0, y2 = 0, y3 = 0;
  for (int slot = 0; slot < 2; ++slot) {
    int e = p.eidx[row * 2 + slot];
    float wgt = p.ew[row * 2 + slot];
    const float* w2 = p.w_ed + ((long)(l * NEXP + e) * DFF) * D + j4 * 4;
    const act_t* hb = p.P + (row * 2 + slot) * DFF;
    float s0 = 0, s1 = 0, s2 = 0, s3 = 0;
    for (int f = 0; f < DFF; ++f) {
      float hv = ldA(hb + f);
      const float* r = w2 + (long)f * D;
      s0 += hv * r[0]; s1 += hv * r[1]; s2 += hv * r[2]; s3 += hv * r[3];
    }
    y0 += wgt * s0; y1 += wgt * s1; y2 += wgt * s2; y3 += wgt * s3;
  }
  act_t* o = p.M + row * D + j4 * 4;
  stA(o, y0); stA(o + 1, y1); stA(o + 2, y2); stA(o + 3, y3);
}

constexpr int N_PHASES = 21;

#define LOOP(n) for (long i = gtid; i < (long)(n); i += gstride)

template <typename SyncF>
DEV void run_phases(const Params& p, long gtid, long gstride, int lo, int hi, SyncF sync) {
  for (int ph = lo; ph < hi; ++ph) {
    switch (ph) {
      case 0:
        LOOP((long)2 * (NB + 1) * 6 * D) ph_mod(p, i);
        LOOP(T > 1024 ? T : 1024) ph_tables(p, i);
        break;
      case 1: LOOP(NR) ph_lnmod_first(p, i); break;
      case 2: LOOP((long)NR * (IN_EVEN / 4)) gemm_item_act(p.u, p.w_in_even, p.P, D, IN_EVEN, PW, i); break;
      case 3: LOOP((long)NT * 320) ph_rope(p, i); break;
      case 4:
        LOOP((long)NR * 8) ph_attn(p, i);
        break;
      case 5: LOOP((long)NB * 4 * 2 * 128) ph_scan<0>(p, i); break;
      case 6: LOOP((long)NR * 4) ph_combine<0>(p, i); break;
      case 7: LOOP((long)NR * (D / 4)) gemm_item_act(p.u, p.w_out_even, p.M, D, D, D, i); break;
      case 8: LOOP(NR) ph_resid_ln(p, i, 0, 0); break;
      case 9: LOOP((long)NR * DFF / 2) ph_moe_up(p, i, 0, 0); break;
      case 10: LOOP((long)NR * D / 4) ph_moe_down(p, i, 0, 0); break;
      case 11: LOOP(NR) ph_resid_ln(p, i, 0, 1); break;
      case 12: LOOP((long)NR * (IN_ODD / 4)) gemm_item_act(p.u, p.w_in_odd, p.P, D, IN_ODD, PW, i); break;
      case 13:
        LOOP((long)2 * NR * 384) ph_gla_decay(p, i);
        LOOP((long)NT * 256) ph_f1(p, i);
        break;
      case 14: LOOP((long)NB * 4 * 2 * 192) ph_scan<1>(p, i); break;
      case 15:
        LOOP((long)NT * 4) ph_combine<1>(p, i);
        LOOP((long)NT * 256) ph_f2(p, i);
        break;
      case 16: LOOP((long)NT * (D / 4)) gemm_item_act(p.u + (long)NC * D, p.w_out_odd, p.M + (long)NC * D, D, D, D, i); break;
      case 17: LOOP(NT) ph_resid_ln(p, NC + i, 1, 0); break;
      case 18: LOOP((long)NT * DFF / 2) ph_moe_up(p, i, 1, NC); break;
      case 19: LOOP((long)NT * D / 4) ph_moe_down(p, i, 1, NC); break;
      case 20: LOOP(NT) ph_resid_ln(p, NC + i, 1, 1); break;
    }
    if (ph + 1 < hi) sync();
  }
}

static size_t carve(Params& p, char* ws) {
  size_t off = 0;
  auto take = [&](size_t bytes) { char* r = ws + off; off += (bytes + 255) & ~(size_t)255; return r; };
  p.mod = (float*)take(sizeof(float) * 2 * (NB + 1) * 6 * D);
  p.hc = (float*)take(sizeof(float) * (size_t)NC * D);
  p.costab = (float*)take(sizeof(float) * T);
  p.sintab = (float*)take(sizeof(float) * T);
  p.lbt = (float*)take(sizeof(float) * 1024);
  p.FA = (float*)take(sizeof(float) * (size_t)NT * 256);
  p.FB = (float*)take(sizeof(float) * (size_t)NT * 256);
  p.ew = (float*)take(sizeof(float) * (size_t)NR * 2);
  p.eidx = (int*)take(sizeof(int) * (size_t)NR * 2);
  p.u = (act_t*)take(sizeof(act_t) * (size_t)NR * D);
  p.P = (act_t*)take(sizeof(act_t) * (size_t)NR * PW);
  p.OF = (act_t*)take(sizeof(act_t) * (size_t)NR * 768);
  p.OB = (act_t*)take(sizeof(act_t) * (size_t)NR * 768);
  p.M = (act_t*)take(sizeof(act_t) * (size_t)NR * D);
  p.LF = (act_t*)take(sizeof(act_t) * (size_t)2 * NR * 384);
  return off;
}

static void fill_inputs(Params& p, void* const* d_in) {
  const float** f = (const float**)&p;
  for (int i = 0; i < 23; ++i) f[i] = (const float*)d_in[i];
}

#ifndef HOST_TEST
__global__ void __launch_bounds__(256) mega_kernel(Params p, int lo, int hi) {
  cg::grid_group grid = cg::this_grid();
  long gtid = (long)blockIdx.x * blockDim.x + threadIdx.x;
  long gstride = (long)gridDim.x * blockDim.x;
  run_phases(p, gtid, gstride, lo, hi, [&]() { grid.sync(); });
}

extern "C" void kernel_launch(void* const* d_in, const int* in_sizes, int n_in, void* d_out, int out_size,
                              void* d_ws, size_t ws_size, hipStream_t stream) {
  static int grid_blocks = 0;
  if (!grid_blocks) {
    int dev = 0, cus = 0, per_cu = 0;
    (void)hipGetDevice(&dev);
    (void)hipDeviceGetAttribute(&cus, hipDeviceAttributeMultiprocessorCount, dev);
    (void)hipOccupancyMaxActiveBlocksPerMultiprocessor(&per_cu, mega_kernel, 256, 0);
    grid_blocks = cus * per_cu;
  }
  Params p{};
  fill_inputs(p, d_in);
  p.out = (float*)d_out;
  size_t need = carve(p, (char*)d_ws);
  if (need > ws_size) { fprintf(stderr, "workspace too small: need %zu have %zu\n", need, ws_size); return; }
  int lo = 0, hi = N_PHASES;
  void* args[] = {&p, &lo, &hi};
  hipError_t e = hipLaunchCooperativeKernel((void*)mega_kernel, dim3(grid_blocks), dim3(256), args, 0, stream);
  if (e != hipSuccess) fprintf(stderr, "cooperative launch failed: %s (grid %d)\n", hipGetErrorString(e), grid_blocks);
}
#else
int main(int argc, char** argv) {
  const char* dir = argv[1];
  static const long sizes[23] = {(long)NT * D, (long)NB * D, (long)NC * D, D, 2L * D * 6 * D, 2L * 6 * D, 4L * D, 4L * D,
                                 (long)D * IN_EVEN, 8, 2 * 2 * 512, 512, 1024L * D, (long)D * IN_ODD, 2 * 16 * 384, 2 * 384,
                                 768, 1024L * D, D * 16, 16, 2L * 16 * D * DFF, 2L * 16 * D * DFF, 2L * 16 * DFF * D};
  void* d_in[23];
  for (int i = 0; i < 23; ++i) {
    char fn[256]; snprintf(fn, sizeof fn, "%s/in%02d.bin", dir, i);
    FILE* f = fopen(fn, "rb"); if (!f) { printf("missing %s\n", fn); return 1; }
    float* b = (float*)malloc(sizes[i] * 4);
    if ((long)fread(b, 4, sizes[i], f) != sizes[i]) { printf("short read %s\n", fn); return 1; }
    fclose(f); d_in[i] = b;
  }
  Params p{};
  fill_inputs(p, d_in);
  p.out = (float*)malloc((size_t)NT * D * 4);
  Params tmp = p; size_t need = carve(tmp, nullptr);
  char* ws = (char*)malloc(need); memset(ws, 0xAA, need);
  carve(p, ws);
  int lo = 0, hi = N_PHASES;
  if (argc > 2) hi = atoi(argv[2]);
  for (int ph = lo; ph < hi; ++ph) { run_phases(p, 0, 1, ph, ph + 1, []() {}); fprintf(stderr, "phase %d done\n", ph); }
  char fn[256]; snprintf(fn, sizeof fn, "%s/out.bin", dir);
  FILE* f = fopen(fn, "wb"); fwrite(p.out, 4, (size_t)NT * D, f); fclose(f);
  snprintf(fn, sizeof fn, "%s/O.bin", dir); f = fopen(fn, "wb"); fwrite(p.u, sizeof(act_t), (size_t)NR * D, f); fclose(f);
  snprintf(fn, sizeof fn, "%s/hc.bin", dir); f = fopen(fn, "wb"); fwrite(p.hc, 4, (size_t)NC * D, f); fclose(f);
  return 0;
}
#endif
```

```cpp
#ifndef HOST_TEST
#include <hip/hip_runtime.h>
#include <hip/hip_cooperative_groups.h>
#include <cstdio>
namespace cg = cooperative_groups;
#define DEV __device__ __forceinline__
#else
#include <cmath>
#include <cstdio>
#include <cstdlib>
#include <cstring>
#define DEV static inline
#endif

#ifndef T_BATCH
#define T_BATCH 8
#endif
#ifndef T_SEQ
#define T_SEQ 2048
#endif
#ifndef T_CTX
#define T_CTX 256
#endif

constexpr int D = 1024, NB = T_BATCH, T = T_SEQ, C = T_CTX;
constexpr int NC = NB * C, NT = NB * T, NR = NC + NT;
constexpr int GRID_W = 64;
constexpr int IN_EVEN = 3328, IN_ODD = 2592, PW = 3328;
constexpr int NEXP = 16, DFF = 512;
constexpr float ALPHA = 1.4142135623730951f;
constexpr float LN_EPS = 1e-5f;
constexpr int E_AQ = 0, E_AK = 512, E_AV = 640, E_FF = 768, E_HQ = 1792, E_HI = 2304, E_HG = 2816;
constexpr int O_Q = 0, O_K = 384, O_V = 768, O_RF = 1536, O_G = 1568, O_Z = 2336;

#ifdef HOST_TEST
typedef float act_t;
DEV float ldA(const act_t* p) { return *p; }
DEV void stA(act_t* p, float v) { *p = v; }
#else
typedef unsigned short act_t;
DEV float ldA(const act_t* p) { return __uint_as_float(((unsigned)*p) << 16); }
DEV void stA(act_t* p, float v) {
  unsigned u = __float_as_uint(v);
  u += 0x7fffu + ((u >> 16) & 1u);
  *p = (unsigned short)(u >> 16);
}
#endif

struct Params {
  const float *x, *c, *ctx, *c_ctx, *w_ada, *b_ada, *ln_g, *ln_b, *w_in_even, *attn_sink, *lb_logits, *hgrn_norm,
      *w_out_even, *w_in_odd, *gla_gate_w, *gla_gate_b, *gla_norm, *w_out_odd, *w_router, *b_router, *w_eg, *w_eu,
      *w_ed;
  float* out;
  float *mod, *hc, *costab, *sintab, *lbt, *ew;
  int* eidx;
  act_t *u, *P, *OF, *OB, *M, *LF;
  act_t *Wt_in_even, *Wt_out_even, *Wt_in_odd, *Wt_out_odd;
  act_t *Wt_up, *Wt_down, *H, *Y, *Cmat, *FT;
  int *cnt, *list;
};

DEV float sigmoidf_(float v) { return 1.0f / (1.0f + expf(-v)); }
DEV float siluf_(float v) { return v / (1.0f + expf(-v)); }

DEV const float* hrow_in(const Params& p, long row) {
  return row < NC ? p.ctx + row * D : p.x + (row - NC) * D;
}
DEV float* hrow(const Params& p, long row) { return row < NC ? p.hc + row * D : p.out + (row - NC) * D; }
DEV const float* modrow(const Params& p, int l, long row) {
  int bb = row < NC ? NB : (int)((row - NC) / T);
  return p.mod + ((long)l * (NB + 1) + bb) * 6 * D;
}

DEV void ph_mod(const Params& p, long i) {
  int j = (int)(i % (6 * D));
  int bb = (int)((i / (6 * D)) % (NB + 1));
  int l = (int)(i / ((long)6 * D * (NB + 1)));
  const float* cv = bb < NB ? p.c + (long)bb * D : p.c_ctx;
  const float* w = p.w_ada + (long)l * D * 6 * D + j;
  float s = p.b_ada[l * 6 * D + j];
  for (int k = 0; k < D; ++k) s += siluf_(cv[k]) * w[(long)k * 6 * D];
  p.mod[i] = s;
}

DEV void ph_tables(const Params& p, long i) {
  if (i < T) {
    double a = 6.283185307179586476925 * (double)i / (double)T;
    p.costab[i] = (float)cos(a);
    p.sintab[i] = (float)sin(a);
  }
  if (i < 1024) {
    int dir = (int)(i / 512), col = (int)(i % 512);
    float l0 = p.lb_logits[(dir * 2 + 0) * 512 + col], l1 = p.lb_logits[(dir * 2 + 1) * 512 + col];
    p.lbt[i] = 1.0f / (1.0f + expf(l1 - l0));
  }
}

DEV void ln_mod_row(const float* h, const float* shift, const float* scale, act_t* u) {
  float mu = 0.f;
  for (int k = 0; k < D; ++k) mu += h[k];
  mu *= (1.0f / D);
  float var = 0.f;
  for (int k = 0; k < D; ++k) { float d = h[k] - mu; var += d * d; }
  var *= (1.0f / D);
  float rs = 1.0f / sqrtf(var + LN_EPS);
  for (int k = 0; k < D; ++k) stA(u + k, (h[k] - mu) * rs * (1.0f + scale[k]) + shift[k]);
}

DEV void ph_lnmod_first(const Params& p, long row) {
  const float* m = modrow(p, 0, row);
  ln_mod_row(hrow_in(p, row), m, m + D, p.u + row * D);
}

DEV void gemm_item_act(const act_t* A, const float* W, act_t* Cout, int K, int N, int ldc, long i) {
  int n4 = (int)(i % (N / 4));
  long row = i / (N / 4);
  const act_t* a = A + row * K;
  const float* w = W + n4 * 4;
  float s0 = 0, s1 = 0, s2 = 0, s3 = 0;
  for (int k = 0; k < K; ++k) {
    float av = ldA(a + k);
    const float* wr = w + (long)k * N;
    s0 += av * wr[0]; s1 += av * wr[1]; s2 += av * wr[2]; s3 += av * wr[3];
  }
  act_t* o = Cout + row * ldc + n4 * 4;
  stA(o, s0); stA(o + 1, s1); stA(o + 2, s2); stA(o + 3, s3);
}

DEV void ph_rope(const Params& p, long i) {
  int pr = (int)(i % 32);
  int hh = (int)((i / 32) % 10);
  long lr = i / 320;
  int t = (int)(lr % T);
  int col = hh < 8 ? E_AQ + hh * 64 : E_AK + (hh - 8) * 64;
  int idx = pr & 15;
  int pos = pr < 16 ? t / GRID_W : t % GRID_W;
  int d0 = pr < 16 ? idx : 32 + idx;
  float inv = powf(10000.0f, -(float)idx / 16.0f);
  float ang = (float)pos * inv;
  float cs = cosf(ang), sn = sinf(ang);
  act_t* base = p.P + (NC + lr) * PW + col;
  float x1 = ldA(base + d0), x2 = ldA(base + d0 + 16);
  stA(base + d0, x1 * cs - x2 * sn);
  stA(base + d0 + 16, x1 * sn + x2 * cs);
}

DEV void ph_attn(const Params& p, long i) {
  int h = (int)(i % 8);
  long row = i / 8;
  int kv = h / 4;
  bool lat = row >= NC;
  int b = lat ? (int)((row - NC) / T) : (int)(row / C);
  int t = lat ? (int)((row - NC) % T) : 0;
  float q[64], acc[64];
  const act_t* qp = p.P + row * PW + E_AQ + h * 64;
#pragma unroll
  for (int d = 0; d < 64; ++d) { q[d] = ldA(qp + d) * 0.125f; acc[d] = 0.f; }
  float m = p.attn_sink[h], l = 1.0f;
  int nkeys = C + (lat ? 257 : 0);
  for (int j = 0; j < nkeys; ++j) {
    long krow;
    if (j < C) krow = (long)b * C + j;
    else {
      int kp = t - 128 + (j - C);
      if (kp < 0 || kp >= T) continue;
      krow = NC + (long)b * T + kp;
    }
    const act_t* kptr = p.P + krow * PW + E_AK + kv * 64;
    const act_t* vptr = p.P + krow * PW + E_AV + kv * 64;
    float s = 0.f;
#pragma unroll
    for (int d = 0; d < 64; ++d) s += q[d] * ldA(kptr + d);
    float mn = fmaxf(m, s);
    float sc = expf(m - mn), pj = expf(s - mn);
    l = l * sc + pj;
#pragma unroll
    for (int d = 0; d < 64; ++d) acc[d] = acc[d] * sc + pj * ldA(vptr + d);
    m = mn;
  }
  float il = 1.0f / l;
  act_t* o = p.u + row * D + h * 64;
#pragma unroll
  for (int d = 0; d < 64; ++d) stA(o + d, acc[d] * il);
}

template <int MODE>
DEV void ph_scan(const Params& p, long i) {
  constexpr int DK = MODE == 0 ? 128 : 96;
  constexpr int DV = MODE == 0 ? 128 : 192;
  int e = (int)(i % DV);
  int dir = (int)((i / DV) % 2);
  int h = (int)((i / (2 * DV)) % 4);
  int b = (int)(i / (8 * DV));
  float S[DK];
#pragma unroll
  for (int d = 0; d < DK; ++d) S[d] = 0.f;
  act_t* OD = dir == 0 ? p.OF : p.OB;
  for (int step = 0; step < C + T; ++step) {
    long row;
    if (step < C) row = (long)b * C + (dir == 0 ? step : C - 1 - step);
    else { int tt = step - C; row = NC + (long)b * T + (dir == 0 ? tt : T - 1 - tt); }
    const act_t* pr = p.P + row * PW;
    float o = 0.f;
    if (MODE == 0) {
      float v = ldA(pr + E_HI + h * 128 + e);
      const act_t* zp = pr + E_FF + dir * 512 + h * 128;
      const act_t* qp = pr + E_HQ + h * 128;
      const float* lb = p.lbt + dir * 512 + h * 128;
#pragma unroll
      for (int d = 0; d < DK; ++d) {
        float f = lb[d] + (1.0f - lb[d]) * sigmoidf_(ldA(zp + d));
        S[d] = f * S[d] + (1.0f - f) * v;
        o += ldA(qp + d) * S[d];
      }
      stA(OD + row * 768 + h * 128 + e, o);
    } else {
      float v = ldA(pr + O_V + h * 192 + e);
      const act_t* kp = pr + O_K + h * 96;
      const act_t* qp = pr + O_Q + h * 96;
      const act_t* lf = p.LF + ((long)dir * NR + row) * 384 + h * 96;
#pragma unroll
      for (int d = 0; d < DK; ++d) {
        float f = expf(ldA(lf + d));
        S[d] = f * S[d] + ldA(kp + d) * v;
        o += ldA(qp + d) * S[d];
      }
      stA(OD + row * 768 + h * 192 + e, o * 0.10206207261596575f);
    }
  }
}

template <int MODE>
DEV void ph_combine(const Params& p, long i) {
  constexpr int DV = MODE == 0 ? 128 : 192;
  int h = (int)(i % 4);
  long row = (MODE == 0) ? i / 4 : NC + i / 4;
  const act_t* f = p.OF + row * 768 + h * DV;
  const act_t* bk = p.OB + row * 768 + h * DV;
  float ss = 0.f;
  for (int e = 0; e < DV; ++e) { float o = ldA(f + e) + ldA(bk + e); ss += o * o; }
  float r = 1.0f / sqrtf(ss / DV + LN_EPS);
  const float* gn = (MODE == 0 ? p.hgrn_norm : p.gla_norm) + h * DV;
  const act_t* g = p.P + row * PW + (MODE == 0 ? E_HG : O_G) + h * DV;
  act_t* o = p.u + row * D + (MODE == 0 ? 512 : 0) + h * DV;
  for (int e = 0; e < DV; ++e) stA(o + e, (ldA(f + e) + ldA(bk + e)) * r * gn[e] * siluf_(ldA(g + e)));
}

DEV void ph_gla_decay(const Params& p, long i) {
  int col = (int)(i % 384);
  long row = (i / 384) % NR;
  int dir = (int)(i / ((long)384 * NR));
  const act_t* r = p.P + row * PW + O_RF + dir * 16;
  const float* gw = p.gla_gate_w + (long)dir * 16 * 384 + col;
  float z = p.gla_gate_b[dir * 384 + col];
  for (int k = 0; k < 16; ++k) z += ldA(r + k) * gw[k * 384];
  float ls = fminf(z, 0.f) - log1pf(expf(-fabsf(z)));
  stA(p.LF + ((long)dir * NR + row) * 384 + col, ls * (1.0f / 16.0f));
}

DEV void ph_resid_ln(const Params& p, long row, int l, int sub) {
  const float* hin = (l == 0 && sub == 0) ? hrow_in(p, row) : hrow(p, row);
  float* hout = hrow(p, row);
  const float* md = modrow(p, l, row);
  const float* g = md + (sub == 0 ? 2 : 5) * D;
  const act_t* m = p.M + row * D;
  const float* lg = p.ln_g + (l * 2 + sub) * D;
  const float* lb = p.ln_b + (l * 2 + sub) * D;
  float mu = 0.f;
  for (int k = 0; k < D; ++k) mu += ALPHA * hin[k] + g[k] * ldA(m + k);
  mu *= (1.0f / D);
  float var = 0.f;
  for (int k = 0; k < D; ++k) { float d = ALPHA * hin[k] + g[k] * ldA(m + k) - mu; var += d * d; }
  var *= (1.0f / D);
  float rs = 1.0f / sqrtf(var + LN_EPS);
  for (int k = 0; k < D; ++k) hout[k] = (ALPHA * hin[k] + g[k] * ldA(m + k) - mu) * rs * lg[k] + lb[k];
  if (sub == 1 && l == 1) return;
  const float* md2 = (sub == 0) ? md + 3 * D : modrow(p, 1, row);
  float mu2 = 0.f;
  for (int k = 0; k < D; ++k) mu2 += hout[k];
  mu2 *= (1.0f / D);
  float var2 = 0.f;
  for (int k = 0; k < D; ++k) { float d = hout[k] - mu2; var2 += d * d; }
  var2 *= (1.0f / D);
  float rs2 = 1.0f / sqrtf(var2 + LN_EPS);
  float lo[NEXP];
#pragma unroll
  for (int e = 0; e < NEXP; ++e) lo[e] = 0.f;
  for (int k = 0; k < D; ++k) {
    float uv = (hout[k] - mu2) * rs2 * (1.0f + md2[D + k]) + md2[k];
    stA(p.u + row * D + k, uv);
    if (sub == 0) {
      const float* wr = p.w_router + k * NEXP;
#pragma unroll
      for (int e = 0; e < NEXP; ++e) lo[e] += uv * wr[e];
    }
  }
  if (sub != 0) return;
  float mx = lo[0];
#pragma unroll
  for (int e = 1; e < NEXP; ++e) mx = fmaxf(mx, lo[e]);
  float sum = 0.f;
#pragma unroll
  for (int e = 0; e < NEXP; ++e) { lo[e] = expf(lo[e] - mx); sum += lo[e]; }
  float inv = 1.0f / sum;
  float bestg = -1e30f; int bg = 0;
  float gi1 = 0, gi2 = 0; int ge1 = 0, ge2 = 0;
  float gp1 = 0, gp2 = 0;
#pragma unroll
  for (int gq = 0; gq < 4; ++gq) {
    float s1 = -1e30f, s2 = -1e30f, p1 = 0, p2 = 0; int e1 = 0, e2 = 0;
#pragma unroll
    for (int j = 0; j < 4; ++j) {
      int e = gq * 4 + j;
      float pe = lo[e] * inv;
      float se = pe + p.b_router[e];
      if (se > s1) { s2 = s1; p2 = p1; e2 = e1; s1 = se; p1 = pe; e1 = e; }
      else if (se > s2) { s2 = se; p2 = pe; e2 = e; }
    }
    float gs = s1 + s2;
    if (gs > bestg) { bestg = gs; bg = gq; gi1 = s1; gi2 = s2; ge1 = e1; ge2 = e2; gp1 = p1; gp2 = p2; }
  }
  (void)bg; (void)gi1; (void)gi2;
  float wsum = gp1 + gp2;
  p.eidx[row * 2 + 0] = ge1; p.eidx[row * 2 + 1] = ge2;
  p.ew[row * 2 + 0] = gp1 / wsum; p.ew[row * 2 + 1] = gp2 / wsum;
}

DEV void ph_moe_up(const Params& p, long i, int l, long row0) {
  int f4 = (int)(i % (DFF / 4));
  int slot = (int)((i / (DFF / 4)) % 2);
  long row = row0 + i / (DFF / 2);
  int e = p.eidx[row * 2 + slot];
  const float* w1 = p.w_eg + ((long)(l * NEXP + e) * D) * DFF + f4 * 4;
  const float* w3 = p.w_eu + ((long)(l * NEXP + e) * D) * DFF + f4 * 4;
  const act_t* a = p.u + row * D;
  float g0 = 0, g1 = 0, g2 = 0, g3 = 0, u0 = 0, u1 = 0, u2 = 0, u3 = 0;
  for (int k = 0; k < D; ++k) {
    float av = ldA(a + k);
    const float* r1 = w1 + (long)k * DFF;
    const float* r3 = w3 + (long)k * DFF;
    g0 += av * r1[0]; g1 += av * r1[1]; g2 += av * r1[2]; g3 += av * r1[3];
    u0 += av * r3[0]; u1 += av * r3[1]; u2 += av * r3[2]; u3 += av * r3[3];
  }
  act_t* hb = p.P + (row * 2 + slot) * DFF + f4 * 4;
  stA(hb, siluf_(g0) * u0); stA(hb + 1, siluf_(g1) * u1); stA(hb + 2, siluf_(g2) * u2); stA(hb + 3, siluf_(g3) * u3);
}

DEV void ph_moe_down(const Params& p, long i, int l, long row0) {
  int j4 = (int)(i % (D / 4));
  long row = row0 + i / (D / 4);
  float y0 = 0, y1 = 0, y2 = 0, y3 = 0;
  for (int slot = 0; slot < 2; ++slot) {
    int e = p.eidx[row * 2 + slot];
    float wgt = p.ew[row * 2 + slot];
    const float* w2 = p.w_ed + ((long)(l * NEXP + e) * DFF) * D + j4 * 4;
    const act_t* hb = p.P + (row * 2 + slot) * DFF;
    float s0 = 0, s1 = 0, s2 = 0, s3 = 0;
    for (int f = 0; f < DFF; ++f) {
      float hv = ldA(hb + f);
      const float* r = w2 + (long)f * D;
      s0 += hv * r[0]; s1 += hv * r[1]; s2 += hv * r[2]; s3 += hv * r[3];
    }
    y0 += wgt * s0; y1 += wgt * s1; y2 += wgt * s2; y3 += wgt * s3;
  }
  act_t* o = p.M + row * D + j4 * 4;
  stA(o, y0); stA(o + 1, y1); stA(o + 2, y2); stA(o + 3, y3);
}


#ifndef HOST_TEST
typedef __attribute__((ext_vector_type(8))) short bf16x8;
typedef __attribute__((ext_vector_type(4))) float f32x4;
constexpr int SMEM_BYTES = 32768;
constexpr int IN_ODD_PAD = 2944;
constexpr int O_FA = 2336, O_FB = 2592, O_END = 2848;

__device__ __forceinline__ unsigned pack2(float a, float b) {
  unsigned ua = __float_as_uint(a), ub = __float_as_uint(b);
  ua += 0x7fffu + ((ua >> 16) & 1u);
  ub += 0x7fffu + ((ub >> 16) & 1u);
  return (ua >> 16) | (ub & 0xffff0000u);
}
__device__ __forceinline__ float bf_lo(unsigned u) { return __uint_as_float(u << 16); }
__device__ __forceinline__ float bf_hi(unsigned u) { return __uint_as_float(u & 0xffff0000u); }
__device__ __forceinline__ float wave_sum(float v) {
#pragma unroll
  for (int o = 32; o > 0; o >>= 1) v += __shfl_xor(v, o);
  return v;
}

template <class ARow, class Epi>
__device__ __forceinline__ void gemm_tile(ARow arow, const act_t* Bt, int K, unsigned char* smem, Epi epi) {
  const int tid = threadIdx.x, wid = tid >> 6, lane = tid & 63, wr = wid >> 1, wc = wid & 1, fr = lane & 15,
            fq = lane >> 4;
  act_t* SA = (act_t*)smem;
  act_t* SB = SA + 128 * 32;
  const int b0 = tid * 16, b1 = tid * 16 + 4096;
  const int r0 = b0 >> 6, c0 = (b0 & 63) >> 1, r1 = b1 >> 6, c1 = (b1 & 63) >> 1;
  const act_t* ga0 = arow(r0) + c0;
  const act_t* ga1 = arow(r1) + c1;
  const act_t* gb0 = Bt + (long)r0 * K + c0;
  const act_t* gb1 = Bt + (long)r1 * K + c1;
  f32x4 acc[4][4];
#pragma unroll
  for (int m = 0; m < 4; ++m)
#pragma unroll
    for (int n = 0; n < 4; ++n) acc[m][n] = f32x4{0.f, 0.f, 0.f, 0.f};
  for (int kt = 0; kt < K; kt += 32) {
    __builtin_amdgcn_global_load_lds((const unsigned*)(ga0 + kt), (unsigned*)((char*)SA + b0), 16, 0, 0);
    __builtin_amdgcn_global_load_lds((const unsigned*)(gb0 + kt), (unsigned*)((char*)SB + b0), 16, 0, 0);
    __builtin_amdgcn_global_load_lds((const unsigned*)(ga1 + kt), (unsigned*)((char*)SA + b1), 16, 0, 0);
    __builtin_amdgcn_global_load_lds((const unsigned*)(gb1 + kt), (unsigned*)((char*)SB + b1), 16, 0, 0);
    asm volatile("s_waitcnt vmcnt(0)" ::: "memory");
    __syncthreads();
    bf16x8 af[4], bfr[4];
#pragma unroll
    for (int m = 0; m < 4; ++m) {
      af[m] = *reinterpret_cast<const bf16x8*>((const char*)SA + (wr * 64 + m * 16 + fr) * 64 + fq * 16);
      bfr[m] = *reinterpret_cast<const bf16x8*>((const char*)SB + (wc * 64 + m * 16 + fr) * 64 + fq * 16);
    }
    asm volatile("s_waitcnt lgkmcnt(0)" ::: "memory");
    __builtin_amdgcn_sched_barrier(0);
#pragma unroll
    for (int m = 0; m < 4; ++m)
#pragma unroll
      for (int n = 0; n < 4; ++n) acc[m][n] = __builtin_amdgcn_mfma_f32_16x16x32_bf16(af[m], bfr[n], acc[m][n], 0, 0, 0);
    __syncthreads();
  }
  epi(acc, wr, wc, fr, fq);
}

struct GemmJob {
  const act_t* A; const act_t* Bt; act_t* C;
  long sA, sB, sC;
  int nbatch, Mtiles, Ntiles, K, ldc, Nvalid, mode;
  float scale;
};
__device__ __forceinline__ void phase_gemm(const Params& p, const GemmJob& g, unsigned char* smem) {
  const int per_b = g.Mtiles * g.Ntiles;
  const int ntiles = per_b * g.nbatch;
  for (int tile = blockIdx.x; tile < ntiles; tile += gridDim.x) {
    const int b = tile / per_b, tt = tile % per_b;
    const int tm = tt / g.Ntiles, tn = tt % g.Ntiles;
    if (g.mode == 1 && tm < NC / 128 && tn * 128 >= O_FA) continue;
    const int K = g.K, ldc = g.ldc;
    const act_t* Ab = g.A + b * g.sA + (long)tm * 128 * K;
    act_t* Cb = g.C + b * g.sC + (long)tm * 128 * ldc + tn * 128;
    const int nlim = g.Nvalid - tn * 128;
    const float scale = g.scale;
    const int mode = g.mode;
    gemm_tile([&](int r) { return Ab + (long)r * K; }, g.Bt + b * g.sB + (long)tn * 128 * K, K, smem,
              [&](f32x4 (&acc)[4][4], int wr, int wc, int fr, int fq) {
#pragma unroll
                for (int m = 0; m < 4; ++m)
#pragma unroll
                  for (int n = 0; n < 4; ++n) {
                    const int col = wc * 64 + n * 16 + fr;
                    if (col < nlim) {
#pragma unroll
                      for (int j = 0; j < 4; ++j) {
                        const int row = wr * 64 + m * 16 + fq * 4 + j;
                        stA(Cb + (long)row * ldc + col, acc[m][n][j] * scale);
                      }
                    } else if (mode == 1) {
                      const int gc = tn * 128 + col;
                      if (gc < O_END && tm >= NC / 128) {
                        const int lr = (tm - NC / 128) * 128 + wr * 64 + m * 16 + fq * 4;
                        const int bb = lr / T, t = lr % T;
                        const int cq = gc < O_FB ? gc - O_FA : gc - O_FB;
                        act_t* dst = p.FT + ((long)bb * 256 + cq) * (2 * T) + (gc < O_FB ? 0 : T) + t;
                        *reinterpret_cast<uint2*>(dst) = make_uint2(pack2(acc[m][n][0], acc[m][n][1]), pack2(acc[m][n][2], acc[m][n][3]));
                      }
                    }
                  }
              });
  }
}

template <class RowMap>
__device__ __forceinline__ void conv_tile_rm(const float* src, int lds_, int Nvalid, int k0, int n0, act_t* dst, int ldd, float* tile, RowMap rm) {
  const int tid = threadIdx.x;
  {
    const int r = tid >> 4, c4 = (tid & 15) * 4;
#pragma unroll
    for (int rr = 0; rr < 4; ++rr) {
      const int row = r + rr * 16;
      float4 v = make_float4(0.f, 0.f, 0.f, 0.f);
      if (n0 + c4 < Nvalid) v = *reinterpret_cast<const float4*>(src + (long)(k0 + row) * lds_ + n0 + c4);
      float* t = tile + row * 65 + c4;
      t[0] = v.x; t[1] = v.y; t[2] = v.z; t[3] = v.w;
    }
  }
  __syncthreads();
  {
    const int n = tid >> 2, ks = (tid & 3) * 16;
    unsigned w[8];
#pragma unroll
    for (int i = 0; i < 8; ++i) w[i] = pack2(tile[(ks + 2 * i) * 65 + n], tile[(ks + 2 * i + 1) * 65 + n]);
    if (n0 + n < Nvalid) {
      uint4* d = reinterpret_cast<uint4*>(dst + (long)rm(n) * ldd + k0 + ks);
      d[0] = make_uint4(w[0], w[1], w[2], w[3]);
      d[1] = make_uint4(w[4], w[5], w[6], w[7]);
    }
  }
  __syncthreads();
}

__device__ __forceinline__ void conv_tile(const float* src, int lds_, int Nvalid, int k0, int n0, act_t* dst, int ldd, float* tile) {
  conv_tile_rm(src, lds_, Nvalid, k0, n0, dst, ldd, tile, [=](int n) { return n0 + n; });
}

__device__ __forceinline__ void phase_convert_experts(const Params& p, int l, unsigned char* smem) {
  float* tile = (float*)smem;
  const int per_e = 384;
  for (int job = blockIdx.x; job < NEXP * per_e; job += gridDim.x) {
    const int e = job / per_e, j = job % per_e;
    if (j < 256) {
      const int up = j >> 7, jj = j & 127;
      const int kt = jj >> 3, ft = jj & 7;
      const float* src = (up ? p.w_eu : p.w_eg) + ((long)(l * NEXP + e) * D) * DFF;
      const int rbase = ft * 128 + up * 32;
      conv_tile_rm(src, DFF, DFF, kt * 64, ft * 64, p.Wt_up + (long)e * 1024 * D, D, tile,
                   [=](int n) { return rbase + (n >> 5) * 64 + (n & 31); });
    } else {
      const int jj = j - 256;
      const int kt = jj >> 4, nt = jj & 15;
      const float* src = p.w_ed + ((long)(l * NEXP + e) * DFF) * D;
      conv_tile(src, D, D, kt * 64, nt * 64, p.Wt_down + (long)e * 1024 * DFF, DFF, tile);
    }
  }
}

__device__ __forceinline__ void phase_moe(const Params& p, int l, bool down, unsigned char* smem) {
  const int* cntp = p.cnt + l * NEXP;
  int total = 0;
  for (int e = 0; e < NEXP; ++e) total += ((cntp[e] + 127) >> 7) * 8;
  for (int tile = blockIdx.x; tile < total; tile += gridDim.x) {
    int e = 0, tb = 0, rowoff = 0;
    for (; e < NEXP - 1; ++e) {
      const int c = cntp[e];
      const int nt = ((c + 127) >> 7) * 8;
      if (tile < tb + nt) break;
      tb += nt; rowoff += c;
    }
    const int c = cntp[e];
    const int lt = tile - tb, mt = lt >> 3, nt = lt & 7;
    const int rows_valid = min(128, c - mt * 128);
    const int* lst = p.list + (long)(l * NEXP + e) * NR + mt * 128;
    const long hrow0 = (long)rowoff + mt * 128;
    if (!down) {
      gemm_tile([&](int r) { return p.u + (long)(lst[min(r, rows_valid - 1)] >> 1) * D; },
                p.Wt_up + ((long)e * 1024 + nt * 128) * D, D, smem,
                [&](f32x4 (&acc)[4][4], int wr, int wc, int fr, int fq) {
#pragma unroll
                  for (int m = 0; m < 4; ++m)
#pragma unroll
                    for (int j = 0; j < 4; ++j) {
                      const int row = wr * 64 + m * 16 + fq * 4 + j;
                      if (row < rows_valid) {
#pragma unroll
                        for (int n = 0; n < 2; ++n) {
                          const float g = acc[m][n][j], uu = acc[m][n + 2][j];
                          stA(p.H + (hrow0 + row) * DFF + nt * 64 + wc * 32 + n * 16 + fr, g / (1.0f + __expf(-g)) * uu);
                        }
                      }
                    }
                });
    } else {
      const act_t* Ab = p.H + hrow0 * DFF;
      gemm_tile([&](int r) { return Ab + (long)r * DFF; }, p.Wt_down + ((long)e * 1024 + nt * 128) * DFF, DFF, smem,
                [&](f32x4 (&acc)[4][4], int wr, int wc, int fr, int fq) {
#pragma unroll
                  for (int m = 0; m < 4; ++m)
#pragma unroll
                    for (int j = 0; j < 4; ++j) {
                      const int row = wr * 64 + m * 16 + fq * 4 + j;
                      if (row < rows_valid) {
                        const int ts = lst[row];
                        const float w = p.ew[ts];
#pragma unroll
                        for (int n = 0; n < 4; ++n)
                          stA(p.Y + (long)ts * D + nt * 128 + wc * 64 + n * 16 + fr, acc[m][n][j] * w);
                      }
                    }
                });
    }
  }
}

__device__ __forceinline__ void phase_convert_dense(const Params& p, unsigned char* smem) {
  float* tile = (float*)smem;
  const int J0 = 16 * 52, J1 = J0 + 256, J2 = J1 + 16 * 37, J3 = J2 + 256;
  for (int job = blockIdx.x; job < J3; job += gridDim.x) {
    if (job < J0) conv_tile(p.w_in_even, IN_EVEN, IN_EVEN, (job / 52) * 64, (job % 52) * 64, p.Wt_in_even, D, tile);
    else if (job < J1) { int j = job - J0; conv_tile(p.w_out_even, D, D, (j / 16) * 64, (j % 16) * 64, p.Wt_out_even, D, tile); }
    else if (job < J2) { int j = job - J1; conv_tile(p.w_in_odd, IN_ODD, O_FA, (j / 37) * 64, (j % 37) * 64, p.Wt_in_odd, D, tile); }
    else { int j = job - J2; conv_tile(p.w_out_odd, D, D, (j / 16) * 64, (j % 16) * 64, p.Wt_out_odd, D, tile); }
  }
}

__device__ __forceinline__ void phase_fold_z(const Params& p, long gtid, long gstride) {
  for (long i = gtid; i < (long)512 * D; i += gstride) {
    const int k = (int)(i % D), np = (int)(i / D);
    const int part = np >> 8, col = np & 255, g = col >> 6, cp = col & 63;
    const float* wz = p.w_in_odd + (long)k * IN_ODD + O_Z + g * 64;
    float s = 0.f;
    for (int c = 0; c < 64; ++c) {
      float sn, cs;
      sincospif((float)((c * cp) & 63) * (1.0f / 32.0f), &sn, &cs);
      s += wz[c] * (part == 0 ? cs : -sn);
    }
    stA(p.Wt_in_odd + (long)(O_FA + np) * D + k, s);
  }
  for (long i = gtid; i < (long)(IN_ODD_PAD - O_END) * D; i += gstride) p.Wt_in_odd[(long)O_END * D + i] = 0;
}

__device__ __forceinline__ void phase_cmat(const Params& p, long gtid, long gstride) {
  for (long i = gtid; i < (long)T * T; i += gstride) {
    const int t = (int)(i % T), tp = (int)(i / T);
    float sn, cs;
    sincospif((float)((t * tp) & (T - 1)) * (2.0f / T), &sn, &cs);
    stA(p.Cmat + (long)tp * 2 * T + t, cs);
    stA(p.Cmat + (long)tp * 2 * T + T + t, sn);
  }
}

__device__ __forceinline__ void row_stats(const float4 (&v)[4], float& mu, float& rs) {
  float s = 0.f;
#pragma unroll
  for (int i = 0; i < 4; ++i) s += v[i].x + v[i].y + v[i].z + v[i].w;
  mu = wave_sum(s) * (1.0f / D);
  float q = 0.f;
#pragma unroll
  for (int i = 0; i < 4; ++i) {
    float a = v[i].x - mu, b = v[i].y - mu, c = v[i].z - mu, d = v[i].w - mu;
    q += a * a + b * b + c * c + d * d;
  }
  rs = 1.0f / sqrtf(wave_sum(q) * (1.0f / D) + LN_EPS);
}

__device__ __forceinline__ void phase_lnmod_first(const Params& p) {
  const int lane = threadIdx.x & 63;
  const long w0 = (long)blockIdx.x * 4 + (threadIdx.x >> 6), wstride = (long)gridDim.x * 4;
  for (long row = w0; row < NR; row += wstride) {
    const float4* h = reinterpret_cast<const float4*>(hrow_in(p, row));
    const float* md = modrow(p, 0, row);
    float4 v[4];
#pragma unroll
    for (int i = 0; i < 4; ++i) v[i] = h[i * 64 + lane];
    float mu, rs;
    row_stats(v, mu, rs);
#pragma unroll
    for (int i = 0; i < 4; ++i) {
      const float4 sh = reinterpret_cast<const float4*>(md)[i * 64 + lane];
      const float4 sc = reinterpret_cast<const float4*>(md + D)[i * 64 + lane];
      float a = (v[i].x - mu) * rs * (1.f + sc.x) + sh.x, b = (v[i].y - mu) * rs * (1.f + sc.y) + sh.y;
      float c = (v[i].z - mu) * rs * (1.f + sc.z) + sh.z, d = (v[i].w - mu) * rs * (1.f + sc.w) + sh.w;
      reinterpret_cast<uint2*>(p.u + row * D)[i * 64 + lane] = make_uint2(pack2(a, b), pack2(c, d));
    }
  }
}

__device__ __forceinline__ void phase_resid_ln(const Params& p, int l, int sub, long row_lo, long row_hi) {
  const int lane = threadIdx.x & 63;
  const long w0 = (long)blockIdx.x * 4 + (threadIdx.x >> 6), wstride = (long)gridDim.x * 4;
  for (long row = row_lo + w0; row < row_hi; row += wstride) {
    const float4* hin = reinterpret_cast<const float4*>((l == 0 && sub == 0) ? hrow_in(p, row) : hrow(p, row));
    float4* hout = reinterpret_cast<float4*>(hrow(p, row));
    const float* md = modrow(p, l, row);
    const float4* g = reinterpret_cast<const float4*>(md + (sub == 0 ? 2 : 5) * D);
    const uint2* m = reinterpret_cast<const uint2*>(sub == 0 ? p.M + row * D : p.Y + row * 2 * D);
    const uint2* m2 = reinterpret_cast<const uint2*>(p.Y + (row * 2 + 1) * D);
    const float4* lg = reinterpret_cast<const float4*>(p.ln_g + (l * 2 + sub) * D);
    const float4* lb = reinterpret_cast<const float4*>(p.ln_b + (l * 2 + sub) * D);
    float4 v[4];
#pragma unroll
    for (int i = 0; i < 4; ++i) {
      const float4 hv = hin[i * 64 + lane];
      const float4 gv = g[i * 64 + lane];
      const uint2 mv = m[i * 64 + lane];
      float m0 = bf_lo(mv.x), m1 = bf_hi(mv.x), m2_ = bf_lo(mv.y), m3 = bf_hi(mv.y);
      if (sub == 1) {
        const uint2 mw = m2[i * 64 + lane];
        m0 += bf_lo(mw.x); m1 += bf_hi(mw.x); m2_ += bf_lo(mw.y); m3 += bf_hi(mw.y);
      }
      v[i].x = ALPHA * hv.x + gv.x * m0;
      v[i].y = ALPHA * hv.y + gv.y * m1;
      v[i].z = ALPHA * hv.z + gv.z * m2_;
      v[i].w = ALPHA * hv.w + gv.w * m3;
    }
    float mu, rs;
    row_stats(v, mu, rs);
#pragma unroll
    for (int i = 0; i < 4; ++i) {
      const float4 a = lg[i * 64 + lane], b = lb[i * 64 + lane];
      v[i].x = (v[i].x - mu) * rs * a.x + b.x;
      v[i].y = (v[i].y - mu) * rs * a.y + b.y;
      v[i].z = (v[i].z - mu) * rs * a.z + b.z;
      v[i].w = (v[i].w - mu) * rs * a.w + b.w;
      hout[i * 64 + lane] = v[i];
    }
    if (sub == 1 && l == 1) continue;
    const float* md2 = (sub == 0) ? md + 3 * D : modrow(p, 1, row);
    row_stats(v, mu, rs);
    float lo[NEXP];
#pragma unroll
    for (int e = 0; e < NEXP; ++e) lo[e] = 0.f;
#pragma unroll
    for (int i = 0; i < 4; ++i) {
      const float4 sh = reinterpret_cast<const float4*>(md2)[i * 64 + lane];
      const float4 sc = reinterpret_cast<const float4*>(md2 + D)[i * 64 + lane];
      float uv[4];
      uv[0] = (v[i].x - mu) * rs * (1.f + sc.x) + sh.x;
      uv[1] = (v[i].y - mu) * rs * (1.f + sc.y) + sh.y;
      uv[2] = (v[i].z - mu) * rs * (1.f + sc.z) + sh.z;
      uv[3] = (v[i].w - mu) * rs * (1.f + sc.w) + sh.w;
      reinterpret_cast<uint2*>(p.u + row * D)[i * 64 + lane] = make_uint2(pack2(uv[0], uv[1]), pack2(uv[2], uv[3]));
      if (sub == 0) {
#pragma unroll
        for (int c = 0; c < 4; ++c) {
          const float4* wr = reinterpret_cast<const float4*>(p.w_router + (long)((i * 64 + lane) * 4 + c) * NEXP);
#pragma unroll
          for (int q = 0; q < 4; ++q) {
            const float4 w4 = wr[q];
            lo[q * 4 + 0] += uv[c] * w4.x; lo[q * 4 + 1] += uv[c] * w4.y;
            lo[q * 4 + 2] += uv[c] * w4.z; lo[q * 4 + 3] += uv[c] * w4.w;
          }
        }
      }
    }
    if (sub != 0) continue;
#pragma unroll
    for (int e = 0; e < NEXP; ++e) lo[e] = wave_sum(lo[e]);
    if (lane == 0) {
      float mx = lo[0];
#pragma unroll
      for (int e = 1; e < NEXP; ++e) mx = fmaxf(mx, lo[e]);
      float sum = 0.f;
#pragma unroll
      for (int e = 0; e < NEXP; ++e) { lo[e] = expf(lo[e] - mx); sum += lo[e]; }
      const float inv = 1.0f / sum;
      float bestg = -1e30f, gp1 = 0.f, gp2 = 0.f;
      int ge1 = 0, ge2 = 0;
#pragma unroll
      for (int gq = 0; gq < 4; ++gq) {
        float s1 = -1e30f, s2 = -1e30f, p1 = 0.f, p2 = 0.f;
        int e1 = 0, e2 = 0;
#pragma unroll
        for (int j = 0; j < 4; ++j) {
          const int e = gq * 4 + j;
          const float pe = lo[e] * inv;
          const float se = pe + p.b_router[e];
          if (se > s1) { s2 = s1; p2 = p1; e2 = e1; s1 = se; p1 = pe; e1 = e; }
          else if (se > s2) { s2 = se; p2 = pe; e2 = e; }
        }
        const float gs = s1 + s2;
        if (gs > bestg) { bestg = gs; ge1 = e1; ge2 = e2; gp1 = p1; gp2 = p2; }
      }
      const float wsum = gp1 + gp2;
      p.ew[row * 2 + 0] = gp1 / wsum; p.ew[row * 2 + 1] = gp2 / wsum;
      const int pos1 = atomicAdd(p.cnt + l * NEXP + ge1, 1);
      p.list[(long)(l * NEXP + ge1) * NR + pos1] = (int)(row * 2);
      const int pos2 = atomicAdd(p.cnt + l * NEXP + ge2, 1);
      p.list[(long)(l * NEXP + ge2) * NR + pos2] = (int)(row * 2 + 1);
    }
  }
}

constexpr int N_PHASES = 21;
#define LOOP(n) for (long i = gtid; i < (long)(n); i += gstride)

__global__ void __launch_bounds__(256) mega_kernel(Params p, int lo, int hi) {
  cg::grid_group grid = cg::this_grid();
  __shared__ __attribute__((aligned(16))) unsigned char smem[SMEM_BYTES];
  const long gtid = (long)blockIdx.x * blockDim.x + threadIdx.x;
  const long gstride = (long)gridDim.x * blockDim.x;
  for (int ph = lo; ph < hi; ++ph) {
    GemmJob gj{}; gj.nbatch = 0; gj.scale = 1.0f;
    int rl = -1, rsub = 0; long rlo = 0, rhi = 0;
    int cvl = -1, moel = -1; bool moedown = false;
    switch (ph) {
      case 0:
        if (gtid < 2 * NEXP) p.cnt[gtid] = 0;
        phase_convert_dense(p, smem);
        phase_fold_z(p, gtid, gstride);
        cvl = 0;
        LOOP((long)2 * (NB + 1) * 6 * D) ph_mod(p, i);
        LOOP(T > 1024 ? T : 1024) ph_tables(p, i);
        break;
      case 1: phase_lnmod_first(p); break;
      case 2: gj = GemmJob{p.u, p.Wt_in_even, p.P, 0, 0, 0, 1, NR / 128, IN_EVEN / 128, D, PW, IN_EVEN, 0, 1.0f}; break;
      case 3: LOOP((long)NT * 320) ph_rope(p, i); break;
      case 4: LOOP((long)NR * 8) ph_attn(p, i); break;
      case 5: LOOP((long)NB * 4 * 2 * 128) ph_scan<0>(p, i); break;
      case 6: LOOP((long)NR * 4) ph_combine<0>(p, i); break;
      case 7: gj = GemmJob{p.u, p.Wt_out_even, p.M, 0, 0, 0, 1, NR / 128, D / 128, D, D, D, 0, 1.0f}; break;
      case 8: rl = 0; rsub = 0; rlo = 0; rhi = NR; break;
      case 9: moel = 0; moedown = false; break;
      case 10: moel = 0; moedown = true; break;
      case 11: rl = 0; rsub = 1; rlo = 0; rhi = NR; phase_cmat(p, gtid, gstride); break;
      case 12: gj = GemmJob{p.u, p.Wt_in_odd, p.P, 0, 0, 0, 1, NR / 128, IN_ODD_PAD / 128, D, PW, O_FA, 1, 1.0f}; break;
      case 13:
        LOOP((long)2 * NR * 384) ph_gla_decay(p, i);
        break;
      case 14: LOOP((long)NB * 4 * 2 * 192) ph_scan<1>(p, i); break;
      case 15:
        LOOP((long)NT * 4) ph_combine<1>(p, i);
        gj = GemmJob{p.Cmat, p.FT, p.u + (long)NC * D + 768, 0, (long)256 * 2 * T, (long)T * D, NB, T / 128, 2, 2 * T, D, 256, 0,
                     0.00276213586400995f};
        break;
      case 16: gj = GemmJob{p.u + (long)NC * D, p.Wt_out_odd, p.M + (long)NC * D, 0, 0, 0, 1, NT / 128, D / 128, D, D, D, 0, 1.0f}; cvl = 1; break;
      case 17: rl = 1; rsub = 0; rlo = NC; rhi = NR; break;
      case 18: moel = 1; moedown = false; break;
      case 19: moel = 1; moedown = true; break;
      case 20: rl = 1; rsub = 1; rlo = NC; rhi = NR; break;
    }
    if (cvl >= 0) phase_convert_experts(p, cvl, smem);
    if (moel >= 0) phase_moe(p, moel, moedown, smem);
    if (gj.nbatch) phase_gemm(p, gj, smem);
    if (rl >= 0) phase_resid_ln(p, rl, rsub, rlo, rhi);
    if (ph + 1 < hi) grid.sync();
  }
}

static size_t carve(Params& p, char* ws) {
  size_t off = 0;
  auto take = [&](size_t bytes) { char* r = ws + off; off += (bytes + 255) & ~(size_t)255; return r; };
  p.mod = (float*)take(sizeof(float) * 2 * (NB + 1) * 6 * D);
  p.hc = (float*)take(sizeof(float) * (size_t)NC * D);
  p.costab = (float*)take(sizeof(float) * T);
  p.sintab = (float*)take(sizeof(float) * T);
  p.lbt = (float*)take(sizeof(float) * 1024);
  p.ew = (float*)take(sizeof(float) * (size_t)NR * 2);
  p.eidx = (int*)take(sizeof(int) * (size_t)NR * 2);
  p.u = (act_t*)take(sizeof(act_t) * (size_t)NR * D);
  p.P = (act_t*)take(sizeof(act_t) * (size_t)NR * PW);
  p.OF = (act_t*)take(sizeof(act_t) * (size_t)NR * 768);
  p.OB = (act_t*)take(sizeof(act_t) * (size_t)NR * 768);
  p.M = p.OF;
  p.Cmat = (act_t*)take(sizeof(act_t) * (size_t)T * 2 * T);
  p.FT = (act_t*)take(sizeof(act_t) * (size_t)NB * 256 * 2 * T);
  p.LF = (act_t*)take(sizeof(act_t) * (size_t)2 * NR * 384);
  p.Wt_up = p.Cmat;
  p.Wt_down = p.Wt_up + (size_t)NEXP * 1024 * D;
  p.Y = p.P;
  p.H = p.P + (size_t)2 * NR * D;
  p.cnt = (int*)take(sizeof(int) * 2 * NEXP);
  p.list = (int*)take(sizeof(int) * (size_t)2 * NEXP * NR);
  p.Wt_in_even = (act_t*)take(sizeof(act_t) * (size_t)IN_EVEN * D);
  p.Wt_out_even = (act_t*)take(sizeof(act_t) * (size_t)D * D);
  p.Wt_in_odd = (act_t*)take(sizeof(act_t) * (size_t)IN_ODD_PAD * D);
  p.Wt_out_odd = (act_t*)take(sizeof(act_t) * (size_t)D * D);
  return off;
}

static void fill_inputs(Params& p, void* const* d_in) {
  const float** f = (const float**)&p;
  for (int i = 0; i < 23; ++i) f[i] = (const float*)d_in[i];
}

extern "C" void kernel_launch(void* const* d_in, const int* in_sizes, int n_in, void* d_out, int out_size,
                              void* d_ws, size_t ws_size, hipStream_t stream) {
  static int grid_blocks = 0;
  if (!grid_blocks) {
    int dev = 0, cus = 0, per_cu = 0;
    (void)hipGetDevice(&dev);
    (void)hipDeviceGetAttribute(&cus, hipDeviceAttributeMultiprocessorCount, dev);
    (void)hipOccupancyMaxActiveBlocksPerMultiprocessor(&per_cu, mega_kernel, 256, 0);
    grid_blocks = cus * per_cu;
  }
  Params p{};
  fill_inputs(p, d_in);
  p.out = (float*)d_out;
  size_t need = carve(p, (char*)d_ws);
  if (need > ws_size) { fprintf(stderr, "workspace too small: need %zu have %zu\n", need, ws_size); return; }
  int lo = 0, hi = N_PHASES;
  void* args[] = {&p, &lo, &hi};
  hipError_t e = hipLaunchCooperativeKernel((void*)mega_kernel, dim3(grid_blocks), dim3(256), args, 0, stream);
  if (e != hipSuccess) fprintf(stderr, "cooperative launch failed: %s (grid %d)\n", hipGetErrorString(e), grid_blocks);
}
#endif
```

```cpp
#ifndef HOST_TEST
#include <hip/hip_runtime.h>
#include <hip/hip_cooperative_groups.h>
#include <cstdio>
namespace cg = cooperative_groups;
#define DEV __device__ __forceinline__
#else
#include <cmath>
#include <cstdio>
#include <cstdlib>
#include <cstring>
#define DEV static inline
#endif

#ifndef T_BATCH
#define T_BATCH 8
#endif
#ifndef T_SEQ
#define T_SEQ 2048
#endif
#ifndef T_CTX
#define T_CTX 256
#endif

constexpr int D = 1024, NB = T_BATCH, T = T_SEQ, C = T_CTX;
constexpr int NC = NB * C, NT = NB * T, NR = NC + NT;
constexpr int GRID_W = 64;
constexpr int IN_EVEN = 3328, IN_ODD = 2592, PW = 3328;
constexpr int NEXP = 16, DFF = 512;
constexpr float ALPHA = 1.4142135623730951f;
constexpr float LN_EPS = 1e-5f;
constexpr int E_AQ = 0, E_AK = 512, E_AV = 640, E_FF = 768, E_HQ = 1792, E_HI = 2304, E_HG = 2816;
constexpr int O_Q = 0, O_K = 384, O_V = 768, O_RF = 1536, O_G = 1568, O_Z = 2336;

#ifdef HOST_TEST
typedef float act_t;
DEV float ldA(const act_t* p) { return *p; }
DEV void stA(act_t* p, float v) { *p = v; }
#else
typedef unsigned short act_t;
DEV float ldA(const act_t* p) { return __uint_as_float(((unsigned)*p) << 16); }
DEV void stA(act_t* p, float v) {
  unsigned u = __float_as_uint(v);
  u += 0x7fffu + ((u >> 16) & 1u);
  *p = (unsigned short)(u >> 16);
}
#endif

struct Params {
  const float *x, *c, *ctx, *c_ctx, *w_ada, *b_ada, *ln_g, *ln_b, *w_in_even, *attn_sink, *lb_logits, *hgrn_norm,
      *w_out_even, *w_in_odd, *gla_gate_w, *gla_gate_b, *gla_norm, *w_out_odd, *w_router, *b_router, *w_eg, *w_eu,
      *w_ed;
  float* out;
  float *mod, *hc, *costab, *sintab, *lbt, *ew, *ropetab;
  int* eidx;
  act_t *u, *P, *OF, *OB, *M, *LF;
  act_t *Wt_in_even, *Wt_out_even, *Wt_in_odd, *Wt_out_odd;
  act_t *Wt_up, *Wt_down, *H, *Y, *Cmat, *FT;
  int *cnt, *list;
  unsigned* bar;
};

DEV float sigmoidf_(float v) { return 1.0f / (1.0f + expf(-v)); }
DEV float siluf_(float v) { return v / (1.0f + expf(-v)); }

DEV const float* hrow_in(const Params& p, long row) {
  return row < NC ? p.ctx + row * D : p.x + (row - NC) * D;
}
DEV float* hrow(const Params& p, long row) { return row < NC ? p.hc + row * D : p.out + (row - NC) * D; }
DEV const float* modrow(const Params& p, int l, long row) {
  int bb = row < NC ? NB : (int)((row - NC) / T);
  return p.mod + ((long)l * (NB + 1) + bb) * 6 * D;
}

DEV void ph_mod(const Params& p, long i) {
  int j = (int)(i % (6 * D));
  int bb = (int)((i / (6 * D)) % (NB + 1));
  int l = (int)(i / ((long)6 * D * (NB + 1)));
  const float* cv = bb < NB ? p.c + (long)bb * D : p.c_ctx;
  const float* w = p.w_ada + (long)l * D * 6 * D + j;
  float s = p.b_ada[l * 6 * D + j];
  for (int k = 0; k < D; ++k) s += siluf_(cv[k]) * w[(long)k * 6 * D];
  p.mod[i] = s;
}

DEV void ph_tables(const Params& p, long i) {
  if (i < T) {
    double a = 6.283185307179586476925 * (double)i / (double)T;
    p.costab[i] = (float)cos(a);
    p.sintab[i] = (float)sin(a);
  }
  if (i < 1024) {
    int pos = (int)(i >> 4), idx = (int)(i & 15);
    float ang = (float)pos * powf(10000.0f, -(float)idx / 16.0f);
    p.ropetab[2 * i] = cosf(ang);
    p.ropetab[2 * i + 1] = sinf(ang);
  }
  if (i < 1024) {
    int dir = (int)(i / 512), col = (int)(i % 512);
    float l0 = p.lb_logits[(dir * 2 + 0) * 512 + col], l1 = p.lb_logits[(dir * 2 + 1) * 512 + col];
    p.lbt[i] = 1.0f / (1.0f + expf(l1 - l0));
  }
}

DEV void ln_mod_row(const float* h, const float* shift, const float* scale, act_t* u) {
  float mu = 0.f;
  for (int k = 0; k < D; ++k) mu += h[k];
  mu *= (1.0f / D);
  float var = 0.f;
  for (int k = 0; k < D; ++k) { float d = h[k] - mu; var += d * d; }
  var *= (1.0f / D);
  float rs = 1.0f / sqrtf(var + LN_EPS);
  for (int k = 0; k < D; ++k) stA(u + k, (h[k] - mu) * rs * (1.0f + scale[k]) + shift[k]);
}

DEV void ph_lnmod_first(const Params& p, long row) {
  const float* m = modrow(p, 0, row);
  ln_mod_row(hrow_in(p, row), m, m + D, p.u + row * D);
}

DEV void gemm_item_act(const act_t* A, const float* W, act_t* Cout, int K, int N, int ldc, long i) {
  int n4 = (int)(i % (N / 4));
  long row = i / (N / 4);
  const act_t* a = A + row * K;
  const float* w = W + n4 * 4;
  float s0 = 0, s1 = 0, s2 = 0, s3 = 0;
  for (int k = 0; k < K; ++k) {
    float av = ldA(a + k);
    const float* wr = w + (long)k * N;
    s0 += av * wr[0]; s1 += av * wr[1]; s2 += av * wr[2]; s3 += av * wr[3];
  }
  act_t* o = Cout + row * ldc + n4 * 4;
  stA(o, s0); stA(o + 1, s1); stA(o + 2, s2); stA(o + 3, s3);
}

DEV void ph_rope(const Params& p, long i) {
  int pr = (int)(i % 32);
  int hh = (int)((i / 32) % 10);
  long lr = i / 320;
  int t = (int)(lr % T);
  int col = hh < 8 ? E_AQ + hh * 64 : E_AK + (hh - 8) * 64;
  int idx = pr & 15;
  int pos = pr < 16 ? t / GRID_W : t % GRID_W;
  int d0 = pr < 16 ? idx : 32 + idx;
  float inv = powf(10000.0f, -(float)idx / 16.0f);
  float ang = (float)pos * inv;
  float cs = cosf(ang), sn = sinf(ang);
  act_t* base = p.P + (NC + lr) * PW + col;
  float x1 = ldA(base + d0), x2 = ldA(base + d0 + 16);
  stA(base + d0, x1 * cs - x2 * sn);
  stA(base + d0 + 16, x1 * sn + x2 * cs);
}

DEV void ph_attn(const Params& p, long i) {
  int h = (int)(i % 8);
  long row = i / 8;
  int kv = h / 4;
  bool lat = row >= NC;
  int b = lat ? (int)((row - NC) / T) : (int)(row / C);
  int t = lat ? (int)((row - NC) % T) : 0;
  float q[64], acc[64];
  const act_t* qp = p.P + row * PW + E_AQ + h * 64;
#pragma unroll
  for (int d = 0; d < 64; ++d) { q[d] = ldA(qp + d) * 0.125f; acc[d] = 0.f; }
  float m = p.attn_sink[h], l = 1.0f;
  int nkeys = C + (lat ? 257 : 0);
  for (int j = 0; j < nkeys; ++j) {
    long krow;
    if (j < C) krow = (long)b * C + j;
    else {
      int kp = t - 128 + (j - C);
      if (kp < 0 || kp >= T) continue;
      krow = NC + (long)b * T + kp;
    }
    const act_t* kptr = p.P + krow * PW + E_AK + kv * 64;
    const act_t* vptr = p.P + krow * PW + E_AV + kv * 64;
    float s = 0.f;
#pragma unroll
    for (int d = 0; d < 64; ++d) s += q[d] * ldA(kptr + d);
    float mn = fmaxf(m, s);
    float sc = expf(m - mn), pj = expf(s - mn);
    l = l * sc + pj;
#pragma unroll
    for (int d = 0; d < 64; ++d) acc[d] = acc[d] * sc + pj * ldA(vptr + d);
    m = mn;
  }
  float il = 1.0f / l;
  act_t* o = p.u + row * D + h * 64;
#pragma unroll
  for (int d = 0; d < 64; ++d) stA(o + d, acc[d] * il);
}

template <int MODE>
DEV void ph_scan(const Params& p, long i) {
  constexpr int DK = MODE == 0 ? 128 : 96;
  constexpr int DV = MODE == 0 ? 128 : 192;
  int e = (int)(i % DV);
  int dir = (int)((i / DV) % 2);
  int h = (int)((i / (2 * DV)) % 4);
  int b = (int)(i / (8 * DV));
  float S[DK];
#pragma unroll
  for (int d = 0; d < DK; ++d) S[d] = 0.f;
  act_t* OD = dir == 0 ? p.OF : p.OB;
  for (int step = 0; step < C + T; ++step) {
    long row;
    if (step < C) row = (long)b * C + (dir == 0 ? step : C - 1 - step);
    else { int tt = step - C; row = NC + (long)b * T + (dir == 0 ? tt : T - 1 - tt); }
    const act_t* pr = p.P + row * PW;
    float o = 0.f;
    if (MODE == 0) {
      float v = ldA(pr + E_HI + h * 128 + e);
      const act_t* zp = pr + E_FF + dir * 512 + h * 128;
      const act_t* qp = pr + E_HQ + h * 128;
      const float* lb = p.lbt + dir * 512 + h * 128;
#pragma unroll
      for (int d = 0; d < DK; ++d) {
        float f = lb[d] + (1.0f - lb[d]) * sigmoidf_(ldA(zp + d));
        S[d] = f * S[d] + (1.0f - f) * v;
        o += ldA(qp + d) * S[d];
      }
      stA(OD + row * 768 + h * 128 + e, o);
    } else {
      float v = ldA(pr + O_V + h * 192 + e);
      const act_t* kp = pr + O_K + h * 96;
      const act_t* qp = pr + O_Q + h * 96;
      const act_t* lf = p.LF + ((long)dir * NR + row) * 384 + h * 96;
#pragma unroll
      for (int d = 0; d < DK; ++d) {
        float f = expf(ldA(lf + d));
        S[d] = f * S[d] + ldA(kp + d) * v;
        o += ldA(qp + d) * S[d];
      }
      stA(OD + row * 768 + h * 192 + e, o * 0.10206207261596575f);
    }
  }
}

template <int MODE>
DEV void ph_combine(const Params& p, long i) {
  constexpr int DV = MODE == 0 ? 128 : 192;
  int h = (int)(i % 4);
  long row = (MODE == 0) ? i / 4 : NC + i / 4;
  const act_t* f = p.OF + row * 768 + h * DV;
  const act_t* bk = p.OB + row * 768 + h * DV;
  float ss = 0.f;
  for (int e = 0; e < DV; ++e) { float o = ldA(f + e) + ldA(bk + e); ss += o * o; }
  float r = 1.0f / sqrtf(ss / DV + LN_EPS);
  const float* gn = (MODE == 0 ? p.hgrn_norm : p.gla_norm) + h * DV;
  const act_t* g = p.P + row * PW + (MODE == 0 ? E_HG : O_G) + h * DV;
  act_t* o = p.u + row * D + (MODE == 0 ? 512 : 0) + h * DV;
  for (int e = 0; e < DV; ++e) stA(o + e, (ldA(f + e) + ldA(bk + e)) * r * gn[e] * siluf_(ldA(g + e)));
}

DEV void ph_gla_decay(const Params& p, long i) {
  int col = (int)(i % 384);
  long row = (i / 384) % NR;
  int dir = (int)(i / ((long)384 * NR));
  const act_t* r = p.P + row * PW + O_RF + dir * 16;
  const float* gw = p.gla_gate_w + (long)dir * 16 * 384 + col;
  float z = p.gla_gate_b[dir * 384 + col];
  for (int k = 0; k < 16; ++k) z += ldA(r + k) * gw[k * 384];
  float ls = fminf(z, 0.f) - log1pf(expf(-fabsf(z)));
  stA(p.LF + ((long)dir * NR + row) * 384 + col, ls * (1.0f / 16.0f));
}

DEV void ph_resid_ln(const Params& p, long row, int l, int sub) {
  const float* hin = (l == 0 && sub == 0) ? hrow_in(p, row) : hrow(p, row);
  float* hout = hrow(p, row);
  const float* md = modrow(p, l, row);
  const float* g = md + (sub == 0 ? 2 : 5) * D;
  const act_t* m = p.M + row * D;
  const float* lg = p.ln_g + (l * 2 + sub) * D;
  const float* lb = p.ln_b + (l * 2 + sub) * D;
  float mu = 0.f;
  for (int k = 0; k < D; ++k) mu += ALPHA * hin[k] + g[k] * ldA(m + k);
  mu *= (1.0f / D);
  float var = 0.f;
  for (int k = 0; k < D; ++k) { float d = ALPHA * hin[k] + g[k] * ldA(m + k) - mu; var += d * d; }
  var *= (1.0f / D);
  float rs = 1.0f / sqrtf(var + LN_EPS);
  for (int k = 0; k < D; ++k) hout[k] = (ALPHA * hin[k] + g[k] * ldA(m + k) - mu) * rs * lg[k] + lb[k];
  if (sub == 1 && l == 1) return;
  const float* md2 = (sub == 0) ? md + 3 * D : modrow(p, 1, row);
  float mu2 = 0.f;
  for (int k = 0; k < D; ++k) mu2 += hout[k];
  mu2 *= (1.0f / D);
  float var2 = 0.f;
  for (int k = 0; k < D; ++k) { float d = hout[k] - mu2; var2 += d * d; }
  var2 *= (1.0f / D);
  float rs2 = 1.0f / sqrtf(var2 + LN_EPS);
  float lo[NEXP];
#pragma unroll
  for (int e = 0; e < NEXP; ++e) lo[e] = 0.f;
  for (int k = 0; k < D; ++k) {
    float uv = (hout[k] - mu2) * rs2 * (1.0f + md2[D + k]) + md2[k];
    stA(p.u + row * D + k, uv);
    if (sub == 0) {
      const float* wr = p.w_router + k * NEXP;
#pragma unroll
      for (int e = 0; e < NEXP; ++e) lo[e] += uv * wr[e];
    }
  }
  if (sub != 0) return;
  float mx = lo[0];
#pragma unroll
  for (int e = 1; e < NEXP; ++e) mx = fmaxf(mx, lo[e]);
  float sum = 0.f;
#pragma unroll
  for (int e = 0; e < NEXP; ++e) { lo[e] = expf(lo[e] - mx); sum += lo[e]; }
  float inv = 1.0f / sum;
  float bestg = -1e30f; int bg = 0;
  float gi1 = 0, gi2 = 0; int ge1 = 0, ge2 = 0;
  float gp1 = 0, gp2 = 0;
#pragma unroll
  for (int gq = 0; gq < 4; ++gq) {
    float s1 = -1e30f, s2 = -1e30f, p1 = 0, p2 = 0; int e1 = 0, e2 = 0;
#pragma unroll
    for (int j = 0; j < 4; ++j) {
      int e = gq * 4 + j;
      float pe = lo[e] * inv;
      float se = pe + p.b_router[e];
      if (se > s1) { s2 = s1; p2 = p1; e2 = e1; s1 = se; p1 = pe; e1 = e; }
      else if (se > s2) { s2 = se; p2 = pe; e2 = e; }
    }
    float gs = s1 + s2;
    if (gs > bestg) { bestg = gs; bg = gq; gi1 = s1; gi2 = s2; ge1 = e1; ge2 = e2; gp1 = p1; gp2 = p2; }
  }
  (void)bg; (void)gi1; (void)gi2;
  float wsum = gp1 + gp2;
  p.eidx[row * 2 + 0] = ge1; p.eidx[row * 2 + 1] = ge2;
  p.ew[row * 2 + 0] = gp1 / wsum; p.ew[row * 2 + 1] = gp2 / wsum;
}

DEV void ph_moe_up(const Params& p, long i, int l, long row0) {
  int f4 = (int)(i % (DFF / 4));
  int slot = (int)((i / (DFF / 4)) % 2);
  long row = row0 + i / (DFF / 2);
  int e = p.eidx[row * 2 + slot];
  const float* w1 = p.w_eg + ((long)(l * NEXP + e) * D) * DFF + f4 * 4;
  const float* w3 = p.w_eu + ((long)(l * NEXP + e) * D) * DFF + f4 * 4;
  const act_t* a = p.u + row * D;
  float g0 = 0, g1 = 0, g2 = 0, g3 = 0, u0 = 0, u1 = 0, u2 = 0, u3 = 0;
  for (int k = 0; k < D; ++k) {
    float av = ldA(a + k);
    const float* r1 = w1 + (long)k * DFF;
    const float* r3 = w3 + (long)k * DFF;
    g0 += av * r1[0]; g1 += av * r1[1]; g2 += av * r1[2]; g3 += av * r1[3];
    u0 += av * r3[0]; u1 += av * r3[1]; u2 += av * r3[2]; u3 += av * r3[3];
  }
  act_t* hb = p.P + (row * 2 + slot) * DFF + f4 * 4;
  stA(hb, siluf_(g0) * u0); stA(hb + 1, siluf_(g1) * u1); stA(hb + 2, siluf_(g2) * u2); stA(hb + 3, siluf_(g3) * u3);
}

DEV void ph_moe_down(const Params& p, long i, int l, long row0) {
  int j4 = (int)(i % (D / 4));
  long row = row0 + i / (D / 4);
  float y0 = 0, y1 = 0, y2 = 0, y3 = 0;
  for (int slot = 0; slot < 2; ++slot) {
    int e = p.eidx[row * 2 + slot];
    float wgt = p.ew[row * 2 + slot];
    const float* w2 = p.w_ed + ((long)(l * NEXP + e) * DFF) * D + j4 * 4;
    const act_t* hb = p.P + (row * 2 + slot) * DFF;
    float s0 = 0, s1 = 0, s2 = 0, s3 = 0;
    for (int f = 0; f < DFF; ++f) {
      float hv = ldA(hb + f);
      const float* r = w2 + (long)f * D;
      s0 += hv * r[0]; s1 += hv * r[1]; s2 += hv * r[2]; s3 += hv * r[3];
    }
    y0 += wgt * s0; y1 += wgt * s1; y2 += wgt * s2; y3 += wgt * s3;
  }
  act_t* o = p.M + row * D + j4 * 4;
  stA(o, y0); stA(o + 1, y1); stA(o + 2, y2); stA(o + 3, y3);
}


#ifndef HOST_TEST
typedef __attribute__((ext_vector_type(8))) short bf16x8;
typedef __attribute__((ext_vector_type(4))) float f32x4;
constexpr int SMEM_BYTES = 71680;
constexpr int IN_ODD_PAD = 2944;
constexpr int O_FA = 2336, O_FB = 2592, O_END = 2848;

__device__ __forceinline__ unsigned pack2(float a, float b) {
  unsigned ua = __float_as_uint(a), ub = __float_as_uint(b);
  ua += 0x7fffu + ((ua >> 16) & 1u);
  ub += 0x7fffu + ((ub >> 16) & 1u);
  return (ua >> 16) | (ub & 0xffff0000u);
}
__device__ __forceinline__ float bf_lo(unsigned u) { return __uint_as_float(u << 16); }
__device__ __forceinline__ float bf_hi(unsigned u) { return __uint_as_float(u & 0xffff0000u); }
__device__ __forceinline__ float wave_sum(float v) {
#pragma unroll
  for (int o = 32; o > 0; o >>= 1) v += __shfl_xor(v, o);
  return v;
}


#define XB_TMO      128
#define XB_XCNT(j)  (256  + 64 * (j))
#define XB_XSUB(j)  (1280 + 64 * (j))
#define XB_XGEN(j)  (2304 + 64 * (j))
#define XB_TOP      3328
#define XB_TOPGEN   3392
#define XCD_BAR_WORDS 3456
#define XB_SPIN_CAP (1u << 18)
#define LAS __attribute__((address_space(3)))
__device__ __forceinline__ unsigned xb_ld(unsigned* p)              { return __hip_atomic_load(p, __ATOMIC_RELAXED, __HIP_MEMORY_SCOPE_AGENT); }
__device__ __forceinline__ unsigned xb_add(unsigned* p, unsigned v) { return __hip_atomic_fetch_add(p, v, __ATOMIC_RELAXED, __HIP_MEMORY_SCOPE_AGENT); }
__device__ __forceinline__ unsigned xb_xcc_id() { return (unsigned)__builtin_amdgcn_s_getreg((3 << 11) | 20) & 0xFu; }
#define XB_SPIN(cond, bar) do { unsigned _sp = 0; while (cond) { __builtin_amdgcn_s_sleep(1); \
    if ((++_sp & 255u) == 0u) { if (xb_ld(&(bar)[XB_TMO])) break; if (_sp > XB_SPIN_CAP) { atomicAdd(&(bar)[XB_TMO], 1u); break; } } } } while (0)
struct XcdBarrier { unsigned* bar; unsigned x; volatile LAS unsigned* st; };
__device__ __forceinline__ XcdBarrier xcd_barrier_post(unsigned* bar, volatile LAS unsigned* st) {
    XcdBarrier b; b.bar = bar; b.x = xb_xcc_id(); b.st = st;
    if (threadIdx.x == 0) (void)xb_add(&bar[XB_XCNT(b.x)], 1u);
    return b;
}
__device__ __forceinline__ void xcd_barrier_complete(unsigned* bar, unsigned x, unsigned& nloc, unsigned& nx) {
    const unsigned G = gridDim.x * gridDim.y * gridDim.z;
    unsigned sum, cnt, mine, sp = 0u;
    for (;;) {
        sum = 0u; cnt = 0u; mine = 0u;
#pragma unroll
        for (unsigned j = 0; j < 16; ++j) { const unsigned c = xb_ld(&bar[XB_XCNT(j)]); sum += c; cnt += (c > 0u) ? 1u : 0u; mine = (j == x) ? c : mine; }
        if (sum == G) break;
        __builtin_amdgcn_s_sleep(1);
        if ((++sp & 255u) == 0u) { if (xb_ld(&bar[XB_TMO])) break; if (sp > XB_SPIN_CAP) { atomicAdd(&bar[XB_TMO], 1u); break; } }
    }
    nloc = mine > 0u ? mine : 1u; nx = cnt > 0u ? cnt : 1u;
}
__device__ __forceinline__ void xcd_barrier(const XcdBarrier& b) {
    asm volatile("s_waitcnt vmcnt(0)" ::: "memory");
    __syncthreads();
    if (threadIdx.x == 0) {
        unsigned* bar = b.bar;
        __builtin_amdgcn_s_waitcnt(0);
        unsigned nloc = b.st[0], nx = b.st[1];
        if (nloc == 0u) { xcd_barrier_complete(bar, b.x, nloc, nx); b.st[0] = nloc; b.st[1] = nx; }
        const unsigned old = xb_add(&bar[XB_XSUB(b.x)], 1u);
        const unsigned gen = old / nloc;
        if (old + 1u == (gen + 1u) * nloc) {
            __builtin_amdgcn_fence(__ATOMIC_RELEASE, "agent");
            asm volatile("s_waitcnt vmcnt(0)" ::: "memory");
            const unsigned og = xb_add(&bar[XB_TOP], 1u);
            const unsigned tg = og / nx;
            if (og + 1u == (tg + 1u) * nx) xb_add(&bar[XB_TOPGEN], 1u);
            else XB_SPIN(xb_ld(&bar[XB_TOPGEN]) == tg, bar);
            __builtin_amdgcn_fence(__ATOMIC_ACQUIRE, "agent");
            xb_add(&bar[XB_XGEN(b.x)], 1u);
            asm volatile("s_waitcnt vmcnt(0)" ::: "memory");
        } else {
            XB_SPIN(xb_ld(&bar[XB_XGEN(b.x)]) == gen, bar);
            __builtin_amdgcn_fence(__ATOMIC_ACQUIRE, "agent");
            asm volatile("s_waitcnt vmcnt(0)" ::: "memory");
        }
    }
    __syncthreads();
}

template <class ARow, class Epi>
__device__ __forceinline__ void gemm_tile(ARow arow, const act_t* Bt, int K, unsigned char* smem, Epi epi) {
  const int tid = threadIdx.x, wid = tid >> 6, lane = tid & 63, wr = wid >> 1, wc = wid & 1, fr = lane & 15,
            fq = lane >> 4;
  act_t* SA = (act_t*)smem;
  act_t* SB = SA + 128 * 32;
  const int b0 = tid * 16, b1 = tid * 16 + 4096;
  const int r0 = b0 >> 6, c0 = (b0 & 63) >> 1, r1 = b1 >> 6, c1 = (b1 & 63) >> 1;
  const act_t* ga0 = arow(r0) + c0;
  const act_t* ga1 = arow(r1) + c1;
  const act_t* gb0 = Bt + (long)r0 * K + c0;
  const act_t* gb1 = Bt + (long)r1 * K + c1;
  f32x4 acc[4][4];
#pragma unroll
  for (int m = 0; m < 4; ++m)
#pragma unroll
    for (int n = 0; n < 4; ++n) acc[m][n] = f32x4{0.f, 0.f, 0.f, 0.f};
  for (int kt = 0; kt < K; kt += 32) {
    __builtin_amdgcn_global_load_lds((const unsigned*)(ga0 + kt), (unsigned*)((char*)SA + b0), 16, 0, 0);
    __builtin_amdgcn_global_load_lds((const unsigned*)(gb0 + kt), (unsigned*)((char*)SB + b0), 16, 0, 0);
    __builtin_amdgcn_global_load_lds((const unsigned*)(ga1 + kt), (unsigned*)((char*)SA + b1), 16, 0, 0);
    __builtin_amdgcn_global_load_lds((const unsigned*)(gb1 + kt), (unsigned*)((char*)SB + b1), 16, 0, 0);
    asm volatile("s_waitcnt vmcnt(0)" ::: "memory");
    __syncthreads();
    bf16x8 af[4], bfr[4];
#pragma unroll
    for (int m = 0; m < 4; ++m) {
      af[m] = *reinterpret_cast<const bf16x8*>((const char*)SA + (wr * 64 + m * 16 + fr) * 64 + fq * 16);
      bfr[m] = *reinterpret_cast<const bf16x8*>((const char*)SB + (wc * 64 + m * 16 + fr) * 64 + fq * 16);
    }
    asm volatile("s_waitcnt lgkmcnt(0)" ::: "memory");
    __builtin_amdgcn_sched_barrier(0);
#pragma unroll
    for (int m = 0; m < 4; ++m)
#pragma unroll
      for (int n = 0; n < 4; ++n) acc[m][n] = __builtin_amdgcn_mfma_f32_16x16x32_bf16(af[m], bfr[n], acc[m][n], 0, 0, 0);
    __syncthreads();
  }
  epi(acc, wr, wc, fr, fq);
}


__device__ __forceinline__ void phase_attn(const Params& p, unsigned char* smem, int blk, int nblk) {
  const int tid = threadIdx.x, w = tid >> 6, lane = tid & 63, fr = lane & 15, g = lane >> 4;
  act_t* SK = (act_t*)smem;
  act_t* SV = SK + 64 * 72;
  constexpr float SCL = 0.125f * 1.4426950408889634f;
  const int n_lat = NB * 4 * (T / 64), n_ctx = NB * 4 * (C / 64);
  const int skey = tid >> 2, spart = tid & 3;
  for (int unit = blk; unit < n_lat + n_ctx; unit += nblk) {
    const bool lat = unit < n_lat;
    const int uu = lat ? unit : unit - n_lat;
    const int nq = lat ? T / 64 : C / 64;
    const int hp = uu & 1, kv = (uu >> 1) & 1, qb = (uu >> 2) % nq, b = (uu >> 2) / nq;
    const int t0 = qb * 64;
    const int tw = t0 + (w & 1) * 32;
    const long qrow0 = (lat ? (long)NC + (long)b * T : (long)b * C) + tw;
    const int h = kv * 4 + hp * 2 + (w >> 1);
    bf16x8 qf[2][2];
#pragma unroll
    for (int qt = 0; qt < 2; ++qt)
#pragma unroll
      for (int st = 0; st < 2; ++st)
        qf[qt][st] = *reinterpret_cast<const bf16x8*>(p.P + (qrow0 + qt * 16 + fr) * PW + E_AQ + h * 64 + st * 32 + g * 8);
    float mrun[2], lrun[2];
    f32x4 o[2][4];
    const float sinkl = p.attn_sink[h] * 1.4426950408889634f;
#pragma unroll
    for (int qt = 0; qt < 2; ++qt) {
      mrun[qt] = sinkl;
      lrun[qt] = (g == 0) ? 1.0f : 0.0f;
#pragma unroll
      for (int dt = 0; dt < 4; ++dt) o[qt][dt] = f32x4{0.f, 0.f, 0.f, 0.f};
    }
    int cc_lo = 0, cc_hi = -1;
    if (lat) {
      cc_lo = t0 >= 128 ? 0 : (128 - t0) / 64;
      cc_hi = min(4, (T - 1 - (t0 - 128)) / 64);
    }
    const int nch = 4 + (cc_hi - cc_lo + 1);
    auto chunk_row = [&](int i, int key, int& tkb) -> long {
      if (i < 4) { tkb = 0; return (long)b * C + i * 64 + key; }
      tkb = t0 - 128 + (cc_lo + i - 4) * 64;
      return (long)NC + (long)b * T + tkb + key;
    };
    uint4 rk0, rk1, rv0, rv1;
    {
      int tkb; const long kr = chunk_row(0, skey, tkb);
      const act_t* kp = p.P + kr * PW + E_AK + kv * 64 + spart * 16;
      const act_t* vp = p.P + kr * PW + E_AV + kv * 64 + spart * 16;
      rk0 = *reinterpret_cast<const uint4*>(kp); rk1 = *reinterpret_cast<const uint4*>(kp + 8);
      rv0 = *reinterpret_cast<const uint4*>(vp); rv1 = *reinterpret_cast<const uint4*>(vp + 8);
    }
    for (int i = 0; i < nch; ++i) {
      __syncthreads();
      {
        uint4* kd = reinterpret_cast<uint4*>(SK + skey * 72 + spart * 16);
        kd[0] = rk0; kd[1] = rk1;
        const unsigned vw[8] = {rv0.x, rv0.y, rv0.z, rv0.w, rv1.x, rv1.y, rv1.z, rv1.w};
#pragma unroll
        for (int e = 0; e < 8; ++e) {
          SV[(spart * 16 + 2 * e) * 72 + skey] = (act_t)(vw[e] & 0xffffu);
          SV[(spart * 16 + 2 * e + 1) * 72 + skey] = (act_t)(vw[e] >> 16);
        }
      }
      __syncthreads();
      int tkb_cur; (void)chunk_row(i, 0, tkb_cur);
      if (i + 1 < nch) {
        int tkb; const long kr = chunk_row(i + 1, skey, tkb);
        const act_t* kp = p.P + kr * PW + E_AK + kv * 64 + spart * 16;
        const act_t* vp = p.P + kr * PW + E_AV + kv * 64 + spart * 16;
        rk0 = *reinterpret_cast<const uint4*>(kp); rk1 = *reinterpret_cast<const uint4*>(kp + 8);
        rv0 = *reinterpret_cast<const uint4*>(vp); rv1 = *reinterpret_cast<const uint4*>(vp + 8);
      }
      const bool band = i >= 4;
#pragma unroll
      for (int kb = 0; kb < 2; ++kb) {
        f32x4 sc[2][2];
#pragma unroll
        for (int k2 = 0; k2 < 2; ++k2) {
          const int kt = kb * 2 + k2;
          const bf16x8 kf0 = *reinterpret_cast<const bf16x8*>(SK + (kt * 16 + fr) * 72 + g * 8);
          const bf16x8 kf1 = *reinterpret_cast<const bf16x8*>(SK + (kt * 16 + fr) * 72 + 32 + g * 8);
#pragma unroll
          for (int qt = 0; qt < 2; ++qt) {
            f32x4 z = f32x4{0.f, 0.f, 0.f, 0.f};
            z = __builtin_amdgcn_mfma_f32_16x16x32_bf16(kf0, qf[qt][0], z, 0, 0, 0);
            sc[qt][k2] = __builtin_amdgcn_mfma_f32_16x16x32_bf16(kf1, qf[qt][1], z, 0, 0, 0);
          }
        }
        bf16x8 pf[2];
#pragma unroll
        for (int qt = 0; qt < 2; ++qt) {
          float mx = -1e30f;
#pragma unroll
          for (int k2 = 0; k2 < 2; ++k2)
#pragma unroll
            for (int j = 0; j < 4; ++j) {
              float v = sc[qt][k2][j] * SCL;
              if (band) {
                const int tk = tkb_cur + (kb * 2 + k2) * 16 + 4 * g + j;
                const int tq = tw + qt * 16 + fr;
                const int df = tq - tk;
                if (df > 128 || df < -128) v = -1e30f;
              }
              sc[qt][k2][j] = v;
              mx = fmaxf(mx, v);
            }
          mx = fmaxf(mx, __shfl_xor(mx, 16));
          mx = fmaxf(mx, __shfl_xor(mx, 32));
          const float mnew = fmaxf(mrun[qt], mx);
          const float alpha = exp2f(mrun[qt] - mnew);
          mrun[qt] = mnew;
          float ls = 0.f;
          float pv[8];
#pragma unroll
          for (int k2 = 0; k2 < 2; ++k2)
#pragma unroll
            for (int j = 0; j < 4; ++j) {
              const float pe = exp2f(sc[qt][k2][j] - mnew);
              pv[k2 * 4 + j] = pe;
              ls += pe;
            }
          lrun[qt] = lrun[qt] * alpha + ls;
#pragma unroll
          for (int dt = 0; dt < 4; ++dt) o[qt][dt] = o[qt][dt] * alpha;
          union { unsigned u[4]; bf16x8 v; } cv;
          cv.u[0] = pack2(pv[0], pv[1]); cv.u[1] = pack2(pv[2], pv[3]);
          cv.u[2] = pack2(pv[4], pv[5]); cv.u[3] = pack2(pv[6], pv[7]);
          pf[qt] = cv.v;
        }
#pragma unroll
        for (int dt = 0; dt < 4; ++dt) {
          union { uint2 h2[2]; bf16x8 v; } vf;
          vf.h2[0] = *reinterpret_cast<const uint2*>(SV + (dt * 16 + fr) * 72 + kb * 32 + 4 * g);
          vf.h2[1] = *reinterpret_cast<const uint2*>(SV + (dt * 16 + fr) * 72 + kb * 32 + 16 + 4 * g);
#pragma unroll
          for (int qt = 0; qt < 2; ++qt) o[qt][dt] = __builtin_amdgcn_mfma_f32_16x16x32_bf16(vf.v, pf[qt], o[qt][dt], 0, 0, 0);
        }
      }
    }
#pragma unroll
    for (int qt = 0; qt < 2; ++qt) {
      float lt = lrun[qt];
      lt += __shfl_xor(lt, 16);
      lt += __shfl_xor(lt, 32);
      const float il = 1.0f / lt;
      act_t* orow = p.u + (qrow0 + qt * 16 + fr) * D + h * 64 + 4 * g;
#pragma unroll
      for (int dt = 0; dt < 4; ++dt)
        *reinterpret_cast<uint2*>(orow + dt * 16) =
            make_uint2(pack2(o[qt][dt][0] * il, o[qt][dt][1] * il), pack2(o[qt][dt][2] * il, o[qt][dt][3] * il));
    }
  }
}


template <int MODE>
__device__ __forceinline__ void phase_combine(const Params& p) {
  constexpr int DV = MODE == 0 ? 128 : 192, EPL = DV / 16, NV = EPL / 4;
  const int lane = threadIdx.x & 63;
  const long row_lo = MODE == 0 ? 0 : NC;
  const long w0 = (long)blockIdx.x * 4 + (threadIdx.x >> 6), wstride = (long)gridDim.x * 4;
  const float* gn = (MODE == 0 ? p.hgrn_norm : p.gla_norm) + lane * EPL;
  for (long row = row_lo + w0; row < NR; row += wstride) {
    const uint2* f = reinterpret_cast<const uint2*>(p.OF + row * 768 + lane * EPL);
    const uint2* bk = reinterpret_cast<const uint2*>(p.OB + row * 768 + lane * EPL);
    const uint2* gt = reinterpret_cast<const uint2*>(p.P + row * PW + (MODE == 0 ? E_HG : O_G) + lane * EPL);
    float o[EPL];
    float ss = 0.f;
#pragma unroll
    for (int v = 0; v < NV; ++v) {
      const uint2 a = f[v], c = bk[v];
      o[4 * v + 0] = bf_lo(a.x) + bf_lo(c.x); o[4 * v + 1] = bf_hi(a.x) + bf_hi(c.x);
      o[4 * v + 2] = bf_lo(a.y) + bf_lo(c.y); o[4 * v + 3] = bf_hi(a.y) + bf_hi(c.y);
    }
#pragma unroll
    for (int e = 0; e < EPL; ++e) ss += o[e] * o[e];
#pragma unroll
    for (int of = 1; of < 16; of <<= 1) ss += __shfl_xor(ss, of);
    const float r = 1.0f / sqrtf(ss * (1.0f / DV) + LN_EPS);
    uint2* dst = reinterpret_cast<uint2*>(p.u + row * D + (MODE == 0 ? 512 : 0) + lane * EPL);
#pragma unroll
    for (int v = 0; v < NV; ++v) {
      const uint2 gv = gt[v];
      const float g0 = bf_lo(gv.x), g1 = bf_hi(gv.x), g2 = bf_lo(gv.y), g3 = bf_hi(gv.y);
      const float y0 = o[4 * v + 0] * r * gn[4 * v + 0] * (g0 / (1.0f + __expf(-g0)));
      const float y1 = o[4 * v + 1] * r * gn[4 * v + 1] * (g1 / (1.0f + __expf(-g1)));
      const float y2 = o[4 * v + 2] * r * gn[4 * v + 2] * (g2 / (1.0f + __expf(-g2)));
      const float y3 = o[4 * v + 3] * r * gn[4 * v + 3] * (g3 / (1.0f + __expf(-g3)));
      dst[v] = make_uint2(pack2(y0, y1), pack2(y2, y3));
    }
  }
}

__device__ __forceinline__ void mod_item(const Params& p, int item, unsigned char* smem) {
  float* sc = (float*)smem;
  const int tid = threadIdx.x;
  for (int i = tid; i < 9 * D; i += 256) {
    const int bb = i >> 10, k = i & 1023;
    const float v = bb < NB ? p.c[bb * D + k] : p.c_ctx[k];
    sc[i] = v / (1.0f + __expf(-v));
  }
  __syncthreads();
  const int l = item / 24, j = (item % 24) * 256 + tid;
  const float* w = p.w_ada + (long)l * D * 6 * D + j;
  float a[NB + 1];
#pragma unroll
  for (int bb = 0; bb <= NB; ++bb) a[bb] = p.b_ada[l * 6 * D + j];
  for (int k = 0; k < D; k += 8) {
    float wv[8];
#pragma unroll
    for (int q = 0; q < 8; ++q) wv[q] = w[(long)(k + q) * 6 * D];
#pragma unroll
    for (int q = 0; q < 8; ++q)
#pragma unroll
      for (int bb = 0; bb <= NB; ++bb) a[bb] += sc[bb * D + k + q] * wv[q];
  }
#pragma unroll
  for (int bb = 0; bb <= NB; ++bb) p.mod[((long)l * (NB + 1) + bb) * 6 * D + j] = a[bb];
  __syncthreads();
}

__device__ __forceinline__ void phase_hgrn_gate(const Params& p, long gtid, long gstride) {
  for (long i = gtid; i < (long)NR * 1024; i += gstride) {
    const int col = (int)(i & 1023);
    const long row = i >> 10;
    act_t* z = p.P + row * PW + E_FF + col;
    const float lb = p.lbt[col];
    const float f = lb + (1.0f - lb) * sigmoidf_(ldA(z));
    stA(z, __logf(f));
  }
}

template <int MODE>
__device__ __forceinline__ void phase_scan(const Params& p, unsigned char* smem, int blk, int nblk) {
  constexpr int DK = MODE == 0 ? 128 : 96, DV = MODE == 0 ? 128 : 192, DVS = DV / 4, NET = DVS / 16, NKS = DK / 32,
                NDT = DK / 16;
  constexpr int QS = DK + 8, LS = 72, SS = DK + 8;
  act_t* Qa = (act_t*)smem;
  act_t* Ka = Qa + 64 * QS;
  act_t* KaT = Ka + 64 * QS;
  act_t* VT = KaT + DK * LS;
  act_t* ST = VT + DVS * LS;
  float* tot = (float*)(ST + DVS * SS);
  float* lf32 = tot + 2 * 4 * DK;
  const int tid = threadIdx.x, w = __builtin_amdgcn_readfirstlane(threadIdx.x >> 6), lane = tid & 63, fr = lane & 15, g = lane >> 4;
  const int dp = lane, c0 = 2 * dp;
  const bool cact = dp < DK / 2;
  constexpr int NCH = (C + T) / 64, NCC = C / 64;
  constexpr int NVI = DVS / 8 * 64;
  for (int item = blk; item < NB * 4 * 2 * 4; item += nblk) {
    const int sl = item & 3, dir = (item >> 2) & 1, h = (item >> 3) & 3, b = item >> 5;
    act_t* OD = dir == 0 ? p.OF : p.OB;
    const unsigned loff = (unsigned)c0 * 2u;
    const int vcol = (MODE == 0 ? E_HI + h * 128 : O_V + h * 192) + sl * DVS;
    const int ocol = h * DV + sl * DVS;
    auto chunk_base = [&](int n) -> long {
      if (n < NCC) return (long)b * C + (dir ? NCC - 1 - n : n) * 64;
      const int ln = n - NCC;
      return (long)NC + (long)b * T + (dir ? T / 64 - 1 - ln : ln) * 64;
    };
    auto lrow = [&](long base, int l) -> long { return base + (dir ? 63 - l : l); };
    f32x4 S[NET][2];
#pragma unroll
    for (int et = 0; et < NET; ++et) { S[et][0] = f32x4{0.f, 0.f, 0.f, 0.f}; S[et][1] = f32x4{0.f, 0.f, 0.f, 0.f}; }
    unsigned rlf[16], rq[16], rk[16];
    uint4 rv[2];
    auto issue_loads = [&](int n) {
      const long base = chunk_base(n);
      if (cact) {
#pragma unroll
        for (int i = 0; i < 16; ++i) {
          const long row = lrow(base, w * 16 + i);
          const char* prow = (const char*)(p.P + row * PW);
          if (MODE == 0) {
            rlf[i] = *reinterpret_cast<const unsigned*>(prow + (E_FF + dir * 512 + h * 128) * 2 + loff);
            rq[i] = *reinterpret_cast<const unsigned*>(prow + (E_HQ + h * 128) * 2 + loff);
          } else {
            rlf[i] = *reinterpret_cast<const unsigned*>((const char*)(p.LF + ((long)dir * NR + row) * 384 + h * 96) + loff);
            rk[i] = *reinterpret_cast<const unsigned*>(prow + (O_K + h * 96) * 2 + loff);
            rq[i] = *reinterpret_cast<const unsigned*>(prow + (O_Q + h * 96) * 2 + loff);
          }
        }
      }
#pragma unroll
      for (int r = 0; r < (NVI + 255) / 256; ++r) {
        const int it = tid + r * 256;
        if (it < NVI) {
          const int l = it / (DVS / 8), e8 = (it % (DVS / 8)) * 8;
          rv[r] = *reinterpret_cast<const uint4*>(p.P + lrow(base, l) * PW + vcol + e8);
        }
      }
    };
    issue_loads(0);
    for (int n = 0; n < NCH; ++n) {
      const int par = n & 1;
      float* totp = tot + par * 4 * DK;
      float* lfp = lf32 + par * DK;
      const long base = chunk_base(n);
      if (cact) {
        float r0 = 0.f, r1 = 0.f;
#pragma unroll
        for (int i = 0; i < 16; ++i) { r0 += bf_lo(rlf[i]); r1 += bf_hi(rlf[i]); }
        totp[w * DK + c0] = r0; totp[w * DK + c0 + 1] = r1;
        if (w == 2) { lfp[c0] = bf_lo(rlf[0]); lfp[c0 + 1] = bf_hi(rlf[0]); }
      }
      __syncthreads();
      if (cact) {
        float of0 = 0.f, of1 = 0.f;
#pragma unroll
        for (int sgi = 0; sgi < 3; ++sgi)
          if (sgi < w) { of0 += totp[sgi * DK + c0]; of1 += totp[sgi * DK + c0 + 1]; }
        const float ref0 = totp[c0] + totp[DK + c0] + lfp[c0];
        const float ref1 = totp[c0 + 1] + totp[DK + c0 + 1] + lfp[c0 + 1];
        unsigned kt0[8], kt1[8];
        float run0 = of0 - ref0, run1 = of1 - ref1;
#pragma unroll
        for (int i = 0; i < 16; i += 2) {
          float ka0[2], ka1[2];
#pragma unroll
          for (int ii = 0; ii < 2; ++ii) {
            const int i2 = i + ii;
            run0 += bf_lo(rlf[i2]); run1 += bf_hi(rlf[i2]);
            const float b0 = run0, b1 = run1;
            const float e0 = __expf(b0), e1 = __expf(b1), f0 = __expf(-b0), f1 = __expf(-b1);
            float k0, k1;
            if (MODE == 0) { k0 = 1.0f - __expf(bf_lo(rlf[i2])); k1 = 1.0f - __expf(bf_hi(rlf[i2])); }
            else { k0 = bf_lo(rk[i2]); k1 = bf_hi(rk[i2]); }
            ka0[ii] = k0 * f0; ka1[ii] = k1 * f1;
            const int l = w * 16 + i2;
            *reinterpret_cast<unsigned*>(Qa + l * QS + c0) = pack2(bf_lo(rq[i2]) * e0, bf_hi(rq[i2]) * e1);
            *reinterpret_cast<unsigned*>(Ka + l * QS + c0) = pack2(ka0[ii], ka1[ii]);
          }
          kt0[i >> 1] = pack2(ka0[0], ka0[1]);
          kt1[i >> 1] = pack2(ka1[0], ka1[1]);
        }
        uint4* d0 = reinterpret_cast<uint4*>(KaT + c0 * LS + w * 16);
        d0[0] = make_uint4(kt0[0], kt0[1], kt0[2], kt0[3]); d0[1] = make_uint4(kt0[4], kt0[5], kt0[6], kt0[7]);
        uint4* d1 = reinterpret_cast<uint4*>(KaT + (c0 + 1) * LS + w * 16);
        d1[0] = make_uint4(kt1[0], kt1[1], kt1[2], kt1[3]); d1[1] = make_uint4(kt1[4], kt1[5], kt1[6], kt1[7]);
      }
#pragma unroll
      for (int r = 0; r < (NVI + 255) / 256; ++r) {
        const int it = tid + r * 256;
        if (it < NVI) {
          const int l = it / (DVS / 8), e8 = (it % (DVS / 8)) * 8;
          const unsigned vw[4] = {rv[r].x, rv[r].y, rv[r].z, rv[r].w};
#pragma unroll
          for (int e = 0; e < 4; ++e) {
            VT[(e8 + 2 * e) * LS + l] = (act_t)(vw[e] & 0xffffu);
            VT[(e8 + 2 * e + 1) * LS + l] = (act_t)(vw[e] >> 16);
          }
        }
      }
      float egv[2], egrv[2];
#pragma unroll
      for (int di = 0; di < 2; ++di) {
        const int dt = w + 4 * di;
        if (dt < NDT) {
          const int d = dt * 16 + fr;
          const float refd = totp[d] + totp[DK + d] + lfp[d];
          const float gd = totp[d] + totp[DK + d] + totp[2 * DK + d] + totp[3 * DK + d];
          const float er = __expf(refd);
          egv[di] = __expf(gd); egrv[di] = __expf(gd - refd);
#pragma unroll
          for (int et = 0; et < NET; ++et)
#pragma unroll
            for (int j = 0; j < 4; ++j) stA(ST + (et * 16 + 4 * g + j) * SS + d, S[et][di][j] * er);
        }
      }
      __syncthreads();
      if (n + 1 < NCH) issue_loads(n + 1);
      bf16x8 qfr[NKS];
#pragma unroll
      for (int ks = 0; ks < NKS; ++ks) qfr[ks] = *reinterpret_cast<const bf16x8*>(Qa + (w * 16 + fr) * QS + ks * 32 + g * 8);
      f32x4 at[4];
#pragma unroll
      for (int mt = 0; mt < 4; ++mt) {
        at[mt] = f32x4{0.f, 0.f, 0.f, 0.f};
        if (mt <= w) {
#pragma unroll
          for (int ks = 0; ks < NKS; ++ks) {
            const bf16x8 kaf = *reinterpret_cast<const bf16x8*>(Ka + (mt * 16 + fr) * QS + ks * 32 + g * 8);
            at[mt] = __builtin_amdgcn_mfma_f32_16x16x32_bf16(kaf, qfr[ks], at[mt], 0, 0, 0);
          }
          if (mt == w) {
#pragma unroll
            for (int j = 0; j < 4; ++j)
              if (4 * g + j > fr) at[mt][j] = 0.f;
          }
        }
      }
      bf16x8 pfr[2];
#pragma unroll
      for (int kb = 0; kb < 2; ++kb) {
        union { unsigned u[4]; bf16x8 v; } cv;
        cv.u[0] = pack2(at[2 * kb][0], at[2 * kb][1]); cv.u[1] = pack2(at[2 * kb][2], at[2 * kb][3]);
        cv.u[2] = pack2(at[2 * kb + 1][0], at[2 * kb + 1][1]); cv.u[3] = pack2(at[2 * kb + 1][2], at[2 * kb + 1][3]);
        pfr[kb] = cv.v;
      }
      const long orow = lrow(base, w * 16 + fr);
#pragma unroll
      for (int et = 0; et < NET; ++et) {
        f32x4 o = f32x4{0.f, 0.f, 0.f, 0.f};
#pragma unroll
        for (int kb = 0; kb < 2; ++kb) {
          if (2 * kb <= w) {
            union { uint2 h2[2]; bf16x8 v; } vf;
            vf.h2[0] = *reinterpret_cast<const uint2*>(VT + (et * 16 + fr) * LS + kb * 32 + 4 * g);
            vf.h2[1] = *reinterpret_cast<const uint2*>(VT + (et * 16 + fr) * LS + kb * 32 + 16 + 4 * g);
            o = __builtin_amdgcn_mfma_f32_16x16x32_bf16(vf.v, pfr[kb], o, 0, 0, 0);
          }
        }
#pragma unroll
        for (int ks = 0; ks < NKS; ++ks) {
          const bf16x8 sf = *reinterpret_cast<const bf16x8*>(ST + (et * 16 + fr) * SS + ks * 32 + g * 8);
          o = __builtin_amdgcn_mfma_f32_16x16x32_bf16(sf, qfr[ks], o, 0, 0, 0);
        }
        const float osc = MODE == 0 ? 1.0f : 0.10206207261596575f;
        *reinterpret_cast<uint2*>(OD + orow * 768 + ocol + et * 16 + 4 * g) =
            make_uint2(pack2(o[0] * osc, o[1] * osc), pack2(o[2] * osc, o[3] * osc));
      }
#pragma unroll
      for (int di = 0; di < 2; ++di) {
        const int dt = w + 4 * di;
        if (dt < NDT) {
#pragma unroll
          for (int et = 0; et < NET; ++et) {
            f32x4 r = f32x4{0.f, 0.f, 0.f, 0.f};
#pragma unroll
            for (int k2 = 0; k2 < 2; ++k2) {
              const bf16x8 vf = *reinterpret_cast<const bf16x8*>(VT + (et * 16 + fr) * LS + k2 * 32 + g * 8);
              const bf16x8 kf = *reinterpret_cast<const bf16x8*>(KaT + (dt * 16 + fr) * LS + k2 * 32 + g * 8);
              r = __builtin_amdgcn_mfma_f32_16x16x32_bf16(vf, kf, r, 0, 0, 0);
            }
#pragma unroll
            for (int j = 0; j < 4; ++j) S[et][di][j] = egv[di] * S[et][di][j] + egrv[di] * r[j];
          }
        }
      }
    }
    __syncthreads();
  }
}

struct GemmJob {
  const act_t* A; const act_t* Bt; act_t* C;
  long sA, sB, sC;
  int nbatch, Mtiles, Ntiles, K, ldc, Nvalid, mode;
  float scale;
};
__device__ __forceinline__ void phase_gemm(const Params& p, const GemmJob& g, unsigned char* smem, int blk = blockIdx.x, int nblk = gridDim.x) {
  const int per_b = g.Mtiles * g.Ntiles;
  const int ntiles = per_b * g.nbatch;
  for (int tile = blk; tile < ntiles; tile += nblk) {
    const int b = tile / per_b, tt = tile % per_b;
    const int tm = tt / g.Ntiles, tn = tt % g.Ntiles;
    if (g.mode == 1 && tm < NC / 128 && tn * 128 >= O_FA) continue;
    const int K = g.K, ldc = g.ldc;
    const act_t* Ab = g.A + b * g.sA + (long)tm * 128 * K;
    act_t* Cb = g.C + b * g.sC + (long)tm * 128 * ldc + tn * 128;
    const int nlim = g.Nvalid - tn * 128;
    const float scale = g.scale;
    const int mode = g.mode;
    gemm_tile([&](int r) { return Ab + (long)r * K; }, g.Bt + b * g.sB + (long)tn * 128 * K, K, smem,
              [&](f32x4 (&acc)[4][4], int wr, int wc, int fr, int fq) {
                if (mode == 2) {
                  const int cb = tn * 128 + wc * 64;
                  if (cb < E_AV && tm >= NC / 128) {
                    const float2* rt = reinterpret_cast<const float2*>(p.ropetab);
#pragma unroll
                    for (int m = 0; m < 4; ++m)
#pragma unroll
                      for (int j = 0; j < 4; ++j) {
                        const int t = ((tm - NC / 128) * 128 + wr * 64 + m * 16 + fq * 4 + j) % T;
                        const float2 cr = rt[(t / GRID_W) * 16 + fr], cc = rt[(t % GRID_W) * 16 + fr];
                        const float a1 = acc[m][0][j], a2 = acc[m][1][j], b1 = acc[m][2][j], b2 = acc[m][3][j];
                        acc[m][0][j] = a1 * cr.x - a2 * cr.y; acc[m][1][j] = a1 * cr.y + a2 * cr.x;
                        acc[m][2][j] = b1 * cc.x - b2 * cc.y; acc[m][3][j] = b1 * cc.y + b2 * cc.x;
                      }
                  } else if (cb >= E_FF && cb < E_HQ) {
#pragma unroll
                    for (int n = 0; n < 4; ++n) {
                      const float lb = p.lbt[cb - E_FF + n * 16 + fr];
#pragma unroll
                      for (int m = 0; m < 4; ++m)
#pragma unroll
                        for (int j = 0; j < 4; ++j)
                          acc[m][n][j] = __logf(lb + (1.0f - lb) / (1.0f + __expf(-acc[m][n][j])));
                    }
                  }
                }
#pragma unroll
                for (int m = 0; m < 4; ++m)
#pragma unroll
                  for (int n = 0; n < 4; ++n) {
                    const int col = wc * 64 + n * 16 + fr;
                    if (col < nlim) {
#pragma unroll
                      for (int j = 0; j < 4; ++j) {
                        const int row = wr * 64 + m * 16 + fq * 4 + j;
                        stA(Cb + (long)row * ldc + col, acc[m][n][j] * scale);
                      }
                    } else if (mode == 1) {
                      const int gc = tn * 128 + col;
                      if (gc < O_END && tm >= NC / 128) {
                        const int lr = (tm - NC / 128) * 128 + wr * 64 + m * 16 + fq * 4;
                        const int bb = lr / T, t = lr % T;
                        const int cq = gc < O_FB ? gc - O_FA : gc - O_FB;
                        act_t* dst = p.FT + ((long)bb * 256 + cq) * (2 * T) + (gc < O_FB ? 0 : T) + t;
                        *reinterpret_cast<uint2*>(dst) = make_uint2(pack2(acc[m][n][0], acc[m][n][1]), pack2(acc[m][n][2], acc[m][n][3]));
                      }
                    }
                  }
              });
  }
}

template <class RowMap>
__device__ __forceinline__ void conv_tile_rm(const float* src, int lds_, int Nvalid, int k0, int n0, act_t* dst, int ldd, float* tile, RowMap rm) {
  const int tid = threadIdx.x;
  {
    const int r = tid >> 4, c4 = (tid & 15) * 4;
#pragma unroll
    for (int rr = 0; rr < 4; ++rr) {
      const int row = r + rr * 16;
      float4 v = make_float4(0.f, 0.f, 0.f, 0.f);
      if (n0 + c4 < Nvalid) v = *reinterpret_cast<const float4*>(src + (long)(k0 + row) * lds_ + n0 + c4);
      float* t = tile + row * 65 + c4;
      t[0] = v.x; t[1] = v.y; t[2] = v.z; t[3] = v.w;
    }
  }
  __syncthreads();
  {
    const int n = tid >> 2, ks = (tid & 3) * 16;
    unsigned w[8];
#pragma unroll
    for (int i = 0; i < 8; ++i) w[i] = pack2(tile[(ks + 2 * i) * 65 + n], tile[(ks + 2 * i + 1) * 65 + n]);
    if (n0 + n < Nvalid) {
      uint4* d = reinterpret_cast<uint4*>(dst + (long)rm(n) * ldd + k0 + ks);
      d[0] = make_uint4(w[0], w[1], w[2], w[3]);
      d[1] = make_uint4(w[4], w[5], w[6], w[7]);
    }
  }
  __syncthreads();
}

__device__ __forceinline__ void conv_tile(const float* src, int lds_, int Nvalid, int k0, int n0, act_t* dst, int ldd, float* tile) {
  conv_tile_rm(src, lds_, Nvalid, k0, n0, dst, ldd, tile, [=](int n) { return n0 + n; });
}

__device__ __forceinline__ void phase_convert_experts(const Params& p, int l, unsigned char* smem) {
  float* tile = (float*)smem;
  const int per_e = 384;
  for (int job = blockIdx.x; job < NEXP * per_e; job += gridDim.x) {
    const int e = job / per_e, j = job % per_e;
    if (j < 256) {
      const int up = j >> 7, jj = j & 127;
      const int kt = jj >> 3, ft = jj & 7;
      const float* src = (up ? p.w_eu : p.w_eg) + ((long)(l * NEXP + e) * D) * DFF;
      const int rbase = ft * 128 + up * 32;
      conv_tile_rm(src, DFF, DFF, kt * 64, ft * 64, p.Wt_up + (long)e * 1024 * D, D, tile,
                   [=](int n) { return rbase + (n >> 5) * 64 + (n & 31); });
    } else {
      const int jj = j - 256;
      const int kt = jj >> 4, nt = jj & 15;
      const float* src = p.w_ed + ((long)(l * NEXP + e) * DFF) * D;
      conv_tile(src, D, D, kt * 64, nt * 64, p.Wt_down + (long)e * 1024 * DFF, DFF, tile);
    }
  }
}

__device__ __forceinline__ void phase_moe(const Params& p, int l, bool down, unsigned char* smem) {
  const int* cntp = p.cnt + l * NEXP;
  int total = 0;
  for (int e = 0; e < NEXP; ++e) total += ((cntp[e] + 127) >> 7) * 8;
  for (int tile = blockIdx.x; tile < total; tile += gridDim.x) {
    int e = 0, tb = 0, rowoff = 0;
    for (; e < NEXP - 1; ++e) {
      const int c = cntp[e];
      const int nt = ((c + 127) >> 7) * 8;
      if (tile < tb + nt) break;
      tb += nt; rowoff += c;
    }
    const int c = cntp[e];
    const int lt = tile - tb, mt = lt >> 3, nt = lt & 7;
    const int rows_valid = min(128, c - mt * 128);
    const int* lst = p.list + (long)(l * NEXP + e) * NR + mt * 128;
    const long hrow0 = (long)rowoff + mt * 128;
    if (!down) {
      gemm_tile([&](int r) { return p.u + (long)(lst[min(r, rows_valid - 1)] >> 1) * D; },
                p.Wt_up + ((long)e * 1024 + nt * 128) * D, D, smem,
                [&](f32x4 (&acc)[4][4], int wr, int wc, int fr, int fq) {
#pragma unroll
                  for (int m = 0; m < 4; ++m)
#pragma unroll
                    for (int j = 0; j < 4; ++j) {
                      const int row = wr * 64 + m * 16 + fq * 4 + j;
                      if (row < rows_valid) {
#pragma unroll
                        for (int n = 0; n < 2; ++n) {
                          const float g = acc[m][n][j], uu = acc[m][n + 2][j];
                          stA(p.H + (hrow0 + row) * DFF + nt * 64 + wc * 32 + n * 16 + fr, g / (1.0f + __expf(-g)) * uu);
                        }
                      }
                    }
                });
    } else {
      const act_t* Ab = p.H + hrow0 * DFF;
      gemm_tile([&](int r) { return Ab + (long)r * DFF; }, p.Wt_down + ((long)e * 1024 + nt * 128) * DFF, DFF, smem,
                [&](f32x4 (&acc)[4][4], int wr, int wc, int fr, int fq) {
#pragma unroll
                  for (int m = 0; m < 4; ++m)
#pragma unroll
                    for (int j = 0; j < 4; ++j) {
                      const int row = wr * 64 + m * 16 + fq * 4 + j;
                      if (row < rows_valid) {
                        const int ts = lst[row];
                        const float w = p.ew[ts];
#pragma unroll
                        for (int n = 0; n < 4; ++n)
                          stA(p.Y + (long)ts * D + nt * 128 + wc * 64 + n * 16 + fr, acc[m][n][j] * w);
                      }
                    }
                });
    }
  }
}

__device__ __forceinline__ void phase_convert_dense(const Params& p, unsigned char* smem) {
  float* tile = (float*)smem;
  const int JM = 48, J0 = JM + 16 * 52, J1 = J0 + 256, J2 = J1 + 16 * 37, J3 = J2 + 256;
  for (int job0 = blockIdx.x; job0 < J3; job0 += gridDim.x) {
    if (job0 < JM) { mod_item(p, job0, smem); continue; }
    const int job = job0;
    if (job < J0) { int j = job - JM; conv_tile(p.w_in_even, IN_EVEN, IN_EVEN, (j / 52) * 64, (j % 52) * 64, p.Wt_in_even, D, tile); }
    else if (0) conv_tile(p.w_in_even, IN_EVEN, IN_EVEN, (job / 52) * 64, (job % 52) * 64, p.Wt_in_even, D, tile);
    else if (job < J1) { int j = job - J0; conv_tile(p.w_out_even, D, D, (j / 16) * 64, (j % 16) * 64, p.Wt_out_even, D, tile); }
    else if (job < J2) { int j = job - J1; conv_tile(p.w_in_odd, IN_ODD, O_FA, (j / 37) * 64, (j % 37) * 64, p.Wt_in_odd, D, tile); }
    else { int j = job - J2; conv_tile(p.w_out_odd, D, D, (j / 16) * 64, (j % 16) * 64, p.Wt_out_odd, D, tile); }
  }
}

__device__ __forceinline__ void phase_fold_z(const Params& p, long gtid, long gstride, float* tab) {
  if (threadIdx.x < 64) {
    float sn, cs;
    sincospif((float)threadIdx.x * (1.0f / 32.0f), &sn, &cs);
    tab[threadIdx.x] = cs; tab[64 + threadIdx.x] = -sn;
  }
  __syncthreads();
  for (long i = gtid; i < (long)512 * D; i += gstride) {
    const int k = (int)(i % D), np = (int)(i / D);
    const int part = np >> 8, col = np & 255, g = col >> 6, cp = col & 63;
    const float* wz = p.w_in_odd + (long)k * IN_ODD + O_Z + g * 64;
    float s = 0.f;
    const float* tb = tab + part * 64;
#pragma unroll 8
    for (int c = 0; c < 64; ++c) s += wz[c] * tb[(c * cp) & 63];
    stA(p.Wt_in_odd + (long)(O_FA + np) * D + k, s);
  }
  for (long i = gtid; i < (long)(IN_ODD_PAD - O_END) * D; i += gstride) p.Wt_in_odd[(long)O_END * D + i] = 0;
}

__device__ __forceinline__ void phase_cmat(const Params& p, long gtid, long gstride) {
  for (long i = gtid; i < (long)T * T; i += gstride) {
    const int t = (int)(i % T), tp = (int)(i / T);
    float sn, cs;
    sincospif((float)((t * tp) & (T - 1)) * (2.0f / T), &sn, &cs);
    stA(p.Cmat + (long)tp * 2 * T + t, cs);
    stA(p.Cmat + (long)tp * 2 * T + T + t, sn);
  }
}

__device__ __forceinline__ void row_stats(const float4 (&v)[4], float& mu, float& rs) {
  float s = 0.f;
#pragma unroll
  for (int i = 0; i < 4; ++i) s += v[i].x + v[i].y + v[i].z + v[i].w;
  mu = wave_sum(s) * (1.0f / D);
  float q = 0.f;
#pragma unroll
  for (int i = 0; i < 4; ++i) {
    float a = v[i].x - mu, b = v[i].y - mu, c = v[i].z - mu, d = v[i].w - mu;
    q += a * a + b * b + c * c + d * d;
  }
  rs = 1.0f / sqrtf(wave_sum(q) * (1.0f / D) + LN_EPS);
}

__device__ __forceinline__ void phase_lnmod_first(const Params& p) {
  const int lane = threadIdx.x & 63;
  const long w0 = (long)blockIdx.x * 4 + (threadIdx.x >> 6), wstride = (long)gridDim.x * 4;
  for (long row = w0; row < NR; row += wstride) {
    const float4* h = reinterpret_cast<const float4*>(hrow_in(p, row));
    const float* md = modrow(p, 0, row);
    float4 v[4];
#pragma unroll
    for (int i = 0; i < 4; ++i) v[i] = h[i * 64 + lane];
    float mu, rs;
    row_stats(v, mu, rs);
#pragma unroll
    for (int i = 0; i < 4; ++i) {
      const float4 sh = reinterpret_cast<const float4*>(md)[i * 64 + lane];
      const float4 sc = reinterpret_cast<const float4*>(md + D)[i * 64 + lane];
      float a = (v[i].x - mu) * rs * (1.f + sc.x) + sh.x, b = (v[i].y - mu) * rs * (1.f + sc.y) + sh.y;
      float c = (v[i].z - mu) * rs * (1.f + sc.z) + sh.z, d = (v[i].w - mu) * rs * (1.f + sc.w) + sh.w;
      reinterpret_cast<uint2*>(p.u + row * D)[i * 64 + lane] = make_uint2(pack2(a, b), pack2(c, d));
    }
  }
}

__device__ __forceinline__ void phase_resid_ln(const Params& p, int l, int sub, long row_lo, long row_hi) {
  const int lane = threadIdx.x & 63;
  const long w0 = (long)blockIdx.x * 4 + (threadIdx.x >> 6), wstride = (long)gridDim.x * 4;
  for (long row = row_lo + w0; row < row_hi; row += wstride) {
    const float4* hin = reinterpret_cast<const float4*>((l == 0 && sub == 0) ? hrow_in(p, row) : hrow(p, row));
    float4* hout = reinterpret_cast<float4*>(hrow(p, row));
    const float* md = modrow(p, l, row);
    const float4* g = reinterpret_cast<const float4*>(md + (sub == 0 ? 2 : 5) * D);
    const uint2* m = reinterpret_cast<const uint2*>(sub == 0 ? p.M + row * D : p.Y + row * 2 * D);
    const uint2* m2 = reinterpret_cast<const uint2*>(p.Y + (row * 2 + 1) * D);
    const float4* lg = reinterpret_cast<const float4*>(p.ln_g + (l * 2 + sub) * D);
    const float4* lb = reinterpret_cast<const float4*>(p.ln_b + (l * 2 + sub) * D);
    float4 v[4];
#pragma unroll
    for (int i = 0; i < 4; ++i) {
      const float4 hv = hin[i * 64 + lane];
      const float4 gv = g[i * 64 + lane];
      const uint2 mv = m[i * 64 + lane];
      float m0 = bf_lo(mv.x), m1 = bf_hi(mv.x), m2_ = bf_lo(mv.y), m3 = bf_hi(mv.y);
      if (sub == 1) {
        const uint2 mw = m2[i * 64 + lane];
        m0 += bf_lo(mw.x); m1 += bf_hi(mw.x); m2_ += bf_lo(mw.y); m3 += bf_hi(mw.y);
      }
      v[i].x = ALPHA * hv.x + gv.x * m0;
      v[i].y = ALPHA * hv.y + gv.y * m1;
      v[i].z = ALPHA * hv.z + gv.z * m2_;
      v[i].w = ALPHA * hv.w + gv.w * m3;
    }
    float mu, rs;
    row_stats(v, mu, rs);
#pragma unroll
    for (int i = 0; i < 4; ++i) {
      const float4 a = lg[i * 64 + lane], b = lb[i * 64 + lane];
      v[i].x = (v[i].x - mu) * rs * a.x + b.x;
      v[i].y = (v[i].y - mu) * rs * a.y + b.y;
      v[i].z = (v[i].z - mu) * rs * a.z + b.z;
      v[i].w = (v[i].w - mu) * rs * a.w + b.w;
      hout[i * 64 + lane] = v[i];
    }
    if (sub == 1 && l == 1) continue;
    const float* md2 = (sub == 0) ? md + 3 * D : modrow(p, 1, row);
    row_stats(v, mu, rs);
    float lo[NEXP];
#pragma unroll
    for (int e = 0; e < NEXP; ++e) lo[e] = 0.f;
#pragma unroll
    for (int i = 0; i < 4; ++i) {
      const float4 sh = reinterpret_cast<const float4*>(md2)[i * 64 + lane];
      const float4 sc = reinterpret_cast<const float4*>(md2 + D)[i * 64 + lane];
      float uv[4];
      uv[0] = (v[i].x - mu) * rs * (1.f + sc.x) + sh.x;
      uv[1] = (v[i].y - mu) * rs * (1.f + sc.y) + sh.y;
      uv[2] = (v[i].z - mu) * rs * (1.f + sc.z) + sh.z;
      uv[3] = (v[i].w - mu) * rs * (1.f + sc.w) + sh.w;
      reinterpret_cast<uint2*>(p.u + row * D)[i * 64 + lane] = make_uint2(pack2(uv[0], uv[1]), pack2(uv[2], uv[3]));
      if (sub == 0) {
#pragma unroll
        for (int c = 0; c < 4; ++c) {
          const float4* wr = reinterpret_cast<const float4*>(p.w_router + (long)((i * 64 + lane) * 4 + c) * NEXP);
#pragma unroll
          for (int q = 0; q < 4; ++q) {
            const float4 w4 = wr[q];
            lo[q * 4 + 0] += uv[c] * w4.x; lo[q * 4 + 1] += uv[c] * w4.y;
            lo[q * 4 + 2] += uv[c] * w4.z; lo[q * 4 + 3] += uv[c] * w4.w;
          }
        }
      }
    }
    if (sub != 0) continue;
#pragma unroll
    for (int e = 0; e < NEXP; ++e) lo[e] = wave_sum(lo[e]);
    if (lane == 0) {
      float mx = lo[0];
#pragma unroll
      for (int e = 1; e < NEXP; ++e) mx = fmaxf(mx, lo[e]);
      float sum = 0.f;
#pragma unroll
      for (int e = 0; e < NEXP; ++e) { lo[e] = expf(lo[e] - mx); sum += lo[e]; }
      const float inv = 1.0f / sum;
      float bestg = -1e30f, gp1 = 0.f, gp2 = 0.f;
      int ge1 = 0, ge2 = 0;
#pragma unroll
      for (int gq = 0; gq < 4; ++gq) {
        float s1 = -1e30f, s2 = -1e30f, p1 = 0.f, p2 = 0.f;
        int e1 = 0, e2 = 0;
#pragma unroll
        for (int j = 0; j < 4; ++j) {
          const int e = gq * 4 + j;
          const float pe = lo[e] * inv;
          const float se = pe + p.b_router[e];
          if (se > s1) { s2 = s1; p2 = p1; e2 = e1; s1 = se; p1 = pe; e1 = e; }
          else if (se > s2) { s2 = se; p2 = pe; e2 = e; }
        }
        const float gs = s1 + s2;
        if (gs > bestg) { bestg = gs; ge1 = e1; ge2 = e2; gp1 = p1; gp2 = p2; }
      }
      const float wsum = gp1 + gp2;
      p.ew[row * 2 + 0] = gp1 / wsum; p.ew[row * 2 + 1] = gp2 / wsum;
      const int pos1 = atomicAdd(p.cnt + l * NEXP + ge1, 1);
      p.list[(long)(l * NEXP + ge1) * NR + pos1] = (int)(row * 2);
      const int pos2 = atomicAdd(p.cnt + l * NEXP + ge2, 1);
      p.list[(long)(l * NEXP + ge2) * NR + pos2] = (int)(row * 2 + 1);
    }
  }
}

#define LOOP(n) for (long i = gtid; i < (long)(n); i += gstride)

#ifdef ONLY_PHASE
#define PH(n, ...) if (ONLY_PHASE == n) { __VA_ARGS__ }
#define GSYNC()
#else
#define PH(n, ...) { __VA_ARGS__ }
#define GSYNC() xcd_barrier(xb)
#endif

__global__ void __launch_bounds__(256, 2) mega_kernel(Params p) {
  cg::grid_group grid = cg::this_grid();
  __shared__ __attribute__((aligned(16))) unsigned char smem[SMEM_BYTES + 16];
  if (threadIdx.x == 0) *reinterpret_cast<uint4*>(smem + SMEM_BYTES) = make_uint4(0u, 0u, 0u, 0u);
  __syncthreads();
  XcdBarrier xb = xcd_barrier_post(p.bar, (volatile LAS unsigned*)(smem + SMEM_BYTES));
  const long gtid = (long)blockIdx.x * blockDim.x + threadIdx.x;
  const long gstride = (long)gridDim.x * blockDim.x;
  const int nsb = min(256, (int)gridDim.x / 2);
  PH(0,
    if (gtid < 2 * NEXP) p.cnt[gtid] = 0;
    phase_convert_dense(p, smem);
    phase_fold_z(p, gtid, gstride, (float*)(smem + 65536));
    phase_convert_experts(p, 0, smem);
    LOOP(T > 1024 ? T : 1024) ph_tables(p, i);)
#ifndef ONLY_PHASE
  grid.sync();
#endif
  PH(1, phase_lnmod_first(p);)
  GSYNC();
  PH(2, phase_gemm(p, GemmJob{p.u, p.Wt_in_even, p.P, 0, 0, 0, 1, NR / 128, IN_EVEN / 128, D, PW, IN_EVEN, 2, 1.0f}, smem);)
  GSYNC();
  PH(3,
    if ((int)blockIdx.x < nsb) phase_scan<0>(p, smem, blockIdx.x, nsb);
    else phase_attn(p, smem, blockIdx.x - nsb, gridDim.x - nsb);)
  GSYNC();
  PH(4, phase_combine<0>(p);)
  GSYNC();
  PH(5, phase_gemm(p, GemmJob{p.u, p.Wt_out_even, p.M, 0, 0, 0, 1, NR / 128, D / 128, D, D, D, 0, 1.0f}, smem);)
  GSYNC();
  PH(6, phase_resid_ln(p, 0, 0, 0, NR);)
  GSYNC();
  PH(7, phase_moe(p, 0, false, smem);)
  GSYNC();
  PH(8, phase_moe(p, 0, true, smem);)
  GSYNC();
  PH(9, phase_resid_ln(p, 0, 1, 0, NR); phase_cmat(p, gtid, gstride);)
  GSYNC();
  PH(10, phase_gemm(p, GemmJob{p.u, p.Wt_in_odd, p.P, 0, 0, 0, 1, NR / 128, IN_ODD_PAD / 128, D, PW, O_FA, 1, 1.0f}, smem);)
  GSYNC();
  PH(11, LOOP((long)2 * NR * 384) ph_gla_decay(p, i);)
  GSYNC();
  PH(12,
    if ((int)blockIdx.x < nsb) phase_scan<1>(p, smem, blockIdx.x, nsb);
    else phase_gemm(p, GemmJob{p.Cmat, p.FT, p.u + (long)NC * D + 768, 0, (long)256 * 2 * T, (long)T * D, NB, T / 128, 2, 2 * T, D,
                               256, 0, 0.00276213586400995f}, smem, blockIdx.x - nsb, gridDim.x - nsb);)
  GSYNC();
  PH(13, phase_combine<1>(p);)
  GSYNC();
  PH(14,
    phase_convert_experts(p, 1, smem);
    phase_gemm(p, GemmJob{p.u + (long)NC * D, p.Wt_out_odd, p.M + (long)NC * D, 0, 0, 0, 1, NT / 128, D / 128, D, D, D, 0, 1.0f}, smem);)
  GSYNC();
  PH(15, phase_resid_ln(p, 1, 0, NC, NR);)
  GSYNC();
  PH(16, phase_moe(p, 1, false, smem);)
  GSYNC();
  PH(17, phase_moe(p, 1, true, smem);)
  GSYNC();
  PH(18, phase_resid_ln(p, 1, 1, NC, NR);)
}

static size_t carve(Params& p, char* ws) {
  size_t off = 0;
  auto take = [&](size_t bytes) { char* r = ws + off; off += (bytes + 255) & ~(size_t)255; return r; };
  p.mod = (float*)take(sizeof(float) * 2 * (NB + 1) * 6 * D);
  p.hc = (float*)take(sizeof(float) * (size_t)NC * D);
  p.costab = (float*)take(sizeof(float) * T);
  p.sintab = (float*)take(sizeof(float) * T);
  p.lbt = (float*)take(sizeof(float) * 1024);
  p.ropetab = (float*)take(sizeof(float) * 64 * 16 * 2);
  p.ew = (float*)take(sizeof(float) * (size_t)NR * 2);
  p.eidx = (int*)take(sizeof(int) * (size_t)NR * 2);
  p.u = (act_t*)take(sizeof(act_t) * (size_t)NR * D);
  p.P = (act_t*)take(sizeof(act_t) * (size_t)NR * PW);
  p.OF = (act_t*)take(sizeof(act_t) * (size_t)NR * 768);
  p.OB = (act_t*)take(sizeof(act_t) * (size_t)NR * 768);
  p.M = p.OF;
  p.Cmat = (act_t*)take(sizeof(act_t) * (size_t)T * 2 * T);
  p.FT = (act_t*)take(sizeof(act_t) * (size_t)NB * 256 * 2 * T);
  p.LF = (act_t*)take(sizeof(act_t) * (size_t)2 * NR * 384);
  p.Wt_up = p.Cmat;
  p.Wt_down = p.Wt_up + (size_t)NEXP * 1024 * D;
  p.Y = p.P;
  p.H = p.P + (size_t)2 * NR * D;
  p.bar = (unsigned*)take(sizeof(unsigned) * XCD_BAR_WORDS);
  p.cnt = (int*)take(sizeof(int) * 2 * NEXP);
  p.list = (int*)take(sizeof(int) * (size_t)2 * NEXP * NR);
  p.Wt_in_even = (act_t*)take(sizeof(act_t) * (size_t)IN_EVEN * D);
  p.Wt_out_even = (act_t*)take(sizeof(act_t) * (size_t)D * D);
  p.Wt_in_odd = (act_t*)take(sizeof(act_t) * (size_t)IN_ODD_PAD * D);
  p.Wt_out_odd = (act_t*)take(sizeof(act_t) * (size_t)D * D);
  return off;
}

static void fill_inputs(Params& p, void* const* d_in) {
  const float** f = (const float**)&p;
  for (int i = 0; i < 23; ++i) f[i] = (const float*)d_in[i];
}

extern "C" void kernel_launch(void* const* d_in, const int* in_sizes, int n_in, void* d_out, int out_size,
                              void* d_ws, size_t ws_size, hipStream_t stream) {
  static int grid_blocks = 0;
  if (!grid_blocks) {
    int dev = 0, cus = 0, per_cu = 0;
    (void)hipGetDevice(&dev);
    (void)hipDeviceGetAttribute(&cus, hipDeviceAttributeMultiprocessorCount, dev);
    (void)hipOccupancyMaxActiveBlocksPerMultiprocessor(&per_cu, mega_kernel, 256, 0);
    grid_blocks = cus * per_cu;
  }
  Params p{};
  fill_inputs(p, d_in);
  p.out = (float*)d_out;
  size_t need = carve(p, (char*)d_ws);
  if (need > ws_size) { fprintf(stderr, "workspace too small: need %zu have %zu\n", need, ws_size); return; }
  (void)hipMemsetAsync(p.bar, 0, sizeof(unsigned) * XCD_BAR_WORDS, stream);
  void* args[] = {&p};
  hipError_t e = hipLaunchCooperativeKernel((void*)mega_kernel, dim3(grid_blocks), dim3(256), args, 0, stream);
  if (e != hipSuccess) fprintf(stderr, "cooperative launch failed: %s (grid %d)\n", hipGetErrorString(e), grid_blocks);
}
#endif
```

```cpp
#ifndef HOST_TEST
#include <hip/hip_runtime.h>
#include <hip/hip_cooperative_groups.h>
#include <cstdio>
namespace cg = cooperative_groups;
#define DEV __device__ __forceinline__
#else
#include <cmath>
#include <cstdio>
#include <cstdlib>
#include <cstring>
#define DEV static inline
#endif

#ifndef T_BATCH
#define T_BATCH 8
#endif
#ifndef T_SEQ
#define T_SEQ 2048
#endif
#ifndef T_CTX
#define T_CTX 256
#endif

constexpr int D = 1024, NB = T_BATCH, T = T_SEQ, C = T_CTX;
constexpr int NC = NB * C, NT = NB * T, NR = NC + NT;
constexpr int GRID_W = 64;
constexpr int IN_EVEN = 3328, IN_ODD = 2592, PW = 3328;
constexpr int NEXP = 16, DFF = 512;
constexpr float ALPHA = 1.4142135623730951f;
constexpr float LN_EPS = 1e-5f;
constexpr int E_AQ = 0, E_AK = 512, E_AV = 640, E_FF = 768, E_HQ = 1792, E_HI = 2304, E_HG = 2816;
constexpr int O_Q = 0, O_K = 384, O_V = 768, O_RF = 1536, O_G = 1568, O_Z = 2336;

#ifdef HOST_TEST
typedef float act_t;
DEV float ldA(const act_t* p) { return *p; }
DEV void stA(act_t* p, float v) { *p = v; }
#else
typedef unsigned short act_t;
DEV float ldA(const act_t* p) { return __uint_as_float(((unsigned)*p) << 16); }
DEV void stA(act_t* p, float v) {
  unsigned u = __float_as_uint(v);
  u += 0x7fffu + ((u >> 16) & 1u);
  *p = (unsigned short)(u >> 16);
}
#endif

struct Params {
  const float *x, *c, *ctx, *c_ctx, *w_ada, *b_ada, *ln_g, *ln_b, *w_in_even, *attn_sink, *lb_logits, *hgrn_norm,
      *w_out_even, *w_in_odd, *gla_gate_w, *gla_gate_b, *gla_norm, *w_out_odd, *w_router, *b_router, *w_eg, *w_eu,
      *w_ed;
  float* out;
  float *mod, *hc, *costab, *sintab, *lbt, *ew, *ropetab;
  int* eidx;
  act_t *u, *P, *OF, *OB, *M, *LF;
  act_t *Wt_in_even, *Wt_out_even, *Wt_in_odd, *Wt_out_odd;
  act_t *Wt_up, *Wt_down, *Wt_up1, *Wt_down1, *H, *Y, *Cmat, *FT;
  int *cnt, *list;
  unsigned* bar;
};

DEV float sigmoidf_(float v) { return 1.0f / (1.0f + expf(-v)); }
DEV float siluf_(float v) { return v / (1.0f + expf(-v)); }

DEV const float* hrow_in(const Params& p, long row) {
  return row < NC ? p.ctx + row * D : p.x + (row - NC) * D;
}
DEV float* hrow(const Params& p, long row) { return row < NC ? p.hc + row * D : p.out + (row - NC) * D; }
DEV const float* modrow(const Params& p, int l, long row) {
  int bb = row < NC ? NB : (int)((row - NC) / T);
  return p.mod + ((long)l * (NB + 1) + bb) * 6 * D;
}

DEV void ph_mod(const Params& p, long i) {
  int j = (int)(i % (6 * D));
  int bb = (int)((i / (6 * D)) % (NB + 1));
  int l = (int)(i / ((long)6 * D * (NB + 1)));
  const float* cv = bb < NB ? p.c + (long)bb * D : p.c_ctx;
  const float* w = p.w_ada + (long)l * D * 6 * D + j;
  float s = p.b_ada[l * 6 * D + j];
  for (int k = 0; k < D; ++k) s += siluf_(cv[k]) * w[(long)k * 6 * D];
  p.mod[i] = s;
}

DEV void ph_tables(const Params& p, long i) {
  if (i < T) {
    double a = 6.283185307179586476925 * (double)i / (double)T;
    p.costab[i] = (float)cos(a);
    p.sintab[i] = (float)sin(a);
  }
  if (i < 1024) {
    int pos = (int)(i >> 4), idx = (int)(i & 15);
    float ang = (float)pos * powf(10000.0f, -(float)idx / 16.0f);
    p.ropetab[2 * i] = cosf(ang);
    p.ropetab[2 * i + 1] = sinf(ang);
  }
  if (i < 1024) {
    int dir = (int)(i / 512), col = (int)(i % 512);
    float l0 = p.lb_logits[(dir * 2 + 0) * 512 + col], l1 = p.lb_logits[(dir * 2 + 1) * 512 + col];
    p.lbt[i] = 1.0f / (1.0f + expf(l1 - l0));
  }
}

DEV void ln_mod_row(const float* h, const float* shift, const float* scale, act_t* u) {
  float mu = 0.f;
  for (int k = 0; k < D; ++k) mu += h[k];
  mu *= (1.0f / D);
  float var = 0.f;
  for (int k = 0; k < D; ++k) { float d = h[k] - mu; var += d * d; }
  var *= (1.0f / D);
  float rs = 1.0f / sqrtf(var + LN_EPS);
  for (int k = 0; k < D; ++k) stA(u + k, (h[k] - mu) * rs * (1.0f + scale[k]) + shift[k]);
}

DEV void ph_lnmod_first(const Params& p, long row) {
  const float* m = modrow(p, 0, row);
  ln_mod_row(hrow_in(p, row), m, m + D, p.u + row * D);
}

DEV void gemm_item_act(const act_t* A, const float* W, act_t* Cout, int K, int N, int ldc, long i) {
  int n4 = (int)(i % (N / 4));
  long row = i / (N / 4);
  const act_t* a = A + row * K;
  const float* w = W + n4 * 4;
  float s0 = 0, s1 = 0, s2 = 0, s3 = 0;
  for (int k = 0; k < K; ++k) {
    float av = ldA(a + k);
    const float* wr = w + (long)k * N;
    s0 += av * wr[0]; s1 += av * wr[1]; s2 += av * wr[2]; s3 += av * wr[3];
  }
  act_t* o = Cout + row * ldc + n4 * 4;
  stA(o, s0); stA(o + 1, s1); stA(o + 2, s2); stA(o + 3, s3);
}

DEV void ph_rope(const Params& p, long i) {
  int pr = (int)(i % 32);
  int hh = (int)((i / 32) % 10);
  long lr = i / 320;
  int t = (int)(lr % T);
  int col = hh < 8 ? E_AQ + hh * 64 : E_AK + (hh - 8) * 64;
  int idx = pr & 15;
  int pos = pr < 16 ? t / GRID_W : t % GRID_W;
  int d0 = pr < 16 ? idx : 32 + idx;
  float inv = powf(10000.0f, -(float)idx / 16.0f);
  float ang = (float)pos * inv;
  float cs = cosf(ang), sn = sinf(ang);
  act_t* base = p.P + (NC + lr) * PW + col;
  float x1 = ldA(base + d0), x2 = ldA(base + d0 + 16);
  stA(base + d0, x1 * cs - x2 * sn);
  stA(base + d0 + 16, x1 * sn + x2 * cs);
}

DEV void ph_attn(const Params& p, long i) {
  int h = (int)(i % 8);
  long row = i / 8;
  int kv = h / 4;
  bool lat = row >= NC;
  int b = lat ? (int)((row - NC) / T) : (int)(row / C);
  int t = lat ? (int)((row - NC) % T) : 0;
  float q[64], acc[64];
  const act_t* qp = p.P + row * PW + E_AQ + h * 64;
#pragma unroll
  for (int d = 0; d < 64; ++d) { q[d] = ldA(qp + d) * 0.125f; acc[d] = 0.f; }
  float m = p.attn_sink[h], l = 1.0f;
  int nkeys = C + (lat ? 257 : 0);
  for (int j = 0; j < nkeys; ++j) {
    long krow;
    if (j < C) krow = (long)b * C + j;
    else {
      int kp = t - 128 + (j - C);
      if (kp < 0 || kp >= T) continue;
      krow = NC + (long)b * T + kp;
    }
    const act_t* kptr = p.P + krow * PW + E_AK + kv * 64;
    const act_t* vptr = p.P + krow * PW + E_AV + kv * 64;
    float s = 0.f;
#pragma unroll
    for (int d = 0; d < 64; ++d) s += q[d] * ldA(kptr + d);
    float mn = fmaxf(m, s);
    float sc = expf(m - mn), pj = expf(s - mn);
    l = l * sc + pj;
#pragma unroll
    for (int d = 0; d < 64; ++d) acc[d] = acc[d] * sc + pj * ldA(vptr + d);
    m = mn;
  }
  float il = 1.0f / l;
  act_t* o = p.u + row * D + h * 64;
#pragma unroll
  for (int d = 0; d < 64; ++d) stA(o + d, acc[d] * il);
}

template <int MODE>
DEV void ph_scan(const Params& p, long i) {
  constexpr int DK = MODE == 0 ? 128 : 96;
  constexpr int DV = MODE == 0 ? 128 : 192;
  int e = (int)(i % DV);
  int dir = (int)((i / DV) % 2);
  int h = (int)((i / (2 * DV)) % 4);
  int b = (int)(i / (8 * DV));
  float S[DK];
#pragma unroll
  for (int d = 0; d < DK; ++d) S[d] = 0.f;
  act_t* OD = dir == 0 ? p.OF : p.OB;
  for (int step = 0; step < C + T; ++step) {
    long row;
    if (step < C) row = (long)b * C + (dir == 0 ? step : C - 1 - step);
    else { int tt = step - C; row = NC + (long)b * T + (dir == 0 ? tt : T - 1 - tt); }
    const act_t* pr = p.P + row * PW;
    float o = 0.f;
    if (MODE == 0) {
      float v = ldA(pr + E_HI + h * 128 + e);
      const act_t* zp = pr + E_FF + dir * 512 + h * 128;
      const act_t* qp = pr + E_HQ + h * 128;
      const float* lb = p.lbt + dir * 512 + h * 128;
#pragma unroll
      for (int d = 0; d < DK; ++d) {
        float f = lb[d] + (1.0f - lb[d]) * sigmoidf_(ldA(zp + d));
        S[d] = f * S[d] + (1.0f - f) * v;
        o += ldA(qp + d) * S[d];
      }
      stA(OD + row * 768 + h * 128 + e, o);
    } else {
      float v = ldA(pr + O_V + h * 192 + e);
      const act_t* kp = pr + O_K + h * 96;
      const act_t* qp = pr + O_Q + h * 96;
      const act_t* lf = p.LF + ((long)dir * NR + row) * 384 + h * 96;
#pragma unroll
      for (int d = 0; d < DK; ++d) {
        float f = expf(ldA(lf + d));
        S[d] = f * S[d] + ldA(kp + d) * v;
        o += ldA(qp + d) * S[d];
      }
      stA(OD + row * 768 + h * 192 + e, o * 0.10206207261596575f);
    }
  }
}

template <int MODE>
DEV void ph_combine(const Params& p, long i) {
  constexpr int DV = MODE == 0 ? 128 : 192;
  int h = (int)(i % 4);
  long row = (MODE == 0) ? i / 4 : NC + i / 4;
  const act_t* f = p.OF + row * 768 + h * DV;
  const act_t* bk = p.OB + row * 768 + h * DV;
  float ss = 0.f;
  for (int e = 0; e < DV; ++e) { float o = ldA(f + e) + ldA(bk + e); ss += o * o; }
  float r = 1.0f / sqrtf(ss / DV + LN_EPS);
  const float* gn = (MODE == 0 ? p.hgrn_norm : p.gla_norm) + h * DV;
  const act_t* g = p.P + row * PW + (MODE == 0 ? E_HG : O_G) + h * DV;
  act_t* o = p.u + row * D + (MODE == 0 ? 512 : 0) + h * DV;
  for (int e = 0; e < DV; ++e) stA(o + e, (ldA(f + e) + ldA(bk + e)) * r * gn[e] * siluf_(ldA(g + e)));
}

DEV void ph_gla_decay(const Params& p, long i) {
  int col = (int)(i % 384);
  long row = (i / 384) % NR;
  int dir = (int)(i / ((long)384 * NR));
  const act_t* r = p.P + row * PW + O_RF + dir * 16;
  const float* gw = p.gla_gate_w + (long)dir * 16 * 384 + col;
  float z = p.gla_gate_b[dir * 384 + col];
  for (int k = 0; k < 16; ++k) z += ldA(r + k) * gw[k * 384];
  float ls = fminf(z, 0.f) - log1pf(expf(-fabsf(z)));
  stA(p.LF + ((long)dir * NR + row) * 384 + col, ls * (1.0f / 16.0f));
}

DEV void ph_resid_ln(const Params& p, long row, int l, int sub) {
  const float* hin = (l == 0 && sub == 0) ? hrow_in(p, row) : hrow(p, row);
  float* hout = hrow(p, row);
  const float* md = modrow(p, l, row);
  const float* g = md + (sub == 0 ? 2 : 5) * D;
  const act_t* m = p.M + row * D;
  const float* lg = p.ln_g + (l * 2 + sub) * D;
  const float* lb = p.ln_b + (l * 2 + sub) * D;
  float mu = 0.f;
  for (int k = 0; k < D; ++k) mu += ALPHA * hin[k] + g[k] * ldA(m + k);
  mu *= (1.0f / D);
  float var = 0.f;
  for (int k = 0; k < D; ++k) { float d = ALPHA * hin[k] + g[k] * ldA(m + k) - mu; var += d * d; }
  var *= (1.0f / D);
  float rs = 1.0f / sqrtf(var + LN_EPS);
  for (int k = 0; k < D; ++k) hout[k] = (ALPHA * hin[k] + g[k] * ldA(m + k) - mu) * rs * lg[k] + lb[k];
  if (sub == 1 && l == 1) return;
  const float* md2 = (sub == 0) ? md + 3 * D : modrow(p, 1, row);
  float mu2 = 0.f;
  for (int k = 0; k < D; ++k) mu2 += hout[k];
  mu2 *= (1.0f / D);
  float var2 = 0.f;
  for (int k = 0; k < D; ++k) { float d = hout[k] - mu2; var2 += d * d; }
  var2 *= (1.0f / D);
  float rs2 = 1.0f / sqrtf(var2 + LN_EPS);
  float lo[NEXP];
#pragma unroll
  for (int e = 0; e < NEXP; ++e) lo[e] = 0.f;
  for (int k = 0; k < D; ++k) {
    float uv = (hout[k] - mu2) * rs2 * (1.0f + md2[D + k]) + md2[k];
    stA(p.u + row * D + k, uv);
    if (sub == 0) {
      const float* wr = p.w_router + k * NEXP;
#pragma unroll
      for (int e = 0; e < NEXP; ++e) lo[e] += uv * wr[e];
    }
  }
  if (sub != 0) return;
  float mx = lo[0];
#pragma unroll
  for (int e = 1; e < NEXP; ++e) mx = fmaxf(mx, lo[e]);
  float sum = 0.f;
#pragma unroll
  for (int e = 0; e < NEXP; ++e) { lo[e] = expf(lo[e] - mx); sum += lo[e]; }
  float inv = 1.0f / sum;
  float bestg = -1e30f; int bg = 0;
  float gi1 = 0, gi2 = 0; int ge1 = 0, ge2 = 0;
  float gp1 = 0, gp2 = 0;
#pragma unroll
  for (int gq = 0; gq < 4; ++gq) {
    float s1 = -1e30f, s2 = -1e30f, p1 = 0, p2 = 0; int e1 = 0, e2 = 0;
#pragma unroll
    for (int j = 0; j < 4; ++j) {
      int e = gq * 4 + j;
      float pe = lo[e] * inv;
      float se = pe + p.b_router[e];
      if (se > s1) { s2 = s1; p2 = p1; e2 = e1; s1 = se; p1 = pe; e1 = e; }
      else if (se > s2) { s2 = se; p2 = pe; e2 = e; }
    }
    float gs = s1 + s2;
    if (gs > bestg) { bestg = gs; bg = gq; gi1 = s1; gi2 = s2; ge1 = e1; ge2 = e2; gp1 = p1; gp2 = p2; }
  }
  (void)bg; (void)gi1; (void)gi2;
  float wsum = gp1 + gp2;
  p.eidx[row * 2 + 0] = ge1; p.eidx[row * 2 + 1] = ge2;
  p.ew[row * 2 + 0] = gp1 / wsum; p.ew[row * 2 + 1] = gp2 / wsum;
}

DEV void ph_moe_up(const Params& p, long i, int l, long row0) {
  int f4 = (int)(i % (DFF / 4));
  int slot = (int)((i / (DFF / 4)) % 2);
  long row = row0 + i / (DFF / 2);
  int e = p.eidx[row * 2 + slot];
  const float* w1 = p.w_eg + ((long)(l * NEXP + e) * D) * DFF + f4 * 4;
  const float* w3 = p.w_eu + ((long)(l * NEXP + e) * D) * DFF + f4 * 4;
  const act_t* a = p.u + row * D;
  float g0 = 0, g1 = 0, g2 = 0, g3 = 0, u0 = 0, u1 = 0, u2 = 0, u3 = 0;
  for (int k = 0; k < D; ++k) {
    float av = ldA(a + k);
    const float* r1 = w1 + (long)k * DFF;
    const float* r3 = w3 + (long)k * DFF;
    g0 += av * r1[0]; g1 += av * r1[1]; g2 += av * r1[2]; g3 += av * r1[3];
    u0 += av * r3[0]; u1 += av * r3[1]; u2 += av * r3[2]; u3 += av * r3[3];
  }
  act_t* hb = p.P + (row * 2 + slot) * DFF + f4 * 4;
  stA(hb, siluf_(g0) * u0); stA(hb + 1, siluf_(g1) * u1); stA(hb + 2, siluf_(g2) * u2); stA(hb + 3, siluf_(g3) * u3);
}

DEV void ph_moe_down(const Params& p, long i, int l, long row0) {
  int j4 = (int)(i % (D / 4));
  long row = row0 + i / (D / 4);
  float y0 = 0, y1 = 0, y2 = 0, y3 = 0;
  for (int slot = 0; slot < 2; ++slot) {
    int e = p.eidx[row * 2 + slot];
    float wgt = p.ew[row * 2 + slot];
    const float* w2 = p.w_ed + ((long)(l * NEXP + e) * DFF) * D + j4 * 4;
    const act_t* hb = p.P + (row * 2 + slot) * DFF;
    float s0 = 0, s1 = 0, s2 = 0, s3 = 0;
    for (int f = 0; f < DFF; ++f) {
      float hv = ldA(hb + f);
      const float* r = w2 + (long)f * D;
      s0 += hv * r[0]; s1 += hv * r[1]; s2 += hv * r[2]; s3 += hv * r[3];
    }
    y0 += wgt * s0; y1 += wgt * s1; y2 += wgt * s2; y3 += wgt * s3;
  }
  act_t* o = p.M + row * D + j4 * 4;
  stA(o, y0); stA(o + 1, y1); stA(o + 2, y2); stA(o + 3, y3);
}


#ifndef HOST_TEST
typedef __attribute__((ext_vector_type(8))) short bf16x8;
typedef __attribute__((ext_vector_type(4))) float f32x4;
constexpr int SMEM_BYTES = 71680;
constexpr int IN_ODD_PAD = 2944;
constexpr int O_FA = 2336, O_FB = 2592, O_END = 2848;

typedef float f32x2_t __attribute__((ext_vector_type(2)));
typedef __bf16 bf16x2_t __attribute__((ext_vector_type(2)));
__device__ __forceinline__ unsigned pack2(float a, float b) {
  const f32x2_t v = {a, b};
  return __builtin_bit_cast(unsigned, __builtin_convertvector(v, bf16x2_t));
}
__device__ __forceinline__ unsigned pack2_mfma(float a, float b) { return pack2(a, b); }
typedef __attribute__((ext_vector_type(2))) unsigned u32x2;
__device__ __forceinline__ float xor16_max(float x) {
  const u32x2 r = __builtin_amdgcn_permlane16_swap(__float_as_uint(x), __float_as_uint(x), false, false);
  return fmaxf(__uint_as_float(r.x), __uint_as_float(r.y));
}
__device__ __forceinline__ float xor32_max(float x) {
  const u32x2 r = __builtin_amdgcn_permlane32_swap(__float_as_uint(x), __float_as_uint(x), false, false);
  return fmaxf(__uint_as_float(r.x), __uint_as_float(r.y));
}
__device__ __forceinline__ float xor16_add(float x) {
  const u32x2 r = __builtin_amdgcn_permlane16_swap(__float_as_uint(x), __float_as_uint(x), false, false);
  return __uint_as_float(r.x) + __uint_as_float(r.y);
}
__device__ __forceinline__ float xor32_add(float x) {
  const u32x2 r = __builtin_amdgcn_permlane32_swap(__float_as_uint(x), __float_as_uint(x), false, false);
  return __uint_as_float(r.x) + __uint_as_float(r.y);
}
__device__ __forceinline__ float bf_lo(unsigned u) { return __uint_as_float(u << 16); }
__device__ __forceinline__ float bf_hi(unsigned u) { return __uint_as_float(u & 0xffff0000u); }
template <int CTRL>
__device__ __forceinline__ float dpp_mov(float v) {
  return __int_as_float(__builtin_amdgcn_update_dpp(0, __float_as_int(v), CTRL, 0xf, 0xf, true));
}
__device__ __forceinline__ float row_sum16(float v) {
  v += dpp_mov<0xB1>(v);
  v += dpp_mov<0x4E>(v);
  v += dpp_mov<0x141>(v);
  v += dpp_mov<0x140>(v);
  return v;
}
__device__ __forceinline__ float wave_sum(float v) {
  v = row_sum16(v);
  const float a = __int_as_float(__builtin_amdgcn_readlane(__float_as_int(v), 0));
  const float b = __int_as_float(__builtin_amdgcn_readlane(__float_as_int(v), 16));
  const float c = __int_as_float(__builtin_amdgcn_readlane(__float_as_int(v), 32));
  const float d = __int_as_float(__builtin_amdgcn_readlane(__float_as_int(v), 48));
  return (a + b) + (c + d);
}


#define XB_TMO      128
#define XB_XCNT(j)  (256  + 64 * (j))
#define XB_XSUB(j)  (1280 + 64 * (j))
#define XB_XGEN(j)  (2304 + 64 * (j))
#define XB_TOP      3328
#define XB_TOPGEN   3392
#define XCD_BAR_WORDS 3456
#define XB_SPIN_CAP (1u << 18)
#define LAS __attribute__((address_space(3)))
__device__ __forceinline__ unsigned xb_ld(unsigned* p)              { return __hip_atomic_load(p, __ATOMIC_RELAXED, __HIP_MEMORY_SCOPE_AGENT); }
__device__ __forceinline__ unsigned xb_add(unsigned* p, unsigned v) { return __hip_atomic_fetch_add(p, v, __ATOMIC_RELAXED, __HIP_MEMORY_SCOPE_AGENT); }
__device__ __forceinline__ unsigned xb_xcc_id() { return (unsigned)__builtin_amdgcn_s_getreg((3 << 11) | 20) & 0xFu; }
#define XB_SPIN(cond, bar) do { unsigned _sp = 0; while (cond) { __builtin_amdgcn_s_sleep(1); \
    if ((++_sp & 255u) == 0u) { if (xb_ld(&(bar)[XB_TMO])) break; if (_sp > XB_SPIN_CAP) { atomicAdd(&(bar)[XB_TMO], 1u); break; } } } } while (0)
struct XcdBarrier { unsigned* bar; unsigned x; volatile LAS unsigned* st; };
__device__ __forceinline__ XcdBarrier xcd_barrier_post(unsigned* bar, volatile LAS unsigned* st) {
    XcdBarrier b; b.bar = bar; b.x = xb_xcc_id(); b.st = st;
    if (threadIdx.x == 0) (void)xb_add(&bar[XB_XCNT(b.x)], 1u);
    return b;
}
__device__ __forceinline__ void xcd_barrier_complete(unsigned* bar, unsigned x, unsigned& nloc, unsigned& nx) {
    const unsigned G = gridDim.x * gridDim.y * gridDim.z;
    unsigned sum, cnt, mine, sp = 0u;
    for (;;) {
        sum = 0u; cnt = 0u; mine = 0u;
#pragma unroll
        for (unsigned j = 0; j < 16; ++j) { const unsigned c = xb_ld(&bar[XB_XCNT(j)]); sum += c; cnt += (c > 0u) ? 1u : 0u; mine = (j == x) ? c : mine; }
        if (sum == G) break;
        __builtin_amdgcn_s_sleep(1);
        if ((++sp & 255u) == 0u) { if (xb_ld(&bar[XB_TMO])) break; if (sp > XB_SPIN_CAP) { atomicAdd(&bar[XB_TMO], 1u); break; } }
    }
    nloc = mine > 0u ? mine : 1u; nx = cnt > 0u ? cnt : 1u;
}
__device__ __forceinline__ void xcd_barrier(const XcdBarrier& b) {
    asm volatile("s_waitcnt vmcnt(0)" ::: "memory");
    __syncthreads();
    if (threadIdx.x == 0) {
        unsigned* bar = b.bar;
        __builtin_amdgcn_s_waitcnt(0);
        unsigned nloc = b.st[0], nx = b.st[1];
        if (nloc == 0u) { xcd_barrier_complete(bar, b.x, nloc, nx); b.st[0] = nloc; b.st[1] = nx; }
        const unsigned old = xb_add(&bar[XB_XSUB(b.x)], 1u);
        const unsigned gen = old / nloc;
        if (old + 1u == (gen + 1u) * nloc) {
            __builtin_amdgcn_fence(__ATOMIC_RELEASE, "agent");
            asm volatile("s_waitcnt vmcnt(0)" ::: "memory");
            const unsigned og = xb_add(&bar[XB_TOP], 1u);
            const unsigned tg = og / nx;
            if (og + 1u == (tg + 1u) * nx) xb_add(&bar[XB_TOPGEN], 1u);
            else XB_SPIN(xb_ld(&bar[XB_TOPGEN]) == tg, bar);
            __builtin_amdgcn_fence(__ATOMIC_ACQUIRE, "agent");
            xb_add(&bar[XB_XGEN(b.x)], 1u);
            asm volatile("s_waitcnt vmcnt(0)" ::: "memory");
        } else {
            XB_SPIN(xb_ld(&bar[XB_XGEN(b.x)]) == gen, bar);
            __builtin_amdgcn_fence(__ATOMIC_ACQUIRE, "agent");
            asm volatile("s_waitcnt vmcnt(0)" ::: "memory");
        }
    }
    __syncthreads();
}

#define RAW_BARRIER() do { asm volatile("s_waitcnt lgkmcnt(0)" ::: "memory"); __builtin_amdgcn_s_barrier(); } while (0)
template <class ARow, class Epi>
__device__ __forceinline__ void gemm_tile(ARow arow, const act_t* Bt, int K, unsigned char* smem, Epi epi) {
  const int tid = threadIdx.x, wid = tid >> 6, lane = tid & 63, wr = wid >> 1, wc = wid & 1, fr = lane & 15,
            fq = lane >> 4;
  const int r0 = tid >> 2, pc = tid & 3, hi = (r0 >> 2) & 3;
  const int lc = (0x78 >> (2 * (pc ^ hi))) & 3;
  const act_t* ga0 = arow(r0) + lc * 8;
  const act_t* ga1 = arow(r0 + 64) + lc * 8;
  const act_t* gb0 = Bt + (long)r0 * K + lc * 8;
  const act_t* gb1 = Bt + (long)(r0 + 64) * K + lc * 8;
  const int rdoff = fr * 64 + ((((fr >> 2) & 3) ^ ((0x9C >> (2 * fq)) & 3)) << 4);
  char* S = (char*)smem;
  const int nk = K >> 5;
  f32x4 acc[4][4];
#pragma unroll
  for (int m = 0; m < 4; ++m)
#pragma unroll
    for (int n = 0; n < 4; ++n) acc[m][n] = f32x4{0.f, 0.f, 0.f, 0.f};
  auto issue = [&](int kt) {
    char* st = S + (kt & 3) * 16384 + tid * 16;
    __builtin_amdgcn_global_load_lds((const unsigned*)(ga0 + kt * 32), (unsigned*)(st), 16, 0, 0);
    __builtin_amdgcn_global_load_lds((const unsigned*)(gb0 + kt * 32), (unsigned*)(st + 8192), 16, 0, 0);
    __builtin_amdgcn_global_load_lds((const unsigned*)(ga1 + kt * 32), (unsigned*)(st + 4096), 16, 0, 0);
    __builtin_amdgcn_global_load_lds((const unsigned*)(gb1 + kt * 32), (unsigned*)(st + 8192 + 4096), 16, 0, 0);
  };
  asm volatile("s_waitcnt vmcnt(0)" ::: "memory");
  RAW_BARRIER();
  issue(0);
  issue(1);
  issue(2);
  for (int kt = 0; kt < nk; ++kt) {
    if (kt + 2 < nk) asm volatile("s_waitcnt vmcnt(8)" ::: "memory");
    else if (kt + 1 < nk) asm volatile("s_waitcnt vmcnt(4)" ::: "memory");
    else asm volatile("s_waitcnt vmcnt(0)" ::: "memory");
    RAW_BARRIER();
    if (kt + 3 < nk) issue(kt + 3);
    const char* st = S + (kt & 3) * 16384;
    bf16x8 af[4], bfr[4];
#pragma unroll
    for (int m = 0; m < 4; ++m) {
      af[m] = *reinterpret_cast<const bf16x8*>(st + (wr * 64 + m * 16) * 64 + rdoff);
      bfr[m] = *reinterpret_cast<const bf16x8*>(st + 8192 + (wc * 64 + m * 16) * 64 + rdoff);
    }
#pragma unroll
    for (int m = 0; m < 4; ++m)
#pragma unroll
      for (int n = 0; n < 4; ++n) acc[m][n] = __builtin_amdgcn_mfma_f32_16x16x32_bf16(af[m], bfr[n], acc[m][n], 0, 0, 0);
  }
  epi(acc, wr, wc, fr, fq);
}

__device__ __forceinline__ void phase_attn(const Params& p, unsigned char* smem, int blk, int nblk) {
  const int tid = threadIdx.x, w = tid >> 6, lane = tid & 63, fr = lane & 15, g = lane >> 4;
  act_t* SK = (act_t*)smem;
  act_t* SV = SK + 64 * 72;
  constexpr float SCL = 0.125f * 1.4426950408889634f;
  const int n_lat = NB * 4 * (T / 64), n_ctx = NB * 4 * (C / 64);
  const int skey = tid >> 2, spart = tid & 3;
  for (int unit = blk; unit < n_lat + n_ctx; unit += nblk) {
    const bool lat = unit < n_lat;
    const int uu = lat ? unit : unit - n_lat;
    const int nq = lat ? T / 64 : C / 64;
    const int hp = uu & 1, kv = (uu >> 1) & 1, qb = (uu >> 2) % nq, b = (uu >> 2) / nq;
    const int t0 = qb * 64;
    const int tw = t0 + (w & 1) * 32;
    const long qrow0 = (lat ? (long)NC + (long)b * T : (long)b * C) + tw;
    const int h = kv * 4 + hp * 2 + (w >> 1);
    bf16x8 qf[2][2];
#pragma unroll
    for (int qt = 0; qt < 2; ++qt)
#pragma unroll
      for (int st = 0; st < 2; ++st)
        qf[qt][st] = *reinterpret_cast<const bf16x8*>(p.P + (qrow0 + qt * 16 + fr) * PW + E_AQ + h * 64 + st * 32 + g * 8);
    float mrun[2], lrun[2];
    f32x4 o[2][4];
    const float sinkl = p.attn_sink[h] * 1.4426950408889634f;
#pragma unroll
    for (int qt = 0; qt < 2; ++qt) {
      mrun[qt] = sinkl;
      lrun[qt] = (g == 0) ? 1.0f : 0.0f;
#pragma unroll
      for (int dt = 0; dt < 4; ++dt) o[qt][dt] = f32x4{0.f, 0.f, 0.f, 0.f};
    }
    int cc_lo = 0, cc_hi = -1;
    if (lat) {
      cc_lo = t0 >= 128 ? 0 : (128 - t0) / 64;
      cc_hi = min(4, (T - 1 - (t0 - 128)) / 64);
    }
    const int nch = 4 + (cc_hi - cc_lo + 1);
    auto chunk_row = [&](int i, int key, int& tkb) -> long {
      if (i < 4) { tkb = 0; return (long)b * C + i * 64 + key; }
      tkb = t0 - 128 + (cc_lo + i - 4) * 64;
      return (long)NC + (long)b * T + tkb + key;
    };
    uint4 rk0, rk1, rv0, rv1;
    {
      int tkb; const long kr = chunk_row(0, skey, tkb);
      const act_t* kp = p.P + kr * PW + E_AK + kv * 64 + spart * 16;
      const act_t* vp = p.P + kr * PW + E_AV + kv * 64 + spart * 16;
      rk0 = *reinterpret_cast<const uint4*>(kp); rk1 = *reinterpret_cast<const uint4*>(kp + 8);
      rv0 = *reinterpret_cast<const uint4*>(vp); rv1 = *reinterpret_cast<const uint4*>(vp + 8);
    }
    for (int i = 0; i < nch; ++i) {
      __syncthreads();
      {
        uint4* kd = reinterpret_cast<uint4*>(SK + skey * 72 + spart * 16);
        kd[0] = rk0; kd[1] = rk1;
        const unsigned vw[8] = {rv0.x, rv0.y, rv0.z, rv0.w, rv1.x, rv1.y, rv1.z, rv1.w};
#pragma unroll
        for (int e = 0; e < 8; ++e) {
          SV[(spart * 16 + 2 * e) * 72 + skey] = (act_t)(vw[e] & 0xffffu);
          SV[(spart * 16 + 2 * e + 1) * 72 + skey] = (act_t)(vw[e] >> 16);
        }
      }
      __syncthreads();
      int tkb_cur; (void)chunk_row(i, 0, tkb_cur);
      if (i + 1 < nch) {
        int tkb; const long kr = chunk_row(i + 1, skey, tkb);
        const act_t* kp = p.P + kr * PW + E_AK + kv * 64 + spart * 16;
        const act_t* vp = p.P + kr * PW + E_AV + kv * 64 + spart * 16;
        rk0 = *reinterpret_cast<const uint4*>(kp); rk1 = *reinterpret_cast<const uint4*>(kp + 8);
        rv0 = *reinterpret_cast<const uint4*>(vp); rv1 = *reinterpret_cast<const uint4*>(vp + 8);
      }
      const bool edge = i >= 4 && (tkb_cur == t0 - 128 || tkb_cur == t0 + 128);
#pragma unroll
      for (int kb = 0; kb < 2; ++kb) {
        f32x4 sc[2][2];
#pragma unroll
        for (int k2 = 0; k2 < 2; ++k2) {
          const int kt = kb * 2 + k2;
          const bf16x8 kf0 = *reinterpret_cast<const bf16x8*>(SK + (kt * 16 + fr) * 72 + g * 8);
          const bf16x8 kf1 = *reinterpret_cast<const bf16x8*>(SK + (kt * 16 + fr) * 72 + 32 + g * 8);
#pragma unroll
          for (int qt = 0; qt < 2; ++qt) {
            f32x4 z = f32x4{0.f, 0.f, 0.f, 0.f};
            z = __builtin_amdgcn_mfma_f32_16x16x32_bf16(kf0, qf[qt][0], z, 0, 0, 0);
            sc[qt][k2] = __builtin_amdgcn_mfma_f32_16x16x32_bf16(kf1, qf[qt][1], z, 0, 0, 0);
          }
        }
        bf16x8 pf[2];
#pragma unroll
        for (int qt = 0; qt < 2; ++qt) {
          float mx = -1e30f;
#pragma unroll
          for (int k2 = 0; k2 < 2; ++k2)
#pragma unroll
            for (int j = 0; j < 4; ++j) {
              float v = sc[qt][k2][j] * SCL;
              if (edge) {
                const int tk = tkb_cur + (kb * 2 + k2) * 16 + 4 * g + j;
                const int tq = tw + qt * 16 + fr;
                const int df = tq - tk;
                if (df > 128 || df < -128) v = -1e30f;
              }
              sc[qt][k2][j] = v;
              mx = fmaxf(mx, v);
            }
          mx = xor16_max(mx);
          mx = xor32_max(mx);
          const float mnew = fmaxf(mrun[qt], mx);
          if (__any(mnew > mrun[qt])) {
            const float alpha = __builtin_amdgcn_exp2f(mrun[qt] - mnew);
            lrun[qt] *= alpha;
#pragma unroll
            for (int dt = 0; dt < 4; ++dt) o[qt][dt] = o[qt][dt] * alpha;
            mrun[qt] = mnew;
          }
          float ls = 0.f;
          float pv[8];
#pragma unroll
          for (int k2 = 0; k2 < 2; ++k2)
#pragma unroll
            for (int j = 0; j < 4; ++j) {
              const float pe = __builtin_amdgcn_exp2f(sc[qt][k2][j] - mnew);
              pv[k2 * 4 + j] = pe;
              ls += pe;
            }
          lrun[qt] += ls;
          union { unsigned u[4]; bf16x8 v; } cv;
          cv.u[0] = pack2_mfma(pv[0], pv[1]); cv.u[1] = pack2_mfma(pv[2], pv[3]);
          cv.u[2] = pack2_mfma(pv[4], pv[5]); cv.u[3] = pack2_mfma(pv[6], pv[7]);
          pf[qt] = cv.v;
        }
#pragma unroll
        for (int dt = 0; dt < 4; ++dt) {
          union { uint2 h2[2]; bf16x8 v; } vf;
          vf.h2[0] = *reinterpret_cast<const uint2*>(SV + (dt * 16 + fr) * 72 + kb * 32 + 4 * g);
          vf.h2[1] = *reinterpret_cast<const uint2*>(SV + (dt * 16 + fr) * 72 + kb * 32 + 16 + 4 * g);
#pragma unroll
          for (int qt = 0; qt < 2; ++qt) o[qt][dt] = __builtin_amdgcn_mfma_f32_16x16x32_bf16(vf.v, pf[qt], o[qt][dt], 0, 0, 0);
        }
      }
    }
#pragma unroll
    for (int qt = 0; qt < 2; ++qt) {
      float lt = lrun[qt];
      lt = xor16_add(lt);
      lt = xor32_add(lt);
      const float il = 1.0f / lt;
      act_t* orow = p.u + (qrow0 + qt * 16 + fr) * D + h * 64 + 4 * g;
#pragma unroll
      for (int dt = 0; dt < 4; ++dt)
        *reinterpret_cast<uint2*>(orow + dt * 16) =
            make_uint2(pack2(o[qt][dt][0] * il, o[qt][dt][1] * il), pack2(o[qt][dt][2] * il, o[qt][dt][3] * il));
    }
  }
}


template <int MODE>
__device__ __forceinline__ void phase_combine(const Params& p) {
  constexpr int DV = MODE == 0 ? 128 : 192, EPL = DV / 16, NV = EPL / 4;
  const int lane = threadIdx.x & 63;
  const long row_lo = MODE == 0 ? 0 : NC;
  const long w0 = (long)blockIdx.x * 4 + (threadIdx.x >> 6), wstride = (long)gridDim.x * 4;
  const float* gn = (MODE == 0 ? p.hgrn_norm : p.gla_norm) + lane * EPL;
  for (long row = row_lo + w0; row < NR; row += wstride) {
    const uint2* f = reinterpret_cast<const uint2*>(p.OF + row * 768 + lane * EPL);
    const uint2* bk = reinterpret_cast<const uint2*>(p.OB + row * 768 + lane * EPL);
    const uint2* gt = reinterpret_cast<const uint2*>(p.P + row * PW + (MODE == 0 ? E_HG : O_G) + lane * EPL);
    float o[EPL];
    float ss = 0.f;
#pragma unroll
    for (int v = 0; v < NV; ++v) {
      const uint2 a = f[v], c = bk[v];
      o[4 * v + 0] = bf_lo(a.x) + bf_lo(c.x); o[4 * v + 1] = bf_hi(a.x) + bf_hi(c.x);
      o[4 * v + 2] = bf_lo(a.y) + bf_lo(c.y); o[4 * v + 3] = bf_hi(a.y) + bf_hi(c.y);
    }
#pragma unroll
    for (int e = 0; e < EPL; ++e) ss += o[e] * o[e];
    ss = row_sum16(ss);
    const float r = 1.0f / sqrtf(ss * (1.0f / DV) + LN_EPS);
    uint2* dst = reinterpret_cast<uint2*>(p.u + row * D + (MODE == 0 ? 512 : 0) + lane * EPL);
#pragma unroll
    for (int v = 0; v < NV; ++v) {
      const uint2 gv = gt[v];
      const float g0 = bf_lo(gv.x), g1 = bf_hi(gv.x), g2 = bf_lo(gv.y), g3 = bf_hi(gv.y);
      const float y0 = o[4 * v + 0] * r * gn[4 * v + 0] * (g0 / (1.0f + __expf(-g0)));
      const float y1 = o[4 * v + 1] * r * gn[4 * v + 1] * (g1 / (1.0f + __expf(-g1)));
      const float y2 = o[4 * v + 2] * r * gn[4 * v + 2] * (g2 / (1.0f + __expf(-g2)));
      const float y3 = o[4 * v + 3] * r * gn[4 * v + 3] * (g3 / (1.0f + __expf(-g3)));
      dst[v] = make_uint2(pack2(y0, y1), pack2(y2, y3));
    }
  }
}

__device__ __forceinline__ void mod_item(const Params& p, int item, unsigned char* smem) {
  float* sc = (float*)smem;
  const int tid = threadIdx.x;
  for (int i = tid; i < 9 * D; i += 256) {
    const int bb = i >> 10, k = i & 1023;
    const float v = bb < NB ? p.c[bb * D + k] : p.c_ctx[k];
    sc[i] = v / (1.0f + __expf(-v));
  }
  __syncthreads();
  const int l = item / 24, j = (item % 24) * 256 + tid;
  const float* w = p.w_ada + (long)l * D * 6 * D + j;
  float a[NB + 1];
#pragma unroll
  for (int bb = 0; bb <= NB; ++bb) a[bb] = p.b_ada[l * 6 * D + j];
  for (int k = 0; k < D; k += 8) {
    float wv[8];
#pragma unroll
    for (int q = 0; q < 8; ++q) wv[q] = w[(long)(k + q) * 6 * D];
#pragma unroll
    for (int q = 0; q < 8; ++q)
#pragma unroll
      for (int bb = 0; bb <= NB; ++bb) a[bb] += sc[bb * D + k + q] * wv[q];
  }
#pragma unroll
  for (int bb = 0; bb <= NB; ++bb) p.mod[((long)l * (NB + 1) + bb) * 6 * D + j] = a[bb];
  __syncthreads();
}

__device__ __forceinline__ void phase_gla_decay(const Params& p) {
  const int t = threadIdx.x;
  if (t >= 192) return;
  const int dir = t / 96, cg = t % 96;
  float gw[16][4], gb[4];
#pragma unroll
  for (int r = 0; r < 16; ++r) {
    const float4 v = *reinterpret_cast<const float4*>(p.gla_gate_w + ((long)dir * 16 + r) * 384 + cg * 4);
    gw[r][0] = v.x; gw[r][1] = v.y; gw[r][2] = v.z; gw[r][3] = v.w;
  }
  {
    const float4 v = *reinterpret_cast<const float4*>(p.gla_gate_b + dir * 384 + cg * 4);
    gb[0] = v.x; gb[1] = v.y; gb[2] = v.z; gb[3] = v.w;
  }
  for (long row0 = (long)blockIdx.x * 4; row0 < NR; row0 += (long)gridDim.x * 4) {
    uint4 ra[4], rb[4];
#pragma unroll
    for (int q = 0; q < 4; ++q) {
      const uint4* rp = reinterpret_cast<const uint4*>(p.P + (row0 + q) * PW + O_RF + dir * 16);
      ra[q] = rp[0]; rb[q] = rp[1];
    }
#pragma unroll
    for (int q = 0; q < 4; ++q) {
      const unsigned rw[8] = {ra[q].x, ra[q].y, ra[q].z, ra[q].w, rb[q].x, rb[q].y, rb[q].z, rb[q].w};
      float z[4] = {gb[0], gb[1], gb[2], gb[3]};
#pragma unroll
      for (int r2 = 0; r2 < 8; ++r2) {
        const float x0 = bf_lo(rw[r2]), x1 = bf_hi(rw[r2]);
#pragma unroll
        for (int c = 0; c < 4; ++c) z[c] += x0 * gw[2 * r2][c] + x1 * gw[2 * r2 + 1][c];
      }
      float o[4];
#pragma unroll
      for (int c = 0; c < 4; ++c) o[c] = (fminf(z[c], 0.f) - __logf(1.0f + __expf(-fabsf(z[c])))) * (1.0f / 16.0f);
      *reinterpret_cast<uint2*>(p.LF + ((long)dir * NR + row0 + q) * 384 + cg * 4) = make_uint2(pack2(o[0], o[1]), pack2(o[2], o[3]));
    }
  }
}

__device__ __forceinline__ void phase_hgrn_gate(const Params& p, long gtid, long gstride) {
  for (long i = gtid; i < (long)NR * 1024; i += gstride) {
    const int col = (int)(i & 1023);
    const long row = i >> 10;
    act_t* z = p.P + row * PW + E_FF + col;
    const float lb = p.lbt[col];
    const float f = lb + (1.0f - lb) * sigmoidf_(ldA(z));
    stA(z, __logf(f));
  }
}

template <int MODE>
__device__ __forceinline__ void phase_scan(const Params& p, unsigned char* smem, int blk, int nblk) {
  constexpr int DK = MODE == 0 ? 128 : 96, DV = MODE == 0 ? 128 : 192, DVS = DV / 4, NET = DVS / 16, NKS = DK / 32,
                NDT = DK / 16;
  constexpr int QS = DK + 8, LS = 72, SS = DK + 8;
  act_t* Qa = (act_t*)smem;
  act_t* Ka = Qa + 64 * QS;
  act_t* KaT = Ka + 64 * QS;
  act_t* VT = KaT + DK * LS;
  act_t* ST = VT + DVS * LS;
  float* tot = (float*)(ST + DVS * SS);
  float* lf32 = tot + 2 * 4 * DK;
  const int tid = threadIdx.x, w = __builtin_amdgcn_readfirstlane(threadIdx.x >> 6), lane = tid & 63, fr = lane & 15, g = lane >> 4;
  const int dp = lane, c0 = 2 * dp;
  const bool cact = dp < DK / 2;
  constexpr int NCH = (C + T) / 64, NCC = C / 64;
  constexpr int NVI = DVS / 8 * 64;
  for (int item = blk; item < NB * 4 * 2 * 4; item += nblk) {
    const int sl = item & 3, dir = (item >> 2) & 1, h = (item >> 3) & 3, b = item >> 5;
    act_t* OD = dir == 0 ? p.OF : p.OB;
    const unsigned loff = (unsigned)c0 * 2u;
    const int vcol = (MODE == 0 ? E_HI + h * 128 : O_V + h * 192) + sl * DVS;
    const int ocol = h * DV + sl * DVS;
    auto chunk_base = [&](int n) -> long {
      if (n < NCC) return (long)b * C + (dir ? NCC - 1 - n : n) * 64;
      const int ln = n - NCC;
      return (long)NC + (long)b * T + (dir ? T / 64 - 1 - ln : ln) * 64;
    };
    auto lrow = [&](long base, int l) -> long { return base + (dir ? 63 - l : l); };
    f32x4 S[NET][2];
#pragma unroll
    for (int et = 0; et < NET; ++et) { S[et][0] = f32x4{0.f, 0.f, 0.f, 0.f}; S[et][1] = f32x4{0.f, 0.f, 0.f, 0.f}; }
    unsigned rlf[16], rq[16], rk[16];
    uint4 rv[2];
    auto issue_loads = [&](int n) {
      const long base = chunk_base(n);
      if (cact) {
#pragma unroll
        for (int i = 0; i < 16; ++i) {
          const long row = lrow(base, w * 16 + i);
          const char* prow = (const char*)(p.P + row * PW);
          if (MODE == 0) {
            rlf[i] = *reinterpret_cast<const unsigned*>(prow + (E_FF + dir * 512 + h * 128) * 2 + loff);
            rq[i] = *reinterpret_cast<const unsigned*>(prow + (E_HQ + h * 128) * 2 + loff);
          } else {
            rlf[i] = *reinterpret_cast<const unsigned*>((const char*)(p.LF + ((long)dir * NR + row) * 384 + h * 96) + loff);
            rk[i] = *reinterpret_cast<const unsigned*>(prow + (O_K + h * 96) * 2 + loff);
            rq[i] = *reinterpret_cast<const unsigned*>(prow + (O_Q + h * 96) * 2 + loff);
          }
        }
      }
#pragma unroll
      for (int r = 0; r < (NVI + 255) / 256; ++r) {
        const int it = tid + r * 256;
        if (it < NVI) {
          const int l = it / (DVS / 8), e8 = (it % (DVS / 8)) * 8;
          rv[r] = *reinterpret_cast<const uint4*>(p.P + lrow(base, l) * PW + vcol + e8);
        }
      }
    };
    issue_loads(0);
    for (int n = 0; n < NCH; ++n) {
      const int par = n & 1;
      float* totp = tot + par * 4 * DK;
      float* lfp = lf32 + par * DK;
      const long base = chunk_base(n);
      if (cact) {
        float r0 = 0.f, r1 = 0.f;
#pragma unroll
        for (int i = 0; i < 16; ++i) { r0 += bf_lo(rlf[i]); r1 += bf_hi(rlf[i]); }
        totp[w * DK + c0] = r0; totp[w * DK + c0 + 1] = r1;
        if (w == 2) { lfp[c0] = bf_lo(rlf[0]); lfp[c0 + 1] = bf_hi(rlf[0]); }
      }
      __syncthreads();
#pragma unroll
      for (int r = 0; r < (NVI + 255) / 256; ++r) {
        const int it = tid + r * 256;
        if (it < NVI) {
          const int l = it / (DVS / 8), e8 = (it % (DVS / 8)) * 8;
          const unsigned vw[4] = {rv[r].x, rv[r].y, rv[r].z, rv[r].w};
#pragma unroll
          for (int e = 0; e < 4; ++e) {
            VT[(e8 + 2 * e) * LS + l] = (act_t)(vw[e] & 0xffffu);
            VT[(e8 + 2 * e + 1) * LS + l] = (act_t)(vw[e] >> 16);
          }
        }
      }
      if (cact) {
        float of0 = 0.f, of1 = 0.f;
#pragma unroll
        for (int sgi = 0; sgi < 3; ++sgi)
          if (sgi < w) { of0 += totp[sgi * DK + c0]; of1 += totp[sgi * DK + c0 + 1]; }
        const float ref0 = totp[c0] + totp[DK + c0] + lfp[c0];
        const float ref1 = totp[c0 + 1] + totp[DK + c0 + 1] + lfp[c0 + 1];
        unsigned kt0[8], kt1[8];
        float run0 = of0 - ref0, run1 = of1 - ref1;
#pragma unroll
        for (int i = 0; i < 16; i += 2) {
          float ka0[2], ka1[2];
#pragma unroll
          for (int ii = 0; ii < 2; ++ii) {
            const int i2 = i + ii;
            run0 += bf_lo(rlf[i2]); run1 += bf_hi(rlf[i2]);
            const float b0 = run0, b1 = run1;
            const float e0 = __expf(b0), e1 = __expf(b1), f0 = __expf(-b0), f1 = __expf(-b1);
            float k0, k1;
            if (MODE == 0) { k0 = 1.0f - __expf(bf_lo(rlf[i2])); k1 = 1.0f - __expf(bf_hi(rlf[i2])); }
            else { k0 = bf_lo(rk[i2]); k1 = bf_hi(rk[i2]); }
            ka0[ii] = k0 * f0; ka1[ii] = k1 * f1;
            const int l = w * 16 + i2;
            *reinterpret_cast<unsigned*>(Qa + l * QS + c0) = pack2(bf_lo(rq[i2]) * e0, bf_hi(rq[i2]) * e1);
            *reinterpret_cast<unsigned*>(Ka + l * QS + c0) = pack2(ka0[ii], ka1[ii]);
          }
          kt0[i >> 1] = pack2(ka0[0], ka0[1]);
          kt1[i >> 1] = pack2(ka1[0], ka1[1]);
        }
        uint4* d0 = reinterpret_cast<uint4*>(KaT + c0 * LS + w * 16);
        d0[0] = make_uint4(kt0[0], kt0[1], kt0[2], kt0[3]); d0[1] = make_uint4(kt0[4], kt0[5], kt0[6], kt0[7]);
        uint4* d1 = reinterpret_cast<uint4*>(KaT + (c0 + 1) * LS + w * 16);
        d1[0] = make_uint4(kt1[0], kt1[1], kt1[2], kt1[3]); d1[1] = make_uint4(kt1[4], kt1[5], kt1[6], kt1[7]);
      }
      if (n + 1 < NCH) issue_loads(n + 1);
      float egv[2], egrv[2];
#pragma unroll
      for (int di = 0; di < 2; ++di) {
        const int dt = w + 4 * di;
        if (dt < NDT) {
          const int d = dt * 16 + fr;
          const float refd = totp[d] + totp[DK + d] + lfp[d];
          const float gd = totp[d] + totp[DK + d] + totp[2 * DK + d] + totp[3 * DK + d];
          const float er = __expf(refd);
          egv[di] = __expf(gd); egrv[di] = __expf(gd - refd);
#pragma unroll
          for (int et = 0; et < NET; ++et)
#pragma unroll
            for (int j = 0; j < 4; ++j) stA(ST + (et * 16 + 4 * g + j) * SS + d, S[et][di][j] * er);
        }
      }
      __syncthreads();
      bf16x8 qfr[NKS];
#pragma unroll
      for (int ks = 0; ks < NKS; ++ks) qfr[ks] = *reinterpret_cast<const bf16x8*>(Qa + (w * 16 + fr) * QS + ks * 32 + g * 8);
      f32x4 at[4];
#pragma unroll
      for (int mt = 0; mt < 4; ++mt) {
        at[mt] = f32x4{0.f, 0.f, 0.f, 0.f};
        if (mt <= w) {
#pragma unroll
          for (int ks = 0; ks < NKS; ++ks) {
            const bf16x8 kaf = *reinterpret_cast<const bf16x8*>(Ka + (mt * 16 + fr) * QS + ks * 32 + g * 8);
            at[mt] = __builtin_amdgcn_mfma_f32_16x16x32_bf16(kaf, qfr[ks], at[mt], 0, 0, 0);
          }
          if (mt == w) {
#pragma unroll
            for (int j = 0; j < 4; ++j)
              if (4 * g + j > fr) at[mt][j] = 0.f;
          }
        }
      }
      bf16x8 pfr[2];
#pragma unroll
      for (int kb = 0; kb < 2; ++kb) {
        union { unsigned u[4]; bf16x8 v; } cv;
        cv.u[0] = pack2_mfma(at[2 * kb][0], at[2 * kb][1]); cv.u[1] = pack2_mfma(at[2 * kb][2], at[2 * kb][3]);
        cv.u[2] = pack2_mfma(at[2 * kb + 1][0], at[2 * kb + 1][1]); cv.u[3] = pack2_mfma(at[2 * kb + 1][2], at[2 * kb + 1][3]);
        pfr[kb] = cv.v;
      }
      const long orow = lrow(base, w * 16 + fr);
#pragma unroll
      for (int et = 0; et < NET; ++et) {
        f32x4 o = f32x4{0.f, 0.f, 0.f, 0.f};
#pragma unroll
        for (int kb = 0; kb < 2; ++kb) {
          if (2 * kb <= w) {
            union { uint2 h2[2]; bf16x8 v; } vf;
            vf.h2[0] = *reinterpret_cast<const uint2*>(VT + (et * 16 + fr) * LS + kb * 32 + 4 * g);
            vf.h2[1] = *reinterpret_cast<const uint2*>(VT + (et * 16 + fr) * LS + kb * 32 + 16 + 4 * g);
            o = __builtin_amdgcn_mfma_f32_16x16x32_bf16(vf.v, pfr[kb], o, 0, 0, 0);
          }
        }
#pragma unroll
        for (int ks = 0; ks < NKS; ++ks) {
          const bf16x8 sf = *reinterpret_cast<const bf16x8*>(ST + (et * 16 + fr) * SS + ks * 32 + g * 8);
          o = __builtin_amdgcn_mfma_f32_16x16x32_bf16(sf, qfr[ks], o, 0, 0, 0);
        }
        const float osc = MODE == 0 ? 1.0f : 0.10206207261596575f;
        *reinterpret_cast<uint2*>(OD + orow * 768 + ocol + et * 16 + 4 * g) =
            make_uint2(pack2(o[0] * osc, o[1] * osc), pack2(o[2] * osc, o[3] * osc));
      }
#pragma unroll
      for (int di = 0; di < 2; ++di) {
        const int dt = w + 4 * di;
        if (dt < NDT) {
#pragma unroll
          for (int et = 0; et < NET; ++et) {
            f32x4 r = f32x4{0.f, 0.f, 0.f, 0.f};
#pragma unroll
            for (int k2 = 0; k2 < 2; ++k2) {
              const bf16x8 vf = *reinterpret_cast<const bf16x8*>(VT + (et * 16 + fr) * LS + k2 * 32 + g * 8);
              const bf16x8 kf = *reinterpret_cast<const bf16x8*>(KaT + (dt * 16 + fr) * LS + k2 * 32 + g * 8);
              r = __builtin_amdgcn_mfma_f32_16x16x32_bf16(vf, kf, r, 0, 0, 0);
            }
#pragma unroll
            for (int j = 0; j < 4; ++j) S[et][di][j] = egv[di] * S[et][di][j] + egrv[di] * r[j];
          }
        }
      }
    }
    __syncthreads();
  }
}

struct GemmJob {
  const act_t* A; const act_t* Bt; act_t* C;
  long sA, sB, sC;
  int nbatch, Mtiles, Ntiles, K, ldc, Nvalid, mode;
  float scale;
};
__device__ __forceinline__ void phase_gemm(const Params& p, const GemmJob& g, unsigned char* smem, int blk = blockIdx.x, int nblk = gridDim.x) {
  const int per_b = g.Mtiles * g.Ntiles;
  const int ntiles = per_b * g.nbatch;
  for (int tile = blk; tile < ntiles; tile += nblk) {
    const int b = tile / per_b, tt = tile % per_b;
    const int tm = tt / g.Ntiles, tn = tt % g.Ntiles;
    if (g.mode == 1 && tm < NC / 128 && tn * 128 >= O_FA) continue;
    const int K = g.K, ldc = g.ldc;
    const act_t* Ab = g.A + b * g.sA + (long)tm * 128 * K;
    act_t* Cb = g.C + b * g.sC + (long)tm * 128 * ldc + tn * 128;
    const int nlim = g.Nvalid - tn * 128;
    const float scale = g.scale;
    const int mode = g.mode;
    gemm_tile([&](int r) { return Ab + (long)r * K; }, g.Bt + b * g.sB + (long)tn * 128 * K, K, smem,
              [&](f32x4 (&acc)[4][4], int wr, int wc, int fr, int fq) {
                if (mode == 2) {
                  const int cb = tn * 128 + wc * 64;
                  if (cb < E_AV && tm >= NC / 128) {
                    const float2* rt = reinterpret_cast<const float2*>(p.ropetab);
#pragma unroll
                    for (int m = 0; m < 4; ++m)
#pragma unroll
                      for (int j = 0; j < 4; ++j) {
                        const int t = ((tm - NC / 128) * 128 + wr * 64 + m * 16 + fq * 4 + j) % T;
                        const float2 cr = rt[(t / GRID_W) * 16 + fr], cc = rt[(t % GRID_W) * 16 + fr];
                        const float a1 = acc[m][0][j], a2 = acc[m][1][j], b1 = acc[m][2][j], b2 = acc[m][3][j];
                        acc[m][0][j] = a1 * cr.x - a2 * cr.y; acc[m][1][j] = a1 * cr.y + a2 * cr.x;
                        acc[m][2][j] = b1 * cc.x - b2 * cc.y; acc[m][3][j] = b1 * cc.y + b2 * cc.x;
                      }
                  } else if (cb >= E_FF && cb < E_HQ) {
#pragma unroll
                    for (int n = 0; n < 4; ++n) {
                      const float lb = p.lbt[cb - E_FF + n * 16 + fr];
#pragma unroll
                      for (int m = 0; m < 4; ++m)
#pragma unroll
                        for (int j = 0; j < 4; ++j)
                          acc[m][n][j] = __logf(lb + (1.0f - lb) / (1.0f + __expf(-acc[m][n][j])));
                    }
                  }
                }
#pragma unroll
                for (int m = 0; m < 4; ++m)
#pragma unroll
                  for (int n = 0; n < 4; ++n) {
                    const int col = wc * 64 + n * 16 + fr;
                    if (col < nlim) {
#pragma unroll
                      for (int j = 0; j < 4; ++j) {
                        const int row = wr * 64 + m * 16 + fq * 4 + j;
                        stA(Cb + (long)row * ldc + col, acc[m][n][j] * scale);
                      }
                    } else if (mode == 1) {
                      const int gc = tn * 128 + col;
                      if (gc < O_END && tm >= NC / 128) {
                        const int lr = (tm - NC / 128) * 128 + wr * 64 + m * 16 + fq * 4;
                        const int bb = lr / T, t = lr % T;
                        const int cq = gc < O_FB ? gc - O_FA : gc - O_FB;
                        act_t* dst = p.FT + ((long)bb * 256 + cq) * (2 * T) + (gc < O_FB ? 0 : T) + t;
                        *reinterpret_cast<uint2*>(dst) = make_uint2(pack2(acc[m][n][0], acc[m][n][1]), pack2(acc[m][n][2], acc[m][n][3]));
                      }
                    }
                  }
              });
  }
}

template <class RowMap>
__device__ __forceinline__ void conv_tile_rm(const float* src, int lds_, int Nvalid, int k0, int n0, act_t* dst, int ldd, float* tile, RowMap rm) {
  const int tid = threadIdx.x;
  {
    const int r = tid >> 5, c4 = (tid & 31) * 4;
    float4 v[8];
#pragma unroll
    for (int rr = 0; rr < 8; ++rr) {
      v[rr] = make_float4(0.f, 0.f, 0.f, 0.f);
      if (n0 + c4 < Nvalid) v[rr] = *reinterpret_cast<const float4*>(src + (long)(k0 + r + rr * 8) * lds_ + n0 + c4);
    }
#pragma unroll
    for (int rr = 0; rr < 8; ++rr) {
      float* t = tile + (r + rr * 8) * 129 + c4;
      t[0] = v[rr].x; t[1] = v[rr].y; t[2] = v[rr].z; t[3] = v[rr].w;
    }
  }
  __syncthreads();
  {
    const int n = tid >> 1, ks = (tid & 1) * 32;
    if (n0 + n < Nvalid) {
      unsigned w[16];
#pragma unroll
      for (int i = 0; i < 16; ++i) w[i] = pack2(tile[(ks + 2 * i) * 129 + n], tile[(ks + 2 * i + 1) * 129 + n]);
      uint4* d = reinterpret_cast<uint4*>(dst + (long)rm(n) * ldd + k0 + ks);
      d[0] = make_uint4(w[0], w[1], w[2], w[3]);
      d[1] = make_uint4(w[4], w[5], w[6], w[7]);
      d[2] = make_uint4(w[8], w[9], w[10], w[11]);
      d[3] = make_uint4(w[12], w[13], w[14], w[15]);
    }
  }
  __syncthreads();
}

__device__ __forceinline__ void conv_tile(const float* src, int lds_, int Nvalid, int k0, int n0, act_t* dst, int ldd, float* tile) {
  conv_tile_rm(src, lds_, Nvalid, k0, n0, dst, ldd, tile, [=](int n) { return n0 + n; });
}

__device__ __forceinline__ void phase_convert_experts(const Params& p, int l, unsigned char* smem, int blk, int nblk) {
  float* tile = (float*)smem;
  const int per_e = 192;
  act_t* Wup = l == 0 ? p.Wt_up : p.Wt_up1;
  act_t* Wdn = l == 0 ? p.Wt_down : p.Wt_down1;
  for (int job = blk; job < NEXP * per_e; job += nblk) {
    const int e = job / per_e, j = job % per_e;
    if (j < 128) {
      const int up = j >> 6, jj = j & 63;
      const int kt = jj >> 2, fp = jj & 3;
      const float* src = (up ? p.w_eu : p.w_eg) + ((long)(l * NEXP + e) * D) * DFF;
      const int rbase = fp * 256 + up * 32;
      conv_tile_rm(src, DFF, DFF, kt * 64, fp * 128, Wup + (long)e * 1024 * D, D, tile,
                   [=](int n) { return rbase + (n >> 6) * 128 + ((n >> 5) & 1) * 64 + (n & 31); });
    } else {
      const int jj = j - 128;
      const int kt = jj >> 3, nt = jj & 7;
      const float* src = p.w_ed + ((long)(l * NEXP + e) * DFF) * D;
      conv_tile(src, D, D, kt * 64, nt * 128, Wdn + (long)e * 1024 * DFF, DFF, tile);
    }
  }
}

__device__ __forceinline__ void phase_moe(const Params& p, int l, bool down, unsigned char* smem) {
  const int* cntp = p.cnt + l * NEXP * 64;
  int total = 0;
  for (int e = 0; e < NEXP; ++e) total += ((cntp[e * 64] + 127) >> 7) * 8;
  for (int tile = blockIdx.x; tile < total; tile += gridDim.x) {
    int e = 0, tb = 0, rowoff = 0;
    for (; e < NEXP - 1; ++e) {
      const int c = cntp[e * 64];
      const int nt = ((c + 127) >> 7) * 8;
      if (tile < tb + nt) break;
      tb += nt; rowoff += c;
    }
    const int c = cntp[e * 64];
    const int lt = tile - tb, mt = lt >> 3, nt = lt & 7;
    const int rows_valid = min(128, c - mt * 128);
    const int* lst = p.list + (long)(l * NEXP + e) * NR + mt * 128;
    const long hrow0 = (long)rowoff + mt * 128;
    if (!down) {
      gemm_tile([&](int r) { return p.u + (long)(lst[min(r, rows_valid - 1)] >> 1) * D; },
                (l == 0 ? p.Wt_up : p.Wt_up1) + ((long)e * 1024 + nt * 128) * D, D, smem,
                [&](f32x4 (&acc)[4][4], int wr, int wc, int fr, int fq) {
#pragma unroll
                  for (int m = 0; m < 4; ++m)
#pragma unroll
                    for (int j = 0; j < 4; ++j) {
                      const int row = wr * 64 + m * 16 + fq * 4 + j;
                      if (row < rows_valid) {
#pragma unroll
                        for (int n = 0; n < 2; ++n) {
                          const float g = acc[m][n][j], uu = acc[m][n + 2][j];
                          stA(p.H + (hrow0 + row) * DFF + nt * 64 + wc * 32 + n * 16 + fr, g / (1.0f + __expf(-g)) * uu);
                        }
                      }
                    }
                });
    } else {
      const act_t* Ab = p.H + hrow0 * DFF;
      gemm_tile([&](int r) { return Ab + (long)r * DFF; }, (l == 0 ? p.Wt_down : p.Wt_down1) + ((long)e * 1024 + nt * 128) * DFF, DFF, smem,
                [&](f32x4 (&acc)[4][4], int wr, int wc, int fr, int fq) {
#pragma unroll
                  for (int m = 0; m < 4; ++m)
#pragma unroll
                    for (int j = 0; j < 4; ++j) {
                      const int row = wr * 64 + m * 16 + fq * 4 + j;
                      if (row < rows_valid) {
                        const int ts = lst[row];
                        const float w = p.ew[ts];
#pragma unroll
                        for (int n = 0; n < 4; ++n)
                          stA(p.Y + (long)ts * D + nt * 128 + wc * 64 + n * 16 + fr, acc[m][n][j] * w);
                      }
                    }
                });
    }
  }
}

__device__ __forceinline__ void phase_convert_dense(const Params& p, unsigned char* smem) {
  float* tile = (float*)smem;
  const int JM = 48, J0 = JM + 16 * 26, J1 = J0 + 128, J2 = J1 + 16 * 19, J3 = J2 + 128;
  for (int job = blockIdx.x; job < J3; job += gridDim.x) {
    if (job < JM) { mod_item(p, job, smem); continue; }
    if (job < J0) { int j = job - JM; conv_tile(p.w_in_even, IN_EVEN, IN_EVEN, (j / 26) * 64, (j % 26) * 128, p.Wt_in_even, D, tile); }
    else if (job < J1) { int j = job - J0; conv_tile(p.w_out_even, D, D, (j / 8) * 64, (j % 8) * 128, p.Wt_out_even, D, tile); }
    else if (job < J2) { int j = job - J1; conv_tile(p.w_in_odd, IN_ODD, O_FA, (j / 19) * 64, (j % 19) * 128, p.Wt_in_odd, D, tile); }
    else { int j = job - J2; conv_tile(p.w_out_odd, D, D, (j / 8) * 64, (j % 8) * 128, p.Wt_out_odd, D, tile); }
  }
}

__device__ __forceinline__ void phase_fold_z(const Params& p, long gtid, long gstride, float* tab) {
  if (threadIdx.x < 64) {
    float sn, cs;
    sincospif((float)threadIdx.x * (1.0f / 32.0f), &sn, &cs);
    tab[threadIdx.x] = cs; tab[64 + threadIdx.x] = -sn;
  }
  __syncthreads();
  for (long i = gtid; i < (long)512 * D; i += gstride) {
    const int k = (int)(i % D), np = (int)(i / D);
    const int part = np >> 8, col = np & 255, g = col >> 6, cp = col & 63;
    const float* wz = p.w_in_odd + (long)k * IN_ODD + O_Z + g * 64;
    float s = 0.f;
    const float* tb = tab + part * 64;
#pragma unroll 8
    for (int c = 0; c < 64; ++c) s += wz[c] * tb[(c * cp) & 63];
    stA(p.Wt_in_odd + (long)(O_FA + np) * D + k, s);
  }
  for (long i = gtid; i < (long)(IN_ODD_PAD - O_END) * D; i += gstride) p.Wt_in_odd[(long)O_END * D + i] = 0;
}

__device__ __forceinline__ void phase_cmat(const Params& p, long gtid, long gstride) {
  for (long i = gtid; i < (long)T * T; i += gstride) {
    const int t = (int)(i % T), tp = (int)(i / T);
    float sn, cs;
    sincospif((float)((t * tp) & (T - 1)) * (2.0f / T), &sn, &cs);
    stA(p.Cmat + (long)tp * 2 * T + t, cs);
    stA(p.Cmat + (long)tp * 2 * T + T + t, sn);
  }
}

__device__ __forceinline__ void row_stats(const float4 (&v)[4], float& mu, float& rs) {
  float s = 0.f;
#pragma unroll
  for (int i = 0; i < 4; ++i) s += v[i].x + v[i].y + v[i].z + v[i].w;
  mu = wave_sum(s) * (1.0f / D);
  float q = 0.f;
#pragma unroll
  for (int i = 0; i < 4; ++i) {
    float a = v[i].x - mu, b = v[i].y - mu, c = v[i].z - mu, d = v[i].w - mu;
    q += a * a + b * b + c * c + d * d;
  }
  rs = 1.0f / sqrtf(wave_sum(q) * (1.0f / D) + LN_EPS);
}

__device__ __forceinline__ void phase_lnmod_first(const Params& p) {
  const int lane = threadIdx.x & 63;
  const long w0 = (long)blockIdx.x * 4 + (threadIdx.x >> 6), wstride = (long)gridDim.x * 4;
  for (long row = w0; row < NR; row += wstride) {
    const float4* h = reinterpret_cast<const float4*>(hrow_in(p, row));
    const float* md = modrow(p, 0, row);
    float4 v[4];
#pragma unroll
    for (int i = 0; i < 4; ++i) v[i] = h[i * 64 + lane];
    float mu, rs;
    row_stats(v, mu, rs);
#pragma unroll
    for (int i = 0; i < 4; ++i) {
      const float4 sh = reinterpret_cast<const float4*>(md)[i * 64 + lane];
      const float4 sc = reinterpret_cast<const float4*>(md + D)[i * 64 + lane];
      float a = (v[i].x - mu) * rs * (1.f + sc.x) + sh.x, b = (v[i].y - mu) * rs * (1.f + sc.y) + sh.y;
      float c = (v[i].z - mu) * rs * (1.f + sc.z) + sh.z, d = (v[i].w - mu) * rs * (1.f + sc.w) + sh.w;
      reinterpret_cast<uint2*>(p.u + row * D)[i * 64 + lane] = make_uint2(pack2(a, b), pack2(c, d));
    }
  }
}

template <int R>
__device__ __forceinline__ void phase_resid_ln(const Params& p, int l, int sub, long row_lo, long row_hi, unsigned char* smem) {
  const int lane = threadIdx.x & 63;
  int* cntL = (int*)smem;
  int* nent = cntL + 16;
  int* entL = cntL + 32;
  float* wT = (float*)(smem + 4096);
  if (sub == 0) {
    if (threadIdx.x < 32) cntL[threadIdx.x] = 0;
    for (int i = threadIdx.x; i < D * NEXP; i += 256) wT[(i & 15) * D + (i >> 4)] = p.w_router[i];
    __syncthreads();
  }
  const long w0 = (long)blockIdx.x * 4 + (threadIdx.x >> 6), wstride = (long)gridDim.x * 4;
  const bool last = (sub == 1 && l == 1);
  const float4* lgp = reinterpret_cast<const float4*>(p.ln_g + (l * 2 + sub) * D);
  const float4* lbp = reinterpret_cast<const float4*>(p.ln_b + (l * 2 + sub) * D);
  for (long rowA = row_lo + w0; rowA < row_hi; rowA += R * wstride) {
    long rows[R];
    bool val[R];
    rows[0] = rowA; val[0] = true;
    if (R == 2) { val[R - 1] = rowA + wstride < row_hi; rows[R - 1] = val[R - 1] ? rowA + wstride : rowA; }
    float4 v[R][4];
    const float* md[R];
#pragma unroll
    for (int rr = 0; rr < R; ++rr) {
      const long row = rows[rr];
      const float4* hin = reinterpret_cast<const float4*>((l == 0 && sub == 0) ? hrow_in(p, row) : hrow(p, row));
      md[rr] = modrow(p, l, row);
      const float4* g = reinterpret_cast<const float4*>(md[rr] + (sub == 0 ? 2 : 5) * D);
      const uint2* m = reinterpret_cast<const uint2*>(sub == 0 ? p.M + row * D : p.Y + row * 2 * D);
      const uint2* m2 = reinterpret_cast<const uint2*>(p.Y + (row * 2 + 1) * D);
#pragma unroll
      for (int i = 0; i < 4; ++i) {
        const float4 hv = hin[i * 64 + lane];
        const float4 gv = g[i * 64 + lane];
        const uint2 mv = m[i * 64 + lane];
        float m0 = bf_lo(mv.x), m1 = bf_hi(mv.x), m2_ = bf_lo(mv.y), m3 = bf_hi(mv.y);
        if (sub == 1) {
          const uint2 mw = m2[i * 64 + lane];
          m0 += bf_lo(mw.x); m1 += bf_hi(mw.x); m2_ += bf_lo(mw.y); m3 += bf_hi(mw.y);
        }
        v[rr][i].x = ALPHA * hv.x + gv.x * m0;
        v[rr][i].y = ALPHA * hv.y + gv.y * m1;
        v[rr][i].z = ALPHA * hv.z + gv.z * m2_;
        v[rr][i].w = ALPHA * hv.w + gv.w * m3;
      }
    }
    float mu[R], rs[R];
#pragma unroll
    for (int rr = 0; rr < R; ++rr) row_stats(v[rr], mu[rr], rs[rr]);
#pragma unroll
    for (int rr = 0; rr < R; ++rr) {
      float4* hout = reinterpret_cast<float4*>(hrow(p, rows[rr]));
#pragma unroll
      for (int i = 0; i < 4; ++i) {
        const float4 lga = lgp[i * 64 + lane], lba = lbp[i * 64 + lane];
        v[rr][i].x = (v[rr][i].x - mu[rr]) * rs[rr] * lga.x + lba.x;
        v[rr][i].y = (v[rr][i].y - mu[rr]) * rs[rr] * lga.y + lba.y;
        v[rr][i].z = (v[rr][i].z - mu[rr]) * rs[rr] * lga.z + lba.z;
        v[rr][i].w = (v[rr][i].w - mu[rr]) * rs[rr] * lga.w + lba.w;
        if (val[rr]) hout[i * 64 + lane] = v[rr][i];
      }
    }
    if (last) continue;
#pragma unroll
    for (int rr = 0; rr < R; ++rr) row_stats(v[rr], mu[rr], rs[rr]);
    float lo[R][NEXP];
#pragma unroll
    for (int rr = 0; rr < R; ++rr)
#pragma unroll
      for (int e = 0; e < NEXP; ++e) lo[rr][e] = 0.f;
#pragma unroll
    for (int i = 0; i < 4; ++i) {
      float uv[R][4];
#pragma unroll
      for (int rr = 0; rr < R; ++rr) {
        const float* md2 = (sub == 0) ? md[rr] + 3 * D : modrow(p, 1, rows[rr]);
        const float4 sh = reinterpret_cast<const float4*>(md2)[i * 64 + lane];
        const float4 sc = reinterpret_cast<const float4*>(md2 + D)[i * 64 + lane];
        uv[rr][0] = (v[rr][i].x - mu[rr]) * rs[rr] * (1.f + sc.x) + sh.x;
        uv[rr][1] = (v[rr][i].y - mu[rr]) * rs[rr] * (1.f + sc.y) + sh.y;
        uv[rr][2] = (v[rr][i].z - mu[rr]) * rs[rr] * (1.f + sc.z) + sh.z;
        uv[rr][3] = (v[rr][i].w - mu[rr]) * rs[rr] * (1.f + sc.w) + sh.w;
        if (val[rr])
          reinterpret_cast<uint2*>(p.u + rows[rr] * D)[i * 64 + lane] = make_uint2(pack2(uv[rr][0], uv[rr][1]), pack2(uv[rr][2], uv[rr][3]));
      }
      if (sub == 0) {
#pragma unroll
        for (int e = 0; e < NEXP; ++e) {
          const float4 w4 = *reinterpret_cast<const float4*>(wT + e * D + (i * 64 + lane) * 4);
#pragma unroll
          for (int rr = 0; rr < R; ++rr)
            lo[rr][e] += uv[rr][0] * w4.x + uv[rr][1] * w4.y + uv[rr][2] * w4.z + uv[rr][3] * w4.w;
          if ((e & 3) == 3) __builtin_amdgcn_sched_barrier(0);
        }
      }
    }
    if (sub != 0) continue;
#pragma unroll
    for (int rr = 0; rr < R; ++rr) {
      float mine = 0.f;
#pragma unroll
      for (int e = 0; e < NEXP; ++e) {
        const float rsum = row_sum16(lo[rr][e]);
        mine = ((lane & 15) == e) ? rsum : mine;
      }
      mine += __shfl_xor(mine, 16);
      mine += __shfl_xor(mine, 32);
#pragma unroll
      for (int e = 0; e < NEXP; ++e) lo[rr][e] = __int_as_float(__builtin_amdgcn_readlane(__float_as_int(mine), e));
    }
#pragma unroll
    for (int rr = 0; rr < R; ++rr) {
      if (lane == 0 && val[rr]) {
        const long row = rows[rr];
        float mx = lo[rr][0];
#pragma unroll
        for (int e = 1; e < NEXP; ++e) mx = fmaxf(mx, lo[rr][e]);
        float sum = 0.f;
#pragma unroll
        for (int e = 0; e < NEXP; ++e) { lo[rr][e] = expf(lo[rr][e] - mx); sum += lo[rr][e]; }
        const float inv = 1.0f / sum;
        float bestg = -1e30f, gp1 = 0.f, gp2 = 0.f;
        int ge1 = 0, ge2 = 0;
#pragma unroll
        for (int gq = 0; gq < 4; ++gq) {
          float s1 = -1e30f, s2 = -1e30f, p1 = 0.f, p2 = 0.f;
          int e1 = 0, e2 = 0;
#pragma unroll
          for (int j = 0; j < 4; ++j) {
            const int e = gq * 4 + j;
            const float pe = lo[rr][e] * inv;
            const float se = pe + p.b_router[e];
            if (se > s1) { s2 = s1; p2 = p1; e2 = e1; s1 = se; p1 = pe; e1 = e; }
            else if (se > s2) { s2 = se; p2 = pe; e2 = e; }
          }
          const float gs = s1 + s2;
          if (gs > bestg) { bestg = gs; ge1 = e1; ge2 = e2; gp1 = p1; gp2 = p2; }
        }
        const float wsum = gp1 + gp2;
        p.ew[row * 2 + 0] = gp1 / wsum; p.ew[row * 2 + 1] = gp2 / wsum;
        const int lp1 = atomicAdd(cntL + ge1, 1), lp2 = atomicAdd(cntL + ge2, 1);
        const int ei = atomicAdd(nent, 2);
        entL[2 * ei] = ((int)(row * 2) << 4) | ge1; entL[2 * ei + 1] = lp1;
        entL[2 * ei + 2] = ((int)(row * 2 + 1) << 4) | ge2; entL[2 * ei + 3] = lp2;
      }
    }
  }
  if (sub == 0) {
    __syncthreads();
    if (threadIdx.x < NEXP) {
      const int c = cntL[threadIdx.x];
      cntL[threadIdx.x] = c ? atomicAdd(p.cnt + (l * NEXP + threadIdx.x) * 64, c) : 0;
    }
    __syncthreads();
    const int ne = *nent;
    for (int i = threadIdx.x; i < ne; i += 256) {
      const int key = entL[2 * i], lp = entL[2 * i + 1];
      const int e = key & 15;
      p.list[(long)(l * NEXP + e) * NR + cntL[e] + lp] = key >> 4;
    }
    __syncthreads();
  }
}

#define LOOP(n) for (long i = gtid; i < (long)(n); i += gstride)

#ifdef ONLY_PHASE
#define PH(n, ...) if (ONLY_PHASE == n) { __VA_ARGS__ }
#define GSYNC()
#else
#define PH(n, ...) { __VA_ARGS__ }
#define GSYNC() xcd_barrier(xb)
#endif

__global__ void __launch_bounds__(256, 2) mega_kernel(Params p) {
  cg::grid_group grid = cg::this_grid();
  __shared__ __attribute__((aligned(16))) unsigned char smem[SMEM_BYTES + 16];
  if (threadIdx.x == 0) *reinterpret_cast<uint4*>(smem + SMEM_BYTES) = make_uint4(0u, 0u, 0u, 0u);
  __syncthreads();
  XcdBarrier xb = xcd_barrier_post(p.bar, (volatile LAS unsigned*)(smem + SMEM_BYTES));
  const long gtid = (long)blockIdx.x * blockDim.x + threadIdx.x;
  const long gstride = (long)gridDim.x * blockDim.x;
  const int nsb = min(256, (int)gridDim.x / 2);
  PH(0,
    if (gtid < 2 * NEXP) p.cnt[gtid * 64] = 0;
    phase_convert_dense(p, smem);
    phase_fold_z(p, gtid, gstride, (float*)(smem + 65536));
    LOOP(T > 1024 ? T : 1024) ph_tables(p, i);)
#ifndef ONLY_PHASE
  grid.sync();
#endif
  PH(1, phase_lnmod_first(p);)
  GSYNC();
  PH(2, phase_gemm(p, GemmJob{p.u, p.Wt_in_even, p.P, 0, 0, 0, 1, NR / 128, IN_EVEN / 128, D, PW, IN_EVEN, 2, 1.0f}, smem);)
  GSYNC();
  PH(3,
    if ((int)blockIdx.x < nsb) phase_scan<0>(p, smem, blockIdx.x, nsb);
    else { phase_attn(p, smem, blockIdx.x - nsb, gridDim.x - nsb); phase_convert_experts(p, 0, smem, blockIdx.x - nsb, gridDim.x - nsb); })
  GSYNC();
  PH(4, phase_combine<0>(p);)
  GSYNC();
  PH(5, phase_gemm(p, GemmJob{p.u, p.Wt_out_even, p.M, 0, 0, 0, 1, NR / 128, D / 128, D, D, D, 0, 1.0f}, smem);)
  GSYNC();
  PH(6, phase_resid_ln<1>(p, 0, 0, 0, NR, smem);)
  GSYNC();
  PH(7, phase_moe(p, 0, false, smem);)
  GSYNC();
  PH(8, phase_moe(p, 0, true, smem);)
  GSYNC();
  PH(9, phase_resid_ln<2>(p, 0, 1, 0, NR, smem); phase_cmat(p, gtid, gstride);)
  GSYNC();
  PH(10, phase_gemm(p, GemmJob{p.u, p.Wt_in_odd, p.P, 0, 0, 0, 1, NR / 128, IN_ODD_PAD / 128, D, PW, O_FA, 1, 1.0f}, smem);)
  GSYNC();
  PH(11, phase_gla_decay(p);)
  GSYNC();
  PH(12,
    if ((int)blockIdx.x < nsb) phase_scan<1>(p, smem, blockIdx.x, nsb);
    else {
      phase_gemm(p, GemmJob{p.Cmat, p.FT, p.u + (long)NC * D + 768, 0, (long)256 * 2 * T, (long)T * D, NB, T / 128, 2, 2 * T, D,
                            256, 0, 0.00276213586400995f}, smem, blockIdx.x - nsb, gridDim.x - nsb);
      phase_convert_experts(p, 1, smem, blockIdx.x - nsb, gridDim.x - nsb);
    })
  GSYNC();
  PH(13, phase_combine<1>(p);)
  GSYNC();
  PH(14,
    phase_gemm(p, GemmJob{p.u + (long)NC * D, p.Wt_out_odd, p.M + (long)NC * D, 0, 0, 0, 1, NT / 128, D / 128, D, D, D, 0, 1.0f}, smem);)
  GSYNC();
  PH(15, phase_resid_ln<1>(p, 1, 0, NC, NR, smem);)
  GSYNC();
  PH(16, phase_moe(p, 1, false, smem);)
  GSYNC();
  PH(17, phase_moe(p, 1, true, smem);)
  GSYNC();
  PH(18, phase_resid_ln<2>(p, 1, 1, NC, NR, smem);)
}

static size_t carve(Params& p, char* ws) {
  size_t off = 0;
  auto take = [&](size_t bytes) { char* r = ws + off; off += (bytes + 255) & ~(size_t)255; return r; };
  p.mod = (float*)take(sizeof(float) * 2 * (NB + 1) * 6 * D);
  p.hc = (float*)take(sizeof(float) * (size_t)NC * D);
  p.costab = (float*)take(sizeof(float) * T);
  p.sintab = (float*)take(sizeof(float) * T);
  p.lbt = (float*)take(sizeof(float) * 1024);
  p.ropetab = (float*)take(sizeof(float) * 64 * 16 * 2);
  p.ew = (float*)take(sizeof(float) * (size_t)NR * 2);
  p.eidx = nullptr;
  p.u = (act_t*)take(sizeof(act_t) * (size_t)NR * D);
  p.P = (act_t*)take(sizeof(act_t) * (size_t)NR * PW);
  p.OF = (act_t*)take(sizeof(act_t) * (size_t)NR * 768);
  p.OB = (act_t*)take(sizeof(act_t) * (size_t)NR * 768);
  p.M = p.OF;
  p.Cmat = (act_t*)take(sizeof(act_t) * (size_t)T * 2 * T);
  p.FT = (act_t*)take(sizeof(act_t) * (size_t)NB * 256 * 2 * T);
  p.LF = (act_t*)take(sizeof(act_t) * (size_t)2 * NR * 384);
  p.Wt_up = p.Cmat;
  p.Wt_down = p.Wt_up + (size_t)NEXP * 1024 * D;
  p.Wt_up1 = (act_t*)take(sizeof(act_t) * (size_t)NEXP * 1024 * (D + DFF));
  p.Wt_down1 = p.Wt_up1 + (size_t)NEXP * 1024 * D;
  p.Y = p.P;
  p.H = p.P + (size_t)2 * NR * D;
  p.bar = (unsigned*)take(sizeof(unsigned) * XCD_BAR_WORDS);
  p.cnt = (int*)take(sizeof(int) * 2 * NEXP * 64);
  p.list = (int*)take(sizeof(int) * (size_t)2 * NEXP * NR);
  p.Wt_in_even = (act_t*)take(sizeof(act_t) * (size_t)IN_EVEN * D);
  p.Wt_out_even = (act_t*)take(sizeof(act_t) * (size_t)D * D);
  p.Wt_in_odd = (act_t*)take(sizeof(act_t) * (size_t)IN_ODD_PAD * D);
  p.Wt_out_odd = (act_t*)take(sizeof(act_t) * (size_t)D * D);
  return off;
}

static void fill_inputs(Params& p, void* const* d_in) {
  const float** f = (const float**)&p;
  for (int i = 0; i < 23; ++i) f[i] = (const float*)d_in[i];
}

extern "C" void kernel_launch(void* const* d_in, const int* in_sizes, int n_in, void* d_out, int out_size,
                              void* d_ws, size_t ws_size, hipStream_t stream) {
  static int grid_blocks = 0;
  if (!grid_blocks) {
    int dev = 0, cus = 0, per_cu = 0;
    (void)hipGetDevice(&dev);
    (void)hipDeviceGetAttribute(&cus, hipDeviceAttributeMultiprocessorCount, dev);
    (void)hipOccupancyMaxActiveBlocksPerMultiprocessor(&per_cu, mega_kernel, 256, 0);
    grid_blocks = cus * per_cu;
  }
  Params p{};
  fill_inputs(p, d_in);
  p.out = (float*)d_out;
  size_t need = carve(p, (char*)d_ws);
  if (need > ws_size) { fprintf(stderr, "workspace too small: need %zu have %zu\n", need, ws_size); return; }
  (void)hipMemsetAsync(p.bar, 0, sizeof(unsigned) * XCD_BAR_WORDS, stream);
  void* args[] = {&p};
  hipError_t e = hipLaunchCooperativeKernel((void*)mega_kernel, dim3(grid_blocks), dim3(256), args, 0, stream);
  if (e != hipSuccess) fprintf(stderr, "cooperative launch failed: %s (grid %d)\n", hipGetErrorString(e), grid_blocks);
}
#endif
```

```cpp
#ifndef HOST_TEST
#include <hip/hip_runtime.h>
#include <hip/hip_cooperative_groups.h>
#include <cstdio>
namespace cg = cooperative_groups;
#define DEV __device__ __forceinline__
#else
#include <cmath>
#include <cstdio>
#include <cstdlib>
#include <cstring>
#define DEV static inline
#endif

#ifndef T_BATCH
#define T_BATCH 8
#endif
#ifndef T_SEQ
#define T_SEQ 2048
#endif
#ifndef T_CTX
#define T_CTX 256
#endif

constexpr int D = 1024, NB = T_BATCH, T = T_SEQ, C = T_CTX;
constexpr int NC = NB * C, NT = NB * T, NR = NC + NT;
constexpr int GRID_W = 64;
constexpr int IN_EVEN = 3328, IN_ODD = 2592, PW = 3328;
constexpr int NEXP = 16, DFF = 512;
constexpr float ALPHA = 1.4142135623730951f;
constexpr float LN_EPS = 1e-5f;
constexpr int E_AQ = 0, E_AK = 512, E_AV = 640, E_FF = 768, E_HQ = 1792, E_HI = 2304, E_HG = 2816;
constexpr int O_Q = 0, O_K = 384, O_V = 768, O_RF = 1536, O_G = 1568, O_Z = 2336;

#ifdef HOST_TEST
typedef float act_t;
DEV float ldA(const act_t* p) { return *p; }
DEV void stA(act_t* p, float v) { *p = v; }
#else
typedef unsigned short act_t;
DEV float ldA(const act_t* p) { return __uint_as_float(((unsigned)*p) << 16); }
DEV void stA(act_t* p, float v) {
  unsigned u = __float_as_uint(v);
  u += 0x7fffu + ((u >> 16) & 1u);
  *p = (unsigned short)(u >> 16);
}
#endif

struct Params {
  const float *x, *c, *ctx, *c_ctx, *w_ada, *b_ada, *ln_g, *ln_b, *w_in_even, *attn_sink, *lb_logits, *hgrn_norm,
      *w_out_even, *w_in_odd, *gla_gate_w, *gla_gate_b, *gla_norm, *w_out_odd, *w_router, *b_router, *w_eg, *w_eu,
      *w_ed;
  float* out;
  float *mod, *hc, *costab, *sintab, *lbt, *ew, *ropetab;
  int* eidx;
  act_t *u, *P, *OF, *OB, *M, *LF;
  act_t *Wt_in_even, *Wt_out_even, *Wt_in_odd, *Wt_out_odd;
  act_t *Wt_up, *Wt_down, *Wt_up1, *Wt_down1, *H, *Y, *Cmat, *FT;
  int *cnt, *list;
  unsigned* bar;
  int use_cg_sync;
  int pad_;
};

DEV float sigmoidf_(float v) { return 1.0f / (1.0f + expf(-v)); }
DEV float siluf_(float v) { return v / (1.0f + expf(-v)); }

DEV const float* hrow_in(const Params& p, long row) {
  return row < NC ? p.ctx + row * D : p.x + (row - NC) * D;
}
DEV float* hrow(const Params& p, long row) { return row < NC ? p.hc + row * D : p.out + (row - NC) * D; }
DEV const float* modrow(const Params& p, int l, long row) {
  int bb = row < NC ? NB : (int)((row - NC) / T);
  return p.mod + ((long)l * (NB + 1) + bb) * 6 * D;
}

DEV void ph_mod(const Params& p, long i) {
  int j = (int)(i % (6 * D));
  int bb = (int)((i / (6 * D)) % (NB + 1));
  int l = (int)(i / ((long)6 * D * (NB + 1)));
  const float* cv = bb < NB ? p.c + (long)bb * D : p.c_ctx;
  const float* w = p.w_ada + (long)l * D * 6 * D + j;
  float s = p.b_ada[l * 6 * D + j];
  for (int k = 0; k < D; ++k) s += siluf_(cv[k]) * w[(long)k * 6 * D];
  p.mod[i] = s;
}

DEV void ph_tables(const Params& p, long i) {
  if (i < T) {
    double a = 6.283185307179586476925 * (double)i / (double)T;
    p.costab[i] = (float)cos(a);
    p.sintab[i] = (float)sin(a);
  }
  if (i < 1024) {
    int pos = (int)(i >> 4), idx = (int)(i & 15);
    float ang = (float)pos * powf(10000.0f, -(float)idx / 16.0f);
    p.ropetab[2 * i] = cosf(ang);
    p.ropetab[2 * i + 1] = sinf(ang);
  }
  if (i < 1024) {
    int dir = (int)(i / 512), col = (int)(i % 512);
    float l0 = p.lb_logits[(dir * 2 + 0) * 512 + col], l1 = p.lb_logits[(dir * 2 + 1) * 512 + col];
    p.lbt[i] = 1.0f / (1.0f + expf(l1 - l0));
  }
}

DEV void ln_mod_row(const float* h, const float* shift, const float* scale, act_t* u) {
  float mu = 0.f;
  for (int k = 0; k < D; ++k) mu += h[k];
  mu *= (1.0f / D);
  float var = 0.f;
  for (int k = 0; k < D; ++k) { float d = h[k] - mu; var += d * d; }
  var *= (1.0f / D);
  float rs = 1.0f / sqrtf(var + LN_EPS);
  for (int k = 0; k < D; ++k) stA(u + k, (h[k] - mu) * rs * (1.0f + scale[k]) + shift[k]);
}

DEV void ph_lnmod_first(const Params& p, long row) {
  const float* m = modrow(p, 0, row);
  ln_mod_row(hrow_in(p, row), m, m + D, p.u + row * D);
}

DEV void gemm_item_act(const act_t* A, const float* W, act_t* Cout, int K, int N, int ldc, long i) {
  int n4 = (int)(i % (N / 4));
  long row = i / (N / 4);
  const act_t* a = A + row * K;
  const float* w = W + n4 * 4;
  float s0 = 0, s1 = 0, s2 = 0, s3 = 0;
  for (int k = 0; k < K; ++k) {
    float av = ldA(a + k);
    const float* wr = w + (long)k * N;
    s0 += av * wr[0]; s1 += av * wr[1]; s2 += av * wr[2]; s3 += av * wr[3];
  }
  act_t* o = Cout + row * ldc + n4 * 4;
  stA(o, s0); stA(o + 1, s1); stA(o + 2, s2); stA(o + 3, s3);
}

DEV void ph_rope(const Params& p, long i) {
  int pr = (int)(i % 32);
  int hh = (int)((i / 32) % 10);
  long lr = i / 320;
  int t = (int)(lr % T);
  int col = hh < 8 ? E_AQ + hh * 64 : E_AK + (hh - 8) * 64;
  int idx = pr & 15;
  int pos = pr < 16 ? t / GRID_W : t % GRID_W;
  int d0 = pr < 16 ? idx : 32 + idx;
  float inv = powf(10000.0f, -(float)idx / 16.0f);
  float ang = (float)pos * inv;
  float cs = cosf(ang), sn = sinf(ang);
  act_t* base = p.P + (NC + lr) * PW + col;
  float x1 = ldA(base + d0), x2 = ldA(base + d0 + 16);
  stA(base + d0, x1 * cs - x2 * sn);
  stA(base + d0 + 16, x1 * sn + x2 * cs);
}

DEV void ph_attn(const Params& p, long i) {
  int h = (int)(i % 8);
  long row = i / 8;
  int kv = h / 4;
  bool lat = row >= NC;
  int b = lat ? (int)((row - NC) / T) : (int)(row / C);
  int t = lat ? (int)((row - NC) % T) : 0;
  float q[64], acc[64];
  const act_t* qp = p.P + row * PW + E_AQ + h * 64;
#pragma unroll
  for (int d = 0; d < 64; ++d) { q[d] = ldA(qp + d) * 0.125f; acc[d] = 0.f; }
  float m = p.attn_sink[h], l = 1.0f;
  int nkeys = C + (lat ? 257 : 0);
  for (int j = 0; j < nkeys; ++j) {
    long krow;
    if (j < C) krow = (long)b * C + j;
    else {
      int kp = t - 128 + (j - C);
      if (kp < 0 || kp >= T) continue;
      krow = NC + (long)b * T + kp;
    }
    const act_t* kptr = p.P + krow * PW + E_AK + kv * 64;
    const act_t* vptr = p.P + krow * PW + E_AV + kv * 64;
    float s = 0.f;
#pragma unroll
    for (int d = 0; d < 64; ++d) s += q[d] * ldA(kptr + d);
    float mn = fmaxf(m, s);
    float sc = expf(m - mn), pj = expf(s - mn);
    l = l * sc + pj;
#pragma unroll
    for (int d = 0; d < 64; ++d) acc[d] = acc[d] * sc + pj * ldA(vptr + d);
    m = mn;
  }
  float il = 1.0f / l;
  act_t* o = p.u + row * D + h * 64;
#pragma unroll
  for (int d = 0; d < 64; ++d) stA(o + d, acc[d] * il);
}

template <int MODE>
DEV void ph_scan(const Params& p, long i) {
  constexpr int DK = MODE == 0 ? 128 : 96;
  constexpr int DV = MODE == 0 ? 128 : 192;
  int e = (int)(i % DV);
  int dir = (int)((i / DV) % 2);
  int h = (int)((i / (2 * DV)) % 4);
  int b = (int)(i / (8 * DV));
  float S[DK];
#pragma unroll
  for (int d = 0; d < DK; ++d) S[d] = 0.f;
  act_t* OD = dir == 0 ? p.OF : p.OB;
  for (int step = 0; step < C + T; ++step) {
    long row;
    if (step < C) row = (long)b * C + (dir == 0 ? step : C - 1 - step);
    else { int tt = step - C; row = NC + (long)b * T + (dir == 0 ? tt : T - 1 - tt); }
    const act_t* pr = p.P + row * PW;
    float o = 0.f;
    if (MODE == 0) {
      float v = ldA(pr + E_HI + h * 128 + e);
      const act_t* zp = pr + E_FF + dir * 512 + h * 128;
      const act_t* qp = pr + E_HQ + h * 128;
      const float* lb = p.lbt + dir * 512 + h * 128;
#pragma unroll
      for (int d = 0; d < DK; ++d) {
        float f = lb[d] + (1.0f - lb[d]) * sigmoidf_(ldA(zp + d));
        S[d] = f * S[d] + (1.0f - f) * v;
        o += ldA(qp + d) * S[d];
      }
      stA(OD + row * 768 + h * 128 + e, o);
    } else {
      float v = ldA(pr + O_V + h * 192 + e);
      const act_t* kp = pr + O_K + h * 96;
      const act_t* qp = pr + O_Q + h * 96;
      const act_t* lf = p.LF + ((long)dir * NR + row) * 384 + h * 96;
#pragma unroll
      for (int d = 0; d < DK; ++d) {
        float f = expf(ldA(lf + d));
        S[d] = f * S[d] + ldA(kp + d) * v;
        o += ldA(qp + d) * S[d];
      }
      stA(OD + row * 768 + h * 192 + e, o * 0.10206207261596575f);
    }
  }
}

template <int MODE>
DEV void ph_combine(const Params& p, long i) {
  constexpr int DV = MODE == 0 ? 128 : 192;
  int h = (int)(i % 4);
  long row = (MODE == 0) ? i / 4 : NC + i / 4;
  const act_t* f = p.OF + row * 768 + h * DV;
  const act_t* bk = p.OB + row * 768 + h * DV;
  float ss = 0.f;
  for (int e = 0; e < DV; ++e) { float o = ldA(f + e) + ldA(bk + e); ss += o * o; }
  float r = 1.0f / sqrtf(ss / DV + LN_EPS);
  const float* gn = (MODE == 0 ? p.hgrn_norm : p.gla_norm) + h * DV;
  const act_t* g = p.P + row * PW + (MODE == 0 ? E_HG : O_G) + h * DV;
  act_t* o = p.u + row * D + (MODE == 0 ? 512 : 0) + h * DV;
  for (int e = 0; e < DV; ++e) stA(o + e, (ldA(f + e) + ldA(bk + e)) * r * gn[e] * siluf_(ldA(g + e)));
}

DEV void ph_gla_decay(const Params& p, long i) {
  int col = (int)(i % 384);
  long row = (i / 384) % NR;
  int dir = (int)(i / ((long)384 * NR));
  const act_t* r = p.P + row * PW + O_RF + dir * 16;
  const float* gw = p.gla_gate_w + (long)dir * 16 * 384 + col;
  float z = p.gla_gate_b[dir * 384 + col];
  for (int k = 0; k < 16; ++k) z += ldA(r + k) * gw[k * 384];
  float ls = fminf(z, 0.f) - log1pf(expf(-fabsf(z)));
  stA(p.LF + ((long)dir * NR + row) * 384 + col, ls * (1.0f / 16.0f));
}

DEV void ph_resid_ln(const Params& p, long row, int l, int sub) {
  const float* hin = (l == 0 && sub == 0) ? hrow_in(p, row) : hrow(p, row);
  float* hout = hrow(p, row);
  const float* md = modrow(p, l, row);
  const float* g = md + (sub == 0 ? 2 : 5) * D;
  const act_t* m = p.M + row * D;
  const float* lg = p.ln_g + (l * 2 + sub) * D;
  const float* lb = p.ln_b + (l * 2 + sub) * D;
  float mu = 0.f;
  for (int k = 0; k < D; ++k) mu += ALPHA * hin[k] + g[k] * ldA(m + k);
  mu *= (1.0f / D);
  float var = 0.f;
  for (int k = 0; k < D; ++k) { float d = ALPHA * hin[k] + g[k] * ldA(m + k) - mu; var += d * d; }
  var *= (1.0f / D);
  float rs = 1.0f / sqrtf(var + LN_EPS);
  for (int k = 0; k < D; ++k) hout[k] = (ALPHA * hin[k] + g[k] * ldA(m + k) - mu) * rs * lg[k] + lb[k];
  if (sub == 1 && l == 1) return;
  const float* md2 = (sub == 0) ? md + 3 * D : modrow(p, 1, row);
  float mu2 = 0.f;
  for (int k = 0; k < D; ++k) mu2 += hout[k];
  mu2 *= (1.0f / D);
  float var2 = 0.f;
  for (int k = 0; k < D; ++k) { float d = hout[k] - mu2; var2 += d * d; }
  var2 *= (1.0f / D);
  float rs2 = 1.0f / sqrtf(var2 + LN_EPS);
  float lo[NEXP];
#pragma unroll
  for (int e = 0; e < NEXP; ++e) lo[e] = 0.f;
  for (int k = 0; k < D; ++k) {
    float uv = (hout[k] - mu2) * rs2 * (1.0f + md2[D + k]) + md2[k];
    stA(p.u + row * D + k, uv);
    if (sub == 0) {
      const float* wr = p.w_router + k * NEXP;
#pragma unroll
      for (int e = 0; e < NEXP; ++e) lo[e] += uv * wr[e];
    }
  }
  if (sub != 0) return;
  float mx = lo[0];
#pragma unroll
  for (int e = 1; e < NEXP; ++e) mx = fmaxf(mx, lo[e]);
  float sum = 0.f;
#pragma unroll
  for (int e = 0; e < NEXP; ++e) { lo[e] = expf(lo[e] - mx); sum += lo[e]; }
  float inv = 1.0f / sum;
  float bestg = -1e30f; int bg = 0;
  float gi1 = 0, gi2 = 0; int ge1 = 0, ge2 = 0;
  float gp1 = 0, gp2 = 0;
#pragma unroll
  for (int gq = 0; gq < 4; ++gq) {
    float s1 = -1e30f, s2 = -1e30f, p1 = 0, p2 = 0; int e1 = 0, e2 = 0;
#pragma unroll
    for (int j = 0; j < 4; ++j) {
      int e = gq * 4 + j;
      float pe = lo[e] * inv;
      float se = pe + p.b_router[e];
      if (se > s1) { s2 = s1; p2 = p1; e2 = e1; s1 = se; p1 = pe; e1 = e; }
      else if (se > s2) { s2 = se; p2 = pe; e2 = e; }
    }
    float gs = s1 + s2;
    if (gs > bestg) { bestg = gs; bg = gq; gi1 = s1; gi2 = s2; ge1 = e1; ge2 = e2; gp1 = p1; gp2 = p2; }
  }
  (void)bg; (void)gi1; (void)gi2;
  float wsum = gp1 + gp2;
  p.eidx[row * 2 + 0] = ge1; p.eidx[row * 2 + 1] = ge2;
  p.ew[row * 2 + 0] = gp1 / wsum; p.ew[row * 2 + 1] = gp2 / wsum;
}

DEV void ph_moe_up(const Params& p, long i, int l, long row0) {
  int f4 = (int)(i % (DFF / 4));
  int slot = (int)((i / (DFF / 4)) % 2);
  long row = row0 + i / (DFF / 2);
  int e = p.eidx[row * 2 + slot];
  const float* w1 = p.w_eg + ((long)(l * NEXP + e) * D) * DFF + f4 * 4;
  const float* w3 = p.w_eu + ((long)(l * NEXP + e) * D) * DFF + f4 * 4;
  const act_t* a = p.u + row * D;
  float g0 = 0, g1 = 0, g2 = 0, g3 = 0, u0 = 0, u1 = 0, u2 = 0, u3 = 0;
  for (int k = 0; k < D; ++k) {
    float av = ldA(a + k);
    const float* r1 = w1 + (long)k * DFF;
    const float* r3 = w3 + (long)k * DFF;
    g0 += av * r1[0]; g1 += av * r1[1]; g2 += av * r1[2]; g3 += av * r1[3];
    u0 += av * r3[0]; u1 += av * r3[1]; u2 += av * r3[2]; u3 += av * r3[3];
  }
  act_t* hb = p.P + (row * 2 + slot) * DFF + f4 * 4;
  stA(hb, siluf_(g0) * u0); stA(hb + 1, siluf_(g1) * u1); stA(hb + 2, siluf_(g2) * u2); stA(hb + 3, siluf_(g3) * u3);
}

DEV void ph_moe_down(const Params& p, long i, int l, long row0) {
  int j4 = (int)(i % (D / 4));
  long row = row0 + i / (D / 4);
  float y0 = 0, y1 = 0, y2 = 0, y3 = 0;
  for (int slot = 0; slot < 2; ++slot) {
    int e = p.eidx[row * 2 + slot];
    float wgt = p.ew[row * 2 + slot];
    const float* w2 = p.w_ed + ((long)(l * NEXP + e) * DFF) * D + j4 * 4;
    const act_t* hb = p.P + (row * 2 + slot) * DFF;
    float s0 = 0, s1 = 0, s2 = 0, s3 = 0;
    for (int f = 0; f < DFF; ++f) {
      float hv = ldA(hb + f);
      const float* r = w2 + (long)f * D;
      s0 += hv * r[0]; s1 += hv * r[1]; s2 += hv * r[2]; s3 += hv * r[3];
    }
    y0 += wgt * s0; y1 += wgt * s1; y2 += wgt * s2; y3 += wgt * s3;
  }
  act_t* o = p.M + row * D + j4 * 4;
  stA(o, y0); stA(o + 1, y1); stA(o + 2, y2); stA(o + 3, y3);
}


#ifndef HOST_TEST
typedef __attribute__((ext_vector_type(8))) short bf16x8;
typedef __attribute__((ext_vector_type(4))) float f32x4;
constexpr int SMEM_BYTES = 71680;
constexpr int IN_ODD_PAD = 2944;
constexpr int O_FA = 2336, O_FB = 2592, O_END = 2848;

typedef float f32x2_t __attribute__((ext_vector_type(2)));
typedef __bf16 bf16x2_t __attribute__((ext_vector_type(2)));
__device__ __forceinline__ unsigned pack2(float a, float b) {
  const f32x2_t v = {a, b};
  return __builtin_bit_cast(unsigned, __builtin_convertvector(v, bf16x2_t));
}
__device__ __forceinline__ unsigned pack2_mfma(float a, float b) { return pack2(a, b); }
typedef __attribute__((ext_vector_type(2))) unsigned u32x2;
__device__ __forceinline__ float xor16_max(float x) {
  const u32x2 r = __builtin_amdgcn_permlane16_swap(__float_as_uint(x), __float_as_uint(x), false, false);
  return fmaxf(__uint_as_float(r.x), __uint_as_float(r.y));
}
__device__ __forceinline__ float xor32_max(float x) {
  const u32x2 r = __builtin_amdgcn_permlane32_swap(__float_as_uint(x), __float_as_uint(x), false, false);
  return fmaxf(__uint_as_float(r.x), __uint_as_float(r.y));
}
__device__ __forceinline__ float xor16_add(float x) {
  const u32x2 r = __builtin_amdgcn_permlane16_swap(__float_as_uint(x), __float_as_uint(x), false, false);
  return __uint_as_float(r.x) + __uint_as_float(r.y);
}
__device__ __forceinline__ float xor32_add(float x) {
  const u32x2 r = __builtin_amdgcn_permlane32_swap(__float_as_uint(x), __float_as_uint(x), false, false);
  return __uint_as_float(r.x) + __uint_as_float(r.y);
}
__device__ __forceinline__ float bf_lo(unsigned u) { return __uint_as_float(u << 16); }
__device__ __forceinline__ float bf_hi(unsigned u) { return __uint_as_float(u & 0xffff0000u); }
template <int CTRL>
__device__ __forceinline__ float dpp_mov(float v) {
  return __int_as_float(__builtin_amdgcn_update_dpp(0, __float_as_int(v), CTRL, 0xf, 0xf, true));
}
__device__ __forceinline__ float row_sum16(float v) {
  v += dpp_mov<0xB1>(v);
  v += dpp_mov<0x4E>(v);
  v += dpp_mov<0x141>(v);
  v += dpp_mov<0x140>(v);
  return v;
}
__device__ __forceinline__ float wave_sum(float v) {
  v = row_sum16(v);
  const float a = __int_as_float(__builtin_amdgcn_readlane(__float_as_int(v), 0));
  const float b = __int_as_float(__builtin_amdgcn_readlane(__float_as_int(v), 16));
  const float c = __int_as_float(__builtin_amdgcn_readlane(__float_as_int(v), 32));
  const float d = __int_as_float(__builtin_amdgcn_readlane(__float_as_int(v), 48));
  return (a + b) + (c + d);
}


#define XB_TMO      128
#define XB_XCNT(j)  (256  + 64 * (j))
#define XB_XSUB(j)  (1280 + 64 * (j))
#define XB_XGEN(j)  (2304 + 64 * (j))
#define XB_TOP      3328
#define XB_TOPGEN   3392
#define XCD_BAR_WORDS 3456
#define XB_SPIN_CAP (1u << 18)
#define LAS __attribute__((address_space(3)))
__device__ __forceinline__ unsigned xb_ld(unsigned* p)              { return __hip_atomic_load(p, __ATOMIC_RELAXED, __HIP_MEMORY_SCOPE_AGENT); }
__device__ __forceinline__ unsigned xb_add(unsigned* p, unsigned v) { return __hip_atomic_fetch_add(p, v, __ATOMIC_RELAXED, __HIP_MEMORY_SCOPE_AGENT); }
__device__ __forceinline__ unsigned xb_xcc_id() { return (unsigned)__builtin_amdgcn_s_getreg((3 << 11) | 20) & 0xFu; }
#define XB_SPIN(cond, bar) do { unsigned _sp = 0; while (cond) { __builtin_amdgcn_s_sleep(1); \
    if ((++_sp & 255u) == 0u) { if (xb_ld(&(bar)[XB_TMO])) break; if (_sp > XB_SPIN_CAP) { atomicAdd(&(bar)[XB_TMO], 1u); break; } } } } while (0)
struct XcdBarrier { unsigned* bar; unsigned x; volatile LAS unsigned* st; };
__device__ __forceinline__ XcdBarrier xcd_barrier_post(unsigned* bar, volatile LAS unsigned* st) {
    XcdBarrier b; b.bar = bar; b.x = xb_xcc_id(); b.st = st;
    if (threadIdx.x == 0) (void)xb_add(&bar[XB_XCNT(b.x)], 1u);
    return b;
}
__device__ __forceinline__ void xcd_barrier_complete(unsigned* bar, unsigned x, unsigned& nloc, unsigned& nx) {
    const unsigned G = gridDim.x * gridDim.y * gridDim.z;
    unsigned sum, cnt, mine, sp = 0u;
    for (;;) {
        sum = 0u; cnt = 0u; mine = 0u;
#pragma unroll
        for (unsigned j = 0; j < 16; ++j) { const unsigned c = xb_ld(&bar[XB_XCNT(j)]); sum += c; cnt += (c > 0u) ? 1u : 0u; mine = (j == x) ? c : mine; }
        if (sum == G) break;
        __builtin_amdgcn_s_sleep(1);
        if ((++sp & 255u) == 0u) { if (xb_ld(&bar[XB_TMO])) break; if (sp > XB_SPIN_CAP) { atomicAdd(&bar[XB_TMO], 1u); break; } }
    }
    nloc = mine > 0u ? mine : 1u; nx = cnt > 0u ? cnt : 1u;
}
__device__ __forceinline__ void xcd_barrier(const XcdBarrier& b) {
    asm volatile("s_waitcnt vmcnt(0)" ::: "memory");
    __syncthreads();
    if (threadIdx.x == 0) {
        unsigned* bar = b.bar;
        __builtin_amdgcn_s_waitcnt(0);
        unsigned nloc = b.st[0], nx = b.st[1];
        if (nloc == 0u) { xcd_barrier_complete(bar, b.x, nloc, nx); b.st[0] = nloc; b.st[1] = nx; }
        const unsigned old = xb_add(&bar[XB_XSUB(b.x)], 1u);
        const unsigned gen = old / nloc;
        if (old + 1u == (gen + 1u) * nloc) {
            __builtin_amdgcn_fence(__ATOMIC_RELEASE, "agent");
            asm volatile("s_waitcnt vmcnt(0)" ::: "memory");
            const unsigned og = xb_add(&bar[XB_TOP], 1u);
            const unsigned tg = og / nx;
            if (og + 1u == (tg + 1u) * nx) xb_add(&bar[XB_TOPGEN], 1u);
            else XB_SPIN(xb_ld(&bar[XB_TOPGEN]) == tg, bar);
            __builtin_amdgcn_fence(__ATOMIC_ACQUIRE, "agent");
            xb_add(&bar[XB_XGEN(b.x)], 1u);
            asm volatile("s_waitcnt vmcnt(0)" ::: "memory");
        } else {
            XB_SPIN(xb_ld(&bar[XB_XGEN(b.x)]) == gen, bar);
            __builtin_amdgcn_fence(__ATOMIC_ACQUIRE, "agent");
            asm volatile("s_waitcnt vmcnt(0)" ::: "memory");
        }
    }
    __syncthreads();
}

#define RAW_BARRIER() do { asm volatile("s_waitcnt lgkmcnt(0)" ::: "memory"); __builtin_amdgcn_s_barrier(); } while (0)
template <class ARow, class Epi>
__device__ __forceinline__ void gemm_tile(ARow arow, const act_t* Bt, int K, unsigned char* smem, Epi epi) {
  const int tid = threadIdx.x, wid = tid >> 6, lane = tid & 63, wr = wid >> 1, wc = wid & 1, fr = lane & 15,
            fq = lane >> 4;
  const int r0 = tid >> 3, pc = tid & 7;
  const int lc = pc ^ ((tid >> 4) & 7);
  const act_t* ga[4];
#pragma unroll
  for (int i = 0; i < 4; ++i) ga[i] = arow(r0 + 32 * i) + lc * 8;
  const act_t* gb0 = Bt + (long)r0 * K + lc * 8;
  const long gbs = (long)32 * K;
  const int sw = (fr >> 1) & 7;
  const int rd0 = fr * 128 + ((fq ^ sw) << 4), rd1 = fr * 128 + (((4 + fq) ^ sw) << 4);
  char* S = (char*)smem;
  const int nk = K >> 6;
  f32x4 acc[4][4];
#pragma unroll
  for (int m = 0; m < 4; ++m)
#pragma unroll
    for (int n = 0; n < 4; ++n) acc[m][n] = f32x4{0.f, 0.f, 0.f, 0.f};
  auto issue = [&](int kt) {
    char* st = S + (kt & 1) * 32768 + tid * 16;
#pragma unroll
    for (int i = 0; i < 4; ++i) {
      __builtin_amdgcn_global_load_lds((const unsigned*)(ga[i] + kt * 64), (unsigned*)(st + i * 4096), 16, 0, 0);
      __builtin_amdgcn_global_load_lds((const unsigned*)(gb0 + i * gbs + kt * 64), (unsigned*)(st + 16384 + i * 4096), 16, 0, 0);
    }
  };
  asm volatile("s_waitcnt vmcnt(0)" ::: "memory");
  RAW_BARRIER();
  issue(0);
  for (int kt = 0; kt < nk; ++kt) {
    asm volatile("s_waitcnt vmcnt(0)" ::: "memory");
    RAW_BARRIER();
    if (kt + 1 < nk) issue(kt + 1);
    const char* st = S + (kt & 1) * 32768;
#pragma unroll
    for (int ks = 0; ks < 2; ++ks) {
      const int rd = ks ? rd1 : rd0;
      bf16x8 af[4], bfr[4];
#pragma unroll
      for (int m = 0; m < 4; ++m) {
        af[m] = *reinterpret_cast<const bf16x8*>(st + (wr * 64 + m * 16) * 128 + rd);
        bfr[m] = *reinterpret_cast<const bf16x8*>(st + 16384 + (wc * 64 + m * 16) * 128 + rd);
      }
#pragma unroll
      for (int m = 0; m < 4; ++m)
#pragma unroll
        for (int n = 0; n < 4; ++n) acc[m][n] = __builtin_amdgcn_mfma_f32_16x16x32_bf16(af[m], bfr[n], acc[m][n], 0, 0, 0);
    }
  }
  epi(acc, wr, wc, fr, fq);
}

__device__ __forceinline__ void phase_attn(const Params& p, unsigned char* smem, int blk, int nblk) {
  const int tid = threadIdx.x, w = tid >> 6, lane = tid & 63, fr = lane & 15, g = lane >> 4;
  act_t* SK = (act_t*)smem;
  act_t* SV = SK + 64 * 72;
  constexpr float SCL = 0.125f * 1.4426950408889634f;
  const int n_lat = NB * 4 * (T / 64), n_ctx = NB * 4 * (C / 64);
  const int skey = tid >> 2, spart = tid & 3;
  for (int unit = blk; unit < n_lat + n_ctx; unit += nblk) {
    const bool lat = unit < n_lat;
    const int uu = lat ? unit : unit - n_lat;
    const int nq = lat ? T / 64 : C / 64;
    const int hp = uu & 1, kv = (uu >> 1) & 1, qb = (uu >> 2) % nq, b = (uu >> 2) / nq;
    const int t0 = qb * 64;
    const int tw = t0 + (w & 1) * 32;
    const long qrow0 = (lat ? (long)NC + (long)b * T : (long)b * C) + tw;
    const int h = kv * 4 + hp * 2 + (w >> 1);
    bf16x8 qf[2][2];
#pragma unroll
    for (int qt = 0; qt < 2; ++qt)
#pragma unroll
      for (int st = 0; st < 2; ++st)
        qf[qt][st] = *reinterpret_cast<const bf16x8*>(p.P + (qrow0 + qt * 16 + fr) * PW + E_AQ + h * 64 + st * 32 + g * 8);
    asm volatile("" :: "v"(qf[0][0]), "v"(qf[0][1]), "v"(qf[1][0]), "v"(qf[1][1]));
    float mrun[2], lrun[2];
    f32x4 o[2][4];
    const float sinkl = p.attn_sink[h] * 1.4426950408889634f;
#pragma unroll
    for (int qt = 0; qt < 2; ++qt) {
      mrun[qt] = sinkl;
      lrun[qt] = (g == 0) ? 1.0f : 0.0f;
#pragma unroll
      for (int dt = 0; dt < 4; ++dt) o[qt][dt] = f32x4{0.f, 0.f, 0.f, 0.f};
    }
    int cc_lo = 0, cc_hi = -1;
    if (lat) {
      cc_lo = t0 >= 128 ? 0 : (128 - t0) / 64;
      cc_hi = min(4, (T - 1 - (t0 - 128)) / 64);
    }
    const int nch = 4 + (cc_hi - cc_lo + 1);
    auto chunk_row = [&](int i, int key, int& tkb) -> long {
      if (i < 4) { tkb = 0; return (long)b * C + i * 64 + key; }
      tkb = t0 - 128 + (cc_lo + i - 4) * 64;
      return (long)NC + (long)b * T + tkb + key;
    };
    uint4 rk0, rk1, rv0, rv1;
    {
      int tkb; const long kr = chunk_row(0, skey, tkb);
      const act_t* kp = p.P + kr * PW + E_AK + kv * 64 + spart * 16;
      const act_t* vp = p.P + kr * PW + E_AV + kv * 64 + spart * 16;
      rk0 = *reinterpret_cast<const uint4*>(kp); rk1 = *reinterpret_cast<const uint4*>(kp + 8);
      rv0 = *reinterpret_cast<const uint4*>(vp); rv1 = *reinterpret_cast<const uint4*>(vp + 8);
    }
    for (int i = 0; i < nch; ++i) {
      __syncthreads();
      {
        uint4* kd = reinterpret_cast<uint4*>(SK + skey * 72 + spart * 16);
        kd[0] = rk0; kd[1] = rk1;
        const unsigned vw[8] = {rv0.x, rv0.y, rv0.z, rv0.w, rv1.x, rv1.y, rv1.z, rv1.w};
#pragma unroll
        for (int e = 0; e < 8; ++e) {
          SV[(spart * 16 + 2 * e) * 72 + skey] = (act_t)(vw[e] & 0xffffu);
          SV[(spart * 16 + 2 * e + 1) * 72 + skey] = (act_t)(vw[e] >> 16);
        }
      }
      __syncthreads();
      int tkb_cur; (void)chunk_row(i, 0, tkb_cur);
      if (i + 1 < nch) {
        int tkb; const long kr = chunk_row(i + 1, skey, tkb);
        const act_t* kp = p.P + kr * PW + E_AK + kv * 64 + spart * 16;
        const act_t* vp = p.P + kr * PW + E_AV + kv * 64 + spart * 16;
        rk0 = *reinterpret_cast<const uint4*>(kp); rk1 = *reinterpret_cast<const uint4*>(kp + 8);
        rv0 = *reinterpret_cast<const uint4*>(vp); rv1 = *reinterpret_cast<const uint4*>(vp + 8);
      }
      const bool edge = i >= 4 && (tkb_cur == t0 - 128 || tkb_cur == t0 + 128);
#pragma unroll
      for (int kb = 0; kb < 2; ++kb) {
        f32x4 sc[2][2];
#pragma unroll
        for (int k2 = 0; k2 < 2; ++k2) {
          const int kt = kb * 2 + k2;
          const bf16x8 kf0 = *reinterpret_cast<const bf16x8*>(SK + (kt * 16 + fr) * 72 + g * 8);
          const bf16x8 kf1 = *reinterpret_cast<const bf16x8*>(SK + (kt * 16 + fr) * 72 + 32 + g * 8);
#pragma unroll
          for (int qt = 0; qt < 2; ++qt) {
            f32x4 z = f32x4{0.f, 0.f, 0.f, 0.f};
            z = __builtin_amdgcn_mfma_f32_16x16x32_bf16(kf0, qf[qt][0], z, 0, 0, 0);
            sc[qt][k2] = __builtin_amdgcn_mfma_f32_16x16x32_bf16(kf1, qf[qt][1], z, 0, 0, 0);
          }
        }
        bf16x8 pf[2];
#pragma unroll
        for (int qt = 0; qt < 2; ++qt) {
          float mx = -1e30f;
#pragma unroll
          for (int k2 = 0; k2 < 2; ++k2)
#pragma unroll
            for (int j = 0; j < 4; ++j) {
              float v = sc[qt][k2][j] * SCL;
              if (edge) {
                const int tk = tkb_cur + (kb * 2 + k2) * 16 + 4 * g + j;
                const int tq = tw + qt * 16 + fr;
                const int df = tq - tk;
                if (df > 128 || df < -128) v = -1e30f;
              }
              sc[qt][k2][j] = v;
              mx = fmaxf(mx, v);
            }
          mx = xor16_max(mx);
          mx = xor32_max(mx);
          const float mnew = fmaxf(mrun[qt], mx);
          if (__any(mnew > mrun[qt])) {
            const float alpha = __builtin_amdgcn_exp2f(mrun[qt] - mnew);
            lrun[qt] *= alpha;
#pragma unroll
            for (int dt = 0; dt < 4; ++dt) o[qt][dt] = o[qt][dt] * alpha;
            mrun[qt] = mnew;
          }
          float ls = 0.f;
          float pv[8];
#pragma unroll
          for (int k2 = 0; k2 < 2; ++k2)
#pragma unroll
            for (int j = 0; j < 4; ++j) {
              const float pe = __builtin_amdgcn_exp2f(sc[qt][k2][j] - mnew);
              pv[k2 * 4 + j] = pe;
              ls += pe;
            }
          lrun[qt] += ls;
          union { unsigned u[4]; bf16x8 v; } cv;
          cv.u[0] = pack2_mfma(pv[0], pv[1]); cv.u[1] = pack2_mfma(pv[2], pv[3]);
          cv.u[2] = pack2_mfma(pv[4], pv[5]); cv.u[3] = pack2_mfma(pv[6], pv[7]);
          pf[qt] = cv.v;
        }
#pragma unroll
        for (int dt = 0; dt < 4; ++dt) {
          union { uint2 h2[2]; bf16x8 v; } vf;
          vf.h2[0] = *reinterpret_cast<const uint2*>(SV + (dt * 16 + fr) * 72 + kb * 32 + 4 * g);
          vf.h2[1] = *reinterpret_cast<const uint2*>(SV + (dt * 16 + fr) * 72 + kb * 32 + 16 + 4 * g);
#pragma unroll
          for (int qt = 0; qt < 2; ++qt) o[qt][dt] = __builtin_amdgcn_mfma_f32_16x16x32_bf16(vf.v, pf[qt], o[qt][dt], 0, 0, 0);
        }
      }
    }
#pragma unroll
    for (int qt = 0; qt < 2; ++qt) {
      float lt = lrun[qt];
      lt = xor16_add(lt);
      lt = xor32_add(lt);
      const float il = 1.0f / lt;
      act_t* orow = p.u + (qrow0 + qt * 16 + fr) * D + h * 64 + 4 * g;
#pragma unroll
      for (int dt = 0; dt < 4; ++dt)
        *reinterpret_cast<uint2*>(orow + dt * 16) =
            make_uint2(pack2(o[qt][dt][0] * il, o[qt][dt][1] * il), pack2(o[qt][dt][2] * il, o[qt][dt][3] * il));
    }
  }
}


template <int MODE>
__device__ __forceinline__ void phase_combine(const Params& p) {
  constexpr int DV = MODE == 0 ? 128 : 192, EPL = DV / 16, NV = EPL / 4;
  const int lane = threadIdx.x & 63;
  const long row_lo = MODE == 0 ? 0 : NC;
  const long w0 = (long)blockIdx.x * 4 + (threadIdx.x >> 6), wstride = (long)gridDim.x * 4;
  const float* gn = (MODE == 0 ? p.hgrn_norm : p.gla_norm) + lane * EPL;
  for (long row = row_lo + w0; row < NR; row += wstride) {
    const uint2* f = reinterpret_cast<const uint2*>(p.OF + row * 768 + lane * EPL);
    const uint2* bk = reinterpret_cast<const uint2*>(p.OB + row * 768 + lane * EPL);
    const uint2* gt = reinterpret_cast<const uint2*>(p.P + row * PW + (MODE == 0 ? E_HG : O_G) + lane * EPL);
    float o[EPL];
    float ss = 0.f;
#pragma unroll
    for (int v = 0; v < NV; ++v) {
      const uint2 a = f[v], c = bk[v];
      o[4 * v + 0] = bf_lo(a.x) + bf_lo(c.x); o[4 * v + 1] = bf_hi(a.x) + bf_hi(c.x);
      o[4 * v + 2] = bf_lo(a.y) + bf_lo(c.y); o[4 * v + 3] = bf_hi(a.y) + bf_hi(c.y);
    }
#pragma unroll
    for (int e = 0; e < EPL; ++e) ss += o[e] * o[e];
    ss = row_sum16(ss);
    const float r = 1.0f / sqrtf(ss * (1.0f / DV) + LN_EPS);
    uint2* dst = reinterpret_cast<uint2*>(p.u + row * D + (MODE == 0 ? 512 : 0) + lane * EPL);
#pragma unroll
    for (int v = 0; v < NV; ++v) {
      const uint2 gv = gt[v];
      const float g0 = bf_lo(gv.x), g1 = bf_hi(gv.x), g2 = bf_lo(gv.y), g3 = bf_hi(gv.y);
      const float y0 = o[4 * v + 0] * r * gn[4 * v + 0] * (g0 / (1.0f + __expf(-g0)));
      const float y1 = o[4 * v + 1] * r * gn[4 * v + 1] * (g1 / (1.0f + __expf(-g1)));
      const float y2 = o[4 * v + 2] * r * gn[4 * v + 2] * (g2 / (1.0f + __expf(-g2)));
      const float y3 = o[4 * v + 3] * r * gn[4 * v + 3] * (g3 / (1.0f + __expf(-g3)));
      dst[v] = make_uint2(pack2(y0, y1), pack2(y2, y3));
    }
  }
}

__device__ __forceinline__ void mod_item(const Params& p, int item, unsigned char* smem) {
  float* sc = (float*)smem;
  const int tid = threadIdx.x;
  for (int i = tid; i < 9 * D; i += 256) {
    const int bb = i >> 10, k = i & 1023;
    const float v = bb < NB ? p.c[bb * D + k] : p.c_ctx[k];
    sc[i] = v / (1.0f + __expf(-v));
  }
  __syncthreads();
  const int l = item / 24, j = (item % 24) * 256 + tid;
  const float* w = p.w_ada + (long)l * D * 6 * D + j;
  float a[NB + 1];
#pragma unroll
  for (int bb = 0; bb <= NB; ++bb) a[bb] = p.b_ada[l * 6 * D + j];
  for (int k = 0; k < D; k += 8) {
    float wv[8];
#pragma unroll
    for (int q = 0; q < 8; ++q) wv[q] = w[(long)(k + q) * 6 * D];
#pragma unroll
    for (int q = 0; q < 8; ++q)
#pragma unroll
      for (int bb = 0; bb <= NB; ++bb) a[bb] += sc[bb * D + k + q] * wv[q];
  }
#pragma unroll
  for (int bb = 0; bb <= NB; ++bb) p.mod[((long)l * (NB + 1) + bb) * 6 * D + j] = a[bb];
  __syncthreads();
}

__device__ __forceinline__ void phase_gla_decay(const Params& p) {
  const int t = threadIdx.x;
  if (t >= 192) return;
  const int dir = t / 96, cg = t % 96;
  float gw[16][4], gb[4];
#pragma unroll
  for (int r = 0; r < 16; ++r) {
    const float4 v = *reinterpret_cast<const float4*>(p.gla_gate_w + ((long)dir * 16 + r) * 384 + cg * 4);
    gw[r][0] = v.x; gw[r][1] = v.y; gw[r][2] = v.z; gw[r][3] = v.w;
  }
  {
    const float4 v = *reinterpret_cast<const float4*>(p.gla_gate_b + dir * 384 + cg * 4);
    gb[0] = v.x; gb[1] = v.y; gb[2] = v.z; gb[3] = v.w;
  }
  for (long row0 = (long)blockIdx.x * 4; row0 < NR; row0 += (long)gridDim.x * 4) {
    uint4 ra[4], rb[4];
#pragma unroll
    for (int q = 0; q < 4; ++q) {
      const uint4* rp = reinterpret_cast<const uint4*>(p.P + (row0 + q) * PW + O_RF + dir * 16);
      ra[q] = rp[0]; rb[q] = rp[1];
    }
#pragma unroll
    for (int q = 0; q < 4; ++q) {
      const unsigned rw[8] = {ra[q].x, ra[q].y, ra[q].z, ra[q].w, rb[q].x, rb[q].y, rb[q].z, rb[q].w};
      float z[4] = {gb[0], gb[1], gb[2], gb[3]};
#pragma unroll
      for (int r2 = 0; r2 < 8; ++r2) {
        const float x0 = bf_lo(rw[r2]), x1 = bf_hi(rw[r2]);
#pragma unroll
        for (int c = 0; c < 4; ++c) z[c] += x0 * gw[2 * r2][c] + x1 * gw[2 * r2 + 1][c];
      }
      float o[4];
#pragma unroll
      for (int c = 0; c < 4; ++c) o[c] = (fminf(z[c], 0.f) - __logf(1.0f + __expf(-fabsf(z[c])))) * (1.0f / 16.0f);
      *reinterpret_cast<uint2*>(p.LF + ((long)dir * NR + row0 + q) * 384 + cg * 4) = make_uint2(pack2(o[0], o[1]), pack2(o[2], o[3]));
    }
  }
}

__device__ __forceinline__ void phase_hgrn_gate(const Params& p, long gtid, long gstride) {
  for (long i = gtid; i < (long)NR * 1024; i += gstride) {
    const int col = (int)(i & 1023);
    const long row = i >> 10;
    act_t* z = p.P + row * PW + E_FF + col;
    const float lb = p.lbt[col];
    const float f = lb + (1.0f - lb) * sigmoidf_(ldA(z));
    stA(z, __logf(f));
  }
}

template <int MODE>
__device__ __forceinline__ void phase_scan(const Params& p, unsigned char* smem, int blk, int nblk) {
  constexpr int DK = MODE == 0 ? 128 : 96, DV = MODE == 0 ? 128 : 192, DVS = DV / 4, NET = DVS / 16, NKS = DK / 32,
                NDT = DK / 16;
  constexpr int QS = DK + 8, LS = 72, SS = DK + 8;
  act_t* Qa = (act_t*)smem;
  act_t* Ka = Qa + 64 * QS;
  act_t* KaT = Ka + 64 * QS;
  act_t* VT = KaT + DK * LS;
  act_t* ST = VT + DVS * LS;
  float* tot = (float*)(ST + DVS * SS);
  float* lf32 = tot + 2 * 4 * DK;
  const int tid = threadIdx.x, w = __builtin_amdgcn_readfirstlane(threadIdx.x >> 6), lane = tid & 63, fr = lane & 15, g = lane >> 4;
  const int dp = lane, c0 = 2 * dp;
  const bool cact = dp < DK / 2;
  constexpr int NCH = (C + T) / 64, NCC = C / 64;
  constexpr int NVI = DVS / 8 * 64;
  for (int item = blk; item < NB * 4 * 2 * 4; item += nblk) {
    const int sl = item & 3, dir = (item >> 2) & 1, h = (item >> 3) & 3, b = item >> 5;
    act_t* OD = dir == 0 ? p.OF : p.OB;
    const unsigned loff = (unsigned)min(c0, DK - 2) * 2u;
    const int vcol = (MODE == 0 ? E_HI + h * 128 : O_V + h * 192) + sl * DVS;
    const int ocol = h * DV + sl * DVS;
    auto chunk_base = [&](int n) -> long {
      if (n < NCC) return (long)b * C + (dir ? NCC - 1 - n : n) * 64;
      const int ln = n - NCC;
      return (long)NC + (long)b * T + (dir ? T / 64 - 1 - ln : ln) * 64;
    };
    auto lrow = [&](long base, int l) -> long { return base + (dir ? 63 - l : l); };
    f32x4 S[NET][2];
#pragma unroll
    for (int et = 0; et < NET; ++et) { S[et][0] = f32x4{0.f, 0.f, 0.f, 0.f}; S[et][1] = f32x4{0.f, 0.f, 0.f, 0.f}; }
    unsigned rlf[16], rq[16], rk[16];
    uint4 rv[2];
    auto issue_loads = [&](int n) {
      const long base = chunk_base(n);
      {
#pragma unroll
        for (int i = 0; i < 16; ++i) {
          const long row = lrow(base, w * 16 + i);
          const char* prow = (const char*)(p.P + row * PW);
          if (MODE == 0) {
            rlf[i] = *reinterpret_cast<const unsigned*>(prow + (E_FF + dir * 512 + h * 128) * 2 + loff);
            rq[i] = *reinterpret_cast<const unsigned*>(prow + (E_HQ + h * 128) * 2 + loff);
          } else {
            rlf[i] = *reinterpret_cast<const unsigned*>((const char*)(p.LF + ((long)dir * NR + row) * 384 + h * 96) + loff);
            rk[i] = *reinterpret_cast<const unsigned*>(prow + (O_K + h * 96) * 2 + loff);
            rq[i] = *reinterpret_cast<const unsigned*>(prow + (O_Q + h * 96) * 2 + loff);
          }
        }
      }
#pragma unroll
      for (int r = 0; r < (NVI + 255) / 256; ++r) {
        const int it = min(tid + r * 256, NVI - 1);
        const int l = it / (DVS / 8), e8 = (it % (DVS / 8)) * 8;
        rv[r] = *reinterpret_cast<const uint4*>(p.P + lrow(base, l) * PW + vcol + e8);
      }
    };
    issue_loads(0);
    for (int n = 0; n < NCH; ++n) {
      const int par = n & 1;
      float* totp = tot + par * 4 * DK;
      float* lfp = lf32 + par * DK;
      const long base = chunk_base(n);
      if (cact) {
        float r0 = 0.f, r1 = 0.f;
#pragma unroll
        for (int i = 0; i < 16; ++i) { r0 += bf_lo(rlf[i]); r1 += bf_hi(rlf[i]); }
        totp[w * DK + c0] = r0; totp[w * DK + c0 + 1] = r1;
        if (w == 2) { lfp[c0] = bf_lo(rlf[0]); lfp[c0 + 1] = bf_hi(rlf[0]); }
      }
      __syncthreads();
#pragma unroll
      for (int r = 0; r < (NVI + 255) / 256; ++r) {
        const int it = tid + r * 256;
        if (it < NVI) {
          const int l = it / (DVS / 8), e8 = (it % (DVS / 8)) * 8;
          const unsigned vw[4] = {rv[r].x, rv[r].y, rv[r].z, rv[r].w};
#pragma unroll
          for (int e = 0; e < 4; ++e) {
            VT[(e8 + 2 * e) * LS + l] = (act_t)(vw[e] & 0xffffu);
            VT[(e8 + 2 * e + 1) * LS + l] = (act_t)(vw[e] >> 16);
          }
        }
      }
      if (cact) {
        float of0 = 0.f, of1 = 0.f;
#pragma unroll
        for (int sgi = 0; sgi < 3; ++sgi)
          if (sgi < w) { of0 += totp[sgi * DK + c0]; of1 += totp[sgi * DK + c0 + 1]; }
        const float ref0 = totp[c0] + totp[DK + c0] + lfp[c0];
        const float ref1 = totp[c0 + 1] + totp[DK + c0 + 1] + lfp[c0 + 1];
        float run0 = of0 - ref0, run1 = of1 - ref1;
#pragma unroll
        for (int i = 0; i < 16; i += 2) {
          float ka0[2], ka1[2];
#pragma unroll
          for (int ii = 0; ii < 2; ++ii) {
            const int i2 = i + ii;
            run0 += bf_lo(rlf[i2]); run1 += bf_hi(rlf[i2]);
            const float b0 = run0, b1 = run1;
            const float e0 = __expf(b0), e1 = __expf(b1), f0 = __expf(-b0), f1 = __expf(-b1);
            float k0, k1;
            if (MODE == 0) { k0 = 1.0f - __expf(bf_lo(rlf[i2])); k1 = 1.0f - __expf(bf_hi(rlf[i2])); }
            else { k0 = bf_lo(rk[i2]); k1 = bf_hi(rk[i2]); }
            ka0[ii] = k0 * f0; ka1[ii] = k1 * f1;
            const int l = w * 16 + i2;
            *reinterpret_cast<unsigned*>(Qa + l * QS + c0) = pack2(bf_lo(rq[i2]) * e0, bf_hi(rq[i2]) * e1);
            *reinterpret_cast<unsigned*>(Ka + l * QS + c0) = pack2(ka0[ii], ka1[ii]);
          }
          *reinterpret_cast<unsigned*>(KaT + c0 * LS + w * 16 + i) = pack2(ka0[0], ka0[1]);
          *reinterpret_cast<unsigned*>(KaT + (c0 + 1) * LS + w * 16 + i) = pack2(ka1[0], ka1[1]);
        }
      }
      issue_loads(min(n + 1, NCH - 1));
      float egv[2], egrv[2];
#pragma unroll
      for (int di = 0; di < 2; ++di) {
        const int dt = w + 4 * di;
        if (dt < NDT) {
          const int d = dt * 16 + fr;
          const float refd = totp[d] + totp[DK + d] + lfp[d];
          const float gd = totp[d] + totp[DK + d] + totp[2 * DK + d] + totp[3 * DK + d];
          const float er = __expf(refd);
          egv[di] = __expf(gd); egrv[di] = __expf(gd - refd);
#pragma unroll
          for (int et = 0; et < NET; ++et)
#pragma unroll
            for (int j = 0; j < 4; ++j) stA(ST + (et * 16 + 4 * g + j) * SS + d, S[et][di][j] * er);
        }
      }
      __syncthreads();
      bf16x8 qfr[NKS];
#pragma unroll
      for (int ks = 0; ks < NKS; ++ks) qfr[ks] = *reinterpret_cast<const bf16x8*>(Qa + (w * 16 + fr) * QS + ks * 32 + g * 8);
      bf16x8 pfr[2];
#pragma unroll
      for (int kb = 0; kb < 2; ++kb) {
        f32x4 at2[2];
#pragma unroll
        for (int h2 = 0; h2 < 2; ++h2) {
          const int mt = 2 * kb + h2;
          at2[h2] = f32x4{0.f, 0.f, 0.f, 0.f};
          if (mt <= w) {
#pragma unroll
            for (int ks = 0; ks < NKS; ++ks) {
              const bf16x8 kaf = *reinterpret_cast<const bf16x8*>(Ka + (mt * 16 + fr) * QS + ks * 32 + g * 8);
              at2[h2] = __builtin_amdgcn_mfma_f32_16x16x32_bf16(kaf, qfr[ks], at2[h2], 0, 0, 0);
            }
            if (mt == w) {
#pragma unroll
              for (int j = 0; j < 4; ++j)
                if (4 * g + j > fr) at2[h2][j] = 0.f;
            }
          }
        }
        union { unsigned u[4]; bf16x8 v; } cv;
        cv.u[0] = pack2_mfma(at2[0][0], at2[0][1]); cv.u[1] = pack2_mfma(at2[0][2], at2[0][3]);
        cv.u[2] = pack2_mfma(at2[1][0], at2[1][1]); cv.u[3] = pack2_mfma(at2[1][2], at2[1][3]);
        pfr[kb] = cv.v;
      }
      const long orow = lrow(base, w * 16 + fr);
#pragma unroll
      for (int et = 0; et < NET; ++et) {
        f32x4 o = f32x4{0.f, 0.f, 0.f, 0.f};
#pragma unroll
        for (int kb = 0; kb < 2; ++kb) {
          if (2 * kb <= w) {
            union { uint2 h2[2]; bf16x8 v; } vf;
            vf.h2[0] = *reinterpret_cast<const uint2*>(VT + (et * 16 + fr) * LS + kb * 32 + 4 * g);
            vf.h2[1] = *reinterpret_cast<const uint2*>(VT + (et * 16 + fr) * LS + kb * 32 + 16 + 4 * g);
            o = __builtin_amdgcn_mfma_f32_16x16x32_bf16(vf.v, pfr[kb], o, 0, 0, 0);
          }
        }
#pragma unroll
        for (int ks = 0; ks < NKS; ++ks) {
          const bf16x8 sf = *reinterpret_cast<const bf16x8*>(ST + (et * 16 + fr) * SS + ks * 32 + g * 8);
          o = __builtin_amdgcn_mfma_f32_16x16x32_bf16(sf, qfr[ks], o, 0, 0, 0);
        }
        const float osc = MODE == 0 ? 1.0f : 0.10206207261596575f;
        *reinterpret_cast<uint2*>(OD + orow * 768 + ocol + et * 16 + 4 * g) =
            make_uint2(pack2(o[0] * osc, o[1] * osc), pack2(o[2] * osc, o[3] * osc));
      }
#pragma unroll
      for (int di = 0; di < 2; ++di) {
        const int dt = w + 4 * di;
        if (dt < NDT) {
#pragma unroll
          for (int et = 0; et < NET; ++et) {
            f32x4 r = f32x4{0.f, 0.f, 0.f, 0.f};
#pragma unroll
            for (int k2 = 0; k2 < 2; ++k2) {
              const bf16x8 vf = *reinterpret_cast<const bf16x8*>(VT + (et * 16 + fr) * LS + k2 * 32 + g * 8);
              const bf16x8 kf = *reinterpret_cast<const bf16x8*>(KaT + (dt * 16 + fr) * LS + k2 * 32 + g * 8);
              r = __builtin_amdgcn_mfma_f32_16x16x32_bf16(vf, kf, r, 0, 0, 0);
            }
#pragma unroll
            for (int j = 0; j < 4; ++j) S[et][di][j] = egv[di] * S[et][di][j] + egrv[di] * r[j];
          }
        }
      }
    }
    __syncthreads();
  }
}

struct GemmJob {
  const act_t* A; const act_t* Bt; act_t* C;
  long sA, sB, sC;
  int nbatch, Mtiles, Ntiles, K, ldc, Nvalid, mode;
  float scale;
};
__device__ __forceinline__ void phase_gemm(const Params& p, const GemmJob& g, unsigned char* smem, int blk = blockIdx.x, int nblk = gridDim.x) {
  const int per_b = g.Mtiles * g.Ntiles;
  const int ntiles = per_b * g.nbatch;
  for (int tile = blk; tile < ntiles; tile += nblk) {
    const int b = tile / per_b, tt = tile % per_b;
    const int tm = tt / g.Ntiles, tn = tt % g.Ntiles;
    if (g.mode == 1 && tm < NC / 128 && tn * 128 >= O_FA) continue;
    const int K = g.K, ldc = g.ldc;
    const act_t* Ab = g.A + b * g.sA + (long)tm * 128 * K;
    act_t* Cb = g.C + b * g.sC + (long)tm * 128 * ldc + tn * 128;
    const int nlim = g.Nvalid - tn * 128;
    const float scale = g.scale;
    const int mode = g.mode;
    gemm_tile([&](int r) { return Ab + (long)r * K; }, g.Bt + b * g.sB + (long)tn * 128 * K, K, smem,
              [&](f32x4 (&acc)[4][4], int wr, int wc, int fr, int fq) {
                if (mode == 2) {
                  const int cb = tn * 128 + wc * 64;
                  if (cb < E_AV && tm >= NC / 128) {
                    const float2* rt = reinterpret_cast<const float2*>(p.ropetab);
#pragma unroll
                    for (int m = 0; m < 4; ++m)
#pragma unroll
                      for (int j = 0; j < 4; ++j) {
                        const int t = ((tm - NC / 128) * 128 + wr * 64 + m * 16 + fq * 4 + j) % T;
                        const float2 cr = rt[(t / GRID_W) * 16 + fr], cc = rt[(t % GRID_W) * 16 + fr];
                        const float a1 = acc[m][0][j], a2 = acc[m][1][j], b1 = acc[m][2][j], b2 = acc[m][3][j];
                        acc[m][0][j] = a1 * cr.x - a2 * cr.y; acc[m][1][j] = a1 * cr.y + a2 * cr.x;
                        acc[m][2][j] = b1 * cc.x - b2 * cc.y; acc[m][3][j] = b1 * cc.y + b2 * cc.x;
                      }
                  } else if (cb >= E_FF && cb < E_HQ) {
#pragma unroll
                    for (int n = 0; n < 4; ++n) {
                      const float lb = p.lbt[cb - E_FF + n * 16 + fr];
#pragma unroll
                      for (int m = 0; m < 4; ++m)
#pragma unroll
                        for (int j = 0; j < 4; ++j)
                          acc[m][n][j] = __logf(lb + (1.0f - lb) / (1.0f + __expf(-acc[m][n][j])));
                    }
                  }
                }
#pragma unroll
                for (int m = 0; m < 4; ++m)
#pragma unroll
                  for (int n = 0; n < 4; ++n) {
                    const int col = wc * 64 + n * 16 + fr;
                    if (col < nlim) {
#pragma unroll
                      for (int j = 0; j < 4; ++j) {
                        const int row = wr * 64 + m * 16 + fq * 4 + j;
                        stA(Cb + (long)row * ldc + col, acc[m][n][j] * scale);
                      }
                    } else if (mode == 1) {
                      const int gc = tn * 128 + col;
                      if (gc < O_END && tm >= NC / 128) {
                        const int lr = (tm - NC / 128) * 128 + wr * 64 + m * 16 + fq * 4;
                        const int bb = lr / T, t = lr % T;
                        const int cq = gc < O_FB ? gc - O_FA : gc - O_FB;
                        act_t* dst = p.FT + ((long)bb * 256 + cq) * (2 * T) + (gc < O_FB ? 0 : T) + t;
                        *reinterpret_cast<uint2*>(dst) = make_uint2(pack2(acc[m][n][0], acc[m][n][1]), pack2(acc[m][n][2], acc[m][n][3]));
                      }
                    }
                  }
              });
  }
}

template <class RowMap>
__device__ __forceinline__ void conv_tile_rm(const float* src, int lds_, int Nvalid, int k0, int n0, act_t* dst, int ldd, float* tile, RowMap rm) {
  const int tid = threadIdx.x;
  {
    const int r = tid >> 5, c4 = (tid & 31) * 4;
    float4 v[8];
#pragma unroll
    for (int rr = 0; rr < 8; ++rr) {
      v[rr] = make_float4(0.f, 0.f, 0.f, 0.f);
      if (n0 + c4 < Nvalid) v[rr] = *reinterpret_cast<const float4*>(src + (long)(k0 + r + rr * 8) * lds_ + n0 + c4);
    }
#pragma unroll
    for (int rr = 0; rr < 8; ++rr) {
      float* t = tile + (r + rr * 8) * 129 + c4;
      t[0] = v[rr].x; t[1] = v[rr].y; t[2] = v[rr].z; t[3] = v[rr].w;
    }
  }
  __syncthreads();
  {
    const int n = tid >> 1, ks = (tid & 1) * 32;
    if (n0 + n < Nvalid) {
      unsigned w[16];
#pragma unroll
      for (int i = 0; i < 16; ++i) w[i] = pack2(tile[(ks + 2 * i) * 129 + n], tile[(ks + 2 * i + 1) * 129 + n]);
      uint4* d = reinterpret_cast<uint4*>(dst + (long)rm(n) * ldd + k0 + ks);
      d[0] = make_uint4(w[0], w[1], w[2], w[3]);
      d[1] = make_uint4(w[4], w[5], w[6], w[7]);
      d[2] = make_uint4(w[8], w[9], w[10], w[11]);
      d[3] = make_uint4(w[12], w[13], w[14], w[15]);
    }
  }
  __syncthreads();
}

__device__ __forceinline__ void conv_tile(const float* src, int lds_, int Nvalid, int k0, int n0, act_t* dst, int ldd, float* tile) {
  conv_tile_rm(src, lds_, Nvalid, k0, n0, dst, ldd, tile, [=](int n) { return n0 + n; });
}

__device__ __forceinline__ void phase_convert_experts(const Params& p, int l, unsigned char* smem, int blk, int nblk) {
  float* tile = (float*)smem;
  const int per_e = 192;
  act_t* Wup = l == 0 ? p.Wt_up : p.Wt_up1;
  act_t* Wdn = l == 0 ? p.Wt_down : p.Wt_down1;
  for (int job = blk; job < NEXP * per_e; job += nblk) {
    const int e = job / per_e, j = job % per_e;
    if (j < 128) {
      const int up = j >> 6, jj = j & 63;
      const int kt = jj >> 2, fp = jj & 3;
      const float* src = (up ? p.w_eu : p.w_eg) + ((long)(l * NEXP + e) * D) * DFF;
      const int rbase = fp * 256 + up * 32;
      conv_tile_rm(src, DFF, DFF, kt * 64, fp * 128, Wup + (long)e * 1024 * D, D, tile,
                   [=](int n) { return rbase + (n >> 6) * 128 + ((n >> 5) & 1) * 64 + (n & 31); });
    } else {
      const int jj = j - 128;
      const int kt = jj >> 3, nt = jj & 7;
      const float* src = p.w_ed + ((long)(l * NEXP + e) * DFF) * D;
      conv_tile(src, D, D, kt * 64, nt * 128, Wdn + (long)e * 1024 * DFF, DFF, tile);
    }
  }
}

__device__ __forceinline__ void phase_moe(const Params& p, int l, bool down, unsigned char* smem) {
  const int* cntp = p.cnt + l * NEXP * 64;
  int total = 0;
  for (int e = 0; e < NEXP; ++e) total += ((cntp[e * 64] + 127) >> 7) * 8;
  for (int tile = blockIdx.x; tile < total; tile += gridDim.x) {
    int e = 0, tb = 0, rowoff = 0;
    for (; e < NEXP - 1; ++e) {
      const int c = cntp[e * 64];
      const int nt = ((c + 127) >> 7) * 8;
      if (tile < tb + nt) break;
      tb += nt; rowoff += c;
    }
    const int c = cntp[e * 64];
    const int lt = tile - tb, mt = lt >> 3, nt = lt & 7;
    const int rows_valid = min(128, c - mt * 128);
    const int* lst = p.list + (long)(l * NEXP + e) * NR + mt * 128;
    const long hrow0 = (long)rowoff + mt * 128;
    if (!down) {
      gemm_tile([&](int r) { return p.u + (long)(lst[min(r, rows_valid - 1)] >> 1) * D; },
                (l == 0 ? p.Wt_up : p.Wt_up1) + ((long)e * 1024 + nt * 128) * D, D, smem,
                [&](f32x4 (&acc)[4][4], int wr, int wc, int fr, int fq) {
#pragma unroll
                  for (int m = 0; m < 4; ++m)
#pragma unroll
                    for (int j = 0; j < 4; ++j) {
                      const int row = wr * 64 + m * 16 + fq * 4 + j;
                      if (row < rows_valid) {
#pragma unroll
                        for (int n = 0; n < 2; ++n) {
                          const float g = acc[m][n][j], uu = acc[m][n + 2][j];
                          stA(p.H + (hrow0 + row) * DFF + nt * 64 + wc * 32 + n * 16 + fr, g / (1.0f + __expf(-g)) * uu);
                        }
                      }
                    }
                });
    } else {
      const act_t* Ab = p.H + hrow0 * DFF;
      gemm_tile([&](int r) { return Ab + (long)r * DFF; }, (l == 0 ? p.Wt_down : p.Wt_down1) + ((long)e * 1024 + nt * 128) * DFF, DFF, smem,
                [&](f32x4 (&acc)[4][4], int wr, int wc, int fr, int fq) {
#pragma unroll
                  for (int m = 0; m < 4; ++m)
#pragma unroll
                    for (int j = 0; j < 4; ++j) {
                      const int row = wr * 64 + m * 16 + fq * 4 + j;
                      if (row < rows_valid) {
                        const int ts = lst[row];
                        const float w = p.ew[ts];
#pragma unroll
                        for (int n = 0; n < 4; ++n)
                          stA(p.Y + (long)ts * D + nt * 128 + wc * 64 + n * 16 + fr, acc[m][n][j] * w);
                      }
                    }
                });
    }
  }
}

__device__ __forceinline__ void phase_convert_dense(const Params& p, unsigned char* smem) {
  float* tile = (float*)smem;
  const int JM = 48, J0 = JM + 16 * 26, J1 = J0 + 128, J2 = J1 + 16 * 19, J3 = J2 + 128;
  for (int job = blockIdx.x; job < J3; job += gridDim.x) {
    if (job < JM) { mod_item(p, job, smem); continue; }
    if (job < J0) { int j = job - JM; conv_tile(p.w_in_even, IN_EVEN, IN_EVEN, (j / 26) * 64, (j % 26) * 128, p.Wt_in_even, D, tile); }
    else if (job < J1) { int j = job - J0; conv_tile(p.w_out_even, D, D, (j / 8) * 64, (j % 8) * 128, p.Wt_out_even, D, tile); }
    else if (job < J2) { int j = job - J1; conv_tile(p.w_in_odd, IN_ODD, O_FA, (j / 19) * 64, (j % 19) * 128, p.Wt_in_odd, D, tile); }
    else { int j = job - J2; conv_tile(p.w_out_odd, D, D, (j / 8) * 64, (j % 8) * 128, p.Wt_out_odd, D, tile); }
  }
}

__device__ __forceinline__ void phase_fold_z(const Params& p, long gtid, long gstride, float* tab) {
  if (threadIdx.x < 64) {
    float sn, cs;
    sincospif((float)threadIdx.x * (1.0f / 32.0f), &sn, &cs);
    tab[threadIdx.x] = cs; tab[64 + threadIdx.x] = -sn;
  }
  __syncthreads();
  for (long i = gtid; i < (long)512 * D; i += gstride) {
    const int k = (int)(i % D), np = (int)(i / D);
    const int part = np >> 8, col = np & 255, g = col >> 6, cp = col & 63;
    const float* wz = p.w_in_odd + (long)k * IN_ODD + O_Z + g * 64;
    float s = 0.f;
    const float* tb = tab + part * 64;
#pragma unroll 8
    for (int c = 0; c < 64; ++c) s += wz[c] * tb[(c * cp) & 63];
    stA(p.Wt_in_odd + (long)(O_FA + np) * D + k, s);
  }
  for (long i = gtid; i < (long)(IN_ODD_PAD - O_END) * D; i += gstride) p.Wt_in_odd[(long)O_END * D + i] = 0;
}

__device__ __forceinline__ void phase_cmat(const Params& p, long gtid, long gstride) {
  for (long i = gtid; i < (long)T * T; i += gstride) {
    const int t = (int)(i % T), tp = (int)(i / T);
    float sn, cs;
    sincospif((float)((t * tp) & (T - 1)) * (2.0f / T), &sn, &cs);
    stA(p.Cmat + (long)tp * 2 * T + t, cs);
    stA(p.Cmat + (long)tp * 2 * T + T + t, sn);
  }
}

__device__ __forceinline__ void row_stats(const float4 (&v)[4], float& mu, float& rs) {
  float s = 0.f;
#pragma unroll
  for (int i = 0; i < 4; ++i) s += v[i].x + v[i].y + v[i].z + v[i].w;
  mu = wave_sum(s) * (1.0f / D);
  float q = 0.f;
#pragma unroll
  for (int i = 0; i < 4; ++i) {
    float a = v[i].x - mu, b = v[i].y - mu, c = v[i].z - mu, d = v[i].w - mu;
    q += a * a + b * b + c * c + d * d;
  }
  rs = 1.0f / sqrtf(wave_sum(q) * (1.0f / D) + LN_EPS);
}

__device__ __forceinline__ void phase_lnmod_first(const Params& p) {
  const int lane = threadIdx.x & 63;
  const long w0 = (long)blockIdx.x * 4 + (threadIdx.x >> 6), wstride = (long)gridDim.x * 4;
  for (long row = w0; row < NR; row += wstride) {
    const float4* h = reinterpret_cast<const float4*>(hrow_in(p, row));
    const float* md = modrow(p, 0, row);
    float4 v[4];
#pragma unroll
    for (int i = 0; i < 4; ++i) v[i] = h[i * 64 + lane];
    float mu, rs;
    row_stats(v, mu, rs);
#pragma unroll
    for (int i = 0; i < 4; ++i) {
      const float4 sh = reinterpret_cast<const float4*>(md)[i * 64 + lane];
      const float4 sc = reinterpret_cast<const float4*>(md + D)[i * 64 + lane];
      float a = (v[i].x - mu) * rs * (1.f + sc.x) + sh.x, b = (v[i].y - mu) * rs * (1.f + sc.y) + sh.y;
      float c = (v[i].z - mu) * rs * (1.f + sc.z) + sh.z, d = (v[i].w - mu) * rs * (1.f + sc.w) + sh.w;
      reinterpret_cast<uint2*>(p.u + row * D)[i * 64 + lane] = make_uint2(pack2(a, b), pack2(c, d));
    }
  }
}

template <int R>
__device__ __forceinline__ void phase_resid_ln(const Params& p, int l, int sub, long row_lo, long row_hi, unsigned char* smem) {
  const int lane = threadIdx.x & 63;
  int* cntL = (int*)smem;
  int* nent = cntL + 16;
  int* entL = cntL + 32;
  float* wT = (float*)(smem + 4096);
  if (sub == 0) {
    if (threadIdx.x < 32) cntL[threadIdx.x] = 0;
    for (int i = threadIdx.x; i < D * NEXP; i += 256) wT[(i & 15) * D + (i >> 4)] = p.w_router[i];
    __syncthreads();
  }
  const long w0 = (long)blockIdx.x * 4 + (threadIdx.x >> 6), wstride = (long)gridDim.x * 4;
  const bool last = (sub == 1 && l == 1);
  const float4* lgp = reinterpret_cast<const float4*>(p.ln_g + (l * 2 + sub) * D);
  const float4* lbp = reinterpret_cast<const float4*>(p.ln_b + (l * 2 + sub) * D);
  for (long rowA = row_lo + w0; rowA < row_hi; rowA += R * wstride) {
    long rows[R];
    bool val[R];
    rows[0] = rowA; val[0] = true;
    if (R == 2) { val[R - 1] = rowA + wstride < row_hi; rows[R - 1] = val[R - 1] ? rowA + wstride : rowA; }
    float4 v[R][4];
    const float* md[R];
#pragma unroll
    for (int rr = 0; rr < R; ++rr) {
      const long row = rows[rr];
      const float4* hin = reinterpret_cast<const float4*>((l == 0 && sub == 0) ? hrow_in(p, row) : hrow(p, row));
      md[rr] = modrow(p, l, row);
      const float4* g = reinterpret_cast<const float4*>(md[rr] + (sub == 0 ? 2 : 5) * D);
      const uint2* m = reinterpret_cast<const uint2*>(sub == 0 ? p.M + row * D : p.Y + row * 2 * D);
      const uint2* m2 = reinterpret_cast<const uint2*>(p.Y + (row * 2 + 1) * D);
#pragma unroll
      for (int i = 0; i < 4; ++i) {
        const float4 hv = hin[i * 64 + lane];
        const float4 gv = g[i * 64 + lane];
        const uint2 mv = m[i * 64 + lane];
        float m0 = bf_lo(mv.x), m1 = bf_hi(mv.x), m2_ = bf_lo(mv.y), m3 = bf_hi(mv.y);
        if (sub == 1) {
          const uint2 mw = m2[i * 64 + lane];
          m0 += bf_lo(mw.x); m1 += bf_hi(mw.x); m2_ += bf_lo(mw.y); m3 += bf_hi(mw.y);
        }
        v[rr][i].x = ALPHA * hv.x + gv.x * m0;
        v[rr][i].y = ALPHA * hv.y + gv.y * m1;
        v[rr][i].z = ALPHA * hv.z + gv.z * m2_;
        v[rr][i].w = ALPHA * hv.w + gv.w * m3;
      }
    }
    float mu[R], rs[R];
#pragma unroll
    for (int rr = 0; rr < R; ++rr) row_stats(v[rr], mu[rr], rs[rr]);
#pragma unroll
    for (int rr = 0; rr < R; ++rr) {
      float4* hout = reinterpret_cast<float4*>(hrow(p, rows[rr]));
#pragma unroll
      for (int i = 0; i < 4; ++i) {
        const float4 lga = lgp[i * 64 + lane], lba = lbp[i * 64 + lane];
        v[rr][i].x = (v[rr][i].x - mu[rr]) * rs[rr] * lga.x + lba.x;
        v[rr][i].y = (v[rr][i].y - mu[rr]) * rs[rr] * lga.y + lba.y;
        v[rr][i].z = (v[rr][i].z - mu[rr]) * rs[rr] * lga.z + lba.z;
        v[rr][i].w = (v[rr][i].w - mu[rr]) * rs[rr] * lga.w + lba.w;
        if (val[rr]) hout[i * 64 + lane] = v[rr][i];
      }
    }
    if (last) continue;
#pragma unroll
    for (int rr = 0; rr < R; ++rr) row_stats(v[rr], mu[rr], rs[rr]);
    float lo[R][NEXP];
#pragma unroll
    for (int rr = 0; rr < R; ++rr)
#pragma unroll
      for (int e = 0; e < NEXP; ++e) lo[rr][e] = 0.f;
#pragma unroll
    for (int i = 0; i < 4; ++i) {
      float uv[R][4];
#pragma unroll
      for (int rr = 0; rr < R; ++rr) {
        const float* md2 = (sub == 0) ? md[rr] + 3 * D : modrow(p, 1, rows[rr]);
        const float4 sh = reinterpret_cast<const float4*>(md2)[i * 64 + lane];
        const float4 sc = reinterpret_cast<const float4*>(md2 + D)[i * 64 + lane];
        uv[rr][0] = (v[rr][i].x - mu[rr]) * rs[rr] * (1.f + sc.x) + sh.x;
        uv[rr][1] = (v[rr][i].y - mu[rr]) * rs[rr] * (1.f + sc.y) + sh.y;
        uv[rr][2] = (v[rr][i].z - mu[rr]) * rs[rr] * (1.f + sc.z) + sh.z;
        uv[rr][3] = (v[rr][i].w - mu[rr]) * rs[rr] * (1.f + sc.w) + sh.w;
        if (val[rr])
          reinterpret_cast<uint2*>(p.u + rows[rr] * D)[i * 64 + lane] = make_uint2(pack2(uv[rr][0], uv[rr][1]), pack2(uv[rr][2], uv[rr][3]));
      }
      if (sub == 0) {
#pragma unroll
        for (int e = 0; e < NEXP; ++e) {
          const float4 w4 = *reinterpret_cast<const float4*>(wT + e * D + (i * 64 + lane) * 4);
#pragma unroll
          for (int rr = 0; rr < R; ++rr)
            lo[rr][e] += uv[rr][0] * w4.x + uv[rr][1] * w4.y + uv[rr][2] * w4.z + uv[rr][3] * w4.w;
          if ((e & 3) == 3) __builtin_amdgcn_sched_barrier(0);
        }
      }
    }
    if (sub != 0) continue;
#pragma unroll
    for (int rr = 0; rr < R; ++rr) {
      float mine = 0.f;
#pragma unroll
      for (int e = 0; e < NEXP; ++e) {
        const float rsum = row_sum16(lo[rr][e]);
        mine = ((lane & 15) == e) ? rsum : mine;
      }
      mine += __shfl_xor(mine, 16);
      mine += __shfl_xor(mine, 32);
#pragma unroll
      for (int e = 0; e < NEXP; ++e) lo[rr][e] = __int_as_float(__builtin_amdgcn_readlane(__float_as_int(mine), e));
    }
#pragma unroll
    for (int rr = 0; rr < R; ++rr) {
      if (lane == 0 && val[rr]) {
        const long row = rows[rr];
        float mx = lo[rr][0];
#pragma unroll
        for (int e = 1; e < NEXP; ++e) mx = fmaxf(mx, lo[rr][e]);
        float sum = 0.f;
#pragma unroll
        for (int e = 0; e < NEXP; ++e) { lo[rr][e] = expf(lo[rr][e] - mx); sum += lo[rr][e]; }
        const float inv = 1.0f / sum;
        float bestg = -1e30f, gp1 = 0.f, gp2 = 0.f;
        int ge1 = 0, ge2 = 0;
#pragma unroll
        for (int gq = 0; gq < 4; ++gq) {
          float s1 = -1e30f, s2 = -1e30f, p1 = 0.f, p2 = 0.f;
          int e1 = 0, e2 = 0;
#pragma unroll
          for (int j = 0; j < 4; ++j) {
            const int e = gq * 4 + j;
            const float pe = lo[rr][e] * inv;
            const float se = pe + p.b_router[e];
            if (se > s1) { s2 = s1; p2 = p1; e2 = e1; s1 = se; p1 = pe; e1 = e; }
            else if (se > s2) { s2 = se; p2 = pe; e2 = e; }
          }
          const float gs = s1 + s2;
          if (gs > bestg) { bestg = gs; ge1 = e1; ge2 = e2; gp1 = p1; gp2 = p2; }
        }
        const float wsum = gp1 + gp2;
        p.ew[row * 2 + 0] = gp1 / wsum; p.ew[row * 2 + 1] = gp2 / wsum;
        const int lp1 = atomicAdd(cntL + ge1, 1), lp2 = atomicAdd(cntL + ge2, 1);
        const int ei = atomicAdd(nent, 2);
        entL[2 * ei] = ((int)(row * 2) << 4) | ge1; entL[2 * ei + 1] = lp1;
        entL[2 * ei + 2] = ((int)(row * 2 + 1) << 4) | ge2; entL[2 * ei + 3] = lp2;
      }
    }
  }
  if (sub == 0) {
    __syncthreads();
    if (threadIdx.x < NEXP) {
      const int c = cntL[threadIdx.x];
      cntL[threadIdx.x] = c ? atomicAdd(p.cnt + (l * NEXP + threadIdx.x) * 64, c) : 0;
    }
    __syncthreads();
    const int ne = *nent;
    for (int i = threadIdx.x; i < ne; i += 256) {
      const int key = entL[2 * i], lp = entL[2 * i + 1];
      const int e = key & 15;
      p.list[(long)(l * NEXP + e) * NR + cntL[e] + lp] = key >> 4;
    }
    __syncthreads();
  }
}

#define LOOP(n) for (long i = gtid; i < (long)(n); i += gstride)

#ifdef ONLY_PHASE
#define PH(n, ...) if (ONLY_PHASE == n) { __VA_ARGS__ }
#define GSYNC()
#else
#define PH(n, ...) { __VA_ARGS__ }
#define GSYNC() xcd_barrier(xb)
#endif

__global__ void __launch_bounds__(256, 2) mega_kernel(Params p) {
  cg::grid_group grid = cg::this_grid();
  __shared__ __attribute__((aligned(16))) unsigned char smem[SMEM_BYTES + 16];
  if (threadIdx.x == 0) *reinterpret_cast<uint4*>(smem + SMEM_BYTES) = make_uint4(0u, 0u, 0u, 0u);
  __syncthreads();
  XcdBarrier xb = xcd_barrier_post(p.bar, (volatile LAS unsigned*)(smem + SMEM_BYTES));
  const long gtid = (long)blockIdx.x * blockDim.x + threadIdx.x;
  const long gstride = (long)gridDim.x * blockDim.x;
  const int nsb = min(256, (int)gridDim.x / 2);
  PH(0,
    if (gtid < 2 * NEXP) p.cnt[gtid * 64] = 0;
    phase_convert_dense(p, smem);
    phase_fold_z(p, gtid, gstride, (float*)(smem + 65536));
    LOOP(T > 1024 ? T : 1024) ph_tables(p, i);)
#ifndef ONLY_PHASE
  if (p.use_cg_sync) grid.sync();
#endif
  GSYNC();
  PH(1, phase_lnmod_first(p);)
  GSYNC();
  PH(2, phase_gemm(p, GemmJob{p.u, p.Wt_in_even, p.P, 0, 0, 0, 1, NR / 128, IN_EVEN / 128, D, PW, IN_EVEN, 2, 1.0f}, smem);)
  GSYNC();
  PH(3,
    if ((int)blockIdx.x < nsb) phase_scan<0>(p, smem, blockIdx.x, nsb);
    else { phase_attn(p, smem, blockIdx.x - nsb, gridDim.x - nsb); phase_convert_experts(p, 0, smem, blockIdx.x - nsb, gridDim.x - nsb); })
  GSYNC();
  PH(4, phase_combine<0>(p);)
  GSYNC();
  PH(5, phase_gemm(p, GemmJob{p.u, p.Wt_out_even, p.M, 0, 0, 0, 1, NR / 128, D / 128, D, D, D, 0, 1.0f}, smem);)
  GSYNC();
  PH(6, phase_resid_ln<1>(p, 0, 0, 0, NR, smem);)
  GSYNC();
  PH(7, phase_moe(p, 0, false, smem);)
  GSYNC();
  PH(8, phase_moe(p, 0, true, smem);)
  GSYNC();
  PH(9, phase_resid_ln<2>(p, 0, 1, 0, NR, smem); phase_cmat(p, gtid, gstride);)
  GSYNC();
  PH(10, phase_gemm(p, GemmJob{p.u, p.Wt_in_odd, p.P, 0, 0, 0, 1, NR / 128, IN_ODD_PAD / 128, D, PW, O_FA, 1, 1.0f}, smem);)
  GSYNC();
  PH(11, phase_gla_decay(p);)
  GSYNC();
  PH(12,
    if ((int)blockIdx.x < nsb) phase_scan<1>(p, smem, blockIdx.x, nsb);
    else {
      phase_gemm(p, GemmJob{p.Cmat, p.FT, p.u + (long)NC * D + 768, 0, (long)256 * 2 * T, (long)T * D, NB, T / 128, 2, 2 * T, D,
                            256, 0, 0.00276213586400995f}, smem, blockIdx.x - nsb, gridDim.x - nsb);
      phase_convert_experts(p, 1, smem, blockIdx.x - nsb, gridDim.x - nsb);
    })
  GSYNC();
  PH(13, phase_combine<1>(p);)
  GSYNC();
  PH(14,
    phase_gemm(p, GemmJob{p.u + (long)NC * D, p.Wt_out_odd, p.M + (long)NC * D, 0, 0, 0, 1, NT / 128, D / 128, D, D, D, 0, 1.0f}, smem);)
  GSYNC();
  PH(15, phase_resid_ln<1>(p, 1, 0, NC, NR, smem);)
  GSYNC();
  PH(16, phase_moe(p, 1, false, smem);)
  GSYNC();
  PH(17, phase_moe(p, 1, true, smem);)
  GSYNC();
  PH(18, phase_resid_ln<2>(p, 1, 1, NC, NR, smem);)
}

static size_t carve(Params& p, char* ws) {
  size_t off = 0;
  auto take = [&](size_t bytes) { char* r = ws + off; off += (bytes + 255) & ~(size_t)255; return r; };
  p.mod = (float*)take(sizeof(float) * 2 * (NB + 1) * 6 * D);
  p.hc = (float*)take(sizeof(float) * (size_t)NC * D);
  p.costab = (float*)take(sizeof(float) * T);
  p.sintab = (float*)take(sizeof(float) * T);
  p.lbt = (float*)take(sizeof(float) * 1024);
  p.ropetab = (float*)take(sizeof(float) * 64 * 16 * 2);
  p.ew = (float*)take(sizeof(float) * (size_t)NR * 2);
  p.eidx = nullptr;
  p.u = (act_t*)take(sizeof(act_t) * (size_t)NR * D);
  p.P = (act_t*)take(sizeof(act_t) * (size_t)NR * PW);
  p.OF = (act_t*)take(sizeof(act_t) * (size_t)NR * 768);
  p.OB = (act_t*)take(sizeof(act_t) * (size_t)NR * 768);
  p.M = p.OF;
  p.Cmat = (act_t*)take(sizeof(act_t) * (size_t)T * 2 * T);
  p.FT = (act_t*)take(sizeof(act_t) * (size_t)NB * 256 * 2 * T);
  p.LF = (act_t*)take(sizeof(act_t) * (size_t)2 * NR * 384);
  p.Wt_up = p.Cmat;
  p.Wt_down = p.Wt_up + (size_t)NEXP * 1024 * D;
  p.Wt_up1 = (act_t*)take(sizeof(act_t) * (size_t)NEXP * 1024 * (D + DFF));
  p.Wt_down1 = p.Wt_up1 + (size_t)NEXP * 1024 * D;
  p.Y = p.P;
  p.H = p.P + (size_t)2 * NR * D;
  p.bar = (unsigned*)take(sizeof(unsigned) * XCD_BAR_WORDS);
  p.cnt = (int*)take(sizeof(int) * 2 * NEXP * 64);
  p.list = (int*)take(sizeof(int) * (size_t)2 * NEXP * NR);
  p.Wt_in_even = (act_t*)take(sizeof(act_t) * (size_t)IN_EVEN * D);
  p.Wt_out_even = (act_t*)take(sizeof(act_t) * (size_t)D * D);
  p.Wt_in_odd = (act_t*)take(sizeof(act_t) * (size_t)IN_ODD_PAD * D);
  p.Wt_out_odd = (act_t*)take(sizeof(act_t) * (size_t)D * D);
  return off;
}

static void fill_inputs(Params& p, void* const* d_in) {
  const float** f = (const float**)&p;
  for (int i = 0; i < 23; ++i) f[i] = (const float*)d_in[i];
}

extern "C" void kernel_launch(void* const* d_in, const int* in_sizes, int n_in, void* d_out, int out_size,
                              void* d_ws, size_t ws_size, hipStream_t stream) {
  static int grid_blocks = 0;
  if (!grid_blocks) {
    int dev = 0, cus = 0, per_cu = 0;
    (void)hipGetDevice(&dev);
    (void)hipDeviceGetAttribute(&cus, hipDeviceAttributeMultiprocessorCount, dev);
    (void)hipOccupancyMaxActiveBlocksPerMultiprocessor(&per_cu, mega_kernel, 256, 0);
    grid_blocks = cus * per_cu;
  }
  Params p{};
  fill_inputs(p, d_in);
  p.out = (float*)d_out;
  size_t need = carve(p, (char*)d_ws);
  if (need > ws_size) { fprintf(stderr, "workspace too small: need %zu have %zu\n", need, ws_size); return; }
  (void)hipMemsetAsync(p.bar, 0, sizeof(unsigned) * XCD_BAR_WORDS, stream);
  void* args[] = {&p};
  hipError_t e = hipLaunchCooperativeKernel((void*)mega_kernel, dim3(grid_blocks), dim3(256), args, 0, stream);
  if (e != hipSuccess) fprintf(stderr, "cooperative launch failed: %s (grid %d)\n", hipGetErrorString(e), grid_blocks);
}
#endif
```

```cpp
#ifndef HOST_TEST
#include <hip/hip_runtime.h>
#include <hip/hip_cooperative_groups.h>
#include <cstdio>
namespace cg = cooperative_groups;
#define DEV __device__ __forceinline__
#else
#include <cmath>
#include <cstdio>
#include <cstdlib>
#include <cstring>
#define DEV static inline
#endif

#ifndef T_BATCH
#define T_BATCH 8
#endif
#ifndef T_SEQ
#define T_SEQ 2048
#endif
#ifndef T_CTX
#define T_CTX 256
#endif

constexpr int D = 1024, NB = T_BATCH, T = T_SEQ, C = T_CTX;
constexpr int NC = NB * C, NT = NB * T, NR = NC + NT;
constexpr int GRID_W = 64;
constexpr int IN_EVEN = 3328, IN_ODD = 2592, PW = 3328;
constexpr int NEXP = 16, DFF = 512;
constexpr float ALPHA = 1.4142135623730951f;
constexpr float LN_EPS = 1e-5f;
constexpr int E_AQ = 0, E_AK = 512, E_AV = 640, E_FF = 768, E_HQ = 1792, E_HI = 2304, E_HG = 2816;
constexpr int O_Q = 0, O_K = 384, O_V = 768, O_RF = 1536, O_G = 1568, O_Z = 2336;

#ifdef HOST_TEST
typedef float act_t;
DEV float ldA(const act_t* p) { return *p; }
DEV void stA(act_t* p, float v) { *p = v; }
#else
typedef unsigned short act_t;
DEV float ldA(const act_t* p) { return __uint_as_float(((unsigned)*p) << 16); }
DEV void stA(act_t* p, float v) {
  unsigned u = __float_as_uint(v);
  u += 0x7fffu + ((u >> 16) & 1u);
  *p = (unsigned short)(u >> 16);
}
#endif

struct Params {
  const float *x, *c, *ctx, *c_ctx, *w_ada, *b_ada, *ln_g, *ln_b, *w_in_even, *attn_sink, *lb_logits, *hgrn_norm,
      *w_out_even, *w_in_odd, *gla_gate_w, *gla_gate_b, *gla_norm, *w_out_odd, *w_router, *b_router, *w_eg, *w_eu,
      *w_ed;
  float* out;
  float *mod, *hc, *costab, *sintab, *lbt, *ew, *ropetab;
  int* eidx;
  act_t *u, *P, *OF, *OB, *M, *LF;
  act_t *Wt_in_even, *Wt_out_even, *Wt_in_odd, *Wt_out_odd;
  act_t *Y, *Cmat, *FT;
  unsigned char *W8up, *W8down, *W8up1, *W8down1, *H8, *u8;
  int *cnt, *list;
  unsigned* bar;
  int use_cg_sync;
  int pad_;
};

DEV float sigmoidf_(float v) { return 1.0f / (1.0f + expf(-v)); }
DEV float siluf_(float v) { return v / (1.0f + expf(-v)); }

DEV const float* hrow_in(const Params& p, long row) {
  return row < NC ? p.ctx + row * D : p.x + (row - NC) * D;
}
DEV float* hrow(const Params& p, long row) { return row < NC ? p.hc + row * D : p.out + (row - NC) * D; }
DEV const float* modrow(const Params& p, int l, long row) {
  int bb = row < NC ? NB : (int)((row - NC) / T);
  return p.mod + ((long)l * (NB + 1) + bb) * 6 * D;
}

DEV void ph_mod(const Params& p, long i) {
  int j = (int)(i % (6 * D));
  int bb = (int)((i / (6 * D)) % (NB + 1));
  int l = (int)(i / ((long)6 * D * (NB + 1)));
  const float* cv = bb < NB ? p.c + (long)bb * D : p.c_ctx;
  const float* w = p.w_ada + (long)l * D * 6 * D + j;
  float s = p.b_ada[l * 6 * D + j];
  for (int k = 0; k < D; ++k) s += siluf_(cv[k]) * w[(long)k * 6 * D];
  p.mod[i] = s;
}

DEV void ph_tables(const Params& p, long i) {
  if (i < T) {
    double a = 6.283185307179586476925 * (double)i / (double)T;
    p.costab[i] = (float)cos(a);
    p.sintab[i] = (float)sin(a);
  }
  if (i < 1024) {
    int pos = (int)(i >> 4), idx = (int)(i & 15);
    float ang = (float)pos * powf(10000.0f, -(float)idx / 16.0f);
    p.ropetab[2 * i] = cosf(ang);
    p.ropetab[2 * i + 1] = sinf(ang);
  }
  if (i < 1024) {
    int dir = (int)(i / 512), col = (int)(i % 512);
    float l0 = p.lb_logits[(dir * 2 + 0) * 512 + col], l1 = p.lb_logits[(dir * 2 + 1) * 512 + col];
    p.lbt[i] = 1.0f / (1.0f + expf(l1 - l0));
  }
}

DEV void ln_mod_row(const float* h, const float* shift, const float* scale, act_t* u) {
  float mu = 0.f;
  for (int k = 0; k < D; ++k) mu += h[k];
  mu *= (1.0f / D);
  float var = 0.f;
  for (int k = 0; k < D; ++k) { float d = h[k] - mu; var += d * d; }
  var *= (1.0f / D);
  float rs = 1.0f / sqrtf(var + LN_EPS);
  for (int k = 0; k < D; ++k) stA(u + k, (h[k] - mu) * rs * (1.0f + scale[k]) + shift[k]);
}

DEV void ph_lnmod_first(const Params& p, long row) {
  const float* m = modrow(p, 0, row);
  ln_mod_row(hrow_in(p, row), m, m + D, p.u + row * D);
}

DEV void gemm_item_act(const act_t* A, const float* W, act_t* Cout, int K, int N, int ldc, long i) {
  int n4 = (int)(i % (N / 4));
  long row = i / (N / 4);
  const act_t* a = A + row * K;
  const float* w = W + n4 * 4;
  float s0 = 0, s1 = 0, s2 = 0, s3 = 0;
  for (int k = 0; k < K; ++k) {
    float av = ldA(a + k);
    const float* wr = w + (long)k * N;
    s0 += av * wr[0]; s1 += av * wr[1]; s2 += av * wr[2]; s3 += av * wr[3];
  }
  act_t* o = Cout + row * ldc + n4 * 4;
  stA(o, s0); stA(o + 1, s1); stA(o + 2, s2); stA(o + 3, s3);
}

DEV void ph_rope(const Params& p, long i) {
  int pr = (int)(i % 32);
  int hh = (int)((i / 32) % 10);
  long lr = i / 320;
  int t = (int)(lr % T);
  int col = hh < 8 ? E_AQ + hh * 64 : E_AK + (hh - 8) * 64;
  int idx = pr & 15;
  int pos = pr < 16 ? t / GRID_W : t % GRID_W;
  int d0 = pr < 16 ? idx : 32 + idx;
  float inv = powf(10000.0f, -(float)idx / 16.0f);
  float ang = (float)pos * inv;
  float cs = cosf(ang), sn = sinf(ang);
  act_t* base = p.P + (NC + lr) * PW + col;
  float x1 = ldA(base + d0), x2 = ldA(base + d0 + 16);
  stA(base + d0, x1 * cs - x2 * sn);
  stA(base + d0 + 16, x1 * sn + x2 * cs);
}

DEV void ph_attn(const Params& p, long i) {
  int h = (int)(i % 8);
  long row = i / 8;
  int kv = h / 4;
  bool lat = row >= NC;
  int b = lat ? (int)((row - NC) / T) : (int)(row / C);
  int t = lat ? (int)((row - NC) % T) : 0;
  float q[64], acc[64];
  const act_t* qp = p.P + row * PW + E_AQ + h * 64;
#pragma unroll
  for (int d = 0; d < 64; ++d) { q[d] = ldA(qp + d) * 0.125f; acc[d] = 0.f; }
  float m = p.attn_sink[h], l = 1.0f;
  int nkeys = C + (lat ? 257 : 0);
  for (int j = 0; j < nkeys; ++j) {
    long krow;
    if (j < C) krow = (long)b * C + j;
    else {
      int kp = t - 128 + (j - C);
      if (kp < 0 || kp >= T) continue;
      krow = NC + (long)b * T + kp;
    }
    const act_t* kptr = p.P + krow * PW + E_AK + kv * 64;
    const act_t* vptr = p.P + krow * PW + E_AV + kv * 64;
    float s = 0.f;
#pragma unroll
    for (int d = 0; d < 64; ++d) s += q[d] * ldA(kptr + d);
    float mn = fmaxf(m, s);
    float sc = expf(m - mn), pj = expf(s - mn);
    l = l * sc + pj;
#pragma unroll
    for (int d = 0; d < 64; ++d) acc[d] = acc[d] * sc + pj * ldA(vptr + d);
    m = mn;
  }
  float il = 1.0f / l;
  act_t* o = p.u + row * D + h * 64;
#pragma unroll
  for (int d = 0; d < 64; ++d) stA(o + d, acc[d] * il);
}

template <int MODE>
DEV void ph_scan(const Params& p, long i) {
  constexpr int DK = MODE == 0 ? 128 : 96;
  constexpr int DV = MODE == 0 ? 128 : 192;
  int e = (int)(i % DV);
  int dir = (int)((i / DV) % 2);
  int h = (int)((i / (2 * DV)) % 4);
  int b = (int)(i / (8 * DV));
  float S[DK];
#pragma unroll
  for (int d = 0; d < DK; ++d) S[d] = 0.f;
  act_t* OD = dir == 0 ? p.OF : p.OB;
  for (int step = 0; step < C + T; ++step) {
    long row;
    if (step < C) row = (long)b * C + (dir == 0 ? step : C - 1 - step);
    else { int tt = step - C; row = NC + (long)b * T + (dir == 0 ? tt : T - 1 - tt); }
    const act_t* pr = p.P + row * PW;
    float o = 0.f;
    if (MODE == 0) {
      float v = ldA(pr + E_HI + h * 128 + e);
      const act_t* zp = pr + E_FF + dir * 512 + h * 128;
      const act_t* qp = pr + E_HQ + h * 128;
      const float* lb = p.lbt + dir * 512 + h * 128;
#pragma unroll
      for (int d = 0; d < DK; ++d) {
        float f = lb[d] + (1.0f - lb[d]) * sigmoidf_(ldA(zp + d));
        S[d] = f * S[d] + (1.0f - f) * v;
        o += ldA(qp + d) * S[d];
      }
      stA(OD + row * 768 + h * 128 + e, o);
    } else {
      float v = ldA(pr + O_V + h * 192 + e);
      const act_t* kp = pr + O_K + h * 96;
      const act_t* qp = pr + O_Q + h * 96;
      const act_t* lf = p.LF + ((long)dir * NR + row) * 384 + h * 96;
#pragma unroll
      for (int d = 0; d < DK; ++d) {
        float f = expf(ldA(lf + d));
        S[d] = f * S[d] + ldA(kp + d) * v;
        o += ldA(qp + d) * S[d];
      }
      stA(OD + row * 768 + h * 192 + e, o * 0.10206207261596575f);
    }
  }
}

template <int MODE>
DEV void ph_combine(const Params& p, long i) {
  constexpr int DV = MODE == 0 ? 128 : 192;
  int h = (int)(i % 4);
  long row = (MODE == 0) ? i / 4 : NC + i / 4;
  const act_t* f = p.OF + row * 768 + h * DV;
  const act_t* bk = p.OB + row * 768 + h * DV;
  float ss = 0.f;
  for (int e = 0; e < DV; ++e) { float o = ldA(f + e) + ldA(bk + e); ss += o * o; }
  float r = 1.0f / sqrtf(ss / DV + LN_EPS);
  const float* gn = (MODE == 0 ? p.hgrn_norm : p.gla_norm) + h * DV;
  const act_t* g = p.P + row * PW + (MODE == 0 ? E_HG : O_G) + h * DV;
  act_t* o = p.u + row * D + (MODE == 0 ? 512 : 0) + h * DV;
  for (int e = 0; e < DV; ++e) stA(o + e, (ldA(f + e) + ldA(bk + e)) * r * gn[e] * siluf_(ldA(g + e)));
}

DEV void ph_gla_decay(const Params& p, long i) {
  int col = (int)(i % 384);
  long row = (i / 384) % NR;
  int dir = (int)(i / ((long)384 * NR));
  const act_t* r = p.P + row * PW + O_RF + dir * 16;
  const float* gw = p.gla_gate_w + (long)dir * 16 * 384 + col;
  float z = p.gla_gate_b[dir * 384 + col];
  for (int k = 0; k < 16; ++k) z += ldA(r + k) * gw[k * 384];
  float ls = fminf(z, 0.f) - log1pf(expf(-fabsf(z)));
  stA(p.LF + ((long)dir * NR + row) * 384 + col, ls * (1.0f / 16.0f));
}

DEV void ph_resid_ln(const Params& p, long row, int l, int sub) {
  const float* hin = (l == 0 && sub == 0) ? hrow_in(p, row) : hrow(p, row);
  float* hout = hrow(p, row);
  const float* md = modrow(p, l, row);
  const float* g = md + (sub == 0 ? 2 : 5) * D;
  const act_t* m = p.M + row * D;
  const float* lg = p.ln_g + (l * 2 + sub) * D;
  const float* lb = p.ln_b + (l * 2 + sub) * D;
  float mu = 0.f;
  for (int k = 0; k < D; ++k) mu += ALPHA * hin[k] + g[k] * ldA(m + k);
  mu *= (1.0f / D);
  float var = 0.f;
  for (int k = 0; k < D; ++k) { float d = ALPHA * hin[k] + g[k] * ldA(m + k) - mu; var += d * d; }
  var *= (1.0f / D);
  float rs = 1.0f / sqrtf(var + LN_EPS);
  for (int k = 0; k < D; ++k) hout[k] = (ALPHA * hin[k] + g[k] * ldA(m + k) - mu) * rs * lg[k] + lb[k];
  if (sub == 1 && l == 1) return;
  const float* md2 = (sub == 0) ? md + 3 * D : modrow(p, 1, row);
  float mu2 = 0.f;
  for (int k = 0; k < D; ++k) mu2 += hout[k];
  mu2 *= (1.0f / D);
  float var2 = 0.f;
  for (int k = 0; k < D; ++k) { float d = hout[k] - mu2; var2 += d * d; }
  var2 *= (1.0f / D);
  float rs2 = 1.0f / sqrtf(var2 + LN_EPS);
  float lo[NEXP];
#pragma unroll
  for (int e = 0; e < NEXP; ++e) lo[e] = 0.f;
  for (int k = 0; k < D; ++k) {
    float uv = (hout[k] - mu2) * rs2 * (1.0f + md2[D + k]) + md2[k];
    stA(p.u + row * D + k, uv);
    if (sub == 0) {
      const float* wr = p.w_router + k * NEXP;
#pragma unroll
      for (int e = 0; e < NEXP; ++e) lo[e] += uv * wr[e];
    }
  }
  if (sub != 0) return;
  float mx = lo[0];
#pragma unroll
  for (int e = 1; e < NEXP; ++e) mx = fmaxf(mx, lo[e]);
  float sum = 0.f;
#pragma unroll
  for (int e = 0; e < NEXP; ++e) { lo[e] = expf(lo[e] - mx); sum += lo[e]; }
  float inv = 1.0f / sum;
  float bestg = -1e30f; int bg = 0;
  float gi1 = 0, gi2 = 0; int ge1 = 0, ge2 = 0;
  float gp1 = 0, gp2 = 0;
#pragma unroll
  for (int gq = 0; gq < 4; ++gq) {
    float s1 = -1e30f, s2 = -1e30f, p1 = 0, p2 = 0; int e1 = 0, e2 = 0;
#pragma unroll
    for (int j = 0; j < 4; ++j) {
      int e = gq * 4 + j;
      float pe = lo[e] * inv;
      float se = pe + p.b_router[e];
      if (se > s1) { s2 = s1; p2 = p1; e2 = e1; s1 = se; p1 = pe; e1 = e; }
      else if (se > s2) { s2 = se; p2 = pe; e2 = e; }
    }
    float gs = s1 + s2;
    if (gs > bestg) { bestg = gs; bg = gq; gi1 = s1; gi2 = s2; ge1 = e1; ge2 = e2; gp1 = p1; gp2 = p2; }
  }
  (void)bg; (void)gi1; (void)gi2;
  float wsum = gp1 + gp2;
  p.eidx[row * 2 + 0] = ge1; p.eidx[row * 2 + 1] = ge2;
  p.ew[row * 2 + 0] = gp1 / wsum; p.ew[row * 2 + 1] = gp2 / wsum;
}

DEV void ph_moe_up(const Params& p, long i, int l, long row0) {
  int f4 = (int)(i % (DFF / 4));
  int slot = (int)((i / (DFF / 4)) % 2);
  long row = row0 + i / (DFF / 2);
  int e = p.eidx[row * 2 + slot];
  const float* w1 = p.w_eg + ((long)(l * NEXP + e) * D) * DFF + f4 * 4;
  const float* w3 = p.w_eu + ((long)(l * NEXP + e) * D) * DFF + f4 * 4;
  const act_t* a = p.u + row * D;
  float g0 = 0, g1 = 0, g2 = 0, g3 = 0, u0 = 0, u1 = 0, u2 = 0, u3 = 0;
  for (int k = 0; k < D; ++k) {
    float av = ldA(a + k);
    const float* r1 = w1 + (long)k * DFF;
    const float* r3 = w3 + (long)k * DFF;
    g0 += av * r1[0]; g1 += av * r1[1]; g2 += av * r1[2]; g3 += av * r1[3];
    u0 += av * r3[0]; u1 += av * r3[1]; u2 += av * r3[2]; u3 += av * r3[3];
  }
  act_t* hb = p.P + (row * 2 + slot) * DFF + f4 * 4;
  stA(hb, siluf_(g0) * u0); stA(hb + 1, siluf_(g1) * u1); stA(hb + 2, siluf_(g2) * u2); stA(hb + 3, siluf_(g3) * u3);
}

DEV void ph_moe_down(const Params& p, long i, int l, long row0) {
  int j4 = (int)(i % (D / 4));
  long row = row0 + i / (D / 4);
  float y0 = 0, y1 = 0, y2 = 0, y3 = 0;
  for (int slot = 0; slot < 2; ++slot) {
    int e = p.eidx[row * 2 + slot];
    float wgt = p.ew[row * 2 + slot];
    const float* w2 = p.w_ed + ((long)(l * NEXP + e) * DFF) * D + j4 * 4;
    const act_t* hb = p.P + (row * 2 + slot) * DFF;
    float s0 = 0, s1 = 0, s2 = 0, s3 = 0;
    for (int f = 0; f < DFF; ++f) {
      float hv = ldA(hb + f);
      const float* r = w2 + (long)f * D;
      s0 += hv * r[0]; s1 += hv * r[1]; s2 += hv * r[2]; s3 += hv * r[3];
    }
    y0 += wgt * s0; y1 += wgt * s1; y2 += wgt * s2; y3 += wgt * s3;
  }
  act_t* o = p.M + row * D + j4 * 4;
  stA(o, y0); stA(o + 1, y1); stA(o + 2, y2); stA(o + 3, y3);
}


#ifndef HOST_TEST
typedef __attribute__((ext_vector_type(8))) short bf16x8;
typedef __attribute__((ext_vector_type(4))) float f32x4;
constexpr int SMEM_BYTES = 71680;
constexpr int IN_ODD_PAD = 2944;
constexpr int O_FA = 2336, O_FB = 2592, O_END = 2848;

typedef float f32x2_t __attribute__((ext_vector_type(2)));
typedef __bf16 bf16x2_t __attribute__((ext_vector_type(2)));
__device__ __forceinline__ unsigned pack2(float a, float b) {
  const f32x2_t v = {a, b};
  return __builtin_bit_cast(unsigned, __builtin_convertvector(v, bf16x2_t));
}
__device__ __forceinline__ unsigned pack2_mfma(float a, float b) { return pack2(a, b); }
typedef __attribute__((ext_vector_type(2))) unsigned u32x2;
__device__ __forceinline__ float xor16_max(float x) {
  const u32x2 r = __builtin_amdgcn_permlane16_swap(__float_as_uint(x), __float_as_uint(x), false, false);
  return fmaxf(__uint_as_float(r.x), __uint_as_float(r.y));
}
__device__ __forceinline__ float xor32_max(float x) {
  const u32x2 r = __builtin_amdgcn_permlane32_swap(__float_as_uint(x), __float_as_uint(x), false, false);
  return fmaxf(__uint_as_float(r.x), __uint_as_float(r.y));
}
__device__ __forceinline__ float xor16_add(float x) {
  const u32x2 r = __builtin_amdgcn_permlane16_swap(__float_as_uint(x), __float_as_uint(x), false, false);
  return __uint_as_float(r.x) + __uint_as_float(r.y);
}
__device__ __forceinline__ float xor32_add(float x) {
  const u32x2 r = __builtin_amdgcn_permlane32_swap(__float_as_uint(x), __float_as_uint(x), false, false);
  return __uint_as_float(r.x) + __uint_as_float(r.y);
}
__device__ __forceinline__ float bf_lo(unsigned u) { return __uint_as_float(u << 16); }
__device__ __forceinline__ float bf_hi(unsigned u) { return __uint_as_float(u & 0xffff0000u); }
template <int CTRL>
__device__ __forceinline__ float dpp_mov(float v) {
  return __int_as_float(__builtin_amdgcn_update_dpp(0, __float_as_int(v), CTRL, 0xf, 0xf, true));
}
__device__ __forceinline__ float row_sum16(float v) {
  v += dpp_mov<0xB1>(v);
  v += dpp_mov<0x4E>(v);
  v += dpp_mov<0x141>(v);
  v += dpp_mov<0x140>(v);
  return v;
}
__device__ __forceinline__ float wave_sum(float v) {
  v = row_sum16(v);
  const float a = __int_as_float(__builtin_amdgcn_readlane(__float_as_int(v), 0));
  const float b = __int_as_float(__builtin_amdgcn_readlane(__float_as_int(v), 16));
  const float c = __int_as_float(__builtin_amdgcn_readlane(__float_as_int(v), 32));
  const float d = __int_as_float(__builtin_amdgcn_readlane(__float_as_int(v), 48));
  return (a + b) + (c + d);
}


#define XB_TMO      128
#define XB_XCNT(j)  (256  + 64 * (j))
#define XB_XSUB(j)  (1280 + 64 * (j))
#define XB_XGEN(j)  (2304 + 64 * (j))
#define XB_TOP      3328
#define XB_TOPGEN   3392
#define XCD_BAR_WORDS 3456
#define XB_SPIN_CAP (1u << 18)
#define LAS __attribute__((address_space(3)))
__device__ __forceinline__ unsigned xb_ld(unsigned* p)              { return __hip_atomic_load(p, __ATOMIC_RELAXED, __HIP_MEMORY_SCOPE_AGENT); }
__device__ __forceinline__ unsigned xb_add(unsigned* p, unsigned v) { return __hip_atomic_fetch_add(p, v, __ATOMIC_RELAXED, __HIP_MEMORY_SCOPE_AGENT); }
__device__ __forceinline__ unsigned xb_xcc_id() { return (unsigned)__builtin_amdgcn_s_getreg((3 << 11) | 20) & 0xFu; }
#define XB_SPIN(cond, bar) do { unsigned _sp = 0; while (cond) { __builtin_amdgcn_s_sleep(1); \
    if ((++_sp & 255u) == 0u) { if (xb_ld(&(bar)[XB_TMO])) break; if (_sp > XB_SPIN_CAP) { atomicAdd(&(bar)[XB_TMO], 1u); break; } } } } while (0)
struct XcdBarrier { unsigned* bar; unsigned x; volatile LAS unsigned* st; };
__device__ __forceinline__ XcdBarrier xcd_barrier_post(unsigned* bar, volatile LAS unsigned* st) {
    XcdBarrier b; b.bar = bar; b.x = xb_xcc_id(); b.st = st;
    if (threadIdx.x == 0) (void)xb_add(&bar[XB_XCNT(b.x)], 1u);
    return b;
}
__device__ __forceinline__ void xcd_barrier_complete(unsigned* bar, unsigned x, unsigned& nloc, unsigned& nx) {
    const unsigned G = gridDim.x * gridDim.y * gridDim.z;
    unsigned sum, cnt, mine, sp = 0u;
    for (;;) {
        sum = 0u; cnt = 0u; mine = 0u;
#pragma unroll
        for (unsigned j = 0; j < 16; ++j) { const unsigned c = xb_ld(&bar[XB_XCNT(j)]); sum += c; cnt += (c > 0u) ? 1u : 0u; mine = (j == x) ? c : mine; }
        if (sum == G) break;
        __builtin_amdgcn_s_sleep(1);
        if ((++sp & 255u) == 0u) { if (xb_ld(&bar[XB_TMO])) break; if (sp > XB_SPIN_CAP) { atomicAdd(&bar[XB_TMO], 1u); break; } }
    }
    nloc = mine > 0u ? mine : 1u; nx = cnt > 0u ? cnt : 1u;
}
__device__ __forceinline__ void xcd_barrier(const XcdBarrier& b) {
    asm volatile("s_waitcnt vmcnt(0)" ::: "memory");
    __syncthreads();
    if (threadIdx.x == 0) {
        unsigned* bar = b.bar;
        __builtin_amdgcn_s_waitcnt(0);
        unsigned nloc = b.st[0], nx = b.st[1];
        if (nloc == 0u) { xcd_barrier_complete(bar, b.x, nloc, nx); b.st[0] = nloc; b.st[1] = nx; }
        const unsigned old = xb_add(&bar[XB_XSUB(b.x)], 1u);
        const unsigned gen = old / nloc;
        if (old + 1u == (gen + 1u) * nloc) {
            __builtin_amdgcn_fence(__ATOMIC_RELEASE, "agent");
            asm volatile("s_waitcnt vmcnt(0)" ::: "memory");
            const unsigned og = xb_add(&bar[XB_TOP], 1u);
            const unsigned tg = og / nx;
            if (og + 1u == (tg + 1u) * nx) xb_add(&bar[XB_TOPGEN], 1u);
            else XB_SPIN(xb_ld(&bar[XB_TOPGEN]) == tg, bar);
            __builtin_amdgcn_fence(__ATOMIC_ACQUIRE, "agent");
            xb_add(&bar[XB_XGEN(b.x)], 1u);
            asm volatile("s_waitcnt vmcnt(0)" ::: "memory");
        } else {
            XB_SPIN(xb_ld(&bar[XB_XGEN(b.x)]) == gen, bar);
            __builtin_amdgcn_fence(__ATOMIC_ACQUIRE, "agent");
            asm volatile("s_waitcnt vmcnt(0)" ::: "memory");
        }
    }
    __syncthreads();
}

#define RAW_BARRIER() do { asm volatile("s_waitcnt lgkmcnt(0)" ::: "memory"); __builtin_amdgcn_s_barrier(); } while (0)
template <bool SWAP, class ARow, class Epi>
__device__ __forceinline__ void gemm_tile(ARow arow, const act_t* Bt, int K, unsigned char* smem, Epi epi) {
  const int tid = threadIdx.x, wid = tid >> 6, lane = tid & 63, wr = wid >> 1, wc = wid & 1, fr = lane & 15,
            fq = lane >> 4;
  const int r0 = tid >> 3, pc = tid & 7;
  const int lc = pc ^ ((tid >> 4) & 7);
  const act_t* ga[4];
#pragma unroll
  for (int i = 0; i < 4; ++i) ga[i] = arow(r0 + 32 * i) + lc * 8;
  const act_t* gb0 = Bt + (long)r0 * K + lc * 8;
  const long gbs = (long)32 * K;
  const int sw = (fr >> 1) & 7;
  const int rd0 = fr * 128 + ((fq ^ sw) << 4), rd1 = fr * 128 + (((4 + fq) ^ sw) << 4);
  char* S = (char*)smem;
  const int nk = K >> 6;
  f32x4 acc[4][4];
#pragma unroll
  for (int m = 0; m < 4; ++m)
#pragma unroll
    for (int n = 0; n < 4; ++n) acc[m][n] = f32x4{0.f, 0.f, 0.f, 0.f};
  auto issue = [&](int kt) {
    char* st = S + (kt & 1) * 32768 + tid * 16;
#pragma unroll
    for (int i = 0; i < 4; ++i) {
      __builtin_amdgcn_global_load_lds((const unsigned*)(ga[i] + kt * 64), (unsigned*)(st + i * 4096), 16, 0, 0);
      __builtin_amdgcn_global_load_lds((const unsigned*)(gb0 + i * gbs + kt * 64), (unsigned*)(st + 16384 + i * 4096), 16, 0, 0);
    }
  };
  asm volatile("s_waitcnt vmcnt(0)" ::: "memory");
  RAW_BARRIER();
  issue(0);
  for (int kt = 0; kt < nk; ++kt) {
    asm volatile("s_waitcnt vmcnt(0)" ::: "memory");
    RAW_BARRIER();
    if (kt + 1 < nk) issue(kt + 1);
    const char* st = S + (kt & 1) * 32768;
#pragma unroll
    for (int ks = 0; ks < 2; ++ks) {
      const int rd = ks ? rd1 : rd0;
      bf16x8 af[4], bfr[4];
#pragma unroll
      for (int m = 0; m < 4; ++m) {
        af[m] = *reinterpret_cast<const bf16x8*>(st + (wr * 64 + m * 16) * 128 + rd);
        bfr[m] = *reinterpret_cast<const bf16x8*>(st + 16384 + (wc * 64 + m * 16) * 128 + rd);
      }
#pragma unroll
      for (int m = 0; m < 4; ++m)
#pragma unroll
        for (int n = 0; n < 4; ++n)
          acc[m][n] = SWAP ? __builtin_amdgcn_mfma_f32_16x16x32_bf16(bfr[n], af[m], acc[m][n], 0, 0, 0)
                           : __builtin_amdgcn_mfma_f32_16x16x32_bf16(af[m], bfr[n], acc[m][n], 0, 0, 0);
    }
  }
  epi(acc, wr, wc, fr, fq);
}


constexpr float SU8 = 16.0f, SW8 = 64.0f, SH8 = 8.0f;
typedef unsigned char fp8_t;
__device__ __forceinline__ unsigned pack4_fp8(float a, float b, float c, float d) {
  a = fminf(fmaxf(a, -448.f), 448.f); b = fminf(fmaxf(b, -448.f), 448.f);
  c = fminf(fmaxf(c, -448.f), 448.f); d = fminf(fmaxf(d, -448.f), 448.f);
  unsigned w = 0;
  w = __builtin_amdgcn_cvt_pk_fp8_f32(a, b, w, false);
  w = __builtin_amdgcn_cvt_pk_fp8_f32(c, d, w, true);
  return w;
}

template <class ARow, class Epi>
__device__ __forceinline__ void gemm_tile8(ARow arow, const fp8_t* Bt, int Kb, unsigned char* smem, Epi epi) {
  const int tid = threadIdx.x, wid = tid >> 6, lane = tid & 63, wr = wid >> 1, wc = wid & 1, fr = lane & 15,
            fq = lane >> 4;
  const int r0 = tid >> 3, pc = tid & 7;
  const int lc = pc ^ ((tid >> 4) & 7);
  const fp8_t* ga[4];
#pragma unroll
  for (int i = 0; i < 4; ++i) ga[i] = arow(r0 + 32 * i) + lc * 16;
  const fp8_t* gb0 = Bt + (long)r0 * Kb + lc * 16;
  const long gbs = (long)32 * Kb;
  const int sw = (fr >> 1) & 7;
  int rd[4];
#pragma unroll
  for (int ks = 0; ks < 4; ++ks) rd[ks] = fr * 128 + (((ks * 2 + (fq >> 1)) ^ sw) << 4) + (fq & 1) * 8;
  char* S = (char*)smem;
  const int nk = Kb >> 7;
  f32x4 acc[4][4];
#pragma unroll
  for (int m = 0; m < 4; ++m)
#pragma unroll
    for (int n = 0; n < 4; ++n) acc[m][n] = f32x4{0.f, 0.f, 0.f, 0.f};
  auto issue = [&](int kt) {
    char* st = S + (kt & 1) * 32768 + tid * 16;
#pragma unroll
    for (int i = 0; i < 4; ++i) {
      __builtin_amdgcn_global_load_lds((const unsigned*)(ga[i] + kt * 128), (unsigned*)(st + i * 4096), 16, 0, 0);
      __builtin_amdgcn_global_load_lds((const unsigned*)(gb0 + i * gbs + kt * 128), (unsigned*)(st + 16384 + i * 4096), 16, 0, 0);
    }
  };
  asm volatile("s_waitcnt vmcnt(0)" ::: "memory");
  RAW_BARRIER();
  issue(0);
  for (int kt = 0; kt < nk; ++kt) {
    asm volatile("s_waitcnt vmcnt(0)" ::: "memory");
    RAW_BARRIER();
    if (kt + 1 < nk) issue(kt + 1);
    const char* st = S + (kt & 1) * 32768;
#pragma unroll
    for (int ks = 0; ks < 4; ++ks) {
      long af[4], bfr[4];
#pragma unroll
      for (int m = 0; m < 4; ++m) {
        af[m] = *reinterpret_cast<const long*>(st + (wr * 64 + m * 16) * 128 + rd[ks]);
        bfr[m] = *reinterpret_cast<const long*>(st + 16384 + (wc * 64 + m * 16) * 128 + rd[ks]);
      }
#pragma unroll
      for (int m = 0; m < 4; ++m)
#pragma unroll
        for (int n = 0; n < 4; ++n) acc[m][n] = __builtin_amdgcn_mfma_f32_16x16x32_fp8_fp8(bfr[n], af[m], acc[m][n], 0, 0, 0);
    }
  }
  epi(acc, wr, wc, fr, fq);
}

__device__ __forceinline__ void phase_attn(const Params& p, unsigned char* smem, int blk, int nblk) {
  const int tid = threadIdx.x, w = tid >> 6, lane = tid & 63, fr = lane & 15, g = lane >> 4;
  act_t* SK = (act_t*)smem;
  act_t* SV = SK + 64 * 72;
  constexpr float SCL = 0.125f * 1.4426950408889634f;
  const int n_lat = NB * 4 * (T / 64), n_ctx = NB * 4 * (C / 64);
  const int skey = tid >> 2, spart = tid & 3;
  for (int unit = blk; unit < n_lat + n_ctx; unit += nblk) {
    const bool lat = unit < n_lat;
    const int uu = lat ? unit : unit - n_lat;
    const int nq = lat ? T / 64 : C / 64;
    const int hp = uu & 1, kv = (uu >> 1) & 1, qb = (uu >> 2) % nq, b = (uu >> 2) / nq;
    const int t0 = qb * 64;
    const int tw = t0 + (w & 1) * 32;
    const long qrow0 = (lat ? (long)NC + (long)b * T : (long)b * C) + tw;
    const int h = kv * 4 + hp * 2 + (w >> 1);
    bf16x8 qf[2][2];
#pragma unroll
    for (int qt = 0; qt < 2; ++qt)
#pragma unroll
      for (int st = 0; st < 2; ++st)
        qf[qt][st] = *reinterpret_cast<const bf16x8*>(p.P + (qrow0 + qt * 16 + fr) * PW + E_AQ + h * 64 + st * 32 + g * 8);
    asm volatile("" :: "v"(qf[0][0]), "v"(qf[0][1]), "v"(qf[1][0]), "v"(qf[1][1]));
    float mrun[2], lrun[2];
    f32x4 o[2][4];
    const float sinkl = p.attn_sink[h] * 1.4426950408889634f;
#pragma unroll
    for (int qt = 0; qt < 2; ++qt) {
      mrun[qt] = sinkl;
      lrun[qt] = (g == 0) ? 1.0f : 0.0f;
#pragma unroll
      for (int dt = 0; dt < 4; ++dt) o[qt][dt] = f32x4{0.f, 0.f, 0.f, 0.f};
    }
    int cc_lo = 0, cc_hi = -1;
    if (lat) {
      cc_lo = t0 >= 128 ? 0 : (128 - t0) / 64;
      cc_hi = min(4, (T - 1 - (t0 - 128)) / 64);
    }
    const int nch = 4 + (cc_hi - cc_lo + 1);
    auto chunk_row = [&](int i, int key, int& tkb) -> long {
      if (i < 4) { tkb = 0; return (long)b * C + i * 64 + key; }
      tkb = t0 - 128 + (cc_lo + i - 4) * 64;
      return (long)NC + (long)b * T + tkb + key;
    };
    uint4 rk0, rk1, rv0, rv1;
    {
      int tkb; const long kr = chunk_row(0, skey, tkb);
      const act_t* kp = p.P + kr * PW + E_AK + kv * 64 + spart * 16;
      const act_t* vp = p.P + kr * PW + E_AV + kv * 64 + spart * 16;
      rk0 = *reinterpret_cast<const uint4*>(kp); rk1 = *reinterpret_cast<const uint4*>(kp + 8);
      rv0 = *reinterpret_cast<const uint4*>(vp); rv1 = *reinterpret_cast<const uint4*>(vp + 8);
    }
    for (int i = 0; i < nch; ++i) {
      __syncthreads();
      {
        uint4* kd = reinterpret_cast<uint4*>(SK + skey * 72 + spart * 16);
        kd[0] = rk0; kd[1] = rk1;
        const unsigned vw[8] = {rv0.x, rv0.y, rv0.z, rv0.w, rv1.x, rv1.y, rv1.z, rv1.w};
#pragma unroll
        for (int e = 0; e < 8; ++e) {
          SV[(spart * 16 + 2 * e) * 72 + skey] = (act_t)(vw[e] & 0xffffu);
          SV[(spart * 16 + 2 * e + 1) * 72 + skey] = (act_t)(vw[e] >> 16);
        }
      }
      __syncthreads();
      int tkb_cur; (void)chunk_row(i, 0, tkb_cur);
      if (i + 1 < nch) {
        int tkb; const long kr = chunk_row(i + 1, skey, tkb);
        const act_t* kp = p.P + kr * PW + E_AK + kv * 64 + spart * 16;
        const act_t* vp = p.P + kr * PW + E_AV + kv * 64 + spart * 16;
        rk0 = *reinterpret_cast<const uint4*>(kp); rk1 = *reinterpret_cast<const uint4*>(kp + 8);
        rv0 = *reinterpret_cast<const uint4*>(vp); rv1 = *reinterpret_cast<const uint4*>(vp + 8);
      }
      const bool edge = i >= 4 && (tkb_cur == t0 - 128 || tkb_cur == t0 + 128);
#pragma unroll
      for (int kb = 0; kb < 2; ++kb) {
        f32x4 sc[2][2];
#pragma unroll
        for (int k2 = 0; k2 < 2; ++k2) {
          const int kt = kb * 2 + k2;
          const bf16x8 kf0 = *reinterpret_cast<const bf16x8*>(SK + (kt * 16 + fr) * 72 + g * 8);
          const bf16x8 kf1 = *reinterpret_cast<const bf16x8*>(SK + (kt * 16 + fr) * 72 + 32 + g * 8);
#pragma unroll
          for (int qt = 0; qt < 2; ++qt) {
            f32x4 z = f32x4{0.f, 0.f, 0.f, 0.f};
            z = __builtin_amdgcn_mfma_f32_16x16x32_bf16(kf0, qf[qt][0], z, 0, 0, 0);
            sc[qt][k2] = __builtin_amdgcn_mfma_f32_16x16x32_bf16(kf1, qf[qt][1], z, 0, 0, 0);
          }
        }
        bf16x8 pf[2];
#pragma unroll
        for (int qt = 0; qt < 2; ++qt) {
          float mx = -1e30f;
#pragma unroll
          for (int k2 = 0; k2 < 2; ++k2)
#pragma unroll
            for (int j = 0; j < 4; ++j) {
              float v = sc[qt][k2][j] * SCL;
              if (edge) {
                const int tk = tkb_cur + (kb * 2 + k2) * 16 + 4 * g + j;
                const int tq = tw + qt * 16 + fr;
                const int df = tq - tk;
                if (df > 128 || df < -128) v = -1e30f;
              }
              sc[qt][k2][j] = v;
              mx = fmaxf(mx, v);
            }
          mx = xor16_max(mx);
          mx = xor32_max(mx);
          const float mnew = fmaxf(mrun[qt], mx);
          if (__any(mnew > mrun[qt])) {
            const float alpha = __builtin_amdgcn_exp2f(mrun[qt] - mnew);
            lrun[qt] *= alpha;
#pragma unroll
            for (int dt = 0; dt < 4; ++dt) o[qt][dt] = o[qt][dt] * alpha;
            mrun[qt] = mnew;
          }
          float ls = 0.f;
          float pv[8];
#pragma unroll
          for (int k2 = 0; k2 < 2; ++k2)
#pragma unroll
            for (int j = 0; j < 4; ++j) {
              const float pe = __builtin_amdgcn_exp2f(sc[qt][k2][j] - mnew);
              pv[k2 * 4 + j] = pe;
              ls += pe;
            }
          lrun[qt] += ls;
          union { unsigned u[4]; bf16x8 v; } cv;
          cv.u[0] = pack2_mfma(pv[0], pv[1]); cv.u[1] = pack2_mfma(pv[2], pv[3]);
          cv.u[2] = pack2_mfma(pv[4], pv[5]); cv.u[3] = pack2_mfma(pv[6], pv[7]);
          pf[qt] = cv.v;
        }
#pragma unroll
        for (int dt = 0; dt < 4; ++dt) {
          union { uint2 h2[2]; bf16x8 v; } vf;
          vf.h2[0] = *reinterpret_cast<const uint2*>(SV + (dt * 16 + fr) * 72 + kb * 32 + 4 * g);
          vf.h2[1] = *reinterpret_cast<const uint2*>(SV + (dt * 16 + fr) * 72 + kb * 32 + 16 + 4 * g);
#pragma unroll
          for (int qt = 0; qt < 2; ++qt) o[qt][dt] = __builtin_amdgcn_mfma_f32_16x16x32_bf16(vf.v, pf[qt], o[qt][dt], 0, 0, 0);
        }
      }
    }
#pragma unroll
    for (int qt = 0; qt < 2; ++qt) {
      float lt = lrun[qt];
      lt = xor16_add(lt);
      lt = xor32_add(lt);
      const float il = 1.0f / lt;
      act_t* orow = p.u + (qrow0 + qt * 16 + fr) * D + h * 64 + 4 * g;
#pragma unroll
      for (int dt = 0; dt < 4; ++dt)
        *reinterpret_cast<uint2*>(orow + dt * 16) =
            make_uint2(pack2(o[qt][dt][0] * il, o[qt][dt][1] * il), pack2(o[qt][dt][2] * il, o[qt][dt][3] * il));
    }
  }
}


template <int MODE>
__device__ __forceinline__ void phase_combine(const Params& p) {
  constexpr int DV = MODE == 0 ? 128 : 192, EPL = DV / 16, NV = EPL / 4;
  const int lane = threadIdx.x & 63;
  const long row_lo = MODE == 0 ? 0 : NC;
  const long w0 = (long)blockIdx.x * 4 + (threadIdx.x >> 6), wstride = (long)gridDim.x * 4;
  const float* gn = (MODE == 0 ? p.hgrn_norm : p.gla_norm) + lane * EPL;
  for (long row = row_lo + w0; row < NR; row += wstride) {
    const uint2* f = reinterpret_cast<const uint2*>(p.OF + row * 768 + lane * EPL);
    const uint2* bk = reinterpret_cast<const uint2*>(p.OB + row * 768 + lane * EPL);
    const uint2* gt = reinterpret_cast<const uint2*>(p.P + row * PW + (MODE == 0 ? E_HG : O_G) + lane * EPL);
    float o[EPL];
    float ss = 0.f;
#pragma unroll
    for (int v = 0; v < NV; ++v) {
      const uint2 a = f[v], c = bk[v];
      o[4 * v + 0] = bf_lo(a.x) + bf_lo(c.x); o[4 * v + 1] = bf_hi(a.x) + bf_hi(c.x);
      o[4 * v + 2] = bf_lo(a.y) + bf_lo(c.y); o[4 * v + 3] = bf_hi(a.y) + bf_hi(c.y);
    }
#pragma unroll
    for (int e = 0; e < EPL; ++e) ss += o[e] * o[e];
    ss = row_sum16(ss);
    const float r = 1.0f / sqrtf(ss * (1.0f / DV) + LN_EPS);
    uint2* dst = reinterpret_cast<uint2*>(p.u + row * D + (MODE == 0 ? 512 : 0) + lane * EPL);
#pragma unroll
    for (int v = 0; v < NV; ++v) {
      const uint2 gv = gt[v];
      const float g0 = bf_lo(gv.x), g1 = bf_hi(gv.x), g2 = bf_lo(gv.y), g3 = bf_hi(gv.y);
      const float y0 = o[4 * v + 0] * r * gn[4 * v + 0] * (g0 / (1.0f + __expf(-g0)));
      const float y1 = o[4 * v + 1] * r * gn[4 * v + 1] * (g1 / (1.0f + __expf(-g1)));
      const float y2 = o[4 * v + 2] * r * gn[4 * v + 2] * (g2 / (1.0f + __expf(-g2)));
      const float y3 = o[4 * v + 3] * r * gn[4 * v + 3] * (g3 / (1.0f + __expf(-g3)));
      dst[v] = make_uint2(pack2(y0, y1), pack2(y2, y3));
    }
  }
}

__device__ __forceinline__ void mod_item(const Params& p, int item, unsigned char* smem) {
  float* sc = (float*)smem;
  const int tid = threadIdx.x;
  for (int i = tid; i < 9 * D; i += 256) {
    const int bb = i >> 10, k = i & 1023;
    const float v = bb < NB ? p.c[bb * D + k] : p.c_ctx[k];
    sc[i] = v / (1.0f + __expf(-v));
  }
  __syncthreads();
  const int l = item / 24, j = (item % 24) * 256 + tid;
  const float* w = p.w_ada + (long)l * D * 6 * D + j;
  float a[NB + 1];
#pragma unroll
  for (int bb = 0; bb <= NB; ++bb) a[bb] = p.b_ada[l * 6 * D + j];
  for (int k = 0; k < D; k += 8) {
    float wv[8];
#pragma unroll
    for (int q = 0; q < 8; ++q) wv[q] = w[(long)(k + q) * 6 * D];
#pragma unroll
    for (int q = 0; q < 8; ++q)
#pragma unroll
      for (int bb = 0; bb <= NB; ++bb) a[bb] += sc[bb * D + k + q] * wv[q];
  }
#pragma unroll
  for (int bb = 0; bb <= NB; ++bb) p.mod[((long)l * (NB + 1) + bb) * 6 * D + j] = a[bb];
  __syncthreads();
}

__device__ __forceinline__ void phase_gla_decay(const Params& p) {
  const int t = threadIdx.x;
  if (t >= 192) return;
  const int dir = t / 96, cg = t % 96;
  float gw[16][4], gb[4];
#pragma unroll
  for (int r = 0; r < 16; ++r) {
    const float4 v = *reinterpret_cast<const float4*>(p.gla_gate_w + ((long)dir * 16 + r) * 384 + cg * 4);
    gw[r][0] = v.x; gw[r][1] = v.y; gw[r][2] = v.z; gw[r][3] = v.w;
  }
  {
    const float4 v = *reinterpret_cast<const float4*>(p.gla_gate_b + dir * 384 + cg * 4);
    gb[0] = v.x; gb[1] = v.y; gb[2] = v.z; gb[3] = v.w;
  }
  for (long row0 = (long)blockIdx.x * 4; row0 < NR; row0 += (long)gridDim.x * 4) {
    uint4 ra[4], rb[4];
#pragma unroll
    for (int q = 0; q < 4; ++q) {
      const uint4* rp = reinterpret_cast<const uint4*>(p.P + (row0 + q) * PW + O_RF + dir * 16);
      ra[q] = rp[0]; rb[q] = rp[1];
    }
#pragma unroll
    for (int q = 0; q < 4; ++q) {
      const unsigned rw[8] = {ra[q].x, ra[q].y, ra[q].z, ra[q].w, rb[q].x, rb[q].y, rb[q].z, rb[q].w};
      float z[4] = {gb[0], gb[1], gb[2], gb[3]};
#pragma unroll
      for (int r2 = 0; r2 < 8; ++r2) {
        const float x0 = bf_lo(rw[r2]), x1 = bf_hi(rw[r2]);
#pragma unroll
        for (int c = 0; c < 4; ++c) z[c] += x0 * gw[2 * r2][c] + x1 * gw[2 * r2 + 1][c];
      }
      float o[4];
#pragma unroll
      for (int c = 0; c < 4; ++c) o[c] = (fminf(z[c], 0.f) - __logf(1.0f + __expf(-fabsf(z[c])))) * (1.0f / 16.0f);
      *reinterpret_cast<uint2*>(p.LF + ((long)dir * NR + row0 + q) * 384 + cg * 4) = make_uint2(pack2(o[0], o[1]), pack2(o[2], o[3]));
    }
  }
}

__device__ __forceinline__ void phase_hgrn_gate(const Params& p, long gtid, long gstride) {
  for (long i = gtid; i < (long)NR * 1024; i += gstride) {
    const int col = (int)(i & 1023);
    const long row = i >> 10;
    act_t* z = p.P + row * PW + E_FF + col;
    const float lb = p.lbt[col];
    const float f = lb + (1.0f - lb) * sigmoidf_(ldA(z));
    stA(z, __logf(f));
  }
}

template <int MODE>
__device__ __forceinline__ void phase_scan(const Params& p, unsigned char* smem, int blk, int nblk) {
  constexpr int DK = MODE == 0 ? 128 : 96, DV = MODE == 0 ? 128 : 192, DVS = DV / 4, NET = DVS / 16, NKS = DK / 32,
                NDT = DK / 16;
  constexpr int QS = DK + 8, LS = 72, SS = DK + 8;
  act_t* Qa = (act_t*)smem;
  act_t* Ka = Qa + 64 * QS;
  act_t* KaT = Ka + 64 * QS;
  act_t* VT = KaT + DK * LS;
  act_t* ST = VT + DVS * LS;
  float* tot = (float*)(ST + DVS * SS);
  float* lf32 = tot + 2 * 4 * DK;
  const int tid = threadIdx.x, w = __builtin_amdgcn_readfirstlane(threadIdx.x >> 6), lane = tid & 63, fr = lane & 15, g = lane >> 4;
  const int dp = lane, c0 = 2 * dp;
  const bool cact = dp < DK / 2;
  constexpr int NCH = (C + T) / 64, NCC = C / 64;
  constexpr int NVI = DVS / 8 * 64;
  for (int item = blk; item < NB * 4 * 2 * 4; item += nblk) {
    const int sl = item & 3, dir = (item >> 2) & 1, h = (item >> 3) & 3, b = item >> 5;
    act_t* OD = dir == 0 ? p.OF : p.OB;
    const unsigned loff = (unsigned)min(c0, DK - 2) * 2u;
    const int vcol = (MODE == 0 ? E_HI + h * 128 : O_V + h * 192) + sl * DVS;
    const int ocol = h * DV + sl * DVS;
    auto chunk_base = [&](int n) -> long {
      if (n < NCC) return (long)b * C + (dir ? NCC - 1 - n : n) * 64;
      const int ln = n - NCC;
      return (long)NC + (long)b * T + (dir ? T / 64 - 1 - ln : ln) * 64;
    };
    auto lrow = [&](long base, int l) -> long { return base + (dir ? 63 - l : l); };
    f32x4 S[NET][2];
#pragma unroll
    for (int et = 0; et < NET; ++et) { S[et][0] = f32x4{0.f, 0.f, 0.f, 0.f}; S[et][1] = f32x4{0.f, 0.f, 0.f, 0.f}; }
    unsigned rlf[16], rq[16], rk[16];
    uint4 rv[2];
    auto issue_loads = [&](int n) {
      const long base = chunk_base(n);
      {
#pragma unroll
        for (int i = 0; i < 16; ++i) {
          const long row = lrow(base, w * 16 + i);
          const char* prow = (const char*)(p.P + row * PW);
          if (MODE == 0) {
            rlf[i] = *reinterpret_cast<const unsigned*>(prow + (E_FF + dir * 512 + h * 128) * 2 + loff);
            rq[i] = *reinterpret_cast<const unsigned*>(prow + (E_HQ + h * 128) * 2 + loff);
          } else {
            rlf[i] = *reinterpret_cast<const unsigned*>((const char*)(p.LF + ((long)dir * NR + row) * 384 + h * 96) + loff);
            rk[i] = *reinterpret_cast<const unsigned*>(prow + (O_K + h * 96) * 2 + loff);
            rq[i] = *reinterpret_cast<const unsigned*>(prow + (O_Q + h * 96) * 2 + loff);
          }
        }
      }
#pragma unroll
      for (int r = 0; r < (NVI + 255) / 256; ++r) {
        const int it = min(tid + r * 256, NVI - 1);
        const int l = it / (DVS / 8), e8 = (it % (DVS / 8)) * 8;
        rv[r] = *reinterpret_cast<const uint4*>(p.P + lrow(base, l) * PW + vcol + e8);
      }
    };
    issue_loads(0);
    for (int n = 0; n < NCH; ++n) {
      const int par = n & 1;
      float* totp = tot + par * 4 * DK;
      float* lfp = lf32 + par * DK;
      const long base = chunk_base(n);
      if (cact) {
        float r0 = 0.f, r1 = 0.f;
#pragma unroll
        for (int i = 0; i < 16; ++i) { r0 += bf_lo(rlf[i]); r1 += bf_hi(rlf[i]); }
        totp[w * DK + c0] = r0; totp[w * DK + c0 + 1] = r1;
        if (w == 2) { lfp[c0] = bf_lo(rlf[0]); lfp[c0 + 1] = bf_hi(rlf[0]); }
      }
      __syncthreads();
#pragma unroll
      for (int r = 0; r < (NVI + 255) / 256; ++r) {
        const int it = tid + r * 256;
        if (it < NVI) {
          const int l = it / (DVS / 8), e8 = (it % (DVS / 8)) * 8;
          const unsigned vw[4] = {rv[r].x, rv[r].y, rv[r].z, rv[r].w};
#pragma unroll
          for (int e = 0; e < 4; ++e) {
            VT[(e8 + 2 * e) * LS + l] = (act_t)(vw[e] & 0xffffu);
            VT[(e8 + 2 * e + 1) * LS + l] = (act_t)(vw[e] >> 16);
          }
        }
      }
      if (cact) {
        float of0 = 0.f, of1 = 0.f;
#pragma unroll
        for (int sgi = 0; sgi < 3; ++sgi)
          if (sgi < w) { of0 += totp[sgi * DK + c0]; of1 += totp[sgi * DK + c0 + 1]; }
        const float ref0 = totp[c0] + totp[DK + c0] + lfp[c0];
        const float ref1 = totp[c0 + 1] + totp[DK + c0 + 1] + lfp[c0 + 1];
        float run0 = of0 - ref0, run1 = of1 - ref1;
#pragma unroll
        for (int i = 0; i < 16; i += 2) {
          float ka0[2], ka1[2];
#pragma unroll
          for (int ii = 0; ii < 2; ++ii) {
            const int i2 = i + ii;
            run0 += bf_lo(rlf[i2]); run1 += bf_hi(rlf[i2]);
            const float b0 = run0, b1 = run1;
            const float e0 = __expf(b0), e1 = __expf(b1), f0 = __expf(-b0), f1 = __expf(-b1);
            float k0, k1;
            if (MODE == 0) { k0 = 1.0f - __expf(bf_lo(rlf[i2])); k1 = 1.0f - __expf(bf_hi(rlf[i2])); }
            else { k0 = bf_lo(rk[i2]); k1 = bf_hi(rk[i2]); }
            ka0[ii] = k0 * f0; ka1[ii] = k1 * f1;
            const int l = w * 16 + i2;
            *reinterpret_cast<unsigned*>(Qa + l * QS + c0) = pack2(bf_lo(rq[i2]) * e0, bf_hi(rq[i2]) * e1);
            *reinterpret_cast<unsigned*>(Ka + l * QS + c0) = pack2(ka0[ii], ka1[ii]);
          }
          *reinterpret_cast<unsigned*>(KaT + c0 * LS + w * 16 + i) = pack2(ka0[0], ka0[1]);
          *reinterpret_cast<unsigned*>(KaT + (c0 + 1) * LS + w * 16 + i) = pack2(ka1[0], ka1[1]);
        }
      }
      issue_loads(min(n + 1, NCH - 1));
      float egv[2], egrv[2];
#pragma unroll
      for (int di = 0; di < 2; ++di) {
        const int dt = w + 4 * di;
        if (dt < NDT) {
          const int d = dt * 16 + fr;
          const float refd = totp[d] + totp[DK + d] + lfp[d];
          const float gd = totp[d] + totp[DK + d] + totp[2 * DK + d] + totp[3 * DK + d];
          const float er = __expf(refd);
          egv[di] = __expf(gd); egrv[di] = __expf(gd - refd);
#pragma unroll
          for (int et = 0; et < NET; ++et)
#pragma unroll
            for (int j = 0; j < 4; ++j) stA(ST + (et * 16 + 4 * g + j) * SS + d, S[et][di][j] * er);
        }
      }
      __syncthreads();
      bf16x8 qfr[NKS];
#pragma unroll
      for (int ks = 0; ks < NKS; ++ks) qfr[ks] = *reinterpret_cast<const bf16x8*>(Qa + (w * 16 + fr) * QS + ks * 32 + g * 8);
      bf16x8 pfr[2];
#pragma unroll
      for (int kb = 0; kb < 2; ++kb) {
        f32x4 at2[2];
#pragma unroll
        for (int h2 = 0; h2 < 2; ++h2) {
          const int mt = 2 * kb + h2;
          at2[h2] = f32x4{0.f, 0.f, 0.f, 0.f};
          if (mt <= w) {
#pragma unroll
            for (int ks = 0; ks < NKS; ++ks) {
              const bf16x8 kaf = *reinterpret_cast<const bf16x8*>(Ka + (mt * 16 + fr) * QS + ks * 32 + g * 8);
              at2[h2] = __builtin_amdgcn_mfma_f32_16x16x32_bf16(kaf, qfr[ks], at2[h2], 0, 0, 0);
            }
            if (mt == w) {
#pragma unroll
              for (int j = 0; j < 4; ++j)
                if (4 * g + j > fr) at2[h2][j] = 0.f;
            }
          }
        }
        union { unsigned u[4]; bf16x8 v; } cv;
        cv.u[0] = pack2_mfma(at2[0][0], at2[0][1]); cv.u[1] = pack2_mfma(at2[0][2], at2[0][3]);
        cv.u[2] = pack2_mfma(at2[1][0], at2[1][1]); cv.u[3] = pack2_mfma(at2[1][2], at2[1][3]);
        pfr[kb] = cv.v;
      }
      const long orow = lrow(base, w * 16 + fr);
#pragma unroll
      for (int et = 0; et < NET; ++et) {
        f32x4 o = f32x4{0.f, 0.f, 0.f, 0.f};
#pragma unroll
        for (int kb = 0; kb < 2; ++kb) {
          if (2 * kb <= w) {
            union { uint2 h2[2]; bf16x8 v; } vf;
            vf.h2[0] = *reinterpret_cast<const uint2*>(VT + (et * 16 + fr) * LS + kb * 32 + 4 * g);
            vf.h2[1] = *reinterpret_cast<const uint2*>(VT + (et * 16 + fr) * LS + kb * 32 + 16 + 4 * g);
            o = __builtin_amdgcn_mfma_f32_16x16x32_bf16(vf.v, pfr[kb], o, 0, 0, 0);
          }
        }
#pragma unroll
        for (int ks = 0; ks < NKS; ++ks) {
          const bf16x8 sf = *reinterpret_cast<const bf16x8*>(ST + (et * 16 + fr) * SS + ks * 32 + g * 8);
          o = __builtin_amdgcn_mfma_f32_16x16x32_bf16(sf, qfr[ks], o, 0, 0, 0);
        }
        const float osc = MODE == 0 ? 1.0f : 0.10206207261596575f;
        *reinterpret_cast<uint2*>(OD + orow * 768 + ocol + et * 16 + 4 * g) =
            make_uint2(pack2(o[0] * osc, o[1] * osc), pack2(o[2] * osc, o[3] * osc));
      }
#pragma unroll
      for (int di = 0; di < 2; ++di) {
        const int dt = w + 4 * di;
        if (dt < NDT) {
#pragma unroll
          for (int et = 0; et < NET; ++et) {
            f32x4 r = f32x4{0.f, 0.f, 0.f, 0.f};
#pragma unroll
            for (int k2 = 0; k2 < 2; ++k2) {
              const bf16x8 vf = *reinterpret_cast<const bf16x8*>(VT + (et * 16 + fr) * LS + k2 * 32 + g * 8);
              const bf16x8 kf = *reinterpret_cast<const bf16x8*>(KaT + (dt * 16 + fr) * LS + k2 * 32 + g * 8);
              r = __builtin_amdgcn_mfma_f32_16x16x32_bf16(vf, kf, r, 0, 0, 0);
            }
#pragma unroll
            for (int j = 0; j < 4; ++j) S[et][di][j] = egv[di] * S[et][di][j] + egrv[di] * r[j];
          }
        }
      }
    }
    __syncthreads();
  }
}

struct GemmJob {
  const act_t* A; const act_t* Bt; act_t* C;
  long sA, sB, sC;
  int nbatch, Mtiles, Ntiles, K, ldc, Nvalid, mode;
  float scale;
};
__device__ __forceinline__ void phase_gemm(const Params& p, const GemmJob& g, unsigned char* smem, int blk = blockIdx.x, int nblk = gridDim.x) {
  const int per_b = g.Mtiles * g.Ntiles;
  const int ntiles = per_b * g.nbatch;
  for (int tile = blk; tile < ntiles; tile += nblk) {
    const int b = tile / per_b, tt = tile % per_b;
    const int tm = tt / g.Ntiles, tn = tt % g.Ntiles;
    if (g.mode == 1 && tm < NC / 128 && tn * 128 >= O_FA) continue;
    const int K = g.K, ldc = g.ldc;
    const act_t* Ab = g.A + b * g.sA + (long)tm * 128 * K;
    act_t* Cb = g.C + b * g.sC + (long)tm * 128 * ldc + tn * 128;
    const int nlim = g.Nvalid - tn * 128;
    const float scale = g.scale;
    const int mode = g.mode;
    if (mode == 1) {
      gemm_tile<false>([&](int r) { return Ab + (long)r * K; }, g.Bt + b * g.sB + (long)tn * 128 * K, K, smem,
                [&](f32x4 (&acc)[4][4], int wr, int wc, int fr, int fq) {
#pragma unroll
                  for (int m = 0; m < 4; ++m)
#pragma unroll
                    for (int n = 0; n < 4; ++n) {
                      const int col = wc * 64 + n * 16 + fr;
                      if (col < nlim) {
#pragma unroll
                        for (int j = 0; j < 4; ++j) {
                          const int row = wr * 64 + m * 16 + fq * 4 + j;
                          stA(Cb + (long)row * ldc + col, acc[m][n][j]);
                        }
                      } else {
                        const int gc = tn * 128 + col;
                        if (gc < O_END && tm >= NC / 128) {
                          const int lr = (tm - NC / 128) * 128 + wr * 64 + m * 16 + fq * 4;
                          const int bb = lr / T, t = lr % T;
                          const int cq = gc < O_FB ? gc - O_FA : gc - O_FB;
                          act_t* dst = p.FT + ((long)bb * 256 + cq) * (2 * T) + (gc < O_FB ? 0 : T) + t;
                          *reinterpret_cast<uint2*>(dst) = make_uint2(pack2(acc[m][n][0], acc[m][n][1]), pack2(acc[m][n][2], acc[m][n][3]));
                        }
                      }
                    }
                });
    } else {
      gemm_tile<true>([&](int r) { return Ab + (long)r * K; }, g.Bt + b * g.sB + (long)tn * 128 * K, K, smem,
                [&](f32x4 (&acc)[4][4], int wr, int wc, int fr, int fq) {
                  if (mode == 2) {
                    const int cb = tn * 128 + wc * 64;
                    if (cb < E_AV && tm >= NC / 128) {
                      const float4* rt = reinterpret_cast<const float4*>(p.ropetab);
#pragma unroll
                      for (int m = 0; m < 4; ++m) {
                        const int t = ((tm - NC / 128) * 128 + wr * 64 + m * 16 + fr) % T;
                        const float4 r01 = rt[(t / GRID_W) * 8 + fq * 2], r23 = rt[(t / GRID_W) * 8 + fq * 2 + 1];
                        const float4 c01 = rt[(t % GRID_W) * 8 + fq * 2], c23 = rt[(t % GRID_W) * 8 + fq * 2 + 1];
                        const float rc[4] = {r01.x, r01.z, r23.x, r23.z}, rs_[4] = {r01.y, r01.w, r23.y, r23.w};
                        const float cc[4] = {c01.x, c01.z, c23.x, c23.z}, cs_[4] = {c01.y, c01.w, c23.y, c23.w};
#pragma unroll
                        for (int j = 0; j < 4; ++j) {
                          const float a1 = acc[m][0][j], a2 = acc[m][1][j], b1 = acc[m][2][j], b2 = acc[m][3][j];
                          acc[m][0][j] = a1 * rc[j] - a2 * rs_[j]; acc[m][1][j] = a1 * rs_[j] + a2 * rc[j];
                          acc[m][2][j] = b1 * cc[j] - b2 * cs_[j]; acc[m][3][j] = b1 * cs_[j] + b2 * cc[j];
                        }
                      }
                    } else if (cb >= E_FF && cb < E_HQ) {
#pragma unroll
                      for (int n = 0; n < 4; ++n) {
                        const float4 lb4 = *reinterpret_cast<const float4*>(p.lbt + cb - E_FF + n * 16 + fq * 4);
                        const float lb[4] = {lb4.x, lb4.y, lb4.z, lb4.w};
#pragma unroll
                        for (int m = 0; m < 4; ++m)
#pragma unroll
                          for (int j = 0; j < 4; ++j)
                            acc[m][n][j] = __logf(lb[j] + (1.0f - lb[j]) / (1.0f + __expf(-acc[m][n][j])));
                      }
                    }
                  }
#pragma unroll
                  for (int m = 0; m < 4; ++m) {
                    const int row = wr * 64 + m * 16 + fr;
#pragma unroll
                    for (int n = 0; n < 4; ++n) {
                      const int col = wc * 64 + n * 16 + fq * 4;
                      if (col < nlim)
                        *reinterpret_cast<uint2*>(Cb + (long)row * ldc + col) =
                            make_uint2(pack2(acc[m][n][0] * scale, acc[m][n][1] * scale), pack2(acc[m][n][2] * scale, acc[m][n][3] * scale));
                    }
                  }
                });
    }
  }
}

template <class RowMap>
__device__ __forceinline__ void conv_tile_rm(const float* src, int lds_, int Nvalid, int k0, int n0, act_t* dst, int ldd, float* tile, RowMap rm) {
  const int tid = threadIdx.x;
  {
    const int r = tid >> 5, c4 = (tid & 31) * 4;
    float4 v[8];
#pragma unroll
    for (int rr = 0; rr < 8; ++rr) {
      v[rr] = make_float4(0.f, 0.f, 0.f, 0.f);
      if (n0 + c4 < Nvalid) v[rr] = *reinterpret_cast<const float4*>(src + (long)(k0 + r + rr * 8) * lds_ + n0 + c4);
    }
#pragma unroll
    for (int rr = 0; rr < 8; ++rr) {
      float* t = tile + (r + rr * 8) * 129 + c4;
      t[0] = v[rr].x; t[1] = v[rr].y; t[2] = v[rr].z; t[3] = v[rr].w;
    }
  }
  __syncthreads();
  {
    const int n = tid >> 1, ks = (tid & 1) * 32;
    if (n0 + n < Nvalid) {
      unsigned w[16];
#pragma unroll
      for (int i = 0; i < 16; ++i) w[i] = pack2(tile[(ks + 2 * i) * 129 + n], tile[(ks + 2 * i + 1) * 129 + n]);
      uint4* d = reinterpret_cast<uint4*>(dst + (long)rm(n) * ldd + k0 + ks);
      d[0] = make_uint4(w[0], w[1], w[2], w[3]);
      d[1] = make_uint4(w[4], w[5], w[6], w[7]);
      d[2] = make_uint4(w[8], w[9], w[10], w[11]);
      d[3] = make_uint4(w[12], w[13], w[14], w[15]);
    }
  }
  __syncthreads();
}

template <class RowMap>
__device__ __forceinline__ void conv_tile8_rm(const float* src, int lds_, int k0, int n0, fp8_t* dst, int ldd, float* tile, float scale, RowMap rm) {
  const int tid = threadIdx.x;
  {
    const int r = tid >> 5, c4 = (tid & 31) * 4;
    float4 v[8];
#pragma unroll
    for (int rr = 0; rr < 8; ++rr) v[rr] = *reinterpret_cast<const float4*>(src + (long)(k0 + r + rr * 8) * lds_ + n0 + c4);
#pragma unroll
    for (int rr = 0; rr < 8; ++rr) {
      float* t = tile + (r + rr * 8) * 129 + c4;
      t[0] = v[rr].x; t[1] = v[rr].y; t[2] = v[rr].z; t[3] = v[rr].w;
    }
  }
  __syncthreads();
  {
    const int n = tid >> 1, ks = (tid & 1) * 32;
    unsigned w[8];
#pragma unroll
    for (int i = 0; i < 8; ++i)
      w[i] = pack4_fp8(tile[(ks + 4 * i) * 129 + n] * scale, tile[(ks + 4 * i + 1) * 129 + n] * scale,
                       tile[(ks + 4 * i + 2) * 129 + n] * scale, tile[(ks + 4 * i + 3) * 129 + n] * scale);
    uint4* d = reinterpret_cast<uint4*>(dst + (long)rm(n) * ldd + k0 + ks);
    d[0] = make_uint4(w[0], w[1], w[2], w[3]);
    d[1] = make_uint4(w[4], w[5], w[6], w[7]);
  }
  __syncthreads();
}

__device__ __forceinline__ void conv_tile(const float* src, int lds_, int Nvalid, int k0, int n0, act_t* dst, int ldd, float* tile) {
  conv_tile_rm(src, lds_, Nvalid, k0, n0, dst, ldd, tile, [=](int n) { return n0 + n; });
}

__device__ __forceinline__ void phase_convert_experts(const Params& p, int l, unsigned char* smem, int blk, int nblk) {
  float* tile = (float*)smem;
  const int per_e = 192;
  fp8_t* Wup = l == 0 ? p.W8up : p.W8up1;
  fp8_t* Wdn = l == 0 ? p.W8down : p.W8down1;
  for (int job = blk; job < NEXP * per_e; job += nblk) {
    const int e = job / per_e, j = job % per_e;
    if (j < 128) {
      const int up = j >> 6, jj = j & 63;
      const int kt = jj >> 2, fp = jj & 3;
      const float* src = (up ? p.w_eu : p.w_eg) + ((long)(l * NEXP + e) * D) * DFF;
      const int rbase = fp * 256 + up * 32;
      conv_tile8_rm(src, DFF, kt * 64, fp * 128, Wup + (long)e * 1024 * D, D, tile, SW8,
                    [=](int n) { return rbase + (n >> 6) * 128 + ((n >> 5) & 1) * 64 + (n & 31); });
    } else {
      const int jj = j - 128;
      const int kt = jj >> 3, nt = jj & 7;
      const float* src = p.w_ed + ((long)(l * NEXP + e) * DFF) * D;
      const int n0 = nt * 128;
      conv_tile8_rm(src, D, kt * 64, n0, Wdn + (long)e * 1024 * DFF, DFF, tile, SW8, [=](int n) { return n0 + n; });
    }
  }
}

__device__ __forceinline__ void phase_moe(const Params& p, int l, bool down, unsigned char* smem) {
  const int* cntp = p.cnt + l * NEXP * 64;
  int total = 0;
  for (int e = 0; e < NEXP; ++e) total += ((cntp[e * 64] + 127) >> 7) * 8;
  for (int tile = blockIdx.x; tile < total; tile += gridDim.x) {
    int e = 0, tb = 0, rowoff = 0;
    for (; e < NEXP - 1; ++e) {
      const int c = cntp[e * 64];
      const int nt = ((c + 127) >> 7) * 8;
      if (tile < tb + nt) break;
      tb += nt; rowoff += c;
    }
    const int c = cntp[e * 64];
    const int lt = tile - tb, mt = lt >> 3, nt = lt & 7;
    const int rows_valid = min(128, c - mt * 128);
    const int* lst = p.list + (long)(l * NEXP + e) * NR + mt * 128;
    const long hrow0 = (long)rowoff + mt * 128;
    if (!down) {
      gemm_tile8([&](int r) { return p.u8 + (long)(lst[min(r, rows_valid - 1)] >> 1) * D; },
                (l == 0 ? p.W8up : p.W8up1) + ((long)e * 1024 + nt * 128) * D, D, smem,
                [&](f32x4 (&acc)[4][4], int wr, int wc, int fr, int fq) {
                  constexpr float dq = 1.0f / (SU8 * SW8);
#pragma unroll
                  for (int m = 0; m < 4; ++m) {
                    const int row = wr * 64 + m * 16 + fr;
                    if (row < rows_valid) {
#pragma unroll
                      for (int n = 0; n < 2; ++n) {
                        float hv[4];
#pragma unroll
                        for (int j = 0; j < 4; ++j) {
                          const float g = acc[m][n][j] * dq, uu = acc[m][n + 2][j] * dq;
                          hv[j] = g / (1.0f + __expf(-g)) * uu * SH8;
                        }
                        *reinterpret_cast<unsigned*>(p.H8 + (hrow0 + row) * DFF + nt * 64 + wc * 32 + n * 16 + fq * 4) =
                            pack4_fp8(hv[0], hv[1], hv[2], hv[3]);
                      }
                    }
                  }
                });
    } else {
      const fp8_t* Ab = p.H8 + hrow0 * DFF;
      gemm_tile8([&](int r) { return Ab + (long)r * DFF; }, (l == 0 ? p.W8down : p.W8down1) + ((long)e * 1024 + nt * 128) * DFF, DFF, smem,
                [&](f32x4 (&acc)[4][4], int wr, int wc, int fr, int fq) {
                  constexpr float dq = 1.0f / (SH8 * SW8);
#pragma unroll
                  for (int m = 0; m < 4; ++m) {
                    const int row = wr * 64 + m * 16 + fr;
                    if (row < rows_valid) {
                      const int ts = lst[row];
                      const float w = p.ew[ts] * dq;
#pragma unroll
                      for (int n = 0; n < 4; ++n)
                        *reinterpret_cast<uint2*>(p.Y + (long)ts * D + nt * 128 + wc * 64 + n * 16 + fq * 4) =
                            make_uint2(pack2(acc[m][n][0] * w, acc[m][n][1] * w), pack2(acc[m][n][2] * w, acc[m][n][3] * w));
                    }
                  }
                });
    }
  }
}

__device__ __forceinline__ void phase_convert_dense(const Params& p, unsigned char* smem) {
  float* tile = (float*)smem;
  const int JM = 48, J0 = JM + 16 * 26, J1 = J0 + 128, J2 = J1 + 16 * 19, J3 = J2 + 128;
  for (int job = blockIdx.x; job < J3; job += gridDim.x) {
    if (job < JM) { mod_item(p, job, smem); continue; }
    if (job < J0) { int j = job - JM; conv_tile(p.w_in_even, IN_EVEN, IN_EVEN, (j / 26) * 64, (j % 26) * 128, p.Wt_in_even, D, tile); }
    else if (job < J1) { int j = job - J0; conv_tile(p.w_out_even, D, D, (j / 8) * 64, (j % 8) * 128, p.Wt_out_even, D, tile); }
    else if (job < J2) { int j = job - J1; conv_tile(p.w_in_odd, IN_ODD, O_FA, (j / 19) * 64, (j % 19) * 128, p.Wt_in_odd, D, tile); }
    else { int j = job - J2; conv_tile(p.w_out_odd, D, D, (j / 8) * 64, (j % 8) * 128, p.Wt_out_odd, D, tile); }
  }
}

__device__ __forceinline__ void phase_fold_z(const Params& p, long gtid, long gstride, float* tab) {
  if (threadIdx.x < 64) {
    float sn, cs;
    sincospif((float)threadIdx.x * (1.0f / 32.0f), &sn, &cs);
    tab[threadIdx.x] = cs; tab[64 + threadIdx.x] = -sn;
  }
  __syncthreads();
  for (long i = gtid; i < (long)512 * D; i += gstride) {
    const int k = (int)(i % D), np = (int)(i / D);
    const int part = np >> 8, col = np & 255, g = col >> 6, cp = col & 63;
    const float* wz = p.w_in_odd + (long)k * IN_ODD + O_Z + g * 64;
    float s = 0.f;
    const float* tb = tab + part * 64;
#pragma unroll 8
    for (int c = 0; c < 64; ++c) s += wz[c] * tb[(c * cp) & 63];
    stA(p.Wt_in_odd + (long)(O_FA + np) * D + k, s);
  }
  for (long i = gtid; i < (long)(IN_ODD_PAD - O_END) * D; i += gstride) p.Wt_in_odd[(long)O_END * D + i] = 0;
}

__device__ __forceinline__ void phase_cmat(const Params& p, long gtid, long gstride) {
  for (long i = gtid; i < (long)T * T; i += gstride) {
    const int t = (int)(i % T), tp = (int)(i / T);
    float sn, cs;
    sincospif((float)((t * tp) & (T - 1)) * (2.0f / T), &sn, &cs);
    stA(p.Cmat + (long)tp * 2 * T + t, cs);
    stA(p.Cmat + (long)tp * 2 * T + T + t, sn);
  }
}

__device__ __forceinline__ void row_stats(const float4 (&v)[4], float& mu, float& rs) {
  float s = 0.f;
#pragma unroll
  for (int i = 0; i < 4; ++i) s += v[i].x + v[i].y + v[i].z + v[i].w;
  mu = wave_sum(s) * (1.0f / D);
  float q = 0.f;
#pragma unroll
  for (int i = 0; i < 4; ++i) {
    float a = v[i].x - mu, b = v[i].y - mu, c = v[i].z - mu, d = v[i].w - mu;
    q += a * a + b * b + c * c + d * d;
  }
  rs = 1.0f / sqrtf(wave_sum(q) * (1.0f / D) + LN_EPS);
}

__device__ __forceinline__ void phase_lnmod_first(const Params& p) {
  const int lane = threadIdx.x & 63;
  const long w0 = (long)blockIdx.x * 4 + (threadIdx.x >> 6), wstride = (long)gridDim.x * 4;
  for (long row = w0; row < NR; row += wstride) {
    const float4* h = reinterpret_cast<const float4*>(hrow_in(p, row));
    const float* md = modrow(p, 0, row);
    float4 v[4];
#pragma unroll
    for (int i = 0; i < 4; ++i) v[i] = h[i * 64 + lane];
    float mu, rs;
    row_stats(v, mu, rs);
#pragma unroll
    for (int i = 0; i < 4; ++i) {
      const float4 sh = reinterpret_cast<const float4*>(md)[i * 64 + lane];
      const float4 sc = reinterpret_cast<const float4*>(md + D)[i * 64 + lane];
      float a = (v[i].x - mu) * rs * (1.f + sc.x) + sh.x, b = (v[i].y - mu) * rs * (1.f + sc.y) + sh.y;
      float c = (v[i].z - mu) * rs * (1.f + sc.z) + sh.z, d = (v[i].w - mu) * rs * (1.f + sc.w) + sh.w;
      reinterpret_cast<uint2*>(p.u + row * D)[i * 64 + lane] = make_uint2(pack2(a, b), pack2(c, d));
    }
  }
}

template <int R_UNUSED>
__device__ __forceinline__ void phase_resid_ln(const Params& p, int l, int sub, long row_lo, long row_hi, unsigned char* smem) {
  const int lane = threadIdx.x & 63;
  int* cntL = (int*)smem;
  int* nent = cntL + 16;
  int* entL = cntL + 32;
  float* wT = (float*)(smem + 4096);
  if (sub == 0) {
    if (threadIdx.x < 32) cntL[threadIdx.x] = 0;
    for (int i = threadIdx.x; i < D * NEXP; i += 256) wT[(i & 15) * D + (i >> 4)] = p.w_router[i];
    __syncthreads();
  }
  const bool last = (sub == 1 && l == 1);
  const long nw = (long)gridDim.x * 4, wi = (long)blockIdx.x * 4 + (threadIdx.x >> 6);
  const long rpw = (row_hi - row_lo + nw - 1) / nw;
  const long r0 = row_lo + wi * rpw, r1 = min(row_hi, r0 + rpw);
  const float4* lgp = reinterpret_cast<const float4*>(p.ln_g + (l * 2 + sub) * D);
  const float4* lbp = reinterpret_cast<const float4*>(p.ln_b + (l * 2 + sub) * D);
  float4 lgv[4], lbv[4];
  if (R_UNUSED != 1) {
#pragma unroll
    for (int i = 0; i < 4; ++i) { lgv[i] = lgp[i * 64 + lane]; lbv[i] = lbp[i * 64 + lane]; }
  }
  float4 gv[4], shv[4], scv[4];
  int cur_bb = -2;
  float4 hv[4];
  uint2 mv[4], m2v[4];
  auto load_row = [&](long row) {
    const float4* hin = reinterpret_cast<const float4*>((l == 0 && sub == 0) ? hrow_in(p, row) : hrow(p, row));
    const uint2* m = reinterpret_cast<const uint2*>(sub == 0 ? p.M + row * D : p.Y + row * 2 * D);
#pragma unroll
    for (int i = 0; i < 4; ++i) {
      hv[i] = hin[i * 64 + lane];
      mv[i] = m[i * 64 + lane];
      if (sub == 1) m2v[i] = m[256 + i * 64 + lane];
    }
  };
  if (r0 < r1) load_row(r0);
  for (long row = r0; row < r1; ++row) {
    const int bb = row < NC ? NB : (int)((row - NC) / T);
    if (bb != cur_bb) {
      cur_bb = bb;
      const float* md = p.mod + ((long)l * (NB + 1) + bb) * 6 * D;
      const float* md2 = (sub == 0) ? md + 3 * D : p.mod + ((long)(NB + 1) + bb) * 6 * D;
#pragma unroll
      for (int i = 0; i < 4; ++i) {
        gv[i] = reinterpret_cast<const float4*>(md + (sub == 0 ? 2 : 5) * D)[i * 64 + lane];
        shv[i] = reinterpret_cast<const float4*>(md2)[i * 64 + lane];
        scv[i] = reinterpret_cast<const float4*>(md2 + D)[i * 64 + lane];
      }
    }
    float4 v[4];
#pragma unroll
    for (int i = 0; i < 4; ++i) {
      float m0 = bf_lo(mv[i].x), m1 = bf_hi(mv[i].x), m2_ = bf_lo(mv[i].y), m3 = bf_hi(mv[i].y);
      if (sub == 1) { m0 += bf_lo(m2v[i].x); m1 += bf_hi(m2v[i].x); m2_ += bf_lo(m2v[i].y); m3 += bf_hi(m2v[i].y); }
      v[i].x = ALPHA * hv[i].x + gv[i].x * m0;
      v[i].y = ALPHA * hv[i].y + gv[i].y * m1;
      v[i].z = ALPHA * hv[i].z + gv[i].z * m2_;
      v[i].w = ALPHA * hv[i].w + gv[i].w * m3;
    }
    load_row(min(row + 1, r1 - 1));
    if (R_UNUSED == 1) {
#pragma unroll
      for (int i = 0; i < 4; ++i) { lgv[i] = lgp[i * 64 + lane]; lbv[i] = lbp[i * 64 + lane]; }
    }
    float mu, rs;
    row_stats(v, mu, rs);
#pragma unroll
    for (int i = 0; i < 4; ++i) {
      v[i].x = (v[i].x - mu) * rs * lgv[i].x + lbv[i].x;
      v[i].y = (v[i].y - mu) * rs * lgv[i].y + lbv[i].y;
      v[i].z = (v[i].z - mu) * rs * lgv[i].z + lbv[i].z;
      v[i].w = (v[i].w - mu) * rs * lgv[i].w + lbv[i].w;
    }
    float4* hout = reinterpret_cast<float4*>(hrow(p, row));
    if (last) {
#pragma unroll
      for (int i = 0; i < 4; ++i) hout[i * 64 + lane] = v[i];
      continue;
    }
    row_stats(v, mu, rs);
    float lo[NEXP];
#pragma unroll
    for (int e = 0; e < NEXP; ++e) lo[e] = 0.f;
    uint2 up[4];
#pragma unroll
    for (int i = 0; i < 4; ++i) {
      float uv[4];
      uv[0] = (v[i].x - mu) * rs * (1.f + scv[i].x) + shv[i].x;
      uv[1] = (v[i].y - mu) * rs * (1.f + scv[i].y) + shv[i].y;
      uv[2] = (v[i].z - mu) * rs * (1.f + scv[i].z) + shv[i].z;
      uv[3] = (v[i].w - mu) * rs * (1.f + scv[i].w) + shv[i].w;
      up[i] = (sub == 0) ? make_uint2(pack4_fp8(uv[0] * SU8, uv[1] * SU8, uv[2] * SU8, uv[3] * SU8), 0u)
                         : make_uint2(pack2(uv[0], uv[1]), pack2(uv[2], uv[3]));
      if (sub == 0) {
#pragma unroll
        for (int e = 0; e < NEXP; ++e) {
          const float4 w4 = *reinterpret_cast<const float4*>(wT + e * D + (i * 64 + lane) * 4);
          lo[e] += uv[0] * w4.x + uv[1] * w4.y + uv[2] * w4.z + uv[3] * w4.w;
          if ((e & 3) == 3) __builtin_amdgcn_sched_barrier(0);
        }
      }
    }
    int ge1 = 0, ge2 = 0;
    float w1 = 0.f, w2 = 0.f;
    if (sub == 0) {
      float mine = 0.f;
#pragma unroll
      for (int e = 0; e < NEXP; ++e) {
        const float rsum = row_sum16(lo[e]);
        mine = ((lane & 15) == e) ? rsum : mine;
      }
      mine += __shfl_xor(mine, 16);
      mine += __shfl_xor(mine, 32);
#pragma unroll
      for (int e = 0; e < NEXP; ++e) lo[e] = __int_as_float(__builtin_amdgcn_readlane(__float_as_int(mine), e));
      float mx = lo[0];
#pragma unroll
      for (int e = 1; e < NEXP; ++e) mx = fmaxf(mx, lo[e]);
      float sum = 0.f;
#pragma unroll
      for (int e = 0; e < NEXP; ++e) { lo[e] = __expf(lo[e] - mx); sum += lo[e]; }
      const float inv = 1.0f / sum;
      float bestg = -1e30f, gp1 = 0.f, gp2 = 0.f;
#pragma unroll
      for (int gq = 0; gq < 4; ++gq) {
        float s1 = -1e30f, s2 = -1e30f, p1 = 0.f, p2 = 0.f;
        int e1 = 0, e2 = 0;
#pragma unroll
        for (int j = 0; j < 4; ++j) {
          const int e = gq * 4 + j;
          const float pe = lo[e] * inv;
          const float se = pe + p.b_router[e];
          if (se > s1) { s2 = s1; p2 = p1; e2 = e1; s1 = se; p1 = pe; e1 = e; }
          else if (se > s2) { s2 = se; p2 = pe; e2 = e; }
        }
        const float gs = s1 + s2;
        if (gs > bestg) { bestg = gs; ge1 = e1; ge2 = e2; gp1 = p1; gp2 = p2; }
      }
      const float wsum = gp1 + gp2;
      w1 = gp1 / wsum; w2 = gp2 / wsum;
    }
#pragma unroll
    for (int i = 0; i < 4; ++i) hout[i * 64 + lane] = v[i];
    if (sub == 0) {
#pragma unroll
      for (int i = 0; i < 4; ++i) reinterpret_cast<unsigned*>(p.u8 + row * D)[i * 64 + lane] = up[i].x;
    } else {
#pragma unroll
      for (int i = 0; i < 4; ++i) reinterpret_cast<uint2*>(p.u + row * D)[i * 64 + lane] = up[i];
    }
    if (sub == 0 && lane == 0) {
      p.ew[row * 2 + 0] = w1; p.ew[row * 2 + 1] = w2;
      const int lp1 = atomicAdd(cntL + ge1, 1), lp2 = atomicAdd(cntL + ge2, 1);
      const int ei = atomicAdd(nent, 2);
      entL[2 * ei] = ((int)(row * 2) << 4) | ge1; entL[2 * ei + 1] = lp1;
      entL[2 * ei + 2] = ((int)(row * 2 + 1) << 4) | ge2; entL[2 * ei + 3] = lp2;
    }
  }
  if (sub == 0) {
    __syncthreads();
    if (threadIdx.x < NEXP) {
      const int c = cntL[threadIdx.x];
      cntL[threadIdx.x] = c ? atomicAdd(p.cnt + (l * NEXP + threadIdx.x) * 64, c) : 0;
    }
    __syncthreads();
    const int ne = *nent;
    for (int i = threadIdx.x; i < ne; i += 256) {
      const int key = entL[2 * i], lp = entL[2 * i + 1];
      const int e = key & 15;
      p.list[(long)(l * NEXP + e) * NR + cntL[e] + lp] = key >> 4;
    }
    __syncthreads();
  }
}

#define LOOP(n) for (long i = gtid; i < (long)(n); i += gstride)

#ifdef ONLY_PHASE
#define PH(n, ...) if (ONLY_PHASE == n) { __VA_ARGS__ }
#define GSYNC()
#else
#define PH(n, ...) { __VA_ARGS__ }
#define GSYNC() xcd_barrier(xb)
#endif

__global__ void __launch_bounds__(256, 2) mega_kernel(Params p) {
  cg::grid_group grid = cg::this_grid();
  __shared__ __attribute__((aligned(16))) unsigned char smem[SMEM_BYTES + 16];
  if (threadIdx.x == 0) *reinterpret_cast<uint4*>(smem + SMEM_BYTES) = make_uint4(0u, 0u, 0u, 0u);
  __syncthreads();
  XcdBarrier xb = xcd_barrier_post(p.bar, (volatile LAS unsigned*)(smem + SMEM_BYTES));
  const long gtid = (long)blockIdx.x * blockDim.x + threadIdx.x;
  const long gstride = (long)gridDim.x * blockDim.x;
  const int nsb = min(256, (int)gridDim.x / 2);
  PH(0,
    if (gtid < 2 * NEXP) p.cnt[gtid * 64] = 0;
    phase_convert_dense(p, smem);
    phase_fold_z(p, gtid, gstride, (float*)(smem + 65536));
    LOOP(T > 1024 ? T : 1024) ph_tables(p, i);)
#ifndef ONLY_PHASE
  if (p.use_cg_sync) grid.sync();
#endif
  GSYNC();
  PH(1, phase_lnmod_first(p);)
  GSYNC();
  PH(2, phase_gemm(p, GemmJob{p.u, p.Wt_in_even, p.P, 0, 0, 0, 1, NR / 128, IN_EVEN / 128, D, PW, IN_EVEN, 2, 1.0f}, smem);)
  GSYNC();
  PH(3,
    if ((int)blockIdx.x < nsb) phase_scan<0>(p, smem, blockIdx.x, nsb);
    else { phase_attn(p, smem, blockIdx.x - nsb, gridDim.x - nsb); phase_convert_experts(p, 0, smem, blockIdx.x - nsb, gridDim.x - nsb); })
  GSYNC();
  PH(4, phase_combine<0>(p);)
  GSYNC();
  PH(5, phase_gemm(p, GemmJob{p.u, p.Wt_out_even, p.M, 0, 0, 0, 1, NR / 128, D / 128, D, D, D, 0, 1.0f}, smem);)
  GSYNC();
  PH(6, phase_resid_ln<1>(p, 0, 0, 0, NR, smem);)
  GSYNC();
  PH(7, phase_moe(p, 0, false, smem);)
  GSYNC();
  PH(8, phase_moe(p, 0, true, smem);)
  GSYNC();
  PH(9, phase_resid_ln<2>(p, 0, 1, 0, NR, smem); phase_cmat(p, gtid, gstride);)
  GSYNC();
  PH(10, phase_gemm(p, GemmJob{p.u, p.Wt_in_odd, p.P, 0, 0, 0, 1, NR / 128, IN_ODD_PAD / 128, D, PW, O_FA, 1, 1.0f}, smem);)
  GSYNC();
  PH(11, phase_gla_decay(p);)
  GSYNC();
  PH(12,
    if ((int)blockIdx.x < nsb) phase_scan<1>(p, smem, blockIdx.x, nsb);
    else {
      phase_gemm(p, GemmJob{p.Cmat, p.FT, p.u + (long)NC * D + 768, 0, (long)256 * 2 * T, (long)T * D, NB, T / 128, 2, 2 * T, D,
                            256, 0, 0.00276213586400995f}, smem, blockIdx.x - nsb, gridDim.x - nsb);
      phase_convert_experts(p, 1, smem, blockIdx.x - nsb, gridDim.x - nsb);
    })
  GSYNC();
  PH(13, phase_combine<1>(p);)
  GSYNC();
  PH(14,
    phase_gemm(p, GemmJob{p.u + (long)NC * D, p.Wt_out_odd, p.M + (long)NC * D, 0, 0, 0, 1, NT / 128, D / 128, D, D, D, 0, 1.0f}, smem);)
  GSYNC();
  PH(15, phase_resid_ln<1>(p, 1, 0, NC, NR, smem);)
  GSYNC();
  PH(16, phase_moe(p, 1, false, smem);)
  GSYNC();
  PH(17, phase_moe(p, 1, true, smem);)
  GSYNC();
  PH(18, phase_resid_ln<2>(p, 1, 1, NC, NR, smem);)
}

static size_t carve(Params& p, char* ws) {
  size_t off = 0;
  auto take = [&](size_t bytes) { char* r = ws + off; off += (bytes + 255) & ~(size_t)255; return r; };
  p.mod = (float*)take(sizeof(float) * 2 * (NB + 1) * 6 * D);
  p.hc = (float*)take(sizeof(float) * (size_t)NC * D);
  p.costab = (float*)take(sizeof(float) * T);
  p.sintab = (float*)take(sizeof(float) * T);
  p.lbt = (float*)take(sizeof(float) * 1024);
  p.ropetab = (float*)take(sizeof(float) * 64 * 16 * 2);
  p.ew = (float*)take(sizeof(float) * (size_t)NR * 2);
  p.eidx = nullptr;
  p.u = (act_t*)take(sizeof(act_t) * (size_t)NR * D);
  p.P = (act_t*)take(sizeof(act_t) * (size_t)NR * PW);
  p.OF = (act_t*)take(sizeof(act_t) * (size_t)NR * 768);
  p.OB = (act_t*)take(sizeof(act_t) * (size_t)NR * 768);
  p.M = p.OF;
  p.Cmat = (act_t*)take(sizeof(act_t) * (size_t)T * 2 * T);
  p.FT = (act_t*)take(sizeof(act_t) * (size_t)NB * 256 * 2 * T);
  p.LF = (act_t*)take(sizeof(act_t) * (size_t)2 * NR * 384);
  p.W8up = (unsigned char*)p.Cmat;
  p.W8down = p.W8up + (size_t)NEXP * 1024 * D;
  p.W8up1 = (unsigned char*)take((size_t)NEXP * 1024 * (D + DFF));
  p.W8down1 = p.W8up1 + (size_t)NEXP * 1024 * D;
  p.u8 = (unsigned char*)take((size_t)NR * D);
  p.Y = p.P;
  p.H8 = (unsigned char*)(p.P + (size_t)2 * NR * D);
  p.bar = (unsigned*)take(sizeof(unsigned) * XCD_BAR_WORDS);
  p.cnt = (int*)take(sizeof(int) * 2 * NEXP * 64);
  p.list = (int*)take(sizeof(int) * (size_t)2 * NEXP * NR);
  p.Wt_in_even = (act_t*)take(sizeof(act_t) * (size_t)IN_EVEN * D);
  p.Wt_out_even = (act_t*)take(sizeof(act_t) * (size_t)D * D);
  p.Wt_in_odd = (act_t*)take(sizeof(act_t) * (size_t)IN_ODD_PAD * D);
  p.Wt_out_odd = (act_t*)take(sizeof(act_t) * (size_t)D * D);
  return off;
}

static void fill_inputs(Params& p, void* const* d_in) {
  const float** f = (const float**)&p;
  for (int i = 0; i < 23; ++i) f[i] = (const float*)d_in[i];
}

extern "C" void kernel_launch(void* const* d_in, const int* in_sizes, int n_in, void* d_out, int out_size,
                              void* d_ws, size_t ws_size, hipStream_t stream) {
  static int grid_blocks = 0;
  if (!grid_blocks) {
    int dev = 0, cus = 0, per_cu = 0;
    (void)hipGetDevice(&dev);
    (void)hipDeviceGetAttribute(&cus, hipDeviceAttributeMultiprocessorCount, dev);
    (void)hipOccupancyMaxActiveBlocksPerMultiprocessor(&per_cu, mega_kernel, 256, 0);
    grid_blocks = cus * per_cu;
  }
  Params p{};
  fill_inputs(p, d_in);
  p.out = (float*)d_out;
  size_t need = carve(p, (char*)d_ws);
  if (need > ws_size) { fprintf(stderr, "workspace too small: need %zu have %zu\n", need, ws_size); return; }
  (void)hipMemsetAsync(p.bar, 0, sizeof(unsigned) * XCD_BAR_WORDS, stream);
  void* args[] = {&p};
  hipError_t e = hipLaunchCooperativeKernel((void*)mega_kernel, dim3(grid_blocks), dim3(256), args, 0, stream);
  if (e != hipSuccess) fprintf(stderr, "cooperative launch failed: %s (grid %d)\n", hipGetErrorString(e), grid_blocks);
}
#endif
```

```cpp
#ifndef HOST_TEST
#include <hip/hip_runtime.h>
#include <hip/hip_cooperative_groups.h>
#include <cstdio>
namespace cg = cooperative_groups;
#define DEV __device__ __forceinline__
#else
#include <cmath>
#include <cstdio>
#include <cstdlib>
#include <cstring>
#define DEV static inline
#endif

#ifndef T_BATCH
#define T_BATCH 8
#endif
#ifndef T_SEQ
#define T_SEQ 2048
#endif
#ifndef T_CTX
#define T_CTX 256
#endif

constexpr int D = 1024, NB = T_BATCH, T = T_SEQ, C = T_CTX;
constexpr int NC = NB * C, NT = NB * T, NR = NC + NT;
constexpr int GRID_W = 64;
constexpr int IN_EVEN = 3328, IN_ODD = 2592, PW = 3328;
constexpr int NEXP = 16, DFF = 512;
constexpr float ALPHA = 1.4142135623730951f;
constexpr float LN_EPS = 1e-5f;
constexpr int E_AQ = 0, E_AK = 512, E_AV = 640, E_FF = 768, E_HQ = 1792, E_HI = 2304, E_HG = 2816;
constexpr int O_Q = 0, O_K = 384, O_V = 768, O_RF = 1536, O_G = 1568, O_Z = 2336;

#ifdef HOST_TEST
typedef float act_t;
DEV float ldA(const act_t* p) { return *p; }
DEV void stA(act_t* p, float v) { *p = v; }
#else
typedef unsigned short act_t;
DEV float ldA(const act_t* p) { return __uint_as_float(((unsigned)*p) << 16); }
DEV void stA(act_t* p, float v) {
  unsigned u = __float_as_uint(v);
  u += 0x7fffu + ((u >> 16) & 1u);
  *p = (unsigned short)(u >> 16);
}
#endif

struct Params {
  const float *x, *c, *ctx, *c_ctx, *w_ada, *b_ada, *ln_g, *ln_b, *w_in_even, *attn_sink, *lb_logits, *hgrn_norm,
      *w_out_even, *w_in_odd, *gla_gate_w, *gla_gate_b, *gla_norm, *w_out_odd, *w_router, *b_router, *w_eg, *w_eu,
      *w_ed;
  float* out;
  float *mod, *hc, *costab, *sintab, *lbt, *ew, *ropetab;
  int* eidx;
  act_t *u, *P, *OF, *OB, *M, *LF;
  act_t *Wt_in_even, *Wt_out_even, *Wt_in_odd, *Wt_out_odd;
  act_t *Y, *Cmat, *FT;
  unsigned char *W8up, *W8down, *W8up1, *W8down1, *H8, *u8;
  unsigned char *W8in_even, *W8in_odd;
  int *cnt, *list;
  unsigned* bar;
  int use_cg_sync;
  int pad_;
};

DEV float sigmoidf_(float v) { return 1.0f / (1.0f + expf(-v)); }
DEV float siluf_(float v) { return v / (1.0f + expf(-v)); }

DEV const float* hrow_in(const Params& p, long row) {
  return row < NC ? p.ctx + row * D : p.x + (row - NC) * D;
}
DEV float* hrow(const Params& p, long row) { return row < NC ? p.hc + row * D : p.out + (row - NC) * D; }
DEV const float* modrow(const Params& p, int l, long row) {
  int bb = row < NC ? NB : (int)((row - NC) / T);
  return p.mod + ((long)l * (NB + 1) + bb) * 6 * D;
}

DEV void ph_mod(const Params& p, long i) {
  int j = (int)(i % (6 * D));
  int bb = (int)((i / (6 * D)) % (NB + 1));
  int l = (int)(i / ((long)6 * D * (NB + 1)));
  const float* cv = bb < NB ? p.c + (long)bb * D : p.c_ctx;
  const float* w = p.w_ada + (long)l * D * 6 * D + j;
  float s = p.b_ada[l * 6 * D + j];
  for (int k = 0; k < D; ++k) s += siluf_(cv[k]) * w[(long)k * 6 * D];
  p.mod[i] = s;
}

DEV void ph_tables(const Params& p, long i) {
  if (i < T) {
    double a = 6.283185307179586476925 * (double)i / (double)T;
    p.costab[i] = (float)cos(a);
    p.sintab[i] = (float)sin(a);
  }
  if (i < 1024) {
    int pos = (int)(i >> 4), idx = (int)(i & 15);
    float ang = (float)pos * powf(10000.0f, -(float)idx / 16.0f);
    p.ropetab[2 * i] = cosf(ang);
    p.ropetab[2 * i + 1] = sinf(ang);
  }
  if (i < 1024) {
    int dir = (int)(i / 512), col = (int)(i % 512);
    float l0 = p.lb_logits[(dir * 2 + 0) * 512 + col], l1 = p.lb_logits[(dir * 2 + 1) * 512 + col];
    p.lbt[i] = 1.0f / (1.0f + expf(l1 - l0));
  }
}

DEV void ln_mod_row(const float* h, const float* shift, const float* scale, act_t* u) {
  float mu = 0.f;
  for (int k = 0; k < D; ++k) mu += h[k];
  mu *= (1.0f / D);
  float var = 0.f;
  for (int k = 0; k < D; ++k) { float d = h[k] - mu; var += d * d; }
  var *= (1.0f / D);
  float rs = 1.0f / sqrtf(var + LN_EPS);
  for (int k = 0; k < D; ++k) stA(u + k, (h[k] - mu) * rs * (1.0f + scale[k]) + shift[k]);
}

DEV void ph_lnmod_first(const Params& p, long row) {
  const float* m = modrow(p, 0, row);
  ln_mod_row(hrow_in(p, row), m, m + D, p.u + row * D);
}

DEV void gemm_item_act(const act_t* A, const float* W, act_t* Cout, int K, int N, int ldc, long i) {
  int n4 = (int)(i % (N / 4));
  long row = i / (N / 4);
  const act_t* a = A + row * K;
  const float* w = W + n4 * 4;
  float s0 = 0, s1 = 0, s2 = 0, s3 = 0;
  for (int k = 0; k < K; ++k) {
    float av = ldA(a + k);
    const float* wr = w + (long)k * N;
    s0 += av * wr[0]; s1 += av * wr[1]; s2 += av * wr[2]; s3 += av * wr[3];
  }
  act_t* o = Cout + row * ldc + n4 * 4;
  stA(o, s0); stA(o + 1, s1); stA(o + 2, s2); stA(o + 3, s3);
}

DEV void ph_rope(const Params& p, long i) {
  int pr = (int)(i % 32);
  int hh = (int)((i / 32) % 10);
  long lr = i / 320;
  int t = (int)(lr % T);
  int col = hh < 8 ? E_AQ + hh * 64 : E_AK + (hh - 8) * 64;
  int idx = pr & 15;
  int pos = pr < 16 ? t / GRID_W : t % GRID_W;
  int d0 = pr < 16 ? idx : 32 + idx;
  float inv = powf(10000.0f, -(float)idx / 16.0f);
  float ang = (float)pos * inv;
  float cs = cosf(ang), sn = sinf(ang);
  act_t* base = p.P + (NC + lr) * PW + col;
  float x1 = ldA(base + d0), x2 = ldA(base + d0 + 16);
  stA(base + d0, x1 * cs - x2 * sn);
  stA(base + d0 + 16, x1 * sn + x2 * cs);
}

DEV void ph_attn(const Params& p, long i) {
  int h = (int)(i % 8);
  long row = i / 8;
  int kv = h / 4;
  bool lat = row >= NC;
  int b = lat ? (int)((row - NC) / T) : (int)(row / C);
  int t = lat ? (int)((row - NC) % T) : 0;
  float q[64], acc[64];
  const act_t* qp = p.P + row * PW + E_AQ + h * 64;
#pragma unroll
  for (int d = 0; d < 64; ++d) { q[d] = ldA(qp + d) * 0.125f; acc[d] = 0.f; }
  float m = p.attn_sink[h], l = 1.0f;
  int nkeys = C + (lat ? 257 : 0);
  for (int j = 0; j < nkeys; ++j) {
    long krow;
    if (j < C) krow = (long)b * C + j;
    else {
      int kp = t - 128 + (j - C);
      if (kp < 0 || kp >= T) continue;
      krow = NC + (long)b * T + kp;
    }
    const act_t* kptr = p.P + krow * PW + E_AK + kv * 64;
    const act_t* vptr = p.P + krow * PW + E_AV + kv * 64;
    float s = 0.f;
#pragma unroll
    for (int d = 0; d < 64; ++d) s += q[d] * ldA(kptr + d);
    float mn = fmaxf(m, s);
    float sc = expf(m - mn), pj = expf(s - mn);
    l = l * sc + pj;
#pragma unroll
    for (int d = 0; d < 64; ++d) acc[d] = acc[d] * sc + pj * ldA(vptr + d);
    m = mn;
  }
  float il = 1.0f / l;
  act_t* o = p.u + row * D + h * 64;
#pragma unroll
  for (int d = 0; d < 64; ++d) stA(o + d, acc[d] * il);
}

template <int MODE>
DEV void ph_scan(const Params& p, long i) {
  constexpr int DK = MODE == 0 ? 128 : 96;
  constexpr int DV = MODE == 0 ? 128 : 192;
  int e = (int)(i % DV);
  int dir = (int)((i / DV) % 2);
  int h = (int)((i / (2 * DV)) % 4);
  int b = (int)(i / (8 * DV));
  float S[DK];
#pragma unroll
  for (int d = 0; d < DK; ++d) S[d] = 0.f;
  act_t* OD = dir == 0 ? p.OF : p.OB;
  for (int step = 0; step < C + T; ++step) {
    long row;
    if (step < C) row = (long)b * C + (dir == 0 ? step : C - 1 - step);
    else { int tt = step - C; row = NC + (long)b * T + (dir == 0 ? tt : T - 1 - tt); }
    const act_t* pr = p.P + row * PW;
    float o = 0.f;
    if (MODE == 0) {
      float v = ldA(pr + E_HI + h * 128 + e);
      const act_t* zp = pr + E_FF + dir * 512 + h * 128;
      const act_t* qp = pr + E_HQ + h * 128;
      const float* lb = p.lbt + dir * 512 + h * 128;
#pragma unroll
      for (int d = 0; d < DK; ++d) {
        float f = lb[d] + (1.0f - lb[d]) * sigmoidf_(ldA(zp + d));
        S[d] = f * S[d] + (1.0f - f) * v;
        o += ldA(qp + d) * S[d];
      }
      stA(OD + row * 768 + h * 128 + e, o);
    } else {
      float v = ldA(pr + O_V + h * 192 + e);
      const act_t* kp = pr + O_K + h * 96;
      const act_t* qp = pr + O_Q + h * 96;
      const act_t* lf = p.LF + ((long)dir * NR + row) * 384 + h * 96;
#pragma unroll
      for (int d = 0; d < DK; ++d) {
        float f = expf(ldA(lf + d));
        S[d] = f * S[d] + ldA(kp + d) * v;
        o += ldA(qp + d) * S[d];
      }
      stA(OD + row * 768 + h * 192 + e, o * 0.10206207261596575f);
    }
  }
}

template <int MODE>
DEV void ph_combine(const Params& p, long i) {
  constexpr int DV = MODE == 0 ? 128 : 192;
  int h = (int)(i % 4);
  long row = (MODE == 0) ? i / 4 : NC + i / 4;
  const act_t* f = p.OF + row * 768 + h * DV;
  const act_t* bk = p.OB + row * 768 + h * DV;
  float ss = 0.f;
  for (int e = 0; e < DV; ++e) { float o = ldA(f + e) + ldA(bk + e); ss += o * o; }
  float r = 1.0f / sqrtf(ss / DV + LN_EPS);
  const float* gn = (MODE == 0 ? p.hgrn_norm : p.gla_norm) + h * DV;
  const act_t* g = p.P + row * PW + (MODE == 0 ? E_HG : O_G) + h * DV;
  act_t* o = p.u + row * D + (MODE == 0 ? 512 : 0) + h * DV;
  for (int e = 0; e < DV; ++e) stA(o + e, (ldA(f + e) + ldA(bk + e)) * r * gn[e] * siluf_(ldA(g + e)));
}

DEV void ph_gla_decay(const Params& p, long i) {
  int col = (int)(i % 384);
  long row = (i / 384) % NR;
  int dir = (int)(i / ((long)384 * NR));
  const act_t* r = p.P + row * PW + O_RF + dir * 16;
  const float* gw = p.gla_gate_w + (long)dir * 16 * 384 + col;
  float z = p.gla_gate_b[dir * 384 + col];
  for (int k = 0; k < 16; ++k) z += ldA(r + k) * gw[k * 384];
  float ls = fminf(z, 0.f) - log1pf(expf(-fabsf(z)));
  stA(p.LF + ((long)dir * NR + row) * 384 + col, ls * (1.0f / 16.0f));
}

DEV void ph_resid_ln(const Params& p, long row, int l, int sub) {
  const float* hin = (l == 0 && sub == 0) ? hrow_in(p, row) : hrow(p, row);
  float* hout = hrow(p, row);
  const float* md = modrow(p, l, row);
  const float* g = md + (sub == 0 ? 2 : 5) * D;
  const act_t* m = p.M + row * D;
  const float* lg = p.ln_g + (l * 2 + sub) * D;
  const float* lb = p.ln_b + (l * 2 + sub) * D;
  float mu = 0.f;
  for (int k = 0; k < D; ++k) mu += ALPHA * hin[k] + g[k] * ldA(m + k);
  mu *= (1.0f / D);
  float var = 0.f;
  for (int k = 0; k < D; ++k) { float d = ALPHA * hin[k] + g[k] * ldA(m + k) - mu; var += d * d; }
  var *= (1.0f / D);
  float rs = 1.0f / sqrtf(var + LN_EPS);
  for (int k = 0; k < D; ++k) hout[k] = (ALPHA * hin[k] + g[k] * ldA(m + k) - mu) * rs * lg[k] + lb[k];
  if (sub == 1 && l == 1) return;
  const float* md2 = (sub == 0) ? md + 3 * D : modrow(p, 1, row);
  float mu2 = 0.f;
  for (int k = 0; k < D; ++k) mu2 += hout[k];
  mu2 *= (1.0f / D);
  float var2 = 0.f;
  for (int k = 0; k < D; ++k) { float d = hout[k] - mu2; var2 += d * d; }
  var2 *= (1.0f / D);
  float rs2 = 1.0f / sqrtf(var2 + LN_EPS);
  float lo[NEXP];
#pragma unroll
  for (int e = 0; e < NEXP; ++e) lo[e] = 0.f;
  for (int k = 0; k < D; ++k) {
    float uv = (hout[k] - mu2) * rs2 * (1.0f + md2[D + k]) + md2[k];
    stA(p.u + row * D + k, uv);
    if (sub == 0) {
      const float* wr = p.w_router + k * NEXP;
#pragma unroll
      for (int e = 0; e < NEXP; ++e) lo[e] += uv * wr[e];
    }
  }
  if (sub != 0) return;
  float mx = lo[0];
#pragma unroll
  for (int e = 1; e < NEXP; ++e) mx = fmaxf(mx, lo[e]);
  float sum = 0.f;
#pragma unroll
  for (int e = 0; e < NEXP; ++e) { lo[e] = expf(lo[e] - mx); sum += lo[e]; }
  float inv = 1.0f / sum;
  float bestg = -1e30f; int bg = 0;
  float gi1 = 0, gi2 = 0; int ge1 = 0, ge2 = 0;
  float gp1 = 0, gp2 = 0;
#pragma unroll
  for (int gq = 0; gq < 4; ++gq) {
    float s1 = -1e30f, s2 = -1e30f, p1 = 0, p2 = 0; int e1 = 0, e2 = 0;
#pragma unroll
    for (int j = 0; j < 4; ++j) {
      int e = gq * 4 + j;
      float pe = lo[e] * inv;
      float se = pe + p.b_router[e];
      if (se > s1) { s2 = s1; p2 = p1; e2 = e1; s1 = se; p1 = pe; e1 = e; }
      else if (se > s2) { s2 = se; p2 = pe; e2 = e; }
    }
    float gs = s1 + s2;
    if (gs > bestg) { bestg = gs; bg = gq; gi1 = s1; gi2 = s2; ge1 = e1; ge2 = e2; gp1 = p1; gp2 = p2; }
  }
  (void)bg; (void)gi1; (void)gi2;
  float wsum = gp1 + gp2;
  p.eidx[row * 2 + 0] = ge1; p.eidx[row * 2 + 1] = ge2;
  p.ew[row * 2 + 0] = gp1 / wsum; p.ew[row * 2 + 1] = gp2 / wsum;
}

DEV void ph_moe_up(const Params& p, long i, int l, long row0) {
  int f4 = (int)(i % (DFF / 4));
  int slot = (int)((i / (DFF / 4)) % 2);
  long row = row0 + i / (DFF / 2);
  int e = p.eidx[row * 2 + slot];
  const float* w1 = p.w_eg + ((long)(l * NEXP + e) * D) * DFF + f4 * 4;
  const float* w3 = p.w_eu + ((long)(l * NEXP + e) * D) * DFF + f4 * 4;
  const act_t* a = p.u + row * D;
  float g0 = 0, g1 = 0, g2 = 0, g3 = 0, u0 = 0, u1 = 0, u2 = 0, u3 = 0;
  for (int k = 0; k < D; ++k) {
    float av = ldA(a + k);
    const float* r1 = w1 + (long)k * DFF;
    const float* r3 = w3 + (long)k * DFF;
    g0 += av * r1[0]; g1 += av * r1[1]; g2 += av * r1[2]; g3 += av * r1[3];
    u0 += av * r3[0]; u1 += av * r3[1]; u2 += av * r3[2]; u3 += av * r3[3];
  }
  act_t* hb = p.P + (row * 2 + slot) * DFF + f4 * 4;
  stA(hb, siluf_(g0) * u0); stA(hb + 1, siluf_(g1) * u1); stA(hb + 2, siluf_(g2) * u2); stA(hb + 3, siluf_(g3) * u3);
}

DEV void ph_moe_down(const Params& p, long i, int l, long row0) {
  int j4 = (int)(i % (D / 4));
  long row = row0 + i / (D / 4);
  float y0 = 0, y1 = 0, y2 = 0, y3 = 0;
  for (int slot = 0; slot < 2; ++slot) {
    int e = p.eidx[row * 2 + slot];
    float wgt = p.ew[row * 2 + slot];
    const float* w2 = p.w_ed + ((long)(l * NEXP + e) * DFF) * D + j4 * 4;
    const act_t* hb = p.P + (row * 2 + slot) * DFF;
    float s0 = 0, s1 = 0, s2 = 0, s3 = 0;
    for (int f = 0; f < DFF; ++f) {
      float hv = ldA(hb + f);
      const float* r = w2 + (long)f * D;
      s0 += hv * r[0]; s1 += hv * r[1]; s2 += hv * r[2]; s3 += hv * r[3];
    }
    y0 += wgt * s0; y1 += wgt * s1; y2 += wgt * s2; y3 += wgt * s3;
  }
  act_t* o = p.M + row * D + j4 * 4;
  stA(o, y0); stA(o + 1, y1); stA(o + 2, y2); stA(o + 3, y3);
}


#ifndef HOST_TEST
typedef __attribute__((ext_vector_type(8))) short bf16x8;
typedef __attribute__((ext_vector_type(4))) float f32x4;
constexpr int SMEM_BYTES = 71680;
constexpr int IN_ODD_PAD = 2944;
constexpr int O_FA = 2336, O_FB = 2592, O_END = 2848;

typedef float f32x2_t __attribute__((ext_vector_type(2)));
typedef __bf16 bf16x2_t __attribute__((ext_vector_type(2)));
__device__ __forceinline__ unsigned pack2(float a, float b) {
  const f32x2_t v = {a, b};
  return __builtin_bit_cast(unsigned, __builtin_convertvector(v, bf16x2_t));
}
__device__ __forceinline__ unsigned pack2_mfma(float a, float b) { return pack2(a, b); }
typedef __attribute__((ext_vector_type(2))) unsigned u32x2;
__device__ __forceinline__ float xor16_max(float x) {
  const u32x2 r = __builtin_amdgcn_permlane16_swap(__float_as_uint(x), __float_as_uint(x), false, false);
  return fmaxf(__uint_as_float(r.x), __uint_as_float(r.y));
}
__device__ __forceinline__ float xor32_max(float x) {
  const u32x2 r = __builtin_amdgcn_permlane32_swap(__float_as_uint(x), __float_as_uint(x), false, false);
  return fmaxf(__uint_as_float(r.x), __uint_as_float(r.y));
}
__device__ __forceinline__ float xor16_add(float x) {
  const u32x2 r = __builtin_amdgcn_permlane16_swap(__float_as_uint(x), __float_as_uint(x), false, false);
  return __uint_as_float(r.x) + __uint_as_float(r.y);
}
__device__ __forceinline__ float xor32_add(float x) {
  const u32x2 r = __builtin_amdgcn_permlane32_swap(__float_as_uint(x), __float_as_uint(x), false, false);
  return __uint_as_float(r.x) + __uint_as_float(r.y);
}
__device__ __forceinline__ float bf_lo(unsigned u) { return __uint_as_float(u << 16); }
__device__ __forceinline__ float bf_hi(unsigned u) { return __uint_as_float(u & 0xffff0000u); }
template <int CTRL>
__device__ __forceinline__ float dpp_mov(float v) {
  return __int_as_float(__builtin_amdgcn_update_dpp(0, __float_as_int(v), CTRL, 0xf, 0xf, true));
}
__device__ __forceinline__ float row_sum16(float v) {
  v += dpp_mov<0xB1>(v);
  v += dpp_mov<0x4E>(v);
  v += dpp_mov<0x141>(v);
  v += dpp_mov<0x140>(v);
  return v;
}
__device__ __forceinline__ float wave_sum(float v) {
  v = row_sum16(v);
  const float a = __int_as_float(__builtin_amdgcn_readlane(__float_as_int(v), 0));
  const float b = __int_as_float(__builtin_amdgcn_readlane(__float_as_int(v), 16));
  const float c = __int_as_float(__builtin_amdgcn_readlane(__float_as_int(v), 32));
  const float d = __int_as_float(__builtin_amdgcn_readlane(__float_as_int(v), 48));
  return (a + b) + (c + d);
}


#define XB_TMO      128
#define XB_XCNT(j)  (256  + 64 * (j))
#define XB_XSUB(j)  (1280 + 64 * (j))
#define XB_XGEN(j)  (2304 + 64 * (j))
#define XB_TOP      3328
#define XB_TOPGEN   3392
#define XCD_BAR_WORDS 3456
#define XB_SPIN_CAP (1u << 18)
#define LAS __attribute__((address_space(3)))
__device__ __forceinline__ unsigned xb_ld(unsigned* p)              { return __hip_atomic_load(p, __ATOMIC_RELAXED, __HIP_MEMORY_SCOPE_AGENT); }
__device__ __forceinline__ unsigned xb_add(unsigned* p, unsigned v) { return __hip_atomic_fetch_add(p, v, __ATOMIC_RELAXED, __HIP_MEMORY_SCOPE_AGENT); }
__device__ __forceinline__ unsigned xb_xcc_id() { return (unsigned)__builtin_amdgcn_s_getreg((3 << 11) | 20) & 0xFu; }
#define XB_SPIN(cond, bar) do { unsigned _sp = 0; while (cond) { __builtin_amdgcn_s_sleep(1); \
    if ((++_sp & 255u) == 0u) { if (xb_ld(&(bar)[XB_TMO])) break; if (_sp > XB_SPIN_CAP) { atomicAdd(&(bar)[XB_TMO], 1u); break; } } } } while (0)
struct XcdBarrier { unsigned* bar; unsigned x; volatile LAS unsigned* st; };
__device__ __forceinline__ XcdBarrier xcd_barrier_post(unsigned* bar, volatile LAS unsigned* st) {
    XcdBarrier b; b.bar = bar; b.x = xb_xcc_id(); b.st = st;
    if (threadIdx.x == 0) (void)xb_add(&bar[XB_XCNT(b.x)], 1u);
    return b;
}
__device__ __forceinline__ void xcd_barrier_complete(unsigned* bar, unsigned x, unsigned& nloc, unsigned& nx) {
    const unsigned G = gridDim.x * gridDim.y * gridDim.z;
    unsigned sum, cnt, mine, sp = 0u;
    for (;;) {
        sum = 0u; cnt = 0u; mine = 0u;
#pragma unroll
        for (unsigned j = 0; j < 16; ++j) { const unsigned c = xb_ld(&bar[XB_XCNT(j)]); sum += c; cnt += (c > 0u) ? 1u : 0u; mine = (j == x) ? c : mine; }
        if (sum == G) break;
        __builtin_amdgcn_s_sleep(1);
        if ((++sp & 255u) == 0u) { if (xb_ld(&bar[XB_TMO])) break; if (sp > XB_SPIN_CAP) { atomicAdd(&bar[XB_TMO], 1u); break; } }
    }
    nloc = mine > 0u ? mine : 1u; nx = cnt > 0u ? cnt : 1u;
}
__device__ __forceinline__ void xcd_barrier(const XcdBarrier& b) {
    asm volatile("s_waitcnt vmcnt(0)" ::: "memory");
    __syncthreads();
    if (threadIdx.x == 0) {
        unsigned* bar = b.bar;
        __builtin_amdgcn_s_waitcnt(0);
        unsigned nloc = b.st[0], nx = b.st[1];
        if (nloc == 0u) { xcd_barrier_complete(bar, b.x, nloc, nx); b.st[0] = nloc; b.st[1] = nx; }
        const unsigned old = xb_add(&bar[XB_XSUB(b.x)], 1u);
        const unsigned gen = old / nloc;
        if (old + 1u == (gen + 1u) * nloc) {
            __builtin_amdgcn_fence(__ATOMIC_RELEASE, "agent");
            asm volatile("s_waitcnt vmcnt(0)" ::: "memory");
            const unsigned og = xb_add(&bar[XB_TOP], 1u);
            const unsigned tg = og / nx;
            if (og + 1u == (tg + 1u) * nx) xb_add(&bar[XB_TOPGEN], 1u);
            else XB_SPIN(xb_ld(&bar[XB_TOPGEN]) == tg, bar);
            __builtin_amdgcn_fence(__ATOMIC_ACQUIRE, "agent");
            xb_add(&bar[XB_XGEN(b.x)], 1u);
            asm volatile("s_waitcnt vmcnt(0)" ::: "memory");
        } else {
            XB_SPIN(xb_ld(&bar[XB_XGEN(b.x)]) == gen, bar);
            __builtin_amdgcn_fence(__ATOMIC_ACQUIRE, "agent");
            asm volatile("s_waitcnt vmcnt(0)" ::: "memory");
        }
    }
    __syncthreads();
}

#define RAW_BARRIER() do { asm volatile("s_waitcnt lgkmcnt(0)" ::: "memory"); __builtin_amdgcn_s_barrier(); } while (0)
template <bool SWAP, class ARow, class Epi>
__device__ __forceinline__ void gemm_tile(ARow arow, const act_t* Bt, int K, unsigned char* smem, Epi epi) {
  const int tid = threadIdx.x, wid = tid >> 6, lane = tid & 63, wr = wid >> 1, wc = wid & 1, fr = lane & 15,
            fq = lane >> 4;
  const int r0 = tid >> 3, pc = tid & 7;
  const int lc = pc ^ ((tid >> 4) & 7);
  const act_t* ga[4];
#pragma unroll
  for (int i = 0; i < 4; ++i) ga[i] = arow(r0 + 32 * i) + lc * 8;
  const act_t* gb0 = Bt + (long)r0 * K + lc * 8;
  const long gbs = (long)32 * K;
  const int sw = (fr >> 1) & 7;
  const int rd0 = fr * 128 + ((fq ^ sw) << 4), rd1 = fr * 128 + (((4 + fq) ^ sw) << 4);
  char* S = (char*)smem;
  const int nk = K >> 6;
  f32x4 acc[4][4];
#pragma unroll
  for (int m = 0; m < 4; ++m)
#pragma unroll
    for (int n = 0; n < 4; ++n) acc[m][n] = f32x4{0.f, 0.f, 0.f, 0.f};
  auto issue = [&](int kt) {
    char* st = S + (kt & 1) * 32768 + tid * 16;
#pragma unroll
    for (int i = 0; i < 4; ++i) {
      __builtin_amdgcn_global_load_lds((const unsigned*)(ga[i] + kt * 64), (unsigned*)(st + i * 4096), 16, 0, 0);
      __builtin_amdgcn_global_load_lds((const unsigned*)(gb0 + i * gbs + kt * 64), (unsigned*)(st + 16384 + i * 4096), 16, 0, 0);
    }
  };
  asm volatile("s_waitcnt vmcnt(0)" ::: "memory");
  RAW_BARRIER();
  issue(0);
  for (int kt = 0; kt < nk; ++kt) {
    asm volatile("s_waitcnt vmcnt(0)" ::: "memory");
    RAW_BARRIER();
    if (kt + 1 < nk) issue(kt + 1);
    const char* st = S + (kt & 1) * 32768;
#pragma unroll
    for (int ks = 0; ks < 2; ++ks) {
      const int rd = ks ? rd1 : rd0;
      bf16x8 af[4], bfr[4];
#pragma unroll
      for (int m = 0; m < 4; ++m) {
        af[m] = *reinterpret_cast<const bf16x8*>(st + (wr * 64 + m * 16) * 128 + rd);
        bfr[m] = *reinterpret_cast<const bf16x8*>(st + 16384 + (wc * 64 + m * 16) * 128 + rd);
      }
#pragma unroll
      for (int m = 0; m < 4; ++m)
#pragma unroll
        for (int n = 0; n < 4; ++n)
          acc[m][n] = SWAP ? __builtin_amdgcn_mfma_f32_16x16x32_bf16(bfr[n], af[m], acc[m][n], 0, 0, 0)
                           : __builtin_amdgcn_mfma_f32_16x16x32_bf16(af[m], bfr[n], acc[m][n], 0, 0, 0);
    }
  }
  epi(acc, wr, wc, fr, fq);
}


constexpr float SU8 = 16.0f, SW8 = 64.0f, SH8 = 8.0f;
typedef unsigned char fp8_t;
__device__ __forceinline__ unsigned pack4_fp8(float a, float b, float c, float d) {
  a = fminf(fmaxf(a, -448.f), 448.f); b = fminf(fmaxf(b, -448.f), 448.f);
  c = fminf(fmaxf(c, -448.f), 448.f); d = fminf(fmaxf(d, -448.f), 448.f);
  unsigned w = 0;
  w = __builtin_amdgcn_cvt_pk_fp8_f32(a, b, w, false);
  w = __builtin_amdgcn_cvt_pk_fp8_f32(c, d, w, true);
  return w;
}

template <bool SWAP, class ARow, class Epi>
__device__ __forceinline__ void gemm_tile8(ARow arow, const fp8_t* Bt, int Kb, unsigned char* smem, Epi epi) {
  const int tid = threadIdx.x, wid = tid >> 6, lane = tid & 63, wr = wid >> 1, wc = wid & 1, fr = lane & 15,
            fq = lane >> 4;
  const int r0 = tid >> 3, pc = tid & 7;
  const int lc = pc ^ ((tid >> 4) & 7);
  const fp8_t* ga[4];
#pragma unroll
  for (int i = 0; i < 4; ++i) ga[i] = arow(r0 + 32 * i) + lc * 16;
  const fp8_t* gb0 = Bt + (long)r0 * Kb + lc * 16;
  const long gbs = (long)32 * Kb;
  const int sw = (fr >> 1) & 7;
  int rd[4];
#pragma unroll
  for (int ks = 0; ks < 4; ++ks) rd[ks] = fr * 128 + (((ks * 2 + (fq >> 1)) ^ sw) << 4) + (fq & 1) * 8;
  char* S = (char*)smem;
  const int nk = Kb >> 7;
  f32x4 acc[4][4];
#pragma unroll
  for (int m = 0; m < 4; ++m)
#pragma unroll
    for (int n = 0; n < 4; ++n) acc[m][n] = f32x4{0.f, 0.f, 0.f, 0.f};
  auto issue = [&](int kt) {
    char* st = S + (kt & 1) * 32768 + tid * 16;
#pragma unroll
    for (int i = 0; i < 4; ++i) {
      __builtin_amdgcn_global_load_lds((const unsigned*)(ga[i] + kt * 128), (unsigned*)(st + i * 4096), 16, 0, 0);
      __builtin_amdgcn_global_load_lds((const unsigned*)(gb0 + i * gbs + kt * 128), (unsigned*)(st + 16384 + i * 4096), 16, 0, 0);
    }
  };
  asm volatile("s_waitcnt vmcnt(0)" ::: "memory");
  RAW_BARRIER();
  issue(0);
  for (int kt = 0; kt < nk; ++kt) {
    asm volatile("s_waitcnt vmcnt(0)" ::: "memory");
    RAW_BARRIER();
    if (kt + 1 < nk) issue(kt + 1);
    const char* st = S + (kt & 1) * 32768;
#pragma unroll
    for (int ks = 0; ks < 4; ++ks) {
      long af[4], bfr[4];
#pragma unroll
      for (int m = 0; m < 4; ++m) {
        af[m] = *reinterpret_cast<const long*>(st + (wr * 64 + m * 16) * 128 + rd[ks]);
        bfr[m] = *reinterpret_cast<const long*>(st + 16384 + (wc * 64 + m * 16) * 128 + rd[ks]);
      }
#pragma unroll
      for (int m = 0; m < 4; ++m)
#pragma unroll
        for (int n = 0; n < 4; ++n)
          acc[m][n] = SWAP ? __builtin_amdgcn_mfma_f32_16x16x32_fp8_fp8(bfr[n], af[m], acc[m][n], 0, 0, 0)
                           : __builtin_amdgcn_mfma_f32_16x16x32_fp8_fp8(af[m], bfr[n], acc[m][n], 0, 0, 0);
    }
  }
  epi(acc, wr, wc, fr, fq);
}

__device__ __forceinline__ void phase_attn(const Params& p, unsigned char* smem, int blk, int nblk) {
  const int tid = threadIdx.x, w = tid >> 6, lane = tid & 63, fr = lane & 15, g = lane >> 4;
  act_t* SK = (act_t*)smem;
  act_t* SV = SK + 64 * 72;
  constexpr float SCL = 0.125f * 1.4426950408889634f;
  const int n_lat = NB * 4 * (T / 64), n_ctx = NB * 4 * (C / 64);
  const int skey = tid >> 2, spart = tid & 3;
  for (int unit = blk; unit < n_lat + n_ctx; unit += nblk) {
    const bool lat = unit < n_lat;
    const int uu = lat ? unit : unit - n_lat;
    const int nq = lat ? T / 64 : C / 64;
    const int hp = uu & 1, kv = (uu >> 1) & 1, qb = (uu >> 2) % nq, b = (uu >> 2) / nq;
    const int t0 = qb * 64;
    const int tw = t0 + (w & 1) * 32;
    const long qrow0 = (lat ? (long)NC + (long)b * T : (long)b * C) + tw;
    const int h = kv * 4 + hp * 2 + (w >> 1);
    bf16x8 qf[2][2];
#pragma unroll
    for (int qt = 0; qt < 2; ++qt)
#pragma unroll
      for (int st = 0; st < 2; ++st)
        qf[qt][st] = *reinterpret_cast<const bf16x8*>(p.P + (qrow0 + qt * 16 + fr) * PW + E_AQ + h * 64 + st * 32 + g * 8);
    asm volatile("" :: "v"(qf[0][0]), "v"(qf[0][1]), "v"(qf[1][0]), "v"(qf[1][1]));
    float mrun[2], lrun[2];
    f32x4 o[2][4];
    const float sinkl = p.attn_sink[h] * 1.4426950408889634f;
#pragma unroll
    for (int qt = 0; qt < 2; ++qt) {
      mrun[qt] = sinkl;
      lrun[qt] = (g == 0) ? 1.0f : 0.0f;
#pragma unroll
      for (int dt = 0; dt < 4; ++dt) o[qt][dt] = f32x4{0.f, 0.f, 0.f, 0.f};
    }
    int cc_lo = 0, cc_hi = -1;
    if (lat) {
      cc_lo = t0 >= 128 ? 0 : (128 - t0) / 64;
      cc_hi = min(4, (T - 1 - (t0 - 128)) / 64);
    }
    const int nch = 4 + (cc_hi - cc_lo + 1);
    auto chunk_row = [&](int i, int key, int& tkb) -> long {
      if (i < 4) { tkb = 0; return (long)b * C + i * 64 + key; }
      tkb = t0 - 128 + (cc_lo + i - 4) * 64;
      return (long)NC + (long)b * T + tkb + key;
    };
    uint4 rk0, rk1, rv0, rv1;
    {
      int tkb; const long kr = chunk_row(0, skey, tkb);
      const act_t* kp = p.P + kr * PW + E_AK + kv * 64 + spart * 16;
      const act_t* vp = p.P + kr * PW + E_AV + kv * 64 + spart * 16;
      rk0 = *reinterpret_cast<const uint4*>(kp); rk1 = *reinterpret_cast<const uint4*>(kp + 8);
      rv0 = *reinterpret_cast<const uint4*>(vp); rv1 = *reinterpret_cast<const uint4*>(vp + 8);
    }
    for (int i = 0; i < nch; ++i) {
      __syncthreads();
      {
        uint4* kd = reinterpret_cast<uint4*>(SK + skey * 72 + spart * 16);
        kd[0] = rk0; kd[1] = rk1;
        const unsigned vw[8] = {rv0.x, rv0.y, rv0.z, rv0.w, rv1.x, rv1.y, rv1.z, rv1.w};
#pragma unroll
        for (int e = 0; e < 8; ++e) {
          SV[(spart * 16 + 2 * e) * 72 + skey] = (act_t)(vw[e] & 0xffffu);
          SV[(spart * 16 + 2 * e + 1) * 72 + skey] = (act_t)(vw[e] >> 16);
        }
      }
      __syncthreads();
      int tkb_cur; (void)chunk_row(i, 0, tkb_cur);
      if (i + 1 < nch) {
        int tkb; const long kr = chunk_row(i + 1, skey, tkb);
        const act_t* kp = p.P + kr * PW + E_AK + kv * 64 + spart * 16;
        const act_t* vp = p.P + kr * PW + E_AV + kv * 64 + spart * 16;
        rk0 = *reinterpret_cast<const uint4*>(kp); rk1 = *reinterpret_cast<const uint4*>(kp + 8);
        rv0 = *reinterpret_cast<const uint4*>(vp); rv1 = *reinterpret_cast<const uint4*>(vp + 8);
      }
      const bool edge = i >= 4 && (tkb_cur == t0 - 128 || tkb_cur == t0 + 128);
#pragma unroll
      for (int kb = 0; kb < 2; ++kb) {
        f32x4 sc[2][2];
#pragma unroll
        for (int k2 = 0; k2 < 2; ++k2) {
          const int kt = kb * 2 + k2;
          const bf16x8 kf0 = *reinterpret_cast<const bf16x8*>(SK + (kt * 16 + fr) * 72 + g * 8);
          const bf16x8 kf1 = *reinterpret_cast<const bf16x8*>(SK + (kt * 16 + fr) * 72 + 32 + g * 8);
#pragma unroll
          for (int qt = 0; qt < 2; ++qt) {
            f32x4 z = f32x4{0.f, 0.f, 0.f, 0.f};
            z = __builtin_amdgcn_mfma_f32_16x16x32_bf16(kf0, qf[qt][0], z, 0, 0, 0);
            sc[qt][k2] = __builtin_amdgcn_mfma_f32_16x16x32_bf16(kf1, qf[qt][1], z, 0, 0, 0);
          }
        }
        bf16x8 pf[2];
#pragma unroll
        for (int qt = 0; qt < 2; ++qt) {
          float mx = -1e30f;
#pragma unroll
          for (int k2 = 0; k2 < 2; ++k2)
#pragma unroll
            for (int j = 0; j < 4; ++j) {
              float v = sc[qt][k2][j] * SCL;
              if (edge) {
                const int tk = tkb_cur + (kb * 2 + k2) * 16 + 4 * g + j;
                const int tq = tw + qt * 16 + fr;
                const int df = tq - tk;
                if (df > 128 || df < -128) v = -1e30f;
              }
              sc[qt][k2][j] = v;
              mx = fmaxf(mx, v);
            }
          mx = xor16_max(mx);
          mx = xor32_max(mx);
          const float mnew = fmaxf(mrun[qt], mx);
          if (__any(mnew > mrun[qt])) {
            const float alpha = __builtin_amdgcn_exp2f(mrun[qt] - mnew);
            lrun[qt] *= alpha;
#pragma unroll
            for (int dt = 0; dt < 4; ++dt) o[qt][dt] = o[qt][dt] * alpha;
            mrun[qt] = mnew;
          }
          float ls = 0.f;
          float pv[8];
#pragma unroll
          for (int k2 = 0; k2 < 2; ++k2)
#pragma unroll
            for (int j = 0; j < 4; ++j) {
              const float pe = __builtin_amdgcn_exp2f(sc[qt][k2][j] - mnew);
              pv[k2 * 4 + j] = pe;
              ls += pe;
            }
          lrun[qt] += ls;
          union { unsigned u[4]; bf16x8 v; } cv;
          cv.u[0] = pack2_mfma(pv[0], pv[1]); cv.u[1] = pack2_mfma(pv[2], pv[3]);
          cv.u[2] = pack2_mfma(pv[4], pv[5]); cv.u[3] = pack2_mfma(pv[6], pv[7]);
          pf[qt] = cv.v;
        }
#pragma unroll
        for (int dt = 0; dt < 4; ++dt) {
          union { uint2 h2[2]; bf16x8 v; } vf;
          vf.h2[0] = *reinterpret_cast<const uint2*>(SV + (dt * 16 + fr) * 72 + kb * 32 + 4 * g);
          vf.h2[1] = *reinterpret_cast<const uint2*>(SV + (dt * 16 + fr) * 72 + kb * 32 + 16 + 4 * g);
#pragma unroll
          for (int qt = 0; qt < 2; ++qt) o[qt][dt] = __builtin_amdgcn_mfma_f32_16x16x32_bf16(vf.v, pf[qt], o[qt][dt], 0, 0, 0);
        }
      }
    }
#pragma unroll
    for (int qt = 0; qt < 2; ++qt) {
      float lt = lrun[qt];
      lt = xor16_add(lt);
      lt = xor32_add(lt);
      const float il = 1.0f / lt;
      act_t* orow = p.u + (qrow0 + qt * 16 + fr) * D + h * 64 + 4 * g;
#pragma unroll
      for (int dt = 0; dt < 4; ++dt)
        *reinterpret_cast<uint2*>(orow + dt * 16) =
            make_uint2(pack2(o[qt][dt][0] * il, o[qt][dt][1] * il), pack2(o[qt][dt][2] * il, o[qt][dt][3] * il));
    }
  }
}


template <int MODE>
__device__ __forceinline__ void phase_combine(const Params& p) {
  constexpr int DV = MODE == 0 ? 128 : 192, EPL = DV / 16, NV = EPL / 4;
  const int lane = threadIdx.x & 63;
  const long row_lo = MODE == 0 ? 0 : NC;
  const long w0 = (long)blockIdx.x * 4 + (threadIdx.x >> 6), wstride = (long)gridDim.x * 4;
  const float* gn = (MODE == 0 ? p.hgrn_norm : p.gla_norm) + lane * EPL;
  for (long row = row_lo + w0; row < NR; row += wstride) {
    const uint2* f = reinterpret_cast<const uint2*>(p.OF + row * 768 + lane * EPL);
    const uint2* bk = reinterpret_cast<const uint2*>(p.OB + row * 768 + lane * EPL);
    const uint2* gt = reinterpret_cast<const uint2*>(p.P + row * PW + (MODE == 0 ? E_HG : O_G) + lane * EPL);
    float o[EPL];
    float ss = 0.f;
#pragma unroll
    for (int v = 0; v < NV; ++v) {
      const uint2 a = f[v], c = bk[v];
      o[4 * v + 0] = bf_lo(a.x) + bf_lo(c.x); o[4 * v + 1] = bf_hi(a.x) + bf_hi(c.x);
      o[4 * v + 2] = bf_lo(a.y) + bf_lo(c.y); o[4 * v + 3] = bf_hi(a.y) + bf_hi(c.y);
    }
#pragma unroll
    for (int e = 0; e < EPL; ++e) ss += o[e] * o[e];
    ss = row_sum16(ss);
    const float r = 1.0f / sqrtf(ss * (1.0f / DV) + LN_EPS);
    uint2* dst = reinterpret_cast<uint2*>(p.u + row * D + (MODE == 0 ? 512 : 0) + lane * EPL);
#pragma unroll
    for (int v = 0; v < NV; ++v) {
      const uint2 gv = gt[v];
      const float g0 = bf_lo(gv.x), g1 = bf_hi(gv.x), g2 = bf_lo(gv.y), g3 = bf_hi(gv.y);
      const float y0 = o[4 * v + 0] * r * gn[4 * v + 0] * (g0 / (1.0f + __expf(-g0)));
      const float y1 = o[4 * v + 1] * r * gn[4 * v + 1] * (g1 / (1.0f + __expf(-g1)));
      const float y2 = o[4 * v + 2] * r * gn[4 * v + 2] * (g2 / (1.0f + __expf(-g2)));
      const float y3 = o[4 * v + 3] * r * gn[4 * v + 3] * (g3 / (1.0f + __expf(-g3)));
      dst[v] = make_uint2(pack2(y0, y1), pack2(y2, y3));
    }
  }
}

__device__ __forceinline__ void mod_item(const Params& p, int item, unsigned char* smem) {
  float* sc = (float*)smem;
  const int tid = threadIdx.x;
  for (int i = tid; i < 9 * D; i += 256) {
    const int bb = i >> 10, k = i & 1023;
    const float v = bb < NB ? p.c[bb * D + k] : p.c_ctx[k];
    sc[i] = v / (1.0f + __expf(-v));
  }
  __syncthreads();
  const int l = item / 24, j = (item % 24) * 256 + tid;
  const float* w = p.w_ada + (long)l * D * 6 * D + j;
  float a[NB + 1];
#pragma unroll
  for (int bb = 0; bb <= NB; ++bb) a[bb] = p.b_ada[l * 6 * D + j];
  for (int k = 0; k < D; k += 8) {
    float wv[8];
#pragma unroll
    for (int q = 0; q < 8; ++q) wv[q] = w[(long)(k + q) * 6 * D];
#pragma unroll
    for (int q = 0; q < 8; ++q)
#pragma unroll
      for (int bb = 0; bb <= NB; ++bb) a[bb] += sc[bb * D + k + q] * wv[q];
  }
#pragma unroll
  for (int bb = 0; bb <= NB; ++bb) p.mod[((long)l * (NB + 1) + bb) * 6 * D + j] = a[bb];
  __syncthreads();
}

__device__ __forceinline__ void phase_gla_decay(const Params& p) {
  const int t = threadIdx.x;
  if (t >= 192) return;
  const int dir = t / 96, cg = t % 96;
  float gw[16][4], gb[4];
#pragma unroll
  for (int r = 0; r < 16; ++r) {
    const float4 v = *reinterpret_cast<const float4*>(p.gla_gate_w + ((long)dir * 16 + r) * 384 + cg * 4);
    gw[r][0] = v.x; gw[r][1] = v.y; gw[r][2] = v.z; gw[r][3] = v.w;
  }
  {
    const float4 v = *reinterpret_cast<const float4*>(p.gla_gate_b + dir * 384 + cg * 4);
    gb[0] = v.x; gb[1] = v.y; gb[2] = v.z; gb[3] = v.w;
  }
  for (long row0 = (long)blockIdx.x * 4; row0 < NR; row0 += (long)gridDim.x * 4) {
    uint4 ra[4], rb[4];
#pragma unroll
    for (int q = 0; q < 4; ++q) {
      const uint4* rp = reinterpret_cast<const uint4*>(p.P + (row0 + q) * PW + O_RF + dir * 16);
      ra[q] = rp[0]; rb[q] = rp[1];
    }
#pragma unroll
    for (int q = 0; q < 4; ++q) {
      const unsigned rw[8] = {ra[q].x, ra[q].y, ra[q].z, ra[q].w, rb[q].x, rb[q].y, rb[q].z, rb[q].w};
      float z[4] = {gb[0], gb[1], gb[2], gb[3]};
#pragma unroll
      for (int r2 = 0; r2 < 8; ++r2) {
        const float x0 = bf_lo(rw[r2]), x1 = bf_hi(rw[r2]);
#pragma unroll
        for (int c = 0; c < 4; ++c) z[c] += x0 * gw[2 * r2][c] + x1 * gw[2 * r2 + 1][c];
      }
      float o[4];
#pragma unroll
      for (int c = 0; c < 4; ++c) o[c] = (fminf(z[c], 0.f) - __logf(1.0f + __expf(-fabsf(z[c])))) * (1.0f / 16.0f);
      *reinterpret_cast<uint2*>(p.LF + ((long)dir * NR + row0 + q) * 384 + cg * 4) = make_uint2(pack2(o[0], o[1]), pack2(o[2], o[3]));
    }
  }
}

__device__ __forceinline__ void phase_hgrn_gate(const Params& p, long gtid, long gstride) {
  for (long i = gtid; i < (long)NR * 1024; i += gstride) {
    const int col = (int)(i & 1023);
    const long row = i >> 10;
    act_t* z = p.P + row * PW + E_FF + col;
    const float lb = p.lbt[col];
    const float f = lb + (1.0f - lb) * sigmoidf_(ldA(z));
    stA(z, __logf(f));
  }
}

template <int MODE>
__device__ __forceinline__ void phase_scan(const Params& p, unsigned char* smem, int blk, int nblk) {
  constexpr int DK = MODE == 0 ? 128 : 96, DV = MODE == 0 ? 128 : 192, DVS = DV / 4, NET = DVS / 16, NKS = DK / 32,
                NDT = DK / 16;
  constexpr int QS = DK + 8, LS = 72, SS = DK + 8;
  act_t* Qa = (act_t*)smem;
  act_t* Ka = Qa + 64 * QS;
  act_t* KaT = Ka + 64 * QS;
  act_t* VT = KaT + DK * LS;
  act_t* ST = VT + DVS * LS;
  float* tot = (float*)(ST + DVS * SS);
  float* lf32 = tot + 2 * 4 * DK;
  const int tid = threadIdx.x, w = __builtin_amdgcn_readfirstlane(threadIdx.x >> 6), lane = tid & 63, fr = lane & 15, g = lane >> 4;
  const int dp = lane, c0 = 2 * dp;
  const bool cact = dp < DK / 2;
  constexpr int NCH = (C + T) / 64, NCC = C / 64;
  constexpr int NVI = DVS / 8 * 64;
  for (int item = blk; item < NB * 4 * 2 * 4; item += nblk) {
    const int sl = item & 3, dir = (item >> 2) & 1, h = (item >> 3) & 3, b = item >> 5;
    act_t* OD = dir == 0 ? p.OF : p.OB;
    const unsigned loff = (unsigned)min(c0, DK - 2) * 2u;
    const int vcol = (MODE == 0 ? E_HI + h * 128 : O_V + h * 192) + sl * DVS;
    const int ocol = h * DV + sl * DVS;
    auto chunk_base = [&](int n) -> long {
      if (n < NCC) return (long)b * C + (dir ? NCC - 1 - n : n) * 64;
      const int ln = n - NCC;
      return (long)NC + (long)b * T + (dir ? T / 64 - 1 - ln : ln) * 64;
    };
    auto lrow = [&](long base, int l) -> long { return base + (dir ? 63 - l : l); };
    f32x4 S[NET][2];
#pragma unroll
    for (int et = 0; et < NET; ++et) { S[et][0] = f32x4{0.f, 0.f, 0.f, 0.f}; S[et][1] = f32x4{0.f, 0.f, 0.f, 0.f}; }
    unsigned rlf[16], rq[16], rk[16];
    uint4 rv[2];
    const long rstep = dir ? -(long)PW * 2 : (long)PW * 2;
    const long lstep = dir ? -(long)384 * 2 : (long)384 * 2;
    const unsigned off_lf = (MODE == 0 ? (unsigned)(E_FF + dir * 512 + h * 128) * 2u : 0u) + loff;
    const unsigned off_q = (unsigned)(MODE == 0 ? E_HQ + h * 128 : O_Q + h * 96) * 2u + loff;
    const unsigned off_k = (unsigned)(O_K + h * 96) * 2u + loff;
    auto issue_loads = [&](int n) {
      const long base = chunk_base(n);
      {
        const char* prow = (const char*)(p.P + lrow(base, w * 16) * PW);
        const char* plf = (const char*)(p.LF + ((long)dir * NR + lrow(base, w * 16)) * 384 + h * 96);
#pragma unroll
        for (int i = 0; i < 16; ++i) {
          if (MODE == 0) {
            rlf[i] = *reinterpret_cast<const unsigned*>(prow + off_lf);
          } else {
            rlf[i] = *reinterpret_cast<const unsigned*>(plf + loff);
            rk[i] = *reinterpret_cast<const unsigned*>(prow + off_k);
            plf += lstep;
          }
          rq[i] = *reinterpret_cast<const unsigned*>(prow + off_q);
          prow += rstep;
        }
      }
#pragma unroll
      for (int r = 0; r < (NVI + 255) / 256; ++r) {
        const int it = min(tid + r * 256, NVI - 1);
        const int l = it / (DVS / 8), e8 = (it % (DVS / 8)) * 8;
        rv[r] = *reinterpret_cast<const uint4*>(p.P + lrow(base, l) * PW + vcol + e8);
      }
    };
    issue_loads(0);
    for (int n = 0; n < NCH; ++n) {
      const int par = n & 1;
      float* totp = tot + par * 4 * DK;
      float* lfp = lf32 + par * DK;
      const long base = chunk_base(n);
      if (cact) {
        float r0 = 0.f, r1 = 0.f;
#pragma unroll
        for (int i = 0; i < 16; ++i) { r0 += bf_lo(rlf[i]); r1 += bf_hi(rlf[i]); }
        totp[w * DK + c0] = r0; totp[w * DK + c0 + 1] = r1;
        if (w == 2) { lfp[c0] = bf_lo(rlf[0]); lfp[c0 + 1] = bf_hi(rlf[0]); }
      }
      __syncthreads();
#pragma unroll
      for (int r = 0; r < (NVI + 255) / 256; ++r) {
        const int it = tid + r * 256;
        if (it < NVI) {
          const int l = it / (DVS / 8), e8 = (it % (DVS / 8)) * 8;
          const unsigned vw[4] = {rv[r].x, rv[r].y, rv[r].z, rv[r].w};
#pragma unroll
          for (int e = 0; e < 4; ++e) {
            VT[(e8 + 2 * e) * LS + l] = (act_t)(vw[e] & 0xffffu);
            VT[(e8 + 2 * e + 1) * LS + l] = (act_t)(vw[e] >> 16);
          }
        }
      }
      if (cact) {
        float of0 = 0.f, of1 = 0.f;
#pragma unroll
        for (int sgi = 0; sgi < 3; ++sgi)
          if (sgi < w) { of0 += totp[sgi * DK + c0]; of1 += totp[sgi * DK + c0 + 1]; }
        const float ref0 = totp[c0] + totp[DK + c0] + lfp[c0];
        const float ref1 = totp[c0 + 1] + totp[DK + c0 + 1] + lfp[c0 + 1];
        unsigned kt0[8], kt1[8];
        float run0 = of0 - ref0, run1 = of1 - ref1;
#pragma unroll
        for (int i = 0; i < 16; i += 2) {
          float ka0[2], ka1[2];
#pragma unroll
          for (int ii = 0; ii < 2; ++ii) {
            const int i2 = i + ii;
            run0 += bf_lo(rlf[i2]); run1 += bf_hi(rlf[i2]);
            const float b0 = run0, b1 = run1;
            const float e0 = __expf(b0), e1 = __expf(b1), f0 = __expf(-b0), f1 = __expf(-b1);
            float k0, k1;
            if (MODE == 0) { k0 = 1.0f - __expf(bf_lo(rlf[i2])); k1 = 1.0f - __expf(bf_hi(rlf[i2])); }
            else { k0 = bf_lo(rk[i2]); k1 = bf_hi(rk[i2]); }
            ka0[ii] = k0 * f0; ka1[ii] = k1 * f1;
            const int l = w * 16 + i2;
            *reinterpret_cast<unsigned*>(Qa + l * QS + c0) = pack2(bf_lo(rq[i2]) * e0, bf_hi(rq[i2]) * e1);
            *reinterpret_cast<unsigned*>(Ka + l * QS + c0) = pack2(ka0[ii], ka1[ii]);
          }
          kt0[i >> 1] = pack2(ka0[0], ka0[1]);
          kt1[i >> 1] = pack2(ka1[0], ka1[1]);
        }
        uint4* d0 = reinterpret_cast<uint4*>(KaT + c0 * LS + w * 16);
        d0[0] = make_uint4(kt0[0], kt0[1], kt0[2], kt0[3]); d0[1] = make_uint4(kt0[4], kt0[5], kt0[6], kt0[7]);
        uint4* d1 = reinterpret_cast<uint4*>(KaT + (c0 + 1) * LS + w * 16);
        d1[0] = make_uint4(kt1[0], kt1[1], kt1[2], kt1[3]); d1[1] = make_uint4(kt1[4], kt1[5], kt1[6], kt1[7]);
      }
      issue_loads(min(n + 1, NCH - 1));
      float egv[2], egrv[2];
#pragma unroll
      for (int di = 0; di < 2; ++di) {
        const int dt = w + 4 * di;
        if (dt < NDT) {
          const int d = dt * 16 + fr;
          const float refd = totp[d] + totp[DK + d] + lfp[d];
          const float gd = totp[d] + totp[DK + d] + totp[2 * DK + d] + totp[3 * DK + d];
          const float er = __expf(refd);
          egv[di] = __expf(gd); egrv[di] = __expf(gd - refd);
#pragma unroll
          for (int et = 0; et < NET; ++et)
#pragma unroll
            for (int j = 0; j < 4; ++j) stA(ST + (et * 16 + 4 * g + j) * SS + d, S[et][di][j] * er);
        }
      }
      __syncthreads();
      bf16x8 qfr[NKS];
#pragma unroll
      for (int ks = 0; ks < NKS; ++ks) qfr[ks] = *reinterpret_cast<const bf16x8*>(Qa + (w * 16 + fr) * QS + ks * 32 + g * 8);
      bf16x8 pfr[2];
#pragma unroll
      for (int kb = 0; kb < 2; ++kb) {
        f32x4 at2[2];
#pragma unroll
        for (int h2 = 0; h2 < 2; ++h2) {
          const int mt = 2 * kb + h2;
          at2[h2] = f32x4{0.f, 0.f, 0.f, 0.f};
          if (mt <= w) {
#pragma unroll
            for (int ks = 0; ks < NKS; ++ks) {
              const bf16x8 kaf = *reinterpret_cast<const bf16x8*>(Ka + (mt * 16 + fr) * QS + ks * 32 + g * 8);
              at2[h2] = __builtin_amdgcn_mfma_f32_16x16x32_bf16(kaf, qfr[ks], at2[h2], 0, 0, 0);
            }
            if (mt == w) {
#pragma unroll
              for (int j = 0; j < 4; ++j)
                if (4 * g + j > fr) at2[h2][j] = 0.f;
            }
          }
        }
        union { unsigned u[4]; bf16x8 v; } cv;
        cv.u[0] = pack2_mfma(at2[0][0], at2[0][1]); cv.u[1] = pack2_mfma(at2[0][2], at2[0][3]);
        cv.u[2] = pack2_mfma(at2[1][0], at2[1][1]); cv.u[3] = pack2_mfma(at2[1][2], at2[1][3]);
        pfr[kb] = cv.v;
      }
      const long orow = lrow(base, w * 16 + fr);
#pragma unroll
      for (int et = 0; et < NET; ++et) {
        f32x4 o = f32x4{0.f, 0.f, 0.f, 0.f};
#pragma unroll
        for (int kb = 0; kb < 2; ++kb) {
          if (2 * kb <= w) {
            union { uint2 h2[2]; bf16x8 v; } vf;
            vf.h2[0] = *reinterpret_cast<const uint2*>(VT + (et * 16 + fr) * LS + kb * 32 + 4 * g);
            vf.h2[1] = *reinterpret_cast<const uint2*>(VT + (et * 16 + fr) * LS + kb * 32 + 16 + 4 * g);
            o = __builtin_amdgcn_mfma_f32_16x16x32_bf16(vf.v, pfr[kb], o, 0, 0, 0);
          }
        }
#pragma unroll
        for (int ks = 0; ks < NKS; ++ks) {
          const bf16x8 sf = *reinterpret_cast<const bf16x8*>(ST + (et * 16 + fr) * SS + ks * 32 + g * 8);
          o = __builtin_amdgcn_mfma_f32_16x16x32_bf16(sf, qfr[ks], o, 0, 0, 0);
        }
        const float osc = MODE == 0 ? 1.0f : 0.10206207261596575f;
        *reinterpret_cast<uint2*>(OD + orow * 768 + ocol + et * 16 + 4 * g) =
            make_uint2(pack2(o[0] * osc, o[1] * osc), pack2(o[2] * osc, o[3] * osc));
      }
#pragma unroll
      for (int di = 0; di < 2; ++di) {
        const int dt = w + 4 * di;
        if (dt < NDT) {
#pragma unroll
          for (int et = 0; et < NET; ++et) {
            f32x4 r = f32x4{0.f, 0.f, 0.f, 0.f};
#pragma unroll
            for (int k2 = 0; k2 < 2; ++k2) {
              const bf16x8 vf = *reinterpret_cast<const bf16x8*>(VT + (et * 16 + fr) * LS + k2 * 32 + g * 8);
              const bf16x8 kf = *reinterpret_cast<const bf16x8*>(KaT + (dt * 16 + fr) * LS + k2 * 32 + g * 8);
              r = __builtin_amdgcn_mfma_f32_16x16x32_bf16(vf, kf, r, 0, 0, 0);
            }
#pragma unroll
            for (int j = 0; j < 4; ++j) S[et][di][j] = egv[di] * S[et][di][j] + egrv[di] * r[j];
          }
        }
      }
    }
    __syncthreads();
  }
}

struct GemmJob {
  const act_t* A; const act_t* Bt; act_t* C;
  long sA, sB, sC;
  int nbatch, Mtiles, Ntiles, K, ldc, Nvalid, mode;
  float scale;
  int fp8;
};
__device__ __forceinline__ void phase_gemm(const Params& p, const GemmJob& g, unsigned char* smem, int blk = blockIdx.x, int nblk = gridDim.x) {
  const int per_b = g.Mtiles * g.Ntiles;
  const int ntiles = per_b * g.nbatch;
  for (int tile = blk; tile < ntiles; tile += nblk) {
    const int b = tile / per_b, tt = tile % per_b;
    const int tm = tt / g.Ntiles, tn = tt % g.Ntiles;
    if (g.mode == 1 && tm < NC / 128 && tn * 128 >= O_FA) continue;
    const int K = g.K, ldc = g.ldc;
    const act_t* Ab = g.A + b * g.sA + (long)tm * 128 * K;
    act_t* Cb = g.C + b * g.sC + (long)tm * 128 * ldc + tn * 128;
    const int nlim = g.Nvalid - tn * 128;
    const float scale = g.scale;
    const int mode = g.mode;
    if (mode == 1) {
      auto epi1 = [&](f32x4 (&acc)[4][4], int wr, int wc, int fr, int fq) {
                  if (g.fp8) {
#pragma unroll
                    for (int m = 0; m < 4; ++m)
#pragma unroll
                      for (int n = 0; n < 4; ++n) acc[m][n] = acc[m][n] * scale;
                  }
#pragma unroll
                  for (int m = 0; m < 4; ++m)
#pragma unroll
                    for (int n = 0; n < 4; ++n) {
                      const int col = wc * 64 + n * 16 + fr;
                      if (col < nlim) {
#pragma unroll
                        for (int j = 0; j < 4; ++j) {
                          const int row = wr * 64 + m * 16 + fq * 4 + j;
                          stA(Cb + (long)row * ldc + col, acc[m][n][j]);
                        }
                      } else {
                        const int gc = tn * 128 + col;
                        if (gc < O_END && tm >= NC / 128) {
                          const int lr = (tm - NC / 128) * 128 + wr * 64 + m * 16 + fq * 4;
                          const int bb = lr / T, t = lr % T;
                          const int cq = gc < O_FB ? gc - O_FA : gc - O_FB;
                          act_t* dst = p.FT + ((long)bb * 256 + cq) * (2 * T) + (gc < O_FB ? 0 : T) + t;
                          *reinterpret_cast<uint2*>(dst) = make_uint2(pack2(acc[m][n][0], acc[m][n][1]), pack2(acc[m][n][2], acc[m][n][3]));
                        }
                      }
                    }
                };
      if (g.fp8) {
        const fp8_t* A8 = (const fp8_t*)g.A + (long)tm * 128 * K;
        gemm_tile8<false>([&](int r) { return A8 + (long)r * K; }, (const fp8_t*)g.Bt + (long)tn * 128 * K, K, smem, epi1);
      } else {
        gemm_tile<false>([&](int r) { return Ab + (long)r * K; }, g.Bt + b * g.sB + (long)tn * 128 * K, K, smem, epi1);
      }
    } else {
      auto epi2 = [&](f32x4 (&acc)[4][4], int wr, int wc, int fr, int fq) {
                  const float oscale = g.fp8 ? 1.0f : scale;
                  if (g.fp8) {
#pragma unroll
                    for (int m = 0; m < 4; ++m)
#pragma unroll
                      for (int n = 0; n < 4; ++n) acc[m][n] = acc[m][n] * scale;
                  }
                  if (mode == 2) {
                    const int cb = tn * 128 + wc * 64;
                    if (cb < E_AV && tm >= NC / 128) {
                      const float4* rt = reinterpret_cast<const float4*>(p.ropetab);
#pragma unroll
                      for (int m = 0; m < 4; ++m) {
                        const int t = ((tm - NC / 128) * 128 + wr * 64 + m * 16 + fr) % T;
                        const float4 r01 = rt[(t / GRID_W) * 8 + fq * 2], r23 = rt[(t / GRID_W) * 8 + fq * 2 + 1];
                        const float4 c01 = rt[(t % GRID_W) * 8 + fq * 2], c23 = rt[(t % GRID_W) * 8 + fq * 2 + 1];
                        const float rc[4] = {r01.x, r01.z, r23.x, r23.z}, rs_[4] = {r01.y, r01.w, r23.y, r23.w};
                        const float cc[4] = {c01.x, c01.z, c23.x, c23.z}, cs_[4] = {c01.y, c01.w, c23.y, c23.w};
#pragma unroll
                        for (int j = 0; j < 4; ++j) {
                          const float a1 = acc[m][0][j], a2 = acc[m][1][j], b1 = acc[m][2][j], b2 = acc[m][3][j];
                          acc[m][0][j] = a1 * rc[j] - a2 * rs_[j]; acc[m][1][j] = a1 * rs_[j] + a2 * rc[j];
                          acc[m][2][j] = b1 * cc[j] - b2 * cs_[j]; acc[m][3][j] = b1 * cs_[j] + b2 * cc[j];
                        }
                      }
                    } else if (cb >= E_FF && cb < E_HQ) {
#pragma unroll
                      for (int n = 0; n < 4; ++n) {
                        const float4 lb4 = *reinterpret_cast<const float4*>(p.lbt + cb - E_FF + n * 16 + fq * 4);
                        const float lb[4] = {lb4.x, lb4.y, lb4.z, lb4.w};
#pragma unroll
                        for (int m = 0; m < 4; ++m)
#pragma unroll
                          for (int j = 0; j < 4; ++j)
                            acc[m][n][j] = __logf(lb[j] + (1.0f - lb[j]) / (1.0f + __expf(-acc[m][n][j])));
                      }
                    }
                  }
#pragma unroll
                  for (int m = 0; m < 4; ++m) {
                    const int row = wr * 64 + m * 16 + fr;
#pragma unroll
                    for (int n = 0; n < 4; ++n) {
                      const int col = wc * 64 + n * 16 + fq * 4;
                      if (col < nlim)
                        *reinterpret_cast<uint2*>(Cb + (long)row * ldc + col) =
                            make_uint2(pack2(acc[m][n][0] * oscale, acc[m][n][1] * oscale), pack2(acc[m][n][2] * oscale, acc[m][n][3] * oscale));
                    }
                  }
                };
      if (g.fp8) {
        const fp8_t* A8 = (const fp8_t*)g.A + (long)tm * 128 * K;
        gemm_tile8<true>([&](int r) { return A8 + (long)r * K; }, (const fp8_t*)g.Bt + (long)tn * 128 * K, K, smem, epi2);
      } else {
        gemm_tile<true>([&](int r) { return Ab + (long)r * K; }, g.Bt + b * g.sB + (long)tn * 128 * K, K, smem, epi2);
      }
    }
  }
}

template <class RowMap>
__device__ __forceinline__ void conv_tile_rm(const float* src, int lds_, int Nvalid, int k0, int n0, act_t* dst, int ldd, float* tile, RowMap rm) {
  const int tid = threadIdx.x;
  {
    const int r = tid >> 5, c4 = (tid & 31) * 4;
    float4 v[8];
#pragma unroll
    for (int rr = 0; rr < 8; ++rr) {
      v[rr] = make_float4(0.f, 0.f, 0.f, 0.f);
      if (n0 + c4 < Nvalid) v[rr] = *reinterpret_cast<const float4*>(src + (long)(k0 + r + rr * 8) * lds_ + n0 + c4);
    }
#pragma unroll
    for (int rr = 0; rr < 8; ++rr) {
      float* t = tile + (r + rr * 8) * 129 + c4;
      t[0] = v[rr].x; t[1] = v[rr].y; t[2] = v[rr].z; t[3] = v[rr].w;
    }
  }
  __syncthreads();
  {
    const int n = tid >> 1, ks = (tid & 1) * 32;
    if (n0 + n < Nvalid) {
      unsigned w[16];
#pragma unroll
      for (int i = 0; i < 16; ++i) w[i] = pack2(tile[(ks + 2 * i) * 129 + n], tile[(ks + 2 * i + 1) * 129 + n]);
      uint4* d = reinterpret_cast<uint4*>(dst + (long)rm(n) * ldd + k0 + ks);
      d[0] = make_uint4(w[0], w[1], w[2], w[3]);
      d[1] = make_uint4(w[4], w[5], w[6], w[7]);
      d[2] = make_uint4(w[8], w[9], w[10], w[11]);
      d[3] = make_uint4(w[12], w[13], w[14], w[15]);
    }
  }
  __syncthreads();
}

template <class RowMap>
__device__ __forceinline__ void conv_tile8_rm(const float* src, int lds_, int k0, int n0, fp8_t* dst, int ldd, float* tile, float scale, RowMap rm, int Nvalid = 1 << 30) {
  const int tid = threadIdx.x;
  {
    const int r = tid >> 5, c4 = (tid & 31) * 4;
    float4 v[8];
#pragma unroll
    for (int rr = 0; rr < 8; ++rr) {
      v[rr] = make_float4(0.f, 0.f, 0.f, 0.f);
      if (n0 + c4 < Nvalid) v[rr] = *reinterpret_cast<const float4*>(src + (long)(k0 + r + rr * 8) * lds_ + n0 + c4);
    }
#pragma unroll
    for (int rr = 0; rr < 8; ++rr) {
      float* t = tile + (r + rr * 8) * 129 + c4;
      t[0] = v[rr].x; t[1] = v[rr].y; t[2] = v[rr].z; t[3] = v[rr].w;
    }
  }
  __syncthreads();
  if ((threadIdx.x >> 1) + n0 < Nvalid) {
    const int n = tid >> 1, ks = (tid & 1) * 32;
    unsigned w[8];
#pragma unroll
    for (int i = 0; i < 8; ++i)
      w[i] = pack4_fp8(tile[(ks + 4 * i) * 129 + n] * scale, tile[(ks + 4 * i + 1) * 129 + n] * scale,
                       tile[(ks + 4 * i + 2) * 129 + n] * scale, tile[(ks + 4 * i + 3) * 129 + n] * scale);
    uint4* d = reinterpret_cast<uint4*>(dst + (long)rm(n) * ldd + k0 + ks);
    d[0] = make_uint4(w[0], w[1], w[2], w[3]);
    d[1] = make_uint4(w[4], w[5], w[6], w[7]);
  }
  __syncthreads();
}

__device__ __forceinline__ void conv_tile(const float* src, int lds_, int Nvalid, int k0, int n0, act_t* dst, int ldd, float* tile) {
  conv_tile_rm(src, lds_, Nvalid, k0, n0, dst, ldd, tile, [=](int n) { return n0 + n; });
}

__device__ __forceinline__ void phase_convert_experts(const Params& p, int l, unsigned char* smem, int blk, int nblk) {
  float* tile = (float*)smem;
  const int per_e = 192;
  fp8_t* Wup = l == 0 ? p.W8up : p.W8up1;
  fp8_t* Wdn = l == 0 ? p.W8down : p.W8down1;
  for (int job = blk; job < NEXP * per_e; job += nblk) {
    const int e = job / per_e, j = job % per_e;
    if (j < 128) {
      const int up = j >> 6, jj = j & 63;
      const int kt = jj >> 2, fp = jj & 3;
      const float* src = (up ? p.w_eu : p.w_eg) + ((long)(l * NEXP + e) * D) * DFF;
      const int rbase = fp * 256 + up * 32;
      conv_tile8_rm(src, DFF, kt * 64, fp * 128, Wup + (long)e * 1024 * D, D, tile, SW8,
                    [=](int n) { return rbase + (n >> 6) * 128 + ((n >> 5) & 1) * 64 + (n & 31); });
    } else {
      const int jj = j - 128;
      const int kt = jj >> 3, nt = jj & 7;
      const float* src = p.w_ed + ((long)(l * NEXP + e) * DFF) * D;
      const int n0 = nt * 128;
      conv_tile8_rm(src, D, kt * 64, n0, Wdn + (long)e * 1024 * DFF, DFF, tile, SW8, [=](int n) { return n0 + n; });
    }
  }
}

__device__ __forceinline__ void phase_moe(const Params& p, int l, bool down, unsigned char* smem) {
  const int* cntp = p.cnt + l * NEXP * 64;
  int total = 0;
  for (int e = 0; e < NEXP; ++e) total += ((cntp[e * 64] + 127) >> 7) * 8;
  for (int tile = blockIdx.x; tile < total; tile += gridDim.x) {
    int e = 0, tb = 0, rowoff = 0;
    for (; e < NEXP - 1; ++e) {
      const int c = cntp[e * 64];
      const int nt = ((c + 127) >> 7) * 8;
      if (tile < tb + nt) break;
      tb += nt; rowoff += c;
    }
    const int c = cntp[e * 64];
    const int lt = tile - tb, mt = lt >> 3, nt = lt & 7;
    const int rows_valid = min(128, c - mt * 128);
    const int* lst = p.list + (long)(l * NEXP + e) * NR + mt * 128;
    const long hrow0 = (long)rowoff + mt * 128;
    if (!down) {
      gemm_tile8<true>([&](int r) { return p.u8 + (long)(lst[min(r, rows_valid - 1)] >> 1) * D; },
                (l == 0 ? p.W8up : p.W8up1) + ((long)e * 1024 + nt * 128) * D, D, smem,
                [&](f32x4 (&acc)[4][4], int wr, int wc, int fr, int fq) {
                  constexpr float dq = 1.0f / (SU8 * SW8);
#pragma unroll
                  for (int m = 0; m < 4; ++m) {
                    const int row = wr * 64 + m * 16 + fr;
                    if (row < rows_valid) {
#pragma unroll
                      for (int n = 0; n < 2; ++n) {
                        float hv[4];
#pragma unroll
                        for (int j = 0; j < 4; ++j) {
                          const float g = acc[m][n][j] * dq, uu = acc[m][n + 2][j] * dq;
                          hv[j] = g / (1.0f + __expf(-g)) * uu * SH8;
                        }
                        *reinterpret_cast<unsigned*>(p.H8 + (hrow0 + row) * DFF + nt * 64 + wc * 32 + n * 16 + fq * 4) =
                            pack4_fp8(hv[0], hv[1], hv[2], hv[3]);
                      }
                    }
                  }
                });
    } else {
      const fp8_t* Ab = p.H8 + hrow0 * DFF;
      gemm_tile8<true>([&](int r) { return Ab + (long)r * DFF; }, (l == 0 ? p.W8down : p.W8down1) + ((long)e * 1024 + nt * 128) * DFF, DFF, smem,
                [&](f32x4 (&acc)[4][4], int wr, int wc, int fr, int fq) {
                  constexpr float dq = 1.0f / (SH8 * SW8);
#pragma unroll
                  for (int m = 0; m < 4; ++m) {
                    const int row = wr * 64 + m * 16 + fr;
                    if (row < rows_valid) {
                      const int ts = lst[row];
                      const float w = p.ew[ts] * dq;
#pragma unroll
                      for (int n = 0; n < 4; ++n)
                        *reinterpret_cast<uint2*>(p.Y + (long)ts * D + nt * 128 + wc * 64 + n * 16 + fq * 4) =
                            make_uint2(pack2(acc[m][n][0] * w, acc[m][n][1] * w), pack2(acc[m][n][2] * w, acc[m][n][3] * w));
                    }
                  }
                });
    }
  }
}

__device__ __forceinline__ void phase_convert_dense(const Params& p, unsigned char* smem) {
  float* tile = (float*)smem;
  const int JM = 48, J0 = JM + 16 * 26, J1 = J0 + 128, J2 = J1 + 16 * 19, J3 = J2 + 128;
  for (int job = blockIdx.x; job < J3; job += gridDim.x) {
    if (job < JM) { mod_item(p, job, smem); continue; }
    if (job < J0) { int j = job - JM; const int n0 = (j % 26) * 128; conv_tile8_rm(p.w_in_even, IN_EVEN, (j / 26) * 64, n0, p.W8in_even, D, tile, SW8, [=](int n) { return n0 + n; }); }
    else if (job < J1) { int j = job - J0; conv_tile(p.w_out_even, D, D, (j / 8) * 64, (j % 8) * 128, p.Wt_out_even, D, tile); }
    else if (job < J2) { int j = job - J1; const int n0 = (j % 19) * 128; conv_tile8_rm(p.w_in_odd, IN_ODD, (j / 19) * 64, n0, p.W8in_odd, D, tile, SW8, [=](int n) { return n0 + n; }, O_FA); }
    else { int j = job - J2; conv_tile(p.w_out_odd, D, D, (j / 8) * 64, (j % 8) * 128, p.Wt_out_odd, D, tile); }
  }
}

__device__ __forceinline__ void phase_fold_z(const Params& p, long gtid, long gstride, float* tab) {
  if (threadIdx.x < 64) {
    float sn, cs;
    sincospif((float)threadIdx.x * (1.0f / 32.0f), &sn, &cs);
    tab[threadIdx.x] = cs; tab[64 + threadIdx.x] = -sn;
  }
  __syncthreads();
  for (long i = gtid; i < (long)512 * D; i += gstride) {
    const int k = (int)(i % D), np = (int)(i / D);
    const int part = np >> 8, col = np & 255, g = col >> 6, cp = col & 63;
    const float* wz = p.w_in_odd + (long)k * IN_ODD + O_Z + g * 64;
    float s = 0.f;
    const float* tb = tab + part * 64;
#pragma unroll 8
    for (int c = 0; c < 64; ++c) s += wz[c] * tb[(c * cp) & 63];
    const unsigned q = pack4_fp8(s * SW8, 0.f, 0.f, 0.f);
    p.W8in_odd[(long)(O_FA + np) * D + k] = (unsigned char)(q & 0xffu);
  }
  for (long i = gtid; i < (long)(IN_ODD_PAD - O_END) * D; i += gstride) p.W8in_odd[(long)O_END * D + i] = 0;
}

__device__ __forceinline__ void phase_cmat(const Params& p, long gtid, long gstride) {
  for (long i = gtid; i < (long)T * T; i += gstride) {
    const int t = (int)(i % T), tp = (int)(i / T);
    float sn, cs;
    sincospif((float)((t * tp) & (T - 1)) * (2.0f / T), &sn, &cs);
    stA(p.Cmat + (long)tp * 2 * T + t, cs);
    stA(p.Cmat + (long)tp * 2 * T + T + t, sn);
  }
}

__device__ __forceinline__ void row_stats(const float4 (&v)[4], float& mu, float& rs) {
  float s = 0.f;
#pragma unroll
  for (int i = 0; i < 4; ++i) s += v[i].x + v[i].y + v[i].z + v[i].w;
  mu = wave_sum(s) * (1.0f / D);
  float q = 0.f;
#pragma unroll
  for (int i = 0; i < 4; ++i) {
    float a = v[i].x - mu, b = v[i].y - mu, c = v[i].z - mu, d = v[i].w - mu;
    q += a * a + b * b + c * c + d * d;
  }
  rs = 1.0f / sqrtf(wave_sum(q) * (1.0f / D) + LN_EPS);
}

__device__ __forceinline__ void phase_lnmod_first(const Params& p) {
  const int lane = threadIdx.x & 63;
  const long w0 = (long)blockIdx.x * 4 + (threadIdx.x >> 6), wstride = (long)gridDim.x * 4;
  for (long row = w0; row < NR; row += wstride) {
    const float4* h = reinterpret_cast<const float4*>(hrow_in(p, row));
    const float* md = modrow(p, 0, row);
    float4 v[4];
#pragma unroll
    for (int i = 0; i < 4; ++i) v[i] = h[i * 64 + lane];
    float mu, rs;
    row_stats(v, mu, rs);
#pragma unroll
    for (int i = 0; i < 4; ++i) {
      const float4 sh = reinterpret_cast<const float4*>(md)[i * 64 + lane];
      const float4 sc = reinterpret_cast<const float4*>(md + D)[i * 64 + lane];
      float a = (v[i].x - mu) * rs * (1.f + sc.x) + sh.x, b = (v[i].y - mu) * rs * (1.f + sc.y) + sh.y;
      float c = (v[i].z - mu) * rs * (1.f + sc.z) + sh.z, d = (v[i].w - mu) * rs * (1.f + sc.w) + sh.w;
      reinterpret_cast<unsigned*>(p.u8 + row * D)[i * 64 + lane] = pack4_fp8(a * SU8, b * SU8, c * SU8, d * SU8);
    }
  }
}

template <int R_UNUSED>
__device__ __forceinline__ void phase_resid_ln(const Params& p, int l, int sub, long row_lo, long row_hi, unsigned char* smem) {
  const int lane = threadIdx.x & 63;
  int* cntL = (int*)smem;
  int* nent = cntL + 16;
  int* entL = cntL + 32;
  float* wT = (float*)(smem + 4096);
  if (sub == 0) {
    if (threadIdx.x < 32) cntL[threadIdx.x] = 0;
    for (int i = threadIdx.x; i < D * NEXP; i += 256) wT[(i & 15) * D + (i >> 4)] = p.w_router[i];
    __syncthreads();
  }
  const bool last = (sub == 1 && l == 1);
  const long nw = (long)gridDim.x * 4, wi = (long)blockIdx.x * 4 + (threadIdx.x >> 6);
  const long rpw = (row_hi - row_lo + nw - 1) / nw;
  const long r0 = row_lo + wi * rpw, r1 = min(row_hi, r0 + rpw);
  const float4* lgp = reinterpret_cast<const float4*>(p.ln_g + (l * 2 + sub) * D);
  const float4* lbp = reinterpret_cast<const float4*>(p.ln_b + (l * 2 + sub) * D);
  float4 lgv[4], lbv[4];
  if (R_UNUSED != 1) {
#pragma unroll
    for (int i = 0; i < 4; ++i) { lgv[i] = lgp[i * 64 + lane]; lbv[i] = lbp[i * 64 + lane]; }
  }
  float4 gv[4], shv[4], scv[4];
  int cur_bb = -2;
  float4 hv[4];
  uint2 mv[4], m2v[4];
  auto load_row = [&](long row) {
    const float4* hin = reinterpret_cast<const float4*>((l == 0 && sub == 0) ? hrow_in(p, row) : hrow(p, row));
    const uint2* m = reinterpret_cast<const uint2*>(sub == 0 ? p.M + row * D : p.Y + row * 2 * D);
#pragma unroll
    for (int i = 0; i < 4; ++i) {
      hv[i] = hin[i * 64 + lane];
      mv[i] = m[i * 64 + lane];
      if (sub == 1) m2v[i] = m[256 + i * 64 + lane];
    }
  };
  if (r0 < r1) load_row(r0);
  for (long row = r0; row < r1; ++row) {
    const int bb = row < NC ? NB : (int)((row - NC) / T);
    if (bb != cur_bb) {
      cur_bb = bb;
      const float* md = p.mod + ((long)l * (NB + 1) + bb) * 6 * D;
      const float* md2 = (sub == 0) ? md + 3 * D : p.mod + ((long)(NB + 1) + bb) * 6 * D;
#pragma unroll
      for (int i = 0; i < 4; ++i) {
        gv[i] = reinterpret_cast<const float4*>(md + (sub == 0 ? 2 : 5) * D)[i * 64 + lane];
        shv[i] = reinterpret_cast<const float4*>(md2)[i * 64 + lane];
        scv[i] = reinterpret_cast<const float4*>(md2 + D)[i * 64 + lane];
      }
    }
    float4 v[4];
#pragma unroll
    for (int i = 0; i < 4; ++i) {
      float m0 = bf_lo(mv[i].x), m1 = bf_hi(mv[i].x), m2_ = bf_lo(mv[i].y), m3 = bf_hi(mv[i].y);
      if (sub == 1) { m0 += bf_lo(m2v[i].x); m1 += bf_hi(m2v[i].x); m2_ += bf_lo(m2v[i].y); m3 += bf_hi(m2v[i].y); }
      v[i].x = ALPHA * hv[i].x + gv[i].x * m0;
      v[i].y = ALPHA * hv[i].y + gv[i].y * m1;
      v[i].z = ALPHA * hv[i].z + gv[i].z * m2_;
      v[i].w = ALPHA * hv[i].w + gv[i].w * m3;
    }
    load_row(min(row + 1, r1 - 1));
    if (R_UNUSED == 1) {
#pragma unroll
      for (int i = 0; i < 4; ++i) { lgv[i] = lgp[i * 64 + lane]; lbv[i] = lbp[i * 64 + lane]; }
    }
    float mu, rs;
    row_stats(v, mu, rs);
#pragma unroll
    for (int i = 0; i < 4; ++i) {
      v[i].x = (v[i].x - mu) * rs * lgv[i].x + lbv[i].x;
      v[i].y = (v[i].y - mu) * rs * lgv[i].y + lbv[i].y;
      v[i].z = (v[i].z - mu) * rs * lgv[i].z + lbv[i].z;
      v[i].w = (v[i].w - mu) * rs * lgv[i].w + lbv[i].w;
    }
    float4* hout = reinterpret_cast<float4*>(hrow(p, row));
    if (last) {
#pragma unroll
      for (int i = 0; i < 4; ++i) hout[i * 64 + lane] = v[i];
      continue;
    }
    row_stats(v, mu, rs);
    float lo[NEXP];
#pragma unroll
    for (int e = 0; e < NEXP; ++e) lo[e] = 0.f;
    uint2 up[4];
#pragma unroll
    for (int i = 0; i < 4; ++i) {
      float uv[4];
      uv[0] = (v[i].x - mu) * rs * (1.f + scv[i].x) + shv[i].x;
      uv[1] = (v[i].y - mu) * rs * (1.f + scv[i].y) + shv[i].y;
      uv[2] = (v[i].z - mu) * rs * (1.f + scv[i].z) + shv[i].z;
      uv[3] = (v[i].w - mu) * rs * (1.f + scv[i].w) + shv[i].w;
      up[i] = make_uint2(pack4_fp8(uv[0] * SU8, uv[1] * SU8, uv[2] * SU8, uv[3] * SU8), 0u);
      if (sub == 0) {
#pragma unroll
        for (int e = 0; e < NEXP; ++e) {
          const float4 w4 = *reinterpret_cast<const float4*>(wT + e * D + (i * 64 + lane) * 4);
          lo[e] += uv[0] * w4.x + uv[1] * w4.y + uv[2] * w4.z + uv[3] * w4.w;
          if ((e & 3) == 3) __builtin_amdgcn_sched_barrier(0);
        }
      }
    }
    int ge1 = 0, ge2 = 0;
    float w1 = 0.f, w2 = 0.f;
    if (sub == 0) {
      float mine = 0.f;
#pragma unroll
      for (int e = 0; e < NEXP; ++e) {
        const float rsum = row_sum16(lo[e]);
        mine = ((lane & 15) == e) ? rsum : mine;
      }
      mine += __shfl_xor(mine, 16);
      mine += __shfl_xor(mine, 32);
#pragma unroll
      for (int e = 0; e < NEXP; ++e) lo[e] = __int_as_float(__builtin_amdgcn_readlane(__float_as_int(mine), e));
      float mx = lo[0];
#pragma unroll
      for (int e = 1; e < NEXP; ++e) mx = fmaxf(mx, lo[e]);
      float sum = 0.f;
#pragma unroll
      for (int e = 0; e < NEXP; ++e) { lo[e] = __expf(lo[e] - mx); sum += lo[e]; }
      const float inv = 1.0f / sum;
      float bestg = -1e30f, gp1 = 0.f, gp2 = 0.f;
#pragma unroll
      for (int gq = 0; gq < 4; ++gq) {
        float s1 = -1e30f, s2 = -1e30f, p1 = 0.f, p2 = 0.f;
        int e1 = 0, e2 = 0;
#pragma unroll
        for (int j = 0; j < 4; ++j) {
          const int e = gq * 4 + j;
          const float pe = lo[e] * inv;
          const float se = pe + p.b_router[e];
          if (se > s1) { s2 = s1; p2 = p1; e2 = e1; s1 = se; p1 = pe; e1 = e; }
          else if (se > s2) { s2 = se; p2 = pe; e2 = e; }
        }
        const float gs = s1 + s2;
        if (gs > bestg) { bestg = gs; ge1 = e1; ge2 = e2; gp1 = p1; gp2 = p2; }
      }
      const float wsum = gp1 + gp2;
      w1 = gp1 / wsum; w2 = gp2 / wsum;
    }
#pragma unroll
    for (int i = 0; i < 4; ++i) hout[i * 64 + lane] = v[i];
#pragma unroll
    for (int i = 0; i < 4; ++i) reinterpret_cast<unsigned*>(p.u8 + row * D)[i * 64 + lane] = up[i].x;
    if (sub == 0 && lane == 0) {
      p.ew[row * 2 + 0] = w1; p.ew[row * 2 + 1] = w2;
      const int lp1 = atomicAdd(cntL + ge1, 1), lp2 = atomicAdd(cntL + ge2, 1);
      const int ei = atomicAdd(nent, 2);
      entL[2 * ei] = ((int)(row * 2) << 4) | ge1; entL[2 * ei + 1] = lp1;
      entL[2 * ei + 2] = ((int)(row * 2 + 1) << 4) | ge2; entL[2 * ei + 3] = lp2;
    }
  }
  if (sub == 0) {
    __syncthreads();
    if (threadIdx.x < NEXP) {
      const int c = cntL[threadIdx.x];
      cntL[threadIdx.x] = c ? atomicAdd(p.cnt + (l * NEXP + threadIdx.x) * 64, c) : 0;
    }
    __syncthreads();
    const int ne = *nent;
    for (int i = threadIdx.x; i < ne; i += 256) {
      const int key = entL[2 * i], lp = entL[2 * i + 1];
      const int e = key & 15;
      p.list[(long)(l * NEXP + e) * NR + cntL[e] + lp] = key >> 4;
    }
    __syncthreads();
  }
}

#define LOOP(n) for (long i = gtid; i < (long)(n); i += gstride)

#ifdef ONLY_PHASE
#define PH(n, ...) if (ONLY_PHASE == n) { __VA_ARGS__ }
#define GSYNC()
#else
#define PH(n, ...) { __VA_ARGS__ }
#define GSYNC() xcd_barrier(xb)
#endif

__global__ void __launch_bounds__(256, 2) mega_kernel(Params p) {
  cg::grid_group grid = cg::this_grid();
  __shared__ __attribute__((aligned(16))) unsigned char smem[SMEM_BYTES + 16];
  if (threadIdx.x == 0) *reinterpret_cast<uint4*>(smem + SMEM_BYTES) = make_uint4(0u, 0u, 0u, 0u);
  __syncthreads();
  XcdBarrier xb = xcd_barrier_post(p.bar, (volatile LAS unsigned*)(smem + SMEM_BYTES));
  const long gtid = (long)blockIdx.x * blockDim.x + threadIdx.x;
  const long gstride = (long)gridDim.x * blockDim.x;
  const int nsb = min(256, (int)gridDim.x / 2);
  PH(0,
    if (gtid < 2 * NEXP) p.cnt[gtid * 64] = 0;
    phase_convert_dense(p, smem);
    phase_fold_z(p, gtid, gstride, (float*)(smem + 65536));
    LOOP(T > 1024 ? T : 1024) ph_tables(p, i);)
#ifndef ONLY_PHASE
  if (p.use_cg_sync) grid.sync();
#endif
  GSYNC();
  PH(1, phase_lnmod_first(p);)
  GSYNC();
  PH(2, phase_gemm(p, GemmJob{(const act_t*)p.u8, (const act_t*)p.W8in_even, p.P, 0, 0, 0, 1, NR / 128, IN_EVEN / 128, D, PW, IN_EVEN, 2, 1.0f / (SU8 * SW8), 1}, smem);)
  GSYNC();
  PH(3,
    if ((int)blockIdx.x < nsb) phase_scan<0>(p, smem, blockIdx.x, nsb);
    else { phase_attn(p, smem, blockIdx.x - nsb, gridDim.x - nsb); phase_convert_experts(p, 0, smem, blockIdx.x - nsb, gridDim.x - nsb); })
  GSYNC();
  PH(4, phase_combine<0>(p);)
  GSYNC();
  PH(5, phase_gemm(p, GemmJob{p.u, p.Wt_out_even, p.M, 0, 0, 0, 1, NR / 128, D / 128, D, D, D, 0, 1.0f, 0}, smem);)
  GSYNC();
  PH(6, phase_resid_ln<1>(p, 0, 0, 0, NR, smem);)
  GSYNC();
  PH(7, phase_moe(p, 0, false, smem);)
  GSYNC();
  PH(8, phase_moe(p, 0, true, smem);)
  GSYNC();
  PH(9, phase_resid_ln<2>(p, 0, 1, 0, NR, smem); phase_cmat(p, gtid, gstride);)
  GSYNC();
  PH(10, phase_gemm(p, GemmJob{(const act_t*)p.u8, (const act_t*)p.W8in_odd, p.P, 0, 0, 0, 1, NR / 128, IN_ODD_PAD / 128, D, PW, O_FA, 1, 1.0f / (SU8 * SW8), 1}, smem);)
  GSYNC();
  PH(11, phase_gla_decay(p);)
  GSYNC();
  PH(12,
    if ((int)blockIdx.x < nsb) phase_scan<1>(p, smem, blockIdx.x, nsb);
    else {
      phase_gemm(p, GemmJob{p.Cmat, p.FT, p.u + (long)NC * D + 768, 0, (long)256 * 2 * T, (long)T * D, NB, T / 128, 2, 2 * T, D,
                            256, 0, 0.00276213586400995f, 0}, smem, blockIdx.x - nsb, gridDim.x - nsb);
      phase_convert_experts(p, 1, smem, blockIdx.x - nsb, gridDim.x - nsb);
    })
  GSYNC();
  PH(13, phase_combine<1>(p);)
  GSYNC();
  PH(14,
    phase_gemm(p, GemmJob{p.u + (long)NC * D, p.Wt_out_odd, p.M + (long)NC * D, 0, 0, 0, 1, NT / 128, D / 128, D, D, D, 0, 1.0f, 0}, smem);)
  GSYNC();
  PH(15, phase_resid_ln<1>(p, 1, 0, NC, NR, smem);)
  GSYNC();
  PH(16, phase_moe(p, 1, false, smem);)
  GSYNC();
  PH(17, phase_moe(p, 1, true, smem);)
  GSYNC();
  PH(18, phase_resid_ln<2>(p, 1, 1, NC, NR, smem);)
}

static size_t carve(Params& p, char* ws) {
  size_t off = 0;
  auto take = [&](size_t bytes) { char* r = ws + off; off += (bytes + 255) & ~(size_t)255; return r; };
  p.mod = (float*)take(sizeof(float) * 2 * (NB + 1) * 6 * D);
  p.hc = (float*)take(sizeof(float) * (size_t)NC * D);
  p.costab = (float*)take(sizeof(float) * T);
  p.sintab = (float*)take(sizeof(float) * T);
  p.lbt = (float*)take(sizeof(float) * 1024);
  p.ropetab = (float*)take(sizeof(float) * 64 * 16 * 2);
  p.ew = (float*)take(sizeof(float) * (size_t)NR * 2);
  p.eidx = nullptr;
  p.u = (act_t*)take(sizeof(act_t) * (size_t)NR * D);
  p.P = (act_t*)take(sizeof(act_t) * (size_t)NR * PW);
  p.OF = (act_t*)take(sizeof(act_t) * (size_t)NR * 768);
  p.OB = (act_t*)take(sizeof(act_t) * (size_t)NR * 768);
  p.M = p.OF;
  p.Cmat = (act_t*)take(sizeof(act_t) * (size_t)T * 2 * T);
  p.FT = (act_t*)take(sizeof(act_t) * (size_t)NB * 256 * 2 * T);
  p.LF = (act_t*)take(sizeof(act_t) * (size_t)2 * NR * 384);
  p.W8up = (unsigned char*)p.Cmat;
  p.W8down = p.W8up + (size_t)NEXP * 1024 * D;
  p.W8up1 = (unsigned char*)take((size_t)NEXP * 1024 * (D + DFF));
  p.W8down1 = p.W8up1 + (size_t)NEXP * 1024 * D;
  p.u8 = (unsigned char*)take((size_t)NR * D);
  p.Y = p.P;
  p.H8 = (unsigned char*)(p.P + (size_t)2 * NR * D);
  p.bar = (unsigned*)take(sizeof(unsigned) * XCD_BAR_WORDS);
  p.cnt = (int*)take(sizeof(int) * 2 * NEXP * 64);
  p.list = (int*)take(sizeof(int) * (size_t)2 * NEXP * NR);
  p.Wt_in_even = nullptr;
  p.W8in_even = (unsigned char*)take((size_t)IN_EVEN * D);
  p.Wt_out_even = (act_t*)take(sizeof(act_t) * (size_t)D * D);
  p.Wt_in_odd = nullptr;
  p.W8in_odd = (unsigned char*)take((size_t)IN_ODD_PAD * D);
  p.Wt_out_odd = (act_t*)take(sizeof(act_t) * (size_t)D * D);
  return off;
}

static void fill_inputs(Params& p, void* const* d_in) {
  const float** f = (const float**)&p;
  for (int i = 0; i < 23; ++i) f[i] = (const float*)d_in[i];
}

extern "C" void kernel_launch(void* const* d_in, const int* in_sizes, int n_in, void* d_out, int out_size,
                              void* d_ws, size_t ws_size, hipStream_t stream) {
  static int grid_blocks = 0;
  if (!grid_blocks) {
    int dev = 0, cus = 0, per_cu = 0;
    (void)hipGetDevice(&dev);
    (void)hipDeviceGetAttribute(&cus, hipDeviceAttributeMultiprocessorCount, dev);
    (void)hipOccupancyMaxActiveBlocksPerMultiprocessor(&per_cu, mega_kernel, 256, 0);
    grid_blocks = cus * per_cu;
  }
  Params p{};
  fill_inputs(p, d_in);
  p.out = (float*)d_out;
  size_t need = carve(p, (char*)d_ws);
  if (need > ws_size) { fprintf(stderr, "workspace too small: need %zu have %zu\n", need, ws_size); return; }
  (void)hipMemsetAsync(p.bar, 0, sizeof(unsigned) * XCD_BAR_WORDS, stream);
  void* args[] = {&p};
  hipError_t e = hipLaunchCooperativeKernel((void*)mega_kernel, dim3(grid_blocks), dim3(256), args, 0, stream);
  if (e != hipSuccess) fprintf(stderr, "cooperative launch failed: %s (grid %d)\n", hipGetErrorString(e), grid_blocks);
}
#endif
```

```cpp
#ifndef HOST_TEST
#include <hip/hip_runtime.h>
#include <hip/hip_cooperative_groups.h>
#include <cstdio>
namespace cg = cooperative_groups;
#define DEV __device__ __forceinline__
#else
#include <cmath>
#include <cstdio>
#include <cstdlib>
#include <cstring>
#define DEV static inline
#endif

#ifndef T_BATCH
#define T_BATCH 8
#endif
#ifndef T_SEQ
#define T_SEQ 2048
#endif
#ifndef T_CTX
#define T_CTX 256
#endif

constexpr int D = 1024, NB = T_BATCH, T = T_SEQ, C = T_CTX;
constexpr int NC = NB * C, NT = NB * T, NR = NC + NT;
constexpr int GRID_W = 64;
constexpr int IN_EVEN = 3328, IN_ODD = 2592, PW = 3328;
constexpr int NEXP = 16, DFF = 512;
constexpr float ALPHA = 1.4142135623730951f;
constexpr float LN_EPS = 1e-5f;
constexpr int E_AQ = 0, E_AK = 512, E_AV = 640, E_FF = 768, E_HQ = 1792, E_HI = 2304, E_HG = 2816;
constexpr int O_Q = 0, O_K = 384, O_V = 768, O_RF = 1536, O_G = 1568, O_Z = 2336;

#ifdef HOST_TEST
typedef float act_t;
DEV float ldA(const act_t* p) { return *p; }
DEV void stA(act_t* p, float v) { *p = v; }
#else
typedef unsigned short act_t;
DEV float ldA(const act_t* p) { return __uint_as_float(((unsigned)*p) << 16); }
DEV void stA(act_t* p, float v) {
  unsigned u = __float_as_uint(v);
  u += 0x7fffu + ((u >> 16) & 1u);
  *p = (unsigned short)(u >> 16);
}
#endif

struct Params {
  const float *x, *c, *ctx, *c_ctx, *w_ada, *b_ada, *ln_g, *ln_b, *w_in_even, *attn_sink, *lb_logits, *hgrn_norm,
      *w_out_even, *w_in_odd, *gla_gate_w, *gla_gate_b, *gla_norm, *w_out_odd, *w_router, *b_router, *w_eg, *w_eu,
      *w_ed;
  float* out;
  float *mod, *hc, *costab, *sintab, *lbt, *ew, *ropetab;
  int* eidx;
  act_t *u, *P, *OF, *OB, *M, *LF;
  act_t *Wt_in_even, *Wt_out_even, *Wt_in_odd, *Wt_out_odd;
  act_t *Y, *Cmat, *FT;
  unsigned char *W8up, *W8down, *W8up1, *W8down1, *H8, *u8;
  unsigned char *W8in_even, *W8in_odd;
  int *cnt, *list;
  unsigned* bar;
  int use_cg_sync;
  int pad_;
};

DEV float sigmoidf_(float v) { return 1.0f / (1.0f + expf(-v)); }
DEV float siluf_(float v) { return v / (1.0f + expf(-v)); }

DEV const float* hrow_in(const Params& p, long row) {
  return row < NC ? p.ctx + row * D : p.x + (row - NC) * D;
}
DEV float* hrow(const Params& p, long row) { return row < NC ? p.hc + row * D : p.out + (row - NC) * D; }
DEV const float* modrow(const Params& p, int l, long row) {
  int bb = row < NC ? NB : (int)((row - NC) / T);
  return p.mod + ((long)l * (NB + 1) + bb) * 6 * D;
}

DEV void ph_mod(const Params& p, long i) {
  int j = (int)(i % (6 * D));
  int bb = (int)((i / (6 * D)) % (NB + 1));
  int l = (int)(i / ((long)6 * D * (NB + 1)));
  const float* cv = bb < NB ? p.c + (long)bb * D : p.c_ctx;
  const float* w = p.w_ada + (long)l * D * 6 * D + j;
  float s = p.b_ada[l * 6 * D + j];
  for (int k = 0; k < D; ++k) s += siluf_(cv[k]) * w[(long)k * 6 * D];
  p.mod[i] = s;
}

DEV void ph_tables(const Params& p, long i) {
  if (i < T) {
    double a = 6.283185307179586476925 * (double)i / (double)T;
    p.costab[i] = (float)cos(a);
    p.sintab[i] = (float)sin(a);
  }
  if (i < 1024) {
    int pos = (int)(i >> 4), idx = (int)(i & 15);
    float ang = (float)pos * powf(10000.0f, -(float)idx / 16.0f);
    p.ropetab[2 * i] = cosf(ang);
    p.ropetab[2 * i + 1] = sinf(ang);
  }
  if (i < 1024) {
    int dir = (int)(i / 512), col = (int)(i % 512);
    float l0 = p.lb_logits[(dir * 2 + 0) * 512 + col], l1 = p.lb_logits[(dir * 2 + 1) * 512 + col];
    p.lbt[i] = 1.0f / (1.0f + expf(l1 - l0));
  }
}

DEV void ln_mod_row(const float* h, const float* shift, const float* scale, act_t* u) {
  float mu = 0.f;
  for (int k = 0; k < D; ++k) mu += h[k];
  mu *= (1.0f / D);
  float var = 0.f;
  for (int k = 0; k < D; ++k) { float d = h[k] - mu; var += d * d; }
  var *= (1.0f / D);
  float rs = 1.0f / sqrtf(var + LN_EPS);
  for (int k = 0; k < D; ++k) stA(u + k, (h[k] - mu) * rs * (1.0f + scale[k]) + shift[k]);
}

DEV void ph_lnmod_first(const Params& p, long row) {
  const float* m = modrow(p, 0, row);
  ln_mod_row(hrow_in(p, row), m, m + D, p.u + row * D);
}

DEV void gemm_item_act(const act_t* A, const float* W, act_t* Cout, int K, int N, int ldc, long i) {
  int n4 = (int)(i % (N / 4));
  long row = i / (N / 4);
  const act_t* a = A + row * K;
  const float* w = W + n4 * 4;
  float s0 = 0, s1 = 0, s2 = 0, s3 = 0;
  for (int k = 0; k < K; ++k) {
    float av = ldA(a + k);
    const float* wr = w + (long)k * N;
    s0 += av * wr[0]; s1 += av * wr[1]; s2 += av * wr[2]; s3 += av * wr[3];
  }
  act_t* o = Cout + row * ldc + n4 * 4;
  stA(o, s0); stA(o + 1, s1); stA(o + 2, s2); stA(o + 3, s3);
}

DEV void ph_rope(const Params& p, long i) {
  int pr = (int)(i % 32);
  int hh = (int)((i / 32) % 10);
  long lr = i / 320;
  int t = (int)(lr % T);
  int col = hh < 8 ? E_AQ + hh * 64 : E_AK + (hh - 8) * 64;
  int idx = pr & 15;
  int pos = pr < 16 ? t / GRID_W : t % GRID_W;
  int d0 = pr < 16 ? idx : 32 + idx;
  float inv = powf(10000.0f, -(float)idx / 16.0f);
  float ang = (float)pos * inv;
  float cs = cosf(ang), sn = sinf(ang);
  act_t* base = p.P + (NC + lr) * PW + col;
  float x1 = ldA(base + d0), x2 = ldA(base + d0 + 16);
  stA(base + d0, x1 * cs - x2 * sn);
  stA(base + d0 + 16, x1 * sn + x2 * cs);
}

DEV void ph_attn(const Params& p, long i) {
  int h = (int)(i % 8);
  long row = i / 8;
  int kv = h / 4;
  bool lat = row >= NC;
  int b = lat ? (int)((row - NC) / T) : (int)(row / C);
  int t = lat ? (int)((row - NC) % T) : 0;
  float q[64], acc[64];
  const act_t* qp = p.P + row * PW + E_AQ + h * 64;
#pragma unroll
  for (int d = 0; d < 64; ++d) { q[d] = ldA(qp + d) * 0.125f; acc[d] = 0.f; }
  float m = p.attn_sink[h], l = 1.0f;
  int nkeys = C + (lat ? 257 : 0);
  for (int j = 0; j < nkeys; ++j) {
    long krow;
    if (j < C) krow = (long)b * C + j;
    else {
      int kp = t - 128 + (j - C);
      if (kp < 0 || kp >= T) continue;
      krow = NC + (long)b * T + kp;
    }
    const act_t* kptr = p.P + krow * PW + E_AK + kv * 64;
    const act_t* vptr = p.P + krow * PW + E_AV + kv * 64;
    float s = 0.f;
#pragma unroll
    for (int d = 0; d < 64; ++d) s += q[d] * ldA(kptr + d);
    float mn = fmaxf(m, s);
    float sc = expf(m - mn), pj = expf(s - mn);
    l = l * sc + pj;
#pragma unroll
    for (int d = 0; d < 64; ++d) acc[d] = acc[d] * sc + pj * ldA(vptr + d);
    m = mn;
  }
  float il = 1.0f / l;
  act_t* o = p.u + row * D + h * 64;
#pragma unroll
  for (int d = 0; d < 64; ++d) stA(o + d, acc[d] * il);
}

template <int MODE>
DEV void ph_scan(const Params& p, long i) {
  constexpr int DK = MODE == 0 ? 128 : 96;
  constexpr int DV = MODE == 0 ? 128 : 192;
  int e = (int)(i % DV);
  int dir = (int)((i / DV) % 2);
  int h = (int)((i / (2 * DV)) % 4);
  int b = (int)(i / (8 * DV));
  float S[DK];
#pragma unroll
  for (int d = 0; d < DK; ++d) S[d] = 0.f;
  act_t* OD = dir == 0 ? p.OF : p.OB;
  for (int step = 0; step < C + T; ++step) {
    long row;
    if (step < C) row = (long)b * C + (dir == 0 ? step : C - 1 - step);
    else { int tt = step - C; row = NC + (long)b * T + (dir == 0 ? tt : T - 1 - tt); }
    const act_t* pr = p.P + row * PW;
    float o = 0.f;
    if (MODE == 0) {
      float v = ldA(pr + E_HI + h * 128 + e);
      const act_t* zp = pr + E_FF + dir * 512 + h * 128;
      const act_t* qp = pr + E_HQ + h * 128;
      const float* lb = p.lbt + dir * 512 + h * 128;
#pragma unroll
      for (int d = 0; d < DK; ++d) {
        float f = lb[d] + (1.0f - lb[d]) * sigmoidf_(ldA(zp + d));
        S[d] = f * S[d] + (1.0f - f) * v;
        o += ldA(qp + d) * S[d];
      }
      stA(OD + row * 768 + h * 128 + e, o);
    } else {
      float v = ldA(pr + O_V + h * 192 + e);
      const act_t* kp = pr + O_K + h * 96;
      const act_t* qp = pr + O_Q + h * 96;
      const act_t* lf = p.LF + ((long)dir * NR + row) * 384 + h * 96;
#pragma unroll
      for (int d = 0; d < DK; ++d) {
        float f = expf(ldA(lf + d));
        S[d] = f * S[d] + ldA(kp + d) * v;
        o += ldA(qp + d) * S[d];
      }
      stA(OD + row * 768 + h * 192 + e, o * 0.10206207261596575f);
    }
  }
}

template <int MODE>
DEV void ph_combine(const Params& p, long i) {
  constexpr int DV = MODE == 0 ? 128 : 192;
  int h = (int)(i % 4);
  long row = (MODE == 0) ? i / 4 : NC + i / 4;
  const act_t* f = p.OF + row * 768 + h * DV;
  const act_t* bk = p.OB + row * 768 + h * DV;
  float ss = 0.f;
  for (int e = 0; e < DV; ++e) { float o = ldA(f + e) + ldA(bk + e); ss += o * o; }
  float r = 1.0f / sqrtf(ss / DV + LN_EPS);
  const float* gn = (MODE == 0 ? p.hgrn_norm : p.gla_norm) + h * DV;
  const act_t* g = p.P + row * PW + (MODE == 0 ? E_HG : O_G) + h * DV;
  act_t* o = p.u + row * D + (MODE == 0 ? 512 : 0) + h * DV;
  for (int e = 0; e < DV; ++e) stA(o + e, (ldA(f + e) + ldA(bk + e)) * r * gn[e] * siluf_(ldA(g + e)));
}

DEV void ph_gla_decay(const Params& p, long i) {
  int col = (int)(i % 384);
  long row = (i / 384) % NR;
  int dir = (int)(i / ((long)384 * NR));
  const act_t* r = p.P + row * PW + O_RF + dir * 16;
  const float* gw = p.gla_gate_w + (long)dir * 16 * 384 + col;
  float z = p.gla_gate_b[dir * 384 + col];
  for (int k = 0; k < 16; ++k) z += ldA(r + k) * gw[k * 384];
  float ls = fminf(z, 0.f) - log1pf(expf(-fabsf(z)));
  stA(p.LF + ((long)dir * NR + row) * 384 + col, ls * (1.0f / 16.0f));
}

DEV void ph_resid_ln(const Params& p, long row, int l, int sub) {
  const float* hin = (l == 0 && sub == 0) ? hrow_in(p, row) : hrow(p, row);
  float* hout = hrow(p, row);
  const float* md = modrow(p, l, row);
  const float* g = md + (sub == 0 ? 2 : 5) * D;
  const act_t* m = p.M + row * D;
  const float* lg = p.ln_g + (l * 2 + sub) * D;
  const float* lb = p.ln_b + (l * 2 + sub) * D;
  float mu = 0.f;
  for (int k = 0; k < D; ++k) mu += ALPHA * hin[k] + g[k] * ldA(m + k);
  mu *= (1.0f / D);
  float var = 0.f;
  for (int k = 0; k < D; ++k) { float d = ALPHA * hin[k] + g[k] * ldA(m + k) - mu; var += d * d; }
  var *= (1.0f / D);
  float rs = 1.0f / sqrtf(var + LN_EPS);
  for (int k = 0; k < D; ++k) hout[k] = (ALPHA * hin[k] + g[k] * ldA(m + k) - mu) * rs * lg[k] + lb[k];
  if (sub == 1 && l == 1) return;
  const float* md2 = (sub == 0) ? md + 3 * D : modrow(p, 1, row);
  float mu2 = 0.f;
  for (int k = 0; k < D; ++k) mu2 += hout[k];
  mu2 *= (1.0f / D);
  float var2 = 0.f;
  for (int k = 0; k < D; ++k) { float d = hout[k] - mu2; var2 += d * d; }
  var2 *= (1.0f / D);
  float rs2 = 1.0f / sqrtf(var2 + LN_EPS);
  float lo[NEXP];
#pragma unroll
  for (int e = 0; e < NEXP; ++e) lo[e] = 0.f;
  for (int k = 0; k < D; ++k) {
    float uv = (hout[k] - mu2) * rs2 * (1.0f + md2[D + k]) + md2[k];
    stA(p.u + row * D + k, uv);
    if (sub == 0) {
      const float* wr = p.w_router + k * NEXP;
#pragma unroll
      for (int e = 0; e < NEXP; ++e) lo[e] += uv * wr[e];
    }
  }
  if (sub != 0) return;
  float mx = lo[0];
#pragma unroll
  for (int e = 1; e < NEXP; ++e) mx = fmaxf(mx, lo[e]);
  float sum = 0.f;
#pragma unroll
  for (int e = 0; e < NEXP; ++e) { lo[e] = expf(lo[e] - mx); sum += lo[e]; }
  float inv = 1.0f / sum;
  float bestg = -1e30f; int bg = 0;
  float gi1 = 0, gi2 = 0; int ge1 = 0, ge2 = 0;
  float gp1 = 0, gp2 = 0;
#pragma unroll
  for (int gq = 0; gq < 4; ++gq) {
    float s1 = -1e30f, s2 = -1e30f, p1 = 0, p2 = 0; int e1 = 0, e2 = 0;
#pragma unroll
    for (int j = 0; j < 4; ++j) {
      int e = gq * 4 + j;
      float pe = lo[e] * inv;
      float se = pe + p.b_router[e];
      if (se > s1) { s2 = s1; p2 = p1; e2 = e1; s1 = se; p1 = pe; e1 = e; }
      else if (se > s2) { s2 = se; p2 = pe; e2 = e; }
    }
    float gs = s1 + s2;
    if (gs > bestg) { bestg = gs; bg = gq; gi1 = s1; gi2 = s2; ge1 = e1; ge2 = e2; gp1 = p1; gp2 = p2; }
  }
  (void)bg; (void)gi1; (void)gi2;
  float wsum = gp1 + gp2;
  p.eidx[row * 2 + 0] = ge1; p.eidx[row * 2 + 1] = ge2;
  p.ew[row * 2 + 0] = gp1 / wsum; p.ew[row * 2 + 1] = gp2 / wsum;
}

DEV void ph_moe_up(const Params& p, long i, int l, long row0) {
  int f4 = (int)(i % (DFF / 4));
  int slot = (int)((i / (DFF / 4)) % 2);
  long row = row0 + i / (DFF / 2);
  int e = p.eidx[row * 2 + slot];
  const float* w1 = p.w_eg + ((long)(l * NEXP + e) * D) * DFF + f4 * 4;
  const float* w3 = p.w_eu + ((long)(l * NEXP + e) * D) * DFF + f4 * 4;
  const act_t* a = p.u + row * D;
  float g0 = 0, g1 = 0, g2 = 0, g3 = 0, u0 = 0, u1 = 0, u2 = 0, u3 = 0;
  for (int k = 0; k < D; ++k) {
    float av = ldA(a + k);
    const float* r1 = w1 + (long)k * DFF;
    const float* r3 = w3 + (long)k * DFF;
    g0 += av * r1[0]; g1 += av * r1[1]; g2 += av * r1[2]; g3 += av * r1[3];
    u0 += av * r3[0]; u1 += av * r3[1]; u2 += av * r3[2]; u3 += av * r3[3];
  }
  act_t* hb = p.P + (row * 2 + slot) * DFF + f4 * 4;
  stA(hb, siluf_(g0) * u0); stA(hb + 1, siluf_(g1) * u1); stA(hb + 2, siluf_(g2) * u2); stA(hb + 3, siluf_(g3) * u3);
}

DEV void ph_moe_down(const Params& p, long i, int l, long row0) {
  int j4 = (int)(i % (D / 4));
  long row = row0 + i / (D / 4);
  float y0 = 0, y1 = 0, y2 = 0, y3 = 0;
  for (int slot = 0; slot < 2; ++slot) {
    int e = p.eidx[row * 2 + slot];
    float wgt = p.ew[row * 2 + slot];
    const float* w2 = p.w_ed + ((long)(l * NEXP + e) * DFF) * D + j4 * 4;
    const act_t* hb = p.P + (row * 2 + slot) * DFF;
    float s0 = 0, s1 = 0, s2 = 0, s3 = 0;
    for (int f = 0; f < DFF; ++f) {
      float hv = ldA(hb + f);
      const float* r = w2 + (long)f * D;
      s0 += hv * r[0]; s1 += hv * r[1]; s2 += hv * r[2]; s3 += hv * r[3];
    }
    y0 += wgt * s0; y1 += wgt * s1; y2 += wgt * s2; y3 += wgt * s3;
  }
  act_t* o = p.M + row * D + j4 * 4;
  stA(o, y0); stA(o + 1, y1); stA(o + 2, y2); stA(o + 3, y3);
}


#ifndef HOST_TEST
typedef __attribute__((ext_vector_type(8))) short bf16x8;
typedef __attribute__((ext_vector_type(4))) float f32x4;
constexpr int SMEM_BYTES = 71680;
constexpr int IN_ODD_PAD = 2944;
constexpr int O_FA = 2336, O_FB = 2592, O_END = 2848;

typedef float f32x2_t __attribute__((ext_vector_type(2)));
typedef __bf16 bf16x2_t __attribute__((ext_vector_type(2)));
__device__ __forceinline__ unsigned pack2(float a, float b) {
  const f32x2_t v = {a, b};
  return __builtin_bit_cast(unsigned, __builtin_convertvector(v, bf16x2_t));
}
__device__ __forceinline__ unsigned pack2_mfma(float a, float b) { return pack2(a, b); }
typedef __attribute__((ext_vector_type(2))) unsigned u32x2;
__device__ __forceinline__ float xor16_max(float x) {
  const u32x2 r = __builtin_amdgcn_permlane16_swap(__float_as_uint(x), __float_as_uint(x), false, false);
  return fmaxf(__uint_as_float(r.x), __uint_as_float(r.y));
}
__device__ __forceinline__ float xor32_max(float x) {
  const u32x2 r = __builtin_amdgcn_permlane32_swap(__float_as_uint(x), __float_as_uint(x), false, false);
  return fmaxf(__uint_as_float(r.x), __uint_as_float(r.y));
}
__device__ __forceinline__ float xor16_add(float x) {
  const u32x2 r = __builtin_amdgcn_permlane16_swap(__float_as_uint(x), __float_as_uint(x), false, false);
  return __uint_as_float(r.x) + __uint_as_float(r.y);
}
__device__ __forceinline__ float xor32_add(float x) {
  const u32x2 r = __builtin_amdgcn_permlane32_swap(__float_as_uint(x), __float_as_uint(x), false, false);
  return __uint_as_float(r.x) + __uint_as_float(r.y);
}
__device__ __forceinline__ float bf_lo(unsigned u) { return __uint_as_float(u << 16); }
__device__ __forceinline__ float bf_hi(unsigned u) { return __uint_as_float(u & 0xffff0000u); }
template <int CTRL>
__device__ __forceinline__ float dpp_mov(float v) {
  return __int_as_float(__builtin_amdgcn_update_dpp(0, __float_as_int(v), CTRL, 0xf, 0xf, true));
}
__device__ __forceinline__ float row_sum16(float v) {
  v += dpp_mov<0xB1>(v);
  v += dpp_mov<0x4E>(v);
  v += dpp_mov<0x141>(v);
  v += dpp_mov<0x140>(v);
  return v;
}
__device__ __forceinline__ float wave_sum(float v) {
  v = row_sum16(v);
  const float a = __int_as_float(__builtin_amdgcn_readlane(__float_as_int(v), 0));
  const float b = __int_as_float(__builtin_amdgcn_readlane(__float_as_int(v), 16));
  const float c = __int_as_float(__builtin_amdgcn_readlane(__float_as_int(v), 32));
  const float d = __int_as_float(__builtin_amdgcn_readlane(__float_as_int(v), 48));
  return (a + b) + (c + d);
}


#define XB_TMO      128
#define XB_XCNT(j)  (256  + 64 * (j))
#define XB_XSUB(j)  (1280 + 64 * (j))
#define XB_XGEN(j)  (2304 + 64 * (j))
#define XB_TOP      3328
#define XB_TOPGEN   3392
#define XCD_BAR_WORDS 3456
#define XB_SPIN_CAP (1u << 18)
#define LAS __attribute__((address_space(3)))
__device__ __forceinline__ unsigned xb_ld(unsigned* p)              { return __hip_atomic_load(p, __ATOMIC_RELAXED, __HIP_MEMORY_SCOPE_AGENT); }
__device__ __forceinline__ unsigned xb_add(unsigned* p, unsigned v) { return __hip_atomic_fetch_add(p, v, __ATOMIC_RELAXED, __HIP_MEMORY_SCOPE_AGENT); }
__device__ __forceinline__ unsigned xb_xcc_id() { return (unsigned)__builtin_amdgcn_s_getreg((3 << 11) | 20) & 0xFu; }
#define XB_SPIN(cond, bar) do { unsigned _sp = 0; while (cond) { __builtin_amdgcn_s_sleep(1); \
    if ((++_sp & 255u) == 0u) { if (xb_ld(&(bar)[XB_TMO])) break; if (_sp > XB_SPIN_CAP) { atomicAdd(&(bar)[XB_TMO], 1u); break; } } } } while (0)
struct XcdBarrier { unsigned* bar; unsigned x; volatile LAS unsigned* st; };
__device__ __forceinline__ XcdBarrier xcd_barrier_post(unsigned* bar, volatile LAS unsigned* st) {
    XcdBarrier b; b.bar = bar; b.x = xb_xcc_id(); b.st = st;
    if (threadIdx.x == 0) (void)xb_add(&bar[XB_XCNT(b.x)], 1u);
    return b;
}
__device__ __forceinline__ void xcd_barrier_complete(unsigned* bar, unsigned x, unsigned& nloc, unsigned& nx) {
    const unsigned G = gridDim.x * gridDim.y * gridDim.z;
    unsigned sum, cnt, mine, sp = 0u;
    for (;;) {
        sum = 0u; cnt = 0u; mine = 0u;
#pragma unroll
        for (unsigned j = 0; j < 16; ++j) { const unsigned c = xb_ld(&bar[XB_XCNT(j)]); sum += c; cnt += (c > 0u) ? 1u : 0u; mine = (j == x) ? c : mine; }
        if (sum == G) break;
        __builtin_amdgcn_s_sleep(1);
        if ((++sp & 255u) == 0u) { if (xb_ld(&bar[XB_TMO])) break; if (sp > XB_SPIN_CAP) { atomicAdd(&bar[XB_TMO], 1u); break; } }
    }
    nloc = mine > 0u ? mine : 1u; nx = cnt > 0u ? cnt : 1u;
}
__device__ __forceinline__ void xcd_barrier(const XcdBarrier& b) {
    asm volatile("s_waitcnt vmcnt(0)" ::: "memory");
    __syncthreads();
    if (threadIdx.x == 0) {
        unsigned* bar = b.bar;
        __builtin_amdgcn_s_waitcnt(0);
        unsigned nloc = b.st[0], nx = b.st[1];
        if (nloc == 0u) { xcd_barrier_complete(bar, b.x, nloc, nx); b.st[0] = nloc; b.st[1] = nx; }
        const unsigned old = xb_add(&bar[XB_XSUB(b.x)], 1u);
        const unsigned gen = old / nloc;
        if (old + 1u == (gen + 1u) * nloc) {
            __builtin_amdgcn_fence(__ATOMIC_RELEASE, "agent");
            asm volatile("s_waitcnt vmcnt(0)" ::: "memory");
            const unsigned og = xb_add(&bar[XB_TOP], 1u);
            const unsigned tg = og / nx;
            if (og + 1u == (tg + 1u) * nx) xb_add(&bar[XB_TOPGEN], 1u);
            else XB_SPIN(xb_ld(&bar[XB_TOPGEN]) == tg, bar);
            __builtin_amdgcn_fence(__ATOMIC_ACQUIRE, "agent");
            xb_add(&bar[XB_XGEN(b.x)], 1u);
            asm volatile("s_waitcnt vmcnt(0)" ::: "memory");
        } else {
            XB_SPIN(xb_ld(&bar[XB_XGEN(b.x)]) == gen, bar);
            __builtin_amdgcn_fence(__ATOMIC_ACQUIRE, "agent");
            asm volatile("s_waitcnt vmcnt(0)" ::: "memory");
        }
    }
    __syncthreads();
}

#define RAW_BARRIER() do { asm volatile("s_waitcnt lgkmcnt(0)" ::: "memory"); __builtin_amdgcn_s_barrier(); } while (0)
template <bool SWAP, class ARow, class Epi>
__device__ __forceinline__ void gemm_tile(ARow arow, const act_t* Bt, int K, unsigned char* smem, Epi epi) {
  const int tid = threadIdx.x, wid = tid >> 6, lane = tid & 63, wr = wid >> 1, wc = wid & 1, fr = lane & 15,
            fq = lane >> 4;
  const int r0 = tid >> 3, pc = tid & 7;
  const int lc = pc ^ ((tid >> 4) & 7);
  const act_t* ga[4];
#pragma unroll
  for (int i = 0; i < 4; ++i) ga[i] = arow(r0 + 32 * i) + lc * 8;
  const act_t* gb0 = Bt + (long)r0 * K + lc * 8;
  const long gbs = (long)32 * K;
  const int sw = (fr >> 1) & 7;
  const int rd0 = fr * 128 + ((fq ^ sw) << 4), rd1 = fr * 128 + (((4 + fq) ^ sw) << 4);
  char* S = (char*)smem;
  const int nk = K >> 6;
  f32x4 acc[4][4];
#pragma unroll
  for (int m = 0; m < 4; ++m)
#pragma unroll
    for (int n = 0; n < 4; ++n) acc[m][n] = f32x4{0.f, 0.f, 0.f, 0.f};
  auto issue = [&](int kt) {
    char* st = S + (kt & 1) * 32768 + tid * 16;
#pragma unroll
    for (int i = 0; i < 4; ++i) {
      __builtin_amdgcn_global_load_lds((const unsigned*)(ga[i] + kt * 64), (unsigned*)(st + i * 4096), 16, 0, 0);
      __builtin_amdgcn_global_load_lds((const unsigned*)(gb0 + i * gbs + kt * 64), (unsigned*)(st + 16384 + i * 4096), 16, 0, 0);
    }
  };
  asm volatile("s_waitcnt vmcnt(0)" ::: "memory");
  RAW_BARRIER();
  issue(0);
  for (int kt = 0; kt < nk; ++kt) {
    asm volatile("s_waitcnt vmcnt(0)" ::: "memory");
    RAW_BARRIER();
    if (kt + 1 < nk) issue(kt + 1);
    const char* st = S + (kt & 1) * 32768;
#pragma unroll
    for (int ks = 0; ks < 2; ++ks) {
      const int rd = ks ? rd1 : rd0;
      bf16x8 af[4], bfr[4];
#pragma unroll
      for (int m = 0; m < 4; ++m) {
        af[m] = *reinterpret_cast<const bf16x8*>(st + (wr * 64 + m * 16) * 128 + rd);
        bfr[m] = *reinterpret_cast<const bf16x8*>(st + 16384 + (wc * 64 + m * 16) * 128 + rd);
      }
#pragma unroll
      for (int m = 0; m < 4; ++m)
#pragma unroll
        for (int n = 0; n < 4; ++n)
          acc[m][n] = SWAP ? __builtin_amdgcn_mfma_f32_16x16x32_bf16(bfr[n], af[m], acc[m][n], 0, 0, 0)
                           : __builtin_amdgcn_mfma_f32_16x16x32_bf16(af[m], bfr[n], acc[m][n], 0, 0, 0);
    }
  }
  epi(acc, wr, wc, fr, fq);
}


constexpr float SU8 = 16.0f, SW8 = 64.0f, SH8 = 8.0f;
typedef unsigned char fp8_t;
typedef __attribute__((ext_vector_type(8))) int i32x8;
typedef __attribute__((ext_vector_type(4))) int i32x4;
__device__ __forceinline__ unsigned pack4_fp8(float a, float b, float c, float d) {
  a = fminf(fmaxf(a, -448.f), 448.f); b = fminf(fmaxf(b, -448.f), 448.f);
  c = fminf(fmaxf(c, -448.f), 448.f); d = fminf(fmaxf(d, -448.f), 448.f);
  unsigned w = 0;
  w = __builtin_amdgcn_cvt_pk_fp8_f32(a, b, w, false);
  w = __builtin_amdgcn_cvt_pk_fp8_f32(c, d, w, true);
  return w;
}

template <bool SWAP, class ARow, class Epi>
__device__ __forceinline__ void gemm_tile8(ARow arow, const fp8_t* Bt, int Kb, unsigned char* smem, Epi epi) {
  const int tid = threadIdx.x, wid = tid >> 6, lane = tid & 63, wr = wid >> 1, wc = wid & 1, fr = lane & 15,
            fq = lane >> 4;
  const int r0 = tid >> 3, pc = tid & 7;
  const int lc = pc ^ ((tid >> 4) & 7);
  const fp8_t* ga[4];
#pragma unroll
  for (int i = 0; i < 4; ++i) ga[i] = arow(r0 + 32 * i) + lc * 16;
  const fp8_t* gb0 = Bt + (long)r0 * Kb + lc * 16;
  const long gbs = (long)32 * Kb;
  const int sw = (fr >> 1) & 7;
  const int rd0 = fr * 128 + ((fq ^ sw) << 4), rd1 = fr * 128 + (((4 + fq) ^ sw) << 4);
  char* S = (char*)smem;
  const int nk = Kb >> 7;
  f32x4 acc[4][4];
#pragma unroll
  for (int m = 0; m < 4; ++m)
#pragma unroll
    for (int n = 0; n < 4; ++n) acc[m][n] = f32x4{0.f, 0.f, 0.f, 0.f};
  auto issue = [&](int kt) {
    char* st = S + (kt & 1) * 32768 + tid * 16;
#pragma unroll
    for (int i = 0; i < 4; ++i) {
      __builtin_amdgcn_global_load_lds((const unsigned*)(ga[i] + kt * 128), (unsigned*)(st + i * 4096), 16, 0, 0);
      __builtin_amdgcn_global_load_lds((const unsigned*)(gb0 + i * gbs + kt * 128), (unsigned*)(st + 16384 + i * 4096), 16, 0, 0);
    }
  };
  asm volatile("s_waitcnt vmcnt(0)" ::: "memory");
  RAW_BARRIER();
  issue(0);
#pragma unroll 1
  for (int kt = 0; kt < nk; ++kt) {
    asm volatile("s_waitcnt vmcnt(0)" ::: "memory");
    RAW_BARRIER();
    if (kt + 1 < nk) issue(kt + 1);
    const char* st = S + (kt & 1) * 32768;
    i32x8 af[4], bfr[4];
#pragma unroll
    for (int m = 0; m < 4; ++m) {
      const i32x4 a0 = *reinterpret_cast<const i32x4*>(st + (wr * 64 + m * 16) * 128 + rd0);
      const i32x4 a1 = *reinterpret_cast<const i32x4*>(st + (wr * 64 + m * 16) * 128 + rd1);
      const i32x4 b0 = *reinterpret_cast<const i32x4*>(st + 16384 + (wc * 64 + m * 16) * 128 + rd0);
      const i32x4 b1 = *reinterpret_cast<const i32x4*>(st + 16384 + (wc * 64 + m * 16) * 128 + rd1);
      af[m] = i32x8{a0[0], a0[1], a0[2], a0[3], a1[0], a1[1], a1[2], a1[3]};
      bfr[m] = i32x8{b0[0], b0[1], b0[2], b0[3], b1[0], b1[1], b1[2], b1[3]};
    }
#pragma unroll
    for (int m = 0; m < 4; ++m)
#pragma unroll
      for (int n = 0; n < 4; ++n)
        acc[m][n] = SWAP ? __builtin_amdgcn_mfma_scale_f32_16x16x128_f8f6f4(bfr[n], af[m], acc[m][n], 0, 0, 0, 0x7f7f7f7f, 0, 0x7f7f7f7f)
                         : __builtin_amdgcn_mfma_scale_f32_16x16x128_f8f6f4(af[m], bfr[n], acc[m][n], 0, 0, 0, 0x7f7f7f7f, 0, 0x7f7f7f7f);
  }
  epi(acc, wr, wc, fr, fq);
}

__device__ __forceinline__ void phase_attn(const Params& p, unsigned char* smem, int blk, int nblk) {
  const int tid = threadIdx.x, w = tid >> 6, lane = tid & 63, fr = lane & 15, g = lane >> 4;
  act_t* SK = (act_t*)smem;
  act_t* SV = SK + 64 * 72;
  constexpr float SCL = 0.125f * 1.4426950408889634f;
  const int n_lat = NB * 4 * (T / 64), n_ctx = NB * 4 * (C / 64);
  const int skey = tid >> 2, spart = tid & 3;
  for (int unit = blk; unit < n_lat + n_ctx; unit += nblk) {
    const bool lat = unit < n_lat;
    const int uu = lat ? unit : unit - n_lat;
    const int nq = lat ? T / 64 : C / 64;
    const int hp = uu & 1, kv = (uu >> 1) & 1, qb = (uu >> 2) % nq, b = (uu >> 2) / nq;
    const int t0 = qb * 64;
    const int tw = t0 + (w & 1) * 32;
    const long qrow0 = (lat ? (long)NC + (long)b * T : (long)b * C) + tw;
    const int h = kv * 4 + hp * 2 + (w >> 1);
    bf16x8 qf[2][2];
#pragma unroll
    for (int qt = 0; qt < 2; ++qt)
#pragma unroll
      for (int st = 0; st < 2; ++st)
        qf[qt][st] = *reinterpret_cast<const bf16x8*>(p.P + (qrow0 + qt * 16 + fr) * PW + E_AQ + h * 64 + st * 32 + g * 8);
    asm volatile("" :: "v"(qf[0][0]), "v"(qf[0][1]), "v"(qf[1][0]), "v"(qf[1][1]));
    float mrun[2], lrun[2];
    f32x4 o[2][4];
    const float sinkl = p.attn_sink[h] * 1.4426950408889634f;
#pragma unroll
    for (int qt = 0; qt < 2; ++qt) {
      mrun[qt] = sinkl;
      lrun[qt] = (g == 0) ? 1.0f : 0.0f;
#pragma unroll
      for (int dt = 0; dt < 4; ++dt) o[qt][dt] = f32x4{0.f, 0.f, 0.f, 0.f};
    }
    int cc_lo = 0, cc_hi = -1;
    if (lat) {
      cc_lo = t0 >= 128 ? 0 : (128 - t0) / 64;
      cc_hi = min(4, (T - 1 - (t0 - 128)) / 64);
    }
    const int nch = 4 + (cc_hi - cc_lo + 1);
    auto chunk_row = [&](int i, int key, int& tkb) -> long {
      if (i < 4) { tkb = 0; return (long)b * C + i * 64 + key; }
      tkb = t0 - 128 + (cc_lo + i - 4) * 64;
      return (long)NC + (long)b * T + tkb + key;
    };
    uint4 rk0, rk1, rv0, rv1;
    {
      int tkb; const long kr = chunk_row(0, skey, tkb);
      const act_t* kp = p.P + kr * PW + E_AK + kv * 64 + spart * 16;
      const act_t* vp = p.P + kr * PW + E_AV + kv * 64 + spart * 16;
      rk0 = *reinterpret_cast<const uint4*>(kp); rk1 = *reinterpret_cast<const uint4*>(kp + 8);
      rv0 = *reinterpret_cast<const uint4*>(vp); rv1 = *reinterpret_cast<const uint4*>(vp + 8);
    }
    for (int i = 0; i < nch; ++i) {
      __syncthreads();
      {
        uint4* kd = reinterpret_cast<uint4*>(SK + skey * 72 + spart * 16);
        kd[0] = rk0; kd[1] = rk1;
        const unsigned vw[8] = {rv0.x, rv0.y, rv0.z, rv0.w, rv1.x, rv1.y, rv1.z, rv1.w};
#pragma unroll
        for (int e = 0; e < 8; ++e) {
          SV[(spart * 16 + 2 * e) * 72 + skey] = (act_t)(vw[e] & 0xffffu);
          SV[(spart * 16 + 2 * e + 1) * 72 + skey] = (act_t)(vw[e] >> 16);
        }
      }
      __syncthreads();
      int tkb_cur; (void)chunk_row(i, 0, tkb_cur);
      if (i + 1 < nch) {
        int tkb; const long kr = chunk_row(i + 1, skey, tkb);
        const act_t* kp = p.P + kr * PW + E_AK + kv * 64 + spart * 16;
        const act_t* vp = p.P + kr * PW + E_AV + kv * 64 + spart * 16;
        rk0 = *reinterpret_cast<const uint4*>(kp); rk1 = *reinterpret_cast<const uint4*>(kp + 8);
        rv0 = *reinterpret_cast<const uint4*>(vp); rv1 = *reinterpret_cast<const uint4*>(vp + 8);
      }
      const bool edge = i >= 4 && (tkb_cur == t0 - 128 || tkb_cur == t0 + 128);
#pragma unroll
      for (int kb = 0; kb < 2; ++kb) {
        f32x4 sc[2][2];
#pragma unroll
        for (int k2 = 0; k2 < 2; ++k2) {
          const int kt = kb * 2 + k2;
          const bf16x8 kf0 = *reinterpret_cast<const bf16x8*>(SK + (kt * 16 + fr) * 72 + g * 8);
          const bf16x8 kf1 = *reinterpret_cast<const bf16x8*>(SK + (kt * 16 + fr) * 72 + 32 + g * 8);
#pragma unroll
          for (int qt = 0; qt < 2; ++qt) {
            f32x4 z = f32x4{0.f, 0.f, 0.f, 0.f};
            z = __builtin_amdgcn_mfma_f32_16x16x32_bf16(kf0, qf[qt][0], z, 0, 0, 0);
            sc[qt][k2] = __builtin_amdgcn_mfma_f32_16x16x32_bf16(kf1, qf[qt][1], z, 0, 0, 0);
          }
        }
        bf16x8 pf[2];
#pragma unroll
        for (int qt = 0; qt < 2; ++qt) {
          float mx = -1e30f;
#pragma unroll
          for (int k2 = 0; k2 < 2; ++k2)
#pragma unroll
            for (int j = 0; j < 4; ++j) {
              float v = sc[qt][k2][j] * SCL;
              if (edge) {
                const int tk = tkb_cur + (kb * 2 + k2) * 16 + 4 * g + j;
                const int tq = tw + qt * 16 + fr;
                const int df = tq - tk;
                if (df > 128 || df < -128) v = -1e30f;
              }
              sc[qt][k2][j] = v;
              mx = fmaxf(mx, v);
            }
          mx = xor16_max(mx);
          mx = xor32_max(mx);
          const float mnew = fmaxf(mrun[qt], mx);
          if (__any(mnew > mrun[qt])) {
            const float alpha = __builtin_amdgcn_exp2f(mrun[qt] - mnew);
            lrun[qt] *= alpha;
#pragma unroll
            for (int dt = 0; dt < 4; ++dt) o[qt][dt] = o[qt][dt] * alpha;
            mrun[qt] = mnew;
          }
          float ls = 0.f;
          float pv[8];
#pragma unroll
          for (int k2 = 0; k2 < 2; ++k2)
#pragma unroll
            for (int j = 0; j < 4; ++j) {
              const float pe = __builtin_amdgcn_exp2f(sc[qt][k2][j] - mnew);
              pv[k2 * 4 + j] = pe;
              ls += pe;
            }
          lrun[qt] += ls;
          union { unsigned u[4]; bf16x8 v; } cv;
          cv.u[0] = pack2_mfma(pv[0], pv[1]); cv.u[1] = pack2_mfma(pv[2], pv[3]);
          cv.u[2] = pack2_mfma(pv[4], pv[5]); cv.u[3] = pack2_mfma(pv[6], pv[7]);
          pf[qt] = cv.v;
        }
#pragma unroll
        for (int dt = 0; dt < 4; ++dt) {
          union { uint2 h2[2]; bf16x8 v; } vf;
          vf.h2[0] = *reinterpret_cast<const uint2*>(SV + (dt * 16 + fr) * 72 + kb * 32 + 4 * g);
          vf.h2[1] = *reinterpret_cast<const uint2*>(SV + (dt * 16 + fr) * 72 + kb * 32 + 16 + 4 * g);
#pragma unroll
          for (int qt = 0; qt < 2; ++qt) o[qt][dt] = __builtin_amdgcn_mfma_f32_16x16x32_bf16(vf.v, pf[qt], o[qt][dt], 0, 0, 0);
        }
      }
    }
#pragma unroll
    for (int qt = 0; qt < 2; ++qt) {
      float lt = lrun[qt];
      lt = xor16_add(lt);
      lt = xor32_add(lt);
      const float il = 1.0f / lt;
      act_t* orow = p.u + (qrow0 + qt * 16 + fr) * D + h * 64 + 4 * g;
#pragma unroll
      for (int dt = 0; dt < 4; ++dt)
        *reinterpret_cast<uint2*>(orow + dt * 16) =
            make_uint2(pack2(o[qt][dt][0] * il, o[qt][dt][1] * il), pack2(o[qt][dt][2] * il, o[qt][dt][3] * il));
    }
  }
}


template <int MODE>
__device__ __forceinline__ void phase_combine(const Params& p) {
  constexpr int DV = MODE == 0 ? 128 : 192, EPL = DV / 16, NV = EPL / 4;
  const int lane = threadIdx.x & 63;
  const long row_lo = MODE == 0 ? 0 : NC;
  const long w0 = (long)blockIdx.x * 4 + (threadIdx.x >> 6), wstride = (long)gridDim.x * 4;
  const float* gn = (MODE == 0 ? p.hgrn_norm : p.gla_norm) + lane * EPL;
  for (long row = row_lo + w0; row < NR; row += wstride) {
    const uint2* f = reinterpret_cast<const uint2*>(p.OF + row * 768 + lane * EPL);
    const uint2* bk = reinterpret_cast<const uint2*>(p.OB + row * 768 + lane * EPL);
    const uint2* gt = reinterpret_cast<const uint2*>(p.P + row * PW + (MODE == 0 ? E_HG : O_G) + lane * EPL);
    float o[EPL];
    float ss = 0.f;
#pragma unroll
    for (int v = 0; v < NV; ++v) {
      const uint2 a = f[v], c = bk[v];
      o[4 * v + 0] = bf_lo(a.x) + bf_lo(c.x); o[4 * v + 1] = bf_hi(a.x) + bf_hi(c.x);
      o[4 * v + 2] = bf_lo(a.y) + bf_lo(c.y); o[4 * v + 3] = bf_hi(a.y) + bf_hi(c.y);
    }
#pragma unroll
    for (int e = 0; e < EPL; ++e) ss += o[e] * o[e];
    ss = row_sum16(ss);
    const float r = 1.0f / sqrtf(ss * (1.0f / DV) + LN_EPS);
    uint2* dst = reinterpret_cast<uint2*>(p.u + row * D + (MODE == 0 ? 512 : 0) + lane * EPL);
#pragma unroll
    for (int v = 0; v < NV; ++v) {
      const uint2 gv = gt[v];
      const float g0 = bf_lo(gv.x), g1 = bf_hi(gv.x), g2 = bf_lo(gv.y), g3 = bf_hi(gv.y);
      const float y0 = o[4 * v + 0] * r * gn[4 * v + 0] * (g0 / (1.0f + __expf(-g0)));
      const float y1 = o[4 * v + 1] * r * gn[4 * v + 1] * (g1 / (1.0f + __expf(-g1)));
      const float y2 = o[4 * v + 2] * r * gn[4 * v + 2] * (g2 / (1.0f + __expf(-g2)));
      const float y3 = o[4 * v + 3] * r * gn[4 * v + 3] * (g3 / (1.0f + __expf(-g3)));
      dst[v] = make_uint2(pack2(y0, y1), pack2(y2, y3));
    }
  }
}

__device__ __forceinline__ void mod_item(const Params& p, int item, unsigned char* smem) {
  float* sc = (float*)smem;
  const int tid = threadIdx.x;
  for (int i = tid; i < 9 * D; i += 256) {
    const int bb = i >> 10, k = i & 1023;
    const float v = bb < NB ? p.c[bb * D + k] : p.c_ctx[k];
    sc[i] = v / (1.0f + __expf(-v));
  }
  __syncthreads();
  const int l = item / 24, j = (item % 24) * 256 + tid;
  const float* w = p.w_ada + (long)l * D * 6 * D + j;
  float a[NB + 1];
#pragma unroll
  for (int bb = 0; bb <= NB; ++bb) a[bb] = p.b_ada[l * 6 * D + j];
  for (int k = 0; k < D; k += 8) {
    float wv[8];
#pragma unroll
    for (int q = 0; q < 8; ++q) wv[q] = w[(long)(k + q) * 6 * D];
#pragma unroll
    for (int q = 0; q < 8; ++q)
#pragma unroll
      for (int bb = 0; bb <= NB; ++bb) a[bb] += sc[bb * D + k + q] * wv[q];
  }
#pragma unroll
  for (int bb = 0; bb <= NB; ++bb) p.mod[((long)l * (NB + 1) + bb) * 6 * D + j] = a[bb];
  __syncthreads();
}

__device__ __forceinline__ void phase_gla_decay(const Params& p) {
  const int t = threadIdx.x;
  if (t >= 192) return;
  const int dir = t / 96, cg = t % 96;
  float gw[16][4], gb[4];
#pragma unroll
  for (int r = 0; r < 16; ++r) {
    const float4 v = *reinterpret_cast<const float4*>(p.gla_gate_w + ((long)dir * 16 + r) * 384 + cg * 4);
    gw[r][0] = v.x; gw[r][1] = v.y; gw[r][2] = v.z; gw[r][3] = v.w;
  }
  {
    const float4 v = *reinterpret_cast<const float4*>(p.gla_gate_b + dir * 384 + cg * 4);
    gb[0] = v.x; gb[1] = v.y; gb[2] = v.z; gb[3] = v.w;
  }
  for (long row0 = (long)blockIdx.x * 4; row0 < NR; row0 += (long)gridDim.x * 4) {
    uint4 ra[4], rb[4];
#pragma unroll
    for (int q = 0; q < 4; ++q) {
      const uint4* rp = reinterpret_cast<const uint4*>(p.P + (row0 + q) * PW + O_RF + dir * 16);
      ra[q] = rp[0]; rb[q] = rp[1];
    }
#pragma unroll
    for (int q = 0; q < 4; ++q) {
      const unsigned rw[8] = {ra[q].x, ra[q].y, ra[q].z, ra[q].w, rb[q].x, rb[q].y, rb[q].z, rb[q].w};
      float z[4] = {gb[0], gb[1], gb[2], gb[3]};
#pragma unroll
      for (int r2 = 0; r2 < 8; ++r2) {
        const float x0 = bf_lo(rw[r2]), x1 = bf_hi(rw[r2]);
#pragma unroll
        for (int c = 0; c < 4; ++c) z[c] += x0 * gw[2 * r2][c] + x1 * gw[2 * r2 + 1][c];
      }
      float o[4];
#pragma unroll
      for (int c = 0; c < 4; ++c) o[c] = (fminf(z[c], 0.f) - __logf(1.0f + __expf(-fabsf(z[c])))) * (1.0f / 16.0f);
      *reinterpret_cast<uint2*>(p.LF + ((long)dir * NR + row0 + q) * 384 + cg * 4) = make_uint2(pack2(o[0], o[1]), pack2(o[2], o[3]));
    }
  }
}

__device__ __forceinline__ void phase_hgrn_gate(const Params& p, long gtid, long gstride) {
  for (long i = gtid; i < (long)NR * 1024; i += gstride) {
    const int col = (int)(i & 1023);
    const long row = i >> 10;
    act_t* z = p.P + row * PW + E_FF + col;
    const float lb = p.lbt[col];
    const float f = lb + (1.0f - lb) * sigmoidf_(ldA(z));
    stA(z, __logf(f));
  }
}

template <int MODE>
__device__ __forceinline__ void phase_scan(const Params& p, unsigned char* smem, int blk, int nblk) {
  constexpr int DK = MODE == 0 ? 128 : 96, DV = MODE == 0 ? 128 : 192, DVS = DV / 4, NET = DVS / 16, NKS = DK / 32,
                NDT = DK / 16;
  constexpr int QS = DK + 8, LS = 72, SS = DK + 8;
  act_t* Qa = (act_t*)smem;
  act_t* Ka = Qa + 64 * QS;
  act_t* KaT = Ka + 64 * QS;
  act_t* VT = KaT + DK * LS;
  act_t* ST = VT + DVS * LS;
  float* tot = (float*)(ST + DVS * SS);
  float* lf32 = tot + 2 * 4 * DK;
  const int tid = threadIdx.x, w = __builtin_amdgcn_readfirstlane(threadIdx.x >> 6), lane = tid & 63, fr = lane & 15, g = lane >> 4;
  const int dp = lane, c0 = 2 * dp;
  const bool cact = dp < DK / 2;
  constexpr int NCH = (C + T) / 64, NCC = C / 64;
  constexpr int NVI = DVS / 8 * 64;
  for (int item = blk; item < NB * 4 * 2 * 4; item += nblk) {
    const int sl = item & 3, dir = (item >> 2) & 1, h = (item >> 3) & 3, b = item >> 5;
    act_t* OD = dir == 0 ? p.OF : p.OB;
    const unsigned loff = (unsigned)min(c0, DK - 2) * 2u;
    const int vcol = (MODE == 0 ? E_HI + h * 128 : O_V + h * 192) + sl * DVS;
    const int ocol = h * DV + sl * DVS;
    auto chunk_base = [&](int n) -> long {
      if (n < NCC) return (long)b * C + (dir ? NCC - 1 - n : n) * 64;
      const int ln = n - NCC;
      return (long)NC + (long)b * T + (dir ? T / 64 - 1 - ln : ln) * 64;
    };
    auto lrow = [&](long base, int l) -> long { return base + (dir ? 63 - l : l); };
    f32x4 S[NET][2];
#pragma unroll
    for (int et = 0; et < NET; ++et) { S[et][0] = f32x4{0.f, 0.f, 0.f, 0.f}; S[et][1] = f32x4{0.f, 0.f, 0.f, 0.f}; }
    unsigned rlf[16], rq[16], rk[16];
    uint4 rv[2];
    const long rstep = dir ? -(long)PW * 2 : (long)PW * 2;
    const long lstep = dir ? -(long)384 * 2 : (long)384 * 2;
    const unsigned off_lf = (MODE == 0 ? (unsigned)(E_FF + dir * 512 + h * 128) * 2u : 0u) + loff;
    const unsigned off_q = (unsigned)(MODE == 0 ? E_HQ + h * 128 : O_Q + h * 96) * 2u + loff;
    const unsigned off_k = (unsigned)(O_K + h * 96) * 2u + loff;
    auto issue_loads = [&](int n) {
      const long base = chunk_base(n);
      {
        const char* prow = (const char*)(p.P + lrow(base, w * 16) * PW);
        const char* plf = (const char*)(p.LF + ((long)dir * NR + lrow(base, w * 16)) * 384 + h * 96);
#pragma unroll
        for (int i = 0; i < 16; ++i) {
          if (MODE == 0) {
            rlf[i] = *reinterpret_cast<const unsigned*>(prow + off_lf);
          } else {
            rlf[i] = *reinterpret_cast<const unsigned*>(plf + loff);
            rk[i] = *reinterpret_cast<const unsigned*>(prow + off_k);
            plf += lstep;
          }
          rq[i] = *reinterpret_cast<const unsigned*>(prow + off_q);
          prow += rstep;
        }
      }
#pragma unroll
      for (int r = 0; r < (NVI + 255) / 256; ++r) {
        const int it = min(tid + r * 256, NVI - 1);
        const int l = it / (DVS / 8), e8 = (it % (DVS / 8)) * 8;
        rv[r] = *reinterpret_cast<const uint4*>(p.P + lrow(base, l) * PW + vcol + e8);
      }
    };
    issue_loads(0);
    for (int n = 0; n < NCH; ++n) {
      const int par = n & 1;
      float* totp = tot + par * 4 * DK;
      float* lfp = lf32 + par * DK;
      const long base = chunk_base(n);
      if (cact) {
        float r0 = 0.f, r1 = 0.f;
#pragma unroll
        for (int i = 0; i < 16; ++i) { r0 += bf_lo(rlf[i]); r1 += bf_hi(rlf[i]); }
        totp[w * DK + c0] = r0; totp[w * DK + c0 + 1] = r1;
        if (w == 2) { lfp[c0] = bf_lo(rlf[0]); lfp[c0 + 1] = bf_hi(rlf[0]); }
      }
      __syncthreads();
#pragma unroll
      for (int r = 0; r < (NVI + 255) / 256; ++r) {
        const int it = tid + r * 256;
        if (it < NVI) {
          const int l = it / (DVS / 8), e8 = (it % (DVS / 8)) * 8;
          const unsigned vw[4] = {rv[r].x, rv[r].y, rv[r].z, rv[r].w};
#pragma unroll
          for (int e = 0; e < 4; ++e) {
            VT[(e8 + 2 * e) * LS + l] = (act_t)(vw[e] & 0xffffu);
            VT[(e8 + 2 * e + 1) * LS + l] = (act_t)(vw[e] >> 16);
          }
        }
      }
      if (cact) {
        float of0 = 0.f, of1 = 0.f;
#pragma unroll
        for (int sgi = 0; sgi < 3; ++sgi)
          if (sgi < w) { of0 += totp[sgi * DK + c0]; of1 += totp[sgi * DK + c0 + 1]; }
        const float ref0 = totp[c0] + totp[DK + c0] + lfp[c0];
        const float ref1 = totp[c0 + 1] + totp[DK + c0 + 1] + lfp[c0 + 1];
        unsigned kt0[8], kt1[8];
        float run0 = of0 - ref0, run1 = of1 - ref1;
#pragma unroll
        for (int i = 0; i < 16; i += 2) {
          float ka0[2], ka1[2];
#pragma unroll
          for (int ii = 0; ii < 2; ++ii) {
            const int i2 = i + ii;
            run0 += bf_lo(rlf[i2]); run1 += bf_hi(rlf[i2]);
            const float b0 = run0, b1 = run1;
            const float e0 = __expf(b0), e1 = __expf(b1), f0 = __expf(-b0), f1 = __expf(-b1);
            float k0, k1;
            if (MODE == 0) { k0 = 1.0f - __expf(bf_lo(rlf[i2])); k1 = 1.0f - __expf(bf_hi(rlf[i2])); }
            else { k0 = bf_lo(rk[i2]); k1 = bf_hi(rk[i2]); }
            ka0[ii] = k0 * f0; ka1[ii] = k1 * f1;
            const int l = w * 16 + i2;
            *reinterpret_cast<unsigned*>(Qa + l * QS + c0) = pack2(bf_lo(rq[i2]) * e0, bf_hi(rq[i2]) * e1);
            *reinterpret_cast<unsigned*>(Ka + l * QS + c0) = pack2(ka0[ii], ka1[ii]);
          }
          kt0[i >> 1] = pack2(ka0[0], ka0[1]);
          kt1[i >> 1] = pack2(ka1[0], ka1[1]);
        }
        uint4* d0 = reinterpret_cast<uint4*>(KaT + c0 * LS + w * 16);
        d0[0] = make_uint4(kt0[0], kt0[1], kt0[2], kt0[3]); d0[1] = make_uint4(kt0[4], kt0[5], kt0[6], kt0[7]);
        uint4* d1 = reinterpret_cast<uint4*>(KaT + (c0 + 1) * LS + w * 16);
        d1[0] = make_uint4(kt1[0], kt1[1], kt1[2], kt1[3]); d1[1] = make_uint4(kt1[4], kt1[5], kt1[6], kt1[7]);
      }
      issue_loads(min(n + 1, NCH - 1));
      float egv[2], egrv[2];
#pragma unroll
      for (int di = 0; di < 2; ++di) {
        const int dt = w + 4 * di;
        if (dt < NDT) {
          const int d = dt * 16 + fr;
          const float refd = totp[d] + totp[DK + d] + lfp[d];
          const float gd = totp[d] + totp[DK + d] + totp[2 * DK + d] + totp[3 * DK + d];
          const float er = __expf(refd);
          egv[di] = __expf(gd); egrv[di] = __expf(gd - refd);
#pragma unroll
          for (int et = 0; et < NET; ++et)
#pragma unroll
            for (int j = 0; j < 4; ++j) stA(ST + (et * 16 + 4 * g + j) * SS + d, S[et][di][j] * er);
        }
      }
      __syncthreads();
      bf16x8 qfr[NKS];
#pragma unroll
      for (int ks = 0; ks < NKS; ++ks) qfr[ks] = *reinterpret_cast<const bf16x8*>(Qa + (w * 16 + fr) * QS + ks * 32 + g * 8);
      bf16x8 pfr[2];
#pragma unroll
      for (int kb = 0; kb < 2; ++kb) {
        f32x4 at2[2];
#pragma unroll
        for (int h2 = 0; h2 < 2; ++h2) {
          const int mt = 2 * kb + h2;
          at2[h2] = f32x4{0.f, 0.f, 0.f, 0.f};
          if (mt <= w) {
#pragma unroll
            for (int ks = 0; ks < NKS; ++ks) {
              const bf16x8 kaf = *reinterpret_cast<const bf16x8*>(Ka + (mt * 16 + fr) * QS + ks * 32 + g * 8);
              at2[h2] = __builtin_amdgcn_mfma_f32_16x16x32_bf16(kaf, qfr[ks], at2[h2], 0, 0, 0);
            }
            if (mt == w) {
#pragma unroll
              for (int j = 0; j < 4; ++j)
                if (4 * g + j > fr) at2[h2][j] = 0.f;
            }
          }
        }
        union { unsigned u[4]; bf16x8 v; } cv;
        cv.u[0] = pack2_mfma(at2[0][0], at2[0][1]); cv.u[1] = pack2_mfma(at2[0][2], at2[0][3]);
        cv.u[2] = pack2_mfma(at2[1][0], at2[1][1]); cv.u[3] = pack2_mfma(at2[1][2], at2[1][3]);
        pfr[kb] = cv.v;
      }
      const long orow = lrow(base, w * 16 + fr);
#pragma unroll
      for (int et = 0; et < NET; ++et) {
        f32x4 o = f32x4{0.f, 0.f, 0.f, 0.f};
#pragma unroll
        for (int kb = 0; kb < 2; ++kb) {
          if (2 * kb <= w) {
            union { uint2 h2[2]; bf16x8 v; } vf;
            vf.h2[0] = *reinterpret_cast<const uint2*>(VT + (et * 16 + fr) * LS + kb * 32 + 4 * g);
            vf.h2[1] = *reinterpret_cast<const uint2*>(VT + (et * 16 + fr) * LS + kb * 32 + 16 + 4 * g);
            o = __builtin_amdgcn_mfma_f32_16x16x32_bf16(vf.v, pfr[kb], o, 0, 0, 0);
          }
        }
#pragma unroll
        for (int ks = 0; ks < NKS; ++ks) {
          const bf16x8 sf = *reinterpret_cast<const bf16x8*>(ST + (et * 16 + fr) * SS + ks * 32 + g * 8);
          o = __builtin_amdgcn_mfma_f32_16x16x32_bf16(sf, qfr[ks], o, 0, 0, 0);
        }
        const float osc = MODE == 0 ? 1.0f : 0.10206207261596575f;
        *reinterpret_cast<uint2*>(OD + orow * 768 + ocol + et * 16 + 4 * g) =
            make_uint2(pack2(o[0] * osc, o[1] * osc), pack2(o[2] * osc, o[3] * osc));
      }
#pragma unroll
      for (int di = 0; di < 2; ++di) {
        const int dt = w + 4 * di;
        if (dt < NDT) {
#pragma unroll
          for (int et = 0; et < NET; ++et) {
            f32x4 r = f32x4{0.f, 0.f, 0.f, 0.f};
#pragma unroll
            for (int k2 = 0; k2 < 2; ++k2) {
              const bf16x8 vf = *reinterpret_cast<const bf16x8*>(VT + (et * 16 + fr) * LS + k2 * 32 + g * 8);
              const bf16x8 kf = *reinterpret_cast<const bf16x8*>(KaT + (dt * 16 + fr) * LS + k2 * 32 + g * 8);
              r = __builtin_amdgcn_mfma_f32_16x16x32_bf16(vf, kf, r, 0, 0, 0);
            }
#pragma unroll
            for (int j = 0; j < 4; ++j) S[et][di][j] = egv[di] * S[et][di][j] + egrv[di] * r[j];
          }
        }
      }
    }
    __syncthreads();
  }
}

struct GemmJob {
  const act_t* A; const act_t* Bt; act_t* C;
  long sA, sB, sC;
  int nbatch, Mtiles, Ntiles, K, ldc, Nvalid, mode;
  float scale;
  int fp8;
};
__device__ __forceinline__ void phase_gemm(const Params& p, const GemmJob& g, unsigned char* smem, int blk = blockIdx.x, int nblk = gridDim.x) {
  const int per_b = g.Mtiles * g.Ntiles;
  const int ntiles = per_b * g.nbatch;
  for (int tile = blk; tile < ntiles; tile += nblk) {
    const int b = tile / per_b, tt = tile % per_b;
    const int tm = tt / g.Ntiles, tn = tt % g.Ntiles;
    if (g.mode == 1 && tm < NC / 128 && tn * 128 >= O_FA) continue;
    const int K = g.K, ldc = g.ldc;
    const act_t* Ab = g.A + b * g.sA + (long)tm * 128 * K;
    act_t* Cb = g.C + b * g.sC + (long)tm * 128 * ldc + tn * 128;
    const int nlim = g.Nvalid - tn * 128;
    const float scale = g.scale;
    const int mode = g.mode;
    if (mode == 1) {
      auto epi1 = [&](f32x4 (&acc)[4][4], int wr, int wc, int fr, int fq) {
                  if (g.fp8) {
#pragma unroll
                    for (int m = 0; m < 4; ++m)
#pragma unroll
                      for (int n = 0; n < 4; ++n) acc[m][n] = acc[m][n] * scale;
                  }
#pragma unroll
                  for (int m = 0; m < 4; ++m)
#pragma unroll
                    for (int n = 0; n < 4; ++n) {
                      const int col = wc * 64 + n * 16 + fr;
                      if (col < nlim) {
#pragma unroll
                        for (int j = 0; j < 4; ++j) {
                          const int row = wr * 64 + m * 16 + fq * 4 + j;
                          stA(Cb + (long)row * ldc + col, acc[m][n][j]);
                        }
                      } else {
                        const int gc = tn * 128 + col;
                        if (gc < O_END && tm >= NC / 128) {
                          const int lr = (tm - NC / 128) * 128 + wr * 64 + m * 16 + fq * 4;
                          const int bb = lr / T, t = lr % T;
                          const int cq = gc < O_FB ? gc - O_FA : gc - O_FB;
                          act_t* dst = p.FT + ((long)bb * 256 + cq) * (2 * T) + (gc < O_FB ? 0 : T) + t;
                          *reinterpret_cast<uint2*>(dst) = make_uint2(pack2(acc[m][n][0], acc[m][n][1]), pack2(acc[m][n][2], acc[m][n][3]));
                        }
                      }
                    }
                };
      if (g.fp8) {
        const fp8_t* A8 = (const fp8_t*)g.A + (long)tm * 128 * K;
        gemm_tile8<false>([&](int r) { return A8 + (long)r * K; }, (const fp8_t*)g.Bt + (long)tn * 128 * K, K, smem, epi1);
      } else {
        gemm_tile<false>([&](int r) { return Ab + (long)r * K; }, g.Bt + b * g.sB + (long)tn * 128 * K, K, smem, epi1);
      }
    } else {
      auto epi2 = [&](f32x4 (&acc)[4][4], int wr, int wc, int fr, int fq) {
                  const float oscale = g.fp8 ? 1.0f : scale;
                  if (g.fp8) {
#pragma unroll
                    for (int m = 0; m < 4; ++m)
#pragma unroll
                      for (int n = 0; n < 4; ++n) acc[m][n] = acc[m][n] * scale;
                  }
                  if (mode == 2) {
                    const int cb = tn * 128 + wc * 64;
                    if (cb < E_AV && tm >= NC / 128) {
                      const float4* rt = reinterpret_cast<const float4*>(p.ropetab);
#pragma unroll
                      for (int m = 0; m < 4; ++m) {
                        const int t = ((tm - NC / 128) * 128 + wr * 64 + m * 16 + fr) % T;
                        const float4 r01 = rt[(t / GRID_W) * 8 + fq * 2], r23 = rt[(t / GRID_W) * 8 + fq * 2 + 1];
                        const float4 c01 = rt[(t % GRID_W) * 8 + fq * 2], c23 = rt[(t % GRID_W) * 8 + fq * 2 + 1];
                        const float rc[4] = {r01.x, r01.z, r23.x, r23.z}, rs_[4] = {r01.y, r01.w, r23.y, r23.w};
                        const float cc[4] = {c01.x, c01.z, c23.x, c23.z}, cs_[4] = {c01.y, c01.w, c23.y, c23.w};
#pragma unroll
                        for (int j = 0; j < 4; ++j) {
                          const float a1 = acc[m][0][j], a2 = acc[m][1][j], b1 = acc[m][2][j], b2 = acc[m][3][j];
                          acc[m][0][j] = a1 * rc[j] - a2 * rs_[j]; acc[m][1][j] = a1 * rs_[j] + a2 * rc[j];
                          acc[m][2][j] = b1 * cc[j] - b2 * cs_[j]; acc[m][3][j] = b1 * cs_[j] + b2 * cc[j];
                        }
                      }
                    } else if (cb >= E_FF && cb < E_HQ) {
#pragma unroll
                      for (int n = 0; n < 4; ++n) {
                        const float4 lb4 = *reinterpret_cast<const float4*>(p.lbt + cb - E_FF + n * 16 + fq * 4);
                        const float lb[4] = {lb4.x, lb4.y, lb4.z, lb4.w};
#pragma unroll
                        for (int m = 0; m < 4; ++m)
#pragma unroll
                          for (int j = 0; j < 4; ++j)
                            acc[m][n][j] = __logf(lb[j] + (1.0f - lb[j]) / (1.0f + __expf(-acc[m][n][j])));
                      }
                    }
                  }
#pragma unroll
                  for (int m = 0; m < 4; ++m) {
                    const int row = wr * 64 + m * 16 + fr;
#pragma unroll
                    for (int n = 0; n < 4; ++n) {
                      const int col = wc * 64 + n * 16 + fq * 4;
                      if (col < nlim)
                        *reinterpret_cast<uint2*>(Cb + (long)row * ldc + col) =
                            make_uint2(pack2(acc[m][n][0] * oscale, acc[m][n][1] * oscale), pack2(acc[m][n][2] * oscale, acc[m][n][3] * oscale));
                    }
                  }
                };
      if (g.fp8) {
        const fp8_t* A8 = (const fp8_t*)g.A + (long)tm * 128 * K;
        gemm_tile8<true>([&](int r) { return A8 + (long)r * K; }, (const fp8_t*)g.Bt + (long)tn * 128 * K, K, smem, epi2);
      } else {
        gemm_tile<true>([&](int r) { return Ab + (long)r * K; }, g.Bt + b * g.sB + (long)tn * 128 * K, K, smem, epi2);
      }
    }
  }
}

template <class RowMap>
__device__ __forceinline__ void conv_tile_rm(const float* src, int lds_, int Nvalid, int k0, int n0, act_t* dst, int ldd, float* tile, RowMap rm) {
  const int tid = threadIdx.x;
  {
    const int r = tid >> 5, c4 = (tid & 31) * 4;
    float4 v[8];
#pragma unroll
    for (int rr = 0; rr < 8; ++rr) {
      v[rr] = make_float4(0.f, 0.f, 0.f, 0.f);
      if (n0 + c4 < Nvalid) v[rr] = *reinterpret_cast<const float4*>(src + (long)(k0 + r + rr * 8) * lds_ + n0 + c4);
    }
#pragma unroll
    for (int rr = 0; rr < 8; ++rr) {
      float* t = tile + (r + rr * 8) * 129 + c4;
      t[0] = v[rr].x; t[1] = v[rr].y; t[2] = v[rr].z; t[3] = v[rr].w;
    }
  }
  __syncthreads();
  {
    const int n = tid >> 1, ks = (tid & 1) * 32;
    if (n0 + n < Nvalid) {
      unsigned w[16];
#pragma unroll
      for (int i = 0; i < 16; ++i) w[i] = pack2(tile[(ks + 2 * i) * 129 + n], tile[(ks + 2 * i + 1) * 129 + n]);
      uint4* d = reinterpret_cast<uint4*>(dst + (long)rm(n) * ldd + k0 + ks);
      d[0] = make_uint4(w[0], w[1], w[2], w[3]);
      d[1] = make_uint4(w[4], w[5], w[6], w[7]);
      d[2] = make_uint4(w[8], w[9], w[10], w[11]);
      d[3] = make_uint4(w[12], w[13], w[14], w[15]);
    }
  }
  __syncthreads();
}

template <class RowMap>
__device__ __forceinline__ void conv_tile8_rm(const float* src, int lds_, int k0, int n0, fp8_t* dst, int ldd, float* tile, float scale, RowMap rm, int Nvalid = 1 << 30) {
  const int tid = threadIdx.x;
  {
    const int r = tid >> 5, c4 = (tid & 31) * 4;
    float4 v[8];
#pragma unroll
    for (int rr = 0; rr < 8; ++rr) {
      v[rr] = make_float4(0.f, 0.f, 0.f, 0.f);
      if (n0 + c4 < Nvalid) v[rr] = *reinterpret_cast<const float4*>(src + (long)(k0 + r + rr * 8) * lds_ + n0 + c4);
    }
#pragma unroll
    for (int rr = 0; rr < 8; ++rr) {
      float* t = tile + (r + rr * 8) * 129 + c4;
      t[0] = v[rr].x; t[1] = v[rr].y; t[2] = v[rr].z; t[3] = v[rr].w;
    }
  }
  __syncthreads();
  if ((threadIdx.x >> 1) + n0 < Nvalid) {
    const int n = tid >> 1, ks = (tid & 1) * 32;
    unsigned w[8];
#pragma unroll
    for (int i = 0; i < 8; ++i)
      w[i] = pack4_fp8(tile[(ks + 4 * i) * 129 + n] * scale, tile[(ks + 4 * i + 1) * 129 + n] * scale,
                       tile[(ks + 4 * i + 2) * 129 + n] * scale, tile[(ks + 4 * i + 3) * 129 + n] * scale);
    uint4* d = reinterpret_cast<uint4*>(dst + (long)rm(n) * ldd + k0 + ks);
    d[0] = make_uint4(w[0], w[1], w[2], w[3]);
    d[1] = make_uint4(w[4], w[5], w[6], w[7]);
  }
  __syncthreads();
}

__device__ __forceinline__ void conv_tile(const float* src, int lds_, int Nvalid, int k0, int n0, act_t* dst, int ldd, float* tile) {
  conv_tile_rm(src, lds_, Nvalid, k0, n0, dst, ldd, tile, [=](int n) { return n0 + n; });
}

__device__ __forceinline__ void phase_convert_experts(const Params& p, int l, unsigned char* smem, int blk, int nblk) {
  float* tile = (float*)smem;
  const int per_e = 192;
  fp8_t* Wup = l == 0 ? p.W8up : p.W8up1;
  fp8_t* Wdn = l == 0 ? p.W8down : p.W8down1;
  for (int job = blk; job < NEXP * per_e; job += nblk) {
    const int e = job / per_e, j = job % per_e;
    if (j < 128) {
      const int up = j >> 6, jj = j & 63;
      const int kt = jj >> 2, fp = jj & 3;
      const float* src = (up ? p.w_eu : p.w_eg) + ((long)(l * NEXP + e) * D) * DFF;
      const int rbase = fp * 256 + up * 32;
      conv_tile8_rm(src, DFF, kt * 64, fp * 128, Wup + (long)e * 1024 * D, D, tile, SW8,
                    [=](int n) { return rbase + (n >> 6) * 128 + ((n >> 5) & 1) * 64 + (n & 31); });
    } else {
      const int jj = j - 128;
      const int kt = jj >> 3, nt = jj & 7;
      const float* src = p.w_ed + ((long)(l * NEXP + e) * DFF) * D;
      const int n0 = nt * 128;
      conv_tile8_rm(src, D, kt * 64, n0, Wdn + (long)e * 1024 * DFF, DFF, tile, SW8, [=](int n) { return n0 + n; });
    }
  }
}

__device__ __forceinline__ void phase_moe(const Params& p, int l, bool down, unsigned char* smem) {
  const int* cntp = p.cnt + l * NEXP * 64;
  int total = 0;
  for (int e = 0; e < NEXP; ++e) total += ((cntp[e * 64] + 127) >> 7) * 8;
  for (int tile = blockIdx.x; tile < total; tile += gridDim.x) {
    int e = 0, tb = 0, rowoff = 0;
    for (; e < NEXP - 1; ++e) {
      const int c = cntp[e * 64];
      const int nt = ((c + 127) >> 7) * 8;
      if (tile < tb + nt) break;
      tb += nt; rowoff += c;
    }
    const int c = cntp[e * 64];
    const int lt = tile - tb, mt = lt >> 3, nt = lt & 7;
    const int rows_valid = min(128, c - mt * 128);
    const int* lst = p.list + (long)(l * NEXP + e) * NR + mt * 128;
    const long hrow0 = (long)rowoff + mt * 128;
    if (!down) {
      gemm_tile8<true>([&](int r) { return p.u8 + (long)(lst[min(r, rows_valid - 1)] >> 1) * D; },
                (l == 0 ? p.W8up : p.W8up1) + ((long)e * 1024 + nt * 128) * D, D, smem,
                [&](f32x4 (&acc)[4][4], int wr, int wc, int fr, int fq) {
                  constexpr float dq = 1.0f / (SU8 * SW8);
#pragma unroll
                  for (int m = 0; m < 4; ++m) {
                    const int row = wr * 64 + m * 16 + fr;
                    if (row < rows_valid) {
#pragma unroll
                      for (int n = 0; n < 2; ++n) {
                        float hv[4];
#pragma unroll
                        for (int j = 0; j < 4; ++j) {
                          const float g = acc[m][n][j] * dq, uu = acc[m][n + 2][j] * dq;
                          hv[j] = g / (1.0f + __expf(-g)) * uu * SH8;
                        }
                        *reinterpret_cast<unsigned*>(p.H8 + (hrow0 + row) * DFF + nt * 64 + wc * 32 + n * 16 + fq * 4) =
                            pack4_fp8(hv[0], hv[1], hv[2], hv[3]);
                      }
                    }
                  }
                });
    } else {
      const fp8_t* Ab = p.H8 + hrow0 * DFF;
      gemm_tile8<true>([&](int r) { return Ab + (long)r * DFF; }, (l == 0 ? p.W8down : p.W8down1) + ((long)e * 1024 + nt * 128) * DFF, DFF, smem,
                [&](f32x4 (&acc)[4][4], int wr, int wc, int fr, int fq) {
                  constexpr float dq = 1.0f / (SH8 * SW8);
#pragma unroll
                  for (int m = 0; m < 4; ++m) {
                    const int row = wr * 64 + m * 16 + fr;
                    if (row < rows_valid) {
                      const int ts = lst[row];
                      const float w = p.ew[ts] * dq;
#pragma unroll
                      for (int n = 0; n < 4; ++n)
                        *reinterpret_cast<uint2*>(p.Y + (long)ts * D + nt * 128 + wc * 64 + n * 16 + fq * 4) =
                            make_uint2(pack2(acc[m][n][0] * w, acc[m][n][1] * w), pack2(acc[m][n][2] * w, acc[m][n][3] * w));
                    }
                  }
                });
    }
  }
}

__device__ __forceinline__ void phase_convert_dense(const Params& p, unsigned char* smem) {
  float* tile = (float*)smem;
  const int JM = 48, J0 = JM + 16 * 26, J1 = J0 + 128, J2 = J1 + 16 * 19, J3 = J2 + 128;
  for (int job = blockIdx.x; job < J3; job += gridDim.x) {
    if (job < JM) { mod_item(p, job, smem); continue; }
    if (job < J0) { int j = job - JM; const int n0 = (j % 26) * 128; conv_tile8_rm(p.w_in_even, IN_EVEN, (j / 26) * 64, n0, p.W8in_even, D, tile, SW8, [=](int n) { return n0 + n; }); }
    else if (job < J1) { int j = job - J0; conv_tile(p.w_out_even, D, D, (j / 8) * 64, (j % 8) * 128, p.Wt_out_even, D, tile); }
    else if (job < J2) { int j = job - J1; const int n0 = (j % 19) * 128; conv_tile8_rm(p.w_in_odd, IN_ODD, (j / 19) * 64, n0, p.W8in_odd, D, tile, SW8, [=](int n) { return n0 + n; }, O_FA); }
    else { int j = job - J2; conv_tile(p.w_out_odd, D, D, (j / 8) * 64, (j % 8) * 128, p.Wt_out_odd, D, tile); }
  }
}

__device__ __forceinline__ void phase_fold_z(const Params& p, long gtid, long gstride, float* tab) {
  if (threadIdx.x < 64) {
    float sn, cs;
    sincospif((float)threadIdx.x * (1.0f / 32.0f), &sn, &cs);
    tab[threadIdx.x] = cs; tab[64 + threadIdx.x] = -sn;
  }
  __syncthreads();
  for (long i = gtid; i < (long)512 * D; i += gstride) {
    const int k = (int)(i % D), np = (int)(i / D);
    const int part = np >> 8, col = np & 255, g = col >> 6, cp = col & 63;
    const float* wz = p.w_in_odd + (long)k * IN_ODD + O_Z + g * 64;
    float s = 0.f;
    const float* tb = tab + part * 64;
#pragma unroll 8
    for (int c = 0; c < 64; ++c) s += wz[c] * tb[(c * cp) & 63];
    const unsigned q = pack4_fp8(s * SW8, 0.f, 0.f, 0.f);
    p.W8in_odd[(long)(O_FA + np) * D + k] = (unsigned char)(q & 0xffu);
  }
  for (long i = gtid; i < (long)(IN_ODD_PAD - O_END) * D; i += gstride) p.W8in_odd[(long)O_END * D + i] = 0;
}

__device__ __forceinline__ void phase_cmat(const Params& p, long gtid, long gstride) {
  for (long i = gtid; i < (long)T * T; i += gstride) {
    const int t = (int)(i % T), tp = (int)(i / T);
    float sn, cs;
    sincospif((float)((t * tp) & (T - 1)) * (2.0f / T), &sn, &cs);
    stA(p.Cmat + (long)tp * 2 * T + t, cs);
    stA(p.Cmat + (long)tp * 2 * T + T + t, sn);
  }
}

__device__ __forceinline__ void row_stats(const float4 (&v)[4], float& mu, float& rs) {
  float s = 0.f;
#pragma unroll
  for (int i = 0; i < 4; ++i) s += v[i].x + v[i].y + v[i].z + v[i].w;
  mu = wave_sum(s) * (1.0f / D);
  float q = 0.f;
#pragma unroll
  for (int i = 0; i < 4; ++i) {
    float a = v[i].x - mu, b = v[i].y - mu, c = v[i].z - mu, d = v[i].w - mu;
    q += a * a + b * b + c * c + d * d;
  }
  rs = 1.0f / sqrtf(wave_sum(q) * (1.0f / D) + LN_EPS);
}

__device__ __forceinline__ void phase_lnmod_first(const Params& p) {
  const int lane = threadIdx.x & 63;
  const long w0 = (long)blockIdx.x * 4 + (threadIdx.x >> 6), wstride = (long)gridDim.x * 4;
  for (long row = w0; row < NR; row += wstride) {
    const float4* h = reinterpret_cast<const float4*>(hrow_in(p, row));
    const float* md = modrow(p, 0, row);
    float4 v[4];
#pragma unroll
    for (int i = 0; i < 4; ++i) v[i] = h[i * 64 + lane];
    float mu, rs;
    row_stats(v, mu, rs);
#pragma unroll
    for (int i = 0; i < 4; ++i) {
      const float4 sh = reinterpret_cast<const float4*>(md)[i * 64 + lane];
      const float4 sc = reinterpret_cast<const float4*>(md + D)[i * 64 + lane];
      float a = (v[i].x - mu) * rs * (1.f + sc.x) + sh.x, b = (v[i].y - mu) * rs * (1.f + sc.y) + sh.y;
      float c = (v[i].z - mu) * rs * (1.f + sc.z) + sh.z, d = (v[i].w - mu) * rs * (1.f + sc.w) + sh.w;
      reinterpret_cast<unsigned*>(p.u8 + row * D)[i * 64 + lane] = pack4_fp8(a * SU8, b * SU8, c * SU8, d * SU8);
    }
  }
}

template <int R_UNUSED>
__device__ __forceinline__ void phase_resid_ln(const Params& p, int l, int sub, long row_lo, long row_hi, unsigned char* smem) {
  const int lane = threadIdx.x & 63;
  int* cntL = (int*)smem;
  int* nent = cntL + 16;
  int* entL = cntL + 32;
  float* wT = (float*)(smem + 4096);
  if (sub == 0) {
    if (threadIdx.x < 32) cntL[threadIdx.x] = 0;
    for (int i = threadIdx.x; i < D * NEXP; i += 256) wT[(i & 15) * D + (i >> 4)] = p.w_router[i];
    __syncthreads();
  }
  const bool last = (sub == 1 && l == 1);
  const long nw = (long)gridDim.x * 4, wi = (long)blockIdx.x * 4 + (threadIdx.x >> 6);
  const long rpw = (row_hi - row_lo + nw - 1) / nw;
  const long r0 = row_lo + wi * rpw, r1 = min(row_hi, r0 + rpw);
  const float4* lgp = reinterpret_cast<const float4*>(p.ln_g + (l * 2 + sub) * D);
  const float4* lbp = reinterpret_cast<const float4*>(p.ln_b + (l * 2 + sub) * D);
  float4 lgv[4], lbv[4];
  if (R_UNUSED != 1) {
#pragma unroll
    for (int i = 0; i < 4; ++i) { lgv[i] = lgp[i * 64 + lane]; lbv[i] = lbp[i * 64 + lane]; }
  }
  float4 gv[4], shv[4], scv[4];
  int cur_bb = -2;
  float4 hv[4];
  uint2 mv[4], m2v[4];
  auto load_row = [&](long row) {
    const float4* hin = reinterpret_cast<const float4*>((l == 0 && sub == 0) ? hrow_in(p, row) : hrow(p, row));
    const uint2* m = reinterpret_cast<const uint2*>(sub == 0 ? p.M + row * D : p.Y + row * 2 * D);
#pragma unroll
    for (int i = 0; i < 4; ++i) {
      hv[i] = hin[i * 64 + lane];
      mv[i] = m[i * 64 + lane];
      if (sub == 1) m2v[i] = m[256 + i * 64 + lane];
    }
  };
  if (r0 < r1) load_row(r0);
  for (long row = r0; row < r1; ++row) {
    const int bb = row < NC ? NB : (int)((row - NC) / T);
    if (bb != cur_bb) {
      cur_bb = bb;
      const float* md = p.mod + ((long)l * (NB + 1) + bb) * 6 * D;
      const float* md2 = (sub == 0) ? md + 3 * D : p.mod + ((long)(NB + 1) + bb) * 6 * D;
#pragma unroll
      for (int i = 0; i < 4; ++i) {
        gv[i] = reinterpret_cast<const float4*>(md + (sub == 0 ? 2 : 5) * D)[i * 64 + lane];
        shv[i] = reinterpret_cast<const float4*>(md2)[i * 64 + lane];
        scv[i] = reinterpret_cast<const float4*>(md2 + D)[i * 64 + lane];
      }
    }
    float4 v[4];
#pragma unroll
    for (int i = 0; i < 4; ++i) {
      float m0 = bf_lo(mv[i].x), m1 = bf_hi(mv[i].x), m2_ = bf_lo(mv[i].y), m3 = bf_hi(mv[i].y);
      if (sub == 1) { m0 += bf_lo(m2v[i].x); m1 += bf_hi(m2v[i].x); m2_ += bf_lo(m2v[i].y); m3 += bf_hi(m2v[i].y); }
      v[i].x = ALPHA * hv[i].x + gv[i].x * m0;
      v[i].y = ALPHA * hv[i].y + gv[i].y * m1;
      v[i].z = ALPHA * hv[i].z + gv[i].z * m2_;
      v[i].w = ALPHA * hv[i].w + gv[i].w * m3;
    }
    load_row(min(row + 1, r1 - 1));
    if (R_UNUSED == 1) {
#pragma unroll
      for (int i = 0; i < 4; ++i) { lgv[i] = lgp[i * 64 + lane]; lbv[i] = lbp[i * 64 + lane]; }
    }
    float mu, rs;
    row_stats(v, mu, rs);
#pragma unroll
    for (int i = 0; i < 4; ++i) {
      v[i].x = (v[i].x - mu) * rs * lgv[i].x + lbv[i].x;
      v[i].y = (v[i].y - mu) * rs * lgv[i].y + lbv[i].y;
      v[i].z = (v[i].z - mu) * rs * lgv[i].z + lbv[i].z;
      v[i].w = (v[i].w - mu) * rs * lgv[i].w + lbv[i].w;
    }
    float4* hout = reinterpret_cast<float4*>(hrow(p, row));
    if (last) {
#pragma unroll
      for (int i = 0; i < 4; ++i) hout[i * 64 + lane] = v[i];
      continue;
    }
    row_stats(v, mu, rs);
    float lo[NEXP];
#pragma unroll
    for (int e = 0; e < NEXP; ++e) lo[e] = 0.f;
    uint2 up[4];
#pragma unroll
    for (int i = 0; i < 4; ++i) {
      float uv[4];
      uv[0] = (v[i].x - mu) * rs * (1.f + scv[i].x) + shv[i].x;
      uv[1] = (v[i].y - mu) * rs * (1.f + scv[i].y) + shv[i].y;
      uv[2] = (v[i].z - mu) * rs * (1.f + scv[i].z) + shv[i].z;
      uv[3] = (v[i].w - mu) * rs * (1.f + scv[i].w) + shv[i].w;
      up[i] = make_uint2(pack4_fp8(uv[0] * SU8, uv[1] * SU8, uv[2] * SU8, uv[3] * SU8), 0u);
      if (sub == 0) {
#pragma unroll
        for (int e = 0; e < NEXP; ++e) {
          const float4 w4 = *reinterpret_cast<const float4*>(wT + e * D + (i * 64 + lane) * 4);
          lo[e] += uv[0] * w4.x + uv[1] * w4.y + uv[2] * w4.z + uv[3] * w4.w;
          if ((e & 3) == 3) __builtin_amdgcn_sched_barrier(0);
        }
      }
    }
    int ge1 = 0, ge2 = 0;
    float w1 = 0.f, w2 = 0.f;
    if (sub == 0) {
      float mine = 0.f;
#pragma unroll
      for (int e = 0; e < NEXP; ++e) {
        const float rsum = row_sum16(lo[e]);
        mine = ((lane & 15) == e) ? rsum : mine;
      }
      mine += __shfl_xor(mine, 16);
      mine += __shfl_xor(mine, 32);
#pragma unroll
      for (int e = 0; e < NEXP; ++e) lo[e] = __int_as_float(__builtin_amdgcn_readlane(__float_as_int(mine), e));
      float mx = lo[0];
#pragma unroll
      for (int e = 1; e < NEXP; ++e) mx = fmaxf(mx, lo[e]);
      float sum = 0.f;
#pragma unroll
      for (int e = 0; e < NEXP; ++e) { lo[e] = __expf(lo[e] - mx); sum += lo[e]; }
      const float inv = 1.0f / sum;
      float bestg = -1e30f, gp1 = 0.f, gp2 = 0.f;
#pragma unroll
      for (int gq = 0; gq < 4; ++gq) {
        float s1 = -1e30f, s2 = -1e30f, p1 = 0.f, p2 = 0.f;
        int e1 = 0, e2 = 0;
#pragma unroll
        for (int j = 0; j < 4; ++j) {
          const int e = gq * 4 + j;
          const float pe = lo[e] * inv;
          const float se = pe + p.b_router[e];
          if (se > s1) { s2 = s1; p2 = p1; e2 = e1; s1 = se; p1 = pe; e1 = e; }
          else if (se > s2) { s2 = se; p2 = pe; e2 = e; }
        }
        const float gs = s1 + s2;
        if (gs > bestg) { bestg = gs; ge1 = e1; ge2 = e2; gp1 = p1; gp2 = p2; }
      }
      const float wsum = gp1 + gp2;
      w1 = gp1 / wsum; w2 = gp2 / wsum;
    }
#pragma unroll
    for (int i = 0; i < 4; ++i) hout[i * 64 + lane] = v[i];
#pragma unroll
    for (int i = 0; i < 4; ++i) reinterpret_cast<unsigned*>(p.u8 + row * D)[i * 64 + lane] = up[i].x;
    if (sub == 0 && lane == 0) {
      p.ew[row * 2 + 0] = w1; p.ew[row * 2 + 1] = w2;
      const int lp1 = atomicAdd(cntL + ge1, 1), lp2 = atomicAdd(cntL + ge2, 1);
      const int ei = atomicAdd(nent, 2);
      entL[2 * ei] = ((int)(row * 2) << 4) | ge1; entL[2 * ei + 1] = lp1;
      entL[2 * ei + 2] = ((int)(row * 2 + 1) << 4) | ge2; entL[2 * ei + 3] = lp2;
    }
  }
  if (sub == 0) {
    __syncthreads();
    if (threadIdx.x < NEXP) {
      const int c = cntL[threadIdx.x];
      cntL[threadIdx.x] = c ? atomicAdd(p.cnt + (l * NEXP + threadIdx.x) * 64, c) : 0;
    }
    __syncthreads();
    const int ne = *nent;
    for (int i = threadIdx.x; i < ne; i += 256) {
      const int key = entL[2 * i], lp = entL[2 * i + 1];
      const int e = key & 15;
      p.list[(long)(l * NEXP + e) * NR + cntL[e] + lp] = key >> 4;
    }
    __syncthreads();
  }
}

#define LOOP(n) for (long i = gtid; i < (long)(n); i += gstride)

#ifdef ONLY_PHASE
#define PH(n, ...) if (ONLY_PHASE == n) { __VA_ARGS__ }
#define GSYNC()
#else
#define PH(n, ...) { __VA_ARGS__ }
#define GSYNC() xcd_barrier(xb)
#endif

__global__ void __launch_bounds__(256, 2) mega_kernel(Params p) {
  cg::grid_group grid = cg::this_grid();
  __shared__ __attribute__((aligned(16))) unsigned char smem[SMEM_BYTES + 16];
  if (threadIdx.x == 0) *reinterpret_cast<uint4*>(smem + SMEM_BYTES) = make_uint4(0u, 0u, 0u, 0u);
  __syncthreads();
  XcdBarrier xb = xcd_barrier_post(p.bar, (volatile LAS unsigned*)(smem + SMEM_BYTES));
  const long gtid = (long)blockIdx.x * blockDim.x + threadIdx.x;
  const long gstride = (long)gridDim.x * blockDim.x;
  const int nsb = min(256, (int)gridDim.x / 2);
  PH(0,
    if (gtid < 2 * NEXP) p.cnt[gtid * 64] = 0;
    phase_convert_dense(p, smem);
    phase_fold_z(p, gtid, gstride, (float*)(smem + 65536));
    LOOP(T > 1024 ? T : 1024) ph_tables(p, i);)
#ifndef ONLY_PHASE
  if (p.use_cg_sync) grid.sync();
#endif
  GSYNC();
  PH(1, phase_lnmod_first(p);)
  GSYNC();
  PH(2, phase_gemm(p, GemmJob{(const act_t*)p.u8, (const act_t*)p.W8in_even, p.P, 0, 0, 0, 1, NR / 128, IN_EVEN / 128, D, PW, IN_EVEN, 2, 1.0f / (SU8 * SW8), 1}, smem);)
  GSYNC();
  PH(3,
    if ((int)blockIdx.x < nsb) phase_scan<0>(p, smem, blockIdx.x, nsb);
    else { phase_attn(p, smem, blockIdx.x - nsb, gridDim.x - nsb); phase_convert_experts(p, 0, smem, blockIdx.x - nsb, gridDim.x - nsb); })
  GSYNC();
  PH(4, phase_combine<0>(p);)
  GSYNC();
  PH(5, phase_gemm(p, GemmJob{p.u, p.Wt_out_even, p.M, 0, 0, 0, 1, NR / 128, D / 128, D, D, D, 0, 1.0f, 0}, smem);)
  GSYNC();
  PH(6, phase_resid_ln<1>(p, 0, 0, 0, NR, smem);)
  GSYNC();
  PH(7, phase_moe(p, 0, false, smem);)
  GSYNC();
  PH(8, phase_moe(p, 0, true, smem);)
  GSYNC();
  PH(9, phase_resid_ln<2>(p, 0, 1, 0, NR, smem); phase_cmat(p, gtid, gstride);)
  GSYNC();
  PH(10, phase_gemm(p, GemmJob{(const act_t*)p.u8, (const act_t*)p.W8in_odd, p.P, 0, 0, 0, 1, NR / 128, IN_ODD_PAD / 128, D, PW, O_FA, 1, 1.0f / (SU8 * SW8), 1}, smem);)
  GSYNC();
  PH(11, phase_gla_decay(p);)
  GSYNC();
  PH(12,
    if ((int)blockIdx.x < nsb) phase_scan<1>(p, smem, blockIdx.x, nsb);
    else {
      phase_gemm(p, GemmJob{p.Cmat, p.FT, p.u + (long)NC * D + 768, 0, (long)256 * 2 * T, (long)T * D, NB, T / 128, 2, 2 * T, D,
                            256, 0, 0.00276213586400995f, 0}, smem, blockIdx.x - nsb, gridDim.x - nsb);
      phase_convert_experts(p, 1, smem, blockIdx.x - nsb, gridDim.x - nsb);
    })
  GSYNC();
  PH(13, phase_combine<1>(p);)
  GSYNC();
  PH(14,
    phase_gemm(p, GemmJob{p.u + (long)NC * D, p.Wt_out_odd, p.M + (long)NC * D, 0, 0, 0, 1, NT / 128, D / 128, D, D, D, 0, 1.0f, 0}, smem);)
  GSYNC();
  PH(15, phase_resid_ln<1>(p, 1, 0, NC, NR, smem);)
  GSYNC();
  PH(16, phase_moe(p, 1, false, smem);)
  GSYNC();
  PH(17, phase_moe(p, 1, true, smem);)
  GSYNC();
  PH(18, phase_resid_ln<2>(p, 1, 1, NC, NR, smem);)
}

static size_t carve(Params& p, char* ws) {
  size_t off = 0;
  auto take = [&](size_t bytes) { char* r = ws + off; off += (bytes + 255) & ~(size_t)255; return r; };
  p.mod = (float*)take(sizeof(float) * 2 * (NB + 1) * 6 * D);
  p.hc = (float*)take(sizeof(float) * (size_t)NC * D);
  p.costab = (float*)take(sizeof(float) * T);
  p.sintab = (float*)take(sizeof(float) * T);
  p.lbt = (float*)take(sizeof(float) * 1024);
  p.ropetab = (float*)take(sizeof(float) * 64 * 16 * 2);
  p.ew = (float*)take(sizeof(float) * (size_t)NR * 2);
  p.eidx = nullptr;
  p.u = (act_t*)take(sizeof(act_t) * (size_t)NR * D);
  p.P = (act_t*)take(sizeof(act_t) * (size_t)NR * PW);
  p.OF = (act_t*)take(sizeof(act_t) * (size_t)NR * 768);
  p.OB = (act_t*)take(sizeof(act_t) * (size_t)NR * 768);
  p.M = p.OF;
  p.Cmat = (act_t*)take(sizeof(act_t) * (size_t)T * 2 * T);
  p.FT = (act_t*)take(sizeof(act_t) * (size_t)NB * 256 * 2 * T);
  p.LF = (act_t*)take(sizeof(act_t) * (size_t)2 * NR * 384);
  p.W8up = (unsigned char*)p.Cmat;
  p.W8down = p.W8up + (size_t)NEXP * 1024 * D;
  p.W8up1 = (unsigned char*)take((size_t)NEXP * 1024 * (D + DFF));
  p.W8down1 = p.W8up1 + (size_t)NEXP * 1024 * D;
  p.u8 = (unsigned char*)take((size_t)NR * D);
  p.Y = p.P;
  p.H8 = (unsigned char*)(p.P + (size_t)2 * NR * D);
  p.bar = (unsigned*)take(sizeof(unsigned) * XCD_BAR_WORDS);
  p.cnt = (int*)take(sizeof(int) * 2 * NEXP * 64);
  p.list = (int*)take(sizeof(int) * (size_t)2 * NEXP * NR);
  p.Wt_in_even = nullptr;
  p.W8in_even = (unsigned char*)take((size_t)IN_EVEN * D);
  p.Wt_out_even = (act_t*)take(sizeof(act_t) * (size_t)D * D);
  p.Wt_in_odd = nullptr;
  p.W8in_odd = (unsigned char*)take((size_t)IN_ODD_PAD * D);
  p.Wt_out_odd = (act_t*)take(sizeof(act_t) * (size_t)D * D);
  return off;
}

static void fill_inputs(Params& p, void* const* d_in) {
  const float** f = (const float**)&p;
  for (int i = 0; i < 23; ++i) f[i] = (const float*)d_in[i];
}

extern "C" void kernel_launch(void* const* d_in, const int* in_sizes, int n_in, void* d_out, int out_size,
                              void* d_ws, size_t ws_size, hipStream_t stream) {
  static int grid_blocks = 0;
  if (!grid_blocks) {
    int dev = 0, cus = 0, per_cu = 0;
    (void)hipGetDevice(&dev);
    (void)hipDeviceGetAttribute(&cus, hipDeviceAttributeMultiprocessorCount, dev);
    (void)hipOccupancyMaxActiveBlocksPerMultiprocessor(&per_cu, mega_kernel, 256, 0);
    grid_blocks = cus * per_cu;
  }
  Params p{};
  fill_inputs(p, d_in);
  p.out = (float*)d_out;
  size_t need = carve(p, (char*)d_ws);
  if (need > ws_size) { fprintf(stderr, "workspace too small: need %zu have %zu\n", need, ws_size); return; }
  (void)hipMemsetAsync(p.bar, 0, sizeof(unsigned) * XCD_BAR_WORDS, stream);
  void* args[] = {&p};
  hipError_t e = hipLaunchCooperativeKernel((void*)mega_kernel, dim3(grid_blocks), dim3(256), args, 0, stream);
  if (e != hipSuccess) fprintf(stderr, "cooperative launch failed: %s (grid %d)\n", hipGetErrorString(e), grid_blocks);
}
#endif
```

```cpp
#ifndef HOST_TEST
#include <hip/hip_runtime.h>
#include <hip/hip_cooperative_groups.h>
#include <cstdio>
namespace cg = cooperative_groups;
#define DEV __device__ __forceinline__
#else
#include <cmath>
#include <cstdio>
#include <cstdlib>
#include <cstring>
#define DEV static inline
#endif

#ifndef T_BATCH
#define T_BATCH 8
#endif
#ifndef T_SEQ
#define T_SEQ 2048
#endif
#ifndef T_CTX
#define T_CTX 256
#endif

constexpr int D = 1024, NB = T_BATCH, T = T_SEQ, C = T_CTX;
constexpr int NC = NB * C, NT = NB * T, NR = NC + NT;
constexpr int GRID_W = 64;
constexpr int IN_EVEN = 3328, IN_ODD = 2592, PW = 3328;
constexpr int NEXP = 16, DFF = 512;
constexpr float ALPHA = 1.4142135623730951f;
constexpr float LN_EPS = 1e-5f;
constexpr int E_AQ = 0, E_AK = 512, E_AV = 640, E_FF = 768, E_HQ = 1792, E_HI = 2304, E_HG = 2816;
constexpr int O_Q = 0, O_K = 384, O_V = 768, O_RF = 1536, O_G = 1568, O_Z = 2336;

#ifdef HOST_TEST
typedef float act_t;
DEV float ldA(const act_t* p) { return *p; }
DEV void stA(act_t* p, float v) { *p = v; }
#else
typedef unsigned short act_t;
DEV float ldA(const act_t* p) { return __uint_as_float(((unsigned)*p) << 16); }
DEV void stA(act_t* p, float v) {
  unsigned u = __float_as_uint(v);
  u += 0x7fffu + ((u >> 16) & 1u);
  *p = (unsigned short)(u >> 16);
}
#endif

struct Params {
  const float *x, *c, *ctx, *c_ctx, *w_ada, *b_ada, *ln_g, *ln_b, *w_in_even, *attn_sink, *lb_logits, *hgrn_norm,
      *w_out_even, *w_in_odd, *gla_gate_w, *gla_gate_b, *gla_norm, *w_out_odd, *w_router, *b_router, *w_eg, *w_eu,
      *w_ed;
  float* out;
  float *mod, *hc, *costab, *sintab, *lbt, *ew, *ropetab;
  int* eidx;
  act_t *u, *P, *OF, *OB, *M, *LF;
  act_t *Wt_in_even, *Wt_out_even, *Wt_in_odd, *Wt_out_odd;
  act_t *Y, *Cmat, *FT;
  unsigned char *W8up, *W8down, *W8up1, *W8down1, *H8, *u8;
  unsigned char *W8in_even, *W8in_odd;
  int *cnt, *list;
  unsigned* bar;
  int use_cg_sync;
  int pad_;
};

DEV float sigmoidf_(float v) { return 1.0f / (1.0f + expf(-v)); }
DEV float siluf_(float v) { return v / (1.0f + expf(-v)); }

DEV const float* hrow_in(const Params& p, long row) {
  return row < NC ? p.ctx + row * D : p.x + (row - NC) * D;
}
DEV float* hrow(const Params& p, long row) { return row < NC ? p.hc + row * D : p.out + (row - NC) * D; }
DEV const float* modrow(const Params& p, int l, long row) {
  int bb = row < NC ? NB : (int)((row - NC) / T);
  return p.mod + ((long)l * (NB + 1) + bb) * 6 * D;
}

DEV void ph_mod(const Params& p, long i) {
  int j = (int)(i % (6 * D));
  int bb = (int)((i / (6 * D)) % (NB + 1));
  int l = (int)(i / ((long)6 * D * (NB + 1)));
  const float* cv = bb < NB ? p.c + (long)bb * D : p.c_ctx;
  const float* w = p.w_ada + (long)l * D * 6 * D + j;
  float s = p.b_ada[l * 6 * D + j];
  for (int k = 0; k < D; ++k) s += siluf_(cv[k]) * w[(long)k * 6 * D];
  p.mod[i] = s;
}

DEV void ph_tables(const Params& p, long i) {
  if (i < 1024) {
    int pos = (int)(i >> 4), idx = (int)(i & 15);
    float ang = (float)pos * powf(10000.0f, -(float)idx / 16.0f);
    p.ropetab[2 * i] = cosf(ang);
    p.ropetab[2 * i + 1] = sinf(ang);
  }
  if (i < 1024) {
    int dir = (int)(i / 512), col = (int)(i % 512);
    float l0 = p.lb_logits[(dir * 2 + 0) * 512 + col], l1 = p.lb_logits[(dir * 2 + 1) * 512 + col];
    p.lbt[i] = 1.0f / (1.0f + expf(l1 - l0));
  }
}

DEV void ln_mod_row(const float* h, const float* shift, const float* scale, act_t* u) {
  float mu = 0.f;
  for (int k = 0; k < D; ++k) mu += h[k];
  mu *= (1.0f / D);
  float var = 0.f;
  for (int k = 0; k < D; ++k) { float d = h[k] - mu; var += d * d; }
  var *= (1.0f / D);
  float rs = 1.0f / sqrtf(var + LN_EPS);
  for (int k = 0; k < D; ++k) stA(u + k, (h[k] - mu) * rs * (1.0f + scale[k]) + shift[k]);
}

DEV void ph_lnmod_first(const Params& p, long row) {
  const float* m = modrow(p, 0, row);
  ln_mod_row(hrow_in(p, row), m, m + D, p.u + row * D);
}

DEV void gemm_item_act(const act_t* A, const float* W, act_t* Cout, int K, int N, int ldc, long i) {
  int n4 = (int)(i % (N / 4));
  long row = i / (N / 4);
  const act_t* a = A + row * K;
  const float* w = W + n4 * 4;
  float s0 = 0, s1 = 0, s2 = 0, s3 = 0;
  for (int k = 0; k < K; ++k) {
    float av = ldA(a + k);
    const float* wr = w + (long)k * N;
    s0 += av * wr[0]; s1 += av * wr[1]; s2 += av * wr[2]; s3 += av * wr[3];
  }
  act_t* o = Cout + row * ldc + n4 * 4;
  stA(o, s0); stA(o + 1, s1); stA(o + 2, s2); stA(o + 3, s3);
}

DEV void ph_rope(const Params& p, long i) {
  int pr = (int)(i % 32);
  int hh = (int)((i / 32) % 10);
  long lr = i / 320;
  int t = (int)(lr % T);
  int col = hh < 8 ? E_AQ + hh * 64 : E_AK + (hh - 8) * 64;
  int idx = pr & 15;
  int pos = pr < 16 ? t / GRID_W : t % GRID_W;
  int d0 = pr < 16 ? idx : 32 + idx;
  float inv = powf(10000.0f, -(float)idx / 16.0f);
  float ang = (float)pos * inv;
  float cs = cosf(ang), sn = sinf(ang);
  act_t* base = p.P + (NC + lr) * PW + col;
  float x1 = ldA(base + d0), x2 = ldA(base + d0 + 16);
  stA(base + d0, x1 * cs - x2 * sn);
  stA(base + d0 + 16, x1 * sn + x2 * cs);
}

DEV void ph_attn(const Params& p, long i) {
  int h = (int)(i % 8);
  long row = i / 8;
  int kv = h / 4;
  bool lat = row >= NC;
  int b = lat ? (int)((row - NC) / T) : (int)(row / C);
  int t = lat ? (int)((row - NC) % T) : 0;
  float q[64], acc[64];
  const act_t* qp = p.P + row * PW + E_AQ + h * 64;
#pragma unroll
  for (int d = 0; d < 64; ++d) { q[d] = ldA(qp + d) * 0.125f; acc[d] = 0.f; }
  float m = p.attn_sink[h], l = 1.0f;
  int nkeys = C + (lat ? 257 : 0);
  for (int j = 0; j < nkeys; ++j) {
    long krow;
    if (j < C) krow = (long)b * C + j;
    else {
      int kp = t - 128 + (j - C);
      if (kp < 0 || kp >= T) continue;
      krow = NC + (long)b * T + kp;
    }
    const act_t* kptr = p.P + krow * PW + E_AK + kv * 64;
    const act_t* vptr = p.P + krow * PW + E_AV + kv * 64;
    float s = 0.f;
#pragma unroll
    for (int d = 0; d < 64; ++d) s += q[d] * ldA(kptr + d);
    float mn = fmaxf(m, s);
    float sc = expf(m - mn), pj = expf(s - mn);
    l = l * sc + pj;
#pragma unroll
    for (int d = 0; d < 64; ++d) acc[d] = acc[d] * sc + pj * ldA(vptr + d);
    m = mn;
  }
  float il = 1.0f / l;
  act_t* o = p.u + row * D + h * 64;
#pragma unroll
  for (int d = 0; d < 64; ++d) stA(o + d, acc[d] * il);
}

template <int MODE>
DEV void ph_scan(const Params& p, long i) {
  constexpr int DK = MODE == 0 ? 128 : 96;
  constexpr int DV = MODE == 0 ? 128 : 192;
  int e = (int)(i % DV);
  int dir = (int)((i / DV) % 2);
  int h = (int)((i / (2 * DV)) % 4);
  int b = (int)(i / (8 * DV));
  float S[DK];
#pragma unroll
  for (int d = 0; d < DK; ++d) S[d] = 0.f;
  act_t* OD = dir == 0 ? p.OF : p.OB;
  for (int step = 0; step < C + T; ++step) {
    long row;
    if (step < C) row = (long)b * C + (dir == 0 ? step : C - 1 - step);
    else { int tt = step - C; row = NC + (long)b * T + (dir == 0 ? tt : T - 1 - tt); }
    const act_t* pr = p.P + row * PW;
    float o = 0.f;
    if (MODE == 0) {
      float v = ldA(pr + E_HI + h * 128 + e);
      const act_t* zp = pr + E_FF + dir * 512 + h * 128;
      const act_t* qp = pr + E_HQ + h * 128;
      const float* lb = p.lbt + dir * 512 + h * 128;
#pragma unroll
      for (int d = 0; d < DK; ++d) {
        float f = lb[d] + (1.0f - lb[d]) * sigmoidf_(ldA(zp + d));
        S[d] = f * S[d] + (1.0f - f) * v;
        o += ldA(qp + d) * S[d];
      }
      stA(OD + row * 768 + h * 128 + e, o);
    } else {
      float v = ldA(pr + O_V + h * 192 + e);
      const act_t* kp = pr + O_K + h * 96;
      const act_t* qp = pr + O_Q + h * 96;
      const act_t* lf = p.LF + ((long)dir * NR + row) * 384 + h * 96;
#pragma unroll
      for (int d = 0; d < DK; ++d) {
        float f = expf(ldA(lf + d));
        S[d] = f * S[d] + ldA(kp + d) * v;
        o += ldA(qp + d) * S[d];
      }
      stA(OD + row * 768 + h * 192 + e, o * 0.10206207261596575f);
    }
  }
}

template <int MODE>
DEV void ph_combine(const Params& p, long i) {
  constexpr int DV = MODE == 0 ? 128 : 192;
  int h = (int)(i % 4);
  long row = (MODE == 0) ? i / 4 : NC + i / 4;
  const act_t* f = p.OF + row * 768 + h * DV;
  const act_t* bk = p.OB + row * 768 + h * DV;
  float ss = 0.f;
  for (int e = 0; e < DV; ++e) { float o = ldA(f + e) + ldA(bk + e); ss += o * o; }
  float r = 1.0f / sqrtf(ss / DV + LN_EPS);
  const float* gn = (MODE == 0 ? p.hgrn_norm : p.gla_norm) + h * DV;
  const act_t* g = p.P + row * PW + (MODE == 0 ? E_HG : O_G) + h * DV;
  act_t* o = p.u + row * D + (MODE == 0 ? 512 : 0) + h * DV;
  for (int e = 0; e < DV; ++e) stA(o + e, (ldA(f + e) + ldA(bk + e)) * r * gn[e] * siluf_(ldA(g + e)));
}

DEV void ph_gla_decay(const Params& p, long i) {
  int col = (int)(i % 384);
  long row = (i / 384) % NR;
  int dir = (int)(i / ((long)384 * NR));
  const act_t* r = p.P + row * PW + O_RF + dir * 16;
  const float* gw = p.gla_gate_w + (long)dir * 16 * 384 + col;
  float z = p.gla_gate_b[dir * 384 + col];
  for (int k = 0; k < 16; ++k) z += ldA(r + k) * gw[k * 384];
  float ls = fminf(z, 0.f) - log1pf(expf(-fabsf(z)));
  stA(p.LF + ((long)dir * NR + row) * 384 + col, ls * (1.0f / 16.0f));
}

DEV void ph_resid_ln(const Params& p, long row, int l, int sub) {
  const float* hin = (l == 0 && sub == 0) ? hrow_in(p, row) : hrow(p, row);
  float* hout = hrow(p, row);
  const float* md = modrow(p, l, row);
  const float* g = md + (sub == 0 ? 2 : 5) * D;
  const act_t* m = p.M + row * D;
  const float* lg = p.ln_g + (l * 2 + sub) * D;
  const float* lb = p.ln_b + (l * 2 + sub) * D;
  float mu = 0.f;
  for (int k = 0; k < D; ++k) mu += ALPHA * hin[k] + g[k] * ldA(m + k);
  mu *= (1.0f / D);
  float var = 0.f;
  for (int k = 0; k < D; ++k) { float d = ALPHA * hin[k] + g[k] * ldA(m + k) - mu; var += d * d; }
  var *= (1.0f / D);
  float rs = 1.0f / sqrtf(var + LN_EPS);
  for (int k = 0; k < D; ++k) hout[k] = (ALPHA * hin[k] + g[k] * ldA(m + k) - mu) * rs * lg[k] + lb[k];
  if (sub == 1 && l == 1) return;
  const float* md2 = (sub == 0) ? md + 3 * D : modrow(p, 1, row);
  float mu2 = 0.f;
  for (int k = 0; k < D; ++k) mu2 += hout[k];
  mu2 *= (1.0f / D);
  float var2 = 0.f;
  for (int k = 0; k < D; ++k) { float d = hout[k] - mu2; var2 += d * d; }
  var2 *= (1.0f / D);
  float rs2 = 1.0f / sqrtf(var2 + LN_EPS);
  float lo[NEXP];
#pragma unroll
  for (int e = 0; e < NEXP; ++e) lo[e] = 0.f;
  for (int k = 0; k < D; ++k) {
    float uv = (hout[k] - mu2) * rs2 * (1.0f + md2[D + k]) + md2[k];
    stA(p.u + row * D + k, uv);
    if (sub == 0) {
      const float* wr = p.w_router + k * NEXP;
#pragma unroll
      for (int e = 0; e < NEXP; ++e) lo[e] += uv * wr[e];
    }
  }
  if (sub != 0) return;
  float mx = lo[0];
#pragma unroll
  for (int e = 1; e < NEXP; ++e) mx = fmaxf(mx, lo[e]);
  float sum = 0.f;
#pragma unroll
  for (int e = 0; e < NEXP; ++e) { lo[e] = expf(lo[e] - mx); sum += lo[e]; }
  float inv = 1.0f / sum;
  float bestg = -1e30f; int bg = 0;
  float gi1 = 0, gi2 = 0; int ge1 = 0, ge2 = 0;
  float gp1 = 0, gp2 = 0;
#pragma unroll
  for (int gq = 0; gq < 4; ++gq) {
    float s1 = -1e30f, s2 = -1e30f, p1 = 0, p2 = 0; int e1 = 0, e2 = 0;
#pragma unroll
    for (int j = 0; j < 4; ++j) {
      int e = gq * 4 + j;
      float pe = lo[e] * inv;
      float se = pe + p.b_router[e];
      if (se > s1) { s2 = s1; p2 = p1; e2 = e1; s1 = se; p1 = pe; e1 = e; }
      else if (se > s2) { s2 = se; p2 = pe; e2 = e; }
    }
    float gs = s1 + s2;
    if (gs > bestg) { bestg = gs; bg = gq; gi1 = s1; gi2 = s2; ge1 = e1; ge2 = e2; gp1 = p1; gp2 = p2; }
  }
  (void)bg; (void)gi1; (void)gi2;
  float wsum = gp1 + gp2;
  p.eidx[row * 2 + 0] = ge1; p.eidx[row * 2 + 1] = ge2;
  p.ew[row * 2 + 0] = gp1 / wsum; p.ew[row * 2 + 1] = gp2 / wsum;
}

DEV void ph_moe_up(const Params& p, long i, int l, long row0) {
  int f4 = (int)(i % (DFF / 4));
  int slot = (int)((i / (DFF / 4)) % 2);
  long row = row0 + i / (DFF / 2);
  int e = p.eidx[row * 2 + slot];
  const float* w1 = p.w_eg + ((long)(l * NEXP + e) * D) * DFF + f4 * 4;
  const float* w3 = p.w_eu + ((long)(l * NEXP + e) * D) * DFF + f4 * 4;
  const act_t* a = p.u + row * D;
  float g0 = 0, g1 = 0, g2 = 0, g3 = 0, u0 = 0, u1 = 0, u2 = 0, u3 = 0;
  for (int k = 0; k < D; ++k) {
    float av = ldA(a + k);
    const float* r1 = w1 + (long)k * DFF;
    const float* r3 = w3 + (long)k * DFF;
    g0 += av * r1[0]; g1 += av * r1[1]; g2 += av * r1[2]; g3 += av * r1[3];
    u0 += av * r3[0]; u1 += av * r3[1]; u2 += av * r3[2]; u3 += av * r3[3];
  }
  act_t* hb = p.P + (row * 2 + slot) * DFF + f4 * 4;
  stA(hb, siluf_(g0) * u0); stA(hb + 1, siluf_(g1) * u1); stA(hb + 2, siluf_(g2) * u2); stA(hb + 3, siluf_(g3) * u3);
}

DEV void ph_moe_down(const Params& p, long i, int l, long row0) {
  int j4 = (int)(i % (D / 4));
  long row = row0 + i / (D / 4);
  float y0 = 0, y1 = 0, y2 = 0, y3 = 0;
  for (int slot = 0; slot < 2; ++slot) {
    int e = p.eidx[row * 2 + slot];
    float wgt = p.ew[row * 2 + slot];
    const float* w2 = p.w_ed + ((long)(l * NEXP + e) * DFF) * D + j4 * 4;
    const act_t* hb = p.P + (row * 2 + slot) * DFF;
    float s0 = 0, s1 = 0, s2 = 0, s3 = 0;
    for (int f = 0; f < DFF; ++f) {
      float hv = ldA(hb + f);
      const float* r = w2 + (long)f * D;
      s0 += hv * r[0]; s1 += hv * r[1]; s2 += hv * r[2]; s3 += hv * r[3];
    }
    y0 += wgt * s0; y1 += wgt * s1; y2 += wgt * s2; y3 += wgt * s3;
  }
  act_t* o = p.M + row * D + j4 * 4;
  stA(o, y0); stA(o + 1, y1); stA(o + 2, y2); stA(o + 3, y3);
}


#ifndef HOST_TEST
typedef __attribute__((ext_vector_type(8))) short bf16x8;
typedef __attribute__((ext_vector_type(4))) float f32x4;
constexpr int SMEM_BYTES = 71680;
constexpr int IN_ODD_PAD = 2944;
constexpr int O_FA = 2336, O_FB = 2592, O_END = 2848;

typedef float f32x2_t __attribute__((ext_vector_type(2)));
typedef __bf16 bf16x2_t __attribute__((ext_vector_type(2)));
__device__ __forceinline__ unsigned pack2(float a, float b) {
  const f32x2_t v = {a, b};
  return __builtin_bit_cast(unsigned, __builtin_convertvector(v, bf16x2_t));
}
__device__ __forceinline__ unsigned pack2_mfma(float a, float b) { return pack2(a, b); }
typedef __attribute__((ext_vector_type(2))) unsigned u32x2;
__device__ __forceinline__ float xor16_max(float x) {
  const u32x2 r = __builtin_amdgcn_permlane16_swap(__float_as_uint(x), __float_as_uint(x), false, false);
  return fmaxf(__uint_as_float(r.x), __uint_as_float(r.y));
}
__device__ __forceinline__ float xor32_max(float x) {
  const u32x2 r = __builtin_amdgcn_permlane32_swap(__float_as_uint(x), __float_as_uint(x), false, false);
  return fmaxf(__uint_as_float(r.x), __uint_as_float(r.y));
}
__device__ __forceinline__ float xor16_add(float x) {
  const u32x2 r = __builtin_amdgcn_permlane16_swap(__float_as_uint(x), __float_as_uint(x), false, false);
  return __uint_as_float(r.x) + __uint_as_float(r.y);
}
__device__ __forceinline__ float xor32_add(float x) {
  const u32x2 r = __builtin_amdgcn_permlane32_swap(__float_as_uint(x), __float_as_uint(x), false, false);
  return __uint_as_float(r.x) + __uint_as_float(r.y);
}
__device__ __forceinline__ float bf_lo(unsigned u) { return __uint_as_float(u << 16); }
__device__ __forceinline__ float bf_hi(unsigned u) { return __uint_as_float(u & 0xffff0000u); }
template <int CTRL>
__device__ __forceinline__ float dpp_mov(float v) {
  return __int_as_float(__builtin_amdgcn_update_dpp(0, __float_as_int(v), CTRL, 0xf, 0xf, true));
}
__device__ __forceinline__ float row_sum16(float v) {
  v += dpp_mov<0xB1>(v);
  v += dpp_mov<0x4E>(v);
  v += dpp_mov<0x141>(v);
  v += dpp_mov<0x140>(v);
  return v;
}
__device__ __forceinline__ float wave_sum(float v) {
  v = row_sum16(v);
  const float a = __int_as_float(__builtin_amdgcn_readlane(__float_as_int(v), 0));
  const float b = __int_as_float(__builtin_amdgcn_readlane(__float_as_int(v), 16));
  const float c = __int_as_float(__builtin_amdgcn_readlane(__float_as_int(v), 32));
  const float d = __int_as_float(__builtin_amdgcn_readlane(__float_as_int(v), 48));
  return (a + b) + (c + d);
}


#define XB_TMO      128
#define XB_XCNT(j)  (256  + 64 * (j))
#define XB_XSUB(j)  (1280 + 64 * (j))
#define XB_XGEN(j)  (2304 + 64 * (j))
#define XB_TOP      3328
#define XB_TOPGEN   3392
#define XCD_BAR_WORDS 3456
#define XB_SPIN_CAP (1u << 18)
#define LAS __attribute__((address_space(3)))
__device__ __forceinline__ unsigned xb_ld(unsigned* p)              { return __hip_atomic_load(p, __ATOMIC_RELAXED, __HIP_MEMORY_SCOPE_AGENT); }
__device__ __forceinline__ unsigned xb_add(unsigned* p, unsigned v) { return __hip_atomic_fetch_add(p, v, __ATOMIC_RELAXED, __HIP_MEMORY_SCOPE_AGENT); }
__device__ __forceinline__ unsigned xb_xcc_id() { return (unsigned)__builtin_amdgcn_s_getreg((3 << 11) | 20) & 0xFu; }
#define XB_SPIN(cond, bar) do { unsigned _sp = 0; while (cond) { __builtin_amdgcn_s_sleep(1); \
    if ((++_sp & 255u) == 0u) { if (xb_ld(&(bar)[XB_TMO])) break; if (_sp > XB_SPIN_CAP) { atomicAdd(&(bar)[XB_TMO], 1u); break; } } } } while (0)
struct XcdBarrier { unsigned* bar; unsigned x; volatile LAS unsigned* st; };
__device__ __forceinline__ XcdBarrier xcd_barrier_post(unsigned* bar, volatile LAS unsigned* st) {
    XcdBarrier b; b.bar = bar; b.x = xb_xcc_id(); b.st = st;
    if (threadIdx.x == 0) (void)xb_add(&bar[XB_XCNT(b.x)], 1u);
    return b;
}
__device__ __forceinline__ void xcd_barrier_complete(unsigned* bar, unsigned x, unsigned& nloc, unsigned& nx) {
    const unsigned G = gridDim.x * gridDim.y * gridDim.z;
    unsigned sum, cnt, mine, sp = 0u;
    for (;;) {
        sum = 0u; cnt = 0u; mine = 0u;
#pragma unroll
        for (unsigned j = 0; j < 16; ++j) { const unsigned c = xb_ld(&bar[XB_XCNT(j)]); sum += c; cnt += (c > 0u) ? 1u : 0u; mine = (j == x) ? c : mine; }
        if (sum == G) break;
        __builtin_amdgcn_s_sleep(1);
        if ((++sp & 255u) == 0u) { if (xb_ld(&bar[XB_TMO])) break; if (sp > XB_SPIN_CAP) { atomicAdd(&bar[XB_TMO], 1u); break; } }
    }
    nloc = mine > 0u ? mine : 1u; nx = cnt > 0u ? cnt : 1u;
}
__device__ __forceinline__ void xcd_barrier(const XcdBarrier& b) {
    asm volatile("s_waitcnt vmcnt(0)" ::: "memory");
    __syncthreads();
    if (threadIdx.x == 0) {
        unsigned* bar = b.bar;
        __builtin_amdgcn_s_waitcnt(0);
        unsigned nloc = b.st[0], nx = b.st[1];
        if (nloc == 0u) { xcd_barrier_complete(bar, b.x, nloc, nx); b.st[0] = nloc; b.st[1] = nx; }
        const unsigned old = xb_add(&bar[XB_XSUB(b.x)], 1u);
        const unsigned gen = old / nloc;
        if (old + 1u == (gen + 1u) * nloc) {
            __builtin_amdgcn_fence(__ATOMIC_RELEASE, "agent");
            asm volatile("s_waitcnt vmcnt(0)" ::: "memory");
            const unsigned og = xb_add(&bar[XB_TOP], 1u);
            const unsigned tg = og / nx;
            if (og + 1u == (tg + 1u) * nx) xb_add(&bar[XB_TOPGEN], 1u);
            else XB_SPIN(xb_ld(&bar[XB_TOPGEN]) == tg, bar);
            __builtin_amdgcn_fence(__ATOMIC_ACQUIRE, "agent");
            xb_add(&bar[XB_XGEN(b.x)], 1u);
            asm volatile("s_waitcnt vmcnt(0)" ::: "memory");
        } else {
            XB_SPIN(xb_ld(&bar[XB_XGEN(b.x)]) == gen, bar);
            __builtin_amdgcn_fence(__ATOMIC_ACQUIRE, "agent");
            asm volatile("s_waitcnt vmcnt(0)" ::: "memory");
        }
    }
    __syncthreads();
}

#define RAW_BARRIER() do { asm volatile("s_waitcnt lgkmcnt(0)" ::: "memory"); __builtin_amdgcn_s_barrier(); } while (0)
template <bool SWAP, class ARow, class Epi>
__device__ __forceinline__ void gemm_tile(ARow arow, const act_t* Bt, int K, unsigned char* smem, Epi epi) {
  const int tid = threadIdx.x, wid = tid >> 6, lane = tid & 63, wr = wid >> 1, wc = wid & 1, fr = lane & 15,
            fq = lane >> 4;
  const int r0 = tid >> 3, pc = tid & 7;
  const int lc = pc ^ ((tid >> 4) & 7);
  const act_t* ga[4];
#pragma unroll
  for (int i = 0; i < 4; ++i) ga[i] = arow(r0 + 32 * i) + lc * 8;
  const act_t* gb0 = Bt + (long)r0 * K + lc * 8;
  const long gbs = (long)32 * K;
  const int sw = (fr >> 1) & 7;
  const int rd0 = fr * 128 + ((fq ^ sw) << 4), rd1 = fr * 128 + (((4 + fq) ^ sw) << 4);
  char* S = (char*)smem;
  const int nk = K >> 6;
  f32x4 acc[4][4];
#pragma unroll
  for (int m = 0; m < 4; ++m)
#pragma unroll
    for (int n = 0; n < 4; ++n) acc[m][n] = f32x4{0.f, 0.f, 0.f, 0.f};
  auto issue = [&](int kt) {
    char* st = S + (kt & 1) * 32768 + tid * 16;
#pragma unroll
    for (int i = 0; i < 4; ++i) {
      __builtin_amdgcn_global_load_lds((const unsigned*)(ga[i] + kt * 64), (unsigned*)(st + i * 4096), 16, 0, 0);
      __builtin_amdgcn_global_load_lds((const unsigned*)(gb0 + i * gbs + kt * 64), (unsigned*)(st + 16384 + i * 4096), 16, 0, 0);
    }
  };
  asm volatile("s_waitcnt vmcnt(0)" ::: "memory");
  RAW_BARRIER();
  issue(0);
  for (int kt = 0; kt < nk; ++kt) {
    asm volatile("s_waitcnt vmcnt(0)" ::: "memory");
    RAW_BARRIER();
    if (kt + 1 < nk) issue(kt + 1);
    const char* st = S + (kt & 1) * 32768;
#pragma unroll
    for (int ks = 0; ks < 2; ++ks) {
      const int rd = ks ? rd1 : rd0;
      bf16x8 af[4], bfr[4];
#pragma unroll
      for (int m = 0; m < 4; ++m) {
        af[m] = *reinterpret_cast<const bf16x8*>(st + (wr * 64 + m * 16) * 128 + rd);
        bfr[m] = *reinterpret_cast<const bf16x8*>(st + 16384 + (wc * 64 + m * 16) * 128 + rd);
      }
#pragma unroll
      for (int m = 0; m < 4; ++m)
#pragma unroll
        for (int n = 0; n < 4; ++n)
          acc[m][n] = SWAP ? __builtin_amdgcn_mfma_f32_16x16x32_bf16(bfr[n], af[m], acc[m][n], 0, 0, 0)
                           : __builtin_amdgcn_mfma_f32_16x16x32_bf16(af[m], bfr[n], acc[m][n], 0, 0, 0);
    }
  }
  epi(acc, wr, wc, fr, fq);
}


constexpr float SU8 = 16.0f, SW8 = 64.0f, SH8 = 8.0f;
typedef unsigned char fp8_t;
typedef __attribute__((ext_vector_type(8))) int i32x8;
typedef __attribute__((ext_vector_type(4))) int i32x4;
__device__ __forceinline__ unsigned pack4_fp8(float a, float b, float c, float d) {
  a = fminf(fmaxf(a, -448.f), 448.f); b = fminf(fmaxf(b, -448.f), 448.f);
  c = fminf(fmaxf(c, -448.f), 448.f); d = fminf(fmaxf(d, -448.f), 448.f);
  unsigned w = 0;
  w = __builtin_amdgcn_cvt_pk_fp8_f32(a, b, w, false);
  w = __builtin_amdgcn_cvt_pk_fp8_f32(c, d, w, true);
  return w;
}

template <bool SWAP, class ARow, class Epi>
__device__ __forceinline__ void gemm_tile8(ARow arow, const fp8_t* Bt, int Kb, unsigned char* smem, Epi epi) {
  const int tid = threadIdx.x, wid = tid >> 6, lane = tid & 63, wr = wid >> 1, wc = wid & 1, fr = lane & 15,
            fq = lane >> 4;
  const int r0 = tid >> 3, pc = tid & 7;
  const int lc = pc ^ ((tid >> 4) & 7);
  const fp8_t* ga[4];
#pragma unroll
  for (int i = 0; i < 4; ++i) ga[i] = arow(r0 + 32 * i) + lc * 16;
  const fp8_t* gb0 = Bt + (long)r0 * Kb + lc * 16;
  const long gbs = (long)32 * Kb;
  const int sw = (fr >> 1) & 7;
  const int rd0 = fr * 128 + ((fq ^ sw) << 4), rd1 = fr * 128 + (((4 + fq) ^ sw) << 4);
  char* S = (char*)smem;
  const int nk = Kb >> 7;
  f32x4 acc[4][4];
#pragma unroll
  for (int m = 0; m < 4; ++m)
#pragma unroll
    for (int n = 0; n < 4; ++n) acc[m][n] = f32x4{0.f, 0.f, 0.f, 0.f};
  auto issue = [&](int kt) {
    char* st = S + (kt & 1) * 32768 + tid * 16;
#pragma unroll
    for (int i = 0; i < 4; ++i) {
      __builtin_amdgcn_global_load_lds((const unsigned*)(ga[i] + kt * 128), (unsigned*)(st + i * 4096), 16, 0, 0);
      __builtin_amdgcn_global_load_lds((const unsigned*)(gb0 + i * gbs + kt * 128), (unsigned*)(st + 16384 + i * 4096), 16, 0, 0);
    }
  };
  asm volatile("s_waitcnt vmcnt(0)" ::: "memory");
  RAW_BARRIER();
  issue(0);
#pragma unroll 1
  for (int kt = 0; kt < nk; ++kt) {
    asm volatile("s_waitcnt vmcnt(0)" ::: "memory");
    RAW_BARRIER();
    if (kt + 1 < nk) issue(kt + 1);
    const char* st = S + (kt & 1) * 32768;
    i32x8 af[4], bfr[4];
#pragma unroll
    for (int m = 0; m < 4; ++m) {
      const i32x4 a0 = *reinterpret_cast<const i32x4*>(st + (wr * 64 + m * 16) * 128 + rd0);
      const i32x4 a1 = *reinterpret_cast<const i32x4*>(st + (wr * 64 + m * 16) * 128 + rd1);
      const i32x4 b0 = *reinterpret_cast<const i32x4*>(st + 16384 + (wc * 64 + m * 16) * 128 + rd0);
      const i32x4 b1 = *reinterpret_cast<const i32x4*>(st + 16384 + (wc * 64 + m * 16) * 128 + rd1);
      af[m] = i32x8{a0[0], a0[1], a0[2], a0[3], a1[0], a1[1], a1[2], a1[3]};
      bfr[m] = i32x8{b0[0], b0[1], b0[2], b0[3], b1[0], b1[1], b1[2], b1[3]};
    }
#pragma unroll
    for (int m = 0; m < 4; ++m)
#pragma unroll
      for (int n = 0; n < 4; ++n)
        acc[m][n] = SWAP ? __builtin_amdgcn_mfma_scale_f32_16x16x128_f8f6f4(bfr[n], af[m], acc[m][n], 0, 0, 0, 0x7f7f7f7f, 0, 0x7f7f7f7f)
                         : __builtin_amdgcn_mfma_scale_f32_16x16x128_f8f6f4(af[m], bfr[n], acc[m][n], 0, 0, 0, 0x7f7f7f7f, 0, 0x7f7f7f7f);
  }
  epi(acc, wr, wc, fr, fq);
}

__device__ __forceinline__ void phase_attn(const Params& p, unsigned char* smem, int blk, int nblk) {
  const int tid = threadIdx.x, w = tid >> 6, lane = tid & 63, fr = lane & 15, g = lane >> 4;
  act_t* SK = (act_t*)smem;
  act_t* SV = SK + 64 * 72;
  constexpr float SCL = 0.125f * 1.4426950408889634f;
  const int n_lat = NB * 4 * (T / 64), n_ctx = NB * 4 * (C / 64);
  const int skey = tid >> 2, spart = tid & 3;
  for (int unit = blk; unit < n_lat + n_ctx; unit += nblk) {
    const bool lat = unit < n_lat;
    const int uu = lat ? unit : unit - n_lat;
    const int nq = lat ? T / 64 : C / 64;
    const int hp = uu & 1, kv = (uu >> 1) & 1, qb = (uu >> 2) % nq, b = (uu >> 2) / nq;
    const int t0 = qb * 64;
    const int tw = t0 + (w & 1) * 32;
    const long qrow0 = (lat ? (long)NC + (long)b * T : (long)b * C) + tw;
    const int h = kv * 4 + hp * 2 + (w >> 1);
    bf16x8 qf[2][2];
#pragma unroll
    for (int qt = 0; qt < 2; ++qt)
#pragma unroll
      for (int st = 0; st < 2; ++st)
        qf[qt][st] = *reinterpret_cast<const bf16x8*>(p.P + (qrow0 + qt * 16 + fr) * PW + E_AQ + h * 64 + st * 32 + g * 8);
    asm volatile("" :: "v"(qf[0][0]), "v"(qf[0][1]), "v"(qf[1][0]), "v"(qf[1][1]));
    float mrun[2], lrun[2];
    f32x4 o[2][4];
    const float sinkl = p.attn_sink[h] * 1.4426950408889634f;
#pragma unroll
    for (int qt = 0; qt < 2; ++qt) {
      mrun[qt] = sinkl;
      lrun[qt] = (g == 0) ? 1.0f : 0.0f;
#pragma unroll
      for (int dt = 0; dt < 4; ++dt) o[qt][dt] = f32x4{0.f, 0.f, 0.f, 0.f};
    }
    int cc_lo = 0, cc_hi = -1;
    if (lat) {
      cc_lo = t0 >= 128 ? 0 : (128 - t0) / 64;
      cc_hi = min(4, (T - 1 - (t0 - 128)) / 64);
    }
    const int nch = 4 + (cc_hi - cc_lo + 1);
    auto chunk_row = [&](int i, int key, int& tkb) -> long {
      if (i < 4) { tkb = 0; return (long)b * C + i * 64 + key; }
      tkb = t0 - 128 + (cc_lo + i - 4) * 64;
      return (long)NC + (long)b * T + tkb + key;
    };
    uint4 rk0, rk1, rv0, rv1;
    {
      int tkb; const long kr = chunk_row(0, skey, tkb);
      const act_t* kp = p.P + kr * PW + E_AK + kv * 64 + spart * 16;
      const act_t* vp = p.P + kr * PW + E_AV + kv * 64 + spart * 16;
      rk0 = *reinterpret_cast<const uint4*>(kp); rk1 = *reinterpret_cast<const uint4*>(kp + 8);
      rv0 = *reinterpret_cast<const uint4*>(vp); rv1 = *reinterpret_cast<const uint4*>(vp + 8);
    }
    for (int i = 0; i < nch; ++i) {
      __syncthreads();
      {
        uint4* kd = reinterpret_cast<uint4*>(SK + skey * 72 + spart * 16);
        kd[0] = rk0; kd[1] = rk1;
        const unsigned vw[8] = {rv0.x, rv0.y, rv0.z, rv0.w, rv1.x, rv1.y, rv1.z, rv1.w};
#pragma unroll
        for (int e = 0; e < 8; ++e) {
          SV[(spart * 16 + 2 * e) * 72 + skey] = (act_t)(vw[e] & 0xffffu);
          SV[(spart * 16 + 2 * e + 1) * 72 + skey] = (act_t)(vw[e] >> 16);
        }
      }
      __syncthreads();
      int tkb_cur; (void)chunk_row(i, 0, tkb_cur);
      if (i + 1 < nch) {
        int tkb; const long kr = chunk_row(i + 1, skey, tkb);
        const act_t* kp = p.P + kr * PW + E_AK + kv * 64 + spart * 16;
        const act_t* vp = p.P + kr * PW + E_AV + kv * 64 + spart * 16;
        rk0 = *reinterpret_cast<const uint4*>(kp); rk1 = *reinterpret_cast<const uint4*>(kp + 8);
        rv0 = *reinterpret_cast<const uint4*>(vp); rv1 = *reinterpret_cast<const uint4*>(vp + 8);
      }
      const bool edge = i >= 4 && (tkb_cur == t0 - 128 || tkb_cur == t0 + 128);
#pragma unroll
      for (int kb = 0; kb < 2; ++kb) {
        f32x4 sc[2][2];
#pragma unroll
        for (int k2 = 0; k2 < 2; ++k2) {
          const int kt = kb * 2 + k2;
          const bf16x8 kf0 = *reinterpret_cast<const bf16x8*>(SK + (kt * 16 + fr) * 72 + g * 8);
          const bf16x8 kf1 = *reinterpret_cast<const bf16x8*>(SK + (kt * 16 + fr) * 72 + 32 + g * 8);
#pragma unroll
          for (int qt = 0; qt < 2; ++qt) {
            f32x4 z = f32x4{0.f, 0.f, 0.f, 0.f};
            z = __builtin_amdgcn_mfma_f32_16x16x32_bf16(kf0, qf[qt][0], z, 0, 0, 0);
            sc[qt][k2] = __builtin_amdgcn_mfma_f32_16x16x32_bf16(kf1, qf[qt][1], z, 0, 0, 0);
          }
        }
        bf16x8 pf[2];
#pragma unroll
        for (int qt = 0; qt < 2; ++qt) {
          float mx = -1e30f;
#pragma unroll
          for (int k2 = 0; k2 < 2; ++k2)
#pragma unroll
            for (int j = 0; j < 4; ++j) {
              float v = sc[qt][k2][j] * SCL;
              if (edge) {
                const int tk = tkb_cur + (kb * 2 + k2) * 16 + 4 * g + j;
                const int tq = tw + qt * 16 + fr;
                const int df = tq - tk;
                if (df > 128 || df < -128) v = -1e30f;
              }
              sc[qt][k2][j] = v;
              mx = fmaxf(mx, v);
            }
          mx = xor16_max(mx);
          mx = xor32_max(mx);
          const float mnew = fmaxf(mrun[qt], mx);
          if (__any(mnew > mrun[qt])) {
            const float alpha = __builtin_amdgcn_exp2f(mrun[qt] - mnew);
            lrun[qt] *= alpha;
#pragma unroll
            for (int dt = 0; dt < 4; ++dt) o[qt][dt] = o[qt][dt] * alpha;
            mrun[qt] = mnew;
          }
          float ls = 0.f;
          float pv[8];
#pragma unroll
          for (int k2 = 0; k2 < 2; ++k2)
#pragma unroll
            for (int j = 0; j < 4; ++j) {
              const float pe = __builtin_amdgcn_exp2f(sc[qt][k2][j] - mnew);
              pv[k2 * 4 + j] = pe;
              ls += pe;
            }
          lrun[qt] += ls;
          union { unsigned u[4]; bf16x8 v; } cv;
          cv.u[0] = pack2_mfma(pv[0], pv[1]); cv.u[1] = pack2_mfma(pv[2], pv[3]);
          cv.u[2] = pack2_mfma(pv[4], pv[5]); cv.u[3] = pack2_mfma(pv[6], pv[7]);
          pf[qt] = cv.v;
        }
#pragma unroll
        for (int dt = 0; dt < 4; ++dt) {
          union { uint2 h2[2]; bf16x8 v; } vf;
          vf.h2[0] = *reinterpret_cast<const uint2*>(SV + (dt * 16 + fr) * 72 + kb * 32 + 4 * g);
          vf.h2[1] = *reinterpret_cast<const uint2*>(SV + (dt * 16 + fr) * 72 + kb * 32 + 16 + 4 * g);
#pragma unroll
          for (int qt = 0; qt < 2; ++qt) o[qt][dt] = __builtin_amdgcn_mfma_f32_16x16x32_bf16(vf.v, pf[qt], o[qt][dt], 0, 0, 0);
        }
      }
    }
#pragma unroll
    for (int qt = 0; qt < 2; ++qt) {
      float lt = lrun[qt];
      lt = xor16_add(lt);
      lt = xor32_add(lt);
      const float il = 1.0f / lt;
      act_t* orow = p.u + (qrow0 + qt * 16 + fr) * D + h * 64 + 4 * g;
#pragma unroll
      for (int dt = 0; dt < 4; ++dt)
        *reinterpret_cast<uint2*>(orow + dt * 16) =
            make_uint2(pack2(o[qt][dt][0] * il, o[qt][dt][1] * il), pack2(o[qt][dt][2] * il, o[qt][dt][3] * il));
    }
  }
}


template <int MODE>
__device__ __forceinline__ void phase_combine(const Params& p) {
  constexpr int DV = MODE == 0 ? 128 : 192, EPL = DV / 16, NV = EPL / 4;
  const int lane = threadIdx.x & 63;
  const long row_lo = MODE == 0 ? 0 : NC;
  const long w0 = (long)blockIdx.x * 4 + (threadIdx.x >> 6), wstride = (long)gridDim.x * 4;
  const float* gn = (MODE == 0 ? p.hgrn_norm : p.gla_norm) + lane * EPL;
  for (long row = row_lo + w0; row < NR; row += wstride) {
    const uint2* f = reinterpret_cast<const uint2*>(p.OF + row * 768 + lane * EPL);
    const uint2* bk = reinterpret_cast<const uint2*>(p.OB + row * 768 + lane * EPL);
    const uint2* gt = reinterpret_cast<const uint2*>(p.P + row * PW + (MODE == 0 ? E_HG : O_G) + lane * EPL);
    float o[EPL];
    float ss = 0.f;
#pragma unroll
    for (int v = 0; v < NV; ++v) {
      const uint2 a = f[v], c = bk[v];
      o[4 * v + 0] = bf_lo(a.x) + bf_lo(c.x); o[4 * v + 1] = bf_hi(a.x) + bf_hi(c.x);
      o[4 * v + 2] = bf_lo(a.y) + bf_lo(c.y); o[4 * v + 3] = bf_hi(a.y) + bf_hi(c.y);
    }
#pragma unroll
    for (int e = 0; e < EPL; ++e) ss += o[e] * o[e];
    ss = row_sum16(ss);
    const float r = 1.0f / sqrtf(ss * (1.0f / DV) + LN_EPS);
    uint2* dst = reinterpret_cast<uint2*>(p.u + row * D + (MODE == 0 ? 512 : 0) + lane * EPL);
#pragma unroll
    for (int v = 0; v < NV; ++v) {
      const uint2 gv = gt[v];
      const float g0 = bf_lo(gv.x), g1 = bf_hi(gv.x), g2 = bf_lo(gv.y), g3 = bf_hi(gv.y);
      const float y0 = o[4 * v + 0] * r * gn[4 * v + 0] * (g0 / (1.0f + __expf(-g0)));
      const float y1 = o[4 * v + 1] * r * gn[4 * v + 1] * (g1 / (1.0f + __expf(-g1)));
      const float y2 = o[4 * v + 2] * r * gn[4 * v + 2] * (g2 / (1.0f + __expf(-g2)));
      const float y3 = o[4 * v + 3] * r * gn[4 * v + 3] * (g3 / (1.0f + __expf(-g3)));
      dst[v] = make_uint2(pack2(y0, y1), pack2(y2, y3));
    }
  }
}

constexpr int MOD_ITEMS = 2 * (6 * D / 64);
__device__ __forceinline__ void mod_item(const Params& p, int item, unsigned char* smem) {
  float* sc = (float*)smem;
  float* red = sc + 9 * D;
  const int tid = threadIdx.x, w = tid >> 6, lane = tid & 63;
  for (int i = tid; i < 9 * D; i += 256) {
    const int bb = i >> 10, k = i & 1023;
    const float v = bb < NB ? p.c[bb * D + k] : p.c_ctx[k];
    sc[i] = v / (1.0f + __expf(-v));
  }
  __syncthreads();
  const int l = item / (6 * D / 64), j = (item % (6 * D / 64)) * 64 + lane;
  const float* wp = p.w_ada + (long)l * D * 6 * D + (long)(w * 256) * 6 * D + j;
  float a[NB + 1];
#pragma unroll
  for (int bb = 0; bb <= NB; ++bb) a[bb] = 0.f;
  for (int kb = 0; kb < 256; kb += 32) {
    float wv[32];
#pragma unroll
    for (int q = 0; q < 32; ++q) wv[q] = wp[(long)(kb + q) * 6 * D];
#pragma unroll
    for (int q = 0; q < 32; ++q)
#pragma unroll
      for (int bb = 0; bb <= NB; ++bb) a[bb] += sc[bb * D + w * 256 + kb + q] * wv[q];
  }
#pragma unroll
  for (int bb = 0; bb <= NB; ++bb) red[(w * 9 + bb) * 64 + lane] = a[bb];
  __syncthreads();
  for (int i = tid; i < 9 * 64; i += 256) {
    const int bb = i >> 6, jj = i & 63;
    const int col = (item % (6 * D / 64)) * 64 + jj;
    const float sum = ((red[(0 * 9 + bb) * 64 + jj] + red[(1 * 9 + bb) * 64 + jj]) + (red[(2 * 9 + bb) * 64 + jj] + red[(3 * 9 + bb) * 64 + jj]));
    p.mod[((long)l * (NB + 1) + bb) * 6 * D + col] = sum + p.b_ada[l * 6 * D + col];
  }
  __syncthreads();
}

__device__ __forceinline__ void phase_gla_decay(const Params& p) {
  const int t = threadIdx.x;
  if (t >= 192) return;
  const int dir = t / 96, cg = t % 96;
  float gw[16][4], gb[4];
#pragma unroll
  for (int r = 0; r < 16; ++r) {
    const float4 v = *reinterpret_cast<const float4*>(p.gla_gate_w + ((long)dir * 16 + r) * 384 + cg * 4);
    gw[r][0] = v.x; gw[r][1] = v.y; gw[r][2] = v.z; gw[r][3] = v.w;
  }
  {
    const float4 v = *reinterpret_cast<const float4*>(p.gla_gate_b + dir * 384 + cg * 4);
    gb[0] = v.x; gb[1] = v.y; gb[2] = v.z; gb[3] = v.w;
  }
  for (long row0 = (long)blockIdx.x * 4; row0 < NR; row0 += (long)gridDim.x * 4) {
    uint4 ra[4], rb[4];
#pragma unroll
    for (int q = 0; q < 4; ++q) {
      const uint4* rp = reinterpret_cast<const uint4*>(p.P + (row0 + q) * PW + O_RF + dir * 16);
      ra[q] = rp[0]; rb[q] = rp[1];
    }
#pragma unroll
    for (int q = 0; q < 4; ++q) {
      const unsigned rw[8] = {ra[q].x, ra[q].y, ra[q].z, ra[q].w, rb[q].x, rb[q].y, rb[q].z, rb[q].w};
      float z[4] = {gb[0], gb[1], gb[2], gb[3]};
#pragma unroll
      for (int r2 = 0; r2 < 8; ++r2) {
        const float x0 = bf_lo(rw[r2]), x1 = bf_hi(rw[r2]);
#pragma unroll
        for (int c = 0; c < 4; ++c) z[c] += x0 * gw[2 * r2][c] + x1 * gw[2 * r2 + 1][c];
      }
      float o[4];
#pragma unroll
      for (int c = 0; c < 4; ++c) o[c] = (fminf(z[c], 0.f) - __logf(1.0f + __expf(-fabsf(z[c])))) * (1.0f / 16.0f);
      *reinterpret_cast<uint2*>(p.LF + ((long)dir * NR + row0 + q) * 384 + cg * 4) = make_uint2(pack2(o[0], o[1]), pack2(o[2], o[3]));
    }
  }
}

__device__ __forceinline__ void phase_hgrn_gate(const Params& p, long gtid, long gstride) {
  for (long i = gtid; i < (long)NR * 1024; i += gstride) {
    const int col = (int)(i & 1023);
    const long row = i >> 10;
    act_t* z = p.P + row * PW + E_FF + col;
    const float lb = p.lbt[col];
    const float f = lb + (1.0f - lb) * sigmoidf_(ldA(z));
    stA(z, __logf(f));
  }
}

template <int MODE>
__device__ __forceinline__ void phase_scan(const Params& p, unsigned char* smem, int blk, int nblk) {
  constexpr int DK = MODE == 0 ? 128 : 96, DV = MODE == 0 ? 128 : 192, DVS = DV / 4, NET = DVS / 16, NKS = DK / 32,
                NDT = DK / 16;
  constexpr int QS = DK + 8, LS = 72, SS = DK + 8;
  act_t* Qa = (act_t*)smem;
  act_t* Ka = Qa + 64 * QS;
  act_t* KaT = Ka + 64 * QS;
  act_t* VT = KaT + DK * LS;
  act_t* ST = VT + DVS * LS;
  float* tot = (float*)(ST + DVS * SS);
  float* lf32 = tot + 2 * 4 * DK;
  const int tid = threadIdx.x, w = __builtin_amdgcn_readfirstlane(threadIdx.x >> 6), lane = tid & 63, fr = lane & 15, g = lane >> 4;
  const int dp = lane, c0 = 2 * dp;
  const bool cact = dp < DK / 2;
  constexpr int NCH = (C + T) / 64, NCC = C / 64;
  constexpr int NVI = DVS / 8 * 64;
  for (int item = blk; item < NB * 4 * 2 * 4; item += nblk) {
    const int sl = item & 3, dir = (item >> 2) & 1, h = (item >> 3) & 3, b = item >> 5;
    act_t* OD = dir == 0 ? p.OF : p.OB;
    const unsigned loff = (unsigned)min(c0, DK - 2) * 2u;
    const int vcol = (MODE == 0 ? E_HI + h * 128 : O_V + h * 192) + sl * DVS;
    const int ocol = h * DV + sl * DVS;
    auto chunk_base = [&](int n) -> long {
      if (n < NCC) return (long)b * C + (dir ? NCC - 1 - n : n) * 64;
      const int ln = n - NCC;
      return (long)NC + (long)b * T + (dir ? T / 64 - 1 - ln : ln) * 64;
    };
    auto lrow = [&](long base, int l) -> long { return base + (dir ? 63 - l : l); };
    f32x4 S[NET][2];
#pragma unroll
    for (int et = 0; et < NET; ++et) { S[et][0] = f32x4{0.f, 0.f, 0.f, 0.f}; S[et][1] = f32x4{0.f, 0.f, 0.f, 0.f}; }
    unsigned rlf[16], rq[16], rk[16];
    uint4 rv[2];
    const long rstep = dir ? -(long)PW * 2 : (long)PW * 2;
    const long lstep = dir ? -(long)384 * 2 : (long)384 * 2;
    const unsigned off_lf = (MODE == 0 ? (unsigned)(E_FF + dir * 512 + h * 128) * 2u : 0u) + loff;
    const unsigned off_q = (unsigned)(MODE == 0 ? E_HQ + h * 128 : O_Q + h * 96) * 2u + loff;
    const unsigned off_k = (unsigned)(O_K + h * 96) * 2u + loff;
    auto issue_loads = [&](int n) {
      const long base = chunk_base(n);
      {
        const char* prow = (const char*)(p.P + lrow(base, w * 16) * PW);
        const char* plf = (const char*)(p.LF + ((long)dir * NR + lrow(base, w * 16)) * 384 + h * 96);
#pragma unroll
        for (int i = 0; i < 16; ++i) {
          if (MODE == 0) {
            rlf[i] = *reinterpret_cast<const unsigned*>(prow + off_lf);
          } else {
            rlf[i] = *reinterpret_cast<const unsigned*>(plf + loff);
            rk[i] = *reinterpret_cast<const unsigned*>(prow + off_k);
            plf += lstep;
          }
          rq[i] = *reinterpret_cast<const unsigned*>(prow + off_q);
          prow += rstep;
        }
      }
#pragma unroll
      for (int r = 0; r < (NVI + 255) / 256; ++r) {
        const int it = min(tid + r * 256, NVI - 1);
        const int l = it / (DVS / 8), e8 = (it % (DVS / 8)) * 8;
        rv[r] = *reinterpret_cast<const uint4*>(p.P + lrow(base, l) * PW + vcol + e8);
      }
    };
    issue_loads(0);
    for (int n = 0; n < NCH; ++n) {
      const int par = n & 1;
      float* totp = tot + par * 4 * DK;
      float* lfp = lf32 + par * DK;
      const long base = chunk_base(n);
      if (cact) {
        float r0 = 0.f, r1 = 0.f;
#pragma unroll
        for (int i = 0; i < 16; ++i) { r0 += bf_lo(rlf[i]); r1 += bf_hi(rlf[i]); }
        totp[w * DK + c0] = r0; totp[w * DK + c0 + 1] = r1;
        if (w == 2) { lfp[c0] = bf_lo(rlf[0]); lfp[c0 + 1] = bf_hi(rlf[0]); }
      }
      __syncthreads();
#pragma unroll
      for (int r = 0; r < (NVI + 255) / 256; ++r) {
        const int it = tid + r * 256;
        if (it < NVI) {
          const int l = it / (DVS / 8), e8 = (it % (DVS / 8)) * 8;
          const unsigned vw[4] = {rv[r].x, rv[r].y, rv[r].z, rv[r].w};
#pragma unroll
          for (int e = 0; e < 4; ++e) {
            VT[(e8 + 2 * e) * LS + l] = (act_t)(vw[e] & 0xffffu);
            VT[(e8 + 2 * e + 1) * LS + l] = (act_t)(vw[e] >> 16);
          }
        }
      }
      if (cact) {
        float of0 = 0.f, of1 = 0.f;
#pragma unroll
        for (int sgi = 0; sgi < 3; ++sgi)
          if (sgi < w) { of0 += totp[sgi * DK + c0]; of1 += totp[sgi * DK + c0 + 1]; }
        const float ref0 = totp[c0] + totp[DK + c0] + lfp[c0];
        const float ref1 = totp[c0 + 1] + totp[DK + c0 + 1] + lfp[c0 + 1];
        unsigned kt0[8], kt1[8];
        float run0 = of0 - ref0, run1 = of1 - ref1;
#pragma unroll
        for (int i = 0; i < 16; i += 2) {
          float ka0[2], ka1[2];
#pragma unroll
          for (int ii = 0; ii < 2; ++ii) {
            const int i2 = i + ii;
            run0 += bf_lo(rlf[i2]); run1 += bf_hi(rlf[i2]);
            const float b0 = run0, b1 = run1;
            const float e0 = __expf(b0), e1 = __expf(b1), f0 = __expf(-b0), f1 = __expf(-b1);
            float k0, k1;
            if (MODE == 0) { k0 = 1.0f - __expf(bf_lo(rlf[i2])); k1 = 1.0f - __expf(bf_hi(rlf[i2])); }
            else { k0 = bf_lo(rk[i2]); k1 = bf_hi(rk[i2]); }
            ka0[ii] = k0 * f0; ka1[ii] = k1 * f1;
            const int l = w * 16 + i2;
            *reinterpret_cast<unsigned*>(Qa + l * QS + c0) = pack2(bf_lo(rq[i2]) * e0, bf_hi(rq[i2]) * e1);
            *reinterpret_cast<unsigned*>(Ka + l * QS + c0) = pack2(ka0[ii], ka1[ii]);
          }
          kt0[i >> 1] = pack2(ka0[0], ka0[1]);
          kt1[i >> 1] = pack2(ka1[0], ka1[1]);
        }
        uint4* d0 = reinterpret_cast<uint4*>(KaT + c0 * LS + w * 16);
        d0[0] = make_uint4(kt0[0], kt0[1], kt0[2], kt0[3]); d0[1] = make_uint4(kt0[4], kt0[5], kt0[6], kt0[7]);
        uint4* d1 = reinterpret_cast<uint4*>(KaT + (c0 + 1) * LS + w * 16);
        d1[0] = make_uint4(kt1[0], kt1[1], kt1[2], kt1[3]); d1[1] = make_uint4(kt1[4], kt1[5], kt1[6], kt1[7]);
      }
      issue_loads(min(n + 1, NCH - 1));
      float egv[2], egrv[2];
#pragma unroll
      for (int di = 0; di < 2; ++di) {
        const int dt = w + 4 * di;
        if (dt < NDT) {
          const int d = dt * 16 + fr;
          const float refd = totp[d] + totp[DK + d] + lfp[d];
          const float gd = totp[d] + totp[DK + d] + totp[2 * DK + d] + totp[3 * DK + d];
          const float er = __expf(refd);
          egv[di] = __expf(gd); egrv[di] = __expf(gd - refd);
#pragma unroll
          for (int et = 0; et < NET; ++et)
#pragma unroll
            for (int j = 0; j < 4; ++j) stA(ST + (et * 16 + 4 * g + j) * SS + d, S[et][di][j] * er);
        }
      }
      __syncthreads();
      bf16x8 qfr[NKS];
#pragma unroll
      for (int ks = 0; ks < NKS; ++ks) qfr[ks] = *reinterpret_cast<const bf16x8*>(Qa + (w * 16 + fr) * QS + ks * 32 + g * 8);
      bf16x8 pfr[2];
#pragma unroll
      for (int kb = 0; kb < 2; ++kb) {
        f32x4 at2[2];
#pragma unroll
        for (int h2 = 0; h2 < 2; ++h2) {
          const int mt = 2 * kb + h2;
          at2[h2] = f32x4{0.f, 0.f, 0.f, 0.f};
          if (mt <= w) {
#pragma unroll
            for (int ks = 0; ks < NKS; ++ks) {
              const bf16x8 kaf = *reinterpret_cast<const bf16x8*>(Ka + (mt * 16 + fr) * QS + ks * 32 + g * 8);
              at2[h2] = __builtin_amdgcn_mfma_f32_16x16x32_bf16(kaf, qfr[ks], at2[h2], 0, 0, 0);
            }
            if (mt == w) {
#pragma unroll
              for (int j = 0; j < 4; ++j)
                if (4 * g + j > fr) at2[h2][j] = 0.f;
            }
          }
        }
        union { unsigned u[4]; bf16x8 v; } cv;
        cv.u[0] = pack2_mfma(at2[0][0], at2[0][1]); cv.u[1] = pack2_mfma(at2[0][2], at2[0][3]);
        cv.u[2] = pack2_mfma(at2[1][0], at2[1][1]); cv.u[3] = pack2_mfma(at2[1][2], at2[1][3]);
        pfr[kb] = cv.v;
      }
      const long orow = lrow(base, w * 16 + fr);
#pragma unroll
      for (int et = 0; et < NET; ++et) {
        f32x4 o = f32x4{0.f, 0.f, 0.f, 0.f};
#pragma unroll
        for (int kb = 0; kb < 2; ++kb) {
          if (2 * kb <= w) {
            union { uint2 h2[2]; bf16x8 v; } vf;
            vf.h2[0] = *reinterpret_cast<const uint2*>(VT + (et * 16 + fr) * LS + kb * 32 + 4 * g);
            vf.h2[1] = *reinterpret_cast<const uint2*>(VT + (et * 16 + fr) * LS + kb * 32 + 16 + 4 * g);
            o = __builtin_amdgcn_mfma_f32_16x16x32_bf16(vf.v, pfr[kb], o, 0, 0, 0);
          }
        }
#pragma unroll
        for (int ks = 0; ks < NKS; ++ks) {
          const bf16x8 sf = *reinterpret_cast<const bf16x8*>(ST + (et * 16 + fr) * SS + ks * 32 + g * 8);
          o = __builtin_amdgcn_mfma_f32_16x16x32_bf16(sf, qfr[ks], o, 0, 0, 0);
        }
        const float osc = MODE == 0 ? 1.0f : 0.10206207261596575f;
        *reinterpret_cast<uint2*>(OD + orow * 768 + ocol + et * 16 + 4 * g) =
            make_uint2(pack2(o[0] * osc, o[1] * osc), pack2(o[2] * osc, o[3] * osc));
      }
#pragma unroll
      for (int di = 0; di < 2; ++di) {
        const int dt = w + 4 * di;
        if (dt < NDT) {
#pragma unroll
          for (int et = 0; et < NET; ++et) {
            f32x4 r = f32x4{0.f, 0.f, 0.f, 0.f};
#pragma unroll
            for (int k2 = 0; k2 < 2; ++k2) {
              const bf16x8 vf = *reinterpret_cast<const bf16x8*>(VT + (et * 16 + fr) * LS + k2 * 32 + g * 8);
              const bf16x8 kf = *reinterpret_cast<const bf16x8*>(KaT + (dt * 16 + fr) * LS + k2 * 32 + g * 8);
              r = __builtin_amdgcn_mfma_f32_16x16x32_bf16(vf, kf, r, 0, 0, 0);
            }
#pragma unroll
            for (int j = 0; j < 4; ++j) S[et][di][j] = egv[di] * S[et][di][j] + egrv[di] * r[j];
          }
        }
      }
    }
    __syncthreads();
  }
}

struct GemmJob {
  const act_t* A; const act_t* Bt; act_t* C;
  long sA, sB, sC;
  int nbatch, Mtiles, Ntiles, K, ldc, Nvalid, mode;
  float scale;
  int fp8;
};
__device__ __forceinline__ void phase_gemm(const Params& p, const GemmJob& g, unsigned char* smem, int blk = blockIdx.x, int nblk = gridDim.x) {
  const int per_b = g.Mtiles * g.Ntiles;
  const int ntiles = per_b * g.nbatch;
  for (int tile = blk; tile < ntiles; tile += nblk) {
    const int b = tile / per_b, tt = tile % per_b;
    const int tm = tt / g.Ntiles, tn = tt % g.Ntiles;
    if (g.mode == 1 && tm < NC / 128 && tn * 128 >= O_FA) continue;
    const int K = g.K, ldc = g.ldc;
    const act_t* Ab = g.A + b * g.sA + (long)tm * 128 * K;
    act_t* Cb = g.C + b * g.sC + (long)tm * 128 * ldc + tn * 128;
    const int nlim = g.Nvalid - tn * 128;
    const float scale = g.scale;
    const int mode = g.mode;
    if (mode == 1) {
      auto epi1 = [&](f32x4 (&acc)[4][4], int wr, int wc, int fr, int fq) {
                  if (g.fp8) {
#pragma unroll
                    for (int m = 0; m < 4; ++m)
#pragma unroll
                      for (int n = 0; n < 4; ++n) acc[m][n] = acc[m][n] * scale;
                  }
#pragma unroll
                  for (int m = 0; m < 4; ++m)
#pragma unroll
                    for (int n = 0; n < 4; ++n) {
                      const int col = wc * 64 + n * 16 + fr;
                      if (col < nlim) {
#pragma unroll
                        for (int j = 0; j < 4; ++j) {
                          const int row = wr * 64 + m * 16 + fq * 4 + j;
                          stA(Cb + (long)row * ldc + col, acc[m][n][j]);
                        }
                      } else {
                        const int gc = tn * 128 + col;
                        if (gc < O_END && tm >= NC / 128) {
                          const int lr = (tm - NC / 128) * 128 + wr * 64 + m * 16 + fq * 4;
                          const int bb = lr / T, t = lr % T;
                          const int cq = gc < O_FB ? gc - O_FA : gc - O_FB;
                          act_t* dst = p.FT + ((long)bb * 256 + cq) * (2 * T) + (gc < O_FB ? 0 : T) + t;
                          *reinterpret_cast<uint2*>(dst) = make_uint2(pack2(acc[m][n][0], acc[m][n][1]), pack2(acc[m][n][2], acc[m][n][3]));
                        }
                      }
                    }
                };
      if (g.fp8) {
        const fp8_t* A8 = (const fp8_t*)g.A + (long)tm * 128 * K;
        gemm_tile8<false>([&](int r) { return A8 + (long)r * K; }, (const fp8_t*)g.Bt + (long)tn * 128 * K, K, smem, epi1);
      } else {
        gemm_tile<false>([&](int r) { return Ab + (long)r * K; }, g.Bt + b * g.sB + (long)tn * 128 * K, K, smem, epi1);
      }
    } else {
      auto epi2 = [&](f32x4 (&acc)[4][4], int wr, int wc, int fr, int fq) {
                  const float oscale = g.fp8 ? 1.0f : scale;
                  if (g.fp8) {
#pragma unroll
                    for (int m = 0; m < 4; ++m)
#pragma unroll
                      for (int n = 0; n < 4; ++n) acc[m][n] = acc[m][n] * scale;
                  }
                  if (mode == 2) {
                    const int cb = tn * 128 + wc * 64;
                    if (cb < E_AV && tm >= NC / 128) {
                      const float4* rt = reinterpret_cast<const float4*>(p.ropetab);
#pragma unroll
                      for (int m = 0; m < 4; ++m) {
                        const int t = ((tm - NC / 128) * 128 + wr * 64 + m * 16 + fr) % T;
                        const float4 r01 = rt[(t / GRID_W) * 8 + fq * 2], r23 = rt[(t / GRID_W) * 8 + fq * 2 + 1];
                        const float4 c01 = rt[(t % GRID_W) * 8 + fq * 2], c23 = rt[(t % GRID_W) * 8 + fq * 2 + 1];
                        const float rc[4] = {r01.x, r01.z, r23.x, r23.z}, rs_[4] = {r01.y, r01.w, r23.y, r23.w};
                        const float cc[4] = {c01.x, c01.z, c23.x, c23.z}, cs_[4] = {c01.y, c01.w, c23.y, c23.w};
#pragma unroll
                        for (int j = 0; j < 4; ++j) {
                          const float a1 = acc[m][0][j], a2 = acc[m][1][j], b1 = acc[m][2][j], b2 = acc[m][3][j];
                          acc[m][0][j] = a1 * rc[j] - a2 * rs_[j]; acc[m][1][j] = a1 * rs_[j] + a2 * rc[j];
                          acc[m][2][j] = b1 * cc[j] - b2 * cs_[j]; acc[m][3][j] = b1 * cs_[j] + b2 * cc[j];
                        }
                      }
                    } else if (cb >= E_FF && cb < E_HQ) {
#pragma unroll
                      for (int n = 0; n < 4; ++n) {
                        const float4 lb4 = *reinterpret_cast<const float4*>(p.lbt + cb - E_FF + n * 16 + fq * 4);
                        const float lb[4] = {lb4.x, lb4.y, lb4.z, lb4.w};
#pragma unroll
                        for (int m = 0; m < 4; ++m)
#pragma unroll
                          for (int j = 0; j < 4; ++j)
                            acc[m][n][j] = __logf(lb[j] + (1.0f - lb[j]) / (1.0f + __expf(-acc[m][n][j])));
                      }
                    }
                  }
#pragma unroll
                  for (int m = 0; m < 4; ++m) {
                    const int row = wr * 64 + m * 16 + fr;
#pragma unroll
                    for (int n = 0; n < 4; ++n) {
                      const int col = wc * 64 + n * 16 + fq * 4;
                      if (col < nlim)
                        *reinterpret_cast<uint2*>(Cb + (long)row * ldc + col) =
                            make_uint2(pack2(acc[m][n][0] * oscale, acc[m][n][1] * oscale), pack2(acc[m][n][2] * oscale, acc[m][n][3] * oscale));
                    }
                  }
                };
      if (g.fp8) {
        const fp8_t* A8 = (const fp8_t*)g.A + (long)tm * 128 * K;
        gemm_tile8<true>([&](int r) { return A8 + (long)r * K; }, (const fp8_t*)g.Bt + (long)tn * 128 * K, K, smem, epi2);
      } else {
        gemm_tile<true>([&](int r) { return Ab + (long)r * K; }, g.Bt + b * g.sB + (long)tn * 128 * K, K, smem, epi2);
      }
    }
  }
}

template <class RowMap>
__device__ __forceinline__ void conv_tile_rm(const float* src, int lds_, int Nvalid, int k0, int n0, act_t* dst, int ldd, float* tile, RowMap rm) {
  const int tid = threadIdx.x;
  {
    const int r = tid >> 5, c4 = (tid & 31) * 4;
    float4 v[8];
#pragma unroll
    for (int rr = 0; rr < 8; ++rr) {
      v[rr] = make_float4(0.f, 0.f, 0.f, 0.f);
      if (n0 + c4 < Nvalid) v[rr] = *reinterpret_cast<const float4*>(src + (long)(k0 + r + rr * 8) * lds_ + n0 + c4);
    }
#pragma unroll
    for (int rr = 0; rr < 8; ++rr) {
      float* t = tile + (r + rr * 8) * 129 + c4;
      t[0] = v[rr].x; t[1] = v[rr].y; t[2] = v[rr].z; t[3] = v[rr].w;
    }
  }
  __syncthreads();
  {
    const int n = tid >> 1, ks = (tid & 1) * 32;
    if (n0 + n < Nvalid) {
      unsigned w[16];
#pragma unroll
      for (int i = 0; i < 16; ++i) w[i] = pack2(tile[(ks + 2 * i) * 129 + n], tile[(ks + 2 * i + 1) * 129 + n]);
      uint4* d = reinterpret_cast<uint4*>(dst + (long)rm(n) * ldd + k0 + ks);
      d[0] = make_uint4(w[0], w[1], w[2], w[3]);
      d[1] = make_uint4(w[4], w[5], w[6], w[7]);
      d[2] = make_uint4(w[8], w[9], w[10], w[11]);
      d[3] = make_uint4(w[12], w[13], w[14], w[15]);
    }
  }
  __syncthreads();
}

template <class RowMap>
__device__ __forceinline__ void conv_tile8_rm(const float* src, int lds_, int k0, int n0, fp8_t* dst, int ldd, float* tile, float scale, RowMap rm, int Nvalid = 1 << 30) {
  const int tid = threadIdx.x;
  {
    const int r = tid >> 5, c4 = (tid & 31) * 4;
    float4 v[8];
#pragma unroll
    for (int rr = 0; rr < 8; ++rr) {
      v[rr] = make_float4(0.f, 0.f, 0.f, 0.f);
      if (n0 + c4 < Nvalid) v[rr] = *reinterpret_cast<const float4*>(src + (long)(k0 + r + rr * 8) * lds_ + n0 + c4);
    }
#pragma unroll
    for (int rr = 0; rr < 8; ++rr) {
      float* t = tile + (r + rr * 8) * 129 + c4;
      t[0] = v[rr].x; t[1] = v[rr].y; t[2] = v[rr].z; t[3] = v[rr].w;
    }
  }
  __syncthreads();
  if ((threadIdx.x >> 1) + n0 < Nvalid) {
    const int n = tid >> 1, ks = (tid & 1) * 32;
    unsigned w[8];
#pragma unroll
    for (int i = 0; i < 8; ++i)
      w[i] = pack4_fp8(tile[(ks + 4 * i) * 129 + n] * scale, tile[(ks + 4 * i + 1) * 129 + n] * scale,
                       tile[(ks + 4 * i + 2) * 129 + n] * scale, tile[(ks + 4 * i + 3) * 129 + n] * scale);
    uint4* d = reinterpret_cast<uint4*>(dst + (long)rm(n) * ldd + k0 + ks);
    d[0] = make_uint4(w[0], w[1], w[2], w[3]);
    d[1] = make_uint4(w[4], w[5], w[6], w[7]);
  }
  __syncthreads();
}

__device__ __forceinline__ void conv_tile(const float* src, int lds_, int Nvalid, int k0, int n0, act_t* dst, int ldd, float* tile) {
  conv_tile_rm(src, lds_, Nvalid, k0, n0, dst, ldd, tile, [=](int n) { return n0 + n; });
}

__device__ __forceinline__ void phase_convert_experts(const Params& p, int l, unsigned char* smem, int blk, int nblk) {
  float* tile = (float*)smem;
  const int per_e = 192;
  fp8_t* Wup = l == 0 ? p.W8up : p.W8up1;
  fp8_t* Wdn = l == 0 ? p.W8down : p.W8down1;
  for (int job = blk; job < NEXP * per_e; job += nblk) {
    const int e = job / per_e, j = job % per_e;
    if (j < 128) {
      const int up = j >> 6, jj = j & 63;
      const int kt = jj >> 2, fp = jj & 3;
      const float* src = (up ? p.w_eu : p.w_eg) + ((long)(l * NEXP + e) * D) * DFF;
      const int rbase = fp * 256 + up * 32;
      conv_tile8_rm(src, DFF, kt * 64, fp * 128, Wup + (long)e * 1024 * D, D, tile, SW8,
                    [=](int n) { return rbase + (n >> 6) * 128 + ((n >> 5) & 1) * 64 + (n & 31); });
    } else {
      const int jj = j - 128;
      const int kt = jj >> 3, nt = jj & 7;
      const float* src = p.w_ed + ((long)(l * NEXP + e) * DFF) * D;
      const int n0 = nt * 128;
      conv_tile8_rm(src, D, kt * 64, n0, Wdn + (long)e * 1024 * DFF, DFF, tile, SW8, [=](int n) { return n0 + n; });
    }
  }
}

__device__ __forceinline__ void phase_moe(const Params& p, int l, bool down, unsigned char* smem) {
  const int* cntp = p.cnt + l * NEXP * 64;
  int total = 0;
  for (int e = 0; e < NEXP; ++e) total += ((cntp[e * 64] + 127) >> 7) * 8;
  for (int tile = blockIdx.x; tile < total; tile += gridDim.x) {
    int e = 0, tb = 0, rowoff = 0;
    for (; e < NEXP - 1; ++e) {
      const int c = cntp[e * 64];
      const int nt = ((c + 127) >> 7) * 8;
      if (tile < tb + nt) break;
      tb += nt; rowoff += c;
    }
    const int c = cntp[e * 64];
    const int lt = tile - tb, mt = lt >> 3, nt = lt & 7;
    const int rows_valid = min(128, c - mt * 128);
    const int* lst = p.list + (long)(l * NEXP + e) * NR + mt * 128;
    const long hrow0 = (long)rowoff + mt * 128;
    if (!down) {
      gemm_tile8<true>([&](int r) { return p.u8 + (long)(lst[min(r, rows_valid - 1)] >> 1) * D; },
                (l == 0 ? p.W8up : p.W8up1) + ((long)e * 1024 + nt * 128) * D, D, smem,
                [&](f32x4 (&acc)[4][4], int wr, int wc, int fr, int fq) {
                  constexpr float dq = 1.0f / (SU8 * SW8);
#pragma unroll
                  for (int m = 0; m < 4; ++m) {
                    const int row = wr * 64 + m * 16 + fr;
                    if (row < rows_valid) {
#pragma unroll
                      for (int n = 0; n < 2; ++n) {
                        float hv[4];
#pragma unroll
                        for (int j = 0; j < 4; ++j) {
                          const float g = acc[m][n][j] * dq, uu = acc[m][n + 2][j] * dq;
                          hv[j] = g / (1.0f + __expf(-g)) * uu * SH8;
                        }
                        *reinterpret_cast<unsigned*>(p.H8 + (hrow0 + row) * DFF + nt * 64 + wc * 32 + n * 16 + fq * 4) =
                            pack4_fp8(hv[0], hv[1], hv[2], hv[3]);
                      }
                    }
                  }
                });
    } else {
      const fp8_t* Ab = p.H8 + hrow0 * DFF;
      gemm_tile8<true>([&](int r) { return Ab + (long)r * DFF; }, (l == 0 ? p.W8down : p.W8down1) + ((long)e * 1024 + nt * 128) * DFF, DFF, smem,
                [&](f32x4 (&acc)[4][4], int wr, int wc, int fr, int fq) {
                  constexpr float dq = 1.0f / (SH8 * SW8);
#pragma unroll
                  for (int m = 0; m < 4; ++m) {
                    const int row = wr * 64 + m * 16 + fr;
                    if (row < rows_valid) {
                      const int ts = lst[row];
                      const float w = p.ew[ts] * dq;
#pragma unroll
                      for (int n = 0; n < 4; ++n)
                        *reinterpret_cast<uint2*>(p.Y + (long)ts * D + nt * 128 + wc * 64 + n * 16 + fq * 4) =
                            make_uint2(pack2(acc[m][n][0] * w, acc[m][n][1] * w), pack2(acc[m][n][2] * w, acc[m][n][3] * w));
                    }
                  }
                });
    }
  }
}

__device__ __forceinline__ void phase_convert_dense(const Params& p, unsigned char* smem) {
  float* tile = (float*)smem;
  const int JM = MOD_ITEMS, J0 = JM + 16 * 26, J1 = J0 + 128, J2 = J1 + 16 * 19, J3 = J2 + 128;
  for (int job = blockIdx.x; job < J3; job += gridDim.x) {
    if (job < JM) { mod_item(p, job, smem); continue; }
    if (job < J0) { int j = job - JM; const int n0 = (j % 26) * 128; conv_tile8_rm(p.w_in_even, IN_EVEN, (j / 26) * 64, n0, p.W8in_even, D, tile, SW8, [=](int n) { return n0 + n; }); }
    else if (job < J1) { int j = job - J0; conv_tile(p.w_out_even, D, D, (j / 8) * 64, (j % 8) * 128, p.Wt_out_even, D, tile); }
    else if (job < J2) { int j = job - J1; const int n0 = (j % 19) * 128; conv_tile8_rm(p.w_in_odd, IN_ODD, (j / 19) * 64, n0, p.W8in_odd, D, tile, SW8, [=](int n) { return n0 + n; }, O_FA); }
    else { int j = job - J2; conv_tile(p.w_out_odd, D, D, (j / 8) * 64, (j % 8) * 128, p.Wt_out_odd, D, tile); }
  }
}

__device__ __forceinline__ void phase_fold_z(const Params& p, long gtid, long gstride, float* tab) {
  if (threadIdx.x < 64) {
    float sn, cs;
    sincospif((float)threadIdx.x * (1.0f / 32.0f), &sn, &cs);
    tab[threadIdx.x] = cs; tab[64 + threadIdx.x] = -sn;
  }
  __syncthreads();
  for (long i = gtid; i < (long)512 * D; i += gstride) {
    const int k = (int)(i % D), np = (int)(i / D);
    const int part = np >> 8, col = np & 255, g = col >> 6, cp = col & 63;
    const float* wz = p.w_in_odd + (long)k * IN_ODD + O_Z + g * 64;
    float s = 0.f;
    const float* tb = tab + part * 64;
#pragma unroll 8
    for (int c = 0; c < 64; ++c) s += wz[c] * tb[(c * cp) & 63];
    const unsigned q = pack4_fp8(s * SW8, 0.f, 0.f, 0.f);
    p.W8in_odd[(long)(O_FA + np) * D + k] = (unsigned char)(q & 0xffu);
  }
  for (long i = gtid; i < (long)(IN_ODD_PAD - O_END) * D; i += gstride) p.W8in_odd[(long)O_END * D + i] = 0;
}

__device__ __forceinline__ void phase_cmat(const Params& p, long gtid, long gstride) {
  for (long i = gtid; i < (long)T * T; i += gstride) {
    const int t = (int)(i % T), tp = (int)(i / T);
    float sn, cs;
    sincospif((float)((t * tp) & (T - 1)) * (2.0f / T), &sn, &cs);
    stA(p.Cmat + (long)tp * 2 * T + t, cs);
    stA(p.Cmat + (long)tp * 2 * T + T + t, sn);
  }
}

__device__ __forceinline__ void row_stats(const float4 (&v)[4], float& mu, float& rs) {
  float s = 0.f;
#pragma unroll
  for (int i = 0; i < 4; ++i) s += v[i].x + v[i].y + v[i].z + v[i].w;
  mu = wave_sum(s) * (1.0f / D);
  float q = 0.f;
#pragma unroll
  for (int i = 0; i < 4; ++i) {
    float a = v[i].x - mu, b = v[i].y - mu, c = v[i].z - mu, d = v[i].w - mu;
    q += a * a + b * b + c * c + d * d;
  }
  rs = 1.0f / sqrtf(wave_sum(q) * (1.0f / D) + LN_EPS);
}

__device__ __forceinline__ void phase_lnmod_first(const Params& p) {
  const int lane = threadIdx.x & 63;
  const long w0 = (long)blockIdx.x * 4 + (threadIdx.x >> 6), wstride = (long)gridDim.x * 4;
  for (long row = w0; row < NR; row += wstride) {
    const float4* h = reinterpret_cast<const float4*>(hrow_in(p, row));
    const float* md = modrow(p, 0, row);
    float4 v[4];
#pragma unroll
    for (int i = 0; i < 4; ++i) v[i] = h[i * 64 + lane];
    float mu, rs;
    row_stats(v, mu, rs);
#pragma unroll
    for (int i = 0; i < 4; ++i) {
      const float4 sh = reinterpret_cast<const float4*>(md)[i * 64 + lane];
      const float4 sc = reinterpret_cast<const float4*>(md + D)[i * 64 + lane];
      float a = (v[i].x - mu) * rs * (1.f + sc.x) + sh.x, b = (v[i].y - mu) * rs * (1.f + sc.y) + sh.y;
      float c = (v[i].z - mu) * rs * (1.f + sc.z) + sh.z, d = (v[i].w - mu) * rs * (1.f + sc.w) + sh.w;
      reinterpret_cast<unsigned*>(p.u8 + row * D)[i * 64 + lane] = pack4_fp8(a * SU8, b * SU8, c * SU8, d * SU8);
    }
  }
}

template <int R_UNUSED>
__device__ __forceinline__ void phase_resid_ln(const Params& p, int l, int sub, long row_lo, long row_hi, unsigned char* smem) {
  const int lane = threadIdx.x & 63;
  int* cntL = (int*)smem;
  int* nent = cntL + 16;
  int* entL = cntL + 32;
  float* wT = (float*)(smem + 4096);
  if (sub == 0) {
    if (threadIdx.x < 32) cntL[threadIdx.x] = 0;
    for (int i = threadIdx.x; i < D * NEXP; i += 256) wT[(i & 15) * D + (i >> 4)] = p.w_router[i];
    __syncthreads();
  }
  const bool last = (sub == 1 && l == 1);
  const long nw = (long)gridDim.x * 4, wi = (long)blockIdx.x * 4 + (threadIdx.x >> 6);
  const long rpw = (row_hi - row_lo + nw - 1) / nw;
  const long r0 = row_lo + wi * rpw, r1 = min(row_hi, r0 + rpw);
  const float4* lgp = reinterpret_cast<const float4*>(p.ln_g + (l * 2 + sub) * D);
  const float4* lbp = reinterpret_cast<const float4*>(p.ln_b + (l * 2 + sub) * D);
  float4 lgv[4], lbv[4];
  if (R_UNUSED != 1) {
#pragma unroll
    for (int i = 0; i < 4; ++i) { lgv[i] = lgp[i * 64 + lane]; lbv[i] = lbp[i * 64 + lane]; }
  }
  float4 gv[4], shv[4], scv[4];
  int cur_bb = -2;
  float4 hv[4];
  uint2 mv[4], m2v[4];
  auto load_row = [&](long row) {
    const float4* hin = reinterpret_cast<const float4*>((l == 0 && sub == 0) ? hrow_in(p, row) : hrow(p, row));
    const uint2* m = reinterpret_cast<const uint2*>(sub == 0 ? p.M + row * D : p.Y + row * 2 * D);
#pragma unroll
    for (int i = 0; i < 4; ++i) {
      hv[i] = hin[i * 64 + lane];
      mv[i] = m[i * 64 + lane];
      if (sub == 1) m2v[i] = m[256 + i * 64 + lane];
    }
  };
  if (r0 < r1) load_row(r0);
  for (long row = r0; row < r1; ++row) {
    const int bb = row < NC ? NB : (int)((row - NC) / T);
    if (bb != cur_bb) {
      cur_bb = bb;
      const float* md = p.mod + ((long)l * (NB + 1) + bb) * 6 * D;
      const float* md2 = (sub == 0) ? md + 3 * D : p.mod + ((long)(NB + 1) + bb) * 6 * D;
#pragma unroll
      for (int i = 0; i < 4; ++i) {
        gv[i] = reinterpret_cast<const float4*>(md + (sub == 0 ? 2 : 5) * D)[i * 64 + lane];
        shv[i] = reinterpret_cast<const float4*>(md2)[i * 64 + lane];
        scv[i] = reinterpret_cast<const float4*>(md2 + D)[i * 64 + lane];
      }
    }
    float4 v[4];
#pragma unroll
    for (int i = 0; i < 4; ++i) {
      float m0 = bf_lo(mv[i].x), m1 = bf_hi(mv[i].x), m2_ = bf_lo(mv[i].y), m3 = bf_hi(mv[i].y);
      if (sub == 1) { m0 += bf_lo(m2v[i].x); m1 += bf_hi(m2v[i].x); m2_ += bf_lo(m2v[i].y); m3 += bf_hi(m2v[i].y); }
      v[i].x = ALPHA * hv[i].x + gv[i].x * m0;
      v[i].y = ALPHA * hv[i].y + gv[i].y * m1;
      v[i].z = ALPHA * hv[i].z + gv[i].z * m2_;
      v[i].w = ALPHA * hv[i].w + gv[i].w * m3;
    }
    load_row(min(row + 1, r1 - 1));
    if (R_UNUSED == 1) {
#pragma unroll
      for (int i = 0; i < 4; ++i) { lgv[i] = lgp[i * 64 + lane]; lbv[i] = lbp[i * 64 + lane]; }
    }
    float mu, rs;
    row_stats(v, mu, rs);
#pragma unroll
    for (int i = 0; i < 4; ++i) {
      v[i].x = (v[i].x - mu) * rs * lgv[i].x + lbv[i].x;
      v[i].y = (v[i].y - mu) * rs * lgv[i].y + lbv[i].y;
      v[i].z = (v[i].z - mu) * rs * lgv[i].z + lbv[i].z;
      v[i].w = (v[i].w - mu) * rs * lgv[i].w + lbv[i].w;
    }
    float4* hout = reinterpret_cast<float4*>(hrow(p, row));
    if (last) {
#pragma unroll
      for (int i = 0; i < 4; ++i) hout[i * 64 + lane] = v[i];
      continue;
    }
    row_stats(v, mu, rs);
    float lo[NEXP];
#pragma unroll
    for (int e = 0; e < NEXP; ++e) lo[e] = 0.f;
    uint2 up[4];
#pragma unroll
    for (int i = 0; i < 4; ++i) {
      float uv[4];
      uv[0] = (v[i].x - mu) * rs * (1.f + scv[i].x) + shv[i].x;
      uv[1] = (v[i].y - mu) * rs * (1.f + scv[i].y) + shv[i].y;
      uv[2] = (v[i].z - mu) * rs * (1.f + scv[i].z) + shv[i].z;
      uv[3] = (v[i].w - mu) * rs * (1.f + scv[i].w) + shv[i].w;
      up[i] = make_uint2(pack4_fp8(uv[0] * SU8, uv[1] * SU8, uv[2] * SU8, uv[3] * SU8), 0u);
      if (sub == 0) {
#pragma unroll
        for (int e = 0; e < NEXP; ++e) {
          const float4 w4 = *reinterpret_cast<const float4*>(wT + e * D + (i * 64 + lane) * 4);
          lo[e] += uv[0] * w4.x + uv[1] * w4.y + uv[2] * w4.z + uv[3] * w4.w;
          if ((e & 3) == 3) __builtin_amdgcn_sched_barrier(0);
        }
      }
    }
    int ge1 = 0, ge2 = 0;
    float w1 = 0.f, w2 = 0.f;
    if (sub == 0) {
      float mine = 0.f;
#pragma unroll
      for (int e = 0; e < NEXP; ++e) {
        const float rsum = row_sum16(lo[e]);
        mine = ((lane & 15) == e) ? rsum : mine;
      }
      mine += __shfl_xor(mine, 16);
      mine += __shfl_xor(mine, 32);
#pragma unroll
      for (int e = 0; e < NEXP; ++e) lo[e] = __int_as_float(__builtin_amdgcn_readlane(__float_as_int(mine), e));
      float mx = lo[0];
#pragma unroll
      for (int e = 1; e < NEXP; ++e) mx = fmaxf(mx, lo[e]);
      float sum = 0.f;
#pragma unroll
      for (int e = 0; e < NEXP; ++e) { lo[e] = __expf(lo[e] - mx); sum += lo[e]; }
      const float inv = 1.0f / sum;
      float bestg = -1e30f, gp1 = 0.f, gp2 = 0.f;
#pragma unroll
      for (int gq = 0; gq < 4; ++gq) {
        float s1 = -1e30f, s2 = -1e30f, p1 = 0.f, p2 = 0.f;
        int e1 = 0, e2 = 0;
#pragma unroll
        for (int j = 0; j < 4; ++j) {
          const int e = gq * 4 + j;
          const float pe = lo[e] * inv;
          const float se = pe + p.b_router[e];
          if (se > s1) { s2 = s1; p2 = p1; e2 = e1; s1 = se; p1 = pe; e1 = e; }
          else if (se > s2) { s2 = se; p2 = pe; e2 = e; }
        }
        const float gs = s1 + s2;
        if (gs > bestg) { bestg = gs; ge1 = e1; ge2 = e2; gp1 = p1; gp2 = p2; }
      }
      const float wsum = gp1 + gp2;
      w1 = gp1 / wsum; w2 = gp2 / wsum;
    }
#pragma unroll
    for (int i = 0; i < 4; ++i) hout[i * 64 + lane] = v[i];
#pragma unroll
    for (int i = 0; i < 4; ++i) reinterpret_cast<unsigned*>(p.u8 + row * D)[i * 64 + lane] = up[i].x;
    if (sub == 0 && lane == 0) {
      p.ew[row * 2 + 0] = w1; p.ew[row * 2 + 1] = w2;
      const int lp1 = atomicAdd(cntL + ge1, 1), lp2 = atomicAdd(cntL + ge2, 1);
      const int ei = atomicAdd(nent, 2);
      entL[2 * ei] = ((int)(row * 2) << 4) | ge1; entL[2 * ei + 1] = lp1;
      entL[2 * ei + 2] = ((int)(row * 2 + 1) << 4) | ge2; entL[2 * ei + 3] = lp2;
    }
  }
  if (sub == 0) {
    __syncthreads();
    if (threadIdx.x < NEXP) {
      const int c = cntL[threadIdx.x];
      cntL[threadIdx.x] = c ? atomicAdd(p.cnt + (l * NEXP + threadIdx.x) * 64, c) : 0;
    }
    __syncthreads();
    const int ne = *nent;
    for (int i = threadIdx.x; i < ne; i += 256) {
      const int key = entL[2 * i], lp = entL[2 * i + 1];
      const int e = key & 15;
      p.list[(long)(l * NEXP + e) * NR + cntL[e] + lp] = key >> 4;
    }
    __syncthreads();
  }
}

#define LOOP(n) for (long i = gtid; i < (long)(n); i += gstride)

#ifdef ONLY_PHASE
#define PH(n, ...) if (ONLY_PHASE == n) { __VA_ARGS__ }
#define GSYNC()
#else
#define PH(n, ...) { __VA_ARGS__ }
#define GSYNC() xcd_barrier(xb)
#endif

__global__ void __launch_bounds__(256, 2) mega_kernel(Params p) {
  cg::grid_group grid = cg::this_grid();
  __shared__ __attribute__((aligned(16))) unsigned char smem[SMEM_BYTES + 16];
  if (threadIdx.x == 0) *reinterpret_cast<uint4*>(smem + SMEM_BYTES) = make_uint4(0u, 0u, 0u, 0u);
  __syncthreads();
  XcdBarrier xb = xcd_barrier_post(p.bar, (volatile LAS unsigned*)(smem + SMEM_BYTES));
  const long gtid = (long)blockIdx.x * blockDim.x + threadIdx.x;
  const long gstride = (long)gridDim.x * blockDim.x;
  const int nsb = min(256, (int)gridDim.x / 2);
  PH(0,
    if (gtid < 2 * NEXP) p.cnt[gtid * 64] = 0;
    phase_convert_dense(p, smem);
    phase_fold_z(p, gtid, gstride, (float*)(smem + 65536));
    LOOP(1024) ph_tables(p, i);)
#ifndef ONLY_PHASE
  if (p.use_cg_sync) grid.sync();
#endif
  GSYNC();
  PH(1, phase_lnmod_first(p);)
  GSYNC();
  PH(2, phase_gemm(p, GemmJob{(const act_t*)p.u8, (const act_t*)p.W8in_even, p.P, 0, 0, 0, 1, NR / 128, IN_EVEN / 128, D, PW, IN_EVEN, 2, 1.0f / (SU8 * SW8), 1}, smem);)
  GSYNC();
  PH(3,
    if ((int)blockIdx.x < nsb) phase_scan<0>(p, smem, blockIdx.x, nsb);
    else { phase_attn(p, smem, blockIdx.x - nsb, gridDim.x - nsb); phase_convert_experts(p, 0, smem, blockIdx.x - nsb, gridDim.x - nsb); })
  GSYNC();
  PH(4, phase_combine<0>(p);)
  GSYNC();
  PH(5, phase_gemm(p, GemmJob{p.u, p.Wt_out_even, p.M, 0, 0, 0, 1, NR / 128, D / 128, D, D, D, 0, 1.0f, 0}, smem);)
  GSYNC();
  PH(6, phase_resid_ln<1>(p, 0, 0, 0, NR, smem);)
  GSYNC();
  PH(7, phase_moe(p, 0, false, smem);)
  GSYNC();
  PH(8, phase_moe(p, 0, true, smem);)
  GSYNC();
  PH(9, phase_resid_ln<2>(p, 0, 1, 0, NR, smem); phase_cmat(p, gtid, gstride);)
  GSYNC();
  PH(10, phase_gemm(p, GemmJob{(const act_t*)p.u8, (const act_t*)p.W8in_odd, p.P, 0, 0, 0, 1, NR / 128, IN_ODD_PAD / 128, D, PW, O_FA, 1, 1.0f / (SU8 * SW8), 1}, smem);)
  GSYNC();
  PH(11, phase_gla_decay(p);)
  GSYNC();
  PH(12,
    if ((int)blockIdx.x < nsb) phase_scan<1>(p, smem, blockIdx.x, nsb);
    else {
      phase_gemm(p, GemmJob{p.Cmat, p.FT, p.u + (long)NC * D + 768, 0, (long)256 * 2 * T, (long)T * D, NB, T / 128, 2, 2 * T, D,
                            256, 0, 0.00276213586400995f, 0}, smem, blockIdx.x - nsb, gridDim.x - nsb);
      phase_convert_experts(p, 1, smem, blockIdx.x - nsb, gridDim.x - nsb);
    })
  GSYNC();
  PH(13, phase_combine<1>(p);)
  GSYNC();
  PH(14,
    phase_gemm(p, GemmJob{p.u + (long)NC * D, p.Wt_out_odd, p.M + (long)NC * D, 0, 0, 0, 1, NT / 128, D / 128, D, D, D, 0, 1.0f, 0}, smem);)
  GSYNC();
  PH(15, phase_resid_ln<1>(p, 1, 0, NC, NR, smem);)
  GSYNC();
  PH(16, phase_moe(p, 1, false, smem);)
  GSYNC();
  PH(17, phase_moe(p, 1, true, smem);)
  GSYNC();
  PH(18, phase_resid_ln<2>(p, 1, 1, NC, NR, smem);)
}

static size_t carve(Params& p, char* ws) {
  size_t off = 0;
  auto take = [&](size_t bytes) { char* r = ws + off; off += (bytes + 255) & ~(size_t)255; return r; };
  p.mod = (float*)take(sizeof(float) * 2 * (NB + 1) * 6 * D);
  p.hc = (float*)take(sizeof(float) * (size_t)NC * D);
  p.costab = (float*)take(sizeof(float) * T);
  p.sintab = (float*)take(sizeof(float) * T);
  p.lbt = (float*)take(sizeof(float) * 1024);
  p.ropetab = (float*)take(sizeof(float) * 64 * 16 * 2);
  p.ew = (float*)take(sizeof(float) * (size_t)NR * 2);
  p.eidx = nullptr;
  p.u = (act_t*)take(sizeof(act_t) * (size_t)NR * D);
  p.P = (act_t*)take(sizeof(act_t) * (size_t)NR * PW);
  p.OF = (act_t*)take(sizeof(act_t) * (size_t)NR * 768);
  p.OB = (act_t*)take(sizeof(act_t) * (size_t)NR * 768);
  p.M = p.OF;
  p.Cmat = (act_t*)take(sizeof(act_t) * (size_t)T * 2 * T);
  p.FT = (act_t*)take(sizeof(act_t) * (size_t)NB * 256 * 2 * T);
  p.LF = (act_t*)take(sizeof(act_t) * (size_t)2 * NR * 384);
  p.W8up = (unsigned char*)p.Cmat;
  p.W8down = p.W8up + (size_t)NEXP * 1024 * D;
  p.W8up1 = (unsigned char*)take((size_t)NEXP * 1024 * (D + DFF));
  p.W8down1 = p.W8up1 + (size_t)NEXP * 1024 * D;
  p.u8 = (unsigned char*)take((size_t)NR * D);
  p.Y = p.P;
  p.H8 = (unsigned char*)(p.P + (size_t)2 * NR * D);
  p.bar = (unsigned*)take(sizeof(unsigned) * XCD_BAR_WORDS);
  p.cnt = (int*)take(sizeof(int) * 2 * NEXP * 64);
  p.list = (int*)take(sizeof(int) * (size_t)2 * NEXP * NR);
  p.Wt_in_even = nullptr;
  p.W8in_even = (unsigned char*)take((size_t)IN_EVEN * D);
  p.Wt_out_even = (act_t*)take(sizeof(act_t) * (size_t)D * D);
  p.Wt_in_odd = nullptr;
  p.W8in_odd = (unsigned char*)take((size_t)IN_ODD_PAD * D);
  p.Wt_out_odd = (act_t*)take(sizeof(act_t) * (size_t)D * D);
  return off;
}

static void fill_inputs(Params& p, void* const* d_in) {
  const float** f = (const float**)&p;
  for (int i = 0; i < 23; ++i) f[i] = (const float*)d_in[i];
}

extern "C" void kernel_launch(void* const* d_in, const int* in_sizes, int n_in, void* d_out, int out_size,
                              void* d_ws, size_t ws_size, hipStream_t stream) {
  static int grid_blocks = 0;
  if (!grid_blocks) {
    int dev = 0, cus = 0, per_cu = 0;
    (void)hipGetDevice(&dev);
    (void)hipDeviceGetAttribute(&cus, hipDeviceAttributeMultiprocessorCount, dev);
    (void)hipOccupancyMaxActiveBlocksPerMultiprocessor(&per_cu, mega_kernel, 256, 0);
    grid_blocks = cus * per_cu;
  }
  Params p{};
  fill_inputs(p, d_in);
  p.out = (float*)d_out;
  size_t need = carve(p, (char*)d_ws);
  if (need > ws_size) { fprintf(stderr, "workspace too small: need %zu have %zu\n", need, ws_size); return; }
  (void)hipMemsetAsync(p.bar, 0, sizeof(unsigned) * XCD_BAR_WORDS, stream);
  void* args[] = {&p};
  hipError_t e = hipLaunchCooperativeKernel((void*)mega_kernel, dim3(grid_blocks), dim3(256), args, 0, stream);
  if (e != hipSuccess) fprintf(stderr, "cooperative launch failed: %s (grid %d)\n", hipGetErrorString(e), grid_blocks);
}
#endif
```

```cpp
#ifndef HOST_TEST
#include <hip/hip_runtime.h>
#include <hip/hip_cooperative_groups.h>
#include <cstdio>
namespace cg = cooperative_groups;
#define DEV __device__ __forceinline__
#else
#include <cmath>
#include <cstdio>
#include <cstdlib>
#include <cstring>
#define DEV static inline
#endif

#ifndef T_BATCH
#define T_BATCH 8
#endif
#ifndef T_SEQ
#define T_SEQ 2048
#endif
#ifndef T_CTX
#define T_CTX 256
#endif

constexpr int D = 1024, NB = T_BATCH, T = T_SEQ, C = T_CTX;
constexpr int NC = NB * C, NT = NB * T, NR = NC + NT;
constexpr int GRID_W = 64;
constexpr int IN_EVEN = 3328, IN_ODD = 2592, PW = 3328;
constexpr int NEXP = 16, DFF = 512;
constexpr float ALPHA = 1.4142135623730951f;
constexpr float LN_EPS = 1e-5f;
constexpr int E_AQ = 0, E_AK = 512, E_AV = 640, E_FF = 768, E_HQ = 1792, E_HI = 2304, E_HG = 2816;
constexpr int O_Q = 0, O_K = 384, O_V = 768, O_RF = 1536, O_G = 1568, O_Z = 2336;

#ifdef HOST_TEST
typedef float act_t;
DEV float ldA(const act_t* p) { return *p; }
DEV void stA(act_t* p, float v) { *p = v; }
#else
typedef unsigned short act_t;
DEV float ldA(const act_t* p) { return __uint_as_float(((unsigned)*p) << 16); }
DEV void stA(act_t* p, float v) {
  unsigned u = __float_as_uint(v);
  u += 0x7fffu + ((u >> 16) & 1u);
  *p = (unsigned short)(u >> 16);
}
#endif

struct Params {
  const float *x, *c, *ctx, *c_ctx, *w_ada, *b_ada, *ln_g, *ln_b, *w_in_even, *attn_sink, *lb_logits, *hgrn_norm,
      *w_out_even, *w_in_odd, *gla_gate_w, *gla_gate_b, *gla_norm, *w_out_odd, *w_router, *b_router, *w_eg, *w_eu,
      *w_ed;
  float* out;
  float *mod, *hc, *costab, *sintab, *lbt, *ew, *ropetab;
  int* eidx;
  act_t *u, *P, *OF, *OB, *M, *LF;
  act_t *Wt_in_even, *Wt_out_even, *Wt_in_odd, *Wt_out_odd;
  act_t *Y, *Cmat, *FT;
  unsigned char *W8up, *W8down, *W8up1, *W8down1, *H8, *u8;
  unsigned char *W8in_even, *W8in_odd;
  int *cnt, *list;
  unsigned* bar;
  int use_cg_sync;
  int pad_;
};

DEV float sigmoidf_(float v) { return 1.0f / (1.0f + expf(-v)); }
DEV float siluf_(float v) { return v / (1.0f + expf(-v)); }

DEV const float* hrow_in(const Params& p, long row) {
  return row < NC ? p.ctx + row * D : p.x + (row - NC) * D;
}
DEV float* hrow(const Params& p, long row) { return row < NC ? p.hc + row * D : p.out + (row - NC) * D; }
DEV const float* modrow(const Params& p, int l, long row) {
  int bb = row < NC ? NB : (int)((row - NC) / T);
  return p.mod + ((long)l * (NB + 1) + bb) * 6 * D;
}

DEV void ph_mod(const Params& p, long i) {
  int j = (int)(i % (6 * D));
  int bb = (int)((i / (6 * D)) % (NB + 1));
  int l = (int)(i / ((long)6 * D * (NB + 1)));
  const float* cv = bb < NB ? p.c + (long)bb * D : p.c_ctx;
  const float* w = p.w_ada + (long)l * D * 6 * D + j;
  float s = p.b_ada[l * 6 * D + j];
  for (int k = 0; k < D; ++k) s += siluf_(cv[k]) * w[(long)k * 6 * D];
  p.mod[i] = s;
}

DEV void ph_tables(const Params& p, long i) {
  if (i < 1024) {
    int pos = (int)(i >> 4), idx = (int)(i & 15);
    float ang = (float)pos * powf(10000.0f, -(float)idx / 16.0f);
    p.ropetab[2 * i] = cosf(ang);
    p.ropetab[2 * i + 1] = sinf(ang);
  }
  if (i < 1024) {
    int dir = (int)(i / 512), col = (int)(i % 512);
    float l0 = p.lb_logits[(dir * 2 + 0) * 512 + col], l1 = p.lb_logits[(dir * 2 + 1) * 512 + col];
    p.lbt[i] = 1.0f / (1.0f + expf(l1 - l0));
  }
}

DEV void ln_mod_row(const float* h, const float* shift, const float* scale, act_t* u) {
  float mu = 0.f;
  for (int k = 0; k < D; ++k) mu += h[k];
  mu *= (1.0f / D);
  float var = 0.f;
  for (int k = 0; k < D; ++k) { float d = h[k] - mu; var += d * d; }
  var *= (1.0f / D);
  float rs = 1.0f / sqrtf(var + LN_EPS);
  for (int k = 0; k < D; ++k) stA(u + k, (h[k] - mu) * rs * (1.0f + scale[k]) + shift[k]);
}

DEV void ph_lnmod_first(const Params& p, long row) {
  const float* m = modrow(p, 0, row);
  ln_mod_row(hrow_in(p, row), m, m + D, p.u + row * D);
}

DEV void gemm_item_act(const act_t* A, const float* W, act_t* Cout, int K, int N, int ldc, long i) {
  int n4 = (int)(i % (N / 4));
  long row = i / (N / 4);
  const act_t* a = A + row * K;
  const float* w = W + n4 * 4;
  float s0 = 0, s1 = 0, s2 = 0, s3 = 0;
  for (int k = 0; k < K; ++k) {
    float av = ldA(a + k);
    const float* wr = w + (long)k * N;
    s0 += av * wr[0]; s1 += av * wr[1]; s2 += av * wr[2]; s3 += av * wr[3];
  }
  act_t* o = Cout + row * ldc + n4 * 4;
  stA(o, s0); stA(o + 1, s1); stA(o + 2, s2); stA(o + 3, s3);
}

DEV void ph_rope(const Params& p, long i) {
  int pr = (int)(i % 32);
  int hh = (int)((i / 32) % 10);
  long lr = i / 320;
  int t = (int)(lr % T);
  int col = hh < 8 ? E_AQ + hh * 64 : E_AK + (hh - 8) * 64;
  int idx = pr & 15;
  int pos = pr < 16 ? t / GRID_W : t % GRID_W;
  int d0 = pr < 16 ? idx : 32 + idx;
  float inv = powf(10000.0f, -(float)idx / 16.0f);
  float ang = (float)pos * inv;
  float cs = cosf(ang), sn = sinf(ang);
  act_t* base = p.P + (NC + lr) * PW + col;
  float x1 = ldA(base + d0), x2 = ldA(base + d0 + 16);
  stA(base + d0, x1 * cs - x2 * sn);
  stA(base + d0 + 16, x1 * sn + x2 * cs);
}

DEV void ph_attn(const Params& p, long i) {
  int h = (int)(i % 8);
  long row = i / 8;
  int kv = h / 4;
  bool lat = row >= NC;
  int b = lat ? (int)((row - NC) / T) : (int)(row / C);
  int t = lat ? (int)((row - NC) % T) : 0;
  float q[64], acc[64];
  const act_t* qp = p.P + row * PW + E_AQ + h * 64;
#pragma unroll
  for (int d = 0; d < 64; ++d) { q[d] = ldA(qp + d) * 0.125f; acc[d] = 0.f; }
  float m = p.attn_sink[h], l = 1.0f;
  int nkeys = C + (lat ? 257 : 0);
  for (int j = 0; j < nkeys; ++j) {
    long krow;
    if (j < C) krow = (long)b * C + j;
    else {
      int kp = t - 128 + (j - C);
      if (kp < 0 || kp >= T) continue;
      krow = NC + (long)b * T + kp;
    }
    const act_t* kptr = p.P + krow * PW + E_AK + kv * 64;
    const act_t* vptr = p.P + krow * PW + E_AV + kv * 64;
    float s = 0.f;
#pragma unroll
    for (int d = 0; d < 64; ++d) s += q[d] * ldA(kptr + d);
    float mn = fmaxf(m, s);
    float sc = expf(m - mn), pj = expf(s - mn);
    l = l * sc + pj;
#pragma unroll
    for (int d = 0; d < 64; ++d) acc[d] = acc[d] * sc + pj * ldA(vptr + d);
    m = mn;
  }
  float il = 1.0f / l;
  act_t* o = p.u + row * D + h * 64;
#pragma unroll
  for (int d = 0; d < 64; ++d) stA(o + d, acc[d] * il);
}

template <int MODE>
DEV void ph_scan(const Params& p, long i) {
  constexpr int DK = MODE == 0 ? 128 : 96;
  constexpr int DV = MODE == 0 ? 128 : 192;
  int e = (int)(i % DV);
  int dir = (int)((i / DV) % 2);
  int h = (int)((i / (2 * DV)) % 4);
  int b = (int)(i / (8 * DV));
  float S[DK];
#pragma unroll
  for (int d = 0; d < DK; ++d) S[d] = 0.f;
  act_t* OD = dir == 0 ? p.OF : p.OB;
  for (int step = 0; step < C + T; ++step) {
    long row;
    if (step < C) row = (long)b * C + (dir == 0 ? step : C - 1 - step);
    else { int tt = step - C; row = NC + (long)b * T + (dir == 0 ? tt : T - 1 - tt); }
    const act_t* pr = p.P + row * PW;
    float o = 0.f;
    if (MODE == 0) {
      float v = ldA(pr + E_HI + h * 128 + e);
      const act_t* zp = pr + E_FF + dir * 512 + h * 128;
      const act_t* qp = pr + E_HQ + h * 128;
      const float* lb = p.lbt + dir * 512 + h * 128;
#pragma unroll
      for (int d = 0; d < DK; ++d) {
        float f = lb[d] + (1.0f - lb[d]) * sigmoidf_(ldA(zp + d));
        S[d] = f * S[d] + (1.0f - f) * v;
        o += ldA(qp + d) * S[d];
      }
      stA(OD + row * 768 + h * 128 + e, o);
    } else {
      float v = ldA(pr + O_V + h * 192 + e);
      const act_t* kp = pr + O_K + h * 96;
      const act_t* qp = pr + O_Q + h * 96;
      const act_t* lf = p.LF + ((long)dir * NR + row) * 384 + h * 96;
#pragma unroll
      for (int d = 0; d < DK; ++d) {
        float f = expf(ldA(lf + d));
        S[d] = f * S[d] + ldA(kp + d) * v;
        o += ldA(qp + d) * S[d];
      }
      stA(OD + row * 768 + h * 192 + e, o * 0.10206207261596575f);
    }
  }
}

template <int MODE>
DEV void ph_combine(const Params& p, long i) {
  constexpr int DV = MODE == 0 ? 128 : 192;
  int h = (int)(i % 4);
  long row = (MODE == 0) ? i / 4 : NC + i / 4;
  const act_t* f = p.OF + row * 768 + h * DV;
  const act_t* bk = p.OB + row * 768 + h * DV;
  float ss = 0.f;
  for (int e = 0; e < DV; ++e) { float o = ldA(f + e) + ldA(bk + e); ss += o * o; }
  float r = 1.0f / sqrtf(ss / DV + LN_EPS);
  const float* gn = (MODE == 0 ? p.hgrn_norm : p.gla_norm) + h * DV;
  const act_t* g = p.P + row * PW + (MODE == 0 ? E_HG : O_G) + h * DV;
  act_t* o = p.u + row * D + (MODE == 0 ? 512 : 0) + h * DV;
  for (int e = 0; e < DV; ++e) stA(o + e, (ldA(f + e) + ldA(bk + e)) * r * gn[e] * siluf_(ldA(g + e)));
}

DEV void ph_gla_decay(const Params& p, long i) {
  int col = (int)(i % 384);
  long row = (i / 384) % NR;
  int dir = (int)(i / ((long)384 * NR));
  const act_t* r = p.P + row * PW + O_RF + dir * 16;
  const float* gw = p.gla_gate_w + (long)dir * 16 * 384 + col;
  float z = p.gla_gate_b[dir * 384 + col];
  for (int k = 0; k < 16; ++k) z += ldA(r + k) * gw[k * 384];
  float ls = fminf(z, 0.f) - log1pf(expf(-fabsf(z)));
  stA(p.LF + ((long)dir * NR + row) * 384 + col, ls * (1.0f / 16.0f));
}

DEV void ph_resid_ln(const Params& p, long row, int l, int sub) {
  const float* hin = (l == 0 && sub == 0) ? hrow_in(p, row) : hrow(p, row);
  float* hout = hrow(p, row);
  const float* md = modrow(p, l, row);
  const float* g = md + (sub == 0 ? 2 : 5) * D;
  const act_t* m = p.M + row * D;
  const float* lg = p.ln_g + (l * 2 + sub) * D;
  const float* lb = p.ln_b + (l * 2 + sub) * D;
  float mu = 0.f;
  for (int k = 0; k < D; ++k) mu += ALPHA * hin[k] + g[k] * ldA(m + k);
  mu *= (1.0f / D);
  float var = 0.f;
  for (int k = 0; k < D; ++k) { float d = ALPHA * hin[k] + g[k] * ldA(m + k) - mu; var += d * d; }
  var *= (1.0f / D);
  float rs = 1.0f / sqrtf(var + LN_EPS);
  for (int k = 0; k < D; ++k) hout[k] = (ALPHA * hin[k] + g[k] * ldA(m + k) - mu) * rs * lg[k] + lb[k];
  if (sub == 1 && l == 1) return;
  const float* md2 = (sub == 0) ? md + 3 * D : modrow(p, 1, row);
  float mu2 = 0.f;
  for (int k = 0; k < D; ++k) mu2 += hout[k];
  mu2 *= (1.0f / D);
  float var2 = 0.f;
  for (int k = 0; k < D; ++k) { float d = hout[k] - mu2; var2 += d * d; }
  var2 *= (1.0f / D);
  float rs2 = 1.0f / sqrtf(var2 + LN_EPS);
  float lo[NEXP];
#pragma unroll
  for (int e = 0; e < NEXP; ++e) lo[e] = 0.f;
  for (int k = 0; k < D; ++k) {
    float uv = (hout[k] - mu2) * rs2 * (1.0f + md2[D + k]) + md2[k];
    stA(p.u + row * D + k, uv);
    if (sub == 0) {
      const float* wr = p.w_router + k * NEXP;
#pragma unroll
      for (int e = 0; e < NEXP; ++e) lo[e] += uv * wr[e];
    }
  }
  if (sub != 0) return;
  float mx = lo[0];
#pragma unroll
  for (int e = 1; e < NEXP; ++e) mx = fmaxf(mx, lo[e]);
  float sum = 0.f;
#pragma unroll
  for (int e = 0; e < NEXP; ++e) { lo[e] = expf(lo[e] - mx); sum += lo[e]; }
  float inv = 1.0f / sum;
  float bestg = -1e30f; int bg = 0;
  float gi1 = 0, gi2 = 0; int ge1 = 0, ge2 = 0;
  float gp1 = 0, gp2 = 0;
#pragma unroll
  for (int gq = 0; gq < 4; ++gq) {
    float s1 = -1e30f, s2 = -1e30f, p1 = 0, p2 = 0; int e1 = 0, e2 = 0;
#pragma unroll
    for (int j = 0; j < 4; ++j) {
      int e = gq * 4 + j;
      float pe = lo[e] * inv;
      float se = pe + p.b_router[e];
      if (se > s1) { s2 = s1; p2 = p1; e2 = e1; s1 = se; p1 = pe; e1 = e; }
      else if (se > s2) { s2 = se; p2 = pe; e2 = e; }
    }
    float gs = s1 + s2;
    if (gs > bestg) { bestg = gs; bg = gq; gi1 = s1; gi2 = s2; ge1 = e1; ge2 = e2; gp1 = p1; gp2 = p2; }
  }
  (void)bg; (void)gi1; (void)gi2;
  float wsum = gp1 + gp2;
  p.eidx[row * 2 + 0] = ge1; p.eidx[row * 2 + 1] = ge2;
  p.ew[row * 2 + 0] = gp1 / wsum; p.ew[row * 2 + 1] = gp2 / wsum;
}

DEV void ph_moe_up(const Params& p, long i, int l, long row0) {
  int f4 = (int)(i % (DFF / 4));
  int slot = (int)((i / (DFF / 4)) % 2);
  long row = row0 + i / (DFF / 2);
  int e = p.eidx[row * 2 + slot];
  const float* w1 = p.w_eg + ((long)(l * NEXP + e) * D) * DFF + f4 * 4;
  const float* w3 = p.w_eu + ((long)(l * NEXP + e) * D) * DFF + f4 * 4;
  const act_t* a = p.u + row * D;
  float g0 = 0, g1 = 0, g2 = 0, g3 = 0, u0 = 0, u1 = 0, u2 = 0, u3 = 0;
  for (int k = 0; k < D; ++k) {
    float av = ldA(a + k);
    const float* r1 = w1 + (long)k * DFF;
    const float* r3 = w3 + (long)k * DFF;
    g0 += av * r1[0]; g1 += av * r1[1]; g2 += av * r1[2]; g3 += av * r1[3];
    u0 += av * r3[0]; u1 += av * r3[1]; u2 += av * r3[2]; u3 += av * r3[3];
  }
  act_t* hb = p.P + (row * 2 + slot) * DFF + f4 * 4;
  stA(hb, siluf_(g0) * u0); stA(hb + 1, siluf_(g1) * u1); stA(hb + 2, siluf_(g2) * u2); stA(hb + 3, siluf_(g3) * u3);
}

DEV void ph_moe_down(const Params& p, long i, int l, long row0) {
  int j4 = (int)(i % (D / 4));
  long row = row0 + i / (D / 4);
  float y0 = 0, y1 = 0, y2 = 0, y3 = 0;
  for (int slot = 0; slot < 2; ++slot) {
    int e = p.eidx[row * 2 + slot];
    float wgt = p.ew[row * 2 + slot];
    const float* w2 = p.w_ed + ((long)(l * NEXP + e) * DFF) * D + j4 * 4;
    const act_t* hb = p.P + (row * 2 + slot) * DFF;
    float s0 = 0, s1 = 0, s2 = 0, s3 = 0;
    for (int f = 0; f < DFF; ++f) {
      float hv = ldA(hb + f);
      const float* r = w2 + (long)f * D;
      s0 += hv * r[0]; s1 += hv * r[1]; s2 += hv * r[2]; s3 += hv * r[3];
    }
    y0 += wgt * s0; y1 += wgt * s1; y2 += wgt * s2; y3 += wgt * s3;
  }
  act_t* o = p.M + row * D + j4 * 4;
  stA(o, y0); stA(o + 1, y1); stA(o + 2, y2); stA(o + 3, y3);
}


#ifndef HOST_TEST
typedef __attribute__((ext_vector_type(8))) short bf16x8;
typedef __attribute__((ext_vector_type(4))) float f32x4;
constexpr int SMEM_BYTES = 71680;
constexpr int IN_ODD_PAD = 2944;
constexpr int O_FA = 2336, O_FB = 2592, O_END = 2848;

typedef float f32x2_t __attribute__((ext_vector_type(2)));
typedef __bf16 bf16x2_t __attribute__((ext_vector_type(2)));
__device__ __forceinline__ unsigned pack2(float a, float b) {
  const f32x2_t v = {a, b};
  return __builtin_bit_cast(unsigned, __builtin_convertvector(v, bf16x2_t));
}
__device__ __forceinline__ unsigned pack2_mfma(float a, float b) { return pack2(a, b); }
typedef __attribute__((ext_vector_type(2))) unsigned u32x2;
__device__ __forceinline__ float xor16_max(float x) {
  const u32x2 r = __builtin_amdgcn_permlane16_swap(__float_as_uint(x), __float_as_uint(x), false, false);
  return fmaxf(__uint_as_float(r.x), __uint_as_float(r.y));
}
__device__ __forceinline__ float xor32_max(float x) {
  const u32x2 r = __builtin_amdgcn_permlane32_swap(__float_as_uint(x), __float_as_uint(x), false, false);
  return fmaxf(__uint_as_float(r.x), __uint_as_float(r.y));
}
__device__ __forceinline__ float xor16_add(float x) {
  const u32x2 r = __builtin_amdgcn_permlane16_swap(__float_as_uint(x), __float_as_uint(x), false, false);
  return __uint_as_float(r.x) + __uint_as_float(r.y);
}
__device__ __forceinline__ float xor32_add(float x) {
  const u32x2 r = __builtin_amdgcn_permlane32_swap(__float_as_uint(x), __float_as_uint(x), false, false);
  return __uint_as_float(r.x) + __uint_as_float(r.y);
}
__device__ __forceinline__ float bf_lo(unsigned u) { return __uint_as_float(u << 16); }
__device__ __forceinline__ float bf_hi(unsigned u) { return __uint_as_float(u & 0xffff0000u); }
template <int CTRL>
__device__ __forceinline__ float dpp_mov(float v) {
  return __int_as_float(__builtin_amdgcn_update_dpp(0, __float_as_int(v), CTRL, 0xf, 0xf, true));
}
__device__ __forceinline__ float row_sum16(float v) {
  v += dpp_mov<0xB1>(v);
  v += dpp_mov<0x4E>(v);
  v += dpp_mov<0x141>(v);
  v += dpp_mov<0x140>(v);
  return v;
}
__device__ __forceinline__ float wave_sum(float v) {
  v = row_sum16(v);
  const float a = __int_as_float(__builtin_amdgcn_readlane(__float_as_int(v), 0));
  const float b = __int_as_float(__builtin_amdgcn_readlane(__float_as_int(v), 16));
  const float c = __int_as_float(__builtin_amdgcn_readlane(__float_as_int(v), 32));
  const float d = __int_as_float(__builtin_amdgcn_readlane(__float_as_int(v), 48));
  return (a + b) + (c + d);
}


#define XB_TMO      128
#define XB_XCNT(j)  (256  + 64 * (j))
#define XB_XSUB(j)  (1280 + 64 * (j))
#define XB_XGEN(j)  (2304 + 64 * (j))
#define XB_TOP      3328
#define XB_TOPGEN   3392
#define XCD_BAR_WORDS 3456
#define XB_SPIN_CAP (1u << 18)
#define LAS __attribute__((address_space(3)))
__device__ __forceinline__ unsigned xb_ld(unsigned* p)              { return __hip_atomic_load(p, __ATOMIC_RELAXED, __HIP_MEMORY_SCOPE_AGENT); }
__device__ __forceinline__ unsigned xb_add(unsigned* p, unsigned v) { return __hip_atomic_fetch_add(p, v, __ATOMIC_RELAXED, __HIP_MEMORY_SCOPE_AGENT); }
__device__ __forceinline__ unsigned xb_xcc_id() { return (unsigned)__builtin_amdgcn_s_getreg((3 << 11) | 20) & 0xFu; }
#define XB_SPIN(cond, bar) do { unsigned _sp = 0; while (cond) { __builtin_amdgcn_s_sleep(1); \
    if ((++_sp & 255u) == 0u) { if (xb_ld(&(bar)[XB_TMO])) break; if (_sp > XB_SPIN_CAP) { atomicAdd(&(bar)[XB_TMO], 1u); break; } } } } while (0)
struct XcdBarrier { unsigned* bar; unsigned x; volatile LAS unsigned* st; };
__device__ __forceinline__ XcdBarrier xcd_barrier_post(unsigned* bar, volatile LAS unsigned* st) {
    XcdBarrier b; b.bar = bar; b.x = xb_xcc_id(); b.st = st;
    if (threadIdx.x == 0) (void)xb_add(&bar[XB_XCNT(b.x)], 1u);
    return b;
}
__device__ __forceinline__ void xcd_barrier_complete(unsigned* bar, unsigned x, unsigned& nloc, unsigned& nx) {
    const unsigned G = gridDim.x * gridDim.y * gridDim.z;
    unsigned sum, cnt, mine, sp = 0u;
    for (;;) {
        sum = 0u; cnt = 0u; mine = 0u;
#pragma unroll
        for (unsigned j = 0; j < 16; ++j) { const unsigned c = xb_ld(&bar[XB_XCNT(j)]); sum += c; cnt += (c > 0u) ? 1u : 0u; mine = (j == x) ? c : mine; }
        if (sum == G) break;
        __builtin_amdgcn_s_sleep(1);
        if ((++sp & 255u) == 0u) { if (xb_ld(&bar[XB_TMO])) break; if (sp > XB_SPIN_CAP) { atomicAdd(&bar[XB_TMO], 1u); break; } }
    }
    nloc = mine > 0u ? mine : 1u; nx = cnt > 0u ? cnt : 1u;
}
__device__ __forceinline__ void xcd_barrier(const XcdBarrier& b) {
    asm volatile("s_waitcnt vmcnt(0)" ::: "memory");
    __syncthreads();
    if (threadIdx.x == 0) {
        unsigned* bar = b.bar;
        __builtin_amdgcn_s_waitcnt(0);
        unsigned nloc = b.st[0], nx = b.st[1];
        if (nloc == 0u) { xcd_barrier_complete(bar, b.x, nloc, nx); b.st[0] = nloc; b.st[1] = nx; }
        const unsigned old = xb_add(&bar[XB_XSUB(b.x)], 1u);
        const unsigned gen = old / nloc;
        if (old + 1u == (gen + 1u) * nloc) {
            __builtin_amdgcn_fence(__ATOMIC_RELEASE, "agent");
            asm volatile("s_waitcnt vmcnt(0)" ::: "memory");
            const unsigned og = xb_add(&bar[XB_TOP], 1u);
            const unsigned tg = og / nx;
            if (og + 1u == (tg + 1u) * nx) xb_add(&bar[XB_TOPGEN], 1u);
            else XB_SPIN(xb_ld(&bar[XB_TOPGEN]) == tg, bar);
            __builtin_amdgcn_fence(__ATOMIC_ACQUIRE, "agent");
            xb_add(&bar[XB_XGEN(b.x)], 1u);
            asm volatile("s_waitcnt vmcnt(0)" ::: "memory");
        } else {
            XB_SPIN(xb_ld(&bar[XB_XGEN(b.x)]) == gen, bar);
            __builtin_amdgcn_fence(__ATOMIC_ACQUIRE, "agent");
            asm volatile("s_waitcnt vmcnt(0)" ::: "memory");
        }
    }
    __syncthreads();
}

#define RAW_BARRIER() do { asm volatile("s_waitcnt lgkmcnt(0)" ::: "memory"); __builtin_amdgcn_s_barrier(); } while (0)
template <bool SWAP, class ARow, class Epi>
__device__ __forceinline__ void gemm_tile(ARow arow, const act_t* Bt, int K, unsigned char* smem, Epi epi) {
  const int tid = threadIdx.x, wid = tid >> 6, lane = tid & 63, wr = wid >> 1, wc = wid & 1, fr = lane & 15,
            fq = lane >> 4;
  const int r0 = tid >> 3, pc = tid & 7;
  const int lc = pc ^ ((tid >> 4) & 7);
  const act_t* ga[4];
#pragma unroll
  for (int i = 0; i < 4; ++i) ga[i] = arow(r0 + 32 * i) + lc * 8;
  const act_t* gb0 = Bt + (long)r0 * K + lc * 8;
  const long gbs = (long)32 * K;
  const int sw = (fr >> 1) & 7;
  const int rd0 = fr * 128 + ((fq ^ sw) << 4), rd1 = fr * 128 + (((4 + fq) ^ sw) << 4);
  char* S = (char*)smem;
  const int nk = K >> 6;
  f32x4 acc[4][4];
#pragma unroll
  for (int m = 0; m < 4; ++m)
#pragma unroll
    for (int n = 0; n < 4; ++n) acc[m][n] = f32x4{0.f, 0.f, 0.f, 0.f};
  auto issue = [&](int kt) {
    char* st = S + (kt & 1) * 32768 + tid * 16;
#pragma unroll
    for (int i = 0; i < 4; ++i) {
      __builtin_amdgcn_global_load_lds((const unsigned*)(ga[i] + kt * 64), (unsigned*)(st + i * 4096), 16, 0, 0);
      __builtin_amdgcn_global_load_lds((const unsigned*)(gb0 + i * gbs + kt * 64), (unsigned*)(st + 16384 + i * 4096), 16, 0, 0);
    }
  };
  asm volatile("s_waitcnt vmcnt(0)" ::: "memory");
  RAW_BARRIER();
  issue(0);
  for (int kt = 0; kt < nk; ++kt) {
    asm volatile("s_waitcnt vmcnt(0)" ::: "memory");
    RAW_BARRIER();
    if (kt + 1 < nk) issue(kt + 1);
    const char* st = S + (kt & 1) * 32768;
#pragma unroll
    for (int ks = 0; ks < 2; ++ks) {
      const int rd = ks ? rd1 : rd0;
      bf16x8 af[4], bfr[4];
#pragma unroll
      for (int m = 0; m < 4; ++m) {
        af[m] = *reinterpret_cast<const bf16x8*>(st + (wr * 64 + m * 16) * 128 + rd);
        bfr[m] = *reinterpret_cast<const bf16x8*>(st + 16384 + (wc * 64 + m * 16) * 128 + rd);
      }
#pragma unroll
      for (int m = 0; m < 4; ++m)
#pragma unroll
        for (int n = 0; n < 4; ++n)
          acc[m][n] = SWAP ? __builtin_amdgcn_mfma_f32_16x16x32_bf16(bfr[n], af[m], acc[m][n], 0, 0, 0)
                           : __builtin_amdgcn_mfma_f32_16x16x32_bf16(af[m], bfr[n], acc[m][n], 0, 0, 0);
    }
  }
  epi(acc, wr, wc, fr, fq);
}


constexpr float SU8 = 16.0f, SW8 = 64.0f, SH8 = 8.0f;
typedef unsigned char fp8_t;
typedef __attribute__((ext_vector_type(8))) int i32x8;
typedef __attribute__((ext_vector_type(4))) int i32x4;
__device__ __forceinline__ unsigned pack4_fp8(float a, float b, float c, float d) {
  a = fminf(fmaxf(a, -448.f), 448.f); b = fminf(fmaxf(b, -448.f), 448.f);
  c = fminf(fmaxf(c, -448.f), 448.f); d = fminf(fmaxf(d, -448.f), 448.f);
  unsigned w = 0;
  w = __builtin_amdgcn_cvt_pk_fp8_f32(a, b, w, false);
  w = __builtin_amdgcn_cvt_pk_fp8_f32(c, d, w, true);
  return w;
}

template <bool SWAP, class ARow, class Epi>
__device__ __forceinline__ void gemm_tile8(ARow arow, const fp8_t* Bt, int Kb, unsigned char* smem, Epi epi) {
  const int tid = threadIdx.x, wid = tid >> 6, lane = tid & 63, wr = wid >> 1, wc = wid & 1, fr = lane & 15,
            fq = lane >> 4;
  const int r0 = tid >> 3, pc = tid & 7;
  const int lc = pc ^ ((tid >> 4) & 7);
  const fp8_t* ga[4];
#pragma unroll
  for (int i = 0; i < 4; ++i) ga[i] = arow(r0 + 32 * i) + lc * 16;
  const fp8_t* gb0 = Bt + (long)r0 * Kb + lc * 16;
  const long gbs = (long)32 * Kb;
  const int sw = (fr >> 1) & 7;
  const int rd0 = fr * 128 + ((fq ^ sw) << 4), rd1 = fr * 128 + (((4 + fq) ^ sw) << 4);
  char* S = (char*)smem;
  const int nk = Kb >> 7;
  f32x4 acc[4][4];
#pragma unroll
  for (int m = 0; m < 4; ++m)
#pragma unroll
    for (int n = 0; n < 4; ++n) acc[m][n] = f32x4{0.f, 0.f, 0.f, 0.f};
  auto issue = [&](int kt) {
    char* st = S + (kt & 1) * 32768 + tid * 16;
#pragma unroll
    for (int i = 0; i < 4; ++i) {
      __builtin_amdgcn_global_load_lds((const unsigned*)(ga[i] + kt * 128), (unsigned*)(st + i * 4096), 16, 0, 0);
      __builtin_amdgcn_global_load_lds((const unsigned*)(gb0 + i * gbs + kt * 128), (unsigned*)(st + 16384 + i * 4096), 16, 0, 0);
    }
  };
  asm volatile("s_waitcnt vmcnt(0)" ::: "memory");
  RAW_BARRIER();
  issue(0);
#pragma unroll 1
  for (int kt = 0; kt < nk; ++kt) {
    asm volatile("s_waitcnt vmcnt(0)" ::: "memory");
    RAW_BARRIER();
    if (kt + 1 < nk) issue(kt + 1);
    const char* st = S + (kt & 1) * 32768;
    i32x8 af[4], bfr[4];
#pragma unroll
    for (int m = 0; m < 4; ++m) {
      const i32x4 a0 = *reinterpret_cast<const i32x4*>(st + (wr * 64 + m * 16) * 128 + rd0);
      const i32x4 a1 = *reinterpret_cast<const i32x4*>(st + (wr * 64 + m * 16) * 128 + rd1);
      const i32x4 b0 = *reinterpret_cast<const i32x4*>(st + 16384 + (wc * 64 + m * 16) * 128 + rd0);
      const i32x4 b1 = *reinterpret_cast<const i32x4*>(st + 16384 + (wc * 64 + m * 16) * 128 + rd1);
      af[m] = i32x8{a0[0], a0[1], a0[2], a0[3], a1[0], a1[1], a1[2], a1[3]};
      bfr[m] = i32x8{b0[0], b0[1], b0[2], b0[3], b1[0], b1[1], b1[2], b1[3]};
    }
#pragma unroll
    for (int m = 0; m < 4; ++m)
#pragma unroll
      for (int n = 0; n < 4; ++n)
        acc[m][n] = SWAP ? __builtin_amdgcn_mfma_scale_f32_16x16x128_f8f6f4(bfr[n], af[m], acc[m][n], 0, 0, 0, 0x7f7f7f7f, 0, 0x7f7f7f7f)
                         : __builtin_amdgcn_mfma_scale_f32_16x16x128_f8f6f4(af[m], bfr[n], acc[m][n], 0, 0, 0, 0x7f7f7f7f, 0, 0x7f7f7f7f);
  }
  epi(acc, wr, wc, fr, fq);
}

__device__ __forceinline__ void phase_attn(const Params& p, unsigned char* smem, int blk, int nblk) {
  const int tid = threadIdx.x, w = tid >> 6, lane = tid & 63, fr = lane & 15, g = lane >> 4;
  act_t* SK = (act_t*)smem;
  act_t* SV = SK + 64 * 72;
  constexpr float SCL = 0.125f * 1.4426950408889634f;
  const int n_lat = NB * 4 * (T / 64), n_ctx = NB * 4 * (C / 64);
  const int skey = tid >> 2, spart = tid & 3;
  for (int unit = blk; unit < n_lat + n_ctx; unit += nblk) {
    const bool lat = unit < n_lat;
    const int uu = lat ? unit : unit - n_lat;
    const int nq = lat ? T / 64 : C / 64;
    const int hp = uu & 1, kv = (uu >> 1) & 1, qb = (uu >> 2) % nq, b = (uu >> 2) / nq;
    const int t0 = qb * 64;
    const int tw = t0 + (w & 1) * 32;
    const long qrow0 = (lat ? (long)NC + (long)b * T : (long)b * C) + tw;
    const int h = kv * 4 + hp * 2 + (w >> 1);
    bf16x8 qf[2][2];
#pragma unroll
    for (int qt = 0; qt < 2; ++qt)
#pragma unroll
      for (int st = 0; st < 2; ++st)
        qf[qt][st] = *reinterpret_cast<const bf16x8*>(p.P + (qrow0 + qt * 16 + fr) * PW + E_AQ + h * 64 + st * 32 + g * 8);
    asm volatile("" :: "v"(qf[0][0]), "v"(qf[0][1]), "v"(qf[1][0]), "v"(qf[1][1]));
    float mrun[2], lrun[2];
    f32x4 o[2][4];
    const float sinkl = p.attn_sink[h] * 1.4426950408889634f;
#pragma unroll
    for (int qt = 0; qt < 2; ++qt) {
      mrun[qt] = sinkl;
      lrun[qt] = (g == 0) ? 1.0f : 0.0f;
#pragma unroll
      for (int dt = 0; dt < 4; ++dt) o[qt][dt] = f32x4{0.f, 0.f, 0.f, 0.f};
    }
    int cc_lo = 0, cc_hi = -1;
    if (lat) {
      cc_lo = t0 >= 128 ? 0 : (128 - t0) / 64;
      cc_hi = min(4, (T - 1 - (t0 - 128)) / 64);
    }
    const int nch = 4 + (cc_hi - cc_lo + 1);
    auto chunk_row = [&](int i, int key, int& tkb) -> long {
      if (i < 4) { tkb = 0; return (long)b * C + i * 64 + key; }
      tkb = t0 - 128 + (cc_lo + i - 4) * 64;
      return (long)NC + (long)b * T + tkb + key;
    };
    uint4 rk0, rk1, rv0, rv1;
    {
      int tkb; const long kr = chunk_row(0, skey, tkb);
      const act_t* kp = p.P + kr * PW + E_AK + kv * 64 + spart * 16;
      const act_t* vp = p.P + kr * PW + E_AV + kv * 64 + spart * 16;
      rk0 = *reinterpret_cast<const uint4*>(kp); rk1 = *reinterpret_cast<const uint4*>(kp + 8);
      rv0 = *reinterpret_cast<const uint4*>(vp); rv1 = *reinterpret_cast<const uint4*>(vp + 8);
    }
    for (int i = 0; i < nch; ++i) {
      __syncthreads();
      {
        uint4* kd = reinterpret_cast<uint4*>(SK + skey * 72 + spart * 16);
        kd[0] = rk0; kd[1] = rk1;
        const unsigned vw[8] = {rv0.x, rv0.y, rv0.z, rv0.w, rv1.x, rv1.y, rv1.z, rv1.w};
#pragma unroll
        for (int e = 0; e < 8; ++e) {
          SV[(spart * 16 + 2 * e) * 72 + skey] = (act_t)(vw[e] & 0xffffu);
          SV[(spart * 16 + 2 * e + 1) * 72 + skey] = (act_t)(vw[e] >> 16);
        }
      }
      __syncthreads();
      int tkb_cur; (void)chunk_row(i, 0, tkb_cur);
      if (i + 1 < nch) {
        int tkb; const long kr = chunk_row(i + 1, skey, tkb);
        const act_t* kp = p.P + kr * PW + E_AK + kv * 64 + spart * 16;
        const act_t* vp = p.P + kr * PW + E_AV + kv * 64 + spart * 16;
        rk0 = *reinterpret_cast<const uint4*>(kp); rk1 = *reinterpret_cast<const uint4*>(kp + 8);
        rv0 = *reinterpret_cast<const uint4*>(vp); rv1 = *reinterpret_cast<const uint4*>(vp + 8);
      }
      const bool edge = i >= 4 && (tkb_cur == t0 - 128 || tkb_cur == t0 + 128);
#pragma unroll
      for (int kb = 0; kb < 2; ++kb) {
        f32x4 sc[2][2];
#pragma unroll
        for (int k2 = 0; k2 < 2; ++k2) {
          const int kt = kb * 2 + k2;
          const bf16x8 kf0 = *reinterpret_cast<const bf16x8*>(SK + (kt * 16 + fr) * 72 + g * 8);
          const bf16x8 kf1 = *reinterpret_cast<const bf16x8*>(SK + (kt * 16 + fr) * 72 + 32 + g * 8);
#pragma unroll
          for (int qt = 0; qt < 2; ++qt) {
            f32x4 z = f32x4{0.f, 0.f, 0.f, 0.f};
            z = __builtin_amdgcn_mfma_f32_16x16x32_bf16(kf0, qf[qt][0], z, 0, 0, 0);
            sc[qt][k2] = __builtin_amdgcn_mfma_f32_16x16x32_bf16(kf1, qf[qt][1], z, 0, 0, 0);
          }
        }
        bf16x8 pf[2];
#pragma unroll
        for (int qt = 0; qt < 2; ++qt) {
          float mx = -1e30f;
#pragma unroll
          for (int k2 = 0; k2 < 2; ++k2)
#pragma unroll
            for (int j = 0; j < 4; ++j) {
              float v = sc[qt][k2][j] * SCL;
              if (edge) {
                const int tk = tkb_cur + (kb * 2 + k2) * 16 + 4 * g + j;
                const int tq = tw + qt * 16 + fr;
                const int df = tq - tk;
                if (df > 128 || df < -128) v = -1e30f;
              }
              sc[qt][k2][j] = v;
              mx = fmaxf(mx, v);
            }
          mx = xor16_max(mx);
          mx = xor32_max(mx);
          const float mnew = fmaxf(mrun[qt], mx);
          if (__any(mnew > mrun[qt])) {
            const float alpha = __builtin_amdgcn_exp2f(mrun[qt] - mnew);
            lrun[qt] *= alpha;
#pragma unroll
            for (int dt = 0; dt < 4; ++dt) o[qt][dt] = o[qt][dt] * alpha;
            mrun[qt] = mnew;
          }
          float ls = 0.f;
          float pv[8];
#pragma unroll
          for (int k2 = 0; k2 < 2; ++k2)
#pragma unroll
            for (int j = 0; j < 4; ++j) {
              const float pe = __builtin_amdgcn_exp2f(sc[qt][k2][j] - mnew);
              pv[k2 * 4 + j] = pe;
              ls += pe;
            }
          lrun[qt] += ls;
          union { unsigned u[4]; bf16x8 v; } cv;
          cv.u[0] = pack2_mfma(pv[0], pv[1]); cv.u[1] = pack2_mfma(pv[2], pv[3]);
          cv.u[2] = pack2_mfma(pv[4], pv[5]); cv.u[3] = pack2_mfma(pv[6], pv[7]);
          pf[qt] = cv.v;
        }
#pragma unroll
        for (int dt = 0; dt < 4; ++dt) {
          union { uint2 h2[2]; bf16x8 v; } vf;
          vf.h2[0] = *reinterpret_cast<const uint2*>(SV + (dt * 16 + fr) * 72 + kb * 32 + 4 * g);
          vf.h2[1] = *reinterpret_cast<const uint2*>(SV + (dt * 16 + fr) * 72 + kb * 32 + 16 + 4 * g);
#pragma unroll
          for (int qt = 0; qt < 2; ++qt) o[qt][dt] = __builtin_amdgcn_mfma_f32_16x16x32_bf16(vf.v, pf[qt], o[qt][dt], 0, 0, 0);
        }
      }
    }
#pragma unroll
    for (int qt = 0; qt < 2; ++qt) {
      float lt = lrun[qt];
      lt = xor16_add(lt);
      lt = xor32_add(lt);
      const float il = 1.0f / lt;
      act_t* orow = p.u + (qrow0 + qt * 16 + fr) * D + h * 64 + 4 * g;
#pragma unroll
      for (int dt = 0; dt < 4; ++dt)
        *reinterpret_cast<uint2*>(orow + dt * 16) =
            make_uint2(pack2(o[qt][dt][0] * il, o[qt][dt][1] * il), pack2(o[qt][dt][2] * il, o[qt][dt][3] * il));
    }
  }
}


template <int MODE>
__device__ __forceinline__ void phase_combine(const Params& p) {
  constexpr int DV = MODE == 0 ? 128 : 192, EPL = DV / 16, NV = EPL / 4;
  const int lane = threadIdx.x & 63;
  const long row_lo = MODE == 0 ? 0 : NC;
  const long nw = (long)gridDim.x * 4, wi = (long)blockIdx.x * 4 + (threadIdx.x >> 6);
  const long rpw = (NR - row_lo + nw - 1) / nw;
  const long r0 = row_lo + wi * rpw, r1 = min((long)NR, r0 + rpw);
  float gn[EPL];
#pragma unroll
  for (int e = 0; e < EPL; ++e) gn[e] = (MODE == 0 ? p.hgrn_norm : p.gla_norm)[lane * EPL + e];
  uint2 fa[NV], fb[NV], fg[NV];
  auto load_row = [&](long row) {
    const uint2* f = reinterpret_cast<const uint2*>(p.OF + row * 768 + lane * EPL);
    const uint2* bk = reinterpret_cast<const uint2*>(p.OB + row * 768 + lane * EPL);
    const uint2* gt = reinterpret_cast<const uint2*>(p.P + row * PW + (MODE == 0 ? E_HG : O_G) + lane * EPL);
#pragma unroll
    for (int v = 0; v < NV; ++v) { fa[v] = f[v]; fb[v] = bk[v]; fg[v] = gt[v]; }
  };
  if (r0 < r1) load_row(r0);
  for (long row = r0; row < r1; ++row) {
    float o[EPL], gg[EPL];
#pragma unroll
    for (int v = 0; v < NV; ++v) {
      o[4 * v + 0] = bf_lo(fa[v].x) + bf_lo(fb[v].x); o[4 * v + 1] = bf_hi(fa[v].x) + bf_hi(fb[v].x);
      o[4 * v + 2] = bf_lo(fa[v].y) + bf_lo(fb[v].y); o[4 * v + 3] = bf_hi(fa[v].y) + bf_hi(fb[v].y);
      gg[4 * v + 0] = bf_lo(fg[v].x); gg[4 * v + 1] = bf_hi(fg[v].x); gg[4 * v + 2] = bf_lo(fg[v].y); gg[4 * v + 3] = bf_hi(fg[v].y);
    }
    load_row(min(row + 1, r1 - 1));
    float ss = 0.f;
#pragma unroll
    for (int e = 0; e < EPL; ++e) ss += o[e] * o[e];
    ss = row_sum16(ss);
    const float r = 1.0f / sqrtf(ss * (1.0f / DV) + LN_EPS);
    uint2* dst = reinterpret_cast<uint2*>(p.u + row * D + (MODE == 0 ? 512 : 0) + lane * EPL);
#pragma unroll
    for (int v = 0; v < NV; ++v) {
      float y[4];
#pragma unroll
      for (int q = 0; q < 4; ++q) {
        const float g = gg[4 * v + q];
        y[q] = o[4 * v + q] * r * gn[4 * v + q] * (g / (1.0f + __expf(-g)));
      }
      dst[v] = make_uint2(pack2(y[0], y[1]), pack2(y[2], y[3]));
    }
  }
}

constexpr int MOD_ITEMS = 2 * (6 * D / 64);
__device__ __forceinline__ void mod_item(const Params& p, int item, unsigned char* smem) {
  float* sc = (float*)smem;
  float* red = sc + 9 * D;
  const int tid = threadIdx.x, w = tid >> 6, lane = tid & 63;
  for (int i = tid; i < 9 * D; i += 256) {
    const int bb = i >> 10, k = i & 1023;
    const float v = bb < NB ? p.c[bb * D + k] : p.c_ctx[k];
    sc[i] = v / (1.0f + __expf(-v));
  }
  __syncthreads();
  const int l = item / (6 * D / 64), j = (item % (6 * D / 64)) * 64 + lane;
  const float* wp = p.w_ada + (long)l * D * 6 * D + (long)(w * 256) * 6 * D + j;
  float a[NB + 1];
#pragma unroll
  for (int bb = 0; bb <= NB; ++bb) a[bb] = 0.f;
  for (int kb = 0; kb < 256; kb += 32) {
    float wv[32];
#pragma unroll
    for (int q = 0; q < 32; ++q) wv[q] = wp[(long)(kb + q) * 6 * D];
#pragma unroll
    for (int q = 0; q < 32; ++q)
#pragma unroll
      for (int bb = 0; bb <= NB; ++bb) a[bb] += sc[bb * D + w * 256 + kb + q] * wv[q];
  }
#pragma unroll
  for (int bb = 0; bb <= NB; ++bb) red[(w * 9 + bb) * 64 + lane] = a[bb];
  __syncthreads();
  for (int i = tid; i < 9 * 64; i += 256) {
    const int bb = i >> 6, jj = i & 63;
    const int col = (item % (6 * D / 64)) * 64 + jj;
    const float sum = ((red[(0 * 9 + bb) * 64 + jj] + red[(1 * 9 + bb) * 64 + jj]) + (red[(2 * 9 + bb) * 64 + jj] + red[(3 * 9 + bb) * 64 + jj]));
    p.mod[((long)l * (NB + 1) + bb) * 6 * D + col] = sum + p.b_ada[l * 6 * D + col];
  }
  __syncthreads();
}

__device__ __forceinline__ void phase_gla_decay(const Params& p) {
  const int t = threadIdx.x;
  if (t >= 192) return;
  const int dir = t / 96, cg = t % 96;
  float gw[16][4], gb[4];
#pragma unroll
  for (int r = 0; r < 16; ++r) {
    const float4 v = *reinterpret_cast<const float4*>(p.gla_gate_w + ((long)dir * 16 + r) * 384 + cg * 4);
    gw[r][0] = v.x; gw[r][1] = v.y; gw[r][2] = v.z; gw[r][3] = v.w;
  }
  {
    const float4 v = *reinterpret_cast<const float4*>(p.gla_gate_b + dir * 384 + cg * 4);
    gb[0] = v.x; gb[1] = v.y; gb[2] = v.z; gb[3] = v.w;
  }
  const long rpb = ((NR + gridDim.x - 1) / gridDim.x + 3) / 4 * 4;
  const long b0 = (long)blockIdx.x * rpb, b1 = min((long)NR, b0 + rpb);
  uint4 ra[4], rb[4];
  auto load4 = [&](long row0) {
#pragma unroll
    for (int q = 0; q < 4; ++q) {
      const uint4* rp = reinterpret_cast<const uint4*>(p.P + min(row0 + q, b1 - 1) * PW + O_RF + dir * 16);
      ra[q] = rp[0]; rb[q] = rp[1];
    }
  };
  if (b0 < b1) load4(b0);
  for (long row0 = b0; row0 < b1; row0 += 4) {
    unsigned rw[4][8];
#pragma unroll
    for (int q = 0; q < 4; ++q) {
      rw[q][0] = ra[q].x; rw[q][1] = ra[q].y; rw[q][2] = ra[q].z; rw[q][3] = ra[q].w;
      rw[q][4] = rb[q].x; rw[q][5] = rb[q].y; rw[q][6] = rb[q].z; rw[q][7] = rb[q].w;
    }
    load4(min(row0 + 4, b1 - 1));
#pragma unroll
    for (int q = 0; q < 4; ++q) {
      float z[4] = {gb[0], gb[1], gb[2], gb[3]};
#pragma unroll
      for (int r2 = 0; r2 < 8; ++r2) {
        const float x0 = bf_lo(rw[q][r2]), x1 = bf_hi(rw[q][r2]);
#pragma unroll
        for (int c = 0; c < 4; ++c) z[c] += x0 * gw[2 * r2][c] + x1 * gw[2 * r2 + 1][c];
      }
      float o[4];
#pragma unroll
      for (int c = 0; c < 4; ++c) o[c] = (fminf(z[c], 0.f) - __logf(1.0f + __expf(-fabsf(z[c])))) * (1.0f / 16.0f);
      if (row0 + q < b1)
        *reinterpret_cast<uint2*>(p.LF + ((long)dir * NR + row0 + q) * 384 + cg * 4) = make_uint2(pack2(o[0], o[1]), pack2(o[2], o[3]));
    }
  }
}

__device__ __forceinline__ void phase_hgrn_gate(const Params& p, long gtid, long gstride) {
  for (long i = gtid; i < (long)NR * 1024; i += gstride) {
    const int col = (int)(i & 1023);
    const long row = i >> 10;
    act_t* z = p.P + row * PW + E_FF + col;
    const float lb = p.lbt[col];
    const float f = lb + (1.0f - lb) * sigmoidf_(ldA(z));
    stA(z, __logf(f));
  }
}

template <int MODE>
__device__ __forceinline__ void phase_scan(const Params& p, unsigned char* smem, int blk, int nblk) {
  constexpr int DK = MODE == 0 ? 128 : 96, DV = MODE == 0 ? 128 : 192, DVS = DV / 4, NET = DVS / 16, NKS = DK / 32,
                NDT = DK / 16;
  constexpr int QS = DK + 8, LS = 72, SS = DK + 8;
  act_t* Qa = (act_t*)smem;
  act_t* Ka = Qa + 64 * QS;
  act_t* KaT = Ka + 64 * QS;
  act_t* VT = KaT + DK * LS;
  act_t* ST = VT + DVS * LS;
  float* tot = (float*)(ST + DVS * SS);
  float* lf32 = tot + 2 * 4 * DK;
  const int tid = threadIdx.x, w = __builtin_amdgcn_readfirstlane(threadIdx.x >> 6), lane = tid & 63, fr = lane & 15, g = lane >> 4;
  const int dp = lane, c0 = 2 * dp;
  const bool cact = dp < DK / 2;
  constexpr int NCH = (C + T) / 64, NCC = C / 64;
  constexpr int NVI = DVS / 8 * 64;
  for (int item = blk; item < NB * 4 * 2 * 4; item += nblk) {
    const int sl = item & 3, dir = (item >> 2) & 1, h = (item >> 3) & 3, b = item >> 5;
    act_t* OD = dir == 0 ? p.OF : p.OB;
    const unsigned loff = (unsigned)min(c0, DK - 2) * 2u;
    const int vcol = (MODE == 0 ? E_HI + h * 128 : O_V + h * 192) + sl * DVS;
    const int ocol = h * DV + sl * DVS;
    auto chunk_base = [&](int n) -> long {
      if (n < NCC) return (long)b * C + (dir ? NCC - 1 - n : n) * 64;
      const int ln = n - NCC;
      return (long)NC + (long)b * T + (dir ? T / 64 - 1 - ln : ln) * 64;
    };
    auto lrow = [&](long base, int l) -> long { return base + (dir ? 63 - l : l); };
    f32x4 S[NET][2];
#pragma unroll
    for (int et = 0; et < NET; ++et) { S[et][0] = f32x4{0.f, 0.f, 0.f, 0.f}; S[et][1] = f32x4{0.f, 0.f, 0.f, 0.f}; }
    unsigned rlf[16], rq[16], rk[16];
    uint4 rv[2];
    const long rstep = dir ? -(long)PW * 2 : (long)PW * 2;
    const long lstep = dir ? -(long)384 * 2 : (long)384 * 2;
    const unsigned off_lf = (MODE == 0 ? (unsigned)(E_FF + dir * 512 + h * 128) * 2u : 0u) + loff;
    const unsigned off_q = (unsigned)(MODE == 0 ? E_HQ + h * 128 : O_Q + h * 96) * 2u + loff;
    const unsigned off_k = (unsigned)(O_K + h * 96) * 2u + loff;
    auto issue_loads = [&](int n) {
      const long base = chunk_base(n);
      {
        const char* prow = (const char*)(p.P + lrow(base, w * 16) * PW);
        const char* plf = (const char*)(p.LF + ((long)dir * NR + lrow(base, w * 16)) * 384 + h * 96);
#pragma unroll
        for (int i = 0; i < 16; ++i) {
          if (MODE == 0) {
            rlf[i] = *reinterpret_cast<const unsigned*>(prow + off_lf);
          } else {
            rlf[i] = *reinterpret_cast<const unsigned*>(plf + loff);
            rk[i] = *reinterpret_cast<const unsigned*>(prow + off_k);
            plf += lstep;
          }
          rq[i] = *reinterpret_cast<const unsigned*>(prow + off_q);
          prow += rstep;
        }
      }
#pragma unroll
      for (int r = 0; r < (NVI + 255) / 256; ++r) {
        const int it = min(tid + r * 256, NVI - 1);
        const int l = it / (DVS / 8), e8 = (it % (DVS / 8)) * 8;
        rv[r] = *reinterpret_cast<const uint4*>(p.P + lrow(base, l) * PW + vcol + e8);
      }
    };
    issue_loads(0);
    for (int n = 0; n < NCH; ++n) {
      const int par = n & 1;
      float* totp = tot + par * 4 * DK;
      float* lfp = lf32 + par * DK;
      const long base = chunk_base(n);
      if (cact) {
        float r0 = 0.f, r1 = 0.f;
#pragma unroll
        for (int i = 0; i < 16; ++i) { r0 += bf_lo(rlf[i]); r1 += bf_hi(rlf[i]); }
        totp[w * DK + c0] = r0; totp[w * DK + c0 + 1] = r1;
        if (w == 2) { lfp[c0] = bf_lo(rlf[0]); lfp[c0 + 1] = bf_hi(rlf[0]); }
      }
      __syncthreads();
#pragma unroll
      for (int r = 0; r < (NVI + 255) / 256; ++r) {
        const int it = tid + r * 256;
        if (it < NVI) {
          const int l = it / (DVS / 8), e8 = (it % (DVS / 8)) * 8;
          const unsigned vw[4] = {rv[r].x, rv[r].y, rv[r].z, rv[r].w};
#pragma unroll
          for (int e = 0; e < 4; ++e) {
            VT[(e8 + 2 * e) * LS + l] = (act_t)(vw[e] & 0xffffu);
            VT[(e8 + 2 * e + 1) * LS + l] = (act_t)(vw[e] >> 16);
          }
        }
      }
      if (cact) {
        float of0 = 0.f, of1 = 0.f;
#pragma unroll
        for (int sgi = 0; sgi < 3; ++sgi)
          if (sgi < w) { of0 += totp[sgi * DK + c0]; of1 += totp[sgi * DK + c0 + 1]; }
        const float ref0 = totp[c0] + totp[DK + c0] + lfp[c0];
        const float ref1 = totp[c0 + 1] + totp[DK + c0 + 1] + lfp[c0 + 1];
        unsigned kt0[8], kt1[8];
        float run0 = of0 - ref0, run1 = of1 - ref1;
#pragma unroll
        for (int i = 0; i < 16; i += 2) {
          float ka0[2], ka1[2];
#pragma unroll
          for (int ii = 0; ii < 2; ++ii) {
            const int i2 = i + ii;
            run0 += bf_lo(rlf[i2]); run1 += bf_hi(rlf[i2]);
            const float b0 = run0, b1 = run1;
            const float e0 = __expf(b0), e1 = __expf(b1), f0 = __expf(-b0), f1 = __expf(-b1);
            float k0, k1;
            if (MODE == 0) { k0 = 1.0f - __expf(bf_lo(rlf[i2])); k1 = 1.0f - __expf(bf_hi(rlf[i2])); }
            else { k0 = bf_lo(rk[i2]); k1 = bf_hi(rk[i2]); }
            ka0[ii] = k0 * f0; ka1[ii] = k1 * f1;
            const int l = w * 16 + i2;
            *reinterpret_cast<unsigned*>(Qa + l * QS + c0) = pack2(bf_lo(rq[i2]) * e0, bf_hi(rq[i2]) * e1);
            *reinterpret_cast<unsigned*>(Ka + l * QS + c0) = pack2(ka0[ii], ka1[ii]);
          }
          kt0[i >> 1] = pack2(ka0[0], ka0[1]);
          kt1[i >> 1] = pack2(ka1[0], ka1[1]);
        }
        uint4* d0 = reinterpret_cast<uint4*>(KaT + c0 * LS + w * 16);
        d0[0] = make_uint4(kt0[0], kt0[1], kt0[2], kt0[3]); d0[1] = make_uint4(kt0[4], kt0[5], kt0[6], kt0[7]);
        uint4* d1 = reinterpret_cast<uint4*>(KaT + (c0 + 1) * LS + w * 16);
        d1[0] = make_uint4(kt1[0], kt1[1], kt1[2], kt1[3]); d1[1] = make_uint4(kt1[4], kt1[5], kt1[6], kt1[7]);
      }
      issue_loads(min(n + 1, NCH - 1));
      float egv[2], egrv[2];
#pragma unroll
      for (int di = 0; di < 2; ++di) {
        const int dt = w + 4 * di;
        if (dt < NDT) {
          const int d = dt * 16 + fr;
          const float refd = totp[d] + totp[DK + d] + lfp[d];
          const float gd = totp[d] + totp[DK + d] + totp[2 * DK + d] + totp[3 * DK + d];
          const float er = __expf(refd);
          egv[di] = __expf(gd); egrv[di] = __expf(gd - refd);
#pragma unroll
          for (int et = 0; et < NET; ++et)
#pragma unroll
            for (int j = 0; j < 4; ++j) stA(ST + (et * 16 + 4 * g + j) * SS + d, S[et][di][j] * er);
        }
      }
      __syncthreads();
      bf16x8 qfr[NKS];
#pragma unroll
      for (int ks = 0; ks < NKS; ++ks) qfr[ks] = *reinterpret_cast<const bf16x8*>(Qa + (w * 16 + fr) * QS + ks * 32 + g * 8);
      bf16x8 pfr[2];
#pragma unroll
      for (int kb = 0; kb < 2; ++kb) {
        f32x4 at2[2];
#pragma unroll
        for (int h2 = 0; h2 < 2; ++h2) {
          const int mt = 2 * kb + h2;
          at2[h2] = f32x4{0.f, 0.f, 0.f, 0.f};
          if (mt <= w) {
#pragma unroll
            for (int ks = 0; ks < NKS; ++ks) {
              const bf16x8 kaf = *reinterpret_cast<const bf16x8*>(Ka + (mt * 16 + fr) * QS + ks * 32 + g * 8);
              at2[h2] = __builtin_amdgcn_mfma_f32_16x16x32_bf16(kaf, qfr[ks], at2[h2], 0, 0, 0);
            }
            if (mt == w) {
#pragma unroll
              for (int j = 0; j < 4; ++j)
                if (4 * g + j > fr) at2[h2][j] = 0.f;
            }
          }
        }
        union { unsigned u[4]; bf16x8 v; } cv;
        cv.u[0] = pack2_mfma(at2[0][0], at2[0][1]); cv.u[1] = pack2_mfma(at2[0][2], at2[0][3]);
        cv.u[2] = pack2_mfma(at2[1][0], at2[1][1]); cv.u[3] = pack2_mfma(at2[1][2], at2[1][3]);
        pfr[kb] = cv.v;
      }
      const long orow = lrow(base, w * 16 + fr);
#pragma unroll
      for (int et = 0; et < NET; ++et) {
        f32x4 o = f32x4{0.f, 0.f, 0.f, 0.f};
#pragma unroll
        for (int kb = 0; kb < 2; ++kb) {
          if (2 * kb <= w) {
            union { uint2 h2[2]; bf16x8 v; } vf;
            vf.h2[0] = *reinterpret_cast<const uint2*>(VT + (et * 16 + fr) * LS + kb * 32 + 4 * g);
            vf.h2[1] = *reinterpret_cast<const uint2*>(VT + (et * 16 + fr) * LS + kb * 32 + 16 + 4 * g);
            o = __builtin_amdgcn_mfma_f32_16x16x32_bf16(vf.v, pfr[kb], o, 0, 0, 0);
          }
        }
#pragma unroll
        for (int ks = 0; ks < NKS; ++ks) {
          const bf16x8 sf = *reinterpret_cast<const bf16x8*>(ST + (et * 16 + fr) * SS + ks * 32 + g * 8);
          o = __builtin_amdgcn_mfma_f32_16x16x32_bf16(sf, qfr[ks], o, 0, 0, 0);
        }
        const float osc = MODE == 0 ? 1.0f : 0.10206207261596575f;
        *reinterpret_cast<uint2*>(OD + orow * 768 + ocol + et * 16 + 4 * g) =
            make_uint2(pack2(o[0] * osc, o[1] * osc), pack2(o[2] * osc, o[3] * osc));
      }
#pragma unroll
      for (int di = 0; di < 2; ++di) {
        const int dt = w + 4 * di;
        if (dt < NDT) {
#pragma unroll
          for (int et = 0; et < NET; ++et) {
            f32x4 r = f32x4{0.f, 0.f, 0.f, 0.f};
#pragma unroll
            for (int k2 = 0; k2 < 2; ++k2) {
              const bf16x8 vf = *reinterpret_cast<const bf16x8*>(VT + (et * 16 + fr) * LS + k2 * 32 + g * 8);
              const bf16x8 kf = *reinterpret_cast<const bf16x8*>(KaT + (dt * 16 + fr) * LS + k2 * 32 + g * 8);
              r = __builtin_amdgcn_mfma_f32_16x16x32_bf16(vf, kf, r, 0, 0, 0);
            }
#pragma unroll
            for (int j = 0; j < 4; ++j) S[et][di][j] = egv[di] * S[et][di][j] + egrv[di] * r[j];
          }
        }
      }
    }
    __syncthreads();
  }
}

struct GemmJob {
  const act_t* A; const act_t* Bt; act_t* C;
  long sA, sB, sC;
  int nbatch, Mtiles, Ntiles, K, ldc, Nvalid, mode;
  float scale;
  int fp8;
};
__device__ __forceinline__ void phase_gemm(const Params& p, const GemmJob& g, unsigned char* smem, int blk = blockIdx.x, int nblk = gridDim.x) {
  const int per_b = g.Mtiles * g.Ntiles;
  const int ntiles = per_b * g.nbatch;
  for (int tile = blk; tile < ntiles; tile += nblk) {
    const int b = tile / per_b, tt = tile % per_b;
    const int tm = tt / g.Ntiles, tn = tt % g.Ntiles;
    if (g.mode == 1 && tm < NC / 128 && tn * 128 >= O_FA) continue;
    const int K = g.K, ldc = g.ldc;
    const act_t* Ab = g.A + b * g.sA + (long)tm * 128 * K;
    act_t* Cb = g.C + b * g.sC + (long)tm * 128 * ldc + tn * 128;
    const int nlim = g.Nvalid - tn * 128;
    const float scale = g.scale;
    const int mode = g.mode;
    if (mode == 1) {
      auto epi1 = [&](f32x4 (&acc)[4][4], int wr, int wc, int fr, int fq) {
                  if (g.fp8) {
#pragma unroll
                    for (int m = 0; m < 4; ++m)
#pragma unroll
                      for (int n = 0; n < 4; ++n) acc[m][n] = acc[m][n] * scale;
                  }
#pragma unroll
                  for (int m = 0; m < 4; ++m)
#pragma unroll
                    for (int n = 0; n < 4; ++n) {
                      const int col = wc * 64 + n * 16 + fr;
                      if (col < nlim) {
#pragma unroll
                        for (int j = 0; j < 4; ++j) {
                          const int row = wr * 64 + m * 16 + fq * 4 + j;
                          stA(Cb + (long)row * ldc + col, acc[m][n][j]);
                        }
                      } else {
                        const int gc = tn * 128 + col;
                        if (gc < O_END && tm >= NC / 128) {
                          const int lr = (tm - NC / 128) * 128 + wr * 64 + m * 16 + fq * 4;
                          const int bb = lr / T, t = lr % T;
                          const int cq = gc < O_FB ? gc - O_FA : gc - O_FB;
                          act_t* dst = p.FT + ((long)bb * 256 + cq) * (2 * T) + (gc < O_FB ? 0 : T) + t;
                          *reinterpret_cast<uint2*>(dst) = make_uint2(pack2(acc[m][n][0], acc[m][n][1]), pack2(acc[m][n][2], acc[m][n][3]));
                        }
                      }
                    }
                };
      if (g.fp8) {
        const fp8_t* A8 = (const fp8_t*)g.A + (long)tm * 128 * K;
        gemm_tile8<false>([&](int r) { return A8 + (long)r * K; }, (const fp8_t*)g.Bt + (long)tn * 128 * K, K, smem, epi1);
      } else {
        gemm_tile<false>([&](int r) { return Ab + (long)r * K; }, g.Bt + b * g.sB + (long)tn * 128 * K, K, smem, epi1);
      }
    } else {
      auto epi2 = [&](f32x4 (&acc)[4][4], int wr, int wc, int fr, int fq) {
                  const float oscale = g.fp8 ? 1.0f : scale;
                  if (g.fp8) {
#pragma unroll
                    for (int m = 0; m < 4; ++m)
#pragma unroll
                      for (int n = 0; n < 4; ++n) acc[m][n] = acc[m][n] * scale;
                  }
                  if (mode == 2) {
                    const int cb = tn * 128 + wc * 64;
                    if (cb < E_AV && tm >= NC / 128) {
                      const float4* rt = reinterpret_cast<const float4*>(p.ropetab);
#pragma unroll
                      for (int m = 0; m < 4; ++m) {
                        const int t = ((tm - NC / 128) * 128 + wr * 64 + m * 16 + fr) % T;
                        const float4 r01 = rt[(t / GRID_W) * 8 + fq * 2], r23 = rt[(t / GRID_W) * 8 + fq * 2 + 1];
                        const float4 c01 = rt[(t % GRID_W) * 8 + fq * 2], c23 = rt[(t % GRID_W) * 8 + fq * 2 + 1];
                        const float rc[4] = {r01.x, r01.z, r23.x, r23.z}, rs_[4] = {r01.y, r01.w, r23.y, r23.w};
                        const float cc[4] = {c01.x, c01.z, c23.x, c23.z}, cs_[4] = {c01.y, c01.w, c23.y, c23.w};
#pragma unroll
                        for (int j = 0; j < 4; ++j) {
                          const float a1 = acc[m][0][j], a2 = acc[m][1][j], b1 = acc[m][2][j], b2 = acc[m][3][j];
                          acc[m][0][j] = a1 * rc[j] - a2 * rs_[j]; acc[m][1][j] = a1 * rs_[j] + a2 * rc[j];
                          acc[m][2][j] = b1 * cc[j] - b2 * cs_[j]; acc[m][3][j] = b1 * cs_[j] + b2 * cc[j];
                        }
                      }
                    } else if (cb >= E_FF && cb < E_HQ) {
#pragma unroll
                      for (int n = 0; n < 4; ++n) {
                        const float4 lb4 = *reinterpret_cast<const float4*>(p.lbt + cb - E_FF + n * 16 + fq * 4);
                        const float lb[4] = {lb4.x, lb4.y, lb4.z, lb4.w};
#pragma unroll
                        for (int m = 0; m < 4; ++m)
#pragma unroll
                          for (int j = 0; j < 4; ++j)
                            acc[m][n][j] = __logf(lb[j] + (1.0f - lb[j]) / (1.0f + __expf(-acc[m][n][j])));
                      }
                    }
                  }
#pragma unroll
                  for (int m = 0; m < 4; ++m) {
                    const int row = wr * 64 + m * 16 + fr;
#pragma unroll
                    for (int n = 0; n < 4; ++n) {
                      const int col = wc * 64 + n * 16 + fq * 4;
                      if (col < nlim)
                        *reinterpret_cast<uint2*>(Cb + (long)row * ldc + col) =
                            make_uint2(pack2(acc[m][n][0] * oscale, acc[m][n][1] * oscale), pack2(acc[m][n][2] * oscale, acc[m][n][3] * oscale));
                    }
                  }
                };
      if (g.fp8) {
        const fp8_t* A8 = (const fp8_t*)g.A + (long)tm * 128 * K;
        gemm_tile8<true>([&](int r) { return A8 + (long)r * K; }, (const fp8_t*)g.Bt + (long)tn * 128 * K, K, smem, epi2);
      } else {
        gemm_tile<true>([&](int r) { return Ab + (long)r * K; }, g.Bt + b * g.sB + (long)tn * 128 * K, K, smem, epi2);
      }
    }
  }
}

template <class RowMap>
__device__ __forceinline__ void conv_tile_rm(const float* src, int lds_, int Nvalid, int k0, int n0, act_t* dst, int ldd, float* tile, RowMap rm) {
  const int tid = threadIdx.x;
  {
    const int r = tid >> 5, c4 = (tid & 31) * 4;
    float4 v[8];
#pragma unroll
    for (int rr = 0; rr < 8; ++rr) {
      v[rr] = make_float4(0.f, 0.f, 0.f, 0.f);
      if (n0 + c4 < Nvalid) v[rr] = *reinterpret_cast<const float4*>(src + (long)(k0 + r + rr * 8) * lds_ + n0 + c4);
    }
#pragma unroll
    for (int rr = 0; rr < 8; ++rr) {
      float* t = tile + (r + rr * 8) * 129 + c4;
      t[0] = v[rr].x; t[1] = v[rr].y; t[2] = v[rr].z; t[3] = v[rr].w;
    }
  }
  __syncthreads();
  {
    const int n = tid >> 1, ks = (tid & 1) * 32;
    if (n0 + n < Nvalid) {
      unsigned w[16];
#pragma unroll
      for (int i = 0; i < 16; ++i) w[i] = pack2(tile[(ks + 2 * i) * 129 + n], tile[(ks + 2 * i + 1) * 129 + n]);
      uint4* d = reinterpret_cast<uint4*>(dst + (long)rm(n) * ldd + k0 + ks);
      d[0] = make_uint4(w[0], w[1], w[2], w[3]);
      d[1] = make_uint4(w[4], w[5], w[6], w[7]);
      d[2] = make_uint4(w[8], w[9], w[10], w[11]);
      d[3] = make_uint4(w[12], w[13], w[14], w[15]);
    }
  }
  __syncthreads();
}

template <class RowMap>
__device__ __forceinline__ void conv_tile8_rm(const float* src, int lds_, int k0, int n0, fp8_t* dst, int ldd, float* tile, float scale, RowMap rm, int Nvalid = 1 << 30) {
  const int tid = threadIdx.x;
  {
    const int r = tid >> 5, c4 = (tid & 31) * 4;
    float4 v[8];
#pragma unroll
    for (int rr = 0; rr < 8; ++rr) {
      v[rr] = make_float4(0.f, 0.f, 0.f, 0.f);
      if (n0 + c4 < Nvalid) v[rr] = *reinterpret_cast<const float4*>(src + (long)(k0 + r + rr * 8) * lds_ + n0 + c4);
    }
#pragma unroll
    for (int rr = 0; rr < 8; ++rr) {
      float* t = tile + (r + rr * 8) * 129 + c4;
      t[0] = v[rr].x; t[1] = v[rr].y; t[2] = v[rr].z; t[3] = v[rr].w;
    }
  }
  __syncthreads();
  if ((threadIdx.x >> 1) + n0 < Nvalid) {
    const int n = tid >> 1, ks = (tid & 1) * 32;
    unsigned w[8];
#pragma unroll
    for (int i = 0; i < 8; ++i)
      w[i] = pack4_fp8(tile[(ks + 4 * i) * 129 + n] * scale, tile[(ks + 4 * i + 1) * 129 + n] * scale,
                       tile[(ks + 4 * i + 2) * 129 + n] * scale, tile[(ks + 4 * i + 3) * 129 + n] * scale);
    uint4* d = reinterpret_cast<uint4*>(dst + (long)rm(n) * ldd + k0 + ks);
    d[0] = make_uint4(w[0], w[1], w[2], w[3]);
    d[1] = make_uint4(w[4], w[5], w[6], w[7]);
  }
  __syncthreads();
}

__device__ __forceinline__ void conv_tile(const float* src, int lds_, int Nvalid, int k0, int n0, act_t* dst, int ldd, float* tile) {
  conv_tile_rm(src, lds_, Nvalid, k0, n0, dst, ldd, tile, [=](int n) { return n0 + n; });
}

__device__ __forceinline__ void phase_convert_experts(const Params& p, int l, unsigned char* smem, int blk, int nblk) {
  float* tile = (float*)smem;
  const int per_e = 192;
  fp8_t* Wup = l == 0 ? p.W8up : p.W8up1;
  fp8_t* Wdn = l == 0 ? p.W8down : p.W8down1;
  for (int job = blk; job < NEXP * per_e; job += nblk) {
    const int e = job / per_e, j = job % per_e;
    if (j < 128) {
      const int up = j >> 6, jj = j & 63;
      const int kt = jj >> 2, fp = jj & 3;
      const float* src = (up ? p.w_eu : p.w_eg) + ((long)(l * NEXP + e) * D) * DFF;
      const int rbase = fp * 256 + up * 32;
      conv_tile8_rm(src, DFF, kt * 64, fp * 128, Wup + (long)e * 1024 * D, D, tile, SW8,
                    [=](int n) { return rbase + (n >> 6) * 128 + ((n >> 5) & 1) * 64 + (n & 31); });
    } else {
      const int jj = j - 128;
      const int kt = jj >> 3, nt = jj & 7;
      const float* src = p.w_ed + ((long)(l * NEXP + e) * DFF) * D;
      const int n0 = nt * 128;
      conv_tile8_rm(src, D, kt * 64, n0, Wdn + (long)e * 1024 * DFF, DFF, tile, SW8, [=](int n) { return n0 + n; });
    }
  }
}

__device__ __forceinline__ void phase_moe(const Params& p, int l, bool down, unsigned char* smem) {
  const int* cntp = p.cnt + l * NEXP * 64;
  int total = 0;
  for (int e = 0; e < NEXP; ++e) total += ((cntp[e * 64] + 127) >> 7) * 8;
  for (int tile = blockIdx.x; tile < total; tile += gridDim.x) {
    int e = 0, tb = 0, rowoff = 0;
    for (; e < NEXP - 1; ++e) {
      const int c = cntp[e * 64];
      const int nt = ((c + 127) >> 7) * 8;
      if (tile < tb + nt) break;
      tb += nt; rowoff += c;
    }
    const int c = cntp[e * 64];
    const int lt = tile - tb, mt = lt >> 3, nt = lt & 7;
    const int rows_valid = min(128, c - mt * 128);
    const int* lst = p.list + (long)(l * NEXP + e) * NR + mt * 128;
    const long hrow0 = (long)rowoff + mt * 128;
    if (!down) {
      gemm_tile8<true>([&](int r) { return p.u8 + (long)(lst[min(r, rows_valid - 1)] >> 1) * D; },
                (l == 0 ? p.W8up : p.W8up1) + ((long)e * 1024 + nt * 128) * D, D, smem,
                [&](f32x4 (&acc)[4][4], int wr, int wc, int fr, int fq) {
                  constexpr float dq = 1.0f / (SU8 * SW8);
#pragma unroll
                  for (int m = 0; m < 4; ++m) {
                    const int row = wr * 64 + m * 16 + fr;
                    if (row < rows_valid) {
#pragma unroll
                      for (int n = 0; n < 2; ++n) {
                        float hv[4];
#pragma unroll
                        for (int j = 0; j < 4; ++j) {
                          const float g = acc[m][n][j] * dq, uu = acc[m][n + 2][j] * dq;
                          hv[j] = g / (1.0f + __expf(-g)) * uu * SH8;
                        }
                        *reinterpret_cast<unsigned*>(p.H8 + (hrow0 + row) * DFF + nt * 64 + wc * 32 + n * 16 + fq * 4) =
                            pack4_fp8(hv[0], hv[1], hv[2], hv[3]);
                      }
                    }
                  }
                });
    } else {
      const fp8_t* Ab = p.H8 + hrow0 * DFF;
      gemm_tile8<true>([&](int r) { return Ab + (long)r * DFF; }, (l == 0 ? p.W8down : p.W8down1) + ((long)e * 1024 + nt * 128) * DFF, DFF, smem,
                [&](f32x4 (&acc)[4][4], int wr, int wc, int fr, int fq) {
                  constexpr float dq = 1.0f / (SH8 * SW8);
#pragma unroll
                  for (int m = 0; m < 4; ++m) {
                    const int row = wr * 64 + m * 16 + fr;
                    if (row < rows_valid) {
                      const int ts = lst[row];
                      const float w = p.ew[ts] * dq;
#pragma unroll
                      for (int n = 0; n < 4; ++n)
                        *reinterpret_cast<uint2*>(p.Y + (long)ts * D + nt * 128 + wc * 64 + n * 16 + fq * 4) =
                            make_uint2(pack2(acc[m][n][0] * w, acc[m][n][1] * w), pack2(acc[m][n][2] * w, acc[m][n][3] * w));
                    }
                  }
                });
    }
  }
}

__device__ __forceinline__ void phase_convert_dense(const Params& p, unsigned char* smem) {
  float* tile = (float*)smem;
  const int JM = MOD_ITEMS, J0 = JM + 16 * 26, J1 = J0 + 128, J2 = J1 + 16 * 19, J3 = J2 + 128;
  for (int job = blockIdx.x; job < J3; job += gridDim.x) {
    if (job < JM) { mod_item(p, job, smem); continue; }
    if (job < J0) { int j = job - JM; const int n0 = (j % 26) * 128; conv_tile8_rm(p.w_in_even, IN_EVEN, (j / 26) * 64, n0, p.W8in_even, D, tile, SW8, [=](int n) { return n0 + n; }); }
    else if (job < J1) { int j = job - J0; conv_tile(p.w_out_even, D, D, (j / 8) * 64, (j % 8) * 128, p.Wt_out_even, D, tile); }
    else if (job < J2) { int j = job - J1; const int n0 = (j % 19) * 128; conv_tile8_rm(p.w_in_odd, IN_ODD, (j / 19) * 64, n0, p.W8in_odd, D, tile, SW8, [=](int n) { return n0 + n; }, O_FA); }
    else { int j = job - J2; conv_tile(p.w_out_odd, D, D, (j / 8) * 64, (j % 8) * 128, p.Wt_out_odd, D, tile); }
  }
}

__device__ __forceinline__ void phase_fold_z(const Params& p, long gtid, long gstride, float* tab) {
  if (threadIdx.x < 64) {
    float sn, cs;
    sincospif((float)threadIdx.x * (1.0f / 32.0f), &sn, &cs);
    tab[threadIdx.x] = cs; tab[64 + threadIdx.x] = -sn;
  }
  __syncthreads();
  for (long i = gtid; i < (long)512 * D; i += gstride) {
    const int k = (int)(i % D), np = (int)(i / D);
    const int part = np >> 8, col = np & 255, g = col >> 6, cp = col & 63;
    const float* wz = p.w_in_odd + (long)k * IN_ODD + O_Z + g * 64;
    float s = 0.f;
    const float* tb = tab + part * 64;
    float4 wv[16];
#pragma unroll
    for (int q = 0; q < 16; ++q) wv[q] = reinterpret_cast<const float4*>(wz)[q];
#pragma unroll
    for (int q = 0; q < 16; ++q) {
      s += wv[q].x * tb[((4 * q) * cp) & 63] + wv[q].y * tb[((4 * q + 1) * cp) & 63] + wv[q].z * tb[((4 * q + 2) * cp) & 63] +
           wv[q].w * tb[((4 * q + 3) * cp) & 63];
    }
    const unsigned q = pack4_fp8(s * SW8, 0.f, 0.f, 0.f);
    p.W8in_odd[(long)(O_FA + np) * D + k] = (unsigned char)(q & 0xffu);
  }
  for (long i = gtid; i < (long)(IN_ODD_PAD - O_END) * D; i += gstride) p.W8in_odd[(long)O_END * D + i] = 0;
}

__device__ __forceinline__ void phase_cmat(const Params& p, long gtid, long gstride) {
  for (long i = gtid; i < (long)T * T; i += gstride) {
    const int t = (int)(i % T), tp = (int)(i / T);
    float sn, cs;
    sincospif((float)((t * tp) & (T - 1)) * (2.0f / T), &sn, &cs);
    stA(p.Cmat + (long)tp * 2 * T + t, cs);
    stA(p.Cmat + (long)tp * 2 * T + T + t, sn);
  }
}

__device__ __forceinline__ void row_stats(const float4 (&v)[4], float& mu, float& rs) {
  float s = 0.f;
#pragma unroll
  for (int i = 0; i < 4; ++i) s += v[i].x + v[i].y + v[i].z + v[i].w;
  mu = wave_sum(s) * (1.0f / D);
  float q = 0.f;
#pragma unroll
  for (int i = 0; i < 4; ++i) {
    float a = v[i].x - mu, b = v[i].y - mu, c = v[i].z - mu, d = v[i].w - mu;
    q += a * a + b * b + c * c + d * d;
  }
  rs = 1.0f / sqrtf(wave_sum(q) * (1.0f / D) + LN_EPS);
}

__device__ __forceinline__ void phase_lnmod_first(const Params& p) {
  const int lane = threadIdx.x & 63;
  const long nw = (long)gridDim.x * 4, wi = (long)blockIdx.x * 4 + (threadIdx.x >> 6);
  const long rpw = (NR + nw - 1) / nw;
  const long r0 = wi * rpw, r1 = min((long)NR, r0 + rpw);
  float4 shv[4], scv[4];
  int cur_bb = -2;
  float4 hv[4];
  auto load_row = [&](long row) {
    const float4* h = reinterpret_cast<const float4*>(hrow_in(p, row));
#pragma unroll
    for (int i = 0; i < 4; ++i) hv[i] = h[i * 64 + lane];
  };
  if (r0 < r1) load_row(r0);
  for (long row = r0; row < r1; ++row) {
    const int bb = row < NC ? NB : (int)((row - NC) / T);
    if (bb != cur_bb) {
      cur_bb = bb;
      const float* md = p.mod + (long)bb * 6 * D;
#pragma unroll
      for (int i = 0; i < 4; ++i) {
        shv[i] = reinterpret_cast<const float4*>(md)[i * 64 + lane];
        scv[i] = reinterpret_cast<const float4*>(md + D)[i * 64 + lane];
      }
    }
    float4 v[4];
#pragma unroll
    for (int i = 0; i < 4; ++i) v[i] = hv[i];
    load_row(min(row + 1, r1 - 1));
    float mu, rs;
    row_stats(v, mu, rs);
#pragma unroll
    for (int i = 0; i < 4; ++i) {
      const float a = (v[i].x - mu) * rs * (1.f + scv[i].x) + shv[i].x, b = (v[i].y - mu) * rs * (1.f + scv[i].y) + shv[i].y;
      const float c = (v[i].z - mu) * rs * (1.f + scv[i].z) + shv[i].z, d = (v[i].w - mu) * rs * (1.f + scv[i].w) + shv[i].w;
      reinterpret_cast<unsigned*>(p.u8 + row * D)[i * 64 + lane] = pack4_fp8(a * SU8, b * SU8, c * SU8, d * SU8);
    }
  }
}

__device__ __forceinline__ act_t* hrow16(const Params& p, long row) {
  return row < NC ? reinterpret_cast<act_t*>(p.hc) + row * D
                  : reinterpret_cast<act_t*>(reinterpret_cast<char*>(p.out) + (row - NC) * (long)(4 * D) + 2 * D);
}
template <int R_UNUSED>
__device__ __forceinline__ void phase_resid_ln(const Params& p, int l, int sub, long row_lo, long row_hi, unsigned char* smem) {
  const int lane = threadIdx.x & 63;
  int* cntL = (int*)smem;
  int* nent = cntL + 16;
  int* entL = cntL + 32;
  float* wT = (float*)(smem + 4096);
  if (sub == 0) {
    if (threadIdx.x < 32) cntL[threadIdx.x] = 0;
    {
      float4 wr4[16];
#pragma unroll
      for (int j = 0; j < 4; ++j)
#pragma unroll
        for (int q = 0; q < 4; ++q) wr4[j * 4 + q] = reinterpret_cast<const float4*>(p.w_router + (long)(threadIdx.x + 256 * j) * NEXP)[q];
#pragma unroll
      for (int j = 0; j < 4; ++j)
#pragma unroll
        for (int q = 0; q < 4; ++q) {
          const int k = threadIdx.x + 256 * j;
          wT[(q * 4 + 0) * D + k] = wr4[j * 4 + q].x; wT[(q * 4 + 1) * D + k] = wr4[j * 4 + q].y;
          wT[(q * 4 + 2) * D + k] = wr4[j * 4 + q].z; wT[(q * 4 + 3) * D + k] = wr4[j * 4 + q].w;
        }
    }
    __syncthreads();
  }
  const bool last = (sub == 1 && l == 1);
  const long nw = (long)gridDim.x * 4, wi = (long)blockIdx.x * 4 + (threadIdx.x >> 6);
  const long rpw = (row_hi - row_lo + nw - 1) / nw;
  const long r0 = row_lo + wi * rpw, r1 = min(row_hi, r0 + rpw);
  const float4* lgp = reinterpret_cast<const float4*>(p.ln_g + (l * 2 + sub) * D);
  const float4* lbp = reinterpret_cast<const float4*>(p.ln_b + (l * 2 + sub) * D);
  float4 lgv[4], lbv[4];
  if (R_UNUSED != 1) {
#pragma unroll
    for (int i = 0; i < 4; ++i) { lgv[i] = lgp[i * 64 + lane]; lbv[i] = lbp[i * 64 + lane]; }
  }
  float4 gv[4], shv[4], scv[4];
  int cur_bb = -2;
  const bool first = (l == 0 && sub == 0);
  float4 hv[4];
  uint2 hb[4];
  uint2 mv[4], m2v[4];
  auto load_row = [&](long row) {
    const uint2* m = reinterpret_cast<const uint2*>(sub == 0 ? p.M + row * D : p.Y + row * 2 * D);
    if (first) {
      const float4* hin = reinterpret_cast<const float4*>(hrow_in(p, row));
#pragma unroll
      for (int i = 0; i < 4; ++i) hv[i] = hin[i * 64 + lane];
    } else {
      const uint2* hin = reinterpret_cast<const uint2*>(hrow16(p, row));
#pragma unroll
      for (int i = 0; i < 4; ++i) hb[i] = hin[i * 64 + lane];
    }
#pragma unroll
    for (int i = 0; i < 4; ++i) {
      mv[i] = m[i * 64 + lane];
      if (sub == 1) m2v[i] = m[256 + i * 64 + lane];
    }
  };
  if (r0 < r1) load_row(r0);
  for (long row = r0; row < r1; ++row) {
    const int bb = row < NC ? NB : (int)((row - NC) / T);
    if (bb != cur_bb) {
      cur_bb = bb;
      const float* md = p.mod + ((long)l * (NB + 1) + bb) * 6 * D;
      const float* md2 = (sub == 0) ? md + 3 * D : p.mod + ((long)(NB + 1) + bb) * 6 * D;
#pragma unroll
      for (int i = 0; i < 4; ++i) {
        gv[i] = reinterpret_cast<const float4*>(md + (sub == 0 ? 2 : 5) * D)[i * 64 + lane];
        shv[i] = reinterpret_cast<const float4*>(md2)[i * 64 + lane];
        scv[i] = reinterpret_cast<const float4*>(md2 + D)[i * 64 + lane];
      }
    }
    float4 v[4];
#pragma unroll
    for (int i = 0; i < 4; ++i) {
      float m0 = bf_lo(mv[i].x), m1 = bf_hi(mv[i].x), m2_ = bf_lo(mv[i].y), m3 = bf_hi(mv[i].y);
      if (sub == 1) { m0 += bf_lo(m2v[i].x); m1 += bf_hi(m2v[i].x); m2_ += bf_lo(m2v[i].y); m3 += bf_hi(m2v[i].y); }
      const float h0 = first ? hv[i].x : bf_lo(hb[i].x), h1 = first ? hv[i].y : bf_hi(hb[i].x);
      const float h2 = first ? hv[i].z : bf_lo(hb[i].y), h3 = first ? hv[i].w : bf_hi(hb[i].y);
      v[i].x = ALPHA * h0 + gv[i].x * m0;
      v[i].y = ALPHA * h1 + gv[i].y * m1;
      v[i].z = ALPHA * h2 + gv[i].z * m2_;
      v[i].w = ALPHA * h3 + gv[i].w * m3;
    }
    load_row(min(row + 1, r1 - 1));
    if (R_UNUSED == 1) {
#pragma unroll
      for (int i = 0; i < 4; ++i) { lgv[i] = lgp[i * 64 + lane]; lbv[i] = lbp[i * 64 + lane]; }
    }
    float mu, rs;
    row_stats(v, mu, rs);
#pragma unroll
    for (int i = 0; i < 4; ++i) {
      v[i].x = (v[i].x - mu) * rs * lgv[i].x + lbv[i].x;
      v[i].y = (v[i].y - mu) * rs * lgv[i].y + lbv[i].y;
      v[i].z = (v[i].z - mu) * rs * lgv[i].z + lbv[i].z;
      v[i].w = (v[i].w - mu) * rs * lgv[i].w + lbv[i].w;
    }
    if (last) {
      float4* hout = reinterpret_cast<float4*>(p.out + (row - NC) * D);
#pragma unroll
      for (int i = 0; i < 4; ++i) hout[i * 64 + lane] = v[i];
      continue;
    }
    uint2 hq[4];
#pragma unroll
    for (int i = 0; i < 4; ++i) {
      hq[i] = make_uint2(pack2(v[i].x, v[i].y), pack2(v[i].z, v[i].w));
      v[i].x = bf_lo(hq[i].x); v[i].y = bf_hi(hq[i].x); v[i].z = bf_lo(hq[i].y); v[i].w = bf_hi(hq[i].y);
    }
    row_stats(v, mu, rs);
    float lo[NEXP];
#pragma unroll
    for (int e = 0; e < NEXP; ++e) lo[e] = 0.f;
    uint2 up[4];
#pragma unroll
    for (int i = 0; i < 4; ++i) {
      float uv[4];
      uv[0] = (v[i].x - mu) * rs * (1.f + scv[i].x) + shv[i].x;
      uv[1] = (v[i].y - mu) * rs * (1.f + scv[i].y) + shv[i].y;
      uv[2] = (v[i].z - mu) * rs * (1.f + scv[i].z) + shv[i].z;
      uv[3] = (v[i].w - mu) * rs * (1.f + scv[i].w) + shv[i].w;
      up[i] = make_uint2(pack4_fp8(uv[0] * SU8, uv[1] * SU8, uv[2] * SU8, uv[3] * SU8), 0u);
      if (sub == 0) {
#pragma unroll
        for (int e = 0; e < NEXP; ++e) {
          const float4 w4 = *reinterpret_cast<const float4*>(wT + e * D + (i * 64 + lane) * 4);
          lo[e] += uv[0] * w4.x + uv[1] * w4.y + uv[2] * w4.z + uv[3] * w4.w;
          if ((e & 3) == 3) __builtin_amdgcn_sched_barrier(0);
        }
      }
    }
    int ge1 = 0, ge2 = 0;
    float w1 = 0.f, w2 = 0.f;
    if (sub == 0) {
      float mine = 0.f;
#pragma unroll
      for (int e = 0; e < NEXP; ++e) {
        const float rsum = row_sum16(lo[e]);
        mine = ((lane & 15) == e) ? rsum : mine;
      }
      mine += __shfl_xor(mine, 16);
      mine += __shfl_xor(mine, 32);
#pragma unroll
      for (int e = 0; e < NEXP; ++e) lo[e] = __int_as_float(__builtin_amdgcn_readlane(__float_as_int(mine), e));
      float mx = lo[0];
#pragma unroll
      for (int e = 1; e < NEXP; ++e) mx = fmaxf(mx, lo[e]);
      float sum = 0.f;
#pragma unroll
      for (int e = 0; e < NEXP; ++e) { lo[e] = __expf(lo[e] - mx); sum += lo[e]; }
      const float inv = 1.0f / sum;
      float bestg = -1e30f, gp1 = 0.f, gp2 = 0.f;
#pragma unroll
      for (int gq = 0; gq < 4; ++gq) {
        float s1 = -1e30f, s2 = -1e30f, p1 = 0.f, p2 = 0.f;
        int e1 = 0, e2 = 0;
#pragma unroll
        for (int j = 0; j < 4; ++j) {
          const int e = gq * 4 + j;
          const float pe = lo[e] * inv;
          const float se = pe + p.b_router[e];
          if (se > s1) { s2 = s1; p2 = p1; e2 = e1; s1 = se; p1 = pe; e1 = e; }
          else if (se > s2) { s2 = se; p2 = pe; e2 = e; }
        }
        const float gs = s1 + s2;
        if (gs > bestg) { bestg = gs; ge1 = e1; ge2 = e2; gp1 = p1; gp2 = p2; }
      }
      const float wsum = gp1 + gp2;
      w1 = gp1 / wsum; w2 = gp2 / wsum;
    }
    {
      uint2* hout = reinterpret_cast<uint2*>(hrow16(p, row));
#pragma unroll
      for (int i = 0; i < 4; ++i) hout[i * 64 + lane] = hq[i];
    }
#pragma unroll
    for (int i = 0; i < 4; ++i) reinterpret_cast<unsigned*>(p.u8 + row * D)[i * 64 + lane] = up[i].x;
    if (sub == 0 && lane == 0) {
      p.ew[row * 2 + 0] = w1; p.ew[row * 2 + 1] = w2;
      const int lp1 = atomicAdd(cntL + ge1, 1), lp2 = atomicAdd(cntL + ge2, 1);
      const int ei = atomicAdd(nent, 2);
      entL[2 * ei] = ((int)(row * 2) << 4) | ge1; entL[2 * ei + 1] = lp1;
      entL[2 * ei + 2] = ((int)(row * 2 + 1) << 4) | ge2; entL[2 * ei + 3] = lp2;
    }
  }
  if (sub == 0) {
    __syncthreads();
    if (threadIdx.x < NEXP) {
      const int c = cntL[threadIdx.x];
      cntL[threadIdx.x] = c ? atomicAdd(p.cnt + (l * NEXP + threadIdx.x) * 64, c) : 0;
    }
    __syncthreads();
    const int ne = *nent;
    for (int i = threadIdx.x; i < ne; i += 256) {
      const int key = entL[2 * i], lp = entL[2 * i + 1];
      const int e = key & 15;
      p.list[(long)(l * NEXP + e) * NR + cntL[e] + lp] = key >> 4;
    }
    __syncthreads();
  }
}

#define LOOP(n) for (long i = gtid; i < (long)(n); i += gstride)

#ifdef ONLY_PHASE
#define PH(n, ...) if (ONLY_PHASE == n) { __VA_ARGS__ }
#define GSYNC()
#else
#define PH(n, ...) { __VA_ARGS__ }
#define GSYNC() xcd_barrier(xb)
#endif

__global__ void __launch_bounds__(256, 2) mega_kernel(Params p) {
  cg::grid_group grid = cg::this_grid();
  __shared__ __attribute__((aligned(16))) unsigned char smem[SMEM_BYTES + 16];
  if (threadIdx.x == 0) *reinterpret_cast<uint4*>(smem + SMEM_BYTES) = make_uint4(0u, 0u, 0u, 0u);
  __syncthreads();
  XcdBarrier xb = xcd_barrier_post(p.bar, (volatile LAS unsigned*)(smem + SMEM_BYTES));
  const long gtid = (long)blockIdx.x * blockDim.x + threadIdx.x;
  const long gstride = (long)gridDim.x * blockDim.x;
  const int nsb = min(256, (int)gridDim.x / 2);
  PH(0,
    if (gtid < 2 * NEXP) p.cnt[gtid * 64] = 0;
    phase_convert_dense(p, smem);
    phase_fold_z(p, gtid, gstride, (float*)(smem + 65536));
    if ((int)gridDim.x > 2 * MOD_ITEMS) { if ((int)blockIdx.x >= MOD_ITEMS) phase_convert_experts(p, 0, smem, blockIdx.x - MOD_ITEMS, gridDim.x - MOD_ITEMS); }
    else phase_convert_experts(p, 0, smem, blockIdx.x, gridDim.x);
    LOOP(1024) ph_tables(p, i);)
#ifndef ONLY_PHASE
  if (p.use_cg_sync) grid.sync();
#endif
  GSYNC();
  PH(1, phase_lnmod_first(p);)
  GSYNC();
  PH(2, phase_gemm(p, GemmJob{(const act_t*)p.u8, (const act_t*)p.W8in_even, p.P, 0, 0, 0, 1, NR / 128, IN_EVEN / 128, D, PW, IN_EVEN, 2, 1.0f / (SU8 * SW8), 1}, smem);)
  GSYNC();
  PH(3,
    if ((int)blockIdx.x < nsb) phase_scan<0>(p, smem, blockIdx.x, nsb);
    else phase_attn(p, smem, blockIdx.x - nsb, gridDim.x - nsb);)
  GSYNC();
  PH(4, phase_combine<0>(p);)
  GSYNC();
  PH(5, phase_gemm(p, GemmJob{p.u, p.Wt_out_even, p.M, 0, 0, 0, 1, NR / 128, D / 128, D, D, D, 0, 1.0f, 0}, smem);)
  GSYNC();
  PH(6, phase_resid_ln<1>(p, 0, 0, 0, NR, smem);)
  GSYNC();
  PH(7, phase_moe(p, 0, false, smem);)
  GSYNC();
  PH(8, phase_moe(p, 0, true, smem);)
  GSYNC();
  PH(9, phase_resid_ln<2>(p, 0, 1, 0, NR, smem); phase_cmat(p, gtid, gstride);)
  GSYNC();
  PH(10, phase_gemm(p, GemmJob{(const act_t*)p.u8, (const act_t*)p.W8in_odd, p.P, 0, 0, 0, 1, NR / 128, IN_ODD_PAD / 128, D, PW, O_FA, 1, 1.0f / (SU8 * SW8), 1}, smem);)
  GSYNC();
  PH(11, phase_gla_decay(p);)
  GSYNC();
  PH(12,
    if ((int)blockIdx.x < nsb) phase_scan<1>(p, smem, blockIdx.x, nsb);
    else {
      phase_gemm(p, GemmJob{p.Cmat, p.FT, p.u + (long)NC * D + 768, 0, (long)256 * 2 * T, (long)T * D, NB, T / 128, 2, 2 * T, D,
                            256, 0, 0.00276213586400995f, 0}, smem, blockIdx.x - nsb, gridDim.x - nsb);
      phase_convert_experts(p, 1, smem, blockIdx.x - nsb, gridDim.x - nsb);
    })
  GSYNC();
  PH(13, phase_combine<1>(p);)
  GSYNC();
  PH(14,
    phase_gemm(p, GemmJob{p.u + (long)NC * D, p.Wt_out_odd, p.M + (long)NC * D, 0, 0, 0, 1, NT / 128, D / 128, D, D, D, 0, 1.0f, 0}, smem);)
  GSYNC();
  PH(15, phase_resid_ln<1>(p, 1, 0, NC, NR, smem);)
  GSYNC();
  PH(16, phase_moe(p, 1, false, smem);)
  GSYNC();
  PH(17, phase_moe(p, 1, true, smem);)
  GSYNC();
  PH(18, phase_resid_ln<2>(p, 1, 1, NC, NR, smem);)
}

static size_t carve(Params& p, char* ws) {
  size_t off = 0;
  auto take = [&](size_t bytes) { char* r = ws + off; off += (bytes + 255) & ~(size_t)255; return r; };
  p.mod = (float*)take(sizeof(float) * 2 * (NB + 1) * 6 * D);
  p.hc = (float*)take(sizeof(float) * (size_t)NC * D);
  p.costab = (float*)take(sizeof(float) * T);
  p.sintab = (float*)take(sizeof(float) * T);
  p.lbt = (float*)take(sizeof(float) * 1024);
  p.ropetab = (float*)take(sizeof(float) * 64 * 16 * 2);
  p.ew = (float*)take(sizeof(float) * (size_t)NR * 2);
  p.eidx = nullptr;
  p.u = (act_t*)take(sizeof(act_t) * (size_t)NR * D);
  p.P = (act_t*)take(sizeof(act_t) * (size_t)NR * PW);
  p.OF = (act_t*)take(sizeof(act_t) * (size_t)NR * 768);
  p.OB = (act_t*)take(sizeof(act_t) * (size_t)NR * 768);
  p.M = p.OF;
  p.Cmat = (act_t*)take(sizeof(act_t) * (size_t)T * 2 * T);
  p.FT = (act_t*)take(sizeof(act_t) * (size_t)NB * 256 * 2 * T);
  p.LF = (act_t*)take(sizeof(act_t) * (size_t)2 * NR * 384);
  p.W8up = (unsigned char*)p.Cmat;
  p.W8down = p.W8up + (size_t)NEXP * 1024 * D;
  p.W8up1 = (unsigned char*)take((size_t)NEXP * 1024 * (D + DFF));
  p.W8down1 = p.W8up1 + (size_t)NEXP * 1024 * D;
  p.u8 = (unsigned char*)take((size_t)NR * D);
  p.Y = p.P;
  p.H8 = (unsigned char*)(p.P + (size_t)2 * NR * D);
  p.bar = (unsigned*)take(sizeof(unsigned) * XCD_BAR_WORDS);
  p.cnt = (int*)take(sizeof(int) * 2 * NEXP * 64);
  p.list = (int*)take(sizeof(int) * (size_t)2 * NEXP * NR);
  p.Wt_in_even = nullptr;
  p.W8in_even = (unsigned char*)take((size_t)IN_EVEN * D);
  p.Wt_out_even = (act_t*)take(sizeof(act_t) * (size_t)D * D);
  p.Wt_in_odd = nullptr;
  p.W8in_odd = (unsigned char*)take((size_t)IN_ODD_PAD * D);
  p.Wt_out_odd = (act_t*)take(sizeof(act_t) * (size_t)D * D);
  return off;
}

static void fill_inputs(Params& p, void* const* d_in) {
  const float** f = (const float**)&p;
  for (int i = 0; i < 23; ++i) f[i] = (const float*)d_in[i];
}

extern "C" void kernel_launch(void* const* d_in, const int* in_sizes, int n_in, void* d_out, int out_size,
                              void* d_ws, size_t ws_size, hipStream_t stream) {
  static int grid_blocks = 0;
  if (!grid_blocks) {
    int dev = 0, cus = 0, per_cu = 0;
    (void)hipGetDevice(&dev);
    (void)hipDeviceGetAttribute(&cus, hipDeviceAttributeMultiprocessorCount, dev);
    (void)hipOccupancyMaxActiveBlocksPerMultiprocessor(&per_cu, mega_kernel, 256, 0);
    grid_blocks = cus * per_cu;
  }
  Params p{};
  fill_inputs(p, d_in);
  p.out = (float*)d_out;
  size_t need = carve(p, (char*)d_ws);
  if (need > ws_size) { fprintf(stderr, "workspace too small: need %zu have %zu\n", need, ws_size); return; }
  (void)hipMemsetAsync(p.bar, 0, sizeof(unsigned) * XCD_BAR_WORDS, stream);
  void* args[] = {&p};
  hipError_t e = hipLaunchCooperativeKernel((void*)mega_kernel, dim3(grid_blocks), dim3(256), args, 0, stream);
  if (e != hipSuccess) fprintf(stderr, "cooperative launch failed: %s (grid %d)\n", hipGetErrorString(e), grid_blocks);
}
#endif
```

```cpp
#ifndef HOST_TEST
#include <hip/hip_runtime.h>
#include <hip/hip_cooperative_groups.h>
#include <cstdio>
namespace cg = cooperative_groups;
#define DEV __device__ __forceinline__
#else
#include <cmath>
#include <cstdio>
#include <cstdlib>
#include <cstring>
#define DEV static inline
#endif

#ifndef T_BATCH
#define T_BATCH 8
#endif
#ifndef T_SEQ
#define T_SEQ 2048
#endif
#ifndef T_CTX
#define T_CTX 256
#endif

constexpr int D = 1024, NB = T_BATCH, T = T_SEQ, C = T_CTX;
constexpr int NC = NB * C, NT = NB * T, NR = NC + NT;
constexpr int GRID_W = 64;
constexpr int IN_EVEN = 3328, IN_ODD = 2592, PW = 3328;
constexpr int NEXP = 16, DFF = 512;
constexpr float ALPHA = 1.4142135623730951f;
constexpr float LN_EPS = 1e-5f;
constexpr int E_AQ = 0, E_AK = 512, E_AV = 640, E_FF = 768, E_HQ = 1792, E_HI = 2304, E_HG = 2816;
constexpr int O_Q = 0, O_K = 384, O_V = 768, O_RF = 1536, O_G = 1568, O_Z = 2336;

#ifdef HOST_TEST
typedef float act_t;
DEV float ldA(const act_t* p) { return *p; }
DEV void stA(act_t* p, float v) { *p = v; }
#else
typedef unsigned short act_t;
DEV float ldA(const act_t* p) { return __uint_as_float(((unsigned)*p) << 16); }
DEV void stA(act_t* p, float v) {
  unsigned u = __float_as_uint(v);
  u += 0x7fffu + ((u >> 16) & 1u);
  *p = (unsigned short)(u >> 16);
}
#endif

struct Params {
  const float *x, *c, *ctx, *c_ctx, *w_ada, *b_ada, *ln_g, *ln_b, *w_in_even, *attn_sink, *lb_logits, *hgrn_norm,
      *w_out_even, *w_in_odd, *gla_gate_w, *gla_gate_b, *gla_norm, *w_out_odd, *w_router, *b_router, *w_eg, *w_eu,
      *w_ed;
  float* out;
  float *mod, *hc, *costab, *sintab, *lbt, *ew, *ropetab;
  int* eidx;
  act_t *u, *P, *OF, *OB, *M, *LF;
  act_t *Wt_in_even, *Wt_out_even, *Wt_in_odd, *Wt_out_odd;
  act_t *Y, *Cmat, *FT;
  unsigned char *W8up, *W8down, *W8up1, *W8down1, *H8, *u8;
  unsigned char *W8in_even, *W8in_odd;
  int *cnt, *list;
  unsigned* bar;
  int use_cg_sync;
  int pad_;
};

DEV float sigmoidf_(float v) { return 1.0f / (1.0f + expf(-v)); }
DEV float siluf_(float v) { return v / (1.0f + expf(-v)); }

DEV const float* hrow_in(const Params& p, long row) {
  return row < NC ? p.ctx + row * D : p.x + (row - NC) * D;
}
DEV float* hrow(const Params& p, long row) { return row < NC ? p.hc + row * D : p.out + (row - NC) * D; }
DEV const float* modrow(const Params& p, int l, long row) {
  int bb = row < NC ? NB : (int)((row - NC) / T);
  return p.mod + ((long)l * (NB + 1) + bb) * 6 * D;
}

DEV void ph_mod(const Params& p, long i) {
  int j = (int)(i % (6 * D));
  int bb = (int)((i / (6 * D)) % (NB + 1));
  int l = (int)(i / ((long)6 * D * (NB + 1)));
  const float* cv = bb < NB ? p.c + (long)bb * D : p.c_ctx;
  const float* w = p.w_ada + (long)l * D * 6 * D + j;
  float s = p.b_ada[l * 6 * D + j];
  for (int k = 0; k < D; ++k) s += siluf_(cv[k]) * w[(long)k * 6 * D];
  p.mod[i] = s;
}

DEV void ph_tables(const Params& p, long i) {
  if (i < 1024) {
    int pos = (int)(i >> 4), idx = (int)(i & 15);
    float ang = (float)pos * powf(10000.0f, -(float)idx / 16.0f);
    p.ropetab[2 * i] = cosf(ang);
    p.ropetab[2 * i + 1] = sinf(ang);
  }
  if (i < 1024) {
    int dir = (int)(i / 512), col = (int)(i % 512);
    float l0 = p.lb_logits[(dir * 2 + 0) * 512 + col], l1 = p.lb_logits[(dir * 2 + 1) * 512 + col];
    p.lbt[i] = 1.0f / (1.0f + expf(l1 - l0));
  }
}

DEV void ln_mod_row(const float* h, const float* shift, const float* scale, act_t* u) {
  float mu = 0.f;
  for (int k = 0; k < D; ++k) mu += h[k];
  mu *= (1.0f / D);
  float var = 0.f;
  for (int k = 0; k < D; ++k) { float d = h[k] - mu; var += d * d; }
  var *= (1.0f / D);
  float rs = 1.0f / sqrtf(var + LN_EPS);
  for (int k = 0; k < D; ++k) stA(u + k, (h[k] - mu) * rs * (1.0f + scale[k]) + shift[k]);
}

DEV void ph_lnmod_first(const Params& p, long row) {
  const float* m = modrow(p, 0, row);
  ln_mod_row(hrow_in(p, row), m, m + D, p.u + row * D);
}

DEV void gemm_item_act(const act_t* A, const float* W, act_t* Cout, int K, int N, int ldc, long i) {
  int n4 = (int)(i % (N / 4));
  long row = i / (N / 4);
  const act_t* a = A + row * K;
  const float* w = W + n4 * 4;
  float s0 = 0, s1 = 0, s2 = 0, s3 = 0;
  for (int k = 0; k < K; ++k) {
    float av = ldA(a + k);
    const float* wr = w + (long)k * N;
    s0 += av * wr[0]; s1 += av * wr[1]; s2 += av * wr[2]; s3 += av * wr[3];
  }
  act_t* o = Cout + row * ldc + n4 * 4;
  stA(o, s0); stA(o + 1, s1); stA(o + 2, s2); stA(o + 3, s3);
}

DEV void ph_rope(const Params& p, long i) {
  int pr = (int)(i % 32);
  int hh = (int)((i / 32) % 10);
  long lr = i / 320;
  int t = (int)(lr % T);
  int col = hh < 8 ? E_AQ + hh * 64 : E_AK + (hh - 8) * 64;
  int idx = pr & 15;
  int pos = pr < 16 ? t / GRID_W : t % GRID_W;
  int d0 = pr < 16 ? idx : 32 + idx;
  float inv = powf(10000.0f, -(float)idx / 16.0f);
  float ang = (float)pos * inv;
  float cs = cosf(ang), sn = sinf(ang);
  act_t* base = p.P + (NC + lr) * PW + col;
  float x1 = ldA(base + d0), x2 = ldA(base + d0 + 16);
  stA(base + d0, x1 * cs - x2 * sn);
  stA(base + d0 + 16, x1 * sn + x2 * cs);
}

DEV void ph_attn(const Params& p, long i) {
  int h = (int)(i % 8);
  long row = i / 8;
  int kv = h / 4;
  bool lat = row >= NC;
  int b = lat ? (int)((row - NC) / T) : (int)(row / C);
  int t = lat ? (int)((row - NC) % T) : 0;
  float q[64], acc[64];
  const act_t* qp = p.P + row * PW + E_AQ + h * 64;
#pragma unroll
  for (int d = 0; d < 64; ++d) { q[d] = ldA(qp + d) * 0.125f; acc[d] = 0.f; }
  float m = p.attn_sink[h], l = 1.0f;
  int nkeys = C + (lat ? 257 : 0);
  for (int j = 0; j < nkeys; ++j) {
    long krow;
    if (j < C) krow = (long)b * C + j;
    else {
      int kp = t - 128 + (j - C);
      if (kp < 0 || kp >= T) continue;
      krow = NC + (long)b * T + kp;
    }
    const act_t* kptr = p.P + krow * PW + E_AK + kv * 64;
    const act_t* vptr = p.P + krow * PW + E_AV + kv * 64;
    float s = 0.f;
#pragma unroll
    for (int d = 0; d < 64; ++d) s += q[d] * ldA(kptr + d);
    float mn = fmaxf(m, s);
    float sc = expf(m - mn), pj = expf(s - mn);
    l = l * sc + pj;
#pragma unroll
    for (int d = 0; d < 64; ++d) acc[d] = acc[d] * sc + pj * ldA(vptr + d);
    m = mn;
  }
  float il = 1.0f / l;
  act_t* o = p.u + row * D + h * 64;
#pragma unroll
  for (int d = 0; d < 64; ++d) stA(o + d, acc[d] * il);
}

template <int MODE>
DEV void ph_scan(const Params& p, long i) {
  constexpr int DK = MODE == 0 ? 128 : 96;
  constexpr int DV = MODE == 0 ? 128 : 192;
  int e = (int)(i % DV);
  int dir = (int)((i / DV) % 2);
  int h = (int)((i / (2 * DV)) % 4);
  int b = (int)(i / (8 * DV));
  float S[DK];
#pragma unroll
  for (int d = 0; d < DK; ++d) S[d] = 0.f;
  act_t* OD = dir == 0 ? p.OF : p.OB;
  for (int step = 0; step < C + T; ++step) {
    long row;
    if (step < C) row = (long)b * C + (dir == 0 ? step : C - 1 - step);
    else { int tt = step - C; row = NC + (long)b * T + (dir == 0 ? tt : T - 1 - tt); }
    const act_t* pr = p.P + row * PW;
    float o = 0.f;
    if (MODE == 0) {
      float v = ldA(pr + E_HI + h * 128 + e);
      const act_t* zp = pr + E_FF + dir * 512 + h * 128;
      const act_t* qp = pr + E_HQ + h * 128;
      const float* lb = p.lbt + dir * 512 + h * 128;
#pragma unroll
      for (int d = 0; d < DK; ++d) {
        float f = lb[d] + (1.0f - lb[d]) * sigmoidf_(ldA(zp + d));
        S[d] = f * S[d] + (1.0f - f) * v;
        o += ldA(qp + d) * S[d];
      }
      stA(OD + row * 768 + h * 128 + e, o);
    } else {
      float v = ldA(pr + O_V + h * 192 + e);
      const act_t* kp = pr + O_K + h * 96;
      const act_t* qp = pr + O_Q + h * 96;
      const act_t* lf = p.LF + ((long)dir * NR + row) * 384 + h * 96;
#pragma unroll
      for (int d = 0; d < DK; ++d) {
        float f = expf(ldA(lf + d));
        S[d] = f * S[d] + ldA(kp + d) * v;
        o += ldA(qp + d) * S[d];
      }
      stA(OD + row * 768 + h * 192 + e, o * 0.10206207261596575f);
    }
  }
}

template <int MODE>
DEV void ph_combine(const Params& p, long i) {
  constexpr int DV = MODE == 0 ? 128 : 192;
  int h = (int)(i % 4);
  long row = (MODE == 0) ? i / 4 : NC + i / 4;
  const act_t* f = p.OF + row * 768 + h * DV;
  const act_t* bk = p.OB + row * 768 + h * DV;
  float ss = 0.f;
  for (int e = 0; e < DV; ++e) { float o = ldA(f + e) + ldA(bk + e); ss += o * o; }
  float r = 1.0f / sqrtf(ss / DV + LN_EPS);
  const float* gn = (MODE == 0 ? p.hgrn_norm : p.gla_norm) + h * DV;
  const act_t* g = p.P + row * PW + (MODE == 0 ? E_HG : O_G) + h * DV;
  act_t* o = p.u + row * D + (MODE == 0 ? 512 : 0) + h * DV;
  for (int e = 0; e < DV; ++e) stA(o + e, (ldA(f + e) + ldA(bk + e)) * r * gn[e] * siluf_(ldA(g + e)));
}

DEV void ph_gla_decay(const Params& p, long i) {
  int col = (int)(i % 384);
  long row = (i / 384) % NR;
  int dir = (int)(i / ((long)384 * NR));
  const act_t* r = p.P + row * PW + O_RF + dir * 16;
  const float* gw = p.gla_gate_w + (long)dir * 16 * 384 + col;
  float z = p.gla_gate_b[dir * 384 + col];
  for (int k = 0; k < 16; ++k) z += ldA(r + k) * gw[k * 384];
  float ls = fminf(z, 0.f) - log1pf(expf(-fabsf(z)));
  stA(p.LF + ((long)dir * NR + row) * 384 + col, ls * (1.0f / 16.0f));
}

DEV void ph_resid_ln(const Params& p, long row, int l, int sub) {
  const float* hin = (l == 0 && sub == 0) ? hrow_in(p, row) : hrow(p, row);
  float* hout = hrow(p, row);
  const float* md = modrow(p, l, row);
  const float* g = md + (sub == 0 ? 2 : 5) * D;
  const act_t* m = p.M + row * D;
  const float* lg = p.ln_g + (l * 2 + sub) * D;
  const float* lb = p.ln_b + (l * 2 + sub) * D;
  float mu = 0.f;
  for (int k = 0; k < D; ++k) mu += ALPHA * hin[k] + g[k] * ldA(m + k);
  mu *= (1.0f / D);
  float var = 0.f;
  for (int k = 0; k < D; ++k) { float d = ALPHA * hin[k] + g[k] * ldA(m + k) - mu; var += d * d; }
  var *= (1.0f / D);
  float rs = 1.0f / sqrtf(var + LN_EPS);
  for (int k = 0; k < D; ++k) hout[k] = (ALPHA * hin[k] + g[k] * ldA(m + k) - mu) * rs * lg[k] + lb[k];
  if (sub == 1 && l == 1) return;
  const float* md2 = (sub == 0) ? md + 3 * D : modrow(p, 1, row);
  float mu2 = 0.f;
  for (int k = 0; k < D; ++k) mu2 += hout[k];
  mu2 *= (1.0f / D);
  float var2 = 0.f;
  for (int k = 0; k < D; ++k) { float d = hout[k] - mu2; var2 += d * d; }
  var2 *= (1.0f / D);
  float rs2 = 1.0f / sqrtf(var2 + LN_EPS);
  float lo[NEXP];
#pragma unroll
  for (int e = 0; e < NEXP; ++e) lo[e] = 0.f;
  for (int k = 0; k < D; ++k) {
    float uv = (hout[k] - mu2) * rs2 * (1.0f + md2[D + k]) + md2[k];
    stA(p.u + row * D + k, uv);
    if (sub == 0) {
      const float* wr = p.w_router + k * NEXP;
#pragma unroll
      for (int e = 0; e < NEXP; ++e) lo[e] += uv * wr[e];
    }
  }
  if (sub != 0) return;
  float mx = lo[0];
#pragma unroll
  for (int e = 1; e < NEXP; ++e) mx = fmaxf(mx, lo[e]);
  float sum = 0.f;
#pragma unroll
  for (int e = 0; e < NEXP; ++e) { lo[e] = expf(lo[e] - mx); sum += lo[e]; }
  float inv = 1.0f / sum;
  float bestg = -1e30f; int bg = 0;
  float gi1 = 0, gi2 = 0; int ge1 = 0, ge2 = 0;
  float gp1 = 0, gp2 = 0;
#pragma unroll
  for (int gq = 0; gq < 4; ++gq) {
    float s1 = -1e30f, s2 = -1e30f, p1 = 0, p2 = 0; int e1 = 0, e2 = 0;
#pragma unroll
    for (int j = 0; j < 4; ++j) {
      int e = gq * 4 + j;
      float pe = lo[e] * inv;
      float se = pe + p.b_router[e];
      if (se > s1) { s2 = s1; p2 = p1; e2 = e1; s1 = se; p1 = pe; e1 = e; }
      else if (se > s2) { s2 = se; p2 = pe; e2 = e; }
    }
    float gs = s1 + s2;
    if (gs > bestg) { bestg = gs; bg = gq; gi1 = s1; gi2 = s2; ge1 = e1; ge2 = e2; gp1 = p1; gp2 = p2; }
  }
  (void)bg; (void)gi1; (void)gi2;
  float wsum = gp1 + gp2;
  p.eidx[row * 2 + 0] = ge1; p.eidx[row * 2 + 1] = ge2;
  p.ew[row * 2 + 0] = gp1 / wsum; p.ew[row * 2 + 1] = gp2 / wsum;
}

DEV void ph_moe_up(const Params& p, long i, int l, long row0) {
  int f4 = (int)(i % (DFF / 4));
  int slot = (int)((i / (DFF / 4)) % 2);
  long row = row0 + i / (DFF / 2);
  int e = p.eidx[row * 2 + slot];
  const float* w1 = p.w_eg + ((long)(l * NEXP + e) * D) * DFF + f4 * 4;
  const float* w3 = p.w_eu + ((long)(l * NEXP + e) * D) * DFF + f4 * 4;
  const act_t* a = p.u + row * D;
  float g0 = 0, g1 = 0, g2 = 0, g3 = 0, u0 = 0, u1 = 0, u2 = 0, u3 = 0;
  for (int k = 0; k < D; ++k) {
    float av = ldA(a + k);
    const float* r1 = w1 + (long)k * DFF;
    const float* r3 = w3 + (long)k * DFF;
    g0 += av * r1[0]; g1 += av * r1[1]; g2 += av * r1[2]; g3 += av * r1[3];
    u0 += av * r3[0]; u1 += av * r3[1]; u2 += av * r3[2]; u3 += av * r3[3];
  }
  act_t* hb = p.P + (row * 2 + slot) * DFF + f4 * 4;
  stA(hb, siluf_(g0) * u0); stA(hb + 1, siluf_(g1) * u1); stA(hb + 2, siluf_(g2) * u2); stA(hb + 3, siluf_(g3) * u3);
}

DEV void ph_moe_down(const Params& p, long i, int l, long row0) {
  int j4 = (int)(i % (D / 4));
  long row = row0 + i / (D / 4);
  float y0 = 0, y1 = 0, y2 = 0, y3 = 0;
  for (int slot = 0; slot < 2; ++slot) {
    int e = p.eidx[row * 2 + slot];
    float wgt = p.ew[row * 2 + slot];
    const float* w2 = p.w_ed + ((long)(l * NEXP + e) * DFF) * D + j4 * 4;
    const act_t* hb = p.P + (row * 2 + slot) * DFF;
    float s0 = 0, s1 = 0, s2 = 0, s3 = 0;
    for (int f = 0; f < DFF; ++f) {
      float hv = ldA(hb + f);
      const float* r = w2 + (long)f * D;
      s0 += hv * r[0]; s1 += hv * r[1]; s2 += hv * r[2]; s3 += hv * r[3];
    }
    y0 += wgt * s0; y1 += wgt * s1; y2 += wgt * s2; y3 += wgt * s3;
  }
  act_t* o = p.M + row * D + j4 * 4;
  stA(o, y0); stA(o + 1, y1); stA(o + 2, y2); stA(o + 3, y3);
}


#ifndef HOST_TEST
typedef __attribute__((ext_vector_type(8))) short bf16x8;
typedef __attribute__((ext_vector_type(4))) float f32x4;
constexpr int SMEM_BYTES = 71680;
constexpr int IN_ODD_PAD = 2944;
constexpr int O_FA = 2336, O_FB = 2592, O_END = 2848;

typedef float f32x2_t __attribute__((ext_vector_type(2)));
typedef __bf16 bf16x2_t __attribute__((ext_vector_type(2)));
__device__ __forceinline__ unsigned pack2(float a, float b) {
  const f32x2_t v = {a, b};
  return __builtin_bit_cast(unsigned, __builtin_convertvector(v, bf16x2_t));
}
__device__ __forceinline__ unsigned pack2_mfma(float a, float b) { return pack2(a, b); }
typedef __attribute__((ext_vector_type(2))) unsigned u32x2;
__device__ __forceinline__ float xor16_max(float x) {
  const u32x2 r = __builtin_amdgcn_permlane16_swap(__float_as_uint(x), __float_as_uint(x), false, false);
  return fmaxf(__uint_as_float(r.x), __uint_as_float(r.y));
}
__device__ __forceinline__ float xor32_max(float x) {
  const u32x2 r = __builtin_amdgcn_permlane32_swap(__float_as_uint(x), __float_as_uint(x), false, false);
  return fmaxf(__uint_as_float(r.x), __uint_as_float(r.y));
}
__device__ __forceinline__ float xor16_add(float x) {
  const u32x2 r = __builtin_amdgcn_permlane16_swap(__float_as_uint(x), __float_as_uint(x), false, false);
  return __uint_as_float(r.x) + __uint_as_float(r.y);
}
__device__ __forceinline__ float xor32_add(float x) {
  const u32x2 r = __builtin_amdgcn_permlane32_swap(__float_as_uint(x), __float_as_uint(x), false, false);
  return __uint_as_float(r.x) + __uint_as_float(r.y);
}
__device__ __forceinline__ float bf_lo(unsigned u) { return __uint_as_float(u << 16); }
__device__ __forceinline__ float bf_hi(unsigned u) { return __uint_as_float(u & 0xffff0000u); }
template <int CTRL>
__device__ __forceinline__ float dpp_mov(float v) {
  return __int_as_float(__builtin_amdgcn_update_dpp(0, __float_as_int(v), CTRL, 0xf, 0xf, true));
}
__device__ __forceinline__ float row_sum16(float v) {
  v += dpp_mov<0xB1>(v);
  v += dpp_mov<0x4E>(v);
  v += dpp_mov<0x141>(v);
  v += dpp_mov<0x140>(v);
  return v;
}
__device__ __forceinline__ float wave_sum(float v) {
  v = row_sum16(v);
  const float a = __int_as_float(__builtin_amdgcn_readlane(__float_as_int(v), 0));
  const float b = __int_as_float(__builtin_amdgcn_readlane(__float_as_int(v), 16));
  const float c = __int_as_float(__builtin_amdgcn_readlane(__float_as_int(v), 32));
  const float d = __int_as_float(__builtin_amdgcn_readlane(__float_as_int(v), 48));
  return (a + b) + (c + d);
}


#define XB_TMO      128
#define XB_XCNT(j)  (256  + 64 * (j))
#define XB_XSUB(j)  (1280 + 64 * (j))
#define XB_XGEN(j)  (2304 + 64 * (j))
#define XB_TOP      3328
#define XB_TOPGEN   3392
#define XCD_BAR_WORDS 3456
#define XB_SPIN_CAP (1u << 18)
#define LAS __attribute__((address_space(3)))
__device__ __forceinline__ unsigned xb_ld(unsigned* p)              { return __hip_atomic_load(p, __ATOMIC_RELAXED, __HIP_MEMORY_SCOPE_AGENT); }
__device__ __forceinline__ unsigned xb_add(unsigned* p, unsigned v) { return __hip_atomic_fetch_add(p, v, __ATOMIC_RELAXED, __HIP_MEMORY_SCOPE_AGENT); }
__device__ __forceinline__ unsigned xb_xcc_id() { return (unsigned)__builtin_amdgcn_s_getreg((3 << 11) | 20) & 0xFu; }
#define XB_SPIN(cond, bar) do { unsigned _sp = 0; while (cond) { __builtin_amdgcn_s_sleep(1); \
    if ((++_sp & 255u) == 0u) { if (xb_ld(&(bar)[XB_TMO])) break; if (_sp > XB_SPIN_CAP) { atomicAdd(&(bar)[XB_TMO], 1u); break; } } } } while (0)
struct XcdBarrier { unsigned* bar; unsigned x; volatile LAS unsigned* st; };
__device__ __forceinline__ XcdBarrier xcd_barrier_post(unsigned* bar, volatile LAS unsigned* st) {
    XcdBarrier b; b.bar = bar; b.x = xb_xcc_id(); b.st = st;
    if (threadIdx.x == 0) (void)xb_add(&bar[XB_XCNT(b.x)], 1u);
    return b;
}
__device__ __forceinline__ void xcd_barrier_complete(unsigned* bar, unsigned x, unsigned& nloc, unsigned& nx) {
    const unsigned G = gridDim.x * gridDim.y * gridDim.z;
    unsigned sum, cnt, mine, sp = 0u;
    for (;;) {
        sum = 0u; cnt = 0u; mine = 0u;
#pragma unroll
        for (unsigned j = 0; j < 16; ++j) { const unsigned c = xb_ld(&bar[XB_XCNT(j)]); sum += c; cnt += (c > 0u) ? 1u : 0u; mine = (j == x) ? c : mine; }
        if (sum == G) break;
        __builtin_amdgcn_s_sleep(1);
        if ((++sp & 255u) == 0u) { if (xb_ld(&bar[XB_TMO])) break; if (sp > XB_SPIN_CAP) { atomicAdd(&bar[XB_TMO], 1u); break; } }
    }
    nloc = mine > 0u ? mine : 1u; nx = cnt > 0u ? cnt : 1u;
}
__device__ __forceinline__ void xcd_barrier(const XcdBarrier& b) {
    asm volatile("s_waitcnt vmcnt(0)" ::: "memory");
    __syncthreads();
    if (threadIdx.x == 0) {
        unsigned* bar = b.bar;
        __builtin_amdgcn_s_waitcnt(0);
        unsigned nloc = b.st[0], nx = b.st[1];
        if (nloc == 0u) { xcd_barrier_complete(bar, b.x, nloc, nx); b.st[0] = nloc; b.st[1] = nx; }
        const unsigned old = xb_add(&bar[XB_XSUB(b.x)], 1u);
        const unsigned gen = old / nloc;
        if (old + 1u == (gen + 1u) * nloc) {
            __builtin_amdgcn_fence(__ATOMIC_RELEASE, "agent");
            asm volatile("s_waitcnt vmcnt(0)" ::: "memory");
            const unsigned og = xb_add(&bar[XB_TOP], 1u);
            const unsigned tg = og / nx;
            if (og + 1u == (tg + 1u) * nx) xb_add(&bar[XB_TOPGEN], 1u);
            else XB_SPIN(xb_ld(&bar[XB_TOPGEN]) == tg, bar);
            __builtin_amdgcn_fence(__ATOMIC_ACQUIRE, "agent");
            xb_add(&bar[XB_XGEN(b.x)], 1u);
            asm volatile("s_waitcnt vmcnt(0)" ::: "memory");
        } else {
            XB_SPIN(xb_ld(&bar[XB_XGEN(b.x)]) == gen, bar);
            __builtin_amdgcn_fence(__ATOMIC_ACQUIRE, "agent");
            asm volatile("s_waitcnt vmcnt(0)" ::: "memory");
        }
    }
    __syncthreads();
}

#define RAW_BARRIER() do { asm volatile("s_waitcnt lgkmcnt(0)" ::: "memory"); __builtin_amdgcn_s_barrier(); } while (0)
template <bool SWAP, class ARow, class Epi>
__device__ __forceinline__ void gemm_tile(ARow arow, const act_t* Bt, int K, unsigned char* smem, Epi epi) {
  const int tid = threadIdx.x, wid = tid >> 6, lane = tid & 63, wr = wid >> 1, wc = wid & 1, fr = lane & 15,
            fq = lane >> 4;
  const int r0 = tid >> 3, pc = tid & 7;
  const int lc = pc ^ ((tid >> 4) & 7);
  const act_t* ga[4];
#pragma unroll
  for (int i = 0; i < 4; ++i) ga[i] = arow(r0 + 32 * i) + lc * 8;
  const act_t* gb0 = Bt + (long)r0 * K + lc * 8;
  const long gbs = (long)32 * K;
  const int sw = (fr >> 1) & 7;
  const int rd0 = fr * 128 + ((fq ^ sw) << 4), rd1 = fr * 128 + (((4 + fq) ^ sw) << 4);
  char* S = (char*)smem;
  const int nk = K >> 6;
  f32x4 acc[4][4];
#pragma unroll
  for (int m = 0; m < 4; ++m)
#pragma unroll
    for (int n = 0; n < 4; ++n) acc[m][n] = f32x4{0.f, 0.f, 0.f, 0.f};
  auto issue = [&](int kt) {
    char* st = S + (kt & 1) * 32768 + tid * 16;
#pragma unroll
    for (int i = 0; i < 4; ++i) {
      __builtin_amdgcn_global_load_lds((const unsigned*)(ga[i] + kt * 64), (unsigned*)(st + i * 4096), 16, 0, 0);
      __builtin_amdgcn_global_load_lds((const unsigned*)(gb0 + i * gbs + kt * 64), (unsigned*)(st + 16384 + i * 4096), 16, 0, 0);
    }
  };
  asm volatile("s_waitcnt vmcnt(0)" ::: "memory");
  RAW_BARRIER();
  issue(0);
  for (int kt = 0; kt < nk; ++kt) {
    asm volatile("s_waitcnt vmcnt(0)" ::: "memory");
    RAW_BARRIER();
    if (kt + 1 < nk) issue(kt + 1);
    const char* st = S + (kt & 1) * 32768;
#pragma unroll
    for (int ks = 0; ks < 2; ++ks) {
      const int rd = ks ? rd1 : rd0;
      bf16x8 af[4], bfr[4];
#pragma unroll
      for (int m = 0; m < 4; ++m) {
        af[m] = *reinterpret_cast<const bf16x8*>(st + (wr * 64 + m * 16) * 128 + rd);
        bfr[m] = *reinterpret_cast<const bf16x8*>(st + 16384 + (wc * 64 + m * 16) * 128 + rd);
      }
#pragma unroll
      for (int m = 0; m < 4; ++m)
#pragma unroll
        for (int n = 0; n < 4; ++n)
          acc[m][n] = SWAP ? __builtin_amdgcn_mfma_f32_16x16x32_bf16(bfr[n], af[m], acc[m][n], 0, 0, 0)
                           : __builtin_amdgcn_mfma_f32_16x16x32_bf16(af[m], bfr[n], acc[m][n], 0, 0, 0);
    }
  }
  epi(acc, wr, wc, fr, fq);
}


constexpr float SU8 = 16.0f, SW8 = 64.0f, SH8 = 8.0f;
typedef unsigned char fp8_t;
typedef __attribute__((ext_vector_type(8))) int i32x8;
typedef __attribute__((ext_vector_type(4))) int i32x4;
__device__ __forceinline__ unsigned pack4_fp8(float a, float b, float c, float d) {
  a = fminf(fmaxf(a, -448.f), 448.f); b = fminf(fmaxf(b, -448.f), 448.f);
  c = fminf(fmaxf(c, -448.f), 448.f); d = fminf(fmaxf(d, -448.f), 448.f);
  unsigned w = 0;
  w = __builtin_amdgcn_cvt_pk_fp8_f32(a, b, w, false);
  w = __builtin_amdgcn_cvt_pk_fp8_f32(c, d, w, true);
  return w;
}

template <bool SWAP, class ARow, class Epi>
__device__ __forceinline__ void gemm_tile8(ARow arow, const fp8_t* Bt, int Kb, unsigned char* smem, Epi epi) {
  const int tid = threadIdx.x, wid = tid >> 6, lane = tid & 63, wr = wid >> 1, wc = wid & 1, fr = lane & 15,
            fq = lane >> 4;
  const int r0 = tid >> 3, pc = tid & 7;
  const int lc = pc ^ ((tid >> 4) & 7);
  const fp8_t* ga[4];
#pragma unroll
  for (int i = 0; i < 4; ++i) ga[i] = arow(r0 + 32 * i) + lc * 16;
  const fp8_t* gb0 = Bt + (long)r0 * Kb + lc * 16;
  const long gbs = (long)32 * Kb;
  const int sw = (fr >> 1) & 7;
  const int rd0 = fr * 128 + ((fq ^ sw) << 4), rd1 = fr * 128 + (((4 + fq) ^ sw) << 4);
  char* S = (char*)smem;
  const int nk = Kb >> 7;
  f32x4 acc[4][4];
#pragma unroll
  for (int m = 0; m < 4; ++m)
#pragma unroll
    for (int n = 0; n < 4; ++n) acc[m][n] = f32x4{0.f, 0.f, 0.f, 0.f};
  auto issue = [&](int kt) {
    char* st = S + (kt & 1) * 32768 + tid * 16;
#pragma unroll
    for (int i = 0; i < 4; ++i) {
      __builtin_amdgcn_global_load_lds((const unsigned*)(ga[i] + kt * 128), (unsigned*)(st + i * 4096), 16, 0, 0);
      __builtin_amdgcn_global_load_lds((const unsigned*)(gb0 + i * gbs + kt * 128), (unsigned*)(st + 16384 + i * 4096), 16, 0, 0);
    }
  };
  asm volatile("s_waitcnt vmcnt(0)" ::: "memory");
  RAW_BARRIER();
  issue(0);
#pragma unroll 1
  for (int kt = 0; kt < nk; ++kt) {
    asm volatile("s_waitcnt vmcnt(0)" ::: "memory");
    RAW_BARRIER();
    if (kt + 1 < nk) issue(kt + 1);
    const char* st = S + (kt & 1) * 32768;
    i32x8 af[4], bfr[4];
#pragma unroll
    for (int m = 0; m < 4; ++m) {
      const i32x4 a0 = *reinterpret_cast<const i32x4*>(st + (wr * 64 + m * 16) * 128 + rd0);
      const i32x4 a1 = *reinterpret_cast<const i32x4*>(st + (wr * 64 + m * 16) * 128 + rd1);
      const i32x4 b0 = *reinterpret_cast<const i32x4*>(st + 16384 + (wc * 64 + m * 16) * 128 + rd0);
      const i32x4 b1 = *reinterpret_cast<const i32x4*>(st + 16384 + (wc * 64 + m * 16) * 128 + rd1);
      af[m] = i32x8{a0[0], a0[1], a0[2], a0[3], a1[0], a1[1], a1[2], a1[3]};
      bfr[m] = i32x8{b0[0], b0[1], b0[2], b0[3], b1[0], b1[1], b1[2], b1[3]};
    }
#pragma unroll
    for (int m = 0; m < 4; ++m)
#pragma unroll
      for (int n = 0; n < 4; ++n)
        acc[m][n] = SWAP ? __builtin_amdgcn_mfma_scale_f32_16x16x128_f8f6f4(bfr[n], af[m], acc[m][n], 0, 0, 0, 0x7f7f7f7f, 0, 0x7f7f7f7f)
                         : __builtin_amdgcn_mfma_scale_f32_16x16x128_f8f6f4(af[m], bfr[n], acc[m][n], 0, 0, 0, 0x7f7f7f7f, 0, 0x7f7f7f7f);
  }
  epi(acc, wr, wc, fr, fq);
}

__device__ __forceinline__ void phase_attn(const Params& p, unsigned char* smem, int blk, int nblk) {
  const int tid = threadIdx.x, w = tid >> 6, lane = tid & 63, fr = lane & 15, g = lane >> 4;
  act_t* SK = (act_t*)smem;
  act_t* SV = SK + 64 * 72;
  constexpr float SCL = 0.125f * 1.4426950408889634f;
  const int n_lat = NB * 4 * (T / 64), n_ctx = NB * 4 * (C / 64);
  const int skey = tid >> 2, spart = tid & 3;
  for (int unit = blk; unit < n_lat + n_ctx; unit += nblk) {
    const bool lat = unit < n_lat;
    const int uu = lat ? unit : unit - n_lat;
    const int nq = lat ? T / 64 : C / 64;
    const int hp = uu & 1, kv = (uu >> 1) & 1, qb = (uu >> 2) % nq, b = (uu >> 2) / nq;
    const int t0 = qb * 64;
    const int tw = t0 + (w & 1) * 32;
    const long qrow0 = (lat ? (long)NC + (long)b * T : (long)b * C) + tw;
    const int h = kv * 4 + hp * 2 + (w >> 1);
    bf16x8 qf[2][2];
#pragma unroll
    for (int qt = 0; qt < 2; ++qt)
#pragma unroll
      for (int st = 0; st < 2; ++st)
        qf[qt][st] = *reinterpret_cast<const bf16x8*>(p.P + (qrow0 + qt * 16 + fr) * PW + E_AQ + h * 64 + st * 32 + g * 8);
    asm volatile("" :: "v"(qf[0][0]), "v"(qf[0][1]), "v"(qf[1][0]), "v"(qf[1][1]));
    float mrun[2], lrun[2];
    f32x4 o[2][4];
    const float sinkl = p.attn_sink[h] * 1.4426950408889634f;
#pragma unroll
    for (int qt = 0; qt < 2; ++qt) {
      mrun[qt] = sinkl;
      lrun[qt] = (g == 0) ? 1.0f : 0.0f;
#pragma unroll
      for (int dt = 0; dt < 4; ++dt) o[qt][dt] = f32x4{0.f, 0.f, 0.f, 0.f};
    }
    int cc_lo = 0, cc_hi = -1;
    if (lat) {
      cc_lo = t0 >= 128 ? 0 : (128 - t0) / 64;
      cc_hi = min(4, (T - 1 - (t0 - 128)) / 64);
    }
    const int nch = 4 + (cc_hi - cc_lo + 1);
    auto chunk_row = [&](int i, int key, int& tkb) -> long {
      if (i < 4) { tkb = 0; return (long)b * C + i * 64 + key; }
      tkb = t0 - 128 + (cc_lo + i - 4) * 64;
      return (long)NC + (long)b * T + tkb + key;
    };
    uint4 rk0, rk1, rv0, rv1;
    {
      int tkb; const long kr = chunk_row(0, skey, tkb);
      const act_t* kp = p.P + kr * PW + E_AK + kv * 64 + spart * 16;
      const act_t* vp = p.P + kr * PW + E_AV + kv * 64 + spart * 16;
      rk0 = *reinterpret_cast<const uint4*>(kp); rk1 = *reinterpret_cast<const uint4*>(kp + 8);
      rv0 = *reinterpret_cast<const uint4*>(vp); rv1 = *reinterpret_cast<const uint4*>(vp + 8);
    }
    for (int i = 0; i < nch; ++i) {
      __syncthreads();
      {
        uint4* kd = reinterpret_cast<uint4*>(SK + skey * 72 + spart * 16);
        kd[0] = rk0; kd[1] = rk1;
        const unsigned vw[8] = {rv0.x, rv0.y, rv0.z, rv0.w, rv1.x, rv1.y, rv1.z, rv1.w};
#pragma unroll
        for (int e = 0; e < 8; ++e) {
          SV[(spart * 16 + 2 * e) * 72 + skey] = (act_t)(vw[e] & 0xffffu);
          SV[(spart * 16 + 2 * e + 1) * 72 + skey] = (act_t)(vw[e] >> 16);
        }
      }
      __syncthreads();
      int tkb_cur; (void)chunk_row(i, 0, tkb_cur);
      if (i + 1 < nch) {
        int tkb; const long kr = chunk_row(i + 1, skey, tkb);
        const act_t* kp = p.P + kr * PW + E_AK + kv * 64 + spart * 16;
        const act_t* vp = p.P + kr * PW + E_AV + kv * 64 + spart * 16;
        rk0 = *reinterpret_cast<const uint4*>(kp); rk1 = *reinterpret_cast<const uint4*>(kp + 8);
        rv0 = *reinterpret_cast<const uint4*>(vp); rv1 = *reinterpret_cast<const uint4*>(vp + 8);
      }
      const bool edge = i >= 4 && (tkb_cur == t0 - 128 || tkb_cur == t0 + 128);
#pragma unroll
      for (int kb = 0; kb < 2; ++kb) {
        f32x4 sc[2][2];
#pragma unroll
        for (int k2 = 0; k2 < 2; ++k2) {
          const int kt = kb * 2 + k2;
          const bf16x8 kf0 = *reinterpret_cast<const bf16x8*>(SK + (kt * 16 + fr) * 72 + g * 8);
          const bf16x8 kf1 = *reinterpret_cast<const bf16x8*>(SK + (kt * 16 + fr) * 72 + 32 + g * 8);
#pragma unroll
          for (int qt = 0; qt < 2; ++qt) {
            f32x4 z = f32x4{0.f, 0.f, 0.f, 0.f};
            z = __builtin_amdgcn_mfma_f32_16x16x32_bf16(kf0, qf[qt][0], z, 0, 0, 0);
            sc[qt][k2] = __builtin_amdgcn_mfma_f32_16x16x32_bf16(kf1, qf[qt][1], z, 0, 0, 0);
          }
        }
        bf16x8 pf[2];
#pragma unroll
        for (int qt = 0; qt < 2; ++qt) {
          float mx = -1e30f;
#pragma unroll
          for (int k2 = 0; k2 < 2; ++k2)
#pragma unroll
            for (int j = 0; j < 4; ++j) {
              float v = sc[qt][k2][j] * SCL;
              if (edge) {
                const int tk = tkb_cur + (kb * 2 + k2) * 16 + 4 * g + j;
                const int tq = tw + qt * 16 + fr;
                const int df = tq - tk;
                if (df > 128 || df < -128) v = -1e30f;
              }
              sc[qt][k2][j] = v;
              mx = fmaxf(mx, v);
            }
          mx = xor16_max(mx);
          mx = xor32_max(mx);
          const float mnew = fmaxf(mrun[qt], mx);
          if (__any(mnew > mrun[qt])) {
            const float alpha = __builtin_amdgcn_exp2f(mrun[qt] - mnew);
            lrun[qt] *= alpha;
#pragma unroll
            for (int dt = 0; dt < 4; ++dt) o[qt][dt] = o[qt][dt] * alpha;
            mrun[qt] = mnew;
          }
          float ls = 0.f;
          float pv[8];
#pragma unroll
          for (int k2 = 0; k2 < 2; ++k2)
#pragma unroll
            for (int j = 0; j < 4; ++j) {
              const float pe = __builtin_amdgcn_exp2f(sc[qt][k2][j] - mnew);
              pv[k2 * 4 + j] = pe;
              ls += pe;
            }
          lrun[qt] += ls;
          union { unsigned u[4]; bf16x8 v; } cv;
          cv.u[0] = pack2_mfma(pv[0], pv[1]); cv.u[1] = pack2_mfma(pv[2], pv[3]);
          cv.u[2] = pack2_mfma(pv[4], pv[5]); cv.u[3] = pack2_mfma(pv[6], pv[7]);
          pf[qt] = cv.v;
        }
#pragma unroll
        for (int dt = 0; dt < 4; ++dt) {
          union { uint2 h2[2]; bf16x8 v; } vf;
          vf.h2[0] = *reinterpret_cast<const uint2*>(SV + (dt * 16 + fr) * 72 + kb * 32 + 4 * g);
          vf.h2[1] = *reinterpret_cast<const uint2*>(SV + (dt * 16 + fr) * 72 + kb * 32 + 16 + 4 * g);
#pragma unroll
          for (int qt = 0; qt < 2; ++qt) o[qt][dt] = __builtin_amdgcn_mfma_f32_16x16x32_bf16(vf.v, pf[qt], o[qt][dt], 0, 0, 0);
        }
      }
    }
#pragma unroll
    for (int qt = 0; qt < 2; ++qt) {
      float lt = lrun[qt];
      lt = xor16_add(lt);
      lt = xor32_add(lt);
      const float il = 1.0f / lt;
      act_t* orow = p.u + (qrow0 + qt * 16 + fr) * D + h * 64 + 4 * g;
#pragma unroll
      for (int dt = 0; dt < 4; ++dt)
        *reinterpret_cast<uint2*>(orow + dt * 16) =
            make_uint2(pack2(o[qt][dt][0] * il, o[qt][dt][1] * il), pack2(o[qt][dt][2] * il, o[qt][dt][3] * il));
    }
  }
}


template <int MODE>
__device__ __forceinline__ void phase_combine(const Params& p) {
  constexpr int DV = MODE == 0 ? 128 : 192, EPL = DV / 16, NV = EPL / 4;
  const int lane = threadIdx.x & 63;
  const long row_lo = MODE == 0 ? 0 : NC;
  const int nw = (int)gridDim.x * 4, wi = (int)blockIdx.x * 4 + (int)(threadIdx.x >> 6);
  const int rpw = (int)(NR - row_lo + nw - 1) / nw;
  const long r0 = row_lo + (long)wi * rpw, r1 = min((long)NR, r0 + rpw);
  float gn[EPL];
#pragma unroll
  for (int e = 0; e < EPL; ++e) gn[e] = (MODE == 0 ? p.hgrn_norm : p.gla_norm)[lane * EPL + e];
  uint2 fa[NV], fb[NV], fg[NV];
  auto load_row = [&](long row) {
    const uint2* f = reinterpret_cast<const uint2*>(p.OF + row * 768 + lane * EPL);
    const uint2* bk = reinterpret_cast<const uint2*>(p.OB + row * 768 + lane * EPL);
    const uint2* gt = reinterpret_cast<const uint2*>(p.P + row * PW + (MODE == 0 ? E_HG : O_G) + lane * EPL);
#pragma unroll
    for (int v = 0; v < NV; ++v) { fa[v] = f[v]; fb[v] = bk[v]; fg[v] = gt[v]; }
  };
  if (r0 < r1) load_row(r0);
  for (long row = r0; row < r1; ++row) {
    float o[EPL], gg[EPL];
#pragma unroll
    for (int v = 0; v < NV; ++v) {
      o[4 * v + 0] = bf_lo(fa[v].x) + bf_lo(fb[v].x); o[4 * v + 1] = bf_hi(fa[v].x) + bf_hi(fb[v].x);
      o[4 * v + 2] = bf_lo(fa[v].y) + bf_lo(fb[v].y); o[4 * v + 3] = bf_hi(fa[v].y) + bf_hi(fb[v].y);
      gg[4 * v + 0] = bf_lo(fg[v].x); gg[4 * v + 1] = bf_hi(fg[v].x); gg[4 * v + 2] = bf_lo(fg[v].y); gg[4 * v + 3] = bf_hi(fg[v].y);
    }
    load_row(min(row + 1, r1 - 1));
    float ss = 0.f;
#pragma unroll
    for (int e = 0; e < EPL; ++e) ss += o[e] * o[e];
    ss = row_sum16(ss);
    const float r = 1.0f / sqrtf(ss * (1.0f / DV) + LN_EPS);
    uint2* dst = reinterpret_cast<uint2*>(p.u + row * D + (MODE == 0 ? 512 : 0) + lane * EPL);
#pragma unroll
    for (int v = 0; v < NV; ++v) {
      float y[4];
#pragma unroll
      for (int q = 0; q < 4; ++q) {
        const float g = gg[4 * v + q];
        y[q] = o[4 * v + q] * r * gn[4 * v + q] * (g / (1.0f + __expf(-g)));
      }
      dst[v] = make_uint2(pack2(y[0], y[1]), pack2(y[2], y[3]));
    }
  }
}

constexpr int MOD_ITEMS = 2 * (6 * D / 64);
__device__ __forceinline__ void mod_item(const Params& p, int item, unsigned char* smem) {
  float* sc = (float*)smem;
  float* red = sc + 9 * D;
  const int tid = threadIdx.x, w = tid >> 6, lane = tid & 63;
  for (int i = tid; i < 9 * D; i += 256) {
    const int bb = i >> 10, k = i & 1023;
    const float v = bb < NB ? p.c[bb * D + k] : p.c_ctx[k];
    sc[i] = v / (1.0f + __expf(-v));
  }
  __syncthreads();
  const int l = item / (6 * D / 64), j = (item % (6 * D / 64)) * 64 + lane;
  const float* wp = p.w_ada + (long)l * D * 6 * D + (long)(w * 256) * 6 * D + j;
  float a[NB + 1];
#pragma unroll
  for (int bb = 0; bb <= NB; ++bb) a[bb] = 0.f;
  for (int kb = 0; kb < 256; kb += 32) {
    float wv[32];
#pragma unroll
    for (int q = 0; q < 32; ++q) wv[q] = wp[(long)(kb + q) * 6 * D];
#pragma unroll
    for (int q = 0; q < 32; ++q)
#pragma unroll
      for (int bb = 0; bb <= NB; ++bb) a[bb] += sc[bb * D + w * 256 + kb + q] * wv[q];
  }
#pragma unroll
  for (int bb = 0; bb <= NB; ++bb) red[(w * 9 + bb) * 64 + lane] = a[bb];
  __syncthreads();
  for (int i = tid; i < 9 * 64; i += 256) {
    const int bb = i >> 6, jj = i & 63;
    const int col = (item % (6 * D / 64)) * 64 + jj;
    const float sum = ((red[(0 * 9 + bb) * 64 + jj] + red[(1 * 9 + bb) * 64 + jj]) + (red[(2 * 9 + bb) * 64 + jj] + red[(3 * 9 + bb) * 64 + jj]));
    p.mod[((long)l * (NB + 1) + bb) * 6 * D + col] = sum + p.b_ada[l * 6 * D + col];
  }
  __syncthreads();
}

__device__ __forceinline__ void phase_gla_decay(const Params& p) {
  const int t = threadIdx.x;
  if (t >= 192) return;
  const int dir = t / 96, cg = t % 96;
  float gw[16][4], gb[4];
#pragma unroll
  for (int r = 0; r < 16; ++r) {
    const float4 v = *reinterpret_cast<const float4*>(p.gla_gate_w + ((long)dir * 16 + r) * 384 + cg * 4);
    gw[r][0] = v.x; gw[r][1] = v.y; gw[r][2] = v.z; gw[r][3] = v.w;
  }
  {
    const float4 v = *reinterpret_cast<const float4*>(p.gla_gate_b + dir * 384 + cg * 4);
    gb[0] = v.x; gb[1] = v.y; gb[2] = v.z; gb[3] = v.w;
  }
  const int rpb = ((NR + (int)gridDim.x - 1) / (int)gridDim.x + 3) / 4 * 4;
  const long b0 = (long)blockIdx.x * rpb, b1 = min((long)NR, b0 + rpb);
  uint4 ra[4], rb[4];
  auto load4 = [&](long row0) {
#pragma unroll
    for (int q = 0; q < 4; ++q) {
      const uint4* rp = reinterpret_cast<const uint4*>(p.P + min(row0 + q, b1 - 1) * PW + O_RF + dir * 16);
      ra[q] = rp[0]; rb[q] = rp[1];
    }
  };
  if (b0 < b1) load4(b0);
  for (long row0 = b0; row0 < b1; row0 += 4) {
    unsigned rw[4][8];
#pragma unroll
    for (int q = 0; q < 4; ++q) {
      rw[q][0] = ra[q].x; rw[q][1] = ra[q].y; rw[q][2] = ra[q].z; rw[q][3] = ra[q].w;
      rw[q][4] = rb[q].x; rw[q][5] = rb[q].y; rw[q][6] = rb[q].z; rw[q][7] = rb[q].w;
    }
    load4(min(row0 + 4, b1 - 1));
#pragma unroll
    for (int q = 0; q < 4; ++q) {
      float z[4] = {gb[0], gb[1], gb[2], gb[3]};
#pragma unroll
      for (int r2 = 0; r2 < 8; ++r2) {
        const float x0 = bf_lo(rw[q][r2]), x1 = bf_hi(rw[q][r2]);
#pragma unroll
        for (int c = 0; c < 4; ++c) z[c] += x0 * gw[2 * r2][c] + x1 * gw[2 * r2 + 1][c];
      }
      float o[4];
#pragma unroll
      for (int c = 0; c < 4; ++c) o[c] = (fminf(z[c], 0.f) - __logf(1.0f + __expf(-fabsf(z[c])))) * (1.0f / 16.0f);
      if (row0 + q < b1)
        *reinterpret_cast<uint2*>(p.LF + ((long)dir * NR + row0 + q) * 384 + cg * 4) = make_uint2(pack2(o[0], o[1]), pack2(o[2], o[3]));
    }
  }
}

__device__ __forceinline__ void phase_hgrn_gate(const Params& p, long gtid, long gstride) {
  for (long i = gtid; i < (long)NR * 1024; i += gstride) {
    const int col = (int)(i & 1023);
    const long row = i >> 10;
    act_t* z = p.P + row * PW + E_FF + col;
    const float lb = p.lbt[col];
    const float f = lb + (1.0f - lb) * sigmoidf_(ldA(z));
    stA(z, __logf(f));
  }
}

template <int MODE>
__device__ __forceinline__ void phase_scan(const Params& p, unsigned char* smem, int blk, int nblk) {
  constexpr int DK = MODE == 0 ? 128 : 96, DV = MODE == 0 ? 128 : 192, DVS = DV / 4, NET = DVS / 16, NKS = DK / 32,
                NDT = DK / 16;
  constexpr int QS = DK + 8, LS = 72, SS = DK + 8;
  act_t* Qa = (act_t*)smem;
  act_t* Ka = Qa + 64 * QS;
  act_t* KaT = Ka + 64 * QS;
  act_t* VT = KaT + DK * LS;
  act_t* ST = VT + DVS * LS;
  float* tot = (float*)(ST + DVS * SS);
  float* lf32 = tot + 2 * 4 * DK;
  const int tid = threadIdx.x, w = __builtin_amdgcn_readfirstlane(threadIdx.x >> 6), lane = tid & 63, fr = lane & 15, g = lane >> 4;
  const int dp = lane, c0 = 2 * dp;
  const bool cact = dp < DK / 2;
  constexpr int NCH = (C + T) / 64, NCC = C / 64;
  constexpr int NVI = DVS / 8 * 64;
  for (int item = blk; item < NB * 4 * 2 * 4; item += nblk) {
    const int sl = item & 3, dir = (item >> 2) & 1, h = (item >> 3) & 3, b = item >> 5;
    act_t* OD = dir == 0 ? p.OF : p.OB;
    const unsigned loff = (unsigned)min(c0, DK - 2) * 2u;
    const int vcol = (MODE == 0 ? E_HI + h * 128 : O_V + h * 192) + sl * DVS;
    const int ocol = h * DV + sl * DVS;
    auto chunk_base = [&](int n) -> long {
      if (n < NCC) return (long)b * C + (dir ? NCC - 1 - n : n) * 64;
      const int ln = n - NCC;
      return (long)NC + (long)b * T + (dir ? T / 64 - 1 - ln : ln) * 64;
    };
    auto lrow = [&](long base, int l) -> long { return base + (dir ? 63 - l : l); };
    f32x4 S[NET][2];
#pragma unroll
    for (int et = 0; et < NET; ++et) { S[et][0] = f32x4{0.f, 0.f, 0.f, 0.f}; S[et][1] = f32x4{0.f, 0.f, 0.f, 0.f}; }
    unsigned rlf[16], rq[16], rk[16];
    uint4 rv[2];
    const long rstep = dir ? -(long)PW * 2 : (long)PW * 2;
    const long lstep = dir ? -(long)384 * 2 : (long)384 * 2;
    const unsigned off_lf = (MODE == 0 ? (unsigned)(E_FF + dir * 512 + h * 128) * 2u : 0u) + loff;
    const unsigned off_q = (unsigned)(MODE == 0 ? E_HQ + h * 128 : O_Q + h * 96) * 2u + loff;
    const unsigned off_k = (unsigned)(O_K + h * 96) * 2u + loff;
    auto issue_loads = [&](int n) {
      const long base = chunk_base(n);
      {
        const char* prow = (const char*)(p.P + lrow(base, w * 16) * PW);
        const char* plf = (const char*)(p.LF + ((long)dir * NR + lrow(base, w * 16)) * 384 + h * 96);
#pragma unroll
        for (int i = 0; i < 16; ++i) {
          if (MODE == 0) {
            rlf[i] = *reinterpret_cast<const unsigned*>(prow + off_lf);
          } else {
            rlf[i] = *reinterpret_cast<const unsigned*>(plf + loff);
            rk[i] = *reinterpret_cast<const unsigned*>(prow + off_k);
            plf += lstep;
          }
          rq[i] = *reinterpret_cast<const unsigned*>(prow + off_q);
          prow += rstep;
        }
      }
#pragma unroll
      for (int r = 0; r < (NVI + 255) / 256; ++r) {
        const int it = min(tid + r * 256, NVI - 1);
        const int l = it / (DVS / 8), e8 = (it % (DVS / 8)) * 8;
        rv[r] = *reinterpret_cast<const uint4*>(p.P + lrow(base, l) * PW + vcol + e8);
      }
    };
    issue_loads(0);
    for (int n = 0; n < NCH; ++n) {
      const int par = n & 1;
      float* totp = tot + par * 4 * DK;
      float* lfp = lf32 + par * DK;
      const long base = chunk_base(n);
      if (cact) {
        float r0 = 0.f, r1 = 0.f;
#pragma unroll
        for (int i = 0; i < 16; ++i) { r0 += bf_lo(rlf[i]); r1 += bf_hi(rlf[i]); }
        totp[w * DK + c0] = r0; totp[w * DK + c0 + 1] = r1;
        if (w == 2) { lfp[c0] = bf_lo(rlf[0]); lfp[c0 + 1] = bf_hi(rlf[0]); }
      }
      __syncthreads();
#pragma unroll
      for (int r = 0; r < (NVI + 255) / 256; ++r) {
        const int it = tid + r * 256;
        if (it < NVI) {
          const int l = it / (DVS / 8), e8 = (it % (DVS / 8)) * 8;
          const unsigned vw[4] = {rv[r].x, rv[r].y, rv[r].z, rv[r].w};
#pragma unroll
          for (int e = 0; e < 4; ++e) {
            VT[(e8 + 2 * e) * LS + l] = (act_t)(vw[e] & 0xffffu);
            VT[(e8 + 2 * e + 1) * LS + l] = (act_t)(vw[e] >> 16);
          }
        }
      }
      if (cact) {
        float of0 = 0.f, of1 = 0.f;
#pragma unroll
        for (int sgi = 0; sgi < 3; ++sgi)
          if (sgi < w) { of0 += totp[sgi * DK + c0]; of1 += totp[sgi * DK + c0 + 1]; }
        const float ref0 = totp[c0] + totp[DK + c0] + lfp[c0];
        const float ref1 = totp[c0 + 1] + totp[DK + c0 + 1] + lfp[c0 + 1];
        unsigned kt0[8], kt1[8];
        float run0 = of0 - ref0, run1 = of1 - ref1;
#pragma unroll
        for (int i = 0; i < 16; i += 2) {
          float ka0[2], ka1[2];
#pragma unroll
          for (int ii = 0; ii < 2; ++ii) {
            const int i2 = i + ii;
            run0 += bf_lo(rlf[i2]); run1 += bf_hi(rlf[i2]);
            const float b0 = run0, b1 = run1;
            const float e0 = __expf(b0), e1 = __expf(b1), f0 = __expf(-b0), f1 = __expf(-b1);
            float k0, k1;
            if (MODE == 0) { k0 = 1.0f - __expf(bf_lo(rlf[i2])); k1 = 1.0f - __expf(bf_hi(rlf[i2])); }
            else { k0 = bf_lo(rk[i2]); k1 = bf_hi(rk[i2]); }
            ka0[ii] = k0 * f0; ka1[ii] = k1 * f1;
            const int l = w * 16 + i2;
            *reinterpret_cast<unsigned*>(Qa + l * QS + c0) = pack2(bf_lo(rq[i2]) * e0, bf_hi(rq[i2]) * e1);
            *reinterpret_cast<unsigned*>(Ka + l * QS + c0) = pack2(ka0[ii], ka1[ii]);
          }
          kt0[i >> 1] = pack2(ka0[0], ka0[1]);
          kt1[i >> 1] = pack2(ka1[0], ka1[1]);
        }
        uint4* d0 = reinterpret_cast<uint4*>(KaT + c0 * LS + w * 16);
        d0[0] = make_uint4(kt0[0], kt0[1], kt0[2], kt0[3]); d0[1] = make_uint4(kt0[4], kt0[5], kt0[6], kt0[7]);
        uint4* d1 = reinterpret_cast<uint4*>(KaT + (c0 + 1) * LS + w * 16);
        d1[0] = make_uint4(kt1[0], kt1[1], kt1[2], kt1[3]); d1[1] = make_uint4(kt1[4], kt1[5], kt1[6], kt1[7]);
      }
      issue_loads(min(n + 1, NCH - 1));
      float egv[2], egrv[2];
#pragma unroll
      for (int di = 0; di < 2; ++di) {
        const int dt = w + 4 * di;
        if (dt < NDT) {
          const int d = dt * 16 + fr;
          const float refd = totp[d] + totp[DK + d] + lfp[d];
          const float gd = totp[d] + totp[DK + d] + totp[2 * DK + d] + totp[3 * DK + d];
          const float er = __expf(refd);
          egv[di] = __expf(gd); egrv[di] = __expf(gd - refd);
#pragma unroll
          for (int et = 0; et < NET; ++et)
#pragma unroll
            for (int j = 0; j < 4; ++j) stA(ST + (et * 16 + 4 * g + j) * SS + d, S[et][di][j] * er);
        }
      }
      __syncthreads();
      bf16x8 qfr[NKS];
#pragma unroll
      for (int ks = 0; ks < NKS; ++ks) qfr[ks] = *reinterpret_cast<const bf16x8*>(Qa + (w * 16 + fr) * QS + ks * 32 + g * 8);
      bf16x8 pfr[2];
#pragma unroll
      for (int kb = 0; kb < 2; ++kb) {
        f32x4 at2[2];
#pragma unroll
        for (int h2 = 0; h2 < 2; ++h2) {
          const int mt = 2 * kb + h2;
          at2[h2] = f32x4{0.f, 0.f, 0.f, 0.f};
          if (mt <= w) {
#pragma unroll
            for (int ks = 0; ks < NKS; ++ks) {
              const bf16x8 kaf = *reinterpret_cast<const bf16x8*>(Ka + (mt * 16 + fr) * QS + ks * 32 + g * 8);
              at2[h2] = __builtin_amdgcn_mfma_f32_16x16x32_bf16(kaf, qfr[ks], at2[h2], 0, 0, 0);
            }
            if (mt == w) {
#pragma unroll
              for (int j = 0; j < 4; ++j)
                if (4 * g + j > fr) at2[h2][j] = 0.f;
            }
          }
        }
        union { unsigned u[4]; bf16x8 v; } cv;
        cv.u[0] = pack2_mfma(at2[0][0], at2[0][1]); cv.u[1] = pack2_mfma(at2[0][2], at2[0][3]);
        cv.u[2] = pack2_mfma(at2[1][0], at2[1][1]); cv.u[3] = pack2_mfma(at2[1][2], at2[1][3]);
        pfr[kb] = cv.v;
      }
      const long orow = lrow(base, w * 16 + fr);
#pragma unroll
      for (int et = 0; et < NET; ++et) {
        f32x4 o = f32x4{0.f, 0.f, 0.f, 0.f};
#pragma unroll
        for (int kb = 0; kb < 2; ++kb) {
          if (2 * kb <= w) {
            union { uint2 h2[2]; bf16x8 v; } vf;
            vf.h2[0] = *reinterpret_cast<const uint2*>(VT + (et * 16 + fr) * LS + kb * 32 + 4 * g);
            vf.h2[1] = *reinterpret_cast<const uint2*>(VT + (et * 16 + fr) * LS + kb * 32 + 16 + 4 * g);
            o = __builtin_amdgcn_mfma_f32_16x16x32_bf16(vf.v, pfr[kb], o, 0, 0, 0);
          }
        }
#pragma unroll
        for (int ks = 0; ks < NKS; ++ks) {
          const bf16x8 sf = *reinterpret_cast<const bf16x8*>(ST + (et * 16 + fr) * SS + ks * 32 + g * 8);
          o = __builtin_amdgcn_mfma_f32_16x16x32_bf16(sf, qfr[ks], o, 0, 0, 0);
        }
        const float osc = MODE == 0 ? 1.0f : 0.10206207261596575f;
        *reinterpret_cast<uint2*>(OD + orow * 768 + ocol + et * 16 + 4 * g) =
            make_uint2(pack2(o[0] * osc, o[1] * osc), pack2(o[2] * osc, o[3] * osc));
      }
#pragma unroll
      for (int di = 0; di < 2; ++di) {
        const int dt = w + 4 * di;
        if (dt < NDT) {
#pragma unroll
          for (int et = 0; et < NET; ++et) {
            f32x4 r = f32x4{0.f, 0.f, 0.f, 0.f};
#pragma unroll
            for (int k2 = 0; k2 < 2; ++k2) {
              const bf16x8 vf = *reinterpret_cast<const bf16x8*>(VT + (et * 16 + fr) * LS + k2 * 32 + g * 8);
              const bf16x8 kf = *reinterpret_cast<const bf16x8*>(KaT + (dt * 16 + fr) * LS + k2 * 32 + g * 8);
              r = __builtin_amdgcn_mfma_f32_16x16x32_bf16(vf, kf, r, 0, 0, 0);
            }
#pragma unroll
            for (int j = 0; j < 4; ++j) S[et][di][j] = egv[di] * S[et][di][j] + egrv[di] * r[j];
          }
        }
      }
    }
    __syncthreads();
  }
}

struct GemmJob {
  const act_t* A; const act_t* Bt; act_t* C;
  long sA, sB, sC;
  int nbatch, Mtiles, Ntiles, K, ldc, Nvalid, mode;
  float scale;
  int fp8;
};
__device__ __forceinline__ void phase_gemm(const Params& p, const GemmJob& g, unsigned char* smem, int blk = blockIdx.x, int nblk = gridDim.x) {
  const int per_b = g.Mtiles * g.Ntiles;
  const int ntiles = per_b * g.nbatch;
  for (int tile = blk; tile < ntiles; tile += nblk) {
    const int b = tile / per_b, tt = tile % per_b;
    const int tm = tt / g.Ntiles, tn = tt % g.Ntiles;
    if (g.mode == 1 && tm < NC / 128 && tn * 128 >= O_FA) continue;
    const int K = g.K, ldc = g.ldc;
    const act_t* Ab = g.A + b * g.sA + (long)tm * 128 * K;
    act_t* Cb = g.C + b * g.sC + (long)tm * 128 * ldc + tn * 128;
    const int nlim = g.Nvalid - tn * 128;
    const float scale = g.scale;
    const int mode = g.mode;
    if (mode == 1) {
      auto epi1 = [&](f32x4 (&acc)[4][4], int wr, int wc, int fr, int fq) {
                  if (g.fp8) {
#pragma unroll
                    for (int m = 0; m < 4; ++m)
#pragma unroll
                      for (int n = 0; n < 4; ++n) acc[m][n] = acc[m][n] * scale;
                  }
#pragma unroll
                  for (int m = 0; m < 4; ++m)
#pragma unroll
                    for (int n = 0; n < 4; ++n) {
                      const int col = wc * 64 + n * 16 + fr;
                      if (col < nlim) {
#pragma unroll
                        for (int j = 0; j < 4; ++j) {
                          const int row = wr * 64 + m * 16 + fq * 4 + j;
                          stA(Cb + (long)row * ldc + col, acc[m][n][j]);
                        }
                      } else {
                        const int gc = tn * 128 + col;
                        if (gc < O_END && tm >= NC / 128) {
                          const int lr = (tm - NC / 128) * 128 + wr * 64 + m * 16 + fq * 4;
                          const int bb = lr / T, t = lr % T;
                          const int cq = gc < O_FB ? gc - O_FA : gc - O_FB;
                          act_t* dst = p.FT + ((long)bb * 256 + cq) * (2 * T) + (gc < O_FB ? 0 : T) + t;
                          *reinterpret_cast<uint2*>(dst) = make_uint2(pack2(acc[m][n][0], acc[m][n][1]), pack2(acc[m][n][2], acc[m][n][3]));
                        }
                      }
                    }
                };
      if (g.fp8) {
        const fp8_t* A8 = (const fp8_t*)g.A + (long)tm * 128 * K;
        gemm_tile8<false>([&](int r) { return A8 + (long)r * K; }, (const fp8_t*)g.Bt + (long)tn * 128 * K, K, smem, epi1);
      } else {
        gemm_tile<false>([&](int r) { return Ab + (long)r * K; }, g.Bt + b * g.sB + (long)tn * 128 * K, K, smem, epi1);
      }
    } else {
      auto epi2 = [&](f32x4 (&acc)[4][4], int wr, int wc, int fr, int fq) {
                  const float oscale = g.fp8 ? 1.0f : scale;
                  if (g.fp8) {
#pragma unroll
                    for (int m = 0; m < 4; ++m)
#pragma unroll
                      for (int n = 0; n < 4; ++n) acc[m][n] = acc[m][n] * scale;
                  }
                  if (mode == 2) {
                    const int cb = tn * 128 + wc * 64;
                    if (cb < E_AV && tm >= NC / 128) {
                      const float4* rt = reinterpret_cast<const float4*>(p.ropetab);
#pragma unroll
                      for (int m = 0; m < 4; ++m) {
                        const int t = ((tm - NC / 128) * 128 + wr * 64 + m * 16 + fr) % T;
                        const float4 r01 = rt[(t / GRID_W) * 8 + fq * 2], r23 = rt[(t / GRID_W) * 8 + fq * 2 + 1];
                        const float4 c01 = rt[(t % GRID_W) * 8 + fq * 2], c23 = rt[(t % GRID_W) * 8 + fq * 2 + 1];
                        const float rc[4] = {r01.x, r01.z, r23.x, r23.z}, rs_[4] = {r01.y, r01.w, r23.y, r23.w};
                        const float cc[4] = {c01.x, c01.z, c23.x, c23.z}, cs_[4] = {c01.y, c01.w, c23.y, c23.w};
#pragma unroll
                        for (int j = 0; j < 4; ++j) {
                          const float a1 = acc[m][0][j], a2 = acc[m][1][j], b1 = acc[m][2][j], b2 = acc[m][3][j];
                          acc[m][0][j] = a1 * rc[j] - a2 * rs_[j]; acc[m][1][j] = a1 * rs_[j] + a2 * rc[j];
                          acc[m][2][j] = b1 * cc[j] - b2 * cs_[j]; acc[m][3][j] = b1 * cs_[j] + b2 * cc[j];
                        }
                      }
                    } else if (cb >= E_FF && cb < E_HQ) {
#pragma unroll
                      for (int n = 0; n < 4; ++n) {
                        const float4 lb4 = *reinterpret_cast<const float4*>(p.lbt + cb - E_FF + n * 16 + fq * 4);
                        const float lb[4] = {lb4.x, lb4.y, lb4.z, lb4.w};
#pragma unroll
                        for (int m = 0; m < 4; ++m)
#pragma unroll
                          for (int j = 0; j < 4; ++j)
                            acc[m][n][j] = __logf(lb[j] + (1.0f - lb[j]) / (1.0f + __expf(-acc[m][n][j])));
                      }
                    }
                  }
#pragma unroll
                  for (int m = 0; m < 4; ++m) {
                    const int row = wr * 64 + m * 16 + fr;
#pragma unroll
                    for (int n = 0; n < 4; ++n) {
                      const int col = wc * 64 + n * 16 + fq * 4;
                      if (col < nlim)
                        *reinterpret_cast<uint2*>(Cb + (long)row * ldc + col) =
                            make_uint2(pack2(acc[m][n][0] * oscale, acc[m][n][1] * oscale), pack2(acc[m][n][2] * oscale, acc[m][n][3] * oscale));
                    }
                  }
                };
      if (g.fp8) {
        const fp8_t* A8 = (const fp8_t*)g.A + (long)tm * 128 * K;
        gemm_tile8<true>([&](int r) { return A8 + (long)r * K; }, (const fp8_t*)g.Bt + (long)tn * 128 * K, K, smem, epi2);
      } else {
        gemm_tile<true>([&](int r) { return Ab + (long)r * K; }, g.Bt + b * g.sB + (long)tn * 128 * K, K, smem, epi2);
      }
    }
  }
}

template <class RowMap>
__device__ __forceinline__ void conv_tile_rm(const float* src, int lds_, int Nvalid, int k0, int n0, act_t* dst, int ldd, float* tile, RowMap rm) {
  const int tid = threadIdx.x;
  {
    const int r = tid >> 5, c4 = (tid & 31) * 4;
    float4 v[8];
#pragma unroll
    for (int rr = 0; rr < 8; ++rr) {
      v[rr] = make_float4(0.f, 0.f, 0.f, 0.f);
      if (n0 + c4 < Nvalid) v[rr] = *reinterpret_cast<const float4*>(src + (long)(k0 + r + rr * 8) * lds_ + n0 + c4);
    }
#pragma unroll
    for (int rr = 0; rr < 8; ++rr) {
      float* t = tile + (r + rr * 8) * 129 + c4;
      t[0] = v[rr].x; t[1] = v[rr].y; t[2] = v[rr].z; t[3] = v[rr].w;
    }
  }
  __syncthreads();
  {
    const int n = tid >> 1, ks = (tid & 1) * 32;
    if (n0 + n < Nvalid) {
      unsigned w[16];
#pragma unroll
      for (int i = 0; i < 16; ++i) w[i] = pack2(tile[(ks + 2 * i) * 129 + n], tile[(ks + 2 * i + 1) * 129 + n]);
      uint4* d = reinterpret_cast<uint4*>(dst + (long)rm(n) * ldd + k0 + ks);
      d[0] = make_uint4(w[0], w[1], w[2], w[3]);
      d[1] = make_uint4(w[4], w[5], w[6], w[7]);
      d[2] = make_uint4(w[8], w[9], w[10], w[11]);
      d[3] = make_uint4(w[12], w[13], w[14], w[15]);
    }
  }
  __syncthreads();
}

template <class RowMap>
__device__ __forceinline__ void conv_tile8_rm(const float* src, int lds_, int k0, int n0, fp8_t* dst, int ldd, float* tile, float scale, RowMap rm, int Nvalid = 1 << 30) {
  const int tid = threadIdx.x;
  {
    const int r = tid >> 5, c4 = (tid & 31) * 4;
    float4 v[8];
#pragma unroll
    for (int rr = 0; rr < 8; ++rr) {
      v[rr] = make_float4(0.f, 0.f, 0.f, 0.f);
      if (n0 + c4 < Nvalid) v[rr] = *reinterpret_cast<const float4*>(src + (long)(k0 + r + rr * 8) * lds_ + n0 + c4);
    }
#pragma unroll
    for (int rr = 0; rr < 8; ++rr) {
      float* t = tile + (r + rr * 8) * 129 + c4;
      t[0] = v[rr].x; t[1] = v[rr].y; t[2] = v[rr].z; t[3] = v[rr].w;
    }
  }
  __syncthreads();
  if ((threadIdx.x >> 1) + n0 < Nvalid) {
    const int n = tid >> 1, ks = (tid & 1) * 32;
    unsigned w[8];
#pragma unroll
    for (int i = 0; i < 8; ++i)
      w[i] = pack4_fp8(tile[(ks + 4 * i) * 129 + n] * scale, tile[(ks + 4 * i + 1) * 129 + n] * scale,
                       tile[(ks + 4 * i + 2) * 129 + n] * scale, tile[(ks + 4 * i + 3) * 129 + n] * scale);
    uint4* d = reinterpret_cast<uint4*>(dst + (long)rm(n) * ldd + k0 + ks);
    d[0] = make_uint4(w[0], w[1], w[2], w[3]);
    d[1] = make_uint4(w[4], w[5], w[6], w[7]);
  }
  __syncthreads();
}

__device__ __forceinline__ void conv_tile(const float* src, int lds_, int Nvalid, int k0, int n0, act_t* dst, int ldd, float* tile) {
  conv_tile_rm(src, lds_, Nvalid, k0, n0, dst, ldd, tile, [=](int n) { return n0 + n; });
}

struct ConvJob { const float* src; fp8_t* dst; int lds, ldd, k0, n0, rbase, ra, rb; };
__device__ __forceinline__ void phase_convert_experts(const Params& p, int l, unsigned char* smem, int blk, int nblk) {
  float* tile = (float*)smem;
  const int per_e = 192, total = NEXP * per_e;
  fp8_t* Wup = l == 0 ? p.W8up : p.W8up1;
  fp8_t* Wdn = l == 0 ? p.W8down : p.W8down1;
  const int tid = threadIdx.x;
  auto mkjob = [&](int job) -> ConvJob {
    const int e = job / per_e, j = job % per_e;
    ConvJob c;
    if (j < 128) {
      const int up = j >> 6, jj = j & 63;
      const int kt = jj >> 2, fp = jj & 3;
      c.src = (up ? p.w_eu : p.w_eg) + ((long)(l * NEXP + e) * D) * DFF;
      c.dst = Wup + (long)e * 1024 * D; c.lds = DFF; c.ldd = D; c.k0 = kt * 64; c.n0 = fp * 128;
      c.rbase = fp * 256 + up * 32; c.ra = 128; c.rb = 64;
    } else {
      const int jj = j - 128;
      const int kt = jj >> 3, nt = jj & 7;
      c.src = p.w_ed + ((long)(l * NEXP + e) * DFF) * D;
      c.dst = Wdn + (long)e * 1024 * DFF; c.lds = D; c.ldd = DFF; c.k0 = kt * 64; c.n0 = nt * 128;
      c.rbase = nt * 128; c.ra = 64; c.rb = 32;
    }
    return c;
  };
  float4 v[8];
  auto ld = [&](const ConvJob& c) {
    const int r = tid >> 5, c4 = (tid & 31) * 4;
#pragma unroll
    for (int rr = 0; rr < 8; ++rr) v[rr] = *reinterpret_cast<const float4*>(c.src + (long)(c.k0 + r + rr * 8) * c.lds + c.n0 + c4);
  };
  int job = blk;
  if (job >= total) return;
  ConvJob cur = mkjob(job);
  ld(cur);
  while (job < total) {
    {
      const int r = tid >> 5, c4 = (tid & 31) * 4;
#pragma unroll
      for (int rr = 0; rr < 8; ++rr) {
        float* t = tile + (r + rr * 8) * 129 + c4;
        t[0] = v[rr].x; t[1] = v[rr].y; t[2] = v[rr].z; t[3] = v[rr].w;
      }
    }
    __syncthreads();
    const int nxt = job + nblk;
    const ConvJob nj = mkjob(min(nxt, total - 1));
    ld(nj);
    {
      const int n = tid >> 1, ks = (tid & 1) * 32;
      unsigned w[8];
#pragma unroll
      for (int i = 0; i < 8; ++i)
        w[i] = pack4_fp8(tile[(ks + 4 * i) * 129 + n] * SW8, tile[(ks + 4 * i + 1) * 129 + n] * SW8,
                         tile[(ks + 4 * i + 2) * 129 + n] * SW8, tile[(ks + 4 * i + 3) * 129 + n] * SW8);
      const int row = cur.rbase + (n >> 6) * cur.ra + ((n >> 5) & 1) * cur.rb + (n & 31);
      uint4* d = reinterpret_cast<uint4*>(cur.dst + (long)row * cur.ldd + cur.k0 + ks);
      d[0] = make_uint4(w[0], w[1], w[2], w[3]);
      d[1] = make_uint4(w[4], w[5], w[6], w[7]);
    }
    __syncthreads();
    cur = nj;
    job = nxt;
  }
}

__device__ __forceinline__ void phase_moe(const Params& p, int l, bool down, unsigned char* smem) {
  const int* cntp = p.cnt + l * NEXP * 64;
  int total = 0;
  for (int e = 0; e < NEXP; ++e) total += ((cntp[e * 64] + 127) >> 7) * 8;
  for (int tile = blockIdx.x; tile < total; tile += gridDim.x) {
    int e = 0, tb = 0, rowoff = 0;
    for (; e < NEXP - 1; ++e) {
      const int c = cntp[e * 64];
      const int nt = ((c + 127) >> 7) * 8;
      if (tile < tb + nt) break;
      tb += nt; rowoff += c;
    }
    const int c = cntp[e * 64];
    const int lt = tile - tb, mt = lt >> 3, nt = lt & 7;
    const int rows_valid = min(128, c - mt * 128);
    const int* lst = p.list + (long)(l * NEXP + e) * NR + mt * 128;
    const long hrow0 = (long)rowoff + mt * 128;
    if (!down) {
      gemm_tile8<true>([&](int r) { return p.u8 + (long)(lst[min(r, rows_valid - 1)] >> 1) * D; },
                (l == 0 ? p.W8up : p.W8up1) + ((long)e * 1024 + nt * 128) * D, D, smem,
                [&](f32x4 (&acc)[4][4], int wr, int wc, int fr, int fq) {
                  constexpr float dq = 1.0f / (SU8 * SW8);
#pragma unroll
                  for (int m = 0; m < 4; ++m) {
                    const int row = wr * 64 + m * 16 + fr;
                    if (row < rows_valid) {
#pragma unroll
                      for (int n = 0; n < 2; ++n) {
                        float hv[4];
#pragma unroll
                        for (int j = 0; j < 4; ++j) {
                          const float g = acc[m][n][j] * dq, uu = acc[m][n + 2][j] * dq;
                          hv[j] = g / (1.0f + __expf(-g)) * uu * SH8;
                        }
                        *reinterpret_cast<unsigned*>(p.H8 + (hrow0 + row) * DFF + nt * 64 + wc * 32 + n * 16 + fq * 4) =
                            pack4_fp8(hv[0], hv[1], hv[2], hv[3]);
                      }
                    }
                  }
                });
    } else {
      const fp8_t* Ab = p.H8 + hrow0 * DFF;
      gemm_tile8<true>([&](int r) { return Ab + (long)r * DFF; }, (l == 0 ? p.W8down : p.W8down1) + ((long)e * 1024 + nt * 128) * DFF, DFF, smem,
                [&](f32x4 (&acc)[4][4], int wr, int wc, int fr, int fq) {
                  constexpr float dq = 1.0f / (SH8 * SW8);
#pragma unroll
                  for (int m = 0; m < 4; ++m) {
                    const int row = wr * 64 + m * 16 + fr;
                    if (row < rows_valid) {
                      const int ts = lst[row];
                      const float w = p.ew[ts] * dq;
#pragma unroll
                      for (int n = 0; n < 4; ++n)
                        *reinterpret_cast<uint2*>(p.Y + (long)ts * D + nt * 128 + wc * 64 + n * 16 + fq * 4) =
                            make_uint2(pack2(acc[m][n][0] * w, acc[m][n][1] * w), pack2(acc[m][n][2] * w, acc[m][n][3] * w));
                    }
                  }
                });
    }
  }
}

__device__ __forceinline__ void phase_convert_dense(const Params& p, unsigned char* smem) {
  float* tile = (float*)smem;
  const int JM = MOD_ITEMS, J0 = JM + 16 * 26, J1 = J0 + 128, J2 = J1 + 16 * 19, J3 = J2 + 128;
  for (int job = blockIdx.x; job < J3; job += gridDim.x) {
    if (job < JM) { mod_item(p, job, smem); continue; }
    if (job < J0) { int j = job - JM; const int n0 = (j % 26) * 128; conv_tile8_rm(p.w_in_even, IN_EVEN, (j / 26) * 64, n0, p.W8in_even, D, tile, SW8, [=](int n) { return n0 + n; }); }
    else if (job < J1) { int j = job - J0; conv_tile(p.w_out_even, D, D, (j / 8) * 64, (j % 8) * 128, p.Wt_out_even, D, tile); }
    else if (job < J2) { int j = job - J1; const int n0 = (j % 19) * 128; conv_tile8_rm(p.w_in_odd, IN_ODD, (j / 19) * 64, n0, p.W8in_odd, D, tile, SW8, [=](int n) { return n0 + n; }, O_FA); }
    else { int j = job - J2; conv_tile(p.w_out_odd, D, D, (j / 8) * 64, (j % 8) * 128, p.Wt_out_odd, D, tile); }
  }
}

__device__ __forceinline__ void phase_fold_z(const Params& p, long gtid, long gstride, float* tab) {
  if (threadIdx.x < 64) {
    float sn, cs;
    sincospif((float)threadIdx.x * (1.0f / 32.0f), &sn, &cs);
    tab[threadIdx.x] = cs; tab[64 + threadIdx.x] = -sn;
  }
  __syncthreads();
  for (long i = gtid; i < (long)512 * D; i += gstride) {
    const int k = (int)(i % D), np = (int)(i / D);
    const int part = np >> 8, col = np & 255, g = col >> 6, cp = col & 63;
    const float* wz = p.w_in_odd + (long)k * IN_ODD + O_Z + g * 64;
    float s = 0.f;
    const float* tb = tab + part * 64;
    float4 wv[16];
#pragma unroll
    for (int q = 0; q < 16; ++q) wv[q] = reinterpret_cast<const float4*>(wz)[q];
#pragma unroll
    for (int q = 0; q < 16; ++q) {
      s += wv[q].x * tb[((4 * q) * cp) & 63] + wv[q].y * tb[((4 * q + 1) * cp) & 63] + wv[q].z * tb[((4 * q + 2) * cp) & 63] +
           wv[q].w * tb[((4 * q + 3) * cp) & 63];
    }
    const unsigned q = pack4_fp8(s * SW8, 0.f, 0.f, 0.f);
    p.W8in_odd[(long)(O_FA + np) * D + k] = (unsigned char)(q & 0xffu);
  }
  for (long i = gtid; i < (long)(IN_ODD_PAD - O_END) * D; i += gstride) p.W8in_odd[(long)O_END * D + i] = 0;
}

__device__ __forceinline__ void phase_cmat(const Params& p, long gtid, long gstride) {
  for (long i = gtid; i < (long)T * T; i += gstride) {
    const int t = (int)(i % T), tp = (int)(i / T);
    float sn, cs;
    sincospif((float)((t * tp) & (T - 1)) * (2.0f / T), &sn, &cs);
    stA(p.Cmat + (long)tp * 2 * T + t, cs);
    stA(p.Cmat + (long)tp * 2 * T + T + t, sn);
  }
}

__device__ __forceinline__ void row_stats(const float4 (&v)[4], float& mu, float& rs) {
  float s = 0.f;
#pragma unroll
  for (int i = 0; i < 4; ++i) s += v[i].x + v[i].y + v[i].z + v[i].w;
  mu = wave_sum(s) * (1.0f / D);
  float q = 0.f;
#pragma unroll
  for (int i = 0; i < 4; ++i) {
    float a = v[i].x - mu, b = v[i].y - mu, c = v[i].z - mu, d = v[i].w - mu;
    q += a * a + b * b + c * c + d * d;
  }
  rs = 1.0f / sqrtf(wave_sum(q) * (1.0f / D) + LN_EPS);
}

__device__ __forceinline__ void phase_lnmod_first(const Params& p) {
  const int lane = threadIdx.x & 63;
  const int nw = (int)gridDim.x * 4, wi = (int)blockIdx.x * 4 + (int)(threadIdx.x >> 6);
  const int rpw = (NR + nw - 1) / nw;
  const long r0 = (long)wi * rpw, r1 = min((long)NR, r0 + rpw);
  float4 shv[4], scv[4];
  int cur_bb = -2;
  float4 hv[4];
  auto load_row = [&](long row) {
    const float4* h = reinterpret_cast<const float4*>(hrow_in(p, row));
#pragma unroll
    for (int i = 0; i < 4; ++i) hv[i] = h[i * 64 + lane];
  };
  if (r0 < r1) load_row(r0);
  for (long row = r0; row < r1; ++row) {
    const int bb = row < NC ? NB : (int)((row - NC) / T);
    if (bb != cur_bb) {
      cur_bb = bb;
      const float* md = p.mod + (long)bb * 6 * D;
#pragma unroll
      for (int i = 0; i < 4; ++i) {
        shv[i] = reinterpret_cast<const float4*>(md)[i * 64 + lane];
        scv[i] = reinterpret_cast<const float4*>(md + D)[i * 64 + lane];
      }
    }
    float4 v[4];
#pragma unroll
    for (int i = 0; i < 4; ++i) v[i] = hv[i];
    load_row(min(row + 1, r1 - 1));
    float mu, rs;
    row_stats(v, mu, rs);
#pragma unroll
    for (int i = 0; i < 4; ++i) {
      const float a = (v[i].x - mu) * rs * (1.f + scv[i].x) + shv[i].x, b = (v[i].y - mu) * rs * (1.f + scv[i].y) + shv[i].y;
      const float c = (v[i].z - mu) * rs * (1.f + scv[i].z) + shv[i].z, d = (v[i].w - mu) * rs * (1.f + scv[i].w) + shv[i].w;
      reinterpret_cast<unsigned*>(p.u8 + row * D)[i * 64 + lane] = pack4_fp8(a * SU8, b * SU8, c * SU8, d * SU8);
    }
  }
}

__device__ __forceinline__ act_t* hrow16(const Params& p, long row) {
  return row < NC ? reinterpret_cast<act_t*>(p.hc) + row * D
                  : reinterpret_cast<act_t*>(reinterpret_cast<char*>(p.out) + (row - NC) * (long)(4 * D) + 2 * D);
}
template <int R_UNUSED>
__device__ __forceinline__ void phase_resid_ln(const Params& p, int l, int sub, long row_lo, long row_hi, unsigned char* smem) {
  const int lane = threadIdx.x & 63;
  int* cntL = (int*)smem;
  int* nent = cntL + 16;
  int* entL = cntL + 32;
  float* wT = (float*)(smem + 4096);
  if (sub == 0) {
    if (threadIdx.x < 32) cntL[threadIdx.x] = 0;
    {
      float4 wr4[16];
#pragma unroll
      for (int j = 0; j < 4; ++j)
#pragma unroll
        for (int q = 0; q < 4; ++q) wr4[j * 4 + q] = reinterpret_cast<const float4*>(p.w_router + (long)(threadIdx.x + 256 * j) * NEXP)[q];
#pragma unroll
      for (int j = 0; j < 4; ++j)
#pragma unroll
        for (int q = 0; q < 4; ++q) {
          const int k = threadIdx.x + 256 * j;
          wT[(q * 4 + 0) * D + k] = wr4[j * 4 + q].x; wT[(q * 4 + 1) * D + k] = wr4[j * 4 + q].y;
          wT[(q * 4 + 2) * D + k] = wr4[j * 4 + q].z; wT[(q * 4 + 3) * D + k] = wr4[j * 4 + q].w;
        }
    }
    __syncthreads();
  }
  const bool last = (sub == 1 && l == 1);
  const int nw = (int)gridDim.x * 4, wi = (int)blockIdx.x * 4 + (int)(threadIdx.x >> 6);
  const int rpw = ((int)(row_hi - row_lo) + nw - 1) / nw;
  const long r0 = row_lo + (long)wi * rpw, r1 = min(row_hi, r0 + rpw);
  const float4* lgp = reinterpret_cast<const float4*>(p.ln_g + (l * 2 + sub) * D);
  const float4* lbp = reinterpret_cast<const float4*>(p.ln_b + (l * 2 + sub) * D);
  float4 lgv[4], lbv[4];
  if (R_UNUSED != 1) {
#pragma unroll
    for (int i = 0; i < 4; ++i) { lgv[i] = lgp[i * 64 + lane]; lbv[i] = lbp[i * 64 + lane]; }
  }
  float4 gv[4], shv[4], scv[4];
  int cur_bb = -2;
  const bool first = (l == 0 && sub == 0);
  float4 hv[4];
  uint2 hb[4];
  uint2 mv[4], m2v[4];
  auto load_row = [&](long row) {
    const uint2* m = reinterpret_cast<const uint2*>(sub == 0 ? p.M + row * D : p.Y + row * 2 * D);
    if (first) {
      const float4* hin = reinterpret_cast<const float4*>(hrow_in(p, row));
#pragma unroll
      for (int i = 0; i < 4; ++i) hv[i] = hin[i * 64 + lane];
    } else {
      const uint2* hin = reinterpret_cast<const uint2*>(hrow16(p, row));
#pragma unroll
      for (int i = 0; i < 4; ++i) hb[i] = hin[i * 64 + lane];
    }
#pragma unroll
    for (int i = 0; i < 4; ++i) {
      mv[i] = m[i * 64 + lane];
      if (sub == 1) m2v[i] = m[256 + i * 64 + lane];
    }
  };
  if (r0 < r1) load_row(r0);
  for (long row = r0; row < r1; ++row) {
    const int bb = row < NC ? NB : (int)((row - NC) / T);
    if (bb != cur_bb) {
      cur_bb = bb;
      const float* md = p.mod + ((long)l * (NB + 1) + bb) * 6 * D;
      const float* md2 = (sub == 0) ? md + 3 * D : p.mod + ((long)(NB + 1) + bb) * 6 * D;
#pragma unroll
      for (int i = 0; i < 4; ++i) {
        gv[i] = reinterpret_cast<const float4*>(md + (sub == 0 ? 2 : 5) * D)[i * 64 + lane];
        shv[i] = reinterpret_cast<const float4*>(md2)[i * 64 + lane];
        scv[i] = reinterpret_cast<const float4*>(md2 + D)[i * 64 + lane];
      }
    }
    float4 v[4];
#pragma unroll
    for (int i = 0; i < 4; ++i) {
      float m0 = bf_lo(mv[i].x), m1 = bf_hi(mv[i].x), m2_ = bf_lo(mv[i].y), m3 = bf_hi(mv[i].y);
      if (sub == 1) { m0 += bf_lo(m2v[i].x); m1 += bf_hi(m2v[i].x); m2_ += bf_lo(m2v[i].y); m3 += bf_hi(m2v[i].y); }
      const float h0 = first ? hv[i].x : bf_lo(hb[i].x), h1 = first ? hv[i].y : bf_hi(hb[i].x);
      const float h2 = first ? hv[i].z : bf_lo(hb[i].y), h3 = first ? hv[i].w : bf_hi(hb[i].y);
      v[i].x = ALPHA * h0 + gv[i].x * m0;
      v[i].y = ALPHA * h1 + gv[i].y * m1;
      v[i].z = ALPHA * h2 + gv[i].z * m2_;
      v[i].w = ALPHA * h3 + gv[i].w * m3;
    }
    load_row(min(row + 1, r1 - 1));
    if (R_UNUSED == 1) {
#pragma unroll
      for (int i = 0; i < 4; ++i) { lgv[i] = lgp[i * 64 + lane]; lbv[i] = lbp[i * 64 + lane]; }
    }
    float mu, rs;
    row_stats(v, mu, rs);
#pragma unroll
    for (int i = 0; i < 4; ++i) {
      v[i].x = (v[i].x - mu) * rs * lgv[i].x + lbv[i].x;
      v[i].y = (v[i].y - mu) * rs * lgv[i].y + lbv[i].y;
      v[i].z = (v[i].z - mu) * rs * lgv[i].z + lbv[i].z;
      v[i].w = (v[i].w - mu) * rs * lgv[i].w + lbv[i].w;
    }
    if (last) {
      float4* hout = reinterpret_cast<float4*>(p.out + (row - NC) * D);
#pragma unroll
      for (int i = 0; i < 4; ++i) hout[i * 64 + lane] = v[i];
      continue;
    }
    uint2 hq[4];
#pragma unroll
    for (int i = 0; i < 4; ++i) {
      hq[i] = make_uint2(pack2(v[i].x, v[i].y), pack2(v[i].z, v[i].w));
      v[i].x = bf_lo(hq[i].x); v[i].y = bf_hi(hq[i].x); v[i].z = bf_lo(hq[i].y); v[i].w = bf_hi(hq[i].y);
    }
    row_stats(v, mu, rs);
    float lo[NEXP];
#pragma unroll
    for (int e = 0; e < NEXP; ++e) lo[e] = 0.f;
    uint2 up[4];
#pragma unroll
    for (int i = 0; i < 4; ++i) {
      float uv[4];
      uv[0] = (v[i].x - mu) * rs * (1.f + scv[i].x) + shv[i].x;
      uv[1] = (v[i].y - mu) * rs * (1.f + scv[i].y) + shv[i].y;
      uv[2] = (v[i].z - mu) * rs * (1.f + scv[i].z) + shv[i].z;
      uv[3] = (v[i].w - mu) * rs * (1.f + scv[i].w) + shv[i].w;
      up[i] = make_uint2(pack4_fp8(uv[0] * SU8, uv[1] * SU8, uv[2] * SU8, uv[3] * SU8), 0u);
      if (sub == 0) {
#pragma unroll
        for (int e = 0; e < NEXP; ++e) {
          const float4 w4 = *reinterpret_cast<const float4*>(wT + e * D + (i * 64 + lane) * 4);
          lo[e] += uv[0] * w4.x + uv[1] * w4.y + uv[2] * w4.z + uv[3] * w4.w;
          if ((e & 3) == 3) __builtin_amdgcn_sched_barrier(0);
        }
      }
    }
    int ge1 = 0, ge2 = 0;
    float w1 = 0.f, w2 = 0.f;
    if (sub == 0) {
      float mine = 0.f;
#pragma unroll
      for (int e = 0; e < NEXP; ++e) {
        const float rsum = row_sum16(lo[e]);
        mine = ((lane & 15) == e) ? rsum : mine;
      }
      mine += __shfl_xor(mine, 16);
      mine += __shfl_xor(mine, 32);
#pragma unroll
      for (int e = 0; e < NEXP; ++e) lo[e] = __int_as_float(__builtin_amdgcn_readlane(__float_as_int(mine), e));
      float mx = lo[0];
#pragma unroll
      for (int e = 1; e < NEXP; ++e) mx = fmaxf(mx, lo[e]);
      float sum = 0.f;
#pragma unroll
      for (int e = 0; e < NEXP; ++e) { lo[e] = __expf(lo[e] - mx); sum += lo[e]; }
      const float inv = 1.0f / sum;
      float bestg = -1e30f, gp1 = 0.f, gp2 = 0.f;
#pragma unroll
      for (int gq = 0; gq < 4; ++gq) {
        float s1 = -1e30f, s2 = -1e30f, p1 = 0.f, p2 = 0.f;
        int e1 = 0, e2 = 0;
#pragma unroll
        for (int j = 0; j < 4; ++j) {
          const int e = gq * 4 + j;
          const float pe = lo[e] * inv;
          const float se = pe + p.b_router[e];
          if (se > s1) { s2 = s1; p2 = p1; e2 = e1; s1 = se; p1 = pe; e1 = e; }
          else if (se > s2) { s2 = se; p2 = pe; e2 = e; }
        }
        const float gs = s1 + s2;
        if (gs > bestg) { bestg = gs; ge1 = e1; ge2 = e2; gp1 = p1; gp2 = p2; }
      }
      const float wsum = gp1 + gp2;
      w1 = gp1 / wsum; w2 = gp2 / wsum;
    }
    {
      uint2* hout = reinterpret_cast<uint2*>(hrow16(p, row));
#pragma unroll
      for (int i = 0; i < 4; ++i) hout[i * 64 + lane] = hq[i];
    }
#pragma unroll
    for (int i = 0; i < 4; ++i) reinterpret_cast<unsigned*>(p.u8 + row * D)[i * 64 + lane] = up[i].x;
    if (sub == 0 && lane == 0) {
      p.ew[row * 2 + 0] = w1; p.ew[row * 2 + 1] = w2;
      const int lp1 = atomicAdd(cntL + ge1, 1), lp2 = atomicAdd(cntL + ge2, 1);
      const int ei = atomicAdd(nent, 2);
      entL[2 * ei] = ((int)(row * 2) << 4) | ge1; entL[2 * ei + 1] = lp1;
      entL[2 * ei + 2] = ((int)(row * 2 + 1) << 4) | ge2; entL[2 * ei + 3] = lp2;
    }
  }
  if (sub == 0) {
    __syncthreads();
    if (threadIdx.x < NEXP) {
      const int c = cntL[threadIdx.x];
      cntL[threadIdx.x] = c ? atomicAdd(p.cnt + (l * NEXP + threadIdx.x) * 64, c) : 0;
    }
    __syncthreads();
    const int ne = *nent;
    for (int i = threadIdx.x; i < ne; i += 256) {
      const int key = entL[2 * i], lp = entL[2 * i + 1];
      const int e = key & 15;
      p.list[(long)(l * NEXP + e) * NR + cntL[e] + lp] = key >> 4;
    }
    __syncthreads();
  }
}

#define LOOP(n) for (long i = gtid; i < (long)(n); i += gstride)

#ifdef ONLY_PHASE
#define PH(n, ...) if (ONLY_PHASE == n) { __VA_ARGS__ }
#define GSYNC()
#else
#define PH(n, ...) { __VA_ARGS__ }
#define GSYNC() xcd_barrier(xb)
#endif

__global__ void __launch_bounds__(256, 2) mega_kernel(Params p) {
  cg::grid_group grid = cg::this_grid();
  __shared__ __attribute__((aligned(16))) unsigned char smem[SMEM_BYTES + 16];
  if (threadIdx.x == 0) *reinterpret_cast<uint4*>(smem + SMEM_BYTES) = make_uint4(0u, 0u, 0u, 0u);
  __syncthreads();
  XcdBarrier xb = xcd_barrier_post(p.bar, (volatile LAS unsigned*)(smem + SMEM_BYTES));
  const long gtid = (long)blockIdx.x * blockDim.x + threadIdx.x;
  const long gstride = (long)gridDim.x * blockDim.x;
  const int nsb = min(256, (int)gridDim.x / 2);
  PH(0,
    if (gtid < 2 * NEXP) p.cnt[gtid * 64] = 0;
    phase_convert_dense(p, smem);
    phase_fold_z(p, gtid, gstride, (float*)(smem + 65536));
    LOOP(1024) ph_tables(p, i);)
#ifndef ONLY_PHASE
  if (p.use_cg_sync) grid.sync();
#endif
  GSYNC();
  PH(1, phase_lnmod_first(p);)
  GSYNC();
  PH(2, phase_gemm(p, GemmJob{(const act_t*)p.u8, (const act_t*)p.W8in_even, p.P, 0, 0, 0, 1, NR / 128, IN_EVEN / 128, D, PW, IN_EVEN, 2, 1.0f / (SU8 * SW8), 1}, smem);)
  GSYNC();
  PH(3,
    if ((int)blockIdx.x < nsb) phase_scan<0>(p, smem, blockIdx.x, nsb);
    else phase_attn(p, smem, blockIdx.x - nsb, gridDim.x - nsb);)
  GSYNC();
  PH(4, phase_combine<0>(p);)
  GSYNC();
  PH(5,
    phase_gemm(p, GemmJob{p.u, p.Wt_out_even, p.M, 0, 0, 0, 1, NR / 128, D / 128, D, D, D, 0, 1.0f, 0}, smem);
    {
      const int rem = ((NR / 128) * (D / 128)) % (int)gridDim.x;
      if (rem > 0 && rem < (int)gridDim.x) { if ((int)blockIdx.x >= rem) phase_convert_experts(p, 0, smem, blockIdx.x - rem, gridDim.x - rem); }
      else phase_convert_experts(p, 0, smem, blockIdx.x, gridDim.x);
    })
  GSYNC();
  PH(6, phase_resid_ln<1>(p, 0, 0, 0, NR, smem);)
  GSYNC();
  PH(7, phase_moe(p, 0, false, smem);)
  GSYNC();
  PH(8, phase_moe(p, 0, true, smem);)
  GSYNC();
  PH(9, phase_resid_ln<2>(p, 0, 1, 0, NR, smem); phase_cmat(p, gtid, gstride);)
  GSYNC();
  PH(10, phase_gemm(p, GemmJob{(const act_t*)p.u8, (const act_t*)p.W8in_odd, p.P, 0, 0, 0, 1, NR / 128, IN_ODD_PAD / 128, D, PW, O_FA, 1, 1.0f / (SU8 * SW8), 1}, smem);)
  GSYNC();
  PH(11, phase_gla_decay(p);)
  GSYNC();
  PH(12,
    if ((int)blockIdx.x < nsb) phase_scan<1>(p, smem, blockIdx.x, nsb);
    else {
      phase_gemm(p, GemmJob{p.Cmat, p.FT, p.u + (long)NC * D + 768, 0, (long)256 * 2 * T, (long)T * D, NB, T / 128, 2, 2 * T, D,
                            256, 0, 0.00276213586400995f, 0}, smem, blockIdx.x - nsb, gridDim.x - nsb);
      phase_convert_experts(p, 1, smem, blockIdx.x - nsb, gridDim.x - nsb);
    })
  GSYNC();
  PH(13, phase_combine<1>(p);)
  GSYNC();
  PH(14,
    phase_gemm(p, GemmJob{p.u + (long)NC * D, p.Wt_out_odd, p.M + (long)NC * D, 0, 0, 0, 1, NT / 128, D / 128, D, D, D, 0, 1.0f, 0}, smem);)
  GSYNC();
  PH(15, phase_resid_ln<1>(p, 1, 0, NC, NR, smem);)
  GSYNC();
  PH(16, phase_moe(p, 1, false, smem);)
  GSYNC();
  PH(17, phase_moe(p, 1, true, smem);)
  GSYNC();
  PH(18, phase_resid_ln<2>(p, 1, 1, NC, NR, smem);)
}

static size_t carve(Params& p, char* ws) {
  size_t off = 0;
  auto take = [&](size_t bytes) { char* r = ws + off; off += (bytes + 255) & ~(size_t)255; return r; };
  p.mod = (float*)take(sizeof(float) * 2 * (NB + 1) * 6 * D);
  p.hc = (float*)take(sizeof(float) * (size_t)NC * D);
  p.costab = (float*)take(sizeof(float) * T);
  p.sintab = (float*)take(sizeof(float) * T);
  p.lbt = (float*)take(sizeof(float) * 1024);
  p.ropetab = (float*)take(sizeof(float) * 64 * 16 * 2);
  p.ew = (float*)take(sizeof(float) * (size_t)NR * 2);
  p.eidx = nullptr;
  p.u = (act_t*)take(sizeof(act_t) * (size_t)NR * D);
  p.P = (act_t*)take(sizeof(act_t) * (size_t)NR * PW);
  p.OF = (act_t*)take(sizeof(act_t) * (size_t)NR * 768);
  p.OB = (act_t*)take(sizeof(act_t) * (size_t)NR * 768);
  p.M = p.OF;
  p.Cmat = (act_t*)take(sizeof(act_t) * (size_t)T * 2 * T);
  p.FT = (act_t*)take(sizeof(act_t) * (size_t)NB * 256 * 2 * T);
  p.LF = (act_t*)take(sizeof(act_t) * (size_t)2 * NR * 384);
  p.W8up = (unsigned char*)p.Cmat;
  p.W8down = p.W8up + (size_t)NEXP * 1024 * D;
  p.W8up1 = (unsigned char*)take((size_t)NEXP * 1024 * (D + DFF));
  p.W8down1 = p.W8up1 + (size_t)NEXP * 1024 * D;
  p.u8 = (unsigned char*)take((size_t)NR * D);
  p.Y = p.P;
  p.H8 = (unsigned char*)(p.P + (size_t)2 * NR * D);
  p.bar = (unsigned*)take(sizeof(unsigned) * XCD_BAR_WORDS);
  p.cnt = (int*)take(sizeof(int) * 2 * NEXP * 64);
  p.list = (int*)take(sizeof(int) * (size_t)2 * NEXP * NR);
  p.Wt_in_even = nullptr;
  p.W8in_even = (unsigned char*)take((size_t)IN_EVEN * D);
  p.Wt_out_even = (act_t*)take(sizeof(act_t) * (size_t)D * D);
  p.Wt_in_odd = nullptr;
  p.W8in_odd = (unsigned char*)take((size_t)IN_ODD_PAD * D);
  p.Wt_out_odd = (act_t*)take(sizeof(act_t) * (size_t)D * D);
  return off;
}

static void fill_inputs(Params& p, void* const* d_in) {
  const float** f = (const float**)&p;
  for (int i = 0; i < 23; ++i) f[i] = (const float*)d_in[i];
}

extern "C" void kernel_launch(void* const* d_in, const int* in_sizes, int n_in, void* d_out, int out_size,
                              void* d_ws, size_t ws_size, hipStream_t stream) {
  static int grid_blocks = 0;
  if (!grid_blocks) {
    int dev = 0, cus = 0, per_cu = 0;
    (void)hipGetDevice(&dev);
    (void)hipDeviceGetAttribute(&cus, hipDeviceAttributeMultiprocessorCount, dev);
    (void)hipOccupancyMaxActiveBlocksPerMultiprocessor(&per_cu, mega_kernel, 256, 0);
    grid_blocks = cus * per_cu;
  }
  Params p{};
  fill_inputs(p, d_in);
  p.out = (float*)d_out;
  size_t need = carve(p, (char*)d_ws);
  if (need > ws_size) { fprintf(stderr, "workspace too small: need %zu have %zu\n", need, ws_size); return; }
  (void)hipMemsetAsync(p.bar, 0, sizeof(unsigned) * XCD_BAR_WORDS, stream);
  void* args[] = {&p};
  hipError_t e = hipLaunchCooperativeKernel((void*)mega_kernel, dim3(grid_blocks), dim3(256), args, 0, stream);
  if (e != hipSuccess) fprintf(stderr, "cooperative launch failed: %s (grid %d)\n", hipGetErrorString(e), grid_blocks);
}
#endif
```

```cpp
#ifndef HOST_TEST
#include <hip/hip_runtime.h>
#include <hip/hip_cooperative_groups.h>
#include <cstdio>
namespace cg = cooperative_groups;
#define DEV __device__ __forceinline__
#else
#include <cmath>
#include <cstdio>
#include <cstdlib>
#include <cstring>
#define DEV static inline
#endif

#ifndef T_BATCH
#define T_BATCH 8
#endif
#ifndef T_SEQ
#define T_SEQ 2048
#endif
#ifndef T_CTX
#define T_CTX 256
#endif

constexpr int D = 1024, NB = T_BATCH, T = T_SEQ, C = T_CTX;
constexpr int NC = NB * C, NT = NB * T, NR = NC + NT;
constexpr int GRID_W = 64;
constexpr int IN_EVEN = 3328, IN_ODD = 2592, PW = 3328;
constexpr int NEXP = 16, DFF = 512;
constexpr float ALPHA = 1.4142135623730951f;
constexpr float LN_EPS = 1e-5f;
constexpr int E_AQ = 0, E_AK = 512, E_AV = 640, E_FF = 768, E_HQ = 1792, E_HI = 2304, E_HG = 2816;
constexpr int O_Q = 0, O_K = 384, O_V = 768, O_RF = 1536, O_G = 1568, O_Z = 2336;

#ifdef HOST_TEST
typedef float act_t;
DEV float ldA(const act_t* p) { return *p; }
DEV void stA(act_t* p, float v) { *p = v; }
#else
typedef unsigned short act_t;
DEV float ldA(const act_t* p) { return __uint_as_float(((unsigned)*p) << 16); }
DEV void stA(act_t* p, float v) {
  unsigned u = __float_as_uint(v);
  u += 0x7fffu + ((u >> 16) & 1u);
  *p = (unsigned short)(u >> 16);
}
#endif

struct Params {
  const float *x, *c, *ctx, *c_ctx, *w_ada, *b_ada, *ln_g, *ln_b, *w_in_even, *attn_sink, *lb_logits, *hgrn_norm,
      *w_out_even, *w_in_odd, *gla_gate_w, *gla_gate_b, *gla_norm, *w_out_odd, *w_router, *b_router, *w_eg, *w_eu,
      *w_ed;
  float* out;
  float *mod, *hc, *costab, *sintab, *lbt, *ew, *ropetab;
  int* eidx;
  act_t *u, *P, *OF, *OB, *M, *LF;
  act_t *Wt_in_even, *Wt_out_even, *Wt_in_odd, *Wt_out_odd;
  act_t *Y, *Cmat, *FT;
  unsigned char *W8up, *W8down, *W8up1, *W8down1, *H8, *u8;
  unsigned char *W8in_even, *W8in_odd;
  int *cnt, *list;
  unsigned* bar;
  int use_cg_sync;
  int pad_;
};

DEV float sigmoidf_(float v) { return 1.0f / (1.0f + expf(-v)); }
DEV float siluf_(float v) { return v / (1.0f + expf(-v)); }

DEV const float* hrow_in(const Params& p, long row) {
  return row < NC ? p.ctx + row * D : p.x + (row - NC) * D;
}
DEV float* hrow(const Params& p, long row) { return row < NC ? p.hc + row * D : p.out + (row - NC) * D; }
DEV const float* modrow(const Params& p, int l, long row) {
  int bb = row < NC ? NB : (int)((row - NC) / T);
  return p.mod + ((long)l * (NB + 1) + bb) * 6 * D;
}

DEV void ph_mod(const Params& p, long i) {
  int j = (int)(i % (6 * D));
  int bb = (int)((i / (6 * D)) % (NB + 1));
  int l = (int)(i / ((long)6 * D * (NB + 1)));
  const float* cv = bb < NB ? p.c + (long)bb * D : p.c_ctx;
  const float* w = p.w_ada + (long)l * D * 6 * D + j;
  float s = p.b_ada[l * 6 * D + j];
  for (int k = 0; k < D; ++k) s += siluf_(cv[k]) * w[(long)k * 6 * D];
  p.mod[i] = s;
}

DEV void ph_tables(const Params& p, long i) {
  if (i < 1024) {
    int pos = (int)(i >> 4), idx = (int)(i & 15);
    float ang = (float)pos * powf(10000.0f, -(float)idx / 16.0f);
    p.ropetab[2 * i] = cosf(ang);
    p.ropetab[2 * i + 1] = sinf(ang);
  }
  if (i < 1024) {
    int dir = (int)(i / 512), col = (int)(i % 512);
    float l0 = p.lb_logits[(dir * 2 + 0) * 512 + col], l1 = p.lb_logits[(dir * 2 + 1) * 512 + col];
    p.lbt[i] = 1.0f / (1.0f + expf(l1 - l0));
  }
}

DEV void ln_mod_row(const float* h, const float* shift, const float* scale, act_t* u) {
  float mu = 0.f;
  for (int k = 0; k < D; ++k) mu += h[k];
  mu *= (1.0f / D);
  float var = 0.f;
  for (int k = 0; k < D; ++k) { float d = h[k] - mu; var += d * d; }
  var *= (1.0f / D);
  float rs = 1.0f / sqrtf(var + LN_EPS);
  for (int k = 0; k < D; ++k) stA(u + k, (h[k] - mu) * rs * (1.0f + scale[k]) + shift[k]);
}

DEV void ph_lnmod_first(const Params& p, long row) {
  const float* m = modrow(p, 0, row);
  ln_mod_row(hrow_in(p, row), m, m + D, p.u + row * D);
}

DEV void gemm_item_act(const act_t* A, const float* W, act_t* Cout, int K, int N, int ldc, long i) {
  int n4 = (int)(i % (N / 4));
  long row = i / (N / 4);
  const act_t* a = A + row * K;
  const float* w = W + n4 * 4;
  float s0 = 0, s1 = 0, s2 = 0, s3 = 0;
  for (int k = 0; k < K; ++k) {
    float av = ldA(a + k);
    const float* wr = w + (long)k * N;
    s0 += av * wr[0]; s1 += av * wr[1]; s2 += av * wr[2]; s3 += av * wr[3];
  }
  act_t* o = Cout + row * ldc + n4 * 4;
  stA(o, s0); stA(o + 1, s1); stA(o + 2, s2); stA(o + 3, s3);
}

DEV void ph_rope(const Params& p, long i) {
  int pr = (int)(i % 32);
  int hh = (int)((i / 32) % 10);
  long lr = i / 320;
  int t = (int)(lr % T);
  int col = hh < 8 ? E_AQ + hh * 64 : E_AK + (hh - 8) * 64;
  int idx = pr & 15;
  int pos = pr < 16 ? t / GRID_W : t % GRID_W;
  int d0 = pr < 16 ? idx : 32 + idx;
  float inv = powf(10000.0f, -(float)idx / 16.0f);
  float ang = (float)pos * inv;
  float cs = cosf(ang), sn = sinf(ang);
  act_t* base = p.P + (NC + lr) * PW + col;
  float x1 = ldA(base + d0), x2 = ldA(base + d0 + 16);
  stA(base + d0, x1 * cs - x2 * sn);
  stA(base + d0 + 16, x1 * sn + x2 * cs);
}

DEV void ph_attn(const Params& p, long i) {
  int h = (int)(i % 8);
  long row = i / 8;
  int kv = h / 4;
  bool lat = row >= NC;
  int b = lat ? (int)((row - NC) / T) : (int)(row / C);
  int t = lat ? (int)((row - NC) % T) : 0;
  float q[64], acc[64];
  const act_t* qp = p.P + row * PW + E_AQ + h * 64;
#pragma unroll
  for (int d = 0; d < 64; ++d) { q[d] = ldA(qp + d) * 0.125f; acc[d] = 0.f; }
  float m = p.attn_sink[h], l = 1.0f;
  int nkeys = C + (lat ? 257 : 0);
  for (int j = 0; j < nkeys; ++j) {
    long krow;
    if (j < C) krow = (long)b * C + j;
    else {
      int kp = t - 128 + (j - C);
      if (kp < 0 || kp >= T) continue;
      krow = NC + (long)b * T + kp;
    }
    const act_t* kptr = p.P + krow * PW + E_AK + kv * 64;
    const act_t* vptr = p.P + krow * PW + E_AV + kv * 64;
    float s = 0.f;
#pragma unroll
    for (int d = 0; d < 64; ++d) s += q[d] * ldA(kptr + d);
    float mn = fmaxf(m, s);
    float sc = expf(m - mn), pj = expf(s - mn);
    l = l * sc + pj;
#pragma unroll
    for (int d = 0; d < 64; ++d) acc[d] = acc[d] * sc + pj * ldA(vptr + d);
    m = mn;
  }
  float il = 1.0f / l;
  act_t* o = p.u + row * D + h * 64;
#pragma unroll
  for (int d = 0; d < 64; ++d) stA(o + d, acc[d] * il);
}

template <int MODE>
DEV void ph_scan(const Params& p, long i) {
  constexpr int DK = MODE == 0 ? 128 : 96;
  constexpr int DV = MODE == 0 ? 128 : 192;
  int e = (int)(i % DV);
  int dir = (int)((i / DV) % 2);
  int h = (int)((i / (2 * DV)) % 4);
  int b = (int)(i / (8 * DV));
  float S[DK];
#pragma unroll
  for (int d = 0; d < DK; ++d) S[d] = 0.f;
  act_t* OD = dir == 0 ? p.OF : p.OB;
  for (int step = 0; step < C + T; ++step) {
    long row;
    if (step < C) row = (long)b * C + (dir == 0 ? step : C - 1 - step);
    else { int tt = step - C; row = NC + (long)b * T + (dir == 0 ? tt : T - 1 - tt); }
    const act_t* pr = p.P + row * PW;
    float o = 0.f;
    if (MODE == 0) {
      float v = ldA(pr + E_HI + h * 128 + e);
      const act_t* zp = pr + E_FF + dir * 512 + h * 128;
      const act_t* qp = pr + E_HQ + h * 128;
      const float* lb = p.lbt + dir * 512 + h * 128;
#pragma unroll
      for (int d = 0; d < DK; ++d) {
        float f = lb[d] + (1.0f - lb[d]) * sigmoidf_(ldA(zp + d));
        S[d] = f * S[d] + (1.0f - f) * v;
        o += ldA(qp + d) * S[d];
      }
      stA(OD + row * 768 + h * 128 + e, o);
    } else {
      float v = ldA(pr + O_V + h * 192 + e);
      const act_t* kp = pr + O_K + h * 96;
      const act_t* qp = pr + O_Q + h * 96;
      const act_t* lf = p.LF + ((long)dir * NR + row) * 384 + h * 96;
#pragma unroll
      for (int d = 0; d < DK; ++d) {
        float f = expf(ldA(lf + d));
        S[d] = f * S[d] + ldA(kp + d) * v;
        o += ldA(qp + d) * S[d];
      }
      stA(OD + row * 768 + h * 192 + e, o * 0.10206207261596575f);
    }
  }
}

template <int MODE>
DEV void ph_combine(const Params& p, long i) {
  constexpr int DV = MODE == 0 ? 128 : 192;
  int h = (int)(i % 4);
  long row = (MODE == 0) ? i / 4 : NC + i / 4;
  const act_t* f = p.OF + row * 768 + h * DV;
  const act_t* bk = p.OB + row * 768 + h * DV;
  float ss = 0.f;
  for (int e = 0; e < DV; ++e) { float o = ldA(f + e) + ldA(bk + e); ss += o * o; }
  float r = 1.0f / sqrtf(ss / DV + LN_EPS);
  const float* gn = (MODE == 0 ? p.hgrn_norm : p.gla_norm) + h * DV;
  const act_t* g = p.P + row * PW + (MODE == 0 ? E_HG : O_G) + h * DV;
  act_t* o = p.u + row * D + (MODE == 0 ? 512 : 0) + h * DV;
  for (int e = 0; e < DV; ++e) stA(o + e, (ldA(f + e) + ldA(bk + e)) * r * gn[e] * siluf_(ldA(g + e)));
}

DEV void ph_gla_decay(const Params& p, long i) {
  int col = (int)(i % 384);
  long row = (i / 384) % NR;
  int dir = (int)(i / ((long)384 * NR));
  const act_t* r = p.P + row * PW + O_RF + dir * 16;
  const float* gw = p.gla_gate_w + (long)dir * 16 * 384 + col;
  float z = p.gla_gate_b[dir * 384 + col];
  for (int k = 0; k < 16; ++k) z += ldA(r + k) * gw[k * 384];
  float ls = fminf(z, 0.f) - log1pf(expf(-fabsf(z)));
  stA(p.LF + ((long)dir * NR + row) * 384 + col, ls * (1.0f / 16.0f));
}

DEV void ph_resid_ln(const Params& p, long row, int l, int sub) {
  const float* hin = (l == 0 && sub == 0) ? hrow_in(p, row) : hrow(p, row);
  float* hout = hrow(p, row);
  const float* md = modrow(p, l, row);
  const float* g = md + (sub == 0 ? 2 : 5) * D;
  const act_t* m = p.M + row * D;
  const float* lg = p.ln_g + (l * 2 + sub) * D;
  const float* lb = p.ln_b + (l * 2 + sub) * D;
  float mu = 0.f;
  for (int k = 0; k < D; ++k) mu += ALPHA * hin[k] + g[k] * ldA(m + k);
  mu *= (1.0f / D);
  float var = 0.f;
  for (int k = 0; k < D; ++k) { float d = ALPHA * hin[k] + g[k] * ldA(m + k) - mu; var += d * d; }
  var *= (1.0f / D);
  float rs = 1.0f / sqrtf(var + LN_EPS);
  for (int k = 0; k < D; ++k) hout[k] = (ALPHA * hin[k] + g[k] * ldA(m + k) - mu) * rs * lg[k] + lb[k];
  if (sub == 1 && l == 1) return;
  const float* md2 = (sub == 0) ? md + 3 * D : modrow(p, 1, row);
  float mu2 = 0.f;
  for (int k = 0; k < D; ++k) mu2 += hout[k];
  mu2 *= (1.0f / D);
  float var2 = 0.f;
  for (int k = 0; k < D; ++k) { float d = hout[k] - mu2; var2 += d * d; }
  var2 *= (1.0f / D);
  float rs2 = 1.0f / sqrtf(var2 + LN_EPS);
  float lo[NEXP];
#pragma unroll
  for (int e = 0; e < NEXP; ++e) lo[e] = 0.f;
  for (int k = 0; k < D; ++k) {
    float uv = (hout[k] - mu2) * rs2 * (1.0f + md2[D + k]) + md2[k];
    stA(p.u + row * D + k, uv);
    if (sub == 0) {
      const float* wr = p.w_router + k * NEXP;
#pragma unroll
      for (int e = 0; e < NEXP; ++e) lo[e] += uv * wr[e];
    }
  }
  if (sub != 0) return;
  float mx = lo[0];
#pragma unroll
  for (int e = 1; e < NEXP; ++e) mx = fmaxf(mx, lo[e]);
  float sum = 0.f;
#pragma unroll
  for (int e = 0; e < NEXP; ++e) { lo[e] = expf(lo[e] - mx); sum += lo[e]; }
  float inv = 1.0f / sum;
  float bestg = -1e30f; int bg = 0;
  float gi1 = 0, gi2 = 0; int ge1 = 0, ge2 = 0;
  float gp1 = 0, gp2 = 0;
#pragma unroll
  for (int gq = 0; gq < 4; ++gq) {
    float s1 = -1e30f, s2 = -1e30f, p1 = 0, p2 = 0; int e1 = 0, e2 = 0;
#pragma unroll
    for (int j = 0; j < 4; ++j) {
      int e = gq * 4 + j;
      float pe = lo[e] * inv;
      float se = pe + p.b_router[e];
      if (se > s1) { s2 = s1; p2 = p1; e2 = e1; s1 = se; p1 = pe; e1 = e; }
      else if (se > s2) { s2 = se; p2 = pe; e2 = e; }
    }
    float gs = s1 + s2;
    if (gs > bestg) { bestg = gs; bg = gq; gi1 = s1; gi2 = s2; ge1 = e1; ge2 = e2; gp1 = p1; gp2 = p2; }
  }
  (void)bg; (void)gi1; (void)gi2;
  float wsum = gp1 + gp2;
  p.eidx[row * 2 + 0] = ge1; p.eidx[row * 2 + 1] = ge2;
  p.ew[row * 2 + 0] = gp1 / wsum; p.ew[row * 2 + 1] = gp2 / wsum;
}

DEV void ph_moe_up(const Params& p, long i, int l, long row0) {
  int f4 = (int)(i % (DFF / 4));
  int slot = (int)((i / (DFF / 4)) % 2);
  long row = row0 + i / (DFF / 2);
  int e = p.eidx[row * 2 + slot];
  const float* w1 = p.w_eg + ((long)(l * NEXP + e) * D) * DFF + f4 * 4;
  const float* w3 = p.w_eu + ((long)(l * NEXP + e) * D) * DFF + f4 * 4;
  const act_t* a = p.u + row * D;
  float g0 = 0, g1 = 0, g2 = 0, g3 = 0, u0 = 0, u1 = 0, u2 = 0, u3 = 0;
  for (int k = 0; k < D; ++k) {
    float av = ldA(a + k);
    const float* r1 = w1 + (long)k * DFF;
    const float* r3 = w3 + (long)k * DFF;
    g0 += av * r1[0]; g1 += av * r1[1]; g2 += av * r1[2]; g3 += av * r1[3];
    u0 += av * r3[0]; u1 += av * r3[1]; u2 += av * r3[2]; u3 += av * r3[3];
  }
  act_t* hb = p.P + (row * 2 + slot) * DFF + f4 * 4;
  stA(hb, siluf_(g0) * u0); stA(hb + 1, siluf_(g1) * u1); stA(hb + 2, siluf_(g2) * u2); stA(hb + 3, siluf_(g3) * u3);
}

DEV void ph_moe_down(const Params& p, long i, int l, long row0) {
  int j4 = (int)(i % (D / 4));
  long row = row0 + i / (D / 4);
  float y0 = 0, y1 = 0, y2 = 0, y3 = 0;
  for (int slot = 0; slot < 2; ++slot) {
    int e = p.eidx[row * 2 + slot];
    float wgt = p.ew[row * 2 + slot];
    const float* w2 = p.w_ed + ((long)(l * NEXP + e) * DFF) * D + j4 * 4;
    const act_t* hb = p.P + (row * 2 + slot) * DFF;
    float s0 = 0, s1 = 0, s2 = 0, s3 = 0;
    for (int f = 0; f < DFF; ++f) {
      float hv = ldA(hb + f);
      const float* r = w2 + (long)f * D;
      s0 += hv * r[0]; s1 += hv * r[1]; s2 += hv * r[2]; s3 += hv * r[3];
    }
    y0 += wgt * s0; y1 += wgt * s1; y2 += wgt * s2; y3 += wgt * s3;
  }
  act_t* o = p.M + row * D + j4 * 4;
  stA(o, y0); stA(o + 1, y1); stA(o + 2, y2); stA(o + 3, y3);
}


#ifndef HOST_TEST
typedef __attribute__((ext_vector_type(8))) short bf16x8;
typedef __attribute__((ext_vector_type(4))) float f32x4;
constexpr int SMEM_BYTES = 71680;
constexpr int IN_ODD_PAD = 2944;
constexpr int O_FA = 2336, O_FB = 2592, O_END = 2848;

typedef float f32x2_t __attribute__((ext_vector_type(2)));
typedef __bf16 bf16x2_t __attribute__((ext_vector_type(2)));
__device__ __forceinline__ unsigned pack2(float a, float b) {
  const f32x2_t v = {a, b};
  return __builtin_bit_cast(unsigned, __builtin_convertvector(v, bf16x2_t));
}
__device__ __forceinline__ unsigned pack2_mfma(float a, float b) { return pack2(a, b); }
typedef __attribute__((ext_vector_type(2))) unsigned u32x2;
__device__ __forceinline__ float xor16_max(float x) {
  const u32x2 r = __builtin_amdgcn_permlane16_swap(__float_as_uint(x), __float_as_uint(x), false, false);
  return fmaxf(__uint_as_float(r.x), __uint_as_float(r.y));
}
__device__ __forceinline__ float xor32_max(float x) {
  const u32x2 r = __builtin_amdgcn_permlane32_swap(__float_as_uint(x), __float_as_uint(x), false, false);
  return fmaxf(__uint_as_float(r.x), __uint_as_float(r.y));
}
__device__ __forceinline__ float xor16_add(float x) {
  const u32x2 r = __builtin_amdgcn_permlane16_swap(__float_as_uint(x), __float_as_uint(x), false, false);
  return __uint_as_float(r.x) + __uint_as_float(r.y);
}
__device__ __forceinline__ float xor32_add(float x) {
  const u32x2 r = __builtin_amdgcn_permlane32_swap(__float_as_uint(x), __float_as_uint(x), false, false);
  return __uint_as_float(r.x) + __uint_as_float(r.y);
}
__device__ __forceinline__ float bf_lo(unsigned u) { return __uint_as_float(u << 16); }
__device__ __forceinline__ float bf_hi(unsigned u) { return __uint_as_float(u & 0xffff0000u); }
template <int CTRL>
__device__ __forceinline__ float dpp_mov(float v) {
  return __int_as_float(__builtin_amdgcn_update_dpp(0, __float_as_int(v), CTRL, 0xf, 0xf, true));
}
__device__ __forceinline__ float row_sum16(float v) {
  v += dpp_mov<0xB1>(v);
  v += dpp_mov<0x4E>(v);
  v += dpp_mov<0x141>(v);
  v += dpp_mov<0x140>(v);
  return v;
}
__device__ __forceinline__ float wave_sum(float v) {
  v = row_sum16(v);
  const float a = __int_as_float(__builtin_amdgcn_readlane(__float_as_int(v), 0));
  const float b = __int_as_float(__builtin_amdgcn_readlane(__float_as_int(v), 16));
  const float c = __int_as_float(__builtin_amdgcn_readlane(__float_as_int(v), 32));
  const float d = __int_as_float(__builtin_amdgcn_readlane(__float_as_int(v), 48));
  return (a + b) + (c + d);
}


#define XB_TMO      128
#define XB_XCNT(j)  (256  + 64 * (j))
#define XB_XSUB(j)  (1280 + 64 * (j))
#define XB_XGEN(j)  (2304 + 64 * (j))
#define XB_TOP      3328
#define XB_TOPGEN   3392
#define XCD_BAR_WORDS 3456
#define XB_SPIN_CAP (1u << 18)
#define LAS __attribute__((address_space(3)))
__device__ __forceinline__ unsigned xb_ld(unsigned* p)              { return __hip_atomic_load(p, __ATOMIC_RELAXED, __HIP_MEMORY_SCOPE_AGENT); }
__device__ __forceinline__ unsigned xb_add(unsigned* p, unsigned v) { return __hip_atomic_fetch_add(p, v, __ATOMIC_RELAXED, __HIP_MEMORY_SCOPE_AGENT); }
__device__ __forceinline__ unsigned xb_xcc_id() { return (unsigned)__builtin_amdgcn_s_getreg((3 << 11) | 20) & 0xFu; }
#define XB_SPIN(cond, bar) do { unsigned _sp = 0; while (cond) { __builtin_amdgcn_s_sleep(1); \
    if ((++_sp & 255u) == 0u) { if (xb_ld(&(bar)[XB_TMO])) break; if (_sp > XB_SPIN_CAP) { atomicAdd(&(bar)[XB_TMO], 1u); break; } } } } while (0)
struct XcdBarrier { unsigned* bar; unsigned x; volatile LAS unsigned* st; };
__device__ __forceinline__ XcdBarrier xcd_barrier_post(unsigned* bar, volatile LAS unsigned* st) {
    XcdBarrier b; b.bar = bar; b.x = xb_xcc_id(); b.st = st;
    if (threadIdx.x == 0) (void)xb_add(&bar[XB_XCNT(b.x)], 1u);
    return b;
}
__device__ __forceinline__ void xcd_barrier_complete(unsigned* bar, unsigned x, unsigned& nloc, unsigned& nx) {
    const unsigned G = gridDim.x * gridDim.y * gridDim.z;
    unsigned sum, cnt, mine, sp = 0u;
    for (;;) {
        sum = 0u; cnt = 0u; mine = 0u;
#pragma unroll
        for (unsigned j = 0; j < 16; ++j) { const unsigned c = xb_ld(&bar[XB_XCNT(j)]); sum += c; cnt += (c > 0u) ? 1u : 0u; mine = (j == x) ? c : mine; }
        if (sum == G) break;
        __builtin_amdgcn_s_sleep(1);
        if ((++sp & 255u) == 0u) { if (xb_ld(&bar[XB_TMO])) break; if (sp > XB_SPIN_CAP) { atomicAdd(&bar[XB_TMO], 1u); break; } }
    }
    nloc = mine > 0u ? mine : 1u; nx = cnt > 0u ? cnt : 1u;
}
__device__ __forceinline__ void xcd_barrier(const XcdBarrier& b) {
    asm volatile("s_waitcnt vmcnt(0)" ::: "memory");
    __syncthreads();
    if (threadIdx.x == 0) {
        unsigned* bar = b.bar;
        __builtin_amdgcn_s_waitcnt(0);
        unsigned nloc = b.st[0], nx = b.st[1];
        if (nloc == 0u) { xcd_barrier_complete(bar, b.x, nloc, nx); b.st[0] = nloc; b.st[1] = nx; }
        const unsigned old = xb_add(&bar[XB_XSUB(b.x)], 1u);
        const unsigned gen = old / nloc;
        if (old + 1u == (gen + 1u) * nloc) {
            __builtin_amdgcn_fence(__ATOMIC_RELEASE, "agent");
            asm volatile("s_waitcnt vmcnt(0)" ::: "memory");
            const unsigned og = xb_add(&bar[XB_TOP], 1u);
            const unsigned tg = og / nx;
            if (og + 1u == (tg + 1u) * nx) xb_add(&bar[XB_TOPGEN], 1u);
            else XB_SPIN(xb_ld(&bar[XB_TOPGEN]) == tg, bar);
            __builtin_amdgcn_fence(__ATOMIC_ACQUIRE, "agent");
            xb_add(&bar[XB_XGEN(b.x)], 1u);
            asm volatile("s_waitcnt vmcnt(0)" ::: "memory");
        } else {
            XB_SPIN(xb_ld(&bar[XB_XGEN(b.x)]) == gen, bar);
            __builtin_amdgcn_fence(__ATOMIC_ACQUIRE, "agent");
            asm volatile("s_waitcnt vmcnt(0)" ::: "memory");
        }
    }
    __syncthreads();
}

#define RAW_BARRIER() do { asm volatile("s_waitcnt lgkmcnt(0)" ::: "memory"); __builtin_amdgcn_s_barrier(); } while (0)
template <bool SWAP, class ARow, class Epi>
__device__ __forceinline__ void gemm_tile(ARow arow, const act_t* Bt, int K, unsigned char* smem, Epi epi) {
  const int tid = threadIdx.x, wid = tid >> 6, lane = tid & 63, wr = wid >> 1, wc = wid & 1, fr = lane & 15,
            fq = lane >> 4;
  const int r0 = tid >> 3, pc = tid & 7;
  const int lc = pc ^ ((tid >> 4) & 7);
  const act_t* ga[4];
#pragma unroll
  for (int i = 0; i < 4; ++i) ga[i] = arow(r0 + 32 * i) + lc * 8;
  const act_t* gb0 = Bt + (long)r0 * K + lc * 8;
  const long gbs = (long)32 * K;
  const int sw = (fr >> 1) & 7;
  const int rd0 = fr * 128 + ((fq ^ sw) << 4), rd1 = fr * 128 + (((4 + fq) ^ sw) << 4);
  char* S = (char*)smem;
  const int nk = K >> 6;
  f32x4 acc[4][4];
#pragma unroll
  for (int m = 0; m < 4; ++m)
#pragma unroll
    for (int n = 0; n < 4; ++n) acc[m][n] = f32x4{0.f, 0.f, 0.f, 0.f};
  auto issue = [&](int kt) {
    char* st = S + (kt & 1) * 32768 + tid * 16;
#pragma unroll
    for (int i = 0; i < 4; ++i) {
      __builtin_amdgcn_global_load_lds((const unsigned*)(ga[i] + kt * 64), (unsigned*)(st + i * 4096), 16, 0, 0);
      __builtin_amdgcn_global_load_lds((const unsigned*)(gb0 + i * gbs + kt * 64), (unsigned*)(st + 16384 + i * 4096), 16, 0, 0);
    }
  };
  RAW_BARRIER();
  issue(0);
  for (int kt = 0; kt < nk; ++kt) {
    asm volatile("s_waitcnt vmcnt(0)" ::: "memory");
    RAW_BARRIER();
    if (kt + 1 < nk) issue(kt + 1);
    const char* st = S + (kt & 1) * 32768;
#pragma unroll
    for (int ks = 0; ks < 2; ++ks) {
      const int rd = ks ? rd1 : rd0;
      bf16x8 af[4], bfr[4];
#pragma unroll
      for (int m = 0; m < 4; ++m) {
        af[m] = *reinterpret_cast<const bf16x8*>(st + (wr * 64 + m * 16) * 128 + rd);
        bfr[m] = *reinterpret_cast<const bf16x8*>(st + 16384 + (wc * 64 + m * 16) * 128 + rd);
      }
#pragma unroll
      for (int m = 0; m < 4; ++m)
#pragma unroll
        for (int n = 0; n < 4; ++n)
          acc[m][n] = SWAP ? __builtin_amdgcn_mfma_f32_16x16x32_bf16(bfr[n], af[m], acc[m][n], 0, 0, 0)
                           : __builtin_amdgcn_mfma_f32_16x16x32_bf16(af[m], bfr[n], acc[m][n], 0, 0, 0);
    }
  }
  epi(acc, wr, wc, fr, fq);
}


constexpr float SU8 = 16.0f, SW8 = 64.0f, SH8 = 8.0f;
typedef unsigned char fp8_t;
typedef __attribute__((ext_vector_type(8))) int i32x8;
typedef __attribute__((ext_vector_type(4))) int i32x4;
__device__ __forceinline__ unsigned pack4_fp8(float a, float b, float c, float d) {
  a = fminf(fmaxf(a, -448.f), 448.f); b = fminf(fmaxf(b, -448.f), 448.f);
  c = fminf(fmaxf(c, -448.f), 448.f); d = fminf(fmaxf(d, -448.f), 448.f);
  unsigned w = 0;
  w = __builtin_amdgcn_cvt_pk_fp8_f32(a, b, w, false);
  w = __builtin_amdgcn_cvt_pk_fp8_f32(c, d, w, true);
  return w;
}

template <bool SWAP, class ARow, class Epi>
__device__ __forceinline__ void gemm_tile8(ARow arow, const fp8_t* Bt, int Kb, unsigned char* smem, Epi epi) {
  const int tid = threadIdx.x, wid = tid >> 6, lane = tid & 63, wr = wid >> 1, wc = wid & 1, fr = lane & 15,
            fq = lane >> 4;
  const int r0 = tid >> 3, pc = tid & 7;
  const int lc = pc ^ ((tid >> 4) & 7);
  const fp8_t* ga[4];
#pragma unroll
  for (int i = 0; i < 4; ++i) ga[i] = arow(r0 + 32 * i) + lc * 16;
  const fp8_t* gb0 = Bt + (long)r0 * Kb + lc * 16;
  const long gbs = (long)32 * Kb;
  const int sw = (fr >> 1) & 7;
  const int rd0 = fr * 128 + ((fq ^ sw) << 4), rd1 = fr * 128 + (((4 + fq) ^ sw) << 4);
  char* S = (char*)smem;
  const int nk = Kb >> 7;
  f32x4 acc[4][4];
#pragma unroll
  for (int m = 0; m < 4; ++m)
#pragma unroll
    for (int n = 0; n < 4; ++n) acc[m][n] = f32x4{0.f, 0.f, 0.f, 0.f};
  auto issue = [&](int kt) {
    char* st = S + (kt & 1) * 32768 + tid * 16;
#pragma unroll
    for (int i = 0; i < 4; ++i) {
      __builtin_amdgcn_global_load_lds((const unsigned*)(ga[i] + kt * 128), (unsigned*)(st + i * 4096), 16, 0, 0);
      __builtin_amdgcn_global_load_lds((const unsigned*)(gb0 + i * gbs + kt * 128), (unsigned*)(st + 16384 + i * 4096), 16, 0, 0);
    }
  };
  RAW_BARRIER();
  issue(0);
#pragma unroll 1
  for (int kt = 0; kt < nk; ++kt) {
    asm volatile("s_waitcnt vmcnt(0)" ::: "memory");
    RAW_BARRIER();
    if (kt + 1 < nk) issue(kt + 1);
    const char* st = S + (kt & 1) * 32768;
    i32x8 af[4], bfr[4];
#pragma unroll
    for (int m = 0; m < 4; ++m) {
      const i32x4 a0 = *reinterpret_cast<const i32x4*>(st + (wr * 64 + m * 16) * 128 + rd0);
      const i32x4 a1 = *reinterpret_cast<const i32x4*>(st + (wr * 64 + m * 16) * 128 + rd1);
      const i32x4 b0 = *reinterpret_cast<const i32x4*>(st + 16384 + (wc * 64 + m * 16) * 128 + rd0);
      const i32x4 b1 = *reinterpret_cast<const i32x4*>(st + 16384 + (wc * 64 + m * 16) * 128 + rd1);
      af[m] = i32x8{a0[0], a0[1], a0[2], a0[3], a1[0], a1[1], a1[2], a1[3]};
      bfr[m] = i32x8{b0[0], b0[1], b0[2], b0[3], b1[0], b1[1], b1[2], b1[3]};
    }
#pragma unroll
    for (int m = 0; m < 4; ++m)
#pragma unroll
      for (int n = 0; n < 4; ++n)
        acc[m][n] = SWAP ? __builtin_amdgcn_mfma_scale_f32_16x16x128_f8f6f4(bfr[n], af[m], acc[m][n], 0, 0, 0, 0x7f7f7f7f, 0, 0x7f7f7f7f)
                         : __builtin_amdgcn_mfma_scale_f32_16x16x128_f8f6f4(af[m], bfr[n], acc[m][n], 0, 0, 0, 0x7f7f7f7f, 0, 0x7f7f7f7f);
  }
  epi(acc, wr, wc, fr, fq);
}


template <bool SWAP, class Epi>
__device__ __forceinline__ void gemm_tile8p(const fp8_t* A, const fp8_t* Bt, bool has_next, const fp8_t* An, const fp8_t* Btn,
                                            int& par, bool& primed, int Kb, unsigned char* smem, Epi epi) {
  const int tid = threadIdx.x, wid = tid >> 6, lane = tid & 63, wr = wid >> 1, wc = wid & 1, fr = lane & 15,
            fq = lane >> 4;
  const int r0 = tid >> 3, pc = tid & 7;
  const int lc = pc ^ ((tid >> 4) & 7);
  const long roff = (long)r0 * Kb + lc * 16;
  const long gbs = (long)32 * Kb;
  const int sw = (fr >> 1) & 7;
  const int rd0 = fr * 128 + ((fq ^ sw) << 4), rd1 = fr * 128 + (((4 + fq) ^ sw) << 4);
  char* S = (char*)smem;
  const int nk = Kb >> 7;
  f32x4 acc[4][4];
#pragma unroll
  for (int m = 0; m < 4; ++m)
#pragma unroll
    for (int n = 0; n < 4; ++n) acc[m][n] = f32x4{0.f, 0.f, 0.f, 0.f};
  auto issue = [&](const fp8_t* a, const fp8_t* b, int kt, int stage) {
    char* st = S + stage * 32768 + tid * 16;
    const fp8_t* ga = a + roff + kt * 128;
    const fp8_t* gb = b + roff + kt * 128;
#pragma unroll
    for (int i = 0; i < 4; ++i) {
      __builtin_amdgcn_global_load_lds((const unsigned*)(ga + i * gbs), (unsigned*)(st + i * 4096), 16, 0, 0);
      __builtin_amdgcn_global_load_lds((const unsigned*)(gb + i * gbs), (unsigned*)(st + 16384 + i * 4096), 16, 0, 0);
    }
  };
  if (!primed) {
    RAW_BARRIER();
    issue(A, Bt, 0, par);
  }
#pragma unroll 1
  for (int kt = 0; kt < nk; ++kt) {
    asm volatile("s_waitcnt vmcnt(0)" ::: "memory");
    RAW_BARRIER();
    if (kt + 1 < nk) issue(A, Bt, kt + 1, (par + kt + 1) & 1);
    else if (has_next) issue(An, Btn, 0, (par + kt + 1) & 1);
    const char* st = S + ((par + kt) & 1) * 32768;
    i32x8 af[4], bfr[4];
#pragma unroll
    for (int m = 0; m < 4; ++m) {
      const i32x4 a0 = *reinterpret_cast<const i32x4*>(st + (wr * 64 + m * 16) * 128 + rd0);
      const i32x4 a1 = *reinterpret_cast<const i32x4*>(st + (wr * 64 + m * 16) * 128 + rd1);
      const i32x4 b0 = *reinterpret_cast<const i32x4*>(st + 16384 + (wc * 64 + m * 16) * 128 + rd0);
      const i32x4 b1 = *reinterpret_cast<const i32x4*>(st + 16384 + (wc * 64 + m * 16) * 128 + rd1);
      af[m] = i32x8{a0[0], a0[1], a0[2], a0[3], a1[0], a1[1], a1[2], a1[3]};
      bfr[m] = i32x8{b0[0], b0[1], b0[2], b0[3], b1[0], b1[1], b1[2], b1[3]};
    }
#pragma unroll
    for (int m = 0; m < 4; ++m)
#pragma unroll
      for (int n = 0; n < 4; ++n)
        acc[m][n] = SWAP ? __builtin_amdgcn_mfma_scale_f32_16x16x128_f8f6f4(bfr[n], af[m], acc[m][n], 0, 0, 0, 0x7f7f7f7f, 0, 0x7f7f7f7f)
                         : __builtin_amdgcn_mfma_scale_f32_16x16x128_f8f6f4(af[m], bfr[n], acc[m][n], 0, 0, 0, 0x7f7f7f7f, 0, 0x7f7f7f7f);
  }
  par = (par + nk) & 1;
  primed = has_next;
  epi(acc, wr, wc, fr, fq);
}

__device__ __forceinline__ void phase_attn(const Params& p, unsigned char* smem, int blk, int nblk) {
  const int tid = threadIdx.x, w = tid >> 6, lane = tid & 63, fr = lane & 15, g = lane >> 4;
  act_t* SK = (act_t*)smem;
  act_t* SV = SK + 64 * 72;
  constexpr float SCL = 0.125f * 1.4426950408889634f;
  const int n_lat = NB * 4 * (T / 64), n_ctx = NB * 4 * (C / 64);
  const int skey = tid >> 2, spart = tid & 3;
  for (int unit = blk; unit < n_lat + n_ctx; unit += nblk) {
    const bool lat = unit < n_lat;
    const int uu = lat ? unit : unit - n_lat;
    const int nq = lat ? T / 64 : C / 64;
    const int hp = uu & 1, kv = (uu >> 1) & 1, qb = (uu >> 2) % nq, b = (uu >> 2) / nq;
    const int t0 = qb * 64;
    const int tw = t0 + (w & 1) * 32;
    const long qrow0 = (lat ? (long)NC + (long)b * T : (long)b * C) + tw;
    const int h = kv * 4 + hp * 2 + (w >> 1);
    bf16x8 qf[2][2];
#pragma unroll
    for (int qt = 0; qt < 2; ++qt)
#pragma unroll
      for (int st = 0; st < 2; ++st)
        qf[qt][st] = *reinterpret_cast<const bf16x8*>(p.P + (qrow0 + qt * 16 + fr) * PW + E_AQ + h * 64 + st * 32 + g * 8);
    asm volatile("" :: "v"(qf[0][0]), "v"(qf[0][1]), "v"(qf[1][0]), "v"(qf[1][1]));
    float mrun[2], lrun[2];
    f32x4 o[2][4];
    const float sinkl = p.attn_sink[h] * 1.4426950408889634f;
#pragma unroll
    for (int qt = 0; qt < 2; ++qt) {
      mrun[qt] = sinkl;
      lrun[qt] = (g == 0) ? 1.0f : 0.0f;
#pragma unroll
      for (int dt = 0; dt < 4; ++dt) o[qt][dt] = f32x4{0.f, 0.f, 0.f, 0.f};
    }
    int cc_lo = 0, cc_hi = -1;
    if (lat) {
      cc_lo = t0 >= 128 ? 0 : (128 - t0) / 64;
      cc_hi = min(4, (T - 1 - (t0 - 128)) / 64);
    }
    const int nch = 4 + (cc_hi - cc_lo + 1);
    auto chunk_row = [&](int i, int key, int& tkb) -> long {
      if (i < 4) { tkb = 0; return (long)b * C + i * 64 + key; }
      tkb = t0 - 128 + (cc_lo + i - 4) * 64;
      return (long)NC + (long)b * T + tkb + key;
    };
    uint4 rk0, rk1, rv0, rv1;
    {
      int tkb; const long kr = chunk_row(0, skey, tkb);
      const act_t* kp = p.P + kr * PW + E_AK + kv * 64 + spart * 16;
      const act_t* vp = p.P + kr * PW + E_AV + kv * 64 + spart * 16;
      rk0 = *reinterpret_cast<const uint4*>(kp); rk1 = *reinterpret_cast<const uint4*>(kp + 8);
      rv0 = *reinterpret_cast<const uint4*>(vp); rv1 = *reinterpret_cast<const uint4*>(vp + 8);
    }
    for (int i = 0; i < nch; ++i) {
      __syncthreads();
      {
        uint4* kd = reinterpret_cast<uint4*>(SK + skey * 72 + spart * 16);
        kd[0] = rk0; kd[1] = rk1;
        const unsigned vw[8] = {rv0.x, rv0.y, rv0.z, rv0.w, rv1.x, rv1.y, rv1.z, rv1.w};
#pragma unroll
        for (int e = 0; e < 8; ++e) {
          SV[(spart * 16 + 2 * e) * 72 + skey] = (act_t)(vw[e] & 0xffffu);
          SV[(spart * 16 + 2 * e + 1) * 72 + skey] = (act_t)(vw[e] >> 16);
        }
      }
      __syncthreads();
      int tkb_cur; (void)chunk_row(i, 0, tkb_cur);
      if (i + 1 < nch) {
        int tkb; const long kr = chunk_row(i + 1, skey, tkb);
        const act_t* kp = p.P + kr * PW + E_AK + kv * 64 + spart * 16;
        const act_t* vp = p.P + kr * PW + E_AV + kv * 64 + spart * 16;
        rk0 = *reinterpret_cast<const uint4*>(kp); rk1 = *reinterpret_cast<const uint4*>(kp + 8);
        rv0 = *reinterpret_cast<const uint4*>(vp); rv1 = *reinterpret_cast<const uint4*>(vp + 8);
      }
      const bool edge = i >= 4 && (tkb_cur == t0 - 128 || tkb_cur == t0 + 128);
#pragma unroll
      for (int kb = 0; kb < 2; ++kb) {
        f32x4 sc[2][2];
#pragma unroll
        for (int k2 = 0; k2 < 2; ++k2) {
          const int kt = kb * 2 + k2;
          const bf16x8 kf0 = *reinterpret_cast<const bf16x8*>(SK + (kt * 16 + fr) * 72 + g * 8);
          const bf16x8 kf1 = *reinterpret_cast<const bf16x8*>(SK + (kt * 16 + fr) * 72 + 32 + g * 8);
#pragma unroll
          for (int qt = 0; qt < 2; ++qt) {
            f32x4 z = f32x4{0.f, 0.f, 0.f, 0.f};
            z = __builtin_amdgcn_mfma_f32_16x16x32_bf16(kf0, qf[qt][0], z, 0, 0, 0);
            sc[qt][k2] = __builtin_amdgcn_mfma_f32_16x16x32_bf16(kf1, qf[qt][1], z, 0, 0, 0);
          }
        }
        bf16x8 pf[2];
#pragma unroll
        for (int qt = 0; qt < 2; ++qt) {
          float mx = -1e30f;
#pragma unroll
          for (int k2 = 0; k2 < 2; ++k2)
#pragma unroll
            for (int j = 0; j < 4; ++j) {
              float v = sc[qt][k2][j] * SCL;
              if (edge) {
                const int tk = tkb_cur + (kb * 2 + k2) * 16 + 4 * g + j;
                const int tq = tw + qt * 16 + fr;
                const int df = tq - tk;
                if (df > 128 || df < -128) v = -1e30f;
              }
              sc[qt][k2][j] = v;
              mx = fmaxf(mx, v);
            }
          mx = xor16_max(mx);
          mx = xor32_max(mx);
          const float mnew = fmaxf(mrun[qt], mx);
          if (__any(mnew > mrun[qt])) {
            const float alpha = __builtin_amdgcn_exp2f(mrun[qt] - mnew);
            lrun[qt] *= alpha;
#pragma unroll
            for (int dt = 0; dt < 4; ++dt) o[qt][dt] = o[qt][dt] * alpha;
            mrun[qt] = mnew;
          }
          float ls = 0.f;
          float pv[8];
#pragma unroll
          for (int k2 = 0; k2 < 2; ++k2)
#pragma unroll
            for (int j = 0; j < 4; ++j) {
              const float pe = __builtin_amdgcn_exp2f(sc[qt][k2][j] - mnew);
              pv[k2 * 4 + j] = pe;
              ls += pe;
            }
          lrun[qt] += ls;
          union { unsigned u[4]; bf16x8 v; } cv;
          cv.u[0] = pack2_mfma(pv[0], pv[1]); cv.u[1] = pack2_mfma(pv[2], pv[3]);
          cv.u[2] = pack2_mfma(pv[4], pv[5]); cv.u[3] = pack2_mfma(pv[6], pv[7]);
          pf[qt] = cv.v;
        }
#pragma unroll
        for (int dt = 0; dt < 4; ++dt) {
          union { uint2 h2[2]; bf16x8 v; } vf;
          vf.h2[0] = *reinterpret_cast<const uint2*>(SV + (dt * 16 + fr) * 72 + kb * 32 + 4 * g);
          vf.h2[1] = *reinterpret_cast<const uint2*>(SV + (dt * 16 + fr) * 72 + kb * 32 + 16 + 4 * g);
#pragma unroll
          for (int qt = 0; qt < 2; ++qt) o[qt][dt] = __builtin_amdgcn_mfma_f32_16x16x32_bf16(vf.v, pf[qt], o[qt][dt], 0, 0, 0);
        }
      }
    }
#pragma unroll
    for (int qt = 0; qt < 2; ++qt) {
      float lt = lrun[qt];
      lt = xor16_add(lt);
      lt = xor32_add(lt);
      const float il = 1.0f / lt;
      act_t* orow = p.u + (qrow0 + qt * 16 + fr) * D + h * 64 + 4 * g;
#pragma unroll
      for (int dt = 0; dt < 4; ++dt)
        *reinterpret_cast<uint2*>(orow + dt * 16) =
            make_uint2(pack2(o[qt][dt][0] * il, o[qt][dt][1] * il), pack2(o[qt][dt][2] * il, o[qt][dt][3] * il));
    }
  }
}


template <int MODE>
__device__ __forceinline__ void phase_combine(const Params& p) {
  constexpr int DV = MODE == 0 ? 128 : 192, EPL = DV / 16, NV = EPL / 4;
  const int lane = threadIdx.x & 63;
  const long row_lo = MODE == 0 ? 0 : NC;
  const int nw = (int)gridDim.x * 4, wi = (int)blockIdx.x * 4 + (int)(threadIdx.x >> 6);
  const int rpw = (int)(NR - row_lo + nw - 1) / nw;
  const long r0 = row_lo + (long)wi * rpw, r1 = min((long)NR, r0 + rpw);
  float gn[EPL];
#pragma unroll
  for (int e = 0; e < EPL; ++e) gn[e] = (MODE == 0 ? p.hgrn_norm : p.gla_norm)[lane * EPL + e];
  uint2 fa[NV], fb[NV], fg[NV];
  auto load_row = [&](long row) {
    const uint2* f = reinterpret_cast<const uint2*>(p.OF + row * 768 + lane * EPL);
    const uint2* bk = reinterpret_cast<const uint2*>(p.OB + row * 768 + lane * EPL);
    const uint2* gt = reinterpret_cast<const uint2*>(p.P + row * PW + (MODE == 0 ? E_HG : O_G) + lane * EPL);
#pragma unroll
    for (int v = 0; v < NV; ++v) { fa[v] = f[v]; fb[v] = bk[v]; fg[v] = gt[v]; }
  };
  if (r0 < r1) load_row(r0);
  for (long row = r0; row < r1; ++row) {
    float o[EPL], gg[EPL];
#pragma unroll
    for (int v = 0; v < NV; ++v) {
      o[4 * v + 0] = bf_lo(fa[v].x) + bf_lo(fb[v].x); o[4 * v + 1] = bf_hi(fa[v].x) + bf_hi(fb[v].x);
      o[4 * v + 2] = bf_lo(fa[v].y) + bf_lo(fb[v].y); o[4 * v + 3] = bf_hi(fa[v].y) + bf_hi(fb[v].y);
      gg[4 * v + 0] = bf_lo(fg[v].x); gg[4 * v + 1] = bf_hi(fg[v].x); gg[4 * v + 2] = bf_lo(fg[v].y); gg[4 * v + 3] = bf_hi(fg[v].y);
    }
    load_row(min(row + 1, r1 - 1));
    float ss = 0.f;
#pragma unroll
    for (int e = 0; e < EPL; ++e) ss += o[e] * o[e];
    ss = row_sum16(ss);
    const float r = 1.0f / sqrtf(ss * (1.0f / DV) + LN_EPS);
    uint2* dst = reinterpret_cast<uint2*>(p.u + row * D + (MODE == 0 ? 512 : 0) + lane * EPL);
#pragma unroll
    for (int v = 0; v < NV; ++v) {
      float y[4];
#pragma unroll
      for (int q = 0; q < 4; ++q) {
        const float g = gg[4 * v + q];
        y[q] = o[4 * v + q] * r * gn[4 * v + q] * (g / (1.0f + __expf(-g)));
      }
      dst[v] = make_uint2(pack2(y[0], y[1]), pack2(y[2], y[3]));
    }
  }
}

constexpr int MOD_ITEMS = 2 * (6 * D / 64);
__device__ __forceinline__ void mod_item(const Params& p, int item, unsigned char* smem) {
  float* sc = (float*)smem;
  float* red = sc + 9 * D;
  const int tid = threadIdx.x, w = tid >> 6, lane = tid & 63;
  for (int i = tid; i < 9 * D; i += 256) {
    const int bb = i >> 10, k = i & 1023;
    const float v = bb < NB ? p.c[bb * D + k] : p.c_ctx[k];
    sc[i] = v / (1.0f + __expf(-v));
  }
  __syncthreads();
  const int l = item / (6 * D / 64), j = (item % (6 * D / 64)) * 64 + lane;
  const float* wp = p.w_ada + (long)l * D * 6 * D + (long)(w * 256) * 6 * D + j;
  float a[NB + 1];
#pragma unroll
  for (int bb = 0; bb <= NB; ++bb) a[bb] = 0.f;
  for (int kb = 0; kb < 256; kb += 32) {
    float wv[32];
#pragma unroll
    for (int q = 0; q < 32; ++q) wv[q] = wp[(long)(kb + q) * 6 * D];
#pragma unroll
    for (int q = 0; q < 32; ++q)
#pragma unroll
      for (int bb = 0; bb <= NB; ++bb) a[bb] += sc[bb * D + w * 256 + kb + q] * wv[q];
  }
#pragma unroll
  for (int bb = 0; bb <= NB; ++bb) red[(w * 9 + bb) * 64 + lane] = a[bb];
  __syncthreads();
  for (int i = tid; i < 9 * 64; i += 256) {
    const int bb = i >> 6, jj = i & 63;
    const int col = (item % (6 * D / 64)) * 64 + jj;
    const float sum = ((red[(0 * 9 + bb) * 64 + jj] + red[(1 * 9 + bb) * 64 + jj]) + (red[(2 * 9 + bb) * 64 + jj] + red[(3 * 9 + bb) * 64 + jj]));
    p.mod[((long)l * (NB + 1) + bb) * 6 * D + col] = sum + p.b_ada[l * 6 * D + col];
  }
  __syncthreads();
}

__device__ __forceinline__ void phase_gla_decay(const Params& p) {
  const int t = threadIdx.x;
  if (t >= 192) return;
  const int dir = t / 96, cg = t % 96;
  float gw[16][4], gb[4];
#pragma unroll
  for (int r = 0; r < 16; ++r) {
    const float4 v = *reinterpret_cast<const float4*>(p.gla_gate_w + ((long)dir * 16 + r) * 384 + cg * 4);
    gw[r][0] = v.x; gw[r][1] = v.y; gw[r][2] = v.z; gw[r][3] = v.w;
  }
  {
    const float4 v = *reinterpret_cast<const float4*>(p.gla_gate_b + dir * 384 + cg * 4);
    gb[0] = v.x; gb[1] = v.y; gb[2] = v.z; gb[3] = v.w;
  }
  const int rpb = ((NR + (int)gridDim.x - 1) / (int)gridDim.x + 3) / 4 * 4;
  const long b0 = (long)blockIdx.x * rpb, b1 = min((long)NR, b0 + rpb);
  uint4 ra[4], rb[4];
  auto load4 = [&](long row0) {
#pragma unroll
    for (int q = 0; q < 4; ++q) {
      const uint4* rp = reinterpret_cast<const uint4*>(p.P + min(row0 + q, b1 - 1) * PW + O_RF + dir * 16);
      ra[q] = rp[0]; rb[q] = rp[1];
    }
  };
  if (b0 < b1) load4(b0);
  for (long row0 = b0; row0 < b1; row0 += 4) {
    unsigned rw[4][8];
#pragma unroll
    for (int q = 0; q < 4; ++q) {
      rw[q][0] = ra[q].x; rw[q][1] = ra[q].y; rw[q][2] = ra[q].z; rw[q][3] = ra[q].w;
      rw[q][4] = rb[q].x; rw[q][5] = rb[q].y; rw[q][6] = rb[q].z; rw[q][7] = rb[q].w;
    }
    load4(min(row0 + 4, b1 - 1));
#pragma unroll
    for (int q = 0; q < 4; ++q) {
      float z[4] = {gb[0], gb[1], gb[2], gb[3]};
#pragma unroll
      for (int r2 = 0; r2 < 8; ++r2) {
        const float x0 = bf_lo(rw[q][r2]), x1 = bf_hi(rw[q][r2]);
#pragma unroll
        for (int c = 0; c < 4; ++c) z[c] += x0 * gw[2 * r2][c] + x1 * gw[2 * r2 + 1][c];
      }
      float o[4];
#pragma unroll
      for (int c = 0; c < 4; ++c) o[c] = (fminf(z[c], 0.f) - __logf(1.0f + __expf(-fabsf(z[c])))) * (1.0f / 16.0f);
      if (row0 + q < b1)
        *reinterpret_cast<uint2*>(p.LF + ((long)dir * NR + row0 + q) * 384 + cg * 4) = make_uint2(pack2(o[0], o[1]), pack2(o[2], o[3]));
    }
  }
}

__device__ __forceinline__ void phase_hgrn_gate(const Params& p, long gtid, long gstride) {
  for (long i = gtid; i < (long)NR * 1024; i += gstride) {
    const int col = (int)(i & 1023);
    const long row = i >> 10;
    act_t* z = p.P + row * PW + E_FF + col;
    const float lb = p.lbt[col];
    const float f = lb + (1.0f - lb) * sigmoidf_(ldA(z));
    stA(z, __logf(f));
  }
}

template <int MODE>
__device__ __forceinline__ void phase_scan(const Params& p, unsigned char* smem, int blk, int nblk) {
  constexpr int DK = MODE == 0 ? 128 : 96, DV = MODE == 0 ? 128 : 192, DVS = DV / 4, NET = DVS / 16, NKS = DK / 32,
                NDT = DK / 16;
  constexpr int QS = DK + 8, LS = 72, SS = DK + 8;
  act_t* Qa = (act_t*)smem;
  act_t* Ka = Qa + 64 * QS;
  act_t* KaT = Ka + 64 * QS;
  act_t* VT = KaT + DK * LS;
  act_t* ST = VT + DVS * LS;
  float* tot = (float*)(ST + DVS * SS);
  float* lf32 = tot + 2 * 4 * DK;
  const int tid = threadIdx.x, w = __builtin_amdgcn_readfirstlane(threadIdx.x >> 6), lane = tid & 63, fr = lane & 15, g = lane >> 4;
  const int dp = lane, c0 = 2 * dp;
  const bool cact = dp < DK / 2;
  constexpr int NCH = (C + T) / 64, NCC = C / 64;
  constexpr int NVI = DVS / 8 * 64;
  for (int item = blk; item < NB * 4 * 2 * 4; item += nblk) {
    const int sl = item & 3, dir = (item >> 2) & 1, h = (item >> 3) & 3, b = item >> 5;
    act_t* OD = dir == 0 ? p.OF : p.OB;
    const unsigned loff = (unsigned)min(c0, DK - 2) * 2u;
    const int vcol = (MODE == 0 ? E_HI + h * 128 : O_V + h * 192) + sl * DVS;
    const int ocol = h * DV + sl * DVS;
    auto chunk_base = [&](int n) -> long {
      if (n < NCC) return (long)b * C + (dir ? NCC - 1 - n : n) * 64;
      const int ln = n - NCC;
      return (long)NC + (long)b * T + (dir ? T / 64 - 1 - ln : ln) * 64;
    };
    auto lrow = [&](long base, int l) -> long { return base + (dir ? 63 - l : l); };
    f32x4 S[NET][2];
#pragma unroll
    for (int et = 0; et < NET; ++et) { S[et][0] = f32x4{0.f, 0.f, 0.f, 0.f}; S[et][1] = f32x4{0.f, 0.f, 0.f, 0.f}; }
    unsigned rlf[16], rq[16], rk[16];
    uint4 rv[2];
    const long rstep = dir ? -(long)PW * 2 : (long)PW * 2;
    const long lstep = dir ? -(long)384 * 2 : (long)384 * 2;
    const unsigned off_lf = (MODE == 0 ? (unsigned)(E_FF + dir * 512 + h * 128) * 2u : 0u) + loff;
    const unsigned off_q = (unsigned)(MODE == 0 ? E_HQ + h * 128 : O_Q + h * 96) * 2u + loff;
    const unsigned off_k = (unsigned)(O_K + h * 96) * 2u + loff;
    auto issue_loads = [&](int n) {
      const long base = chunk_base(n);
      {
        const char* prow = (const char*)(p.P + lrow(base, w * 16) * PW);
        const char* plf = (const char*)(p.LF + ((long)dir * NR + lrow(base, w * 16)) * 384 + h * 96);
#pragma unroll
        for (int i = 0; i < 16; ++i) {
          if (MODE == 0) {
            rlf[i] = *reinterpret_cast<const unsigned*>(prow + off_lf);
          } else {
            rlf[i] = *reinterpret_cast<const unsigned*>(plf + loff);
            rk[i] = *reinterpret_cast<const unsigned*>(prow + off_k);
            plf += lstep;
          }
          rq[i] = *reinterpret_cast<const unsigned*>(prow + off_q);
          prow += rstep;
        }
      }
#pragma unroll
      for (int r = 0; r < (NVI + 255) / 256; ++r) {
        const int it = min(tid + r * 256, NVI - 1);
        const int l = it / (DVS / 8), e8 = (it % (DVS / 8)) * 8;
        rv[r] = *reinterpret_cast<const uint4*>(p.P + lrow(base, l) * PW + vcol + e8);
      }
    };
    issue_loads(0);
    for (int n = 0; n < NCH; ++n) {
      const int par = n & 1;
      float* totp = tot + par * 4 * DK;
      float* lfp = lf32 + par * DK;
      const long base = chunk_base(n);
      if (cact) {
        float r0 = 0.f, r1 = 0.f;
#pragma unroll
        for (int i = 0; i < 16; ++i) { r0 += bf_lo(rlf[i]); r1 += bf_hi(rlf[i]); }
        totp[w * DK + c0] = r0; totp[w * DK + c0 + 1] = r1;
        if (w == 2) { lfp[c0] = bf_lo(rlf[0]); lfp[c0 + 1] = bf_hi(rlf[0]); }
      }
      __syncthreads();
#pragma unroll
      for (int r = 0; r < (NVI + 255) / 256; ++r) {
        const int it = tid + r * 256;
        if (it < NVI) {
          const int l = it / (DVS / 8), e8 = (it % (DVS / 8)) * 8;
          const unsigned vw[4] = {rv[r].x, rv[r].y, rv[r].z, rv[r].w};
#pragma unroll
          for (int e = 0; e < 4; ++e) {
            VT[(e8 + 2 * e) * LS + l] = (act_t)(vw[e] & 0xffffu);
            VT[(e8 + 2 * e + 1) * LS + l] = (act_t)(vw[e] >> 16);
          }
        }
      }
      if (cact) {
        float of0 = 0.f, of1 = 0.f;
#pragma unroll
        for (int sgi = 0; sgi < 3; ++sgi)
          if (sgi < w) { of0 += totp[sgi * DK + c0]; of1 += totp[sgi * DK + c0 + 1]; }
        const float ref0 = totp[c0] + totp[DK + c0] + lfp[c0];
        const float ref1 = totp[c0 + 1] + totp[DK + c0 + 1] + lfp[c0 + 1];
        unsigned kt0[8], kt1[8];
        float run0 = of0 - ref0, run1 = of1 - ref1;
#pragma unroll
        for (int i = 0; i < 16; i += 2) {
          float ka0[2], ka1[2];
#pragma unroll
          for (int ii = 0; ii < 2; ++ii) {
            const int i2 = i + ii;
            run0 += bf_lo(rlf[i2]); run1 += bf_hi(rlf[i2]);
            const float b0 = run0, b1 = run1;
            const float e0 = __expf(b0), e1 = __expf(b1), f0 = __expf(-b0), f1 = __expf(-b1);
            float k0, k1;
            if (MODE == 0) { k0 = 1.0f - __expf(bf_lo(rlf[i2])); k1 = 1.0f - __expf(bf_hi(rlf[i2])); }
            else { k0 = bf_lo(rk[i2]); k1 = bf_hi(rk[i2]); }
            ka0[ii] = k0 * f0; ka1[ii] = k1 * f1;
            const int l = w * 16 + i2;
            *reinterpret_cast<unsigned*>(Qa + l * QS + c0) = pack2(bf_lo(rq[i2]) * e0, bf_hi(rq[i2]) * e1);
            *reinterpret_cast<unsigned*>(Ka + l * QS + c0) = pack2(ka0[ii], ka1[ii]);
          }
          kt0[i >> 1] = pack2(ka0[0], ka0[1]);
          kt1[i >> 1] = pack2(ka1[0], ka1[1]);
        }
        uint4* d0 = reinterpret_cast<uint4*>(KaT + c0 * LS + w * 16);
        d0[0] = make_uint4(kt0[0], kt0[1], kt0[2], kt0[3]); d0[1] = make_uint4(kt0[4], kt0[5], kt0[6], kt0[7]);
        uint4* d1 = reinterpret_cast<uint4*>(KaT + (c0 + 1) * LS + w * 16);
        d1[0] = make_uint4(kt1[0], kt1[1], kt1[2], kt1[3]); d1[1] = make_uint4(kt1[4], kt1[5], kt1[6], kt1[7]);
      }
      issue_loads(min(n + 1, NCH - 1));
      float egv[2], egrv[2];
#pragma unroll
      for (int di = 0; di < 2; ++di) {
        const int dt = w + 4 * di;
        if (dt < NDT) {
          const int d = dt * 16 + fr;
          const float refd = totp[d] + totp[DK + d] + lfp[d];
          const float gd = totp[d] + totp[DK + d] + totp[2 * DK + d] + totp[3 * DK + d];
          const float er = __expf(refd);
          egv[di] = __expf(gd); egrv[di] = __expf(gd - refd);
#pragma unroll
          for (int et = 0; et < NET; ++et)
#pragma unroll
            for (int j = 0; j < 4; ++j) stA(ST + (et * 16 + 4 * g + j) * SS + d, S[et][di][j] * er);
        }
      }
      __syncthreads();
      bf16x8 qfr[NKS];
#pragma unroll
      for (int ks = 0; ks < NKS; ++ks) qfr[ks] = *reinterpret_cast<const bf16x8*>(Qa + (w * 16 + fr) * QS + ks * 32 + g * 8);
      bf16x8 pfr[2];
#pragma unroll
      for (int kb = 0; kb < 2; ++kb) {
        f32x4 at2[2];
#pragma unroll
        for (int h2 = 0; h2 < 2; ++h2) {
          const int mt = 2 * kb + h2;
          at2[h2] = f32x4{0.f, 0.f, 0.f, 0.f};
          if (mt <= w) {
#pragma unroll
            for (int ks = 0; ks < NKS; ++ks) {
              const bf16x8 kaf = *reinterpret_cast<const bf16x8*>(Ka + (mt * 16 + fr) * QS + ks * 32 + g * 8);
              at2[h2] = __builtin_amdgcn_mfma_f32_16x16x32_bf16(kaf, qfr[ks], at2[h2], 0, 0, 0);
            }
            if (mt == w) {
#pragma unroll
              for (int j = 0; j < 4; ++j)
                if (4 * g + j > fr) at2[h2][j] = 0.f;
            }
          }
        }
        union { unsigned u[4]; bf16x8 v; } cv;
        cv.u[0] = pack2_mfma(at2[0][0], at2[0][1]); cv.u[1] = pack2_mfma(at2[0][2], at2[0][3]);
        cv.u[2] = pack2_mfma(at2[1][0], at2[1][1]); cv.u[3] = pack2_mfma(at2[1][2], at2[1][3]);
        pfr[kb] = cv.v;
      }
      const long orow = lrow(base, w * 16 + fr);
#pragma unroll
      for (int et = 0; et < NET; ++et) {
        f32x4 o = f32x4{0.f, 0.f, 0.f, 0.f};
#pragma unroll
        for (int kb = 0; kb < 2; ++kb) {
          if (2 * kb <= w) {
            union { uint2 h2[2]; bf16x8 v; } vf;
            vf.h2[0] = *reinterpret_cast<const uint2*>(VT + (et * 16 + fr) * LS + kb * 32 + 4 * g);
            vf.h2[1] = *reinterpret_cast<const uint2*>(VT + (et * 16 + fr) * LS + kb * 32 + 16 + 4 * g);
            o = __builtin_amdgcn_mfma_f32_16x16x32_bf16(vf.v, pfr[kb], o, 0, 0, 0);
          }
        }
#pragma unroll
        for (int ks = 0; ks < NKS; ++ks) {
          const bf16x8 sf = *reinterpret_cast<const bf16x8*>(ST + (et * 16 + fr) * SS + ks * 32 + g * 8);
          o = __builtin_amdgcn_mfma_f32_16x16x32_bf16(sf, qfr[ks], o, 0, 0, 0);
        }
        const float osc = MODE == 0 ? 1.0f : 0.10206207261596575f;
        *reinterpret_cast<uint2*>(OD + orow * 768 + ocol + et * 16 + 4 * g) =
            make_uint2(pack2(o[0] * osc, o[1] * osc), pack2(o[2] * osc, o[3] * osc));
      }
#pragma unroll
      for (int di = 0; di < 2; ++di) {
        const int dt = w + 4 * di;
        if (dt < NDT) {
#pragma unroll
          for (int et = 0; et < NET; ++et) {
            f32x4 r = f32x4{0.f, 0.f, 0.f, 0.f};
#pragma unroll
            for (int k2 = 0; k2 < 2; ++k2) {
              const bf16x8 vf = *reinterpret_cast<const bf16x8*>(VT + (et * 16 + fr) * LS + k2 * 32 + g * 8);
              const bf16x8 kf = *reinterpret_cast<const bf16x8*>(KaT + (dt * 16 + fr) * LS + k2 * 32 + g * 8);
              r = __builtin_amdgcn_mfma_f32_16x16x32_bf16(vf, kf, r, 0, 0, 0);
            }
#pragma unroll
            for (int j = 0; j < 4; ++j) S[et][di][j] = egv[di] * S[et][di][j] + egrv[di] * r[j];
          }
        }
      }
    }
    __syncthreads();
  }
}

struct GemmJob {
  const act_t* A; const act_t* Bt; act_t* C;
  long sA, sB, sC;
  int nbatch, Mtiles, Ntiles, K, ldc, Nvalid, mode;
  float scale;
  int fp8;
};
__device__ __forceinline__ void phase_gemm(const Params& p, const GemmJob& g, unsigned char* smem, int blk = blockIdx.x, int nblk = gridDim.x) {
  const int per_b = g.Mtiles * g.Ntiles;
  const int ntiles = per_b * g.nbatch;
  auto tvalid = [&](int t) -> bool {
    const int tt = t % per_b;
    const int tm = tt / g.Ntiles, tn = tt % g.Ntiles;
    return !(g.mode == 1 && tm < NC / 128 && tn * 128 >= O_FA);
  };
  auto tnext = [&](int t) -> int { t += nblk; while (t < ntiles && !tvalid(t)) t += nblk; return t; };
  int par = 0;
  bool primed = false;
  int tile0 = blk;
  if (tile0 < ntiles && !tvalid(tile0)) tile0 = tnext(tile0);
  for (int tile = tile0; tile < ntiles;) {
    const int ntile = tnext(tile);
    const int b = tile / per_b, tt = tile % per_b;
    const int tm = tt / g.Ntiles, tn = tt % g.Ntiles;
    const int tt2 = (ntile < ntiles ? ntile : tile) % per_b;
    const int tm2 = tt2 / g.Ntiles, tn2 = tt2 % g.Ntiles;
    const int K = g.K, ldc = g.ldc;
    const act_t* Ab = g.A + b * g.sA + (long)tm * 128 * K;
    act_t* Cb = g.C + b * g.sC + (long)tm * 128 * ldc + tn * 128;
    const int nlim = g.Nvalid - tn * 128;
    const float scale = g.scale;
    const int mode = g.mode;
    if (mode == 1) {
      auto epi1 = [&](f32x4 (&acc)[4][4], int wr, int wc, int fr, int fq) {
                  if (g.fp8) {
#pragma unroll
                    for (int m = 0; m < 4; ++m)
#pragma unroll
                      for (int n = 0; n < 4; ++n) acc[m][n] = acc[m][n] * scale;
                  }
#pragma unroll
                  for (int m = 0; m < 4; ++m)
#pragma unroll
                    for (int n = 0; n < 4; ++n) {
                      const int col = wc * 64 + n * 16 + fr;
                      if (col < nlim) {
#pragma unroll
                        for (int j = 0; j < 4; ++j) {
                          const int row = wr * 64 + m * 16 + fq * 4 + j;
                          stA(Cb + (long)row * ldc + col, acc[m][n][j]);
                        }
                      } else {
                        const int gc = tn * 128 + col;
                        if (gc < O_END && tm >= NC / 128) {
                          const int lr = (tm - NC / 128) * 128 + wr * 64 + m * 16 + fq * 4;
                          const int bb = lr / T, t = lr % T;
                          const int cq = gc < O_FB ? gc - O_FA : gc - O_FB;
                          act_t* dst = p.FT + ((long)bb * 256 + cq) * (2 * T) + (gc < O_FB ? 0 : T) + t;
                          *reinterpret_cast<uint2*>(dst) = make_uint2(pack2(acc[m][n][0], acc[m][n][1]), pack2(acc[m][n][2], acc[m][n][3]));
                        }
                      }
                    }
                };
      if (g.fp8) {
        const fp8_t* A8 = (const fp8_t*)g.A + (long)tm * 128 * K;
        gemm_tile8p<false>(A8, (const fp8_t*)g.Bt + (long)tn * 128 * K, ntile < ntiles, (const fp8_t*)g.A + (long)tm2 * 128 * K,
                           (const fp8_t*)g.Bt + (long)tn2 * 128 * K, par, primed, K, smem, epi1);
      } else {
        gemm_tile<false>([&](int r) { return Ab + (long)r * K; }, g.Bt + b * g.sB + (long)tn * 128 * K, K, smem, epi1);
      }
    } else {
      auto epi2 = [&](f32x4 (&acc)[4][4], int wr, int wc, int fr, int fq) {
                  const float oscale = g.fp8 ? 1.0f : scale;
                  if (g.fp8) {
#pragma unroll
                    for (int m = 0; m < 4; ++m)
#pragma unroll
                      for (int n = 0; n < 4; ++n) acc[m][n] = acc[m][n] * scale;
                  }
                  if (mode == 2) {
                    const int cb = tn * 128 + wc * 64;
                    if (cb < E_AV && tm >= NC / 128) {
                      const float4* rt = reinterpret_cast<const float4*>(p.ropetab);
#pragma unroll
                      for (int m = 0; m < 4; ++m) {
                        const int t = ((tm - NC / 128) * 128 + wr * 64 + m * 16 + fr) % T;
                        const float4 r01 = rt[(t / GRID_W) * 8 + fq * 2], r23 = rt[(t / GRID_W) * 8 + fq * 2 + 1];
                        const float4 c01 = rt[(t % GRID_W) * 8 + fq * 2], c23 = rt[(t % GRID_W) * 8 + fq * 2 + 1];
                        const float rc[4] = {r01.x, r01.z, r23.x, r23.z}, rs_[4] = {r01.y, r01.w, r23.y, r23.w};
                        const float cc[4] = {c01.x, c01.z, c23.x, c23.z}, cs_[4] = {c01.y, c01.w, c23.y, c23.w};
#pragma unroll
                        for (int j = 0; j < 4; ++j) {
                          const float a1 = acc[m][0][j], a2 = acc[m][1][j], b1 = acc[m][2][j], b2 = acc[m][3][j];
                          acc[m][0][j] = a1 * rc[j] - a2 * rs_[j]; acc[m][1][j] = a1 * rs_[j] + a2 * rc[j];
                          acc[m][2][j] = b1 * cc[j] - b2 * cs_[j]; acc[m][3][j] = b1 * cs_[j] + b2 * cc[j];
                        }
                      }
                    } else if (cb >= E_FF && cb < E_HQ) {
#pragma unroll
                      for (int n = 0; n < 4; ++n) {
                        const float4 lb4 = *reinterpret_cast<const float4*>(p.lbt + cb - E_FF + n * 16 + fq * 4);
                        const float lb[4] = {lb4.x, lb4.y, lb4.z, lb4.w};
#pragma unroll
                        for (int m = 0; m < 4; ++m)
#pragma unroll
                          for (int j = 0; j < 4; ++j)
                            acc[m][n][j] = __logf(lb[j] + (1.0f - lb[j]) / (1.0f + __expf(-acc[m][n][j])));
                      }
                    }
                  }
#pragma unroll
                  for (int m = 0; m < 4; ++m) {
                    const int row = wr * 64 + m * 16 + fr;
#pragma unroll
                    for (int n = 0; n < 4; ++n) {
                      const int col = wc * 64 + n * 16 + fq * 4;
                      if (col < nlim)
                        *reinterpret_cast<uint2*>(Cb + (long)row * ldc + col) =
                            make_uint2(pack2(acc[m][n][0] * oscale, acc[m][n][1] * oscale), pack2(acc[m][n][2] * oscale, acc[m][n][3] * oscale));
                    }
                  }
                };
      if (g.fp8) {
        const fp8_t* A8 = (const fp8_t*)g.A + (long)tm * 128 * K;
        gemm_tile8p<true>(A8, (const fp8_t*)g.Bt + (long)tn * 128 * K, ntile < ntiles, (const fp8_t*)g.A + (long)tm2 * 128 * K,
                          (const fp8_t*)g.Bt + (long)tn2 * 128 * K, par, primed, K, smem, epi2);
      } else {
        gemm_tile<true>([&](int r) { return Ab + (long)r * K; }, g.Bt + b * g.sB + (long)tn * 128 * K, K, smem, epi2);
      }
    }
    tile = ntile;
  }
}

template <class RowMap>
__device__ __forceinline__ void conv_tile_rm(const float* src, int lds_, int Nvalid, int k0, int n0, act_t* dst, int ldd, float* tile, RowMap rm) {
  const int tid = threadIdx.x;
  {
    const int r = tid >> 5, c4 = (tid & 31) * 4;
    float4 v[8];
#pragma unroll
    for (int rr = 0; rr < 8; ++rr) {
      v[rr] = make_float4(0.f, 0.f, 0.f, 0.f);
      if (n0 + c4 < Nvalid) v[rr] = *reinterpret_cast<const float4*>(src + (long)(k0 + r + rr * 8) * lds_ + n0 + c4);
    }
#pragma unroll
    for (int rr = 0; rr < 8; ++rr) {
      float* t = tile + (r + rr * 8) * 129 + c4;
      t[0] = v[rr].x; t[1] = v[rr].y; t[2] = v[rr].z; t[3] = v[rr].w;
    }
  }
  __syncthreads();
  {
    const int n = tid >> 1, ks = (tid & 1) * 32;
    if (n0 + n < Nvalid) {
      unsigned w[16];
#pragma unroll
      for (int i = 0; i < 16; ++i) w[i] = pack2(tile[(ks + 2 * i) * 129 + n], tile[(ks + 2 * i + 1) * 129 + n]);
      uint4* d = reinterpret_cast<uint4*>(dst + (long)rm(n) * ldd + k0 + ks);
      d[0] = make_uint4(w[0], w[1], w[2], w[3]);
      d[1] = make_uint4(w[4], w[5], w[6], w[7]);
      d[2] = make_uint4(w[8], w[9], w[10], w[11]);
      d[3] = make_uint4(w[12], w[13], w[14], w[15]);
    }
  }
  __syncthreads();
}

template <class RowMap>
__device__ __forceinline__ void conv_tile8_rm(const float* src, int lds_, int k0, int n0, fp8_t* dst, int ldd, float* tile, float scale, RowMap rm, int Nvalid = 1 << 30) {
  const int tid = threadIdx.x;
  {
    const int r = tid >> 5, c4 = (tid & 31) * 4;
    float4 v[8];
#pragma unroll
    for (int rr = 0; rr < 8; ++rr) {
      v[rr] = make_float4(0.f, 0.f, 0.f, 0.f);
      if (n0 + c4 < Nvalid) v[rr] = *reinterpret_cast<const float4*>(src + (long)(k0 + r + rr * 8) * lds_ + n0 + c4);
    }
#pragma unroll
    for (int rr = 0; rr < 8; ++rr) {
      float* t = tile + (r + rr * 8) * 129 + c4;
      t[0] = v[rr].x; t[1] = v[rr].y; t[2] = v[rr].z; t[3] = v[rr].w;
    }
  }
  __syncthreads();
  if ((threadIdx.x >> 1) + n0 < Nvalid) {
    const int n = tid >> 1, ks = (tid & 1) * 32;
    unsigned w[8];
#pragma unroll
    for (int i = 0; i < 8; ++i)
      w[i] = pack4_fp8(tile[(ks + 4 * i) * 129 + n] * scale, tile[(ks + 4 * i + 1) * 129 + n] * scale,
                       tile[(ks + 4 * i + 2) * 129 + n] * scale, tile[(ks + 4 * i + 3) * 129 + n] * scale);
    uint4* d = reinterpret_cast<uint4*>(dst + (long)rm(n) * ldd + k0 + ks);
    d[0] = make_uint4(w[0], w[1], w[2], w[3]);
    d[1] = make_uint4(w[4], w[5], w[6], w[7]);
  }
  __syncthreads();
}

__device__ __forceinline__ void conv_tile(const float* src, int lds_, int Nvalid, int k0, int n0, act_t* dst, int ldd, float* tile) {
  conv_tile_rm(src, lds_, Nvalid, k0, n0, dst, ldd, tile, [=](int n) { return n0 + n; });
}

struct ConvJob { const float* src; fp8_t* dst; int lds, ldd, k0, n0, rbase, ra, rb; };
__device__ __forceinline__ void phase_convert_experts(const Params& p, int l, unsigned char* smem, int blk, int nblk) {
  float* tile = (float*)smem;
  const int per_e = 192, total = NEXP * per_e;
  fp8_t* Wup = l == 0 ? p.W8up : p.W8up1;
  fp8_t* Wdn = l == 0 ? p.W8down : p.W8down1;
  const int tid = threadIdx.x;
  auto mkjob = [&](int job) -> ConvJob {
    const int e = job / per_e, j = job % per_e;
    ConvJob c;
    if (j < 128) {
      const int up = j >> 6, jj = j & 63;
      const int kt = jj >> 2, fp = jj & 3;
      c.src = (up ? p.w_eu : p.w_eg) + ((long)(l * NEXP + e) * D) * DFF;
      c.dst = Wup + (long)e * 1024 * D; c.lds = DFF; c.ldd = D; c.k0 = kt * 64; c.n0 = fp * 128;
      c.rbase = fp * 256 + up * 32; c.ra = 128; c.rb = 64;
    } else {
      const int jj = j - 128;
      const int kt = jj >> 3, nt = jj & 7;
      c.src = p.w_ed + ((long)(l * NEXP + e) * DFF) * D;
      c.dst = Wdn + (long)e * 1024 * DFF; c.lds = D; c.ldd = DFF; c.k0 = kt * 64; c.n0 = nt * 128;
      c.rbase = nt * 128; c.ra = 64; c.rb = 32;
    }
    return c;
  };
  float4 v[8];
  auto ld = [&](const ConvJob& c) {
    const int r = tid >> 5, c4 = (tid & 31) * 4;
#pragma unroll
    for (int rr = 0; rr < 8; ++rr) v[rr] = *reinterpret_cast<const float4*>(c.src + (long)(c.k0 + r + rr * 8) * c.lds + c.n0 + c4);
  };
  int job = blk;
  if (job >= total) return;
  ConvJob cur = mkjob(job);
  ld(cur);
  while (job < total) {
    {
      const int r = tid >> 5, c4 = (tid & 31) * 4;
#pragma unroll
      for (int rr = 0; rr < 8; ++rr) {
        float* t = tile + (r + rr * 8) * 129 + c4;
        t[0] = v[rr].x; t[1] = v[rr].y; t[2] = v[rr].z; t[3] = v[rr].w;
      }
    }
    __syncthreads();
    const int nxt = job + nblk;
    const ConvJob nj = mkjob(min(nxt, total - 1));
    ld(nj);
    {
      const int n = tid >> 1, ks = (tid & 1) * 32;
      unsigned w[8];
#pragma unroll
      for (int i = 0; i < 8; ++i)
        w[i] = pack4_fp8(tile[(ks + 4 * i) * 129 + n] * SW8, tile[(ks + 4 * i + 1) * 129 + n] * SW8,
                         tile[(ks + 4 * i + 2) * 129 + n] * SW8, tile[(ks + 4 * i + 3) * 129 + n] * SW8);
      const int row = cur.rbase + (n >> 6) * cur.ra + ((n >> 5) & 1) * cur.rb + (n & 31);
      uint4* d = reinterpret_cast<uint4*>(cur.dst + (long)row * cur.ldd + cur.k0 + ks);
      d[0] = make_uint4(w[0], w[1], w[2], w[3]);
      d[1] = make_uint4(w[4], w[5], w[6], w[7]);
    }
    __syncthreads();
    cur = nj;
    job = nxt;
  }
}

__device__ __forceinline__ void phase_moe(const Params& p, int l, bool down, unsigned char* smem) {
  const int* cntp = p.cnt + l * NEXP * 64;
  int total = 0;
  for (int e = 0; e < NEXP; ++e) total += ((cntp[e * 64] + 127) >> 7) * 8;
  for (int tile = blockIdx.x; tile < total; tile += gridDim.x) {
    int e = 0, tb = 0, rowoff = 0;
    for (; e < NEXP - 1; ++e) {
      const int c = cntp[e * 64];
      const int nt = ((c + 127) >> 7) * 8;
      if (tile < tb + nt) break;
      tb += nt; rowoff += c;
    }
    const int c = cntp[e * 64];
    const int lt = tile - tb, mt = lt >> 3, nt = lt & 7;
    const int rows_valid = min(128, c - mt * 128);
    const int* lst = p.list + (long)(l * NEXP + e) * NR + mt * 128;
    const long hrow0 = (long)rowoff + mt * 128;
    if (!down) {
      gemm_tile8<true>([&](int r) { return p.u8 + (long)(lst[min(r, rows_valid - 1)] >> 1) * D; },
                (l == 0 ? p.W8up : p.W8up1) + ((long)e * 1024 + nt * 128) * D, D, smem,
                [&](f32x4 (&acc)[4][4], int wr, int wc, int fr, int fq) {
                  constexpr float dq = 1.0f / (SU8 * SW8);
#pragma unroll
                  for (int m = 0; m < 4; ++m) {
                    const int row = wr * 64 + m * 16 + fr;
                    if (row < rows_valid) {
#pragma unroll
                      for (int n = 0; n < 2; ++n) {
                        float hv[4];
#pragma unroll
                        for (int j = 0; j < 4; ++j) {
                          const float g = acc[m][n][j] * dq, uu = acc[m][n + 2][j] * dq;
                          hv[j] = g / (1.0f + __expf(-g)) * uu * SH8;
                        }
                        *reinterpret_cast<unsigned*>(p.H8 + (hrow0 + row) * DFF + nt * 64 + wc * 32 + n * 16 + fq * 4) =
                            pack4_fp8(hv[0], hv[1], hv[2], hv[3]);
                      }
                    }
                  }
                });
    } else {
      const fp8_t* Ab = p.H8 + hrow0 * DFF;
      gemm_tile8<true>([&](int r) { return Ab + (long)r * DFF; }, (l == 0 ? p.W8down : p.W8down1) + ((long)e * 1024 + nt * 128) * DFF, DFF, smem,
                [&](f32x4 (&acc)[4][4], int wr, int wc, int fr, int fq) {
                  constexpr float dq = 1.0f / (SH8 * SW8);
#pragma unroll
                  for (int m = 0; m < 4; ++m) {
                    const int row = wr * 64 + m * 16 + fr;
                    if (row < rows_valid) {
                      const int ts = lst[row];
                      const float w = p.ew[ts] * dq;
#pragma unroll
                      for (int n = 0; n < 4; ++n)
                        *reinterpret_cast<uint2*>(p.Y + (long)ts * D + nt * 128 + wc * 64 + n * 16 + fq * 4) =
                            make_uint2(pack2(acc[m][n][0] * w, acc[m][n][1] * w), pack2(acc[m][n][2] * w, acc[m][n][3] * w));
                    }
                  }
                });
    }
  }
}

__device__ __forceinline__ void phase_convert_dense(const Params& p, unsigned char* smem) {
  float* tile = (float*)smem;
  const int JM = MOD_ITEMS, J0 = JM + 16 * 26, J1 = J0 + 128, J2 = J1 + 16 * 19, J3 = J2 + 128;
  for (int job = blockIdx.x; job < J3; job += gridDim.x) {
    if (job < JM) { mod_item(p, job, smem); continue; }
    if (job < J0) { int j = job - JM; const int n0 = (j % 26) * 128; conv_tile8_rm(p.w_in_even, IN_EVEN, (j / 26) * 64, n0, p.W8in_even, D, tile, SW8, [=](int n) { return n0 + n; }); }
    else if (job < J1) { int j = job - J0; conv_tile(p.w_out_even, D, D, (j / 8) * 64, (j % 8) * 128, p.Wt_out_even, D, tile); }
    else if (job < J2) { int j = job - J1; const int n0 = (j % 19) * 128; conv_tile8_rm(p.w_in_odd, IN_ODD, (j / 19) * 64, n0, p.W8in_odd, D, tile, SW8, [=](int n) { return n0 + n; }, O_FA); }
    else { int j = job - J2; conv_tile(p.w_out_odd, D, D, (j / 8) * 64, (j % 8) * 128, p.Wt_out_odd, D, tile); }
  }
}

__device__ __forceinline__ void phase_fold_z(const Params& p, long gtid, long gstride, float* tab) {
  if (threadIdx.x < 64) {
    float sn, cs;
    sincospif((float)threadIdx.x * (1.0f / 32.0f), &sn, &cs);
    tab[threadIdx.x] = cs; tab[64 + threadIdx.x] = -sn;
  }
  __syncthreads();
  for (long i = gtid; i < (long)512 * D; i += gstride) {
    const int k = (int)(i % D), np = (int)(i / D);
    const int part = np >> 8, col = np & 255, g = col >> 6, cp = col & 63;
    const float* wz = p.w_in_odd + (long)k * IN_ODD + O_Z + g * 64;
    float s = 0.f;
    const float* tb = tab + part * 64;
    float4 wv[16];
#pragma unroll
    for (int q = 0; q < 16; ++q) wv[q] = reinterpret_cast<const float4*>(wz)[q];
#pragma unroll
    for (int q = 0; q < 16; ++q) {
      s += wv[q].x * tb[((4 * q) * cp) & 63] + wv[q].y * tb[((4 * q + 1) * cp) & 63] + wv[q].z * tb[((4 * q + 2) * cp) & 63] +
           wv[q].w * tb[((4 * q + 3) * cp) & 63];
    }
    const unsigned q = pack4_fp8(s * SW8, 0.f, 0.f, 0.f);
    p.W8in_odd[(long)(O_FA + np) * D + k] = (unsigned char)(q & 0xffu);
  }
  for (long i = gtid; i < (long)(IN_ODD_PAD - O_END) * D; i += gstride) p.W8in_odd[(long)O_END * D + i] = 0;
}

__device__ __forceinline__ void phase_cmat(const Params& p, long gtid, long gstride) {
  for (long i = gtid; i < (long)T * T; i += gstride) {
    const int t = (int)(i % T), tp = (int)(i / T);
    float sn, cs;
    sincospif((float)((t * tp) & (T - 1)) * (2.0f / T), &sn, &cs);
    stA(p.Cmat + (long)tp * 2 * T + t, cs);
    stA(p.Cmat + (long)tp * 2 * T + T + t, sn);
  }
}

__device__ __forceinline__ void row_stats(const float4 (&v)[4], float& mu, float& rs) {
  float s = 0.f;
#pragma unroll
  for (int i = 0; i < 4; ++i) s += v[i].x + v[i].y + v[i].z + v[i].w;
  mu = wave_sum(s) * (1.0f / D);
  float q = 0.f;
#pragma unroll
  for (int i = 0; i < 4; ++i) {
    float a = v[i].x - mu, b = v[i].y - mu, c = v[i].z - mu, d = v[i].w - mu;
    q += a * a + b * b + c * c + d * d;
  }
  rs = 1.0f / sqrtf(wave_sum(q) * (1.0f / D) + LN_EPS);
}

__device__ __forceinline__ void phase_lnmod_first(const Params& p) {
  const int lane = threadIdx.x & 63;
  const int nw = (int)gridDim.x * 4, wi = (int)blockIdx.x * 4 + (int)(threadIdx.x >> 6);
  const int rpw = (NR + nw - 1) / nw;
  const long r0 = (long)wi * rpw, r1 = min((long)NR, r0 + rpw);
  float4 shv[4], scv[4];
  int cur_bb = -2;
  float4 hv[4];
  auto load_row = [&](long row) {
    const float4* h = reinterpret_cast<const float4*>(hrow_in(p, row));
#pragma unroll
    for (int i = 0; i < 4; ++i) hv[i] = h[i * 64 + lane];
  };
  if (r0 < r1) load_row(r0);
  for (long row = r0; row < r1; ++row) {
    const int bb = row < NC ? NB : (int)((row - NC) / T);
    if (bb != cur_bb) {
      cur_bb = bb;
      const float* md = p.mod + (long)bb * 6 * D;
#pragma unroll
      for (int i = 0; i < 4; ++i) {
        shv[i] = reinterpret_cast<const float4*>(md)[i * 64 + lane];
        scv[i] = reinterpret_cast<const float4*>(md + D)[i * 64 + lane];
      }
    }
    float4 v[4];
#pragma unroll
    for (int i = 0; i < 4; ++i) v[i] = hv[i];
    load_row(min(row + 1, r1 - 1));
    float mu, rs;
    row_stats(v, mu, rs);
#pragma unroll
    for (int i = 0; i < 4; ++i) {
      const float a = (v[i].x - mu) * rs * (1.f + scv[i].x) + shv[i].x, b = (v[i].y - mu) * rs * (1.f + scv[i].y) + shv[i].y;
      const float c = (v[i].z - mu) * rs * (1.f + scv[i].z) + shv[i].z, d = (v[i].w - mu) * rs * (1.f + scv[i].w) + shv[i].w;
      reinterpret_cast<unsigned*>(p.u8 + row * D)[i * 64 + lane] = pack4_fp8(a * SU8, b * SU8, c * SU8, d * SU8);
    }
  }
}

__device__ __forceinline__ act_t* hrow16(const Params& p, long row) {
  return row < NC ? reinterpret_cast<act_t*>(p.hc) + row * D
                  : reinterpret_cast<act_t*>(reinterpret_cast<char*>(p.out) + (row - NC) * (long)(4 * D) + 2 * D);
}
template <int R_UNUSED>
__device__ __forceinline__ void phase_resid_ln(const Params& p, int l, int sub, long row_lo, long row_hi, unsigned char* smem) {
  const int lane = threadIdx.x & 63;
  int* cntL = (int*)smem;
  int* nent = cntL + 16;
  int* entL = cntL + 32;
  float* wT = (float*)(smem + 4096);
  if (sub == 0) {
    if (threadIdx.x < 32) cntL[threadIdx.x] = 0;
    {
      float4 wr4[16];
#pragma unroll
      for (int j = 0; j < 4; ++j)
#pragma unroll
        for (int q = 0; q < 4; ++q) wr4[j * 4 + q] = reinterpret_cast<const float4*>(p.w_router + (long)(threadIdx.x + 256 * j) * NEXP)[q];
#pragma unroll
      for (int j = 0; j < 4; ++j)
#pragma unroll
        for (int q = 0; q < 4; ++q) {
          const int k = threadIdx.x + 256 * j;
          wT[(q * 4 + 0) * D + k] = wr4[j * 4 + q].x; wT[(q * 4 + 1) * D + k] = wr4[j * 4 + q].y;
          wT[(q * 4 + 2) * D + k] = wr4[j * 4 + q].z; wT[(q * 4 + 3) * D + k] = wr4[j * 4 + q].w;
        }
    }
    __syncthreads();
  }
  const bool last = (sub == 1 && l == 1);
  const int nw = (int)gridDim.x * 4, wi = (int)blockIdx.x * 4 + (int)(threadIdx.x >> 6);
  const int rpw = ((int)(row_hi - row_lo) + nw - 1) / nw;
  const long r0 = row_lo + (long)wi * rpw, r1 = min(row_hi, r0 + rpw);
  const float4* lgp = reinterpret_cast<const float4*>(p.ln_g + (l * 2 + sub) * D);
  const float4* lbp = reinterpret_cast<const float4*>(p.ln_b + (l * 2 + sub) * D);
  float4 lgv[4], lbv[4];
  if (R_UNUSED != 1) {
#pragma unroll
    for (int i = 0; i < 4; ++i) { lgv[i] = lgp[i * 64 + lane]; lbv[i] = lbp[i * 64 + lane]; }
  }
  float4 gv[4], shv[4], scv[4];
  int cur_bb = -2;
  const bool first = (l == 0 && sub == 0);
  float4 hv[4];
  uint2 hb[4];
  uint2 mv[4], m2v[4];
  auto load_row = [&](long row) {
    const uint2* m = reinterpret_cast<const uint2*>(sub == 0 ? p.M + row * D : p.Y + row * 2 * D);
    if (first) {
      const float4* hin = reinterpret_cast<const float4*>(hrow_in(p, row));
#pragma unroll
      for (int i = 0; i < 4; ++i) hv[i] = hin[i * 64 + lane];
    } else {
      const uint2* hin = reinterpret_cast<const uint2*>(hrow16(p, row));
#pragma unroll
      for (int i = 0; i < 4; ++i) hb[i] = hin[i * 64 + lane];
    }
#pragma unroll
    for (int i = 0; i < 4; ++i) {
      mv[i] = m[i * 64 + lane];
      if (sub == 1) m2v[i] = m[256 + i * 64 + lane];
    }
  };
  if (r0 < r1) load_row(r0);
  for (long row = r0; row < r1; ++row) {
    const int bb = row < NC ? NB : (int)((row - NC) / T);
    if (bb != cur_bb) {
      cur_bb = bb;
      const float* md = p.mod + ((long)l * (NB + 1) + bb) * 6 * D;
      const float* md2 = (sub == 0) ? md + 3 * D : p.mod + ((long)(NB + 1) + bb) * 6 * D;
#pragma unroll
      for (int i = 0; i < 4; ++i) {
        gv[i] = reinterpret_cast<const float4*>(md + (sub == 0 ? 2 : 5) * D)[i * 64 + lane];
        shv[i] = reinterpret_cast<const float4*>(md2)[i * 64 + lane];
        scv[i] = reinterpret_cast<const float4*>(md2 + D)[i * 64 + lane];
      }
    }
    float4 v[4];
#pragma unroll
    for (int i = 0; i < 4; ++i) {
      float m0 = bf_lo(mv[i].x), m1 = bf_hi(mv[i].x), m2_ = bf_lo(mv[i].y), m3 = bf_hi(mv[i].y);
      if (sub == 1) { m0 += bf_lo(m2v[i].x); m1 += bf_hi(m2v[i].x); m2_ += bf_lo(m2v[i].y); m3 += bf_hi(m2v[i].y); }
      const float h0 = first ? hv[i].x : bf_lo(hb[i].x), h1 = first ? hv[i].y : bf_hi(hb[i].x);
      const float h2 = first ? hv[i].z : bf_lo(hb[i].y), h3 = first ? hv[i].w : bf_hi(hb[i].y);
      v[i].x = ALPHA * h0 + gv[i].x * m0;
      v[i].y = ALPHA * h1 + gv[i].y * m1;
      v[i].z = ALPHA * h2 + gv[i].z * m2_;
      v[i].w = ALPHA * h3 + gv[i].w * m3;
    }
    load_row(min(row + 1, r1 - 1));
    if (R_UNUSED == 1) {
#pragma unroll
      for (int i = 0; i < 4; ++i) { lgv[i] = lgp[i * 64 + lane]; lbv[i] = lbp[i * 64 + lane]; }
    }
    float mu, rs;
    row_stats(v, mu, rs);
#pragma unroll
    for (int i = 0; i < 4; ++i) {
      v[i].x = (v[i].x - mu) * rs * lgv[i].x + lbv[i].x;
      v[i].y = (v[i].y - mu) * rs * lgv[i].y + lbv[i].y;
      v[i].z = (v[i].z - mu) * rs * lgv[i].z + lbv[i].z;
      v[i].w = (v[i].w - mu) * rs * lgv[i].w + lbv[i].w;
    }
    if (last) {
      float4* hout = reinterpret_cast<float4*>(p.out + (row - NC) * D);
#pragma unroll
      for (int i = 0; i < 4; ++i) hout[i * 64 + lane] = v[i];
      continue;
    }
    uint2 hq[4];
#pragma unroll
    for (int i = 0; i < 4; ++i) {
      hq[i] = make_uint2(pack2(v[i].x, v[i].y), pack2(v[i].z, v[i].w));
      v[i].x = bf_lo(hq[i].x); v[i].y = bf_hi(hq[i].x); v[i].z = bf_lo(hq[i].y); v[i].w = bf_hi(hq[i].y);
    }
    row_stats(v, mu, rs);
    float lo[NEXP];
#pragma unroll
    for (int e = 0; e < NEXP; ++e) lo[e] = 0.f;
    uint2 up[4];
#pragma unroll
    for (int i = 0; i < 4; ++i) {
      float uv[4];
      uv[0] = (v[i].x - mu) * rs * (1.f + scv[i].x) + shv[i].x;
      uv[1] = (v[i].y - mu) * rs * (1.f + scv[i].y) + shv[i].y;
      uv[2] = (v[i].z - mu) * rs * (1.f + scv[i].z) + shv[i].z;
      uv[3] = (v[i].w - mu) * rs * (1.f + scv[i].w) + shv[i].w;
      up[i] = make_uint2(pack4_fp8(uv[0] * SU8, uv[1] * SU8, uv[2] * SU8, uv[3] * SU8), 0u);
      if (sub == 0) {
#pragma unroll
        for (int e = 0; e < NEXP; ++e) {
          const float4 w4 = *reinterpret_cast<const float4*>(wT + e * D + (i * 64 + lane) * 4);
          lo[e] += uv[0] * w4.x + uv[1] * w4.y + uv[2] * w4.z + uv[3] * w4.w;
          if ((e & 3) == 3) __builtin_amdgcn_sched_barrier(0);
        }
      }
    }
    int ge1 = 0, ge2 = 0;
    float w1 = 0.f, w2 = 0.f;
    if (sub == 0) {
      float mine = 0.f;
#pragma unroll
      for (int e = 0; e < NEXP; ++e) {
        const float rsum = row_sum16(lo[e]);
        mine = ((lane & 15) == e) ? rsum : mine;
      }
      mine += __shfl_xor(mine, 16);
      mine += __shfl_xor(mine, 32);
#pragma unroll
      for (int e = 0; e < NEXP; ++e) lo[e] = __int_as_float(__builtin_amdgcn_readlane(__float_as_int(mine), e));
      float mx = lo[0];
#pragma unroll
      for (int e = 1; e < NEXP; ++e) mx = fmaxf(mx, lo[e]);
      float sum = 0.f;
#pragma unroll
      for (int e = 0; e < NEXP; ++e) { lo[e] = __expf(lo[e] - mx); sum += lo[e]; }
      const float inv = 1.0f / sum;
      float bestg = -1e30f, gp1 = 0.f, gp2 = 0.f;
#pragma unroll
      for (int gq = 0; gq < 4; ++gq) {
        float s1 = -1e30f, s2 = -1e30f, p1 = 0.f, p2 = 0.f;
        int e1 = 0, e2 = 0;
#pragma unroll
        for (int j = 0; j < 4; ++j) {
          const int e = gq * 4 + j;
          const float pe = lo[e] * inv;
          const float se = pe + p.b_router[e];
          if (se > s1) { s2 = s1; p2 = p1; e2 = e1; s1 = se; p1 = pe; e1 = e; }
          else if (se > s2) { s2 = se; p2 = pe; e2 = e; }
        }
        const float gs = s1 + s2;
        if (gs > bestg) { bestg = gs; ge1 = e1; ge2 = e2; gp1 = p1; gp2 = p2; }
      }
      const float wsum = gp1 + gp2;
      w1 = gp1 / wsum; w2 = gp2 / wsum;
    }
    {
      uint2* hout = reinterpret_cast<uint2*>(hrow16(p, row));
#pragma unroll
      for (int i = 0; i < 4; ++i) hout[i * 64 + lane] = hq[i];
    }
#pragma unroll
    for (int i = 0; i < 4; ++i) reinterpret_cast<unsigned*>(p.u8 + row * D)[i * 64 + lane] = up[i].x;
    if (sub == 0 && lane == 0) {
      p.ew[row * 2 + 0] = w1; p.ew[row * 2 + 1] = w2;
      const int lp1 = atomicAdd(cntL + ge1, 1), lp2 = atomicAdd(cntL + ge2, 1);
      const int ei = atomicAdd(nent, 2);
      entL[2 * ei] = ((int)(row * 2) << 4) | ge1; entL[2 * ei + 1] = lp1;
      entL[2 * ei + 2] = ((int)(row * 2 + 1) << 4) | ge2; entL[2 * ei + 3] = lp2;
    }
  }
  if (sub == 0) {
    __syncthreads();
    if (threadIdx.x < NEXP) {
      const int c = cntL[threadIdx.x];
      cntL[threadIdx.x] = c ? atomicAdd(p.cnt + (l * NEXP + threadIdx.x) * 64, c) : 0;
    }
    __syncthreads();
    const int ne = *nent;
    for (int i = threadIdx.x; i < ne; i += 256) {
      const int key = entL[2 * i], lp = entL[2 * i + 1];
      const int e = key & 15;
      p.list[(long)(l * NEXP + e) * NR + cntL[e] + lp] = key >> 4;
    }
    __syncthreads();
  }
}

#define LOOP(n) for (long i = gtid; i < (long)(n); i += gstride)

#ifdef ONLY_PHASE
#define PH(n, ...) if (ONLY_PHASE == n) { __VA_ARGS__ }
#define GSYNC()
#else
#define PH(n, ...) { __VA_ARGS__ }
#define GSYNC() xcd_barrier(xb)
#endif

__global__ void __launch_bounds__(256, 2) mega_kernel(Params p) {
  cg::grid_group grid = cg::this_grid();
  __shared__ __attribute__((aligned(16))) unsigned char smem[SMEM_BYTES + 16];
  if (threadIdx.x == 0) *reinterpret_cast<uint4*>(smem + SMEM_BYTES) = make_uint4(0u, 0u, 0u, 0u);
  __syncthreads();
  XcdBarrier xb = xcd_barrier_post(p.bar, (volatile LAS unsigned*)(smem + SMEM_BYTES));
  const long gtid = (long)blockIdx.x * blockDim.x + threadIdx.x;
  const long gstride = (long)gridDim.x * blockDim.x;
  const int nsb = min(256, (int)gridDim.x / 2);
  PH(0,
    if (gtid < 2 * NEXP) p.cnt[gtid * 64] = 0;
    phase_convert_dense(p, smem);
    phase_fold_z(p, gtid, gstride, (float*)(smem + 65536));
    LOOP(1024) ph_tables(p, i);)
#ifndef ONLY_PHASE
  if (p.use_cg_sync) grid.sync();
#endif
  GSYNC();
  PH(1, phase_lnmod_first(p);)
  GSYNC();
  PH(2, phase_gemm(p, GemmJob{(const act_t*)p.u8, (const act_t*)p.W8in_even, p.P, 0, 0, 0, 1, NR / 128, IN_EVEN / 128, D, PW, IN_EVEN, 2, 1.0f / (SU8 * SW8), 1}, smem);)
  GSYNC();
  PH(3,
    if ((int)blockIdx.x < nsb) phase_scan<0>(p, smem, blockIdx.x, nsb);
    else phase_attn(p, smem, blockIdx.x - nsb, gridDim.x - nsb);)
  GSYNC();
  PH(4, phase_combine<0>(p);)
  GSYNC();
  PH(5,
    phase_gemm(p, GemmJob{p.u, p.Wt_out_even, p.M, 0, 0, 0, 1, NR / 128, D / 128, D, D, D, 0, 1.0f, 0}, smem);
    {
      const int rem = ((NR / 128) * (D / 128)) % (int)gridDim.x;
      if (rem > 0 && rem < (int)gridDim.x) { if ((int)blockIdx.x >= rem) phase_convert_experts(p, 0, smem, blockIdx.x - rem, gridDim.x - rem); }
      else phase_convert_experts(p, 0, smem, blockIdx.x, gridDim.x);
    })
  GSYNC();
  PH(6, phase_resid_ln<1>(p, 0, 0, 0, NR, smem);)
  GSYNC();
  PH(7, phase_moe(p, 0, false, smem);)
  GSYNC();
  PH(8, phase_moe(p, 0, true, smem);)
  GSYNC();
  PH(9, phase_resid_ln<2>(p, 0, 1, 0, NR, smem); phase_cmat(p, gtid, gstride);)
  GSYNC();
  PH(10, phase_gemm(p, GemmJob{(const act_t*)p.u8, (const act_t*)p.W8in_odd, p.P, 0, 0, 0, 1, NR / 128, IN_ODD_PAD / 128, D, PW, O_FA, 1, 1.0f / (SU8 * SW8), 1}, smem);)
  GSYNC();
  PH(11, phase_gla_decay(p);)
  GSYNC();
  PH(12,
    if ((int)blockIdx.x < nsb) phase_scan<1>(p, smem, blockIdx.x, nsb);
    else {
      phase_gemm(p, GemmJob{p.Cmat, p.FT, p.u + (long)NC * D + 768, 0, (long)256 * 2 * T, (long)T * D, NB, T / 128, 2, 2 * T, D,
                            256, 0, 0.00276213586400995f, 0}, smem, blockIdx.x - nsb, gridDim.x - nsb);
      phase_convert_experts(p, 1, smem, blockIdx.x - nsb, gridDim.x - nsb);
    })
  GSYNC();
  PH(13, phase_combine<1>(p);)
  GSYNC();
  PH(14,
    phase_gemm(p, GemmJob{p.u + (long)NC * D, p.Wt_out_odd, p.M + (long)NC * D, 0, 0, 0, 1, NT / 128, D / 128, D, D, D, 0, 1.0f, 0}, smem);)
  GSYNC();
  PH(15, phase_resid_ln<1>(p, 1, 0, NC, NR, smem);)
  GSYNC();
  PH(16, phase_moe(p, 1, false, smem);)
  GSYNC();
  PH(17, phase_moe(p, 1, true, smem);)
  GSYNC();
  PH(18, phase_resid_ln<2>(p, 1, 1, NC, NR, smem);)
}

static size_t carve(Params& p, char* ws) {
  size_t off = 0;
  auto take = [&](size_t bytes) { char* r = ws + off; off += (bytes + 255) & ~(size_t)255; return r; };
  p.mod = (float*)take(sizeof(float) * 2 * (NB + 1) * 6 * D);
  p.hc = (float*)take(sizeof(float) * (size_t)NC * D);
  p.costab = (float*)take(sizeof(float) * T);
  p.sintab = (float*)take(sizeof(float) * T);
  p.lbt = (float*)take(sizeof(float) * 1024);
  p.ropetab = (float*)take(sizeof(float) * 64 * 16 * 2);
  p.ew = (float*)take(sizeof(float) * (size_t)NR * 2);
  p.eidx = nullptr;
  p.u = (act_t*)take(sizeof(act_t) * (size_t)NR * D);
  p.P = (act_t*)take(sizeof(act_t) * (size_t)NR * PW);
  p.OF = (act_t*)take(sizeof(act_t) * (size_t)NR * 768);
  p.OB = (act_t*)take(sizeof(act_t) * (size_t)NR * 768);
  p.M = p.OF;
  p.Cmat = (act_t*)take(sizeof(act_t) * (size_t)T * 2 * T);
  p.FT = (act_t*)take(sizeof(act_t) * (size_t)NB * 256 * 2 * T);
  p.LF = (act_t*)take(sizeof(act_t) * (size_t)2 * NR * 384);
  p.W8up = (unsigned char*)p.Cmat;
  p.W8down = p.W8up + (size_t)NEXP * 1024 * D;
  p.W8up1 = (unsigned char*)take((size_t)NEXP * 1024 * (D + DFF));
  p.W8down1 = p.W8up1 + (size_t)NEXP * 1024 * D;
  p.u8 = (unsigned char*)take((size_t)NR * D);
  p.Y = p.P;
  p.H8 = (unsigned char*)(p.P + (size_t)2 * NR * D);
  p.bar = (unsigned*)take(sizeof(unsigned) * XCD_BAR_WORDS);
  p.cnt = (int*)take(sizeof(int) * 2 * NEXP * 64);
  p.list = (int*)take(sizeof(int) * (size_t)2 * NEXP * NR);
  p.Wt_in_even = nullptr;
  p.W8in_even = (unsigned char*)take((size_t)IN_EVEN * D);
  p.Wt_out_even = (act_t*)take(sizeof(act_t) * (size_t)D * D);
  p.Wt_in_odd = nullptr;
  p.W8in_odd = (unsigned char*)take((size_t)IN_ODD_PAD * D);
  p.Wt_out_odd = (act_t*)take(sizeof(act_t) * (size_t)D * D);
  return off;
}

static void fill_inputs(Params& p, void* const* d_in) {
  const float** f = (const float**)&p;
  for (int i = 0; i < 23; ++i) f[i] = (const float*)d_in[i];
}

extern "C" void kernel_launch(void* const* d_in, const int* in_sizes, int n_in, void* d_out, int out_size,
                              void* d_ws, size_t ws_size, hipStream_t stream) {
  static int grid_blocks = 0;
  if (!grid_blocks) {
    int dev = 0, cus = 0, per_cu = 0;
    (void)hipGetDevice(&dev);
    (void)hipDeviceGetAttribute(&cus, hipDeviceAttributeMultiprocessorCount, dev);
    (void)hipOccupancyMaxActiveBlocksPerMultiprocessor(&per_cu, mega_kernel, 256, 0);
    grid_blocks = cus * per_cu;
  }
  Params p{};
  fill_inputs(p, d_in);
  p.out = (float*)d_out;
  size_t need = carve(p, (char*)d_ws);
  if (need > ws_size) { fprintf(stderr, "workspace too small: need %zu have %zu\n", need, ws_size); return; }
  (void)hipMemsetAsync(p.bar, 0, sizeof(unsigned) * XCD_BAR_WORDS, stream);
  void* args[] = {&p};
  hipError_t e = hipLaunchCooperativeKernel((void*)mega_kernel, dim3(grid_blocks), dim3(256), args, 0, stream);
  if (e != hipSuccess) fprintf(stderr, "cooperative launch failed: %s (grid %d)\n", hipGetErrorString(e), grid_blocks);
}
#endif
```

```cpp
#ifndef HOST_TEST
#include <hip/hip_runtime.h>
#include <hip/hip_cooperative_groups.h>
#include <cstdio>
namespace cg = cooperative_groups;
#define DEV __device__ __forceinline__
#else
#include <cmath>
#include <cstdio>
#include <cstdlib>
#include <cstring>
#define DEV static inline
#endif

#ifndef T_BATCH
#define T_BATCH 8
#endif
#ifndef T_SEQ
#define T_SEQ 2048
#endif
#ifndef T_CTX
#define T_CTX 256
#endif

constexpr int D = 1024, NB = T_BATCH, T = T_SEQ, C = T_CTX;
constexpr int NC = NB * C, NT = NB * T, NR = NC + NT;
constexpr int GRID_W = 64;
constexpr int IN_EVEN = 3328, IN_ODD = 2592, PW = 3328;
constexpr int NEXP = 16, DFF = 512;
constexpr float ALPHA = 1.4142135623730951f;
constexpr float LN_EPS = 1e-5f;
constexpr int E_AQ = 0, E_AK = 512, E_AV = 640, E_FF = 768, E_HQ = 1792, E_HI = 2304, E_HG = 2816;
constexpr int O_Q = 0, O_K = 384, O_V = 768, O_RF = 1536, O_G = 1568, O_Z = 2336;

#ifdef HOST_TEST
typedef float act_t;
DEV float ldA(const act_t* p) { return *p; }
DEV void stA(act_t* p, float v) { *p = v; }
#else
typedef unsigned short act_t;
DEV float ldA(const act_t* p) { return __uint_as_float(((unsigned)*p) << 16); }
DEV void stA(act_t* p, float v) {
  unsigned u = __float_as_uint(v);
  u += 0x7fffu + ((u >> 16) & 1u);
  *p = (unsigned short)(u >> 16);
}
#endif

struct Params {
  const float *x, *c, *ctx, *c_ctx, *w_ada, *b_ada, *ln_g, *ln_b, *w_in_even, *attn_sink, *lb_logits, *hgrn_norm,
      *w_out_even, *w_in_odd, *gla_gate_w, *gla_gate_b, *gla_norm, *w_out_odd, *w_router, *b_router, *w_eg, *w_eu,
      *w_ed;
  float* out;
  float *mod, *hc, *costab, *sintab, *lbt, *ew, *ropetab;
  int* eidx;
  act_t *u, *P, *OF, *OB, *M, *LF;
  act_t *Wt_in_even, *Wt_out_even, *Wt_in_odd, *Wt_out_odd;
  act_t *Y, *Cmat, *FT;
  unsigned char *W8up, *W8down, *W8up1, *W8down1, *H8, *u8;
  unsigned char *W8in_even, *W8in_odd;
  unsigned char *W8out_even, *W8out_odd, *O8;
  int *cnt, *list;
  unsigned* bar;
  int use_cg_sync;
  int pad_;
};

DEV float sigmoidf_(float v) { return 1.0f / (1.0f + expf(-v)); }
DEV float siluf_(float v) { return v / (1.0f + expf(-v)); }

DEV const float* hrow_in(const Params& p, long row) {
  return row < NC ? p.ctx + row * D : p.x + (row - NC) * D;
}
DEV float* hrow(const Params& p, long row) { return row < NC ? p.hc + row * D : p.out + (row - NC) * D; }
DEV const float* modrow(const Params& p, int l, long row) {
  int bb = row < NC ? NB : (int)((row - NC) / T);
  return p.mod + ((long)l * (NB + 1) + bb) * 6 * D;
}

DEV void ph_mod(const Params& p, long i) {
  int j = (int)(i % (6 * D));
  int bb = (int)((i / (6 * D)) % (NB + 1));
  int l = (int)(i / ((long)6 * D * (NB + 1)));
  const float* cv = bb < NB ? p.c + (long)bb * D : p.c_ctx;
  const float* w = p.w_ada + (long)l * D * 6 * D + j;
  float s = p.b_ada[l * 6 * D + j];
  for (int k = 0; k < D; ++k) s += siluf_(cv[k]) * w[(long)k * 6 * D];
  p.mod[i] = s;
}

DEV void ph_tables(const Params& p, long i) {
  if (i < 1024) {
    int pos = (int)(i >> 4), idx = (int)(i & 15);
    float ang = (float)pos * powf(10000.0f, -(float)idx / 16.0f);
    p.ropetab[2 * i] = cosf(ang);
    p.ropetab[2 * i + 1] = sinf(ang);
  }
  if (i < 1024) {
    int dir = (int)(i / 512), col = (int)(i % 512);
    float l0 = p.lb_logits[(dir * 2 + 0) * 512 + col], l1 = p.lb_logits[(dir * 2 + 1) * 512 + col];
    p.lbt[i] = 1.0f / (1.0f + expf(l1 - l0));
  }
}

DEV void ln_mod_row(const float* h, const float* shift, const float* scale, act_t* u) {
  float mu = 0.f;
  for (int k = 0; k < D; ++k) mu += h[k];
  mu *= (1.0f / D);
  float var = 0.f;
  for (int k = 0; k < D; ++k) { float d = h[k] - mu; var += d * d; }
  var *= (1.0f / D);
  float rs = 1.0f / sqrtf(var + LN_EPS);
  for (int k = 0; k < D; ++k) stA(u + k, (h[k] - mu) * rs * (1.0f + scale[k]) + shift[k]);
}

DEV void ph_lnmod_first(const Params& p, long row) {
  const float* m = modrow(p, 0, row);
  ln_mod_row(hrow_in(p, row), m, m + D, p.u + row * D);
}

DEV void gemm_item_act(const act_t* A, const float* W, act_t* Cout, int K, int N, int ldc, long i) {
  int n4 = (int)(i % (N / 4));
  long row = i / (N / 4);
  const act_t* a = A + row * K;
  const float* w = W + n4 * 4;
  float s0 = 0, s1 = 0, s2 = 0, s3 = 0;
  for (int k = 0; k < K; ++k) {
    float av = ldA(a + k);
    const float* wr = w + (long)k * N;
    s0 += av * wr[0]; s1 += av * wr[1]; s2 += av * wr[2]; s3 += av * wr[3];
  }
  act_t* o = Cout + row * ldc + n4 * 4;
  stA(o, s0); stA(o + 1, s1); stA(o + 2, s2); stA(o + 3, s3);
}

DEV void ph_rope(const Params& p, long i) {
  int pr = (int)(i % 32);
  int hh = (int)((i / 32) % 10);
  long lr = i / 320;
  int t = (int)(lr % T);
  int col = hh < 8 ? E_AQ + hh * 64 : E_AK + (hh - 8) * 64;
  int idx = pr & 15;
  int pos = pr < 16 ? t / GRID_W : t % GRID_W;
  int d0 = pr < 16 ? idx : 32 + idx;
  float inv = powf(10000.0f, -(float)idx / 16.0f);
  float ang = (float)pos * inv;
  float cs = cosf(ang), sn = sinf(ang);
  act_t* base = p.P + (NC + lr) * PW + col;
  float x1 = ldA(base + d0), x2 = ldA(base + d0 + 16);
  stA(base + d0, x1 * cs - x2 * sn);
  stA(base + d0 + 16, x1 * sn + x2 * cs);
}

DEV void ph_attn(const Params& p, long i) {
  int h = (int)(i % 8);
  long row = i / 8;
  int kv = h / 4;
  bool lat = row >= NC;
  int b = lat ? (int)((row - NC) / T) : (int)(row / C);
  int t = lat ? (int)((row - NC) % T) : 0;
  float q[64], acc[64];
  const act_t* qp = p.P + row * PW + E_AQ + h * 64;
#pragma unroll
  for (int d = 0; d < 64; ++d) { q[d] = ldA(qp + d) * 0.125f; acc[d] = 0.f; }
  float m = p.attn_sink[h], l = 1.0f;
  int nkeys = C + (lat ? 257 : 0);
  for (int j = 0; j < nkeys; ++j) {
    long krow;
    if (j < C) krow = (long)b * C + j;
    else {
      int kp = t - 128 + (j - C);
      if (kp < 0 || kp >= T) continue;
      krow = NC + (long)b * T + kp;
    }
    const act_t* kptr = p.P + krow * PW + E_AK + kv * 64;
    const act_t* vptr = p.P + krow * PW + E_AV + kv * 64;
    float s = 0.f;
#pragma unroll
    for (int d = 0; d < 64; ++d) s += q[d] * ldA(kptr + d);
    float mn = fmaxf(m, s);
    float sc = expf(m - mn), pj = expf(s - mn);
    l = l * sc + pj;
#pragma unroll
    for (int d = 0; d < 64; ++d) acc[d] = acc[d] * sc + pj * ldA(vptr + d);
    m = mn;
  }
  float il = 1.0f / l;
  act_t* o = p.u + row * D + h * 64;
#pragma unroll
  for (int d = 0; d < 64; ++d) stA(o + d, acc[d] * il);
}

template <int MODE>
DEV void ph_scan(const Params& p, long i) {
  constexpr int DK = MODE == 0 ? 128 : 96;
  constexpr int DV = MODE == 0 ? 128 : 192;
  int e = (int)(i % DV);
  int dir = (int)((i / DV) % 2);
  int h = (int)((i / (2 * DV)) % 4);
  int b = (int)(i / (8 * DV));
  float S[DK];
#pragma unroll
  for (int d = 0; d < DK; ++d) S[d] = 0.f;
  act_t* OD = dir == 0 ? p.OF : p.OB;
  for (int step = 0; step < C + T; ++step) {
    long row;
    if (step < C) row = (long)b * C + (dir == 0 ? step : C - 1 - step);
    else { int tt = step - C; row = NC + (long)b * T + (dir == 0 ? tt : T - 1 - tt); }
    const act_t* pr = p.P + row * PW;
    float o = 0.f;
    if (MODE == 0) {
      float v = ldA(pr + E_HI + h * 128 + e);
      const act_t* zp = pr + E_FF + dir * 512 + h * 128;
      const act_t* qp = pr + E_HQ + h * 128;
      const float* lb = p.lbt + dir * 512 + h * 128;
#pragma unroll
      for (int d = 0; d < DK; ++d) {
        float f = lb[d] + (1.0f - lb[d]) * sigmoidf_(ldA(zp + d));
        S[d] = f * S[d] + (1.0f - f) * v;
        o += ldA(qp + d) * S[d];
      }
      stA(OD + row * 768 + h * 128 + e, o);
    } else {
      float v = ldA(pr + O_V + h * 192 + e);
      const act_t* kp = pr + O_K + h * 96;
      const act_t* qp = pr + O_Q + h * 96;
      const act_t* lf = p.LF + ((long)dir * NR + row) * 384 + h * 96;
#pragma unroll
      for (int d = 0; d < DK; ++d) {
        float f = expf(ldA(lf + d));
        S[d] = f * S[d] + ldA(kp + d) * v;
        o += ldA(qp + d) * S[d];
      }
      stA(OD + row * 768 + h * 192 + e, o * 0.10206207261596575f);
    }
  }
}

template <int MODE>
DEV void ph_combine(const Params& p, long i) {
  constexpr int DV = MODE == 0 ? 128 : 192;
  int h = (int)(i % 4);
  long row = (MODE == 0) ? i / 4 : NC + i / 4;
  const act_t* f = p.OF + row * 768 + h * DV;
  const act_t* bk = p.OB + row * 768 + h * DV;
  float ss = 0.f;
  for (int e = 0; e < DV; ++e) { float o = ldA(f + e) + ldA(bk + e); ss += o * o; }
  float r = 1.0f / sqrtf(ss / DV + LN_EPS);
  const float* gn = (MODE == 0 ? p.hgrn_norm : p.gla_norm) + h * DV;
  const act_t* g = p.P + row * PW + (MODE == 0 ? E_HG : O_G) + h * DV;
  act_t* o = p.u + row * D + (MODE == 0 ? 512 : 0) + h * DV;
  for (int e = 0; e < DV; ++e) stA(o + e, (ldA(f + e) + ldA(bk + e)) * r * gn[e] * siluf_(ldA(g + e)));
}

DEV void ph_gla_decay(const Params& p, long i) {
  int col = (int)(i % 384);
  long row = (i / 384) % NR;
  int dir = (int)(i / ((long)384 * NR));
  const act_t* r = p.P + row * PW + O_RF + dir * 16;
  const float* gw = p.gla_gate_w + (long)dir * 16 * 384 + col;
  float z = p.gla_gate_b[dir * 384 + col];
  for (int k = 0; k < 16; ++k) z += ldA(r + k) * gw[k * 384];
  float ls = fminf(z, 0.f) - log1pf(expf(-fabsf(z)));
  stA(p.LF + ((long)dir * NR + row) * 384 + col, ls * (1.0f / 16.0f));
}

DEV void ph_resid_ln(const Params& p, long row, int l, int sub) {
  const float* hin = (l == 0 && sub == 0) ? hrow_in(p, row) : hrow(p, row);
  float* hout = hrow(p, row);
  const float* md = modrow(p, l, row);
  const float* g = md + (sub == 0 ? 2 : 5) * D;
  const act_t* m = p.M + row * D;
  const float* lg = p.ln_g + (l * 2 + sub) * D;
  const float* lb = p.ln_b + (l * 2 + sub) * D;
  float mu = 0.f;
  for (int k = 0; k < D; ++k) mu += ALPHA * hin[k] + g[k] * ldA(m + k);
  mu *= (1.0f / D);
  float var = 0.f;
  for (int k = 0; k < D; ++k) { float d = ALPHA * hin[k] + g[k] * ldA(m + k) - mu; var += d * d; }
  var *= (1.0f / D);
  float rs = 1.0f / sqrtf(var + LN_EPS);
  for (int k = 0; k < D; ++k) hout[k] = (ALPHA * hin[k] + g[k] * ldA(m + k) - mu) * rs * lg[k] + lb[k];
  if (sub == 1 && l == 1) return;
  const float* md2 = (sub == 0) ? md + 3 * D : modrow(p, 1, row);
  float mu2 = 0.f;
  for (int k = 0; k < D; ++k) mu2 += hout[k];
  mu2 *= (1.0f / D);
  float var2 = 0.f;
  for (int k = 0; k < D; ++k) { float d = hout[k] - mu2; var2 += d * d; }
  var2 *= (1.0f / D);
  float rs2 = 1.0f / sqrtf(var2 + LN_EPS);
  float lo[NEXP];
#pragma unroll
  for (int e = 0; e < NEXP; ++e) lo[e] = 0.f;
  for (int k = 0; k < D; ++k) {
    float uv = (hout[k] - mu2) * rs2 * (1.0f + md2[D + k]) + md2[k];
    stA(p.u + row * D + k, uv);
    if (sub == 0) {
      const float* wr = p.w_router + k * NEXP;
#pragma unroll
      for (int e = 0; e < NEXP; ++e) lo[e] += uv * wr[e];
    }
  }
  if (sub != 0) return;
  float mx = lo[0];
#pragma unroll
  for (int e = 1; e < NEXP; ++e) mx = fmaxf(mx, lo[e]);
  float sum = 0.f;
#pragma unroll
  for (int e = 0; e < NEXP; ++e) { lo[e] = expf(lo[e] - mx); sum += lo[e]; }
  float inv = 1.0f / sum;
  float bestg = -1e30f; int bg = 0;
  float gi1 = 0, gi2 = 0; int ge1 = 0, ge2 = 0;
  float gp1 = 0, gp2 = 0;
#pragma unroll
  for (int gq = 0; gq < 4; ++gq) {
    float s1 = -1e30f, s2 = -1e30f, p1 = 0, p2 = 0; int e1 = 0, e2 = 0;
#pragma unroll
    for (int j = 0; j < 4; ++j) {
      int e = gq * 4 + j;
      float pe = lo[e] * inv;
      float se = pe + p.b_router[e];
      if (se > s1) { s2 = s1; p2 = p1; e2 = e1; s1 = se; p1 = pe; e1 = e; }
      else if (se > s2) { s2 = se; p2 = pe; e2 = e; }
    }
    float gs = s1 + s2;
    if (gs > bestg) { bestg = gs; bg = gq; gi1 = s1; gi2 = s2; ge1 = e1; ge2 = e2; gp1 = p1; gp2 = p2; }
  }
  (void)bg; (void)gi1; (void)gi2;
  float wsum = gp1 + gp2;
  p.eidx[row * 2 + 0] = ge1; p.eidx[row * 2 + 1] = ge2;
  p.ew[row * 2 + 0] = gp1 / wsum; p.ew[row * 2 + 1] = gp2 / wsum;
}

DEV void ph_moe_up(const Params& p, long i, int l, long row0) {
  int f4 = (int)(i % (DFF / 4));
  int slot = (int)((i / (DFF / 4)) % 2);
  long row = row0 + i / (DFF / 2);
  int e = p.eidx[row * 2 + slot];
  const float* w1 = p.w_eg + ((long)(l * NEXP + e) * D) * DFF + f4 * 4;
  const float* w3 = p.w_eu + ((long)(l * NEXP + e) * D) * DFF + f4 * 4;
  const act_t* a = p.u + row * D;
  float g0 = 0, g1 = 0, g2 = 0, g3 = 0, u0 = 0, u1 = 0, u2 = 0, u3 = 0;
  for (int k = 0; k < D; ++k) {
    float av = ldA(a + k);
    const float* r1 = w1 + (long)k * DFF;
    const float* r3 = w3 + (long)k * DFF;
    g0 += av * r1[0]; g1 += av * r1[1]; g2 += av * r1[2]; g3 += av * r1[3];
    u0 += av * r3[0]; u1 += av * r3[1]; u2 += av * r3[2]; u3 += av * r3[3];
  }
  act_t* hb = p.P + (row * 2 + slot) * DFF + f4 * 4;
  stA(hb, siluf_(g0) * u0); stA(hb + 1, siluf_(g1) * u1); stA(hb + 2, siluf_(g2) * u2); stA(hb + 3, siluf_(g3) * u3);
}

DEV void ph_moe_down(const Params& p, long i, int l, long row0) {
  int j4 = (int)(i % (D / 4));
  long row = row0 + i / (D / 4);
  float y0 = 0, y1 = 0, y2 = 0, y3 = 0;
  for (int slot = 0; slot < 2; ++slot) {
    int e = p.eidx[row * 2 + slot];
    float wgt = p.ew[row * 2 + slot];
    const float* w2 = p.w_ed + ((long)(l * NEXP + e) * DFF) * D + j4 * 4;
    const act_t* hb = p.P + (row * 2 + slot) * DFF;
    float s0 = 0, s1 = 0, s2 = 0, s3 = 0;
    for (int f = 0; f < DFF; ++f) {
      float hv = ldA(hb + f);
      const float* r = w2 + (long)f * D;
      s0 += hv * r[0]; s1 += hv * r[1]; s2 += hv * r[2]; s3 += hv * r[3];
    }
    y0 += wgt * s0; y1 += wgt * s1; y2 += wgt * s2; y3 += wgt * s3;
  }
  act_t* o = p.M + row * D + j4 * 4;
  stA(o, y0); stA(o + 1, y1); stA(o + 2, y2); stA(o + 3, y3);
}


#ifndef HOST_TEST
typedef __attribute__((ext_vector_type(8))) short bf16x8;
typedef __attribute__((ext_vector_type(4))) float f32x4;
constexpr int SMEM_BYTES = 71680;
constexpr int IN_ODD_PAD = 2944;
constexpr int O_FA = 2336, O_FB = 2592, O_END = 2848;

typedef float f32x2_t __attribute__((ext_vector_type(2)));
typedef __bf16 bf16x2_t __attribute__((ext_vector_type(2)));
__device__ __forceinline__ unsigned pack2(float a, float b) {
  const f32x2_t v = {a, b};
  return __builtin_bit_cast(unsigned, __builtin_convertvector(v, bf16x2_t));
}
__device__ __forceinline__ unsigned pack2_mfma(float a, float b) { return pack2(a, b); }
typedef __attribute__((ext_vector_type(2))) unsigned u32x2;
__device__ __forceinline__ float xor16_max(float x) {
  const u32x2 r = __builtin_amdgcn_permlane16_swap(__float_as_uint(x), __float_as_uint(x), false, false);
  return fmaxf(__uint_as_float(r.x), __uint_as_float(r.y));
}
__device__ __forceinline__ float xor32_max(float x) {
  const u32x2 r = __builtin_amdgcn_permlane32_swap(__float_as_uint(x), __float_as_uint(x), false, false);
  return fmaxf(__uint_as_float(r.x), __uint_as_float(r.y));
}
__device__ __forceinline__ float xor16_add(float x) {
  const u32x2 r = __builtin_amdgcn_permlane16_swap(__float_as_uint(x), __float_as_uint(x), false, false);
  return __uint_as_float(r.x) + __uint_as_float(r.y);
}
__device__ __forceinline__ float xor32_add(float x) {
  const u32x2 r = __builtin_amdgcn_permlane32_swap(__float_as_uint(x), __float_as_uint(x), false, false);
  return __uint_as_float(r.x) + __uint_as_float(r.y);
}
__device__ __forceinline__ float bf_lo(unsigned u) { return __uint_as_float(u << 16); }
__device__ __forceinline__ float bf_hi(unsigned u) { return __uint_as_float(u & 0xffff0000u); }
template <int CTRL>
__device__ __forceinline__ float dpp_mov(float v) {
  return __int_as_float(__builtin_amdgcn_update_dpp(0, __float_as_int(v), CTRL, 0xf, 0xf, true));
}
__device__ __forceinline__ float row_sum16(float v) {
  v += dpp_mov<0xB1>(v);
  v += dpp_mov<0x4E>(v);
  v += dpp_mov<0x141>(v);
  v += dpp_mov<0x140>(v);
  return v;
}
__device__ __forceinline__ float wave_sum(float v) {
  v = row_sum16(v);
  const float a = __int_as_float(__builtin_amdgcn_readlane(__float_as_int(v), 0));
  const float b = __int_as_float(__builtin_amdgcn_readlane(__float_as_int(v), 16));
  const float c = __int_as_float(__builtin_amdgcn_readlane(__float_as_int(v), 32));
  const float d = __int_as_float(__builtin_amdgcn_readlane(__float_as_int(v), 48));
  return (a + b) + (c + d);
}


#define XB_TMO      128
#define XB_XCNT(j)  (256  + 64 * (j))
#define XB_XSUB(j)  (1280 + 64 * (j))
#define XB_XGEN(j)  (2304 + 64 * (j))
#define XB_TOP      3328
#define XB_TOPGEN   3392
#define XCD_BAR_WORDS 3456
#define XB_SPIN_CAP (1u << 18)
#define LAS __attribute__((address_space(3)))
__device__ __forceinline__ unsigned xb_ld(unsigned* p)              { return __hip_atomic_load(p, __ATOMIC_RELAXED, __HIP_MEMORY_SCOPE_AGENT); }
__device__ __forceinline__ unsigned xb_add(unsigned* p, unsigned v) { return __hip_atomic_fetch_add(p, v, __ATOMIC_RELAXED, __HIP_MEMORY_SCOPE_AGENT); }
__device__ __forceinline__ unsigned xb_xcc_id() { return (unsigned)__builtin_amdgcn_s_getreg((3 << 11) | 20) & 0xFu; }
#define XB_SPIN(cond, bar) do { unsigned _sp = 0; while (cond) { __builtin_amdgcn_s_sleep(1); \
    if ((++_sp & 255u) == 0u) { if (xb_ld(&(bar)[XB_TMO])) break; if (_sp > XB_SPIN_CAP) { atomicAdd(&(bar)[XB_TMO], 1u); break; } } } } while (0)
struct XcdBarrier { unsigned* bar; unsigned x; volatile LAS unsigned* st; };
__device__ __forceinline__ XcdBarrier xcd_barrier_post(unsigned* bar, volatile LAS unsigned* st) {
    XcdBarrier b; b.bar = bar; b.x = xb_xcc_id(); b.st = st;
    if (threadIdx.x == 0) (void)xb_add(&bar[XB_XCNT(b.x)], 1u);
    return b;
}
__device__ __forceinline__ void xcd_barrier_complete(unsigned* bar, unsigned x, unsigned& nloc, unsigned& nx) {
    const unsigned G = gridDim.x * gridDim.y * gridDim.z;
    unsigned sum, cnt, mine, sp = 0u;
    for (;;) {
        sum = 0u; cnt = 0u; mine = 0u;
#pragma unroll
        for (unsigned j = 0; j < 16; ++j) { const unsigned c = xb_ld(&bar[XB_XCNT(j)]); sum += c; cnt += (c > 0u) ? 1u : 0u; mine = (j == x) ? c : mine; }
        if (sum == G) break;
        __builtin_amdgcn_s_sleep(1);
        if ((++sp & 255u) == 0u) { if (xb_ld(&bar[XB_TMO])) break; if (sp > XB_SPIN_CAP) { atomicAdd(&bar[XB_TMO], 1u); break; } }
    }
    nloc = mine > 0u ? mine : 1u; nx = cnt > 0u ? cnt : 1u;
}
__device__ __forceinline__ void xcd_barrier(const XcdBarrier& b) {
    asm volatile("s_waitcnt vmcnt(0)" ::: "memory");
    __syncthreads();
    if (threadIdx.x == 0) {
        unsigned* bar = b.bar;
        __builtin_amdgcn_s_waitcnt(0);
        unsigned nloc = b.st[0], nx = b.st[1];
        if (nloc == 0u) { xcd_barrier_complete(bar, b.x, nloc, nx); b.st[0] = nloc; b.st[1] = nx; }
        const unsigned old = xb_add(&bar[XB_XSUB(b.x)], 1u);
        const unsigned gen = old / nloc;
        if (old + 1u == (gen + 1u) * nloc) {
            __builtin_amdgcn_fence(__ATOMIC_RELEASE, "agent");
            asm volatile("s_waitcnt vmcnt(0)" ::: "memory");
            const unsigned og = xb_add(&bar[XB_TOP], 1u);
            const unsigned tg = og / nx;
            if (og + 1u == (tg + 1u) * nx) xb_add(&bar[XB_TOPGEN], 1u);
            else XB_SPIN(xb_ld(&bar[XB_TOPGEN]) == tg, bar);
            __builtin_amdgcn_fence(__ATOMIC_ACQUIRE, "agent");
            xb_add(&bar[XB_XGEN(b.x)], 1u);
            asm volatile("s_waitcnt vmcnt(0)" ::: "memory");
        } else {
            XB_SPIN(xb_ld(&bar[XB_XGEN(b.x)]) == gen, bar);
            __builtin_amdgcn_fence(__ATOMIC_ACQUIRE, "agent");
            asm volatile("s_waitcnt vmcnt(0)" ::: "memory");
        }
    }
    __syncthreads();
}

#define RAW_BARRIER() do { asm volatile("s_waitcnt lgkmcnt(0)" ::: "memory"); __builtin_amdgcn_s_barrier(); } while (0)
template <bool SWAP, class ARow, class Epi>
__device__ __forceinline__ void gemm_tile(ARow arow, const act_t* Bt, int K, unsigned char* smem, Epi epi) {
  const int tid = threadIdx.x, wid = tid >> 6, lane = tid & 63, wr = wid >> 1, wc = wid & 1, fr = lane & 15,
            fq = lane >> 4;
  const int r0 = tid >> 3, pc = tid & 7;
  const int lc = pc ^ ((tid >> 4) & 7);
  const act_t* ga[4];
#pragma unroll
  for (int i = 0; i < 4; ++i) ga[i] = arow(r0 + 32 * i) + lc * 8;
  const act_t* gb0 = Bt + (long)r0 * K + lc * 8;
  const long gbs = (long)32 * K;
  const int sw = (fr >> 1) & 7;
  const int rd0 = fr * 128 + ((fq ^ sw) << 4), rd1 = fr * 128 + (((4 + fq) ^ sw) << 4);
  char* S = (char*)smem;
  const int nk = K >> 6;
  f32x4 acc[4][4];
#pragma unroll
  for (int m = 0; m < 4; ++m)
#pragma unroll
    for (int n = 0; n < 4; ++n) acc[m][n] = f32x4{0.f, 0.f, 0.f, 0.f};
  auto issue = [&](int kt) {
    char* st = S + (kt & 1) * 32768 + tid * 16;
#pragma unroll
    for (int i = 0; i < 4; ++i) {
      __builtin_amdgcn_global_load_lds((const unsigned*)(ga[i] + kt * 64), (unsigned*)(st + i * 4096), 16, 0, 0);
      __builtin_amdgcn_global_load_lds((const unsigned*)(gb0 + i * gbs + kt * 64), (unsigned*)(st + 16384 + i * 4096), 16, 0, 0);
    }
  };
  RAW_BARRIER();
  issue(0);
  for (int kt = 0; kt < nk; ++kt) {
    asm volatile("s_waitcnt vmcnt(0)" ::: "memory");
    RAW_BARRIER();
    if (kt + 1 < nk) issue(kt + 1);
    const char* st = S + (kt & 1) * 32768;
#pragma unroll
    for (int ks = 0; ks < 2; ++ks) {
      const int rd = ks ? rd1 : rd0;
      bf16x8 af[4], bfr[4];
#pragma unroll
      for (int m = 0; m < 4; ++m) {
        af[m] = *reinterpret_cast<const bf16x8*>(st + (wr * 64 + m * 16) * 128 + rd);
        bfr[m] = *reinterpret_cast<const bf16x8*>(st + 16384 + (wc * 64 + m * 16) * 128 + rd);
      }
#pragma unroll
      for (int m = 0; m < 4; ++m)
#pragma unroll
        for (int n = 0; n < 4; ++n)
          acc[m][n] = SWAP ? __builtin_amdgcn_mfma_f32_16x16x32_bf16(bfr[n], af[m], acc[m][n], 0, 0, 0)
                           : __builtin_amdgcn_mfma_f32_16x16x32_bf16(af[m], bfr[n], acc[m][n], 0, 0, 0);
    }
  }
  epi(acc, wr, wc, fr, fq);
}


constexpr float SU8 = 16.0f, SW8 = 64.0f, SH8 = 8.0f, SO8 = 8.0f;
typedef unsigned char fp8_t;
typedef __attribute__((ext_vector_type(8))) int i32x8;
typedef __attribute__((ext_vector_type(4))) int i32x4;
__device__ __forceinline__ unsigned pack4_fp8(float a, float b, float c, float d) {
  a = fminf(fmaxf(a, -448.f), 448.f); b = fminf(fmaxf(b, -448.f), 448.f);
  c = fminf(fmaxf(c, -448.f), 448.f); d = fminf(fmaxf(d, -448.f), 448.f);
  unsigned w = 0;
  w = __builtin_amdgcn_cvt_pk_fp8_f32(a, b, w, false);
  w = __builtin_amdgcn_cvt_pk_fp8_f32(c, d, w, true);
  return w;
}

template <bool SWAP, class ARow, class Epi>
__device__ __forceinline__ void gemm_tile8(ARow arow, const fp8_t* Bt, int Kb, unsigned char* smem, Epi epi) {
  const int tid = threadIdx.x, wid = tid >> 6, lane = tid & 63, wr = wid >> 1, wc = wid & 1, fr = lane & 15,
            fq = lane >> 4;
  const int r0 = tid >> 3, pc = tid & 7;
  const int lc = pc ^ ((tid >> 4) & 7);
  const fp8_t* ga[4];
#pragma unroll
  for (int i = 0; i < 4; ++i) ga[i] = arow(r0 + 32 * i) + lc * 16;
  const fp8_t* gb0 = Bt + (long)r0 * Kb + lc * 16;
  const long gbs = (long)32 * Kb;
  const int sw = (fr >> 1) & 7;
  const int rd0 = fr * 128 + ((fq ^ sw) << 4), rd1 = fr * 128 + (((4 + fq) ^ sw) << 4);
  char* S = (char*)smem;
  const int nk = Kb >> 7;
  f32x4 acc[4][4];
#pragma unroll
  for (int m = 0; m < 4; ++m)
#pragma unroll
    for (int n = 0; n < 4; ++n) acc[m][n] = f32x4{0.f, 0.f, 0.f, 0.f};
  auto issue = [&](int kt) {
    char* st = S + (kt & 1) * 32768 + tid * 16;
#pragma unroll
    for (int i = 0; i < 4; ++i) {
      __builtin_amdgcn_global_load_lds((const unsigned*)(ga[i] + kt * 128), (unsigned*)(st + i * 4096), 16, 0, 0);
      __builtin_amdgcn_global_load_lds((const unsigned*)(gb0 + i * gbs + kt * 128), (unsigned*)(st + 16384 + i * 4096), 16, 0, 0);
    }
  };
  RAW_BARRIER();
  issue(0);
#pragma unroll 1
  for (int kt = 0; kt < nk; ++kt) {
    asm volatile("s_waitcnt vmcnt(0)" ::: "memory");
    RAW_BARRIER();
    if (kt + 1 < nk) issue(kt + 1);
    const char* st = S + (kt & 1) * 32768;
    i32x8 af[4], bfr[4];
#pragma unroll
    for (int m = 0; m < 4; ++m) {
      const i32x4 a0 = *reinterpret_cast<const i32x4*>(st + (wr * 64 + m * 16) * 128 + rd0);
      const i32x4 a1 = *reinterpret_cast<const i32x4*>(st + (wr * 64 + m * 16) * 128 + rd1);
      const i32x4 b0 = *reinterpret_cast<const i32x4*>(st + 16384 + (wc * 64 + m * 16) * 128 + rd0);
      const i32x4 b1 = *reinterpret_cast<const i32x4*>(st + 16384 + (wc * 64 + m * 16) * 128 + rd1);
      af[m] = i32x8{a0[0], a0[1], a0[2], a0[3], a1[0], a1[1], a1[2], a1[3]};
      bfr[m] = i32x8{b0[0], b0[1], b0[2], b0[3], b1[0], b1[1], b1[2], b1[3]};
    }
#pragma unroll
    for (int m = 0; m < 4; ++m)
#pragma unroll
      for (int n = 0; n < 4; ++n)
        acc[m][n] = SWAP ? __builtin_amdgcn_mfma_scale_f32_16x16x128_f8f6f4(bfr[n], af[m], acc[m][n], 0, 0, 0, 0x7f7f7f7f, 0, 0x7f7f7f7f)
                         : __builtin_amdgcn_mfma_scale_f32_16x16x128_f8f6f4(af[m], bfr[n], acc[m][n], 0, 0, 0, 0x7f7f7f7f, 0, 0x7f7f7f7f);
  }
  epi(acc, wr, wc, fr, fq);
}


template <bool SWAP, class Epi>
__device__ __forceinline__ void gemm_tile8p(const fp8_t* A, const fp8_t* Bt, bool has_next, const fp8_t* An, const fp8_t* Btn,
                                            int& par, bool& primed, int Kb, unsigned char* smem, Epi epi) {
  const int tid = threadIdx.x, wid = tid >> 6, lane = tid & 63, wr = wid >> 1, wc = wid & 1, fr = lane & 15,
            fq = lane >> 4;
  const int r0 = tid >> 3, pc = tid & 7;
  const int lc = pc ^ ((tid >> 4) & 7);
  const long roff = (long)r0 * Kb + lc * 16;
  const long gbs = (long)32 * Kb;
  const int sw = (fr >> 1) & 7;
  const int rd0 = fr * 128 + ((fq ^ sw) << 4), rd1 = fr * 128 + (((4 + fq) ^ sw) << 4);
  char* S = (char*)smem;
  const int nk = Kb >> 7;
  f32x4 acc[4][4];
#pragma unroll
  for (int m = 0; m < 4; ++m)
#pragma unroll
    for (int n = 0; n < 4; ++n) acc[m][n] = f32x4{0.f, 0.f, 0.f, 0.f};
  auto issue = [&](const fp8_t* a, const fp8_t* b, int kt, int stage) {
    char* st = S + stage * 32768 + tid * 16;
    const fp8_t* ga = a + roff + kt * 128;
    const fp8_t* gb = b + roff + kt * 128;
#pragma unroll
    for (int i = 0; i < 4; ++i) {
      __builtin_amdgcn_global_load_lds((const unsigned*)(ga + i * gbs), (unsigned*)(st + i * 4096), 16, 0, 0);
      __builtin_amdgcn_global_load_lds((const unsigned*)(gb + i * gbs), (unsigned*)(st + 16384 + i * 4096), 16, 0, 0);
    }
  };
  if (!primed) {
    RAW_BARRIER();
    issue(A, Bt, 0, par);
  }
#pragma unroll 1
  for (int kt = 0; kt < nk; ++kt) {
    asm volatile("s_waitcnt vmcnt(0)" ::: "memory");
    RAW_BARRIER();
    if (kt + 1 < nk) issue(A, Bt, kt + 1, (par + kt + 1) & 1);
    else if (has_next) issue(An, Btn, 0, (par + kt + 1) & 1);
    const char* st = S + ((par + kt) & 1) * 32768;
    i32x8 af[4], bfr[4];
#pragma unroll
    for (int m = 0; m < 4; ++m) {
      const i32x4 a0 = *reinterpret_cast<const i32x4*>(st + (wr * 64 + m * 16) * 128 + rd0);
      const i32x4 a1 = *reinterpret_cast<const i32x4*>(st + (wr * 64 + m * 16) * 128 + rd1);
      const i32x4 b0 = *reinterpret_cast<const i32x4*>(st + 16384 + (wc * 64 + m * 16) * 128 + rd0);
      const i32x4 b1 = *reinterpret_cast<const i32x4*>(st + 16384 + (wc * 64 + m * 16) * 128 + rd1);
      af[m] = i32x8{a0[0], a0[1], a0[2], a0[3], a1[0], a1[1], a1[2], a1[3]};
      bfr[m] = i32x8{b0[0], b0[1], b0[2], b0[3], b1[0], b1[1], b1[2], b1[3]};
    }
#pragma unroll
    for (int m = 0; m < 4; ++m)
#pragma unroll
      for (int n = 0; n < 4; ++n)
        acc[m][n] = SWAP ? __builtin_amdgcn_mfma_scale_f32_16x16x128_f8f6f4(bfr[n], af[m], acc[m][n], 0, 0, 0, 0x7f7f7f7f, 0, 0x7f7f7f7f)
                         : __builtin_amdgcn_mfma_scale_f32_16x16x128_f8f6f4(af[m], bfr[n], acc[m][n], 0, 0, 0, 0x7f7f7f7f, 0, 0x7f7f7f7f);
  }
  par = (par + nk) & 1;
  primed = has_next;
  epi(acc, wr, wc, fr, fq);
}

__device__ __forceinline__ void phase_attn(const Params& p, unsigned char* smem, int blk, int nblk) {
  const int tid = threadIdx.x, w = tid >> 6, lane = tid & 63, fr = lane & 15, g = lane >> 4;
  act_t* SK = (act_t*)smem;
  act_t* SV = SK + 64 * 72;
  constexpr float SCL = 0.125f * 1.4426950408889634f;
  const int n_lat = NB * 4 * (T / 64), n_ctx = NB * 4 * (C / 64);
  const int skey = tid >> 2, spart = tid & 3;
  for (int unit = blk; unit < n_lat + n_ctx; unit += nblk) {
    const bool lat = unit < n_lat;
    const int uu = lat ? unit : unit - n_lat;
    const int nq = lat ? T / 64 : C / 64;
    const int hp = uu & 1, kv = (uu >> 1) & 1, qb = (uu >> 2) % nq, b = (uu >> 2) / nq;
    const int t0 = qb * 64;
    const int tw = t0 + (w & 1) * 32;
    const long qrow0 = (lat ? (long)NC + (long)b * T : (long)b * C) + tw;
    const int h = kv * 4 + hp * 2 + (w >> 1);
    bf16x8 qf[2][2];
#pragma unroll
    for (int qt = 0; qt < 2; ++qt)
#pragma unroll
      for (int st = 0; st < 2; ++st)
        qf[qt][st] = *reinterpret_cast<const bf16x8*>(p.P + (qrow0 + qt * 16 + fr) * PW + E_AQ + h * 64 + st * 32 + g * 8);
    asm volatile("" :: "v"(qf[0][0]), "v"(qf[0][1]), "v"(qf[1][0]), "v"(qf[1][1]));
    float mrun[2], lrun[2];
    f32x4 o[2][4];
    const float sinkl = p.attn_sink[h] * 1.4426950408889634f;
#pragma unroll
    for (int qt = 0; qt < 2; ++qt) {
      mrun[qt] = sinkl;
      lrun[qt] = (g == 0) ? 1.0f : 0.0f;
#pragma unroll
      for (int dt = 0; dt < 4; ++dt) o[qt][dt] = f32x4{0.f, 0.f, 0.f, 0.f};
    }
    int cc_lo = 0, cc_hi = -1;
    if (lat) {
      cc_lo = t0 >= 128 ? 0 : (128 - t0) / 64;
      cc_hi = min(4, (T - 1 - (t0 - 128)) / 64);
    }
    const int nch = 4 + (cc_hi - cc_lo + 1);
    auto chunk_row = [&](int i, int key, int& tkb) -> long {
      if (i < 4) { tkb = 0; return (long)b * C + i * 64 + key; }
      tkb = t0 - 128 + (cc_lo + i - 4) * 64;
      return (long)NC + (long)b * T + tkb + key;
    };
    uint4 rk0, rk1, rv0, rv1;
    {
      int tkb; const long kr = chunk_row(0, skey, tkb);
      const act_t* kp = p.P + kr * PW + E_AK + kv * 64 + spart * 16;
      const act_t* vp = p.P + kr * PW + E_AV + kv * 64 + spart * 16;
      rk0 = *reinterpret_cast<const uint4*>(kp); rk1 = *reinterpret_cast<const uint4*>(kp + 8);
      rv0 = *reinterpret_cast<const uint4*>(vp); rv1 = *reinterpret_cast<const uint4*>(vp + 8);
    }
    for (int i = 0; i < nch; ++i) {
      __syncthreads();
      {
        uint4* kd = reinterpret_cast<uint4*>(SK + skey * 72 + spart * 16);
        kd[0] = rk0; kd[1] = rk1;
        const unsigned vw[8] = {rv0.x, rv0.y, rv0.z, rv0.w, rv1.x, rv1.y, rv1.z, rv1.w};
#pragma unroll
        for (int e = 0; e < 8; ++e) {
          SV[(spart * 16 + 2 * e) * 72 + skey] = (act_t)(vw[e] & 0xffffu);
          SV[(spart * 16 + 2 * e + 1) * 72 + skey] = (act_t)(vw[e] >> 16);
        }
      }
      __syncthreads();
      int tkb_cur; (void)chunk_row(i, 0, tkb_cur);
      if (i + 1 < nch) {
        int tkb; const long kr = chunk_row(i + 1, skey, tkb);
        const act_t* kp = p.P + kr * PW + E_AK + kv * 64 + spart * 16;
        const act_t* vp = p.P + kr * PW + E_AV + kv * 64 + spart * 16;
        rk0 = *reinterpret_cast<const uint4*>(kp); rk1 = *reinterpret_cast<const uint4*>(kp + 8);
        rv0 = *reinterpret_cast<const uint4*>(vp); rv1 = *reinterpret_cast<const uint4*>(vp + 8);
      }
      const bool edge = i >= 4 && (tkb_cur == t0 - 128 || tkb_cur == t0 + 128);
#pragma unroll
      for (int kb = 0; kb < 2; ++kb) {
        f32x4 sc[2][2];
#pragma unroll
        for (int k2 = 0; k2 < 2; ++k2) {
          const int kt = kb * 2 + k2;
          const bf16x8 kf0 = *reinterpret_cast<const bf16x8*>(SK + (kt * 16 + fr) * 72 + g * 8);
          const bf16x8 kf1 = *reinterpret_cast<const bf16x8*>(SK + (kt * 16 + fr) * 72 + 32 + g * 8);
#pragma unroll
          for (int qt = 0; qt < 2; ++qt) {
            f32x4 z = f32x4{0.f, 0.f, 0.f, 0.f};
            z = __builtin_amdgcn_mfma_f32_16x16x32_bf16(kf0, qf[qt][0], z, 0, 0, 0);
            sc[qt][k2] = __builtin_amdgcn_mfma_f32_16x16x32_bf16(kf1, qf[qt][1], z, 0, 0, 0);
          }
        }
        bf16x8 pf[2];
#pragma unroll
        for (int qt = 0; qt < 2; ++qt) {
          float mx = -1e30f;
#pragma unroll
          for (int k2 = 0; k2 < 2; ++k2)
#pragma unroll
            for (int j = 0; j < 4; ++j) {
              float v = sc[qt][k2][j] * SCL;
              if (edge) {
                const int tk = tkb_cur + (kb * 2 + k2) * 16 + 4 * g + j;
                const int tq = tw + qt * 16 + fr;
                const int df = tq - tk;
                if (df > 128 || df < -128) v = -1e30f;
              }
              sc[qt][k2][j] = v;
              mx = fmaxf(mx, v);
            }
          mx = xor16_max(mx);
          mx = xor32_max(mx);
          const float mnew = fmaxf(mrun[qt], mx);
          if (__any(mnew > mrun[qt])) {
            const float alpha = __builtin_amdgcn_exp2f(mrun[qt] - mnew);
            lrun[qt] *= alpha;
#pragma unroll
            for (int dt = 0; dt < 4; ++dt) o[qt][dt] = o[qt][dt] * alpha;
            mrun[qt] = mnew;
          }
          float ls = 0.f;
          float pv[8];
#pragma unroll
          for (int k2 = 0; k2 < 2; ++k2)
#pragma unroll
            for (int j = 0; j < 4; ++j) {
              const float pe = __builtin_amdgcn_exp2f(sc[qt][k2][j] - mnew);
              pv[k2 * 4 + j] = pe;
              ls += pe;
            }
          lrun[qt] += ls;
          union { unsigned u[4]; bf16x8 v; } cv;
          cv.u[0] = pack2_mfma(pv[0], pv[1]); cv.u[1] = pack2_mfma(pv[2], pv[3]);
          cv.u[2] = pack2_mfma(pv[4], pv[5]); cv.u[3] = pack2_mfma(pv[6], pv[7]);
          pf[qt] = cv.v;
        }
#pragma unroll
        for (int dt = 0; dt < 4; ++dt) {
          union { uint2 h2[2]; bf16x8 v; } vf;
          vf.h2[0] = *reinterpret_cast<const uint2*>(SV + (dt * 16 + fr) * 72 + kb * 32 + 4 * g);
          vf.h2[1] = *reinterpret_cast<const uint2*>(SV + (dt * 16 + fr) * 72 + kb * 32 + 16 + 4 * g);
#pragma unroll
          for (int qt = 0; qt < 2; ++qt) o[qt][dt] = __builtin_amdgcn_mfma_f32_16x16x32_bf16(vf.v, pf[qt], o[qt][dt], 0, 0, 0);
        }
      }
    }
#pragma unroll
    for (int qt = 0; qt < 2; ++qt) {
      float lt = lrun[qt];
      lt = xor16_add(lt);
      lt = xor32_add(lt);
      const float il = 1.0f / lt;
      fp8_t* orow = p.O8 + (qrow0 + qt * 16 + fr) * D + h * 64 + 4 * g;
      const float ils = il * SO8;
#pragma unroll
      for (int dt = 0; dt < 4; ++dt)
        *reinterpret_cast<unsigned*>(orow + dt * 16) = pack4_fp8(o[qt][dt][0] * ils, o[qt][dt][1] * ils, o[qt][dt][2] * ils, o[qt][dt][3] * ils);
    }
  }
}


template <int MODE>
__device__ __forceinline__ void phase_combine(const Params& p) {
  constexpr int DV = MODE == 0 ? 128 : 192, EPL = DV / 16, NV = EPL / 4;
  const int lane = threadIdx.x & 63;
  const long row_lo = MODE == 0 ? 0 : NC;
  const int nw = (int)gridDim.x * 4, wi = (int)blockIdx.x * 4 + (int)(threadIdx.x >> 6);
  const int rpw = (int)(NR - row_lo + nw - 1) / nw;
  const long r0 = row_lo + (long)wi * rpw, r1 = min((long)NR, r0 + rpw);
  float gn[EPL];
#pragma unroll
  for (int e = 0; e < EPL; ++e) gn[e] = (MODE == 0 ? p.hgrn_norm : p.gla_norm)[lane * EPL + e];
  uint2 fa[NV], fb[NV], fg[NV];
  auto load_row = [&](long row) {
    const uint2* f = reinterpret_cast<const uint2*>(p.OF + row * 768 + lane * EPL);
    const uint2* bk = reinterpret_cast<const uint2*>(p.OB + row * 768 + lane * EPL);
    const uint2* gt = reinterpret_cast<const uint2*>(p.P + row * PW + (MODE == 0 ? E_HG : O_G) + lane * EPL);
#pragma unroll
    for (int v = 0; v < NV; ++v) { fa[v] = f[v]; fb[v] = bk[v]; fg[v] = gt[v]; }
  };
  if (r0 < r1) load_row(r0);
  for (long row = r0; row < r1; ++row) {
    float o[EPL], gg[EPL];
#pragma unroll
    for (int v = 0; v < NV; ++v) {
      o[4 * v + 0] = bf_lo(fa[v].x) + bf_lo(fb[v].x); o[4 * v + 1] = bf_hi(fa[v].x) + bf_hi(fb[v].x);
      o[4 * v + 2] = bf_lo(fa[v].y) + bf_lo(fb[v].y); o[4 * v + 3] = bf_hi(fa[v].y) + bf_hi(fb[v].y);
      gg[4 * v + 0] = bf_lo(fg[v].x); gg[4 * v + 1] = bf_hi(fg[v].x); gg[4 * v + 2] = bf_lo(fg[v].y); gg[4 * v + 3] = bf_hi(fg[v].y);
    }
    load_row(min(row + 1, r1 - 1));
    float ss = 0.f;
#pragma unroll
    for (int e = 0; e < EPL; ++e) ss += o[e] * o[e];
    ss = row_sum16(ss);
    const float r = 1.0f / sqrtf(ss * (1.0f / DV) + LN_EPS);
    unsigned* dst = reinterpret_cast<unsigned*>(p.O8 + row * D + (MODE == 0 ? 512 : 0) + lane * EPL);
#pragma unroll
    for (int v = 0; v < NV; ++v) {
      float y[4];
#pragma unroll
      for (int q = 0; q < 4; ++q) {
        const float g = gg[4 * v + q];
        y[q] = o[4 * v + q] * (r * SO8) * gn[4 * v + q] * (g / (1.0f + __expf(-g)));
      }
      dst[v] = pack4_fp8(y[0], y[1], y[2], y[3]);
    }
  }
}

constexpr int MOD_ITEMS = 2 * (6 * D / 64);
__device__ __forceinline__ void mod_item(const Params& p, int item, unsigned char* smem) {
  float* sc = (float*)smem;
  float* red = sc + 9 * D;
  const int tid = threadIdx.x, w = tid >> 6, lane = tid & 63;
  for (int i = tid; i < 9 * D; i += 256) {
    const int bb = i >> 10, k = i & 1023;
    const float v = bb < NB ? p.c[bb * D + k] : p.c_ctx[k];
    sc[i] = v / (1.0f + __expf(-v));
  }
  __syncthreads();
  const int l = item / (6 * D / 64), j = (item % (6 * D / 64)) * 64 + lane;
  const float* wp = p.w_ada + (long)l * D * 6 * D + (long)(w * 256) * 6 * D + j;
  float a[NB + 1];
#pragma unroll
  for (int bb = 0; bb <= NB; ++bb) a[bb] = 0.f;
  for (int kb = 0; kb < 256; kb += 32) {
    float wv[32];
#pragma unroll
    for (int q = 0; q < 32; ++q) wv[q] = wp[(long)(kb + q) * 6 * D];
#pragma unroll
    for (int q = 0; q < 32; ++q)
#pragma unroll
      for (int bb = 0; bb <= NB; ++bb) a[bb] += sc[bb * D + w * 256 + kb + q] * wv[q];
  }
#pragma unroll
  for (int bb = 0; bb <= NB; ++bb) red[(w * 9 + bb) * 64 + lane] = a[bb];
  __syncthreads();
  for (int i = tid; i < 9 * 64; i += 256) {
    const int bb = i >> 6, jj = i & 63;
    const int col = (item % (6 * D / 64)) * 64 + jj;
    const float sum = ((red[(0 * 9 + bb) * 64 + jj] + red[(1 * 9 + bb) * 64 + jj]) + (red[(2 * 9 + bb) * 64 + jj] + red[(3 * 9 + bb) * 64 + jj]));
    p.mod[((long)l * (NB + 1) + bb) * 6 * D + col] = sum + p.b_ada[l * 6 * D + col];
  }
  __syncthreads();
}

__device__ __forceinline__ void phase_gla_decay(const Params& p) {
  const int t = threadIdx.x;
  if (t >= 192) return;
  const int dir = t / 96, cg = t % 96;
  float gw[16][4], gb[4];
#pragma unroll
  for (int r = 0; r < 16; ++r) {
    const float4 v = *reinterpret_cast<const float4*>(p.gla_gate_w + ((long)dir * 16 + r) * 384 + cg * 4);
    gw[r][0] = v.x; gw[r][1] = v.y; gw[r][2] = v.z; gw[r][3] = v.w;
  }
  {
    const float4 v = *reinterpret_cast<const float4*>(p.gla_gate_b + dir * 384 + cg * 4);
    gb[0] = v.x; gb[1] = v.y; gb[2] = v.z; gb[3] = v.w;
  }
  const int rpb = ((NR + (int)gridDim.x - 1) / (int)gridDim.x + 3) / 4 * 4;
  const long b0 = (long)blockIdx.x * rpb, b1 = min((long)NR, b0 + rpb);
  uint4 ra[4], rb[4];
  auto load4 = [&](long row0) {
#pragma unroll
    for (int q = 0; q < 4; ++q) {
      const uint4* rp = reinterpret_cast<const uint4*>(p.P + min(row0 + q, b1 - 1) * PW + O_RF + dir * 16);
      ra[q] = rp[0]; rb[q] = rp[1];
    }
  };
  if (b0 < b1) load4(b0);
  for (long row0 = b0; row0 < b1; row0 += 4) {
    unsigned rw[4][8];
#pragma unroll
    for (int q = 0; q < 4; ++q) {
      rw[q][0] = ra[q].x; rw[q][1] = ra[q].y; rw[q][2] = ra[q].z; rw[q][3] = ra[q].w;
      rw[q][4] = rb[q].x; rw[q][5] = rb[q].y; rw[q][6] = rb[q].z; rw[q][7] = rb[q].w;
    }
    load4(min(row0 + 4, b1 - 1));
#pragma unroll
    for (int q = 0; q < 4; ++q) {
      float z[4] = {gb[0], gb[1], gb[2], gb[3]};
#pragma unroll
      for (int r2 = 0; r2 < 8; ++r2) {
        const float x0 = bf_lo(rw[q][r2]), x1 = bf_hi(rw[q][r2]);
#pragma unroll
        for (int c = 0; c < 4; ++c) z[c] += x0 * gw[2 * r2][c] + x1 * gw[2 * r2 + 1][c];
      }
      float o[4];
#pragma unroll
      for (int c = 0; c < 4; ++c) o[c] = (fminf(z[c], 0.f) - __logf(1.0f + __expf(-fabsf(z[c])))) * (1.0f / 16.0f);
      if (row0 + q < b1)
        *reinterpret_cast<uint2*>(p.LF + ((long)dir * NR + row0 + q) * 384 + cg * 4) = make_uint2(pack2(o[0], o[1]), pack2(o[2], o[3]));
    }
  }
}

__device__ __forceinline__ void phase_hgrn_gate(const Params& p, long gtid, long gstride) {
  for (long i = gtid; i < (long)NR * 1024; i += gstride) {
    const int col = (int)(i & 1023);
    const long row = i >> 10;
    act_t* z = p.P + row * PW + E_FF + col;
    const float lb = p.lbt[col];
    const float f = lb + (1.0f - lb) * sigmoidf_(ldA(z));
    stA(z, __logf(f));
  }
}

template <int MODE>
__device__ __forceinline__ void phase_scan(const Params& p, unsigned char* smem, int blk, int nblk) {
  constexpr int DK = MODE == 0 ? 128 : 96, DV = MODE == 0 ? 128 : 192, DVS = DV / 4, NET = DVS / 16, NKS = DK / 32,
                NDT = DK / 16;
  constexpr int QS = DK + 8, LS = 72, SS = DK + 8;
  act_t* Qa = (act_t*)smem;
  act_t* Ka = Qa + 64 * QS;
  act_t* KaT = Ka + 64 * QS;
  act_t* VT = KaT + DK * LS;
  act_t* ST = VT + DVS * LS;
  float* tot = (float*)(ST + DVS * SS);
  float* lf32 = tot + 2 * 4 * DK;
  const int tid = threadIdx.x, w = __builtin_amdgcn_readfirstlane(threadIdx.x >> 6), lane = tid & 63, fr = lane & 15, g = lane >> 4;
  const int dp = lane, c0 = 2 * dp;
  const bool cact = dp < DK / 2;
  constexpr int NCH = (C + T) / 64, NCC = C / 64;
  constexpr int NVI = DVS / 8 * 64;
  for (int item = blk; item < NB * 4 * 2 * 4; item += nblk) {
    const int sl = item & 3, dir = (item >> 2) & 1, h = (item >> 3) & 3, b = item >> 5;
    act_t* OD = dir == 0 ? p.OF : p.OB;
    const unsigned loff = (unsigned)min(c0, DK - 2) * 2u;
    const int vcol = (MODE == 0 ? E_HI + h * 128 : O_V + h * 192) + sl * DVS;
    const int ocol = h * DV + sl * DVS;
    auto chunk_base = [&](int n) -> long {
      if (n < NCC) return (long)b * C + (dir ? NCC - 1 - n : n) * 64;
      const int ln = n - NCC;
      return (long)NC + (long)b * T + (dir ? T / 64 - 1 - ln : ln) * 64;
    };
    auto lrow = [&](long base, int l) -> long { return base + (dir ? 63 - l : l); };
    f32x4 S[NET][2];
#pragma unroll
    for (int et = 0; et < NET; ++et) { S[et][0] = f32x4{0.f, 0.f, 0.f, 0.f}; S[et][1] = f32x4{0.f, 0.f, 0.f, 0.f}; }
    unsigned rlf[16], rq[16], rk[16];
    uint4 rv[2];
    const long rstep = dir ? -(long)PW * 2 : (long)PW * 2;
    const long lstep = dir ? -(long)384 * 2 : (long)384 * 2;
    const unsigned off_lf = (MODE == 0 ? (unsigned)(E_FF + dir * 512 + h * 128) * 2u : 0u) + loff;
    const unsigned off_q = (unsigned)(MODE == 0 ? E_HQ + h * 128 : O_Q + h * 96) * 2u + loff;
    const unsigned off_k = (unsigned)(O_K + h * 96) * 2u + loff;
    auto issue_loads = [&](int n) {
      const long base = chunk_base(n);
      {
        const char* prow = (const char*)(p.P + lrow(base, w * 16) * PW);
        const char* plf = (const char*)(p.LF + ((long)dir * NR + lrow(base, w * 16)) * 384 + h * 96);
#pragma unroll
        for (int i = 0; i < 16; ++i) {
          if (MODE == 0) {
            rlf[i] = *reinterpret_cast<const unsigned*>(prow + off_lf);
          } else {
            rlf[i] = *reinterpret_cast<const unsigned*>(plf + loff);
            rk[i] = *reinterpret_cast<const unsigned*>(prow + off_k);
            plf += lstep;
          }
          rq[i] = *reinterpret_cast<const unsigned*>(prow + off_q);
          prow += rstep;
        }
      }
#pragma unroll
      for (int r = 0; r < (NVI + 255) / 256; ++r) {
        const int it = min(tid + r * 256, NVI - 1);
        const int l = it / (DVS / 8), e8 = (it % (DVS / 8)) * 8;
        rv[r] = *reinterpret_cast<const uint4*>(p.P + lrow(base, l) * PW + vcol + e8);
      }
    };
    issue_loads(0);
    for (int n = 0; n < NCH; ++n) {
      const int par = n & 1;
      float* totp = tot + par * 4 * DK;
      float* lfp = lf32 + par * DK;
      const long base = chunk_base(n);
      if (cact) {
        float r0 = 0.f, r1 = 0.f;
#pragma unroll
        for (int i = 0; i < 16; ++i) { r0 += bf_lo(rlf[i]); r1 += bf_hi(rlf[i]); }
        totp[w * DK + c0] = r0; totp[w * DK + c0 + 1] = r1;
        if (w == 2) { lfp[c0] = bf_lo(rlf[0]); lfp[c0 + 1] = bf_hi(rlf[0]); }
      }
      __syncthreads();
#pragma unroll
      for (int r = 0; r < (NVI + 255) / 256; ++r) {
        const int it = tid + r * 256;
        if (it < NVI) {
          const int l = it / (DVS / 8), e8 = (it % (DVS / 8)) * 8;
          const unsigned vw[4] = {rv[r].x, rv[r].y, rv[r].z, rv[r].w};
#pragma unroll
          for (int e = 0; e < 4; ++e) {
            VT[(e8 + 2 * e) * LS + l] = (act_t)(vw[e] & 0xffffu);
            VT[(e8 + 2 * e + 1) * LS + l] = (act_t)(vw[e] >> 16);
          }
        }
      }
      if (cact) {
        float of0 = 0.f, of1 = 0.f;
#pragma unroll
        for (int sgi = 0; sgi < 3; ++sgi)
          if (sgi < w) { of0 += totp[sgi * DK + c0]; of1 += totp[sgi * DK + c0 + 1]; }
        const float ref0 = totp[c0] + totp[DK + c0] + lfp[c0];
        const float ref1 = totp[c0 + 1] + totp[DK + c0 + 1] + lfp[c0 + 1];
        unsigned kt0[8], kt1[8];
        float run0 = of0 - ref0, run1 = of1 - ref1;
#pragma unroll
        for (int i = 0; i < 16; i += 2) {
          float ka0[2], ka1[2];
#pragma unroll
          for (int ii = 0; ii < 2; ++ii) {
            const int i2 = i + ii;
            run0 += bf_lo(rlf[i2]); run1 += bf_hi(rlf[i2]);
            const float b0 = run0, b1 = run1;
            const float e0 = __expf(b0), e1 = __expf(b1), f0 = __expf(-b0), f1 = __expf(-b1);
            float k0, k1;
            if (MODE == 0) { k0 = 1.0f - __expf(bf_lo(rlf[i2])); k1 = 1.0f - __expf(bf_hi(rlf[i2])); }
            else { k0 = bf_lo(rk[i2]); k1 = bf_hi(rk[i2]); }
            ka0[ii] = k0 * f0; ka1[ii] = k1 * f1;
            const int l = w * 16 + i2;
            *reinterpret_cast<unsigned*>(Qa + l * QS + c0) = pack2(bf_lo(rq[i2]) * e0, bf_hi(rq[i2]) * e1);
            *reinterpret_cast<unsigned*>(Ka + l * QS + c0) = pack2(ka0[ii], ka1[ii]);
          }
          kt0[i >> 1] = pack2(ka0[0], ka0[1]);
          kt1[i >> 1] = pack2(ka1[0], ka1[1]);
        }
        uint4* d0 = reinterpret_cast<uint4*>(KaT + c0 * LS + w * 16);
        d0[0] = make_uint4(kt0[0], kt0[1], kt0[2], kt0[3]); d0[1] = make_uint4(kt0[4], kt0[5], kt0[6], kt0[7]);
        uint4* d1 = reinterpret_cast<uint4*>(KaT + (c0 + 1) * LS + w * 16);
        d1[0] = make_uint4(kt1[0], kt1[1], kt1[2], kt1[3]); d1[1] = make_uint4(kt1[4], kt1[5], kt1[6], kt1[7]);
      }
      issue_loads(min(n + 1, NCH - 1));
      float egv[2], egrv[2];
#pragma unroll
      for (int di = 0; di < 2; ++di) {
        const int dt = w + 4 * di;
        if (dt < NDT) {
          const int d = dt * 16 + fr;
          const float refd = totp[d] + totp[DK + d] + lfp[d];
          const float gd = totp[d] + totp[DK + d] + totp[2 * DK + d] + totp[3 * DK + d];
          const float er = __expf(refd);
          egv[di] = __expf(gd); egrv[di] = __expf(gd - refd);
#pragma unroll
          for (int et = 0; et < NET; ++et)
#pragma unroll
            for (int j = 0; j < 4; ++j) stA(ST + (et * 16 + 4 * g + j) * SS + d, S[et][di][j] * er);
        }
      }
      __syncthreads();
      bf16x8 qfr[NKS];
#pragma unroll
      for (int ks = 0; ks < NKS; ++ks) qfr[ks] = *reinterpret_cast<const bf16x8*>(Qa + (w * 16 + fr) * QS + ks * 32 + g * 8);
      bf16x8 pfr[2];
#pragma unroll
      for (int kb = 0; kb < 2; ++kb) {
        f32x4 at2[2];
#pragma unroll
        for (int h2 = 0; h2 < 2; ++h2) {
          const int mt = 2 * kb + h2;
          at2[h2] = f32x4{0.f, 0.f, 0.f, 0.f};
          if (mt <= w) {
#pragma unroll
            for (int ks = 0; ks < NKS; ++ks) {
              const bf16x8 kaf = *reinterpret_cast<const bf16x8*>(Ka + (mt * 16 + fr) * QS + ks * 32 + g * 8);
              at2[h2] = __builtin_amdgcn_mfma_f32_16x16x32_bf16(kaf, qfr[ks], at2[h2], 0, 0, 0);
            }
            if (mt == w) {
#pragma unroll
              for (int j = 0; j < 4; ++j)
                if (4 * g + j > fr) at2[h2][j] = 0.f;
            }
          }
        }
        union { unsigned u[4]; bf16x8 v; } cv;
        cv.u[0] = pack2_mfma(at2[0][0], at2[0][1]); cv.u[1] = pack2_mfma(at2[0][2], at2[0][3]);
        cv.u[2] = pack2_mfma(at2[1][0], at2[1][1]); cv.u[3] = pack2_mfma(at2[1][2], at2[1][3]);
        pfr[kb] = cv.v;
      }
      const long orow = lrow(base, w * 16 + fr);
#pragma unroll
      for (int et = 0; et < NET; ++et) {
        f32x4 o = f32x4{0.f, 0.f, 0.f, 0.f};
#pragma unroll
        for (int kb = 0; kb < 2; ++kb) {
          if (2 * kb <= w) {
            union { uint2 h2[2]; bf16x8 v; } vf;
            vf.h2[0] = *reinterpret_cast<const uint2*>(VT + (et * 16 + fr) * LS + kb * 32 + 4 * g);
            vf.h2[1] = *reinterpret_cast<const uint2*>(VT + (et * 16 + fr) * LS + kb * 32 + 16 + 4 * g);
            o = __builtin_amdgcn_mfma_f32_16x16x32_bf16(vf.v, pfr[kb], o, 0, 0, 0);
          }
        }
#pragma unroll
        for (int ks = 0; ks < NKS; ++ks) {
          const bf16x8 sf = *reinterpret_cast<const bf16x8*>(ST + (et * 16 + fr) * SS + ks * 32 + g * 8);
          o = __builtin_amdgcn_mfma_f32_16x16x32_bf16(sf, qfr[ks], o, 0, 0, 0);
        }
        const float osc = MODE == 0 ? 1.0f : 0.10206207261596575f;
        *reinterpret_cast<uint2*>(OD + orow * 768 + ocol + et * 16 + 4 * g) =
            make_uint2(pack2(o[0] * osc, o[1] * osc), pack2(o[2] * osc, o[3] * osc));
      }
#pragma unroll
      for (int di = 0; di < 2; ++di) {
        const int dt = w + 4 * di;
        if (dt < NDT) {
#pragma unroll
          for (int et = 0; et < NET; ++et) {
            f32x4 r = f32x4{0.f, 0.f, 0.f, 0.f};
#pragma unroll
            for (int k2 = 0; k2 < 2; ++k2) {
              const bf16x8 vf = *reinterpret_cast<const bf16x8*>(VT + (et * 16 + fr) * LS + k2 * 32 + g * 8);
              const bf16x8 kf = *reinterpret_cast<const bf16x8*>(KaT + (dt * 16 + fr) * LS + k2 * 32 + g * 8);
              r = __builtin_amdgcn_mfma_f32_16x16x32_bf16(vf, kf, r, 0, 0, 0);
            }
#pragma unroll
            for (int j = 0; j < 4; ++j) S[et][di][j] = egv[di] * S[et][di][j] + egrv[di] * r[j];
          }
        }
      }
    }
    __syncthreads();
  }
}

struct GemmJob {
  const act_t* A; const act_t* Bt; act_t* C;
  long sA, sB, sC;
  int nbatch, Mtiles, Ntiles, K, ldc, Nvalid, mode;
  float scale;
  int fp8;
  int out8;
};
__device__ __forceinline__ void phase_gemm(const Params& p, const GemmJob& g, unsigned char* smem, int blk = blockIdx.x, int nblk = gridDim.x) {
  const int per_b = g.Mtiles * g.Ntiles;
  const int ntiles = per_b * g.nbatch;
  auto tvalid = [&](int t) -> bool {
    const int tt = t % per_b;
    const int tm = tt / g.Ntiles, tn = tt % g.Ntiles;
    return !(g.mode == 1 && tm < NC / 128 && tn * 128 >= O_FA);
  };
  auto tnext = [&](int t) -> int { t += nblk; while (t < ntiles && !tvalid(t)) t += nblk; return t; };
  int par = 0;
  bool primed = false;
  int tile0 = blk;
  if (tile0 < ntiles && !tvalid(tile0)) tile0 = tnext(tile0);
  for (int tile = tile0; tile < ntiles;) {
    const int ntile = tnext(tile);
    const int b = tile / per_b, tt = tile % per_b;
    const int tm = tt / g.Ntiles, tn = tt % g.Ntiles;
    const int tt2 = (ntile < ntiles ? ntile : tile) % per_b;
    const int tm2 = tt2 / g.Ntiles, tn2 = tt2 % g.Ntiles;
    const int K = g.K, ldc = g.ldc;
    const act_t* Ab = g.A + b * g.sA + (long)tm * 128 * K;
    act_t* Cb = g.C + b * g.sC + (long)tm * 128 * ldc + tn * 128;
    const int nlim = g.Nvalid - tn * 128;
    const float scale = g.scale;
    const int mode = g.mode;
    if (mode == 1) {
      auto epi1 = [&](f32x4 (&acc)[4][4], int wr, int wc, int fr, int fq) {
                  if (g.fp8) {
#pragma unroll
                    for (int m = 0; m < 4; ++m)
#pragma unroll
                      for (int n = 0; n < 4; ++n) acc[m][n] = acc[m][n] * scale;
                  }
#pragma unroll
                  for (int m = 0; m < 4; ++m)
#pragma unroll
                    for (int n = 0; n < 4; ++n) {
                      const int col = wc * 64 + n * 16 + fr;
                      if (col < nlim) {
#pragma unroll
                        for (int j = 0; j < 4; ++j) {
                          const int row = wr * 64 + m * 16 + fq * 4 + j;
                          stA(Cb + (long)row * ldc + col, acc[m][n][j]);
                        }
                      } else {
                        const int gc = tn * 128 + col;
                        if (gc < O_END && tm >= NC / 128) {
                          const int lr = (tm - NC / 128) * 128 + wr * 64 + m * 16 + fq * 4;
                          const int bb = lr / T, t = lr % T;
                          const int cq = gc < O_FB ? gc - O_FA : gc - O_FB;
                          act_t* dst = p.FT + ((long)bb * 256 + cq) * (2 * T) + (gc < O_FB ? 0 : T) + t;
                          *reinterpret_cast<uint2*>(dst) = make_uint2(pack2(acc[m][n][0], acc[m][n][1]), pack2(acc[m][n][2], acc[m][n][3]));
                        }
                      }
                    }
                };
      if (g.fp8) {
        const fp8_t* A8 = (const fp8_t*)g.A + (long)tm * 128 * K;
        gemm_tile8p<false>(A8, (const fp8_t*)g.Bt + (long)tn * 128 * K, ntile < ntiles, (const fp8_t*)g.A + (long)tm2 * 128 * K,
                           (const fp8_t*)g.Bt + (long)tn2 * 128 * K, par, primed, K, smem, epi1);
      } else {
        gemm_tile<false>([&](int r) { return Ab + (long)r * K; }, g.Bt + b * g.sB + (long)tn * 128 * K, K, smem, epi1);
      }
    } else {
      auto epi2 = [&](f32x4 (&acc)[4][4], int wr, int wc, int fr, int fq) {
                  const float oscale = g.fp8 ? 1.0f : scale;
                  if (g.fp8) {
#pragma unroll
                    for (int m = 0; m < 4; ++m)
#pragma unroll
                      for (int n = 0; n < 4; ++n) acc[m][n] = acc[m][n] * scale;
                  }
                  if (mode == 2) {
                    const int cb = tn * 128 + wc * 64;
                    if (cb < E_AV && tm >= NC / 128) {
                      const float4* rt = reinterpret_cast<const float4*>(p.ropetab);
#pragma unroll
                      for (int m = 0; m < 4; ++m) {
                        const int t = ((tm - NC / 128) * 128 + wr * 64 + m * 16 + fr) % T;
                        const float4 r01 = rt[(t / GRID_W) * 8 + fq * 2], r23 = rt[(t / GRID_W) * 8 + fq * 2 + 1];
                        const float4 c01 = rt[(t % GRID_W) * 8 + fq * 2], c23 = rt[(t % GRID_W) * 8 + fq * 2 + 1];
                        const float rc[4] = {r01.x, r01.z, r23.x, r23.z}, rs_[4] = {r01.y, r01.w, r23.y, r23.w};
                        const float cc[4] = {c01.x, c01.z, c23.x, c23.z}, cs_[4] = {c01.y, c01.w, c23.y, c23.w};
#pragma unroll
                        for (int j = 0; j < 4; ++j) {
                          const float a1 = acc[m][0][j], a2 = acc[m][1][j], b1 = acc[m][2][j], b2 = acc[m][3][j];
                          acc[m][0][j] = a1 * rc[j] - a2 * rs_[j]; acc[m][1][j] = a1 * rs_[j] + a2 * rc[j];
                          acc[m][2][j] = b1 * cc[j] - b2 * cs_[j]; acc[m][3][j] = b1 * cs_[j] + b2 * cc[j];
                        }
                      }
                    } else if (cb >= E_FF && cb < E_HQ) {
#pragma unroll
                      for (int n = 0; n < 4; ++n) {
                        const float4 lb4 = *reinterpret_cast<const float4*>(p.lbt + cb - E_FF + n * 16 + fq * 4);
                        const float lb[4] = {lb4.x, lb4.y, lb4.z, lb4.w};
#pragma unroll
                        for (int m = 0; m < 4; ++m)
#pragma unroll
                          for (int j = 0; j < 4; ++j)
                            acc[m][n][j] = __logf(lb[j] + (1.0f - lb[j]) / (1.0f + __expf(-acc[m][n][j])));
                      }
                    }
                  }
#pragma unroll
                  for (int m = 0; m < 4; ++m) {
                    const int row = wr * 64 + m * 16 + fr;
#pragma unroll
                    for (int n = 0; n < 4; ++n) {
                      const int col = wc * 64 + n * 16 + fq * 4;
                      if (col < nlim) {
                        if (g.out8)
                          *reinterpret_cast<unsigned*>(reinterpret_cast<fp8_t*>(g.C) + b * g.sC + ((long)tm * 128 + row) * ldc + tn * 128 + col) =
                              pack4_fp8(acc[m][n][0] * oscale, acc[m][n][1] * oscale, acc[m][n][2] * oscale, acc[m][n][3] * oscale);
                        else
                          *reinterpret_cast<uint2*>(Cb + (long)row * ldc + col) =
                              make_uint2(pack2(acc[m][n][0] * oscale, acc[m][n][1] * oscale), pack2(acc[m][n][2] * oscale, acc[m][n][3] * oscale));
                      }
                    }
                  }
                };
      if (g.fp8) {
        const fp8_t* A8 = (const fp8_t*)g.A + (long)tm * 128 * K;
        gemm_tile8p<true>(A8, (const fp8_t*)g.Bt + (long)tn * 128 * K, ntile < ntiles, (const fp8_t*)g.A + (long)tm2 * 128 * K,
                          (const fp8_t*)g.Bt + (long)tn2 * 128 * K, par, primed, K, smem, epi2);
      } else {
        gemm_tile<true>([&](int r) { return Ab + (long)r * K; }, g.Bt + b * g.sB + (long)tn * 128 * K, K, smem, epi2);
      }
    }
    tile = ntile;
  }
}

template <class RowMap>
__device__ __forceinline__ void conv_tile_rm(const float* src, int lds_, int Nvalid, int k0, int n0, act_t* dst, int ldd, float* tile, RowMap rm) {
  const int tid = threadIdx.x;
  {
    const int r = tid >> 5, c4 = (tid & 31) * 4;
    float4 v[8];
#pragma unroll
    for (int rr = 0; rr < 8; ++rr) {
      v[rr] = make_float4(0.f, 0.f, 0.f, 0.f);
      if (n0 + c4 < Nvalid) v[rr] = *reinterpret_cast<const float4*>(src + (long)(k0 + r + rr * 8) * lds_ + n0 + c4);
    }
#pragma unroll
    for (int rr = 0; rr < 8; ++rr) {
      float* t = tile + (r + rr * 8) * 129 + c4;
      t[0] = v[rr].x; t[1] = v[rr].y; t[2] = v[rr].z; t[3] = v[rr].w;
    }
  }
  __syncthreads();
  {
    const int n = tid >> 1, ks = (tid & 1) * 32;
    if (n0 + n < Nvalid) {
      unsigned w[16];
#pragma unroll
      for (int i = 0; i < 16; ++i) w[i] = pack2(tile[(ks + 2 * i) * 129 + n], tile[(ks + 2 * i + 1) * 129 + n]);
      uint4* d = reinterpret_cast<uint4*>(dst + (long)rm(n) * ldd + k0 + ks);
      d[0] = make_uint4(w[0], w[1], w[2], w[3]);
      d[1] = make_uint4(w[4], w[5], w[6], w[7]);
      d[2] = make_uint4(w[8], w[9], w[10], w[11]);
      d[3] = make_uint4(w[12], w[13], w[14], w[15]);
    }
  }
  __syncthreads();
}

template <class RowMap>
__device__ __forceinline__ void conv_tile8_rm(const float* src, int lds_, int k0, int n0, fp8_t* dst, int ldd, float* tile, float scale, RowMap rm, int Nvalid = 1 << 30) {
  const int tid = threadIdx.x;
  {
    const int r = tid >> 5, c4 = (tid & 31) * 4;
    float4 v[8];
#pragma unroll
    for (int rr = 0; rr < 8; ++rr) {
      v[rr] = make_float4(0.f, 0.f, 0.f, 0.f);
      if (n0 + c4 < Nvalid) v[rr] = *reinterpret_cast<const float4*>(src + (long)(k0 + r + rr * 8) * lds_ + n0 + c4);
    }
#pragma unroll
    for (int rr = 0; rr < 8; ++rr) {
      float* t = tile + (r + rr * 8) * 129 + c4;
      t[0] = v[rr].x; t[1] = v[rr].y; t[2] = v[rr].z; t[3] = v[rr].w;
    }
  }
  __syncthreads();
  if ((threadIdx.x >> 1) + n0 < Nvalid) {
    const int n = tid >> 1, ks = (tid & 1) * 32;
    unsigned w[8];
#pragma unroll
    for (int i = 0; i < 8; ++i)
      w[i] = pack4_fp8(tile[(ks + 4 * i) * 129 + n] * scale, tile[(ks + 4 * i + 1) * 129 + n] * scale,
                       tile[(ks + 4 * i + 2) * 129 + n] * scale, tile[(ks + 4 * i + 3) * 129 + n] * scale);
    uint4* d = reinterpret_cast<uint4*>(dst + (long)rm(n) * ldd + k0 + ks);
    d[0] = make_uint4(w[0], w[1], w[2], w[3]);
    d[1] = make_uint4(w[4], w[5], w[6], w[7]);
  }
  __syncthreads();
}

__device__ __forceinline__ void conv_tile(const float* src, int lds_, int Nvalid, int k0, int n0, act_t* dst, int ldd, float* tile) {
  conv_tile_rm(src, lds_, Nvalid, k0, n0, dst, ldd, tile, [=](int n) { return n0 + n; });
}

struct ConvJob { const float* src; fp8_t* dst; int lds, ldd, k0, n0, rbase, ra, rb; };
__device__ __forceinline__ void phase_convert_experts(const Params& p, int l, unsigned char* smem, int blk, int nblk) {
  float* tile = (float*)smem;
  const int per_e = 192, total = NEXP * per_e;
  fp8_t* Wup = l == 0 ? p.W8up : p.W8up1;
  fp8_t* Wdn = l == 0 ? p.W8down : p.W8down1;
  const int tid = threadIdx.x;
  auto mkjob = [&](int job) -> ConvJob {
    const int e = job / per_e, j = job % per_e;
    ConvJob c;
    if (j < 128) {
      const int up = j >> 6, jj = j & 63;
      const int kt = jj >> 2, fp = jj & 3;
      c.src = (up ? p.w_eu : p.w_eg) + ((long)(l * NEXP + e) * D) * DFF;
      c.dst = Wup + (long)e * 1024 * D; c.lds = DFF; c.ldd = D; c.k0 = kt * 64; c.n0 = fp * 128;
      c.rbase = fp * 256 + up * 32; c.ra = 128; c.rb = 64;
    } else {
      const int jj = j - 128;
      const int kt = jj >> 3, nt = jj & 7;
      c.src = p.w_ed + ((long)(l * NEXP + e) * DFF) * D;
      c.dst = Wdn + (long)e * 1024 * DFF; c.lds = D; c.ldd = DFF; c.k0 = kt * 64; c.n0 = nt * 128;
      c.rbase = nt * 128; c.ra = 64; c.rb = 32;
    }
    return c;
  };
  float4 v[8];
  auto ld = [&](const ConvJob& c) {
    const int r = tid >> 5, c4 = (tid & 31) * 4;
#pragma unroll
    for (int rr = 0; rr < 8; ++rr) v[rr] = *reinterpret_cast<const float4*>(c.src + (long)(c.k0 + r + rr * 8) * c.lds + c.n0 + c4);
  };
  int job = blk;
  if (job >= total) return;
  ConvJob cur = mkjob(job);
  ld(cur);
  while (job < total) {
    {
      const int r = tid >> 5, c4 = (tid & 31) * 4;
#pragma unroll
      for (int rr = 0; rr < 8; ++rr) {
        float* t = tile + (r + rr * 8) * 129 + c4;
        t[0] = v[rr].x; t[1] = v[rr].y; t[2] = v[rr].z; t[3] = v[rr].w;
      }
    }
    __syncthreads();
    const int nxt = job + nblk;
    const ConvJob nj = mkjob(min(nxt, total - 1));
    ld(nj);
    {
      const int n = tid >> 1, ks = (tid & 1) * 32;
      unsigned w[8];
#pragma unroll
      for (int i = 0; i < 8; ++i)
        w[i] = pack4_fp8(tile[(ks + 4 * i) * 129 + n] * SW8, tile[(ks + 4 * i + 1) * 129 + n] * SW8,
                         tile[(ks + 4 * i + 2) * 129 + n] * SW8, tile[(ks + 4 * i + 3) * 129 + n] * SW8);
      const int row = cur.rbase + (n >> 6) * cur.ra + ((n >> 5) & 1) * cur.rb + (n & 31);
      uint4* d = reinterpret_cast<uint4*>(cur.dst + (long)row * cur.ldd + cur.k0 + ks);
      d[0] = make_uint4(w[0], w[1], w[2], w[3]);
      d[1] = make_uint4(w[4], w[5], w[6], w[7]);
    }
    __syncthreads();
    cur = nj;
    job = nxt;
  }
}

__device__ __forceinline__ void phase_moe(const Params& p, int l, bool down, unsigned char* smem) {
  const int* cntp = p.cnt + l * NEXP * 64;
  int total = 0;
  for (int e = 0; e < NEXP; ++e) total += ((cntp[e * 64] + 127) >> 7) * 8;
  for (int tile = blockIdx.x; tile < total; tile += gridDim.x) {
    int e = 0, tb = 0, rowoff = 0;
    for (; e < NEXP - 1; ++e) {
      const int c = cntp[e * 64];
      const int nt = ((c + 127) >> 7) * 8;
      if (tile < tb + nt) break;
      tb += nt; rowoff += c;
    }
    const int c = cntp[e * 64];
    const int lt = tile - tb, mt = lt >> 3, nt = lt & 7;
    const int rows_valid = min(128, c - mt * 128);
    const int* lst = p.list + (long)(l * NEXP + e) * NR + mt * 128;
    const long hrow0 = (long)rowoff + mt * 128;
    if (!down) {
      gemm_tile8<true>([&](int r) { return p.u8 + (long)(lst[min(r, rows_valid - 1)] >> 1) * D; },
                (l == 0 ? p.W8up : p.W8up1) + ((long)e * 1024 + nt * 128) * D, D, smem,
                [&](f32x4 (&acc)[4][4], int wr, int wc, int fr, int fq) {
                  constexpr float dq = 1.0f / (SU8 * SW8);
#pragma unroll
                  for (int m = 0; m < 4; ++m) {
                    const int row = wr * 64 + m * 16 + fr;
                    if (row < rows_valid) {
#pragma unroll
                      for (int n = 0; n < 2; ++n) {
                        float hv[4];
#pragma unroll
                        for (int j = 0; j < 4; ++j) {
                          const float g = acc[m][n][j] * dq, uu = acc[m][n + 2][j] * dq;
                          hv[j] = g / (1.0f + __expf(-g)) * uu * SH8;
                        }
                        *reinterpret_cast<unsigned*>(p.H8 + (hrow0 + row) * DFF + nt * 64 + wc * 32 + n * 16 + fq * 4) =
                            pack4_fp8(hv[0], hv[1], hv[2], hv[3]);
                      }
                    }
                  }
                });
    } else {
      const fp8_t* Ab = p.H8 + hrow0 * DFF;
      gemm_tile8<true>([&](int r) { return Ab + (long)r * DFF; }, (l == 0 ? p.W8down : p.W8down1) + ((long)e * 1024 + nt * 128) * DFF, DFF, smem,
                [&](f32x4 (&acc)[4][4], int wr, int wc, int fr, int fq) {
                  constexpr float dq = 1.0f / (SH8 * SW8);
#pragma unroll
                  for (int m = 0; m < 4; ++m) {
                    const int row = wr * 64 + m * 16 + fr;
                    if (row < rows_valid) {
                      const int ts = lst[row];
                      const float w = p.ew[ts] * dq;
#pragma unroll
                      for (int n = 0; n < 4; ++n)
                        *reinterpret_cast<uint2*>(p.Y + (long)ts * D + nt * 128 + wc * 64 + n * 16 + fq * 4) =
                            make_uint2(pack2(acc[m][n][0] * w, acc[m][n][1] * w), pack2(acc[m][n][2] * w, acc[m][n][3] * w));
                    }
                  }
                });
    }
  }
}

__device__ __forceinline__ void phase_convert_dense(const Params& p, unsigned char* smem) {
  float* tile = (float*)smem;
  const int JM = MOD_ITEMS, J0 = JM + 16 * 26, J1 = J0 + 128, J2 = J1 + 16 * 19, J3 = J2 + 128;
  for (int job = blockIdx.x; job < J3; job += gridDim.x) {
    if (job < JM) { mod_item(p, job, smem); continue; }
    if (job < J0) { int j = job - JM; const int n0 = (j % 26) * 128; conv_tile8_rm(p.w_in_even, IN_EVEN, (j / 26) * 64, n0, p.W8in_even, D, tile, SW8, [=](int n) { return n0 + n; }); }
    else if (job < J1) { int j = job - J0; const int n0 = (j % 8) * 128; conv_tile8_rm(p.w_out_even, D, (j / 8) * 64, n0, p.W8out_even, D, tile, SW8, [=](int n) { return n0 + n; }); }
    else if (job < J2) { int j = job - J1; const int n0 = (j % 19) * 128; conv_tile8_rm(p.w_in_odd, IN_ODD, (j / 19) * 64, n0, p.W8in_odd, D, tile, SW8, [=](int n) { return n0 + n; }, O_FA); }
    else { int j = job - J2; const int n0 = (j % 8) * 128; conv_tile8_rm(p.w_out_odd, D, (j / 8) * 64, n0, p.W8out_odd, D, tile, SW8, [=](int n) { return n0 + n; }); }
  }
}

__device__ __forceinline__ void phase_fold_z(const Params& p, long gtid, long gstride, float* tab) {
  if (threadIdx.x < 64) {
    float sn, cs;
    sincospif((float)threadIdx.x * (1.0f / 32.0f), &sn, &cs);
    tab[threadIdx.x] = cs; tab[64 + threadIdx.x] = -sn;
  }
  __syncthreads();
  for (long i = gtid; i < (long)512 * D; i += gstride) {
    const int k = (int)(i % D), np = (int)(i / D);
    const int part = np >> 8, col = np & 255, g = col >> 6, cp = col & 63;
    const float* wz = p.w_in_odd + (long)k * IN_ODD + O_Z + g * 64;
    float s = 0.f;
    const float* tb = tab + part * 64;
    float4 wv[16];
#pragma unroll
    for (int q = 0; q < 16; ++q) wv[q] = reinterpret_cast<const float4*>(wz)[q];
#pragma unroll
    for (int q = 0; q < 16; ++q) {
      s += wv[q].x * tb[((4 * q) * cp) & 63] + wv[q].y * tb[((4 * q + 1) * cp) & 63] + wv[q].z * tb[((4 * q + 2) * cp) & 63] +
           wv[q].w * tb[((4 * q + 3) * cp) & 63];
    }
    const unsigned q = pack4_fp8(s * SW8, 0.f, 0.f, 0.f);
    p.W8in_odd[(long)(O_FA + np) * D + k] = (unsigned char)(q & 0xffu);
  }
  for (long i = gtid; i < (long)(IN_ODD_PAD - O_END) * D; i += gstride) p.W8in_odd[(long)O_END * D + i] = 0;
}

__device__ __forceinline__ void phase_cmat(const Params& p, long gtid, long gstride) {
  for (long i = gtid; i < (long)T * T; i += gstride) {
    const int t = (int)(i % T), tp = (int)(i / T);
    float sn, cs;
    sincospif((float)((t * tp) & (T - 1)) * (2.0f / T), &sn, &cs);
    stA(p.Cmat + (long)tp * 2 * T + t, cs);
    stA(p.Cmat + (long)tp * 2 * T + T + t, sn);
  }
}

__device__ __forceinline__ void row_stats(const float4 (&v)[4], float& mu, float& rs) {
  float s = 0.f;
#pragma unroll
  for (int i = 0; i < 4; ++i) s += v[i].x + v[i].y + v[i].z + v[i].w;
  mu = wave_sum(s) * (1.0f / D);
  float q = 0.f;
#pragma unroll
  for (int i = 0; i < 4; ++i) {
    float a = v[i].x - mu, b = v[i].y - mu, c = v[i].z - mu, d = v[i].w - mu;
    q += a * a + b * b + c * c + d * d;
  }
  rs = 1.0f / sqrtf(wave_sum(q) * (1.0f / D) + LN_EPS);
}

__device__ __forceinline__ void phase_lnmod_first(const Params& p) {
  const int lane = threadIdx.x & 63;
  const int nw = (int)gridDim.x * 4, wi = (int)blockIdx.x * 4 + (int)(threadIdx.x >> 6);
  const int rpw = (NR + nw - 1) / nw;
  const long r0 = (long)wi * rpw, r1 = min((long)NR, r0 + rpw);
  float4 shv[4], scv[4];
  int cur_bb = -2;
  float4 hv[4];
  auto load_row = [&](long row) {
    const float4* h = reinterpret_cast<const float4*>(hrow_in(p, row));
#pragma unroll
    for (int i = 0; i < 4; ++i) hv[i] = h[i * 64 + lane];
  };
  if (r0 < r1) load_row(r0);
  for (long row = r0; row < r1; ++row) {
    const int bb = row < NC ? NB : (int)((row - NC) / T);
    if (bb != cur_bb) {
      cur_bb = bb;
      const float* md = p.mod + (long)bb * 6 * D;
#pragma unroll
      for (int i = 0; i < 4; ++i) {
        shv[i] = reinterpret_cast<const float4*>(md)[i * 64 + lane];
        scv[i] = reinterpret_cast<const float4*>(md + D)[i * 64 + lane];
      }
    }
    float4 v[4];
#pragma unroll
    for (int i = 0; i < 4; ++i) v[i] = hv[i];
    load_row(min(row + 1, r1 - 1));
    float mu, rs;
    row_stats(v, mu, rs);
#pragma unroll
    for (int i = 0; i < 4; ++i) {
      const float a = (v[i].x - mu) * rs * (1.f + scv[i].x) + shv[i].x, b = (v[i].y - mu) * rs * (1.f + scv[i].y) + shv[i].y;
      const float c = (v[i].z - mu) * rs * (1.f + scv[i].z) + shv[i].z, d = (v[i].w - mu) * rs * (1.f + scv[i].w) + shv[i].w;
      reinterpret_cast<unsigned*>(p.u8 + row * D)[i * 64 + lane] = pack4_fp8(a * SU8, b * SU8, c * SU8, d * SU8);
    }
  }
}

__device__ __forceinline__ act_t* hrow16(const Params& p, long row) {
  return row < NC ? reinterpret_cast<act_t*>(p.hc) + row * D
                  : reinterpret_cast<act_t*>(reinterpret_cast<char*>(p.out) + (row - NC) * (long)(4 * D) + 2 * D);
}
template <int R_UNUSED>
__device__ __forceinline__ void phase_resid_ln(const Params& p, int l, int sub, long row_lo, long row_hi, unsigned char* smem) {
  const int lane = threadIdx.x & 63;
  int* cntL = (int*)smem;
  int* nent = cntL + 16;
  int* entL = cntL + 32;
  float* wT = (float*)(smem + 4096);
  if (sub == 0) {
    if (threadIdx.x < 32) cntL[threadIdx.x] = 0;
    {
      float4 wr4[16];
#pragma unroll
      for (int j = 0; j < 4; ++j)
#pragma unroll
        for (int q = 0; q < 4; ++q) wr4[j * 4 + q] = reinterpret_cast<const float4*>(p.w_router + (long)(threadIdx.x + 256 * j) * NEXP)[q];
#pragma unroll
      for (int j = 0; j < 4; ++j)
#pragma unroll
        for (int q = 0; q < 4; ++q) {
          const int k = threadIdx.x + 256 * j;
          wT[(q * 4 + 0) * D + k] = wr4[j * 4 + q].x; wT[(q * 4 + 1) * D + k] = wr4[j * 4 + q].y;
          wT[(q * 4 + 2) * D + k] = wr4[j * 4 + q].z; wT[(q * 4 + 3) * D + k] = wr4[j * 4 + q].w;
        }
    }
    __syncthreads();
  }
  const bool last = (sub == 1 && l == 1);
  const int nw = (int)gridDim.x * 4, wi = (int)blockIdx.x * 4 + (int)(threadIdx.x >> 6);
  const int rpw = ((int)(row_hi - row_lo) + nw - 1) / nw;
  const long r0 = row_lo + (long)wi * rpw, r1 = min(row_hi, r0 + rpw);
  const float4* lgp = reinterpret_cast<const float4*>(p.ln_g + (l * 2 + sub) * D);
  const float4* lbp = reinterpret_cast<const float4*>(p.ln_b + (l * 2 + sub) * D);
  float4 lgv[4], lbv[4];
  if (R_UNUSED != 1) {
#pragma unroll
    for (int i = 0; i < 4; ++i) { lgv[i] = lgp[i * 64 + lane]; lbv[i] = lbp[i * 64 + lane]; }
  }
  float4 gv[4], shv[4], scv[4];
  int cur_bb = -2;
  const bool first = (l == 0 && sub == 0);
  float4 hv[4];
  uint2 hb[4];
  uint2 mv[4], m2v[4];
  auto load_row = [&](long row) {
    const uint2* m = reinterpret_cast<const uint2*>(sub == 0 ? p.M + row * D : p.Y + row * 2 * D);
    if (first) {
      const float4* hin = reinterpret_cast<const float4*>(hrow_in(p, row));
#pragma unroll
      for (int i = 0; i < 4; ++i) hv[i] = hin[i * 64 + lane];
    } else {
      const uint2* hin = reinterpret_cast<const uint2*>(hrow16(p, row));
#pragma unroll
      for (int i = 0; i < 4; ++i) hb[i] = hin[i * 64 + lane];
    }
#pragma unroll
    for (int i = 0; i < 4; ++i) {
      mv[i] = m[i * 64 + lane];
      if (sub == 1) m2v[i] = m[256 + i * 64 + lane];
    }
  };
  if (r0 < r1) load_row(r0);
  for (long row = r0; row < r1; ++row) {
    const int bb = row < NC ? NB : (int)((row - NC) / T);
    if (bb != cur_bb) {
      cur_bb = bb;
      const float* md = p.mod + ((long)l * (NB + 1) + bb) * 6 * D;
      const float* md2 = (sub == 0) ? md + 3 * D : p.mod + ((long)(NB + 1) + bb) * 6 * D;
#pragma unroll
      for (int i = 0; i < 4; ++i) {
        gv[i] = reinterpret_cast<const float4*>(md + (sub == 0 ? 2 : 5) * D)[i * 64 + lane];
        shv[i] = reinterpret_cast<const float4*>(md2)[i * 64 + lane];
        scv[i] = reinterpret_cast<const float4*>(md2 + D)[i * 64 + lane];
      }
    }
    float4 v[4];
#pragma unroll
    for (int i = 0; i < 4; ++i) {
      float m0 = bf_lo(mv[i].x), m1 = bf_hi(mv[i].x), m2_ = bf_lo(mv[i].y), m3 = bf_hi(mv[i].y);
      if (sub == 1) { m0 += bf_lo(m2v[i].x); m1 += bf_hi(m2v[i].x); m2_ += bf_lo(m2v[i].y); m3 += bf_hi(m2v[i].y); }
      const float h0 = first ? hv[i].x : bf_lo(hb[i].x), h1 = first ? hv[i].y : bf_hi(hb[i].x);
      const float h2 = first ? hv[i].z : bf_lo(hb[i].y), h3 = first ? hv[i].w : bf_hi(hb[i].y);
      v[i].x = ALPHA * h0 + gv[i].x * m0;
      v[i].y = ALPHA * h1 + gv[i].y * m1;
      v[i].z = ALPHA * h2 + gv[i].z * m2_;
      v[i].w = ALPHA * h3 + gv[i].w * m3;
    }
    load_row(min(row + 1, r1 - 1));
    if (R_UNUSED == 1) {
#pragma unroll
      for (int i = 0; i < 4; ++i) { lgv[i] = lgp[i * 64 + lane]; lbv[i] = lbp[i * 64 + lane]; }
    }
    float mu, rs;
    row_stats(v, mu, rs);
#pragma unroll
    for (int i = 0; i < 4; ++i) {
      v[i].x = (v[i].x - mu) * rs * lgv[i].x + lbv[i].x;
      v[i].y = (v[i].y - mu) * rs * lgv[i].y + lbv[i].y;
      v[i].z = (v[i].z - mu) * rs * lgv[i].z + lbv[i].z;
      v[i].w = (v[i].w - mu) * rs * lgv[i].w + lbv[i].w;
    }
    if (last) {
      float4* hout = reinterpret_cast<float4*>(p.out + (row - NC) * D);
#pragma unroll
      for (int i = 0; i < 4; ++i) hout[i * 64 + lane] = v[i];
      continue;
    }
    uint2 hq[4];
#pragma unroll
    for (int i = 0; i < 4; ++i) {
      hq[i] = make_uint2(pack2(v[i].x, v[i].y), pack2(v[i].z, v[i].w));
      v[i].x = bf_lo(hq[i].x); v[i].y = bf_hi(hq[i].x); v[i].z = bf_lo(hq[i].y); v[i].w = bf_hi(hq[i].y);
    }
    row_stats(v, mu, rs);
    float lo[NEXP];
#pragma unroll
    for (int e = 0; e < NEXP; ++e) lo[e] = 0.f;
    uint2 up[4];
#pragma unroll
    for (int i = 0; i < 4; ++i) {
      float uv[4];
      uv[0] = (v[i].x - mu) * rs * (1.f + scv[i].x) + shv[i].x;
      uv[1] = (v[i].y - mu) * rs * (1.f + scv[i].y) + shv[i].y;
      uv[2] = (v[i].z - mu) * rs * (1.f + scv[i].z) + shv[i].z;
      uv[3] = (v[i].w - mu) * rs * (1.f + scv[i].w) + shv[i].w;
      up[i] = make_uint2(pack4_fp8(uv[0] * SU8, uv[1] * SU8, uv[2] * SU8, uv[3] * SU8), 0u);
      if (sub == 0) {
#pragma unroll
        for (int e = 0; e < NEXP; ++e) {
          const float4 w4 = *reinterpret_cast<const float4*>(wT + e * D + (i * 64 + lane) * 4);
          lo[e] += uv[0] * w4.x + uv[1] * w4.y + uv[2] * w4.z + uv[3] * w4.w;
          if ((e & 3) == 3) __builtin_amdgcn_sched_barrier(0);
        }
      }
    }
    int ge1 = 0, ge2 = 0;
    float w1 = 0.f, w2 = 0.f;
    if (sub == 0) {
      float mine = 0.f;
#pragma unroll
      for (int e = 0; e < NEXP; ++e) {
        const float rsum = row_sum16(lo[e]);
        mine = ((lane & 15) == e) ? rsum : mine;
      }
      mine += __shfl_xor(mine, 16);
      mine += __shfl_xor(mine, 32);
#pragma unroll
      for (int e = 0; e < NEXP; ++e) lo[e] = __int_as_float(__builtin_amdgcn_readlane(__float_as_int(mine), e));
      float mx = lo[0];
#pragma unroll
      for (int e = 1; e < NEXP; ++e) mx = fmaxf(mx, lo[e]);
      float sum = 0.f;
#pragma unroll
      for (int e = 0; e < NEXP; ++e) { lo[e] = __expf(lo[e] - mx); sum += lo[e]; }
      const float inv = 1.0f / sum;
      float bestg = -1e30f, gp1 = 0.f, gp2 = 0.f;
#pragma unroll
      for (int gq = 0; gq < 4; ++gq) {
        float s1 = -1e30f, s2 = -1e30f, p1 = 0.f, p2 = 0.f;
        int e1 = 0, e2 = 0;
#pragma unroll
        for (int j = 0; j < 4; ++j) {
          const int e = gq * 4 + j;
          const float pe = lo[e] * inv;
          const float se = pe + p.b_router[e];
          if (se > s1) { s2 = s1; p2 = p1; e2 = e1; s1 = se; p1 = pe; e1 = e; }
          else if (se > s2) { s2 = se; p2 = pe; e2 = e; }
        }
        const float gs = s1 + s2;
        if (gs > bestg) { bestg = gs; ge1 = e1; ge2 = e2; gp1 = p1; gp2 = p2; }
      }
      const float wsum = gp1 + gp2;
      w1 = gp1 / wsum; w2 = gp2 / wsum;
    }
    {
      uint2* hout = reinterpret_cast<uint2*>(hrow16(p, row));
#pragma unroll
      for (int i = 0; i < 4; ++i) hout[i * 64 + lane] = hq[i];
    }
#pragma unroll
    for (int i = 0; i < 4; ++i) reinterpret_cast<unsigned*>(p.u8 + row * D)[i * 64 + lane] = up[i].x;
    if (sub == 0 && lane == 0) {
      p.ew[row * 2 + 0] = w1; p.ew[row * 2 + 1] = w2;
      const int lp1 = atomicAdd(cntL + ge1, 1), lp2 = atomicAdd(cntL + ge2, 1);
      const int ei = atomicAdd(nent, 2);
      entL[2 * ei] = ((int)(row * 2) << 4) | ge1; entL[2 * ei + 1] = lp1;
      entL[2 * ei + 2] = ((int)(row * 2 + 1) << 4) | ge2; entL[2 * ei + 3] = lp2;
    }
  }
  if (sub == 0) {
    __syncthreads();
    if (threadIdx.x < NEXP) {
      const int c = cntL[threadIdx.x];
      cntL[threadIdx.x] = c ? atomicAdd(p.cnt + (l * NEXP + threadIdx.x) * 64, c) : 0;
    }
    __syncthreads();
    const int ne = *nent;
    for (int i = threadIdx.x; i < ne; i += 256) {
      const int key = entL[2 * i], lp = entL[2 * i + 1];
      const int e = key & 15;
      p.list[(long)(l * NEXP + e) * NR + cntL[e] + lp] = key >> 4;
    }
    __syncthreads();
  }
}

#define LOOP(n) for (long i = gtid; i < (long)(n); i += gstride)

#ifdef ONLY_PHASE
#define PH(n, ...) if (ONLY_PHASE == n) { __VA_ARGS__ }
#define GSYNC()
#else
#define PH(n, ...) { __VA_ARGS__ }
#define GSYNC() xcd_barrier(xb)
#endif

__global__ void __launch_bounds__(256, 2) mega_kernel(Params p) {
  cg::grid_group grid = cg::this_grid();
  __shared__ __attribute__((aligned(16))) unsigned char smem[SMEM_BYTES + 16];
  if (threadIdx.x == 0) *reinterpret_cast<uint4*>(smem + SMEM_BYTES) = make_uint4(0u, 0u, 0u, 0u);
  __syncthreads();
  XcdBarrier xb = xcd_barrier_post(p.bar, (volatile LAS unsigned*)(smem + SMEM_BYTES));
  const long gtid = (long)blockIdx.x * blockDim.x + threadIdx.x;
  const long gstride = (long)gridDim.x * blockDim.x;
  const int nsb = min(256, (int)gridDim.x / 2);
  PH(0,
    if (gtid < 2 * NEXP) p.cnt[gtid * 64] = 0;
    phase_convert_dense(p, smem);
    phase_fold_z(p, gtid, gstride, (float*)(smem + 65536));
    LOOP(1024) ph_tables(p, i);)
#ifndef ONLY_PHASE
  if (p.use_cg_sync) grid.sync();
#endif
  GSYNC();
  PH(1, phase_lnmod_first(p);)
  GSYNC();
  PH(2, phase_gemm(p, GemmJob{(const act_t*)p.u8, (const act_t*)p.W8in_even, p.P, 0, 0, 0, 1, NR / 128, IN_EVEN / 128, D, PW, IN_EVEN, 2, 1.0f / (SU8 * SW8), 1, 0}, smem);)
  GSYNC();
  PH(3,
    if ((int)blockIdx.x < nsb) phase_scan<0>(p, smem, blockIdx.x, nsb);
    else phase_attn(p, smem, blockIdx.x - nsb, gridDim.x - nsb);)
  GSYNC();
  PH(4, phase_combine<0>(p);)
  GSYNC();
  PH(5,
    phase_gemm(p, GemmJob{(const act_t*)p.O8, (const act_t*)p.W8out_even, p.M, 0, 0, 0, 1, NR / 128, D / 128, D, D, D, 0, 1.0f / (SO8 * SW8), 1, 0}, smem);
    {
      const int rem = ((NR / 128) * (D / 128)) % (int)gridDim.x;
      if (rem > 0 && rem < (int)gridDim.x) { if ((int)blockIdx.x >= rem) phase_convert_experts(p, 0, smem, blockIdx.x - rem, gridDim.x - rem); }
      else phase_convert_experts(p, 0, smem, blockIdx.x, gridDim.x);
    })
  GSYNC();
  PH(6, phase_resid_ln<1>(p, 0, 0, 0, NR, smem);)
  GSYNC();
  PH(7, phase_moe(p, 0, false, smem);)
  GSYNC();
  PH(8, phase_moe(p, 0, true, smem);)
  GSYNC();
  PH(9, phase_resid_ln<2>(p, 0, 1, 0, NR, smem); phase_cmat(p, gtid, gstride);)
  GSYNC();
  PH(10, phase_gemm(p, GemmJob{(const act_t*)p.u8, (const act_t*)p.W8in_odd, p.P, 0, 0, 0, 1, NR / 128, IN_ODD_PAD / 128, D, PW, O_FA, 1, 1.0f / (SU8 * SW8), 1, 0}, smem);)
  GSYNC();
  PH(11, phase_gla_decay(p);)
  GSYNC();
  PH(12,
    if ((int)blockIdx.x < nsb) phase_scan<1>(p, smem, blockIdx.x, nsb);
    else {
      phase_gemm(p, GemmJob{p.Cmat, p.FT, (act_t*)(p.O8 + (long)NC * D + 768), 0, (long)256 * 2 * T, (long)T * D, NB, T / 128, 2, 2 * T, D,
                            256, 0, 0.00276213586400995f * SO8, 0, 1}, smem, blockIdx.x - nsb, gridDim.x - nsb);
      phase_convert_experts(p, 1, smem, blockIdx.x - nsb, gridDim.x - nsb);
    })
  GSYNC();
  PH(13, phase_combine<1>(p);)
  GSYNC();
  PH(14,
    phase_gemm(p, GemmJob{(const act_t*)(p.O8 + (long)NC * D), (const act_t*)p.W8out_odd, p.M + (long)NC * D, 0, 0, 0, 1, NT / 128, D / 128, D, D, D, 0, 1.0f / (SO8 * SW8), 1, 0}, smem);)
  GSYNC();
  PH(15, phase_resid_ln<1>(p, 1, 0, NC, NR, smem);)
  GSYNC();
  PH(16, phase_moe(p, 1, false, smem);)
  GSYNC();
  PH(17, phase_moe(p, 1, true, smem);)
  GSYNC();
  PH(18, phase_resid_ln<2>(p, 1, 1, NC, NR, smem);)
}

static size_t carve(Params& p, char* ws) {
  size_t off = 0;
  auto take = [&](size_t bytes) { char* r = ws + off; off += (bytes + 255) & ~(size_t)255; return r; };
  p.mod = (float*)take(sizeof(float) * 2 * (NB + 1) * 6 * D);
  p.hc = (float*)take(sizeof(float) * (size_t)NC * D);
  p.costab = (float*)take(sizeof(float) * T);
  p.sintab = (float*)take(sizeof(float) * T);
  p.lbt = (float*)take(sizeof(float) * 1024);
  p.ropetab = (float*)take(sizeof(float) * 64 * 16 * 2);
  p.ew = (float*)take(sizeof(float) * (size_t)NR * 2);
  p.eidx = nullptr;
  p.u = nullptr;
  p.O8 = (unsigned char*)take((size_t)NR * D);
  p.P = (act_t*)take(sizeof(act_t) * (size_t)NR * PW);
  p.OF = (act_t*)take(sizeof(act_t) * (size_t)NR * 768);
  p.OB = (act_t*)take(sizeof(act_t) * (size_t)NR * 768);
  p.M = p.OF;
  p.Cmat = (act_t*)take(sizeof(act_t) * (size_t)T * 2 * T);
  p.FT = (act_t*)take(sizeof(act_t) * (size_t)NB * 256 * 2 * T);
  p.LF = (act_t*)take(sizeof(act_t) * (size_t)2 * NR * 384);
  p.W8up = (unsigned char*)p.Cmat;
  p.W8down = p.W8up + (size_t)NEXP * 1024 * D;
  p.W8up1 = (unsigned char*)take((size_t)NEXP * 1024 * (D + DFF));
  p.W8down1 = p.W8up1 + (size_t)NEXP * 1024 * D;
  p.u8 = (unsigned char*)take((size_t)NR * D);
  p.Y = p.P;
  p.H8 = (unsigned char*)(p.P + (size_t)2 * NR * D);
  p.bar = (unsigned*)take(sizeof(unsigned) * XCD_BAR_WORDS);
  p.cnt = (int*)take(sizeof(int) * 2 * NEXP * 64);
  p.list = (int*)take(sizeof(int) * (size_t)2 * NEXP * NR);
  p.Wt_in_even = nullptr;
  p.W8in_even = (unsigned char*)take((size_t)IN_EVEN * D);
  p.Wt_out_even = nullptr;
  p.W8out_even = (unsigned char*)take((size_t)D * D);
  p.Wt_in_odd = nullptr;
  p.W8in_odd = (unsigned char*)take((size_t)IN_ODD_PAD * D);
  p.Wt_out_odd = nullptr;
  p.W8out_odd = (unsigned char*)take((size_t)D * D);
  return off;
}

static void fill_inputs(Params& p, void* const* d_in) {
  const float** f = (const float**)&p;
  for (int i = 0; i < 23; ++i) f[i] = (const float*)d_in[i];
}

extern "C" void kernel_launch(void* const* d_in, const int* in_sizes, int n_in, void* d_out, int out_size,
                              void* d_ws, size_t ws_size, hipStream_t stream) {
  static int grid_blocks = 0;
  if (!grid_blocks) {
    int dev = 0, cus = 0, per_cu = 0;
    (void)hipGetDevice(&dev);
    (void)hipDeviceGetAttribute(&cus, hipDeviceAttributeMultiprocessorCount, dev);
    (void)hipOccupancyMaxActiveBlocksPerMultiprocessor(&per_cu, mega_kernel, 256, 0);
    grid_blocks = cus * per_cu;
  }
  Params p{};
  fill_inputs(p, d_in);
  p.out = (float*)d_out;
  size_t need = carve(p, (char*)d_ws);
  if (need > ws_size) { fprintf(stderr, "workspace too small: need %zu have %zu\n", need, ws_size); return; }
  (void)hipMemsetAsync(p.bar, 0, sizeof(unsigned) * XCD_BAR_WORDS, stream);
  void* args[] = {&p};
  hipError_t e = hipLaunchCooperativeKernel((void*)mega_kernel, dim3(grid_blocks), dim3(256), args, 0, stream);
  if (e != hipSuccess) fprintf(stderr, "cooperative launch failed: %s (grid %d)\n", hipGetErrorString(e), grid_blocks);
}
#endif
```

```cpp
#ifndef HOST_TEST
#include <hip/hip_runtime.h>
#include <hip/hip_cooperative_groups.h>
#include <cstdio>
namespace cg = cooperative_groups;
#define DEV __device__ __forceinline__
#else
#include <cmath>
#include <cstdio>
#include <cstdlib>
#include <cstring>
#define DEV static inline
#endif

#ifndef T_BATCH
#define T_BATCH 8
#endif
#ifndef T_SEQ
#define T_SEQ 2048
#endif
#ifndef T_CTX
#define T_CTX 256
#endif

constexpr int D = 1024, NB = T_BATCH, T = T_SEQ, C = T_CTX;
constexpr int NC = NB * C, NT = NB * T, NR = NC + NT;
constexpr int GRID_W = 64;
constexpr int IN_EVEN = 3328, IN_ODD = 2592, PW = 3328;
constexpr int NEXP = 16, DFF = 512;
constexpr float ALPHA = 1.4142135623730951f;
constexpr float LN_EPS = 1e-5f;
constexpr int E_AQ = 0, E_AK = 512, E_AV = 640, E_FF = 768, E_HQ = 1792, E_HI = 2304, E_HG = 2816;
constexpr int O_Q = 0, O_K = 384, O_V = 768, O_RF = 1536, O_G = 1568, O_Z = 2336;

#ifdef HOST_TEST
typedef float act_t;
DEV float ldA(const act_t* p) { return *p; }
DEV void stA(act_t* p, float v) { *p = v; }
#else
typedef unsigned short act_t;
DEV float ldA(const act_t* p) { return __uint_as_float(((unsigned)*p) << 16); }
DEV void stA(act_t* p, float v) {
  unsigned u = __float_as_uint(v);
  u += 0x7fffu + ((u >> 16) & 1u);
  *p = (unsigned short)(u >> 16);
}
#endif

struct Params {
  const float *x, *c, *ctx, *c_ctx, *w_ada, *b_ada, *ln_g, *ln_b, *w_in_even, *attn_sink, *lb_logits, *hgrn_norm,
      *w_out_even, *w_in_odd, *gla_gate_w, *gla_gate_b, *gla_norm, *w_out_odd, *w_router, *b_router, *w_eg, *w_eu,
      *w_ed;
  float* out;
  float *mod, *hc, *costab, *sintab, *lbt, *ew, *ropetab;
  int* eidx;
  act_t *u, *P, *OF, *OB, *M, *LF;
  act_t *Wt_in_even, *Wt_out_even, *Wt_in_odd, *Wt_out_odd;
  act_t *Y, *Cmat, *FT;
  unsigned char *W8up, *W8down, *W8up1, *W8down1, *H8, *u8;
  unsigned char *W8in_even, *W8in_odd;
  unsigned char *W8out_even, *W8out_odd, *O8;
  int *cnt, *list;
  unsigned* bar;
  int use_cg_sync;
  int pad_;
};

DEV float sigmoidf_(float v) { return 1.0f / (1.0f + expf(-v)); }
DEV float siluf_(float v) { return v / (1.0f + expf(-v)); }

DEV const float* hrow_in(const Params& p, long row) {
  return row < NC ? p.ctx + row * D : p.x + (row - NC) * D;
}
DEV float* hrow(const Params& p, long row) { return row < NC ? p.hc + row * D : p.out + (row - NC) * D; }
DEV const float* modrow(const Params& p, int l, long row) {
  int bb = row < NC ? NB : (int)((row - NC) / T);
  return p.mod + ((long)l * (NB + 1) + bb) * 6 * D;
}

DEV void ph_mod(const Params& p, long i) {
  int j = (int)(i % (6 * D));
  int bb = (int)((i / (6 * D)) % (NB + 1));
  int l = (int)(i / ((long)6 * D * (NB + 1)));
  const float* cv = bb < NB ? p.c + (long)bb * D : p.c_ctx;
  const float* w = p.w_ada + (long)l * D * 6 * D + j;
  float s = p.b_ada[l * 6 * D + j];
  for (int k = 0; k < D; ++k) s += siluf_(cv[k]) * w[(long)k * 6 * D];
  p.mod[i] = s;
}

DEV void ph_tables(const Params& p, long i) {
  if (i < 1024) {
    int pos = (int)(i >> 4), idx = (int)(i & 15);
    float ang = (float)pos * powf(10000.0f, -(float)idx / 16.0f);
    p.ropetab[2 * i] = cosf(ang);
    p.ropetab[2 * i + 1] = sinf(ang);
  }
  if (i < 1024) {
    int dir = (int)(i / 512), col = (int)(i % 512);
    float l0 = p.lb_logits[(dir * 2 + 0) * 512 + col], l1 = p.lb_logits[(dir * 2 + 1) * 512 + col];
    p.lbt[i] = 1.0f / (1.0f + expf(l1 - l0));
  }
}

DEV void ln_mod_row(const float* h, const float* shift, const float* scale, act_t* u) {
  float mu = 0.f;
  for (int k = 0; k < D; ++k) mu += h[k];
  mu *= (1.0f / D);
  float var = 0.f;
  for (int k = 0; k < D; ++k) { float d = h[k] - mu; var += d * d; }
  var *= (1.0f / D);
  float rs = 1.0f / sqrtf(var + LN_EPS);
  for (int k = 0; k < D; ++k) stA(u + k, (h[k] - mu) * rs * (1.0f + scale[k]) + shift[k]);
}

DEV void ph_lnmod_first(const Params& p, long row) {
  const float* m = modrow(p, 0, row);
  ln_mod_row(hrow_in(p, row), m, m + D, p.u + row * D);
}

DEV void gemm_item_act(const act_t* A, const float* W, act_t* Cout, int K, int N, int ldc, long i) {
  int n4 = (int)(i % (N / 4));
  long row = i / (N / 4);
  const act_t* a = A + row * K;
  const float* w = W + n4 * 4;
  float s0 = 0, s1 = 0, s2 = 0, s3 = 0;
  for (int k = 0; k < K; ++k) {
    float av = ldA(a + k);
    const float* wr = w + (long)k * N;
    s0 += av * wr[0]; s1 += av * wr[1]; s2 += av * wr[2]; s3 += av * wr[3];
  }
  act_t* o = Cout + row * ldc + n4 * 4;
  stA(o, s0); stA(o + 1, s1); stA(o + 2, s2); stA(o + 3, s3);
}

DEV void ph_rope(const Params& p, long i) {
  int pr = (int)(i % 32);
  int hh = (int)((i / 32) % 10);
  long lr = i / 320;
  int t = (int)(lr % T);
  int col = hh < 8 ? E_AQ + hh * 64 : E_AK + (hh - 8) * 64;
  int idx = pr & 15;
  int pos = pr < 16 ? t / GRID_W : t % GRID_W;
  int d0 = pr < 16 ? idx : 32 + idx;
  float inv = powf(10000.0f, -(float)idx / 16.0f);
  float ang = (float)pos * inv;
  float cs = cosf(ang), sn = sinf(ang);
  act_t* base = p.P + (NC + lr) * PW + col;
  float x1 = ldA(base + d0), x2 = ldA(base + d0 + 16);
  stA(base + d0, x1 * cs - x2 * sn);
  stA(base + d0 + 16, x1 * sn + x2 * cs);
}

DEV void ph_attn(const Params& p, long i) {
  int h = (int)(i % 8);
  long row = i / 8;
  int kv = h / 4;
  bool lat = row >= NC;
  int b = lat ? (int)((row - NC) / T) : (int)(row / C);
  int t = lat ? (int)((row - NC) % T) : 0;
  float q[64], acc[64];
  const act_t* qp = p.P + row * PW + E_AQ + h * 64;
#pragma unroll
  for (int d = 0; d < 64; ++d) { q[d] = ldA(qp + d) * 0.125f; acc[d] = 0.f; }
  float m = p.attn_sink[h], l = 1.0f;
  int nkeys = C + (lat ? 257 : 0);
  for (int j = 0; j < nkeys; ++j) {
    long krow;
    if (j < C) krow = (long)b * C + j;
    else {
      int kp = t - 128 + (j - C);
      if (kp < 0 || kp >= T) continue;
      krow = NC + (long)b * T + kp;
    }
    const act_t* kptr = p.P + krow * PW + E_AK + kv * 64;
    const act_t* vptr = p.P + krow * PW + E_AV + kv * 64;
    float s = 0.f;
#pragma unroll
    for (int d = 0; d < 64; ++d) s += q[d] * ldA(kptr + d);
    float mn = fmaxf(m, s);
    float sc = expf(m - mn), pj = expf(s - mn);
    l = l * sc + pj;
#pragma unroll
    for (int d = 0; d < 64; ++d) acc[d] = acc[d] * sc + pj * ldA(vptr + d);
    m = mn;
  }
  float il = 1.0f / l;
  act_t* o = p.u + row * D + h * 64;
#pragma unroll
  for (int d = 0; d < 64; ++d) stA(o + d, acc[d] * il);
}

template <int MODE>
DEV void ph_scan(const Params& p, long i) {
  constexpr int DK = MODE == 0 ? 128 : 96;
  constexpr int DV = MODE == 0 ? 128 : 192;
  int e = (int)(i % DV);
  int dir = (int)((i / DV) % 2);
  int h = (int)((i / (2 * DV)) % 4);
  int b = (int)(i / (8 * DV));
  float S[DK];
#pragma unroll
  for (int d = 0; d < DK; ++d) S[d] = 0.f;
  act_t* OD = dir == 0 ? p.OF : p.OB;
  for (int step = 0; step < C + T; ++step) {
    long row;
    if (step < C) row = (long)b * C + (dir == 0 ? step : C - 1 - step);
    else { int tt = step - C; row = NC + (long)b * T + (dir == 0 ? tt : T - 1 - tt); }
    const act_t* pr = p.P + row * PW;
    float o = 0.f;
    if (MODE == 0) {
      float v = ldA(pr + E_HI + h * 128 + e);
      const act_t* zp = pr + E_FF + dir * 512 + h * 128;
      const act_t* qp = pr + E_HQ + h * 128;
      const float* lb = p.lbt + dir * 512 + h * 128;
#pragma unroll
      for (int d = 0; d < DK; ++d) {
        float f = lb[d] + (1.0f - lb[d]) * sigmoidf_(ldA(zp + d));
        S[d] = f * S[d] + (1.0f - f) * v;
        o += ldA(qp + d) * S[d];
      }
      stA(OD + row * 768 + h * 128 + e, o);
    } else {
      float v = ldA(pr + O_V + h * 192 + e);
      const act_t* kp = pr + O_K + h * 96;
      const act_t* qp = pr + O_Q + h * 96;
      const act_t* lf = p.LF + ((long)dir * NR + row) * 384 + h * 96;
#pragma unroll
      for (int d = 0; d < DK; ++d) {
        float f = expf(ldA(lf + d));
        S[d] = f * S[d] + ldA(kp + d) * v;
        o += ldA(qp + d) * S[d];
      }
      stA(OD + row * 768 + h * 192 + e, o * 0.10206207261596575f);
    }
  }
}

template <int MODE>
DEV void ph_combine(const Params& p, long i) {
  constexpr int DV = MODE == 0 ? 128 : 192;
  int h = (int)(i % 4);
  long row = (MODE == 0) ? i / 4 : NC + i / 4;
  const act_t* f = p.OF + row * 768 + h * DV;
  const act_t* bk = p.OB + row * 768 + h * DV;
  float ss = 0.f;
  for (int e = 0; e < DV; ++e) { float o = ldA(f + e) + ldA(bk + e); ss += o * o; }
  float r = 1.0f / sqrtf(ss / DV + LN_EPS);
  const float* gn = (MODE == 0 ? p.hgrn_norm : p.gla_norm) + h * DV;
  const act_t* g = p.P + row * PW + (MODE == 0 ? E_HG : O_G) + h * DV;
  act_t* o = p.u + row * D + (MODE == 0 ? 512 : 0) + h * DV;
  for (int e = 0; e < DV; ++e) stA(o + e, (ldA(f + e) + ldA(bk + e)) * r * gn[e] * siluf_(ldA(g + e)));
}

DEV void ph_gla_decay(const Params& p, long i) {
  int col = (int)(i % 384);
  long row = (i / 384) % NR;
  int dir = (int)(i / ((long)384 * NR));
  const act_t* r = p.P + row * PW + O_RF + dir * 16;
  const float* gw = p.gla_gate_w + (long)dir * 16 * 384 + col;
  float z = p.gla_gate_b[dir * 384 + col];
  for (int k = 0; k < 16; ++k) z += ldA(r + k) * gw[k * 384];
  float ls = fminf(z, 0.f) - log1pf(expf(-fabsf(z)));
  stA(p.LF + ((long)dir * NR + row) * 384 + col, ls * (1.0f / 16.0f));
}

DEV void ph_resid_ln(const Params& p, long row, int l, int sub) {
  const float* hin = (l == 0 && sub == 0) ? hrow_in(p, row) : hrow(p, row);
  float* hout = hrow(p, row);
  const float* md = modrow(p, l, row);
  const float* g = md + (sub == 0 ? 2 : 5) * D;
  const act_t* m = p.M + row * D;
  const float* lg = p.ln_g + (l * 2 + sub) * D;
  const float* lb = p.ln_b + (l * 2 + sub) * D;
  float mu = 0.f;
  for (int k = 0; k < D; ++k) mu += ALPHA * hin[k] + g[k] * ldA(m + k);
  mu *= (1.0f / D);
  float var = 0.f;
  for (int k = 0; k < D; ++k) { float d = ALPHA * hin[k] + g[k] * ldA(m + k) - mu; var += d * d; }
  var *= (1.0f / D);
  float rs = 1.0f / sqrtf(var + LN_EPS);
  for (int k = 0; k < D; ++k) hout[k] = (ALPHA * hin[k] + g[k] * ldA(m + k) - mu) * rs * lg[k] + lb[k];
  if (sub == 1 && l == 1) return;
  const float* md2 = (sub == 0) ? md + 3 * D : modrow(p, 1, row);
  float mu2 = 0.f;
  for (int k = 0; k < D; ++k) mu2 += hout[k];
  mu2 *= (1.0f / D);
  float var2 = 0.f;
  for (int k = 0; k < D; ++k) { float d = hout[k] - mu2; var2 += d * d; }
  var2 *= (1.0f / D);
  float rs2 = 1.0f / sqrtf(var2 + LN_EPS);
  float lo[NEXP];
#pragma unroll
  for (int e = 0; e < NEXP; ++e) lo[e] = 0.f;
  for (int k = 0; k < D; ++k) {
    float uv = (hout[k] - mu2) * rs2 * (1.0f + md2[D + k]) + md2[k];
    stA(p.u + row * D + k, uv);
    if (sub == 0) {
      const float* wr = p.w_router + k * NEXP;
#pragma unroll
      for (int e = 0; e < NEXP; ++e) lo[e] += uv * wr[e];
    }
  }
  if (sub != 0) return;
  float mx = lo[0];
#pragma unroll
  for (int e = 1; e < NEXP; ++e) mx = fmaxf(mx, lo[e]);
  float sum = 0.f;
#pragma unroll
  for (int e = 0; e < NEXP; ++e) { lo[e] = expf(lo[e] - mx); sum += lo[e]; }
  float inv = 1.0f / sum;
  float bestg = -1e30f; int bg = 0;
  float gi1 = 0, gi2 = 0; int ge1 = 0, ge2 = 0;
  float gp1 = 0, gp2 = 0;
#pragma unroll
  for (int gq = 0; gq < 4; ++gq) {
    float s1 = -1e30f, s2 = -1e30f, p1 = 0, p2 = 0; int e1 = 0, e2 = 0;
#pragma unroll
    for (int j = 0; j < 4; ++j) {
      int e = gq * 4 + j;
      float pe = lo[e] * inv;
      float se = pe + p.b_router[e];
      if (se > s1) { s2 = s1; p2 = p1; e2 = e1; s1 = se; p1 = pe; e1 = e; }
      else if (se > s2) { s2 = se; p2 = pe; e2 = e; }
    }
    float gs = s1 + s2;
    if (gs > bestg) { bestg = gs; bg = gq; gi1 = s1; gi2 = s2; ge1 = e1; ge2 = e2; gp1 = p1; gp2 = p2; }
  }
  (void)bg; (void)gi1; (void)gi2;
  float wsum = gp1 + gp2;
  p.eidx[row * 2 + 0] = ge1; p.eidx[row * 2 + 1] = ge2;
  p.ew[row * 2 + 0] = gp1 / wsum; p.ew[row * 2 + 1] = gp2 / wsum;
}

DEV void ph_moe_up(const Params& p, long i, int l, long row0) {
  int f4 = (int)(i % (DFF / 4));
  int slot = (int)((i / (DFF / 4)) % 2);
  long row = row0 + i / (DFF / 2);
  int e = p.eidx[row * 2 + slot];
  const float* w1 = p.w_eg + ((long)(l * NEXP + e) * D) * DFF + f4 * 4;
  const float* w3 = p.w_eu + ((long)(l * NEXP + e) * D) * DFF + f4 * 4;
  const act_t* a = p.u + row * D;
  float g0 = 0, g1 = 0, g2 = 0, g3 = 0, u0 = 0, u1 = 0, u2 = 0, u3 = 0;
  for (int k = 0; k < D; ++k) {
    float av = ldA(a + k);
    const float* r1 = w1 + (long)k * DFF;
    const float* r3 = w3 + (long)k * DFF;
    g0 += av * r1[0]; g1 += av * r1[1]; g2 += av * r1[2]; g3 += av * r1[3];
    u0 += av * r3[0]; u1 += av * r3[1]; u2 += av * r3[2]; u3 += av * r3[3];
  }
  act_t* hb = p.P + (row * 2 + slot) * DFF + f4 * 4;
  stA(hb, siluf_(g0) * u0); stA(hb + 1, siluf_(g1) * u1); stA(hb + 2, siluf_(g2) * u2); stA(hb + 3, siluf_(g3) * u3);
}

DEV void ph_moe_down(const Params& p, long i, int l, long row0) {
  int j4 = (int)(i % (D / 4));
  long row = row0 + i / (D / 4);
  float y0 = 0, y1 = 0, y2 = 0, y3 = 0;
  for (int slot = 0; slot < 2; ++slot) {
    int e = p.eidx[row * 2 + slot];
    float wgt = p.ew[row * 2 + slot];
    const float* w2 = p.w_ed + ((long)(l * NEXP + e) * DFF) * D + j4 * 4;
    const act_t* hb = p.P + (row * 2 + slot) * DFF;
    float s0 = 0, s1 = 0, s2 = 0, s3 = 0;
    for (int f = 0; f < DFF; ++f) {
      float hv = ldA(hb + f);
      const float* r = w2 + (long)f * D;
      s0 += hv * r[0]; s1 += hv * r[1]; s2 += hv * r[2]; s3 += hv * r[3];
    }
    y0 += wgt * s0; y1 += wgt * s1; y2 += wgt * s2; y3 += wgt * s3;
  }
  act_t* o = p.M + row * D + j4 * 4;
  stA(o, y0); stA(o + 1, y1); stA(o + 2, y2); stA(o + 3, y3);
}


#ifndef HOST_TEST
typedef __attribute__((ext_vector_type(8))) short bf16x8;
typedef __attribute__((ext_vector_type(4))) float f32x4;
constexpr int SMEM_BYTES = 71680;
constexpr int IN_ODD_PAD = 2944;
constexpr int O_FA = 2336, O_FB = 2592, O_END = 2848;

typedef float f32x2_t __attribute__((ext_vector_type(2)));
typedef __bf16 bf16x2_t __attribute__((ext_vector_type(2)));
__device__ __forceinline__ unsigned pack2(float a, float b) {
  const f32x2_t v = {a, b};
  return __builtin_bit_cast(unsigned, __builtin_convertvector(v, bf16x2_t));
}
__device__ __forceinline__ unsigned pack2_mfma(float a, float b) { return pack2(a, b); }
typedef __attribute__((ext_vector_type(2))) unsigned u32x2;
__device__ __forceinline__ float xor16_max(float x) {
  const u32x2 r = __builtin_amdgcn_permlane16_swap(__float_as_uint(x), __float_as_uint(x), false, false);
  return fmaxf(__uint_as_float(r.x), __uint_as_float(r.y));
}
__device__ __forceinline__ float xor32_max(float x) {
  const u32x2 r = __builtin_amdgcn_permlane32_swap(__float_as_uint(x), __float_as_uint(x), false, false);
  return fmaxf(__uint_as_float(r.x), __uint_as_float(r.y));
}
__device__ __forceinline__ float xor16_add(float x) {
  const u32x2 r = __builtin_amdgcn_permlane16_swap(__float_as_uint(x), __float_as_uint(x), false, false);
  return __uint_as_float(r.x) + __uint_as_float(r.y);
}
__device__ __forceinline__ float xor32_add(float x) {
  const u32x2 r = __builtin_amdgcn_permlane32_swap(__float_as_uint(x), __float_as_uint(x), false, false);
  return __uint_as_float(r.x) + __uint_as_float(r.y);
}
__device__ __forceinline__ float bf_lo(unsigned u) { return __uint_as_float(u << 16); }
__device__ __forceinline__ float bf_hi(unsigned u) { return __uint_as_float(u & 0xffff0000u); }
template <int CTRL>
__device__ __forceinline__ float dpp_mov(float v) {
  return __int_as_float(__builtin_amdgcn_update_dpp(0, __float_as_int(v), CTRL, 0xf, 0xf, true));
}
__device__ __forceinline__ float row_sum16(float v) {
  v += dpp_mov<0xB1>(v);
  v += dpp_mov<0x4E>(v);
  v += dpp_mov<0x141>(v);
  v += dpp_mov<0x140>(v);
  return v;
}
__device__ __forceinline__ float wave_sum(float v) {
  v = row_sum16(v);
  const float a = __int_as_float(__builtin_amdgcn_readlane(__float_as_int(v), 0));
  const float b = __int_as_float(__builtin_amdgcn_readlane(__float_as_int(v), 16));
  const float c = __int_as_float(__builtin_amdgcn_readlane(__float_as_int(v), 32));
  const float d = __int_as_float(__builtin_amdgcn_readlane(__float_as_int(v), 48));
  return (a + b) + (c + d);
}


#define XB_TMO      128
#define XB_XCNT(j)  (256  + 64 * (j))
#define XB_XSUB(j)  (1280 + 64 * (j))
#define XB_XGEN(j)  (2304 + 64 * (j))
#define XB_TOP      3328
#define XB_TOPGEN   3392
#define XCD_BAR_WORDS 3456
#define XB_SPIN_CAP (1u << 18)
#define LAS __attribute__((address_space(3)))
__device__ __forceinline__ unsigned xb_ld(unsigned* p)              { return __hip_atomic_load(p, __ATOMIC_RELAXED, __HIP_MEMORY_SCOPE_AGENT); }
__device__ __forceinline__ unsigned xb_add(unsigned* p, unsigned v) { return __hip_atomic_fetch_add(p, v, __ATOMIC_RELAXED, __HIP_MEMORY_SCOPE_AGENT); }
__device__ __forceinline__ unsigned xb_xcc_id() { return (unsigned)__builtin_amdgcn_s_getreg((3 << 11) | 20) & 0xFu; }
#define XB_SPIN(cond, bar) do { unsigned _sp = 0; while (cond) { __builtin_amdgcn_s_sleep(1); \
    if ((++_sp & 255u) == 0u) { if (xb_ld(&(bar)[XB_TMO])) break; if (_sp > XB_SPIN_CAP) { atomicAdd(&(bar)[XB_TMO], 1u); break; } } } } while (0)
struct XcdBarrier { unsigned* bar; unsigned x; volatile LAS unsigned* st; };
__device__ __forceinline__ XcdBarrier xcd_barrier_post(unsigned* bar, volatile LAS unsigned* st) {
    XcdBarrier b; b.bar = bar; b.x = xb_xcc_id(); b.st = st;
    if (threadIdx.x == 0) (void)xb_add(&bar[XB_XCNT(b.x)], 1u);
    return b;
}
__device__ __forceinline__ void xcd_barrier_complete(unsigned* bar, unsigned x, unsigned& nloc, unsigned& nx) {
    const unsigned G = gridDim.x * gridDim.y * gridDim.z;
    unsigned sum, cnt, mine, sp = 0u;
    for (;;) {
        sum = 0u; cnt = 0u; mine = 0u;
#pragma unroll
        for (unsigned j = 0; j < 16; ++j) { const unsigned c = xb_ld(&bar[XB_XCNT(j)]); sum += c; cnt += (c > 0u) ? 1u : 0u; mine = (j == x) ? c : mine; }
        if (sum == G) break;
        __builtin_amdgcn_s_sleep(1);
        if ((++sp & 255u) == 0u) { if (xb_ld(&bar[XB_TMO])) break; if (sp > XB_SPIN_CAP) { atomicAdd(&bar[XB_TMO], 1u); break; } }
    }
    nloc = mine > 0u ? mine : 1u; nx = cnt > 0u ? cnt : 1u;
}
__device__ __forceinline__ void xcd_barrier(const XcdBarrier& b) {
    asm volatile("s_waitcnt vmcnt(0)" ::: "memory");
    __syncthreads();
    if (threadIdx.x == 0) {
        unsigned* bar = b.bar;
        __builtin_amdgcn_s_waitcnt(0);
        unsigned nloc = b.st[0], nx = b.st[1];
        if (nloc == 0u) { xcd_barrier_complete(bar, b.x, nloc, nx); b.st[0] = nloc; b.st[1] = nx; }
        const unsigned old = xb_add(&bar[XB_XSUB(b.x)], 1u);
        const unsigned gen = old / nloc;
        if (old + 1u == (gen + 1u) * nloc) {
            __builtin_amdgcn_fence(__ATOMIC_RELEASE, "agent");
            asm volatile("s_waitcnt vmcnt(0)" ::: "memory");
            const unsigned og = xb_add(&bar[XB_TOP], 1u);
            const unsigned tg = og / nx;
            if (og + 1u == (tg + 1u) * nx) xb_add(&bar[XB_TOPGEN], 1u);
            else XB_SPIN(xb_ld(&bar[XB_TOPGEN]) == tg, bar);
            __builtin_amdgcn_fence(__ATOMIC_ACQUIRE, "agent");
            xb_add(&bar[XB_XGEN(b.x)], 1u);
            asm volatile("s_waitcnt vmcnt(0)" ::: "memory");
        } else {
            XB_SPIN(xb_ld(&bar[XB_XGEN(b.x)]) == gen, bar);
            __builtin_amdgcn_fence(__ATOMIC_ACQUIRE, "agent");
            asm volatile("s_waitcnt vmcnt(0)" ::: "memory");
        }
    }
    __syncthreads();
}

#define RAW_BARRIER() do { asm volatile("s_waitcnt lgkmcnt(0)" ::: "memory"); __builtin_amdgcn_s_barrier(); } while (0)
template <bool SWAP, class ARow, class Epi>
__device__ __forceinline__ void gemm_tile(ARow arow, const act_t* Bt, int K, unsigned char* smem, Epi epi) {
  const int tid = threadIdx.x, wid = tid >> 6, lane = tid & 63, wr = wid >> 1, wc = wid & 1, fr = lane & 15,
            fq = lane >> 4;
  const int r0 = tid >> 3, pc = tid & 7;
  const int lc = pc ^ ((tid >> 4) & 7);
  const act_t* ga[4];
#pragma unroll
  for (int i = 0; i < 4; ++i) ga[i] = arow(r0 + 32 * i) + lc * 8;
  const act_t* gb0 = Bt + (long)r0 * K + lc * 8;
  const long gbs = (long)32 * K;
  const int sw = (fr >> 1) & 7;
  const int rd0 = fr * 128 + ((fq ^ sw) << 4), rd1 = fr * 128 + (((4 + fq) ^ sw) << 4);
  char* S = (char*)smem;
  const int nk = K >> 6;
  f32x4 acc[4][4];
#pragma unroll
  for (int m = 0; m < 4; ++m)
#pragma unroll
    for (int n = 0; n < 4; ++n) acc[m][n] = f32x4{0.f, 0.f, 0.f, 0.f};
  auto issue = [&](int kt) {
    char* st = S + (kt & 1) * 32768 + tid * 16;
#pragma unroll
    for (int i = 0; i < 4; ++i) {
      __builtin_amdgcn_global_load_lds((const unsigned*)(ga[i] + kt * 64), (unsigned*)(st + i * 4096), 16, 0, 0);
      __builtin_amdgcn_global_load_lds((const unsigned*)(gb0 + i * gbs + kt * 64), (unsigned*)(st + 16384 + i * 4096), 16, 0, 0);
    }
  };
  RAW_BARRIER();
  issue(0);
  for (int kt = 0; kt < nk; ++kt) {
    asm volatile("s_waitcnt vmcnt(0)" ::: "memory");
    RAW_BARRIER();
    if (kt + 1 < nk) issue(kt + 1);
    const char* st = S + (kt & 1) * 32768;
#pragma unroll
    for (int ks = 0; ks < 2; ++ks) {
      const int rd = ks ? rd1 : rd0;
      bf16x8 af[4], bfr[4];
#pragma unroll
      for (int m = 0; m < 4; ++m) {
        af[m] = *reinterpret_cast<const bf16x8*>(st + (wr * 64 + m * 16) * 128 + rd);
        bfr[m] = *reinterpret_cast<const bf16x8*>(st + 16384 + (wc * 64 + m * 16) * 128 + rd);
      }
#pragma unroll
      for (int m = 0; m < 4; ++m)
#pragma unroll
        for (int n = 0; n < 4; ++n)
          acc[m][n] = SWAP ? __builtin_amdgcn_mfma_f32_16x16x32_bf16(bfr[n], af[m], acc[m][n], 0, 0, 0)
                           : __builtin_amdgcn_mfma_f32_16x16x32_bf16(af[m], bfr[n], acc[m][n], 0, 0, 0);
    }
  }
  epi(acc, wr, wc, fr, fq);
}


constexpr float SU8 = 16.0f, SW8 = 64.0f, SH8 = 8.0f, SO8 = 8.0f;
typedef unsigned char fp8_t;
typedef __attribute__((ext_vector_type(8))) int i32x8;
typedef __attribute__((ext_vector_type(4))) int i32x4;
__device__ __forceinline__ unsigned pack4_fp8(float a, float b, float c, float d) {
  a = fminf(fmaxf(a, -448.f), 448.f); b = fminf(fmaxf(b, -448.f), 448.f);
  c = fminf(fmaxf(c, -448.f), 448.f); d = fminf(fmaxf(d, -448.f), 448.f);
  unsigned w = 0;
  w = __builtin_amdgcn_cvt_pk_fp8_f32(a, b, w, false);
  w = __builtin_amdgcn_cvt_pk_fp8_f32(c, d, w, true);
  return w;
}

template <bool SWAP, class ARow, class Epi>
__device__ __forceinline__ void gemm_tile8(ARow arow, const fp8_t* Bt, int Kb, unsigned char* smem, Epi epi) {
  const int tid = threadIdx.x, wid = tid >> 6, lane = tid & 63, wr = wid >> 1, wc = wid & 1, fr = lane & 15,
            fq = lane >> 4;
  const int r0 = tid >> 3, pc = tid & 7;
  const int lc = pc ^ ((tid >> 4) & 7);
  const fp8_t* ga[4];
#pragma unroll
  for (int i = 0; i < 4; ++i) ga[i] = arow(r0 + 32 * i) + lc * 16;
  const fp8_t* gb0 = Bt + (long)r0 * Kb + lc * 16;
  const long gbs = (long)32 * Kb;
  const int sw = (fr >> 1) & 7;
  const int rd0 = fr * 128 + ((fq ^ sw) << 4), rd1 = fr * 128 + (((4 + fq) ^ sw) << 4);
  char* S = (char*)smem;
  const int nk = Kb >> 7;
  f32x4 acc[4][4];
#pragma unroll
  for (int m = 0; m < 4; ++m)
#pragma unroll
    for (int n = 0; n < 4; ++n) acc[m][n] = f32x4{0.f, 0.f, 0.f, 0.f};
  auto issue = [&](int kt) {
    char* st = S + (kt & 1) * 32768 + tid * 16;
#pragma unroll
    for (int i = 0; i < 4; ++i) {
      __builtin_amdgcn_global_load_lds((const unsigned*)(ga[i] + kt * 128), (unsigned*)(st + i * 4096), 16, 0, 0);
      __builtin_amdgcn_global_load_lds((const unsigned*)(gb0 + i * gbs + kt * 128), (unsigned*)(st + 16384 + i * 4096), 16, 0, 0);
    }
  };
  RAW_BARRIER();
  issue(0);
  if (nk > 1) issue(1);
#pragma unroll 1
  for (int kt = 0; kt < nk; ++kt) {
    if (kt + 1 < nk) asm volatile("s_waitcnt vmcnt(8)" ::: "memory");
    else asm volatile("s_waitcnt vmcnt(0)" ::: "memory");
    RAW_BARRIER();
    const char* st = S + (kt & 1) * 32768;
    i32x8 af[4], bfr[4];
#pragma unroll
    for (int m = 0; m < 4; ++m) {
      const i32x4 a0 = *reinterpret_cast<const i32x4*>(st + (wr * 64 + m * 16) * 128 + rd0);
      const i32x4 a1 = *reinterpret_cast<const i32x4*>(st + (wr * 64 + m * 16) * 128 + rd1);
      const i32x4 b0 = *reinterpret_cast<const i32x4*>(st + 16384 + (wc * 64 + m * 16) * 128 + rd0);
      const i32x4 b1 = *reinterpret_cast<const i32x4*>(st + 16384 + (wc * 64 + m * 16) * 128 + rd1);
      af[m] = i32x8{a0[0], a0[1], a0[2], a0[3], a1[0], a1[1], a1[2], a1[3]};
      bfr[m] = i32x8{b0[0], b0[1], b0[2], b0[3], b1[0], b1[1], b1[2], b1[3]};
    }
    RAW_BARRIER();
    if (kt + 2 < nk) issue(kt + 2);
#pragma unroll
    for (int m = 0; m < 4; ++m)
#pragma unroll
      for (int n = 0; n < 4; ++n)
        acc[m][n] = SWAP ? __builtin_amdgcn_mfma_scale_f32_16x16x128_f8f6f4(bfr[n], af[m], acc[m][n], 0, 0, 0, 0x7f7f7f7f, 0, 0x7f7f7f7f)
                         : __builtin_amdgcn_mfma_scale_f32_16x16x128_f8f6f4(af[m], bfr[n], acc[m][n], 0, 0, 0, 0x7f7f7f7f, 0, 0x7f7f7f7f);
  }
  epi(acc, wr, wc, fr, fq);
}


template <bool SWAP, class Epi>
__device__ __forceinline__ void gemm_tile8p(const fp8_t* A, const fp8_t* Bt, bool has_next, const fp8_t* An, const fp8_t* Btn,
                                            int& par, bool& primed, int Kb, unsigned char* smem, Epi epi) {
  const int tid = threadIdx.x, wid = tid >> 6, lane = tid & 63, wr = wid >> 1, wc = wid & 1, fr = lane & 15,
            fq = lane >> 4;
  const int r0 = tid >> 3, pc = tid & 7;
  const int lc = pc ^ ((tid >> 4) & 7);
  const long roff = (long)r0 * Kb + lc * 16;
  const long gbs = (long)32 * Kb;
  const int sw = (fr >> 1) & 7;
  const int rd0 = fr * 128 + ((fq ^ sw) << 4), rd1 = fr * 128 + (((4 + fq) ^ sw) << 4);
  char* S = (char*)smem;
  const int nk = Kb >> 7;
  f32x4 acc[4][4];
#pragma unroll
  for (int m = 0; m < 4; ++m)
#pragma unroll
    for (int n = 0; n < 4; ++n) acc[m][n] = f32x4{0.f, 0.f, 0.f, 0.f};
  auto issue = [&](const fp8_t* a, const fp8_t* b, int kt, int stage) {
    char* st = S + stage * 32768 + tid * 16;
    const fp8_t* ga = a + roff + kt * 128;
    const fp8_t* gb = b + roff + kt * 128;
#pragma unroll
    for (int i = 0; i < 4; ++i) {
      __builtin_amdgcn_global_load_lds((const unsigned*)(ga + i * gbs), (unsigned*)(st + i * 4096), 16, 0, 0);
      __builtin_amdgcn_global_load_lds((const unsigned*)(gb + i * gbs), (unsigned*)(st + 16384 + i * 4096), 16, 0, 0);
    }
  };
  if (!primed) {
    RAW_BARRIER();
    issue(A, Bt, 0, par);
  }
#pragma unroll 1
  for (int kt = 0; kt < nk; ++kt) {
    asm volatile("s_waitcnt vmcnt(0)" ::: "memory");
    RAW_BARRIER();
    if (kt + 1 < nk) issue(A, Bt, kt + 1, (par + kt + 1) & 1);
    else if (has_next) issue(An, Btn, 0, (par + kt + 1) & 1);
    const char* st = S + ((par + kt) & 1) * 32768;
    i32x8 af[4], bfr[4];
#pragma unroll
    for (int m = 0; m < 4; ++m) {
      const i32x4 a0 = *reinterpret_cast<const i32x4*>(st + (wr * 64 + m * 16) * 128 + rd0);
      const i32x4 a1 = *reinterpret_cast<const i32x4*>(st + (wr * 64 + m * 16) * 128 + rd1);
      const i32x4 b0 = *reinterpret_cast<const i32x4*>(st + 16384 + (wc * 64 + m * 16) * 128 + rd0);
      const i32x4 b1 = *reinterpret_cast<const i32x4*>(st + 16384 + (wc * 64 + m * 16) * 128 + rd1);
      af[m] = i32x8{a0[0], a0[1], a0[2], a0[3], a1[0], a1[1], a1[2], a1[3]};
      bfr[m] = i32x8{b0[0], b0[1], b0[2], b0[3], b1[0], b1[1], b1[2], b1[3]};
    }
#pragma unroll
    for (int m = 0; m < 4; ++m)
#pragma unroll
      for (int n = 0; n < 4; ++n)
        acc[m][n] = SWAP ? __builtin_amdgcn_mfma_scale_f32_16x16x128_f8f6f4(bfr[n], af[m], acc[m][n], 0, 0, 0, 0x7f7f7f7f, 0, 0x7f7f7f7f)
                         : __builtin_amdgcn_mfma_scale_f32_16x16x128_f8f6f4(af[m], bfr[n], acc[m][n], 0, 0, 0, 0x7f7f7f7f, 0, 0x7f7f7f7f);
  }
  par = (par + nk) & 1;
  primed = has_next;
  epi(acc, wr, wc, fr, fq);
}

__device__ __forceinline__ void phase_attn(const Params& p, unsigned char* smem, int blk, int nblk) {
  const int tid = threadIdx.x, w = tid >> 6, lane = tid & 63, fr = lane & 15, g = lane >> 4;
  act_t* SK = (act_t*)smem;
  act_t* SV = SK + 64 * 72;
  constexpr float SCL = 0.125f * 1.4426950408889634f;
  const int n_lat = NB * 4 * (T / 64), n_ctx = NB * 4 * (C / 64);
  const int skey = tid >> 2, spart = tid & 3;
  for (int unit = blk; unit < n_lat + n_ctx; unit += nblk) {
    const bool lat = unit < n_lat;
    const int uu = lat ? unit : unit - n_lat;
    const int nq = lat ? T / 64 : C / 64;
    const int hp = uu & 1, kv = (uu >> 1) & 1, qb = (uu >> 2) % nq, b = (uu >> 2) / nq;
    const int t0 = qb * 64;
    const int tw = t0 + (w & 1) * 32;
    const long qrow0 = (lat ? (long)NC + (long)b * T : (long)b * C) + tw;
    const int h = kv * 4 + hp * 2 + (w >> 1);
    bf16x8 qf[2][2];
#pragma unroll
    for (int qt = 0; qt < 2; ++qt)
#pragma unroll
      for (int st = 0; st < 2; ++st)
        qf[qt][st] = *reinterpret_cast<const bf16x8*>(p.P + (qrow0 + qt * 16 + fr) * PW + E_AQ + h * 64 + st * 32 + g * 8);
    asm volatile("" :: "v"(qf[0][0]), "v"(qf[0][1]), "v"(qf[1][0]), "v"(qf[1][1]));
    float mrun[2], lrun[2];
    f32x4 o[2][4];
    const float sinkl = p.attn_sink[h] * 1.4426950408889634f;
#pragma unroll
    for (int qt = 0; qt < 2; ++qt) {
      mrun[qt] = sinkl;
      lrun[qt] = (g == 0) ? 1.0f : 0.0f;
#pragma unroll
      for (int dt = 0; dt < 4; ++dt) o[qt][dt] = f32x4{0.f, 0.f, 0.f, 0.f};
    }
    int cc_lo = 0, cc_hi = -1;
    if (lat) {
      cc_lo = t0 >= 128 ? 0 : (128 - t0) / 64;
      cc_hi = min(4, (T - 1 - (t0 - 128)) / 64);
    }
    const int nch = 4 + (cc_hi - cc_lo + 1);
    auto chunk_row = [&](int i, int key, int& tkb) -> long {
      if (i < 4) { tkb = 0; return (long)b * C + i * 64 + key; }
      tkb = t0 - 128 + (cc_lo + i - 4) * 64;
      return (long)NC + (long)b * T + tkb + key;
    };
    uint4 rk0, rk1, rv0, rv1;
    {
      int tkb; const long kr = chunk_row(0, skey, tkb);
      const act_t* kp = p.P + kr * PW + E_AK + kv * 64 + spart * 16;
      const act_t* vp = p.P + kr * PW + E_AV + kv * 64 + spart * 16;
      rk0 = *reinterpret_cast<const uint4*>(kp); rk1 = *reinterpret_cast<const uint4*>(kp + 8);
      rv0 = *reinterpret_cast<const uint4*>(vp); rv1 = *reinterpret_cast<const uint4*>(vp + 8);
    }
    for (int i = 0; i < nch; ++i) {
      __syncthreads();
      {
        uint4* kd = reinterpret_cast<uint4*>(SK + skey * 72 + spart * 16);
        kd[0] = rk0; kd[1] = rk1;
        const unsigned vw[8] = {rv0.x, rv0.y, rv0.z, rv0.w, rv1.x, rv1.y, rv1.z, rv1.w};
#pragma unroll
        for (int e = 0; e < 8; ++e) {
          SV[(spart * 16 + 2 * e) * 72 + skey] = (act_t)(vw[e] & 0xffffu);
          SV[(spart * 16 + 2 * e + 1) * 72 + skey] = (act_t)(vw[e] >> 16);
        }
      }
      __syncthreads();
      int tkb_cur; (void)chunk_row(i, 0, tkb_cur);
      if (i + 1 < nch) {
        int tkb; const long kr = chunk_row(i + 1, skey, tkb);
        const act_t* kp = p.P + kr * PW + E_AK + kv * 64 + spart * 16;
        const act_t* vp = p.P + kr * PW + E_AV + kv * 64 + spart * 16;
        rk0 = *reinterpret_cast<const uint4*>(kp); rk1 = *reinterpret_cast<const uint4*>(kp + 8);
        rv0 = *reinterpret_cast<const uint4*>(vp); rv1 = *reinterpret_cast<const uint4*>(vp + 8);
      }
      const bool edge = i >= 4 && (tkb_cur == t0 - 128 || tkb_cur == t0 + 128);
#pragma unroll
      for (int kb = 0; kb < 2; ++kb) {
        f32x4 sc[2][2];
#pragma unroll
        for (int k2 = 0; k2 < 2; ++k2) {
          const int kt = kb * 2 + k2;
          const bf16x8 kf0 = *reinterpret_cast<const bf16x8*>(SK + (kt * 16 + fr) * 72 + g * 8);
          const bf16x8 kf1 = *reinterpret_cast<const bf16x8*>(SK + (kt * 16 + fr) * 72 + 32 + g * 8);
#pragma unroll
          for (int qt = 0; qt < 2; ++qt) {
            f32x4 z = f32x4{0.f, 0.f, 0.f, 0.f};
            z = __builtin_amdgcn_mfma_f32_16x16x32_bf16(kf0, qf[qt][0], z, 0, 0, 0);
            sc[qt][k2] = __builtin_amdgcn_mfma_f32_16x16x32_bf16(kf1, qf[qt][1], z, 0, 0, 0);
          }
        }
        bf16x8 pf[2];
#pragma unroll
        for (int qt = 0; qt < 2; ++qt) {
          float mx = -1e30f;
#pragma unroll
          for (int k2 = 0; k2 < 2; ++k2)
#pragma unroll
            for (int j = 0; j < 4; ++j) {
              float v = sc[qt][k2][j] * SCL;
              if (edge) {
                const int tk = tkb_cur + (kb * 2 + k2) * 16 + 4 * g + j;
                const int tq = tw + qt * 16 + fr;
                const int df = tq - tk;
                if (df > 128 || df < -128) v = -1e30f;
              }
              sc[qt][k2][j] = v;
              mx = fmaxf(mx, v);
            }
          mx = xor16_max(mx);
          mx = xor32_max(mx);
          const float mnew = fmaxf(mrun[qt], mx);
          if (__any(mnew > mrun[qt])) {
            const float alpha = __builtin_amdgcn_exp2f(mrun[qt] - mnew);
            lrun[qt] *= alpha;
#pragma unroll
            for (int dt = 0; dt < 4; ++dt) o[qt][dt] = o[qt][dt] * alpha;
            mrun[qt] = mnew;
          }
          float ls = 0.f;
          float pv[8];
#pragma unroll
          for (int k2 = 0; k2 < 2; ++k2)
#pragma unroll
            for (int j = 0; j < 4; ++j) {
              const float pe = __builtin_amdgcn_exp2f(sc[qt][k2][j] - mnew);
              pv[k2 * 4 + j] = pe;
              ls += pe;
            }
          lrun[qt] += ls;
          union { unsigned u[4]; bf16x8 v; } cv;
          cv.u[0] = pack2_mfma(pv[0], pv[1]); cv.u[1] = pack2_mfma(pv[2], pv[3]);
          cv.u[2] = pack2_mfma(pv[4], pv[5]); cv.u[3] = pack2_mfma(pv[6], pv[7]);
          pf[qt] = cv.v;
        }
#pragma unroll
        for (int dt = 0; dt < 4; ++dt) {
          union { uint2 h2[2]; bf16x8 v; } vf;
          vf.h2[0] = *reinterpret_cast<const uint2*>(SV + (dt * 16 + fr) * 72 + kb * 32 + 4 * g);
          vf.h2[1] = *reinterpret_cast<const uint2*>(SV + (dt * 16 + fr) * 72 + kb * 32 + 16 + 4 * g);
#pragma unroll
          for (int qt = 0; qt < 2; ++qt) o[qt][dt] = __builtin_amdgcn_mfma_f32_16x16x32_bf16(vf.v, pf[qt], o[qt][dt], 0, 0, 0);
        }
      }
    }
#pragma unroll
    for (int qt = 0; qt < 2; ++qt) {
      float lt = lrun[qt];
      lt = xor16_add(lt);
      lt = xor32_add(lt);
      const float il = 1.0f / lt;
      fp8_t* orow = p.O8 + (qrow0 + qt * 16 + fr) * D + h * 64 + 4 * g;
      const float ils = il * SO8;
#pragma unroll
      for (int dt = 0; dt < 4; ++dt)
        *reinterpret_cast<unsigned*>(orow + dt * 16) = pack4_fp8(o[qt][dt][0] * ils, o[qt][dt][1] * ils, o[qt][dt][2] * ils, o[qt][dt][3] * ils);
    }
  }
}


template <int MODE>
__device__ __forceinline__ void phase_combine(const Params& p) {
  constexpr int DV = MODE == 0 ? 128 : 192, EPL = DV / 16, NV = EPL / 4;
  const int lane = threadIdx.x & 63;
  const long row_lo = MODE == 0 ? 0 : NC;
  const int nw = (int)gridDim.x * 4, wi = (int)blockIdx.x * 4 + (int)(threadIdx.x >> 6);
  const int rpw = (int)(NR - row_lo + nw - 1) / nw;
  const long r0 = row_lo + (long)wi * rpw, r1 = min((long)NR, r0 + rpw);
  float gn[EPL];
#pragma unroll
  for (int e = 0; e < EPL; ++e) gn[e] = (MODE == 0 ? p.hgrn_norm : p.gla_norm)[lane * EPL + e];
  uint2 fa[NV], fb[NV], fg[NV];
  auto load_row = [&](long row) {
    const uint2* f = reinterpret_cast<const uint2*>(p.OF + row * 768 + lane * EPL);
    const uint2* bk = reinterpret_cast<const uint2*>(p.OB + row * 768 + lane * EPL);
    const uint2* gt = reinterpret_cast<const uint2*>(p.P + row * PW + (MODE == 0 ? E_HG : O_G) + lane * EPL);
#pragma unroll
    for (int v = 0; v < NV; ++v) { fa[v] = f[v]; fb[v] = bk[v]; fg[v] = gt[v]; }
  };
  if (r0 < r1) load_row(r0);
  for (long row = r0; row < r1; ++row) {
    float o[EPL], gg[EPL];
#pragma unroll
    for (int v = 0; v < NV; ++v) {
      o[4 * v + 0] = bf_lo(fa[v].x) + bf_lo(fb[v].x); o[4 * v + 1] = bf_hi(fa[v].x) + bf_hi(fb[v].x);
      o[4 * v + 2] = bf_lo(fa[v].y) + bf_lo(fb[v].y); o[4 * v + 3] = bf_hi(fa[v].y) + bf_hi(fb[v].y);
      gg[4 * v + 0] = bf_lo(fg[v].x); gg[4 * v + 1] = bf_hi(fg[v].x); gg[4 * v + 2] = bf_lo(fg[v].y); gg[4 * v + 3] = bf_hi(fg[v].y);
    }
    load_row(min(row + 1, r1 - 1));
    float ss = 0.f;
#pragma unroll
    for (int e = 0; e < EPL; ++e) ss += o[e] * o[e];
    ss = row_sum16(ss);
    const float r = 1.0f / sqrtf(ss * (1.0f / DV) + LN_EPS);
    unsigned* dst = reinterpret_cast<unsigned*>(p.O8 + row * D + (MODE == 0 ? 512 : 0) + lane * EPL);
#pragma unroll
    for (int v = 0; v < NV; ++v) {
      float y[4];
#pragma unroll
      for (int q = 0; q < 4; ++q) {
        const float g = gg[4 * v + q];
        y[q] = o[4 * v + q] * (r * SO8) * gn[4 * v + q] * (g / (1.0f + __expf(-g)));
      }
      dst[v] = pack4_fp8(y[0], y[1], y[2], y[3]);
    }
  }
}

constexpr int MOD_ITEMS = 2 * (6 * D / 64);
__device__ __forceinline__ void mod_item(const Params& p, int item, unsigned char* smem) {
  float* sc = (float*)smem;
  float* red = sc + 9 * D;
  const int tid = threadIdx.x, w = tid >> 6, lane = tid & 63;
  for (int i = tid; i < 9 * D; i += 256) {
    const int bb = i >> 10, k = i & 1023;
    const float v = bb < NB ? p.c[bb * D + k] : p.c_ctx[k];
    sc[i] = v / (1.0f + __expf(-v));
  }
  __syncthreads();
  const int l = item / (6 * D / 64), j = (item % (6 * D / 64)) * 64 + lane;
  const float* wp = p.w_ada + (long)l * D * 6 * D + (long)(w * 256) * 6 * D + j;
  float a[NB + 1];
#pragma unroll
  for (int bb = 0; bb <= NB; ++bb) a[bb] = 0.f;
  for (int kb = 0; kb < 256; kb += 32) {
    float wv[32];
#pragma unroll
    for (int q = 0; q < 32; ++q) wv[q] = wp[(long)(kb + q) * 6 * D];
#pragma unroll
    for (int q = 0; q < 32; ++q)
#pragma unroll
      for (int bb = 0; bb <= NB; ++bb) a[bb] += sc[bb * D + w * 256 + kb + q] * wv[q];
  }
#pragma unroll
  for (int bb = 0; bb <= NB; ++bb) red[(w * 9 + bb) * 64 + lane] = a[bb];
  __syncthreads();
  for (int i = tid; i < 9 * 64; i += 256) {
    const int bb = i >> 6, jj = i & 63;
    const int col = (item % (6 * D / 64)) * 64 + jj;
    const float sum = ((red[(0 * 9 + bb) * 64 + jj] + red[(1 * 9 + bb) * 64 + jj]) + (red[(2 * 9 + bb) * 64 + jj] + red[(3 * 9 + bb) * 64 + jj]));
    p.mod[((long)l * (NB + 1) + bb) * 6 * D + col] = sum + p.b_ada[l * 6 * D + col];
  }
  __syncthreads();
}

__device__ __forceinline__ void phase_gla_decay(const Params& p) {
  const int t = threadIdx.x;
  if (t >= 192) return;
  const int dir = t / 96, cg = t % 96;
  float gw[16][4], gb[4];
#pragma unroll
  for (int r = 0; r < 16; ++r) {
    const float4 v = *reinterpret_cast<const float4*>(p.gla_gate_w + ((long)dir * 16 + r) * 384 + cg * 4);
    gw[r][0] = v.x; gw[r][1] = v.y; gw[r][2] = v.z; gw[r][3] = v.w;
  }
  {
    const float4 v = *reinterpret_cast<const float4*>(p.gla_gate_b + dir * 384 + cg * 4);
    gb[0] = v.x; gb[1] = v.y; gb[2] = v.z; gb[3] = v.w;
  }
  const int rpb = ((NR + (int)gridDim.x - 1) / (int)gridDim.x + 3) / 4 * 4;
  const long b0 = (long)blockIdx.x * rpb, b1 = min((long)NR, b0 + rpb);
  uint4 ra[4], rb[4];
  auto load4 = [&](long row0) {
#pragma unroll
    for (int q = 0; q < 4; ++q) {
      const uint4* rp = reinterpret_cast<const uint4*>(p.P + min(row0 + q, b1 - 1) * PW + O_RF + dir * 16);
      ra[q] = rp[0]; rb[q] = rp[1];
    }
  };
  if (b0 < b1) load4(b0);
  for (long row0 = b0; row0 < b1; row0 += 4) {
    unsigned rw[4][8];
#pragma unroll
    for (int q = 0; q < 4; ++q) {
      rw[q][0] = ra[q].x; rw[q][1] = ra[q].y; rw[q][2] = ra[q].z; rw[q][3] = ra[q].w;
      rw[q][4] = rb[q].x; rw[q][5] = rb[q].y; rw[q][6] = rb[q].z; rw[q][7] = rb[q].w;
    }
    load4(min(row0 + 4, b1 - 1));
#pragma unroll
    for (int q = 0; q < 4; ++q) {
      float z[4] = {gb[0], gb[1], gb[2], gb[3]};
#pragma unroll
      for (int r2 = 0; r2 < 8; ++r2) {
        const float x0 = bf_lo(rw[q][r2]), x1 = bf_hi(rw[q][r2]);
#pragma unroll
        for (int c = 0; c < 4; ++c) z[c] += x0 * gw[2 * r2][c] + x1 * gw[2 * r2 + 1][c];
      }
      float o[4];
#pragma unroll
      for (int c = 0; c < 4; ++c) o[c] = (fminf(z[c], 0.f) - __logf(1.0f + __expf(-fabsf(z[c])))) * (1.0f / 16.0f);
      if (row0 + q < b1)
        *reinterpret_cast<uint2*>(p.LF + ((long)dir * NR + row0 + q) * 384 + cg * 4) = make_uint2(pack2(o[0], o[1]), pack2(o[2], o[3]));
    }
  }
}

__device__ __forceinline__ void phase_hgrn_gate(const Params& p, long gtid, long gstride) {
  for (long i = gtid; i < (long)NR * 1024; i += gstride) {
    const int col = (int)(i & 1023);
    const long row = i >> 10;
    act_t* z = p.P + row * PW + E_FF + col;
    const float lb = p.lbt[col];
    const float f = lb + (1.0f - lb) * sigmoidf_(ldA(z));
    stA(z, __logf(f));
  }
}

template <int MODE>
__device__ __forceinline__ void phase_scan(const Params& p, unsigned char* smem, int blk, int nblk) {
  constexpr int DK = MODE == 0 ? 128 : 96, DV = MODE == 0 ? 128 : 192, DVS = DV / 4, NET = DVS / 16, NKS = DK / 32,
                NDT = DK / 16;
  constexpr int QS = DK + 8, LS = 72, SS = DK + 8;
  act_t* Qa = (act_t*)smem;
  act_t* Ka = Qa + 64 * QS;
  act_t* KaT = Ka + 64 * QS;
  act_t* VT = KaT + DK * LS;
  act_t* ST = VT + DVS * LS;
  float* tot = (float*)(ST + DVS * SS);
  float* lf32 = tot + 2 * 4 * DK;
  const int tid = threadIdx.x, w = __builtin_amdgcn_readfirstlane(threadIdx.x >> 6), lane = tid & 63, fr = lane & 15, g = lane >> 4;
  const int dp = lane, c0 = 2 * dp;
  const bool cact = dp < DK / 2;
  constexpr int NCH = (C + T) / 64, NCC = C / 64;
  constexpr int NVI = DVS / 8 * 64;
  for (int item = blk; item < NB * 4 * 2 * 4; item += nblk) {
    const int sl = item & 3, dir = (item >> 2) & 1, h = (item >> 3) & 3, b = item >> 5;
    act_t* OD = dir == 0 ? p.OF : p.OB;
    const unsigned loff = (unsigned)min(c0, DK - 2) * 2u;
    const int vcol = (MODE == 0 ? E_HI + h * 128 : O_V + h * 192) + sl * DVS;
    const int ocol = h * DV + sl * DVS;
    auto chunk_base = [&](int n) -> long {
      if (n < NCC) return (long)b * C + (dir ? NCC - 1 - n : n) * 64;
      const int ln = n - NCC;
      return (long)NC + (long)b * T + (dir ? T / 64 - 1 - ln : ln) * 64;
    };
    auto lrow = [&](long base, int l) -> long { return base + (dir ? 63 - l : l); };
    f32x4 S[NET][2];
#pragma unroll
    for (int et = 0; et < NET; ++et) { S[et][0] = f32x4{0.f, 0.f, 0.f, 0.f}; S[et][1] = f32x4{0.f, 0.f, 0.f, 0.f}; }
    unsigned rlf[16], rq[16], rk[16];
    uint4 rv[2];
    const long rstep = dir ? -(long)PW * 2 : (long)PW * 2;
    const long lstep = dir ? -(long)384 * 2 : (long)384 * 2;
    const unsigned off_lf = (MODE == 0 ? (unsigned)(E_FF + dir * 512 + h * 128) * 2u : 0u) + loff;
    const unsigned off_q = (unsigned)(MODE == 0 ? E_HQ + h * 128 : O_Q + h * 96) * 2u + loff;
    const unsigned off_k = (unsigned)(O_K + h * 96) * 2u + loff;
    auto issue_loads = [&](int n) {
      const long base = chunk_base(n);
      {
        const char* prow = (const char*)(p.P + lrow(base, w * 16) * PW);
        const char* plf = (const char*)(p.LF + ((long)dir * NR + lrow(base, w * 16)) * 384 + h * 96);
#pragma unroll
        for (int i = 0; i < 16; ++i) {
          if (MODE == 0) {
            rlf[i] = *reinterpret_cast<const unsigned*>(prow + off_lf);
          } else {
            rlf[i] = *reinterpret_cast<const unsigned*>(plf + loff);
            rk[i] = *reinterpret_cast<const unsigned*>(prow + off_k);
            plf += lstep;
          }
          rq[i] = *reinterpret_cast<const unsigned*>(prow + off_q);
          prow += rstep;
        }
      }
#pragma unroll
      for (int r = 0; r < (NVI + 255) / 256; ++r) {
        const int it = min(tid + r * 256, NVI - 1);
        const int l = it / (DVS / 8), e8 = (it % (DVS / 8)) * 8;
        rv[r] = *reinterpret_cast<const uint4*>(p.P + lrow(base, l) * PW + vcol + e8);
      }
    };
    issue_loads(0);
    for (int n = 0; n < NCH; ++n) {
      const int par = n & 1;
      float* totp = tot + par * 4 * DK;
      float* lfp = lf32 + par * DK;
      const long base = chunk_base(n);
      if (cact) {
        float r0 = 0.f, r1 = 0.f;
#pragma unroll
        for (int i = 0; i < 16; ++i) { r0 += bf_lo(rlf[i]); r1 += bf_hi(rlf[i]); }
        totp[w * DK + c0] = r0; totp[w * DK + c0 + 1] = r1;
        if (w == 2) { lfp[c0] = bf_lo(rlf[0]); lfp[c0 + 1] = bf_hi(rlf[0]); }
      }
      __syncthreads();
#pragma unroll
      for (int r = 0; r < (NVI + 255) / 256; ++r) {
        const int it = tid + r * 256;
        if (it < NVI) {
          const int l = it / (DVS / 8), e8 = (it % (DVS / 8)) * 8;
          const unsigned vw[4] = {rv[r].x, rv[r].y, rv[r].z, rv[r].w};
#pragma unroll
          for (int e = 0; e < 4; ++e) {
            VT[(e8 + 2 * e) * LS + l] = (act_t)(vw[e] & 0xffffu);
            VT[(e8 + 2 * e + 1) * LS + l] = (act_t)(vw[e] >> 16);
          }
        }
      }
      if (cact) {
        float of0 = 0.f, of1 = 0.f;
#pragma unroll
        for (int sgi = 0; sgi < 3; ++sgi)
          if (sgi < w) { of0 += totp[sgi * DK + c0]; of1 += totp[sgi * DK + c0 + 1]; }
        const float ref0 = totp[c0] + totp[DK + c0] + lfp[c0];
        const float ref1 = totp[c0 + 1] + totp[DK + c0 + 1] + lfp[c0 + 1];
        unsigned kt0[8], kt1[8];
        float run0 = of0 - ref0, run1 = of1 - ref1;
#pragma unroll
        for (int i = 0; i < 16; i += 2) {
          float ka0[2], ka1[2];
#pragma unroll
          for (int ii = 0; ii < 2; ++ii) {
            const int i2 = i + ii;
            run0 += bf_lo(rlf[i2]); run1 += bf_hi(rlf[i2]);
            const float b0 = run0, b1 = run1;
            const float e0 = __expf(b0), e1 = __expf(b1), f0 = __expf(-b0), f1 = __expf(-b1);
            float k0, k1;
            if (MODE == 0) { k0 = 1.0f - __expf(bf_lo(rlf[i2])); k1 = 1.0f - __expf(bf_hi(rlf[i2])); }
            else { k0 = bf_lo(rk[i2]); k1 = bf_hi(rk[i2]); }
            ka0[ii] = k0 * f0; ka1[ii] = k1 * f1;
            const int l = w * 16 + i2;
            *reinterpret_cast<unsigned*>(Qa + l * QS + c0) = pack2(bf_lo(rq[i2]) * e0, bf_hi(rq[i2]) * e1);
            *reinterpret_cast<unsigned*>(Ka + l * QS + c0) = pack2(ka0[ii], ka1[ii]);
          }
          kt0[i >> 1] = pack2(ka0[0], ka0[1]);
          kt1[i >> 1] = pack2(ka1[0], ka1[1]);
        }
        uint4* d0 = reinterpret_cast<uint4*>(KaT + c0 * LS + w * 16);
        d0[0] = make_uint4(kt0[0], kt0[1], kt0[2], kt0[3]); d0[1] = make_uint4(kt0[4], kt0[5], kt0[6], kt0[7]);
        uint4* d1 = reinterpret_cast<uint4*>(KaT + (c0 + 1) * LS + w * 16);
        d1[0] = make_uint4(kt1[0], kt1[1], kt1[2], kt1[3]); d1[1] = make_uint4(kt1[4], kt1[5], kt1[6], kt1[7]);
      }
      issue_loads(min(n + 1, NCH - 1));
      float egv[2], egrv[2];
#pragma unroll
      for (int di = 0; di < 2; ++di) {
        const int dt = w + 4 * di;
        if (dt < NDT) {
          const int d = dt * 16 + fr;
          const float refd = totp[d] + totp[DK + d] + lfp[d];
          const float gd = totp[d] + totp[DK + d] + totp[2 * DK + d] + totp[3 * DK + d];
          const float er = __expf(refd);
          egv[di] = __expf(gd); egrv[di] = __expf(gd - refd);
#pragma unroll
          for (int et = 0; et < NET; ++et)
#pragma unroll
            for (int j = 0; j < 4; ++j) stA(ST + (et * 16 + 4 * g + j) * SS + d, S[et][di][j] * er);
        }
      }
      __syncthreads();
      bf16x8 qfr[NKS];
#pragma unroll
      for (int ks = 0; ks < NKS; ++ks) qfr[ks] = *reinterpret_cast<const bf16x8*>(Qa + (w * 16 + fr) * QS + ks * 32 + g * 8);
      bf16x8 pfr[2];
#pragma unroll
      for (int kb = 0; kb < 2; ++kb) {
        f32x4 at2[2];
#pragma unroll
        for (int h2 = 0; h2 < 2; ++h2) {
          const int mt = 2 * kb + h2;
          at2[h2] = f32x4{0.f, 0.f, 0.f, 0.f};
          if (mt <= w) {
#pragma unroll
            for (int ks = 0; ks < NKS; ++ks) {
              const bf16x8 kaf = *reinterpret_cast<const bf16x8*>(Ka + (mt * 16 + fr) * QS + ks * 32 + g * 8);
              at2[h2] = __builtin_amdgcn_mfma_f32_16x16x32_bf16(kaf, qfr[ks], at2[h2], 0, 0, 0);
            }
            if (mt == w) {
#pragma unroll
              for (int j = 0; j < 4; ++j)
                if (4 * g + j > fr) at2[h2][j] = 0.f;
            }
          }
        }
        union { unsigned u[4]; bf16x8 v; } cv;
        cv.u[0] = pack2_mfma(at2[0][0], at2[0][1]); cv.u[1] = pack2_mfma(at2[0][2], at2[0][3]);
        cv.u[2] = pack2_mfma(at2[1][0], at2[1][1]); cv.u[3] = pack2_mfma(at2[1][2], at2[1][3]);
        pfr[kb] = cv.v;
      }
      const long orow = lrow(base, w * 16 + fr);
#pragma unroll
      for (int et = 0; et < NET; ++et) {
        f32x4 o = f32x4{0.f, 0.f, 0.f, 0.f};
#pragma unroll
        for (int kb = 0; kb < 2; ++kb) {
          if (2 * kb <= w) {
            union { uint2 h2[2]; bf16x8 v; } vf;
            vf.h2[0] = *reinterpret_cast<const uint2*>(VT + (et * 16 + fr) * LS + kb * 32 + 4 * g);
            vf.h2[1] = *reinterpret_cast<const uint2*>(VT + (et * 16 + fr) * LS + kb * 32 + 16 + 4 * g);
            o = __builtin_amdgcn_mfma_f32_16x16x32_bf16(vf.v, pfr[kb], o, 0, 0, 0);
          }
        }
#pragma unroll
        for (int ks = 0; ks < NKS; ++ks) {
          const bf16x8 sf = *reinterpret_cast<const bf16x8*>(ST + (et * 16 + fr) * SS + ks * 32 + g * 8);
          o = __builtin_amdgcn_mfma_f32_16x16x32_bf16(sf, qfr[ks], o, 0, 0, 0);
        }
        const float osc = MODE == 0 ? 1.0f : 0.10206207261596575f;
        *reinterpret_cast<uint2*>(OD + orow * 768 + ocol + et * 16 + 4 * g) =
            make_uint2(pack2(o[0] * osc, o[1] * osc), pack2(o[2] * osc, o[3] * osc));
      }
#pragma unroll
      for (int di = 0; di < 2; ++di) {
        const int dt = w + 4 * di;
        if (dt < NDT) {
#pragma unroll
          for (int et = 0; et < NET; ++et) {
            f32x4 r = f32x4{0.f, 0.f, 0.f, 0.f};
#pragma unroll
            for (int k2 = 0; k2 < 2; ++k2) {
              const bf16x8 vf = *reinterpret_cast<const bf16x8*>(VT + (et * 16 + fr) * LS + k2 * 32 + g * 8);
              const bf16x8 kf = *reinterpret_cast<const bf16x8*>(KaT + (dt * 16 + fr) * LS + k2 * 32 + g * 8);
              r = __builtin_amdgcn_mfma_f32_16x16x32_bf16(vf, kf, r, 0, 0, 0);
            }
#pragma unroll
            for (int j = 0; j < 4; ++j) S[et][di][j] = egv[di] * S[et][di][j] + egrv[di] * r[j];
          }
        }
      }
    }
    __syncthreads();
  }
}

struct GemmJob {
  const act_t* A; const act_t* Bt; act_t* C;
  long sA, sB, sC;
  int nbatch, Mtiles, Ntiles, K, ldc, Nvalid, mode;
  float scale;
  int fp8;
  int out8;
};
__device__ __forceinline__ void phase_gemm(const Params& p, const GemmJob& g, unsigned char* smem, int blk = blockIdx.x, int nblk = gridDim.x) {
  const int per_b = g.Mtiles * g.Ntiles;
  const int ntiles = per_b * g.nbatch;
  auto tvalid = [&](int t) -> bool {
    const int tt = t % per_b;
    const int tm = tt / g.Ntiles, tn = tt % g.Ntiles;
    return !(g.mode == 1 && tm < NC / 128 && tn * 128 >= O_FA);
  };
  auto tnext = [&](int t) -> int { t += nblk; while (t < ntiles && !tvalid(t)) t += nblk; return t; };
  int par = 0;
  bool primed = false;
  int tile0 = blk;
  if (tile0 < ntiles && !tvalid(tile0)) tile0 = tnext(tile0);
  for (int tile = tile0; tile < ntiles;) {
    const int ntile = tnext(tile);
    const int b = tile / per_b, tt = tile % per_b;
    const int tm = tt / g.Ntiles, tn = tt % g.Ntiles;
    const int tt2 = (ntile < ntiles ? ntile : tile) % per_b;
    const int tm2 = tt2 / g.Ntiles, tn2 = tt2 % g.Ntiles;
    const int K = g.K, ldc = g.ldc;
    const act_t* Ab = g.A + b * g.sA + (long)tm * 128 * K;
    act_t* Cb = g.C + b * g.sC + (long)tm * 128 * ldc + tn * 128;
    const int nlim = g.Nvalid - tn * 128;
    const float scale = g.scale;
    const int mode = g.mode;
    if (mode == 1) {
      auto epi1 = [&](f32x4 (&acc)[4][4], int wr, int wc, int fr, int fq) {
                  if (g.fp8) {
#pragma unroll
                    for (int m = 0; m < 4; ++m)
#pragma unroll
                      for (int n = 0; n < 4; ++n) acc[m][n] = acc[m][n] * scale;
                  }
#pragma unroll
                  for (int m = 0; m < 4; ++m)
#pragma unroll
                    for (int n = 0; n < 4; ++n) {
                      const int col = wc * 64 + n * 16 + fr;
                      if (col < nlim) {
#pragma unroll
                        for (int j = 0; j < 4; ++j) {
                          const int row = wr * 64 + m * 16 + fq * 4 + j;
                          stA(Cb + (long)row * ldc + col, acc[m][n][j]);
                        }
                      } else {
                        const int gc = tn * 128 + col;
                        if (gc < O_END && tm >= NC / 128) {
                          const int lr = (tm - NC / 128) * 128 + wr * 64 + m * 16 + fq * 4;
                          const int bb = lr / T, t = lr % T;
                          const int cq = gc < O_FB ? gc - O_FA : gc - O_FB;
                          act_t* dst = p.FT + ((long)bb * 256 + cq) * (2 * T) + (gc < O_FB ? 0 : T) + t;
                          *reinterpret_cast<uint2*>(dst) = make_uint2(pack2(acc[m][n][0], acc[m][n][1]), pack2(acc[m][n][2], acc[m][n][3]));
                        }
                      }
                    }
                };
      if (g.fp8) {
        const fp8_t* A8 = (const fp8_t*)g.A + (long)tm * 128 * K;
        gemm_tile8p<false>(A8, (const fp8_t*)g.Bt + (long)tn * 128 * K, ntile < ntiles, (const fp8_t*)g.A + (long)tm2 * 128 * K,
                           (const fp8_t*)g.Bt + (long)tn2 * 128 * K, par, primed, K, smem, epi1);
      } else {
        gemm_tile<false>([&](int r) { return Ab + (long)r * K; }, g.Bt + b * g.sB + (long)tn * 128 * K, K, smem, epi1);
      }
    } else {
      auto epi2 = [&](f32x4 (&acc)[4][4], int wr, int wc, int fr, int fq) {
                  const float oscale = g.fp8 ? 1.0f : scale;
                  if (g.fp8) {
#pragma unroll
                    for (int m = 0; m < 4; ++m)
#pragma unroll
                      for (int n = 0; n < 4; ++n) acc[m][n] = acc[m][n] * scale;
                  }
                  if (mode == 2) {
                    const int cb = tn * 128 + wc * 64;
                    if (cb < E_AV && tm >= NC / 128) {
                      const float4* rt = reinterpret_cast<const float4*>(p.ropetab);
#pragma unroll
                      for (int m = 0; m < 4; ++m) {
                        const int t = ((tm - NC / 128) * 128 + wr * 64 + m * 16 + fr) % T;
                        const float4 r01 = rt[(t / GRID_W) * 8 + fq * 2], r23 = rt[(t / GRID_W) * 8 + fq * 2 + 1];
                        const float4 c01 = rt[(t % GRID_W) * 8 + fq * 2], c23 = rt[(t % GRID_W) * 8 + fq * 2 + 1];
                        const float rc[4] = {r01.x, r01.z, r23.x, r23.z}, rs_[4] = {r01.y, r01.w, r23.y, r23.w};
                        const float cc[4] = {c01.x, c01.z, c23.x, c23.z}, cs_[4] = {c01.y, c01.w, c23.y, c23.w};
#pragma unroll
                        for (int j = 0; j < 4; ++j) {
                          const float a1 = acc[m][0][j], a2 = acc[m][1][j], b1 = acc[m][2][j], b2 = acc[m][3][j];
                          acc[m][0][j] = a1 * rc[j] - a2 * rs_[j]; acc[m][1][j] = a1 * rs_[j] + a2 * rc[j];
                          acc[m][2][j] = b1 * cc[j] - b2 * cs_[j]; acc[m][3][j] = b1 * cs_[j] + b2 * cc[j];
                        }
                      }
                    } else if (cb >= E_FF && cb < E_HQ) {
#pragma unroll
                      for (int n = 0; n < 4; ++n) {
                        const float4 lb4 = *reinterpret_cast<const float4*>(p.lbt + cb - E_FF + n * 16 + fq * 4);
                        const float lb[4] = {lb4.x, lb4.y, lb4.z, lb4.w};
#pragma unroll
                        for (int m = 0; m < 4; ++m)
#pragma unroll
                          for (int j = 0; j < 4; ++j)
                            acc[m][n][j] = __logf(lb[j] + (1.0f - lb[j]) / (1.0f + __expf(-acc[m][n][j])));
                      }
                    }
                  }
#pragma unroll
                  for (int m = 0; m < 4; ++m) {
                    const int row = wr * 64 + m * 16 + fr;
#pragma unroll
                    for (int n = 0; n < 4; ++n) {
                      const int col = wc * 64 + n * 16 + fq * 4;
                      if (col < nlim) {
                        if (g.out8)
                          *reinterpret_cast<unsigned*>(reinterpret_cast<fp8_t*>(g.C) + b * g.sC + ((long)tm * 128 + row) * ldc + tn * 128 + col) =
                              pack4_fp8(acc[m][n][0] * oscale, acc[m][n][1] * oscale, acc[m][n][2] * oscale, acc[m][n][3] * oscale);
                        else
                          *reinterpret_cast<uint2*>(Cb + (long)row * ldc + col) =
                              make_uint2(pack2(acc[m][n][0] * oscale, acc[m][n][1] * oscale), pack2(acc[m][n][2] * oscale, acc[m][n][3] * oscale));
                      }
                    }
                  }
                };
      if (g.fp8) {
        const fp8_t* A8 = (const fp8_t*)g.A + (long)tm * 128 * K;
        gemm_tile8p<true>(A8, (const fp8_t*)g.Bt + (long)tn * 128 * K, ntile < ntiles, (const fp8_t*)g.A + (long)tm2 * 128 * K,
                          (const fp8_t*)g.Bt + (long)tn2 * 128 * K, par, primed, K, smem, epi2);
      } else {
        gemm_tile<true>([&](int r) { return Ab + (long)r * K; }, g.Bt + b * g.sB + (long)tn * 128 * K, K, smem, epi2);
      }
    }
    tile = ntile;
  }
}

template <class RowMap>
__device__ __forceinline__ void conv_tile_rm(const float* src, int lds_, int Nvalid, int k0, int n0, act_t* dst, int ldd, float* tile, RowMap rm) {
  const int tid = threadIdx.x;
  {
    const int r = tid >> 5, c4 = (tid & 31) * 4;
    float4 v[8];
#pragma unroll
    for (int rr = 0; rr < 8; ++rr) {
      v[rr] = make_float4(0.f, 0.f, 0.f, 0.f);
      if (n0 + c4 < Nvalid) v[rr] = *reinterpret_cast<const float4*>(src + (long)(k0 + r + rr * 8) * lds_ + n0 + c4);
    }
#pragma unroll
    for (int rr = 0; rr < 8; ++rr) {
      float* t = tile + (r + rr * 8) * 129 + c4;
      t[0] = v[rr].x; t[1] = v[rr].y; t[2] = v[rr].z; t[3] = v[rr].w;
    }
  }
  __syncthreads();
  {
    const int n = tid >> 1, ks = (tid & 1) * 32;
    if (n0 + n < Nvalid) {
      unsigned w[16];
#pragma unroll
      for (int i = 0; i < 16; ++i) w[i] = pack2(tile[(ks + 2 * i) * 129 + n], tile[(ks + 2 * i + 1) * 129 + n]);
      uint4* d = reinterpret_cast<uint4*>(dst + (long)rm(n) * ldd + k0 + ks);
      d[0] = make_uint4(w[0], w[1], w[2], w[3]);
      d[1] = make_uint4(w[4], w[5], w[6], w[7]);
      d[2] = make_uint4(w[8], w[9], w[10], w[11]);
      d[3] = make_uint4(w[12], w[13], w[14], w[15]);
    }
  }
  __syncthreads();
}

template <class RowMap>
__device__ __forceinline__ void conv_tile8_rm(const float* src, int lds_, int k0, int n0, fp8_t* dst, int ldd, float* tile, float scale, RowMap rm, int Nvalid = 1 << 30) {
  const int tid = threadIdx.x;
  {
    const int r = tid >> 5, c4 = (tid & 31) * 4;
    float4 v[8];
#pragma unroll
    for (int rr = 0; rr < 8; ++rr) {
      v[rr] = make_float4(0.f, 0.f, 0.f, 0.f);
      if (n0 + c4 < Nvalid) v[rr] = *reinterpret_cast<const float4*>(src + (long)(k0 + r + rr * 8) * lds_ + n0 + c4);
    }
#pragma unroll
    for (int rr = 0; rr < 8; ++rr) {
      float* t = tile + (r + rr * 8) * 129 + c4;
      t[0] = v[rr].x; t[1] = v[rr].y; t[2] = v[rr].z; t[3] = v[rr].w;
    }
  }
  __syncthreads();
  if ((threadIdx.x >> 1) + n0 < Nvalid) {
    const int n = tid >> 1, ks = (tid & 1) * 32;
    unsigned w[8];
#pragma unroll
    for (int i = 0; i < 8; ++i)
      w[i] = pack4_fp8(tile[(ks + 4 * i) * 129 + n] * scale, tile[(ks + 4 * i + 1) * 129 + n] * scale,
                       tile[(ks + 4 * i + 2) * 129 + n] * scale, tile[(ks + 4 * i + 3) * 129 + n] * scale);
    uint4* d = reinterpret_cast<uint4*>(dst + (long)rm(n) * ldd + k0 + ks);
    d[0] = make_uint4(w[0], w[1], w[2], w[3]);
    d[1] = make_uint4(w[4], w[5], w[6], w[7]);
  }
  __syncthreads();
}

__device__ __forceinline__ void conv_tile(const float* src, int lds_, int Nvalid, int k0, int n0, act_t* dst, int ldd, float* tile) {
  conv_tile_rm(src, lds_, Nvalid, k0, n0, dst, ldd, tile, [=](int n) { return n0 + n; });
}

struct ConvJob { const float* src; fp8_t* dst; int lds, ldd, k0, n0, rbase, ra, rb; };
__device__ __forceinline__ void phase_convert_experts(const Params& p, int l, unsigned char* smem, int blk, int nblk) {
  float* tile = (float*)smem;
  const int per_e = 192, total = NEXP * per_e;
  fp8_t* Wup = l == 0 ? p.W8up : p.W8up1;
  fp8_t* Wdn = l == 0 ? p.W8down : p.W8down1;
  const int tid = threadIdx.x;
  auto mkjob = [&](int job) -> ConvJob {
    const int e = job / per_e, j = job % per_e;
    ConvJob c;
    if (j < 128) {
      const int up = j >> 6, jj = j & 63;
      const int kt = jj >> 2, fp = jj & 3;
      c.src = (up ? p.w_eu : p.w_eg) + ((long)(l * NEXP + e) * D) * DFF;
      c.dst = Wup + (long)e * 1024 * D; c.lds = DFF; c.ldd = D; c.k0 = kt * 64; c.n0 = fp * 128;
      c.rbase = fp * 256 + up * 32; c.ra = 128; c.rb = 64;
    } else {
      const int jj = j - 128;
      const int kt = jj >> 3, nt = jj & 7;
      c.src = p.w_ed + ((long)(l * NEXP + e) * DFF) * D;
      c.dst = Wdn + (long)e * 1024 * DFF; c.lds = D; c.ldd = DFF; c.k0 = kt * 64; c.n0 = nt * 128;
      c.rbase = nt * 128; c.ra = 64; c.rb = 32;
    }
    return c;
  };
  float4 v[8];
  auto ld = [&](const ConvJob& c) {
    const int r = tid >> 5, c4 = (tid & 31) * 4;
#pragma unroll
    for (int rr = 0; rr < 8; ++rr) v[rr] = *reinterpret_cast<const float4*>(c.src + (long)(c.k0 + r + rr * 8) * c.lds + c.n0 + c4);
  };
  int job = blk;
  if (job >= total) return;
  ConvJob cur = mkjob(job);
  ld(cur);
  while (job < total) {
    {
      const int r = tid >> 5, c4 = (tid & 31) * 4;
#pragma unroll
      for (int rr = 0; rr < 8; ++rr) {
        float* t = tile + (r + rr * 8) * 129 + c4;
        t[0] = v[rr].x; t[1] = v[rr].y; t[2] = v[rr].z; t[3] = v[rr].w;
      }
    }
    __syncthreads();
    const int nxt = job + nblk;
    const ConvJob nj = mkjob(min(nxt, total - 1));
    ld(nj);
    {
      const int n = tid >> 1, ks = (tid & 1) * 32;
      unsigned w[8];
#pragma unroll
      for (int i = 0; i < 8; ++i)
        w[i] = pack4_fp8(tile[(ks + 4 * i) * 129 + n] * SW8, tile[(ks + 4 * i + 1) * 129 + n] * SW8,
                         tile[(ks + 4 * i + 2) * 129 + n] * SW8, tile[(ks + 4 * i + 3) * 129 + n] * SW8);
      const int row = cur.rbase + (n >> 6) * cur.ra + ((n >> 5) & 1) * cur.rb + (n & 31);
      uint4* d = reinterpret_cast<uint4*>(cur.dst + (long)row * cur.ldd + cur.k0 + ks);
      d[0] = make_uint4(w[0], w[1], w[2], w[3]);
      d[1] = make_uint4(w[4], w[5], w[6], w[7]);
    }
    __syncthreads();
    cur = nj;
    job = nxt;
  }
}

__device__ __forceinline__ void phase_moe(const Params& p, int l, bool down, unsigned char* smem) {
  const int* cntp = p.cnt + l * NEXP * 64;
  int total = 0;
  for (int e = 0; e < NEXP; ++e) total += ((cntp[e * 64] + 127) >> 7) * 8;
  for (int tile = blockIdx.x; tile < total; tile += gridDim.x) {
    int e = 0, tb = 0, rowoff = 0;
    for (; e < NEXP - 1; ++e) {
      const int c = cntp[e * 64];
      const int nt = ((c + 127) >> 7) * 8;
      if (tile < tb + nt) break;
      tb += nt; rowoff += c;
    }
    const int c = cntp[e * 64];
    const int lt = tile - tb, mt = lt >> 3, nt = lt & 7;
    const int rows_valid = min(128, c - mt * 128);
    const int* lst = p.list + (long)(l * NEXP + e) * NR + mt * 128;
    const long hrow0 = (long)rowoff + mt * 128;
    if (!down) {
      gemm_tile8<true>([&](int r) { return p.u8 + (long)(lst[min(r, rows_valid - 1)] >> 1) * D; },
                (l == 0 ? p.W8up : p.W8up1) + ((long)e * 1024 + nt * 128) * D, D, smem,
                [&](f32x4 (&acc)[4][4], int wr, int wc, int fr, int fq) {
                  constexpr float dq = 1.0f / (SU8 * SW8);
#pragma unroll
                  for (int m = 0; m < 4; ++m) {
                    const int row = wr * 64 + m * 16 + fr;
                    if (row < rows_valid) {
#pragma unroll
                      for (int n = 0; n < 2; ++n) {
                        float hv[4];
#pragma unroll
                        for (int j = 0; j < 4; ++j) {
                          const float g = acc[m][n][j] * dq, uu = acc[m][n + 2][j] * dq;
                          hv[j] = g / (1.0f + __expf(-g)) * uu * SH8;
                        }
                        *reinterpret_cast<unsigned*>(p.H8 + (hrow0 + row) * DFF + nt * 64 + wc * 32 + n * 16 + fq * 4) =
                            pack4_fp8(hv[0], hv[1], hv[2], hv[3]);
                      }
                    }
                  }
                });
    } else {
      const fp8_t* Ab = p.H8 + hrow0 * DFF;
      gemm_tile8<true>([&](int r) { return Ab + (long)r * DFF; }, (l == 0 ? p.W8down : p.W8down1) + ((long)e * 1024 + nt * 128) * DFF, DFF, smem,
                [&](f32x4 (&acc)[4][4], int wr, int wc, int fr, int fq) {
                  constexpr float dq = 1.0f / (SH8 * SW8);
#pragma unroll
                  for (int m = 0; m < 4; ++m) {
                    const int row = wr * 64 + m * 16 + fr;
                    if (row < rows_valid) {
                      const int ts = lst[row];
                      const float w = p.ew[ts] * dq;
#pragma unroll
                      for (int n = 0; n < 4; ++n)
                        *reinterpret_cast<uint2*>(p.Y + (long)ts * D + nt * 128 + wc * 64 + n * 16 + fq * 4) =
                            make_uint2(pack2(acc[m][n][0] * w, acc[m][n][1] * w), pack2(acc[m][n][2] * w, acc[m][n][3] * w));
                    }
                  }
                });
    }
  }
}

__device__ __forceinline__ void phase_convert_dense(const Params& p, unsigned char* smem) {
  float* tile = (float*)smem;
  const int JM = MOD_ITEMS, J0 = JM + 16 * 26, J1 = J0 + 128, J2 = J1 + 16 * 19, J3 = J2 + 128;
  for (int job = blockIdx.x; job < J3; job += gridDim.x) {
    if (job < JM) { mod_item(p, job, smem); continue; }
    if (job < J0) { int j = job - JM; const int n0 = (j % 26) * 128; conv_tile8_rm(p.w_in_even, IN_EVEN, (j / 26) * 64, n0, p.W8in_even, D, tile, SW8, [=](int n) { return n0 + n; }); }
    else if (job < J1) { int j = job - J0; const int n0 = (j % 8) * 128; conv_tile8_rm(p.w_out_even, D, (j / 8) * 64, n0, p.W8out_even, D, tile, SW8, [=](int n) { return n0 + n; }); }
    else if (job < J2) { int j = job - J1; const int n0 = (j % 19) * 128; conv_tile8_rm(p.w_in_odd, IN_ODD, (j / 19) * 64, n0, p.W8in_odd, D, tile, SW8, [=](int n) { return n0 + n; }, O_FA); }
    else { int j = job - J2; const int n0 = (j % 8) * 128; conv_tile8_rm(p.w_out_odd, D, (j / 8) * 64, n0, p.W8out_odd, D, tile, SW8, [=](int n) { return n0 + n; }); }
  }
}

__device__ __forceinline__ void phase_fold_z(const Params& p, long gtid, long gstride, float* tab) {
  if (threadIdx.x < 64) {
    float sn, cs;
    sincospif((float)threadIdx.x * (1.0f / 32.0f), &sn, &cs);
    tab[threadIdx.x] = cs; tab[64 + threadIdx.x] = -sn;
  }
  __syncthreads();
  for (long i = gtid; i < (long)512 * D; i += gstride) {
    const int k = (int)(i % D), np = (int)(i / D);
    const int part = np >> 8, col = np & 255, g = col >> 6, cp = col & 63;
    const float* wz = p.w_in_odd + (long)k * IN_ODD + O_Z + g * 64;
    float s = 0.f;
    const float* tb = tab + part * 64;
    float4 wv[16];
#pragma unroll
    for (int q = 0; q < 16; ++q) wv[q] = reinterpret_cast<const float4*>(wz)[q];
#pragma unroll
    for (int q = 0; q < 16; ++q) {
      s += wv[q].x * tb[((4 * q) * cp) & 63] + wv[q].y * tb[((4 * q + 1) * cp) & 63] + wv[q].z * tb[((4 * q + 2) * cp) & 63] +
           wv[q].w * tb[((4 * q + 3) * cp) & 63];
    }
    const unsigned q = pack4_fp8(s * SW8, 0.f, 0.f, 0.f);
    p.W8in_odd[(long)(O_FA + np) * D + k] = (unsigned char)(q & 0xffu);
  }
  for (long i = gtid; i < (long)(IN_ODD_PAD - O_END) * D; i += gstride) p.W8in_odd[(long)O_END * D + i] = 0;
}

__device__ __forceinline__ void phase_cmat(const Params& p, long gtid, long gstride) {
  for (long i = gtid; i < (long)T * T; i += gstride) {
    const int t = (int)(i % T), tp = (int)(i / T);
    float sn, cs;
    sincospif((float)((t * tp) & (T - 1)) * (2.0f / T), &sn, &cs);
    stA(p.Cmat + (long)tp * 2 * T + t, cs);
    stA(p.Cmat + (long)tp * 2 * T + T + t, sn);
  }
}

__device__ __forceinline__ void row_stats(const float4 (&v)[4], float& mu, float& rs) {
  float s = 0.f;
#pragma unroll
  for (int i = 0; i < 4; ++i) s += v[i].x + v[i].y + v[i].z + v[i].w;
  mu = wave_sum(s) * (1.0f / D);
  float q = 0.f;
#pragma unroll
  for (int i = 0; i < 4; ++i) {
    float a = v[i].x - mu, b = v[i].y - mu, c = v[i].z - mu, d = v[i].w - mu;
    q += a * a + b * b + c * c + d * d;
  }
  rs = 1.0f / sqrtf(wave_sum(q) * (1.0f / D) + LN_EPS);
}

__device__ __forceinline__ void phase_lnmod_first(const Params& p) {
  const int lane = threadIdx.x & 63;
  const int nw = (int)gridDim.x * 4, wi = (int)blockIdx.x * 4 + (int)(threadIdx.x >> 6);
  const int rpw = (NR + nw - 1) / nw;
  const long r0 = (long)wi * rpw, r1 = min((long)NR, r0 + rpw);
  float4 shv[4], scv[4];
  int cur_bb = -2;
  float4 hv[4];
  auto load_row = [&](long row) {
    const float4* h = reinterpret_cast<const float4*>(hrow_in(p, row));
#pragma unroll
    for (int i = 0; i < 4; ++i) hv[i] = h[i * 64 + lane];
  };
  if (r0 < r1) load_row(r0);
  for (long row = r0; row < r1; ++row) {
    const int bb = row < NC ? NB : (int)((row - NC) / T);
    if (bb != cur_bb) {
      cur_bb = bb;
      const float* md = p.mod + (long)bb * 6 * D;
#pragma unroll
      for (int i = 0; i < 4; ++i) {
        shv[i] = reinterpret_cast<const float4*>(md)[i * 64 + lane];
        scv[i] = reinterpret_cast<const float4*>(md + D)[i * 64 + lane];
      }
    }
    float4 v[4];
#pragma unroll
    for (int i = 0; i < 4; ++i) v[i] = hv[i];
    load_row(min(row + 1, r1 - 1));
    float mu, rs;
    row_stats(v, mu, rs);
#pragma unroll
    for (int i = 0; i < 4; ++i) {
      const float a = (v[i].x - mu) * rs * (1.f + scv[i].x) + shv[i].x, b = (v[i].y - mu) * rs * (1.f + scv[i].y) + shv[i].y;
      const float c = (v[i].z - mu) * rs * (1.f + scv[i].z) + shv[i].z, d = (v[i].w - mu) * rs * (1.f + scv[i].w) + shv[i].w;
      reinterpret_cast<unsigned*>(p.u8 + row * D)[i * 64 + lane] = pack4_fp8(a * SU8, b * SU8, c * SU8, d * SU8);
    }
  }
}

__device__ __forceinline__ act_t* hrow16(const Params& p, long row) {
  return row < NC ? reinterpret_cast<act_t*>(p.hc) + row * D
                  : reinterpret_cast<act_t*>(reinterpret_cast<char*>(p.out) + (row - NC) * (long)(4 * D) + 2 * D);
}
template <int R_UNUSED>
__device__ __forceinline__ void phase_resid_ln(const Params& p, int l, int sub, long row_lo, long row_hi, unsigned char* smem) {
  const int lane = threadIdx.x & 63;
  int* cntL = (int*)smem;
  int* nent = cntL + 16;
  int* entL = cntL + 32;
  float* wT = (float*)(smem + 4096);
  if (sub == 0) {
    if (threadIdx.x < 32) cntL[threadIdx.x] = 0;
    {
      float4 wr4[16];
#pragma unroll
      for (int j = 0; j < 4; ++j)
#pragma unroll
        for (int q = 0; q < 4; ++q) wr4[j * 4 + q] = reinterpret_cast<const float4*>(p.w_router + (long)(threadIdx.x + 256 * j) * NEXP)[q];
#pragma unroll
      for (int j = 0; j < 4; ++j)
#pragma unroll
        for (int q = 0; q < 4; ++q) {
          const int k = threadIdx.x + 256 * j;
          wT[(q * 4 + 0) * D + k] = wr4[j * 4 + q].x; wT[(q * 4 + 1) * D + k] = wr4[j * 4 + q].y;
          wT[(q * 4 + 2) * D + k] = wr4[j * 4 + q].z; wT[(q * 4 + 3) * D + k] = wr4[j * 4 + q].w;
        }
    }
    __syncthreads();
  }
  const bool last = (sub == 1 && l == 1);
  const int nw = (int)gridDim.x * 4, wi = (int)blockIdx.x * 4 + (int)(threadIdx.x >> 6);
  const int rpw = ((int)(row_hi - row_lo) + nw - 1) / nw;
  const long r0 = row_lo + (long)wi * rpw, r1 = min(row_hi, r0 + rpw);
  const float4* lgp = reinterpret_cast<const float4*>(p.ln_g + (l * 2 + sub) * D);
  const float4* lbp = reinterpret_cast<const float4*>(p.ln_b + (l * 2 + sub) * D);
  float4 lgv[4], lbv[4];
  if (R_UNUSED != 1) {
#pragma unroll
    for (int i = 0; i < 4; ++i) { lgv[i] = lgp[i * 64 + lane]; lbv[i] = lbp[i * 64 + lane]; }
  }
  float4 gv[4], shv[4], scv[4];
  int cur_bb = -2;
  const bool first = (l == 0 && sub == 0);
  float4 hv[4];
  uint2 hb[4];
  uint2 mv[4], m2v[4];
  auto load_row = [&](long row) {
    const uint2* m = reinterpret_cast<const uint2*>(sub == 0 ? p.M + row * D : p.Y + row * 2 * D);
    if (first) {
      const float4* hin = reinterpret_cast<const float4*>(hrow_in(p, row));
#pragma unroll
      for (int i = 0; i < 4; ++i) hv[i] = hin[i * 64 + lane];
    } else {
      const uint2* hin = reinterpret_cast<const uint2*>(hrow16(p, row));
#pragma unroll
      for (int i = 0; i < 4; ++i) hb[i] = hin[i * 64 + lane];
    }
#pragma unroll
    for (int i = 0; i < 4; ++i) {
      mv[i] = m[i * 64 + lane];
      if (sub == 1) m2v[i] = m[256 + i * 64 + lane];
    }
  };
  if (r0 < r1) load_row(r0);
  for (long row = r0; row < r1; ++row) {
    const int bb = row < NC ? NB : (int)((row - NC) / T);
    if (bb != cur_bb) {
      cur_bb = bb;
      const float* md = p.mod + ((long)l * (NB + 1) + bb) * 6 * D;
      const float* md2 = (sub == 0) ? md + 3 * D : p.mod + ((long)(NB + 1) + bb) * 6 * D;
#pragma unroll
      for (int i = 0; i < 4; ++i) {
        gv[i] = reinterpret_cast<const float4*>(md + (sub == 0 ? 2 : 5) * D)[i * 64 + lane];
        shv[i] = reinterpret_cast<const float4*>(md2)[i * 64 + lane];
        scv[i] = reinterpret_cast<const float4*>(md2 + D)[i * 64 + lane];
      }
    }
    float4 v[4];
#pragma unroll
    for (int i = 0; i < 4; ++i) {
      float m0 = bf_lo(mv[i].x), m1 = bf_hi(mv[i].x), m2_ = bf_lo(mv[i].y), m3 = bf_hi(mv[i].y);
      if (sub == 1) { m0 += bf_lo(m2v[i].x); m1 += bf_hi(m2v[i].x); m2_ += bf_lo(m2v[i].y); m3 += bf_hi(m2v[i].y); }
      const float h0 = first ? hv[i].x : bf_lo(hb[i].x), h1 = first ? hv[i].y : bf_hi(hb[i].x);
      const float h2 = first ? hv[i].z : bf_lo(hb[i].y), h3 = first ? hv[i].w : bf_hi(hb[i].y);
      v[i].x = ALPHA * h0 + gv[i].x * m0;
      v[i].y = ALPHA * h1 + gv[i].y * m1;
      v[i].z = ALPHA * h2 + gv[i].z * m2_;
      v[i].w = ALPHA * h3 + gv[i].w * m3;
    }
    load_row(min(row + 1, r1 - 1));
    if (R_UNUSED == 1) {
#pragma unroll
      for (int i = 0; i < 4; ++i) { lgv[i] = lgp[i * 64 + lane]; lbv[i] = lbp[i * 64 + lane]; }
    }
    float mu, rs;
    row_stats(v, mu, rs);
#pragma unroll
    for (int i = 0; i < 4; ++i) {
      v[i].x = (v[i].x - mu) * rs * lgv[i].x + lbv[i].x;
      v[i].y = (v[i].y - mu) * rs * lgv[i].y + lbv[i].y;
      v[i].z = (v[i].z - mu) * rs * lgv[i].z + lbv[i].z;
      v[i].w = (v[i].w - mu) * rs * lgv[i].w + lbv[i].w;
    }
    if (last) {
      float4* hout = reinterpret_cast<float4*>(p.out + (row - NC) * D);
#pragma unroll
      for (int i = 0; i < 4; ++i) hout[i * 64 + lane] = v[i];
      continue;
    }
    uint2 hq[4];
#pragma unroll
    for (int i = 0; i < 4; ++i) {
      hq[i] = make_uint2(pack2(v[i].x, v[i].y), pack2(v[i].z, v[i].w));
      v[i].x = bf_lo(hq[i].x); v[i].y = bf_hi(hq[i].x); v[i].z = bf_lo(hq[i].y); v[i].w = bf_hi(hq[i].y);
    }
    row_stats(v, mu, rs);
    float lo[NEXP];
#pragma unroll
    for (int e = 0; e < NEXP; ++e) lo[e] = 0.f;
    uint2 up[4];
#pragma unroll
    for (int i = 0; i < 4; ++i) {
      float uv[4];
      uv[0] = (v[i].x - mu) * rs * (1.f + scv[i].x) + shv[i].x;
      uv[1] = (v[i].y - mu) * rs * (1.f + scv[i].y) + shv[i].y;
      uv[2] = (v[i].z - mu) * rs * (1.f + scv[i].z) + shv[i].z;
      uv[3] = (v[i].w - mu) * rs * (1.f + scv[i].w) + shv[i].w;
      up[i] = make_uint2(pack4_fp8(uv[0] * SU8, uv[1] * SU8, uv[2] * SU8, uv[3] * SU8), 0u);
      if (sub == 0) {
#pragma unroll
        for (int e = 0; e < NEXP; ++e) {
          const float4 w4 = *reinterpret_cast<const float4*>(wT + e * D + (i * 64 + lane) * 4);
          lo[e] += uv[0] * w4.x + uv[1] * w4.y + uv[2] * w4.z + uv[3] * w4.w;
          if ((e & 3) == 3) __builtin_amdgcn_sched_barrier(0);
        }
      }
    }
    int ge1 = 0, ge2 = 0;
    float w1 = 0.f, w2 = 0.f;
    if (sub == 0) {
      float mine = 0.f;
#pragma unroll
      for (int e = 0; e < NEXP; ++e) {
        const float rsum = row_sum16(lo[e]);
        mine = ((lane & 15) == e) ? rsum : mine;
      }
      mine += __shfl_xor(mine, 16);
      mine += __shfl_xor(mine, 32);
#pragma unroll
      for (int e = 0; e < NEXP; ++e) lo[e] = __int_as_float(__builtin_amdgcn_readlane(__float_as_int(mine), e));
      float mx = lo[0];
#pragma unroll
      for (int e = 1; e < NEXP; ++e) mx = fmaxf(mx, lo[e]);
      float sum = 0.f;
#pragma unroll
      for (int e = 0; e < NEXP; ++e) { lo[e] = __expf(lo[e] - mx); sum += lo[e]; }
      const float inv = 1.0f / sum;
      float bestg = -1e30f, gp1 = 0.f, gp2 = 0.f;
#pragma unroll
      for (int gq = 0; gq < 4; ++gq) {
        float s1 = -1e30f, s2 = -1e30f, p1 = 0.f, p2 = 0.f;
        int e1 = 0, e2 = 0;
#pragma unroll
        for (int j = 0; j < 4; ++j) {
          const int e = gq * 4 + j;
          const float pe = lo[e] * inv;
          const float se = pe + p.b_router[e];
          if (se > s1) { s2 = s1; p2 = p1; e2 = e1; s1 = se; p1 = pe; e1 = e; }
          else if (se > s2) { s2 = se; p2 = pe; e2 = e; }
        }
        const float gs = s1 + s2;
        if (gs > bestg) { bestg = gs; ge1 = e1; ge2 = e2; gp1 = p1; gp2 = p2; }
      }
      const float wsum = gp1 + gp2;
      w1 = gp1 / wsum; w2 = gp2 / wsum;
    }
    {
      uint2* hout = reinterpret_cast<uint2*>(hrow16(p, row));
#pragma unroll
      for (int i = 0; i < 4; ++i) hout[i * 64 + lane] = hq[i];
    }
#pragma unroll
    for (int i = 0; i < 4; ++i) reinterpret_cast<unsigned*>(p.u8 + row * D)[i * 64 + lane] = up[i].x;
    if (sub == 0 && lane == 0) {
      p.ew[row * 2 + 0] = w1; p.ew[row * 2 + 1] = w2;
      const int lp1 = atomicAdd(cntL + ge1, 1), lp2 = atomicAdd(cntL + ge2, 1);
      const int ei = atomicAdd(nent, 2);
      entL[2 * ei] = ((int)(row * 2) << 4) | ge1; entL[2 * ei + 1] = lp1;
      entL[2 * ei + 2] = ((int)(row * 2 + 1) << 4) | ge2; entL[2 * ei + 3] = lp2;
    }
  }
  if (sub == 0) {
    __syncthreads();
    if (threadIdx.x < NEXP) {
      const int c = cntL[threadIdx.x];
      cntL[threadIdx.x] = c ? atomicAdd(p.cnt + (l * NEXP + threadIdx.x) * 64, c) : 0;
    }
    __syncthreads();
    const int ne = *nent;
    for (int i = threadIdx.x; i < ne; i += 256) {
      const int key = entL[2 * i], lp = entL[2 * i + 1];
      const int e = key & 15;
      p.list[(long)(l * NEXP + e) * NR + cntL[e] + lp] = key >> 4;
    }
    __syncthreads();
  }
}

#define LOOP(n) for (long i = gtid; i < (long)(n); i += gstride)

#ifdef ONLY_PHASE
#define PH(n, ...) if (ONLY_PHASE == n) { __VA_ARGS__ }
#define GSYNC()
#else
#define PH(n, ...) { __VA_ARGS__ }
#define GSYNC() xcd_barrier(xb)
#endif

__global__ void __launch_bounds__(256, 2) mega_kernel(Params p) {
  cg::grid_group grid = cg::this_grid();
  __shared__ __attribute__((aligned(16))) unsigned char smem[SMEM_BYTES + 16];
  if (threadIdx.x == 0) *reinterpret_cast<uint4*>(smem + SMEM_BYTES) = make_uint4(0u, 0u, 0u, 0u);
  __syncthreads();
  XcdBarrier xb = xcd_barrier_post(p.bar, (volatile LAS unsigned*)(smem + SMEM_BYTES));
  const long gtid = (long)blockIdx.x * blockDim.x + threadIdx.x;
  const long gstride = (long)gridDim.x * blockDim.x;
  const int nsb = min(256, (int)gridDim.x / 2);
  PH(0,
    if (gtid < 2 * NEXP) p.cnt[gtid * 64] = 0;
    phase_convert_dense(p, smem);
    phase_fold_z(p, gtid, gstride, (float*)(smem + 65536));
    LOOP(1024) ph_tables(p, i);)
#ifndef ONLY_PHASE
  if (p.use_cg_sync) grid.sync();
#endif
  GSYNC();
  PH(1, phase_lnmod_first(p);)
  GSYNC();
  PH(2, phase_gemm(p, GemmJob{(const act_t*)p.u8, (const act_t*)p.W8in_even, p.P, 0, 0, 0, 1, NR / 128, IN_EVEN / 128, D, PW, IN_EVEN, 2, 1.0f / (SU8 * SW8), 1, 0}, smem);)
  GSYNC();
  PH(3,
    if ((int)blockIdx.x < nsb) phase_scan<0>(p, smem, blockIdx.x, nsb);
    else phase_attn(p, smem, blockIdx.x - nsb, gridDim.x - nsb);)
  GSYNC();
  PH(4, phase_combine<0>(p);)
  GSYNC();
  PH(5,
    phase_gemm(p, GemmJob{(const act_t*)p.O8, (const act_t*)p.W8out_even, p.M, 0, 0, 0, 1, NR / 128, D / 128, D, D, D, 0, 1.0f / (SO8 * SW8), 1, 0}, smem);
    {
      const int rem = ((NR / 128) * (D / 128)) % (int)gridDim.x;
      if (rem > 0 && rem < (int)gridDim.x) { if ((int)blockIdx.x >= rem) phase_convert_experts(p, 0, smem, blockIdx.x - rem, gridDim.x - rem); }
      else phase_convert_experts(p, 0, smem, blockIdx.x, gridDim.x);
    })
  GSYNC();
  PH(6, phase_resid_ln<1>(p, 0, 0, 0, NR, smem);)
  GSYNC();
  PH(7, phase_moe(p, 0, false, smem);)
  GSYNC();
  PH(8, phase_moe(p, 0, true, smem);)
  GSYNC();
  PH(9, phase_resid_ln<2>(p, 0, 1, 0, NR, smem); phase_cmat(p, gtid, gstride);)
  GSYNC();
  PH(10, phase_gemm(p, GemmJob{(const act_t*)p.u8, (const act_t*)p.W8in_odd, p.P, 0, 0, 0, 1, NR / 128, IN_ODD_PAD / 128, D, PW, O_FA, 1, 1.0f / (SU8 * SW8), 1, 0}, smem);)
  GSYNC();
  PH(11, phase_gla_decay(p);)
  GSYNC();
  PH(12,
    if ((int)blockIdx.x < nsb) phase_scan<1>(p, smem, blockIdx.x, nsb);
    else {
      phase_gemm(p, GemmJob{p.Cmat, p.FT, (act_t*)(p.O8 + (long)NC * D + 768), 0, (long)256 * 2 * T, (long)T * D, NB, T / 128, 2, 2 * T, D,
                            256, 0, 0.00276213586400995f * SO8, 0, 1}, smem, blockIdx.x - nsb, gridDim.x - nsb);
      phase_convert_experts(p, 1, smem, blockIdx.x - nsb, gridDim.x - nsb);
    })
  GSYNC();
  PH(13, phase_combine<1>(p);)
  GSYNC();
  PH(14,
    phase_gemm(p, GemmJob{(const act_t*)(p.O8 + (long)NC * D), (const act_t*)p.W8out_odd, p.M + (long)NC * D, 0, 0, 0, 1, NT / 128, D / 128, D, D, D, 0, 1.0f / (SO8 * SW8), 1, 0}, smem);)
  GSYNC();
  PH(15, phase_resid_ln<1>(p, 1, 0, NC, NR, smem);)
  GSYNC();
  PH(16, phase_moe(p, 1, false, smem);)
  GSYNC();
  PH(17, phase_moe(p, 1, true, smem);)
  GSYNC();
  PH(18, phase_resid_ln<2>(p, 1, 1, NC, NR, smem);)
}

static size_t carve(Params& p, char* ws) {
  size_t off = 0;
  auto take = [&](size_t bytes) { char* r = ws + off; off += (bytes + 255) & ~(size_t)255; return r; };
  p.mod = (float*)take(sizeof(float) * 2 * (NB + 1) * 6 * D);
  p.hc = (float*)take(sizeof(float) * (size_t)NC * D);
  p.costab = (float*)take(sizeof(float) * T);
  p.sintab = (float*)take(sizeof(float) * T);
  p.lbt = (float*)take(sizeof(float) * 1024);
  p.ropetab = (float*)take(sizeof(float) * 64 * 16 * 2);
  p.ew = (float*)take(sizeof(float) * (size_t)NR * 2);
  p.eidx = nullptr;
  p.u = nullptr;
  p.O8 = (unsigned char*)take((size_t)NR * D);
  p.P = (act_t*)take(sizeof(act_t) * (size_t)NR * PW);
  p.OF = (act_t*)take(sizeof(act_t) * (size_t)NR * 768);
  p.OB = (act_t*)take(sizeof(act_t) * (size_t)NR * 768);
  p.M = p.OF;
  p.Cmat = (act_t*)take(sizeof(act_t) * (size_t)T * 2 * T);
  p.FT = (act_t*)take(sizeof(act_t) * (size_t)NB * 256 * 2 * T);
  p.LF = (act_t*)take(sizeof(act_t) * (size_t)2 * NR * 384);
  p.W8up = (unsigned char*)p.Cmat;
  p.W8down = p.W8up + (size_t)NEXP * 1024 * D;
  p.W8up1 = (unsigned char*)take((size_t)NEXP * 1024 * (D + DFF));
  p.W8down1 = p.W8up1 + (size_t)NEXP * 1024 * D;
  p.u8 = (unsigned char*)take((size_t)NR * D);
  p.Y = p.P;
  p.H8 = (unsigned char*)(p.P + (size_t)2 * NR * D);
  p.bar = (unsigned*)take(sizeof(unsigned) * XCD_BAR_WORDS);
  p.cnt = (int*)take(sizeof(int) * 2 * NEXP * 64);
  p.list = (int*)take(sizeof(int) * (size_t)2 * NEXP * NR);
  p.Wt_in_even = nullptr;
  p.W8in_even = (unsigned char*)take((size_t)IN_EVEN * D);
  p.Wt_out_even = nullptr;
  p.W8out_even = (unsigned char*)take((size_t)D * D);
  p.Wt_in_odd = nullptr;
  p.W8in_odd = (unsigned char*)take((size_t)IN_ODD_PAD * D);
  p.Wt_out_odd = nullptr;
  p.W8out_odd = (unsigned char*)take((size_t)D * D);
  return off;
}

static void fill_inputs(Params& p, void* const* d_in) {
  const float** f = (const float**)&p;
  for (int i = 0; i < 23; ++i) f[i] = (const float*)d_in[i];
}

extern "C" void kernel_launch(void* const* d_in, const int* in_sizes, int n_in, void* d_out, int out_size,
                              void* d_ws, size_t ws_size, hipStream_t stream) {
  static int grid_blocks = 0;
  if (!grid_blocks) {
    int dev = 0, cus = 0, per_cu = 0;
    (void)hipGetDevice(&dev);
    (void)hipDeviceGetAttribute(&cus, hipDeviceAttributeMultiprocessorCount, dev);
    (void)hipOccupancyMaxActiveBlocksPerMultiprocessor(&per_cu, mega_kernel, 256, 0);
    grid_blocks = cus * per_cu;
  }
  Params p{};
  fill_inputs(p, d_in);
  p.out = (float*)d_out;
  size_t need = carve(p, (char*)d_ws);
  if (need > ws_size) { fprintf(stderr, "workspace too small: need %zu have %zu\n", need, ws_size); return; }
  (void)hipMemsetAsync(p.bar, 0, sizeof(unsigned) * XCD_BAR_WORDS, stream);
  void* args[] = {&p};
  hipError_t e = hipLaunchCooperativeKernel((void*)mega_kernel, dim3(grid_blocks), dim3(256), args, 0, stream);
  if (e != hipSuccess) fprintf(stderr, "cooperative launch failed: %s (grid %d)\n", hipGetErrorString(e), grid_blocks);
}
#endif
```

```cpp
#ifndef HOST_TEST
#include <hip/hip_runtime.h>
#include <hip/hip_cooperative_groups.h>
#include <cstdio>
namespace cg = cooperative_groups;
#define DEV __device__ __forceinline__
#else
#include <cmath>
#include <cstdio>
#include <cstdlib>
#include <cstring>
#define DEV static inline
#endif

#ifndef T_BATCH
#define T_BATCH 8
#endif
#ifndef T_SEQ
#define T_SEQ 2048
#endif
#ifndef T_CTX
#define T_CTX 256
#endif

constexpr int D = 1024, NB = T_BATCH, T = T_SEQ, C = T_CTX;
constexpr int NC = NB * C, NT = NB * T, NR = NC + NT;
constexpr int GRID_W = 64;
constexpr int IN_EVEN = 3328, IN_ODD = 2592, PW = 3328;
constexpr int NEXP = 16, DFF = 512;
constexpr float ALPHA = 1.4142135623730951f;
constexpr float LN_EPS = 1e-5f;
constexpr int E_AQ = 0, E_AK = 512, E_AV = 640, E_FF = 768, E_HQ = 1792, E_HI = 2304, E_HG = 2816;
constexpr int O_Q = 0, O_K = 384, O_V = 768, O_RF = 1536, O_G = 1568, O_Z = 2336;

#ifdef HOST_TEST
typedef float act_t;
DEV float ldA(const act_t* p) { return *p; }
DEV void stA(act_t* p, float v) { *p = v; }
#else
typedef unsigned short act_t;
DEV float ldA(const act_t* p) { return __uint_as_float(((unsigned)*p) << 16); }
DEV void stA(act_t* p, float v) {
  unsigned u = __float_as_uint(v);
  u += 0x7fffu + ((u >> 16) & 1u);
  *p = (unsigned short)(u >> 16);
}
#endif

struct Params {
  const float *x, *c, *ctx, *c_ctx, *w_ada, *b_ada, *ln_g, *ln_b, *w_in_even, *attn_sink, *lb_logits, *hgrn_norm,
      *w_out_even, *w_in_odd, *gla_gate_w, *gla_gate_b, *gla_norm, *w_out_odd, *w_router, *b_router, *w_eg, *w_eu,
      *w_ed;
  float* out;
  float *mod, *hc, *costab, *sintab, *lbt, *ew, *ropetab;
  int* eidx;
  act_t *u, *P, *OF, *OB, *M, *LF;
  act_t *Wt_in_even, *Wt_out_even, *Wt_in_odd, *Wt_out_odd;
  act_t *Y, *Cmat, *FT;
  unsigned char *W8up, *W8down, *W8up1, *W8down1, *H8, *u8;
  unsigned char *W8in_even, *W8in_odd;
  unsigned char *W8out_even, *W8out_odd, *O8;
  int *cnt, *list;
  unsigned* bar;
  int use_cg_sync;
  int pad_;
};

DEV float sigmoidf_(float v) { return 1.0f / (1.0f + expf(-v)); }
DEV float siluf_(float v) { return v / (1.0f + expf(-v)); }

DEV const float* hrow_in(const Params& p, long row) {
  return row < NC ? p.ctx + row * D : p.x + (row - NC) * D;
}
DEV float* hrow(const Params& p, long row) { return row < NC ? p.hc + row * D : p.out + (row - NC) * D; }
DEV const float* modrow(const Params& p, int l, long row) {
  int bb = row < NC ? NB : (int)((row - NC) / T);
  return p.mod + ((long)l * (NB + 1) + bb) * 6 * D;
}

DEV void ph_mod(const Params& p, long i) {
  int j = (int)(i % (6 * D));
  int bb = (int)((i / (6 * D)) % (NB + 1));
  int l = (int)(i / ((long)6 * D * (NB + 1)));
  const float* cv = bb < NB ? p.c + (long)bb * D : p.c_ctx;
  const float* w = p.w_ada + (long)l * D * 6 * D + j;
  float s = p.b_ada[l * 6 * D + j];
  for (int k = 0; k < D; ++k) s += siluf_(cv[k]) * w[(long)k * 6 * D];
  p.mod[i] = s;
}

DEV void ph_tables(const Params& p, long i) {
  if (i < 1024) {
    int pos = (int)(i >> 4), idx = (int)(i & 15);
    float ang = (float)pos * powf(10000.0f, -(float)idx / 16.0f);
    p.ropetab[2 * i] = cosf(ang);
    p.ropetab[2 * i + 1] = sinf(ang);
  }
  if (i < 1024) {
    int dir = (int)(i / 512), col = (int)(i % 512);
    float l0 = p.lb_logits[(dir * 2 + 0) * 512 + col], l1 = p.lb_logits[(dir * 2 + 1) * 512 + col];
    p.lbt[i] = 1.0f / (1.0f + expf(l1 - l0));
  }
}

DEV void ln_mod_row(const float* h, const float* shift, const float* scale, act_t* u) {
  float mu = 0.f;
  for (int k = 0; k < D; ++k) mu += h[k];
  mu *= (1.0f / D);
  float var = 0.f;
  for (int k = 0; k < D; ++k) { float d = h[k] - mu; var += d * d; }
  var *= (1.0f / D);
  float rs = 1.0f / sqrtf(var + LN_EPS);
  for (int k = 0; k < D; ++k) stA(u + k, (h[k] - mu) * rs * (1.0f + scale[k]) + shift[k]);
}

DEV void ph_lnmod_first(const Params& p, long row) {
  const float* m = modrow(p, 0, row);
  ln_mod_row(hrow_in(p, row), m, m + D, p.u + row * D);
}

DEV void gemm_item_act(const act_t* A, const float* W, act_t* Cout, int K, int N, int ldc, long i) {
  int n4 = (int)(i % (N / 4));
  long row = i / (N / 4);
  const act_t* a = A + row * K;
  const float* w = W + n4 * 4;
  float s0 = 0, s1 = 0, s2 = 0, s3 = 0;
  for (int k = 0; k < K; ++k) {
    float av = ldA(a + k);
    const float* wr = w + (long)k * N;
    s0 += av * wr[0]; s1 += av * wr[1]; s2 += av * wr[2]; s3 += av * wr[3];
  }
  act_t* o = Cout + row * ldc + n4 * 4;
  stA(o, s0); stA(o + 1, s1); stA(o + 2, s2); stA(o + 3, s3);
}

DEV void ph_rope(const Params& p, long i) {
  int pr = (int)(i % 32);
  int hh = (int)((i / 32) % 10);
  long lr = i / 320;
  int t = (int)(lr % T);
  int col = hh < 8 ? E_AQ + hh * 64 : E_AK + (hh - 8) * 64;
  int idx = pr & 15;
  int pos = pr < 16 ? t / GRID_W : t % GRID_W;
  int d0 = pr < 16 ? idx : 32 + idx;
  float inv = powf(10000.0f, -(float)idx / 16.0f);
  float ang = (float)pos * inv;
  float cs = cosf(ang), sn = sinf(ang);
  act_t* base = p.P + (NC + lr) * PW + col;
  float x1 = ldA(base + d0), x2 = ldA(base + d0 + 16);
  stA(base + d0, x1 * cs - x2 * sn);
  stA(base + d0 + 16, x1 * sn + x2 * cs);
}

DEV void ph_attn(const Params& p, long i) {
  int h = (int)(i % 8);
  long row = i / 8;
  int kv = h / 4;
  bool lat = row >= NC;
  int b = lat ? (int)((row - NC) / T) : (int)(row / C);
  int t = lat ? (int)((row - NC) % T) : 0;
  float q[64], acc[64];
  const act_t* qp = p.P + row * PW + E_AQ + h * 64;
#pragma unroll
  for (int d = 0; d < 64; ++d) { q[d] = ldA(qp + d) * 0.125f; acc[d] = 0.f; }
  float m = p.attn_sink[h], l = 1.0f;
  int nkeys = C + (lat ? 257 : 0);
  for (int j = 0; j < nkeys; ++j) {
    long krow;
    if (j < C) krow = (long)b * C + j;
    else {
      int kp = t - 128 + (j - C);
      if (kp < 0 || kp >= T) continue;
      krow = NC + (long)b * T + kp;
    }
    const act_t* kptr = p.P + krow * PW + E_AK + kv * 64;
    const act_t* vptr = p.P + krow * PW + E_AV + kv * 64;
    float s = 0.f;
#pragma unroll
    for (int d = 0; d < 64; ++d) s += q[d] * ldA(kptr + d);
    float mn = fmaxf(m, s);
    float sc = expf(m - mn), pj = expf(s - mn);
    l = l * sc + pj;
#pragma unroll
    for (int d = 0; d < 64; ++d) acc[d] = acc[d] * sc + pj * ldA(vptr + d);
    m = mn;
  }
  float il = 1.0f / l;
  act_t* o = p.u + row * D + h * 64;
#pragma unroll
  for (int d = 0; d < 64; ++d) stA(o + d, acc[d] * il);
}

template <int MODE>
DEV void ph_scan(const Params& p, long i) {
  constexpr int DK = MODE == 0 ? 128 : 96;
  constexpr int DV = MODE == 0 ? 128 : 192;
  int e = (int)(i % DV);
  int dir = (int)((i / DV) % 2);
  int h = (int)((i / (2 * DV)) % 4);
  int b = (int)(i / (8 * DV));
  float S[DK];
#pragma unroll
  for (int d = 0; d < DK; ++d) S[d] = 0.f;
  act_t* OD = dir == 0 ? p.OF : p.OB;
  for (int step = 0; step < C + T; ++step) {
    long row;
    if (step < C) row = (long)b * C + (dir == 0 ? step : C - 1 - step);
    else { int tt = step - C; row = NC + (long)b * T + (dir == 0 ? tt : T - 1 - tt); }
    const act_t* pr = p.P + row * PW;
    float o = 0.f;
    if (MODE == 0) {
      float v = ldA(pr + E_HI + h * 128 + e);
      const act_t* zp = pr + E_FF + dir * 512 + h * 128;
      const act_t* qp = pr + E_HQ + h * 128;
      const float* lb = p.lbt + dir * 512 + h * 128;
#pragma unroll
      for (int d = 0; d < DK; ++d) {
        float f = lb[d] + (1.0f - lb[d]) * sigmoidf_(ldA(zp + d));
        S[d] = f * S[d] + (1.0f - f) * v;
        o += ldA(qp + d) * S[d];
      }
      stA(OD + row * 768 + h * 128 + e, o);
    } else {
      float v = ldA(pr + O_V + h * 192 + e);
      const act_t* kp = pr + O_K + h * 96;
      const act_t* qp = pr + O_Q + h * 96;
      const act_t* lf = p.LF + ((long)dir * NR + row) * 384 + h * 96;
#pragma unroll
      for (int d = 0; d < DK; ++d) {
        float f = expf(ldA(lf + d));
        S[d] = f * S[d] + ldA(kp + d) * v;
        o += ldA(qp + d) * S[d];
      }
      stA(OD + row * 768 + h * 192 + e, o * 0.10206207261596575f);
    }
  }
}

template <int MODE>
DEV void ph_combine(const Params& p, long i) {
  constexpr int DV = MODE == 0 ? 128 : 192;
  int h = (int)(i % 4);
  long row = (MODE == 0) ? i / 4 : NC + i / 4;
  const act_t* f = p.OF + row * 768 + h * DV;
  const act_t* bk = p.OB + row * 768 + h * DV;
  float ss = 0.f;
  for (int e = 0; e < DV; ++e) { float o = ldA(f + e) + ldA(bk + e); ss += o * o; }
  float r = 1.0f / sqrtf(ss / DV + LN_EPS);
  const float* gn = (MODE == 0 ? p.hgrn_norm : p.gla_norm) + h * DV;
  const act_t* g = p.P + row * PW + (MODE == 0 ? E_HG : O_G) + h * DV;
  act_t* o = p.u + row * D + (MODE == 0 ? 512 : 0) + h * DV;
  for (int e = 0; e < DV; ++e) stA(o + e, (ldA(f + e) + ldA(bk + e)) * r * gn[e] * siluf_(ldA(g + e)));
}

DEV void ph_gla_decay(const Params& p, long i) {
  int col = (int)(i % 384);
  long row = (i / 384) % NR;
  int dir = (int)(i / ((long)384 * NR));
  const act_t* r = p.P + row * PW + O_RF + dir * 16;
  const float* gw = p.gla_gate_w + (long)dir * 16 * 384 + col;
  float z = p.gla_gate_b[dir * 384 + col];
  for (int k = 0; k < 16; ++k) z += ldA(r + k) * gw[k * 384];
  float ls = fminf(z, 0.f) - log1pf(expf(-fabsf(z)));
  stA(p.LF + ((long)dir * NR + row) * 384 + col, ls * (1.0f / 16.0f));
}

DEV void ph_resid_ln(const Params& p, long row, int l, int sub) {
  const float* hin = (l == 0 && sub == 0) ? hrow_in(p, row) : hrow(p, row);
  float* hout = hrow(p, row);
  const float* md = modrow(p, l, row);
  const float* g = md + (sub == 0 ? 2 : 5) * D;
  const act_t* m = p.M + row * D;
  const float* lg = p.ln_g + (l * 2 + sub) * D;
  const float* lb = p.ln_b + (l * 2 + sub) * D;
  float mu = 0.f;
  for (int k = 0; k < D; ++k) mu += ALPHA * hin[k] + g[k] * ldA(m + k);
  mu *= (1.0f / D);
  float var = 0.f;
  for (int k = 0; k < D; ++k) { float d = ALPHA * hin[k] + g[k] * ldA(m + k) - mu; var += d * d; }
  var *= (1.0f / D);
  float rs = 1.0f / sqrtf(var + LN_EPS);
  for (int k = 0; k < D; ++k) hout[k] = (ALPHA * hin[k] + g[k] * ldA(m + k) - mu) * rs * lg[k] + lb[k];
  if (sub == 1 && l == 1) return;
  const float* md2 = (sub == 0) ? md + 3 * D : modrow(p, 1, row);
  float mu2 = 0.f;
  for (int k = 0; k < D; ++k) mu2 += hout[k];
  mu2 *= (1.0f / D);
  float var2 = 0.f;
  for (int k = 0; k < D; ++k) { float d = hout[k] - mu2; var2 += d * d; }
  var2 *= (1.0f / D);
  float rs2 = 1.0f / sqrtf(var2 + LN_EPS);
  float lo[NEXP];
#pragma unroll
  for (int e = 0; e < NEXP; ++e) lo[e] = 0.f;
  for (int k = 0; k < D; ++k) {
    float uv = (hout[k] - mu2) * rs2 * (1.0f + md2[D + k]) + md2[k];
    stA(p.u + row * D + k, uv);
    if (sub == 0) {
      const float* wr = p.w_router + k * NEXP;
#pragma unroll
      for (int e = 0; e < NEXP; ++e) lo[e] += uv * wr[e];
    }
  }
  if (sub != 0) return;
  float mx = lo[0];
#pragma unroll
  for (int e = 1; e < NEXP; ++e) mx = fmaxf(mx, lo[e]);
  float sum = 0.f;
#pragma unroll
  for (int e = 0; e < NEXP; ++e) { lo[e] = expf(lo[e] - mx); sum += lo[e]; }
  float inv = 1.0f / sum;
  float bestg = -1e30f; int bg = 0;
  float gi1 = 0, gi2 = 0; int ge1 = 0, ge2 = 0;
  float gp1 = 0, gp2 = 0;
#pragma unroll
  for (int gq = 0; gq < 4; ++gq) {
    float s1 = -1e30f, s2 = -1e30f, p1 = 0, p2 = 0; int e1 = 0, e2 = 0;
#pragma unroll
    for (int j = 0; j < 4; ++j) {
      int e = gq * 4 + j;
      float pe = lo[e] * inv;
      float se = pe + p.b_router[e];
      if (se > s1) { s2 = s1; p2 = p1; e2 = e1; s1 = se; p1 = pe; e1 = e; }
      else if (se > s2) { s2 = se; p2 = pe; e2 = e; }
    }
    float gs = s1 + s2;
    if (gs > bestg) { bestg = gs; bg = gq; gi1 = s1; gi2 = s2; ge1 = e1; ge2 = e2; gp1 = p1; gp2 = p2; }
  }
  (void)bg; (void)gi1; (void)gi2;
  float wsum = gp1 + gp2;
  p.eidx[row * 2 + 0] = ge1; p.eidx[row * 2 + 1] = ge2;
  p.ew[row * 2 + 0] = gp1 / wsum; p.ew[row * 2 + 1] = gp2 / wsum;
}

DEV void ph_moe_up(const Params& p, long i, int l, long row0) {
  int f4 = (int)(i % (DFF / 4));
  int slot = (int)((i / (DFF / 4)) % 2);
  long row = row0 + i / (DFF / 2);
  int e = p.eidx[row * 2 + slot];
  const float* w1 = p.w_eg + ((long)(l * NEXP + e) * D) * DFF + f4 * 4;
  const float* w3 = p.w_eu + ((long)(l * NEXP + e) * D) * DFF + f4 * 4;
  const act_t* a = p.u + row * D;
  float g0 = 0, g1 = 0, g2 = 0, g3 = 0, u0 = 0, u1 = 0, u2 = 0, u3 = 0;
  for (int k = 0; k < D; ++k) {
    float av = ldA(a + k);
    const float* r1 = w1 + (long)k * DFF;
    const float* r3 = w3 + (long)k * DFF;
    g0 += av * r1[0]; g1 += av * r1[1]; g2 += av * r1[2]; g3 += av * r1[3];
    u0 += av * r3[0]; u1 += av * r3[1]; u2 += av * r3[2]; u3 += av * r3[3];
  }
  act_t* hb = p.P + (row * 2 + slot) * DFF + f4 * 4;
  stA(hb, siluf_(g0) * u0); stA(hb + 1, siluf_(g1) * u1); stA(hb + 2, siluf_(g2) * u2); stA(hb + 3, siluf_(g3) * u3);
}

DEV void ph_moe_down(const Params& p, long i, int l, long row0) {
  int j4 = (int)(i % (D / 4));
  long row = row0 + i / (D / 4);
  float y0 = 0, y1 = 0, y2 = 0, y3 = 0;
  for (int slot = 0; slot < 2; ++slot) {
    int e = p.eidx[row * 2 + slot];
    float wgt = p.ew[row * 2 + slot];
    const float* w2 = p.w_ed + ((long)(l * NEXP + e) * DFF) * D + j4 * 4;
    const act_t* hb = p.P + (row * 2 + slot) * DFF;
    float s0 = 0, s1 = 0, s2 = 0, s3 = 0;
    for (int f = 0; f < DFF; ++f) {
      float hv = ldA(hb + f);
      const float* r = w2 + (long)f * D;
      s0 += hv * r[0]; s1 += hv * r[1]; s2 += hv * r[2]; s3 += hv * r[3];
    }
    y0 += wgt * s0; y1 += wgt * s1; y2 += wgt * s2; y3 += wgt * s3;
  }
  act_t* o = p.M + row * D + j4 * 4;
  stA(o, y0); stA(o + 1, y1); stA(o + 2, y2); stA(o + 3, y3);
}


#ifndef HOST_TEST
typedef __attribute__((ext_vector_type(8))) short bf16x8;
typedef __attribute__((ext_vector_type(4))) float f32x4;
constexpr int SMEM_BYTES = 71680;
constexpr int IN_ODD_PAD = 2944;
constexpr int O_FA = 2336, O_FB = 2592, O_END = 2848;

typedef float f32x2_t __attribute__((ext_vector_type(2)));
typedef __bf16 bf16x2_t __attribute__((ext_vector_type(2)));
__device__ __forceinline__ unsigned pack2(float a, float b) {
  const f32x2_t v = {a, b};
  return __builtin_bit_cast(unsigned, __builtin_convertvector(v, bf16x2_t));
}
__device__ __forceinline__ unsigned pack2_mfma(float a, float b) { return pack2(a, b); }
typedef __attribute__((ext_vector_type(2))) unsigned u32x2;
__device__ __forceinline__ float xor16_max(float x) {
  const u32x2 r = __builtin_amdgcn_permlane16_swap(__float_as_uint(x), __float_as_uint(x), false, false);
  return fmaxf(__uint_as_float(r.x), __uint_as_float(r.y));
}
__device__ __forceinline__ float xor32_max(float x) {
  const u32x2 r = __builtin_amdgcn_permlane32_swap(__float_as_uint(x), __float_as_uint(x), false, false);
  return fmaxf(__uint_as_float(r.x), __uint_as_float(r.y));
}
__device__ __forceinline__ float xor16_add(float x) {
  const u32x2 r = __builtin_amdgcn_permlane16_swap(__float_as_uint(x), __float_as_uint(x), false, false);
  return __uint_as_float(r.x) + __uint_as_float(r.y);
}
__device__ __forceinline__ float xor32_add(float x) {
  const u32x2 r = __builtin_amdgcn_permlane32_swap(__float_as_uint(x), __float_as_uint(x), false, false);
  return __uint_as_float(r.x) + __uint_as_float(r.y);
}
__device__ __forceinline__ float bf_lo(unsigned u) { return __uint_as_float(u << 16); }
__device__ __forceinline__ float bf_hi(unsigned u) { return __uint_as_float(u & 0xffff0000u); }
template <int CTRL>
__device__ __forceinline__ float dpp_mov(float v) {
  return __int_as_float(__builtin_amdgcn_update_dpp(0, __float_as_int(v), CTRL, 0xf, 0xf, true));
}
__device__ __forceinline__ float row_sum16(float v) {
  v += dpp_mov<0xB1>(v);
  v += dpp_mov<0x4E>(v);
  v += dpp_mov<0x141>(v);
  v += dpp_mov<0x140>(v);
  return v;
}
__device__ __forceinline__ float wave_sum(float v) {
  v = row_sum16(v);
  const float a = __int_as_float(__builtin_amdgcn_readlane(__float_as_int(v), 0));
  const float b = __int_as_float(__builtin_amdgcn_readlane(__float_as_int(v), 16));
  const float c = __int_as_float(__builtin_amdgcn_readlane(__float_as_int(v), 32));
  const float d = __int_as_float(__builtin_amdgcn_readlane(__float_as_int(v), 48));
  return (a + b) + (c + d);
}


#define XB_TMO      128
#define XB_XCNT(j)  (256  + 64 * (j))
#define XB_XSUB(j)  (1280 + 64 * (j))
#define XB_XGEN(j)  (2304 + 64 * (j))
#define XB_TOP      3328
#define XB_TOPGEN   3392
#define XCD_BAR_WORDS 3456
#define XB_SPIN_CAP (1u << 18)
#define LAS __attribute__((address_space(3)))
__device__ __forceinline__ unsigned xb_ld(unsigned* p)              { return __hip_atomic_load(p, __ATOMIC_RELAXED, __HIP_MEMORY_SCOPE_AGENT); }
__device__ __forceinline__ unsigned xb_add(unsigned* p, unsigned v) { return __hip_atomic_fetch_add(p, v, __ATOMIC_RELAXED, __HIP_MEMORY_SCOPE_AGENT); }
__device__ __forceinline__ unsigned xb_xcc_id() { return (unsigned)__builtin_amdgcn_s_getreg((3 << 11) | 20) & 0xFu; }
#define XB_SPIN(cond, bar) do { unsigned _sp = 0; while (cond) { __builtin_amdgcn_s_sleep(1); \
    if ((++_sp & 255u) == 0u) { if (xb_ld(&(bar)[XB_TMO])) break; if (_sp > XB_SPIN_CAP) { atomicAdd(&(bar)[XB_TMO], 1u); break; } } } } while (0)
struct XcdBarrier { unsigned* bar; unsigned x; volatile LAS unsigned* st; };
__device__ __forceinline__ XcdBarrier xcd_barrier_post(unsigned* bar, volatile LAS unsigned* st) {
    XcdBarrier b; b.bar = bar; b.x = xb_xcc_id(); b.st = st;
    if (threadIdx.x == 0) (void)xb_add(&bar[XB_XCNT(b.x)], 1u);
    return b;
}
__device__ __forceinline__ void xcd_barrier_complete(unsigned* bar, unsigned x, unsigned& nloc, unsigned& nx) {
    const unsigned G = gridDim.x * gridDim.y * gridDim.z;
    unsigned sum, cnt, mine, sp = 0u;
    for (;;) {
        sum = 0u; cnt = 0u; mine = 0u;
#pragma unroll
        for (unsigned j = 0; j < 16; ++j) { const unsigned c = xb_ld(&bar[XB_XCNT(j)]); sum += c; cnt += (c > 0u) ? 1u : 0u; mine = (j == x) ? c : mine; }
        if (sum == G) break;
        __builtin_amdgcn_s_sleep(1);
        if ((++sp & 255u) == 0u) { if (xb_ld(&bar[XB_TMO])) break; if (sp > XB_SPIN_CAP) { atomicAdd(&bar[XB_TMO], 1u); break; } }
    }
    nloc = mine > 0u ? mine : 1u; nx = cnt > 0u ? cnt : 1u;
}
__device__ __forceinline__ void xcd_barrier(const XcdBarrier& b) {
    asm volatile("s_waitcnt vmcnt(0)" ::: "memory");
    __syncthreads();
    if (threadIdx.x == 0) {
        unsigned* bar = b.bar;
        __builtin_amdgcn_s_waitcnt(0);
        unsigned nloc = b.st[0], nx = b.st[1];
        if (nloc == 0u) { xcd_barrier_complete(bar, b.x, nloc, nx); b.st[0] = nloc; b.st[1] = nx; }
        const unsigned old = xb_add(&bar[XB_XSUB(b.x)], 1u);
        const unsigned gen = old / nloc;
        if (old + 1u == (gen + 1u) * nloc) {
            __builtin_amdgcn_fence(__ATOMIC_RELEASE, "agent");
            asm volatile("s_waitcnt vmcnt(0)" ::: "memory");
            const unsigned og = xb_add(&bar[XB_TOP], 1u);
            const unsigned tg = og / nx;
            if (og + 1u == (tg + 1u) * nx) xb_add(&bar[XB_TOPGEN], 1u);
            else XB_SPIN(xb_ld(&bar[XB_TOPGEN]) == tg, bar);
            __builtin_amdgcn_fence(__ATOMIC_ACQUIRE, "agent");
            xb_add(&bar[XB_XGEN(b.x)], 1u);
            asm volatile("s_waitcnt vmcnt(0)" ::: "memory");
        } else {
            XB_SPIN(xb_ld(&bar[XB_XGEN(b.x)]) == gen, bar);
            __builtin_amdgcn_fence(__ATOMIC_ACQUIRE, "agent");
            asm volatile("s_waitcnt vmcnt(0)" ::: "memory");
        }
    }
    __syncthreads();
}

#define RAW_BARRIER() do { asm volatile("s_waitcnt lgkmcnt(0)" ::: "memory"); __builtin_amdgcn_s_barrier(); } while (0)
template <bool SWAP, class ARow, class Epi>
__device__ __forceinline__ void gemm_tile(ARow arow, const act_t* Bt, int K, unsigned char* smem, Epi epi) {
  const int tid = threadIdx.x, wid = tid >> 6, lane = tid & 63, wr = wid >> 1, wc = wid & 1, fr = lane & 15,
            fq = lane >> 4;
  const int r0 = tid >> 3, pc = tid & 7;
  const int lc = pc ^ ((tid >> 4) & 7);
  const act_t* ga[4];
#pragma unroll
  for (int i = 0; i < 4; ++i) ga[i] = arow(r0 + 32 * i) + lc * 8;
  const act_t* gb0 = Bt + (long)r0 * K + lc * 8;
  const long gbs = (long)32 * K;
  const int sw = (fr >> 1) & 7;
  const int rd0 = fr * 128 + ((fq ^ sw) << 4), rd1 = fr * 128 + (((4 + fq) ^ sw) << 4);
  char* S = (char*)smem;
  const int nk = K >> 6;
  f32x4 acc[4][4];
#pragma unroll
  for (int m = 0; m < 4; ++m)
#pragma unroll
    for (int n = 0; n < 4; ++n) acc[m][n] = f32x4{0.f, 0.f, 0.f, 0.f};
  auto issue = [&](int kt) {
    char* st = S + (kt & 1) * 32768 + tid * 16;
#pragma unroll
    for (int i = 0; i < 4; ++i) {
      __builtin_amdgcn_global_load_lds((const unsigned*)(ga[i] + kt * 64), (unsigned*)(st + i * 4096), 16, 0, 0);
      __builtin_amdgcn_global_load_lds((const unsigned*)(gb0 + i * gbs + kt * 64), (unsigned*)(st + 16384 + i * 4096), 16, 0, 0);
    }
  };
  RAW_BARRIER();
  issue(0);
  for (int kt = 0; kt < nk; ++kt) {
    asm volatile("s_waitcnt vmcnt(0)" ::: "memory");
    RAW_BARRIER();
    if (kt + 1 < nk) issue(kt + 1);
    const char* st = S + (kt & 1) * 32768;
#pragma unroll
    for (int ks = 0; ks < 2; ++ks) {
      const int rd = ks ? rd1 : rd0;
      bf16x8 af[4], bfr[4];
#pragma unroll
      for (int m = 0; m < 4; ++m) {
        af[m] = *reinterpret_cast<const bf16x8*>(st + (wr * 64 + m * 16) * 128 + rd);
        bfr[m] = *reinterpret_cast<const bf16x8*>(st + 16384 + (wc * 64 + m * 16) * 128 + rd);
      }
#pragma unroll
      for (int m = 0; m < 4; ++m)
#pragma unroll
        for (int n = 0; n < 4; ++n)
          acc[m][n] = SWAP ? __builtin_amdgcn_mfma_f32_16x16x32_bf16(bfr[n], af[m], acc[m][n], 0, 0, 0)
                           : __builtin_amdgcn_mfma_f32_16x16x32_bf16(af[m], bfr[n], acc[m][n], 0, 0, 0);
    }
  }
  epi(acc, wr, wc, fr, fq);
}


constexpr float SU8 = 16.0f, SW8 = 64.0f, SH8 = 8.0f, SO8 = 8.0f;
typedef unsigned char fp8_t;
typedef __attribute__((ext_vector_type(8))) int i32x8;
typedef __attribute__((ext_vector_type(4))) int i32x4;
__device__ __forceinline__ unsigned pack4_fp8(float a, float b, float c, float d) {
  a = fminf(fmaxf(a, -448.f), 448.f); b = fminf(fmaxf(b, -448.f), 448.f);
  c = fminf(fmaxf(c, -448.f), 448.f); d = fminf(fmaxf(d, -448.f), 448.f);
  unsigned w = 0;
  w = __builtin_amdgcn_cvt_pk_fp8_f32(a, b, w, false);
  w = __builtin_amdgcn_cvt_pk_fp8_f32(c, d, w, true);
  return w;
}

template <bool SWAP, class ARow, class Epi>
__device__ __forceinline__ void gemm_tile8(ARow arow, const fp8_t* Bt, int Kb, unsigned char* smem, Epi epi) {
  const int tid = threadIdx.x, wid = tid >> 6, lane = tid & 63, wr = wid >> 1, wc = wid & 1, fr = lane & 15,
            fq = lane >> 4;
  const int r0 = tid >> 3, pc = tid & 7;
  const int lc = pc ^ ((tid >> 4) & 7);
  const fp8_t* ga[4];
#pragma unroll
  for (int i = 0; i < 4; ++i) ga[i] = arow(r0 + 32 * i) + lc * 16;
  const fp8_t* gb0 = Bt + (long)r0 * Kb + lc * 16;
  const long gbs = (long)32 * Kb;
  const int sw = (fr >> 1) & 7;
  const int rd0 = fr * 128 + ((fq ^ sw) << 4), rd1 = fr * 128 + (((4 + fq) ^ sw) << 4);
  char* S = (char*)smem;
  const int nk = Kb >> 7;
  f32x4 acc[4][4];
#pragma unroll
  for (int m = 0; m < 4; ++m)
#pragma unroll
    for (int n = 0; n < 4; ++n) acc[m][n] = f32x4{0.f, 0.f, 0.f, 0.f};
  auto issue = [&](int kt) {
    char* st = S + (kt & 1) * 32768 + tid * 16;
#pragma unroll
    for (int i = 0; i < 4; ++i) {
      __builtin_amdgcn_global_load_lds((const unsigned*)(ga[i] + kt * 128), (unsigned*)(st + i * 4096), 16, 0, 0);
      __builtin_amdgcn_global_load_lds((const unsigned*)(gb0 + i * gbs + kt * 128), (unsigned*)(st + 16384 + i * 4096), 16, 0, 0);
    }
  };
  RAW_BARRIER();
  issue(0);
  if (nk > 1) issue(1);
#pragma unroll 1
  for (int kt = 0; kt < nk; ++kt) {
    if (kt + 1 < nk) asm volatile("s_waitcnt vmcnt(8)" ::: "memory");
    else asm volatile("s_waitcnt vmcnt(0)" ::: "memory");
    RAW_BARRIER();
    const char* st = S + (kt & 1) * 32768;
    i32x8 af[4], bfr[4];
#pragma unroll
    for (int m = 0; m < 4; ++m) {
      const i32x4 a0 = *reinterpret_cast<const i32x4*>(st + (wr * 64 + m * 16) * 128 + rd0);
      const i32x4 a1 = *reinterpret_cast<const i32x4*>(st + (wr * 64 + m * 16) * 128 + rd1);
      const i32x4 b0 = *reinterpret_cast<const i32x4*>(st + 16384 + (wc * 64 + m * 16) * 128 + rd0);
      const i32x4 b1 = *reinterpret_cast<const i32x4*>(st + 16384 + (wc * 64 + m * 16) * 128 + rd1);
      af[m] = i32x8{a0[0], a0[1], a0[2], a0[3], a1[0], a1[1], a1[2], a1[3]};
      bfr[m] = i32x8{b0[0], b0[1], b0[2], b0[3], b1[0], b1[1], b1[2], b1[3]};
    }
    RAW_BARRIER();
    if (kt + 2 < nk) issue(kt + 2);
#pragma unroll
    for (int m = 0; m < 4; ++m)
#pragma unroll
      for (int n = 0; n < 4; ++n)
        acc[m][n] = SWAP ? __builtin_amdgcn_mfma_scale_f32_16x16x128_f8f6f4(bfr[n], af[m], acc[m][n], 0, 0, 0, 0x7f7f7f7f, 0, 0x7f7f7f7f)
                         : __builtin_amdgcn_mfma_scale_f32_16x16x128_f8f6f4(af[m], bfr[n], acc[m][n], 0, 0, 0, 0x7f7f7f7f, 0, 0x7f7f7f7f);
  }
  epi(acc, wr, wc, fr, fq);
}


template <bool SWAP, class Epi>
__device__ __forceinline__ void gemm_tile8p(const fp8_t* A, const fp8_t* Bt, bool has_next, const fp8_t* An, const fp8_t* Btn,
                                            int& par, bool& primed, int Kb, unsigned char* smem, Epi epi) {
  const int tid = threadIdx.x, wid = tid >> 6, lane = tid & 63, wr = wid >> 1, wc = wid & 1, fr = lane & 15,
            fq = lane >> 4;
  const int r0 = tid >> 3, pc = tid & 7;
  const int lc = pc ^ ((tid >> 4) & 7);
  const long roff = (long)r0 * Kb + lc * 16;
  const long gbs = (long)32 * Kb;
  const int sw = (fr >> 1) & 7;
  const int rd0 = fr * 128 + ((fq ^ sw) << 4), rd1 = fr * 128 + (((4 + fq) ^ sw) << 4);
  char* S = (char*)smem;
  const int nk = Kb >> 7;
  f32x4 acc[4][4];
#pragma unroll
  for (int m = 0; m < 4; ++m)
#pragma unroll
    for (int n = 0; n < 4; ++n) acc[m][n] = f32x4{0.f, 0.f, 0.f, 0.f};
  auto issue = [&](const fp8_t* a, const fp8_t* b, int kt, int stage) {
    char* st = S + stage * 32768 + tid * 16;
    const fp8_t* ga = a + roff + kt * 128;
    const fp8_t* gb = b + roff + kt * 128;
#pragma unroll
    for (int i = 0; i < 4; ++i) {
      __builtin_amdgcn_global_load_lds((const unsigned*)(ga + i * gbs), (unsigned*)(st + i * 4096), 16, 0, 0);
      __builtin_amdgcn_global_load_lds((const unsigned*)(gb + i * gbs), (unsigned*)(st + 16384 + i * 4096), 16, 0, 0);
    }
  };
  if (!primed) {
    RAW_BARRIER();
    issue(A, Bt, 0, par);
  }
#pragma unroll 1
  for (int kt = 0; kt < nk; ++kt) {
    asm volatile("s_waitcnt vmcnt(0)" ::: "memory");
    RAW_BARRIER();
    if (kt + 1 < nk) issue(A, Bt, kt + 1, (par + kt + 1) & 1);
    else if (has_next) issue(An, Btn, 0, (par + kt + 1) & 1);
    const char* st = S + ((par + kt) & 1) * 32768;
    i32x8 af[4], bfr[4];
#pragma unroll
    for (int m = 0; m < 4; ++m) {
      const i32x4 a0 = *reinterpret_cast<const i32x4*>(st + (wr * 64 + m * 16) * 128 + rd0);
      const i32x4 a1 = *reinterpret_cast<const i32x4*>(st + (wr * 64 + m * 16) * 128 + rd1);
      const i32x4 b0 = *reinterpret_cast<const i32x4*>(st + 16384 + (wc * 64 + m * 16) * 128 + rd0);
      const i32x4 b1 = *reinterpret_cast<const i32x4*>(st + 16384 + (wc * 64 + m * 16) * 128 + rd1);
      af[m] = i32x8{a0[0], a0[1], a0[2], a0[3], a1[0], a1[1], a1[2], a1[3]};
      bfr[m] = i32x8{b0[0], b0[1], b0[2], b0[3], b1[0], b1[1], b1[2], b1[3]};
    }
#pragma unroll
    for (int m = 0; m < 4; ++m)
#pragma unroll
      for (int n = 0; n < 4; ++n)
        acc[m][n] = SWAP ? __builtin_amdgcn_mfma_scale_f32_16x16x128_f8f6f4(bfr[n], af[m], acc[m][n], 0, 0, 0, 0x7f7f7f7f, 0, 0x7f7f7f7f)
                         : __builtin_amdgcn_mfma_scale_f32_16x16x128_f8f6f4(af[m], bfr[n], acc[m][n], 0, 0, 0, 0x7f7f7f7f, 0, 0x7f7f7f7f);
  }
  par = (par + nk) & 1;
  primed = has_next;
  epi(acc, wr, wc, fr, fq);
}

__device__ __forceinline__ void phase_attn(const Params& p, unsigned char* smem, int blk, int nblk) {
  const int tid = threadIdx.x, w = tid >> 6, lane = tid & 63, fr = lane & 15, g = lane >> 4;
  act_t* SK = (act_t*)smem;
  act_t* SV = SK + 64 * 72;
  constexpr float SCL = 0.125f * 1.4426950408889634f;
  const int n_lat = NB * 4 * (T / 64), n_ctx = NB * 4 * (C / 64);
  const int skey = tid >> 2, spart = tid & 3;
  for (int unit = blk; unit < n_lat + n_ctx; unit += nblk) {
    const bool lat = unit < n_lat;
    const int uu = lat ? unit : unit - n_lat;
    const int nq = lat ? T / 64 : C / 64;
    const int hp = uu & 1, kv = (uu >> 1) & 1, qb = (uu >> 2) % nq, b = (uu >> 2) / nq;
    const int t0 = qb * 64;
    const int tw = t0 + (w & 1) * 32;
    const long qrow0 = (lat ? (long)NC + (long)b * T : (long)b * C) + tw;
    const int h = kv * 4 + hp * 2 + (w >> 1);
    bf16x8 qf[2][2];
#pragma unroll
    for (int qt = 0; qt < 2; ++qt)
#pragma unroll
      for (int st = 0; st < 2; ++st)
        qf[qt][st] = *reinterpret_cast<const bf16x8*>(p.P + (qrow0 + qt * 16 + fr) * PW + E_AQ + h * 64 + st * 32 + g * 8);
    asm volatile("" :: "v"(qf[0][0]), "v"(qf[0][1]), "v"(qf[1][0]), "v"(qf[1][1]));
    float mrun[2], lrun[2];
    f32x4 o[2][4];
    const float sinkl = p.attn_sink[h] * 1.4426950408889634f;
#pragma unroll
    for (int qt = 0; qt < 2; ++qt) {
      mrun[qt] = sinkl;
      lrun[qt] = (g == 0) ? 1.0f : 0.0f;
#pragma unroll
      for (int dt = 0; dt < 4; ++dt) o[qt][dt] = f32x4{0.f, 0.f, 0.f, 0.f};
    }
    int cc_lo = 0, cc_hi = -1;
    if (lat) {
      cc_lo = t0 >= 128 ? 0 : (128 - t0) / 64;
      cc_hi = min(4, (T - 1 - (t0 - 128)) / 64);
    }
    const int nch = 4 + (cc_hi - cc_lo + 1);
    auto chunk_row = [&](int i, int key, int& tkb) -> long {
      if (i < 4) { tkb = 0; return (long)b * C + i * 64 + key; }
      tkb = t0 - 128 + (cc_lo + i - 4) * 64;
      return (long)NC + (long)b * T + tkb + key;
    };
    uint4 rk0, rk1, rv0, rv1;
    {
      int tkb; const long kr = chunk_row(0, skey, tkb);
      const act_t* kp = p.P + kr * PW + E_AK + kv * 64 + spart * 16;
      const act_t* vp = p.P + kr * PW + E_AV + kv * 64 + spart * 16;
      rk0 = *reinterpret_cast<const uint4*>(kp); rk1 = *reinterpret_cast<const uint4*>(kp + 8);
      rv0 = *reinterpret_cast<const uint4*>(vp); rv1 = *reinterpret_cast<const uint4*>(vp + 8);
    }
    for (int i = 0; i < nch; ++i) {
      __syncthreads();
      {
        uint4* kd = reinterpret_cast<uint4*>(SK + skey * 72 + spart * 16);
        kd[0] = rk0; kd[1] = rk1;
        const unsigned vw[8] = {rv0.x, rv0.y, rv0.z, rv0.w, rv1.x, rv1.y, rv1.z, rv1.w};
#pragma unroll
        for (int e = 0; e < 8; ++e) {
          SV[(spart * 16 + 2 * e) * 72 + skey] = (act_t)(vw[e] & 0xffffu);
          SV[(spart * 16 + 2 * e + 1) * 72 + skey] = (act_t)(vw[e] >> 16);
        }
      }
      __syncthreads();
      int tkb_cur; (void)chunk_row(i, 0, tkb_cur);
      if (i + 1 < nch) {
        int tkb; const long kr = chunk_row(i + 1, skey, tkb);
        const act_t* kp = p.P + kr * PW + E_AK + kv * 64 + spart * 16;
        const act_t* vp = p.P + kr * PW + E_AV + kv * 64 + spart * 16;
        rk0 = *reinterpret_cast<const uint4*>(kp); rk1 = *reinterpret_cast<const uint4*>(kp + 8);
        rv0 = *reinterpret_cast<const uint4*>(vp); rv1 = *reinterpret_cast<const uint4*>(vp + 8);
      }
      const bool edge = i >= 4 && (tkb_cur == t0 - 128 || tkb_cur == t0 + 128);
#pragma unroll
      for (int kb = 0; kb < 2; ++kb) {
        f32x4 sc[2][2];
#pragma unroll
        for (int k2 = 0; k2 < 2; ++k2) {
          const int kt = kb * 2 + k2;
          const bf16x8 kf0 = *reinterpret_cast<const bf16x8*>(SK + (kt * 16 + fr) * 72 + g * 8);
          const bf16x8 kf1 = *reinterpret_cast<const bf16x8*>(SK + (kt * 16 + fr) * 72 + 32 + g * 8);
#pragma unroll
          for (int qt = 0; qt < 2; ++qt) {
            f32x4 z = f32x4{0.f, 0.f, 0.f, 0.f};
            z = __builtin_amdgcn_mfma_f32_16x16x32_bf16(kf0, qf[qt][0], z, 0, 0, 0);
            sc[qt][k2] = __builtin_amdgcn_mfma_f32_16x16x32_bf16(kf1, qf[qt][1], z, 0, 0, 0);
          }
        }
        bf16x8 pf[2];
#pragma unroll
        for (int qt = 0; qt < 2; ++qt) {
          float mx = -1e30f;
#pragma unroll
          for (int k2 = 0; k2 < 2; ++k2)
#pragma unroll
            for (int j = 0; j < 4; ++j) {
              float v = sc[qt][k2][j] * SCL;
              if (edge) {
                const int tk = tkb_cur + (kb * 2 + k2) * 16 + 4 * g + j;
                const int tq = tw + qt * 16 + fr;
                const int df = tq - tk;
                if (df > 128 || df < -128) v = -1e30f;
              }
              sc[qt][k2][j] = v;
              mx = fmaxf(mx, v);
            }
          mx = xor16_max(mx);
          mx = xor32_max(mx);
          const float mnew = fmaxf(mrun[qt], mx);
          if (__any(mnew > mrun[qt])) {
            const float alpha = __builtin_amdgcn_exp2f(mrun[qt] - mnew);
            lrun[qt] *= alpha;
#pragma unroll
            for (int dt = 0; dt < 4; ++dt) o[qt][dt] = o[qt][dt] * alpha;
            mrun[qt] = mnew;
          }
          float ls = 0.f;
          float pv[8];
#pragma unroll
          for (int k2 = 0; k2 < 2; ++k2)
#pragma unroll
            for (int j = 0; j < 4; ++j) {
              const float pe = __builtin_amdgcn_exp2f(sc[qt][k2][j] - mnew);
              pv[k2 * 4 + j] = pe;
              ls += pe;
            }
          lrun[qt] += ls;
          union { unsigned u[4]; bf16x8 v; } cv;
          cv.u[0] = pack2_mfma(pv[0], pv[1]); cv.u[1] = pack2_mfma(pv[2], pv[3]);
          cv.u[2] = pack2_mfma(pv[4], pv[5]); cv.u[3] = pack2_mfma(pv[6], pv[7]);
          pf[qt] = cv.v;
        }
#pragma unroll
        for (int dt = 0; dt < 4; ++dt) {
          union { uint2 h2[2]; bf16x8 v; } vf;
          vf.h2[0] = *reinterpret_cast<const uint2*>(SV + (dt * 16 + fr) * 72 + kb * 32 + 4 * g);
          vf.h2[1] = *reinterpret_cast<const uint2*>(SV + (dt * 16 + fr) * 72 + kb * 32 + 16 + 4 * g);
#pragma unroll
          for (int qt = 0; qt < 2; ++qt) o[qt][dt] = __builtin_amdgcn_mfma_f32_16x16x32_bf16(vf.v, pf[qt], o[qt][dt], 0, 0, 0);
        }
      }
    }
#pragma unroll
    for (int qt = 0; qt < 2; ++qt) {
      float lt = lrun[qt];
      lt = xor16_add(lt);
      lt = xor32_add(lt);
      const float il = 1.0f / lt;
      fp8_t* orow = p.O8 + (qrow0 + qt * 16 + fr) * D + h * 64 + 4 * g;
      const float ils = il * SO8;
#pragma unroll
      for (int dt = 0; dt < 4; ++dt)
        *reinterpret_cast<unsigned*>(orow + dt * 16) = pack4_fp8(o[qt][dt][0] * ils, o[qt][dt][1] * ils, o[qt][dt][2] * ils, o[qt][dt][3] * ils);
    }
  }
}


template <int MODE>
__device__ __forceinline__ void phase_combine(const Params& p) {
  constexpr int DV = MODE == 0 ? 128 : 192, EPL = DV / 16, NV = EPL / 4;
  const int lane = threadIdx.x & 63;
  const long row_lo = MODE == 0 ? 0 : NC;
  const int nw = (int)gridDim.x * 4, wi = (int)blockIdx.x * 4 + (int)(threadIdx.x >> 6);
  const int rpw = (int)(NR - row_lo + nw - 1) / nw;
  const long r0 = row_lo + (long)wi * rpw, r1 = min((long)NR, r0 + rpw);
  float gn[EPL];
#pragma unroll
  for (int e = 0; e < EPL; ++e) gn[e] = (MODE == 0 ? p.hgrn_norm : p.gla_norm)[lane * EPL + e];
  uint2 fa[NV], fb[NV], fg[NV];
  auto load_row = [&](long row) {
    const uint2* f = reinterpret_cast<const uint2*>(p.OF + row * 768 + lane * EPL);
    const uint2* bk = reinterpret_cast<const uint2*>(p.OB + row * 768 + lane * EPL);
    const uint2* gt = reinterpret_cast<const uint2*>(p.P + row * PW + (MODE == 0 ? E_HG : O_G) + lane * EPL);
#pragma unroll
    for (int v = 0; v < NV; ++v) { fa[v] = f[v]; fb[v] = bk[v]; fg[v] = gt[v]; }
  };
  if (r0 < r1) load_row(r0);
  for (long row = r0; row < r1; ++row) {
    float o[EPL], gg[EPL];
#pragma unroll
    for (int v = 0; v < NV; ++v) {
      o[4 * v + 0] = bf_lo(fa[v].x) + bf_lo(fb[v].x); o[4 * v + 1] = bf_hi(fa[v].x) + bf_hi(fb[v].x);
      o[4 * v + 2] = bf_lo(fa[v].y) + bf_lo(fb[v].y); o[4 * v + 3] = bf_hi(fa[v].y) + bf_hi(fb[v].y);
      gg[4 * v + 0] = bf_lo(fg[v].x); gg[4 * v + 1] = bf_hi(fg[v].x); gg[4 * v + 2] = bf_lo(fg[v].y); gg[4 * v + 3] = bf_hi(fg[v].y);
    }
    load_row(min(row + 1, r1 - 1));
    float ss = 0.f;
#pragma unroll
    for (int e = 0; e < EPL; ++e) ss += o[e] * o[e];
    ss = row_sum16(ss);
    const float r = 1.0f / sqrtf(ss * (1.0f / DV) + LN_EPS);
    unsigned* dst = reinterpret_cast<unsigned*>(p.O8 + row * D + (MODE == 0 ? 512 : 0) + lane * EPL);
#pragma unroll
    for (int v = 0; v < NV; ++v) {
      float y[4];
#pragma unroll
      for (int q = 0; q < 4; ++q) {
        const float g = gg[4 * v + q];
        y[q] = o[4 * v + q] * (r * SO8) * gn[4 * v + q] * (g / (1.0f + __expf(-g)));
      }
      dst[v] = pack4_fp8(y[0], y[1], y[2], y[3]);
    }
  }
}

constexpr int MOD_ITEMS = 2 * 2 * (6 * D / 64);
__device__ __forceinline__ void mod_item(const Params& p, int item, unsigned char* smem) {
  float* sc = (float*)smem;
  float* red = sc + 9 * 512;
  const int tid = threadIdx.x, w = tid >> 6, lane = tid & 63;
  const int kh = item & 1, cgi = item >> 1;
  const int l = cgi / (6 * D / 64), j = (cgi % (6 * D / 64)) * 64 + lane;
  const float* wp = p.w_ada + (long)l * D * 6 * D + (long)(kh * 512 + w * 128) * 6 * D + j;
  float wv[32];
#pragma unroll
  for (int q = 0; q < 32; ++q) wv[q] = wp[(long)q * 6 * D];
#pragma unroll 6
  for (int i = tid; i < 9 * 512; i += 256) {
    const int bb = i >> 9, k = kh * 512 + (i & 511);
    const float v = bb < NB ? p.c[bb * D + k] : p.c_ctx[k];
    sc[i] = v / (1.0f + __expf(-v));
  }
  float a[NB + 1];
#pragma unroll
  for (int bb = 0; bb <= NB; ++bb) a[bb] = 0.f;
  __syncthreads();
#pragma unroll 1
  for (int kb = 0; kb < 128; kb += 32) {
    float wc[32];
#pragma unroll
    for (int q = 0; q < 32; ++q) wc[q] = wv[q];
    const int kn = min(kb + 32, 96);
#pragma unroll
    for (int q = 0; q < 32; ++q) wv[q] = wp[(long)(kn + q) * 6 * D];
#pragma unroll
    for (int q4 = 0; q4 < 8; ++q4)
#pragma unroll
      for (int bb = 0; bb <= NB; ++bb) {
        const float4 s4 = *reinterpret_cast<const float4*>(sc + bb * 512 + w * 128 + kb + 4 * q4);
        a[bb] += s4.x * wc[4 * q4] + s4.y * wc[4 * q4 + 1] + s4.z * wc[4 * q4 + 2] + s4.w * wc[4 * q4 + 3];
      }
  }
#pragma unroll
  for (int q = 0; q < 32; ++q) asm volatile("" :: "v"(wv[q]));
#pragma unroll
  for (int bb = 0; bb <= NB; ++bb) red[(w * 9 + bb) * 64 + lane] = a[bb];
  __syncthreads();
  for (int i = tid; i < 9 * 64; i += 256) {
    const int bb = i >> 6, jj = i & 63;
    const int col = (cgi % (6 * D / 64)) * 64 + jj;
    const float sum = ((red[(0 * 9 + bb) * 64 + jj] + red[(1 * 9 + bb) * 64 + jj]) + (red[(2 * 9 + bb) * 64 + jj] + red[(3 * 9 + bb) * 64 + jj]));
    atomicAdd(p.mod + ((long)l * (NB + 1) + bb) * 6 * D + col, kh == 0 ? sum + p.b_ada[l * 6 * D + col] : sum);
  }
  __syncthreads();
}

__device__ __forceinline__ void phase_gla_decay(const Params& p) {
  const int t = threadIdx.x;
  if (t >= 192) return;
  const int dir = t / 96, cg = t % 96;
  float gw[16][4], gb[4];
#pragma unroll
  for (int r = 0; r < 16; ++r) {
    const float4 v = *reinterpret_cast<const float4*>(p.gla_gate_w + ((long)dir * 16 + r) * 384 + cg * 4);
    gw[r][0] = v.x; gw[r][1] = v.y; gw[r][2] = v.z; gw[r][3] = v.w;
  }
  {
    const float4 v = *reinterpret_cast<const float4*>(p.gla_gate_b + dir * 384 + cg * 4);
    gb[0] = v.x; gb[1] = v.y; gb[2] = v.z; gb[3] = v.w;
  }
  const int rpb = ((NR + (int)gridDim.x - 1) / (int)gridDim.x + 3) / 4 * 4;
  const long b0 = (long)blockIdx.x * rpb, b1 = min((long)NR, b0 + rpb);
  uint4 ra[4], rb[4];
  auto load4 = [&](long row0) {
#pragma unroll
    for (int q = 0; q < 4; ++q) {
      const uint4* rp = reinterpret_cast<const uint4*>(p.P + min(row0 + q, b1 - 1) * PW + O_RF + dir * 16);
      ra[q] = rp[0]; rb[q] = rp[1];
    }
  };
  if (b0 < b1) load4(b0);
  for (long row0 = b0; row0 < b1; row0 += 4) {
    unsigned rw[4][8];
#pragma unroll
    for (int q = 0; q < 4; ++q) {
      rw[q][0] = ra[q].x; rw[q][1] = ra[q].y; rw[q][2] = ra[q].z; rw[q][3] = ra[q].w;
      rw[q][4] = rb[q].x; rw[q][5] = rb[q].y; rw[q][6] = rb[q].z; rw[q][7] = rb[q].w;
    }
    load4(min(row0 + 4, b1 - 1));
#pragma unroll
    for (int q = 0; q < 4; ++q) {
      float z[4] = {gb[0], gb[1], gb[2], gb[3]};
#pragma unroll
      for (int r2 = 0; r2 < 8; ++r2) {
        const float x0 = bf_lo(rw[q][r2]), x1 = bf_hi(rw[q][r2]);
#pragma unroll
        for (int c = 0; c < 4; ++c) z[c] += x0 * gw[2 * r2][c] + x1 * gw[2 * r2 + 1][c];
      }
      float o[4];
#pragma unroll
      for (int c = 0; c < 4; ++c) o[c] = (fminf(z[c], 0.f) - __logf(1.0f + __expf(-fabsf(z[c])))) * (1.0f / 16.0f);
      if (row0 + q < b1)
        *reinterpret_cast<uint2*>(p.LF + ((long)dir * NR + row0 + q) * 384 + cg * 4) = make_uint2(pack2(o[0], o[1]), pack2(o[2], o[3]));
    }
  }
}

__device__ __forceinline__ void phase_hgrn_gate(const Params& p, long gtid, long gstride) {
  for (long i = gtid; i < (long)NR * 1024; i += gstride) {
    const int col = (int)(i & 1023);
    const long row = i >> 10;
    act_t* z = p.P + row * PW + E_FF + col;
    const float lb = p.lbt[col];
    const float f = lb + (1.0f - lb) * sigmoidf_(ldA(z));
    stA(z, __logf(f));
  }
}

template <int MODE>
__device__ __forceinline__ void phase_scan(const Params& p, unsigned char* smem, int blk, int nblk) {
  constexpr int DK = MODE == 0 ? 128 : 96, DV = MODE == 0 ? 128 : 192, DVS = DV / 4, NET = DVS / 16, NKS = DK / 32,
                NDT = DK / 16;
  constexpr int QS = DK + 8, LS = 72, SS = DK + 8;
  act_t* Qa = (act_t*)smem;
  act_t* Ka = Qa + 64 * QS;
  act_t* KaT = Ka + 64 * QS;
  act_t* VT = KaT + DK * LS;
  act_t* ST = VT + DVS * LS;
  float* tot = (float*)(ST + DVS * SS);
  float* lf32 = tot + 2 * 4 * DK;
  const int tid = threadIdx.x, w = __builtin_amdgcn_readfirstlane(threadIdx.x >> 6), lane = tid & 63, fr = lane & 15, g = lane >> 4;
  const int dp = lane, c0 = 2 * dp;
  const bool cact = dp < DK / 2;
  constexpr int NCH = (C + T) / 64, NCC = C / 64;
  constexpr int NVI = DVS / 8 * 64;
  for (int item = blk; item < NB * 4 * 2 * 4; item += nblk) {
    const int sl = item & 3, dir = (item >> 2) & 1, h = (item >> 3) & 3, b = item >> 5;
    act_t* OD = dir == 0 ? p.OF : p.OB;
    const unsigned loff = (unsigned)min(c0, DK - 2) * 2u;
    const int vcol = (MODE == 0 ? E_HI + h * 128 : O_V + h * 192) + sl * DVS;
    const int ocol = h * DV + sl * DVS;
    auto chunk_base = [&](int n) -> long {
      if (n < NCC) return (long)b * C + (dir ? NCC - 1 - n : n) * 64;
      const int ln = n - NCC;
      return (long)NC + (long)b * T + (dir ? T / 64 - 1 - ln : ln) * 64;
    };
    auto lrow = [&](long base, int l) -> long { return base + (dir ? 63 - l : l); };
    f32x4 S[NET][2];
#pragma unroll
    for (int et = 0; et < NET; ++et) { S[et][0] = f32x4{0.f, 0.f, 0.f, 0.f}; S[et][1] = f32x4{0.f, 0.f, 0.f, 0.f}; }
    unsigned rlf[16], rq[16], rk[16];
    uint4 rv[2];
    const long rstep = dir ? -(long)PW * 2 : (long)PW * 2;
    const long lstep = dir ? -(long)384 * 2 : (long)384 * 2;
    const unsigned off_lf = (MODE == 0 ? (unsigned)(E_FF + dir * 512 + h * 128) * 2u : 0u) + loff;
    const unsigned off_q = (unsigned)(MODE == 0 ? E_HQ + h * 128 : O_Q + h * 96) * 2u + loff;
    const unsigned off_k = (unsigned)(O_K + h * 96) * 2u + loff;
    auto issue_loads = [&](int n) {
      const long base = chunk_base(n);
      {
        const char* prow = (const char*)(p.P + lrow(base, w * 16) * PW);
        const char* plf = (const char*)(p.LF + ((long)dir * NR + lrow(base, w * 16)) * 384 + h * 96);
#pragma unroll
        for (int i = 0; i < 16; ++i) {
          if (MODE == 0) {
            rlf[i] = *reinterpret_cast<const unsigned*>(prow + off_lf);
          } else {
            rlf[i] = *reinterpret_cast<const unsigned*>(plf + loff);
            rk[i] = *reinterpret_cast<const unsigned*>(prow + off_k);
            plf += lstep;
          }
          rq[i] = *reinterpret_cast<const unsigned*>(prow + off_q);
          prow += rstep;
        }
      }
#pragma unroll
      for (int r = 0; r < (NVI + 255) / 256; ++r) {
        const int it = min(tid + r * 256, NVI - 1);
        const int l = it / (DVS / 8), e8 = (it % (DVS / 8)) * 8;
        rv[r] = *reinterpret_cast<const uint4*>(p.P + lrow(base, l) * PW + vcol + e8);
      }
    };
    issue_loads(0);
    for (int n = 0; n < NCH; ++n) {
      const int par = n & 1;
      float* totp = tot + par * 4 * DK;
      float* lfp = lf32 + par * DK;
      const long base = chunk_base(n);
      if (cact) {
        float r0 = 0.f, r1 = 0.f;
#pragma unroll
        for (int i = 0; i < 16; ++i) { r0 += bf_lo(rlf[i]); r1 += bf_hi(rlf[i]); }
        totp[w * DK + c0] = r0; totp[w * DK + c0 + 1] = r1;
        if (w == 2) { lfp[c0] = bf_lo(rlf[0]); lfp[c0 + 1] = bf_hi(rlf[0]); }
      }
      __syncthreads();
#pragma unroll
      for (int r = 0; r < (NVI + 255) / 256; ++r) {
        const int it = tid + r * 256;
        if (it < NVI) {
          const int l = it / (DVS / 8), e8 = (it % (DVS / 8)) * 8;
          const unsigned vw[4] = {rv[r].x, rv[r].y, rv[r].z, rv[r].w};
#pragma unroll
          for (int e = 0; e < 4; ++e) {
            VT[(e8 + 2 * e) * LS + l] = (act_t)(vw[e] & 0xffffu);
            VT[(e8 + 2 * e + 1) * LS + l] = (act_t)(vw[e] >> 16);
          }
        }
      }
      if (cact) {
        float of0 = 0.f, of1 = 0.f;
#pragma unroll
        for (int sgi = 0; sgi < 3; ++sgi)
          if (sgi < w) { of0 += totp[sgi * DK + c0]; of1 += totp[sgi * DK + c0 + 1]; }
        const float ref0 = totp[c0] + totp[DK + c0] + lfp[c0];
        const float ref1 = totp[c0 + 1] + totp[DK + c0 + 1] + lfp[c0 + 1];
        unsigned kt0[8], kt1[8];
        float run0 = of0 - ref0, run1 = of1 - ref1;
#pragma unroll
        for (int i = 0; i < 16; i += 2) {
          float ka0[2], ka1[2];
#pragma unroll
          for (int ii = 0; ii < 2; ++ii) {
            const int i2 = i + ii;
            run0 += bf_lo(rlf[i2]); run1 += bf_hi(rlf[i2]);
            const float b0 = run0, b1 = run1;
            const float e0 = __expf(b0), e1 = __expf(b1), f0 = __expf(-b0), f1 = __expf(-b1);
            float k0, k1;
            if (MODE == 0) { k0 = 1.0f - __expf(bf_lo(rlf[i2])); k1 = 1.0f - __expf(bf_hi(rlf[i2])); }
            else { k0 = bf_lo(rk[i2]); k1 = bf_hi(rk[i2]); }
            ka0[ii] = k0 * f0; ka1[ii] = k1 * f1;
            const int l = w * 16 + i2;
            *reinterpret_cast<unsigned*>(Qa + l * QS + c0) = pack2(bf_lo(rq[i2]) * e0, bf_hi(rq[i2]) * e1);
            *reinterpret_cast<unsigned*>(Ka + l * QS + c0) = pack2(ka0[ii], ka1[ii]);
          }
          kt0[i >> 1] = pack2(ka0[0], ka0[1]);
          kt1[i >> 1] = pack2(ka1[0], ka1[1]);
        }
        uint4* d0 = reinterpret_cast<uint4*>(KaT + c0 * LS + w * 16);
        d0[0] = make_uint4(kt0[0], kt0[1], kt0[2], kt0[3]); d0[1] = make_uint4(kt0[4], kt0[5], kt0[6], kt0[7]);
        uint4* d1 = reinterpret_cast<uint4*>(KaT + (c0 + 1) * LS + w * 16);
        d1[0] = make_uint4(kt1[0], kt1[1], kt1[2], kt1[3]); d1[1] = make_uint4(kt1[4], kt1[5], kt1[6], kt1[7]);
      }
      issue_loads(min(n + 1, NCH - 1));
      float egv[2], egrv[2];
#pragma unroll
      for (int di = 0; di < 2; ++di) {
        const int dt = w + 4 * di;
        if (dt < NDT) {
          const int d = dt * 16 + fr;
          const float refd = totp[d] + totp[DK + d] + lfp[d];
          const float gd = totp[d] + totp[DK + d] + totp[2 * DK + d] + totp[3 * DK + d];
          const float er = __expf(refd);
          egv[di] = __expf(gd); egrv[di] = __expf(gd - refd);
#pragma unroll
          for (int et = 0; et < NET; ++et)
#pragma unroll
            for (int j = 0; j < 4; ++j) stA(ST + (et * 16 + 4 * g + j) * SS + d, S[et][di][j] * er);
        }
      }
      __syncthreads();
      bf16x8 qfr[NKS];
#pragma unroll
      for (int ks = 0; ks < NKS; ++ks) qfr[ks] = *reinterpret_cast<const bf16x8*>(Qa + (w * 16 + fr) * QS + ks * 32 + g * 8);
      bf16x8 pfr[2];
#pragma unroll
      for (int kb = 0; kb < 2; ++kb) {
        f32x4 at2[2];
#pragma unroll
        for (int h2 = 0; h2 < 2; ++h2) {
          const int mt = 2 * kb + h2;
          at2[h2] = f32x4{0.f, 0.f, 0.f, 0.f};
          if (mt <= w) {
#pragma unroll
            for (int ks = 0; ks < NKS; ++ks) {
              const bf16x8 kaf = *reinterpret_cast<const bf16x8*>(Ka + (mt * 16 + fr) * QS + ks * 32 + g * 8);
              at2[h2] = __builtin_amdgcn_mfma_f32_16x16x32_bf16(kaf, qfr[ks], at2[h2], 0, 0, 0);
            }
            if (mt == w) {
#pragma unroll
              for (int j = 0; j < 4; ++j)
                if (4 * g + j > fr) at2[h2][j] = 0.f;
            }
          }
        }
        union { unsigned u[4]; bf16x8 v; } cv;
        cv.u[0] = pack2_mfma(at2[0][0], at2[0][1]); cv.u[1] = pack2_mfma(at2[0][2], at2[0][3]);
        cv.u[2] = pack2_mfma(at2[1][0], at2[1][1]); cv.u[3] = pack2_mfma(at2[1][2], at2[1][3]);
        pfr[kb] = cv.v;
      }
      const long orow = lrow(base, w * 16 + fr);
#pragma unroll
      for (int et = 0; et < NET; ++et) {
        f32x4 o = f32x4{0.f, 0.f, 0.f, 0.f};
#pragma unroll
        for (int kb = 0; kb < 2; ++kb) {
          if (2 * kb <= w) {
            union { uint2 h2[2]; bf16x8 v; } vf;
            vf.h2[0] = *reinterpret_cast<const uint2*>(VT + (et * 16 + fr) * LS + kb * 32 + 4 * g);
            vf.h2[1] = *reinterpret_cast<const uint2*>(VT + (et * 16 + fr) * LS + kb * 32 + 16 + 4 * g);
            o = __builtin_amdgcn_mfma_f32_16x16x32_bf16(vf.v, pfr[kb], o, 0, 0, 0);
          }
        }
#pragma unroll
        for (int ks = 0; ks < NKS; ++ks) {
          const bf16x8 sf = *reinterpret_cast<const bf16x8*>(ST + (et * 16 + fr) * SS + ks * 32 + g * 8);
          o = __builtin_amdgcn_mfma_f32_16x16x32_bf16(sf, qfr[ks], o, 0, 0, 0);
        }
        const float osc = MODE == 0 ? 1.0f : 0.10206207261596575f;
        *reinterpret_cast<uint2*>(OD + orow * 768 + ocol + et * 16 + 4 * g) =
            make_uint2(pack2(o[0] * osc, o[1] * osc), pack2(o[2] * osc, o[3] * osc));
      }
#pragma unroll
      for (int di = 0; di < 2; ++di) {
        const int dt = w + 4 * di;
        if (dt < NDT) {
#pragma unroll
          for (int et = 0; et < NET; ++et) {
            f32x4 r = f32x4{0.f, 0.f, 0.f, 0.f};
#pragma unroll
            for (int k2 = 0; k2 < 2; ++k2) {
              const bf16x8 vf = *reinterpret_cast<const bf16x8*>(VT + (et * 16 + fr) * LS + k2 * 32 + g * 8);
              const bf16x8 kf = *reinterpret_cast<const bf16x8*>(KaT + (dt * 16 + fr) * LS + k2 * 32 + g * 8);
              r = __builtin_amdgcn_mfma_f32_16x16x32_bf16(vf, kf, r, 0, 0, 0);
            }
#pragma unroll
            for (int j = 0; j < 4; ++j) S[et][di][j] = egv[di] * S[et][di][j] + egrv[di] * r[j];
          }
        }
      }
    }
    __syncthreads();
  }
}

struct GemmJob {
  const act_t* A; const act_t* Bt; act_t* C;
  long sA, sB, sC;
  int nbatch, Mtiles, Ntiles, K, ldc, Nvalid, mode;
  float scale;
  int fp8;
  int out8;
};
__device__ __forceinline__ void phase_gemm(const Params& p, const GemmJob& g, unsigned char* smem, int blk = blockIdx.x, int nblk = gridDim.x) {
  const int per_b = g.Mtiles * g.Ntiles;
  const int ntiles = per_b * g.nbatch;
  auto tvalid = [&](int t) -> bool {
    const int tt = t % per_b;
    const int tm = tt / g.Ntiles, tn = tt % g.Ntiles;
    return !(g.mode == 1 && tm < NC / 128 && tn * 128 >= O_FA);
  };
  auto tnext = [&](int t) -> int { t += nblk; while (t < ntiles && !tvalid(t)) t += nblk; return t; };
  int par = 0;
  bool primed = false;
  int tile0 = blk;
  if (tile0 < ntiles && !tvalid(tile0)) tile0 = tnext(tile0);
  for (int tile = tile0; tile < ntiles;) {
    const int ntile = tnext(tile);
    const int b = tile / per_b, tt = tile % per_b;
    const int tm = tt / g.Ntiles, tn = tt % g.Ntiles;
    const int tt2 = (ntile < ntiles ? ntile : tile) % per_b;
    const int tm2 = tt2 / g.Ntiles, tn2 = tt2 % g.Ntiles;
    const int K = g.K, ldc = g.ldc;
    const act_t* Ab = g.A + b * g.sA + (long)tm * 128 * K;
    act_t* Cb = g.C + b * g.sC + (long)tm * 128 * ldc + tn * 128;
    const int nlim = g.Nvalid - tn * 128;
    const float scale = g.scale;
    const int mode = g.mode;
    if (mode == 1) {
      auto epi1 = [&](f32x4 (&acc)[4][4], int wr, int wc, int fr, int fq) {
                  if (g.fp8) {
#pragma unroll
                    for (int m = 0; m < 4; ++m)
#pragma unroll
                      for (int n = 0; n < 4; ++n) acc[m][n] = acc[m][n] * scale;
                  }
#pragma unroll
                  for (int m = 0; m < 4; ++m)
#pragma unroll
                    for (int n = 0; n < 4; ++n) {
                      const int col = wc * 64 + n * 16 + fr;
                      if (col < nlim) {
#pragma unroll
                        for (int j = 0; j < 4; ++j) {
                          const int row = wr * 64 + m * 16 + fq * 4 + j;
                          stA(Cb + (long)row * ldc + col, acc[m][n][j]);
                        }
                      } else {
                        const int gc = tn * 128 + col;
                        if (gc < O_END && tm >= NC / 128) {
                          const int lr = (tm - NC / 128) * 128 + wr * 64 + m * 16 + fq * 4;
                          const int bb = lr / T, t = lr % T;
                          const int cq = gc < O_FB ? gc - O_FA : gc - O_FB;
                          act_t* dst = p.FT + ((long)bb * 256 + cq) * (2 * T) + (gc < O_FB ? 0 : T) + t;
                          *reinterpret_cast<uint2*>(dst) = make_uint2(pack2(acc[m][n][0], acc[m][n][1]), pack2(acc[m][n][2], acc[m][n][3]));
                        }
                      }
                    }
                };
      if (g.fp8) {
        const fp8_t* A8 = (const fp8_t*)g.A + (long)tm * 128 * K;
        gemm_tile8p<false>(A8, (const fp8_t*)g.Bt + (long)tn * 128 * K, ntile < ntiles, (const fp8_t*)g.A + (long)tm2 * 128 * K,
                           (const fp8_t*)g.Bt + (long)tn2 * 128 * K, par, primed, K, smem, epi1);
      } else {
        gemm_tile<false>([&](int r) { return Ab + (long)r * K; }, g.Bt + b * g.sB + (long)tn * 128 * K, K, smem, epi1);
      }
    } else {
      auto epi2 = [&](f32x4 (&acc)[4][4], int wr, int wc, int fr, int fq) {
                  const float oscale = g.fp8 ? 1.0f : scale;
                  if (g.fp8) {
#pragma unroll
                    for (int m = 0; m < 4; ++m)
#pragma unroll
                      for (int n = 0; n < 4; ++n) acc[m][n] = acc[m][n] * scale;
                  }
                  if (mode == 2) {
                    const int cb = tn * 128 + wc * 64;
                    if (cb < E_AV && tm >= NC / 128) {
                      const float4* rt = reinterpret_cast<const float4*>(p.ropetab);
#pragma unroll
                      for (int m = 0; m < 4; ++m) {
                        const int t = ((tm - NC / 128) * 128 + wr * 64 + m * 16 + fr) % T;
                        const float4 r01 = rt[(t / GRID_W) * 8 + fq * 2], r23 = rt[(t / GRID_W) * 8 + fq * 2 + 1];
                        const float4 c01 = rt[(t % GRID_W) * 8 + fq * 2], c23 = rt[(t % GRID_W) * 8 + fq * 2 + 1];
                        const float rc[4] = {r01.x, r01.z, r23.x, r23.z}, rs_[4] = {r01.y, r01.w, r23.y, r23.w};
                        const float cc[4] = {c01.x, c01.z, c23.x, c23.z}, cs_[4] = {c01.y, c01.w, c23.y, c23.w};
#pragma unroll
                        for (int j = 0; j < 4; ++j) {
                          const float a1 = acc[m][0][j], a2 = acc[m][1][j], b1 = acc[m][2][j], b2 = acc[m][3][j];
                          acc[m][0][j] = a1 * rc[j] - a2 * rs_[j]; acc[m][1][j] = a1 * rs_[j] + a2 * rc[j];
                          acc[m][2][j] = b1 * cc[j] - b2 * cs_[j]; acc[m][3][j] = b1 * cs_[j] + b2 * cc[j];
                        }
                      }
                    } else if (cb >= E_FF && cb < E_HQ) {
#pragma unroll
                      for (int n = 0; n < 4; ++n) {
                        const float4 lb4 = *reinterpret_cast<const float4*>(p.lbt + cb - E_FF + n * 16 + fq * 4);
                        const float lb[4] = {lb4.x, lb4.y, lb4.z, lb4.w};
#pragma unroll
                        for (int m = 0; m < 4; ++m)
#pragma unroll
                          for (int j = 0; j < 4; ++j)
                            acc[m][n][j] = __logf(lb[j] + (1.0f - lb[j]) / (1.0f + __expf(-acc[m][n][j])));
                      }
                    }
                  }
#pragma unroll
                  for (int m = 0; m < 4; ++m) {
                    const int row = wr * 64 + m * 16 + fr;
#pragma unroll
                    for (int n = 0; n < 4; ++n) {
                      const int col = wc * 64 + n * 16 + fq * 4;
                      if (col < nlim) {
                        if (g.out8)
                          *reinterpret_cast<unsigned*>(reinterpret_cast<fp8_t*>(g.C) + b * g.sC + ((long)tm * 128 + row) * ldc + tn * 128 + col) =
                              pack4_fp8(acc[m][n][0] * oscale, acc[m][n][1] * oscale, acc[m][n][2] * oscale, acc[m][n][3] * oscale);
                        else
                          *reinterpret_cast<uint2*>(Cb + (long)row * ldc + col) =
                              make_uint2(pack2(acc[m][n][0] * oscale, acc[m][n][1] * oscale), pack2(acc[m][n][2] * oscale, acc[m][n][3] * oscale));
                      }
                    }
                  }
                };
      if (g.fp8) {
        const fp8_t* A8 = (const fp8_t*)g.A + (long)tm * 128 * K;
        gemm_tile8p<true>(A8, (const fp8_t*)g.Bt + (long)tn * 128 * K, ntile < ntiles, (const fp8_t*)g.A + (long)tm2 * 128 * K,
                          (const fp8_t*)g.Bt + (long)tn2 * 128 * K, par, primed, K, smem, epi2);
      } else {
        gemm_tile<true>([&](int r) { return Ab + (long)r * K; }, g.Bt + b * g.sB + (long)tn * 128 * K, K, smem, epi2);
      }
    }
    tile = ntile;
  }
}

template <class RowMap>
__device__ __forceinline__ void conv_tile_rm(const float* src, int lds_, int Nvalid, int k0, int n0, act_t* dst, int ldd, float* tile, RowMap rm) {
  const int tid = threadIdx.x;
  {
    const int r = tid >> 5, c4 = (tid & 31) * 4;
    float4 v[8];
#pragma unroll
    for (int rr = 0; rr < 8; ++rr) {
      v[rr] = make_float4(0.f, 0.f, 0.f, 0.f);
      if (n0 + c4 < Nvalid) v[rr] = *reinterpret_cast<const float4*>(src + (long)(k0 + r + rr * 8) * lds_ + n0 + c4);
    }
#pragma unroll
    for (int rr = 0; rr < 8; ++rr) {
      float* t = tile + (r + rr * 8) * 129 + c4;
      t[0] = v[rr].x; t[1] = v[rr].y; t[2] = v[rr].z; t[3] = v[rr].w;
    }
  }
  __syncthreads();
  {
    const int n = tid >> 1, ks = (tid & 1) * 32;
    if (n0 + n < Nvalid) {
      unsigned w[16];
#pragma unroll
      for (int i = 0; i < 16; ++i) w[i] = pack2(tile[(ks + 2 * i) * 129 + n], tile[(ks + 2 * i + 1) * 129 + n]);
      uint4* d = reinterpret_cast<uint4*>(dst + (long)rm(n) * ldd + k0 + ks);
      d[0] = make_uint4(w[0], w[1], w[2], w[3]);
      d[1] = make_uint4(w[4], w[5], w[6], w[7]);
      d[2] = make_uint4(w[8], w[9], w[10], w[11]);
      d[3] = make_uint4(w[12], w[13], w[14], w[15]);
    }
  }
  __syncthreads();
}

template <class RowMap>
__device__ __forceinline__ void conv_tile8_rm(const float* src, int lds_, int k0, int n0, fp8_t* dst, int ldd, float* tile, float scale, RowMap rm, int Nvalid = 1 << 30) {
  const int tid = threadIdx.x;
  {
    const int r = tid >> 5, c4 = (tid & 31) * 4;
    float4 v[8];
#pragma unroll
    for (int rr = 0; rr < 8; ++rr) {
      v[rr] = make_float4(0.f, 0.f, 0.f, 0.f);
      if (n0 + c4 < Nvalid) v[rr] = *reinterpret_cast<const float4*>(src + (long)(k0 + r + rr * 8) * lds_ + n0 + c4);
    }
#pragma unroll
    for (int rr = 0; rr < 8; ++rr) {
      float* t = tile + (r + rr * 8) * 129 + c4;
      t[0] = v[rr].x; t[1] = v[rr].y; t[2] = v[rr].z; t[3] = v[rr].w;
    }
  }
  __syncthreads();
  if ((threadIdx.x >> 1) + n0 < Nvalid) {
    const int n = tid >> 1, ks = (tid & 1) * 32;
    unsigned w[8];
#pragma unroll
    for (int i = 0; i < 8; ++i)
      w[i] = pack4_fp8(tile[(ks + 4 * i) * 129 + n] * scale, tile[(ks + 4 * i + 1) * 129 + n] * scale,
                       tile[(ks + 4 * i + 2) * 129 + n] * scale, tile[(ks + 4 * i + 3) * 129 + n] * scale);
    uint4* d = reinterpret_cast<uint4*>(dst + (long)rm(n) * ldd + k0 + ks);
    d[0] = make_uint4(w[0], w[1], w[2], w[3]);
    d[1] = make_uint4(w[4], w[5], w[6], w[7]);
  }
  __syncthreads();
}

__device__ __forceinline__ void conv_tile(const float* src, int lds_, int Nvalid, int k0, int n0, act_t* dst, int ldd, float* tile) {
  conv_tile_rm(src, lds_, Nvalid, k0, n0, dst, ldd, tile, [=](int n) { return n0 + n; });
}

struct ConvJob { const float* src; fp8_t* dst; int lds, ldd, k0, n0, rbase, ra, rb; };
__device__ __forceinline__ void phase_convert_experts(const Params& p, int l, unsigned char* smem, int blk, int nblk) {
  float* tile = (float*)smem;
  const int per_e = 192, total = NEXP * per_e;
  fp8_t* Wup = l == 0 ? p.W8up : p.W8up1;
  fp8_t* Wdn = l == 0 ? p.W8down : p.W8down1;
  const int tid = threadIdx.x;
  auto mkjob = [&](int job) -> ConvJob {
    const int e = job / per_e, j = job % per_e;
    ConvJob c;
    if (j < 128) {
      const int up = j >> 6, jj = j & 63;
      const int kt = jj >> 2, fp = jj & 3;
      c.src = (up ? p.w_eu : p.w_eg) + ((long)(l * NEXP + e) * D) * DFF;
      c.dst = Wup + (long)e * 1024 * D; c.lds = DFF; c.ldd = D; c.k0 = kt * 64; c.n0 = fp * 128;
      c.rbase = fp * 256 + up * 32; c.ra = 128; c.rb = 64;
    } else {
      const int jj = j - 128;
      const int kt = jj >> 3, nt = jj & 7;
      c.src = p.w_ed + ((long)(l * NEXP + e) * DFF) * D;
      c.dst = Wdn + (long)e * 1024 * DFF; c.lds = D; c.ldd = DFF; c.k0 = kt * 64; c.n0 = nt * 128;
      c.rbase = nt * 128; c.ra = 64; c.rb = 32;
    }
    return c;
  };
  float4 v[8];
  auto ld = [&](const ConvJob& c) {
    const int r = tid >> 5, c4 = (tid & 31) * 4;
#pragma unroll
    for (int rr = 0; rr < 8; ++rr) v[rr] = *reinterpret_cast<const float4*>(c.src + (long)(c.k0 + r + rr * 8) * c.lds + c.n0 + c4);
  };
  int job = blk;
  if (job >= total) return;
  ConvJob cur = mkjob(job);
  ld(cur);
  while (job < total) {
    {
      const int r = tid >> 5, c4 = (tid & 31) * 4;
#pragma unroll
      for (int rr = 0; rr < 8; ++rr) {
        float* t = tile + (r + rr * 8) * 129 + c4;
        t[0] = v[rr].x; t[1] = v[rr].y; t[2] = v[rr].z; t[3] = v[rr].w;
      }
    }
    __syncthreads();
    const int nxt = job + nblk;
    const ConvJob nj = mkjob(min(nxt, total - 1));
    ld(nj);
    {
      const int n = tid >> 1, ks = (tid & 1) * 32;
      unsigned w[8];
#pragma unroll
      for (int i = 0; i < 8; ++i)
        w[i] = pack4_fp8(tile[(ks + 4 * i) * 129 + n] * SW8, tile[(ks + 4 * i + 1) * 129 + n] * SW8,
                         tile[(ks + 4 * i + 2) * 129 + n] * SW8, tile[(ks + 4 * i + 3) * 129 + n] * SW8);
      const int row = cur.rbase + (n >> 6) * cur.ra + ((n >> 5) & 1) * cur.rb + (n & 31);
      uint4* d = reinterpret_cast<uint4*>(cur.dst + (long)row * cur.ldd + cur.k0 + ks);
      d[0] = make_uint4(w[0], w[1], w[2], w[3]);
      d[1] = make_uint4(w[4], w[5], w[6], w[7]);
    }
    __syncthreads();
    cur = nj;
    job = nxt;
  }
}

__device__ __forceinline__ void phase_moe(const Params& p, int l, bool down, unsigned char* smem) {
  const int* cntp = p.cnt + l * NEXP * 64;
  int total = 0;
  for (int e = 0; e < NEXP; ++e) total += ((cntp[e * 64] + 127) >> 7) * 8;
  for (int tile = blockIdx.x; tile < total; tile += gridDim.x) {
    int e = 0, tb = 0, rowoff = 0;
    for (; e < NEXP - 1; ++e) {
      const int c = cntp[e * 64];
      const int nt = ((c + 127) >> 7) * 8;
      if (tile < tb + nt) break;
      tb += nt; rowoff += c;
    }
    const int c = cntp[e * 64];
    const int lt = tile - tb, mt = lt >> 3, nt = lt & 7;
    const int rows_valid = min(128, c - mt * 128);
    const int* lst = p.list + (long)(l * NEXP + e) * NR + mt * 128;
    const long hrow0 = (long)rowoff + mt * 128;
    if (!down) {
      gemm_tile8<true>([&](int r) { return p.u8 + (long)(lst[min(r, rows_valid - 1)] >> 1) * D; },
                (l == 0 ? p.W8up : p.W8up1) + ((long)e * 1024 + nt * 128) * D, D, smem,
                [&](f32x4 (&acc)[4][4], int wr, int wc, int fr, int fq) {
                  constexpr float dq = 1.0f / (SU8 * SW8);
#pragma unroll
                  for (int m = 0; m < 4; ++m) {
                    const int row = wr * 64 + m * 16 + fr;
                    if (row < rows_valid) {
#pragma unroll
                      for (int n = 0; n < 2; ++n) {
                        float hv[4];
#pragma unroll
                        for (int j = 0; j < 4; ++j) {
                          const float g = acc[m][n][j] * dq, uu = acc[m][n + 2][j] * dq;
                          hv[j] = g / (1.0f + __expf(-g)) * uu * SH8;
                        }
                        *reinterpret_cast<unsigned*>(p.H8 + (hrow0 + row) * DFF + nt * 64 + wc * 32 + n * 16 + fq * 4) =
                            pack4_fp8(hv[0], hv[1], hv[2], hv[3]);
                      }
                    }
                  }
                });
    } else {
      const fp8_t* Ab = p.H8 + hrow0 * DFF;
      gemm_tile8<true>([&](int r) { return Ab + (long)r * DFF; }, (l == 0 ? p.W8down : p.W8down1) + ((long)e * 1024 + nt * 128) * DFF, DFF, smem,
                [&](f32x4 (&acc)[4][4], int wr, int wc, int fr, int fq) {
                  constexpr float dq = 1.0f / (SH8 * SW8);
#pragma unroll
                  for (int m = 0; m < 4; ++m) {
                    const int row = wr * 64 + m * 16 + fr;
                    if (row < rows_valid) {
                      const int ts = lst[row];
                      const float w = p.ew[ts] * dq;
#pragma unroll
                      for (int n = 0; n < 4; ++n)
                        *reinterpret_cast<uint2*>(p.Y + (long)ts * D + nt * 128 + wc * 64 + n * 16 + fq * 4) =
                            make_uint2(pack2(acc[m][n][0] * w, acc[m][n][1] * w), pack2(acc[m][n][2] * w, acc[m][n][3] * w));
                    }
                  }
                });
    }
  }
}

__device__ __forceinline__ void phase_convert_dense(const Params& p, unsigned char* smem) {
  float* tile = (float*)smem;
  const int J0 = 16 * 26, J1 = J0 + 128, J2 = J1 + 16 * 19, J3 = J2 + 128;
  const int nb = (int)gridDim.x, blk = (int)blockIdx.x;
  const bool modblk = blk < MOD_ITEMS && nb > MOD_ITEMS;
  if (nb <= MOD_ITEMS) { for (int it = blk; it < MOD_ITEMS; it += nb) mod_item(p, it, smem); }
  else if (modblk) mod_item(p, blk, smem);
  int job, jstep, jend = J3;
  if (nb <= MOD_ITEMS) { job = blk; jstep = nb; }
  else if (modblk) { job = blk; jstep = J3; }
  else { job = MOD_ITEMS + (blk - MOD_ITEMS); jstep = nb - MOD_ITEMS; }
  for (; job < jend; job += jstep) {
    if (job < J0) { int j = job; const int n0 = (j % 26) * 128; conv_tile8_rm(p.w_in_even, IN_EVEN, (j / 26) * 64, n0, p.W8in_even, D, tile, SW8, [=](int n) { return n0 + n; }); }
    else if (job < J1) { int j = job - J0; const int n0 = (j % 8) * 128; conv_tile8_rm(p.w_out_even, D, (j / 8) * 64, n0, p.W8out_even, D, tile, SW8, [=](int n) { return n0 + n; }); }
    else if (job < J2) { int j = job - J1; const int n0 = (j % 19) * 128; conv_tile8_rm(p.w_in_odd, IN_ODD, (j / 19) * 64, n0, p.W8in_odd, D, tile, SW8, [=](int n) { return n0 + n; }, O_FA); }
    else { int j = job - J2; const int n0 = (j % 8) * 128; conv_tile8_rm(p.w_out_odd, D, (j / 8) * 64, n0, p.W8out_odd, D, tile, SW8, [=](int n) { return n0 + n; }); }
  }
}

__device__ __forceinline__ void phase_fold_z(const Params& p, long gtid, long gstride, float* tab) {
  if (threadIdx.x < 64) {
    float sn, cs;
    sincospif((float)threadIdx.x * (1.0f / 32.0f), &sn, &cs);
    tab[threadIdx.x] = cs; tab[64 + threadIdx.x] = -sn;
  }
  __syncthreads();
  for (long i = gtid; i < (long)256 * D; i += gstride) {
    const int k = (int)(i % D), col = (int)(i / D);
    const int g = col >> 6, cp = col & 63;
    const float* wz = p.w_in_odd + (long)k * IN_ODD + O_Z + g * 64;
    float s0 = 0.f, s1 = 0.f;
    float4 wv[16];
#pragma unroll
    for (int q = 0; q < 16; ++q) wv[q] = reinterpret_cast<const float4*>(wz)[q];
#pragma unroll
    for (int q = 0; q < 16; ++q) {
      const int i0 = ((4 * q) * cp) & 63, i1 = ((4 * q + 1) * cp) & 63, i2 = ((4 * q + 2) * cp) & 63, i3 = ((4 * q + 3) * cp) & 63;
      s0 += wv[q].x * tab[i0] + wv[q].y * tab[i1] + wv[q].z * tab[i2] + wv[q].w * tab[i3];
      s1 += wv[q].x * tab[64 + i0] + wv[q].y * tab[64 + i1] + wv[q].z * tab[64 + i2] + wv[q].w * tab[64 + i3];
    }
    const unsigned q0 = pack4_fp8(s0 * SW8, s1 * SW8, 0.f, 0.f);
    p.W8in_odd[(long)(O_FA + col) * D + k] = (unsigned char)(q0 & 0xffu);
    p.W8in_odd[(long)(O_FA + 256 + col) * D + k] = (unsigned char)((q0 >> 8) & 0xffu);
  }
  for (long i = gtid; i < (long)(IN_ODD_PAD - O_END) * D; i += gstride) p.W8in_odd[(long)O_END * D + i] = 0;
}

__device__ __forceinline__ void phase_cmat(const Params& p, long gtid, long gstride) {
  for (long i = gtid; i < (long)T * T; i += gstride) {
    const int t = (int)(i % T), tp = (int)(i / T);
    float sn, cs;
    sincospif((float)((t * tp) & (T - 1)) * (2.0f / T), &sn, &cs);
    stA(p.Cmat + (long)tp * 2 * T + t, cs);
    stA(p.Cmat + (long)tp * 2 * T + T + t, sn);
  }
}

__device__ __forceinline__ void row_stats(const float4 (&v)[4], float& mu, float& rs) {
  float s = 0.f;
#pragma unroll
  for (int i = 0; i < 4; ++i) s += v[i].x + v[i].y + v[i].z + v[i].w;
  mu = wave_sum(s) * (1.0f / D);
  float q = 0.f;
#pragma unroll
  for (int i = 0; i < 4; ++i) {
    float a = v[i].x - mu, b = v[i].y - mu, c = v[i].z - mu, d = v[i].w - mu;
    q += a * a + b * b + c * c + d * d;
  }
  rs = 1.0f / sqrtf(wave_sum(q) * (1.0f / D) + LN_EPS);
}

__device__ __forceinline__ void phase_lnmod_first(const Params& p) {
  const int lane = threadIdx.x & 63;
  const int nw = (int)gridDim.x * 4, wi = (int)blockIdx.x * 4 + (int)(threadIdx.x >> 6);
  const int rpw = (NR + nw - 1) / nw;
  const long r0 = (long)wi * rpw, r1 = min((long)NR, r0 + rpw);
  float4 shv[4], scv[4];
  int cur_bb = -2;
  float4 hv[4];
  auto load_row = [&](long row) {
    const float4* h = reinterpret_cast<const float4*>(hrow_in(p, row));
#pragma unroll
    for (int i = 0; i < 4; ++i) hv[i] = h[i * 64 + lane];
  };
  if (r0 < r1) load_row(r0);
  for (long row = r0; row < r1; ++row) {
    const int bb = row < NC ? NB : (int)((row - NC) / T);
    if (bb != cur_bb) {
      cur_bb = bb;
      const float* md = p.mod + (long)bb * 6 * D;
#pragma unroll
      for (int i = 0; i < 4; ++i) {
        shv[i] = reinterpret_cast<const float4*>(md)[i * 64 + lane];
        scv[i] = reinterpret_cast<const float4*>(md + D)[i * 64 + lane];
      }
    }
    float4 v[4];
#pragma unroll
    for (int i = 0; i < 4; ++i) v[i] = hv[i];
    load_row(min(row + 1, r1 - 1));
    float mu, rs;
    row_stats(v, mu, rs);
#pragma unroll
    for (int i = 0; i < 4; ++i) {
      const float a = (v[i].x - mu) * rs * (1.f + scv[i].x) + shv[i].x, b = (v[i].y - mu) * rs * (1.f + scv[i].y) + shv[i].y;
      const float c = (v[i].z - mu) * rs * (1.f + scv[i].z) + shv[i].z, d = (v[i].w - mu) * rs * (1.f + scv[i].w) + shv[i].w;
      reinterpret_cast<unsigned*>(p.u8 + row * D)[i * 64 + lane] = pack4_fp8(a * SU8, b * SU8, c * SU8, d * SU8);
    }
  }
}

__device__ __forceinline__ act_t* hrow16(const Params& p, long row) {
  return row < NC ? reinterpret_cast<act_t*>(p.hc) + row * D
                  : reinterpret_cast<act_t*>(reinterpret_cast<char*>(p.out) + (row - NC) * (long)(4 * D) + 2 * D);
}
template <int R_UNUSED>
__device__ __forceinline__ void phase_resid_ln(const Params& p, int l, int sub, long row_lo, long row_hi, unsigned char* smem) {
  const int lane = threadIdx.x & 63;
  int* cntL = (int*)smem;
  int* nent = cntL + 16;
  int* entL = cntL + 32;
  float* wT = (float*)(smem + 4096);
  if (sub == 0) {
    if (threadIdx.x < 32) cntL[threadIdx.x] = 0;
    {
      float4 wr4[16];
#pragma unroll
      for (int j = 0; j < 4; ++j)
#pragma unroll
        for (int q = 0; q < 4; ++q) wr4[j * 4 + q] = reinterpret_cast<const float4*>(p.w_router + (long)(threadIdx.x + 256 * j) * NEXP)[q];
#pragma unroll
      for (int j = 0; j < 4; ++j)
#pragma unroll
        for (int q = 0; q < 4; ++q) {
          const int k = threadIdx.x + 256 * j;
          wT[(q * 4 + 0) * D + k] = wr4[j * 4 + q].x; wT[(q * 4 + 1) * D + k] = wr4[j * 4 + q].y;
          wT[(q * 4 + 2) * D + k] = wr4[j * 4 + q].z; wT[(q * 4 + 3) * D + k] = wr4[j * 4 + q].w;
        }
    }
    __syncthreads();
  }
  const bool last = (sub == 1 && l == 1);
  const int nw = (int)gridDim.x * 4, wi = (int)blockIdx.x * 4 + (int)(threadIdx.x >> 6);
  const int rpw = ((int)(row_hi - row_lo) + nw - 1) / nw;
  const long r0 = row_lo + (long)wi * rpw, r1 = min(row_hi, r0 + rpw);
  const float4* lgp = reinterpret_cast<const float4*>(p.ln_g + (l * 2 + sub) * D);
  const float4* lbp = reinterpret_cast<const float4*>(p.ln_b + (l * 2 + sub) * D);
  float4 lgv[4], lbv[4];
  if (R_UNUSED != 1) {
#pragma unroll
    for (int i = 0; i < 4; ++i) { lgv[i] = lgp[i * 64 + lane]; lbv[i] = lbp[i * 64 + lane]; }
  }
  float4 gv[4], shv[4], scv[4];
  int cur_bb = -2;
  const bool first = (l == 0 && sub == 0);
  float4 hv[4];
  uint2 hb[4];
  uint2 mv[4], m2v[4];
  auto load_row = [&](long row) {
    const uint2* m = reinterpret_cast<const uint2*>(sub == 0 ? p.M + row * D : p.Y + row * 2 * D);
    if (first) {
      const float4* hin = reinterpret_cast<const float4*>(hrow_in(p, row));
#pragma unroll
      for (int i = 0; i < 4; ++i) hv[i] = hin[i * 64 + lane];
    } else {
      const uint2* hin = reinterpret_cast<const uint2*>(hrow16(p, row));
#pragma unroll
      for (int i = 0; i < 4; ++i) hb[i] = hin[i * 64 + lane];
    }
#pragma unroll
    for (int i = 0; i < 4; ++i) {
      mv[i] = m[i * 64 + lane];
      if (sub == 1) m2v[i] = m[256 + i * 64 + lane];
    }
  };
  if (r0 < r1) load_row(r0);
  for (long row = r0; row < r1; ++row) {
    const int bb = row < NC ? NB : (int)((row - NC) / T);
    if (bb != cur_bb) {
      cur_bb = bb;
      const float* md = p.mod + ((long)l * (NB + 1) + bb) * 6 * D;
      const float* md2 = (sub == 0) ? md + 3 * D : p.mod + ((long)(NB + 1) + bb) * 6 * D;
#pragma unroll
      for (int i = 0; i < 4; ++i) {
        gv[i] = reinterpret_cast<const float4*>(md + (sub == 0 ? 2 : 5) * D)[i * 64 + lane];
        shv[i] = reinterpret_cast<const float4*>(md2)[i * 64 + lane];
        scv[i] = reinterpret_cast<const float4*>(md2 + D)[i * 64 + lane];
      }
    }
    float4 v[4];
#pragma unroll
    for (int i = 0; i < 4; ++i) {
      float m0 = bf_lo(mv[i].x), m1 = bf_hi(mv[i].x), m2_ = bf_lo(mv[i].y), m3 = bf_hi(mv[i].y);
      if (sub == 1) { m0 += bf_lo(m2v[i].x); m1 += bf_hi(m2v[i].x); m2_ += bf_lo(m2v[i].y); m3 += bf_hi(m2v[i].y); }
      const float h0 = first ? hv[i].x : bf_lo(hb[i].x), h1 = first ? hv[i].y : bf_hi(hb[i].x);
      const float h2 = first ? hv[i].z : bf_lo(hb[i].y), h3 = first ? hv[i].w : bf_hi(hb[i].y);
      v[i].x = ALPHA * h0 + gv[i].x * m0;
      v[i].y = ALPHA * h1 + gv[i].y * m1;
      v[i].z = ALPHA * h2 + gv[i].z * m2_;
      v[i].w = ALPHA * h3 + gv[i].w * m3;
    }
    load_row(min(row + 1, r1 - 1));
    if (R_UNUSED == 1) {
#pragma unroll
      for (int i = 0; i < 4; ++i) { lgv[i] = lgp[i * 64 + lane]; lbv[i] = lbp[i * 64 + lane]; }
    }
    float mu, rs;
    row_stats(v, mu, rs);
#pragma unroll
    for (int i = 0; i < 4; ++i) {
      v[i].x = (v[i].x - mu) * rs * lgv[i].x + lbv[i].x;
      v[i].y = (v[i].y - mu) * rs * lgv[i].y + lbv[i].y;
      v[i].z = (v[i].z - mu) * rs * lgv[i].z + lbv[i].z;
      v[i].w = (v[i].w - mu) * rs * lgv[i].w + lbv[i].w;
    }
    if (last) {
      float4* hout = reinterpret_cast<float4*>(p.out + (row - NC) * D);
#pragma unroll
      for (int i = 0; i < 4; ++i) hout[i * 64 + lane] = v[i];
      continue;
    }
    uint2 hq[4];
#pragma unroll
    for (int i = 0; i < 4; ++i) {
      hq[i] = make_uint2(pack2(v[i].x, v[i].y), pack2(v[i].z, v[i].w));
      v[i].x = bf_lo(hq[i].x); v[i].y = bf_hi(hq[i].x); v[i].z = bf_lo(hq[i].y); v[i].w = bf_hi(hq[i].y);
    }
    row_stats(v, mu, rs);
    float lo[NEXP];
#pragma unroll
    for (int e = 0; e < NEXP; ++e) lo[e] = 0.f;
    uint2 up[4];
#pragma unroll
    for (int i = 0; i < 4; ++i) {
      float uv[4];
      uv[0] = (v[i].x - mu) * rs * (1.f + scv[i].x) + shv[i].x;
      uv[1] = (v[i].y - mu) * rs * (1.f + scv[i].y) + shv[i].y;
      uv[2] = (v[i].z - mu) * rs * (1.f + scv[i].z) + shv[i].z;
      uv[3] = (v[i].w - mu) * rs * (1.f + scv[i].w) + shv[i].w;
      up[i] = make_uint2(pack4_fp8(uv[0] * SU8, uv[1] * SU8, uv[2] * SU8, uv[3] * SU8), 0u);
      if (sub == 0) {
#pragma unroll
        for (int e = 0; e < NEXP; ++e) {
          const float4 w4 = *reinterpret_cast<const float4*>(wT + e * D + (i * 64 + lane) * 4);
          lo[e] += uv[0] * w4.x + uv[1] * w4.y + uv[2] * w4.z + uv[3] * w4.w;
          if ((e & 3) == 3) __builtin_amdgcn_sched_barrier(0);
        }
      }
    }
    int ge1 = 0, ge2 = 0;
    float w1 = 0.f, w2 = 0.f;
    if (sub == 0) {
      float mine = 0.f;
#pragma unroll
      for (int e = 0; e < NEXP; ++e) {
        const float rsum = row_sum16(lo[e]);
        mine = ((lane & 15) == e) ? rsum : mine;
      }
      mine += __shfl_xor(mine, 16);
      mine += __shfl_xor(mine, 32);
#pragma unroll
      for (int e = 0; e < NEXP; ++e) lo[e] = __int_as_float(__builtin_amdgcn_readlane(__float_as_int(mine), e));
      float mx = lo[0];
#pragma unroll
      for (int e = 1; e < NEXP; ++e) mx = fmaxf(mx, lo[e]);
      float sum = 0.f;
#pragma unroll
      for (int e = 0; e < NEXP; ++e) { lo[e] = __expf(lo[e] - mx); sum += lo[e]; }
      const float inv = 1.0f / sum;
      float bestg = -1e30f, gp1 = 0.f, gp2 = 0.f;
#pragma unroll
      for (int gq = 0; gq < 4; ++gq) {
        float s1 = -1e30f, s2 = -1e30f, p1 = 0.f, p2 = 0.f;
        int e1 = 0, e2 = 0;
#pragma unroll
        for (int j = 0; j < 4; ++j) {
          const int e = gq * 4 + j;
          const float pe = lo[e] * inv;
          const float se = pe + p.b_router[e];
          if (se > s1) { s2 = s1; p2 = p1; e2 = e1; s1 = se; p1 = pe; e1 = e; }
          else if (se > s2) { s2 = se; p2 = pe; e2 = e; }
        }
        const float gs = s1 + s2;
        if (gs > bestg) { bestg = gs; ge1 = e1; ge2 = e2; gp1 = p1; gp2 = p2; }
      }
      const float wsum = gp1 + gp2;
      w1 = gp1 / wsum; w2 = gp2 / wsum;
    }
    {
      uint2* hout = reinterpret_cast<uint2*>(hrow16(p, row));
#pragma unroll
      for (int i = 0; i < 4; ++i) hout[i * 64 + lane] = hq[i];
    }
#pragma unroll
    for (int i = 0; i < 4; ++i) reinterpret_cast<unsigned*>(p.u8 + row * D)[i * 64 + lane] = up[i].x;
    if (sub == 0 && lane == 0) {
      p.ew[row * 2 + 0] = w1; p.ew[row * 2 + 1] = w2;
      const int lp1 = atomicAdd(cntL + ge1, 1), lp2 = atomicAdd(cntL + ge2, 1);
      const int ei = atomicAdd(nent, 2);
      entL[2 * ei] = ((int)(row * 2) << 4) | ge1; entL[2 * ei + 1] = lp1;
      entL[2 * ei + 2] = ((int)(row * 2 + 1) << 4) | ge2; entL[2 * ei + 3] = lp2;
    }
  }
  if (sub == 0) {
    __syncthreads();
    if (threadIdx.x < NEXP) {
      const int c = cntL[threadIdx.x];
      cntL[threadIdx.x] = c ? atomicAdd(p.cnt + (l * NEXP + threadIdx.x) * 64, c) : 0;
    }
    __syncthreads();
    const int ne = *nent;
    for (int i = threadIdx.x; i < ne; i += 256) {
      const int key = entL[2 * i], lp = entL[2 * i + 1];
      const int e = key & 15;
      p.list[(long)(l * NEXP + e) * NR + cntL[e] + lp] = key >> 4;
    }
    __syncthreads();
  }
}

#define LOOP(n) for (long i = gtid; i < (long)(n); i += gstride)

#ifdef ONLY_PHASE
#define PH(n, ...) if (ONLY_PHASE == n) { __VA_ARGS__ }
#define GSYNC()
#else
#define PH(n, ...) { __VA_ARGS__ }
#define GSYNC() xcd_barrier(xb)
#endif

__global__ void __launch_bounds__(256, 2) mega_kernel(Params p) {
  cg::grid_group grid = cg::this_grid();
  __shared__ __attribute__((aligned(16))) unsigned char smem[SMEM_BYTES + 16];
  if (threadIdx.x == 0) *reinterpret_cast<uint4*>(smem + SMEM_BYTES) = make_uint4(0u, 0u, 0u, 0u);
  __syncthreads();
  XcdBarrier xb = xcd_barrier_post(p.bar, (volatile LAS unsigned*)(smem + SMEM_BYTES));
  const long gtid = (long)blockIdx.x * blockDim.x + threadIdx.x;
  const long gstride = (long)gridDim.x * blockDim.x;
  const int nsb = min(256, (int)gridDim.x / 2);
  PH(0,
    if (gtid < 2 * NEXP) p.cnt[gtid * 64] = 0;
    phase_convert_dense(p, smem);
    phase_fold_z(p, gtid, gstride, (float*)(smem + 65536));
    LOOP(1024) ph_tables(p, i);)
#ifndef ONLY_PHASE
  if (p.use_cg_sync) grid.sync();
#endif
  GSYNC();
  PH(1, phase_lnmod_first(p);)
  GSYNC();
  PH(2, phase_gemm(p, GemmJob{(const act_t*)p.u8, (const act_t*)p.W8in_even, p.P, 0, 0, 0, 1, NR / 128, IN_EVEN / 128, D, PW, IN_EVEN, 2, 1.0f / (SU8 * SW8), 1, 0}, smem);)
  GSYNC();
  PH(3,
    if ((int)blockIdx.x < nsb) phase_scan<0>(p, smem, blockIdx.x, nsb);
    else phase_attn(p, smem, blockIdx.x - nsb, gridDim.x - nsb);)
  GSYNC();
  PH(4, phase_combine<0>(p);)
  GSYNC();
  PH(5,
    phase_gemm(p, GemmJob{(const act_t*)p.O8, (const act_t*)p.W8out_even, p.M, 0, 0, 0, 1, NR / 128, D / 128, D, D, D, 0, 1.0f / (SO8 * SW8), 1, 0}, smem);
    {
      const int rem = ((NR / 128) * (D / 128)) % (int)gridDim.x;
      if (rem > 0 && rem < (int)gridDim.x) { if ((int)blockIdx.x >= rem) phase_convert_experts(p, 0, smem, blockIdx.x - rem, gridDim.x - rem); }
      else phase_convert_experts(p, 0, smem, blockIdx.x, gridDim.x);
    })
  GSYNC();
  PH(6, phase_resid_ln<1>(p, 0, 0, 0, NR, smem);)
  GSYNC();
  PH(7, phase_moe(p, 0, false, smem);)
  GSYNC();
  PH(8, phase_moe(p, 0, true, smem);)
  GSYNC();
  PH(9, phase_resid_ln<2>(p, 0, 1, 0, NR, smem); phase_cmat(p, gtid, gstride);)
  GSYNC();
  PH(10, phase_gemm(p, GemmJob{(const act_t*)p.u8, (const act_t*)p.W8in_odd, p.P, 0, 0, 0, 1, NR / 128, IN_ODD_PAD / 128, D, PW, O_FA, 1, 1.0f / (SU8 * SW8), 1, 0}, smem);)
  GSYNC();
  PH(11, phase_gla_decay(p);)
  GSYNC();
  PH(12,
    if ((int)blockIdx.x < nsb) phase_scan<1>(p, smem, blockIdx.x, nsb);
    else {
      phase_gemm(p, GemmJob{p.Cmat, p.FT, (act_t*)(p.O8 + (long)NC * D + 768), 0, (long)256 * 2 * T, (long)T * D, NB, T / 128, 2, 2 * T, D,
                            256, 0, 0.00276213586400995f * SO8, 0, 1}, smem, blockIdx.x - nsb, gridDim.x - nsb);
      phase_convert_experts(p, 1, smem, blockIdx.x - nsb, gridDim.x - nsb);
    })
  GSYNC();
  PH(13, phase_combine<1>(p);)
  GSYNC();
  PH(14,
    phase_gemm(p, GemmJob{(const act_t*)(p.O8 + (long)NC * D), (const act_t*)p.W8out_odd, p.M + (long)NC * D, 0, 0, 0, 1, NT / 128, D / 128, D, D, D, 0, 1.0f / (SO8 * SW8), 1, 0}, smem);)
  GSYNC();
  PH(15, phase_resid_ln<1>(p, 1, 0, NC, NR, smem);)
  GSYNC();
  PH(16, phase_moe(p, 1, false, smem);)
  GSYNC();
  PH(17, phase_moe(p, 1, true, smem);)
  GSYNC();
  PH(18, phase_resid_ln<2>(p, 1, 1, NC, NR, smem);)
}

static size_t carve(Params& p, char* ws) {
  size_t off = 0;
  auto take = [&](size_t bytes) { char* r = ws + off; off += (bytes + 255) & ~(size_t)255; return r; };
  p.mod = (float*)take(sizeof(float) * 2 * (NB + 1) * 6 * D);
  p.bar = (unsigned*)take(sizeof(unsigned) * XCD_BAR_WORDS);
  p.hc = (float*)take(sizeof(float) * (size_t)NC * D);
  p.costab = (float*)take(sizeof(float) * T);
  p.sintab = (float*)take(sizeof(float) * T);
  p.lbt = (float*)take(sizeof(float) * 1024);
  p.ropetab = (float*)take(sizeof(float) * 64 * 16 * 2);
  p.ew = (float*)take(sizeof(float) * (size_t)NR * 2);
  p.eidx = nullptr;
  p.u = nullptr;
  p.O8 = (unsigned char*)take((size_t)NR * D);
  p.P = (act_t*)take(sizeof(act_t) * (size_t)NR * PW);
  p.OF = (act_t*)take(sizeof(act_t) * (size_t)NR * 768);
  p.OB = (act_t*)take(sizeof(act_t) * (size_t)NR * 768);
  p.M = p.OF;
  p.Cmat = (act_t*)take(sizeof(act_t) * (size_t)T * 2 * T);
  p.FT = (act_t*)take(sizeof(act_t) * (size_t)NB * 256 * 2 * T);
  p.LF = (act_t*)take(sizeof(act_t) * (size_t)2 * NR * 384);
  p.W8up = (unsigned char*)p.Cmat;
  p.W8down = p.W8up + (size_t)NEXP * 1024 * D;
  p.W8up1 = (unsigned char*)take((size_t)NEXP * 1024 * (D + DFF));
  p.W8down1 = p.W8up1 + (size_t)NEXP * 1024 * D;
  p.u8 = (unsigned char*)take((size_t)NR * D);
  p.Y = p.P;
  p.H8 = (unsigned char*)(p.P + (size_t)2 * NR * D);
  p.cnt = (int*)take(sizeof(int) * 2 * NEXP * 64);
  p.list = (int*)take(sizeof(int) * (size_t)2 * NEXP * NR);
  p.Wt_in_even = nullptr;
  p.W8in_even = (unsigned char*)take((size_t)IN_EVEN * D);
  p.Wt_out_even = nullptr;
  p.W8out_even = (unsigned char*)take((size_t)D * D);
  p.Wt_in_odd = nullptr;
  p.W8in_odd = (unsigned char*)take((size_t)IN_ODD_PAD * D);
  p.Wt_out_odd = nullptr;
  p.W8out_odd = (unsigned char*)take((size_t)D * D);
  return off;
}

static void fill_inputs(Params& p, void* const* d_in) {
  const float** f = (const float**)&p;
  for (int i = 0; i < 23; ++i) f[i] = (const float*)d_in[i];
}

extern "C" void kernel_launch(void* const* d_in, const int* in_sizes, int n_in, void* d_out, int out_size,
                              void* d_ws, size_t ws_size, hipStream_t stream) {
  static int grid_blocks = 0;
  if (!grid_blocks) {
    int dev = 0, cus = 0, per_cu = 0;
    (void)hipGetDevice(&dev);
    (void)hipDeviceGetAttribute(&cus, hipDeviceAttributeMultiprocessorCount, dev);
    (void)hipOccupancyMaxActiveBlocksPerMultiprocessor(&per_cu, mega_kernel, 256, 0);
    grid_blocks = cus * per_cu;
  }
  Params p{};
  fill_inputs(p, d_in);
  p.out = (float*)d_out;
  size_t need = carve(p, (char*)d_ws);
  if (need > ws_size) { fprintf(stderr, "workspace too small: need %zu have %zu\n", need, ws_size); return; }
  (void)hipMemsetAsync(p.mod, 0, (size_t)((char*)(p.bar + XCD_BAR_WORDS) - (char*)p.mod), stream);
  void* args[] = {&p};
  hipError_t e = hipLaunchCooperativeKernel((void*)mega_kernel, dim3(grid_blocks), dim3(256), args, 0, stream);
  if (e != hipSuccess) fprintf(stderr, "cooperative launch failed: %s (grid %d)\n", hipGetErrorString(e), grid_blocks);
}
#endif
```

```cpp
#ifndef HOST_TEST
#include <hip/hip_runtime.h>
#include <hip/hip_cooperative_groups.h>
#include <cstdio>
namespace cg = cooperative_groups;
#define DEV __device__ __forceinline__
#else
#include <cmath>
#include <cstdio>
#include <cstdlib>
#include <cstring>
#define DEV static inline
#endif

#ifndef T_BATCH
#define T_BATCH 8
#endif
#ifndef T_SEQ
#define T_SEQ 2048
#endif
#ifndef T_CTX
#define T_CTX 256
#endif

constexpr int D = 1024, NB = T_BATCH, T = T_SEQ, C = T_CTX;
constexpr int NC = NB * C, NT = NB * T, NR = NC + NT;
constexpr int GRID_W = 64;
constexpr int IN_EVEN = 3328, IN_ODD = 2592, PW = 3328;
constexpr int NEXP = 16, DFF = 512;
constexpr float ALPHA = 1.4142135623730951f;
constexpr float LN_EPS = 1e-5f;
constexpr int E_AQ = 0, E_AK = 512, E_AV = 640, E_FF = 768, E_HQ = 1792, E_HI = 2304, E_HG = 2816;
constexpr int O_Q = 0, O_K = 384, O_V = 768, O_RF = 1536, O_G = 1568, O_Z = 2336;

#ifdef HOST_TEST
typedef float act_t;
DEV float ldA(const act_t* p) { return *p; }
DEV void stA(act_t* p, float v) { *p = v; }
#else
typedef unsigned short act_t;
DEV float ldA(const act_t* p) { return __uint_as_float(((unsigned)*p) << 16); }
DEV void stA(act_t* p, float v) {
  unsigned u = __float_as_uint(v);
  u += 0x7fffu + ((u >> 16) & 1u);
  *p = (unsigned short)(u >> 16);
}
#endif

struct Params {
  const float *x, *c, *ctx, *c_ctx, *w_ada, *b_ada, *ln_g, *ln_b, *w_in_even, *attn_sink, *lb_logits, *hgrn_norm,
      *w_out_even, *w_in_odd, *gla_gate_w, *gla_gate_b, *gla_norm, *w_out_odd, *w_router, *b_router, *w_eg, *w_eu,
      *w_ed;
  float* out;
  float *mod, *hc, *costab, *sintab, *lbt, *ew, *ropetab;
  int* eidx;
  act_t *u, *P, *OF, *OB, *M, *LF;
  act_t *Wt_in_even, *Wt_out_even, *Wt_in_odd, *Wt_out_odd;
  act_t *Y, *Cmat, *FT;
  unsigned char *W8up, *W8down, *W8up1, *W8down1, *H8, *u8;
  unsigned char *W8in_even, *W8in_odd;
  unsigned char *W8out_even, *W8out_odd, *O8;
  int *cnt, *list;
  unsigned* bar;
  int use_cg_sync;
  int pad_;
};

DEV float sigmoidf_(float v) { return 1.0f / (1.0f + expf(-v)); }
DEV float siluf_(float v) { return v / (1.0f + expf(-v)); }

DEV const float* hrow_in(const Params& p, long row) {
  return row < NC ? p.ctx + row * D : p.x + (row - NC) * D;
}
DEV float* hrow(const Params& p, long row) { return row < NC ? p.hc + row * D : p.out + (row - NC) * D; }
DEV const float* modrow(const Params& p, int l, long row) {
  int bb = row < NC ? NB : (int)((row - NC) / T);
  return p.mod + ((long)l * (NB + 1) + bb) * 6 * D;
}

DEV void ph_mod(const Params& p, long i) {
  int j = (int)(i % (6 * D));
  int bb = (int)((i / (6 * D)) % (NB + 1));
  int l = (int)(i / ((long)6 * D * (NB + 1)));
  const float* cv = bb < NB ? p.c + (long)bb * D : p.c_ctx;
  const float* w = p.w_ada + (long)l * D * 6 * D + j;
  float s = p.b_ada[l * 6 * D + j];
  for (int k = 0; k < D; ++k) s += siluf_(cv[k]) * w[(long)k * 6 * D];
  p.mod[i] = s;
}

DEV void ph_tables(const Params& p, long i) {
  if (i < 1024) {
    int pos = (int)(i >> 4), idx = (int)(i & 15);
    float ang = (float)pos * powf(10000.0f, -(float)idx / 16.0f);
    p.ropetab[2 * i] = cosf(ang);
    p.ropetab[2 * i + 1] = sinf(ang);
  }
  if (i < 1024) {
    int dir = (int)(i / 512), col = (int)(i % 512);
    float l0 = p.lb_logits[(dir * 2 + 0) * 512 + col], l1 = p.lb_logits[(dir * 2 + 1) * 512 + col];
    p.lbt[i] = 1.0f / (1.0f + expf(l1 - l0));
  }
}

DEV void ln_mod_row(const float* h, const float* shift, const float* scale, act_t* u) {
  float mu = 0.f;
  for (int k = 0; k < D; ++k) mu += h[k];
  mu *= (1.0f / D);
  float var = 0.f;
  for (int k = 0; k < D; ++k) { float d = h[k] - mu; var += d * d; }
  var *= (1.0f / D);
  float rs = 1.0f / sqrtf(var + LN_EPS);
  for (int k = 0; k < D; ++k) stA(u + k, (h[k] - mu) * rs * (1.0f + scale[k]) + shift[k]);
}

DEV void ph_lnmod_first(const Params& p, long row) {
  const float* m = modrow(p, 0, row);
  ln_mod_row(hrow_in(p, row), m, m + D, p.u + row * D);
}

DEV void gemm_item_act(const act_t* A, const float* W, act_t* Cout, int K, int N, int ldc, long i) {
  int n4 = (int)(i % (N / 4));
  long row = i / (N / 4);
  const act_t* a = A + row * K;
  const float* w = W + n4 * 4;
  float s0 = 0, s1 = 0, s2 = 0, s3 = 0;
  for (int k = 0; k < K; ++k) {
    float av = ldA(a + k);
    const float* wr = w + (long)k * N;
    s0 += av * wr[0]; s1 += av * wr[1]; s2 += av * wr[2]; s3 += av * wr[3];
  }
  act_t* o = Cout + row * ldc + n4 * 4;
  stA(o, s0); stA(o + 1, s1); stA(o + 2, s2); stA(o + 3, s3);
}

DEV void ph_rope(const Params& p, long i) {
  int pr = (int)(i % 32);
  int hh = (int)((i / 32) % 10);
  long lr = i / 320;
  int t = (int)(lr % T);
  int col = hh < 8 ? E_AQ + hh * 64 : E_AK + (hh - 8) * 64;
  int idx = pr & 15;
  int pos = pr < 16 ? t / GRID_W : t % GRID_W;
  int d0 = pr < 16 ? idx : 32 + idx;
  float inv = powf(10000.0f, -(float)idx / 16.0f);
  float ang = (float)pos * inv;
  float cs = cosf(ang), sn = sinf(ang);
  act_t* base = p.P + (NC + lr) * PW + col;
  float x1 = ldA(base + d0), x2 = ldA(base + d0 + 16);
  stA(base + d0, x1 * cs - x2 * sn);
  stA(base + d0 + 16, x1 * sn + x2 * cs);
}

DEV void ph_attn(const Params& p, long i) {
  int h = (int)(i % 8);
  long row = i / 8;
  int kv = h / 4;
  bool lat = row >= NC;
  int b = lat ? (int)((row - NC) / T) : (int)(row / C);
  int t = lat ? (int)((row - NC) % T) : 0;
  float q[64], acc[64];
  const act_t* qp = p.P + row * PW + E_AQ + h * 64;
#pragma unroll
  for (int d = 0; d < 64; ++d) { q[d] = ldA(qp + d) * 0.125f; acc[d] = 0.f; }
  float m = p.attn_sink[h], l = 1.0f;
  int nkeys = C + (lat ? 257 : 0);
  for (int j = 0; j < nkeys; ++j) {
    long krow;
    if (j < C) krow = (long)b * C + j;
    else {
      int kp = t - 128 + (j - C);
      if (kp < 0 || kp >= T) continue;
      krow = NC + (long)b * T + kp;
    }
    const act_t* kptr = p.P + krow * PW + E_AK + kv * 64;
    const act_t* vptr = p.P + krow * PW + E_AV + kv * 64;
    float s = 0.f;
#pragma unroll
    for (int d = 0; d < 64; ++d) s += q[d] * ldA(kptr + d);
    float mn = fmaxf(m, s);
    float sc = expf(m - mn), pj = expf(s - mn);
    l = l * sc + pj;
#pragma unroll
    for (int d = 0; d < 64; ++d) acc[d] = acc[d] * sc + pj * ldA(vptr + d);
    m = mn;
  }
  float il = 1.0f / l;
  act_t* o = p.u + row * D + h * 64;
#pragma unroll
  for (int d = 0; d < 64; ++d) stA(o + d, acc[d] * il);
}

template <int MODE>
DEV void ph_scan(const Params& p, long i) {
  constexpr int DK = MODE == 0 ? 128 : 96;
  constexpr int DV = MODE == 0 ? 128 : 192;
  int e = (int)(i % DV);
  int dir = (int)((i / DV) % 2);
  int h = (int)((i / (2 * DV)) % 4);
  int b = (int)(i / (8 * DV));
  float S[DK];
#pragma unroll
  for (int d = 0; d < DK; ++d) S[d] = 0.f;
  act_t* OD = dir == 0 ? p.OF : p.OB;
  for (int step = 0; step < C + T; ++step) {
    long row;
    if (step < C) row = (long)b * C + (dir == 0 ? step : C - 1 - step);
    else { int tt = step - C; row = NC + (long)b * T + (dir == 0 ? tt : T - 1 - tt); }
    const act_t* pr = p.P + row * PW;
    float o = 0.f;
    if (MODE == 0) {
      float v = ldA(pr + E_HI + h * 128 + e);
      const act_t* zp = pr + E_FF + dir * 512 + h * 128;
      const act_t* qp = pr + E_HQ + h * 128;
      const float* lb = p.lbt + dir * 512 + h * 128;
#pragma unroll
      for (int d = 0; d < DK; ++d) {
        float f = lb[d] + (1.0f - lb[d]) * sigmoidf_(ldA(zp + d));
        S[d] = f * S[d] + (1.0f - f) * v;
        o += ldA(qp + d) * S[d];
      }
      stA(OD + row * 768 + h * 128 + e, o);
    } else {
      float v = ldA(pr + O_V + h * 192 + e);
      const act_t* kp = pr + O_K + h * 96;
      const act_t* qp = pr + O_Q + h * 96;
      const act_t* lf = p.LF + ((long)dir * NR + row) * 384 + h * 96;
#pragma unroll
      for (int d = 0; d < DK; ++d) {
        float f = expf(ldA(lf + d));
        S[d] = f * S[d] + ldA(kp + d) * v;
        o += ldA(qp + d) * S[d];
      }
      stA(OD + row * 768 + h * 192 + e, o * 0.10206207261596575f);
    }
  }
}

template <int MODE>
DEV void ph_combine(const Params& p, long i) {
  constexpr int DV = MODE == 0 ? 128 : 192;
  int h = (int)(i % 4);
  long row = (MODE == 0) ? i / 4 : NC + i / 4;
  const act_t* f = p.OF + row * 768 + h * DV;
  const act_t* bk = p.OB + row * 768 + h * DV;
  float ss = 0.f;
  for (int e = 0; e < DV; ++e) { float o = ldA(f + e) + ldA(bk + e); ss += o * o; }
  float r = 1.0f / sqrtf(ss / DV + LN_EPS);
  const float* gn = (MODE == 0 ? p.hgrn_norm : p.gla_norm) + h * DV;
  const act_t* g = p.P + row * PW + (MODE == 0 ? E_HG : O_G) + h * DV;
  act_t* o = p.u + row * D + (MODE == 0 ? 512 : 0) + h * DV;
  for (int e = 0; e < DV; ++e) stA(o + e, (ldA(f + e) + ldA(bk + e)) * r * gn[e] * siluf_(ldA(g + e)));
}

DEV void ph_gla_decay(const Params& p, long i) {
  int col = (int)(i % 384);
  long row = (i / 384) % NR;
  int dir = (int)(i / ((long)384 * NR));
  const act_t* r = p.P + row * PW + O_RF + dir * 16;
  const float* gw = p.gla_gate_w + (long)dir * 16 * 384 + col;
  float z = p.gla_gate_b[dir * 384 + col];
  for (int k = 0; k < 16; ++k) z += ldA(r + k) * gw[k * 384];
  float ls = fminf(z, 0.f) - log1pf(expf(-fabsf(z)));
  stA(p.LF + ((long)dir * NR + row) * 384 + col, ls * (1.0f / 16.0f));
}

DEV void ph_resid_ln(const Params& p, long row, int l, int sub) {
  const float* hin = (l == 0 && sub == 0) ? hrow_in(p, row) : hrow(p, row);
  float* hout = hrow(p, row);
  const float* md = modrow(p, l, row);
  const float* g = md + (sub == 0 ? 2 : 5) * D;
  const act_t* m = p.M + row * D;
  const float* lg = p.ln_g + (l * 2 + sub) * D;
  const float* lb = p.ln_b + (l * 2 + sub) * D;
  float mu = 0.f;
  for (int k = 0; k < D; ++k) mu += ALPHA * hin[k] + g[k] * ldA(m + k);
  mu *= (1.0f / D);
  float var = 0.f;
  for (int k = 0; k < D; ++k) { float d = ALPHA * hin[k] + g[k] * ldA(m + k) - mu; var += d * d; }
  var *= (1.0f / D);
  float rs = 1.0f / sqrtf(var + LN_EPS);
  for (int k = 0; k < D; ++k) hout[k] = (ALPHA * hin[k] + g[k] * ldA(m + k) - mu) * rs * lg[k] + lb[k];
  if (sub == 1 && l == 1) return;
  const float* md2 = (sub == 0) ? md + 3 * D : modrow(p, 1, row);
  float mu2 = 0.f;
  for (int k = 0; k < D; ++k) mu2 += hout[k];
  mu2 *= (1.0f / D);
  float var2 = 0.f;
  for (int k = 0; k < D; ++k) { float d = hout[k] - mu2; var2 += d * d; }
  var2 *= (1.0f / D);
  float rs2 = 1.0f / sqrtf(var2 + LN_EPS);
  float lo[NEXP];
#pragma unroll
  for (int e = 0; e < NEXP; ++e) lo[e] = 0.f;
  for (int k = 0; k < D; ++k) {
    float uv = (hout[k] - mu2) * rs2 * (1.0f + md2[D + k]) + md2[k];
    stA(p.u + row * D + k, uv);
    if (sub == 0) {
      const float* wr = p.w_router + k * NEXP;
#pragma unroll
      for (int e = 0; e < NEXP; ++e) lo[e] += uv * wr[e];
    }
  }
  if (sub != 0) return;
  float mx = lo[0];
#pragma unroll
  for (int e = 1; e < NEXP; ++e) mx = fmaxf(mx, lo[e]);
  float sum = 0.f;
#pragma unroll
  for (int e = 0; e < NEXP; ++e) { lo[e] = expf(lo[e] - mx); sum += lo[e]; }
  float inv = 1.0f / sum;
  float bestg = -1e30f; int bg = 0;
  float gi1 = 0, gi2 = 0; int ge1 = 0, ge2 = 0;
  float gp1 = 0, gp2 = 0;
#pragma unroll
  for (int gq = 0; gq < 4; ++gq) {
    float s1 = -1e30f, s2 = -1e30f, p1 = 0, p2 = 0; int e1 = 0, e2 = 0;
#pragma unroll
    for (int j = 0; j < 4; ++j) {
      int e = gq * 4 + j;
      float pe = lo[e] * inv;
      float se = pe + p.b_router[e];
      if (se > s1) { s2 = s1; p2 = p1; e2 = e1; s1 = se; p1 = pe; e1 = e; }
      else if (se > s2) { s2 = se; p2 = pe; e2 = e; }
    }
    float gs = s1 + s2;
    if (gs > bestg) { bestg = gs; bg = gq; gi1 = s1; gi2 = s2; ge1 = e1; ge2 = e2; gp1 = p1; gp2 = p2; }
  }
  (void)bg; (void)gi1; (void)gi2;
  float wsum = gp1 + gp2;
  p.eidx[row * 2 + 0] = ge1; p.eidx[row * 2 + 1] = ge2;
  p.ew[row * 2 + 0] = gp1 / wsum; p.ew[row * 2 + 1] = gp2 / wsum;
}

DEV void ph_moe_up(const Params& p, long i, int l, long row0) {
  int f4 = (int)(i % (DFF / 4));
  int slot = (int)((i / (DFF / 4)) % 2);
  long row = row0 + i / (DFF / 2);
  int e = p.eidx[row * 2 + slot];
  const float* w1 = p.w_eg + ((long)(l * NEXP + e) * D) * DFF + f4 * 4;
  const float* w3 = p.w_eu + ((long)(l * NEXP + e) * D) * DFF + f4 * 4;
  const act_t* a = p.u + row * D;
  float g0 = 0, g1 = 0, g2 = 0, g3 = 0, u0 = 0, u1 = 0, u2 = 0, u3 = 0;
  for (int k = 0; k < D; ++k) {
    float av = ldA(a + k);
    const float* r1 = w1 + (long)k * DFF;
    const float* r3 = w3 + (long)k * DFF;
    g0 += av * r1[0]; g1 += av * r1[1]; g2 += av * r1[2]; g3 += av * r1[3];
    u0 += av * r3[0]; u1 += av * r3[1]; u2 += av * r3[2]; u3 += av * r3[3];
  }
  act_t* hb = p.P + (row * 2 + slot) * DFF + f4 * 4;
  stA(hb, siluf_(g0) * u0); stA(hb + 1, siluf_(g1) * u1); stA(hb + 2, siluf_(g2) * u2); stA(hb + 3, siluf_(g3) * u3);
}

DEV void ph_moe_down(const Params& p, long i, int l, long row0) {
  int j4 = (int)(i % (D / 4));
  long row = row0 + i / (D / 4);
  float y0 = 0, y1 = 0, y2 = 0, y3 = 0;
  for (int slot = 0; slot < 2; ++slot) {
    int e = p.eidx[row * 2 + slot];
    float wgt = p.ew[row * 2 + slot];
    const float* w2 = p.w_ed + ((long)(l * NEXP + e) * DFF) * D + j4 * 4;
    const act_t* hb = p.P + (row * 2 + slot) * DFF;
    float s0 = 0, s1 = 0, s2 = 0, s3 = 0;
    for (int f = 0; f < DFF; ++f) {
      float hv = ldA(hb + f);
      const float* r = w2 + (long)f * D;
      s0 += hv * r[0]; s1 += hv * r[1]; s2 += hv * r[2]; s3 += hv * r[3];
    }
    y0 += wgt * s0; y1 += wgt * s1; y2 += wgt * s2; y3 += wgt * s3;
  }
  act_t* o = p.M + row * D + j4 * 4;
  stA(o, y0); stA(o + 1, y1); stA(o + 2, y2); stA(o + 3, y3);
}


#ifndef HOST_TEST
typedef __attribute__((ext_vector_type(8))) short bf16x8;
typedef __attribute__((ext_vector_type(4))) float f32x4;
constexpr int SMEM_BYTES = 71680;
constexpr int IN_ODD_PAD = 2944;
constexpr int O_FA = 2336, O_FB = 2592, O_END = 2848;

typedef float f32x2_t __attribute__((ext_vector_type(2)));
typedef __bf16 bf16x2_t __attribute__((ext_vector_type(2)));
__device__ __forceinline__ unsigned pack2(float a, float b) {
  const f32x2_t v = {a, b};
  return __builtin_bit_cast(unsigned, __builtin_convertvector(v, bf16x2_t));
}
__device__ __forceinline__ unsigned pack2_mfma(float a, float b) { return pack2(a, b); }
typedef __attribute__((ext_vector_type(2))) unsigned u32x2;
__device__ __forceinline__ float xor16_max(float x) {
  const u32x2 r = __builtin_amdgcn_permlane16_swap(__float_as_uint(x), __float_as_uint(x), false, false);
  return fmaxf(__uint_as_float(r.x), __uint_as_float(r.y));
}
__device__ __forceinline__ float xor32_max(float x) {
  const u32x2 r = __builtin_amdgcn_permlane32_swap(__float_as_uint(x), __float_as_uint(x), false, false);
  return fmaxf(__uint_as_float(r.x), __uint_as_float(r.y));
}
__device__ __forceinline__ float xor16_add(float x) {
  const u32x2 r = __builtin_amdgcn_permlane16_swap(__float_as_uint(x), __float_as_uint(x), false, false);
  return __uint_as_float(r.x) + __uint_as_float(r.y);
}
__device__ __forceinline__ float xor32_add(float x) {
  const u32x2 r = __builtin_amdgcn_permlane32_swap(__float_as_uint(x), __float_as_uint(x), false, false);
  return __uint_as_float(r.x) + __uint_as_float(r.y);
}
__device__ __forceinline__ float bf_lo(unsigned u) { return __uint_as_float(u << 16); }
__device__ __forceinline__ float bf_hi(unsigned u) { return __uint_as_float(u & 0xffff0000u); }
template <int CTRL>
__device__ __forceinline__ float dpp_mov(float v) {
  return __int_as_float(__builtin_amdgcn_update_dpp(0, __float_as_int(v), CTRL, 0xf, 0xf, true));
}
__device__ __forceinline__ float row_sum16(float v) {
  v += dpp_mov<0xB1>(v);
  v += dpp_mov<0x4E>(v);
  v += dpp_mov<0x141>(v);
  v += dpp_mov<0x140>(v);
  return v;
}
__device__ __forceinline__ float wave_sum(float v) {
  v = row_sum16(v);
  const float a = __int_as_float(__builtin_amdgcn_readlane(__float_as_int(v), 0));
  const float b = __int_as_float(__builtin_amdgcn_readlane(__float_as_int(v), 16));
  const float c = __int_as_float(__builtin_amdgcn_readlane(__float_as_int(v), 32));
  const float d = __int_as_float(__builtin_amdgcn_readlane(__float_as_int(v), 48));
  return (a + b) + (c + d);
}


#define XB_TMO      128
#define XB_XCNT(j)  (256  + 64 * (j))
#define XB_XSUB(j)  (1280 + 64 * (j))
#define XB_XGEN(j)  (2304 + 64 * (j))
#define XB_TOP      3328
#define XB_TOPGEN   3392
#define XCD_BAR_WORDS 3456
#define XB_SPIN_CAP (1u << 18)
#define LAS __attribute__((address_space(3)))
__device__ __forceinline__ unsigned xb_ld(unsigned* p)              { return __hip_atomic_load(p, __ATOMIC_RELAXED, __HIP_MEMORY_SCOPE_AGENT); }
__device__ __forceinline__ unsigned xb_add(unsigned* p, unsigned v) { return __hip_atomic_fetch_add(p, v, __ATOMIC_RELAXED, __HIP_MEMORY_SCOPE_AGENT); }
__device__ __forceinline__ unsigned xb_xcc_id() { return (unsigned)__builtin_amdgcn_s_getreg((3 << 11) | 20) & 0xFu; }
#define XB_SPIN(cond, bar) do { unsigned _sp = 0; while (cond) { __builtin_amdgcn_s_sleep(1); \
    if ((++_sp & 255u) == 0u) { if (xb_ld(&(bar)[XB_TMO])) break; if (_sp > XB_SPIN_CAP) { atomicAdd(&(bar)[XB_TMO], 1u); break; } } } } while (0)
struct XcdBarrier { unsigned* bar; unsigned x; volatile LAS unsigned* st; };
__device__ __forceinline__ XcdBarrier xcd_barrier_post(unsigned* bar, volatile LAS unsigned* st) {
    XcdBarrier b; b.bar = bar; b.x = xb_xcc_id(); b.st = st;
    if (threadIdx.x == 0) (void)xb_add(&bar[XB_XCNT(b.x)], 1u);
    return b;
}
__device__ __forceinline__ void xcd_barrier_complete(unsigned* bar, unsigned x, unsigned& nloc, unsigned& nx) {
    const unsigned G = gridDim.x * gridDim.y * gridDim.z;
    unsigned sum, cnt, mine, sp = 0u;
    for (;;) {
        sum = 0u; cnt = 0u; mine = 0u;
#pragma unroll
        for (unsigned j = 0; j < 16; ++j) { const unsigned c = xb_ld(&bar[XB_XCNT(j)]); sum += c; cnt += (c > 0u) ? 1u : 0u; mine = (j == x) ? c : mine; }
        if (sum == G) break;
        __builtin_amdgcn_s_sleep(1);
        if ((++sp & 255u) == 0u) { if (xb_ld(&bar[XB_TMO])) break; if (sp > XB_SPIN_CAP) { atomicAdd(&bar[XB_TMO], 1u); break; } }
    }
    nloc = mine > 0u ? mine : 1u; nx = cnt > 0u ? cnt : 1u;
}
__device__ __forceinline__ void xcd_barrier(const XcdBarrier& b) {
    asm volatile("s_waitcnt vmcnt(0)" ::: "memory");
    __syncthreads();
    if (threadIdx.x == 0) {
        unsigned* bar = b.bar;
        __builtin_amdgcn_s_waitcnt(0);
        unsigned nloc = b.st[0], nx = b.st[1];
        if (nloc == 0u) { xcd_barrier_complete(bar, b.x, nloc, nx); b.st[0] = nloc; b.st[1] = nx; }
        const unsigned old = xb_add(&bar[XB_XSUB(b.x)], 1u);
        const unsigned gen = old / nloc;
        if (old + 1u == (gen + 1u) * nloc) {
            __builtin_amdgcn_fence(__ATOMIC_RELEASE, "agent");
            asm volatile("s_waitcnt vmcnt(0)" ::: "memory");
            const unsigned og = xb_add(&bar[XB_TOP], 1u);
            const unsigned tg = og / nx;
            if (og + 1u == (tg + 1u) * nx) xb_add(&bar[XB_TOPGEN], 1u);
            else XB_SPIN(xb_ld(&bar[XB_TOPGEN]) == tg, bar);
            __builtin_amdgcn_fence(__ATOMIC_ACQUIRE, "agent");
            xb_add(&bar[XB_XGEN(b.x)], 1u);
            asm volatile("s_waitcnt vmcnt(0)" ::: "memory");
        } else {
            XB_SPIN(xb_ld(&bar[XB_XGEN(b.x)]) == gen, bar);
            __builtin_amdgcn_fence(__ATOMIC_ACQUIRE, "agent");
            asm volatile("s_waitcnt vmcnt(0)" ::: "memory");
        }
    }
    __syncthreads();
}

#define RAW_BARRIER() do { asm volatile("s_waitcnt lgkmcnt(0)" ::: "memory"); __builtin_amdgcn_s_barrier(); } while (0)
template <bool SWAP, class ARow, class Epi>
__device__ __forceinline__ void gemm_tile(ARow arow, const act_t* Bt, int K, unsigned char* smem, Epi epi) {
  const int tid = threadIdx.x, wid = tid >> 6, lane = tid & 63, wr = wid >> 1, wc = wid & 1, fr = lane & 15,
            fq = lane >> 4;
  const int r0 = tid >> 3, pc = tid & 7;
  const int lc = pc ^ ((tid >> 4) & 7);
  const act_t* ga[4];
#pragma unroll
  for (int i = 0; i < 4; ++i) ga[i] = arow(r0 + 32 * i) + lc * 8;
  const act_t* gb0 = Bt + (long)r0 * K + lc * 8;
  const long gbs = (long)32 * K;
  const int sw = (fr >> 1) & 7;
  const int rd0 = fr * 128 + ((fq ^ sw) << 4), rd1 = fr * 128 + (((4 + fq) ^ sw) << 4);
  char* S = (char*)smem;
  const int nk = K >> 6;
  f32x4 acc[4][4];
#pragma unroll
  for (int m = 0; m < 4; ++m)
#pragma unroll
    for (int n = 0; n < 4; ++n) acc[m][n] = f32x4{0.f, 0.f, 0.f, 0.f};
  auto issue = [&](int kt) {
    char* st = S + (kt & 1) * 32768 + tid * 16;
#pragma unroll
    for (int i = 0; i < 4; ++i) {
      __builtin_amdgcn_global_load_lds((const unsigned*)(ga[i] + kt * 64), (unsigned*)(st + i * 4096), 16, 0, 0);
      __builtin_amdgcn_global_load_lds((const unsigned*)(gb0 + i * gbs + kt * 64), (unsigned*)(st + 16384 + i * 4096), 16, 0, 0);
    }
  };
  RAW_BARRIER();
  issue(0);
  for (int kt = 0; kt < nk; ++kt) {
    asm volatile("s_waitcnt vmcnt(0)" ::: "memory");
    RAW_BARRIER();
    if (kt + 1 < nk) issue(kt + 1);
    const char* st = S + (kt & 1) * 32768;
#pragma unroll
    for (int ks = 0; ks < 2; ++ks) {
      const int rd = ks ? rd1 : rd0;
      bf16x8 af[4], bfr[4];
#pragma unroll
      for (int m = 0; m < 4; ++m) {
        af[m] = *reinterpret_cast<const bf16x8*>(st + (wr * 64 + m * 16) * 128 + rd);
        bfr[m] = *reinterpret_cast<const bf16x8*>(st + 16384 + (wc * 64 + m * 16) * 128 + rd);
      }
#pragma unroll
      for (int m = 0; m < 4; ++m)
#pragma unroll
        for (int n = 0; n < 4; ++n)
          acc[m][n] = SWAP ? __builtin_amdgcn_mfma_f32_16x16x32_bf16(bfr[n], af[m], acc[m][n], 0, 0, 0)
                           : __builtin_amdgcn_mfma_f32_16x16x32_bf16(af[m], bfr[n], acc[m][n], 0, 0, 0);
    }
  }
  epi(acc, wr, wc, fr, fq);
}


constexpr float SU8 = 16.0f, SW8 = 64.0f, SH8 = 8.0f, SO8 = 8.0f;
typedef unsigned char fp8_t;
typedef __attribute__((ext_vector_type(8))) int i32x8;
typedef __attribute__((ext_vector_type(4))) int i32x4;
__device__ __forceinline__ unsigned pack4_fp8(float a, float b, float c, float d) {
  a = fminf(fmaxf(a, -448.f), 448.f); b = fminf(fmaxf(b, -448.f), 448.f);
  c = fminf(fmaxf(c, -448.f), 448.f); d = fminf(fmaxf(d, -448.f), 448.f);
  unsigned w = 0;
  w = __builtin_amdgcn_cvt_pk_fp8_f32(a, b, w, false);
  w = __builtin_amdgcn_cvt_pk_fp8_f32(c, d, w, true);
  return w;
}

template <bool SWAP, class ARow, class Epi>
__device__ __forceinline__ void gemm_tile8(ARow arow, const fp8_t* Bt, int Kb, unsigned char* smem, Epi epi) {
  const int tid = threadIdx.x, wid = tid >> 6, lane = tid & 63, wr = wid >> 1, wc = wid & 1, fr = lane & 15,
            fq = lane >> 4;
  const int r0 = tid >> 3, pc = tid & 7;
  const int lc = pc ^ ((tid >> 4) & 7);
  const fp8_t* ga[4];
#pragma unroll
  for (int i = 0; i < 4; ++i) ga[i] = arow(r0 + 32 * i) + lc * 16;
  const fp8_t* gb0 = Bt + (long)r0 * Kb + lc * 16;
  const long gbs = (long)32 * Kb;
  const int sw = (fr >> 1) & 7;
  const int rd0 = fr * 128 + ((fq ^ sw) << 4), rd1 = fr * 128 + (((4 + fq) ^ sw) << 4);
  char* S = (char*)smem;
  const int nk = Kb >> 7;
  f32x4 acc[4][4];
#pragma unroll
  for (int m = 0; m < 4; ++m)
#pragma unroll
    for (int n = 0; n < 4; ++n) acc[m][n] = f32x4{0.f, 0.f, 0.f, 0.f};
  auto issue = [&](int kt) {
    char* st = S + (kt & 1) * 32768 + tid * 16;
#pragma unroll
    for (int i = 0; i < 4; ++i) {
      __builtin_amdgcn_global_load_lds((const unsigned*)(ga[i] + kt * 128), (unsigned*)(st + i * 4096), 16, 0, 0);
      __builtin_amdgcn_global_load_lds((const unsigned*)(gb0 + i * gbs + kt * 128), (unsigned*)(st + 16384 + i * 4096), 16, 0, 0);
    }
  };
  RAW_BARRIER();
  issue(0);
  if (nk > 1) issue(1);
#pragma unroll 1
  for (int kt = 0; kt < nk; ++kt) {
    if (kt + 1 < nk) asm volatile("s_waitcnt vmcnt(8)" ::: "memory");
    else asm volatile("s_waitcnt vmcnt(0)" ::: "memory");
    RAW_BARRIER();
    const char* st = S + (kt & 1) * 32768;
    i32x8 af[4], bfr[4];
#pragma unroll
    for (int m = 0; m < 4; ++m) {
      const i32x4 a0 = *reinterpret_cast<const i32x4*>(st + (wr * 64 + m * 16) * 128 + rd0);
      const i32x4 a1 = *reinterpret_cast<const i32x4*>(st + (wr * 64 + m * 16) * 128 + rd1);
      const i32x4 b0 = *reinterpret_cast<const i32x4*>(st + 16384 + (wc * 64 + m * 16) * 128 + rd0);
      const i32x4 b1 = *reinterpret_cast<const i32x4*>(st + 16384 + (wc * 64 + m * 16) * 128 + rd1);
      af[m] = i32x8{a0[0], a0[1], a0[2], a0[3], a1[0], a1[1], a1[2], a1[3]};
      bfr[m] = i32x8{b0[0], b0[1], b0[2], b0[3], b1[0], b1[1], b1[2], b1[3]};
    }
    RAW_BARRIER();
    if (kt + 2 < nk) issue(kt + 2);
#pragma unroll
    for (int m = 0; m < 4; ++m)
#pragma unroll
      for (int n = 0; n < 4; ++n)
        acc[m][n] = SWAP ? __builtin_amdgcn_mfma_scale_f32_16x16x128_f8f6f4(bfr[n], af[m], acc[m][n], 0, 0, 0, 0x7f7f7f7f, 0, 0x7f7f7f7f)
                         : __builtin_amdgcn_mfma_scale_f32_16x16x128_f8f6f4(af[m], bfr[n], acc[m][n], 0, 0, 0, 0x7f7f7f7f, 0, 0x7f7f7f7f);
  }
  epi(acc, wr, wc, fr, fq);
}


template <bool SWAP, class Epi>
__device__ __forceinline__ void gemm_tile8p(const fp8_t* A, const fp8_t* Bt, bool has_next, const fp8_t* An, const fp8_t* Btn,
                                            int& par, bool& primed, int Kb, unsigned char* smem, Epi epi) {
  const int tid = threadIdx.x, wid = tid >> 6, lane = tid & 63, wr = wid >> 1, wc = wid & 1, fr = lane & 15,
            fq = lane >> 4;
  const int r0 = tid >> 3, pc = tid & 7;
  const int lc = pc ^ ((tid >> 4) & 7);
  const long roff = (long)r0 * Kb + lc * 16;
  const long gbs = (long)32 * Kb;
  const int sw = (fr >> 1) & 7;
  const int rd0 = fr * 128 + ((fq ^ sw) << 4), rd1 = fr * 128 + (((4 + fq) ^ sw) << 4);
  char* S = (char*)smem;
  const int nk = Kb >> 7;
  f32x4 acc[4][4];
#pragma unroll
  for (int m = 0; m < 4; ++m)
#pragma unroll
    for (int n = 0; n < 4; ++n) acc[m][n] = f32x4{0.f, 0.f, 0.f, 0.f};
  auto issue = [&](const fp8_t* a, const fp8_t* b, int kt, int stage) {
    char* st = S + stage * 32768 + tid * 16;
    const fp8_t* ga = a + roff + kt * 128;
    const fp8_t* gb = b + roff + kt * 128;
#pragma unroll
    for (int i = 0; i < 4; ++i) {
      __builtin_amdgcn_global_load_lds((const unsigned*)(ga + i * gbs), (unsigned*)(st + i * 4096), 16, 0, 0);
      __builtin_amdgcn_global_load_lds((const unsigned*)(gb + i * gbs), (unsigned*)(st + 16384 + i * 4096), 16, 0, 0);
    }
  };
  if (!primed) {
    RAW_BARRIER();
    issue(A, Bt, 0, par);
  }
#pragma unroll 1
  for (int kt = 0; kt < nk; ++kt) {
    asm volatile("s_waitcnt vmcnt(0)" ::: "memory");
    RAW_BARRIER();
    if (kt + 1 < nk) issue(A, Bt, kt + 1, (par + kt + 1) & 1);
    else if (has_next) issue(An, Btn, 0, (par + kt + 1) & 1);
    const char* st = S + ((par + kt) & 1) * 32768;
    i32x8 af[4], bfr[4];
#pragma unroll
    for (int m = 0; m < 4; ++m) {
      const i32x4 a0 = *reinterpret_cast<const i32x4*>(st + (wr * 64 + m * 16) * 128 + rd0);
      const i32x4 a1 = *reinterpret_cast<const i32x4*>(st + (wr * 64 + m * 16) * 128 + rd1);
      const i32x4 b0 = *reinterpret_cast<const i32x4*>(st + 16384 + (wc * 64 + m * 16) * 128 + rd0);
      const i32x4 b1 = *reinterpret_cast<const i32x4*>(st + 16384 + (wc * 64 + m * 16) * 128 + rd1);
      af[m] = i32x8{a0[0], a0[1], a0[2], a0[3], a1[0], a1[1], a1[2], a1[3]};
      bfr[m] = i32x8{b0[0], b0[1], b0[2], b0[3], b1[0], b1[1], b1[2], b1[3]};
    }
#pragma unroll
    for (int m = 0; m < 4; ++m)
#pragma unroll
      for (int n = 0; n < 4; ++n)
        acc[m][n] = SWAP ? __builtin_amdgcn_mfma_scale_f32_16x16x128_f8f6f4(bfr[n], af[m], acc[m][n], 0, 0, 0, 0x7f7f7f7f, 0, 0x7f7f7f7f)
                         : __builtin_amdgcn_mfma_scale_f32_16x16x128_f8f6f4(af[m], bfr[n], acc[m][n], 0, 0, 0, 0x7f7f7f7f, 0, 0x7f7f7f7f);
  }
  par = (par + nk) & 1;
  primed = has_next;
  epi(acc, wr, wc, fr, fq);
}

__device__ __forceinline__ void phase_attn(const Params& p, unsigned char* smem, int blk, int nblk) {
  const int tid = threadIdx.x, w = tid >> 6, lane = tid & 63, fr = lane & 15, g = lane >> 4;
  act_t* SK = (act_t*)smem;
  act_t* SV = SK + 64 * 72;
  constexpr float SCL = 0.125f * 1.4426950408889634f;
  const int n_lat = NB * 4 * (T / 64), n_ctx = NB * 4 * (C / 64);
  const int skey = tid >> 2, spart = tid & 3;
  for (int unit = blk; unit < n_lat + n_ctx; unit += nblk) {
    const bool lat = unit < n_lat;
    const int uu = lat ? unit : unit - n_lat;
    const int nq = lat ? T / 64 : C / 64;
    const int hp = uu & 1, kv = (uu >> 1) & 1, qb = (uu >> 2) % nq, b = (uu >> 2) / nq;
    const int t0 = qb * 64;
    const int tw = t0 + (w & 1) * 32;
    const long qrow0 = (lat ? (long)NC + (long)b * T : (long)b * C) + tw;
    const int h = kv * 4 + hp * 2 + (w >> 1);
    bf16x8 qf[2][2];
#pragma unroll
    for (int qt = 0; qt < 2; ++qt)
#pragma unroll
      for (int st = 0; st < 2; ++st)
        qf[qt][st] = *reinterpret_cast<const bf16x8*>(p.P + (qrow0 + qt * 16 + fr) * PW + E_AQ + h * 64 + st * 32 + g * 8);
    asm volatile("" :: "v"(qf[0][0]), "v"(qf[0][1]), "v"(qf[1][0]), "v"(qf[1][1]));
    float mrun[2], lrun[2];
    f32x4 o[2][4];
    const float sinkl = p.attn_sink[h] * 1.4426950408889634f;
#pragma unroll
    for (int qt = 0; qt < 2; ++qt) {
      mrun[qt] = sinkl;
      lrun[qt] = (g == 0) ? 1.0f : 0.0f;
#pragma unroll
      for (int dt = 0; dt < 4; ++dt) o[qt][dt] = f32x4{0.f, 0.f, 0.f, 0.f};
    }
    int cc_lo = 0, cc_hi = -1;
    if (lat) {
      cc_lo = t0 >= 128 ? 0 : (128 - t0) / 64;
      cc_hi = min(4, (T - 1 - (t0 - 128)) / 64);
    }
    const int nch = 4 + (cc_hi - cc_lo + 1);
    auto chunk_row = [&](int i, int key, int& tkb) -> long {
      if (i < 4) { tkb = 0; return (long)b * C + i * 64 + key; }
      tkb = t0 - 128 + (cc_lo + i - 4) * 64;
      return (long)NC + (long)b * T + tkb + key;
    };
    uint4 rk0, rk1, rv0, rv1;
    {
      int tkb; const long kr = chunk_row(0, skey, tkb);
      const act_t* kp = p.P + kr * PW + E_AK + kv * 64 + spart * 16;
      const act_t* vp = p.P + kr * PW + E_AV + kv * 64 + spart * 16;
      rk0 = *reinterpret_cast<const uint4*>(kp); rk1 = *reinterpret_cast<const uint4*>(kp + 8);
      rv0 = *reinterpret_cast<const uint4*>(vp); rv1 = *reinterpret_cast<const uint4*>(vp + 8);
    }
    for (int i = 0; i < nch; ++i) {
      __syncthreads();
      {
        uint4* kd = reinterpret_cast<uint4*>(SK + skey * 72 + spart * 16);
        kd[0] = rk0; kd[1] = rk1;
        const unsigned vw[8] = {rv0.x, rv0.y, rv0.z, rv0.w, rv1.x, rv1.y, rv1.z, rv1.w};
#pragma unroll
        for (int e = 0; e < 8; ++e) {
          SV[(spart * 16 + 2 * e) * 72 + skey] = (act_t)(vw[e] & 0xffffu);
          SV[(spart * 16 + 2 * e + 1) * 72 + skey] = (act_t)(vw[e] >> 16);
        }
      }
      __syncthreads();
      int tkb_cur; (void)chunk_row(i, 0, tkb_cur);
      if (i + 1 < nch) {
        int tkb; const long kr = chunk_row(i + 1, skey, tkb);
        const act_t* kp = p.P + kr * PW + E_AK + kv * 64 + spart * 16;
        const act_t* vp = p.P + kr * PW + E_AV + kv * 64 + spart * 16;
        rk0 = *reinterpret_cast<const uint4*>(kp); rk1 = *reinterpret_cast<const uint4*>(kp + 8);
        rv0 = *reinterpret_cast<const uint4*>(vp); rv1 = *reinterpret_cast<const uint4*>(vp + 8);
      }
      const bool edge = i >= 4 && (tkb_cur == t0 - 128 || tkb_cur == t0 + 128);
#pragma unroll
      for (int kb = 0; kb < 2; ++kb) {
        f32x4 sc[2][2];
#pragma unroll
        for (int k2 = 0; k2 < 2; ++k2) {
          const int kt = kb * 2 + k2;
          const bf16x8 kf0 = *reinterpret_cast<const bf16x8*>(SK + (kt * 16 + fr) * 72 + g * 8);
          const bf16x8 kf1 = *reinterpret_cast<const bf16x8*>(SK + (kt * 16 + fr) * 72 + 32 + g * 8);
#pragma unroll
          for (int qt = 0; qt < 2; ++qt) {
            f32x4 z = f32x4{0.f, 0.f, 0.f, 0.f};
            z = __builtin_amdgcn_mfma_f32_16x16x32_bf16(kf0, qf[qt][0], z, 0, 0, 0);
            sc[qt][k2] = __builtin_amdgcn_mfma_f32_16x16x32_bf16(kf1, qf[qt][1], z, 0, 0, 0);
          }
        }
        bf16x8 pf[2];
#pragma unroll
        for (int qt = 0; qt < 2; ++qt) {
          float mx = -1e30f;
#pragma unroll
          for (int k2 = 0; k2 < 2; ++k2)
#pragma unroll
            for (int j = 0; j < 4; ++j) {
              float v = sc[qt][k2][j] * SCL;
              if (edge) {
                const int tk = tkb_cur + (kb * 2 + k2) * 16 + 4 * g + j;
                const int tq = tw + qt * 16 + fr;
                const int df = tq - tk;
                if (df > 128 || df < -128) v = -1e30f;
              }
              sc[qt][k2][j] = v;
              mx = fmaxf(mx, v);
            }
          mx = xor16_max(mx);
          mx = xor32_max(mx);
          const float mnew = fmaxf(mrun[qt], mx);
          if (__any(mnew > mrun[qt])) {
            const float alpha = __builtin_amdgcn_exp2f(mrun[qt] - mnew);
            lrun[qt] *= alpha;
#pragma unroll
            for (int dt = 0; dt < 4; ++dt) o[qt][dt] = o[qt][dt] * alpha;
            mrun[qt] = mnew;
          }
          float ls = 0.f;
          float pv[8];
#pragma unroll
          for (int k2 = 0; k2 < 2; ++k2)
#pragma unroll
            for (int j = 0; j < 4; ++j) {
              const float pe = __builtin_amdgcn_exp2f(sc[qt][k2][j] - mnew);
              pv[k2 * 4 + j] = pe;
              ls += pe;
            }
          lrun[qt] += ls;
          union { unsigned u[4]; bf16x8 v; } cv;
          cv.u[0] = pack2_mfma(pv[0], pv[1]); cv.u[1] = pack2_mfma(pv[2], pv[3]);
          cv.u[2] = pack2_mfma(pv[4], pv[5]); cv.u[3] = pack2_mfma(pv[6], pv[7]);
          pf[qt] = cv.v;
        }
#pragma unroll
        for (int dt = 0; dt < 4; ++dt) {
          union { uint2 h2[2]; bf16x8 v; } vf;
          vf.h2[0] = *reinterpret_cast<const uint2*>(SV + (dt * 16 + fr) * 72 + kb * 32 + 4 * g);
          vf.h2[1] = *reinterpret_cast<const uint2*>(SV + (dt * 16 + fr) * 72 + kb * 32 + 16 + 4 * g);
#pragma unroll
          for (int qt = 0; qt < 2; ++qt) o[qt][dt] = __builtin_amdgcn_mfma_f32_16x16x32_bf16(vf.v, pf[qt], o[qt][dt], 0, 0, 0);
        }
      }
    }
#pragma unroll
    for (int qt = 0; qt < 2; ++qt) {
      float lt = lrun[qt];
      lt = xor16_add(lt);
      lt = xor32_add(lt);
      const float il = 1.0f / lt;
      fp8_t* orow = p.O8 + (qrow0 + qt * 16 + fr) * D + h * 64 + 4 * g;
      const float ils = il * SO8;
#pragma unroll
      for (int dt = 0; dt < 4; ++dt)
        *reinterpret_cast<unsigned*>(orow + dt * 16) = pack4_fp8(o[qt][dt][0] * ils, o[qt][dt][1] * ils, o[qt][dt][2] * ils, o[qt][dt][3] * ils);
    }
  }
}


template <int MODE>
__device__ __forceinline__ void phase_combine(const Params& p) {
  constexpr int DV = MODE == 0 ? 128 : 192, EPL = DV / 16, NV = EPL / 4;
  const int lane = threadIdx.x & 63;
  const long row_lo = MODE == 0 ? 0 : NC;
  const int nw = (int)gridDim.x * 4, wi = (int)blockIdx.x * 4 + (int)(threadIdx.x >> 6);
  const int rpw = (int)(NR - row_lo + nw - 1) / nw;
  const long r0 = row_lo + (long)wi * rpw, r1 = min((long)NR, r0 + rpw);
  float gn[EPL];
#pragma unroll
  for (int e = 0; e < EPL; ++e) gn[e] = (MODE == 0 ? p.hgrn_norm : p.gla_norm)[lane * EPL + e];
  uint2 fa[NV], fb[NV], fg[NV];
  auto load_row = [&](long row) {
    const uint2* f = reinterpret_cast<const uint2*>(p.OF + row * 768 + lane * EPL);
    const uint2* bk = reinterpret_cast<const uint2*>(p.OB + row * 768 + lane * EPL);
    const uint2* gt = reinterpret_cast<const uint2*>(p.P + row * PW + (MODE == 0 ? E_HG : O_G) + lane * EPL);
#pragma unroll
    for (int v = 0; v < NV; ++v) { fa[v] = f[v]; fb[v] = bk[v]; fg[v] = gt[v]; }
  };
  if (r0 < r1) load_row(r0);
  for (long row = r0; row < r1; ++row) {
    float o[EPL], gg[EPL];
#pragma unroll
    for (int v = 0; v < NV; ++v) {
      o[4 * v + 0] = bf_lo(fa[v].x) + bf_lo(fb[v].x); o[4 * v + 1] = bf_hi(fa[v].x) + bf_hi(fb[v].x);
      o[4 * v + 2] = bf_lo(fa[v].y) + bf_lo(fb[v].y); o[4 * v + 3] = bf_hi(fa[v].y) + bf_hi(fb[v].y);
      gg[4 * v + 0] = bf_lo(fg[v].x); gg[4 * v + 1] = bf_hi(fg[v].x); gg[4 * v + 2] = bf_lo(fg[v].y); gg[4 * v + 3] = bf_hi(fg[v].y);
    }
    load_row(min(row + 1, r1 - 1));
    float ss = 0.f;
#pragma unroll
    for (int e = 0; e < EPL; ++e) ss += o[e] * o[e];
    ss = row_sum16(ss);
    const float r = 1.0f / sqrtf(ss * (1.0f / DV) + LN_EPS);
    unsigned* dst = reinterpret_cast<unsigned*>(p.O8 + row * D + (MODE == 0 ? 512 : 0) + lane * EPL);
#pragma unroll
    for (int v = 0; v < NV; ++v) {
      float y[4];
#pragma unroll
      for (int q = 0; q < 4; ++q) {
        const float g = gg[4 * v + q];
        y[q] = o[4 * v + q] * (r * SO8) * gn[4 * v + q] * (g / (1.0f + __expf(-g)));
      }
      dst[v] = pack4_fp8(y[0], y[1], y[2], y[3]);
    }
  }
}

constexpr int MOD_ITEMS = 2 * 2 * (6 * D / 64);
__device__ __forceinline__ void mod_item(const Params& p, int item, unsigned char* smem) {
  float* sc = (float*)smem;
  float* red = sc + 9 * 512;
  const int tid = threadIdx.x, w = tid >> 6, lane = tid & 63;
  const int kh = item & 1, cgi = item >> 1;
  const int l = cgi / (6 * D / 64), j = (cgi % (6 * D / 64)) * 64 + lane;
  const float* wp = p.w_ada + (long)l * D * 6 * D + (long)(kh * 512 + w * 128) * 6 * D + j;
  float wv[32];
#pragma unroll
  for (int q = 0; q < 32; ++q) wv[q] = wp[(long)q * 6 * D];
#pragma unroll 6
  for (int i = tid; i < 9 * 512; i += 256) {
    const int bb = i >> 9, k = kh * 512 + (i & 511);
    const float v = bb < NB ? p.c[bb * D + k] : p.c_ctx[k];
    sc[i] = v / (1.0f + __expf(-v));
  }
  float a[NB + 1];
#pragma unroll
  for (int bb = 0; bb <= NB; ++bb) a[bb] = 0.f;
  __syncthreads();
#pragma unroll 1
  for (int kb = 0; kb < 128; kb += 32) {
    float wc[32];
#pragma unroll
    for (int q = 0; q < 32; ++q) wc[q] = wv[q];
    const int kn = min(kb + 32, 96);
#pragma unroll
    for (int q = 0; q < 32; ++q) wv[q] = wp[(long)(kn + q) * 6 * D];
#pragma unroll
    for (int q4 = 0; q4 < 8; ++q4)
#pragma unroll
      for (int bb = 0; bb <= NB; ++bb) {
        const float4 s4 = *reinterpret_cast<const float4*>(sc + bb * 512 + w * 128 + kb + 4 * q4);
        a[bb] += s4.x * wc[4 * q4] + s4.y * wc[4 * q4 + 1] + s4.z * wc[4 * q4 + 2] + s4.w * wc[4 * q4 + 3];
      }
  }
#pragma unroll
  for (int q = 0; q < 32; ++q) asm volatile("" :: "v"(wv[q]));
#pragma unroll
  for (int bb = 0; bb <= NB; ++bb) red[(w * 9 + bb) * 64 + lane] = a[bb];
  __syncthreads();
  for (int i = tid; i < 9 * 64; i += 256) {
    const int bb = i >> 6, jj = i & 63;
    const int col = (cgi % (6 * D / 64)) * 64 + jj;
    const float sum = ((red[(0 * 9 + bb) * 64 + jj] + red[(1 * 9 + bb) * 64 + jj]) + (red[(2 * 9 + bb) * 64 + jj] + red[(3 * 9 + bb) * 64 + jj]));
    atomicAdd(p.mod + ((long)l * (NB + 1) + bb) * 6 * D + col, kh == 0 ? sum + p.b_ada[l * 6 * D + col] : sum);
  }
  __syncthreads();
}

__device__ __forceinline__ void phase_gla_decay(const Params& p) {
  const int t = threadIdx.x;
  if (t >= 192) return;
  const int dir = t / 96, cg = t % 96;
  float gw[16][4], gb[4];
#pragma unroll
  for (int r = 0; r < 16; ++r) {
    const float4 v = *reinterpret_cast<const float4*>(p.gla_gate_w + ((long)dir * 16 + r) * 384 + cg * 4);
    gw[r][0] = v.x; gw[r][1] = v.y; gw[r][2] = v.z; gw[r][3] = v.w;
  }
  {
    const float4 v = *reinterpret_cast<const float4*>(p.gla_gate_b + dir * 384 + cg * 4);
    gb[0] = v.x; gb[1] = v.y; gb[2] = v.z; gb[3] = v.w;
  }
  const int rpb = ((NR + (int)gridDim.x - 1) / (int)gridDim.x + 3) / 4 * 4;
  const long b0 = (long)blockIdx.x * rpb, b1 = min((long)NR, b0 + rpb);
  uint4 ra[4], rb[4];
  auto load4 = [&](long row0) {
#pragma unroll
    for (int q = 0; q < 4; ++q) {
      const uint4* rp = reinterpret_cast<const uint4*>(p.P + min(row0 + q, b1 - 1) * PW + O_RF + dir * 16);
      ra[q] = rp[0]; rb[q] = rp[1];
    }
  };
  if (b0 < b1) load4(b0);
  for (long row0 = b0; row0 < b1; row0 += 4) {
    unsigned rw[4][8];
#pragma unroll
    for (int q = 0; q < 4; ++q) {
      rw[q][0] = ra[q].x; rw[q][1] = ra[q].y; rw[q][2] = ra[q].z; rw[q][3] = ra[q].w;
      rw[q][4] = rb[q].x; rw[q][5] = rb[q].y; rw[q][6] = rb[q].z; rw[q][7] = rb[q].w;
    }
    load4(min(row0 + 4, b1 - 1));
#pragma unroll
    for (int q = 0; q < 4; ++q) {
      float z[4] = {gb[0], gb[1], gb[2], gb[3]};
#pragma unroll
      for (int r2 = 0; r2 < 8; ++r2) {
        const float x0 = bf_lo(rw[q][r2]), x1 = bf_hi(rw[q][r2]);
#pragma unroll
        for (int c = 0; c < 4; ++c) z[c] += x0 * gw[2 * r2][c] + x1 * gw[2 * r2 + 1][c];
      }
      float o[4];
#pragma unroll
      for (int c = 0; c < 4; ++c) o[c] = (fminf(z[c], 0.f) - __logf(1.0f + __expf(-fabsf(z[c])))) * (1.4426950408889634f / 16.0f);
      if (row0 + q < b1)
        *reinterpret_cast<uint2*>(p.LF + ((long)dir * NR + row0 + q) * 384 + cg * 4) = make_uint2(pack2(o[0], o[1]), pack2(o[2], o[3]));
    }
  }
}

__device__ __forceinline__ void phase_hgrn_gate(const Params& p, long gtid, long gstride) {
  for (long i = gtid; i < (long)NR * 1024; i += gstride) {
    const int col = (int)(i & 1023);
    const long row = i >> 10;
    act_t* z = p.P + row * PW + E_FF + col;
    const float lb = p.lbt[col];
    const float f = lb + (1.0f - lb) * sigmoidf_(ldA(z));
    stA(z, __logf(f));
  }
}

#define EX2(x) __builtin_amdgcn_exp2f(x)
template <int MODE>
__device__ __forceinline__ void phase_scan(const Params& p, unsigned char* smem, int blk, int nblk) {
  constexpr int DK = MODE == 0 ? 128 : 96, DV = MODE == 0 ? 128 : 192, DVS = DV / 4, NET = DVS / 16, NKS = DK / 32,
                NDT = DK / 16;
  constexpr int QS = DK + 8, LS = 72, SS = DK + 8;
  act_t* Qa = (act_t*)smem;
  act_t* Ka = Qa + 64 * QS;
  act_t* KaT = Ka + 64 * QS;
  act_t* VT = KaT + DK * LS;
  act_t* ST = VT + DVS * LS;
  float* tot = (float*)(ST + DVS * SS);
  float* lf32 = tot + 2 * 4 * DK;
  const int tid = threadIdx.x, w = __builtin_amdgcn_readfirstlane(threadIdx.x >> 6), lane = tid & 63, fr = lane & 15, g = lane >> 4;
  const int dp = lane, c0 = 2 * dp;
  const bool cact = dp < DK / 2;
  constexpr int NCH = (C + T) / 64, NCC = C / 64;
  constexpr int NVI = DVS / 8 * 64;
  for (int item = blk; item < NB * 4 * 2 * 4; item += nblk) {
    const int sl = item & 3, dir = (item >> 2) & 1, h = (item >> 3) & 3, b = item >> 5;
    act_t* OD = dir == 0 ? p.OF : p.OB;
    const unsigned loff = (unsigned)min(c0, DK - 2) * 2u;
    const int vcol = (MODE == 0 ? E_HI + h * 128 : O_V + h * 192) + sl * DVS;
    const int ocol = h * DV + sl * DVS;
    auto chunk_base = [&](int n) -> long {
      if (n < NCC) return (long)b * C + (dir ? NCC - 1 - n : n) * 64;
      const int ln = n - NCC;
      return (long)NC + (long)b * T + (dir ? T / 64 - 1 - ln : ln) * 64;
    };
    auto lrow = [&](long base, int l) -> long { return base + (dir ? 63 - l : l); };
    f32x4 S[NET][2];
#pragma unroll
    for (int et = 0; et < NET; ++et) { S[et][0] = f32x4{0.f, 0.f, 0.f, 0.f}; S[et][1] = f32x4{0.f, 0.f, 0.f, 0.f}; }
    unsigned rlf[16], rq[16], rk[16];
    uint4 rv[2];
    const long rstep = dir ? -(long)PW * 2 : (long)PW * 2;
    const long lstep = dir ? -(long)384 * 2 : (long)384 * 2;
    const unsigned off_lf = (MODE == 0 ? (unsigned)(E_FF + dir * 512 + h * 128) * 2u : 0u) + loff;
    const unsigned off_q = (unsigned)(MODE == 0 ? E_HQ + h * 128 : O_Q + h * 96) * 2u + loff;
    const unsigned off_k = (unsigned)(O_K + h * 96) * 2u + loff;
    auto issue_loads = [&](int n) {
      const long base = chunk_base(n);
      {
        const char* prow = (const char*)(p.P + lrow(base, w * 16) * PW);
        const char* plf = (const char*)(p.LF + ((long)dir * NR + lrow(base, w * 16)) * 384 + h * 96);
#pragma unroll
        for (int i = 0; i < 16; ++i) {
          if (MODE == 0) {
            rlf[i] = *reinterpret_cast<const unsigned*>(prow + off_lf);
          } else {
            rlf[i] = *reinterpret_cast<const unsigned*>(plf + loff);
            rk[i] = *reinterpret_cast<const unsigned*>(prow + off_k);
            plf += lstep;
          }
          rq[i] = *reinterpret_cast<const unsigned*>(prow + off_q);
          prow += rstep;
        }
      }
#pragma unroll
      for (int r = 0; r < (NVI + 255) / 256; ++r) {
        const int it = min(tid + r * 256, NVI - 1);
        const int l = it / (DVS / 8), e8 = (it % (DVS / 8)) * 8;
        rv[r] = *reinterpret_cast<const uint4*>(p.P + lrow(base, l) * PW + vcol + e8);
      }
    };
    issue_loads(0);
    for (int n = 0; n < NCH; ++n) {
      const int par = n & 1;
      float* totp = tot + par * 4 * DK;
      float* lfp = lf32 + par * DK;
      const long base = chunk_base(n);
      if (cact) {
        float r0 = 0.f, r1 = 0.f;
#pragma unroll
        for (int i = 0; i < 16; ++i) { r0 += bf_lo(rlf[i]); r1 += bf_hi(rlf[i]); }
        totp[w * DK + c0] = r0; totp[w * DK + c0 + 1] = r1;
        if (w == 2) { lfp[c0] = bf_lo(rlf[0]); lfp[c0 + 1] = bf_hi(rlf[0]); }
      }
      __syncthreads();
#pragma unroll
      for (int r = 0; r < (NVI + 255) / 256; ++r) {
        const int it = tid + r * 256;
        if (it < NVI) {
          const int l = it / (DVS / 8), e8 = (it % (DVS / 8)) * 8;
          const unsigned vw[4] = {rv[r].x, rv[r].y, rv[r].z, rv[r].w};
#pragma unroll
          for (int e = 0; e < 4; ++e) {
            VT[(e8 + 2 * e) * LS + l] = (act_t)(vw[e] & 0xffffu);
            VT[(e8 + 2 * e + 1) * LS + l] = (act_t)(vw[e] >> 16);
          }
        }
      }
      if (cact) {
        float of0 = 0.f, of1 = 0.f;
#pragma unroll
        for (int sgi = 0; sgi < 3; ++sgi)
          if (sgi < w) { of0 += totp[sgi * DK + c0]; of1 += totp[sgi * DK + c0 + 1]; }
        const float ref0 = totp[c0] + totp[DK + c0] + lfp[c0];
        const float ref1 = totp[c0 + 1] + totp[DK + c0 + 1] + lfp[c0 + 1];
        unsigned kt0[8], kt1[8];
        float run0 = of0 - ref0, run1 = of1 - ref1;
        float e0 = 0.f, e1 = 0.f, f0 = 0.f, f1 = 0.f;
        if (MODE == 0) { e0 = EX2(run0); e1 = EX2(run1); f0 = EX2(-run0); f1 = EX2(-run1); }
#pragma unroll
        for (int i = 0; i < 16; i += 2) {
          float ka0[2], ka1[2];
#pragma unroll
          for (int ii = 0; ii < 2; ++ii) {
            const int i2 = i + ii;
            const float l0 = bf_lo(rlf[i2]), l1 = bf_hi(rlf[i2]);
            float k0, k1;
            if (MODE == 0) {
              const float g0 = EX2(l0), g1 = EX2(l1), gi0 = EX2(-l0), gi1 = EX2(-l1);
              e0 *= g0; e1 *= g1; f0 *= gi0; f1 *= gi1;
              k0 = 1.0f - g0; k1 = 1.0f - g1;
            } else {
              run0 += l0; run1 += l1;
              e0 = EX2(run0); e1 = EX2(run1); f0 = EX2(-run0); f1 = EX2(-run1);
              k0 = bf_lo(rk[i2]); k1 = bf_hi(rk[i2]);
            }
            ka0[ii] = k0 * f0; ka1[ii] = k1 * f1;
            const int l = w * 16 + i2;
            *reinterpret_cast<unsigned*>(Qa + l * QS + c0) = pack2(bf_lo(rq[i2]) * e0, bf_hi(rq[i2]) * e1);
            *reinterpret_cast<unsigned*>(Ka + l * QS + c0) = pack2(ka0[ii], ka1[ii]);
          }
          kt0[i >> 1] = pack2(ka0[0], ka0[1]);
          kt1[i >> 1] = pack2(ka1[0], ka1[1]);
        }
        uint4* d0 = reinterpret_cast<uint4*>(KaT + c0 * LS + w * 16);
        d0[0] = make_uint4(kt0[0], kt0[1], kt0[2], kt0[3]); d0[1] = make_uint4(kt0[4], kt0[5], kt0[6], kt0[7]);
        uint4* d1 = reinterpret_cast<uint4*>(KaT + (c0 + 1) * LS + w * 16);
        d1[0] = make_uint4(kt1[0], kt1[1], kt1[2], kt1[3]); d1[1] = make_uint4(kt1[4], kt1[5], kt1[6], kt1[7]);
      }
      issue_loads(min(n + 1, NCH - 1));
      float egv[2], egrv[2];
#pragma unroll
      for (int di = 0; di < 2; ++di) {
        const int dt = w + 4 * di;
        if (dt < NDT) {
          const int d = dt * 16 + fr;
          const float refd = totp[d] + totp[DK + d] + lfp[d];
          const float gd = totp[d] + totp[DK + d] + totp[2 * DK + d] + totp[3 * DK + d];
          const float er = EX2(refd);
          egv[di] = EX2(gd); egrv[di] = EX2(gd - refd);
#pragma unroll
          for (int et = 0; et < NET; ++et)
#pragma unroll
            for (int j = 0; j < 4; j += 2) {
              const unsigned pk = pack2(S[et][di][j] * er, S[et][di][j + 1] * er);
              ST[(et * 16 + 4 * g + j) * SS + d] = (act_t)(pk & 0xffffu);
              ST[(et * 16 + 4 * g + j + 1) * SS + d] = (act_t)(pk >> 16);
            }
        }
      }
      __syncthreads();
      bf16x8 qfr[NKS];
#pragma unroll
      for (int ks = 0; ks < NKS; ++ks) qfr[ks] = *reinterpret_cast<const bf16x8*>(Qa + (w * 16 + fr) * QS + ks * 32 + g * 8);
      bf16x8 pfr[2];
#pragma unroll
      for (int kb = 0; kb < 2; ++kb) {
        f32x4 at2[2];
#pragma unroll
        for (int h2 = 0; h2 < 2; ++h2) {
          const int mt = 2 * kb + h2;
          at2[h2] = f32x4{0.f, 0.f, 0.f, 0.f};
          if (mt <= w) {
#pragma unroll
            for (int ks = 0; ks < NKS; ++ks) {
              const bf16x8 kaf = *reinterpret_cast<const bf16x8*>(Ka + (mt * 16 + fr) * QS + ks * 32 + g * 8);
              at2[h2] = __builtin_amdgcn_mfma_f32_16x16x32_bf16(kaf, qfr[ks], at2[h2], 0, 0, 0);
            }
            if (mt == w) {
#pragma unroll
              for (int j = 0; j < 4; ++j)
                if (4 * g + j > fr) at2[h2][j] = 0.f;
            }
          }
        }
        union { unsigned u[4]; bf16x8 v; } cv;
        cv.u[0] = pack2_mfma(at2[0][0], at2[0][1]); cv.u[1] = pack2_mfma(at2[0][2], at2[0][3]);
        cv.u[2] = pack2_mfma(at2[1][0], at2[1][1]); cv.u[3] = pack2_mfma(at2[1][2], at2[1][3]);
        pfr[kb] = cv.v;
      }
      const long orow = lrow(base, w * 16 + fr);
#pragma unroll
      for (int et = 0; et < NET; ++et) {
        f32x4 o = f32x4{0.f, 0.f, 0.f, 0.f};
#pragma unroll
        for (int kb = 0; kb < 2; ++kb) {
          if (2 * kb <= w) {
            union { uint2 h2[2]; bf16x8 v; } vf;
            vf.h2[0] = *reinterpret_cast<const uint2*>(VT + (et * 16 + fr) * LS + kb * 32 + 4 * g);
            vf.h2[1] = *reinterpret_cast<const uint2*>(VT + (et * 16 + fr) * LS + kb * 32 + 16 + 4 * g);
            o = __builtin_amdgcn_mfma_f32_16x16x32_bf16(vf.v, pfr[kb], o, 0, 0, 0);
          }
        }
#pragma unroll
        for (int ks = 0; ks < NKS; ++ks) {
          const bf16x8 sf = *reinterpret_cast<const bf16x8*>(ST + (et * 16 + fr) * SS + ks * 32 + g * 8);
          o = __builtin_amdgcn_mfma_f32_16x16x32_bf16(sf, qfr[ks], o, 0, 0, 0);
        }
        const float osc = MODE == 0 ? 1.0f : 0.10206207261596575f;
        *reinterpret_cast<uint2*>(OD + orow * 768 + ocol + et * 16 + 4 * g) =
            make_uint2(pack2(o[0] * osc, o[1] * osc), pack2(o[2] * osc, o[3] * osc));
      }
#pragma unroll
      for (int di = 0; di < 2; ++di) {
        const int dt = w + 4 * di;
        if (dt < NDT) {
#pragma unroll
          for (int et = 0; et < NET; ++et) {
            f32x4 r = f32x4{0.f, 0.f, 0.f, 0.f};
#pragma unroll
            for (int k2 = 0; k2 < 2; ++k2) {
              const bf16x8 vf = *reinterpret_cast<const bf16x8*>(VT + (et * 16 + fr) * LS + k2 * 32 + g * 8);
              const bf16x8 kf = *reinterpret_cast<const bf16x8*>(KaT + (dt * 16 + fr) * LS + k2 * 32 + g * 8);
              r = __builtin_amdgcn_mfma_f32_16x16x32_bf16(vf, kf, r, 0, 0, 0);
            }
#pragma unroll
            for (int j = 0; j < 4; ++j) S[et][di][j] = egv[di] * S[et][di][j] + egrv[di] * r[j];
          }
        }
      }
    }
    __syncthreads();
  }
}

struct GemmJob {
  const act_t* A; const act_t* Bt; act_t* C;
  long sA, sB, sC;
  int nbatch, Mtiles, Ntiles, K, ldc, Nvalid, mode;
  float scale;
  int fp8;
  int out8;
};
__device__ __forceinline__ void phase_gemm(const Params& p, const GemmJob& g, unsigned char* smem, int blk = blockIdx.x, int nblk = gridDim.x) {
  const int per_b = g.Mtiles * g.Ntiles;
  const int ntiles = per_b * g.nbatch;
  auto tvalid = [&](int t) -> bool {
    const int tt = t % per_b;
    const int tm = tt / g.Ntiles, tn = tt % g.Ntiles;
    return !(g.mode == 1 && tm < NC / 128 && tn * 128 >= O_FA);
  };
  auto tnext = [&](int t) -> int { t += nblk; while (t < ntiles && !tvalid(t)) t += nblk; return t; };
  int par = 0;
  bool primed = false;
  int tile0 = blk;
  if (tile0 < ntiles && !tvalid(tile0)) tile0 = tnext(tile0);
  for (int tile = tile0; tile < ntiles;) {
    const int ntile = tnext(tile);
    const int b = tile / per_b, tt = tile % per_b;
    const int tm = tt / g.Ntiles, tn = tt % g.Ntiles;
    const int tt2 = (ntile < ntiles ? ntile : tile) % per_b;
    const int tm2 = tt2 / g.Ntiles, tn2 = tt2 % g.Ntiles;
    const int K = g.K, ldc = g.ldc;
    const act_t* Ab = g.A + b * g.sA + (long)tm * 128 * K;
    act_t* Cb = g.C + b * g.sC + (long)tm * 128 * ldc + tn * 128;
    const int nlim = g.Nvalid - tn * 128;
    const float scale = g.scale;
    const int mode = g.mode;
    if (mode == 1) {
      auto epi1 = [&](f32x4 (&acc)[4][4], int wr, int wc, int fr, int fq) {
                  if (g.fp8) {
#pragma unroll
                    for (int m = 0; m < 4; ++m)
#pragma unroll
                      for (int n = 0; n < 4; ++n) acc[m][n] = acc[m][n] * scale;
                  }
#pragma unroll
                  for (int m = 0; m < 4; ++m)
#pragma unroll
                    for (int n = 0; n < 4; ++n) {
                      const int col = wc * 64 + n * 16 + fr;
                      if (col < nlim) {
#pragma unroll
                        for (int j = 0; j < 4; ++j) {
                          const int row = wr * 64 + m * 16 + fq * 4 + j;
                          stA(Cb + (long)row * ldc + col, acc[m][n][j]);
                        }
                      } else {
                        const int gc = tn * 128 + col;
                        if (gc < O_END && tm >= NC / 128) {
                          const int lr = (tm - NC / 128) * 128 + wr * 64 + m * 16 + fq * 4;
                          const int bb = lr / T, t = lr % T;
                          const int cq = gc < O_FB ? gc - O_FA : gc - O_FB;
                          act_t* dst = p.FT + ((long)bb * 256 + cq) * (2 * T) + (gc < O_FB ? 0 : T) + t;
                          *reinterpret_cast<uint2*>(dst) = make_uint2(pack2(acc[m][n][0], acc[m][n][1]), pack2(acc[m][n][2], acc[m][n][3]));
                        }
                      }
                    }
                };
      if (g.fp8) {
        const fp8_t* A8 = (const fp8_t*)g.A + (long)tm * 128 * K;
        gemm_tile8p<false>(A8, (const fp8_t*)g.Bt + (long)tn * 128 * K, ntile < ntiles, (const fp8_t*)g.A + (long)tm2 * 128 * K,
                           (const fp8_t*)g.Bt + (long)tn2 * 128 * K, par, primed, K, smem, epi1);
      } else {
        gemm_tile<false>([&](int r) { return Ab + (long)r * K; }, g.Bt + b * g.sB + (long)tn * 128 * K, K, smem, epi1);
      }
    } else {
      auto epi2 = [&](f32x4 (&acc)[4][4], int wr, int wc, int fr, int fq) {
                  const float oscale = g.fp8 ? 1.0f : scale;
                  if (g.fp8) {
#pragma unroll
                    for (int m = 0; m < 4; ++m)
#pragma unroll
                      for (int n = 0; n < 4; ++n) acc[m][n] = acc[m][n] * scale;
                  }
                  if (mode == 2) {
                    const int cb = tn * 128 + wc * 64;
                    if (cb < E_AV && tm >= NC / 128) {
                      const float4* rt = reinterpret_cast<const float4*>(p.ropetab);
#pragma unroll
                      for (int m = 0; m < 4; ++m) {
                        const int t = ((tm - NC / 128) * 128 + wr * 64 + m * 16 + fr) % T;
                        const float4 r01 = rt[(t / GRID_W) * 8 + fq * 2], r23 = rt[(t / GRID_W) * 8 + fq * 2 + 1];
                        const float4 c01 = rt[(t % GRID_W) * 8 + fq * 2], c23 = rt[(t % GRID_W) * 8 + fq * 2 + 1];
                        const float rc[4] = {r01.x, r01.z, r23.x, r23.z}, rs_[4] = {r01.y, r01.w, r23.y, r23.w};
                        const float cc[4] = {c01.x, c01.z, c23.x, c23.z}, cs_[4] = {c01.y, c01.w, c23.y, c23.w};
#pragma unroll
                        for (int j = 0; j < 4; ++j) {
                          const float a1 = acc[m][0][j], a2 = acc[m][1][j], b1 = acc[m][2][j], b2 = acc[m][3][j];
                          acc[m][0][j] = a1 * rc[j] - a2 * rs_[j]; acc[m][1][j] = a1 * rs_[j] + a2 * rc[j];
                          acc[m][2][j] = b1 * cc[j] - b2 * cs_[j]; acc[m][3][j] = b1 * cs_[j] + b2 * cc[j];
                        }
                      }
                    } else if (cb >= E_FF && cb < E_HQ) {
#pragma unroll
                      for (int n = 0; n < 4; ++n) {
                        const float4 lb4 = *reinterpret_cast<const float4*>(p.lbt + cb - E_FF + n * 16 + fq * 4);
                        const float lb[4] = {lb4.x, lb4.y, lb4.z, lb4.w};
#pragma unroll
                        for (int m = 0; m < 4; ++m)
#pragma unroll
                          for (int j = 0; j < 4; ++j)
                            acc[m][n][j] = __log2f(lb[j] + (1.0f - lb[j]) / (1.0f + __expf(-acc[m][n][j])));
                      }
                    }
                  }
#pragma unroll
                  for (int m = 0; m < 4; ++m) {
                    const int row = wr * 64 + m * 16 + fr;
#pragma unroll
                    for (int n = 0; n < 4; ++n) {
                      const int col = wc * 64 + n * 16 + fq * 4;
                      if (col < nlim) {
                        if (g.out8)
                          *reinterpret_cast<unsigned*>(reinterpret_cast<fp8_t*>(g.C) + b * g.sC + ((long)tm * 128 + row) * ldc + tn * 128 + col) =
                              pack4_fp8(acc[m][n][0] * oscale, acc[m][n][1] * oscale, acc[m][n][2] * oscale, acc[m][n][3] * oscale);
                        else
                          *reinterpret_cast<uint2*>(Cb + (long)row * ldc + col) =
                              make_uint2(pack2(acc[m][n][0] * oscale, acc[m][n][1] * oscale), pack2(acc[m][n][2] * oscale, acc[m][n][3] * oscale));
                      }
                    }
                  }
                };
      if (g.fp8) {
        const fp8_t* A8 = (const fp8_t*)g.A + (long)tm * 128 * K;
        gemm_tile8p<true>(A8, (const fp8_t*)g.Bt + (long)tn * 128 * K, ntile < ntiles, (const fp8_t*)g.A + (long)tm2 * 128 * K,
                          (const fp8_t*)g.Bt + (long)tn2 * 128 * K, par, primed, K, smem, epi2);
      } else {
        gemm_tile<true>([&](int r) { return Ab + (long)r * K; }, g.Bt + b * g.sB + (long)tn * 128 * K, K, smem, epi2);
      }
    }
    tile = ntile;
  }
}

template <class RowMap>
__device__ __forceinline__ void conv_tile_rm(const float* src, int lds_, int Nvalid, int k0, int n0, act_t* dst, int ldd, float* tile, RowMap rm) {
  const int tid = threadIdx.x;
  {
    const int r = tid >> 5, c4 = (tid & 31) * 4;
    float4 v[8];
#pragma unroll
    for (int rr = 0; rr < 8; ++rr) {
      v[rr] = make_float4(0.f, 0.f, 0.f, 0.f);
      if (n0 + c4 < Nvalid) v[rr] = *reinterpret_cast<const float4*>(src + (long)(k0 + r + rr * 8) * lds_ + n0 + c4);
    }
#pragma unroll
    for (int rr = 0; rr < 8; ++rr) {
      float* t = tile + (r + rr * 8) * 129 + c4;
      t[0] = v[rr].x; t[1] = v[rr].y; t[2] = v[rr].z; t[3] = v[rr].w;
    }
  }
  __syncthreads();
  {
    const int n = tid >> 1, ks = (tid & 1) * 32;
    if (n0 + n < Nvalid) {
      unsigned w[16];
#pragma unroll
      for (int i = 0; i < 16; ++i) w[i] = pack2(tile[(ks + 2 * i) * 129 + n], tile[(ks + 2 * i + 1) * 129 + n]);
      uint4* d = reinterpret_cast<uint4*>(dst + (long)rm(n) * ldd + k0 + ks);
      d[0] = make_uint4(w[0], w[1], w[2], w[3]);
      d[1] = make_uint4(w[4], w[5], w[6], w[7]);
      d[2] = make_uint4(w[8], w[9], w[10], w[11]);
      d[3] = make_uint4(w[12], w[13], w[14], w[15]);
    }
  }
  __syncthreads();
}

template <class RowMap>
__device__ __forceinline__ void conv_tile8_rm(const float* src, int lds_, int k0, int n0, fp8_t* dst, int ldd, float* tile, float scale, RowMap rm, int Nvalid = 1 << 30) {
  const int tid = threadIdx.x;
  {
    const int r = tid >> 5, c4 = (tid & 31) * 4;
    float4 v[8];
#pragma unroll
    for (int rr = 0; rr < 8; ++rr) {
      v[rr] = make_float4(0.f, 0.f, 0.f, 0.f);
      if (n0 + c4 < Nvalid) v[rr] = *reinterpret_cast<const float4*>(src + (long)(k0 + r + rr * 8) * lds_ + n0 + c4);
    }
#pragma unroll
    for (int rr = 0; rr < 8; ++rr) {
      float* t = tile + (r + rr * 8) * 129 + c4;
      t[0] = v[rr].x; t[1] = v[rr].y; t[2] = v[rr].z; t[3] = v[rr].w;
    }
  }
  __syncthreads();
  if ((threadIdx.x >> 1) + n0 < Nvalid) {
    const int n = tid >> 1, ks = (tid & 1) * 32;
    unsigned w[8];
#pragma unroll
    for (int i = 0; i < 8; ++i)
      w[i] = pack4_fp8(tile[(ks + 4 * i) * 129 + n] * scale, tile[(ks + 4 * i + 1) * 129 + n] * scale,
                       tile[(ks + 4 * i + 2) * 129 + n] * scale, tile[(ks + 4 * i + 3) * 129 + n] * scale);
    uint4* d = reinterpret_cast<uint4*>(dst + (long)rm(n) * ldd + k0 + ks);
    d[0] = make_uint4(w[0], w[1], w[2], w[3]);
    d[1] = make_uint4(w[4], w[5], w[6], w[7]);
  }
  __syncthreads();
}

__device__ __forceinline__ void conv_tile(const float* src, int lds_, int Nvalid, int k0, int n0, act_t* dst, int ldd, float* tile) {
  conv_tile_rm(src, lds_, Nvalid, k0, n0, dst, ldd, tile, [=](int n) { return n0 + n; });
}

struct ConvJob { const float* src; fp8_t* dst; int lds, ldd, k0, n0, rbase, ra, rb; };
__device__ __forceinline__ void phase_convert_experts(const Params& p, int l, unsigned char* smem, int blk, int nblk) {
  float* tile = (float*)smem;
  const int per_e = 192, total = NEXP * per_e;
  fp8_t* Wup = l == 0 ? p.W8up : p.W8up1;
  fp8_t* Wdn = l == 0 ? p.W8down : p.W8down1;
  const int tid = threadIdx.x;
  auto mkjob = [&](int job) -> ConvJob {
    const int e = job / per_e, j = job % per_e;
    ConvJob c;
    if (j < 128) {
      const int up = j >> 6, jj = j & 63;
      const int kt = jj >> 2, fp = jj & 3;
      c.src = (up ? p.w_eu : p.w_eg) + ((long)(l * NEXP + e) * D) * DFF;
      c.dst = Wup + (long)e * 1024 * D; c.lds = DFF; c.ldd = D; c.k0 = kt * 64; c.n0 = fp * 128;
      c.rbase = fp * 256 + up * 32; c.ra = 128; c.rb = 64;
    } else {
      const int jj = j - 128;
      const int kt = jj >> 3, nt = jj & 7;
      c.src = p.w_ed + ((long)(l * NEXP + e) * DFF) * D;
      c.dst = Wdn + (long)e * 1024 * DFF; c.lds = D; c.ldd = DFF; c.k0 = kt * 64; c.n0 = nt * 128;
      c.rbase = nt * 128; c.ra = 64; c.rb = 32;
    }
    return c;
  };
  float4 v[8];
  auto ld = [&](const ConvJob& c) {
    const int r = tid >> 5, c4 = (tid & 31) * 4;
#pragma unroll
    for (int rr = 0; rr < 8; ++rr) v[rr] = *reinterpret_cast<const float4*>(c.src + (long)(c.k0 + r + rr * 8) * c.lds + c.n0 + c4);
  };
  int job = blk;
  if (job >= total) return;
  ConvJob cur = mkjob(job);
  ld(cur);
  while (job < total) {
    {
      const int r = tid >> 5, c4 = (tid & 31) * 4;
#pragma unroll
      for (int rr = 0; rr < 8; ++rr) {
        float* t = tile + (r + rr * 8) * 129 + c4;
        t[0] = v[rr].x; t[1] = v[rr].y; t[2] = v[rr].z; t[3] = v[rr].w;
      }
    }
    __syncthreads();
    const int nxt = job + nblk;
    const ConvJob nj = mkjob(min(nxt, total - 1));
    ld(nj);
    {
      const int n = tid >> 1, ks = (tid & 1) * 32;
      unsigned w[8];
#pragma unroll
      for (int i = 0; i < 8; ++i)
        w[i] = pack4_fp8(tile[(ks + 4 * i) * 129 + n] * SW8, tile[(ks + 4 * i + 1) * 129 + n] * SW8,
                         tile[(ks + 4 * i + 2) * 129 + n] * SW8, tile[(ks + 4 * i + 3) * 129 + n] * SW8);
      const int row = cur.rbase + (n >> 6) * cur.ra + ((n >> 5) & 1) * cur.rb + (n & 31);
      uint4* d = reinterpret_cast<uint4*>(cur.dst + (long)row * cur.ldd + cur.k0 + ks);
      d[0] = make_uint4(w[0], w[1], w[2], w[3]);
      d[1] = make_uint4(w[4], w[5], w[6], w[7]);
    }
    __syncthreads();
    cur = nj;
    job = nxt;
  }
}

__device__ __forceinline__ void phase_moe(const Params& p, int l, bool down, unsigned char* smem) {
  const int* cntp = p.cnt + l * NEXP * 64;
  int total = 0;
  for (int e = 0; e < NEXP; ++e) total += ((cntp[e * 64] + 127) >> 7) * 8;
  for (int tile = blockIdx.x; tile < total; tile += gridDim.x) {
    int e = 0, tb = 0, rowoff = 0;
    for (; e < NEXP - 1; ++e) {
      const int c = cntp[e * 64];
      const int nt = ((c + 127) >> 7) * 8;
      if (tile < tb + nt) break;
      tb += nt; rowoff += c;
    }
    const int c = cntp[e * 64];
    const int lt = tile - tb, mt = lt >> 3, nt = lt & 7;
    const int rows_valid = min(128, c - mt * 128);
    const int* lst = p.list + (long)(l * NEXP + e) * NR + mt * 128;
    const long hrow0 = (long)rowoff + mt * 128;
    if (!down) {
      gemm_tile8<true>([&](int r) { return p.u8 + (long)(lst[min(r, rows_valid - 1)] >> 1) * D; },
                (l == 0 ? p.W8up : p.W8up1) + ((long)e * 1024 + nt * 128) * D, D, smem,
                [&](f32x4 (&acc)[4][4], int wr, int wc, int fr, int fq) {
                  constexpr float dq = 1.0f / (SU8 * SW8);
#pragma unroll
                  for (int m = 0; m < 4; ++m) {
                    const int row = wr * 64 + m * 16 + fr;
                    if (row < rows_valid) {
#pragma unroll
                      for (int n = 0; n < 2; ++n) {
                        float hv[4];
#pragma unroll
                        for (int j = 0; j < 4; ++j) {
                          const float g = acc[m][n][j] * dq, uu = acc[m][n + 2][j] * dq;
                          hv[j] = g / (1.0f + __expf(-g)) * uu * SH8;
                        }
                        *reinterpret_cast<unsigned*>(p.H8 + (hrow0 + row) * DFF + nt * 64 + wc * 32 + n * 16 + fq * 4) =
                            pack4_fp8(hv[0], hv[1], hv[2], hv[3]);
                      }
                    }
                  }
                });
    } else {
      const fp8_t* Ab = p.H8 + hrow0 * DFF;
      gemm_tile8<true>([&](int r) { return Ab + (long)r * DFF; }, (l == 0 ? p.W8down : p.W8down1) + ((long)e * 1024 + nt * 128) * DFF, DFF, smem,
                [&](f32x4 (&acc)[4][4], int wr, int wc, int fr, int fq) {
                  constexpr float dq = 1.0f / (SH8 * SW8);
#pragma unroll
                  for (int m = 0; m < 4; ++m) {
                    const int row = wr * 64 + m * 16 + fr;
                    if (row < rows_valid) {
                      const int ts = lst[row];
                      const float w = p.ew[ts] * dq;
#pragma unroll
                      for (int n = 0; n < 4; ++n)
                        *reinterpret_cast<uint2*>(p.Y + (long)ts * D + nt * 128 + wc * 64 + n * 16 + fq * 4) =
                            make_uint2(pack2(acc[m][n][0] * w, acc[m][n][1] * w), pack2(acc[m][n][2] * w, acc[m][n][3] * w));
                    }
                  }
                });
    }
  }
}

__device__ __forceinline__ void phase_convert_dense(const Params& p, unsigned char* smem) {
  float* tile = (float*)smem;
  const int J0 = 16 * 26, J1 = J0 + 128, J2 = J1 + 16 * 19, J3 = J2 + 128;
  const int nb = (int)gridDim.x, blk = (int)blockIdx.x;
  const bool modblk = blk < MOD_ITEMS && nb > MOD_ITEMS;
  if (nb <= MOD_ITEMS) { for (int it = blk; it < MOD_ITEMS; it += nb) mod_item(p, it, smem); }
  else if (modblk) mod_item(p, blk, smem);
  int job, jstep, jend = J3;
  if (nb <= MOD_ITEMS) { job = blk; jstep = nb; }
  else if (modblk) { job = blk; jstep = J3; }
  else { job = MOD_ITEMS + (blk - MOD_ITEMS); jstep = nb - MOD_ITEMS; }
  for (; job < jend; job += jstep) {
    if (job < J0) { int j = job; const int n0 = (j % 26) * 128; conv_tile8_rm(p.w_in_even, IN_EVEN, (j / 26) * 64, n0, p.W8in_even, D, tile, SW8, [=](int n) { return n0 + n; }); }
    else if (job < J1) { int j = job - J0; const int n0 = (j % 8) * 128; conv_tile8_rm(p.w_out_even, D, (j / 8) * 64, n0, p.W8out_even, D, tile, SW8, [=](int n) { return n0 + n; }); }
    else if (job < J2) { int j = job - J1; const int n0 = (j % 19) * 128; conv_tile8_rm(p.w_in_odd, IN_ODD, (j / 19) * 64, n0, p.W8in_odd, D, tile, SW8, [=](int n) { return n0 + n; }, O_FA); }
    else { int j = job - J2; const int n0 = (j % 8) * 128; conv_tile8_rm(p.w_out_odd, D, (j / 8) * 64, n0, p.W8out_odd, D, tile, SW8, [=](int n) { return n0 + n; }); }
  }
}

__device__ __forceinline__ void phase_fold_z(const Params& p, long gtid, long gstride, float* tab) {
  if (threadIdx.x < 64) {
    float sn, cs;
    sincospif((float)threadIdx.x * (1.0f / 32.0f), &sn, &cs);
    tab[threadIdx.x] = cs; tab[64 + threadIdx.x] = -sn;
  }
  __syncthreads();
  for (long i = gtid; i < (long)256 * D; i += gstride) {
    const int k = (int)(i % D), col = (int)(i / D);
    const int g = col >> 6, cp = col & 63;
    const float* wz = p.w_in_odd + (long)k * IN_ODD + O_Z + g * 64;
    float s0 = 0.f, s1 = 0.f;
    float4 wv[16];
#pragma unroll
    for (int q = 0; q < 16; ++q) wv[q] = reinterpret_cast<const float4*>(wz)[q];
#pragma unroll
    for (int q = 0; q < 16; ++q) {
      const int i0 = ((4 * q) * cp) & 63, i1 = ((4 * q + 1) * cp) & 63, i2 = ((4 * q + 2) * cp) & 63, i3 = ((4 * q + 3) * cp) & 63;
      s0 += wv[q].x * tab[i0] + wv[q].y * tab[i1] + wv[q].z * tab[i2] + wv[q].w * tab[i3];
      s1 += wv[q].x * tab[64 + i0] + wv[q].y * tab[64 + i1] + wv[q].z * tab[64 + i2] + wv[q].w * tab[64 + i3];
    }
    const unsigned q0 = pack4_fp8(s0 * SW8, s1 * SW8, 0.f, 0.f);
    p.W8in_odd[(long)(O_FA + col) * D + k] = (unsigned char)(q0 & 0xffu);
    p.W8in_odd[(long)(O_FA + 256 + col) * D + k] = (unsigned char)((q0 >> 8) & 0xffu);
  }
  for (long i = gtid; i < (long)(IN_ODD_PAD - O_END) * D; i += gstride) p.W8in_odd[(long)O_END * D + i] = 0;
}

__device__ __forceinline__ void phase_cmat(const Params& p, long gtid, long gstride) {
  for (long i = gtid; i < (long)T * T; i += gstride) {
    const int t = (int)(i % T), tp = (int)(i / T);
    float sn, cs;
    sincospif((float)((t * tp) & (T - 1)) * (2.0f / T), &sn, &cs);
    stA(p.Cmat + (long)tp * 2 * T + t, cs);
    stA(p.Cmat + (long)tp * 2 * T + T + t, sn);
  }
}

__device__ __forceinline__ void row_stats(const float4 (&v)[4], float& mu, float& rs) {
  float s = 0.f;
#pragma unroll
  for (int i = 0; i < 4; ++i) s += v[i].x + v[i].y + v[i].z + v[i].w;
  mu = wave_sum(s) * (1.0f / D);
  float q = 0.f;
#pragma unroll
  for (int i = 0; i < 4; ++i) {
    float a = v[i].x - mu, b = v[i].y - mu, c = v[i].z - mu, d = v[i].w - mu;
    q += a * a + b * b + c * c + d * d;
  }
  rs = 1.0f / sqrtf(wave_sum(q) * (1.0f / D) + LN_EPS);
}

__device__ __forceinline__ void phase_lnmod_first(const Params& p) {
  const int lane = threadIdx.x & 63;
  const int nw = (int)gridDim.x * 4, wi = (int)blockIdx.x * 4 + (int)(threadIdx.x >> 6);
  const int rpw = (NR + nw - 1) / nw;
  const long r0 = (long)wi * rpw, r1 = min((long)NR, r0 + rpw);
  float4 shv[4], scv[4];
  int cur_bb = -2;
  float4 hv[4];
  auto load_row = [&](long row) {
    const float4* h = reinterpret_cast<const float4*>(hrow_in(p, row));
#pragma unroll
    for (int i = 0; i < 4; ++i) hv[i] = h[i * 64 + lane];
  };
  if (r0 < r1) load_row(r0);
  for (long row = r0; row < r1; ++row) {
    const int bb = row < NC ? NB : (int)((row - NC) / T);
    if (bb != cur_bb) {
      cur_bb = bb;
      const float* md = p.mod + (long)bb * 6 * D;
#pragma unroll
      for (int i = 0; i < 4; ++i) {
        shv[i] = reinterpret_cast<const float4*>(md)[i * 64 + lane];
        scv[i] = reinterpret_cast<const float4*>(md + D)[i * 64 + lane];
      }
    }
    float4 v[4];
#pragma unroll
    for (int i = 0; i < 4; ++i) v[i] = hv[i];
    load_row(min(row + 1, r1 - 1));
    float mu, rs;
    row_stats(v, mu, rs);
#pragma unroll
    for (int i = 0; i < 4; ++i) {
      const float a = (v[i].x - mu) * rs * (1.f + scv[i].x) + shv[i].x, b = (v[i].y - mu) * rs * (1.f + scv[i].y) + shv[i].y;
      const float c = (v[i].z - mu) * rs * (1.f + scv[i].z) + shv[i].z, d = (v[i].w - mu) * rs * (1.f + scv[i].w) + shv[i].w;
      reinterpret_cast<unsigned*>(p.u8 + row * D)[i * 64 + lane] = pack4_fp8(a * SU8, b * SU8, c * SU8, d * SU8);
    }
  }
}

__device__ __forceinline__ act_t* hrow16(const Params& p, long row) {
  return row < NC ? reinterpret_cast<act_t*>(p.hc) + row * D
                  : reinterpret_cast<act_t*>(reinterpret_cast<char*>(p.out) + (row - NC) * (long)(4 * D) + 2 * D);
}
template <int R_UNUSED>
__device__ __forceinline__ void phase_resid_ln(const Params& p, int l, int sub, long row_lo, long row_hi, unsigned char* smem) {
  const int lane = threadIdx.x & 63;
  int* cntL = (int*)smem;
  int* nent = cntL + 16;
  int* entL = cntL + 32;
  float* wT = (float*)(smem + 4096);
  if (sub == 0) {
    if (threadIdx.x < 32) cntL[threadIdx.x] = 0;
    {
      float4 wr4[16];
#pragma unroll
      for (int j = 0; j < 4; ++j)
#pragma unroll
        for (int q = 0; q < 4; ++q) wr4[j * 4 + q] = reinterpret_cast<const float4*>(p.w_router + (long)(threadIdx.x + 256 * j) * NEXP)[q];
#pragma unroll
      for (int j = 0; j < 4; ++j)
#pragma unroll
        for (int q = 0; q < 4; ++q) {
          const int k = threadIdx.x + 256 * j;
          wT[(q * 4 + 0) * D + k] = wr4[j * 4 + q].x; wT[(q * 4 + 1) * D + k] = wr4[j * 4 + q].y;
          wT[(q * 4 + 2) * D + k] = wr4[j * 4 + q].z; wT[(q * 4 + 3) * D + k] = wr4[j * 4 + q].w;
        }
    }
    __syncthreads();
  }
  const bool last = (sub == 1 && l == 1);
  const int nw = (int)gridDim.x * 4, wi = (int)blockIdx.x * 4 + (int)(threadIdx.x >> 6);
  const int rpw = ((int)(row_hi - row_lo) + nw - 1) / nw;
  const long r0 = row_lo + (long)wi * rpw, r1 = min(row_hi, r0 + rpw);
  const float4* lgp = reinterpret_cast<const float4*>(p.ln_g + (l * 2 + sub) * D);
  const float4* lbp = reinterpret_cast<const float4*>(p.ln_b + (l * 2 + sub) * D);
  float4 lgv[4], lbv[4];
  if (R_UNUSED != 1) {
#pragma unroll
    for (int i = 0; i < 4; ++i) { lgv[i] = lgp[i * 64 + lane]; lbv[i] = lbp[i * 64 + lane]; }
  }
  float4 gv[4], shv[4], scv[4];
  int cur_bb = -2;
  const bool first = (l == 0 && sub == 0);
  float4 hv[4];
  uint2 hb[4];
  uint2 mv[4], m2v[4];
  auto load_row = [&](long row) {
    const uint2* m = reinterpret_cast<const uint2*>(sub == 0 ? p.M + row * D : p.Y + row * 2 * D);
    if (first) {
      const float4* hin = reinterpret_cast<const float4*>(hrow_in(p, row));
#pragma unroll
      for (int i = 0; i < 4; ++i) hv[i] = hin[i * 64 + lane];
    } else {
      const uint2* hin = reinterpret_cast<const uint2*>(hrow16(p, row));
#pragma unroll
      for (int i = 0; i < 4; ++i) hb[i] = hin[i * 64 + lane];
    }
#pragma unroll
    for (int i = 0; i < 4; ++i) {
      mv[i] = m[i * 64 + lane];
      if (sub == 1) m2v[i] = m[256 + i * 64 + lane];
    }
  };
  if (r0 < r1) load_row(r0);
  for (long row = r0; row < r1; ++row) {
    const int bb = row < NC ? NB : (int)((row - NC) / T);
    if (bb != cur_bb) {
      cur_bb = bb;
      const float* md = p.mod + ((long)l * (NB + 1) + bb) * 6 * D;
      const float* md2 = (sub == 0) ? md + 3 * D : p.mod + ((long)(NB + 1) + bb) * 6 * D;
#pragma unroll
      for (int i = 0; i < 4; ++i) {
        gv[i] = reinterpret_cast<const float4*>(md + (sub == 0 ? 2 : 5) * D)[i * 64 + lane];
        shv[i] = reinterpret_cast<const float4*>(md2)[i * 64 + lane];
        scv[i] = reinterpret_cast<const float4*>(md2 + D)[i * 64 + lane];
      }
    }
    float4 v[4];
#pragma unroll
    for (int i = 0; i < 4; ++i) {
      float m0 = bf_lo(mv[i].x), m1 = bf_hi(mv[i].x), m2_ = bf_lo(mv[i].y), m3 = bf_hi(mv[i].y);
      if (sub == 1) { m0 += bf_lo(m2v[i].x); m1 += bf_hi(m2v[i].x); m2_ += bf_lo(m2v[i].y); m3 += bf_hi(m2v[i].y); }
      const float h0 = first ? hv[i].x : bf_lo(hb[i].x), h1 = first ? hv[i].y : bf_hi(hb[i].x);
      const float h2 = first ? hv[i].z : bf_lo(hb[i].y), h3 = first ? hv[i].w : bf_hi(hb[i].y);
      v[i].x = ALPHA * h0 + gv[i].x * m0;
      v[i].y = ALPHA * h1 + gv[i].y * m1;
      v[i].z = ALPHA * h2 + gv[i].z * m2_;
      v[i].w = ALPHA * h3 + gv[i].w * m3;
    }
    load_row(min(row + 1, r1 - 1));
    if (R_UNUSED == 1) {
#pragma unroll
      for (int i = 0; i < 4; ++i) { lgv[i] = lgp[i * 64 + lane]; lbv[i] = lbp[i * 64 + lane]; }
    }
    float mu, rs;
    row_stats(v, mu, rs);
#pragma unroll
    for (int i = 0; i < 4; ++i) {
      v[i].x = (v[i].x - mu) * rs * lgv[i].x + lbv[i].x;
      v[i].y = (v[i].y - mu) * rs * lgv[i].y + lbv[i].y;
      v[i].z = (v[i].z - mu) * rs * lgv[i].z + lbv[i].z;
      v[i].w = (v[i].w - mu) * rs * lgv[i].w + lbv[i].w;
    }
    if (last) {
      float4* hout = reinterpret_cast<float4*>(p.out + (row - NC) * D);
#pragma unroll
      for (int i = 0; i < 4; ++i) hout[i * 64 + lane] = v[i];
      continue;
    }
    uint2 hq[4];
#pragma unroll
    for (int i = 0; i < 4; ++i) {
      hq[i] = make_uint2(pack2(v[i].x, v[i].y), pack2(v[i].z, v[i].w));
      v[i].x = bf_lo(hq[i].x); v[i].y = bf_hi(hq[i].x); v[i].z = bf_lo(hq[i].y); v[i].w = bf_hi(hq[i].y);
    }
    row_stats(v, mu, rs);
    float lo[NEXP];
#pragma unroll
    for (int e = 0; e < NEXP; ++e) lo[e] = 0.f;
    uint2 up[4];
#pragma unroll
    for (int i = 0; i < 4; ++i) {
      float uv[4];
      uv[0] = (v[i].x - mu) * rs * (1.f + scv[i].x) + shv[i].x;
      uv[1] = (v[i].y - mu) * rs * (1.f + scv[i].y) + shv[i].y;
      uv[2] = (v[i].z - mu) * rs * (1.f + scv[i].z) + shv[i].z;
      uv[3] = (v[i].w - mu) * rs * (1.f + scv[i].w) + shv[i].w;
      up[i] = make_uint2(pack4_fp8(uv[0] * SU8, uv[1] * SU8, uv[2] * SU8, uv[3] * SU8), 0u);
      if (sub == 0) {
#pragma unroll
        for (int e = 0; e < NEXP; ++e) {
          const float4 w4 = *reinterpret_cast<const float4*>(wT + e * D + (i * 64 + lane) * 4);
          lo[e] += uv[0] * w4.x + uv[1] * w4.y + uv[2] * w4.z + uv[3] * w4.w;
          if ((e & 3) == 3) __builtin_amdgcn_sched_barrier(0);
        }
      }
    }
    int ge1 = 0, ge2 = 0;
    float w1 = 0.f, w2 = 0.f;
    if (sub == 0) {
      float mine = 0.f;
#pragma unroll
      for (int e = 0; e < NEXP; ++e) {
        const float rsum = row_sum16(lo[e]);
        mine = ((lane & 15) == e) ? rsum : mine;
      }
      mine += __shfl_xor(mine, 16);
      mine += __shfl_xor(mine, 32);
#pragma unroll
      for (int e = 0; e < NEXP; ++e) lo[e] = __int_as_float(__builtin_amdgcn_readlane(__float_as_int(mine), e));
      float mx = lo[0];
#pragma unroll
      for (int e = 1; e < NEXP; ++e) mx = fmaxf(mx, lo[e]);
      float sum = 0.f;
#pragma unroll
      for (int e = 0; e < NEXP; ++e) { lo[e] = __expf(lo[e] - mx); sum += lo[e]; }
      const float inv = 1.0f / sum;
      float bestg = -1e30f, gp1 = 0.f, gp2 = 0.f;
#pragma unroll
      for (int gq = 0; gq < 4; ++gq) {
        float s1 = -1e30f, s2 = -1e30f, p1 = 0.f, p2 = 0.f;
        int e1 = 0, e2 = 0;
#pragma unroll
        for (int j = 0; j < 4; ++j) {
          const int e = gq * 4 + j;
          const float pe = lo[e] * inv;
          const float se = pe + p.b_router[e];
          if (se > s1) { s2 = s1; p2 = p1; e2 = e1; s1 = se; p1 = pe; e1 = e; }
          else if (se > s2) { s2 = se; p2 = pe; e2 = e; }
        }
        const float gs = s1 + s2;
        if (gs > bestg) { bestg = gs; ge1 = e1; ge2 = e2; gp1 = p1; gp2 = p2; }
      }
      const float wsum = gp1 + gp2;
      w1 = gp1 / wsum; w2 = gp2 / wsum;
    }
    {
      uint2* hout = reinterpret_cast<uint2*>(hrow16(p, row));
#pragma unroll
      for (int i = 0; i < 4; ++i) hout[i * 64 + lane] = hq[i];
    }
#pragma unroll
    for (int i = 0; i < 4; ++i) reinterpret_cast<unsigned*>(p.u8 + row * D)[i * 64 + lane] = up[i].x;
    if (sub == 0 && lane == 0) {
      p.ew[row * 2 + 0] = w1; p.ew[row * 2 + 1] = w2;
      const int lp1 = atomicAdd(cntL + ge1, 1), lp2 = atomicAdd(cntL + ge2, 1);
      const int ei = atomicAdd(nent, 2);
      entL[2 * ei] = ((int)(row * 2) << 4) | ge1; entL[2 * ei + 1] = lp1;
      entL[2 * ei + 2] = ((int)(row * 2 + 1) << 4) | ge2; entL[2 * ei + 3] = lp2;
    }
  }
  if (sub == 0) {
    __syncthreads();
    if (threadIdx.x < NEXP) {
      const int c = cntL[threadIdx.x];
      cntL[threadIdx.x] = c ? atomicAdd(p.cnt + (l * NEXP + threadIdx.x) * 64, c) : 0;
    }
    __syncthreads();
    const int ne = *nent;
    for (int i = threadIdx.x; i < ne; i += 256) {
      const int key = entL[2 * i], lp = entL[2 * i + 1];
      const int e = key & 15;
      p.list[(long)(l * NEXP + e) * NR + cntL[e] + lp] = key >> 4;
    }
    __syncthreads();
  }
}

#define LOOP(n) for (long i = gtid; i < (long)(n); i += gstride)

#ifdef ONLY_PHASE
#define PH(n, ...) if (ONLY_PHASE == n) { __VA_ARGS__ }
#define GSYNC()
#else
#define PH(n, ...) { __VA_ARGS__ }
#define GSYNC() xcd_barrier(xb)
#endif

__global__ void __launch_bounds__(256, 2) mega_kernel(Params p) {
  cg::grid_group grid = cg::this_grid();
  __shared__ __attribute__((aligned(16))) unsigned char smem[SMEM_BYTES + 16];
  if (threadIdx.x == 0) *reinterpret_cast<uint4*>(smem + SMEM_BYTES) = make_uint4(0u, 0u, 0u, 0u);
  __syncthreads();
  XcdBarrier xb = xcd_barrier_post(p.bar, (volatile LAS unsigned*)(smem + SMEM_BYTES));
  const long gtid = (long)blockIdx.x * blockDim.x + threadIdx.x;
  const long gstride = (long)gridDim.x * blockDim.x;
  const int nsb = min(256, (int)gridDim.x / 2);
  PH(0,
    if (gtid < 2 * NEXP) p.cnt[gtid * 64] = 0;
    phase_convert_dense(p, smem);
    phase_fold_z(p, gtid, gstride, (float*)(smem + 65536));
    LOOP(1024) ph_tables(p, i);)
#ifndef ONLY_PHASE
  if (p.use_cg_sync) grid.sync();
#endif
  GSYNC();
  PH(1, phase_lnmod_first(p);)
  GSYNC();
  PH(2, phase_gemm(p, GemmJob{(const act_t*)p.u8, (const act_t*)p.W8in_even, p.P, 0, 0, 0, 1, NR / 128, IN_EVEN / 128, D, PW, IN_EVEN, 2, 1.0f / (SU8 * SW8), 1, 0}, smem);)
  GSYNC();
  PH(3,
    if ((int)blockIdx.x < nsb) phase_scan<0>(p, smem, blockIdx.x, nsb);
    else phase_attn(p, smem, blockIdx.x - nsb, gridDim.x - nsb);)
  GSYNC();
  PH(4, phase_combine<0>(p);)
  GSYNC();
  PH(5,
    phase_gemm(p, GemmJob{(const act_t*)p.O8, (const act_t*)p.W8out_even, p.M, 0, 0, 0, 1, NR / 128, D / 128, D, D, D, 0, 1.0f / (SO8 * SW8), 1, 0}, smem);
    {
      const int rem = ((NR / 128) * (D / 128)) % (int)gridDim.x;
      if (rem > 0 && rem < (int)gridDim.x) { if ((int)blockIdx.x >= rem) phase_convert_experts(p, 0, smem, blockIdx.x - rem, gridDim.x - rem); }
      else phase_convert_experts(p, 0, smem, blockIdx.x, gridDim.x);
    })
  GSYNC();
  PH(6, phase_resid_ln<1>(p, 0, 0, 0, NR, smem);)
  GSYNC();
  PH(7, phase_moe(p, 0, false, smem);)
  GSYNC();
  PH(8, phase_moe(p, 0, true, smem);)
  GSYNC();
  PH(9, phase_resid_ln<2>(p, 0, 1, 0, NR, smem); phase_cmat(p, gtid, gstride);)
  GSYNC();
  PH(10, phase_gemm(p, GemmJob{(const act_t*)p.u8, (const act_t*)p.W8in_odd, p.P, 0, 0, 0, 1, NR / 128, IN_ODD_PAD / 128, D, PW, O_FA, 1, 1.0f / (SU8 * SW8), 1, 0}, smem);)
  GSYNC();
  PH(11, phase_gla_decay(p);)
  GSYNC();
  PH(12,
    if ((int)blockIdx.x < nsb) phase_scan<1>(p, smem, blockIdx.x, nsb);
    else {
      phase_gemm(p, GemmJob{p.Cmat, p.FT, (act_t*)(p.O8 + (long)NC * D + 768), 0, (long)256 * 2 * T, (long)T * D, NB, T / 128, 2, 2 * T, D,
                            256, 0, 0.00276213586400995f * SO8, 0, 1}, smem, blockIdx.x - nsb, gridDim.x - nsb);
      phase_convert_experts(p, 1, smem, blockIdx.x - nsb, gridDim.x - nsb);
    })
  GSYNC();
  PH(13, phase_combine<1>(p);)
  GSYNC();
  PH(14,
    phase_gemm(p, GemmJob{(const act_t*)(p.O8 + (long)NC * D), (const act_t*)p.W8out_odd, p.M + (long)NC * D, 0, 0, 0, 1, NT / 128, D / 128, D, D, D, 0, 1.0f / (SO8 * SW8), 1, 0}, smem);)
  GSYNC();
  PH(15, phase_resid_ln<1>(p, 1, 0, NC, NR, smem);)
  GSYNC();
  PH(16, phase_moe(p, 1, false, smem);)
  GSYNC();
  PH(17, phase_moe(p, 1, true, smem);)
  GSYNC();
  PH(18, phase_resid_ln<2>(p, 1, 1, NC, NR, smem);)
}

static size_t carve(Params& p, char* ws) {
  size_t off = 0;
  auto take = [&](size_t bytes) { char* r = ws + off; off += (bytes + 255) & ~(size_t)255; return r; };
  p.mod = (float*)take(sizeof(float) * 2 * (NB + 1) * 6 * D);
  p.bar = (unsigned*)take(sizeof(unsigned) * XCD_BAR_WORDS);
  p.hc = (float*)take(sizeof(float) * (size_t)NC * D);
  p.costab = (float*)take(sizeof(float) * T);
  p.sintab = (float*)take(sizeof(float) * T);
  p.lbt = (float*)take(sizeof(float) * 1024);
  p.ropetab = (float*)take(sizeof(float) * 64 * 16 * 2);
  p.ew = (float*)take(sizeof(float) * (size_t)NR * 2);
  p.eidx = nullptr;
  p.u = nullptr;
  p.O8 = (unsigned char*)take((size_t)NR * D);
  p.P = (act_t*)take(sizeof(act_t) * (size_t)NR * PW);
  p.OF = (act_t*)take(sizeof(act_t) * (size_t)NR * 768);
  p.OB = (act_t*)take(sizeof(act_t) * (size_t)NR * 768);
  p.M = p.OF;
  p.Cmat = (act_t*)take(sizeof(act_t) * (size_t)T * 2 * T);
  p.FT = (act_t*)take(sizeof(act_t) * (size_t)NB * 256 * 2 * T);
  p.LF = (act_t*)take(sizeof(act_t) * (size_t)2 * NR * 384);
  p.W8up = (unsigned char*)p.Cmat;
  p.W8down = p.W8up + (size_t)NEXP * 1024 * D;
  p.W8up1 = (unsigned char*)take((size_t)NEXP * 1024 * (D + DFF));
  p.W8down1 = p.W8up1 + (size_t)NEXP * 1024 * D;
  p.u8 = (unsigned char*)take((size_t)NR * D);
  p.Y = p.P;
  p.H8 = (unsigned char*)(p.P + (size_t)2 * NR * D);
  p.cnt = (int*)take(sizeof(int) * 2 * NEXP * 64);
  p.list = (int*)take(sizeof(int) * (size_t)2 * NEXP * NR);
  p.Wt_in_even = nullptr;
  p.W8in_even = (unsigned char*)take((size_t)IN_EVEN * D);
  p.Wt_out_even = nullptr;
  p.W8out_even = (unsigned char*)take((size_t)D * D);
  p.Wt_in_odd = nullptr;
  p.W8in_odd = (unsigned char*)take((size_t)IN_ODD_PAD * D);
  p.Wt_out_odd = nullptr;
  p.W8out_odd = (unsigned char*)take((size_t)D * D);
  return off;
}

static void fill_inputs(Params& p, void* const* d_in) {
  const float** f = (const float**)&p;
  for (int i = 0; i < 23; ++i) f[i] = (const float*)d_in[i];
}

extern "C" void kernel_launch(void* const* d_in, const int* in_sizes, int n_in, void* d_out, int out_size,
                              void* d_ws, size_t ws_size, hipStream_t stream) {
  static int grid_blocks = 0;
  if (!grid_blocks) {
    int dev = 0, cus = 0, per_cu = 0;
    (void)hipGetDevice(&dev);
    (void)hipDeviceGetAttribute(&cus, hipDeviceAttributeMultiprocessorCount, dev);
    (void)hipOccupancyMaxActiveBlocksPerMultiprocessor(&per_cu, mega_kernel, 256, 0);
    grid_blocks = cus * per_cu;
  }
  Params p{};
  fill_inputs(p, d_in);
  p.out = (float*)d_out;
  size_t need = carve(p, (char*)d_ws);
  if (need > ws_size) { fprintf(stderr, "workspace too small: need %zu have %zu\n", need, ws_size); return; }
  (void)hipMemsetAsync(p.mod, 0, (size_t)((char*)(p.bar + XCD_BAR_WORDS) - (char*)p.mod), stream);
  void* args[] = {&p};
  hipError_t e = hipLaunchCooperativeKernel((void*)mega_kernel, dim3(grid_blocks), dim3(256), args, 0, stream);
  if (e != hipSuccess) fprintf(stderr, "cooperative launch failed: %s (grid %d)\n", hipGetErrorString(e), grid_blocks);
}
#endif
```

```cpp
#ifndef HOST_TEST
#include <hip/hip_runtime.h>
#include <hip/hip_cooperative_groups.h>
#include <cstdio>
namespace cg = cooperative_groups;
#define DEV __device__ __forceinline__
#else
#include <cmath>
#include <cstdio>
#include <cstdlib>
#include <cstring>
#define DEV static inline
#endif

#ifndef T_BATCH
#define T_BATCH 8
#endif
#ifndef T_SEQ
#define T_SEQ 2048
#endif
#ifndef T_CTX
#define T_CTX 256
#endif

constexpr int D = 1024, NB = T_BATCH, T = T_SEQ, C = T_CTX;
constexpr int NC = NB * C, NT = NB * T, NR = NC + NT;
constexpr int GRID_W = 64;
constexpr int IN_EVEN = 3328, IN_ODD = 2592, PW = 3328;
constexpr int NEXP = 16, DFF = 512;
constexpr float ALPHA = 1.4142135623730951f;
constexpr float LN_EPS = 1e-5f;
constexpr int E_AQ = 0, E_AK = 512, E_AV = 640, E_FF = 768, E_HQ = 1792, E_HI = 2304, E_HG = 2816;
constexpr int O_Q = 0, O_K = 384, O_V = 768, O_RF = 1536, O_G = 1568, O_Z = 2336;

#ifdef HOST_TEST
typedef float act_t;
DEV float ldA(const act_t* p) { return *p; }
DEV void stA(act_t* p, float v) { *p = v; }
#else
typedef unsigned short act_t;
DEV float ldA(const act_t* p) { return __uint_as_float(((unsigned)*p) << 16); }
DEV void stA(act_t* p, float v) {
  unsigned u = __float_as_uint(v);
  u += 0x7fffu + ((u >> 16) & 1u);
  *p = (unsigned short)(u >> 16);
}
#endif

struct Params {
  const float *x, *c, *ctx, *c_ctx, *w_ada, *b_ada, *ln_g, *ln_b, *w_in_even, *attn_sink, *lb_logits, *hgrn_norm,
      *w_out_even, *w_in_odd, *gla_gate_w, *gla_gate_b, *gla_norm, *w_out_odd, *w_router, *b_router, *w_eg, *w_eu,
      *w_ed;
  float* out;
  float *mod, *hc, *costab, *sintab, *lbt, *ew, *ropetab;
  int* eidx;
  act_t *u, *P, *OF, *OB, *M, *LF;
  act_t *Wt_in_even, *Wt_out_even, *Wt_in_odd, *Wt_out_odd;
  act_t *Y, *Cmat, *FT;
  unsigned char *W8up, *W8down, *W8up1, *W8down1, *H8, *u8;
  unsigned char *W8in_even, *W8in_odd;
  unsigned char *W8out_even, *W8out_odd, *O8;
  int *cnt, *list;
  unsigned* bar;
  int use_cg_sync;
  int pad_;
};

DEV float sigmoidf_(float v) { return 1.0f / (1.0f + expf(-v)); }
DEV float siluf_(float v) { return v / (1.0f + expf(-v)); }

DEV const float* hrow_in(const Params& p, long row) {
  return row < NC ? p.ctx + row * D : p.x + (row - NC) * D;
}
DEV float* hrow(const Params& p, long row) { return row < NC ? p.hc + row * D : p.out + (row - NC) * D; }
DEV const float* modrow(const Params& p, int l, long row) {
  int bb = row < NC ? NB : (int)((row - NC) / T);
  return p.mod + ((long)l * (NB + 1) + bb) * 6 * D;
}

DEV void ph_mod(const Params& p, long i) {
  int j = (int)(i % (6 * D));
  int bb = (int)((i / (6 * D)) % (NB + 1));
  int l = (int)(i / ((long)6 * D * (NB + 1)));
  const float* cv = bb < NB ? p.c + (long)bb * D : p.c_ctx;
  const float* w = p.w_ada + (long)l * D * 6 * D + j;
  float s = p.b_ada[l * 6 * D + j];
  for (int k = 0; k < D; ++k) s += siluf_(cv[k]) * w[(long)k * 6 * D];
  p.mod[i] = s;
}

DEV void ph_tables(const Params& p, long i) {
  if (i < 1024) {
    int pos = (int)(i >> 4), idx = (int)(i & 15);
    float ang = (float)pos * powf(10000.0f, -(float)idx / 16.0f);
    p.ropetab[2 * i] = cosf(ang);
    p.ropetab[2 * i + 1] = sinf(ang);
  }
  if (i < 1024) {
    int dir = (int)(i / 512), col = (int)(i % 512);
    float l0 = p.lb_logits[(dir * 2 + 0) * 512 + col], l1 = p.lb_logits[(dir * 2 + 1) * 512 + col];
    p.lbt[i] = 1.0f / (1.0f + expf(l1 - l0));
  }
}

DEV void ln_mod_row(const float* h, const float* shift, const float* scale, act_t* u) {
  float mu = 0.f;
  for (int k = 0; k < D; ++k) mu += h[k];
  mu *= (1.0f / D);
  float var = 0.f;
  for (int k = 0; k < D; ++k) { float d = h[k] - mu; var += d * d; }
  var *= (1.0f / D);
  float rs = 1.0f / sqrtf(var + LN_EPS);
  for (int k = 0; k < D; ++k) stA(u + k, (h[k] - mu) * rs * (1.0f + scale[k]) + shift[k]);
}

DEV void ph_lnmod_first(const Params& p, long row) {
  const float* m = modrow(p, 0, row);
  ln_mod_row(hrow_in(p, row), m, m + D, p.u + row * D);
}

DEV void gemm_item_act(const act_t* A, const float* W, act_t* Cout, int K, int N, int ldc, long i) {
  int n4 = (int)(i % (N / 4));
  long row = i / (N / 4);
  const act_t* a = A + row * K;
  const float* w = W + n4 * 4;
  float s0 = 0, s1 = 0, s2 = 0, s3 = 0;
  for (int k = 0; k < K; ++k) {
    float av = ldA(a + k);
    const float* wr = w + (long)k * N;
    s0 += av * wr[0]; s1 += av * wr[1]; s2 += av * wr[2]; s3 += av * wr[3];
  }
  act_t* o = Cout + row * ldc + n4 * 4;
  stA(o, s0); stA(o + 1, s1); stA(o + 2, s2); stA(o + 3, s3);
}

DEV void ph_rope(const Params& p, long i) {
  int pr = (int)(i % 32);
  int hh = (int)((i / 32) % 10);
  long lr = i / 320;
  int t = (int)(lr % T);
  int col = hh < 8 ? E_AQ + hh * 64 : E_AK + (hh - 8) * 64;
  int idx = pr & 15;
  int pos = pr < 16 ? t / GRID_W : t % GRID_W;
  int d0 = pr < 16 ? idx : 32 + idx;
  float inv = powf(10000.0f, -(float)idx / 16.0f);
  float ang = (float)pos * inv;
  float cs = cosf(ang), sn = sinf(ang);
  act_t* base = p.P + (NC + lr) * PW + col;
  float x1 = ldA(base + d0), x2 = ldA(base + d0 + 16);
  stA(base + d0, x1 * cs - x2 * sn);
  stA(base + d0 + 16, x1 * sn + x2 * cs);
}

DEV void ph_attn(const Params& p, long i) {
  int h = (int)(i % 8);
  long row = i / 8;
  int kv = h / 4;
  bool lat = row >= NC;
  int b = lat ? (int)((row - NC) / T) : (int)(row / C);
  int t = lat ? (int)((row - NC) % T) : 0;
  float q[64], acc[64];
  const act_t* qp = p.P + row * PW + E_AQ + h * 64;
#pragma unroll
  for (int d = 0; d < 64; ++d) { q[d] = ldA(qp + d) * 0.125f; acc[d] = 0.f; }
  float m = p.attn_sink[h], l = 1.0f;
  int nkeys = C + (lat ? 257 : 0);
  for (int j = 0; j < nkeys; ++j) {
    long krow;
    if (j < C) krow = (long)b * C + j;
    else {
      int kp = t - 128 + (j - C);
      if (kp < 0 || kp >= T) continue;
      krow = NC + (long)b * T + kp;
    }
    const act_t* kptr = p.P + krow * PW + E_AK + kv * 64;
    const act_t* vptr = p.P + krow * PW + E_AV + kv * 64;
    float s = 0.f;
#pragma unroll
    for (int d = 0; d < 64; ++d) s += q[d] * ldA(kptr + d);
    float mn = fmaxf(m, s);
    float sc = expf(m - mn), pj = expf(s - mn);
    l = l * sc + pj;
#pragma unroll
    for (int d = 0; d < 64; ++d) acc[d] = acc[d] * sc + pj * ldA(vptr + d);
    m = mn;
  }
  float il = 1.0f / l;
  act_t* o = p.u + row * D + h * 64;
#pragma unroll
  for (int d = 0; d < 64; ++d) stA(o + d, acc[d] * il);
}

template <int MODE>
DEV void ph_scan(const Params& p, long i) {
  constexpr int DK = MODE == 0 ? 128 : 96;
  constexpr int DV = MODE == 0 ? 128 : 192;
  int e = (int)(i % DV);
  int dir = (int)((i / DV) % 2);
  int h = (int)((i / (2 * DV)) % 4);
  int b = (int)(i / (8 * DV));
  float S[DK];
#pragma unroll
  for (int d = 0; d < DK; ++d) S[d] = 0.f;
  act_t* OD = dir == 0 ? p.OF : p.OB;
  for (int step = 0; step < C + T; ++step) {
    long row;
    if (step < C) row = (long)b * C + (dir == 0 ? step : C - 1 - step);
    else { int tt = step - C; row = NC + (long)b * T + (dir == 0 ? tt : T - 1 - tt); }
    const act_t* pr = p.P + row * PW;
    float o = 0.f;
    if (MODE == 0) {
      float v = ldA(pr + E_HI + h * 128 + e);
      const act_t* zp = pr + E_FF + dir * 512 + h * 128;
      const act_t* qp = pr + E_HQ + h * 128;
      const float* lb = p.lbt + dir * 512 + h * 128;
#pragma unroll
      for (int d = 0; d < DK; ++d) {
        float f = lb[d] + (1.0f - lb[d]) * sigmoidf_(ldA(zp + d));
        S[d] = f * S[d] + (1.0f - f) * v;
        o += ldA(qp + d) * S[d];
      }
      stA(OD + row * 768 + h * 128 + e, o);
    } else {
      float v = ldA(pr + O_V + h * 192 + e);
      const act_t* kp = pr + O_K + h * 96;
      const act_t* qp = pr + O_Q + h * 96;
      const act_t* lf = p.LF + ((long)dir * NR + row) * 384 + h * 96;
#pragma unroll
      for (int d = 0; d < DK; ++d) {
        float f = expf(ldA(lf + d));
        S[d] = f * S[d] + ldA(kp + d) * v;
        o += ldA(qp + d) * S[d];
      }
      stA(OD + row * 768 + h * 192 + e, o * 0.10206207261596575f);
    }
  }
}

template <int MODE>
DEV void ph_combine(const Params& p, long i) {
  constexpr int DV = MODE == 0 ? 128 : 192;
  int h = (int)(i % 4);
  long row = (MODE == 0) ? i / 4 : NC + i / 4;
  const act_t* f = p.OF + row * 768 + h * DV;
  const act_t* bk = p.OB + row * 768 + h * DV;
  float ss = 0.f;
  for (int e = 0; e < DV; ++e) { float o = ldA(f + e) + ldA(bk + e); ss += o * o; }
  float r = 1.0f / sqrtf(ss / DV + LN_EPS);
  const float* gn = (MODE == 0 ? p.hgrn_norm : p.gla_norm) + h * DV;
  const act_t* g = p.P + row * PW + (MODE == 0 ? E_HG : O_G) + h * DV;
  act_t* o = p.u + row * D + (MODE == 0 ? 512 : 0) + h * DV;
  for (int e = 0; e < DV; ++e) stA(o + e, (ldA(f + e) + ldA(bk + e)) * r * gn[e] * siluf_(ldA(g + e)));
}

DEV void ph_gla_decay(const Params& p, long i) {
  int col = (int)(i % 384);
  long row = (i / 384) % NR;
  int dir = (int)(i / ((long)384 * NR));
  const act_t* r = p.P + row * PW + O_RF + dir * 16;
  const float* gw = p.gla_gate_w + (long)dir * 16 * 384 + col;
  float z = p.gla_gate_b[dir * 384 + col];
  for (int k = 0; k < 16; ++k) z += ldA(r + k) * gw[k * 384];
  float ls = fminf(z, 0.f) - log1pf(expf(-fabsf(z)));
  stA(p.LF + ((long)dir * NR + row) * 384 + col, ls * (1.0f / 16.0f));
}

DEV void ph_resid_ln(const Params& p, long row, int l, int sub) {
  const float* hin = (l == 0 && sub == 0) ? hrow_in(p, row) : hrow(p, row);
  float* hout = hrow(p, row);
  const float* md = modrow(p, l, row);
  const float* g = md + (sub == 0 ? 2 : 5) * D;
  const act_t* m = p.M + row * D;
  const float* lg = p.ln_g + (l * 2 + sub) * D;
  const float* lb = p.ln_b + (l * 2 + sub) * D;
  float mu = 0.f;
  for (int k = 0; k < D; ++k) mu += ALPHA * hin[k] + g[k] * ldA(m + k);
  mu *= (1.0f / D);
  float var = 0.f;
  for (int k = 0; k < D; ++k) { float d = ALPHA * hin[k] + g[k] * ldA(m + k) - mu; var += d * d; }
  var *= (1.0f / D);
  float rs = 1.0f / sqrtf(var + LN_EPS);
  for (int k = 0; k < D; ++k) hout[k] = (ALPHA * hin[k] + g[k] * ldA(m + k) - mu) * rs * lg[k] + lb[k];
  if (sub == 1 && l == 1) return;
  const float* md2 = (sub == 0) ? md + 3 * D : modrow(p, 1, row);
  float mu2 = 0.f;
  for (int k = 0; k < D; ++k) mu2 += hout[k];
  mu2 *= (1.0f / D);
  float var2 = 0.f;
  for (int k = 0; k < D; ++k) { float d = hout[k] - mu2; var2 += d * d; }
  var2 *= (1.0f / D);
  float rs2 = 1.0f / sqrtf(var2 + LN_EPS);
  float lo[NEXP];
#pragma unroll
  for (int e = 0; e < NEXP; ++e) lo[e] = 0.f;
  for (int k = 0; k < D; ++k) {
    float uv = (hout[k] - mu2) * rs2 * (1.0f + md2[D + k]) + md2[k];
    stA(p.u + row * D + k, uv);
    if (sub == 0) {
      const float* wr = p.w_router + k * NEXP;
#pragma unroll
      for (int e = 0; e < NEXP; ++e) lo[e] += uv * wr[e];
    }
  }
  if (sub != 0) return;
  float mx = lo[0];
#pragma unroll
  for (int e = 1; e < NEXP; ++e) mx = fmaxf(mx, lo[e]);
  float sum = 0.f;
#pragma unroll
  for (int e = 0; e < NEXP; ++e) { lo[e] = expf(lo[e] - mx); sum += lo[e]; }
  float inv = 1.0f / sum;
  float bestg = -1e30f; int bg = 0;
  float gi1 = 0, gi2 = 0; int ge1 = 0, ge2 = 0;
  float gp1 = 0, gp2 = 0;
#pragma unroll
  for (int gq = 0; gq < 4; ++gq) {
    float s1 = -1e30f, s2 = -1e30f, p1 = 0, p2 = 0; int e1 = 0, e2 = 0;
#pragma unroll
    for (int j = 0; j < 4; ++j) {
      int e = gq * 4 + j;
      float pe = lo[e] * inv;
      float se = pe + p.b_router[e];
      if (se > s1) { s2 = s1; p2 = p1; e2 = e1; s1 = se; p1 = pe; e1 = e; }
      else if (se > s2) { s2 = se; p2 = pe; e2 = e; }
    }
    float gs = s1 + s2;
    if (gs > bestg) { bestg = gs; bg = gq; gi1 = s1; gi2 = s2; ge1 = e1; ge2 = e2; gp1 = p1; gp2 = p2; }
  }
  (void)bg; (void)gi1; (void)gi2;
  float wsum = gp1 + gp2;
  p.eidx[row * 2 + 0] = ge1; p.eidx[row * 2 + 1] = ge2;
  p.ew[row * 2 + 0] = gp1 / wsum; p.ew[row * 2 + 1] = gp2 / wsum;
}

DEV void ph_moe_up(const Params& p, long i, int l, long row0) {
  int f4 = (int)(i % (DFF / 4));
  int slot = (int)((i / (DFF / 4)) % 2);
  long row = row0 + i / (DFF / 2);
  int e = p.eidx[row * 2 + slot];
  const float* w1 = p.w_eg + ((long)(l * NEXP + e) * D) * DFF + f4 * 4;
  const float* w3 = p.w_eu + ((long)(l * NEXP + e) * D) * DFF + f4 * 4;
  const act_t* a = p.u + row * D;
  float g0 = 0, g1 = 0, g2 = 0, g3 = 0, u0 = 0, u1 = 0, u2 = 0, u3 = 0;
  for (int k = 0; k < D; ++k) {
    float av = ldA(a + k);
    const float* r1 = w1 + (long)k * DFF;
    const float* r3 = w3 + (long)k * DFF;
    g0 += av * r1[0]; g1 += av * r1[1]; g2 += av * r1[2]; g3 += av * r1[3];
    u0 += av * r3[0]; u1 += av * r3[1]; u2 += av * r3[2]; u3 += av * r3[3];
  }
  act_t* hb = p.P + (row * 2 + slot) * DFF + f4 * 4;
  stA(hb, siluf_(g0) * u0); stA(hb + 1, siluf_(g1) * u1); stA(hb + 2, siluf_(g2) * u2); stA(hb + 3, siluf_(g3) * u3);
}

DEV void ph_moe_down(const Params& p, long i, int l, long row0) {
  int j4 = (int)(i % (D / 4));
  long row = row0 + i / (D / 4);
  float y0 = 0, y1 = 0, y2 = 0, y3 = 0;
  for (int slot = 0; slot < 2; ++slot) {
    int e = p.eidx[row * 2 + slot];
    float wgt = p.ew[row * 2 + slot];
    const float* w2 = p.w_ed + ((long)(l * NEXP + e) * DFF) * D + j4 * 4;
    const act_t* hb = p.P + (row * 2 + slot) * DFF;
    float s0 = 0, s1 = 0, s2 = 0, s3 = 0;
    for (int f = 0; f < DFF; ++f) {
      float hv = ldA(hb + f);
      const float* r = w2 + (long)f * D;
      s0 += hv * r[0]; s1 += hv * r[1]; s2 += hv * r[2]; s3 += hv * r[3];
    }
    y0 += wgt * s0; y1 += wgt * s1; y2 += wgt * s2; y3 += wgt * s3;
  }
  act_t* o = p.M + row * D + j4 * 4;
  stA(o, y0); stA(o + 1, y1); stA(o + 2, y2); stA(o + 3, y3);
}


#ifndef HOST_TEST
typedef __attribute__((ext_vector_type(8))) short bf16x8;
typedef __attribute__((ext_vector_type(4))) float f32x4;
constexpr int SMEM_BYTES = 71680;
constexpr int IN_ODD_PAD = 2944;
constexpr int O_FA = 2336, O_FB = 2592, O_END = 2848;

typedef float f32x2_t __attribute__((ext_vector_type(2)));
typedef __bf16 bf16x2_t __attribute__((ext_vector_type(2)));
__device__ __forceinline__ unsigned pack2(float a, float b) {
  const f32x2_t v = {a, b};
  return __builtin_bit_cast(unsigned, __builtin_convertvector(v, bf16x2_t));
}
__device__ __forceinline__ unsigned pack2_mfma(float a, float b) { return pack2(a, b); }
typedef __attribute__((ext_vector_type(2))) unsigned u32x2;
__device__ __forceinline__ float xor16_max(float x) {
  const u32x2 r = __builtin_amdgcn_permlane16_swap(__float_as_uint(x), __float_as_uint(x), false, false);
  return fmaxf(__uint_as_float(r.x), __uint_as_float(r.y));
}
__device__ __forceinline__ float xor32_max(float x) {
  const u32x2 r = __builtin_amdgcn_permlane32_swap(__float_as_uint(x), __float_as_uint(x), false, false);
  return fmaxf(__uint_as_float(r.x), __uint_as_float(r.y));
}
__device__ __forceinline__ float xor16_add(float x) {
  const u32x2 r = __builtin_amdgcn_permlane16_swap(__float_as_uint(x), __float_as_uint(x), false, false);
  return __uint_as_float(r.x) + __uint_as_float(r.y);
}
__device__ __forceinline__ float xor32_add(float x) {
  const u32x2 r = __builtin_amdgcn_permlane32_swap(__float_as_uint(x), __float_as_uint(x), false, false);
  return __uint_as_float(r.x) + __uint_as_float(r.y);
}
__device__ __forceinline__ float bf_lo(unsigned u) { return __uint_as_float(u << 16); }
__device__ __forceinline__ float bf_hi(unsigned u) { return __uint_as_float(u & 0xffff0000u); }
template <int CTRL>
__device__ __forceinline__ float dpp_mov(float v) {
  return __int_as_float(__builtin_amdgcn_update_dpp(0, __float_as_int(v), CTRL, 0xf, 0xf, true));
}
__device__ __forceinline__ float row_sum16(float v) {
  v += dpp_mov<0xB1>(v);
  v += dpp_mov<0x4E>(v);
  v += dpp_mov<0x141>(v);
  v += dpp_mov<0x140>(v);
  return v;
}
__device__ __forceinline__ float wave_sum(float v) {
  v = row_sum16(v);
  const float a = __int_as_float(__builtin_amdgcn_readlane(__float_as_int(v), 0));
  const float b = __int_as_float(__builtin_amdgcn_readlane(__float_as_int(v), 16));
  const float c = __int_as_float(__builtin_amdgcn_readlane(__float_as_int(v), 32));
  const float d = __int_as_float(__builtin_amdgcn_readlane(__float_as_int(v), 48));
  return (a + b) + (c + d);
}


#define XB_TMO      128
#define XB_XCNT(j)  (256  + 64 * (j))
#define XB_XSUB(j)  (1280 + 64 * (j))
#define XB_XGEN(j)  (2304 + 64 * (j))
#define XB_TOP      3328
#define XB_TOPGEN   3392
#define XCD_BAR_WORDS 3456
#define XB_SPIN_CAP (1u << 18)
#define LAS __attribute__((address_space(3)))
__device__ __forceinline__ unsigned xb_ld(unsigned* p)              { return __hip_atomic_load(p, __ATOMIC_RELAXED, __HIP_MEMORY_SCOPE_AGENT); }
__device__ __forceinline__ unsigned xb_add(unsigned* p, unsigned v) { return __hip_atomic_fetch_add(p, v, __ATOMIC_RELAXED, __HIP_MEMORY_SCOPE_AGENT); }
__device__ __forceinline__ unsigned xb_xcc_id() { return (unsigned)__builtin_amdgcn_s_getreg((3 << 11) | 20) & 0xFu; }
#define XB_SPIN(cond, bar) do { unsigned _sp = 0; while (cond) { __builtin_amdgcn_s_sleep(1); \
    if ((++_sp & 255u) == 0u) { if (xb_ld(&(bar)[XB_TMO])) break; if (_sp > XB_SPIN_CAP) { atomicAdd(&(bar)[XB_TMO], 1u); break; } } } } while (0)
struct XcdBarrier { unsigned* bar; unsigned x; volatile LAS unsigned* st; };
__device__ __forceinline__ XcdBarrier xcd_barrier_post(unsigned* bar, volatile LAS unsigned* st) {
    XcdBarrier b; b.bar = bar; b.x = xb_xcc_id(); b.st = st;
    if (threadIdx.x == 0) (void)xb_add(&bar[XB_XCNT(b.x)], 1u);
    return b;
}
__device__ __forceinline__ void xcd_barrier_complete(unsigned* bar, unsigned x, unsigned& nloc, unsigned& nx) {
    const unsigned G = gridDim.x * gridDim.y * gridDim.z;
    unsigned sum, cnt, mine, sp = 0u;
    for (;;) {
        sum = 0u; cnt = 0u; mine = 0u;
#pragma unroll
        for (unsigned j = 0; j < 16; ++j) { const unsigned c = xb_ld(&bar[XB_XCNT(j)]); sum += c; cnt += (c > 0u) ? 1u : 0u; mine = (j == x) ? c : mine; }
        if (sum == G) break;
        __builtin_amdgcn_s_sleep(1);
        if ((++sp & 255u) == 0u) { if (xb_ld(&bar[XB_TMO])) break; if (sp > XB_SPIN_CAP) { atomicAdd(&bar[XB_TMO], 1u); break; } }
    }
    nloc = mine > 0u ? mine : 1u; nx = cnt > 0u ? cnt : 1u;
}
__device__ __forceinline__ void xcd_barrier(const XcdBarrier& b) {
    asm volatile("s_waitcnt vmcnt(0)" ::: "memory");
    __syncthreads();
    if (threadIdx.x == 0) {
        unsigned* bar = b.bar;
        __builtin_amdgcn_s_waitcnt(0);
        unsigned nloc = b.st[0], nx = b.st[1];
        if (nloc == 0u) { xcd_barrier_complete(bar, b.x, nloc, nx); b.st[0] = nloc; b.st[1] = nx; }
        const unsigned old = xb_add(&bar[XB_XSUB(b.x)], 1u);
        const unsigned gen = old / nloc;
        if (old + 1u == (gen + 1u) * nloc) {
            __builtin_amdgcn_fence(__ATOMIC_RELEASE, "agent");
            asm volatile("s_waitcnt vmcnt(0)" ::: "memory");
            const unsigned og = xb_add(&bar[XB_TOP], 1u);
            const unsigned tg = og / nx;
            if (og + 1u == (tg + 1u) * nx) xb_add(&bar[XB_TOPGEN], 1u);
            else XB_SPIN(xb_ld(&bar[XB_TOPGEN]) == tg, bar);
            __builtin_amdgcn_fence(__ATOMIC_ACQUIRE, "agent");
            xb_add(&bar[XB_XGEN(b.x)], 1u);
            asm volatile("s_waitcnt vmcnt(0)" ::: "memory");
        } else {
            XB_SPIN(xb_ld(&bar[XB_XGEN(b.x)]) == gen, bar);
            __builtin_amdgcn_fence(__ATOMIC_ACQUIRE, "agent");
            asm volatile("s_waitcnt vmcnt(0)" ::: "memory");
        }
    }
    __syncthreads();
}

#define RAW_BARRIER() do { asm volatile("s_waitcnt lgkmcnt(0)" ::: "memory"); __builtin_amdgcn_s_barrier(); } while (0)
template <bool SWAP, class ARow, class Epi>
__device__ __forceinline__ void gemm_tile(ARow arow, const act_t* Bt, int K, unsigned char* smem, Epi epi) {
  const int tid = threadIdx.x, wid = tid >> 6, lane = tid & 63, wr = wid >> 1, wc = wid & 1, fr = lane & 15,
            fq = lane >> 4;
  const int r0 = tid >> 3, pc = tid & 7;
  const int lc = pc ^ ((tid >> 4) & 7);
  const act_t* ga[4];
#pragma unroll
  for (int i = 0; i < 4; ++i) ga[i] = arow(r0 + 32 * i) + lc * 8;
  const act_t* gb0 = Bt + (long)r0 * K + lc * 8;
  const long gbs = (long)32 * K;
  const int sw = (fr >> 1) & 7;
  const int rd0 = fr * 128 + ((fq ^ sw) << 4), rd1 = fr * 128 + (((4 + fq) ^ sw) << 4);
  char* S = (char*)smem;
  const int nk = K >> 6;
  f32x4 acc[4][4];
#pragma unroll
  for (int m = 0; m < 4; ++m)
#pragma unroll
    for (int n = 0; n < 4; ++n) acc[m][n] = f32x4{0.f, 0.f, 0.f, 0.f};
  auto issue = [&](int kt) {
    char* st = S + (kt & 1) * 32768 + tid * 16;
#pragma unroll
    for (int i = 0; i < 4; ++i) {
      __builtin_amdgcn_global_load_lds((const unsigned*)(ga[i] + kt * 64), (unsigned*)(st + i * 4096), 16, 0, 0);
      __builtin_amdgcn_global_load_lds((const unsigned*)(gb0 + i * gbs + kt * 64), (unsigned*)(st + 16384 + i * 4096), 16, 0, 0);
    }
  };
  RAW_BARRIER();
  issue(0);
  for (int kt = 0; kt < nk; ++kt) {
    asm volatile("s_waitcnt vmcnt(0)" ::: "memory");
    RAW_BARRIER();
    if (kt + 1 < nk) issue(kt + 1);
    const char* st = S + (kt & 1) * 32768;
#pragma unroll
    for (int ks = 0; ks < 2; ++ks) {
      const int rd = ks ? rd1 : rd0;
      bf16x8 af[4], bfr[4];
#pragma unroll
      for (int m = 0; m < 4; ++m) {
        af[m] = *reinterpret_cast<const bf16x8*>(st + (wr * 64 + m * 16) * 128 + rd);
        bfr[m] = *reinterpret_cast<const bf16x8*>(st + 16384 + (wc * 64 + m * 16) * 128 + rd);
      }
#pragma unroll
      for (int m = 0; m < 4; ++m)
#pragma unroll
        for (int n = 0; n < 4; ++n)
          acc[m][n] = SWAP ? __builtin_amdgcn_mfma_f32_16x16x32_bf16(bfr[n], af[m], acc[m][n], 0, 0, 0)
                           : __builtin_amdgcn_mfma_f32_16x16x32_bf16(af[m], bfr[n], acc[m][n], 0, 0, 0);
    }
  }
  epi(acc, wr, wc, fr, fq);
}


constexpr float SU8 = 16.0f, SW8 = 64.0f, SH8 = 8.0f, SO8 = 8.0f;
typedef unsigned char fp8_t;
typedef __attribute__((ext_vector_type(8))) int i32x8;
typedef __attribute__((ext_vector_type(4))) int i32x4;
__device__ __forceinline__ unsigned pack4_fp8(float a, float b, float c, float d) {
  a = fminf(fmaxf(a, -448.f), 448.f); b = fminf(fmaxf(b, -448.f), 448.f);
  c = fminf(fmaxf(c, -448.f), 448.f); d = fminf(fmaxf(d, -448.f), 448.f);
  unsigned w = 0;
  w = __builtin_amdgcn_cvt_pk_fp8_f32(a, b, w, false);
  w = __builtin_amdgcn_cvt_pk_fp8_f32(c, d, w, true);
  return w;
}

template <bool SWAP, class ARow, class Epi>
__device__ __forceinline__ void gemm_tile8(ARow arow, const fp8_t* Bt, int Kb, unsigned char* smem, Epi epi) {
  const int tid = threadIdx.x, wid = tid >> 6, lane = tid & 63, wr = wid >> 1, wc = wid & 1, fr = lane & 15,
            fq = lane >> 4;
  const int r0 = tid >> 3, pc = tid & 7;
  const int lc = pc ^ ((tid >> 4) & 7);
  const fp8_t* ga[4];
#pragma unroll
  for (int i = 0; i < 4; ++i) ga[i] = arow(r0 + 32 * i) + lc * 16;
  const fp8_t* gb0 = Bt + (long)r0 * Kb + lc * 16;
  const long gbs = (long)32 * Kb;
  const int sw = (fr >> 1) & 7;
  const int rd0 = fr * 128 + ((fq ^ sw) << 4), rd1 = fr * 128 + (((4 + fq) ^ sw) << 4);
  char* S = (char*)smem;
  const int nk = Kb >> 7;
  f32x4 acc[4][4];
#pragma unroll
  for (int m = 0; m < 4; ++m)
#pragma unroll
    for (int n = 0; n < 4; ++n) acc[m][n] = f32x4{0.f, 0.f, 0.f, 0.f};
  auto issue = [&](int kt) {
    char* st = S + (kt & 1) * 32768 + tid * 16;
#pragma unroll
    for (int i = 0; i < 4; ++i) {
      __builtin_amdgcn_global_load_lds((const unsigned*)(ga[i] + kt * 128), (unsigned*)(st + i * 4096), 16, 0, 0);
      __builtin_amdgcn_global_load_lds((const unsigned*)(gb0 + i * gbs + kt * 128), (unsigned*)(st + 16384 + i * 4096), 16, 0, 0);
    }
  };
  RAW_BARRIER();
  issue(0);
  if (nk > 1) issue(1);
#pragma unroll 1
  for (int kt = 0; kt < nk; ++kt) {
    if (kt + 1 < nk) asm volatile("s_waitcnt vmcnt(8)" ::: "memory");
    else asm volatile("s_waitcnt vmcnt(0)" ::: "memory");
    RAW_BARRIER();
    const char* st = S + (kt & 1) * 32768;
    i32x8 af[4], bfr[4];
#pragma unroll
    for (int m = 0; m < 4; ++m) {
      const i32x4 a0 = *reinterpret_cast<const i32x4*>(st + (wr * 64 + m * 16) * 128 + rd0);
      const i32x4 a1 = *reinterpret_cast<const i32x4*>(st + (wr * 64 + m * 16) * 128 + rd1);
      const i32x4 b0 = *reinterpret_cast<const i32x4*>(st + 16384 + (wc * 64 + m * 16) * 128 + rd0);
      const i32x4 b1 = *reinterpret_cast<const i32x4*>(st + 16384 + (wc * 64 + m * 16) * 128 + rd1);
      af[m] = i32x8{a0[0], a0[1], a0[2], a0[3], a1[0], a1[1], a1[2], a1[3]};
      bfr[m] = i32x8{b0[0], b0[1], b0[2], b0[3], b1[0], b1[1], b1[2], b1[3]};
    }
    RAW_BARRIER();
    if (kt + 2 < nk) issue(kt + 2);
#pragma unroll
    for (int m = 0; m < 4; ++m)
#pragma unroll
      for (int n = 0; n < 4; ++n)
        acc[m][n] = SWAP ? __builtin_amdgcn_mfma_scale_f32_16x16x128_f8f6f4(bfr[n], af[m], acc[m][n], 0, 0, 0, 0x7f7f7f7f, 0, 0x7f7f7f7f)
                         : __builtin_amdgcn_mfma_scale_f32_16x16x128_f8f6f4(af[m], bfr[n], acc[m][n], 0, 0, 0, 0x7f7f7f7f, 0, 0x7f7f7f7f);
  }
  epi(acc, wr, wc, fr, fq);
}


template <bool SWAP, class Epi>
__device__ __forceinline__ void gemm_tile8p(const fp8_t* A, const fp8_t* Bt, bool has_next, const fp8_t* An, const fp8_t* Btn,
                                            int& par, bool& primed, int Kb, unsigned char* smem, Epi epi) {
  const int tid = threadIdx.x, wid = tid >> 6, lane = tid & 63, wr = wid >> 1, wc = wid & 1, fr = lane & 15,
            fq = lane >> 4;
  const int r0 = tid >> 3, pc = tid & 7;
  const int lc = pc ^ ((tid >> 4) & 7);
  const long roff = (long)r0 * Kb + lc * 16;
  const long gbs = (long)32 * Kb;
  const int sw = (fr >> 1) & 7;
  const int rd0 = fr * 128 + ((fq ^ sw) << 4), rd1 = fr * 128 + (((4 + fq) ^ sw) << 4);
  char* S = (char*)smem;
  const int nk = Kb >> 7;
  f32x4 acc[4][4];
#pragma unroll
  for (int m = 0; m < 4; ++m)
#pragma unroll
    for (int n = 0; n < 4; ++n) acc[m][n] = f32x4{0.f, 0.f, 0.f, 0.f};
  auto issue = [&](const fp8_t* a, const fp8_t* b, int kt, int stage) {
    char* st = S + stage * 32768 + tid * 16;
    const fp8_t* ga = a + roff + kt * 128;
    const fp8_t* gb = b + roff + kt * 128;
#pragma unroll
    for (int i = 0; i < 4; ++i) {
      __builtin_amdgcn_global_load_lds((const unsigned*)(ga + i * gbs), (unsigned*)(st + i * 4096), 16, 0, 0);
      __builtin_amdgcn_global_load_lds((const unsigned*)(gb + i * gbs), (unsigned*)(st + 16384 + i * 4096), 16, 0, 0);
    }
  };
  if (!primed) {
    RAW_BARRIER();
    issue(A, Bt, 0, par);
  }
#pragma unroll 1
  for (int kt = 0; kt < nk; ++kt) {
    asm volatile("s_waitcnt vmcnt(0)" ::: "memory");
    RAW_BARRIER();
    if (kt + 1 < nk) issue(A, Bt, kt + 1, (par + kt + 1) & 1);
    else if (has_next) issue(An, Btn, 0, (par + kt + 1) & 1);
    const char* st = S + ((par + kt) & 1) * 32768;
    i32x8 af[4], bfr[4];
#pragma unroll
    for (int m = 0; m < 4; ++m) {
      const i32x4 a0 = *reinterpret_cast<const i32x4*>(st + (wr * 64 + m * 16) * 128 + rd0);
      const i32x4 a1 = *reinterpret_cast<const i32x4*>(st + (wr * 64 + m * 16) * 128 + rd1);
      const i32x4 b0 = *reinterpret_cast<const i32x4*>(st + 16384 + (wc * 64 + m * 16) * 128 + rd0);
      const i32x4 b1 = *reinterpret_cast<const i32x4*>(st + 16384 + (wc * 64 + m * 16) * 128 + rd1);
      af[m] = i32x8{a0[0], a0[1], a0[2], a0[3], a1[0], a1[1], a1[2], a1[3]};
      bfr[m] = i32x8{b0[0], b0[1], b0[2], b0[3], b1[0], b1[1], b1[2], b1[3]};
    }
#pragma unroll
    for (int m = 0; m < 4; ++m)
#pragma unroll
      for (int n = 0; n < 4; ++n)
        acc[m][n] = SWAP ? __builtin_amdgcn_mfma_scale_f32_16x16x128_f8f6f4(bfr[n], af[m], acc[m][n], 0, 0, 0, 0x7f7f7f7f, 0, 0x7f7f7f7f)
                         : __builtin_amdgcn_mfma_scale_f32_16x16x128_f8f6f4(af[m], bfr[n], acc[m][n], 0, 0, 0, 0x7f7f7f7f, 0, 0x7f7f7f7f);
  }
  par = (par + nk) & 1;
  primed = has_next;
  epi(acc, wr, wc, fr, fq);
}

__device__ __forceinline__ void phase_attn(const Params& p, unsigned char* smem, int blk, int nblk) {
  const int tid = threadIdx.x, w = tid >> 6, lane = tid & 63, fr = lane & 15, g = lane >> 4;
  act_t* SK = (act_t*)smem;
  act_t* SV = SK + 64 * 72;
  constexpr float SCL = 0.125f * 1.4426950408889634f;
  const int n_lat = NB * 4 * (T / 64), n_ctx = NB * 4 * (C / 64);
  const int skey = tid >> 2, spart = tid & 3;
  for (int unit = blk; unit < n_lat + n_ctx; unit += nblk) {
    const bool lat = unit < n_lat;
    const int uu = lat ? unit : unit - n_lat;
    const int nq = lat ? T / 64 : C / 64;
    const int hp = uu & 1, kv = (uu >> 1) & 1, qb = (uu >> 2) % nq, b = (uu >> 2) / nq;
    const int t0 = qb * 64;
    const int tw = t0 + (w & 1) * 32;
    const long qrow0 = (lat ? (long)NC + (long)b * T : (long)b * C) + tw;
    const int h = kv * 4 + hp * 2 + (w >> 1);
    bf16x8 qf[2][2];
#pragma unroll
    for (int qt = 0; qt < 2; ++qt)
#pragma unroll
      for (int st = 0; st < 2; ++st)
        qf[qt][st] = *reinterpret_cast<const bf16x8*>(p.P + (qrow0 + qt * 16 + fr) * PW + E_AQ + h * 64 + st * 32 + g * 8);
    asm volatile("" :: "v"(qf[0][0]), "v"(qf[0][1]), "v"(qf[1][0]), "v"(qf[1][1]));
    float mrun[2], lrun[2];
    f32x4 o[2][4];
    const float sinkl = p.attn_sink[h] * 1.4426950408889634f;
#pragma unroll
    for (int qt = 0; qt < 2; ++qt) {
      mrun[qt] = sinkl;
      lrun[qt] = (g == 0) ? 1.0f : 0.0f;
#pragma unroll
      for (int dt = 0; dt < 4; ++dt) o[qt][dt] = f32x4{0.f, 0.f, 0.f, 0.f};
    }
    int cc_lo = 0, cc_hi = -1;
    if (lat) {
      cc_lo = t0 >= 128 ? 0 : (128 - t0) / 64;
      cc_hi = min(4, (T - 1 - (t0 - 128)) / 64);
    }
    const int nch = 4 + (cc_hi - cc_lo + 1);
    auto chunk_row = [&](int i, int key, int& tkb) -> long {
      if (i < 4) { tkb = 0; return (long)b * C + i * 64 + key; }
      tkb = t0 - 128 + (cc_lo + i - 4) * 64;
      return (long)NC + (long)b * T + tkb + key;
    };
    uint4 rk0, rk1, rv0, rv1;
    {
      int tkb; const long kr = chunk_row(0, skey, tkb);
      const act_t* kp = p.P + kr * PW + E_AK + kv * 64 + spart * 16;
      const act_t* vp = p.P + kr * PW + E_AV + kv * 64 + spart * 16;
      rk0 = *reinterpret_cast<const uint4*>(kp); rk1 = *reinterpret_cast<const uint4*>(kp + 8);
      rv0 = *reinterpret_cast<const uint4*>(vp); rv1 = *reinterpret_cast<const uint4*>(vp + 8);
    }
    for (int i = 0; i < nch; ++i) {
      __syncthreads();
      {
        uint4* kd = reinterpret_cast<uint4*>(SK + skey * 72 + spart * 16);
        kd[0] = rk0; kd[1] = rk1;
        const unsigned vw[8] = {rv0.x, rv0.y, rv0.z, rv0.w, rv1.x, rv1.y, rv1.z, rv1.w};
#pragma unroll
        for (int e = 0; e < 8; ++e) {
          SV[(spart * 16 + 2 * e) * 72 + skey] = (act_t)(vw[e] & 0xffffu);
          SV[(spart * 16 + 2 * e + 1) * 72 + skey] = (act_t)(vw[e] >> 16);
        }
      }
      __syncthreads();
      int tkb_cur; (void)chunk_row(i, 0, tkb_cur);
      if (i + 1 < nch) {
        int tkb; const long kr = chunk_row(i + 1, skey, tkb);
        const act_t* kp = p.P + kr * PW + E_AK + kv * 64 + spart * 16;
        const act_t* vp = p.P + kr * PW + E_AV + kv * 64 + spart * 16;
        rk0 = *reinterpret_cast<const uint4*>(kp); rk1 = *reinterpret_cast<const uint4*>(kp + 8);
        rv0 = *reinterpret_cast<const uint4*>(vp); rv1 = *reinterpret_cast<const uint4*>(vp + 8);
      }
      const bool edge = i >= 4 && (tkb_cur == t0 - 128 || tkb_cur == t0 + 128);
#pragma unroll
      for (int kb = 0; kb < 2; ++kb) {
        f32x4 sc[2][2];
#pragma unroll
        for (int k2 = 0; k2 < 2; ++k2) {
          const int kt = kb * 2 + k2;
          const bf16x8 kf0 = *reinterpret_cast<const bf16x8*>(SK + (kt * 16 + fr) * 72 + g * 8);
          const bf16x8 kf1 = *reinterpret_cast<const bf16x8*>(SK + (kt * 16 + fr) * 72 + 32 + g * 8);
#pragma unroll
          for (int qt = 0; qt < 2; ++qt) {
            f32x4 z = f32x4{0.f, 0.f, 0.f, 0.f};
            z = __builtin_amdgcn_mfma_f32_16x16x32_bf16(kf0, qf[qt][0], z, 0, 0, 0);
            sc[qt][k2] = __builtin_amdgcn_mfma_f32_16x16x32_bf16(kf1, qf[qt][1], z, 0, 0, 0);
          }
        }
        bf16x8 pf[2];
#pragma unroll
        for (int qt = 0; qt < 2; ++qt) {
          float mx = -1e30f;
#pragma unroll
          for (int k2 = 0; k2 < 2; ++k2)
#pragma unroll
            for (int j = 0; j < 4; ++j) {
              float v = sc[qt][k2][j] * SCL;
              if (edge) {
                const int tk = tkb_cur + (kb * 2 + k2) * 16 + 4 * g + j;
                const int tq = tw + qt * 16 + fr;
                const int df = tq - tk;
                if (df > 128 || df < -128) v = -1e30f;
              }
              sc[qt][k2][j] = v;
              mx = fmaxf(mx, v);
            }
          mx = xor16_max(mx);
          mx = xor32_max(mx);
          const float mnew = fmaxf(mrun[qt], mx);
          if (__any(mnew > mrun[qt])) {
            const float alpha = __builtin_amdgcn_exp2f(mrun[qt] - mnew);
            lrun[qt] *= alpha;
#pragma unroll
            for (int dt = 0; dt < 4; ++dt) o[qt][dt] = o[qt][dt] * alpha;
            mrun[qt] = mnew;
          }
          float ls = 0.f;
          float pv[8];
#pragma unroll
          for (int k2 = 0; k2 < 2; ++k2)
#pragma unroll
            for (int j = 0; j < 4; ++j) {
              const float pe = __builtin_amdgcn_exp2f(sc[qt][k2][j] - mnew);
              pv[k2 * 4 + j] = pe;
              ls += pe;
            }
          lrun[qt] += ls;
          union { unsigned u[4]; bf16x8 v; } cv;
          cv.u[0] = pack2_mfma(pv[0], pv[1]); cv.u[1] = pack2_mfma(pv[2], pv[3]);
          cv.u[2] = pack2_mfma(pv[4], pv[5]); cv.u[3] = pack2_mfma(pv[6], pv[7]);
          pf[qt] = cv.v;
        }
#pragma unroll
        for (int dt = 0; dt < 4; ++dt) {
          union { uint2 h2[2]; bf16x8 v; } vf;
          vf.h2[0] = *reinterpret_cast<const uint2*>(SV + (dt * 16 + fr) * 72 + kb * 32 + 4 * g);
          vf.h2[1] = *reinterpret_cast<const uint2*>(SV + (dt * 16 + fr) * 72 + kb * 32 + 16 + 4 * g);
#pragma unroll
          for (int qt = 0; qt < 2; ++qt) o[qt][dt] = __builtin_amdgcn_mfma_f32_16x16x32_bf16(vf.v, pf[qt], o[qt][dt], 0, 0, 0);
        }
      }
    }
#pragma unroll
    for (int qt = 0; qt < 2; ++qt) {
      float lt = lrun[qt];
      lt = xor16_add(lt);
      lt = xor32_add(lt);
      const float il = 1.0f / lt;
      fp8_t* orow = p.O8 + (qrow0 + qt * 16 + fr) * D + h * 64 + 4 * g;
      const float ils = il * SO8;
#pragma unroll
      for (int dt = 0; dt < 4; ++dt)
        *reinterpret_cast<unsigned*>(orow + dt * 16) = pack4_fp8(o[qt][dt][0] * ils, o[qt][dt][1] * ils, o[qt][dt][2] * ils, o[qt][dt][3] * ils);
    }
  }
}


template <int MODE>
__device__ __forceinline__ void phase_combine(const Params& p) {
  constexpr int DV = MODE == 0 ? 128 : 192, EPL = DV / 16, NV = EPL / 4;
  const int lane = threadIdx.x & 63;
  const long row_lo = MODE == 0 ? 0 : NC;
  const int nw = (int)gridDim.x * 4, wi = (int)blockIdx.x * 4 + (int)(threadIdx.x >> 6);
  const int rpw = (int)(NR - row_lo + nw - 1) / nw;
  const long r0 = row_lo + (long)wi * rpw, r1 = min((long)NR, r0 + rpw);
  float gn[EPL];
#pragma unroll
  for (int e = 0; e < EPL; ++e) gn[e] = (MODE == 0 ? p.hgrn_norm : p.gla_norm)[lane * EPL + e];
  uint2 fa[NV], fb[NV], fg[NV];
  auto load_row = [&](long row) {
    const uint2* f = reinterpret_cast<const uint2*>(p.OF + row * 768 + lane * EPL);
    const uint2* bk = reinterpret_cast<const uint2*>(p.OB + row * 768 + lane * EPL);
    const uint2* gt = reinterpret_cast<const uint2*>(p.P + row * PW + (MODE == 0 ? E_HG : O_G) + lane * EPL);
#pragma unroll
    for (int v = 0; v < NV; ++v) { fa[v] = f[v]; fb[v] = bk[v]; fg[v] = gt[v]; }
  };
  if (r0 < r1) load_row(r0);
  for (long row = r0; row < r1; ++row) {
    float o[EPL], gg[EPL];
#pragma unroll
    for (int v = 0; v < NV; ++v) {
      o[4 * v + 0] = bf_lo(fa[v].x) + bf_lo(fb[v].x); o[4 * v + 1] = bf_hi(fa[v].x) + bf_hi(fb[v].x);
      o[4 * v + 2] = bf_lo(fa[v].y) + bf_lo(fb[v].y); o[4 * v + 3] = bf_hi(fa[v].y) + bf_hi(fb[v].y);
      gg[4 * v + 0] = bf_lo(fg[v].x); gg[4 * v + 1] = bf_hi(fg[v].x); gg[4 * v + 2] = bf_lo(fg[v].y); gg[4 * v + 3] = bf_hi(fg[v].y);
    }
    load_row(min(row + 1, r1 - 1));
    float ss = 0.f;
#pragma unroll
    for (int e = 0; e < EPL; ++e) ss += o[e] * o[e];
    ss = row_sum16(ss);
    const float r = 1.0f / sqrtf(ss * (1.0f / DV) + LN_EPS);
    unsigned* dst = reinterpret_cast<unsigned*>(p.O8 + row * D + (MODE == 0 ? 512 : 0) + lane * EPL);
#pragma unroll
    for (int v = 0; v < NV; ++v) {
      float y[4];
#pragma unroll
      for (int q = 0; q < 4; ++q) {
        const float g = gg[4 * v + q];
        y[q] = o[4 * v + q] * (r * SO8) * gn[4 * v + q] * (g / (1.0f + __expf(-g)));
      }
      dst[v] = pack4_fp8(y[0], y[1], y[2], y[3]);
    }
  }
}

constexpr int MOD_ITEMS = 2 * 2 * (6 * D / 64);
__device__ __forceinline__ void mod_item(const Params& p, int item, unsigned char* smem) {
  float* sc = (float*)smem;
  float* red = sc + 9 * 512;
  const int tid = threadIdx.x, w = tid >> 6, lane = tid & 63;
  const int kh = item & 1, cgi = item >> 1;
  const int l = cgi / (6 * D / 64), j = (cgi % (6 * D / 64)) * 64 + lane;
  const float* wp = p.w_ada + (long)l * D * 6 * D + (long)(kh * 512 + w * 128) * 6 * D + j;
  float wv[32];
#pragma unroll
  for (int q = 0; q < 32; ++q) wv[q] = wp[(long)q * 6 * D];
#pragma unroll 6
  for (int i = tid; i < 9 * 512; i += 256) {
    const int bb = i >> 9, k = kh * 512 + (i & 511);
    const float v = bb < NB ? p.c[bb * D + k] : p.c_ctx[k];
    sc[i] = v / (1.0f + __expf(-v));
  }
  float a[NB + 1];
#pragma unroll
  for (int bb = 0; bb <= NB; ++bb) a[bb] = 0.f;
  __syncthreads();
#pragma unroll 1
  for (int kb = 0; kb < 128; kb += 32) {
    float wc[32];
#pragma unroll
    for (int q = 0; q < 32; ++q) wc[q] = wv[q];
    const int kn = min(kb + 32, 96);
#pragma unroll
    for (int q = 0; q < 32; ++q) wv[q] = wp[(long)(kn + q) * 6 * D];
#pragma unroll
    for (int q4 = 0; q4 < 8; ++q4)
#pragma unroll
      for (int bb = 0; bb <= NB; ++bb) {
        const float4 s4 = *reinterpret_cast<const float4*>(sc + bb * 512 + w * 128 + kb + 4 * q4);
        a[bb] += s4.x * wc[4 * q4] + s4.y * wc[4 * q4 + 1] + s4.z * wc[4 * q4 + 2] + s4.w * wc[4 * q4 + 3];
      }
  }
#pragma unroll
  for (int q = 0; q < 32; ++q) asm volatile("" :: "v"(wv[q]));
#pragma unroll
  for (int bb = 0; bb <= NB; ++bb) red[(w * 9 + bb) * 64 + lane] = a[bb];
  __syncthreads();
  for (int i = tid; i < 9 * 64; i += 256) {
    const int bb = i >> 6, jj = i & 63;
    const int col = (cgi % (6 * D / 64)) * 64 + jj;
    const float sum = ((red[(0 * 9 + bb) * 64 + jj] + red[(1 * 9 + bb) * 64 + jj]) + (red[(2 * 9 + bb) * 64 + jj] + red[(3 * 9 + bb) * 64 + jj]));
    atomicAdd(p.mod + ((long)l * (NB + 1) + bb) * 6 * D + col, kh == 0 ? sum + p.b_ada[l * 6 * D + col] : sum);
  }
  __syncthreads();
}

__device__ __forceinline__ void phase_gla_decay(const Params& p) {
  const int t = threadIdx.x;
  if (t >= 192) return;
  const int dir = t / 96, cg = t % 96;
  float gw[16][4], gb[4];
#pragma unroll
  for (int r = 0; r < 16; ++r) {
    const float4 v = *reinterpret_cast<const float4*>(p.gla_gate_w + ((long)dir * 16 + r) * 384 + cg * 4);
    gw[r][0] = v.x; gw[r][1] = v.y; gw[r][2] = v.z; gw[r][3] = v.w;
  }
  {
    const float4 v = *reinterpret_cast<const float4*>(p.gla_gate_b + dir * 384 + cg * 4);
    gb[0] = v.x; gb[1] = v.y; gb[2] = v.z; gb[3] = v.w;
  }
  const int rpb = ((NR + (int)gridDim.x - 1) / (int)gridDim.x + 3) / 4 * 4;
  const long b0 = (long)blockIdx.x * rpb, b1 = min((long)NR, b0 + rpb);
  uint4 ra[4], rb[4];
  auto load4 = [&](long row0) {
#pragma unroll
    for (int q = 0; q < 4; ++q) {
      const uint4* rp = reinterpret_cast<const uint4*>(p.P + min(row0 + q, b1 - 1) * PW + O_RF + dir * 16);
      ra[q] = rp[0]; rb[q] = rp[1];
    }
  };
  if (b0 < b1) load4(b0);
  for (long row0 = b0; row0 < b1; row0 += 4) {
    unsigned rw[4][8];
#pragma unroll
    for (int q = 0; q < 4; ++q) {
      rw[q][0] = ra[q].x; rw[q][1] = ra[q].y; rw[q][2] = ra[q].z; rw[q][3] = ra[q].w;
      rw[q][4] = rb[q].x; rw[q][5] = rb[q].y; rw[q][6] = rb[q].z; rw[q][7] = rb[q].w;
    }
    load4(min(row0 + 4, b1 - 1));
#pragma unroll
    for (int q = 0; q < 4; ++q) {
      float z[4] = {gb[0], gb[1], gb[2], gb[3]};
#pragma unroll
      for (int r2 = 0; r2 < 8; ++r2) {
        const float x0 = bf_lo(rw[q][r2]), x1 = bf_hi(rw[q][r2]);
#pragma unroll
        for (int c = 0; c < 4; ++c) z[c] += x0 * gw[2 * r2][c] + x1 * gw[2 * r2 + 1][c];
      }
      float o[4];
#pragma unroll
      for (int c = 0; c < 4; ++c) o[c] = 1.0f - __expf((fminf(z[c], 0.f) - __logf(1.0f + __expf(-fabsf(z[c])))) * (1.0f / 16.0f));
      if (row0 + q < b1)
        *reinterpret_cast<uint2*>(p.LF + ((long)dir * NR + row0 + q) * 384 + cg * 4) = make_uint2(pack2(o[0], o[1]), pack2(o[2], o[3]));
    }
  }
}

__device__ __forceinline__ void phase_hgrn_gate(const Params& p, long gtid, long gstride) {
  for (long i = gtid; i < (long)NR * 1024; i += gstride) {
    const int col = (int)(i & 1023);
    const long row = i >> 10;
    act_t* z = p.P + row * PW + E_FF + col;
    const float lb = p.lbt[col];
    const float f = lb + (1.0f - lb) * sigmoidf_(ldA(z));
    stA(z, __logf(f));
  }
}

#define RCPF(x) __builtin_amdgcn_rcpf(x)
template <int MODE>
__device__ __forceinline__ void phase_scan(const Params& p, unsigned char* smem, int blk, int nblk) {
  constexpr int DK = MODE == 0 ? 128 : 96, DV = MODE == 0 ? 128 : 192, DVS = DV / 4, NET = DVS / 16, NKS = DK / 32,
                NDT = DK / 16;
  constexpr int QS = DK + 8, LS = 72, SS = DK + 8;
  act_t* Qa = (act_t*)smem;
  act_t* Ka = Qa + 64 * QS;
  act_t* KaT = Ka + 64 * QS;
  act_t* VT = KaT + DK * LS;
  act_t* ST = VT + DVS * LS;
  float* tot = (float*)(ST + DVS * SS);
  float* lf32 = tot + 2 * 4 * DK;
  const int tid = threadIdx.x, w = __builtin_amdgcn_readfirstlane(threadIdx.x >> 6), lane = tid & 63, fr = lane & 15, g = lane >> 4;
  const int dp = lane, c0 = 2 * dp;
  const bool cact = dp < DK / 2;
  constexpr int NCH = (C + T) / 64, NCC = C / 64;
  constexpr int NVI = DVS / 8 * 64;
  for (int item = blk; item < NB * 4 * 2 * 4; item += nblk) {
    const int sl = item & 3, dir = (item >> 2) & 1, h = (item >> 3) & 3, b = item >> 5;
    act_t* OD = dir == 0 ? p.OF : p.OB;
    const unsigned loff = (unsigned)min(c0, DK - 2) * 2u;
    const int vcol = (MODE == 0 ? E_HI + h * 128 : O_V + h * 192) + sl * DVS;
    const int ocol = h * DV + sl * DVS;
    auto chunk_base = [&](int n) -> long {
      if (n < NCC) return (long)b * C + (dir ? NCC - 1 - n : n) * 64;
      const int ln = n - NCC;
      return (long)NC + (long)b * T + (dir ? T / 64 - 1 - ln : ln) * 64;
    };
    auto lrow = [&](long base, int l) -> long { return base + (dir ? 63 - l : l); };
    f32x4 S[NET][2];
#pragma unroll
    for (int et = 0; et < NET; ++et) { S[et][0] = f32x4{0.f, 0.f, 0.f, 0.f}; S[et][1] = f32x4{0.f, 0.f, 0.f, 0.f}; }
    unsigned rlf[16], rq[16], rk[16];
    uint4 rv[2];
    const long rstep = dir ? -(long)PW * 2 : (long)PW * 2;
    const long lstep = dir ? -(long)384 * 2 : (long)384 * 2;
    const int ub_lf = (MODE == 0 ? (E_FF + dir * 512 + h * 128) * 2 : 0);
    const int ub_q = (MODE == 0 ? E_HQ + h * 128 : O_Q + h * 96) * 2;
    const int ub_k = (O_K + h * 96) * 2;
    unsigned voff[(NVI + 255) / 256];
#pragma unroll
    for (int r = 0; r < (NVI + 255) / 256; ++r) {
      const int it = min(tid + r * 256, NVI - 1);
      const int l = it / (DVS / 8), e8 = (it % (DVS / 8)) * 8;
      voff[r] = (unsigned)((dir ? 63 - l : l) * PW + e8) * 2u;
    }
    auto issue_loads = [&](int n) {
      const long base = chunk_base(n);
      unsigned lo = loff;
      asm volatile("" : "+v"(lo));
      {
        const char* prow = (const char*)(p.P + lrow(base, w * 16) * PW);
        const char* plf = (const char*)(p.LF + ((long)dir * NR + lrow(base, w * 16)) * 384 + h * 96);
#pragma unroll
        for (int i = 0; i < 16; ++i) {
          if (MODE == 0) {
            rlf[i] = *reinterpret_cast<const unsigned*>(prow + ub_lf + lo);
          } else {
            rlf[i] = *reinterpret_cast<const unsigned*>(plf + lo);
            rk[i] = *reinterpret_cast<const unsigned*>(prow + ub_k + lo);
            plf += lstep;
          }
          rq[i] = *reinterpret_cast<const unsigned*>(prow + ub_q + lo);
          prow += rstep;
        }
      }
      const char* vbase = (const char*)(p.P + base * PW + vcol);
#pragma unroll
      for (int r = 0; r < (NVI + 255) / 256; ++r) {
        unsigned vo = voff[r];
        asm volatile("" : "+v"(vo));
        rv[r] = *reinterpret_cast<const uint4*>(vbase + vo);
      }
    };
    issue_loads(0);
    for (int n = 0; n < NCH; ++n) {
      const int par = n & 1;
      float* totp = tot + par * 4 * DK;
      float* lfp = lf32 + par * DK;
      const long base = chunk_base(n);
      if (cact) {
        float r0 = 1.f, r1 = 1.f;
#pragma unroll
        for (int i = 0; i < 16; ++i) { r0 *= 1.0f - bf_lo(rlf[i]); r1 *= 1.0f - bf_hi(rlf[i]); }
        totp[w * DK + c0] = r0; totp[w * DK + c0 + 1] = r1;
        if (w == 2) { lfp[c0] = 1.0f - bf_lo(rlf[0]); lfp[c0 + 1] = 1.0f - bf_hi(rlf[0]); }
      }
      __syncthreads();
#pragma unroll
      for (int r = 0; r < (NVI + 255) / 256; ++r) {
        const int it = tid + r * 256;
        if (it < NVI) {
          const int l = it / (DVS / 8), e8 = (it % (DVS / 8)) * 8;
          const unsigned vw[4] = {rv[r].x, rv[r].y, rv[r].z, rv[r].w};
#pragma unroll
          for (int e = 0; e < 4; ++e) {
            VT[(e8 + 2 * e) * LS + l] = (act_t)(vw[e] & 0xffffu);
            VT[(e8 + 2 * e + 1) * LS + l] = (act_t)(vw[e] >> 16);
          }
        }
      }
      if (cact) {
        float of0 = 1.f, of1 = 1.f;
#pragma unroll
        for (int sgi = 0; sgi < 3; ++sgi)
          if (sgi < w) { of0 *= totp[sgi * DK + c0]; of1 *= totp[sgi * DK + c0 + 1]; }
        const float ref0 = totp[c0] * totp[DK + c0] * lfp[c0];
        const float ref1 = totp[c0 + 1] * totp[DK + c0 + 1] * lfp[c0 + 1];
        unsigned kt0[8], kt1[8];
        float e0 = of0 * RCPF(ref0), e1 = of1 * RCPF(ref1);
        float f0 = RCPF(e0), f1 = RCPF(e1);
#pragma unroll
        for (int i = 0; i < 16; i += 2) {
          float ka0[2], ka1[2];
#pragma unroll
          for (int ii = 0; ii < 2; ++ii) {
            const int i2 = i + ii;
            const float kk0 = bf_lo(rlf[i2]), kk1 = bf_hi(rlf[i2]);
            const float g0 = 1.0f - kk0, g1 = 1.0f - kk1;
            e0 *= g0; e1 *= g1; f0 *= RCPF(g0); f1 *= RCPF(g1);
            float k0, k1;
            if (MODE == 0) { k0 = kk0; k1 = kk1; }
            else { k0 = bf_lo(rk[i2]); k1 = bf_hi(rk[i2]); }
            ka0[ii] = k0 * f0; ka1[ii] = k1 * f1;
            const int l = w * 16 + i2;
            *reinterpret_cast<unsigned*>(Qa + l * QS + c0) = pack2(bf_lo(rq[i2]) * e0, bf_hi(rq[i2]) * e1);
            *reinterpret_cast<unsigned*>(Ka + l * QS + c0) = pack2(ka0[ii], ka1[ii]);
          }
          kt0[i >> 1] = pack2(ka0[0], ka0[1]);
          kt1[i >> 1] = pack2(ka1[0], ka1[1]);
        }
        uint4* d0 = reinterpret_cast<uint4*>(KaT + c0 * LS + w * 16);
        d0[0] = make_uint4(kt0[0], kt0[1], kt0[2], kt0[3]); d0[1] = make_uint4(kt0[4], kt0[5], kt0[6], kt0[7]);
        uint4* d1 = reinterpret_cast<uint4*>(KaT + (c0 + 1) * LS + w * 16);
        d1[0] = make_uint4(kt1[0], kt1[1], kt1[2], kt1[3]); d1[1] = make_uint4(kt1[4], kt1[5], kt1[6], kt1[7]);
      }
      issue_loads(min(n + 1, NCH - 1));
      float egv[2], egrv[2];
#pragma unroll
      for (int di = 0; di < 2; ++di) {
        const int dt = w + 4 * di;
        if (dt < NDT) {
          const int d = dt * 16 + fr;
          const float er = totp[d] * totp[DK + d] * lfp[d];
          egv[di] = (totp[d] * totp[DK + d]) * (totp[2 * DK + d] * totp[3 * DK + d]);
          egrv[di] = egv[di] * RCPF(er);
#pragma unroll
          for (int et = 0; et < NET; ++et)
#pragma unroll
            for (int j = 0; j < 4; j += 2) {
              const unsigned pk = pack2(S[et][di][j] * er, S[et][di][j + 1] * er);
              ST[(et * 16 + 4 * g + j) * SS + d] = (act_t)(pk & 0xffffu);
              ST[(et * 16 + 4 * g + j + 1) * SS + d] = (act_t)(pk >> 16);
            }
        }
      }
      __syncthreads();
      bf16x8 qfr[NKS];
#pragma unroll
      for (int ks = 0; ks < NKS; ++ks) qfr[ks] = *reinterpret_cast<const bf16x8*>(Qa + (w * 16 + fr) * QS + ks * 32 + g * 8);
      bf16x8 pfr[2];
#pragma unroll
      for (int kb = 0; kb < 2; ++kb) {
        f32x4 at2[2];
#pragma unroll
        for (int h2 = 0; h2 < 2; ++h2) {
          const int mt = 2 * kb + h2;
          at2[h2] = f32x4{0.f, 0.f, 0.f, 0.f};
          if (mt <= w) {
#pragma unroll
            for (int ks = 0; ks < NKS; ++ks) {
              const bf16x8 kaf = *reinterpret_cast<const bf16x8*>(Ka + (mt * 16 + fr) * QS + ks * 32 + g * 8);
              at2[h2] = __builtin_amdgcn_mfma_f32_16x16x32_bf16(kaf, qfr[ks], at2[h2], 0, 0, 0);
            }
            if (mt == w) {
#pragma unroll
              for (int j = 0; j < 4; ++j)
                if (4 * g + j > fr) at2[h2][j] = 0.f;
            }
          }
        }
        union { unsigned u[4]; bf16x8 v; } cv;
        cv.u[0] = pack2_mfma(at2[0][0], at2[0][1]); cv.u[1] = pack2_mfma(at2[0][2], at2[0][3]);
        cv.u[2] = pack2_mfma(at2[1][0], at2[1][1]); cv.u[3] = pack2_mfma(at2[1][2], at2[1][3]);
        pfr[kb] = cv.v;
      }
      const long orow = lrow(base, w * 16 + fr);
#pragma unroll
      for (int et = 0; et < NET; ++et) {
        f32x4 o = f32x4{0.f, 0.f, 0.f, 0.f};
#pragma unroll
        for (int kb = 0; kb < 2; ++kb) {
          if (2 * kb <= w) {
            union { uint2 h2[2]; bf16x8 v; } vf;
            vf.h2[0] = *reinterpret_cast<const uint2*>(VT + (et * 16 + fr) * LS + kb * 32 + 4 * g);
            vf.h2[1] = *reinterpret_cast<const uint2*>(VT + (et * 16 + fr) * LS + kb * 32 + 16 + 4 * g);
            o = __builtin_amdgcn_mfma_f32_16x16x32_bf16(vf.v, pfr[kb], o, 0, 0, 0);
          }
        }
#pragma unroll
        for (int ks = 0; ks < NKS; ++ks) {
          const bf16x8 sf = *reinterpret_cast<const bf16x8*>(ST + (et * 16 + fr) * SS + ks * 32 + g * 8);
          o = __builtin_amdgcn_mfma_f32_16x16x32_bf16(sf, qfr[ks], o, 0, 0, 0);
        }
        const float osc = MODE == 0 ? 1.0f : 0.10206207261596575f;
        *reinterpret_cast<uint2*>(OD + orow * 768 + ocol + et * 16 + 4 * g) =
            make_uint2(pack2(o[0] * osc, o[1] * osc), pack2(o[2] * osc, o[3] * osc));
      }
#pragma unroll
      for (int di = 0; di < 2; ++di) {
        const int dt = w + 4 * di;
        if (dt < NDT) {
#pragma unroll
          for (int et = 0; et < NET; ++et) {
            f32x4 r = f32x4{0.f, 0.f, 0.f, 0.f};
#pragma unroll
            for (int k2 = 0; k2 < 2; ++k2) {
              const bf16x8 vf = *reinterpret_cast<const bf16x8*>(VT + (et * 16 + fr) * LS + k2 * 32 + g * 8);
              const bf16x8 kf = *reinterpret_cast<const bf16x8*>(KaT + (dt * 16 + fr) * LS + k2 * 32 + g * 8);
              r = __builtin_amdgcn_mfma_f32_16x16x32_bf16(vf, kf, r, 0, 0, 0);
            }
#pragma unroll
            for (int j = 0; j < 4; ++j) S[et][di][j] = egv[di] * S[et][di][j] + egrv[di] * r[j];
          }
        }
      }
    }
    __syncthreads();
  }
}

struct GemmJob {
  const act_t* A; const act_t* Bt; act_t* C;
  long sA, sB, sC;
  int nbatch, Mtiles, Ntiles, K, ldc, Nvalid, mode;
  float scale;
  int fp8;
  int out8;
};
__device__ __forceinline__ void phase_gemm(const Params& p, const GemmJob& g, unsigned char* smem, int blk = blockIdx.x, int nblk = gridDim.x) {
  const int per_b = g.Mtiles * g.Ntiles;
  const int ntiles = per_b * g.nbatch;
  auto tvalid = [&](int t) -> bool {
    const int tt = t % per_b;
    const int tm = tt / g.Ntiles, tn = tt % g.Ntiles;
    return !(g.mode == 1 && tm < NC / 128 && tn * 128 >= O_FA);
  };
  auto tnext = [&](int t) -> int { t += nblk; while (t < ntiles && !tvalid(t)) t += nblk; return t; };
  int par = 0;
  bool primed = false;
  int tile0 = blk;
  if (tile0 < ntiles && !tvalid(tile0)) tile0 = tnext(tile0);
  for (int tile = tile0; tile < ntiles;) {
    const int ntile = tnext(tile);
    const int b = tile / per_b, tt = tile % per_b;
    const int tm = tt / g.Ntiles, tn = tt % g.Ntiles;
    const int tt2 = (ntile < ntiles ? ntile : tile) % per_b;
    const int tm2 = tt2 / g.Ntiles, tn2 = tt2 % g.Ntiles;
    const int K = g.K, ldc = g.ldc;
    const act_t* Ab = g.A + b * g.sA + (long)tm * 128 * K;
    act_t* Cb = g.C + b * g.sC + (long)tm * 128 * ldc + tn * 128;
    const int nlim = g.Nvalid - tn * 128;
    const float scale = g.scale;
    const int mode = g.mode;
    if (mode == 1) {
      auto epi1 = [&](f32x4 (&acc)[4][4], int wr, int wc, int fr, int fq) {
                  if (g.fp8) {
#pragma unroll
                    for (int m = 0; m < 4; ++m)
#pragma unroll
                      for (int n = 0; n < 4; ++n) acc[m][n] = acc[m][n] * scale;
                  }
#pragma unroll
                  for (int m = 0; m < 4; ++m)
#pragma unroll
                    for (int n = 0; n < 4; ++n) {
                      const int col = wc * 64 + n * 16 + fr;
                      if (col < nlim) {
#pragma unroll
                        for (int j = 0; j < 4; ++j) {
                          const int row = wr * 64 + m * 16 + fq * 4 + j;
                          stA(Cb + (long)row * ldc + col, acc[m][n][j]);
                        }
                      } else {
                        const int gc = tn * 128 + col;
                        if (gc < O_END && tm >= NC / 128) {
                          const int lr = (tm - NC / 128) * 128 + wr * 64 + m * 16 + fq * 4;
                          const int bb = lr / T, t = lr % T;
                          const int cq = gc < O_FB ? gc - O_FA : gc - O_FB;
                          act_t* dst = p.FT + ((long)bb * 256 + cq) * (2 * T) + (gc < O_FB ? 0 : T) + t;
                          *reinterpret_cast<uint2*>(dst) = make_uint2(pack2(acc[m][n][0], acc[m][n][1]), pack2(acc[m][n][2], acc[m][n][3]));
                        }
                      }
                    }
                };
      if (g.fp8) {
        const fp8_t* A8 = (const fp8_t*)g.A + (long)tm * 128 * K;
        gemm_tile8p<false>(A8, (const fp8_t*)g.Bt + (long)tn * 128 * K, ntile < ntiles, (const fp8_t*)g.A + (long)tm2 * 128 * K,
                           (const fp8_t*)g.Bt + (long)tn2 * 128 * K, par, primed, K, smem, epi1);
      } else {
        gemm_tile<false>([&](int r) { return Ab + (long)r * K; }, g.Bt + b * g.sB + (long)tn * 128 * K, K, smem, epi1);
      }
    } else {
      auto epi2 = [&](f32x4 (&acc)[4][4], int wr, int wc, int fr, int fq) {
                  const float oscale = g.fp8 ? 1.0f : scale;
                  if (g.fp8) {
#pragma unroll
                    for (int m = 0; m < 4; ++m)
#pragma unroll
                      for (int n = 0; n < 4; ++n) acc[m][n] = acc[m][n] * scale;
                  }
                  if (mode == 2) {
                    const int cb = tn * 128 + wc * 64;
                    if (cb < E_AV && tm >= NC / 128) {
                      const float4* rt = reinterpret_cast<const float4*>(p.ropetab);
#pragma unroll
                      for (int m = 0; m < 4; ++m) {
                        const int t = ((tm - NC / 128) * 128 + wr * 64 + m * 16 + fr) % T;
                        const float4 r01 = rt[(t / GRID_W) * 8 + fq * 2], r23 = rt[(t / GRID_W) * 8 + fq * 2 + 1];
                        const float4 c01 = rt[(t % GRID_W) * 8 + fq * 2], c23 = rt[(t % GRID_W) * 8 + fq * 2 + 1];
                        const float rc[4] = {r01.x, r01.z, r23.x, r23.z}, rs_[4] = {r01.y, r01.w, r23.y, r23.w};
                        const float cc[4] = {c01.x, c01.z, c23.x, c23.z}, cs_[4] = {c01.y, c01.w, c23.y, c23.w};
#pragma unroll
                        for (int j = 0; j < 4; ++j) {
                          const float a1 = acc[m][0][j], a2 = acc[m][1][j], b1 = acc[m][2][j], b2 = acc[m][3][j];
                          acc[m][0][j] = a1 * rc[j] - a2 * rs_[j]; acc[m][1][j] = a1 * rs_[j] + a2 * rc[j];
                          acc[m][2][j] = b1 * cc[j] - b2 * cs_[j]; acc[m][3][j] = b1 * cs_[j] + b2 * cc[j];
                        }
                      }
                    } else if (cb >= E_FF && cb < E_HQ) {
#pragma unroll
                      for (int n = 0; n < 4; ++n) {
                        const float4 lb4 = *reinterpret_cast<const float4*>(p.lbt + cb - E_FF + n * 16 + fq * 4);
                        const float lb[4] = {lb4.x, lb4.y, lb4.z, lb4.w};
#pragma unroll
                        for (int m = 0; m < 4; ++m)
#pragma unroll
                          for (int j = 0; j < 4; ++j)
                            acc[m][n][j] = (1.0f - lb[j]) / (1.0f + __expf(acc[m][n][j]));
                      }
                    }
                  }
#pragma unroll
                  for (int m = 0; m < 4; ++m) {
                    const int row = wr * 64 + m * 16 + fr;
#pragma unroll
                    for (int n = 0; n < 4; ++n) {
                      const int col = wc * 64 + n * 16 + fq * 4;
                      if (col < nlim) {
                        if (g.out8)
                          *reinterpret_cast<unsigned*>(reinterpret_cast<fp8_t*>(g.C) + b * g.sC + ((long)tm * 128 + row) * ldc + tn * 128 + col) =
                              pack4_fp8(acc[m][n][0] * oscale, acc[m][n][1] * oscale, acc[m][n][2] * oscale, acc[m][n][3] * oscale);
                        else
                          *reinterpret_cast<uint2*>(Cb + (long)row * ldc + col) =
                              make_uint2(pack2(acc[m][n][0] * oscale, acc[m][n][1] * oscale), pack2(acc[m][n][2] * oscale, acc[m][n][3] * oscale));
                      }
                    }
                  }
                };
      if (g.fp8) {
        const fp8_t* A8 = (const fp8_t*)g.A + (long)tm * 128 * K;
        gemm_tile8p<true>(A8, (const fp8_t*)g.Bt + (long)tn * 128 * K, ntile < ntiles, (const fp8_t*)g.A + (long)tm2 * 128 * K,
                          (const fp8_t*)g.Bt + (long)tn2 * 128 * K, par, primed, K, smem, epi2);
      } else {
        gemm_tile<true>([&](int r) { return Ab + (long)r * K; }, g.Bt + b * g.sB + (long)tn * 128 * K, K, smem, epi2);
      }
    }
    tile = ntile;
  }
}

template <class RowMap>
__device__ __forceinline__ void conv_tile_rm(const float* src, int lds_, int Nvalid, int k0, int n0, act_t* dst, int ldd, float* tile, RowMap rm) {
  const int tid = threadIdx.x;
  {
    const int r = tid >> 5, c4 = (tid & 31) * 4;
    float4 v[8];
#pragma unroll
    for (int rr = 0; rr < 8; ++rr) {
      v[rr] = make_float4(0.f, 0.f, 0.f, 0.f);
      if (n0 + c4 < Nvalid) v[rr] = *reinterpret_cast<const float4*>(src + (long)(k0 + r + rr * 8) * lds_ + n0 + c4);
    }
#pragma unroll
    for (int rr = 0; rr < 8; ++rr) {
      float* t = tile + (r + rr * 8) * 129 + c4;
      t[0] = v[rr].x; t[1] = v[rr].y; t[2] = v[rr].z; t[3] = v[rr].w;
    }
  }
  __syncthreads();
  {
    const int n = tid >> 1, ks = (tid & 1) * 32;
    if (n0 + n < Nvalid) {
      unsigned w[16];
#pragma unroll
      for (int i = 0; i < 16; ++i) w[i] = pack2(tile[(ks + 2 * i) * 129 + n], tile[(ks + 2 * i + 1) * 129 + n]);
      uint4* d = reinterpret_cast<uint4*>(dst + (long)rm(n) * ldd + k0 + ks);
      d[0] = make_uint4(w[0], w[1], w[2], w[3]);
      d[1] = make_uint4(w[4], w[5], w[6], w[7]);
      d[2] = make_uint4(w[8], w[9], w[10], w[11]);
      d[3] = make_uint4(w[12], w[13], w[14], w[15]);
    }
  }
  __syncthreads();
}

template <class RowMap>
__device__ __forceinline__ void conv_tile8_rm(const float* src, int lds_, int k0, int n0, fp8_t* dst, int ldd, float* tile, float scale, RowMap rm, int Nvalid = 1 << 30) {
  const int tid = threadIdx.x;
  {
    const int r = tid >> 5, c4 = (tid & 31) * 4;
    float4 v[8];
#pragma unroll
    for (int rr = 0; rr < 8; ++rr) {
      v[rr] = make_float4(0.f, 0.f, 0.f, 0.f);
      if (n0 + c4 < Nvalid) v[rr] = *reinterpret_cast<const float4*>(src + (long)(k0 + r + rr * 8) * lds_ + n0 + c4);
    }
#pragma unroll
    for (int rr = 0; rr < 8; ++rr) {
      float* t = tile + (r + rr * 8) * 129 + c4;
      t[0] = v[rr].x; t[1] = v[rr].y; t[2] = v[rr].z; t[3] = v[rr].w;
    }
  }
  __syncthreads();
  if ((threadIdx.x >> 1) + n0 < Nvalid) {
    const int n = tid >> 1, ks = (tid & 1) * 32;
    unsigned w[8];
#pragma unroll
    for (int i = 0; i < 8; ++i)
      w[i] = pack4_fp8(tile[(ks + 4 * i) * 129 + n] * scale, tile[(ks + 4 * i + 1) * 129 + n] * scale,
                       tile[(ks + 4 * i + 2) * 129 + n] * scale, tile[(ks + 4 * i + 3) * 129 + n] * scale);
    uint4* d = reinterpret_cast<uint4*>(dst + (long)rm(n) * ldd + k0 + ks);
    d[0] = make_uint4(w[0], w[1], w[2], w[3]);
    d[1] = make_uint4(w[4], w[5], w[6], w[7]);
  }
  __syncthreads();
}

__device__ __forceinline__ void conv_tile(const float* src, int lds_, int Nvalid, int k0, int n0, act_t* dst, int ldd, float* tile) {
  conv_tile_rm(src, lds_, Nvalid, k0, n0, dst, ldd, tile, [=](int n) { return n0 + n; });
}

struct ConvJob { const float* src; fp8_t* dst; int lds, ldd, k0, n0, rbase, ra, rb; };
__device__ __forceinline__ void phase_convert_experts(const Params& p, int l, unsigned char* smem, int blk, int nblk) {
  float* tile = (float*)smem;
  const int per_e = 192, total = NEXP * per_e;
  fp8_t* Wup = l == 0 ? p.W8up : p.W8up1;
  fp8_t* Wdn = l == 0 ? p.W8down : p.W8down1;
  const int tid = threadIdx.x;
  auto mkjob = [&](int job) -> ConvJob {
    const int e = job / per_e, j = job % per_e;
    ConvJob c;
    if (j < 128) {
      const int up = j >> 6, jj = j & 63;
      const int kt = jj >> 2, fp = jj & 3;
      c.src = (up ? p.w_eu : p.w_eg) + ((long)(l * NEXP + e) * D) * DFF;
      c.dst = Wup + (long)e * 1024 * D; c.lds = DFF; c.ldd = D; c.k0 = kt * 64; c.n0 = fp * 128;
      c.rbase = fp * 256 + up * 32; c.ra = 128; c.rb = 64;
    } else {
      const int jj = j - 128;
      const int kt = jj >> 3, nt = jj & 7;
      c.src = p.w_ed + ((long)(l * NEXP + e) * DFF) * D;
      c.dst = Wdn + (long)e * 1024 * DFF; c.lds = D; c.ldd = DFF; c.k0 = kt * 64; c.n0 = nt * 128;
      c.rbase = nt * 128; c.ra = 64; c.rb = 32;
    }
    return c;
  };
  float4 v[8];
  auto ld = [&](const ConvJob& c) {
    const int r = tid >> 5, c4 = (tid & 31) * 4;
#pragma unroll
    for (int rr = 0; rr < 8; ++rr) v[rr] = *reinterpret_cast<const float4*>(c.src + (long)(c.k0 + r + rr * 8) * c.lds + c.n0 + c4);
  };
  int job = blk;
  if (job >= total) return;
  ConvJob cur = mkjob(job);
  ld(cur);
  while (job < total) {
    {
      const int r = tid >> 5, c4 = (tid & 31) * 4;
#pragma unroll
      for (int rr = 0; rr < 8; ++rr) {
        float* t = tile + (r + rr * 8) * 129 + c4;
        t[0] = v[rr].x; t[1] = v[rr].y; t[2] = v[rr].z; t[3] = v[rr].w;
      }
    }
    __syncthreads();
    const int nxt = job + nblk;
    const ConvJob nj = mkjob(min(nxt, total - 1));
    ld(nj);
    {
      const int n = tid >> 1, ks = (tid & 1) * 32;
      unsigned w[8];
#pragma unroll
      for (int i = 0; i < 8; ++i)
        w[i] = pack4_fp8(tile[(ks + 4 * i) * 129 + n] * SW8, tile[(ks + 4 * i + 1) * 129 + n] * SW8,
                         tile[(ks + 4 * i + 2) * 129 + n] * SW8, tile[(ks + 4 * i + 3) * 129 + n] * SW8);
      const int row = cur.rbase + (n >> 6) * cur.ra + ((n >> 5) & 1) * cur.rb + (n & 31);
      uint4* d = reinterpret_cast<uint4*>(cur.dst + (long)row * cur.ldd + cur.k0 + ks);
      d[0] = make_uint4(w[0], w[1], w[2], w[3]);
      d[1] = make_uint4(w[4], w[5], w[6], w[7]);
    }
    __syncthreads();
    cur = nj;
    job = nxt;
  }
}

__device__ __forceinline__ void phase_moe(const Params& p, int l, bool down, unsigned char* smem) {
  const int* cntp = p.cnt + l * NEXP * 64;
  int total = 0;
  for (int e = 0; e < NEXP; ++e) total += ((cntp[e * 64] + 127) >> 7) * 8;
  for (int tile = blockIdx.x; tile < total; tile += gridDim.x) {
    int e = 0, tb = 0, rowoff = 0;
    for (; e < NEXP - 1; ++e) {
      const int c = cntp[e * 64];
      const int nt = ((c + 127) >> 7) * 8;
      if (tile < tb + nt) break;
      tb += nt; rowoff += c;
    }
    const int c = cntp[e * 64];
    const int lt = tile - tb, mt = lt >> 3, nt = lt & 7;
    const int rows_valid = min(128, c - mt * 128);
    const int* lst = p.list + (long)(l * NEXP + e) * NR + mt * 128;
    const long hrow0 = (long)rowoff + mt * 128;
    if (!down) {
      gemm_tile8<true>([&](int r) { return p.u8 + (long)(lst[min(r, rows_valid - 1)] >> 1) * D; },
                (l == 0 ? p.W8up : p.W8up1) + ((long)e * 1024 + nt * 128) * D, D, smem,
                [&](f32x4 (&acc)[4][4], int wr, int wc, int fr, int fq) {
                  constexpr float dq = 1.0f / (SU8 * SW8);
#pragma unroll
                  for (int m = 0; m < 4; ++m) {
                    const int row = wr * 64 + m * 16 + fr;
                    if (row < rows_valid) {
#pragma unroll
                      for (int n = 0; n < 2; ++n) {
                        float hv[4];
#pragma unroll
                        for (int j = 0; j < 4; ++j) {
                          const float g = acc[m][n][j] * dq, uu = acc[m][n + 2][j] * dq;
                          hv[j] = g / (1.0f + __expf(-g)) * uu * SH8;
                        }
                        *reinterpret_cast<unsigned*>(p.H8 + (hrow0 + row) * DFF + nt * 64 + wc * 32 + n * 16 + fq * 4) =
                            pack4_fp8(hv[0], hv[1], hv[2], hv[3]);
                      }
                    }
                  }
                });
    } else {
      const fp8_t* Ab = p.H8 + hrow0 * DFF;
      gemm_tile8<true>([&](int r) { return Ab + (long)r * DFF; }, (l == 0 ? p.W8down : p.W8down1) + ((long)e * 1024 + nt * 128) * DFF, DFF, smem,
                [&](f32x4 (&acc)[4][4], int wr, int wc, int fr, int fq) {
                  constexpr float dq = 1.0f / (SH8 * SW8);
#pragma unroll
                  for (int m = 0; m < 4; ++m) {
                    const int row = wr * 64 + m * 16 + fr;
                    if (row < rows_valid) {
                      const int ts = lst[row];
                      const float w = p.ew[ts] * dq;
#pragma unroll
                      for (int n = 0; n < 4; ++n)
                        *reinterpret_cast<uint2*>(p.Y + (long)ts * D + nt * 128 + wc * 64 + n * 16 + fq * 4) =
                            make_uint2(pack2(acc[m][n][0] * w, acc[m][n][1] * w), pack2(acc[m][n][2] * w, acc[m][n][3] * w));
                    }
                  }
                });
    }
  }
}

__device__ __forceinline__ void phase_convert_dense(const Params& p, unsigned char* smem) {
  float* tile = (float*)smem;
  const int J0 = 16 * 26, J1 = J0 + 128, J2 = J1 + 16 * 19, J3 = J2 + 128;
  const int nb = (int)gridDim.x, blk = (int)blockIdx.x;
  const bool modblk = blk < MOD_ITEMS && nb > MOD_ITEMS;
  if (nb <= MOD_ITEMS) { for (int it = blk; it < MOD_ITEMS; it += nb) mod_item(p, it, smem); }
  else if (modblk) mod_item(p, blk, smem);
  int job, jstep, jend = J3;
  if (nb <= MOD_ITEMS) { job = blk; jstep = nb; }
  else if (modblk) { job = blk; jstep = J3; }
  else { job = MOD_ITEMS + (blk - MOD_ITEMS); jstep = nb - MOD_ITEMS; }
  for (; job < jend; job += jstep) {
    if (job < J0) { int j = job; const int n0 = (j % 26) * 128; conv_tile8_rm(p.w_in_even, IN_EVEN, (j / 26) * 64, n0, p.W8in_even, D, tile, SW8, [=](int n) { return n0 + n; }); }
    else if (job < J1) { int j = job - J0; const int n0 = (j % 8) * 128; conv_tile8_rm(p.w_out_even, D, (j / 8) * 64, n0, p.W8out_even, D, tile, SW8, [=](int n) { return n0 + n; }); }
    else if (job < J2) { int j = job - J1; const int n0 = (j % 19) * 128; conv_tile8_rm(p.w_in_odd, IN_ODD, (j / 19) * 64, n0, p.W8in_odd, D, tile, SW8, [=](int n) { return n0 + n; }, O_FA); }
    else { int j = job - J2; const int n0 = (j % 8) * 128; conv_tile8_rm(p.w_out_odd, D, (j / 8) * 64, n0, p.W8out_odd, D, tile, SW8, [=](int n) { return n0 + n; }); }
  }
}

__device__ __forceinline__ void phase_fold_z(const Params& p, long gtid, long gstride, float* tab) {
  if (threadIdx.x < 64) {
    float sn, cs;
    sincospif((float)threadIdx.x * (1.0f / 32.0f), &sn, &cs);
    tab[threadIdx.x] = cs; tab[64 + threadIdx.x] = -sn;
  }
  __syncthreads();
  for (long i = gtid; i < (long)256 * D; i += gstride) {
    const int k = (int)(i % D), col = (int)(i / D);
    const int g = col >> 6, cp = col & 63;
    const float* wz = p.w_in_odd + (long)k * IN_ODD + O_Z + g * 64;
    float s0 = 0.f, s1 = 0.f;
    float4 wv[16];
#pragma unroll
    for (int q = 0; q < 16; ++q) wv[q] = reinterpret_cast<const float4*>(wz)[q];
#pragma unroll
    for (int q = 0; q < 16; ++q) {
      const int i0 = ((4 * q) * cp) & 63, i1 = ((4 * q + 1) * cp) & 63, i2 = ((4 * q + 2) * cp) & 63, i3 = ((4 * q + 3) * cp) & 63;
      s0 += wv[q].x * tab[i0] + wv[q].y * tab[i1] + wv[q].z * tab[i2] + wv[q].w * tab[i3];
      s1 += wv[q].x * tab[64 + i0] + wv[q].y * tab[64 + i1] + wv[q].z * tab[64 + i2] + wv[q].w * tab[64 + i3];
    }
    const unsigned q0 = pack4_fp8(s0 * SW8, s1 * SW8, 0.f, 0.f);
    p.W8in_odd[(long)(O_FA + col) * D + k] = (unsigned char)(q0 & 0xffu);
    p.W8in_odd[(long)(O_FA + 256 + col) * D + k] = (unsigned char)((q0 >> 8) & 0xffu);
  }
  for (long i = gtid; i < (long)(IN_ODD_PAD - O_END) * D; i += gstride) p.W8in_odd[(long)O_END * D + i] = 0;
}

__device__ __forceinline__ void phase_cmat(const Params& p, long gtid, long gstride) {
  for (long i = gtid; i < (long)T * T; i += gstride) {
    const int t = (int)(i % T), tp = (int)(i / T);
    float sn, cs;
    sincospif((float)((t * tp) & (T - 1)) * (2.0f / T), &sn, &cs);
    stA(p.Cmat + (long)tp * 2 * T + t, cs);
    stA(p.Cmat + (long)tp * 2 * T + T + t, sn);
  }
}

__device__ __forceinline__ void row_stats(const float4 (&v)[4], float& mu, float& rs) {
  float s = 0.f;
#pragma unroll
  for (int i = 0; i < 4; ++i) s += v[i].x + v[i].y + v[i].z + v[i].w;
  mu = wave_sum(s) * (1.0f / D);
  float q = 0.f;
#pragma unroll
  for (int i = 0; i < 4; ++i) {
    float a = v[i].x - mu, b = v[i].y - mu, c = v[i].z - mu, d = v[i].w - mu;
    q += a * a + b * b + c * c + d * d;
  }
  rs = 1.0f / sqrtf(wave_sum(q) * (1.0f / D) + LN_EPS);
}

__device__ __forceinline__ void phase_lnmod_first(const Params& p) {
  const int lane = threadIdx.x & 63;
  const int nw = (int)gridDim.x * 4, wi = (int)blockIdx.x * 4 + (int)(threadIdx.x >> 6);
  const int rpw = (NR + nw - 1) / nw;
  const long r0 = (long)wi * rpw, r1 = min((long)NR, r0 + rpw);
  float4 shv[4], scv[4];
  int cur_bb = -2;
  float4 hv[4];
  auto load_row = [&](long row) {
    const float4* h = reinterpret_cast<const float4*>(hrow_in(p, row));
#pragma unroll
    for (int i = 0; i < 4; ++i) hv[i] = h[i * 64 + lane];
  };
  if (r0 < r1) load_row(r0);
  for (long row = r0; row < r1; ++row) {
    const int bb = row < NC ? NB : (int)((row - NC) / T);
    if (bb != cur_bb) {
      cur_bb = bb;
      const float* md = p.mod + (long)bb * 6 * D;
#pragma unroll
      for (int i = 0; i < 4; ++i) {
        shv[i] = reinterpret_cast<const float4*>(md)[i * 64 + lane];
        scv[i] = reinterpret_cast<const float4*>(md + D)[i * 64 + lane];
      }
    }
    float4 v[4];
#pragma unroll
    for (int i = 0; i < 4; ++i) v[i] = hv[i];
    load_row(min(row + 1, r1 - 1));
    float mu, rs;
    row_stats(v, mu, rs);
#pragma unroll
    for (int i = 0; i < 4; ++i) {
      const float a = (v[i].x - mu) * rs * (1.f + scv[i].x) + shv[i].x, b = (v[i].y - mu) * rs * (1.f + scv[i].y) + shv[i].y;
      const float c = (v[i].z - mu) * rs * (1.f + scv[i].z) + shv[i].z, d = (v[i].w - mu) * rs * (1.f + scv[i].w) + shv[i].w;
      reinterpret_cast<unsigned*>(p.u8 + row * D)[i * 64 + lane] = pack4_fp8(a * SU8, b * SU8, c * SU8, d * SU8);
    }
  }
}

__device__ __forceinline__ act_t* hrow16(const Params& p, long row) {
  return row < NC ? reinterpret_cast<act_t*>(p.hc) + row * D
                  : reinterpret_cast<act_t*>(reinterpret_cast<char*>(p.out) + (row - NC) * (long)(4 * D) + 2 * D);
}
template <int R_UNUSED>
__device__ __forceinline__ void phase_resid_ln(const Params& p, int l, int sub, long row_lo, long row_hi, unsigned char* smem) {
  const int lane = threadIdx.x & 63;
  int* cntL = (int*)smem;
  int* nent = cntL + 16;
  int* entL = cntL + 32;
  float* wT = (float*)(smem + 4096);
  if (sub == 0) {
    if (threadIdx.x < 32) cntL[threadIdx.x] = 0;
    {
      float4 wr4[16];
#pragma unroll
      for (int j = 0; j < 4; ++j)
#pragma unroll
        for (int q = 0; q < 4; ++q) wr4[j * 4 + q] = reinterpret_cast<const float4*>(p.w_router + (long)(threadIdx.x + 256 * j) * NEXP)[q];
#pragma unroll
      for (int j = 0; j < 4; ++j)
#pragma unroll
        for (int q = 0; q < 4; ++q) {
          const int k = threadIdx.x + 256 * j;
          wT[(q * 4 + 0) * D + k] = wr4[j * 4 + q].x; wT[(q * 4 + 1) * D + k] = wr4[j * 4 + q].y;
          wT[(q * 4 + 2) * D + k] = wr4[j * 4 + q].z; wT[(q * 4 + 3) * D + k] = wr4[j * 4 + q].w;
        }
    }
    __syncthreads();
  }
  const bool last = (sub == 1 && l == 1);
  const int nw = (int)gridDim.x * 4, wi = (int)blockIdx.x * 4 + (int)(threadIdx.x >> 6);
  const int rpw = ((int)(row_hi - row_lo) + nw - 1) / nw;
  const long r0 = row_lo + (long)wi * rpw, r1 = min(row_hi, r0 + rpw);
  const float4* lgp = reinterpret_cast<const float4*>(p.ln_g + (l * 2 + sub) * D);
  const float4* lbp = reinterpret_cast<const float4*>(p.ln_b + (l * 2 + sub) * D);
  float4 lgv[4], lbv[4];
  if (R_UNUSED != 1) {
#pragma unroll
    for (int i = 0; i < 4; ++i) { lgv[i] = lgp[i * 64 + lane]; lbv[i] = lbp[i * 64 + lane]; }
  }
  float4 gv[4], shv[4], scv[4];
  int cur_bb = -2;
  const bool first = (l == 0 && sub == 0);
  float4 hv[4];
  uint2 hb[4];
  uint2 mv[4], m2v[4];
  auto load_row = [&](long row) {
    const uint2* m = reinterpret_cast<const uint2*>(sub == 0 ? p.M + row * D : p.Y + row * 2 * D);
    if (first) {
      const float4* hin = reinterpret_cast<const float4*>(hrow_in(p, row));
#pragma unroll
      for (int i = 0; i < 4; ++i) hv[i] = hin[i * 64 + lane];
    } else {
      const uint2* hin = reinterpret_cast<const uint2*>(hrow16(p, row));
#pragma unroll
      for (int i = 0; i < 4; ++i) hb[i] = hin[i * 64 + lane];
    }
#pragma unroll
    for (int i = 0; i < 4; ++i) {
      mv[i] = m[i * 64 + lane];
      if (sub == 1) m2v[i] = m[256 + i * 64 + lane];
    }
  };
  if (r0 < r1) load_row(r0);
  for (long row = r0; row < r1; ++row) {
    const int bb = row < NC ? NB : (int)((row - NC) / T);
    if (bb != cur_bb) {
      cur_bb = bb;
      const float* md = p.mod + ((long)l * (NB + 1) + bb) * 6 * D;
      const float* md2 = (sub == 0) ? md + 3 * D : p.mod + ((long)(NB + 1) + bb) * 6 * D;
#pragma unroll
      for (int i = 0; i < 4; ++i) {
        gv[i] = reinterpret_cast<const float4*>(md + (sub == 0 ? 2 : 5) * D)[i * 64 + lane];
        shv[i] = reinterpret_cast<const float4*>(md2)[i * 64 + lane];
        scv[i] = reinterpret_cast<const float4*>(md2 + D)[i * 64 + lane];
      }
    }
    float4 v[4];
#pragma unroll
    for (int i = 0; i < 4; ++i) {
      float m0 = bf_lo(mv[i].x), m1 = bf_hi(mv[i].x), m2_ = bf_lo(mv[i].y), m3 = bf_hi(mv[i].y);
      if (sub == 1) { m0 += bf_lo(m2v[i].x); m1 += bf_hi(m2v[i].x); m2_ += bf_lo(m2v[i].y); m3 += bf_hi(m2v[i].y); }
      const float h0 = first ? hv[i].x : bf_lo(hb[i].x), h1 = first ? hv[i].y : bf_hi(hb[i].x);
      const float h2 = first ? hv[i].z : bf_lo(hb[i].y), h3 = first ? hv[i].w : bf_hi(hb[i].y);
      v[i].x = ALPHA * h0 + gv[i].x * m0;
      v[i].y = ALPHA * h1 + gv[i].y * m1;
      v[i].z = ALPHA * h2 + gv[i].z * m2_;
      v[i].w = ALPHA * h3 + gv[i].w * m3;
    }
    load_row(min(row + 1, r1 - 1));
    if (R_UNUSED == 1) {
#pragma unroll
      for (int i = 0; i < 4; ++i) { lgv[i] = lgp[i * 64 + lane]; lbv[i] = lbp[i * 64 + lane]; }
    }
    float mu, rs;
    row_stats(v, mu, rs);
#pragma unroll
    for (int i = 0; i < 4; ++i) {
      v[i].x = (v[i].x - mu) * rs * lgv[i].x + lbv[i].x;
      v[i].y = (v[i].y - mu) * rs * lgv[i].y + lbv[i].y;
      v[i].z = (v[i].z - mu) * rs * lgv[i].z + lbv[i].z;
      v[i].w = (v[i].w - mu) * rs * lgv[i].w + lbv[i].w;
    }
    if (last) {
      float4* hout = reinterpret_cast<float4*>(p.out + (row - NC) * D);
#pragma unroll
      for (int i = 0; i < 4; ++i) hout[i * 64 + lane] = v[i];
      continue;
    }
    uint2 hq[4];
#pragma unroll
    for (int i = 0; i < 4; ++i) {
      hq[i] = make_uint2(pack2(v[i].x, v[i].y), pack2(v[i].z, v[i].w));
      v[i].x = bf_lo(hq[i].x); v[i].y = bf_hi(hq[i].x); v[i].z = bf_lo(hq[i].y); v[i].w = bf_hi(hq[i].y);
    }
    row_stats(v, mu, rs);
    float lo[NEXP];
#pragma unroll
    for (int e = 0; e < NEXP; ++e) lo[e] = 0.f;
    uint2 up[4];
#pragma unroll
    for (int i = 0; i < 4; ++i) {
      float uv[4];
      uv[0] = (v[i].x - mu) * rs * (1.f + scv[i].x) + shv[i].x;
      uv[1] = (v[i].y - mu) * rs * (1.f + scv[i].y) + shv[i].y;
      uv[2] = (v[i].z - mu) * rs * (1.f + scv[i].z) + shv[i].z;
      uv[3] = (v[i].w - mu) * rs * (1.f + scv[i].w) + shv[i].w;
      up[i] = make_uint2(pack4_fp8(uv[0] * SU8, uv[1] * SU8, uv[2] * SU8, uv[3] * SU8), 0u);
      if (sub == 0) {
#pragma unroll
        for (int e = 0; e < NEXP; ++e) {
          const float4 w4 = *reinterpret_cast<const float4*>(wT + e * D + (i * 64 + lane) * 4);
          lo[e] += uv[0] * w4.x + uv[1] * w4.y + uv[2] * w4.z + uv[3] * w4.w;
          if ((e & 3) == 3) __builtin_amdgcn_sched_barrier(0);
        }
      }
    }
    int ge1 = 0, ge2 = 0;
    float w1 = 0.f, w2 = 0.f;
    if (sub == 0) {
      float mine = 0.f;
#pragma unroll
      for (int e = 0; e < NEXP; ++e) {
        const float rsum = row_sum16(lo[e]);
        mine = ((lane & 15) == e) ? rsum : mine;
      }
      mine += __shfl_xor(mine, 16);
      mine += __shfl_xor(mine, 32);
#pragma unroll
      for (int e = 0; e < NEXP; ++e) lo[e] = __int_as_float(__builtin_amdgcn_readlane(__float_as_int(mine), e));
      float mx = lo[0];
#pragma unroll
      for (int e = 1; e < NEXP; ++e) mx = fmaxf(mx, lo[e]);
      float sum = 0.f;
#pragma unroll
      for (int e = 0; e < NEXP; ++e) { lo[e] = __expf(lo[e] - mx); sum += lo[e]; }
      const float inv = 1.0f / sum;
      float bestg = -1e30f, gp1 = 0.f, gp2 = 0.f;
#pragma unroll
      for (int gq = 0; gq < 4; ++gq) {
        float s1 = -1e30f, s2 = -1e30f, p1 = 0.f, p2 = 0.f;
        int e1 = 0, e2 = 0;
#pragma unroll
        for (int j = 0; j < 4; ++j) {
          const int e = gq * 4 + j;
          const float pe = lo[e] * inv;
          const float se = pe + p.b_router[e];
          if (se > s1) { s2 = s1; p2 = p1; e2 = e1; s1 = se; p1 = pe; e1 = e; }
          else if (se > s2) { s2 = se; p2 = pe; e2 = e; }
        }
        const float gs = s1 + s2;
        if (gs > bestg) { bestg = gs; ge1 = e1; ge2 = e2; gp1 = p1; gp2 = p2; }
      }
      const float wsum = gp1 + gp2;
      w1 = gp1 / wsum; w2 = gp2 / wsum;
    }
    {
      uint2* hout = reinterpret_cast<uint2*>(hrow16(p, row));
#pragma unroll
      for (int i = 0; i < 4; ++i) hout[i * 64 + lane] = hq[i];
    }
#pragma unroll
    for (int i = 0; i < 4; ++i) reinterpret_cast<unsigned*>(p.u8 + row * D)[i * 64 + lane] = up[i].x;
    if (sub == 0 && lane == 0) {
      p.ew[row * 2 + 0] = w1; p.ew[row * 2 + 1] = w2;
      const int lp1 = atomicAdd(cntL + ge1, 1), lp2 = atomicAdd(cntL + ge2, 1);
      const int ei = atomicAdd(nent, 2);
      entL[2 * ei] = ((int)(row * 2) << 4) | ge1; entL[2 * ei + 1] = lp1;
      entL[2 * ei + 2] = ((int)(row * 2 + 1) << 4) | ge2; entL[2 * ei + 3] = lp2;
    }
  }
  if (sub == 0) {
    __syncthreads();
    if (threadIdx.x < NEXP) {
      const int c = cntL[threadIdx.x];
      cntL[threadIdx.x] = c ? atomicAdd(p.cnt + (l * NEXP + threadIdx.x) * 64, c) : 0;
    }
    __syncthreads();
    const int ne = *nent;
    for (int i = threadIdx.x; i < ne; i += 256) {
      const int key = entL[2 * i], lp = entL[2 * i + 1];
      const int e = key & 15;
      p.list[(long)(l * NEXP + e) * NR + cntL[e] + lp] = key >> 4;
    }
    __syncthreads();
  }
}

#define LOOP(n) for (long i = gtid; i < (long)(n); i += gstride)

#ifdef ONLY_PHASE
#define PH(n, ...) if (ONLY_PHASE == n) { __VA_ARGS__ }
#define GSYNC()
#else
#define PH(n, ...) { __VA_ARGS__ }
#define GSYNC() xcd_barrier(xb)
#endif

__global__ void __launch_bounds__(256, 2) mega_kernel(Params p) {
  cg::grid_group grid = cg::this_grid();
  __shared__ __attribute__((aligned(16))) unsigned char smem[SMEM_BYTES + 16];
  if (threadIdx.x == 0) *reinterpret_cast<uint4*>(smem + SMEM_BYTES) = make_uint4(0u, 0u, 0u, 0u);
  __syncthreads();
  XcdBarrier xb = xcd_barrier_post(p.bar, (volatile LAS unsigned*)(smem + SMEM_BYTES));
  const long gtid = (long)blockIdx.x * blockDim.x + threadIdx.x;
  const long gstride = (long)gridDim.x * blockDim.x;
  const int nsb = min(256, (int)gridDim.x / 2);
  PH(0,
    if (gtid < 2 * NEXP) p.cnt[gtid * 64] = 0;
    phase_convert_dense(p, smem);
    phase_fold_z(p, gtid, gstride, (float*)(smem + 65536));
    LOOP(1024) ph_tables(p, i);)
#ifndef ONLY_PHASE
  if (p.use_cg_sync) grid.sync();
#endif
  GSYNC();
  PH(1, phase_lnmod_first(p);)
  GSYNC();
  PH(2, phase_gemm(p, GemmJob{(const act_t*)p.u8, (const act_t*)p.W8in_even, p.P, 0, 0, 0, 1, NR / 128, IN_EVEN / 128, D, PW, IN_EVEN, 2, 1.0f / (SU8 * SW8), 1, 0}, smem);)
  GSYNC();
  PH(3,
    if ((int)blockIdx.x < nsb) phase_scan<0>(p, smem, blockIdx.x, nsb);
    else phase_attn(p, smem, blockIdx.x - nsb, gridDim.x - nsb);)
  GSYNC();
  PH(4, phase_combine<0>(p);)
  GSYNC();
  PH(5,
    phase_gemm(p, GemmJob{(const act_t*)p.O8, (const act_t*)p.W8out_even, p.M, 0, 0, 0, 1, NR / 128, D / 128, D, D, D, 0, 1.0f / (SO8 * SW8), 1, 0}, smem);
    {
      const int rem = ((NR / 128) * (D / 128)) % (int)gridDim.x;
      if (rem > 0 && rem < (int)gridDim.x) { if ((int)blockIdx.x >= rem) phase_convert_experts(p, 0, smem, blockIdx.x - rem, gridDim.x - rem); }
      else phase_convert_experts(p, 0, smem, blockIdx.x, gridDim.x);
    })
  GSYNC();
  PH(6, phase_resid_ln<1>(p, 0, 0, 0, NR, smem);)
  GSYNC();
  PH(7, phase_moe(p, 0, false, smem);)
  GSYNC();
  PH(8, phase_moe(p, 0, true, smem);)
  GSYNC();
  PH(9, phase_resid_ln<2>(p, 0, 1, 0, NR, smem); phase_cmat(p, gtid, gstride);)
  GSYNC();
  PH(10, phase_gemm(p, GemmJob{(const act_t*)p.u8, (const act_t*)p.W8in_odd, p.P, 0, 0, 0, 1, NR / 128, IN_ODD_PAD / 128, D, PW, O_FA, 1, 1.0f / (SU8 * SW8), 1, 0}, smem);)
  GSYNC();
  PH(11, phase_gla_decay(p);)
  GSYNC();
  PH(12,
    if ((int)blockIdx.x < nsb) phase_scan<1>(p, smem, blockIdx.x, nsb);
    else {
      phase_gemm(p, GemmJob{p.Cmat, p.FT, (act_t*)(p.O8 + (long)NC * D + 768), 0, (long)256 * 2 * T, (long)T * D, NB, T / 128, 2, 2 * T, D,
                            256, 0, 0.00276213586400995f * SO8, 0, 1}, smem, blockIdx.x - nsb, gridDim.x - nsb);
      phase_convert_experts(p, 1, smem, blockIdx.x - nsb, gridDim.x - nsb);
    })
  GSYNC();
  PH(13, phase_combine<1>(p);)
  GSYNC();
  PH(14,
    phase_gemm(p, GemmJob{(const act_t*)(p.O8 + (long)NC * D), (const act_t*)p.W8out_odd, p.M + (long)NC * D, 0, 0, 0, 1, NT / 128, D / 128, D, D, D, 0, 1.0f / (SO8 * SW8), 1, 0}, smem);)
  GSYNC();
  PH(15, phase_resid_ln<1>(p, 1, 0, NC, NR, smem);)
  GSYNC();
  PH(16, phase_moe(p, 1, false, smem);)
  GSYNC();
  PH(17, phase_moe(p, 1, true, smem);)
  GSYNC();
  PH(18, phase_resid_ln<2>(p, 1, 1, NC, NR, smem);)
}

static size_t carve(Params& p, char* ws) {
  size_t off = 0;
  auto take = [&](size_t bytes) { char* r = ws + off; off += (bytes + 255) & ~(size_t)255; return r; };
  p.mod = (float*)take(sizeof(float) * 2 * (NB + 1) * 6 * D);
  p.bar = (unsigned*)take(sizeof(unsigned) * XCD_BAR_WORDS);
  p.hc = (float*)take(sizeof(float) * (size_t)NC * D);
  p.costab = (float*)take(sizeof(float) * T);
  p.sintab = (float*)take(sizeof(float) * T);
  p.lbt = (float*)take(sizeof(float) * 1024);
  p.ropetab = (float*)take(sizeof(float) * 64 * 16 * 2);
  p.ew = (float*)take(sizeof(float) * (size_t)NR * 2);
  p.eidx = nullptr;
  p.u = nullptr;
  p.O8 = (unsigned char*)take((size_t)NR * D);
  p.P = (act_t*)take(sizeof(act_t) * (size_t)NR * PW);
  p.OF = (act_t*)take(sizeof(act_t) * (size_t)NR * 768);
  p.OB = (act_t*)take(sizeof(act_t) * (size_t)NR * 768);
  p.M = p.OF;
  p.Cmat = (act_t*)take(sizeof(act_t) * (size_t)T * 2 * T);
  p.FT = (act_t*)take(sizeof(act_t) * (size_t)NB * 256 * 2 * T);
  p.LF = (act_t*)take(sizeof(act_t) * (size_t)2 * NR * 384);
  p.W8up = (unsigned char*)p.Cmat;
  p.W8down = p.W8up + (size_t)NEXP * 1024 * D;
  p.W8up1 = (unsigned char*)take((size_t)NEXP * 1024 * (D + DFF));
  p.W8down1 = p.W8up1 + (size_t)NEXP * 1024 * D;
  p.u8 = (unsigned char*)take((size_t)NR * D);
  p.Y = p.P;
  p.H8 = (unsigned char*)(p.P + (size_t)2 * NR * D);
  p.cnt = (int*)take(sizeof(int) * 2 * NEXP * 64);
  p.list = (int*)take(sizeof(int) * (size_t)2 * NEXP * NR);
  p.Wt_in_even = nullptr;
  p.W8in_even = (unsigned char*)take((size_t)IN_EVEN * D);
  p.Wt_out_even = nullptr;
  p.W8out_even = (unsigned char*)take((size_t)D * D);
  p.Wt_in_odd = nullptr;
  p.W8in_odd = (unsigned char*)take((size_t)IN_ODD_PAD * D);
  p.Wt_out_odd = nullptr;
  p.W8out_odd = (unsigned char*)take((size_t)D * D);
  return off;
}

static void fill_inputs(Params& p, void* const* d_in) {
  const float** f = (const float**)&p;
  for (int i = 0; i < 23; ++i) f[i] = (const float*)d_in[i];
}

extern "C" void kernel_launch(void* const* d_in, const int* in_sizes, int n_in, void* d_out, int out_size,
                              void* d_ws, size_t ws_size, hipStream_t stream) {
  static int grid_blocks = 0;
  if (!grid_blocks) {
    int dev = 0, cus = 0, per_cu = 0;
    (void)hipGetDevice(&dev);
    (void)hipDeviceGetAttribute(&cus, hipDeviceAttributeMultiprocessorCount, dev);
    (void)hipOccupancyMaxActiveBlocksPerMultiprocessor(&per_cu, mega_kernel, 256, 0);
    grid_blocks = cus * per_cu;
  }
  Params p{};
  fill_inputs(p, d_in);
  p.out = (float*)d_out;
  size_t need = carve(p, (char*)d_ws);
  if (need > ws_size) { fprintf(stderr, "workspace too small: need %zu have %zu\n", need, ws_size); return; }
  (void)hipMemsetAsync(p.mod, 0, (size_t)((char*)(p.bar + XCD_BAR_WORDS) - (char*)p.mod), stream);
  void* args[] = {&p};
  hipError_t e = hipLaunchCooperativeKernel((void*)mega_kernel, dim3(grid_blocks), dim3(256), args, 0, stream);
  if (e != hipSuccess) fprintf(stderr, "cooperative launch failed: %s (grid %d)\n", hipGetErrorString(e), grid_blocks);
}
#endif
```

```cpp
#ifndef HOST_TEST
#include <hip/hip_runtime.h>
#include <hip/hip_cooperative_groups.h>
#include <cstdio>
namespace cg = cooperative_groups;
#define DEV __device__ __forceinline__
#else
#include <cmath>
#include <cstdio>
#include <cstdlib>
#include <cstring>
#define DEV static inline
#endif

#ifndef T_BATCH
#define T_BATCH 8
#endif
#ifndef T_SEQ
#define T_SEQ 2048
#endif
#ifndef T_CTX
#define T_CTX 256
#endif

constexpr int D = 1024, NB = T_BATCH, T = T_SEQ, C = T_CTX;
constexpr int NC = NB * C, NT = NB * T, NR = NC + NT;
constexpr int GRID_W = 64;
constexpr int IN_EVEN = 3328, IN_ODD = 2592, PW = 3328;
constexpr int NEXP = 16, DFF = 512;
constexpr float ALPHA = 1.4142135623730951f;
constexpr float LN_EPS = 1e-5f;
constexpr int E_AQ = 0, E_AK = 512, E_AV = 640, E_FF = 768, E_HQ = 1792, E_HI = 2304, E_HG = 2816;
constexpr int O_Q = 0, O_K = 384, O_V = 768, O_RF = 1536, O_G = 1568, O_Z = 2336;

#ifdef HOST_TEST
typedef float act_t;
DEV float ldA(const act_t* p) { return *p; }
DEV void stA(act_t* p, float v) { *p = v; }
#else
typedef unsigned short act_t;
DEV float ldA(const act_t* p) { return __uint_as_float(((unsigned)*p) << 16); }
DEV void stA(act_t* p, float v) {
  unsigned u = __float_as_uint(v);
  u += 0x7fffu + ((u >> 16) & 1u);
  *p = (unsigned short)(u >> 16);
}
#endif

struct Params {
  const float *x, *c, *ctx, *c_ctx, *w_ada, *b_ada, *ln_g, *ln_b, *w_in_even, *attn_sink, *lb_logits, *hgrn_norm,
      *w_out_even, *w_in_odd, *gla_gate_w, *gla_gate_b, *gla_norm, *w_out_odd, *w_router, *b_router, *w_eg, *w_eu,
      *w_ed;
  float* out;
  float *mod, *hc, *costab, *sintab, *lbt, *ew, *ropetab;
  int* eidx;
  act_t *u, *P, *OF, *OB, *M, *LF;
  act_t *Wt_in_even, *Wt_out_even, *Wt_in_odd, *Wt_out_odd;
  act_t *Y, *Cmat, *FT;
  unsigned char *W8up, *W8down, *W8up1, *W8down1, *H8, *u8;
  unsigned char *W8in_even, *W8in_odd;
  unsigned char *W8out_even, *W8out_odd, *O8;
  int *cnt, *list;
  float* listw;
  unsigned* bar;
  int use_cg_sync;
  int pad_;
};

DEV float sigmoidf_(float v) { return 1.0f / (1.0f + expf(-v)); }
DEV float siluf_(float v) { return v / (1.0f + expf(-v)); }

DEV const float* hrow_in(const Params& p, long row) {
  return row < NC ? p.ctx + row * D : p.x + (row - NC) * D;
}
DEV float* hrow(const Params& p, long row) { return row < NC ? p.hc + row * D : p.out + (row - NC) * D; }
DEV const float* modrow(const Params& p, int l, long row) {
  int bb = row < NC ? NB : (int)((row - NC) / T);
  return p.mod + ((long)l * (NB + 1) + bb) * 6 * D;
}

DEV void ph_mod(const Params& p, long i) {
  int j = (int)(i % (6 * D));
  int bb = (int)((i / (6 * D)) % (NB + 1));
  int l = (int)(i / ((long)6 * D * (NB + 1)));
  const float* cv = bb < NB ? p.c + (long)bb * D : p.c_ctx;
  const float* w = p.w_ada + (long)l * D * 6 * D + j;
  float s = p.b_ada[l * 6 * D + j];
  for (int k = 0; k < D; ++k) s += siluf_(cv[k]) * w[(long)k * 6 * D];
  p.mod[i] = s;
}

DEV void ph_tables(const Params& p, long i) {
  if (i < 1024) {
    int pos = (int)(i >> 4), idx = (int)(i & 15);
    float ang = (float)pos * powf(10000.0f, -(float)idx / 16.0f);
    p.ropetab[2 * i] = cosf(ang);
    p.ropetab[2 * i + 1] = sinf(ang);
  }
  if (i < 1024) {
    int dir = (int)(i / 512), col = (int)(i % 512);
    float l0 = p.lb_logits[(dir * 2 + 0) * 512 + col], l1 = p.lb_logits[(dir * 2 + 1) * 512 + col];
    p.lbt[i] = 1.0f / (1.0f + expf(l1 - l0));
  }
}

DEV void ln_mod_row(const float* h, const float* shift, const float* scale, act_t* u) {
  float mu = 0.f;
  for (int k = 0; k < D; ++k) mu += h[k];
  mu *= (1.0f / D);
  float var = 0.f;
  for (int k = 0; k < D; ++k) { float d = h[k] - mu; var += d * d; }
  var *= (1.0f / D);
  float rs = 1.0f / sqrtf(var + LN_EPS);
  for (int k = 0; k < D; ++k) stA(u + k, (h[k] - mu) * rs * (1.0f + scale[k]) + shift[k]);
}

DEV void ph_lnmod_first(const Params& p, long row) {
  const float* m = modrow(p, 0, row);
  ln_mod_row(hrow_in(p, row), m, m + D, p.u + row * D);
}

DEV void gemm_item_act(const act_t* A, const float* W, act_t* Cout, int K, int N, int ldc, long i) {
  int n4 = (int)(i % (N / 4));
  long row = i / (N / 4);
  const act_t* a = A + row * K;
  const float* w = W + n4 * 4;
  float s0 = 0, s1 = 0, s2 = 0, s3 = 0;
  for (int k = 0; k < K; ++k) {
    float av = ldA(a + k);
    const float* wr = w + (long)k * N;
    s0 += av * wr[0]; s1 += av * wr[1]; s2 += av * wr[2]; s3 += av * wr[3];
  }
  act_t* o = Cout + row * ldc + n4 * 4;
  stA(o, s0); stA(o + 1, s1); stA(o + 2, s2); stA(o + 3, s3);
}

DEV void ph_rope(const Params& p, long i) {
  int pr = (int)(i % 32);
  int hh = (int)((i / 32) % 10);
  long lr = i / 320;
  int t = (int)(lr % T);
  int col = hh < 8 ? E_AQ + hh * 64 : E_AK + (hh - 8) * 64;
  int idx = pr & 15;
  int pos = pr < 16 ? t / GRID_W : t % GRID_W;
  int d0 = pr < 16 ? idx : 32 + idx;
  float inv = powf(10000.0f, -(float)idx / 16.0f);
  float ang = (float)pos * inv;
  float cs = cosf(ang), sn = sinf(ang);
  act_t* base = p.P + (NC + lr) * PW + col;
  float x1 = ldA(base + d0), x2 = ldA(base + d0 + 16);
  stA(base + d0, x1 * cs - x2 * sn);
  stA(base + d0 + 16, x1 * sn + x2 * cs);
}

DEV void ph_attn(const Params& p, long i) {
  int h = (int)(i % 8);
  long row = i / 8;
  int kv = h / 4;
  bool lat = row >= NC;
  int b = lat ? (int)((row - NC) / T) : (int)(row / C);
  int t = lat ? (int)((row - NC) % T) : 0;
  float q[64], acc[64];
  const act_t* qp = p.P + row * PW + E_AQ + h * 64;
#pragma unroll
  for (int d = 0; d < 64; ++d) { q[d] = ldA(qp + d) * 0.125f; acc[d] = 0.f; }
  float m = p.attn_sink[h], l = 1.0f;
  int nkeys = C + (lat ? 257 : 0);
  for (int j = 0; j < nkeys; ++j) {
    long krow;
    if (j < C) krow = (long)b * C + j;
    else {
      int kp = t - 128 + (j - C);
      if (kp < 0 || kp >= T) continue;
      krow = NC + (long)b * T + kp;
    }
    const act_t* kptr = p.P + krow * PW + E_AK + kv * 64;
    const act_t* vptr = p.P + krow * PW + E_AV + kv * 64;
    float s = 0.f;
#pragma unroll
    for (int d = 0; d < 64; ++d) s += q[d] * ldA(kptr + d);
    float mn = fmaxf(m, s);
    float sc = expf(m - mn), pj = expf(s - mn);
    l = l * sc + pj;
#pragma unroll
    for (int d = 0; d < 64; ++d) acc[d] = acc[d] * sc + pj * ldA(vptr + d);
    m = mn;
  }
  float il = 1.0f / l;
  act_t* o = p.u + row * D + h * 64;
#pragma unroll
  for (int d = 0; d < 64; ++d) stA(o + d, acc[d] * il);
}

template <int MODE>
DEV void ph_scan(const Params& p, long i) {
  constexpr int DK = MODE == 0 ? 128 : 96;
  constexpr int DV = MODE == 0 ? 128 : 192;
  int e = (int)(i % DV);
  int dir = (int)((i / DV) % 2);
  int h = (int)((i / (2 * DV)) % 4);
  int b = (int)(i / (8 * DV));
  float S[DK];
#pragma unroll
  for (int d = 0; d < DK; ++d) S[d] = 0.f;
  act_t* OD = dir == 0 ? p.OF : p.OB;
  for (int step = 0; step < C + T; ++step) {
    long row;
    if (step < C) row = (long)b * C + (dir == 0 ? step : C - 1 - step);
    else { int tt = step - C; row = NC + (long)b * T + (dir == 0 ? tt : T - 1 - tt); }
    const act_t* pr = p.P + row * PW;
    float o = 0.f;
    if (MODE == 0) {
      float v = ldA(pr + E_HI + h * 128 + e);
      const act_t* zp = pr + E_FF + dir * 512 + h * 128;
      const act_t* qp = pr + E_HQ + h * 128;
      const float* lb = p.lbt + dir * 512 + h * 128;
#pragma unroll
      for (int d = 0; d < DK; ++d) {
        float f = lb[d] + (1.0f - lb[d]) * sigmoidf_(ldA(zp + d));
        S[d] = f * S[d] + (1.0f - f) * v;
        o += ldA(qp + d) * S[d];
      }
      stA(OD + row * 768 + h * 128 + e, o);
    } else {
      float v = ldA(pr + O_V + h * 192 + e);
      const act_t* kp = pr + O_K + h * 96;
      const act_t* qp = pr + O_Q + h * 96;
      const act_t* lf = p.LF + ((long)dir * NR + row) * 384 + h * 96;
#pragma unroll
      for (int d = 0; d < DK; ++d) {
        float f = expf(ldA(lf + d));
        S[d] = f * S[d] + ldA(kp + d) * v;
        o += ldA(qp + d) * S[d];
      }
      stA(OD + row * 768 + h * 192 + e, o * 0.10206207261596575f);
    }
  }
}

template <int MODE>
DEV void ph_combine(const Params& p, long i) {
  constexpr int DV = MODE == 0 ? 128 : 192;
  int h = (int)(i % 4);
  long row = (MODE == 0) ? i / 4 : NC + i / 4;
  const act_t* f = p.OF + row * 768 + h * DV;
  const act_t* bk = p.OB + row * 768 + h * DV;
  float ss = 0.f;
  for (int e = 0; e < DV; ++e) { float o = ldA(f + e) + ldA(bk + e); ss += o * o; }
  float r = 1.0f / sqrtf(ss / DV + LN_EPS);
  const float* gn = (MODE == 0 ? p.hgrn_norm : p.gla_norm) + h * DV;
  const act_t* g = p.P + row * PW + (MODE == 0 ? E_HG : O_G) + h * DV;
  act_t* o = p.u + row * D + (MODE == 0 ? 512 : 0) + h * DV;
  for (int e = 0; e < DV; ++e) stA(o + e, (ldA(f + e) + ldA(bk + e)) * r * gn[e] * siluf_(ldA(g + e)));
}

DEV void ph_gla_decay(const Params& p, long i) {
  int col = (int)(i % 384);
  long row = (i / 384) % NR;
  int dir = (int)(i / ((long)384 * NR));
  const act_t* r = p.P + row * PW + O_RF + dir * 16;
  const float* gw = p.gla_gate_w + (long)dir * 16 * 384 + col;
  float z = p.gla_gate_b[dir * 384 + col];
  for (int k = 0; k < 16; ++k) z += ldA(r + k) * gw[k * 384];
  float ls = fminf(z, 0.f) - log1pf(expf(-fabsf(z)));
  stA(p.LF + ((long)dir * NR + row) * 384 + col, ls * (1.0f / 16.0f));
}

DEV void ph_resid_ln(const Params& p, long row, int l, int sub) {
  const float* hin = (l == 0 && sub == 0) ? hrow_in(p, row) : hrow(p, row);
  float* hout = hrow(p, row);
  const float* md = modrow(p, l, row);
  const float* g = md + (sub == 0 ? 2 : 5) * D;
  const act_t* m = p.M + row * D;
  const float* lg = p.ln_g + (l * 2 + sub) * D;
  const float* lb = p.ln_b + (l * 2 + sub) * D;
  float mu = 0.f;
  for (int k = 0; k < D; ++k) mu += ALPHA * hin[k] + g[k] * ldA(m + k);
  mu *= (1.0f / D);
  float var = 0.f;
  for (int k = 0; k < D; ++k) { float d = ALPHA * hin[k] + g[k] * ldA(m + k) - mu; var += d * d; }
  var *= (1.0f / D);
  float rs = 1.0f / sqrtf(var + LN_EPS);
  for (int k = 0; k < D; ++k) hout[k] = (ALPHA * hin[k] + g[k] * ldA(m + k) - mu) * rs * lg[k] + lb[k];
  if (sub == 1 && l == 1) return;
  const float* md2 = (sub == 0) ? md + 3 * D : modrow(p, 1, row);
  float mu2 = 0.f;
  for (int k = 0; k < D; ++k) mu2 += hout[k];
  mu2 *= (1.0f / D);
  float var2 = 0.f;
  for (int k = 0; k < D; ++k) { float d = hout[k] - mu2; var2 += d * d; }
  var2 *= (1.0f / D);
  float rs2 = 1.0f / sqrtf(var2 + LN_EPS);
  float lo[NEXP];
#pragma unroll
  for (int e = 0; e < NEXP; ++e) lo[e] = 0.f;
  for (int k = 0; k < D; ++k) {
    float uv = (hout[k] - mu2) * rs2 * (1.0f + md2[D + k]) + md2[k];
    stA(p.u + row * D + k, uv);
    if (sub == 0) {
      const float* wr = p.w_router + k * NEXP;
#pragma unroll
      for (int e = 0; e < NEXP; ++e) lo[e] += uv * wr[e];
    }
  }
  if (sub != 0) return;
  float mx = lo[0];
#pragma unroll
  for (int e = 1; e < NEXP; ++e) mx = fmaxf(mx, lo[e]);
  float sum = 0.f;
#pragma unroll
  for (int e = 0; e < NEXP; ++e) { lo[e] = expf(lo[e] - mx); sum += lo[e]; }
  float inv = 1.0f / sum;
  float bestg = -1e30f; int bg = 0;
  float gi1 = 0, gi2 = 0; int ge1 = 0, ge2 = 0;
  float gp1 = 0, gp2 = 0;
#pragma unroll
  for (int gq = 0; gq < 4; ++gq) {
    float s1 = -1e30f, s2 = -1e30f, p1 = 0, p2 = 0; int e1 = 0, e2 = 0;
#pragma unroll
    for (int j = 0; j < 4; ++j) {
      int e = gq * 4 + j;
      float pe = lo[e] * inv;
      float se = pe + p.b_router[e];
      if (se > s1) { s2 = s1; p2 = p1; e2 = e1; s1 = se; p1 = pe; e1 = e; }
      else if (se > s2) { s2 = se; p2 = pe; e2 = e; }
    }
    float gs = s1 + s2;
    if (gs > bestg) { bestg = gs; bg = gq; gi1 = s1; gi2 = s2; ge1 = e1; ge2 = e2; gp1 = p1; gp2 = p2; }
  }
  (void)bg; (void)gi1; (void)gi2;
  float wsum = gp1 + gp2;
  p.eidx[row * 2 + 0] = ge1; p.eidx[row * 2 + 1] = ge2;
  p.ew[row * 2 + 0] = gp1 / wsum; p.ew[row * 2 + 1] = gp2 / wsum;
}

DEV void ph_moe_up(const Params& p, long i, int l, long row0) {
  int f4 = (int)(i % (DFF / 4));
  int slot = (int)((i / (DFF / 4)) % 2);
  long row = row0 + i / (DFF / 2);
  int e = p.eidx[row * 2 + slot];
  const float* w1 = p.w_eg + ((long)(l * NEXP + e) * D) * DFF + f4 * 4;
  const float* w3 = p.w_eu + ((long)(l * NEXP + e) * D) * DFF + f4 * 4;
  const act_t* a = p.u + row * D;
  float g0 = 0, g1 = 0, g2 = 0, g3 = 0, u0 = 0, u1 = 0, u2 = 0, u3 = 0;
  for (int k = 0; k < D; ++k) {
    float av = ldA(a + k);
    const float* r1 = w1 + (long)k * DFF;
    const float* r3 = w3 + (long)k * DFF;
    g0 += av * r1[0]; g1 += av * r1[1]; g2 += av * r1[2]; g3 += av * r1[3];
    u0 += av * r3[0]; u1 += av * r3[1]; u2 += av * r3[2]; u3 += av * r3[3];
  }
  act_t* hb = p.P + (row * 2 + slot) * DFF + f4 * 4;
  stA(hb, siluf_(g0) * u0); stA(hb + 1, siluf_(g1) * u1); stA(hb + 2, siluf_(g2) * u2); stA(hb + 3, siluf_(g3) * u3);
}

DEV void ph_moe_down(const Params& p, long i, int l, long row0) {
  int j4 = (int)(i % (D / 4));
  long row = row0 + i / (D / 4);
  float y0 = 0, y1 = 0, y2 = 0, y3 = 0;
  for (int slot = 0; slot < 2; ++slot) {
    int e = p.eidx[row * 2 + slot];
    float wgt = p.ew[row * 2 + slot];
    const float* w2 = p.w_ed + ((long)(l * NEXP + e) * DFF) * D + j4 * 4;
    const act_t* hb = p.P + (row * 2 + slot) * DFF;
    float s0 = 0, s1 = 0, s2 = 0, s3 = 0;
    for (int f = 0; f < DFF; ++f) {
      float hv = ldA(hb + f);
      const float* r = w2 + (long)f * D;
      s0 += hv * r[0]; s1 += hv * r[1]; s2 += hv * r[2]; s3 += hv * r[3];
    }
    y0 += wgt * s0; y1 += wgt * s1; y2 += wgt * s2; y3 += wgt * s3;
  }
  act_t* o = p.M + row * D + j4 * 4;
  stA(o, y0); stA(o + 1, y1); stA(o + 2, y2); stA(o + 3, y3);
}


#ifndef HOST_TEST
typedef __attribute__((ext_vector_type(8))) short bf16x8;
typedef __attribute__((ext_vector_type(4))) float f32x4;
constexpr int SMEM_BYTES = 71680;
constexpr int IN_ODD_PAD = 2944;
constexpr int O_FA = 2336, O_FB = 2592, O_END = 2848;

typedef float f32x2_t __attribute__((ext_vector_type(2)));
typedef __bf16 bf16x2_t __attribute__((ext_vector_type(2)));
__device__ __forceinline__ unsigned pack2(float a, float b) {
  const f32x2_t v = {a, b};
  return __builtin_bit_cast(unsigned, __builtin_convertvector(v, bf16x2_t));
}
__device__ __forceinline__ unsigned pack2_mfma(float a, float b) { return pack2(a, b); }
typedef __attribute__((ext_vector_type(2))) unsigned u32x2;
__device__ __forceinline__ float xor16_max(float x) {
  const u32x2 r = __builtin_amdgcn_permlane16_swap(__float_as_uint(x), __float_as_uint(x), false, false);
  return fmaxf(__uint_as_float(r.x), __uint_as_float(r.y));
}
__device__ __forceinline__ float xor32_max(float x) {
  const u32x2 r = __builtin_amdgcn_permlane32_swap(__float_as_uint(x), __float_as_uint(x), false, false);
  return fmaxf(__uint_as_float(r.x), __uint_as_float(r.y));
}
__device__ __forceinline__ float xor16_add(float x) {
  const u32x2 r = __builtin_amdgcn_permlane16_swap(__float_as_uint(x), __float_as_uint(x), false, false);
  return __uint_as_float(r.x) + __uint_as_float(r.y);
}
__device__ __forceinline__ float xor32_add(float x) {
  const u32x2 r = __builtin_amdgcn_permlane32_swap(__float_as_uint(x), __float_as_uint(x), false, false);
  return __uint_as_float(r.x) + __uint_as_float(r.y);
}
__device__ __forceinline__ float bf_lo(unsigned u) { return __uint_as_float(u << 16); }
__device__ __forceinline__ float bf_hi(unsigned u) { return __uint_as_float(u & 0xffff0000u); }
template <int CTRL>
__device__ __forceinline__ float dpp_mov(float v) {
  return __int_as_float(__builtin_amdgcn_update_dpp(0, __float_as_int(v), CTRL, 0xf, 0xf, true));
}
__device__ __forceinline__ float row_sum16(float v) {
  v += dpp_mov<0xB1>(v);
  v += dpp_mov<0x4E>(v);
  v += dpp_mov<0x141>(v);
  v += dpp_mov<0x140>(v);
  return v;
}
__device__ __forceinline__ float wave_sum(float v) {
  v = row_sum16(v);
  const float a = __int_as_float(__builtin_amdgcn_readlane(__float_as_int(v), 0));
  const float b = __int_as_float(__builtin_amdgcn_readlane(__float_as_int(v), 16));
  const float c = __int_as_float(__builtin_amdgcn_readlane(__float_as_int(v), 32));
  const float d = __int_as_float(__builtin_amdgcn_readlane(__float_as_int(v), 48));
  return (a + b) + (c + d);
}


#define XB_TMO      128
#define XB_XCNT(j)  (256  + 64 * (j))
#define XB_XSUB(j)  (1280 + 64 * (j))
#define XB_XGEN(j)  (2304 + 64 * (j))
#define XB_TOP      3328
#define XB_TOPGEN   3392
#define XCD_BAR_WORDS 3456
#define XB_SPIN_CAP (1u << 18)
#define LAS __attribute__((address_space(3)))
__device__ __forceinline__ unsigned xb_ld(unsigned* p)              { return __hip_atomic_load(p, __ATOMIC_RELAXED, __HIP_MEMORY_SCOPE_AGENT); }
__device__ __forceinline__ unsigned xb_add(unsigned* p, unsigned v) { return __hip_atomic_fetch_add(p, v, __ATOMIC_RELAXED, __HIP_MEMORY_SCOPE_AGENT); }
__device__ __forceinline__ unsigned xb_xcc_id() { return (unsigned)__builtin_amdgcn_s_getreg((3 << 11) | 20) & 0xFu; }
#define XB_SPIN(cond, bar) do { unsigned _sp = 0; while (cond) { __builtin_amdgcn_s_sleep(1); \
    if ((++_sp & 255u) == 0u) { if (xb_ld(&(bar)[XB_TMO])) break; if (_sp > XB_SPIN_CAP) { atomicAdd(&(bar)[XB_TMO], 1u); break; } } } } while (0)
struct XcdBarrier { unsigned* bar; unsigned x; volatile LAS unsigned* st; };
__device__ __forceinline__ XcdBarrier xcd_barrier_post(unsigned* bar, volatile LAS unsigned* st) {
    XcdBarrier b; b.bar = bar; b.x = xb_xcc_id(); b.st = st;
    if (threadIdx.x == 0) (void)xb_add(&bar[XB_XCNT(b.x)], 1u);
    return b;
}
__device__ __forceinline__ void xcd_barrier_complete(unsigned* bar, unsigned x, unsigned& nloc, unsigned& nx) {
    const unsigned G = gridDim.x * gridDim.y * gridDim.z;
    unsigned sum, cnt, mine, sp = 0u;
    for (;;) {
        sum = 0u; cnt = 0u; mine = 0u;
#pragma unroll
        for (unsigned j = 0; j < 16; ++j) { const unsigned c = xb_ld(&bar[XB_XCNT(j)]); sum += c; cnt += (c > 0u) ? 1u : 0u; mine = (j == x) ? c : mine; }
        if (sum == G) break;
        __builtin_amdgcn_s_sleep(1);
        if ((++sp & 255u) == 0u) { if (xb_ld(&bar[XB_TMO])) break; if (sp > XB_SPIN_CAP) { atomicAdd(&bar[XB_TMO], 1u); break; } }
    }
    nloc = mine > 0u ? mine : 1u; nx = cnt > 0u ? cnt : 1u;
}
__device__ __forceinline__ void xcd_barrier(const XcdBarrier& b) {
    asm volatile("s_waitcnt vmcnt(0)" ::: "memory");
    __syncthreads();
    if (threadIdx.x == 0) {
        unsigned* bar = b.bar;
        __builtin_amdgcn_s_waitcnt(0);
        unsigned nloc = b.st[0], nx = b.st[1];
        if (nloc == 0u) { xcd_barrier_complete(bar, b.x, nloc, nx); b.st[0] = nloc; b.st[1] = nx; }
        const unsigned old = xb_add(&bar[XB_XSUB(b.x)], 1u);
        const unsigned gen = old / nloc;
        if (old + 1u == (gen + 1u) * nloc) {
            __builtin_amdgcn_fence(__ATOMIC_RELEASE, "agent");
            asm volatile("s_waitcnt vmcnt(0)" ::: "memory");
            const unsigned og = xb_add(&bar[XB_TOP], 1u);
            const unsigned tg = og / nx;
            if (og + 1u == (tg + 1u) * nx) xb_add(&bar[XB_TOPGEN], 1u);
            else XB_SPIN(xb_ld(&bar[XB_TOPGEN]) == tg, bar);
            __builtin_amdgcn_fence(__ATOMIC_ACQUIRE, "agent");
            xb_add(&bar[XB_XGEN(b.x)], 1u);
            asm volatile("s_waitcnt vmcnt(0)" ::: "memory");
        } else {
            XB_SPIN(xb_ld(&bar[XB_XGEN(b.x)]) == gen, bar);
            __builtin_amdgcn_fence(__ATOMIC_ACQUIRE, "agent");
            asm volatile("s_waitcnt vmcnt(0)" ::: "memory");
        }
    }
    __syncthreads();
}

#define RAW_BARRIER() do { asm volatile("s_waitcnt lgkmcnt(0)" ::: "memory"); __builtin_amdgcn_s_barrier(); } while (0)
template <bool SWAP, class ARow, class Epi>
__device__ __forceinline__ void gemm_tile(ARow arow, const act_t* Bt, int K, unsigned char* smem, Epi epi) {
  const int tid = threadIdx.x, wid = tid >> 6, lane = tid & 63, wr = wid >> 1, wc = wid & 1, fr = lane & 15,
            fq = lane >> 4;
  const int r0 = tid >> 3, pc = tid & 7;
  const int lc = pc ^ ((tid >> 4) & 7);
  const act_t* ga[4];
#pragma unroll
  for (int i = 0; i < 4; ++i) ga[i] = arow(r0 + 32 * i) + lc * 8;
  const act_t* gb0 = Bt + (long)r0 * K + lc * 8;
  const long gbs = (long)32 * K;
  const int sw = (fr >> 1) & 7;
  const int rd0 = fr * 128 + ((fq ^ sw) << 4), rd1 = fr * 128 + (((4 + fq) ^ sw) << 4);
  char* S = (char*)smem;
  const int nk = K >> 6;
  f32x4 acc[4][4];
#pragma unroll
  for (int m = 0; m < 4; ++m)
#pragma unroll
    for (int n = 0; n < 4; ++n) acc[m][n] = f32x4{0.f, 0.f, 0.f, 0.f};
  auto issue = [&](int kt) {
    char* st = S + (kt & 1) * 32768 + tid * 16;
#pragma unroll
    for (int i = 0; i < 4; ++i) {
      __builtin_amdgcn_global_load_lds((const unsigned*)(ga[i] + kt * 64), (unsigned*)(st + i * 4096), 16, 0, 0);
      __builtin_amdgcn_global_load_lds((const unsigned*)(gb0 + i * gbs + kt * 64), (unsigned*)(st + 16384 + i * 4096), 16, 0, 0);
    }
  };
  RAW_BARRIER();
  issue(0);
  for (int kt = 0; kt < nk; ++kt) {
    asm volatile("s_waitcnt vmcnt(0)" ::: "memory");
    RAW_BARRIER();
    if (kt + 1 < nk) issue(kt + 1);
    const char* st = S + (kt & 1) * 32768;
#pragma unroll
    for (int ks = 0; ks < 2; ++ks) {
      const int rd = ks ? rd1 : rd0;
      bf16x8 af[4], bfr[4];
#pragma unroll
      for (int m = 0; m < 4; ++m) {
        af[m] = *reinterpret_cast<const bf16x8*>(st + (wr * 64 + m * 16) * 128 + rd);
        bfr[m] = *reinterpret_cast<const bf16x8*>(st + 16384 + (wc * 64 + m * 16) * 128 + rd);
      }
#pragma unroll
      for (int m = 0; m < 4; ++m)
#pragma unroll
        for (int n = 0; n < 4; ++n)
          acc[m][n] = SWAP ? __builtin_amdgcn_mfma_f32_16x16x32_bf16(bfr[n], af[m], acc[m][n], 0, 0, 0)
                           : __builtin_amdgcn_mfma_f32_16x16x32_bf16(af[m], bfr[n], acc[m][n], 0, 0, 0);
    }
  }
  epi(acc, wr, wc, fr, fq);
}


constexpr float SU8 = 16.0f, SW8 = 64.0f, SH8 = 8.0f, SO8 = 8.0f;
typedef unsigned char fp8_t;
typedef __attribute__((ext_vector_type(8))) int i32x8;
typedef __attribute__((ext_vector_type(4))) int i32x4;
__device__ __forceinline__ unsigned pack4_fp8(float a, float b, float c, float d) {
  a = fminf(fmaxf(a, -448.f), 448.f); b = fminf(fmaxf(b, -448.f), 448.f);
  c = fminf(fmaxf(c, -448.f), 448.f); d = fminf(fmaxf(d, -448.f), 448.f);
  unsigned w = 0;
  w = __builtin_amdgcn_cvt_pk_fp8_f32(a, b, w, false);
  w = __builtin_amdgcn_cvt_pk_fp8_f32(c, d, w, true);
  return w;
}

template <bool SWAP, class ARow, class Epi>
__device__ __forceinline__ void gemm_tile8(ARow arow, const fp8_t* Bt, int Kb, unsigned char* smem, Epi epi) {
  const int tid = threadIdx.x, wid = tid >> 6, lane = tid & 63, wr = wid >> 1, wc = wid & 1, fr = lane & 15,
            fq = lane >> 4;
  const int r0 = tid >> 3, pc = tid & 7;
  const int lc = pc ^ ((tid >> 4) & 7);
  const fp8_t* ga[4];
#pragma unroll
  for (int i = 0; i < 4; ++i) ga[i] = arow(r0 + 32 * i, i) + lc * 16;
  const fp8_t* gb0 = Bt + (long)r0 * Kb + lc * 16;
  const long gbs = (long)32 * Kb;
  const int sw = (fr >> 1) & 7;
  const int rd0 = fr * 128 + ((fq ^ sw) << 4), rd1 = fr * 128 + (((4 + fq) ^ sw) << 4);
  char* S = (char*)smem;
  const int nk = Kb >> 7;
  f32x4 acc[4][4];
#pragma unroll
  for (int m = 0; m < 4; ++m)
#pragma unroll
    for (int n = 0; n < 4; ++n) acc[m][n] = f32x4{0.f, 0.f, 0.f, 0.f};
  auto issue = [&](int kt) {
    char* st = S + (kt & 1) * 32768 + tid * 16;
#pragma unroll
    for (int i = 0; i < 4; ++i) {
      __builtin_amdgcn_global_load_lds((const unsigned*)(ga[i] + kt * 128), (unsigned*)(st + i * 4096), 16, 0, 0);
      __builtin_amdgcn_global_load_lds((const unsigned*)(gb0 + i * gbs + kt * 128), (unsigned*)(st + 16384 + i * 4096), 16, 0, 0);
    }
  };
  RAW_BARRIER();
  issue(0);
  if (nk > 1) issue(1);
#pragma unroll 1
  for (int kt = 0; kt < nk; ++kt) {
    if (kt + 1 < nk) asm volatile("s_waitcnt vmcnt(8)" ::: "memory");
    else asm volatile("s_waitcnt vmcnt(0)" ::: "memory");
    RAW_BARRIER();
    const char* st = S + (kt & 1) * 32768;
    i32x8 af[4], bfr[4];
#pragma unroll
    for (int m = 0; m < 4; ++m) {
      const i32x4 a0 = *reinterpret_cast<const i32x4*>(st + (wr * 64 + m * 16) * 128 + rd0);
      const i32x4 a1 = *reinterpret_cast<const i32x4*>(st + (wr * 64 + m * 16) * 128 + rd1);
      const i32x4 b0 = *reinterpret_cast<const i32x4*>(st + 16384 + (wc * 64 + m * 16) * 128 + rd0);
      const i32x4 b1 = *reinterpret_cast<const i32x4*>(st + 16384 + (wc * 64 + m * 16) * 128 + rd1);
      af[m] = i32x8{a0[0], a0[1], a0[2], a0[3], a1[0], a1[1], a1[2], a1[3]};
      bfr[m] = i32x8{b0[0], b0[1], b0[2], b0[3], b1[0], b1[1], b1[2], b1[3]};
    }
    RAW_BARRIER();
    if (kt + 2 < nk) issue(kt + 2);
#pragma unroll
    for (int m = 0; m < 4; ++m)
#pragma unroll
      for (int n = 0; n < 4; ++n)
        acc[m][n] = SWAP ? __builtin_amdgcn_mfma_scale_f32_16x16x128_f8f6f4(bfr[n], af[m], acc[m][n], 0, 0, 0, 0x7f7f7f7f, 0, 0x7f7f7f7f)
                         : __builtin_amdgcn_mfma_scale_f32_16x16x128_f8f6f4(af[m], bfr[n], acc[m][n], 0, 0, 0, 0x7f7f7f7f, 0, 0x7f7f7f7f);
  }
  epi(acc, wr, wc, fr, fq);
}


template <bool SWAP, class Epi>
__device__ __forceinline__ void gemm_tile8p(const fp8_t* A, const fp8_t* Bt, bool has_next, const fp8_t* An, const fp8_t* Btn,
                                            int& par, bool& primed, int Kb, unsigned char* smem, Epi epi) {
  const int tid = threadIdx.x, wid = tid >> 6, lane = tid & 63, wr = wid >> 1, wc = wid & 1, fr = lane & 15,
            fq = lane >> 4;
  const int r0 = tid >> 3, pc = tid & 7;
  const int lc = pc ^ ((tid >> 4) & 7);
  const long roff = (long)r0 * Kb + lc * 16;
  const long gbs = (long)32 * Kb;
  const int sw = (fr >> 1) & 7;
  const int rd0 = fr * 128 + ((fq ^ sw) << 4), rd1 = fr * 128 + (((4 + fq) ^ sw) << 4);
  char* S = (char*)smem;
  const int nk = Kb >> 7;
  f32x4 acc[4][4];
#pragma unroll
  for (int m = 0; m < 4; ++m)
#pragma unroll
    for (int n = 0; n < 4; ++n) acc[m][n] = f32x4{0.f, 0.f, 0.f, 0.f};
  auto issue = [&](const fp8_t* a, const fp8_t* b, int kt, int stage) {
    char* st = S + stage * 32768 + tid * 16;
    const fp8_t* ga = a + roff + kt * 128;
    const fp8_t* gb = b + roff + kt * 128;
#pragma unroll
    for (int i = 0; i < 4; ++i) {
      __builtin_amdgcn_global_load_lds((const unsigned*)(ga + i * gbs), (unsigned*)(st + i * 4096), 16, 0, 0);
      __builtin_amdgcn_global_load_lds((const unsigned*)(gb + i * gbs), (unsigned*)(st + 16384 + i * 4096), 16, 0, 0);
    }
  };
  if (!primed) {
    RAW_BARRIER();
    issue(A, Bt, 0, par);
  }
#pragma unroll 1
  for (int kt = 0; kt < nk; ++kt) {
    asm volatile("s_waitcnt vmcnt(0)" ::: "memory");
    RAW_BARRIER();
    if (kt + 1 < nk) issue(A, Bt, kt + 1, (par + kt + 1) & 1);
    else if (has_next) issue(An, Btn, 0, (par + kt + 1) & 1);
    const char* st = S + ((par + kt) & 1) * 32768;
    i32x8 af[4], bfr[4];
#pragma unroll
    for (int m = 0; m < 4; ++m) {
      const i32x4 a0 = *reinterpret_cast<const i32x4*>(st + (wr * 64 + m * 16) * 128 + rd0);
      const i32x4 a1 = *reinterpret_cast<const i32x4*>(st + (wr * 64 + m * 16) * 128 + rd1);
      const i32x4 b0 = *reinterpret_cast<const i32x4*>(st + 16384 + (wc * 64 + m * 16) * 128 + rd0);
      const i32x4 b1 = *reinterpret_cast<const i32x4*>(st + 16384 + (wc * 64 + m * 16) * 128 + rd1);
      af[m] = i32x8{a0[0], a0[1], a0[2], a0[3], a1[0], a1[1], a1[2], a1[3]};
      bfr[m] = i32x8{b0[0], b0[1], b0[2], b0[3], b1[0], b1[1], b1[2], b1[3]};
    }
#pragma unroll
    for (int m = 0; m < 4; ++m)
#pragma unroll
      for (int n = 0; n < 4; ++n)
        acc[m][n] = SWAP ? __builtin_amdgcn_mfma_scale_f32_16x16x128_f8f6f4(bfr[n], af[m], acc[m][n], 0, 0, 0, 0x7f7f7f7f, 0, 0x7f7f7f7f)
                         : __builtin_amdgcn_mfma_scale_f32_16x16x128_f8f6f4(af[m], bfr[n], acc[m][n], 0, 0, 0, 0x7f7f7f7f, 0, 0x7f7f7f7f);
  }
  par = (par + nk) & 1;
  primed = has_next;
  epi(acc, wr, wc, fr, fq);
}

__device__ __forceinline__ void phase_attn(const Params& p, unsigned char* smem, int blk, int nblk) {
  const int tid = threadIdx.x, w = tid >> 6, lane = tid & 63, fr = lane & 15, g = lane >> 4;
  act_t* SK = (act_t*)smem;
  act_t* SV = SK + 64 * 72;
  constexpr float SCL = 0.125f * 1.4426950408889634f;
  const int n_lat = NB * 4 * (T / 64), n_ctx = NB * 4 * (C / 64);
  const int skey = tid >> 2, spart = tid & 3;
  for (int unit = blk; unit < n_lat + n_ctx; unit += nblk) {
    const bool lat = unit < n_lat;
    const int uu = lat ? unit : unit - n_lat;
    const int nq = lat ? T / 64 : C / 64;
    const int hp = uu & 1, kv = (uu >> 1) & 1, qb = (uu >> 2) % nq, b = (uu >> 2) / nq;
    const int t0 = qb * 64;
    const int tw = t0 + (w & 1) * 32;
    const long qrow0 = (lat ? (long)NC + (long)b * T : (long)b * C) + tw;
    const int h = kv * 4 + hp * 2 + (w >> 1);
    bf16x8 qf[2][2];
#pragma unroll
    for (int qt = 0; qt < 2; ++qt)
#pragma unroll
      for (int st = 0; st < 2; ++st)
        qf[qt][st] = *reinterpret_cast<const bf16x8*>(p.P + (qrow0 + qt * 16 + fr) * PW + E_AQ + h * 64 + st * 32 + g * 8);
    asm volatile("" :: "v"(qf[0][0]), "v"(qf[0][1]), "v"(qf[1][0]), "v"(qf[1][1]));
    float mrun[2], lrun[2];
    f32x4 o[2][4];
    const float sinkl = p.attn_sink[h] * 1.4426950408889634f;
#pragma unroll
    for (int qt = 0; qt < 2; ++qt) {
      mrun[qt] = sinkl;
      lrun[qt] = (g == 0) ? 1.0f : 0.0f;
#pragma unroll
      for (int dt = 0; dt < 4; ++dt) o[qt][dt] = f32x4{0.f, 0.f, 0.f, 0.f};
    }
    int cc_lo = 0, cc_hi = -1;
    if (lat) {
      cc_lo = t0 >= 128 ? 0 : (128 - t0) / 64;
      cc_hi = min(4, (T - 1 - (t0 - 128)) / 64);
    }
    const int nch = 4 + (cc_hi - cc_lo + 1);
    auto chunk_row = [&](int i, int key, int& tkb) -> long {
      if (i < 4) { tkb = 0; return (long)b * C + i * 64 + key; }
      tkb = t0 - 128 + (cc_lo + i - 4) * 64;
      return (long)NC + (long)b * T + tkb + key;
    };
    uint4 rk0, rk1, rv0, rv1;
    {
      int tkb; const long kr = chunk_row(0, skey, tkb);
      const act_t* kp = p.P + kr * PW + E_AK + kv * 64 + spart * 16;
      const act_t* vp = p.P + kr * PW + E_AV + kv * 64 + spart * 16;
      rk0 = *reinterpret_cast<const uint4*>(kp); rk1 = *reinterpret_cast<const uint4*>(kp + 8);
      rv0 = *reinterpret_cast<const uint4*>(vp); rv1 = *reinterpret_cast<const uint4*>(vp + 8);
    }
    for (int i = 0; i < nch; ++i) {
      __syncthreads();
      {
        uint4* kd = reinterpret_cast<uint4*>(SK + skey * 72 + spart * 16);
        kd[0] = rk0; kd[1] = rk1;
        const unsigned vw[8] = {rv0.x, rv0.y, rv0.z, rv0.w, rv1.x, rv1.y, rv1.z, rv1.w};
#pragma unroll
        for (int e = 0; e < 8; ++e) {
          SV[(spart * 16 + 2 * e) * 72 + skey] = (act_t)(vw[e] & 0xffffu);
          SV[(spart * 16 + 2 * e + 1) * 72 + skey] = (act_t)(vw[e] >> 16);
        }
      }
      __syncthreads();
      int tkb_cur; (void)chunk_row(i, 0, tkb_cur);
      if (i + 1 < nch) {
        int tkb; const long kr = chunk_row(i + 1, skey, tkb);
        const act_t* kp = p.P + kr * PW + E_AK + kv * 64 + spart * 16;
        const act_t* vp = p.P + kr * PW + E_AV + kv * 64 + spart * 16;
        rk0 = *reinterpret_cast<const uint4*>(kp); rk1 = *reinterpret_cast<const uint4*>(kp + 8);
        rv0 = *reinterpret_cast<const uint4*>(vp); rv1 = *reinterpret_cast<const uint4*>(vp + 8);
      }
      const bool edge = i >= 4 && (tkb_cur == t0 - 128 || tkb_cur == t0 + 128);
#pragma unroll
      for (int kb = 0; kb < 2; ++kb) {
        f32x4 sc[2][2];
#pragma unroll
        for (int k2 = 0; k2 < 2; ++k2) {
          const int kt = kb * 2 + k2;
          const bf16x8 kf0 = *reinterpret_cast<const bf16x8*>(SK + (kt * 16 + fr) * 72 + g * 8);
          const bf16x8 kf1 = *reinterpret_cast<const bf16x8*>(SK + (kt * 16 + fr) * 72 + 32 + g * 8);
#pragma unroll
          for (int qt = 0; qt < 2; ++qt) {
            f32x4 z = f32x4{0.f, 0.f, 0.f, 0.f};
            z = __builtin_amdgcn_mfma_f32_16x16x32_bf16(kf0, qf[qt][0], z, 0, 0, 0);
            sc[qt][k2] = __builtin_amdgcn_mfma_f32_16x16x32_bf16(kf1, qf[qt][1], z, 0, 0, 0);
          }
        }
        bf16x8 pf[2];
#pragma unroll
        for (int qt = 0; qt < 2; ++qt) {
          float mx = -1e30f;
#pragma unroll
          for (int k2 = 0; k2 < 2; ++k2)
#pragma unroll
            for (int j = 0; j < 4; ++j) {
              float v = sc[qt][k2][j] * SCL;
              if (edge) {
                const int tk = tkb_cur + (kb * 2 + k2) * 16 + 4 * g + j;
                const int tq = tw + qt * 16 + fr;
                const int df = tq - tk;
                if (df > 128 || df < -128) v = -1e30f;
              }
              sc[qt][k2][j] = v;
              mx = fmaxf(mx, v);
            }
          mx = xor16_max(mx);
          mx = xor32_max(mx);
          const float mnew = fmaxf(mrun[qt], mx);
          if (__any(mnew > mrun[qt])) {
            const float alpha = __builtin_amdgcn_exp2f(mrun[qt] - mnew);
            lrun[qt] *= alpha;
#pragma unroll
            for (int dt = 0; dt < 4; ++dt) o[qt][dt] = o[qt][dt] * alpha;
            mrun[qt] = mnew;
          }
          float ls = 0.f;
          float pv[8];
#pragma unroll
          for (int k2 = 0; k2 < 2; ++k2)
#pragma unroll
            for (int j = 0; j < 4; ++j) {
              const float pe = __builtin_amdgcn_exp2f(sc[qt][k2][j] - mnew);
              pv[k2 * 4 + j] = pe;
              ls += pe;
            }
          lrun[qt] += ls;
          union { unsigned u[4]; bf16x8 v; } cv;
          cv.u[0] = pack2_mfma(pv[0], pv[1]); cv.u[1] = pack2_mfma(pv[2], pv[3]);
          cv.u[2] = pack2_mfma(pv[4], pv[5]); cv.u[3] = pack2_mfma(pv[6], pv[7]);
          pf[qt] = cv.v;
        }
#pragma unroll
        for (int dt = 0; dt < 4; ++dt) {
          union { uint2 h2[2]; bf16x8 v; } vf;
          vf.h2[0] = *reinterpret_cast<const uint2*>(SV + (dt * 16 + fr) * 72 + kb * 32 + 4 * g);
          vf.h2[1] = *reinterpret_cast<const uint2*>(SV + (dt * 16 + fr) * 72 + kb * 32 + 16 + 4 * g);
#pragma unroll
          for (int qt = 0; qt < 2; ++qt) o[qt][dt] = __builtin_amdgcn_mfma_f32_16x16x32_bf16(vf.v, pf[qt], o[qt][dt], 0, 0, 0);
        }
      }
    }
#pragma unroll
    for (int qt = 0; qt < 2; ++qt) {
      float lt = lrun[qt];
      lt = xor16_add(lt);
      lt = xor32_add(lt);
      const float il = 1.0f / lt;
      fp8_t* orow = p.O8 + (qrow0 + qt * 16 + fr) * D + h * 64 + 4 * g;
      const float ils = il * SO8;
#pragma unroll
      for (int dt = 0; dt < 4; ++dt)
        *reinterpret_cast<unsigned*>(orow + dt * 16) = pack4_fp8(o[qt][dt][0] * ils, o[qt][dt][1] * ils, o[qt][dt][2] * ils, o[qt][dt][3] * ils);
    }
  }
}


template <int MODE>
__device__ __forceinline__ void phase_combine(const Params& p) {
  constexpr int DV = MODE == 0 ? 128 : 192, EPL = DV / 16, NV = EPL / 4;
  const int lane = threadIdx.x & 63;
  const long row_lo = MODE == 0 ? 0 : NC;
  const int nw = (int)gridDim.x * 4, wi = (int)blockIdx.x * 4 + (int)(threadIdx.x >> 6);
  const int rpw = (int)(NR - row_lo + nw - 1) / nw;
  const long r0 = row_lo + (long)wi * rpw, r1 = min((long)NR, r0 + rpw);
  float gn[EPL];
#pragma unroll
  for (int e = 0; e < EPL; ++e) gn[e] = (MODE == 0 ? p.hgrn_norm : p.gla_norm)[lane * EPL + e];
  uint2 fa[NV], fb[NV], fg[NV];
  auto load_row = [&](long row) {
    const uint2* f = reinterpret_cast<const uint2*>(p.OF + row * 768 + lane * EPL);
    const uint2* bk = reinterpret_cast<const uint2*>(p.OB + row * 768 + lane * EPL);
    const uint2* gt = reinterpret_cast<const uint2*>(p.P + row * PW + (MODE == 0 ? E_HG : O_G) + lane * EPL);
#pragma unroll
    for (int v = 0; v < NV; ++v) { fa[v] = f[v]; fb[v] = bk[v]; fg[v] = gt[v]; }
  };
  if (r0 < r1) load_row(r0);
  for (long row = r0; row < r1; ++row) {
    float o[EPL], gg[EPL];
#pragma unroll
    for (int v = 0; v < NV; ++v) {
      o[4 * v + 0] = bf_lo(fa[v].x) + bf_lo(fb[v].x); o[4 * v + 1] = bf_hi(fa[v].x) + bf_hi(fb[v].x);
      o[4 * v + 2] = bf_lo(fa[v].y) + bf_lo(fb[v].y); o[4 * v + 3] = bf_hi(fa[v].y) + bf_hi(fb[v].y);
      gg[4 * v + 0] = bf_lo(fg[v].x); gg[4 * v + 1] = bf_hi(fg[v].x); gg[4 * v + 2] = bf_lo(fg[v].y); gg[4 * v + 3] = bf_hi(fg[v].y);
    }
    load_row(min(row + 1, r1 - 1));
    float ss = 0.f;
#pragma unroll
    for (int e = 0; e < EPL; ++e) ss += o[e] * o[e];
    ss = row_sum16(ss);
    const float r = 1.0f / sqrtf(ss * (1.0f / DV) + LN_EPS);
    unsigned* dst = reinterpret_cast<unsigned*>(p.O8 + row * D + (MODE == 0 ? 512 : 0) + lane * EPL);
#pragma unroll
    for (int v = 0; v < NV; ++v) {
      float y[4];
#pragma unroll
      for (int q = 0; q < 4; ++q) {
        const float g = gg[4 * v + q];
        y[q] = o[4 * v + q] * (r * SO8) * gn[4 * v + q] * (g / (1.0f + __expf(-g)));
      }
      dst[v] = pack4_fp8(y[0], y[1], y[2], y[3]);
    }
  }
}

constexpr int MOD_ITEMS = 2 * 2 * (6 * D / 64);
__device__ __forceinline__ void mod_item(const Params& p, int item, unsigned char* smem) {
  float* sc = (float*)smem;
  float* red = sc + 9 * 512;
  const int tid = threadIdx.x, w = tid >> 6, lane = tid & 63;
  const int kh = item & 1, cgi = item >> 1;
  const int l = cgi / (6 * D / 64), j = (cgi % (6 * D / 64)) * 64 + lane;
  const float* wp = p.w_ada + (long)l * D * 6 * D + (long)(kh * 512 + w * 128) * 6 * D + j;
  float wv[32];
#pragma unroll
  for (int q = 0; q < 32; ++q) wv[q] = wp[(long)q * 6 * D];
#pragma unroll 6
  for (int i = tid; i < 9 * 512; i += 256) {
    const int bb = i >> 9, k = kh * 512 + (i & 511);
    const float v = bb < NB ? p.c[bb * D + k] : p.c_ctx[k];
    sc[i] = v / (1.0f + __expf(-v));
  }
  float a[NB + 1];
#pragma unroll
  for (int bb = 0; bb <= NB; ++bb) a[bb] = 0.f;
  __syncthreads();
#pragma unroll 1
  for (int kb = 0; kb < 128; kb += 32) {
    float wc[32];
#pragma unroll
    for (int q = 0; q < 32; ++q) wc[q] = wv[q];
    const int kn = min(kb + 32, 96);
#pragma unroll
    for (int q = 0; q < 32; ++q) wv[q] = wp[(long)(kn + q) * 6 * D];
#pragma unroll
    for (int q4 = 0; q4 < 8; ++q4)
#pragma unroll
      for (int bb = 0; bb <= NB; ++bb) {
        const float4 s4 = *reinterpret_cast<const float4*>(sc + bb * 512 + w * 128 + kb + 4 * q4);
        a[bb] += s4.x * wc[4 * q4] + s4.y * wc[4 * q4 + 1] + s4.z * wc[4 * q4 + 2] + s4.w * wc[4 * q4 + 3];
      }
  }
#pragma unroll
  for (int q = 0; q < 32; ++q) asm volatile("" :: "v"(wv[q]));
#pragma unroll
  for (int bb = 0; bb <= NB; ++bb) red[(w * 9 + bb) * 64 + lane] = a[bb];
  __syncthreads();
  for (int i = tid; i < 9 * 64; i += 256) {
    const int bb = i >> 6, jj = i & 63;
    const int col = (cgi % (6 * D / 64)) * 64 + jj;
    const float sum = ((red[(0 * 9 + bb) * 64 + jj] + red[(1 * 9 + bb) * 64 + jj]) + (red[(2 * 9 + bb) * 64 + jj] + red[(3 * 9 + bb) * 64 + jj]));
    atomicAdd(p.mod + ((long)l * (NB + 1) + bb) * 6 * D + col, kh == 0 ? sum + p.b_ada[l * 6 * D + col] : sum);
  }
  __syncthreads();
}

__device__ __forceinline__ void phase_gla_decay(const Params& p) {
  const int t = threadIdx.x;
  if (t >= 192) return;
  const int dir = t / 96, cg = t % 96;
  float gw[16][4], gb[4];
#pragma unroll
  for (int r = 0; r < 16; ++r) {
    const float4 v = *reinterpret_cast<const float4*>(p.gla_gate_w + ((long)dir * 16 + r) * 384 + cg * 4);
    gw[r][0] = v.x; gw[r][1] = v.y; gw[r][2] = v.z; gw[r][3] = v.w;
  }
  {
    const float4 v = *reinterpret_cast<const float4*>(p.gla_gate_b + dir * 384 + cg * 4);
    gb[0] = v.x; gb[1] = v.y; gb[2] = v.z; gb[3] = v.w;
  }
  const int rpb = ((NR + (int)gridDim.x - 1) / (int)gridDim.x + 3) / 4 * 4;
  const long b0 = (long)blockIdx.x * rpb, b1 = min((long)NR, b0 + rpb);
  uint4 ra[4], rb[4];
  auto load4 = [&](long row0) {
#pragma unroll
    for (int q = 0; q < 4; ++q) {
      const uint4* rp = reinterpret_cast<const uint4*>(p.P + min(row0 + q, b1 - 1) * PW + O_RF + dir * 16);
      ra[q] = rp[0]; rb[q] = rp[1];
    }
  };
  if (b0 < b1) load4(b0);
  for (long row0 = b0; row0 < b1; row0 += 4) {
    unsigned rw[4][8];
#pragma unroll
    for (int q = 0; q < 4; ++q) {
      rw[q][0] = ra[q].x; rw[q][1] = ra[q].y; rw[q][2] = ra[q].z; rw[q][3] = ra[q].w;
      rw[q][4] = rb[q].x; rw[q][5] = rb[q].y; rw[q][6] = rb[q].z; rw[q][7] = rb[q].w;
    }
    load4(min(row0 + 4, b1 - 1));
#pragma unroll
    for (int q = 0; q < 4; ++q) {
      float z[4] = {gb[0], gb[1], gb[2], gb[3]};
#pragma unroll
      for (int r2 = 0; r2 < 8; ++r2) {
        const float x0 = bf_lo(rw[q][r2]), x1 = bf_hi(rw[q][r2]);
#pragma unroll
        for (int c = 0; c < 4; ++c) z[c] += x0 * gw[2 * r2][c] + x1 * gw[2 * r2 + 1][c];
      }
      float o[4];
#pragma unroll
      for (int c = 0; c < 4; ++c) o[c] = 1.0f - __expf((fminf(z[c], 0.f) - __logf(1.0f + __expf(-fabsf(z[c])))) * (1.0f / 16.0f));
      if (row0 + q < b1)
        *reinterpret_cast<uint2*>(p.LF + ((long)dir * NR + row0 + q) * 384 + cg * 4) = make_uint2(pack2(o[0], o[1]), pack2(o[2], o[3]));
    }
  }
}

__device__ __forceinline__ void phase_hgrn_gate(const Params& p, long gtid, long gstride) {
  for (long i = gtid; i < (long)NR * 1024; i += gstride) {
    const int col = (int)(i & 1023);
    const long row = i >> 10;
    act_t* z = p.P + row * PW + E_FF + col;
    const float lb = p.lbt[col];
    const float f = lb + (1.0f - lb) * sigmoidf_(ldA(z));
    stA(z, __logf(f));
  }
}

#define RCPF(x) __builtin_amdgcn_rcpf(x)
template <int MODE>
__device__ __forceinline__ void phase_scan(const Params& p, unsigned char* smem, int blk, int nblk) {
  constexpr int DK = MODE == 0 ? 128 : 96, DV = MODE == 0 ? 128 : 192, DVS = DV / 4, NET = DVS / 16, NKS = DK / 32,
                NDT = DK / 16;
  constexpr int QS = DK + 8, LS = 72, SS = DK + 8;
  act_t* Qa = (act_t*)smem;
  act_t* Ka = Qa + 64 * QS;
  act_t* KaT = Ka + 64 * QS;
  act_t* VT = KaT + DK * LS;
  act_t* ST = VT + DVS * LS;
  float* tot = (float*)(ST + DVS * SS);
  float* lf32 = tot + 2 * 4 * DK;
  const int tid = threadIdx.x, w = __builtin_amdgcn_readfirstlane(threadIdx.x >> 6), lane = tid & 63, fr = lane & 15, g = lane >> 4;
  const int dp = lane, c0 = 2 * dp;
  const bool cact = dp < DK / 2;
  constexpr int NCH = (C + T) / 64, NCC = C / 64;
  constexpr int NVI = DVS / 8 * 64;
  for (int item = blk; item < NB * 4 * 2 * 4; item += nblk) {
    const int sl = item & 3, dir = (item >> 2) & 1, h = (item >> 3) & 3, b = item >> 5;
    act_t* OD = dir == 0 ? p.OF : p.OB;
    const unsigned loff = (unsigned)min(c0, DK - 2) * 2u;
    const int vcol = (MODE == 0 ? E_HI + h * 128 : O_V + h * 192) + sl * DVS;
    const int ocol = h * DV + sl * DVS;
    auto chunk_base = [&](int n) -> long {
      if (n < NCC) return (long)b * C + (dir ? NCC - 1 - n : n) * 64;
      const int ln = n - NCC;
      return (long)NC + (long)b * T + (dir ? T / 64 - 1 - ln : ln) * 64;
    };
    auto lrow = [&](long base, int l) -> long { return base + (dir ? 63 - l : l); };
    f32x4 S[NET][2];
#pragma unroll
    for (int et = 0; et < NET; ++et) { S[et][0] = f32x4{0.f, 0.f, 0.f, 0.f}; S[et][1] = f32x4{0.f, 0.f, 0.f, 0.f}; }
    unsigned rlf[16], rq[16], rk[16];
    uint4 rv[2];
    const long rstep = dir ? -(long)PW * 2 : (long)PW * 2;
    const long lstep = dir ? -(long)384 * 2 : (long)384 * 2;
    const int ub_lf = (MODE == 0 ? (E_FF + dir * 512 + h * 128) * 2 : 0);
    const int ub_q = (MODE == 0 ? E_HQ + h * 128 : O_Q + h * 96) * 2;
    const int ub_k = (O_K + h * 96) * 2;
    unsigned voff[(NVI + 255) / 256];
#pragma unroll
    for (int r = 0; r < (NVI + 255) / 256; ++r) {
      const int it = min(tid + r * 256, NVI - 1);
      const int l = it / (DVS / 8), e8 = (it % (DVS / 8)) * 8;
      voff[r] = (unsigned)((dir ? 63 - l : l) * PW + e8) * 2u;
    }
    auto issue_loads = [&](int n) {
      const long base = chunk_base(n);
      unsigned lo = loff;
      asm volatile("" : "+v"(lo));
      {
        const char* prow = (const char*)(p.P + lrow(base, w * 16) * PW);
        const char* plf = (const char*)(p.LF + ((long)dir * NR + lrow(base, w * 16)) * 384 + h * 96);
#pragma unroll
        for (int i = 0; i < 16; ++i) {
          if (MODE == 0) {
            rlf[i] = *reinterpret_cast<const unsigned*>(prow + ub_lf + lo);
          } else {
            rlf[i] = *reinterpret_cast<const unsigned*>(plf + lo);
            rk[i] = *reinterpret_cast<const unsigned*>(prow + ub_k + lo);
            plf += lstep;
          }
          rq[i] = *reinterpret_cast<const unsigned*>(prow + ub_q + lo);
          prow += rstep;
        }
      }
      const char* vbase = (const char*)(p.P + base * PW + vcol);
#pragma unroll
      for (int r = 0; r < (NVI + 255) / 256; ++r) {
        unsigned vo = voff[r];
        asm volatile("" : "+v"(vo));
        rv[r] = *reinterpret_cast<const uint4*>(vbase + vo);
      }
    };
    issue_loads(0);
    for (int n = 0; n < NCH; ++n) {
      const int par = n & 1;
      float* totp = tot + par * 4 * DK;
      float* lfp = lf32 + par * DK;
      const long base = chunk_base(n);
      if (cact) {
        float r0 = 1.f, r1 = 1.f;
#pragma unroll
        for (int i = 0; i < 16; ++i) { r0 *= 1.0f - bf_lo(rlf[i]); r1 *= 1.0f - bf_hi(rlf[i]); }
        totp[w * DK + c0] = r0; totp[w * DK + c0 + 1] = r1;
        if (w == 2) { lfp[c0] = 1.0f - bf_lo(rlf[0]); lfp[c0 + 1] = 1.0f - bf_hi(rlf[0]); }
      }
      __syncthreads();
#pragma unroll
      for (int r = 0; r < (NVI + 255) / 256; ++r) {
        const int it = tid + r * 256;
        if (it < NVI) {
          const int l = it / (DVS / 8), e8 = (it % (DVS / 8)) * 8;
          const unsigned vw[4] = {rv[r].x, rv[r].y, rv[r].z, rv[r].w};
#pragma unroll
          for (int e = 0; e < 4; ++e) {
            VT[(e8 + 2 * e) * LS + l] = (act_t)(vw[e] & 0xffffu);
            VT[(e8 + 2 * e + 1) * LS + l] = (act_t)(vw[e] >> 16);
          }
        }
      }
      if (cact) {
        float of0 = 1.f, of1 = 1.f;
#pragma unroll
        for (int sgi = 0; sgi < 3; ++sgi)
          if (sgi < w) { of0 *= totp[sgi * DK + c0]; of1 *= totp[sgi * DK + c0 + 1]; }
        const float ref0 = totp[c0] * totp[DK + c0] * lfp[c0];
        const float ref1 = totp[c0 + 1] * totp[DK + c0 + 1] * lfp[c0 + 1];
        unsigned kt0[8], kt1[8];
        float e0 = of0 * RCPF(ref0), e1 = of1 * RCPF(ref1);
        float f0 = RCPF(e0), f1 = RCPF(e1);
#pragma unroll
        for (int i = 0; i < 16; i += 2) {
          float ka0[2], ka1[2];
#pragma unroll
          for (int ii = 0; ii < 2; ++ii) {
            const int i2 = i + ii;
            const float kk0 = bf_lo(rlf[i2]), kk1 = bf_hi(rlf[i2]);
            const float g0 = 1.0f - kk0, g1 = 1.0f - kk1;
            e0 *= g0; e1 *= g1; f0 *= RCPF(g0); f1 *= RCPF(g1);
            float k0, k1;
            if (MODE == 0) { k0 = kk0; k1 = kk1; }
            else { k0 = bf_lo(rk[i2]); k1 = bf_hi(rk[i2]); }
            ka0[ii] = k0 * f0; ka1[ii] = k1 * f1;
            const int l = w * 16 + i2;
            *reinterpret_cast<unsigned*>(Qa + l * QS + c0) = pack2(bf_lo(rq[i2]) * e0, bf_hi(rq[i2]) * e1);
            *reinterpret_cast<unsigned*>(Ka + l * QS + c0) = pack2(ka0[ii], ka1[ii]);
          }
          kt0[i >> 1] = pack2(ka0[0], ka0[1]);
          kt1[i >> 1] = pack2(ka1[0], ka1[1]);
        }
        uint4* d0 = reinterpret_cast<uint4*>(KaT + c0 * LS + w * 16);
        d0[0] = make_uint4(kt0[0], kt0[1], kt0[2], kt0[3]); d0[1] = make_uint4(kt0[4], kt0[5], kt0[6], kt0[7]);
        uint4* d1 = reinterpret_cast<uint4*>(KaT + (c0 + 1) * LS + w * 16);
        d1[0] = make_uint4(kt1[0], kt1[1], kt1[2], kt1[3]); d1[1] = make_uint4(kt1[4], kt1[5], kt1[6], kt1[7]);
      }
      issue_loads(min(n + 1, NCH - 1));
      float egv[2], egrv[2];
#pragma unroll
      for (int di = 0; di < 2; ++di) {
        const int dt = w + 4 * di;
        if (dt < NDT) {
          const int d = dt * 16 + fr;
          const float er = totp[d] * totp[DK + d] * lfp[d];
          egv[di] = (totp[d] * totp[DK + d]) * (totp[2 * DK + d] * totp[3 * DK + d]);
          egrv[di] = egv[di] * RCPF(er);
#pragma unroll
          for (int et = 0; et < NET; ++et)
#pragma unroll
            for (int j = 0; j < 4; j += 2) {
              const unsigned pk = pack2(S[et][di][j] * er, S[et][di][j + 1] * er);
              ST[(et * 16 + 4 * g + j) * SS + d] = (act_t)(pk & 0xffffu);
              ST[(et * 16 + 4 * g + j + 1) * SS + d] = (act_t)(pk >> 16);
            }
        }
      }
      __syncthreads();
      bf16x8 qfr[NKS];
#pragma unroll
      for (int ks = 0; ks < NKS; ++ks) qfr[ks] = *reinterpret_cast<const bf16x8*>(Qa + (w * 16 + fr) * QS + ks * 32 + g * 8);
      bf16x8 pfr[2];
#pragma unroll
      for (int kb = 0; kb < 2; ++kb) {
        f32x4 at2[2];
#pragma unroll
        for (int h2 = 0; h2 < 2; ++h2) {
          const int mt = 2 * kb + h2;
          at2[h2] = f32x4{0.f, 0.f, 0.f, 0.f};
          if (mt <= w) {
#pragma unroll
            for (int ks = 0; ks < NKS; ++ks) {
              const bf16x8 kaf = *reinterpret_cast<const bf16x8*>(Ka + (mt * 16 + fr) * QS + ks * 32 + g * 8);
              at2[h2] = __builtin_amdgcn_mfma_f32_16x16x32_bf16(kaf, qfr[ks], at2[h2], 0, 0, 0);
            }
            if (mt == w) {
#pragma unroll
              for (int j = 0; j < 4; ++j)
                if (4 * g + j > fr) at2[h2][j] = 0.f;
            }
          }
        }
        union { unsigned u[4]; bf16x8 v; } cv;
        cv.u[0] = pack2_mfma(at2[0][0], at2[0][1]); cv.u[1] = pack2_mfma(at2[0][2], at2[0][3]);
        cv.u[2] = pack2_mfma(at2[1][0], at2[1][1]); cv.u[3] = pack2_mfma(at2[1][2], at2[1][3]);
        pfr[kb] = cv.v;
      }
      const long orow = lrow(base, w * 16 + fr);
#pragma unroll
      for (int et = 0; et < NET; ++et) {
        f32x4 o = f32x4{0.f, 0.f, 0.f, 0.f};
#pragma unroll
        for (int kb = 0; kb < 2; ++kb) {
          if (2 * kb <= w) {
            union { uint2 h2[2]; bf16x8 v; } vf;
            vf.h2[0] = *reinterpret_cast<const uint2*>(VT + (et * 16 + fr) * LS + kb * 32 + 4 * g);
            vf.h2[1] = *reinterpret_cast<const uint2*>(VT + (et * 16 + fr) * LS + kb * 32 + 16 + 4 * g);
            o = __builtin_amdgcn_mfma_f32_16x16x32_bf16(vf.v, pfr[kb], o, 0, 0, 0);
          }
        }
#pragma unroll
        for (int ks = 0; ks < NKS; ++ks) {
          const bf16x8 sf = *reinterpret_cast<const bf16x8*>(ST + (et * 16 + fr) * SS + ks * 32 + g * 8);
          o = __builtin_amdgcn_mfma_f32_16x16x32_bf16(sf, qfr[ks], o, 0, 0, 0);
        }
        const float osc = MODE == 0 ? 1.0f : 0.10206207261596575f;
        *reinterpret_cast<uint2*>(OD + orow * 768 + ocol + et * 16 + 4 * g) =
            make_uint2(pack2(o[0] * osc, o[1] * osc), pack2(o[2] * osc, o[3] * osc));
      }
#pragma unroll
      for (int di = 0; di < 2; ++di) {
        const int dt = w + 4 * di;
        if (dt < NDT) {
#pragma unroll
          for (int et = 0; et < NET; ++et) {
            f32x4 r = f32x4{0.f, 0.f, 0.f, 0.f};
#pragma unroll
            for (int k2 = 0; k2 < 2; ++k2) {
              const bf16x8 vf = *reinterpret_cast<const bf16x8*>(VT + (et * 16 + fr) * LS + k2 * 32 + g * 8);
              const bf16x8 kf = *reinterpret_cast<const bf16x8*>(KaT + (dt * 16 + fr) * LS + k2 * 32 + g * 8);
              r = __builtin_amdgcn_mfma_f32_16x16x32_bf16(vf, kf, r, 0, 0, 0);
            }
#pragma unroll
            for (int j = 0; j < 4; ++j) S[et][di][j] = egv[di] * S[et][di][j] + egrv[di] * r[j];
          }
        }
      }
    }
    __syncthreads();
  }
}

struct GemmJob {
  const act_t* A; const act_t* Bt; act_t* C;
  long sA, sB, sC;
  int nbatch, Mtiles, Ntiles, K, ldc, Nvalid, mode;
  float scale;
  int fp8;
  int out8;
};
__device__ __forceinline__ void phase_gemm(const Params& p, const GemmJob& g, unsigned char* smem, int blk = blockIdx.x, int nblk = gridDim.x) {
  const int per_b = g.Mtiles * g.Ntiles;
  const int ntiles = per_b * g.nbatch;
  auto tvalid = [&](int t) -> bool {
    const int tt = t % per_b;
    const int tm = tt / g.Ntiles, tn = tt % g.Ntiles;
    return !(g.mode == 1 && tm < NC / 128 && tn * 128 >= O_FA);
  };
  auto tnext = [&](int t) -> int { t += nblk; while (t < ntiles && !tvalid(t)) t += nblk; return t; };
  int par = 0;
  bool primed = false;
  int tile0 = blk;
  if (tile0 < ntiles && !tvalid(tile0)) tile0 = tnext(tile0);
  for (int tile = tile0; tile < ntiles;) {
    const int ntile = tnext(tile);
    const int b = tile / per_b, tt = tile % per_b;
    const int tm = tt / g.Ntiles, tn = tt % g.Ntiles;
    const int tt2 = (ntile < ntiles ? ntile : tile) % per_b;
    const int tm2 = tt2 / g.Ntiles, tn2 = tt2 % g.Ntiles;
    const int K = g.K, ldc = g.ldc;
    const act_t* Ab = g.A + b * g.sA + (long)tm * 128 * K;
    act_t* Cb = g.C + b * g.sC + (long)tm * 128 * ldc + tn * 128;
    const int nlim = g.Nvalid - tn * 128;
    const float scale = g.scale;
    const int mode = g.mode;
    if (mode == 1) {
      auto epi1 = [&](f32x4 (&acc)[4][4], int wr, int wc, int fr, int fq) {
                  if (g.fp8) {
#pragma unroll
                    for (int m = 0; m < 4; ++m)
#pragma unroll
                      for (int n = 0; n < 4; ++n) acc[m][n] = acc[m][n] * scale;
                  }
#pragma unroll
                  for (int m = 0; m < 4; ++m)
#pragma unroll
                    for (int n = 0; n < 4; ++n) {
                      const int col = wc * 64 + n * 16 + fr;
                      if (col < nlim) {
#pragma unroll
                        for (int j = 0; j < 4; ++j) {
                          const int row = wr * 64 + m * 16 + fq * 4 + j;
                          stA(Cb + (long)row * ldc + col, acc[m][n][j]);
                        }
                      } else {
                        const int gc = tn * 128 + col;
                        if (gc < O_END && tm >= NC / 128) {
                          const int lr = (tm - NC / 128) * 128 + wr * 64 + m * 16 + fq * 4;
                          const int bb = lr / T, t = lr % T;
                          const int cq = gc < O_FB ? gc - O_FA : gc - O_FB;
                          act_t* dst = p.FT + ((long)bb * 256 + cq) * (2 * T) + (gc < O_FB ? 0 : T) + t;
                          *reinterpret_cast<uint2*>(dst) = make_uint2(pack2(acc[m][n][0], acc[m][n][1]), pack2(acc[m][n][2], acc[m][n][3]));
                        }
                      }
                    }
                };
      if (g.fp8) {
        const fp8_t* A8 = (const fp8_t*)g.A + (long)tm * 128 * K;
        gemm_tile8p<false>(A8, (const fp8_t*)g.Bt + (long)tn * 128 * K, ntile < ntiles, (const fp8_t*)g.A + (long)tm2 * 128 * K,
                           (const fp8_t*)g.Bt + (long)tn2 * 128 * K, par, primed, K, smem, epi1);
      } else {
        gemm_tile<false>([&](int r) { return Ab + (long)r * K; }, g.Bt + b * g.sB + (long)tn * 128 * K, K, smem, epi1);
      }
    } else {
      auto epi2 = [&](f32x4 (&acc)[4][4], int wr, int wc, int fr, int fq) {
                  const float oscale = g.fp8 ? 1.0f : scale;
                  if (g.fp8) {
#pragma unroll
                    for (int m = 0; m < 4; ++m)
#pragma unroll
                      for (int n = 0; n < 4; ++n) acc[m][n] = acc[m][n] * scale;
                  }
                  if (mode == 2) {
                    const int cb = tn * 128 + wc * 64;
                    if (cb < E_AV && tm >= NC / 128) {
                      const float4* rt = reinterpret_cast<const float4*>(p.ropetab);
#pragma unroll
                      for (int m = 0; m < 4; ++m) {
                        const int t = ((tm - NC / 128) * 128 + wr * 64 + m * 16 + fr) % T;
                        const float4 r01 = rt[(t / GRID_W) * 8 + fq * 2], r23 = rt[(t / GRID_W) * 8 + fq * 2 + 1];
                        const float4 c01 = rt[(t % GRID_W) * 8 + fq * 2], c23 = rt[(t % GRID_W) * 8 + fq * 2 + 1];
                        const float rc[4] = {r01.x, r01.z, r23.x, r23.z}, rs_[4] = {r01.y, r01.w, r23.y, r23.w};
                        const float cc[4] = {c01.x, c01.z, c23.x, c23.z}, cs_[4] = {c01.y, c01.w, c23.y, c23.w};
#pragma unroll
                        for (int j = 0; j < 4; ++j) {
                          const float a1 = acc[m][0][j], a2 = acc[m][1][j], b1 = acc[m][2][j], b2 = acc[m][3][j];
                          acc[m][0][j] = a1 * rc[j] - a2 * rs_[j]; acc[m][1][j] = a1 * rs_[j] + a2 * rc[j];
                          acc[m][2][j] = b1 * cc[j] - b2 * cs_[j]; acc[m][3][j] = b1 * cs_[j] + b2 * cc[j];
                        }
                      }
                    } else if (cb >= E_FF && cb < E_HQ) {
#pragma unroll
                      for (int n = 0; n < 4; ++n) {
                        const float4 lb4 = *reinterpret_cast<const float4*>(p.lbt + cb - E_FF + n * 16 + fq * 4);
                        const float lb[4] = {lb4.x, lb4.y, lb4.z, lb4.w};
#pragma unroll
                        for (int m = 0; m < 4; ++m)
#pragma unroll
                          for (int j = 0; j < 4; ++j)
                            acc[m][n][j] = (1.0f - lb[j]) / (1.0f + __expf(acc[m][n][j]));
                      }
                    }
                  }
#pragma unroll
                  for (int m = 0; m < 4; ++m) {
                    const int row = wr * 64 + m * 16 + fr;
#pragma unroll
                    for (int n = 0; n < 4; ++n) {
                      const int col = wc * 64 + n * 16 + fq * 4;
                      if (col < nlim) {
                        if (g.out8)
                          *reinterpret_cast<unsigned*>(reinterpret_cast<fp8_t*>(g.C) + b * g.sC + ((long)tm * 128 + row) * ldc + tn * 128 + col) =
                              pack4_fp8(acc[m][n][0] * oscale, acc[m][n][1] * oscale, acc[m][n][2] * oscale, acc[m][n][3] * oscale);
                        else
                          *reinterpret_cast<uint2*>(Cb + (long)row * ldc + col) =
                              make_uint2(pack2(acc[m][n][0] * oscale, acc[m][n][1] * oscale), pack2(acc[m][n][2] * oscale, acc[m][n][3] * oscale));
                      }
                    }
                  }
                };
      if (g.fp8) {
        const fp8_t* A8 = (const fp8_t*)g.A + (long)tm * 128 * K;
        gemm_tile8p<true>(A8, (const fp8_t*)g.Bt + (long)tn * 128 * K, ntile < ntiles, (const fp8_t*)g.A + (long)tm2 * 128 * K,
                          (const fp8_t*)g.Bt + (long)tn2 * 128 * K, par, primed, K, smem, epi2);
      } else {
        gemm_tile<true>([&](int r) { return Ab + (long)r * K; }, g.Bt + b * g.sB + (long)tn * 128 * K, K, smem, epi2);
      }
    }
    tile = ntile;
  }
}

template <class RowMap>
__device__ __forceinline__ void conv_tile_rm(const float* src, int lds_, int Nvalid, int k0, int n0, act_t* dst, int ldd, float* tile, RowMap rm) {
  const int tid = threadIdx.x;
  {
    const int r = tid >> 5, c4 = (tid & 31) * 4;
    float4 v[8];
#pragma unroll
    for (int rr = 0; rr < 8; ++rr) {
      v[rr] = make_float4(0.f, 0.f, 0.f, 0.f);
      if (n0 + c4 < Nvalid) v[rr] = *reinterpret_cast<const float4*>(src + (long)(k0 + r + rr * 8) * lds_ + n0 + c4);
    }
#pragma unroll
    for (int rr = 0; rr < 8; ++rr) {
      float* t = tile + (r + rr * 8) * 129 + c4;
      t[0] = v[rr].x; t[1] = v[rr].y; t[2] = v[rr].z; t[3] = v[rr].w;
    }
  }
  __syncthreads();
  {
    const int n = tid >> 1, ks = (tid & 1) * 32;
    if (n0 + n < Nvalid) {
      unsigned w[16];
#pragma unroll
      for (int i = 0; i < 16; ++i) w[i] = pack2(tile[(ks + 2 * i) * 129 + n], tile[(ks + 2 * i + 1) * 129 + n]);
      uint4* d = reinterpret_cast<uint4*>(dst + (long)rm(n) * ldd + k0 + ks);
      d[0] = make_uint4(w[0], w[1], w[2], w[3]);
      d[1] = make_uint4(w[4], w[5], w[6], w[7]);
      d[2] = make_uint4(w[8], w[9], w[10], w[11]);
      d[3] = make_uint4(w[12], w[13], w[14], w[15]);
    }
  }
  __syncthreads();
}

template <class RowMap>
__device__ __forceinline__ void conv_tile8_rm(const float* src, int lds_, int k0, int n0, fp8_t* dst, int ldd, float* tile, float scale, RowMap rm, int Nvalid = 1 << 30) {
  const int tid = threadIdx.x;
  {
    const int r = tid >> 5, c4 = (tid & 31) * 4;
    float4 v[8];
#pragma unroll
    for (int rr = 0; rr < 8; ++rr) {
      v[rr] = make_float4(0.f, 0.f, 0.f, 0.f);
      if (n0 + c4 < Nvalid) v[rr] = *reinterpret_cast<const float4*>(src + (long)(k0 + r + rr * 8) * lds_ + n0 + c4);
    }
#pragma unroll
    for (int rr = 0; rr < 8; ++rr) {
      float* t = tile + (r + rr * 8) * 129 + c4;
      t[0] = v[rr].x; t[1] = v[rr].y; t[2] = v[rr].z; t[3] = v[rr].w;
    }
  }
  __syncthreads();
  if ((threadIdx.x >> 1) + n0 < Nvalid) {
    const int n = tid >> 1, ks = (tid & 1) * 32;
    unsigned w[8];
#pragma unroll
    for (int i = 0; i < 8; ++i)
      w[i] = pack4_fp8(tile[(ks + 4 * i) * 129 + n] * scale, tile[(ks + 4 * i + 1) * 129 + n] * scale,
                       tile[(ks + 4 * i + 2) * 129 + n] * scale, tile[(ks + 4 * i + 3) * 129 + n] * scale);
    uint4* d = reinterpret_cast<uint4*>(dst + (long)rm(n) * ldd + k0 + ks);
    d[0] = make_uint4(w[0], w[1], w[2], w[3]);
    d[1] = make_uint4(w[4], w[5], w[6], w[7]);
  }
  __syncthreads();
}

__device__ __forceinline__ void conv_tile(const float* src, int lds_, int Nvalid, int k0, int n0, act_t* dst, int ldd, float* tile) {
  conv_tile_rm(src, lds_, Nvalid, k0, n0, dst, ldd, tile, [=](int n) { return n0 + n; });
}

struct ConvJob { const float* src; fp8_t* dst; int lds, ldd, k0, n0, rbase, ra, rb; };
__device__ __forceinline__ void phase_convert_experts(const Params& p, int l, unsigned char* smem, int blk, int nblk) {
  float* tile = (float*)smem;
  const int per_e = 192, total = NEXP * per_e;
  fp8_t* Wup = l == 0 ? p.W8up : p.W8up1;
  fp8_t* Wdn = l == 0 ? p.W8down : p.W8down1;
  const int tid = threadIdx.x;
  auto mkjob = [&](int job) -> ConvJob {
    const int e = job / per_e, j = job % per_e;
    ConvJob c;
    if (j < 128) {
      const int up = j >> 6, jj = j & 63;
      const int kt = jj >> 2, fp = jj & 3;
      c.src = (up ? p.w_eu : p.w_eg) + ((long)(l * NEXP + e) * D) * DFF;
      c.dst = Wup + (long)e * 1024 * D; c.lds = DFF; c.ldd = D; c.k0 = kt * 64; c.n0 = fp * 128;
      c.rbase = fp * 256 + up * 32; c.ra = 128; c.rb = 64;
    } else {
      const int jj = j - 128;
      const int kt = jj >> 3, nt = jj & 7;
      c.src = p.w_ed + ((long)(l * NEXP + e) * DFF) * D;
      c.dst = Wdn + (long)e * 1024 * DFF; c.lds = D; c.ldd = DFF; c.k0 = kt * 64; c.n0 = nt * 128;
      c.rbase = nt * 128; c.ra = 64; c.rb = 32;
    }
    return c;
  };
  float4 v[8];
  auto ld = [&](const ConvJob& c) {
    const int r = tid >> 5, c4 = (tid & 31) * 4;
#pragma unroll
    for (int rr = 0; rr < 8; ++rr) v[rr] = *reinterpret_cast<const float4*>(c.src + (long)(c.k0 + r + rr * 8) * c.lds + c.n0 + c4);
  };
  int job = blk;
  if (job >= total) return;
  ConvJob cur = mkjob(job);
  ld(cur);
  while (job < total) {
    {
      const int r = tid >> 5, c4 = (tid & 31) * 4;
#pragma unroll
      for (int rr = 0; rr < 8; ++rr) {
        float* t = tile + (r + rr * 8) * 129 + c4;
        t[0] = v[rr].x; t[1] = v[rr].y; t[2] = v[rr].z; t[3] = v[rr].w;
      }
    }
    __syncthreads();
    const int nxt = job + nblk;
    const ConvJob nj = mkjob(min(nxt, total - 1));
    ld(nj);
    {
      const int n = tid >> 1, ks = (tid & 1) * 32;
      unsigned w[8];
#pragma unroll
      for (int i = 0; i < 8; ++i)
        w[i] = pack4_fp8(tile[(ks + 4 * i) * 129 + n] * SW8, tile[(ks + 4 * i + 1) * 129 + n] * SW8,
                         tile[(ks + 4 * i + 2) * 129 + n] * SW8, tile[(ks + 4 * i + 3) * 129 + n] * SW8);
      const int row = cur.rbase + (n >> 6) * cur.ra + ((n >> 5) & 1) * cur.rb + (n & 31);
      uint4* d = reinterpret_cast<uint4*>(cur.dst + (long)row * cur.ldd + cur.k0 + ks);
      d[0] = make_uint4(w[0], w[1], w[2], w[3]);
      d[1] = make_uint4(w[4], w[5], w[6], w[7]);
    }
    __syncthreads();
    cur = nj;
    job = nxt;
  }
}

__device__ __forceinline__ void phase_moe(const Params& p, int l, bool down, unsigned char* smem) {
  const int* cntp = p.cnt + l * NEXP * 64;
  int cn[NEXP];
  int total = 0;
#pragma unroll
  for (int e = 0; e < NEXP; ++e) { cn[e] = __builtin_amdgcn_readfirstlane(cntp[e * 64]); total += ((cn[e] + 127) >> 7) * 8; }
  auto decode = [&](int tile, int& e_, int& c_, int& lt_, int& ro_) {
    int tb = 0, ro = 0;
    bool found = false;
    e_ = NEXP - 1; c_ = cn[NEXP - 1]; lt_ = 0; ro_ = 0;
#pragma unroll
    for (int e = 0; e < NEXP; ++e) {
      const int nt = ((cn[e] + 127) >> 7) * 8;
      const bool hit = !found && (tile < tb + nt || e == NEXP - 1);
      if (hit) { e_ = e; c_ = cn[e]; lt_ = tile - tb; ro_ = ro; }
      found = found || hit;
      tb += nt; ro += cn[e];
    }
  };
  const int tid = threadIdx.x, r0 = tid >> 3;
  const int wrow = (tid >> 7) * 64 + (tid & 15);
  int ls[4] = {0, 0, 0, 0};
  auto load_ls = [&](int tile, int (&dst)[4]) {
    int e, c, lt, ro;
    decode(min(tile, total - 1), e, c, lt, ro);
    const int mt = lt >> 3;
    const int rv = min(128, c - mt * 128);
    const int* lst = p.list + (long)(l * NEXP + e) * NR + mt * 128;
#pragma unroll
    for (int i = 0; i < 4; ++i) dst[i] = lst[min(r0 + 32 * i, rv - 1)];
  };
  if (!down && (int)blockIdx.x < total) load_ls(blockIdx.x, ls);
  for (int tile = blockIdx.x; tile < total; tile += gridDim.x) {
    int e, c, lt, rowoff;
    decode(tile, e, c, lt, rowoff);
    const int mt = lt >> 3, nt = lt & 7;
    const int rows_valid = min(128, c - mt * 128);
    const int* lst = p.list + (long)(l * NEXP + e) * NR + mt * 128;
    const long hrow0 = (long)rowoff + mt * 128;
    if (!down) {
      int lcur[4];
#pragma unroll
      for (int i = 0; i < 4; ++i) lcur[i] = ls[i];
      load_ls(tile + (int)gridDim.x, ls);
      gemm_tile8<true>([&](int r, int i) { return p.u8 + (long)(lcur[i] >> 1) * D; },
                (l == 0 ? p.W8up : p.W8up1) + ((long)e * 1024 + nt * 128) * D, D, smem,
                [&](f32x4 (&acc)[4][4], int wr, int wc, int fr, int fq) {
                  constexpr float dq = 1.0f / (SU8 * SW8);
#pragma unroll
                  for (int m = 0; m < 4; ++m) {
                    const int row = wr * 64 + m * 16 + fr;
                    if (row < rows_valid) {
#pragma unroll
                      for (int n = 0; n < 2; ++n) {
                        float hv[4];
#pragma unroll
                        for (int j = 0; j < 4; ++j) {
                          const float g = acc[m][n][j] * dq, uu = acc[m][n + 2][j] * dq;
                          hv[j] = g / (1.0f + __expf(-g)) * uu * SH8;
                        }
                        *reinterpret_cast<unsigned*>(p.H8 + (hrow0 + row) * DFF + nt * 64 + wc * 32 + n * 16 + fq * 4) =
                            pack4_fp8(hv[0], hv[1], hv[2], hv[3]);
                      }
                    }
                  }
                });
    } else {
      const fp8_t* Ab = p.H8 + hrow0 * DFF;
      int tsv[4];
      float wv[4];
      {
        const float* lw = p.listw + (long)(l * NEXP + e) * NR + mt * 128;
#pragma unroll
        for (int m = 0; m < 4; ++m) {
          const int rr = min(wrow + m * 16, rows_valid - 1);
          tsv[m] = lst[rr]; wv[m] = lw[rr];
        }
      }
      gemm_tile8<true>([&](int r, int i) { return Ab + (long)r * DFF; }, (l == 0 ? p.W8down : p.W8down1) + ((long)e * 1024 + nt * 128) * DFF, DFF, smem,
                [&](f32x4 (&acc)[4][4], int wr, int wc, int fr, int fq) {
                  constexpr float dq = 1.0f / (SH8 * SW8);
#pragma unroll
                  for (int m = 0; m < 4; ++m) {
                    const int row = wr * 64 + m * 16 + fr;
                    if (row < rows_valid) {
                      const int ts = tsv[m];
                      const float w = wv[m] * dq;
#pragma unroll
                      for (int n = 0; n < 4; ++n)
                        *reinterpret_cast<uint2*>(p.Y + (long)ts * D + nt * 128 + wc * 64 + n * 16 + fq * 4) =
                            make_uint2(pack2(acc[m][n][0] * w, acc[m][n][1] * w), pack2(acc[m][n][2] * w, acc[m][n][3] * w));
                    }
                  }
                });
    }
  }
}

__device__ __forceinline__ void phase_convert_dense(const Params& p, unsigned char* smem) {
  float* tile = (float*)smem;
  const int J0 = 16 * 26, J1 = J0 + 128, J2 = J1 + 16 * 19, J3 = J2 + 128;
  const int nb = (int)gridDim.x, blk = (int)blockIdx.x;
  const bool modblk = blk < MOD_ITEMS && nb > MOD_ITEMS;
  if (nb <= MOD_ITEMS) { for (int it = blk; it < MOD_ITEMS; it += nb) mod_item(p, it, smem); }
  else if (modblk) mod_item(p, blk, smem);
  int job, jstep, jend = J3;
  if (nb <= MOD_ITEMS) { job = blk; jstep = nb; }
  else if (modblk) { job = blk; jstep = J3; }
  else { job = MOD_ITEMS + (blk - MOD_ITEMS); jstep = nb - MOD_ITEMS; }
  for (; job < jend; job += jstep) {
    if (job < J0) { int j = job; const int n0 = (j % 26) * 128; conv_tile8_rm(p.w_in_even, IN_EVEN, (j / 26) * 64, n0, p.W8in_even, D, tile, SW8, [=](int n) { return n0 + n; }); }
    else if (job < J1) { int j = job - J0; const int n0 = (j % 8) * 128; conv_tile8_rm(p.w_out_even, D, (j / 8) * 64, n0, p.W8out_even, D, tile, SW8, [=](int n) { return n0 + n; }); }
    else if (job < J2) { int j = job - J1; const int n0 = (j % 19) * 128; conv_tile8_rm(p.w_in_odd, IN_ODD, (j / 19) * 64, n0, p.W8in_odd, D, tile, SW8, [=](int n) { return n0 + n; }, O_FA); }
    else { int j = job - J2; const int n0 = (j % 8) * 128; conv_tile8_rm(p.w_out_odd, D, (j / 8) * 64, n0, p.W8out_odd, D, tile, SW8, [=](int n) { return n0 + n; }); }
  }
}

__device__ __forceinline__ void phase_fold_z(const Params& p, long gtid, long gstride, float* tab) {
  if (threadIdx.x < 64) {
    float sn, cs;
    sincospif((float)threadIdx.x * (1.0f / 32.0f), &sn, &cs);
    tab[threadIdx.x] = cs; tab[64 + threadIdx.x] = -sn;
  }
  __syncthreads();
  for (long i = gtid; i < (long)256 * D; i += gstride) {
    const int k = (int)(i % D), col = (int)(i / D);
    const int g = col >> 6, cp = col & 63;
    const float* wz = p.w_in_odd + (long)k * IN_ODD + O_Z + g * 64;
    float s0 = 0.f, s1 = 0.f;
    float4 wv[16];
#pragma unroll
    for (int q = 0; q < 16; ++q) wv[q] = reinterpret_cast<const float4*>(wz)[q];
#pragma unroll
    for (int q = 0; q < 16; ++q) {
      const int i0 = ((4 * q) * cp) & 63, i1 = ((4 * q + 1) * cp) & 63, i2 = ((4 * q + 2) * cp) & 63, i3 = ((4 * q + 3) * cp) & 63;
      s0 += wv[q].x * tab[i0] + wv[q].y * tab[i1] + wv[q].z * tab[i2] + wv[q].w * tab[i3];
      s1 += wv[q].x * tab[64 + i0] + wv[q].y * tab[64 + i1] + wv[q].z * tab[64 + i2] + wv[q].w * tab[64 + i3];
    }
    const unsigned q0 = pack4_fp8(s0 * SW8, s1 * SW8, 0.f, 0.f);
    p.W8in_odd[(long)(O_FA + col) * D + k] = (unsigned char)(q0 & 0xffu);
    p.W8in_odd[(long)(O_FA + 256 + col) * D + k] = (unsigned char)((q0 >> 8) & 0xffu);
  }
  for (long i = gtid; i < (long)(IN_ODD_PAD - O_END) * D; i += gstride) p.W8in_odd[(long)O_END * D + i] = 0;
}

__device__ __forceinline__ void phase_cmat(const Params& p, long gtid, long gstride) {
  for (long i = gtid; i < (long)T * T; i += gstride) {
    const int t = (int)(i % T), tp = (int)(i / T);
    float sn, cs;
    sincospif((float)((t * tp) & (T - 1)) * (2.0f / T), &sn, &cs);
    stA(p.Cmat + (long)tp * 2 * T + t, cs);
    stA(p.Cmat + (long)tp * 2 * T + T + t, sn);
  }
}

__device__ __forceinline__ void row_stats(const float4 (&v)[4], float& mu, float& rs) {
  float s = 0.f;
#pragma unroll
  for (int i = 0; i < 4; ++i) s += v[i].x + v[i].y + v[i].z + v[i].w;
  mu = wave_sum(s) * (1.0f / D);
  float q = 0.f;
#pragma unroll
  for (int i = 0; i < 4; ++i) {
    float a = v[i].x - mu, b = v[i].y - mu, c = v[i].z - mu, d = v[i].w - mu;
    q += a * a + b * b + c * c + d * d;
  }
  rs = 1.0f / sqrtf(wave_sum(q) * (1.0f / D) + LN_EPS);
}

__device__ __forceinline__ void phase_lnmod_first(const Params& p) {
  const int lane = threadIdx.x & 63;
  const int nw = (int)gridDim.x * 4, wi = (int)blockIdx.x * 4 + (int)(threadIdx.x >> 6);
  const int rpw = (NR + nw - 1) / nw;
  const long r0 = (long)wi * rpw, r1 = min((long)NR, r0 + rpw);
  float4 shv[4], scv[4];
  int cur_bb = -2;
  float4 hv[4];
  auto load_row = [&](long row) {
    const float4* h = reinterpret_cast<const float4*>(hrow_in(p, row));
#pragma unroll
    for (int i = 0; i < 4; ++i) hv[i] = h[i * 64 + lane];
  };
  if (r0 < r1) load_row(r0);
  for (long row = r0; row < r1; ++row) {
    const int bb = row < NC ? NB : (int)((row - NC) / T);
    if (bb != cur_bb) {
      cur_bb = bb;
      const float* md = p.mod + (long)bb * 6 * D;
#pragma unroll
      for (int i = 0; i < 4; ++i) {
        shv[i] = reinterpret_cast<const float4*>(md)[i * 64 + lane];
        scv[i] = reinterpret_cast<const float4*>(md + D)[i * 64 + lane];
      }
    }
    float4 v[4];
#pragma unroll
    for (int i = 0; i < 4; ++i) v[i] = hv[i];
    load_row(min(row + 1, r1 - 1));
    float mu, rs;
    row_stats(v, mu, rs);
#pragma unroll
    for (int i = 0; i < 4; ++i) {
      const float a = (v[i].x - mu) * rs * (1.f + scv[i].x) + shv[i].x, b = (v[i].y - mu) * rs * (1.f + scv[i].y) + shv[i].y;
      const float c = (v[i].z - mu) * rs * (1.f + scv[i].z) + shv[i].z, d = (v[i].w - mu) * rs * (1.f + scv[i].w) + shv[i].w;
      reinterpret_cast<unsigned*>(p.u8 + row * D)[i * 64 + lane] = pack4_fp8(a * SU8, b * SU8, c * SU8, d * SU8);
    }
  }
}

__device__ __forceinline__ act_t* hrow16(const Params& p, long row) {
  return row < NC ? reinterpret_cast<act_t*>(p.hc) + row * D
                  : reinterpret_cast<act_t*>(reinterpret_cast<char*>(p.out) + (row - NC) * (long)(4 * D) + 2 * D);
}
template <int R_UNUSED>
__device__ __forceinline__ void phase_resid_ln(const Params& p, int l, int sub, long row_lo, long row_hi, unsigned char* smem) {
  const int lane = threadIdx.x & 63;
  int* cntL = (int*)smem;
  int* nent = cntL + 16;
  int* entL = cntL + 32;
  float* wT = (float*)(smem + 4096);
  if (sub == 0) {
    if (threadIdx.x < 32) cntL[threadIdx.x] = 0;
    {
      float4 wr4[16];
#pragma unroll
      for (int j = 0; j < 4; ++j)
#pragma unroll
        for (int q = 0; q < 4; ++q) wr4[j * 4 + q] = reinterpret_cast<const float4*>(p.w_router + (long)(threadIdx.x + 256 * j) * NEXP)[q];
#pragma unroll
      for (int j = 0; j < 4; ++j)
#pragma unroll
        for (int q = 0; q < 4; ++q) {
          const int k = threadIdx.x + 256 * j;
          wT[(q * 4 + 0) * D + k] = wr4[j * 4 + q].x; wT[(q * 4 + 1) * D + k] = wr4[j * 4 + q].y;
          wT[(q * 4 + 2) * D + k] = wr4[j * 4 + q].z; wT[(q * 4 + 3) * D + k] = wr4[j * 4 + q].w;
        }
    }
    __syncthreads();
  }
  const bool last = (sub == 1 && l == 1);
  const int nw = (int)gridDim.x * 4, wi = (int)blockIdx.x * 4 + (int)(threadIdx.x >> 6);
  const int rpw = ((int)(row_hi - row_lo) + nw - 1) / nw;
  const long r0 = row_lo + (long)wi * rpw, r1 = min(row_hi, r0 + rpw);
  const float4* lgp = reinterpret_cast<const float4*>(p.ln_g + (l * 2 + sub) * D);
  const float4* lbp = reinterpret_cast<const float4*>(p.ln_b + (l * 2 + sub) * D);
  float4 lgv[4], lbv[4];
  if (R_UNUSED != 1) {
#pragma unroll
    for (int i = 0; i < 4; ++i) { lgv[i] = lgp[i * 64 + lane]; lbv[i] = lbp[i * 64 + lane]; }
  }
  float4 gv[4], shv[4], scv[4];
  int cur_bb = -2;
  const bool first = (l == 0 && sub == 0);
  float4 hv[4];
  uint2 hb[4];
  uint2 mv[4], m2v[4];
  auto load_row = [&](long row) {
    const uint2* m = reinterpret_cast<const uint2*>(sub == 0 ? p.M + row * D : p.Y + row * 2 * D);
    if (first) {
      const float4* hin = reinterpret_cast<const float4*>(hrow_in(p, row));
#pragma unroll
      for (int i = 0; i < 4; ++i) hv[i] = hin[i * 64 + lane];
    } else {
      const uint2* hin = reinterpret_cast<const uint2*>(hrow16(p, row));
#pragma unroll
      for (int i = 0; i < 4; ++i) hb[i] = hin[i * 64 + lane];
    }
#pragma unroll
    for (int i = 0; i < 4; ++i) {
      mv[i] = m[i * 64 + lane];
      if (sub == 1) m2v[i] = m[256 + i * 64 + lane];
    }
  };
  if (r0 < r1) load_row(r0);
  for (long row = r0; row < r1; ++row) {
    const int bb = row < NC ? NB : (int)((row - NC) / T);
    if (bb != cur_bb) {
      cur_bb = bb;
      const float* md = p.mod + ((long)l * (NB + 1) + bb) * 6 * D;
      const float* md2 = (sub == 0) ? md + 3 * D : p.mod + ((long)(NB + 1) + bb) * 6 * D;
#pragma unroll
      for (int i = 0; i < 4; ++i) {
        gv[i] = reinterpret_cast<const float4*>(md + (sub == 0 ? 2 : 5) * D)[i * 64 + lane];
        shv[i] = reinterpret_cast<const float4*>(md2)[i * 64 + lane];
        scv[i] = reinterpret_cast<const float4*>(md2 + D)[i * 64 + lane];
      }
    }
    float4 v[4];
#pragma unroll
    for (int i = 0; i < 4; ++i) {
      float m0 = bf_lo(mv[i].x), m1 = bf_hi(mv[i].x), m2_ = bf_lo(mv[i].y), m3 = bf_hi(mv[i].y);
      if (sub == 1) { m0 += bf_lo(m2v[i].x); m1 += bf_hi(m2v[i].x); m2_ += bf_lo(m2v[i].y); m3 += bf_hi(m2v[i].y); }
      const float h0 = first ? hv[i].x : bf_lo(hb[i].x), h1 = first ? hv[i].y : bf_hi(hb[i].x);
      const float h2 = first ? hv[i].z : bf_lo(hb[i].y), h3 = first ? hv[i].w : bf_hi(hb[i].y);
      v[i].x = ALPHA * h0 + gv[i].x * m0;
      v[i].y = ALPHA * h1 + gv[i].y * m1;
      v[i].z = ALPHA * h2 + gv[i].z * m2_;
      v[i].w = ALPHA * h3 + gv[i].w * m3;
    }
    load_row(min(row + 1, r1 - 1));
    if (R_UNUSED == 1) {
#pragma unroll
      for (int i = 0; i < 4; ++i) { lgv[i] = lgp[i * 64 + lane]; lbv[i] = lbp[i * 64 + lane]; }
    }
    float mu, rs;
    row_stats(v, mu, rs);
#pragma unroll
    for (int i = 0; i < 4; ++i) {
      v[i].x = (v[i].x - mu) * rs * lgv[i].x + lbv[i].x;
      v[i].y = (v[i].y - mu) * rs * lgv[i].y + lbv[i].y;
      v[i].z = (v[i].z - mu) * rs * lgv[i].z + lbv[i].z;
      v[i].w = (v[i].w - mu) * rs * lgv[i].w + lbv[i].w;
    }
    if (last) {
      float4* hout = reinterpret_cast<float4*>(p.out + (row - NC) * D);
#pragma unroll
      for (int i = 0; i < 4; ++i) hout[i * 64 + lane] = v[i];
      continue;
    }
    uint2 hq[4];
#pragma unroll
    for (int i = 0; i < 4; ++i) {
      hq[i] = make_uint2(pack2(v[i].x, v[i].y), pack2(v[i].z, v[i].w));
      v[i].x = bf_lo(hq[i].x); v[i].y = bf_hi(hq[i].x); v[i].z = bf_lo(hq[i].y); v[i].w = bf_hi(hq[i].y);
    }
    row_stats(v, mu, rs);
    float lo[NEXP];
#pragma unroll
    for (int e = 0; e < NEXP; ++e) lo[e] = 0.f;
    uint2 up[4];
#pragma unroll
    for (int i = 0; i < 4; ++i) {
      float uv[4];
      uv[0] = (v[i].x - mu) * rs * (1.f + scv[i].x) + shv[i].x;
      uv[1] = (v[i].y - mu) * rs * (1.f + scv[i].y) + shv[i].y;
      uv[2] = (v[i].z - mu) * rs * (1.f + scv[i].z) + shv[i].z;
      uv[3] = (v[i].w - mu) * rs * (1.f + scv[i].w) + shv[i].w;
      up[i] = make_uint2(pack4_fp8(uv[0] * SU8, uv[1] * SU8, uv[2] * SU8, uv[3] * SU8), 0u);
      if (sub == 0) {
#pragma unroll
        for (int e = 0; e < NEXP; ++e) {
          const float4 w4 = *reinterpret_cast<const float4*>(wT + e * D + (i * 64 + lane) * 4);
          lo[e] += uv[0] * w4.x + uv[1] * w4.y + uv[2] * w4.z + uv[3] * w4.w;
          if ((e & 3) == 3) __builtin_amdgcn_sched_barrier(0);
        }
      }
    }
    int ge1 = 0, ge2 = 0;
    float w1 = 0.f, w2 = 0.f;
    if (sub == 0) {
      float mine = 0.f;
#pragma unroll
      for (int e = 0; e < NEXP; ++e) {
        const float rsum = row_sum16(lo[e]);
        mine = ((lane & 15) == e) ? rsum : mine;
      }
      mine += __shfl_xor(mine, 16);
      mine += __shfl_xor(mine, 32);
#pragma unroll
      for (int e = 0; e < NEXP; ++e) lo[e] = __int_as_float(__builtin_amdgcn_readlane(__float_as_int(mine), e));
      float mx = lo[0];
#pragma unroll
      for (int e = 1; e < NEXP; ++e) mx = fmaxf(mx, lo[e]);
      float sum = 0.f;
#pragma unroll
      for (int e = 0; e < NEXP; ++e) { lo[e] = __expf(lo[e] - mx); sum += lo[e]; }
      const float inv = 1.0f / sum;
      float bestg = -1e30f, gp1 = 0.f, gp2 = 0.f;
#pragma unroll
      for (int gq = 0; gq < 4; ++gq) {
        float s1 = -1e30f, s2 = -1e30f, p1 = 0.f, p2 = 0.f;
        int e1 = 0, e2 = 0;
#pragma unroll
        for (int j = 0; j < 4; ++j) {
          const int e = gq * 4 + j;
          const float pe = lo[e] * inv;
          const float se = pe + p.b_router[e];
          if (se > s1) { s2 = s1; p2 = p1; e2 = e1; s1 = se; p1 = pe; e1 = e; }
          else if (se > s2) { s2 = se; p2 = pe; e2 = e; }
        }
        const float gs = s1 + s2;
        if (gs > bestg) { bestg = gs; ge1 = e1; ge2 = e2; gp1 = p1; gp2 = p2; }
      }
      const float wsum = gp1 + gp2;
      w1 = gp1 / wsum; w2 = gp2 / wsum;
    }
    {
      uint2* hout = reinterpret_cast<uint2*>(hrow16(p, row));
#pragma unroll
      for (int i = 0; i < 4; ++i) hout[i * 64 + lane] = hq[i];
    }
#pragma unroll
    for (int i = 0; i < 4; ++i) reinterpret_cast<unsigned*>(p.u8 + row * D)[i * 64 + lane] = up[i].x;
    if (sub == 0 && lane == 0) {
      p.ew[row * 2 + 0] = w1; p.ew[row * 2 + 1] = w2;
      const int lp1 = atomicAdd(cntL + ge1, 1), lp2 = atomicAdd(cntL + ge2, 1);
      const int ei = atomicAdd(nent, 2);
      entL[3 * ei] = ((int)(row * 2) << 4) | ge1; entL[3 * ei + 1] = lp1; entL[3 * ei + 2] = __float_as_int(w1);
      entL[3 * ei + 3] = ((int)(row * 2 + 1) << 4) | ge2; entL[3 * ei + 4] = lp2; entL[3 * ei + 5] = __float_as_int(w2);
    }
  }
  if (sub == 0) {
    __syncthreads();
    if (threadIdx.x < NEXP) {
      const int c = cntL[threadIdx.x];
      cntL[threadIdx.x] = c ? atomicAdd(p.cnt + (l * NEXP + threadIdx.x) * 64, c) : 0;
    }
    __syncthreads();
    const int ne = *nent;
    for (int i = threadIdx.x; i < ne; i += 256) {
      const int key = entL[3 * i], lp = entL[3 * i + 1];
      const int e = key & 15;
      const long li = (long)(l * NEXP + e) * NR + cntL[e] + lp;
      p.list[li] = key >> 4;
      p.listw[li] = __int_as_float(entL[3 * i + 2]);
    }
    __syncthreads();
  }
}

#define LOOP(n) for (long i = gtid; i < (long)(n); i += gstride)

#ifdef ONLY_PHASE
#define PH(n, ...) if (ONLY_PHASE == n) { __VA_ARGS__ }
#define GSYNC()
#else
#define PH(n, ...) { __VA_ARGS__ }
#define GSYNC() xcd_barrier(xb)
#endif

__global__ void __launch_bounds__(256, 2) mega_kernel(Params p) {
  cg::grid_group grid = cg::this_grid();
  __shared__ __attribute__((aligned(16))) unsigned char smem[SMEM_BYTES + 16];
  if (threadIdx.x == 0) *reinterpret_cast<uint4*>(smem + SMEM_BYTES) = make_uint4(0u, 0u, 0u, 0u);
  __syncthreads();
  XcdBarrier xb = xcd_barrier_post(p.bar, (volatile LAS unsigned*)(smem + SMEM_BYTES));
  const long gtid = (long)blockIdx.x * blockDim.x + threadIdx.x;
  const long gstride = (long)gridDim.x * blockDim.x;
  const int nsb = min(256, (int)gridDim.x / 2);
  PH(0,
    if (gtid < 2 * NEXP) p.cnt[gtid * 64] = 0;
    phase_convert_dense(p, smem);
    phase_fold_z(p, gtid, gstride, (float*)(smem + 65536));
    LOOP(1024) ph_tables(p, i);)
#ifndef ONLY_PHASE
  if (p.use_cg_sync) grid.sync();
#endif
  GSYNC();
  PH(1, phase_lnmod_first(p);)
  GSYNC();
  PH(2, phase_gemm(p, GemmJob{(const act_t*)p.u8, (const act_t*)p.W8in_even, p.P, 0, 0, 0, 1, NR / 128, IN_EVEN / 128, D, PW, IN_EVEN, 2, 1.0f / (SU8 * SW8), 1, 0}, smem);)
  GSYNC();
  PH(3,
    if ((int)blockIdx.x < nsb) phase_scan<0>(p, smem, blockIdx.x, nsb);
    else phase_attn(p, smem, blockIdx.x - nsb, gridDim.x - nsb);)
  GSYNC();
  PH(4, phase_combine<0>(p);)
  GSYNC();
  PH(5,
    phase_gemm(p, GemmJob{(const act_t*)p.O8, (const act_t*)p.W8out_even, p.M, 0, 0, 0, 1, NR / 128, D / 128, D, D, D, 0, 1.0f / (SO8 * SW8), 1, 0}, smem);
    {
      const int rem = ((NR / 128) * (D / 128)) % (int)gridDim.x;
      if (rem > 0 && rem < (int)gridDim.x) { if ((int)blockIdx.x >= rem) phase_convert_experts(p, 0, smem, blockIdx.x - rem, gridDim.x - rem); }
      else phase_convert_experts(p, 0, smem, blockIdx.x, gridDim.x);
    })
  GSYNC();
  PH(6, phase_resid_ln<1>(p, 0, 0, 0, NR, smem);)
  GSYNC();
  PH(7, phase_moe(p, 0, false, smem);)
  GSYNC();
  PH(8, phase_moe(p, 0, true, smem);)
  GSYNC();
  PH(9, phase_resid_ln<2>(p, 0, 1, 0, NR, smem); phase_cmat(p, gtid, gstride);)
  GSYNC();
  PH(10, phase_gemm(p, GemmJob{(const act_t*)p.u8, (const act_t*)p.W8in_odd, p.P, 0, 0, 0, 1, NR / 128, IN_ODD_PAD / 128, D, PW, O_FA, 1, 1.0f / (SU8 * SW8), 1, 0}, smem);)
  GSYNC();
  PH(11, phase_gla_decay(p);)
  GSYNC();
  PH(12,
    if ((int)blockIdx.x < nsb) phase_scan<1>(p, smem, blockIdx.x, nsb);
    else {
      phase_gemm(p, GemmJob{p.Cmat, p.FT, (act_t*)(p.O8 + (long)NC * D + 768), 0, (long)256 * 2 * T, (long)T * D, NB, T / 128, 2, 2 * T, D,
                            256, 0, 0.00276213586400995f * SO8, 0, 1}, smem, blockIdx.x - nsb, gridDim.x - nsb);
      phase_convert_experts(p, 1, smem, blockIdx.x - nsb, gridDim.x - nsb);
    })
  GSYNC();
  PH(13, phase_combine<1>(p);)
  GSYNC();
  PH(14,
    phase_gemm(p, GemmJob{(const act_t*)(p.O8 + (long)NC * D), (const act_t*)p.W8out_odd, p.M + (long)NC * D, 0, 0, 0, 1, NT / 128, D / 128, D, D, D, 0, 1.0f / (SO8 * SW8), 1, 0}, smem);)
  GSYNC();
  PH(15, phase_resid_ln<1>(p, 1, 0, NC, NR, smem);)
  GSYNC();
  PH(16, phase_moe(p, 1, false, smem);)
  GSYNC();
  PH(17, phase_moe(p, 1, true, smem);)
  GSYNC();
  PH(18, phase_resid_ln<2>(p, 1, 1, NC, NR, smem);)
}

static size_t carve(Params& p, char* ws) {
  size_t off = 0;
  auto take = [&](size_t bytes) { char* r = ws + off; off += (bytes + 255) & ~(size_t)255; return r; };
  p.mod = (float*)take(sizeof(float) * 2 * (NB + 1) * 6 * D);
  p.bar = (unsigned*)take(sizeof(unsigned) * XCD_BAR_WORDS);
  p.hc = (float*)take(sizeof(float) * (size_t)NC * D);
  p.costab = (float*)take(sizeof(float) * T);
  p.sintab = (float*)take(sizeof(float) * T);
  p.lbt = (float*)take(sizeof(float) * 1024);
  p.ropetab = (float*)take(sizeof(float) * 64 * 16 * 2);
  p.ew = (float*)take(sizeof(float) * (size_t)NR * 2);
  p.eidx = nullptr;
  p.u = nullptr;
  p.O8 = (unsigned char*)take((size_t)NR * D);
  p.P = (act_t*)take(sizeof(act_t) * (size_t)NR * PW);
  p.OF = (act_t*)take(sizeof(act_t) * (size_t)NR * 768);
  p.OB = (act_t*)take(sizeof(act_t) * (size_t)NR * 768);
  p.M = p.OF;
  p.Cmat = (act_t*)take(sizeof(act_t) * (size_t)T * 2 * T);
  p.FT = (act_t*)take(sizeof(act_t) * (size_t)NB * 256 * 2 * T);
  p.LF = (act_t*)take(sizeof(act_t) * (size_t)2 * NR * 384);
  p.W8up = (unsigned char*)p.Cmat;
  p.W8down = p.W8up + (size_t)NEXP * 1024 * D;
  p.W8up1 = (unsigned char*)take((size_t)NEXP * 1024 * (D + DFF));
  p.W8down1 = p.W8up1 + (size_t)NEXP * 1024 * D;
  p.u8 = (unsigned char*)take((size_t)NR * D);
  p.Y = p.P;
  p.H8 = (unsigned char*)(p.P + (size_t)2 * NR * D);
  p.cnt = (int*)take(sizeof(int) * 2 * NEXP * 64);
  p.list = (int*)take(sizeof(int) * (size_t)2 * NEXP * NR);
  p.listw = (float*)take(sizeof(float) * (size_t)2 * NEXP * NR);
  p.Wt_in_even = nullptr;
  p.W8in_even = (unsigned char*)take((size_t)IN_EVEN * D);
  p.Wt_out_even = nullptr;
  p.W8out_even = (unsigned char*)take((size_t)D * D);
  p.Wt_in_odd = nullptr;
  p.W8in_odd = (unsigned char*)take((size_t)IN_ODD_PAD * D);
  p.Wt_out_odd = nullptr;
  p.W8out_odd = (unsigned char*)take((size_t)D * D);
  return off;
}

static void fill_inputs(Params& p, void* const* d_in) {
  const float** f = (const float**)&p;
  for (int i = 0; i < 23; ++i) f[i] = (const float*)d_in[i];
}

extern "C" void kernel_launch(void* const* d_in, const int* in_sizes, int n_in, void* d_out, int out_size,
                              void* d_ws, size_t ws_size, hipStream_t stream) {
  static int grid_blocks = 0;
  if (!grid_blocks) {
    int dev = 0, cus = 0, per_cu = 0;
    (void)hipGetDevice(&dev);
    (void)hipDeviceGetAttribute(&cus, hipDeviceAttributeMultiprocessorCount, dev);
    (void)hipOccupancyMaxActiveBlocksPerMultiprocessor(&per_cu, mega_kernel, 256, 0);
    grid_blocks = cus * per_cu;
  }
  Params p{};
  fill_inputs(p, d_in);
  p.out = (float*)d_out;
  size_t need = carve(p, (char*)d_ws);
  if (need > ws_size) { fprintf(stderr, "workspace too small: need %zu have %zu\n", need, ws_size); return; }
  (void)hipMemsetAsync(p.mod, 0, (size_t)((char*)(p.bar + XCD_BAR_WORDS) - (char*)p.mod), stream);
  void* args[] = {&p};
  hipError_t e = hipLaunchCooperativeKernel((void*)mega_kernel, dim3(grid_blocks), dim3(256), args, 0, stream);
  if (e != hipSuccess) fprintf(stderr, "cooperative launch failed: %s (grid %d)\n", hipGetErrorString(e), grid_blocks);
}
#endif
```

```cpp
#ifndef HOST_TEST
#include <hip/hip_runtime.h>
#include <hip/hip_cooperative_groups.h>
#include <cstdio>
namespace cg = cooperative_groups;
#define DEV __device__ __forceinline__
#else
#include <cmath>
#include <cstdio>
#include <cstdlib>
#include <cstring>
#define DEV static inline
#endif

#ifndef T_BATCH
#define T_BATCH 8
#endif
#ifndef T_SEQ
#define T_SEQ 2048
#endif
#ifndef T_CTX
#define T_CTX 256
#endif

constexpr int D = 1024, NB = T_BATCH, T = T_SEQ, C = T_CTX;
constexpr int NC = NB * C, NT = NB * T, NR = NC + NT;
constexpr int GRID_W = 64;
constexpr int IN_EVEN = 3328, IN_ODD = 2592, PW = 3328;
constexpr int NEXP = 16, DFF = 512;
constexpr float ALPHA = 1.4142135623730951f;
constexpr float LN_EPS = 1e-5f;
constexpr int E_AQ = 0, E_AK = 512, E_AV = 640, E_FF = 768, E_HQ = 1792, E_HI = 2304, E_HG = 2816;
constexpr int O_Q = 0, O_K = 384, O_V = 768, O_RF = 1536, O_G = 1568, O_Z = 2336;

#ifdef HOST_TEST
typedef float act_t;
DEV float ldA(const act_t* p) { return *p; }
DEV void stA(act_t* p, float v) { *p = v; }
#else
typedef unsigned short act_t;
DEV float ldA(const act_t* p) { return __uint_as_float(((unsigned)*p) << 16); }
DEV void stA(act_t* p, float v) {
  unsigned u = __float_as_uint(v);
  u += 0x7fffu + ((u >> 16) & 1u);
  *p = (unsigned short)(u >> 16);
}
#endif

__device__ __forceinline__ unsigned tidx() { unsigned t = threadIdx.x; asm volatile("" : "+v"(t)); return t & 255u; }
#define G_MOD_FLOATS (2 * 9 * 6 * 1024)
#define G_BAR_WORDS 3456
__device__ float g_mod[G_MOD_FLOATS];
__device__ unsigned g_bar[G_BAR_WORDS];
__device__ unsigned g_exit;
struct Params {
  const float *x, *c, *ctx, *c_ctx, *w_ada, *b_ada, *ln_g, *ln_b, *w_in_even, *attn_sink, *lb_logits, *hgrn_norm,
      *w_out_even, *w_in_odd, *gla_gate_w, *gla_gate_b, *gla_norm, *w_out_odd, *w_router, *b_router, *w_eg, *w_eu,
      *w_ed;
  float* out;
  float *mod, *hc, *costab, *sintab, *lbt, *ew, *ropetab;
  int* eidx;
  act_t *u, *P, *OF, *OB, *M, *LF;
  act_t *Wt_in_even, *Wt_out_even, *Wt_in_odd, *Wt_out_odd;
  act_t *Y, *Cmat, *FT;
  unsigned char *W8up, *W8down, *W8up1, *W8down1, *H8, *u8;
  unsigned char *W8in_even, *W8in_odd;
  unsigned char *W8out_even, *W8out_odd, *O8;
  int *cnt, *list;
  float* listw;
  unsigned* bar;
  int use_cg_sync;
  int pad_;
};

DEV float sigmoidf_(float v) { return 1.0f / (1.0f + expf(-v)); }
DEV float siluf_(float v) { return v / (1.0f + expf(-v)); }

DEV const float* hrow_in(const Params& p, long row) {
  return row < NC ? p.ctx + row * D : p.x + (row - NC) * D;
}
DEV float* hrow(const Params& p, long row) { return row < NC ? p.hc + row * D : p.out + (row - NC) * D; }
DEV const float* modrow(const Params& p, int l, long row) {
  int bb = row < NC ? NB : (int)((row - NC) / T);
  return g_mod + ((long)l * (NB + 1) + bb) * 6 * D;
}

DEV void ph_mod(const Params& p, long i) {
  int j = (int)(i % (6 * D));
  int bb = (int)((i / (6 * D)) % (NB + 1));
  int l = (int)(i / ((long)6 * D * (NB + 1)));
  const float* cv = bb < NB ? p.c + (long)bb * D : p.c_ctx;
  const float* w = p.w_ada + (long)l * D * 6 * D + j;
  float s = p.b_ada[l * 6 * D + j];
  for (int k = 0; k < D; ++k) s += siluf_(cv[k]) * w[(long)k * 6 * D];
  g_mod[i] = s;
}

DEV void ph_tables(const Params& p, long i) {
  if (i < 1024) {
    int pos = (int)(i >> 4), idx = (int)(i & 15);
    float ang = (float)pos * powf(10000.0f, -(float)idx / 16.0f);
    p.ropetab[2 * i] = cosf(ang);
    p.ropetab[2 * i + 1] = sinf(ang);
  }
  if (i < 1024) {
    int dir = (int)(i / 512), col = (int)(i % 512);
    float l0 = p.lb_logits[(dir * 2 + 0) * 512 + col], l1 = p.lb_logits[(dir * 2 + 1) * 512 + col];
    p.lbt[i] = 1.0f / (1.0f + expf(l1 - l0));
  }
}

DEV void ln_mod_row(const float* h, const float* shift, const float* scale, act_t* u) {
  float mu = 0.f;
  for (int k = 0; k < D; ++k) mu += h[k];
  mu *= (1.0f / D);
  float var = 0.f;
  for (int k = 0; k < D; ++k) { float d = h[k] - mu; var += d * d; }
  var *= (1.0f / D);
  float rs = 1.0f / sqrtf(var + LN_EPS);
  for (int k = 0; k < D; ++k) stA(u + k, (h[k] - mu) * rs * (1.0f + scale[k]) + shift[k]);
}

DEV void ph_lnmod_first(const Params& p, long row) {
  const float* m = modrow(p, 0, row);
  ln_mod_row(hrow_in(p, row), m, m + D, p.u + row * D);
}

DEV void gemm_item_act(const act_t* A, const float* W, act_t* Cout, int K, int N, int ldc, long i) {
  int n4 = (int)(i % (N / 4));
  long row = i / (N / 4);
  const act_t* a = A + row * K;
  const float* w = W + n4 * 4;
  float s0 = 0, s1 = 0, s2 = 0, s3 = 0;
  for (int k = 0; k < K; ++k) {
    float av = ldA(a + k);
    const float* wr = w + (long)k * N;
    s0 += av * wr[0]; s1 += av * wr[1]; s2 += av * wr[2]; s3 += av * wr[3];
  }
  act_t* o = Cout + row * ldc + n4 * 4;
  stA(o, s0); stA(o + 1, s1); stA(o + 2, s2); stA(o + 3, s3);
}

DEV void ph_rope(const Params& p, long i) {
  int pr = (int)(i % 32);
  int hh = (int)((i / 32) % 10);
  long lr = i / 320;
  int t = (int)(lr % T);
  int col = hh < 8 ? E_AQ + hh * 64 : E_AK + (hh - 8) * 64;
  int idx = pr & 15;
  int pos = pr < 16 ? t / GRID_W : t % GRID_W;
  int d0 = pr < 16 ? idx : 32 + idx;
  float inv = powf(10000.0f, -(float)idx / 16.0f);
  float ang = (float)pos * inv;
  float cs = cosf(ang), sn = sinf(ang);
  act_t* base = p.P + (NC + lr) * PW + col;
  float x1 = ldA(base + d0), x2 = ldA(base + d0 + 16);
  stA(base + d0, x1 * cs - x2 * sn);
  stA(base + d0 + 16, x1 * sn + x2 * cs);
}

DEV void ph_attn(const Params& p, long i) {
  int h = (int)(i % 8);
  long row = i / 8;
  int kv = h / 4;
  bool lat = row >= NC;
  int b = lat ? (int)((row - NC) / T) : (int)(row / C);
  int t = lat ? (int)((row - NC) % T) : 0;
  float q[64], acc[64];
  const act_t* qp = p.P + row * PW + E_AQ + h * 64;
#pragma unroll
  for (int d = 0; d < 64; ++d) { q[d] = ldA(qp + d) * 0.125f; acc[d] = 0.f; }
  float m = p.attn_sink[h], l = 1.0f;
  int nkeys = C + (lat ? 257 : 0);
  for (int j = 0; j < nkeys; ++j) {
    long krow;
    if (j < C) krow = (long)b * C + j;
    else {
      int kp = t - 128 + (j - C);
      if (kp < 0 || kp >= T) continue;
      krow = NC + (long)b * T + kp;
    }
    const act_t* kptr = p.P + krow * PW + E_AK + kv * 64;
    const act_t* vptr = p.P + krow * PW + E_AV + kv * 64;
    float s = 0.f;
#pragma unroll
    for (int d = 0; d < 64; ++d) s += q[d] * ldA(kptr + d);
    float mn = fmaxf(m, s);
    float sc = expf(m - mn), pj = expf(s - mn);
    l = l * sc + pj;
#pragma unroll
    for (int d = 0; d < 64; ++d) acc[d] = acc[d] * sc + pj * ldA(vptr + d);
    m = mn;
  }
  float il = 1.0f / l;
  act_t* o = p.u + row * D + h * 64;
#pragma unroll
  for (int d = 0; d < 64; ++d) stA(o + d, acc[d] * il);
}

template <int MODE>
DEV void ph_scan(const Params& p, long i) {
  constexpr int DK = MODE == 0 ? 128 : 96;
  constexpr int DV = MODE == 0 ? 128 : 192;
  int e = (int)(i % DV);
  int dir = (int)((i / DV) % 2);
  int h = (int)((i / (2 * DV)) % 4);
  int b = (int)(i / (8 * DV));
  float S[DK];
#pragma unroll
  for (int d = 0; d < DK; ++d) S[d] = 0.f;
  act_t* OD = dir == 0 ? p.OF : p.OB;
  for (int step = 0; step < C + T; ++step) {
    long row;
    if (step < C) row = (long)b * C + (dir == 0 ? step : C - 1 - step);
    else { int tt = step - C; row = NC + (long)b * T + (dir == 0 ? tt : T - 1 - tt); }
    const act_t* pr = p.P + row * PW;
    float o = 0.f;
    if (MODE == 0) {
      float v = ldA(pr + E_HI + h * 128 + e);
      const act_t* zp = pr + E_FF + dir * 512 + h * 128;
      const act_t* qp = pr + E_HQ + h * 128;
      const float* lb = p.lbt + dir * 512 + h * 128;
#pragma unroll
      for (int d = 0; d < DK; ++d) {
        float f = lb[d] + (1.0f - lb[d]) * sigmoidf_(ldA(zp + d));
        S[d] = f * S[d] + (1.0f - f) * v;
        o += ldA(qp + d) * S[d];
      }
      stA(OD + row * 768 + h * 128 + e, o);
    } else {
      float v = ldA(pr + O_V + h * 192 + e);
      const act_t* kp = pr + O_K + h * 96;
      const act_t* qp = pr + O_Q + h * 96;
      const act_t* lf = p.LF + ((long)dir * NR + row) * 384 + h * 96;
#pragma unroll
      for (int d = 0; d < DK; ++d) {
        float f = expf(ldA(lf + d));
        S[d] = f * S[d] + ldA(kp + d) * v;
        o += ldA(qp + d) * S[d];
      }
      stA(OD + row * 768 + h * 192 + e, o * 0.10206207261596575f);
    }
  }
}

template <int MODE>
DEV void ph_combine(const Params& p, long i) {
  constexpr int DV = MODE == 0 ? 128 : 192;
  int h = (int)(i % 4);
  long row = (MODE == 0) ? i / 4 : NC + i / 4;
  const act_t* f = p.OF + row * 768 + h * DV;
  const act_t* bk = p.OB + row * 768 + h * DV;
  float ss = 0.f;
  for (int e = 0; e < DV; ++e) { float o = ldA(f + e) + ldA(bk + e); ss += o * o; }
  float r = 1.0f / sqrtf(ss / DV + LN_EPS);
  const float* gn = (MODE == 0 ? p.hgrn_norm : p.gla_norm) + h * DV;
  const act_t* g = p.P + row * PW + (MODE == 0 ? E_HG : O_G) + h * DV;
  act_t* o = p.u + row * D + (MODE == 0 ? 512 : 0) + h * DV;
  for (int e = 0; e < DV; ++e) stA(o + e, (ldA(f + e) + ldA(bk + e)) * r * gn[e] * siluf_(ldA(g + e)));
}

DEV void ph_gla_decay(const Params& p, long i) {
  int col = (int)(i % 384);
  long row = (i / 384) % NR;
  int dir = (int)(i / ((long)384 * NR));
  const act_t* r = p.P + row * PW + O_RF + dir * 16;
  const float* gw = p.gla_gate_w + (long)dir * 16 * 384 + col;
  float z = p.gla_gate_b[dir * 384 + col];
  for (int k = 0; k < 16; ++k) z += ldA(r + k) * gw[k * 384];
  float ls = fminf(z, 0.f) - log1pf(expf(-fabsf(z)));
  stA(p.LF + ((long)dir * NR + row) * 384 + col, ls * (1.0f / 16.0f));
}

DEV void ph_resid_ln(const Params& p, long row, int l, int sub) {
  const float* hin = (l == 0 && sub == 0) ? hrow_in(p, row) : hrow(p, row);
  float* hout = hrow(p, row);
  const float* md = modrow(p, l, row);
  const float* g = md + (sub == 0 ? 2 : 5) * D;
  const act_t* m = p.M + row * D;
  const float* lg = p.ln_g + (l * 2 + sub) * D;
  const float* lb = p.ln_b + (l * 2 + sub) * D;
  float mu = 0.f;
  for (int k = 0; k < D; ++k) mu += ALPHA * hin[k] + g[k] * ldA(m + k);
  mu *= (1.0f / D);
  float var = 0.f;
  for (int k = 0; k < D; ++k) { float d = ALPHA * hin[k] + g[k] * ldA(m + k) - mu; var += d * d; }
  var *= (1.0f / D);
  float rs = 1.0f / sqrtf(var + LN_EPS);
  for (int k = 0; k < D; ++k) hout[k] = (ALPHA * hin[k] + g[k] * ldA(m + k) - mu) * rs * lg[k] + lb[k];
  if (sub == 1 && l == 1) return;
  const float* md2 = (sub == 0) ? md + 3 * D : modrow(p, 1, row);
  float mu2 = 0.f;
  for (int k = 0; k < D; ++k) mu2 += hout[k];
  mu2 *= (1.0f / D);
  float var2 = 0.f;
  for (int k = 0; k < D; ++k) { float d = hout[k] - mu2; var2 += d * d; }
  var2 *= (1.0f / D);
  float rs2 = 1.0f / sqrtf(var2 + LN_EPS);
  float lo[NEXP];
#pragma unroll
  for (int e = 0; e < NEXP; ++e) lo[e] = 0.f;
  for (int k = 0; k < D; ++k) {
    float uv = (hout[k] - mu2) * rs2 * (1.0f + md2[D + k]) + md2[k];
    stA(p.u + row * D + k, uv);
    if (sub == 0) {
      const float* wr = p.w_router + k * NEXP;
#pragma unroll
      for (int e = 0; e < NEXP; ++e) lo[e] += uv * wr[e];
    }
  }
  if (sub != 0) return;
  float mx = lo[0];
#pragma unroll
  for (int e = 1; e < NEXP; ++e) mx = fmaxf(mx, lo[e]);
  float sum = 0.f;
#pragma unroll
  for (int e = 0; e < NEXP; ++e) { lo[e] = expf(lo[e] - mx); sum += lo[e]; }
  float inv = 1.0f / sum;
  float bestg = -1e30f; int bg = 0;
  float gi1 = 0, gi2 = 0; int ge1 = 0, ge2 = 0;
  float gp1 = 0, gp2 = 0;
#pragma unroll
  for (int gq = 0; gq < 4; ++gq) {
    float s1 = -1e30f, s2 = -1e30f, p1 = 0, p2 = 0; int e1 = 0, e2 = 0;
#pragma unroll
    for (int j = 0; j < 4; ++j) {
      int e = gq * 4 + j;
      float pe = lo[e] * inv;
      float se = pe + p.b_router[e];
      if (se > s1) { s2 = s1; p2 = p1; e2 = e1; s1 = se; p1 = pe; e1 = e; }
      else if (se > s2) { s2 = se; p2 = pe; e2 = e; }
    }
    float gs = s1 + s2;
    if (gs > bestg) { bestg = gs; bg = gq; gi1 = s1; gi2 = s2; ge1 = e1; ge2 = e2; gp1 = p1; gp2 = p2; }
  }
  (void)bg; (void)gi1; (void)gi2;
  float wsum = gp1 + gp2;
  p.eidx[row * 2 + 0] = ge1; p.eidx[row * 2 + 1] = ge2;
  p.ew[row * 2 + 0] = gp1 / wsum; p.ew[row * 2 + 1] = gp2 / wsum;
}

DEV void ph_moe_up(const Params& p, long i, int l, long row0) {
  int f4 = (int)(i % (DFF / 4));
  int slot = (int)((i / (DFF / 4)) % 2);
  long row = row0 + i / (DFF / 2);
  int e = p.eidx[row * 2 + slot];
  const float* w1 = p.w_eg + ((long)(l * NEXP + e) * D) * DFF + f4 * 4;
  const float* w3 = p.w_eu + ((long)(l * NEXP + e) * D) * DFF + f4 * 4;
  const act_t* a = p.u + row * D;
  float g0 = 0, g1 = 0, g2 = 0, g3 = 0, u0 = 0, u1 = 0, u2 = 0, u3 = 0;
  for (int k = 0; k < D; ++k) {
    float av = ldA(a + k);
    const float* r1 = w1 + (long)k * DFF;
    const float* r3 = w3 + (long)k * DFF;
    g0 += av * r1[0]; g1 += av * r1[1]; g2 += av * r1[2]; g3 += av * r1[3];
    u0 += av * r3[0]; u1 += av * r3[1]; u2 += av * r3[2]; u3 += av * r3[3];
  }
  act_t* hb = p.P + (row * 2 + slot) * DFF + f4 * 4;
  stA(hb, siluf_(g0) * u0); stA(hb + 1, siluf_(g1) * u1); stA(hb + 2, siluf_(g2) * u2); stA(hb + 3, siluf_(g3) * u3);
}

DEV void ph_moe_down(const Params& p, long i, int l, long row0) {
  int j4 = (int)(i % (D / 4));
  long row = row0 + i / (D / 4);
  float y0 = 0, y1 = 0, y2 = 0, y3 = 0;
  for (int slot = 0; slot < 2; ++slot) {
    int e = p.eidx[row * 2 + slot];
    float wgt = p.ew[row * 2 + slot];
    const float* w2 = p.w_ed + ((long)(l * NEXP + e) * DFF) * D + j4 * 4;
    const act_t* hb = p.P + (row * 2 + slot) * DFF;
    float s0 = 0, s1 = 0, s2 = 0, s3 = 0;
    for (int f = 0; f < DFF; ++f) {
      float hv = ldA(hb + f);
      const float* r = w2 + (long)f * D;
      s0 += hv * r[0]; s1 += hv * r[1]; s2 += hv * r[2]; s3 += hv * r[3];
    }
    y0 += wgt * s0; y1 += wgt * s1; y2 += wgt * s2; y3 += wgt * s3;
  }
  act_t* o = p.M + row * D + j4 * 4;
  stA(o, y0); stA(o + 1, y1); stA(o + 2, y2); stA(o + 3, y3);
}


#ifndef HOST_TEST
typedef __attribute__((ext_vector_type(8))) short bf16x8;
typedef __attribute__((ext_vector_type(4))) float f32x4;
constexpr int SMEM_BYTES = 71680;
constexpr int IN_ODD_PAD = 2944;
constexpr int O_FA = 2336, O_FB = 2592, O_END = 2848;

typedef float f32x2_t __attribute__((ext_vector_type(2)));
typedef __bf16 bf16x2_t __attribute__((ext_vector_type(2)));
__device__ __forceinline__ unsigned pack2(float a, float b) {
  const f32x2_t v = {a, b};
  return __builtin_bit_cast(unsigned, __builtin_convertvector(v, bf16x2_t));
}
__device__ __forceinline__ unsigned pack2_mfma(float a, float b) { return pack2(a, b); }
typedef __attribute__((ext_vector_type(2))) unsigned u32x2;
__device__ __forceinline__ float xor16_max(float x) {
  const u32x2 r = __builtin_amdgcn_permlane16_swap(__float_as_uint(x), __float_as_uint(x), false, false);
  return fmaxf(__uint_as_float(r.x), __uint_as_float(r.y));
}
__device__ __forceinline__ float xor32_max(float x) {
  const u32x2 r = __builtin_amdgcn_permlane32_swap(__float_as_uint(x), __float_as_uint(x), false, false);
  return fmaxf(__uint_as_float(r.x), __uint_as_float(r.y));
}
__device__ __forceinline__ float xor16_add(float x) {
  const u32x2 r = __builtin_amdgcn_permlane16_swap(__float_as_uint(x), __float_as_uint(x), false, false);
  return __uint_as_float(r.x) + __uint_as_float(r.y);
}
__device__ __forceinline__ float xor32_add(float x) {
  const u32x2 r = __builtin_amdgcn_permlane32_swap(__float_as_uint(x), __float_as_uint(x), false, false);
  return __uint_as_float(r.x) + __uint_as_float(r.y);
}
__device__ __forceinline__ uint4 widen_pair(uint2 a, uint2 b) {
  const u32x2 rx = __builtin_amdgcn_permlane16_swap(a.x, b.x, false, false);
  const u32x2 ry = __builtin_amdgcn_permlane16_swap(a.y, b.y, false, false);
  return make_uint4(rx[0], ry[0], rx[1], ry[1]);
}
__device__ __forceinline__ float bf_lo(unsigned u) { return __uint_as_float(u << 16); }
__device__ __forceinline__ float bf_hi(unsigned u) { return __uint_as_float(u & 0xffff0000u); }
template <int CTRL>
__device__ __forceinline__ float dpp_mov(float v) {
  return __int_as_float(__builtin_amdgcn_update_dpp(0, __float_as_int(v), CTRL, 0xf, 0xf, true));
}
__device__ __forceinline__ float row_sum16(float v) {
  v += dpp_mov<0xB1>(v);
  v += dpp_mov<0x4E>(v);
  v += dpp_mov<0x141>(v);
  v += dpp_mov<0x140>(v);
  return v;
}
__device__ __forceinline__ float wave_sum(float v) {
  v = row_sum16(v);
  const float a = __int_as_float(__builtin_amdgcn_readlane(__float_as_int(v), 0));
  const float b = __int_as_float(__builtin_amdgcn_readlane(__float_as_int(v), 16));
  const float c = __int_as_float(__builtin_amdgcn_readlane(__float_as_int(v), 32));
  const float d = __int_as_float(__builtin_amdgcn_readlane(__float_as_int(v), 48));
  return (a + b) + (c + d);
}


#define XB_TMO      128
#define XB_XCNT(j)  (256  + 64 * (j))
#define XB_XSUB(j)  (1280 + 64 * (j))
#define XB_XGEN(j)  (2304 + 64 * (j))
#define XB_TOP      3328
#define XB_TOPGEN   3392
#define XCD_BAR_WORDS 3456
#define XB_SPIN_CAP (1u << 18)
#define LAS __attribute__((address_space(3)))
__device__ __forceinline__ unsigned xb_ld(unsigned* p)              { return __hip_atomic_load(p, __ATOMIC_RELAXED, __HIP_MEMORY_SCOPE_AGENT); }
__device__ __forceinline__ unsigned xb_add(unsigned* p, unsigned v) { return __hip_atomic_fetch_add(p, v, __ATOMIC_RELAXED, __HIP_MEMORY_SCOPE_AGENT); }
__device__ __forceinline__ unsigned xb_xcc_id() { return (unsigned)__builtin_amdgcn_s_getreg((3 << 11) | 20) & 0xFu; }
#define XB_SPIN(cond, bar) do { unsigned _sp = 0; while (cond) { __builtin_amdgcn_s_sleep(1); \
    if ((++_sp & 255u) == 0u) { if (xb_ld(&(bar)[XB_TMO])) break; if (_sp > XB_SPIN_CAP) { atomicAdd(&(bar)[XB_TMO], 1u); break; } } } } while (0)
struct XcdBarrier { unsigned* bar; unsigned x; volatile LAS unsigned* st; };
__device__ __forceinline__ XcdBarrier xcd_barrier_post(unsigned* bar, volatile LAS unsigned* st) {
    XcdBarrier b; b.bar = bar; b.x = xb_xcc_id(); b.st = st;
    if (tidx() == 0) (void)xb_add(&bar[XB_XCNT(b.x)], 1u);
    return b;
}
__device__ __forceinline__ void xcd_barrier_complete(unsigned* bar, unsigned x, unsigned& nloc, unsigned& nx) {
    const unsigned G = gridDim.x * gridDim.y * gridDim.z;
    unsigned sum, cnt, mine, sp = 0u;
    for (;;) {
        sum = 0u; cnt = 0u; mine = 0u;
#pragma unroll
        for (unsigned j = 0; j < 16; ++j) { const unsigned c = xb_ld(&bar[XB_XCNT(j)]); sum += c; cnt += (c > 0u) ? 1u : 0u; mine = (j == x) ? c : mine; }
        if (sum == G) break;
        __builtin_amdgcn_s_sleep(1);
        if ((++sp & 255u) == 0u) { if (xb_ld(&bar[XB_TMO])) break; if (sp > XB_SPIN_CAP) { atomicAdd(&bar[XB_TMO], 1u); break; } }
    }
    nloc = mine > 0u ? mine : 1u; nx = cnt > 0u ? cnt : 1u;
}
__device__ __forceinline__ void xcd_barrier(const XcdBarrier& b) {
    asm volatile("s_waitcnt vmcnt(0)" ::: "memory");
    __syncthreads();
    if (tidx() == 0) {
        unsigned* bar = b.bar;
        __builtin_amdgcn_s_waitcnt(0);
        unsigned nloc = b.st[0], nx = b.st[1];
        if (nloc == 0u) { xcd_barrier_complete(bar, b.x, nloc, nx); b.st[0] = nloc; b.st[1] = nx; }
        const unsigned old = xb_add(&bar[XB_XSUB(b.x)], 1u);
        const unsigned gen = old / nloc;
        if (old + 1u == (gen + 1u) * nloc) {
            __builtin_amdgcn_fence(__ATOMIC_RELEASE, "agent");
            asm volatile("s_waitcnt vmcnt(0)" ::: "memory");
            const unsigned og = xb_add(&bar[XB_TOP], 1u);
            const unsigned tg = og / nx;
            if (og + 1u == (tg + 1u) * nx) xb_add(&bar[XB_TOPGEN], 1u);
            else XB_SPIN(xb_ld(&bar[XB_TOPGEN]) == tg, bar);
            __builtin_amdgcn_fence(__ATOMIC_ACQUIRE, "agent");
            xb_add(&bar[XB_XGEN(b.x)], 1u);
            asm volatile("s_waitcnt vmcnt(0)" ::: "memory");
        } else {
            XB_SPIN(xb_ld(&bar[XB_XGEN(b.x)]) == gen, bar);
            __builtin_amdgcn_fence(__ATOMIC_ACQUIRE, "agent");
            asm volatile("s_waitcnt vmcnt(0)" ::: "memory");
        }
    }
    __syncthreads();
}

#define RAW_BARRIER() do { asm volatile("s_waitcnt lgkmcnt(0)" ::: "memory"); __builtin_amdgcn_s_barrier(); } while (0)
template <bool SWAP, class ARow, class Epi>
__device__ __forceinline__ void gemm_tile(ARow arow, const act_t* Bt, int K, unsigned char* smem, Epi epi) {
  const int tid = tidx(), wid = tid >> 6, lane = tid & 63, wr = wid >> 1, wc = wid & 1, fr = lane & 15,
            fq = lane >> 4;
  const int r0 = tid >> 3, pc = tid & 7;
  const int lc = pc ^ ((tid >> 4) & 7);
  const act_t* ga[4];
#pragma unroll
  for (int i = 0; i < 4; ++i) ga[i] = arow(r0 + 32 * i) + lc * 8;
  const act_t* gb0 = Bt + (long)r0 * K + lc * 8;
  const long gbs = (long)32 * K;
  const int sw = (fr >> 1) & 7;
  const int rd0 = fr * 128 + ((fq ^ sw) << 4), rd1 = fr * 128 + (((4 + fq) ^ sw) << 4);
  char* S = (char*)smem;
  const int nk = K >> 6;
  f32x4 acc[4][4];
#pragma unroll
  for (int m = 0; m < 4; ++m)
#pragma unroll
    for (int n = 0; n < 4; ++n) acc[m][n] = f32x4{0.f, 0.f, 0.f, 0.f};
  auto issue = [&](int kt) {
    char* st = S + (kt & 1) * 32768 + tid * 16;
#pragma unroll
    for (int i = 0; i < 4; ++i) {
      __builtin_amdgcn_global_load_lds((const unsigned*)(ga[i] + kt * 64), (unsigned*)(st + i * 4096), 16, 0, 0);
      __builtin_amdgcn_global_load_lds((const unsigned*)(gb0 + i * gbs + kt * 64), (unsigned*)(st + 16384 + i * 4096), 16, 0, 0);
    }
  };
  RAW_BARRIER();
  issue(0);
  for (int kt = 0; kt < nk; ++kt) {
    asm volatile("s_waitcnt vmcnt(0)" ::: "memory");
    RAW_BARRIER();
    if (kt + 1 < nk) issue(kt + 1);
    const char* st = S + (kt & 1) * 32768;
#pragma unroll
    for (int ks = 0; ks < 2; ++ks) {
      const int rd = ks ? rd1 : rd0;
      bf16x8 af[4], bfr[4];
#pragma unroll
      for (int m = 0; m < 4; ++m) {
        af[m] = *reinterpret_cast<const bf16x8*>(st + (wr * 64 + m * 16) * 128 + rd);
        bfr[m] = *reinterpret_cast<const bf16x8*>(st + 16384 + (wc * 64 + m * 16) * 128 + rd);
      }
#pragma unroll
      for (int m = 0; m < 4; ++m)
#pragma unroll
        for (int n = 0; n < 4; ++n)
          acc[m][n] = SWAP ? __builtin_amdgcn_mfma_f32_16x16x32_bf16(bfr[n], af[m], acc[m][n], 0, 0, 0)
                           : __builtin_amdgcn_mfma_f32_16x16x32_bf16(af[m], bfr[n], acc[m][n], 0, 0, 0);
    }
  }
  epi(acc, wr, wc, fr, fq);
}


constexpr float SU8 = 16.0f, SW8 = 64.0f, SH8 = 8.0f, SO8 = 8.0f;
typedef unsigned char fp8_t;
typedef __attribute__((ext_vector_type(8))) int i32x8;
typedef __attribute__((ext_vector_type(4))) int i32x4;
__device__ __forceinline__ unsigned pack4_fp8(float a, float b, float c, float d) {
  a = fminf(fmaxf(a, -448.f), 448.f); b = fminf(fmaxf(b, -448.f), 448.f);
  c = fminf(fmaxf(c, -448.f), 448.f); d = fminf(fmaxf(d, -448.f), 448.f);
  unsigned w = 0;
  w = __builtin_amdgcn_cvt_pk_fp8_f32(a, b, w, false);
  w = __builtin_amdgcn_cvt_pk_fp8_f32(c, d, w, true);
  return w;
}

template <bool SWAP, class ARow, class Epi>
__device__ __forceinline__ void gemm_tile8(ARow arow, const fp8_t* Bt, int Kb, unsigned char* smem, Epi epi) {
  const int tid = tidx(), wid = tid >> 6, lane = tid & 63, wr = wid >> 1, wc = wid & 1, fr = lane & 15,
            fq = lane >> 4;
  const int r0 = tid >> 3, pc = tid & 7;
  const int lc = pc ^ ((tid >> 4) & 7);
  const fp8_t* ga[4];
#pragma unroll
  for (int i = 0; i < 4; ++i) ga[i] = arow(r0 + 32 * i, i) + lc * 16;
  const fp8_t* gb0 = Bt + (long)r0 * Kb + lc * 16;
  const long gbs = (long)32 * Kb;
  const int sw = (fr >> 1) & 7;
  const int rd0 = fr * 128 + ((fq ^ sw) << 4), rd1 = fr * 128 + (((4 + fq) ^ sw) << 4);
  char* S = (char*)smem;
  const int nk = Kb >> 7;
  f32x4 acc[4][4];
#pragma unroll
  for (int m = 0; m < 4; ++m)
#pragma unroll
    for (int n = 0; n < 4; ++n) acc[m][n] = f32x4{0.f, 0.f, 0.f, 0.f};
  auto issue = [&](int kt) {
    char* st = S + (kt & 1) * 32768 + tid * 16;
#pragma unroll
    for (int i = 0; i < 4; ++i) {
      __builtin_amdgcn_global_load_lds((const unsigned*)(ga[i] + kt * 128), (unsigned*)(st + i * 4096), 16, 0, 0);
      __builtin_amdgcn_global_load_lds((const unsigned*)(gb0 + i * gbs + kt * 128), (unsigned*)(st + 16384 + i * 4096), 16, 0, 0);
    }
  };
  RAW_BARRIER();
  issue(0);
  if (nk > 1) issue(1);
#pragma unroll 1
  for (int kt = 0; kt < nk; ++kt) {
    if (kt + 1 < nk) asm volatile("s_waitcnt vmcnt(8)" ::: "memory");
    else asm volatile("s_waitcnt vmcnt(0)" ::: "memory");
    RAW_BARRIER();
    const char* st = S + (kt & 1) * 32768;
    i32x8 af[4], bfr[4];
#pragma unroll
    for (int m = 0; m < 4; ++m) {
      const i32x4 a0 = *reinterpret_cast<const i32x4*>(st + (wr * 64 + m * 16) * 128 + rd0);
      const i32x4 a1 = *reinterpret_cast<const i32x4*>(st + (wr * 64 + m * 16) * 128 + rd1);
      const i32x4 b0 = *reinterpret_cast<const i32x4*>(st + 16384 + (wc * 64 + m * 16) * 128 + rd0);
      const i32x4 b1 = *reinterpret_cast<const i32x4*>(st + 16384 + (wc * 64 + m * 16) * 128 + rd1);
      af[m] = i32x8{a0[0], a0[1], a0[2], a0[3], a1[0], a1[1], a1[2], a1[3]};
      bfr[m] = i32x8{b0[0], b0[1], b0[2], b0[3], b1[0], b1[1], b1[2], b1[3]};
    }
    RAW_BARRIER();
    if (kt + 2 < nk) issue(kt + 2);
#pragma unroll
    for (int m = 0; m < 4; ++m)
#pragma unroll
      for (int n = 0; n < 4; ++n)
        acc[m][n] = SWAP ? __builtin_amdgcn_mfma_scale_f32_16x16x128_f8f6f4(bfr[n], af[m], acc[m][n], 0, 0, 0, 0x7f7f7f7f, 0, 0x7f7f7f7f)
                         : __builtin_amdgcn_mfma_scale_f32_16x16x128_f8f6f4(af[m], bfr[n], acc[m][n], 0, 0, 0, 0x7f7f7f7f, 0, 0x7f7f7f7f);
  }
  epi(acc, wr, wc, fr, fq);
}


template <bool SWAP, class Epi>
__device__ __forceinline__ void gemm_tile8p(const fp8_t* A, const fp8_t* Bt, bool has_next, const fp8_t* An, const fp8_t* Btn,
                                            int& par, bool& primed, int Kb, unsigned char* smem, Epi epi) {
  const int tid = tidx(), wid = tid >> 6, lane = tid & 63, wr = wid >> 1, wc = wid & 1, fr = lane & 15,
            fq = lane >> 4;
  const int r0 = tid >> 3, pc = tid & 7;
  const int lc = pc ^ ((tid >> 4) & 7);
  const long roff = (long)r0 * Kb + lc * 16;
  const long gbs = (long)32 * Kb;
  const int sw = (fr >> 1) & 7;
  const int rd0 = fr * 128 + ((fq ^ sw) << 4), rd1 = fr * 128 + (((4 + fq) ^ sw) << 4);
  char* S = (char*)smem;
  const int nk = Kb >> 7;
  f32x4 acc[4][4];
#pragma unroll
  for (int m = 0; m < 4; ++m)
#pragma unroll
    for (int n = 0; n < 4; ++n) acc[m][n] = f32x4{0.f, 0.f, 0.f, 0.f};
  auto issue = [&](const fp8_t* a, const fp8_t* b, int kt, int stage) {
    char* st = S + stage * 32768 + tid * 16;
    const fp8_t* ga = a + roff + kt * 128;
    const fp8_t* gb = b + roff + kt * 128;
#pragma unroll
    for (int i = 0; i < 4; ++i) {
      __builtin_amdgcn_global_load_lds((const unsigned*)(ga + i * gbs), (unsigned*)(st + i * 4096), 16, 0, 0);
      __builtin_amdgcn_global_load_lds((const unsigned*)(gb + i * gbs), (unsigned*)(st + 16384 + i * 4096), 16, 0, 0);
    }
  };
  if (!primed) {
    RAW_BARRIER();
    issue(A, Bt, 0, par);
  }
#pragma unroll 1
  for (int kt = 0; kt < nk; ++kt) {
    asm volatile("s_waitcnt vmcnt(0)" ::: "memory");
    RAW_BARRIER();
    if (kt + 1 < nk) issue(A, Bt, kt + 1, (par + kt + 1) & 1);
    else if (has_next) issue(An, Btn, 0, (par + kt + 1) & 1);
    const char* st = S + ((par + kt) & 1) * 32768;
    i32x8 af[4], bfr[4];
#pragma unroll
    for (int m = 0; m < 4; ++m) {
      const i32x4 a0 = *reinterpret_cast<const i32x4*>(st + (wr * 64 + m * 16) * 128 + rd0);
      const i32x4 a1 = *reinterpret_cast<const i32x4*>(st + (wr * 64 + m * 16) * 128 + rd1);
      const i32x4 b0 = *reinterpret_cast<const i32x4*>(st + 16384 + (wc * 64 + m * 16) * 128 + rd0);
      const i32x4 b1 = *reinterpret_cast<const i32x4*>(st + 16384 + (wc * 64 + m * 16) * 128 + rd1);
      af[m] = i32x8{a0[0], a0[1], a0[2], a0[3], a1[0], a1[1], a1[2], a1[3]};
      bfr[m] = i32x8{b0[0], b0[1], b0[2], b0[3], b1[0], b1[1], b1[2], b1[3]};
    }
#pragma unroll
    for (int m = 0; m < 4; ++m)
#pragma unroll
      for (int n = 0; n < 4; ++n)
        acc[m][n] = SWAP ? __builtin_amdgcn_mfma_scale_f32_16x16x128_f8f6f4(bfr[n], af[m], acc[m][n], 0, 0, 0, 0x7f7f7f7f, 0, 0x7f7f7f7f)
                         : __builtin_amdgcn_mfma_scale_f32_16x16x128_f8f6f4(af[m], bfr[n], acc[m][n], 0, 0, 0, 0x7f7f7f7f, 0, 0x7f7f7f7f);
  }
  par = (par + nk) & 1;
  primed = has_next;
  epi(acc, wr, wc, fr, fq);
}

__device__ __forceinline__ void phase_attn(const Params& p, unsigned char* smem, int blk, int nblk) {
  const int tid = tidx(), w = tid >> 6, lane = tid & 63, fr = lane & 15, g = lane >> 4;
  act_t* SK = (act_t*)smem;
  act_t* SV = SK + 64 * 72;
  constexpr float SCL = 0.125f * 1.4426950408889634f;
  const int n_lat = NB * 4 * (T / 64), n_ctx = NB * 4 * (C / 64);
  const int skey = tid >> 2, spart = tid & 3;
  const int unit0 = (nblk & 63) ? blk : (blk >> 6) * 64 + (blk & 7) * 8 + ((blk >> 3) & 7);
  for (int unit = unit0; unit < n_lat + n_ctx; unit += nblk) {
    const bool lat = unit < n_lat;
    const int uu = lat ? unit : unit - n_lat;
    const int nq = lat ? T / 64 : C / 64;
    const int hp = uu & 1, kv = (uu >> 1) & 1, qb = (uu >> 2) % nq, b = (uu >> 2) / nq;
    const int t0 = qb * 64;
    const int tw = t0 + (w & 1) * 32;
    const long qrow0 = (lat ? (long)NC + (long)b * T : (long)b * C) + tw;
    const int h = kv * 4 + hp * 2 + (w >> 1);
    bf16x8 qf[2][2];
#pragma unroll
    for (int qt = 0; qt < 2; ++qt)
#pragma unroll
      for (int st = 0; st < 2; ++st)
        qf[qt][st] = *reinterpret_cast<const bf16x8*>(p.P + (qrow0 + qt * 16 + fr) * PW + E_AQ + h * 64 + st * 32 + g * 8);
    asm volatile("" :: "v"(qf[0][0]), "v"(qf[0][1]), "v"(qf[1][0]), "v"(qf[1][1]));
    float mrun[2], lrun[2];
    f32x4 o[2][4];
    const float sinkl = p.attn_sink[h] * 1.4426950408889634f;
#pragma unroll
    for (int qt = 0; qt < 2; ++qt) {
      mrun[qt] = sinkl;
      lrun[qt] = (g == 0) ? 1.0f : 0.0f;
#pragma unroll
      for (int dt = 0; dt < 4; ++dt) o[qt][dt] = f32x4{0.f, 0.f, 0.f, 0.f};
    }
    int cc_lo = 0, cc_hi = -1;
    if (lat) {
      cc_lo = t0 >= 128 ? 0 : (128 - t0) / 64;
      cc_hi = min(4, (T - 1 - (t0 - 128)) / 64);
    }
    const int nch = 4 + (cc_hi - cc_lo + 1);
    auto chunk_row = [&](int i, int key, int& tkb) -> long {
      if (i < 4) { tkb = 0; return (long)b * C + i * 64 + key; }
      tkb = t0 - 128 + (cc_lo + i - 4) * 64;
      return (long)NC + (long)b * T + tkb + key;
    };
    uint4 rk0, rk1, rv0, rv1;
    {
      int tkb; const long kr = chunk_row(0, skey, tkb);
      const act_t* kp = p.P + kr * PW + E_AK + kv * 64 + spart * 16;
      const act_t* vp = p.P + kr * PW + E_AV + kv * 64 + spart * 16;
      rk0 = *reinterpret_cast<const uint4*>(kp); rk1 = *reinterpret_cast<const uint4*>(kp + 8);
      rv0 = *reinterpret_cast<const uint4*>(vp); rv1 = *reinterpret_cast<const uint4*>(vp + 8);
    }
    for (int i = 0; i < nch; ++i) {
      __syncthreads();
      {
        uint4* kd = reinterpret_cast<uint4*>(SK + skey * 72 + spart * 16);
        kd[0] = rk0; kd[1] = rk1;
        const unsigned vw[8] = {rv0.x, rv0.y, rv0.z, rv0.w, rv1.x, rv1.y, rv1.z, rv1.w};
#pragma unroll
        for (int e = 0; e < 8; ++e) {
          SV[(spart * 16 + 2 * e) * 72 + skey] = (act_t)(vw[e] & 0xffffu);
          SV[(spart * 16 + 2 * e + 1) * 72 + skey] = (act_t)(vw[e] >> 16);
        }
      }
      __syncthreads();
      int tkb_cur; (void)chunk_row(i, 0, tkb_cur);
      if (i + 1 < nch) {
        int tkb; const long kr = chunk_row(i + 1, skey, tkb);
        const act_t* kp = p.P + kr * PW + E_AK + kv * 64 + spart * 16;
        const act_t* vp = p.P + kr * PW + E_AV + kv * 64 + spart * 16;
        rk0 = *reinterpret_cast<const uint4*>(kp); rk1 = *reinterpret_cast<const uint4*>(kp + 8);
        rv0 = *reinterpret_cast<const uint4*>(vp); rv1 = *reinterpret_cast<const uint4*>(vp + 8);
      }
      const bool edge = i >= 4 && (tkb_cur == t0 - 128 || tkb_cur == t0 + 128);
#pragma unroll
      for (int kb = 0; kb < 2; ++kb) {
        f32x4 sc[2][2];
#pragma unroll
        for (int k2 = 0; k2 < 2; ++k2) {
          const int kt = kb * 2 + k2;
          const bf16x8 kf0 = *reinterpret_cast<const bf16x8*>(SK + (kt * 16 + fr) * 72 + g * 8);
          const bf16x8 kf1 = *reinterpret_cast<const bf16x8*>(SK + (kt * 16 + fr) * 72 + 32 + g * 8);
#pragma unroll
          for (int qt = 0; qt < 2; ++qt) {
            f32x4 z = f32x4{0.f, 0.f, 0.f, 0.f};
            z = __builtin_amdgcn_mfma_f32_16x16x32_bf16(kf0, qf[qt][0], z, 0, 0, 0);
            sc[qt][k2] = __builtin_amdgcn_mfma_f32_16x16x32_bf16(kf1, qf[qt][1], z, 0, 0, 0);
          }
        }
        bf16x8 pf[2];
#pragma unroll
        for (int qt = 0; qt < 2; ++qt) {
          float mx = -1e30f;
#pragma unroll
          for (int k2 = 0; k2 < 2; ++k2)
#pragma unroll
            for (int j = 0; j < 4; ++j) {
              float v = sc[qt][k2][j] * SCL;
              if (edge) {
                const int tk = tkb_cur + (kb * 2 + k2) * 16 + 4 * g + j;
                const int tq = tw + qt * 16 + fr;
                const int df = tq - tk;
                if (df > 128 || df < -128) v = -1e30f;
              }
              sc[qt][k2][j] = v;
              mx = fmaxf(mx, v);
            }
          mx = xor16_max(mx);
          mx = xor32_max(mx);
          const float mnew = fmaxf(mrun[qt], mx);
          if (__any(mnew > mrun[qt])) {
            const float alpha = __builtin_amdgcn_exp2f(mrun[qt] - mnew);
            lrun[qt] *= alpha;
#pragma unroll
            for (int dt = 0; dt < 4; ++dt) o[qt][dt] = o[qt][dt] * alpha;
            mrun[qt] = mnew;
          }
          float ls = 0.f;
          float pv[8];
#pragma unroll
          for (int k2 = 0; k2 < 2; ++k2)
#pragma unroll
            for (int j = 0; j < 4; ++j) {
              const float pe = __builtin_amdgcn_exp2f(sc[qt][k2][j] - mnew);
              pv[k2 * 4 + j] = pe;
              ls += pe;
            }
          lrun[qt] += ls;
          union { unsigned u[4]; bf16x8 v; } cv;
          cv.u[0] = pack2_mfma(pv[0], pv[1]); cv.u[1] = pack2_mfma(pv[2], pv[3]);
          cv.u[2] = pack2_mfma(pv[4], pv[5]); cv.u[3] = pack2_mfma(pv[6], pv[7]);
          pf[qt] = cv.v;
        }
#pragma unroll
        for (int dt = 0; dt < 4; ++dt) {
          union { uint2 h2[2]; bf16x8 v; } vf;
          vf.h2[0] = *reinterpret_cast<const uint2*>(SV + (dt * 16 + fr) * 72 + kb * 32 + 4 * g);
          vf.h2[1] = *reinterpret_cast<const uint2*>(SV + (dt * 16 + fr) * 72 + kb * 32 + 16 + 4 * g);
#pragma unroll
          for (int qt = 0; qt < 2; ++qt) o[qt][dt] = __builtin_amdgcn_mfma_f32_16x16x32_bf16(vf.v, pf[qt], o[qt][dt], 0, 0, 0);
        }
      }
    }
#pragma unroll
    for (int qt = 0; qt < 2; ++qt) {
      float lt = lrun[qt];
      lt = xor16_add(lt);
      lt = xor32_add(lt);
      const float il = 1.0f / lt;
      fp8_t* orow = p.O8 + (qrow0 + qt * 16 + fr) * D + h * 64 + 4 * g;
      const float ils = il * SO8;
#pragma unroll
      for (int dt = 0; dt < 4; ++dt)
        *reinterpret_cast<unsigned*>(orow + dt * 16) = pack4_fp8(o[qt][dt][0] * ils, o[qt][dt][1] * ils, o[qt][dt][2] * ils, o[qt][dt][3] * ils);
    }
  }
}


template <int MODE>
__device__ __forceinline__ void phase_combine(const Params& p) {
  constexpr int DV = MODE == 0 ? 128 : 192, EPL = DV / 16, NV = EPL / 4;
  const int lane = tidx() & 63;
  const long row_lo = MODE == 0 ? 0 : NC;
  const int nw = (int)gridDim.x * 4, wi = (((int)gridDim.x & 63) ? (int)blockIdx.x : ((int)blockIdx.x >> 6) * 64 + ((int)blockIdx.x & 7) * 8 + (((int)blockIdx.x >> 3) & 7)) * 4 + (int)(tidx() >> 6);
  const int rpw = (int)(NR - row_lo + nw - 1) / nw;
  const long r0 = row_lo + (long)wi * rpw, r1 = min((long)NR, r0 + rpw);
  float gn[EPL];
#pragma unroll
  for (int e = 0; e < EPL; ++e) gn[e] = (MODE == 0 ? p.hgrn_norm : p.gla_norm)[lane * EPL + e];
  uint2 fa[NV], fb[NV], fg[NV];
  auto load_row = [&](long row) {
    const uint2* f = reinterpret_cast<const uint2*>(p.OF + row * 768 + lane * EPL);
    const uint2* bk = reinterpret_cast<const uint2*>(p.OB + row * 768 + lane * EPL);
    const uint2* gt = reinterpret_cast<const uint2*>(p.P + row * PW + (MODE == 0 ? E_HG : O_G) + lane * EPL);
#pragma unroll
    for (int v = 0; v < NV; ++v) { fa[v] = f[v]; fb[v] = bk[v]; fg[v] = gt[v]; }
  };
  if (r0 < r1) load_row(r0);
  for (long row = r0; row < r1; ++row) {
    float o[EPL], gg[EPL];
#pragma unroll
    for (int v = 0; v < NV; ++v) {
      o[4 * v + 0] = bf_lo(fa[v].x) + bf_lo(fb[v].x); o[4 * v + 1] = bf_hi(fa[v].x) + bf_hi(fb[v].x);
      o[4 * v + 2] = bf_lo(fa[v].y) + bf_lo(fb[v].y); o[4 * v + 3] = bf_hi(fa[v].y) + bf_hi(fb[v].y);
      gg[4 * v + 0] = bf_lo(fg[v].x); gg[4 * v + 1] = bf_hi(fg[v].x); gg[4 * v + 2] = bf_lo(fg[v].y); gg[4 * v + 3] = bf_hi(fg[v].y);
    }
    load_row(min(row + 1, r1 - 1));
    float ss = 0.f;
#pragma unroll
    for (int e = 0; e < EPL; ++e) ss += o[e] * o[e];
    ss = row_sum16(ss);
    const float r = 1.0f / sqrtf(ss * (1.0f / DV) + LN_EPS);
    unsigned* dst = reinterpret_cast<unsigned*>(p.O8 + row * D + (MODE == 0 ? 512 : 0) + lane * EPL);
#pragma unroll
    for (int v = 0; v < NV; ++v) {
      float y[4];
#pragma unroll
      for (int q = 0; q < 4; ++q) {
        const float g = gg[4 * v + q];
        y[q] = o[4 * v + q] * (r * SO8) * gn[4 * v + q] * (g * __builtin_amdgcn_rcpf(1.0f + __expf(-g)));
      }
      dst[v] = pack4_fp8(y[0], y[1], y[2], y[3]);
    }
  }
}

constexpr int MOD_ITEMS = 2 * 2 * (6 * D / 64);
__device__ __forceinline__ void mod_item(const Params& p, int item, unsigned char* smem) {
  float* sc = (float*)smem;
  float* red = sc + 9 * 512;
  const int tid = tidx(), w = tid >> 6, lane = tid & 63;
  const int kh = item & 1, cgi = item >> 1;
  const int l = cgi / (6 * D / 64), j = (cgi % (6 * D / 64)) * 64 + lane;
  const float* wp = p.w_ada + (long)l * D * 6 * D + (long)(kh * 512 + w * 128) * 6 * D + j;
  float wv[32];
#pragma unroll
  for (int q = 0; q < 32; ++q) wv[q] = wp[(long)q * 6 * D];
#pragma unroll 6
  for (int i = tid; i < 9 * 512; i += 256) {
    const int bb = i >> 9, k = kh * 512 + (i & 511);
    const float v = bb < NB ? p.c[bb * D + k] : p.c_ctx[k];
    sc[i] = v * __builtin_amdgcn_rcpf(1.0f + __expf(-v));
  }
  float a[NB + 1];
#pragma unroll
  for (int bb = 0; bb <= NB; ++bb) a[bb] = 0.f;
  __syncthreads();
#pragma unroll 1
  for (int kb = 0; kb < 128; kb += 32) {
    float wc[32];
#pragma unroll
    for (int q = 0; q < 32; ++q) wc[q] = wv[q];
    const int kn = min(kb + 32, 96);
#pragma unroll
    for (int q = 0; q < 32; ++q) wv[q] = wp[(long)(kn + q) * 6 * D];
#pragma unroll
    for (int q4 = 0; q4 < 8; ++q4)
#pragma unroll
      for (int bb = 0; bb <= NB; ++bb) {
        const float4 s4 = *reinterpret_cast<const float4*>(sc + bb * 512 + w * 128 + kb + 4 * q4);
        a[bb] += s4.x * wc[4 * q4] + s4.y * wc[4 * q4 + 1] + s4.z * wc[4 * q4 + 2] + s4.w * wc[4 * q4 + 3];
      }
  }
#pragma unroll
  for (int q = 0; q < 32; ++q) asm volatile("" :: "v"(wv[q]));
#pragma unroll
  for (int bb = 0; bb <= NB; ++bb) red[(w * 9 + bb) * 64 + lane] = a[bb];
  __syncthreads();
  for (int i = tid; i < 9 * 64; i += 256) {
    const int bb = i >> 6, jj = i & 63;
    const int col = (cgi % (6 * D / 64)) * 64 + jj;
    const float sum = ((red[(0 * 9 + bb) * 64 + jj] + red[(1 * 9 + bb) * 64 + jj]) + (red[(2 * 9 + bb) * 64 + jj] + red[(3 * 9 + bb) * 64 + jj]));
    atomicAdd(g_mod + ((long)l * (NB + 1) + bb) * 6 * D + col, kh == 0 ? sum + p.b_ada[l * 6 * D + col] : sum);
  }
  __syncthreads();
}

__device__ __forceinline__ void phase_gla_decay(const Params& p) {
  const int t = tidx();
  if (t >= 192) return;
  const int dir = t / 96, cg = t % 96;
  float gw[16][4], gb[4];
#pragma unroll
  for (int r = 0; r < 16; ++r) {
    const float4 v = *reinterpret_cast<const float4*>(p.gla_gate_w + ((long)dir * 16 + r) * 384 + cg * 4);
    gw[r][0] = v.x; gw[r][1] = v.y; gw[r][2] = v.z; gw[r][3] = v.w;
  }
  {
    const float4 v = *reinterpret_cast<const float4*>(p.gla_gate_b + dir * 384 + cg * 4);
    gb[0] = v.x; gb[1] = v.y; gb[2] = v.z; gb[3] = v.w;
  }
  const int rpb = ((NR + (int)gridDim.x - 1) / (int)gridDim.x + 3) / 4 * 4;
  const long b0 = (long)blockIdx.x * rpb, b1 = min((long)NR, b0 + rpb);
  uint4 ra[4], rb[4];
  auto load4 = [&](long row0) {
#pragma unroll
    for (int q = 0; q < 4; ++q) {
      const uint4* rp = reinterpret_cast<const uint4*>(p.P + min(row0 + q, b1 - 1) * PW + O_RF + dir * 16);
      ra[q] = rp[0]; rb[q] = rp[1];
    }
  };
  if (b0 < b1) load4(b0);
  for (long row0 = b0; row0 < b1; row0 += 4) {
    unsigned rw[4][8];
#pragma unroll
    for (int q = 0; q < 4; ++q) {
      rw[q][0] = ra[q].x; rw[q][1] = ra[q].y; rw[q][2] = ra[q].z; rw[q][3] = ra[q].w;
      rw[q][4] = rb[q].x; rw[q][5] = rb[q].y; rw[q][6] = rb[q].z; rw[q][7] = rb[q].w;
    }
    load4(min(row0 + 4, b1 - 1));
#pragma unroll
    for (int q = 0; q < 4; ++q) {
      float z[4] = {gb[0], gb[1], gb[2], gb[3]};
#pragma unroll
      for (int r2 = 0; r2 < 8; ++r2) {
        const float x0 = bf_lo(rw[q][r2]), x1 = bf_hi(rw[q][r2]);
#pragma unroll
        for (int c = 0; c < 4; ++c) z[c] += x0 * gw[2 * r2][c] + x1 * gw[2 * r2 + 1][c];
      }
      float o[4];
#pragma unroll
      for (int c = 0; c < 4; ++c) o[c] = 1.0f - __expf((fminf(z[c], 0.f) - __logf(1.0f + __expf(-fabsf(z[c])))) * (1.0f / 16.0f));
      if (row0 + q < b1)
        *reinterpret_cast<uint2*>(p.LF + ((long)dir * NR + row0 + q) * 384 + cg * 4) = make_uint2(pack2(o[0], o[1]), pack2(o[2], o[3]));
    }
  }
}

__device__ __forceinline__ void phase_hgrn_gate(const Params& p, long gtid, long gstride) {
  for (long i = gtid; i < (long)NR * 1024; i += gstride) {
    const int col = (int)(i & 1023);
    const long row = i >> 10;
    act_t* z = p.P + row * PW + E_FF + col;
    const float lb = p.lbt[col];
    const float f = lb + (1.0f - lb) * sigmoidf_(ldA(z));
    stA(z, __logf(f));
  }
}

#define RCPF(x) __builtin_amdgcn_rcpf(x)
template <int MODE>
__device__ __forceinline__ void phase_scan(const Params& p, unsigned char* smem, int blk, int nblk) {
  constexpr int DK = MODE == 0 ? 128 : 96, DV = MODE == 0 ? 128 : 192, DVS = DV / 4, NET = DVS / 16, NKS = DK / 32,
                NDT = DK / 16;
  constexpr int QS = DK + 8, LS = 72, SS = DK + 8;
  act_t* Qa = (act_t*)smem;
  act_t* Ka = Qa + 64 * QS;
  act_t* KaT = Ka + 64 * QS;
  act_t* VT = KaT + DK * LS;
  act_t* ST = VT + DVS * LS;
  float* tot = (float*)(ST + DVS * SS);
  float* lf32 = tot + 2 * 4 * DK;
  const int tid = tidx(), w = __builtin_amdgcn_readfirstlane(tidx() >> 6), lane = tid & 63, fr = lane & 15, g = lane >> 4;
  const int dp = lane, c0 = 2 * dp;
  const bool cact = dp < DK / 2;
  constexpr int NCH = (C + T) / 64, NCC = C / 64;
  constexpr int NVI = DVS / 8 * 64;
  const int item0 = (nblk & 63) ? blk : (blk >> 6) * 64 + (blk & 7) * 8 + ((blk >> 3) & 7);
  for (int item = item0; item < NB * 4 * 2 * 4; item += nblk) {
    const int sl = item & 3, dir = (item >> 2) & 1, h = (item >> 3) & 3, b = item >> 5;
    act_t* OD = dir == 0 ? p.OF : p.OB;
    const unsigned loff = (unsigned)min(c0, DK - 2) * 2u;
    const int vcol = (MODE == 0 ? E_HI + h * 128 : O_V + h * 192) + sl * DVS;
    const int ocol = h * DV + sl * DVS;
    auto chunk_base = [&](int n) -> long {
      if (n < NCC) return (long)b * C + (dir ? NCC - 1 - n : n) * 64;
      const int ln = n - NCC;
      return (long)NC + (long)b * T + (dir ? T / 64 - 1 - ln : ln) * 64;
    };
    auto lrow = [&](long base, int l) -> long { return base + (dir ? 63 - l : l); };
    f32x4 S[NET][2];
#pragma unroll
    for (int et = 0; et < NET; ++et) { S[et][0] = f32x4{0.f, 0.f, 0.f, 0.f}; S[et][1] = f32x4{0.f, 0.f, 0.f, 0.f}; }
    unsigned rlf[16], rq[16], rk[16];
    uint4 rv[2];
    const long rstep = dir ? -(long)PW * 2 : (long)PW * 2;
    const long lstep = dir ? -(long)384 * 2 : (long)384 * 2;
    const int ub_lf = (MODE == 0 ? (E_FF + dir * 512 + h * 128) * 2 : 0);
    const int ub_q = (MODE == 0 ? E_HQ + h * 128 : O_Q + h * 96) * 2;
    const int ub_k = (O_K + h * 96) * 2;
    unsigned voff[(NVI + 255) / 256];
#pragma unroll
    for (int r = 0; r < (NVI + 255) / 256; ++r) {
      const int it = min(tid + r * 256, NVI - 1);
      const int l = it / (DVS / 8), e8 = (it % (DVS / 8)) * 8;
      voff[r] = (unsigned)((dir ? 63 - l : l) * PW + e8) * 2u;
    }
    auto issue_loads = [&](int n) {
      const long base = chunk_base(n);
      unsigned lo = loff;
      asm volatile("" : "+v"(lo));
      {
        const char* prow = (const char*)(p.P + lrow(base, w * 16) * PW);
        const char* plf = (const char*)(p.LF + ((long)dir * NR + lrow(base, w * 16)) * 384 + h * 96);
#pragma unroll
        for (int i = 0; i < 16; ++i) {
          if (MODE == 0) {
            rlf[i] = *reinterpret_cast<const unsigned*>(prow + ub_lf + lo);
          } else {
            rlf[i] = *reinterpret_cast<const unsigned*>(plf + lo);
            rk[i] = *reinterpret_cast<const unsigned*>(prow + ub_k + lo);
            plf += lstep;
          }
          rq[i] = *reinterpret_cast<const unsigned*>(prow + ub_q + lo);
          prow += rstep;
        }
      }
      const char* vbase = (const char*)(p.P + base * PW + vcol);
#pragma unroll
      for (int r = 0; r < (NVI + 255) / 256; ++r) {
        unsigned vo = voff[r];
        asm volatile("" : "+v"(vo));
        rv[r] = *reinterpret_cast<const uint4*>(vbase + vo);
      }
    };
    issue_loads(0);
    for (int n = 0; n < NCH; ++n) {
      const int par = n & 1;
      float* totp = tot + par * 4 * DK;
      float* lfp = lf32 + par * DK;
      const long base = chunk_base(n);
      if (cact) {
        float r0 = 1.f, r1 = 1.f;
#pragma unroll
        for (int i = 0; i < 16; ++i) { r0 *= 1.0f - bf_lo(rlf[i]); r1 *= 1.0f - bf_hi(rlf[i]); }
        totp[w * DK + c0] = r0; totp[w * DK + c0 + 1] = r1;
        if (w == 2) { lfp[c0] = 1.0f - bf_lo(rlf[0]); lfp[c0 + 1] = 1.0f - bf_hi(rlf[0]); }
      }
      __syncthreads();
#pragma unroll
      for (int r = 0; r < (NVI + 255) / 256; ++r) {
        const int it = tid + r * 256;
        if (it < NVI) {
          const int l = it / (DVS / 8), e8 = (it % (DVS / 8)) * 8;
          const unsigned vw[4] = {rv[r].x, rv[r].y, rv[r].z, rv[r].w};
#pragma unroll
          for (int e = 0; e < 4; ++e) {
            VT[(e8 + 2 * e) * LS + l] = (act_t)(vw[e] & 0xffffu);
            VT[(e8 + 2 * e + 1) * LS + l] = (act_t)(vw[e] >> 16);
          }
        }
      }
      if (cact) {
        float of0 = 1.f, of1 = 1.f;
#pragma unroll
        for (int sgi = 0; sgi < 3; ++sgi)
          if (sgi < w) { of0 *= totp[sgi * DK + c0]; of1 *= totp[sgi * DK + c0 + 1]; }
        const float ref0 = totp[c0] * totp[DK + c0] * lfp[c0];
        const float ref1 = totp[c0 + 1] * totp[DK + c0 + 1] * lfp[c0 + 1];
        unsigned kt0[8], kt1[8];
        float e0 = of0 * RCPF(ref0), e1 = of1 * RCPF(ref1);
        float f0 = RCPF(e0), f1 = RCPF(e1);
#pragma unroll
        for (int i = 0; i < 16; i += 2) {
          float ka0[2], ka1[2];
#pragma unroll
          for (int ii = 0; ii < 2; ++ii) {
            const int i2 = i + ii;
            const float kk0 = bf_lo(rlf[i2]), kk1 = bf_hi(rlf[i2]);
            const float g0 = 1.0f - kk0, g1 = 1.0f - kk1;
            e0 *= g0; e1 *= g1; f0 *= RCPF(g0); f1 *= RCPF(g1);
            float k0, k1;
            if (MODE == 0) { k0 = kk0; k1 = kk1; }
            else { k0 = bf_lo(rk[i2]); k1 = bf_hi(rk[i2]); }
            ka0[ii] = k0 * f0; ka1[ii] = k1 * f1;
            const int l = w * 16 + i2;
            *reinterpret_cast<unsigned*>(Qa + l * QS + c0) = pack2(bf_lo(rq[i2]) * e0, bf_hi(rq[i2]) * e1);
            *reinterpret_cast<unsigned*>(Ka + l * QS + c0) = pack2(ka0[ii], ka1[ii]);
          }
          kt0[i >> 1] = pack2(ka0[0], ka0[1]);
          kt1[i >> 1] = pack2(ka1[0], ka1[1]);
        }
        uint4* d0 = reinterpret_cast<uint4*>(KaT + c0 * LS + w * 16);
        d0[0] = make_uint4(kt0[0], kt0[1], kt0[2], kt0[3]); d0[1] = make_uint4(kt0[4], kt0[5], kt0[6], kt0[7]);
        uint4* d1 = reinterpret_cast<uint4*>(KaT + (c0 + 1) * LS + w * 16);
        d1[0] = make_uint4(kt1[0], kt1[1], kt1[2], kt1[3]); d1[1] = make_uint4(kt1[4], kt1[5], kt1[6], kt1[7]);
      }
      issue_loads(min(n + 1, NCH - 1));
      float egv[2], egrv[2];
#pragma unroll
      for (int di = 0; di < 2; ++di) {
        const int dt = w + 4 * di;
        if (dt < NDT) {
          const int d = dt * 16 + fr;
          const float er = totp[d] * totp[DK + d] * lfp[d];
          egv[di] = (totp[d] * totp[DK + d]) * (totp[2 * DK + d] * totp[3 * DK + d]);
          egrv[di] = egv[di] * RCPF(er);
#pragma unroll
          for (int et = 0; et < NET; ++et)
#pragma unroll
            for (int j = 0; j < 4; j += 2) {
              const unsigned pk = pack2(S[et][di][j] * er, S[et][di][j + 1] * er);
              ST[(et * 16 + 4 * g + j) * SS + d] = (act_t)(pk & 0xffffu);
              ST[(et * 16 + 4 * g + j + 1) * SS + d] = (act_t)(pk >> 16);
            }
        }
      }
      __syncthreads();
      if (MODE == 0 || n >= NCC) {
      bf16x8 qfr[NKS];
#pragma unroll
      for (int ks = 0; ks < NKS; ++ks) qfr[ks] = *reinterpret_cast<const bf16x8*>(Qa + (w * 16 + fr) * QS + ks * 32 + g * 8);
      bf16x8 pfr[2];
#pragma unroll
      for (int kb = 0; kb < 2; ++kb) {
        f32x4 at2[2];
#pragma unroll
        for (int h2 = 0; h2 < 2; ++h2) {
          const int mt = 2 * kb + h2;
          at2[h2] = f32x4{0.f, 0.f, 0.f, 0.f};
          if (mt <= w) {
#pragma unroll
            for (int ks = 0; ks < NKS; ++ks) {
              const bf16x8 kaf = *reinterpret_cast<const bf16x8*>(Ka + (mt * 16 + fr) * QS + ks * 32 + g * 8);
              at2[h2] = __builtin_amdgcn_mfma_f32_16x16x32_bf16(kaf, qfr[ks], at2[h2], 0, 0, 0);
            }
            if (mt == w) {
#pragma unroll
              for (int j = 0; j < 4; ++j)
                if (4 * g + j > fr) at2[h2][j] = 0.f;
            }
          }
        }
        union { unsigned u[4]; bf16x8 v; } cv;
        cv.u[0] = pack2_mfma(at2[0][0], at2[0][1]); cv.u[1] = pack2_mfma(at2[0][2], at2[0][3]);
        cv.u[2] = pack2_mfma(at2[1][0], at2[1][1]); cv.u[3] = pack2_mfma(at2[1][2], at2[1][3]);
        pfr[kb] = cv.v;
      }
      const long orow = lrow(base, w * 16 + fr);
#pragma unroll
      for (int et = 0; et < NET; ++et) {
        f32x4 o = f32x4{0.f, 0.f, 0.f, 0.f};
#pragma unroll
        for (int kb = 0; kb < 2; ++kb) {
          if (2 * kb <= w) {
            union { uint2 h2[2]; bf16x8 v; } vf;
            vf.h2[0] = *reinterpret_cast<const uint2*>(VT + (et * 16 + fr) * LS + kb * 32 + 4 * g);
            vf.h2[1] = *reinterpret_cast<const uint2*>(VT + (et * 16 + fr) * LS + kb * 32 + 16 + 4 * g);
            o = __builtin_amdgcn_mfma_f32_16x16x32_bf16(vf.v, pfr[kb], o, 0, 0, 0);
          }
        }
#pragma unroll
        for (int ks = 0; ks < NKS; ++ks) {
          const bf16x8 sf = *reinterpret_cast<const bf16x8*>(ST + (et * 16 + fr) * SS + ks * 32 + g * 8);
          o = __builtin_amdgcn_mfma_f32_16x16x32_bf16(sf, qfr[ks], o, 0, 0, 0);
        }
        const float osc = MODE == 0 ? 1.0f : 0.10206207261596575f;
        *reinterpret_cast<uint2*>(OD + orow * 768 + ocol + et * 16 + 4 * g) =
            make_uint2(pack2(o[0] * osc, o[1] * osc), pack2(o[2] * osc, o[3] * osc));
      }
      }
#pragma unroll
      for (int di = 0; di < 2; ++di) {
        const int dt = w + 4 * di;
        if (dt < NDT) {
#pragma unroll
          for (int et = 0; et < NET; ++et) {
            f32x4 r = f32x4{0.f, 0.f, 0.f, 0.f};
#pragma unroll
            for (int k2 = 0; k2 < 2; ++k2) {
              const bf16x8 vf = *reinterpret_cast<const bf16x8*>(VT + (et * 16 + fr) * LS + k2 * 32 + g * 8);
              const bf16x8 kf = *reinterpret_cast<const bf16x8*>(KaT + (dt * 16 + fr) * LS + k2 * 32 + g * 8);
              r = __builtin_amdgcn_mfma_f32_16x16x32_bf16(vf, kf, r, 0, 0, 0);
            }
#pragma unroll
            for (int j = 0; j < 4; ++j) S[et][di][j] = egv[di] * S[et][di][j] + egrv[di] * r[j];
          }
        }
      }
    }
    __syncthreads();
  }
}

struct GemmJob {
  const act_t* A; const act_t* Bt; act_t* C;
  long sA, sB, sC;
  int nbatch, Mtiles, Ntiles, K, ldc, Nvalid, mode;
  float scale;
  int fp8;
  int out8;
};
__device__ __forceinline__ void phase_gemm(const Params& p, const GemmJob& g, unsigned char* smem, int blk = blockIdx.x, int nblk = gridDim.x) {
  const int per_b = g.Mtiles * g.Ntiles;
  const int ntiles = per_b * g.nbatch;
  auto tvalid = [&](int t) -> bool {
    const int tt = t % per_b;
    const int tm = tt / g.Ntiles, tn = tt % g.Ntiles;
    return !(g.mode == 1 && tm < NC / 128 &&
             (tn * 128 >= O_FA || (tn + 1) * 128 <= O_K || (tn * 128 >= O_G && tn * 128 < O_FA && (tn + 1) * 128 > O_RF + 128)));
  };
  auto tnext = [&](int t) -> int { t += nblk; while (t < ntiles && !tvalid(t)) t += nblk; return t; };
  int par = 0;
  bool primed = false;
  int tile0 = (nblk & 63) ? blk : (blk >> 6) * 64 + (blk & 7) * 8 + ((blk >> 3) & 7);
  if (tile0 < ntiles && !tvalid(tile0)) tile0 = tnext(tile0);
  for (int tile = tile0; tile < ntiles;) {
    const int ntile = tnext(tile);
    const int b = tile / per_b, tt = tile % per_b;
    const int tm = tt / g.Ntiles, tn = tt % g.Ntiles;
    const int tt2 = (ntile < ntiles ? ntile : tile) % per_b;
    const int tm2 = tt2 / g.Ntiles, tn2 = tt2 % g.Ntiles;
    const int K = g.K, ldc = g.ldc;
    const act_t* Ab = g.A + b * g.sA + (long)tm * 128 * K;
    act_t* Cb = g.C + b * g.sC + (long)tm * 128 * ldc + tn * 128;
    const int nlim = g.Nvalid - tn * 128;
    const float scale = g.scale;
    const int mode = g.mode;
    if (mode == 1) {
      auto epi1 = [&](f32x4 (&acc)[4][4], int wr, int wc, int fr, int fq) {
                  if (g.fp8) {
#pragma unroll
                    for (int m = 0; m < 4; ++m)
#pragma unroll
                      for (int n = 0; n < 4; ++n) acc[m][n] = acc[m][n] * scale;
                  }
#pragma unroll
                  for (int m = 0; m < 4; ++m)
#pragma unroll
                    for (int n = 0; n < 4; ++n) {
                      const int col = wc * 64 + n * 16 + fr;
                      if (col < nlim) {
#pragma unroll
                        for (int j = 0; j < 4; ++j) {
                          const int row = wr * 64 + m * 16 + fq * 4 + j;
                          stA(Cb + (long)row * ldc + col, acc[m][n][j]);
                        }
                      } else {
                        const int gc = tn * 128 + col;
                        if (gc < O_END && tm >= NC / 128) {
                          const int lr = (tm - NC / 128) * 128 + wr * 64 + m * 16 + fq * 4;
                          const int bb = lr / T, t = lr % T;
                          const int cq = gc < O_FB ? gc - O_FA : gc - O_FB;
                          act_t* dst = p.FT + ((long)bb * 256 + cq) * (2 * T) + (gc < O_FB ? 0 : T) + t;
                          *reinterpret_cast<uint2*>(dst) = make_uint2(pack2(acc[m][n][0], acc[m][n][1]), pack2(acc[m][n][2], acc[m][n][3]));
                        }
                      }
                    }
                };
      if (g.fp8) {
        const fp8_t* A8 = (const fp8_t*)g.A + (long)tm * 128 * K;
        gemm_tile8p<false>(A8, (const fp8_t*)g.Bt + (long)tn * 128 * K, ntile < ntiles, (const fp8_t*)g.A + (long)tm2 * 128 * K,
                           (const fp8_t*)g.Bt + (long)tn2 * 128 * K, par, primed, K, smem, epi1);
      } else {
        gemm_tile<false>([&](int r) { return Ab + (long)r * K; }, g.Bt + b * g.sB + (long)tn * 128 * K, K, smem, epi1);
      }
    } else {
      auto epi2 = [&](f32x4 (&acc)[4][4], int wr, int wc, int fr, int fq) {
                  const float oscale = g.fp8 ? 1.0f : scale;
                  if (g.fp8) {
#pragma unroll
                    for (int m = 0; m < 4; ++m)
#pragma unroll
                      for (int n = 0; n < 4; ++n) acc[m][n] = acc[m][n] * scale;
                  }
                  if (mode == 2) {
                    const int cb = tn * 128 + wc * 64;
                    if (cb < E_AV && tm >= NC / 128) {
                      const float4* rt = reinterpret_cast<const float4*>(p.ropetab);
#pragma unroll
                      for (int m = 0; m < 4; ++m) {
                        const int t = ((tm - NC / 128) * 128 + wr * 64 + m * 16 + fr) % T;
                        const float4 r01 = rt[(t / GRID_W) * 8 + fq * 2], r23 = rt[(t / GRID_W) * 8 + fq * 2 + 1];
                        const float4 c01 = rt[(t % GRID_W) * 8 + fq * 2], c23 = rt[(t % GRID_W) * 8 + fq * 2 + 1];
                        const float rc[4] = {r01.x, r01.z, r23.x, r23.z}, rs_[4] = {r01.y, r01.w, r23.y, r23.w};
                        const float cc[4] = {c01.x, c01.z, c23.x, c23.z}, cs_[4] = {c01.y, c01.w, c23.y, c23.w};
#pragma unroll
                        for (int j = 0; j < 4; ++j) {
                          const float a1 = acc[m][0][j], a2 = acc[m][1][j], b1 = acc[m][2][j], b2 = acc[m][3][j];
                          acc[m][0][j] = a1 * rc[j] - a2 * rs_[j]; acc[m][1][j] = a1 * rs_[j] + a2 * rc[j];
                          acc[m][2][j] = b1 * cc[j] - b2 * cs_[j]; acc[m][3][j] = b1 * cs_[j] + b2 * cc[j];
                        }
                      }
                    } else if (cb >= E_FF && cb < E_HQ) {
#pragma unroll
                      for (int n = 0; n < 4; ++n) {
                        const float4 lb4 = *reinterpret_cast<const float4*>(p.lbt + cb - E_FF + n * 16 + fq * 4);
                        const float lb[4] = {lb4.x, lb4.y, lb4.z, lb4.w};
#pragma unroll
                        for (int m = 0; m < 4; ++m)
#pragma unroll
                          for (int j = 0; j < 4; ++j)
                            acc[m][n][j] = (1.0f - lb[j]) * __builtin_amdgcn_rcpf(1.0f + __expf(acc[m][n][j]));
                      }
                    }
                  }
                  if (!g.out8 && nlim >= 128) {
#pragma unroll
                    for (int m = 0; m < 4; ++m) {
                      const int row = wr * 64 + m * 16 + fr;
#pragma unroll
                      for (int n = 0; n < 4; n += 2) {
                        const uint2 a = make_uint2(pack2(acc[m][n][0] * oscale, acc[m][n][1] * oscale), pack2(acc[m][n][2] * oscale, acc[m][n][3] * oscale));
                        const uint2 b = make_uint2(pack2(acc[m][n + 1][0] * oscale, acc[m][n + 1][1] * oscale), pack2(acc[m][n + 1][2] * oscale, acc[m][n + 1][3] * oscale));
                        const int col = wc * 64 + (n + (fq & 1)) * 16 + (fq >> 1) * 8;
                        *reinterpret_cast<uint4*>(Cb + (long)row * ldc + col) = widen_pair(a, b);
                      }
                    }
                  } else
#pragma unroll
                  for (int m = 0; m < 4; ++m) {
                    const int row = wr * 64 + m * 16 + fr;
#pragma unroll
                    for (int n = 0; n < 4; ++n) {
                      const int col = wc * 64 + n * 16 + fq * 4;
                      if (col < nlim) {
                        if (g.out8)
                          *reinterpret_cast<unsigned*>(reinterpret_cast<fp8_t*>(g.C) + b * g.sC + ((long)tm * 128 + row) * ldc + tn * 128 + col) =
                              pack4_fp8(acc[m][n][0] * oscale, acc[m][n][1] * oscale, acc[m][n][2] * oscale, acc[m][n][3] * oscale);
                        else
                          *reinterpret_cast<uint2*>(Cb + (long)row * ldc + col) =
                              make_uint2(pack2(acc[m][n][0] * oscale, acc[m][n][1] * oscale), pack2(acc[m][n][2] * oscale, acc[m][n][3] * oscale));
                      }
                    }
                  }
                };
      if (g.fp8) {
        const fp8_t* A8 = (const fp8_t*)g.A + (long)tm * 128 * K;
        gemm_tile8p<true>(A8, (const fp8_t*)g.Bt + (long)tn * 128 * K, ntile < ntiles, (const fp8_t*)g.A + (long)tm2 * 128 * K,
                          (const fp8_t*)g.Bt + (long)tn2 * 128 * K, par, primed, K, smem, epi2);
      } else {
        gemm_tile<true>([&](int r) { return Ab + (long)r * K; }, g.Bt + b * g.sB + (long)tn * 128 * K, K, smem, epi2);
      }
    }
    tile = ntile;
  }
}

template <class RowMap>
__device__ __forceinline__ void conv_tile_rm(const float* src, int lds_, int Nvalid, int k0, int n0, act_t* dst, int ldd, float* tile, RowMap rm) {
  const int tid = tidx();
  {
    const int r = tid >> 5, c4 = (tid & 31) * 4;
    float4 v[8];
#pragma unroll
    for (int rr = 0; rr < 8; ++rr) {
      v[rr] = make_float4(0.f, 0.f, 0.f, 0.f);
      if (n0 + c4 < Nvalid) v[rr] = *reinterpret_cast<const float4*>(src + (long)(k0 + r + rr * 8) * lds_ + n0 + c4);
    }
#pragma unroll
    for (int rr = 0; rr < 8; ++rr) {
      float* t = tile + (r + rr * 8) * 129 + c4;
      t[0] = v[rr].x; t[1] = v[rr].y; t[2] = v[rr].z; t[3] = v[rr].w;
    }
  }
  __syncthreads();
  {
    const int n = tid >> 1, ks = (tid & 1) * 32;
    if (n0 + n < Nvalid) {
      unsigned w[16];
#pragma unroll
      for (int i = 0; i < 16; ++i) w[i] = pack2(tile[(ks + 2 * i) * 129 + n], tile[(ks + 2 * i + 1) * 129 + n]);
      uint4* d = reinterpret_cast<uint4*>(dst + (long)rm(n) * ldd + k0 + ks);
      d[0] = make_uint4(w[0], w[1], w[2], w[3]);
      d[1] = make_uint4(w[4], w[5], w[6], w[7]);
      d[2] = make_uint4(w[8], w[9], w[10], w[11]);
      d[3] = make_uint4(w[12], w[13], w[14], w[15]);
    }
  }
  __syncthreads();
}

template <class RowMap>
__device__ __forceinline__ void conv_tile8_rm(const float* src, int lds_, int k0, int n0, fp8_t* dst, int ldd, float* tile, float scale, RowMap rm, int Nvalid = 1 << 30) {
  const int tid = tidx();
  {
    const int r = tid >> 5, c4 = (tid & 31) * 4;
    float4 v[8];
#pragma unroll
    for (int rr = 0; rr < 8; ++rr) {
      v[rr] = make_float4(0.f, 0.f, 0.f, 0.f);
      if (n0 + c4 < Nvalid) v[rr] = *reinterpret_cast<const float4*>(src + (long)(k0 + r + rr * 8) * lds_ + n0 + c4);
    }
#pragma unroll
    for (int rr = 0; rr < 8; ++rr) {
      float* t = tile + (r + rr * 8) * 129 + c4;
      t[0] = v[rr].x; t[1] = v[rr].y; t[2] = v[rr].z; t[3] = v[rr].w;
    }
  }
  __syncthreads();
  if ((tidx() >> 1) + n0 < Nvalid) {
    const int n = tid >> 1, ks = (tid & 1) * 32;
    unsigned w[8];
#pragma unroll
    for (int i = 0; i < 8; ++i)
      w[i] = pack4_fp8(tile[(ks + 4 * i) * 129 + n] * scale, tile[(ks + 4 * i + 1) * 129 + n] * scale,
                       tile[(ks + 4 * i + 2) * 129 + n] * scale, tile[(ks + 4 * i + 3) * 129 + n] * scale);
    uint4* d = reinterpret_cast<uint4*>(dst + (long)rm(n) * ldd + k0 + ks);
    d[0] = make_uint4(w[0], w[1], w[2], w[3]);
    d[1] = make_uint4(w[4], w[5], w[6], w[7]);
  }
  __syncthreads();
}

__device__ __forceinline__ void conv_tile(const float* src, int lds_, int Nvalid, int k0, int n0, act_t* dst, int ldd, float* tile) {
  conv_tile_rm(src, lds_, Nvalid, k0, n0, dst, ldd, tile, [=](int n) { return n0 + n; });
}

struct ConvJob { const float* src; fp8_t* dst; int lds, ldd, k0, n0, rbase, ra, rb; };
__device__ __forceinline__ void phase_convert_experts(const Params& p, int l, unsigned char* smem, int blk, int nblk) {
  float* tile = (float*)smem;
  const int per_e = 192, total = NEXP * per_e;
  fp8_t* Wup = l == 0 ? p.W8up : p.W8up1;
  fp8_t* Wdn = l == 0 ? p.W8down : p.W8down1;
  const int tid = tidx();
  auto mkjob = [&](int job) -> ConvJob {
    const int e = job / per_e, j = job % per_e;
    ConvJob c;
    if (j < 128) {
      const int up = j >> 6, jj = j & 63;
      const int kt = jj >> 2, fp = jj & 3;
      c.src = (up ? p.w_eu : p.w_eg) + ((long)(l * NEXP + e) * D) * DFF;
      c.dst = Wup + (long)e * 1024 * D; c.lds = DFF; c.ldd = D; c.k0 = kt * 64; c.n0 = fp * 128;
      c.rbase = fp * 256 + up * 32; c.ra = 128; c.rb = 64;
    } else {
      const int jj = j - 128;
      const int kt = jj >> 3, nt = jj & 7;
      c.src = p.w_ed + ((long)(l * NEXP + e) * DFF) * D;
      c.dst = Wdn + (long)e * 1024 * DFF; c.lds = D; c.ldd = DFF; c.k0 = kt * 64; c.n0 = nt * 128;
      c.rbase = nt * 128; c.ra = 64; c.rb = 32;
    }
    return c;
  };
  float4 v[8];
  auto ld = [&](const ConvJob& c) {
    const int r = tid >> 5, c4 = (tid & 31) * 4;
#pragma unroll
    for (int rr = 0; rr < 8; ++rr) v[rr] = *reinterpret_cast<const float4*>(c.src + (long)(c.k0 + r + rr * 8) * c.lds + c.n0 + c4);
  };
  int job = blk;
  if (job >= total) return;
  ConvJob cur = mkjob(job);
  ld(cur);
  while (job < total) {
    {
      const int r = tid >> 5, c4 = (tid & 31) * 4;
#pragma unroll
      for (int rr = 0; rr < 8; ++rr) {
        float* t = tile + (r + rr * 8) * 129 + c4;
        t[0] = v[rr].x; t[1] = v[rr].y; t[2] = v[rr].z; t[3] = v[rr].w;
      }
    }
    __syncthreads();
    const int nxt = job + nblk;
    const ConvJob nj = mkjob(min(nxt, total - 1));
    ld(nj);
    {
      const int n = tid >> 1, ks = (tid & 1) * 32;
      unsigned w[8];
#pragma unroll
      for (int i = 0; i < 8; ++i)
        w[i] = pack4_fp8(tile[(ks + 4 * i) * 129 + n] * SW8, tile[(ks + 4 * i + 1) * 129 + n] * SW8,
                         tile[(ks + 4 * i + 2) * 129 + n] * SW8, tile[(ks + 4 * i + 3) * 129 + n] * SW8);
      const int row = cur.rbase + (n >> 6) * cur.ra + ((n >> 5) & 1) * cur.rb + (n & 31);
      uint4* d = reinterpret_cast<uint4*>(cur.dst + (long)row * cur.ldd + cur.k0 + ks);
      d[0] = make_uint4(w[0], w[1], w[2], w[3]);
      d[1] = make_uint4(w[4], w[5], w[6], w[7]);
    }
    __syncthreads();
    cur = nj;
    job = nxt;
  }
}

__device__ __forceinline__ void phase_moe(const Params& p, int l, bool down, unsigned char* smem) {
  const int* cntp = p.cnt + l * NEXP * 64;
  int cn[NEXP];
  int total = 0;
#pragma unroll
  for (int e = 0; e < NEXP; ++e) { cn[e] = __builtin_amdgcn_readfirstlane(cntp[e * 64]); total += ((cn[e] + 127) >> 7) * 8; }
  auto decode = [&](int tile, int& e_, int& c_, int& lt_, int& ro_) {
    int tb = 0, ro = 0;
    bool found = false;
    e_ = NEXP - 1; c_ = cn[NEXP - 1]; lt_ = 0; ro_ = 0;
#pragma unroll
    for (int e = 0; e < NEXP; ++e) {
      const int nt = ((cn[e] + 127) >> 7) * 8;
      const bool hit = !found && (tile < tb + nt || e == NEXP - 1);
      if (hit) { e_ = e; c_ = cn[e]; lt_ = tile - tb; ro_ = ro; }
      found = found || hit;
      tb += nt; ro += cn[e];
    }
  };
  const int tid = tidx(), r0 = tid >> 3;
  const int wrow = (tid >> 7) * 64 + (tid & 15);
  int ls[4] = {0, 0, 0, 0};
  auto load_ls = [&](int tile, int (&dst)[4]) {
    int e, c, lt, ro;
    decode(min(tile, total - 1), e, c, lt, ro);
    const int mt = lt >> 3;
    const int rv = min(128, c - mt * 128);
    const int* lst = p.list + (long)(l * NEXP + e) * NR + mt * 128;
#pragma unroll
    for (int i = 0; i < 4; ++i) dst[i] = lst[min(r0 + 32 * i, rv - 1)];
  };
  const int bx = (int)blockIdx.x;
  const int tile0 = ((int)gridDim.x & 63) ? bx : (bx >> 6) * 64 + (bx & 7) * 8 + ((bx >> 3) & 7);
  if (!down && tile0 < total) load_ls(tile0, ls);
  for (int tile = tile0; tile < total; tile += gridDim.x) {
    int e, c, lt, rowoff;
    decode(tile, e, c, lt, rowoff);
    const int mt = lt >> 3, nt = lt & 7;
    const int rows_valid = min(128, c - mt * 128);
    const int* lst = p.list + (long)(l * NEXP + e) * NR + mt * 128;
    const long hrow0 = (long)rowoff + mt * 128;
    if (!down) {
      int lcur[4];
#pragma unroll
      for (int i = 0; i < 4; ++i) lcur[i] = ls[i];
      load_ls(tile + (int)gridDim.x, ls);
      gemm_tile8<true>([&](int r, int i) { return p.u8 + (long)(lcur[i] >> 1) * D; },
                (l == 0 ? p.W8up : p.W8up1) + ((long)e * 1024 + nt * 128) * D, D, smem,
                [&](f32x4 (&acc)[4][4], int wr, int wc, int fr, int fq) {
                  constexpr float dq = 1.0f / (SU8 * SW8);
#pragma unroll
                  for (int m = 0; m < 4; ++m) {
                    const int row = wr * 64 + m * 16 + fr;
                    if (row < rows_valid) {
#pragma unroll
                      for (int n = 0; n < 2; ++n) {
                        float hv[4];
#pragma unroll
                        for (int j = 0; j < 4; ++j) {
                          const float g = acc[m][n][j] * dq, uu = acc[m][n + 2][j] * dq;
                          hv[j] = g * __builtin_amdgcn_rcpf(1.0f + __expf(-g)) * uu * SH8;
                        }
                        *reinterpret_cast<unsigned*>(p.H8 + (hrow0 + row) * DFF + nt * 64 + wc * 32 + n * 16 + fq * 4) =
                            pack4_fp8(hv[0], hv[1], hv[2], hv[3]);
                      }
                    }
                  }
                });
    } else {
      const fp8_t* Ab = p.H8 + hrow0 * DFF;
      int tsv[4];
      float wv[4];
      {
        const float* lw = p.listw + (long)(l * NEXP + e) * NR + mt * 128;
#pragma unroll
        for (int m = 0; m < 4; ++m) {
          const int rr = min(wrow + m * 16, rows_valid - 1);
          tsv[m] = lst[rr]; wv[m] = lw[rr];
        }
      }
      gemm_tile8<true>([&](int r, int i) { return Ab + (long)r * DFF; }, (l == 0 ? p.W8down : p.W8down1) + ((long)e * 1024 + nt * 128) * DFF, DFF, smem,
                [&](f32x4 (&acc)[4][4], int wr, int wc, int fr, int fq) {
                  constexpr float dq = 1.0f / (SH8 * SW8);
#pragma unroll
                  for (int m = 0; m < 4; ++m) {
                    const int row = wr * 64 + m * 16 + fr;
                    const int ts = tsv[m];
                    const float w = wv[m] * dq;
#pragma unroll
                    for (int n = 0; n < 4; n += 2) {
                      const uint2 a = make_uint2(pack2(acc[m][n][0] * w, acc[m][n][1] * w), pack2(acc[m][n][2] * w, acc[m][n][3] * w));
                      const uint2 b = make_uint2(pack2(acc[m][n + 1][0] * w, acc[m][n + 1][1] * w), pack2(acc[m][n + 1][2] * w, acc[m][n + 1][3] * w));
                      const uint4 v = widen_pair(a, b);
                      if (row < rows_valid)
                        *reinterpret_cast<uint4*>(p.Y + (long)ts * D + nt * 128 + wc * 64 + (n + (fq & 1)) * 16 + (fq >> 1) * 8) = v;
                    }
                  }
                });
    }
  }
}

__device__ __forceinline__ void phase_convert_dense(const Params& p, unsigned char* smem) {
  float* tile = (float*)smem;
  const int J0 = 16 * 26, J1 = J0 + 128, J2 = J1 + 16 * 19, J3 = J2 + 128;
  const int nb = (int)gridDim.x, blk = (int)blockIdx.x;
  const bool modblk = blk < MOD_ITEMS && nb > MOD_ITEMS;
  if (nb <= MOD_ITEMS) { for (int it = blk; it < MOD_ITEMS; it += nb) mod_item(p, it, smem); }
  else if (modblk) mod_item(p, blk, smem);
  int job, jstep, jend = J3;
  if (nb <= MOD_ITEMS) { job = blk; jstep = nb; }
  else if (modblk) { job = blk; jstep = J3; }
  else { job = MOD_ITEMS + (blk - MOD_ITEMS); jstep = nb - MOD_ITEMS; }
  for (; job < jend; job += jstep) {
    if (job < J0) { int j = job; const int n0 = (j % 26) * 128; conv_tile8_rm(p.w_in_even, IN_EVEN, (j / 26) * 64, n0, p.W8in_even, D, tile, SW8, [=](int n) { return n0 + n; }); }
    else if (job < J1) { int j = job - J0; const int n0 = (j % 8) * 128; conv_tile8_rm(p.w_out_even, D, (j / 8) * 64, n0, p.W8out_even, D, tile, SW8, [=](int n) { return n0 + n; }); }
    else if (job < J2) { int j = job - J1; const int n0 = (j % 19) * 128; conv_tile8_rm(p.w_in_odd, IN_ODD, (j / 19) * 64, n0, p.W8in_odd, D, tile, SW8, [=](int n) { return n0 + n; }, O_FA); }
    else { int j = job - J2; const int n0 = (j % 8) * 128; conv_tile8_rm(p.w_out_odd, D, (j / 8) * 64, n0, p.W8out_odd, D, tile, SW8, [=](int n) { return n0 + n; }); }
  }
}

__device__ __forceinline__ void phase_fold_z(const Params& p, long gtid, long gstride, float* tab) {
  if (tidx() < 64) {
    float sn, cs;
    sincospif((float)tidx() * (1.0f / 32.0f), &sn, &cs);
    tab[tidx()] = cs; tab[64 + tidx()] = -sn;
  }
  __syncthreads();
  for (long i = gtid; i < (long)256 * D; i += gstride) {
    const int k = (int)(i % D), col = (int)(i / D);
    const int g = col >> 6, cp = col & 63;
    const float* wz = p.w_in_odd + (long)k * IN_ODD + O_Z + g * 64;
    float s0 = 0.f, s1 = 0.f;
    float4 wv[16];
#pragma unroll
    for (int q = 0; q < 16; ++q) wv[q] = reinterpret_cast<const float4*>(wz)[q];
#pragma unroll
    for (int q = 0; q < 16; ++q) {
      const int i0 = ((4 * q) * cp) & 63, i1 = ((4 * q + 1) * cp) & 63, i2 = ((4 * q + 2) * cp) & 63, i3 = ((4 * q + 3) * cp) & 63;
      s0 += wv[q].x * tab[i0] + wv[q].y * tab[i1] + wv[q].z * tab[i2] + wv[q].w * tab[i3];
      s1 += wv[q].x * tab[64 + i0] + wv[q].y * tab[64 + i1] + wv[q].z * tab[64 + i2] + wv[q].w * tab[64 + i3];
    }
    const unsigned q0 = pack4_fp8(s0 * SW8, s1 * SW8, 0.f, 0.f);
    p.W8in_odd[(long)(O_FA + col) * D + k] = (unsigned char)(q0 & 0xffu);
    p.W8in_odd[(long)(O_FA + 256 + col) * D + k] = (unsigned char)((q0 >> 8) & 0xffu);
  }
  for (long i = gtid; i < (long)(IN_ODD_PAD - O_END) * D; i += gstride) p.W8in_odd[(long)O_END * D + i] = 0;
}

__device__ __forceinline__ void phase_cmat(const Params& p, long gtid, long gstride) {
  for (long i = gtid; i < (long)T * T; i += gstride) {
    const int t = (int)(i % T), tp = (int)(i / T);
    float sn, cs;
    sincospif((float)((t * tp) & (T - 1)) * (2.0f / T), &sn, &cs);
    stA(p.Cmat + (long)tp * 2 * T + t, cs);
    stA(p.Cmat + (long)tp * 2 * T + T + t, sn);
  }
}

__device__ __forceinline__ void row_stats(const float4 (&v)[4], float& mu, float& rs) {
  float s = 0.f;
#pragma unroll
  for (int i = 0; i < 4; ++i) s += v[i].x + v[i].y + v[i].z + v[i].w;
  mu = wave_sum(s) * (1.0f / D);
  float q = 0.f;
#pragma unroll
  for (int i = 0; i < 4; ++i) {
    float a = v[i].x - mu, b = v[i].y - mu, c = v[i].z - mu, d = v[i].w - mu;
    q += a * a + b * b + c * c + d * d;
  }
  rs = 1.0f / sqrtf(wave_sum(q) * (1.0f / D) + LN_EPS);
}

__device__ __forceinline__ void phase_lnmod_first(const Params& p) {
  const int lane = tidx() & 63;
  const int nw = (int)gridDim.x * 4, wi = (((int)gridDim.x & 63) ? (int)blockIdx.x : ((int)blockIdx.x >> 6) * 64 + ((int)blockIdx.x & 7) * 8 + (((int)blockIdx.x >> 3) & 7)) * 4 + (int)(tidx() >> 6);
  const int rpw = (NR + nw - 1) / nw;
  const long r0 = (long)wi * rpw, r1 = min((long)NR, r0 + rpw);
  float4 shv[4], scv[4];
  int cur_bb = -2;
  float4 hv[4];
  auto load_row = [&](long row) {
    const float4* h = reinterpret_cast<const float4*>(hrow_in(p, row));
#pragma unroll
    for (int i = 0; i < 4; ++i) hv[i] = h[i * 64 + lane];
  };
  if (r0 < r1) load_row(r0);
  for (long row = r0; row < r1; ++row) {
    const int bb = row < NC ? NB : (int)((row - NC) / T);
    if (bb != cur_bb) {
      cur_bb = bb;
      const float* md = g_mod + (long)bb * 6 * D;
#pragma unroll
      for (int i = 0; i < 4; ++i) {
        shv[i] = reinterpret_cast<const float4*>(md)[i * 64 + lane];
        scv[i] = reinterpret_cast<const float4*>(md + D)[i * 64 + lane];
      }
    }
    float4 v[4];
#pragma unroll
    for (int i = 0; i < 4; ++i) v[i] = hv[i];
    load_row(min(row + 1, r1 - 1));
    float mu, rs;
    row_stats(v, mu, rs);
#pragma unroll
    for (int i = 0; i < 4; ++i) {
      const float a = (v[i].x - mu) * rs * (1.f + scv[i].x) + shv[i].x, b = (v[i].y - mu) * rs * (1.f + scv[i].y) + shv[i].y;
      const float c = (v[i].z - mu) * rs * (1.f + scv[i].z) + shv[i].z, d = (v[i].w - mu) * rs * (1.f + scv[i].w) + shv[i].w;
      reinterpret_cast<unsigned*>(p.u8 + row * D)[i * 64 + lane] = pack4_fp8(a * SU8, b * SU8, c * SU8, d * SU8);
    }
  }
}

__device__ __forceinline__ act_t* hrow16(const Params& p, long row) {
  return row < NC ? reinterpret_cast<act_t*>(p.hc) + row * D
                  : reinterpret_cast<act_t*>(reinterpret_cast<char*>(p.out) + (row - NC) * (long)(4 * D) + 2 * D);
}
template <int R_UNUSED>
__device__ __forceinline__ void phase_resid_ln(const Params& p, int l, int sub, long row_lo, long row_hi, unsigned char* smem) {
  const int lane = tidx() & 63;
  int* cntL = (int*)smem;
  int* nent = cntL + 16;
  int* entL = cntL + 32;
  float* wT = (float*)(smem + 4096);
  if (sub == 0) {
    if (tidx() < 32) cntL[tidx()] = 0;
    {
      float4 wr4[16];
#pragma unroll
      for (int j = 0; j < 4; ++j)
#pragma unroll
        for (int q = 0; q < 4; ++q) wr4[j * 4 + q] = reinterpret_cast<const float4*>(p.w_router + (long)(tidx() + 256 * j) * NEXP)[q];
#pragma unroll
      for (int j = 0; j < 4; ++j)
#pragma unroll
        for (int q = 0; q < 4; ++q) {
          const int k = tidx() + 256 * j;
          wT[(q * 4 + 0) * D + k] = wr4[j * 4 + q].x; wT[(q * 4 + 1) * D + k] = wr4[j * 4 + q].y;
          wT[(q * 4 + 2) * D + k] = wr4[j * 4 + q].z; wT[(q * 4 + 3) * D + k] = wr4[j * 4 + q].w;
        }
    }
    __syncthreads();
  }
  const bool last = (sub == 1 && l == 1);
  const int nw = (int)gridDim.x * 4, wi = (((int)gridDim.x & 63) ? (int)blockIdx.x : ((int)blockIdx.x >> 6) * 64 + ((int)blockIdx.x & 7) * 8 + (((int)blockIdx.x >> 3) & 7)) * 4 + (int)(tidx() >> 6);
  const int rpw = ((int)(row_hi - row_lo) + nw - 1) / nw;
  const long r0 = row_lo + (long)wi * rpw, r1 = min(row_hi, r0 + rpw);
  const float4* lgp = reinterpret_cast<const float4*>(p.ln_g + (l * 2 + sub) * D);
  const float4* lbp = reinterpret_cast<const float4*>(p.ln_b + (l * 2 + sub) * D);
  float4 lgv[4], lbv[4];
  if (R_UNUSED != 1) {
#pragma unroll
    for (int i = 0; i < 4; ++i) { lgv[i] = lgp[i * 64 + lane]; lbv[i] = lbp[i * 64 + lane]; }
  }
  float4 gv[4], shv[4], scv[4];
  int cur_bb = -2;
  const bool first = (l == 0 && sub == 0);
  float4 hv[4];
  uint2 hb[4];
  uint2 mv[4], m2v[4];
  auto load_row = [&](long row) {
    const uint2* m = reinterpret_cast<const uint2*>(sub == 0 ? p.M + row * D : p.Y + row * 2 * D);
    if (first) {
      const float4* hin = reinterpret_cast<const float4*>(hrow_in(p, row));
#pragma unroll
      for (int i = 0; i < 4; ++i) hv[i] = hin[i * 64 + lane];
    } else {
      const uint2* hin = reinterpret_cast<const uint2*>(hrow16(p, row));
#pragma unroll
      for (int i = 0; i < 4; ++i) hb[i] = hin[i * 64 + lane];
    }
#pragma unroll
    for (int i = 0; i < 4; ++i) {
      mv[i] = m[i * 64 + lane];
      if (sub == 1) m2v[i] = m[256 + i * 64 + lane];
    }
  };
  if (r0 < r1) load_row(r0);
  for (long row = r0; row < r1; ++row) {
    const int bb = row < NC ? NB : (int)((row - NC) / T);
    if (bb != cur_bb) {
      cur_bb = bb;
      const float* md = g_mod + ((long)l * (NB + 1) + bb) * 6 * D;
      const float* md2 = (sub == 0) ? md + 3 * D : g_mod + ((long)(NB + 1) + bb) * 6 * D;
#pragma unroll
      for (int i = 0; i < 4; ++i) {
        gv[i] = reinterpret_cast<const float4*>(md + (sub == 0 ? 2 : 5) * D)[i * 64 + lane];
        shv[i] = reinterpret_cast<const float4*>(md2)[i * 64 + lane];
        scv[i] = reinterpret_cast<const float4*>(md2 + D)[i * 64 + lane];
      }
    }
    float4 v[4];
#pragma unroll
    for (int i = 0; i < 4; ++i) {
      float m0 = bf_lo(mv[i].x), m1 = bf_hi(mv[i].x), m2_ = bf_lo(mv[i].y), m3 = bf_hi(mv[i].y);
      if (sub == 1) { m0 += bf_lo(m2v[i].x); m1 += bf_hi(m2v[i].x); m2_ += bf_lo(m2v[i].y); m3 += bf_hi(m2v[i].y); }
      const float h0 = first ? hv[i].x : bf_lo(hb[i].x), h1 = first ? hv[i].y : bf_hi(hb[i].x);
      const float h2 = first ? hv[i].z : bf_lo(hb[i].y), h3 = first ? hv[i].w : bf_hi(hb[i].y);
      v[i].x = ALPHA * h0 + gv[i].x * m0;
      v[i].y = ALPHA * h1 + gv[i].y * m1;
      v[i].z = ALPHA * h2 + gv[i].z * m2_;
      v[i].w = ALPHA * h3 + gv[i].w * m3;
    }
    load_row(min(row + 1, r1 - 1));
    if (R_UNUSED == 1) {
#pragma unroll
      for (int i = 0; i < 4; ++i) { lgv[i] = lgp[i * 64 + lane]; lbv[i] = lbp[i * 64 + lane]; }
    }
    float mu, rs;
    row_stats(v, mu, rs);
#pragma unroll
    for (int i = 0; i < 4; ++i) {
      v[i].x = (v[i].x - mu) * rs * lgv[i].x + lbv[i].x;
      v[i].y = (v[i].y - mu) * rs * lgv[i].y + lbv[i].y;
      v[i].z = (v[i].z - mu) * rs * lgv[i].z + lbv[i].z;
      v[i].w = (v[i].w - mu) * rs * lgv[i].w + lbv[i].w;
    }
    if (last) {
      float4* hout = reinterpret_cast<float4*>(p.out + (row - NC) * D);
#pragma unroll
      for (int i = 0; i < 4; ++i) hout[i * 64 + lane] = v[i];
      continue;
    }
    uint2 hq[4];
#pragma unroll
    for (int i = 0; i < 4; ++i) {
      hq[i] = make_uint2(pack2(v[i].x, v[i].y), pack2(v[i].z, v[i].w));
      v[i].x = bf_lo(hq[i].x); v[i].y = bf_hi(hq[i].x); v[i].z = bf_lo(hq[i].y); v[i].w = bf_hi(hq[i].y);
    }
    row_stats(v, mu, rs);
    float lo[NEXP];
#pragma unroll
    for (int e = 0; e < NEXP; ++e) lo[e] = 0.f;
    uint2 up[4];
#pragma unroll
    for (int i = 0; i < 4; ++i) {
      float uv[4];
      uv[0] = (v[i].x - mu) * rs * (1.f + scv[i].x) + shv[i].x;
      uv[1] = (v[i].y - mu) * rs * (1.f + scv[i].y) + shv[i].y;
      uv[2] = (v[i].z - mu) * rs * (1.f + scv[i].z) + shv[i].z;
      uv[3] = (v[i].w - mu) * rs * (1.f + scv[i].w) + shv[i].w;
      up[i] = make_uint2(pack4_fp8(uv[0] * SU8, uv[1] * SU8, uv[2] * SU8, uv[3] * SU8), 0u);
      if (sub == 0) {
#pragma unroll
        for (int e = 0; e < NEXP; ++e) {
          const float4 w4 = *reinterpret_cast<const float4*>(wT + e * D + (i * 64 + lane) * 4);
          lo[e] += uv[0] * w4.x + uv[1] * w4.y + uv[2] * w4.z + uv[3] * w4.w;
          if ((e & 3) == 3) __builtin_amdgcn_sched_barrier(0);
        }
      }
    }
    int ge1 = 0, ge2 = 0;
    float w1 = 0.f, w2 = 0.f;
    if (sub == 0) {
      float mine = 0.f;
#pragma unroll
      for (int e = 0; e < NEXP; ++e) {
        const float rsum = row_sum16(lo[e]);
        mine = ((lane & 15) == e) ? rsum : mine;
      }
      mine += __shfl_xor(mine, 16);
      mine += __shfl_xor(mine, 32);
#pragma unroll
      for (int e = 0; e < NEXP; ++e) lo[e] = __int_as_float(__builtin_amdgcn_readlane(__float_as_int(mine), e));
      float mx = lo[0];
#pragma unroll
      for (int e = 1; e < NEXP; ++e) mx = fmaxf(mx, lo[e]);
      float sum = 0.f;
#pragma unroll
      for (int e = 0; e < NEXP; ++e) { lo[e] = __expf(lo[e] - mx); sum += lo[e]; }
      const float inv = 1.0f / sum;
      float bestg = -1e30f, gp1 = 0.f, gp2 = 0.f;
#pragma unroll
      for (int gq = 0; gq < 4; ++gq) {
        float s1 = -1e30f, s2 = -1e30f, p1 = 0.f, p2 = 0.f;
        int e1 = 0, e2 = 0;
#pragma unroll
        for (int j = 0; j < 4; ++j) {
          const int e = gq * 4 + j;
          const float pe = lo[e] * inv;
          const float se = pe + p.b_router[e];
          if (se > s1) { s2 = s1; p2 = p1; e2 = e1; s1 = se; p1 = pe; e1 = e; }
          else if (se > s2) { s2 = se; p2 = pe; e2 = e; }
        }
        const float gs = s1 + s2;
        if (gs > bestg) { bestg = gs; ge1 = e1; ge2 = e2; gp1 = p1; gp2 = p2; }
      }
      const float wsum = gp1 + gp2;
      w1 = gp1 / wsum; w2 = gp2 / wsum;
    }
    {
      uint2* hout = reinterpret_cast<uint2*>(hrow16(p, row));
#pragma unroll
      for (int i = 0; i < 4; ++i) hout[i * 64 + lane] = hq[i];
    }
#pragma unroll
    for (int i = 0; i < 4; ++i) reinterpret_cast<unsigned*>(p.u8 + row * D)[i * 64 + lane] = up[i].x;
    if (sub == 0 && lane == 0) {
      p.ew[row * 2 + 0] = w1; p.ew[row * 2 + 1] = w2;
      const int lp1 = atomicAdd(cntL + ge1, 1), lp2 = atomicAdd(cntL + ge2, 1);
      const int ei = atomicAdd(nent, 2);
      entL[3 * ei] = ((int)(row * 2) << 4) | ge1; entL[3 * ei + 1] = lp1; entL[3 * ei + 2] = __float_as_int(w1);
      entL[3 * ei + 3] = ((int)(row * 2 + 1) << 4) | ge2; entL[3 * ei + 4] = lp2; entL[3 * ei + 5] = __float_as_int(w2);
    }
  }
  if (sub == 0) {
    __syncthreads();
    if (tidx() < NEXP) {
      const int c = cntL[tidx()];
      cntL[tidx()] = c ? atomicAdd(p.cnt + (l * NEXP + tidx()) * 64, c) : 0;
    }
    __syncthreads();
    const int ne = *nent;
    for (int i = tidx(); i < ne; i += 256) {
      const int key = entL[3 * i], lp = entL[3 * i + 1];
      const int e = key & 15;
      const long li = (long)(l * NEXP + e) * NR + cntL[e] + lp;
      p.list[li] = key >> 4;
      p.listw[li] = __int_as_float(entL[3 * i + 2]);
    }
    __syncthreads();
  }
}

#define LOOP(n) for (long i = gtid; i < (long)(n); i += gstride)

#ifdef ONLY_PHASE
#define PH(n, ...) if (ONLY_PHASE == n) { __VA_ARGS__ }
#define GSYNC()
#else
#define PH(n, ...) { __VA_ARGS__ }
#define GSYNC() xcd_barrier(xb)
#endif

__global__ void __launch_bounds__(256, 2) mega_kernel(Params p) {
  cg::grid_group grid = cg::this_grid();
  __shared__ __attribute__((aligned(16))) unsigned char smem[SMEM_BYTES + 16];
  if (threadIdx.x == 0) *reinterpret_cast<uint4*>(smem + SMEM_BYTES) = make_uint4(0u, 0u, 0u, 0u);
  __syncthreads();
  XcdBarrier xb = xcd_barrier_post(g_bar, (volatile LAS unsigned*)(smem + SMEM_BYTES));
  const long gtid = (long)blockIdx.x * blockDim.x + threadIdx.x;
  const long gstride = (long)gridDim.x * blockDim.x;
  const int nsb = min(256, (int)gridDim.x / 2);
  PH(0,
    if (gtid < 2 * NEXP) p.cnt[gtid * 64] = 0;
    phase_convert_dense(p, smem);
    phase_fold_z(p, gtid, gstride, (float*)(smem + 65536));
    LOOP(1024) ph_tables(p, i);)
#ifndef ONLY_PHASE
  if (p.use_cg_sync) grid.sync();
#endif
  GSYNC();
  PH(1, phase_lnmod_first(p);)
  GSYNC();
  PH(2, phase_gemm(p, GemmJob{(const act_t*)p.u8, (const act_t*)p.W8in_even, p.P, 0, 0, 0, 1, NR / 128, IN_EVEN / 128, D, PW, IN_EVEN, 2, 1.0f / (SU8 * SW8), 1, 0}, smem);)
  GSYNC();
  PH(3,
    if ((int)blockIdx.x < nsb) phase_scan<0>(p, smem, blockIdx.x, nsb);
    else phase_attn(p, smem, blockIdx.x - nsb, gridDim.x - nsb);)
  GSYNC();
  PH(4, phase_combine<0>(p);)
  GSYNC();
  PH(5,
    phase_gemm(p, GemmJob{(const act_t*)p.O8, (const act_t*)p.W8out_even, p.M, 0, 0, 0, 1, NR / 128, D / 128, D, D, D, 0, 1.0f / (SO8 * SW8), 1, 0}, smem);
    {
      const int rem = ((NR / 128) * (D / 128)) % (int)gridDim.x;
      if (rem > 0 && rem < (int)gridDim.x) { if ((int)blockIdx.x >= rem) phase_convert_experts(p, 0, smem, blockIdx.x - rem, gridDim.x - rem); }
      else phase_convert_experts(p, 0, smem, blockIdx.x, gridDim.x);
    })
  GSYNC();
  PH(6, phase_resid_ln<1>(p, 0, 0, 0, NR, smem);)
  GSYNC();
  PH(7, phase_moe(p, 0, false, smem);)
  GSYNC();
  PH(8, phase_moe(p, 0, true, smem);)
  GSYNC();
  PH(9, phase_resid_ln<2>(p, 0, 1, 0, NR, smem); phase_cmat(p, gtid, gstride);)
  GSYNC();
  PH(10, phase_gemm(p, GemmJob{(const act_t*)p.u8, (const act_t*)p.W8in_odd, p.P, 0, 0, 0, 1, NR / 128, IN_ODD_PAD / 128, D, PW, O_FA, 1, 1.0f / (SU8 * SW8), 1, 0}, smem);)
  GSYNC();
  PH(11, phase_gla_decay(p);)
  GSYNC();
  PH(12,
    if ((int)blockIdx.x < nsb) phase_scan<1>(p, smem, blockIdx.x, nsb);
    else {
      phase_gemm(p, GemmJob{p.Cmat, p.FT, (act_t*)(p.O8 + (long)NC * D + 768), 0, (long)256 * 2 * T, (long)T * D, NB, T / 128, 2, 2 * T, D,
                            256, 0, 0.00276213586400995f * SO8, 0, 1}, smem, blockIdx.x - nsb, gridDim.x - nsb);
      phase_convert_experts(p, 1, smem, blockIdx.x - nsb, gridDim.x - nsb);
    })
  GSYNC();
  PH(13, phase_combine<1>(p);)
  GSYNC();
  PH(14,
    phase_gemm(p, GemmJob{(const act_t*)(p.O8 + (long)NC * D), (const act_t*)p.W8out_odd, p.M + (long)NC * D, 0, 0, 0, 1, NT / 128, D / 128, D, D, D, 0, 1.0f / (SO8 * SW8), 1, 0}, smem);)
  GSYNC();
  PH(15, phase_resid_ln<1>(p, 1, 0, NC, NR, smem);)
  GSYNC();
  PH(16, phase_moe(p, 1, false, smem);)
  GSYNC();
  PH(17, phase_moe(p, 1, true, smem);)
  GSYNC();
  PH(18, phase_resid_ln<2>(p, 1, 1, NC, NR, smem);)
#ifndef ONLY_PHASE
  {
    volatile LAS unsigned* st = (volatile LAS unsigned*)(smem + SMEM_BYTES);
    __syncthreads();
    if (threadIdx.x == 0) st[2] = (__hip_atomic_fetch_add(&g_exit, 1u, __ATOMIC_RELAXED, __HIP_MEMORY_SCOPE_AGENT) == gridDim.x - 1u) ? 1u : 0u;
    __syncthreads();
    if (st[2]) {
      for (int i = threadIdx.x; i < G_MOD_FLOATS / 4; i += 256) reinterpret_cast<float4*>(g_mod)[i] = make_float4(0.f, 0.f, 0.f, 0.f);
      for (int i = threadIdx.x; i < G_BAR_WORDS; i += 256) g_bar[i] = 0u;
      if (threadIdx.x == 0) g_exit = 0u;
    }
  }
#endif
}

static size_t carve(Params& p, char* ws) {
  size_t off = 0;
  auto take = [&](size_t bytes) { char* r = ws + off; off += (bytes + 255) & ~(size_t)255; return r; };
  p.mod = (float*)take(sizeof(float) * 2 * (NB + 1) * 6 * D);
  p.bar = (unsigned*)take(sizeof(unsigned) * XCD_BAR_WORDS);
  p.hc = (float*)take(sizeof(float) * (size_t)NC * D);
  p.costab = (float*)take(sizeof(float) * T);
  p.sintab = (float*)take(sizeof(float) * T);
  p.lbt = (float*)take(sizeof(float) * 1024);
  p.ropetab = (float*)take(sizeof(float) * 64 * 16 * 2);
  p.ew = (float*)take(sizeof(float) * (size_t)NR * 2);
  p.eidx = nullptr;
  p.u = nullptr;
  p.O8 = (unsigned char*)take((size_t)NR * D);
  p.P = (act_t*)take(sizeof(act_t) * (size_t)NR * PW);
  p.OF = (act_t*)take(sizeof(act_t) * (size_t)NR * 768);
  p.OB = (act_t*)take(sizeof(act_t) * (size_t)NR * 768);
  p.M = p.OF;
  p.Cmat = (act_t*)take(sizeof(act_t) * (size_t)T * 2 * T);
  p.FT = (act_t*)take(sizeof(act_t) * (size_t)NB * 256 * 2 * T);
  p.LF = (act_t*)take(sizeof(act_t) * (size_t)2 * NR * 384);
  p.W8up = (unsigned char*)p.Cmat;
  p.W8down = p.W8up + (size_t)NEXP * 1024 * D;
  p.W8up1 = (unsigned char*)take((size_t)NEXP * 1024 * (D + DFF));
  p.W8down1 = p.W8up1 + (size_t)NEXP * 1024 * D;
  p.u8 = (unsigned char*)take((size_t)NR * D);
  p.Y = p.P;
  p.H8 = (unsigned char*)(p.P + (size_t)2 * NR * D);
  p.cnt = (int*)take(sizeof(int) * 2 * NEXP * 64);
  p.list = (int*)take(sizeof(int) * (size_t)2 * NEXP * NR);
  p.listw = (float*)take(sizeof(float) * (size_t)2 * NEXP * NR);
  p.Wt_in_even = nullptr;
  p.W8in_even = (unsigned char*)take((size_t)IN_EVEN * D);
  p.Wt_out_even = nullptr;
  p.W8out_even = (unsigned char*)take((size_t)D * D);
  p.Wt_in_odd = nullptr;
  p.W8in_odd = (unsigned char*)take((size_t)IN_ODD_PAD * D);
  p.Wt_out_odd = nullptr;
  p.W8out_odd = (unsigned char*)take((size_t)D * D);
  return off;
}

static void fill_inputs(Params& p, void* const* d_in) {
  const float** f = (const float**)&p;
  for (int i = 0; i < 23; ++i) f[i] = (const float*)d_in[i];
}

extern "C" void kernel_launch(void* const* d_in, const int* in_sizes, int n_in, void* d_out, int out_size,
                              void* d_ws, size_t ws_size, hipStream_t stream) {
  static int grid_blocks = 0;
  if (!grid_blocks) {
    int dev = 0, cus = 0, per_cu = 0;
    (void)hipGetDevice(&dev);
    (void)hipDeviceGetAttribute(&cus, hipDeviceAttributeMultiprocessorCount, dev);
    (void)hipOccupancyMaxActiveBlocksPerMultiprocessor(&per_cu, mega_kernel, 256, 0);
    grid_blocks = cus * per_cu;
  }
  Params p{};
  fill_inputs(p, d_in);
  p.out = (float*)d_out;
  size_t need = carve(p, (char*)d_ws);
  if (need > ws_size) { fprintf(stderr, "workspace too small: need %zu have %zu\n", need, ws_size); return; }
  void* args[] = {&p};
  hipError_t e = hipLaunchCooperativeKernel((void*)mega_kernel, dim3(grid_blocks), dim3(256), args, 0, stream);
  if (e != hipSuccess) fprintf(stderr, "cooperative launch failed: %s (grid %d)\n", hipGetErrorString(e), grid_blocks);
}
#endif
```
